# Optimizing an MI355X kernel written in HIP

```python
import math
import numpy as np
import jax
import jax.numpy as jnp
from jax import lax


D_MODEL = 2048
BATCH = 8
SEQ = 4096
DEPTH = 4

CHUNK = 64
N_EVEN = (DEPTH + 1) // 2
N_ODD = DEPTH // 2
ROPE_THETA = 500000.0
NORM_EPS = 1e-5

A_HEADS = 8
A_HEAD_DIM = 128
A_ROPE_DIM = A_HEAD_DIM // 4
A_NOPE_DIM = A_HEAD_DIM - A_ROPE_DIM
A_V_DIM = 128
A_WIDTH = A_HEADS * A_V_DIM
A_Q_RANK = 512
A_KV_RANK = 256
IDX_HEADS = 16
IDX_DIM = 64
IDX_ROPE_DIM = IDX_DIM // 4
TOPK_MAX = 256
Q_BLOCK = 128

B_HEAD = 64
B_WIDTH = D_MODEL // 2
B_HEADS = B_WIDTH // B_HEAD
B_DECAY_LORA = 64
B_A_LORA = 64
B_GATE_LORA = 160
B_LN_EPS = 64e-5

C_WIDTH = D_MODEL
C_GROUP = 16
C_GROUPS = C_WIDTH // C_GROUP
C_STATE = 64

MEM_LEN = 256
X_HEADS = 4
X_HEAD_DIM = 128

FFN_DIM = 4 * D_MODEL

A_COLS = A_Q_RANK + A_KV_RANK + A_ROPE_DIM + IDX_DIM + IDX_HEADS
B_COLS = 3 * B_WIDTH + B_DECAY_LORA + B_A_LORA + B_GATE_LORA
EVEN_COLS = A_COLS + B_COLS

kernel_name = 'hybrid_dsa_rwkv7_s5_stream_encoder'


def rms_norm(x, g):
    xf = x.astype(jnp.float32)
    y = xf * lax.rsqrt(jnp.mean(xf * xf, axis=-1, keepdims=True) + NORM_EPS)
    return (y * g.astype(jnp.float32)).astype(x.dtype)


def split_cols(t, sizes):
    offs = np.cumsum(sizes)[:-1].tolist()
    return jnp.split(t, offs, axis=-1)


def rope_tables(pos, rot_dim):
    inv_freq = ROPE_THETA ** (-jnp.arange(0, rot_dim, 2, dtype=jnp.float32) / rot_dim)
    ang = pos[..., None] * inv_freq
    return jnp.cos(ang), jnp.sin(ang)


def apply_partial_rope(x, cos, sin, rot_dim):
    xf = x.astype(jnp.float32)
    half = rot_dim // 2
    x1, x2, rest = xf[..., :half], xf[..., half:rot_dim], xf[..., rot_dim:]
    out = jnp.concatenate([x1 * cos - x2 * sin, x2 * cos + x1 * sin, rest], axis=-1)
    return out.astype(x.dtype)


def token_shift(t):
    return jnp.pad(t[:, :-1], ((0, 0), (1, 0), (0, 0)))


def dsa_mixer(h, cos_a, sin_a, cos_i, sin_i, cq_norm, ckv_norm, kidx_norm, w_uq, w_uk, w_uv, w_qidx):
    f32 = jnp.float32
    bsz, seq, _ = h.shape
    c_q, c_kv, k_rope, k_idx, w_idx = split_cols(h, [A_Q_RANK, A_KV_RANK, A_ROPE_DIM, IDX_DIM, IDX_HEADS])
    c_q = rms_norm(c_q, cq_norm)
    c_kv = rms_norm(c_kv, ckv_norm)
    k_rope = apply_partial_rope(k_rope, cos_a, sin_a, A_ROPE_DIM)
    q = jnp.einsum('bsr,rhd->bshd', c_q, w_uq)
    q_rope = apply_partial_rope(q[..., :A_ROPE_DIM], cos_a[:, :, None], sin_a[:, :, None], A_ROPE_DIM)
    q_lat = jnp.einsum('bshd,rhd->bshr', q[..., A_ROPE_DIM:], w_uk)
    q_idx = apply_partial_rope(jnp.einsum('bsr,rhd->bshd', c_q, w_qidx), cos_i[:, :, None], sin_i[:, :, None], IDX_ROPE_DIM)
    k_idx = apply_partial_rope(rms_norm(k_idx, kidx_norm), cos_i, sin_i, IDX_ROPE_DIM)
    w_idx = w_idx.astype(f32) * (IDX_HEADS ** -0.5) * (IDX_DIM ** -0.5)

    topk = min(TOPK_MAX, seq // 4)
    n_blk = seq // Q_BLOCK
    scale = A_HEAD_DIM ** -0.5
    key_pos = jnp.arange(seq, dtype=jnp.int32)
    gather = jax.vmap(lambda table, idx: table[idx])

    def to_blocks(t):
        return t.reshape((bsz, n_blk, Q_BLOCK) + t.shape[2:]).swapaxes(0, 1)

    def attend_block(args):
        ql, qr, qi, wi, t0 = args
        q_pos = t0 + jnp.arange(Q_BLOCK, dtype=jnp.int32)
        limit = (q_pos // CHUNK + 1) * CHUNK
        allowed = key_pos[None, :] < limit[:, None]
        logits = jnp.einsum('bqhd,bsd->bqhs', qi.astype(f32), k_idx.astype(f32))
        score = jnp.einsum('bqh,bqhs->bqs', wi, jax.nn.relu(logits))
        score = jnp.where(allowed[None], score, -jnp.inf)
        _, sel = lax.top_k(score, topk)
        valid = sel < limit[None, :, None]
        ckv_sel = gather(c_kv, sel)
        kr_sel = gather(k_rope, sel)
        s = (jnp.einsum('bqhr,bqkr->bqhk', ql, ckv_sel).astype(f32)
             + jnp.einsum('bqhd,bqkd->bqhk', qr, kr_sel).astype(f32)) * scale
        s = jnp.where(valid[:, :, None, :], s, -jnp.inf)
        p = jax.nn.softmax(s, axis=-1).astype(ckv_sel.dtype)
        return jnp.einsum('bqhk,bqkr->bqhr', p, ckv_sel)

    blk_start = jnp.arange(n_blk, dtype=jnp.int32) * Q_BLOCK
    o_lat = lax.map(attend_block, (to_blocks(q_lat), to_blocks(q_rope), to_blocks(q_idx), to_blocks(w_idx), blk_start))
    o_lat = o_lat.swapaxes(0, 1).reshape(bsz, seq, A_HEADS, A_KV_RANK)
    return jnp.einsum('bshr,rhd->bshd', o_lat, w_uv).reshape(bsz, seq, A_WIDTH)


def rwkv7_mixer(h, mu, w0, w2, a0, a2, g2, k_k, k_a, r_k, ln_w, ln_b):
    f32 = jnp.float32
    bsz, seq, _ = h.shape
    hm = h + (token_shift(h) - h) * mu
    r, k, v, wl, al, gl = split_cols(hm, [B_WIDTH, B_WIDTH, B_WIDTH, B_DECAY_LORA, B_A_LORA, B_GATE_LORA])
    log_w = -jax.nn.softplus(-(w0 + jnp.tanh(wl) @ w2).astype(f32)) - 0.5
    decay = jnp.exp(-jnp.exp(log_w))
    a = jax.nn.sigmoid((a0 + al @ a2).astype(f32))
    g = (jax.nn.sigmoid(gl) @ g2).astype(f32)

    def heads(t):
        return t.reshape(bsz, seq, B_HEADS, B_HEAD)

    r, k, v = heads(r.astype(f32)), heads(k.astype(f32)), heads(v.astype(f32))
    decay, a = heads(decay), heads(a)
    kk = k * k_k.astype(f32).reshape(B_HEADS, B_HEAD)
    kk = kk * lax.rsqrt(jnp.maximum(jnp.sum(kk * kk, axis=-1, keepdims=True), 1e-24))
    k = k * (1.0 + (a - 1.0) * k_a.astype(f32).reshape(B_HEADS, B_HEAD))

    def step(state, inp):
        r_t, w_t, k_t, v_t, kk_t, a_t = inp
        sa = jnp.einsum('bhvk,bhk->bhv', state, -kk_t)
        state = (state * w_t[:, :, None, :] + sa[..., None] * (kk_t * a_t)[:, :, None, :]
                 + v_t[..., None] * k_t[:, :, None, :])
        return state, jnp.einsum('bhvk,bhk->bhv', state, r_t)

    tm = lambda t: jnp.moveaxis(t, 1, 0)
    state0 = jnp.zeros((bsz, B_HEADS, B_HEAD, B_HEAD), f32)
    _, out = lax.scan(step, state0, (tm(r), tm(decay), tm(k), tm(v), tm(kk), tm(a)))
    out = jnp.moveaxis(out, 0, 1)
    mean = jnp.mean(out, axis=-1, keepdims=True)
    var = jnp.mean(jnp.square(out - mean), axis=-1, keepdims=True)
    out = ((out - mean) * lax.rsqrt(var + B_LN_EPS)).reshape(bsz, seq, B_WIDTH)
    out = out * ln_w.astype(f32) + ln_b.astype(f32)
    bonus = jnp.sum(r * k * r_k.astype(f32), axis=-1, keepdims=True) * v
    out = (out + bonus.reshape(bsz, seq, B_WIDTH)) * g
    return out.astype(h.dtype)


def s5_mixer(u, lam_re, lam_im, log_dt, b_re, b_im, c_re, c_im, d_skip, w_glu, b_glu):
    f32 = jnp.float32
    bsz, seq, _ = u.shape
    lam = lax.complex(jnp.minimum(lam_re.astype(f32), -1e-4), lam_im.astype(f32))
    dt = jnp.exp(log_dt.astype(f32))[:, None]
    lam_bar = jnp.exp(lam * dt)
    b_bar = ((lam_bar - 1.0) / lam)[..., None] * lax.complex(b_re.astype(f32), b_im.astype(f32))
    c_mat = lax.complex(c_re.astype(f32), c_im.astype(f32))
    n_chunk = seq // CHUNK
    uf = u.astype(f32)
    u_chunks = jnp.moveaxis(uf.reshape(bsz, n_chunk, CHUNK, C_GROUPS, C_GROUP), 1, 0)
    a_elem = jnp.broadcast_to(lam_bar, (bsz, CHUNK, C_GROUPS, C_STATE))

    def combine(e1, e2):
        a1, x1 = e1
        a2, x2 = e2
        return a1 * a2, a2 * x1 + x2

    def chunk_step(state, u_c):
        bu = jnp.einsum('bcgi,gpi->bcgp', u_c.astype(jnp.complex64), b_bar)
        bu = bu.at[:, 0].add(lam_bar * state)
        _, states = lax.associative_scan(combine, (a_elem, bu), axis=1)
        y = jnp.einsum('bcgp,gip->bcgi', states, c_mat).real
        return states[:, -1], y

    state0 = jnp.zeros((bsz, C_GROUPS, C_STATE), jnp.complex64)
    _, y = lax.scan(chunk_step, state0, u_chunks)
    y = jnp.moveaxis(y, 0, 1).reshape(bsz, seq, C_WIDTH) + d_skip.astype(f32) * uf
    z = jax.nn.gelu(y)
    out = z * jax.nn.sigmoid(z @ w_glu.astype(f32) + b_glu.astype(f32))
    return out.astype(u.dtype)


def memory_cross_attention(xn, memn, wq, wkv, wo):
    f32 = jnp.float32
    bsz, seq, _ = xn.shape
    q = (xn @ wq).reshape(bsz, seq, X_HEADS, X_HEAD_DIM)
    kv = (memn @ wkv).reshape(bsz, memn.shape[1], 2, X_HEADS, X_HEAD_DIM)
    s = jnp.einsum('bshd,bmhd->bshm', q, kv[:, :, 0]).astype(f32) * (X_HEAD_DIM ** -0.5)
    p = jax.nn.softmax(s, axis=-1).astype(xn.dtype)
    o = jnp.einsum('bshm,bmhd->bshd', p, kv[:, :, 1]).reshape(bsz, seq, X_HEADS * X_HEAD_DIM)
    return o @ wo


def squared_relu_mlp(xn, w_up, w_down):
    return jnp.square(jax.nn.relu(xn @ w_up)) @ w_down


def setup_inputs(seed: int = 0) -> dict:
    key = jax.random.key(seed)
    ks = iter(jax.random.split(key, 64))
    f32 = jnp.float32

    def nrm(shape, scale):
        return scale * jax.random.normal(next(ks), shape, f32)

    def gain(shape):
        return 1.0 + 0.02 * jax.random.normal(next(ks), shape, f32)

    ramp = (jnp.arange(B_WIDTH, dtype=f32) / (B_WIDTH - 1)) ** 0.85
    inp = {}
    inp['x'] = nrm((BATCH, SEQ, D_MODEL), 1.0)
    inp['mem'] = nrm((BATCH, MEM_LEN, D_MODEL), 1.0)
    inp['start_frame'] = jax.random.randint(next(ks), (BATCH,), 0, 256, dtype=jnp.int32) * CHUNK
    inp['norm_mix'] = gain((DEPTH, D_MODEL))
    inp['norm_xattn'] = gain((DEPTH, D_MODEL))
    inp['norm_mem'] = gain((DEPTH, D_MODEL))
    inp['norm_ffn'] = gain((DEPTH, D_MODEL))
    inp['final_norm'] = gain((D_MODEL,))
    inp['xattn_wq'] = nrm((DEPTH, D_MODEL, X_HEADS * X_HEAD_DIM), D_MODEL ** -0.5)
    inp['xattn_wkv'] = nrm((DEPTH, D_MODEL, 2 * X_HEADS * X_HEAD_DIM), D_MODEL ** -0.5)
    inp['xattn_wo'] = nrm((DEPTH, X_HEADS * X_HEAD_DIM, D_MODEL), (X_HEADS * X_HEAD_DIM) ** -0.5)
    inp['ffn_up'] = nrm((DEPTH, D_MODEL, FFN_DIM), D_MODEL ** -0.5)
    inp['ffn_down'] = nrm((DEPTH, FFN_DIM, D_MODEL), FFN_DIM ** -0.5)
    inp['even_w_in'] = nrm((N_EVEN, D_MODEL, EVEN_COLS), D_MODEL ** -0.5)
    inp['even_w_out'] = nrm((N_EVEN, A_WIDTH + B_WIDTH, D_MODEL), (A_WIDTH + B_WIDTH) ** -0.5)
    inp['dsa_cq_norm'] = gain((N_EVEN, A_Q_RANK))
    inp['dsa_ckv_norm'] = gain((N_EVEN, A_KV_RANK))
    inp['dsa_kidx_norm'] = gain((N_EVEN, IDX_DIM))
    inp['dsa_w_uq'] = nrm((N_EVEN, A_Q_RANK, A_HEADS, A_HEAD_DIM), A_Q_RANK ** -0.5)
    inp['dsa_w_uk'] = nrm((N_EVEN, A_KV_RANK, A_HEADS, A_NOPE_DIM), A_KV_RANK ** -0.5)
    inp['dsa_w_uv'] = nrm((N_EVEN, A_KV_RANK, A_HEADS, A_V_DIM), A_KV_RANK ** -0.5)
    inp['dsa_w_qidx'] = nrm((N_EVEN, A_Q_RANK, IDX_HEADS, IDX_DIM), A_Q_RANK ** -0.5)
    inp['rwkv_mu'] = jax.random.uniform(next(ks), (N_EVEN, B_COLS), f32)
    inp['rwkv_w0'] = -6.0 + 5.0 * ramp + nrm((N_EVEN, B_WIDTH), 0.1)
    inp['rwkv_w2'] = nrm((N_EVEN, B_DECAY_LORA, B_WIDTH), 0.5 * B_DECAY_LORA ** -0.5)
    inp['rwkv_a0'] = nrm((N_EVEN, B_WIDTH), 0.1)
    inp['rwkv_a2'] = nrm((N_EVEN, B_A_LORA, B_WIDTH), B_A_LORA ** -0.5)
    inp['rwkv_g2'] = nrm((N_EVEN, B_GATE_LORA, B_WIDTH), B_GATE_LORA ** -0.5)
    inp['rwkv_k_k'] = 0.85 + nrm((N_EVEN, B_WIDTH), 0.02)
    inp['rwkv_k_a'] = gain((N_EVEN, B_WIDTH))
    inp['rwkv_r_k'] = -0.04 + nrm((N_EVEN, B_HEADS, B_HEAD), 0.1)
    inp['rwkv_ln_w'] = gain((N_EVEN, B_WIDTH))
    inp['rwkv_ln_b'] = nrm((N_EVEN, B_WIDTH), 0.02)
    inp['odd_w_in'] = nrm((N_ODD, D_MODEL, C_WIDTH), D_MODEL ** -0.5)
    inp['odd_w_out'] = nrm((N_ODD, C_WIDTH, D_MODEL), C_WIDTH ** -0.5)
    inp['s5_lam_re'] = -0.5 + nrm((N_ODD, C_GROUPS, C_STATE), 0.01)
    inp['s5_lam_im'] = math.pi * jnp.arange(C_STATE, dtype=f32) + nrm((N_ODD, C_GROUPS, C_STATE), 0.01)
    inp['s5_log_dt'] = jax.random.uniform(next(ks), (N_ODD, C_GROUPS), f32, math.log(1e-3), math.log(1e-1))
    inp['s5_b_re'] = nrm((N_ODD, C_GROUPS, C_STATE, C_GROUP), (2 * C_GROUP) ** -0.5)
    inp['s5_b_im'] = nrm((N_ODD, C_GROUPS, C_STATE, C_GROUP), (2 * C_GROUP) ** -0.5)
    inp['s5_c_re'] = nrm((N_ODD, C_GROUPS, C_GROUP, C_STATE), C_STATE ** -0.5)
    inp['s5_c_im'] = nrm((N_ODD, C_GROUPS, C_GROUP, C_STATE), C_STATE ** -0.5)
    inp['s5_d'] = nrm((N_ODD, C_WIDTH), 1.0)
    inp['s5_w_glu'] = nrm((N_ODD, C_WIDTH, C_WIDTH), C_WIDTH ** -0.5)
    inp['s5_b_glu'] = nrm((N_ODD, C_WIDTH), 0.02)
    return inp


def reference(x, mem, start_frame, norm_mix, norm_xattn, norm_mem, norm_ffn, final_norm,
              xattn_wq, xattn_wkv, xattn_wo, ffn_up, ffn_down, even_w_in, even_w_out,
              dsa_cq_norm, dsa_ckv_norm, dsa_kidx_norm, dsa_w_uq, dsa_w_uk, dsa_w_uv, dsa_w_qidx,
              rwkv_mu, rwkv_w0, rwkv_w2, rwkv_a0, rwkv_a2, rwkv_g2, rwkv_k_k, rwkv_k_a, rwkv_r_k,
              rwkv_ln_w, rwkv_ln_b, odd_w_in, odd_w_out, s5_lam_re, s5_lam_im, s5_log_dt,
              s5_b_re, s5_b_im, s5_c_re, s5_c_im, s5_d, s5_w_glu, s5_b_glu):
    bsz, seq, _ = x.shape
    pos = (start_frame[:, None] + jnp.arange(seq, dtype=jnp.int32)[None, :]).astype(jnp.float32)
    cos_a, sin_a = rope_tables(pos, A_ROPE_DIM)
    cos_i, sin_i = rope_tables(pos, IDX_ROPE_DIM)
    for layer in range(DEPTH):
        i = layer // 2
        xn = rms_norm(x, norm_mix[layer])
        if layer % 2 == 0:
            h = xn @ even_w_in[i]
            y_a = dsa_mixer(h[..., :A_COLS], cos_a, sin_a, cos_i, sin_i, dsa_cq_norm[i], dsa_ckv_norm[i],
                            dsa_kidx_norm[i], dsa_w_uq[i], dsa_w_uk[i], dsa_w_uv[i], dsa_w_qidx[i])
            y_b = rwkv7_mixer(h[..., A_COLS:], rwkv_mu[i], rwkv_w0[i], rwkv_w2[i], rwkv_a0[i], rwkv_a2[i],
                              rwkv_g2[i], rwkv_k_k[i], rwkv_k_a[i], rwkv_r_k[i], rwkv_ln_w[i], rwkv_ln_b[i])
            mix = jnp.concatenate([y_a, y_b], axis=-1) @ even_w_out[i]
        else:
            y_c = s5_mixer(xn @ odd_w_in[i], s5_lam_re[i], s5_lam_im[i], s5_log_dt[i], s5_b_re[i], s5_b_im[i],
                           s5_c_re[i], s5_c_im[i], s5_d[i], s5_w_glu[i], s5_b_glu[i])
            mix = y_c @ odd_w_out[i]
        x = x + mix
        x = x + memory_cross_attention(rms_norm(x, norm_xattn[layer]), rms_norm(mem, norm_mem[layer]),
                                       xattn_wq[layer], xattn_wkv[layer], xattn_wo[layer])
        x = x + squared_relu_mlp(rms_norm(x, norm_ffn[layer]), ffn_up[layer], ffn_down[layer])
    return rms_norm(x, final_norm)
```

```cpp
#include <hip/hip_runtime.h>
#include <cstdio>
#include <cstdint>

#ifndef DIAG
#define DIAG 0
#endif
#ifndef ATTN_SPLIT
#define ATTN_SPLIT 0
#endif
#ifndef DBL
#define DBL 0
#endif
#ifndef MK_ONE_LAUNCH
#define MK_ONE_LAUNCH 1
#endif

constexpr int D = 2048, NB = 8, SEQ = 4096, M = NB * SEQ, DEPTH = 4;
constexpr int HC = 4352;
constexpr int EVEN_COLS = 4240, A_COLS = 880, B_COLS = 3360;
constexpr int QC = 3328;
constexpr int OC = 3072;
constexpr int KFW = 288;
constexpr int FFN = 8192;
constexpr int MEMR = NB * 256;
constexpr float NORM_EPS = 1e-5f;
constexpr size_t SC_PER_BATCH = (size_t)4096 * 64 * 65 / 2;

typedef unsigned short bf16;
typedef float f32x4 __attribute__((ext_vector_type(4)));
typedef unsigned u32x4 __attribute__((ext_vector_type(4)));
typedef unsigned u32x2 __attribute__((ext_vector_type(2)));
typedef float f32x2 __attribute__((ext_vector_type(2)));
#define LAS __attribute__((address_space(3)))

constexpr size_t MiB = 1u << 20;
constexpr size_t al256(size_t x) { return (x + 255) & ~(size_t)255; }
constexpr size_t WS_CTL = 0, CTL_BYTES = 1 * MiB;
constexpr size_t WS_ROPEA = WS_CTL + CTL_BYTES;
constexpr size_t WS_ROPEI = WS_ROPEA + (size_t)M * 32 * 4;
constexpr size_t WS_KVBIG = WS_ROPEI + (size_t)M * 16 * 4;
constexpr size_t WS_WKV = WS_KVBIG + (size_t)8192 * 4096 * 2;
constexpr size_t WS_WMIX = WS_WKV + (size_t)4096 * 2048 * 2;
constexpr size_t WMIX_IN = 0, WMIX_Q = (size_t)HC * 2048 * 2, WMIX_OUT = WMIX_Q + (size_t)QC * 512 * 2, WMIX_BYTES = WMIX_OUT + (size_t)2048 * OC * 2;
constexpr size_t WMIX_O_IN = 0, WMIX_O_GLU = (size_t)2048 * 2048 * 2, WMIX_O_OUT = 2 * WMIX_O_GLU;
constexpr size_t WS_WXQ = al256(WS_WMIX + WMIX_BYTES);
constexpr size_t WS_WXO = WS_WXQ + (size_t)512 * 2048 * 2;
constexpr size_t WS_WUP = WS_WXO + (size_t)2048 * 512 * 2;
constexpr size_t WS_WDN = WS_WUP + (size_t)FFN * 2048 * 2;
constexpr size_t WS_CQN = WS_WDN + (size_t)2048 * FFN * 2;
constexpr size_t WS_KF = WS_CQN + (size_t)M * 512 * 2;
constexpr size_t WS_KIDX = WS_KF + (size_t)M * KFW * 2;
constexpr size_t WS_WIDX = WS_KIDX + (size_t)M * 64 * 2;
constexpr size_t WS_SEL = WS_WIDX + (size_t)M * 16 * 4;
constexpr size_t WS_R1 = al256(WS_SEL + (size_t)M * 256 * 2);
constexpr size_t R1_BYTES = (size_t)M * HC * 2;
constexpr size_t WS_R2 = WS_R1 + R1_BYTES;
constexpr size_t R2_BYTES = (size_t)M * QC * 2;
constexpr size_t WS_R3 = WS_R2 + R2_BYTES;
constexpr size_t R3_BYTES = (size_t)M * OC * 2;
constexpr size_t WS_END = WS_R3 + R3_BYTES;
static_assert(SC_PER_BATCH * NB * 4 <= R1_BYTES, "scores fit R1");
static_assert((size_t)8192 * FFN * 2 <= R1_BYTES && (size_t)M * 2048 * 2 * 2 <= R1_BYTES, "R1 overlays");

__device__ __forceinline__ float bf2f(unsigned v) { return __uint_as_float(v << 16); }
__device__ __forceinline__ unsigned f2bf(float f) { unsigned u = __float_as_uint(f); return (u + 0x7fffu + ((u >> 16) & 1u)) >> 16; }
__device__ __forceinline__ unsigned pk2(float lo, float hi) { return f2bf(lo) | (f2bf(hi) << 16); }
__device__ __forceinline__ float wave_sum(float v) {
#pragma unroll
    for (int o = 1; o < 64; o <<= 1) v += __shfl_xor(v, o);
    return v;
}
__device__ __forceinline__ float wave_max(float v) {
#pragma unroll
    for (int o = 1; o < 64; o <<= 1) v = fmaxf(v, __shfl_xor(v, o));
    return v;
}
__device__ __forceinline__ void unpack8(const u32x4 w, float* f) {
    f[0] = __uint_as_float(w.x << 16); f[1] = __uint_as_float(w.x & 0xffff0000u); f[2] = __uint_as_float(w.y << 16); f[3] = __uint_as_float(w.y & 0xffff0000u);
    f[4] = __uint_as_float(w.z << 16); f[5] = __uint_as_float(w.z & 0xffff0000u); f[6] = __uint_as_float(w.w << 16); f[7] = __uint_as_float(w.w & 0xffff0000u);
}
__device__ __forceinline__ float sigmoidf_(float x) { return 1.f / (1.f + __expf(-x)); }
namespace pg8 {
#define PG8_LAS __attribute__((address_space(3)))
typedef unsigned short bf16_t;
typedef short bf16x8 __attribute__((ext_vector_type(8)));
typedef float f32x4 __attribute__((ext_vector_type(4)));
typedef unsigned u32x4 __attribute__((ext_vector_type(4)));
constexpr int BM = 256, BK = 64, HALF = 128, HTB = HALF * BK * 2, STAGE_BYTES = 8 * HTB, NXCD = 8, WGM = 8;

__host__ __device__ __forceinline__ int lds_byte(int r, int c) { const int st = (r >> 4) * 2 + (c >> 5), rr = r & 15, cc = c & 31, ob = rr * 64 + cc * 2; return st * 1024 + (ob ^ (((ob >> 9) & 1) << 5)); }
__host__ __device__ __forceinline__ void stage_rc(int b, int& R, int& C) { const int st = b / 1024, sb = b % 1024, swz = sb ^ (((sb >> 9) & 1) << 5); R = (st >> 1) * 16 + swz / 64; C = (st & 1) * 32 + (swz % 64) / 2; }
__host__ __device__ __forceinline__ int perm32(int rho) { const int n = rho >> 4, i = rho & 15; return 8 * (i >> 2) + 4 * n + (i & 3); }

struct Unit { int pm, pn; };
struct Gemm { const bf16_t* A; const bf16_t* Bt; int lda, ldb, K, pad; };

struct StaticOrder {
    int nM, nN, nwg, G, c;
    __host__ __device__ void init(int nM_, int nN_, int G_, int c_) { nM = nM_; nN = nN_; nwg = nM * nN; G = G_; c = c_; }
    __host__ __device__ bool next(int i, Unit& u) const {
        const long L = (long)i * G + c; if (L >= nwg) return false;
        int wgid = (int)L; { const int q = nwg / NXCD, r = nwg % NXCD, xcd = wgid % NXCD, off = wgid / NXCD; wgid = (xcd < r ? xcd * (q + 1) : r * (q + 1) + (xcd - r) * q) + off; }
        const int nig = WGM * nN, gid = wgid / nig, fm = gid * WGM, gsz = (nM - fm) < WGM ? (nM - fm) : WGM;
        u.pm = fm + ((wgid % nig) % gsz); u.pn = (wgid % nig) / gsz; return true;
    }
    __device__ __forceinline__ void a_ready(const Unit&) const {}
    __device__ __forceinline__ void done(const Unit&) const {}
};
struct KvOrder {
    int G, c;
    __device__ bool next(int i, Unit& u) const { const int L = i * G + c; if (L >= 128) return false; const int ly = L >> 5, r = L & 31; u.pm = ly * 8 + (r & 7); u.pn = ly * 4 + (r >> 3); return true; }
    __device__ __forceinline__ void a_ready(const Unit&) const {}
    __device__ __forceinline__ void done(const Unit&) const {}
};

__device__ __forceinline__ unsigned cvt_pk_bf16(float lo, float hi) { unsigned r; asm volatile("v_cvt_pk_bf16_f32 %0, %1, %2" : "=v"(r) : "v"(lo), "v"(hi)); return r; }

template <int ACT> struct EpiBf16 {
    static constexpr bool PERM = true, AFTER_DRAIN = false;
    bf16_t* O; int ldc; const unsigned long long* rowss;
    __device__ __forceinline__ void operator()(const f32x4 (&acc)[2][2][4][2], const Unit& u, int wr, int wc, int fr, int fq) const {
        const int row0 = u.pm * BM + wr * 64 + fr; const int col0 = u.pn * BM + wc * 32 + 8 * fq;
#pragma unroll
        for (int ai = 0; ai < 2; ++ai)
#pragma unroll
            for (int m = 0; m < 4; ++m) { bf16_t* rowp = O + (size_t)(row0 + ai * HALF + m * 16) * ldc + col0;
                const float rs = rowss ? 1.0f / sqrtf((float)rowss[row0 + ai * HALF + m * 16] * (5.9604644775390625e-08f / 2048.f) + 1e-5f) : 1.f;
#pragma unroll
                for (int bj = 0; bj < 2; ++bj) { f32x4 v0 = acc[ai][bj][m][0] * rs, v1 = acc[ai][bj][m][1] * rs;
                    if (ACT == 1) {
#pragma unroll
                        for (int j = 0; j < 4; ++j) { const float a = fmaxf(v0[j], 0.f), b = fmaxf(v1[j], 0.f); v0[j] = a * a; v1[j] = b * b; } }
                    u32x4 w; w.x = cvt_pk_bf16(v0[0], v0[1]); w.y = cvt_pk_bf16(v0[2], v0[3]); w.z = cvt_pk_bf16(v1[0], v1[1]); w.w = cvt_pk_bf16(v1[2], v1[3]);
                    *(u32x4*)(rowp + bj * HALF) = w; } }
    }
};
struct EpiRes {
    static constexpr bool PERM = false, AFTER_DRAIN = false;
    bf16_t* xb; int ldc; unsigned long long* rowss;
    __device__ __forceinline__ void operator()(const f32x4 (&acc)[2][2][4][2], const Unit& u, int wr, int wc, int fr, int fq) const {
        typedef unsigned u32x2_ __attribute__((ext_vector_type(2)));
        const int row0 = u.pm * BM + wr * 64 + fr, col0 = u.pn * BM + wc * 32 + 4 * fq;
#pragma unroll
        for (int ai = 0; ai < 2; ++ai)
#pragma unroll
            for (int m = 0; m < 4; ++m) { bf16_t* rp = xb + (size_t)(row0 + ai * HALF + m * 16) * ldc + col0; float ss = 0.f;
                u32x2_ bv[2][2];
#pragma unroll
                for (int bj = 0; bj < 2; ++bj)
#pragma unroll
                    for (int n = 0; n < 2; ++n) bv[bj][n] = *(const u32x2_*)(rp + bj * HALF + n * 16);
#pragma unroll
                for (int bj = 0; bj < 2; ++bj)
#pragma unroll
                    for (int n = 0; n < 2; ++n) { const u32x2_ b = bv[bj][n]; f32x4 x = acc[ai][bj][m][n];
                        x[0] += __uint_as_float(b.x << 16); x[1] += __uint_as_float(b.x & 0xffff0000u); x[2] += __uint_as_float(b.y << 16); x[3] += __uint_as_float(b.y & 0xffff0000u);
                        u32x2_ w; w.x = cvt_pk_bf16(x[0], x[1]); w.y = cvt_pk_bf16(x[2], x[3]); *(u32x2_*)(rp + bj * HALF + n * 16) = w;
                        const float r0 = __uint_as_float(w.x << 16), r1 = __uint_as_float(w.x & 0xffff0000u), r2 = __uint_as_float(w.y << 16), r3 = __uint_as_float(w.y & 0xffff0000u);
                        ss += (r0 * r0 + r1 * r1) + (r2 * r2 + r3 * r3); }
                ss += __shfl_xor(ss, 16); ss += __shfl_xor(ss, 32);
                if (fq == 0) atomicAdd(rowss + row0 + ai * HALF + m * 16, (unsigned long long)(ss * 16777216.0f));
                asm volatile("" ::: "memory"); }
    }
};
struct EpiGlu {
    static constexpr bool PERM = true, AFTER_DRAIN = false;
    const bf16_t* Z; bf16_t* O; int ldc; const float* bias;
    __device__ __forceinline__ void operator()(const f32x4 (&acc)[2][2][4][2], const Unit& u, int wr, int wc, int fr, int fq) const {
        const int row0 = u.pm * BM + wr * 64 + fr; const int col0 = u.pn * BM + wc * 32 + 8 * fq;
        f32x4 bv[2][2];
#pragma unroll
        for (int bj = 0; bj < 2; ++bj)
#pragma unroll
            for (int n = 0; n < 2; ++n) bv[bj][n] = *(const f32x4*)(bias + col0 + bj * HALF + 4 * n);
#pragma unroll
        for (int ai = 0; ai < 2; ++ai)
#pragma unroll
            for (int m = 0; m < 4; ++m) { const size_t off = (size_t)(row0 + ai * HALF + m * 16) * ldc + col0;
#pragma unroll
                for (int bj = 0; bj < 2; ++bj) { const f32x4 v0 = acc[ai][bj][m][0] + bv[bj][0], v1 = acc[ai][bj][m][1] + bv[bj][1];
                    const u32x4 zz = *(const u32x4*)(Z + off + bj * HALF); float z[8], o[8];
                    z[0] = __uint_as_float(zz.x << 16); z[1] = __uint_as_float(zz.x & 0xffff0000u); z[2] = __uint_as_float(zz.y << 16); z[3] = __uint_as_float(zz.y & 0xffff0000u);
                    z[4] = __uint_as_float(zz.z << 16); z[5] = __uint_as_float(zz.z & 0xffff0000u); z[6] = __uint_as_float(zz.w << 16); z[7] = __uint_as_float(zz.w & 0xffff0000u);
#pragma unroll
                    for (int j = 0; j < 4; ++j) { o[j] = z[j] / (1.f + __expf(-v0[j])); o[4 + j] = z[4 + j] / (1.f + __expf(-v1[j])); }
                    u32x4 w; w.x = cvt_pk_bf16(o[0], o[1]); w.y = cvt_pk_bf16(o[2], o[3]); w.z = cvt_pk_bf16(o[4], o[5]); w.w = cvt_pk_bf16(o[6], o[7]);
                    *(u32x4*)(O + off + bj * HALF) = w; }
                asm volatile("" ::: "memory"); }
    }
};

template <class Epi, class Sched, bool ALIGN_EPI = false, bool SP2 = false>
__device__ __forceinline__ void gemm_phase(PG8_LAS unsigned char* lds, const Gemm g, const Sched& S, const Epi& E) {
    int tid_l = threadIdx.x; asm volatile("" : "+v"(tid_l));
    const int tid = tid_l, wid = __builtin_amdgcn_readfirstlane(tid >> 6), lane = tid & 63, wr = wid >> 2, wc = wid & 3, fr = lane & 15, fq = lane >> 4;
    const int K = g.K, nt = K / BK;
    unsigned voffA[2], voffB[2];
#pragma unroll
    for (int i = 0; i < 2; ++i) { int R, C; stage_rc(tid * 16 + i * 8192, R, C); const int Rb = Epi::PERM ? ((R & ~31) + perm32(R & 31)) : R;
        voffA[i] = (unsigned)(R * g.lda + C) * 2u; voffB[i] = (unsigned)(Rb * g.ldb + C) * 2u; }
    const size_t kstep = (size_t)(BK * 2);
    const size_t hstepA = (size_t)HALF * g.lda * 2, hstepB = (size_t)HALF * g.ldb * 2;
    const size_t tstepA = 2 * hstepA, tstepB = 2 * hstepB;
    const unsigned ldsw = (unsigned)wid * 1024u;
    const int aoff = lds_byte(wr * 64 + fr, fq * 8), boff = lds_byte(wc * 32 + fr, fq * 8);
#define PG8_SA(b, h) (((b) * 2 + (h)) * HTB)
#define PG8_SB(b, h) ((4 + (b) * 2 + (h)) * HTB)
#define PG8_STAGE(bufoff, gbase, voff) do { _Pragma("unroll") for (int _i = 0; _i < 2; ++_i) \
        __builtin_amdgcn_global_load_lds((const unsigned*)((const char*)(gbase) + (voff)[_i]), (PG8_LAS unsigned*)(lds + (bufoff) + ldsw + _i * 8192), 16, 0, 0); } while (0)
#define PG8_LDA(dst, b, h) do { _Pragma("unroll") for (int m = 0; m < 4; ++m) _Pragma("unroll") for (int k = 0; k < 2; ++k) dst[m][k] = *(const PG8_LAS bf16x8*)(lds + PG8_SA(b, h) + aoff + m * 2048 + k * 1024); } while (0)
#define PG8_LDB(dst, b, h) do { _Pragma("unroll") for (int n = 0; n < 2; ++n) _Pragma("unroll") for (int k = 0; k < 2; ++k) dst[n][k] = *(const PG8_LAS bf16x8*)(lds + PG8_SB(b, h) + boff + n * 2048 + k * 1024); } while (0)
#define PG8_MMA(ai, bj, At, Bt) do { __builtin_amdgcn_s_setprio(1); _Pragma("unroll") for (int m = 0; m < 4; ++m) _Pragma("unroll") for (int n = 0; n < 2; ++n) _Pragma("unroll") for (int k = 0; k < 2; ++k) \
        acc[ai][bj][m][n] = __builtin_amdgcn_mfma_f32_16x16x32_bf16(Bt[n][k], At[m][k], acc[ai][bj][m][n], 0, 0, 0); __builtin_amdgcn_s_setprio(0); } while (0)
#define PG8_WAIT_V(n) asm volatile("s_waitcnt vmcnt(" #n ")" ::: "memory")
#define PG8_WAIT_L(n) asm volatile("s_waitcnt lgkmcnt(" #n ")" ::: "memory")
#define PG8_BAR __builtin_amdgcn_s_barrier()
#define PG8_SCHED __builtin_amdgcn_sched_barrier(0)
    Unit cur, nxt; int ui = 0;
    if (!S.next(0, cur)) return;
    f32x4 acc[2][2][4][2];
#pragma unroll
    for (int a = 0; a < 2; ++a)
#pragma unroll
        for (int b = 0; b < 2; ++b)
#pragma unroll
            for (int m = 0; m < 4; ++m)
#pragma unroll
                for (int n = 0; n < 2; ++n) acc[a][b][m][n] = (f32x4){0.f, 0.f, 0.f, 0.f};
    bf16x8 At[4][2], B0[2][2], B1[2][2];
    const char* cA = (const char*)g.A + (size_t)cur.pm * tstepA; const char* cB = (const char*)g.Bt + (size_t)cur.pn * tstepB;
    S.a_ready(cur);
    if constexpr (SP2) {
        PG8_STAGE(PG8_SB(0, 0), cB, voffB); PG8_STAGE(PG8_SB(0, 1), cB + hstepB, voffB); PG8_STAGE(PG8_SA(0, 0), cA, voffA); PG8_STAGE(PG8_SA(0, 1), cA + hstepA, voffA);
        if (wr == 1) PG8_BAR;
        PG8_WAIT_V(2); PG8_BAR;
        PG8_STAGE(PG8_SB(1, 0), cB + kstep, voffB); PG8_STAGE(PG8_SA(1, 0), cA + kstep, voffA); PG8_STAGE(PG8_SB(1, 1), cB + hstepB + kstep, voffB);
        PG8_WAIT_V(6); PG8_BAR;
    } else {
        PG8_STAGE(PG8_SB(0, 0), cB, voffB); PG8_STAGE(PG8_SA(0, 0), cA, voffA); PG8_STAGE(PG8_SB(0, 1), cB + hstepB, voffB); PG8_STAGE(PG8_SA(0, 1), cA + hstepA, voffA);
        if (wr == 1) PG8_BAR;
        PG8_WAIT_V(4); PG8_BAR;
        PG8_STAGE(PG8_SB(1, 0), cB + kstep, voffB); PG8_STAGE(PG8_SA(1, 0), cA + kstep, voffA); PG8_STAGE(PG8_SB(1, 1), cB + hstepB + kstep, voffB);
        PG8_WAIT_V(6); PG8_BAR;
    }
    for (;;) {
        const bool has_next = S.next(ui + 1, nxt);
        const char* nA = has_next ? (const char*)g.A + (size_t)nxt.pm * tstepA : cA; const char* nB = has_next ? (const char*)g.Bt + (size_t)nxt.pn * tstepB : cB;
        for (int t = 0; t < nt; t += 2) {
            const bool last = (t == nt - 2);
            const char* a1 = cA + (size_t)(t + 1) * kstep;
            const char* a2 = last ? nA : cA + (size_t)(t + 2) * kstep; const char* b2 = last ? nB : cB + (size_t)(t + 2) * kstep;
            const char* a3 = a2 + kstep; const char* b3 = b2 + kstep;
            if (last && has_next) S.a_ready(nxt);
            if constexpr (SP2) {
            PG8_LDB(B0, 0, 0); PG8_LDB(B1, 0, 1); PG8_SCHED; PG8_LDA(At, 0, 0); PG8_STAGE(PG8_SA(1, 1), a1 + hstepA, voffA);
            PG8_WAIT_V(8); PG8_WAIT_L(0); PG8_BAR; PG8_MMA(0, 0, At, B0); PG8_MMA(0, 1, At, B1); PG8_BAR; PG8_SCHED;
            PG8_LDA(At, 0, 1); PG8_STAGE(PG8_SB(0, 0), b2, voffB); PG8_STAGE(PG8_SB(0, 1), b2 + hstepB, voffB); PG8_STAGE(PG8_SA(0, 0), a2, voffA);
            PG8_WAIT_V(8); PG8_WAIT_L(0); PG8_BAR; PG8_MMA(1, 0, At, B0); PG8_MMA(1, 1, At, B1); PG8_BAR; PG8_SCHED;
            PG8_LDB(B0, 1, 0); PG8_LDB(B1, 1, 1); PG8_SCHED; PG8_LDA(At, 1, 0); PG8_STAGE(PG8_SA(0, 1), a2 + hstepA, voffA);
            PG8_WAIT_V(8); PG8_WAIT_L(0); PG8_BAR; PG8_MMA(0, 0, At, B0); PG8_MMA(0, 1, At, B1); PG8_BAR; PG8_SCHED;
            PG8_LDA(At, 1, 1); PG8_STAGE(PG8_SB(1, 0), b3, voffB); PG8_STAGE(PG8_SB(1, 1), b3 + hstepB, voffB); PG8_STAGE(PG8_SA(1, 0), a3, voffA);
            PG8_WAIT_V(8); PG8_WAIT_L(0); PG8_BAR; PG8_MMA(1, 0, At, B0); PG8_MMA(1, 1, At, B1); PG8_BAR; PG8_SCHED;
            } else {
            PG8_LDB(B0, 0, 0); PG8_SCHED; PG8_LDA(At, 0, 0); PG8_STAGE(PG8_SA(1, 1), a1 + hstepA, voffA);
            PG8_WAIT_L(8); PG8_BAR; PG8_WAIT_L(0); PG8_MMA(0, 0, At, B0); PG8_BAR; PG8_SCHED;
            PG8_LDB(B1, 0, 1); PG8_STAGE(PG8_SB(0, 0), b2, voffB);
            PG8_BAR; PG8_WAIT_L(0); PG8_MMA(0, 1, At, B1); PG8_BAR;
            PG8_LDA(At, 0, 1); PG8_STAGE(PG8_SA(0, 0), a2, voffA);
            PG8_BAR; PG8_WAIT_L(0); PG8_MMA(1, 0, At, B0); PG8_BAR; PG8_SCHED;
            PG8_STAGE(PG8_SB(0, 1), b2 + hstepB, voffB);
            PG8_WAIT_V(6); PG8_BAR; PG8_MMA(1, 1, At, B1); PG8_BAR;
            PG8_LDB(B0, 1, 0); PG8_SCHED; PG8_LDA(At, 1, 0); PG8_STAGE(PG8_SA(0, 1), a2 + hstepA, voffA);
            PG8_WAIT_L(8); PG8_BAR; PG8_WAIT_L(0); PG8_MMA(0, 0, At, B0); PG8_BAR; PG8_SCHED;
            PG8_LDB(B1, 1, 1); PG8_STAGE(PG8_SB(1, 0), b3, voffB);
            PG8_BAR; PG8_WAIT_L(0); PG8_MMA(0, 1, At, B1); PG8_BAR;
            PG8_LDA(At, 1, 1); PG8_STAGE(PG8_SA(1, 0), a3, voffA);
            PG8_BAR; PG8_WAIT_L(0); PG8_MMA(1, 0, At, B0); PG8_BAR; PG8_SCHED;
            PG8_STAGE(PG8_SB(1, 1), b3 + hstepB, voffB);
            PG8_WAIT_V(6); PG8_BAR; PG8_MMA(1, 1, At, B1); PG8_BAR;
            }
        }
        if constexpr (ALIGN_EPI) { if (wr == 0) PG8_BAR; }
        E(acc, cur, wr, wc, fr, fq); S.done(cur);
        if (!has_next) break;
#pragma unroll
        for (int a = 0; a < 2; ++a)
#pragma unroll
            for (int b = 0; b < 2; ++b)
#pragma unroll
                for (int m = 0; m < 4; ++m)
#pragma unroll
                    for (int n = 0; n < 2; ++n) acc[a][b][m][n] = (f32x4){0.f, 0.f, 0.f, 0.f};
        cur = nxt; cA = nA; cB = nB; ++ui;
        if constexpr (ALIGN_EPI) { if (wr == 1) PG8_BAR; }
    }
    PG8_WAIT_V(0);
    if constexpr (!ALIGN_EPI) { if (wr == 0) PG8_BAR; }
    PG8_BAR;
#undef PG8_SA
#undef PG8_SB
#undef PG8_STAGE
#undef PG8_LDA
#undef PG8_LDB
#undef PG8_MMA
#undef PG8_WAIT_V
#undef PG8_WAIT_L
#undef PG8_BAR
#undef PG8_SCHED
}
}
#define XB_TMO      128
#define XB_XCNT(j)  (256  + 64 * (j))
#define XB_XSUB(j)  (1280 + 64 * (j))
#define XB_XGEN(j)  (2304 + 64 * (j))
#define XB_TOP      3328
#define XB_TOPGEN   3392
#define XCD_BAR_WORDS 3456
#define XB_SPIN_CAP (1u << 18)
__device__ __forceinline__ unsigned xb_ld(unsigned* p)              { return __hip_atomic_load(p, __ATOMIC_RELAXED, __HIP_MEMORY_SCOPE_AGENT); }
__device__ __forceinline__ unsigned xb_add(unsigned* p, unsigned v) { return __hip_atomic_fetch_add(p, v, __ATOMIC_RELAXED, __HIP_MEMORY_SCOPE_AGENT); }
__device__ __forceinline__ unsigned xb_xcc_id() { return (unsigned)__builtin_amdgcn_s_getreg((3 << 11) | 20) & 0xFu; }
#define XB_SPIN(cond, bar) do { unsigned _sp = 0; while (cond) { __builtin_amdgcn_s_sleep(1); \
    if ((++_sp & 255u) == 0u) { if (xb_ld(&(bar)[XB_TMO])) break; if (_sp > XB_SPIN_CAP) { atomicAdd(&(bar)[XB_TMO], 1u); break; } } } } while (0)
struct XcdBarrier { unsigned* bar; unsigned x; volatile LAS unsigned* st; unsigned G; };
__device__ __forceinline__ XcdBarrier xcd_barrier_post(unsigned* bar, volatile LAS unsigned* st, unsigned G) {
    XcdBarrier b; b.bar = bar; b.x = xb_xcc_id(); b.st = st; b.G = G;
    if (threadIdx.x == 0) (void)xb_add(&bar[XB_XCNT(b.x)], 1u);
    return b;
}
__device__ __forceinline__ void xcd_barrier_complete(unsigned* bar, unsigned x, unsigned G, unsigned& nloc, unsigned& nx) {
    unsigned sum, cnt, mine, sp = 0u;
    for (;;) {
        sum = 0u; cnt = 0u; mine = 0u;
#pragma unroll
        for (unsigned j = 0; j < 16; ++j) { const unsigned c = xb_ld(&bar[XB_XCNT(j)]); sum += c; cnt += (c > 0u) ? 1u : 0u; mine = (j == x) ? c : mine; }
        if (sum == G) break;
        __builtin_amdgcn_s_sleep(1);
        if ((++sp & 255u) == 0u) { if (xb_ld(&bar[XB_TMO])) break; if (sp > XB_SPIN_CAP) { atomicAdd(&bar[XB_TMO], 1u); break; } }
    }
    nloc = mine > 0u ? mine : 1u; nx = cnt > 0u ? cnt : 1u;
}
__device__ __forceinline__ void xcd_barrier(const XcdBarrier& b) {
    asm volatile("s_waitcnt vmcnt(0)" ::: "memory");
    __syncthreads();
    if (threadIdx.x == 0) {
        unsigned* bar = b.bar;
        __builtin_amdgcn_s_waitcnt(0);
        unsigned nloc = b.st[0], nx = b.st[1];
        if (nloc == 0u) { xcd_barrier_complete(bar, b.x, b.G, nloc, nx); b.st[0] = nloc; b.st[1] = nx; }
        const unsigned old = xb_add(&bar[XB_XSUB(b.x)], 1u);
        const unsigned gen = old / nloc;
        if (old + 1u == (gen + 1u) * nloc) {
            __builtin_amdgcn_fence(__ATOMIC_RELEASE, "agent");
            asm volatile("s_waitcnt vmcnt(0)" ::: "memory");
            const unsigned og = xb_add(&bar[XB_TOP], 1u);
            const unsigned tg = og / nx;
            if (og + 1u == (tg + 1u) * nx) xb_add(&bar[XB_TOPGEN], 1u);
            else XB_SPIN(xb_ld(&bar[XB_TOPGEN]) == tg, bar);
            __builtin_amdgcn_fence(__ATOMIC_ACQUIRE, "agent");
            xb_add(&bar[XB_XGEN(b.x)], 1u);
            asm volatile("s_waitcnt vmcnt(0)" ::: "memory");
        } else {
            XB_SPIN(xb_ld(&bar[XB_XGEN(b.x)]) == gen, bar);
            __builtin_amdgcn_fence(__ATOMIC_ACQUIRE, "agent");
            asm volatile("s_waitcnt vmcnt(0)" ::: "memory");
        }
    }
    __syncthreads();
}

constexpr int NWAVES = 8, NTHR = 512;
constexpr int LDS_BYTES = 155648;
constexpr int MISC_OFF = LDS_BYTES - 256;
struct Ctx { unsigned char* lds; int tid, lane, wave, gw, ngw, bid, nb; };

__device__ __forceinline__ void tr_item(const float* __restrict__ W, int ldw, int N, bf16* __restrict__ WT, int ldt, int row_off, int col_off, int kb, int nb, float* scr, int lane, const float* __restrict__ gk) {
    const int k0 = 64 * kb, n0 = 32 * nb; const int n = n0 + (lane & 31);
#pragma unroll 8
    for (int i = 0; i < 32; ++i) { const int kk = 2 * i + (lane >> 5); float v = (n < N) ? W[(size_t)(k0 + kk) * ldw + n] : 0.f; if (gk) v *= gk[k0 + kk]; scr[kk * 33 + (lane & 31)] = v; }
    __builtin_amdgcn_fence(__ATOMIC_RELEASE, "wavefront"); __builtin_amdgcn_wave_barrier(); __builtin_amdgcn_fence(__ATOMIC_ACQUIRE, "wavefront");
    const int c = lane & 7;
#pragma unroll
    for (int j = 0; j < 4; ++j) { const int nn = (lane >> 3) + 8 * j; const float* s = scr + (8 * c) * 33 + nn;
        u32x4 o; o.x = pk2(s[0 * 33], s[1 * 33]); o.y = pk2(s[2 * 33], s[3 * 33]); o.z = pk2(s[4 * 33], s[5 * 33]); o.w = pk2(s[6 * 33], s[7 * 33]);
        *(u32x4*)(WT + (size_t)(row_off + n0 + nn) * ldt + col_off + k0 + 8 * c) = o; }
    __builtin_amdgcn_fence(__ATOMIC_RELEASE, "wavefront"); __builtin_amdgcn_wave_barrier(); __builtin_amdgcn_fence(__ATOMIC_ACQUIRE, "wavefront");
}
__device__ __forceinline__ void conv_mat(const Ctx& c, const float* W, int K, int ldw, int N, int Npad, bf16* WT, int ldt, int row_off, int col_off, const float* gk = nullptr) {
    float* scr = (float*)(c.lds + c.wave * 8704);
    const int nblk = Npad / 32, nit = (K / 64) * nblk;
    for (int it = c.gw; it < nit; it += c.ngw) tr_item(W, ldw, N, WT, ldt, row_off, col_off, it / nblk, it % nblk, scr, c.lane, gk);
}

__device__ __forceinline__ void norm_rows_bf16(const Ctx& c, const float* __restrict__ X, const float* __restrict__ g, bf16* __restrict__ O, int nrows) {
    f32x4 gv[8];
#pragma unroll
    for (int j = 0; j < 8; ++j) gv[j] = *(const f32x4*)(g + 4 * c.lane + 256 * j);
    for (int m = c.gw; m < nrows; m += c.ngw) {
        const f32x4* xr = (const f32x4*)(X + (size_t)m * D) + c.lane; f32x4 v[8]; float s = 0.f;
#pragma unroll
        for (int j = 0; j < 8; ++j) { v[j] = xr[64 * j]; s += (v[j].x * v[j].x + v[j].y * v[j].y) + (v[j].z * v[j].z + v[j].w * v[j].w); }
        const float rstd = 1.0f / sqrtf(wave_sum(s) * (1.f / D) + NORM_EPS);
        u32x2* o8 = (u32x2*)(O + (size_t)m * D) + c.lane;
#pragma unroll
        for (int j = 0; j < 8; ++j) { u32x2 w; w.x = pk2(v[j].x * rstd * gv[j].x, v[j].y * rstd * gv[j].y); w.y = pk2(v[j].z * rstd * gv[j].z, v[j].w * rstd * gv[j].w); o8[64 * j] = w; }
    }
}
__device__ __forceinline__ void cast_rows_ss(const Ctx& c, const float* __restrict__ X, bf16* __restrict__ O, unsigned long long* rowss, int nrows) {
    for (int m = c.gw; m < nrows; m += c.ngw) {
        const f32x4* xr = (const f32x4*)(X + (size_t)m * D) + c.lane; f32x4 v[8]; float s = 0.f;
#pragma unroll
        for (int j = 0; j < 8; ++j) { v[j] = xr[64 * j]; s += (v[j].x * v[j].x + v[j].y * v[j].y) + (v[j].z * v[j].z + v[j].w * v[j].w); }
        s = wave_sum(s);
        u32x2* o8 = (u32x2*)(O + (size_t)m * D) + c.lane;
#pragma unroll
        for (int j = 0; j < 8; ++j) { u32x2 w; w.x = pk2(v[j].x, v[j].y); w.y = pk2(v[j].z, v[j].w); o8[64 * j] = w; }
        if (c.lane == 0) rowss[m] = (unsigned long long)(s * 16777216.0f);
    }
}
__device__ __forceinline__ void scale_rows_out(const Ctx& c, const bf16* __restrict__ XB, const float* __restrict__ g, const unsigned long long* rowss, float* O, int nrows) {
    for (int m = c.gw; m < nrows; m += c.ngw) {
        const float rstd = 1.0f / sqrtf((float)rowss[m] * (5.9604644775390625e-08f / D) + NORM_EPS);
#pragma unroll
        for (int j = 0; j < 4; ++j) { float x[8]; unpack8(*(const u32x4*)(XB + (size_t)m * D + 8 * c.lane + 512 * j), x);
            const f32x4 g0 = *(const f32x4*)(g + 8 * c.lane + 512 * j), g1 = *(const f32x4*)(g + 8 * c.lane + 512 * j + 4);
            *(f32x4*)(O + (size_t)m * D + 8 * c.lane + 512 * j) = (f32x4){x[0] * rstd * g0.x, x[1] * rstd * g0.y, x[2] * rstd * g0.z, x[3] * rstd * g0.w};
            *(f32x4*)(O + (size_t)m * D + 8 * c.lane + 512 * j + 4) = (f32x4){x[4] * rstd * g1.x, x[5] * rstd * g1.y, x[6] * rstd * g1.z, x[7] * rstd * g1.w}; }
    }
}
__device__ __forceinline__ void norm_rows_f32(const Ctx& c, float* X, const float* __restrict__ g, int nrows) {
    f32x4 gv[8];
#pragma unroll
    for (int j = 0; j < 8; ++j) gv[j] = *(const f32x4*)(g + 4 * c.lane + 256 * j);
    for (int m = c.gw; m < nrows; m += c.ngw) {
        f32x4* xr = (f32x4*)(X + (size_t)m * D) + c.lane; f32x4 v[8]; float s = 0.f;
#pragma unroll
        for (int j = 0; j < 8; ++j) { v[j] = xr[64 * j]; s += (v[j].x * v[j].x + v[j].y * v[j].y) + (v[j].z * v[j].z + v[j].w * v[j].w); }
        const float rstd = 1.0f / sqrtf(wave_sum(s) * (1.f / D) + NORM_EPS);
#pragma unroll
        for (int j = 0; j < 8; ++j) xr[64 * j] = v[j] * rstd * gv[j];
    }
}

__device__ __forceinline__ void rope_tables(const Ctx& c, const int* __restrict__ start_frame, float* ropea, float* ropei) {
    const float HA[16] = {1.000000000e+00f, 4.403665960e-01f, 1.939227432e-01f, 8.539710194e-02f, 3.760603070e-02f, 1.656044088e-02f, 7.292664610e-03f, 3.211446106e-03f, 1.414213562e-03f, 6.227724371e-04f, 2.742481884e-04f, 1.207697351e-04f, 5.318295734e-05f, 2.341999971e-05f, 1.031338525e-05f, 4.541670478e-06f};
    const float LA[16] = {0.000000000e+00f, 6.688275267e-09f, 1.547429962e-09f, -1.652958881e-09f, 2.282729838e-10f, -8.020459852e-10f, 1.273676581e-10f, -1.116812753e-10f, -1.115275407e-14f, -1.514006802e-11f, -1.268531807e-11f, 2.335000249e-12f, 1.624761415e-12f, -7.452659366e-13f, 1.309491117e-13f, 2.687890499e-15f};
    const float HI[8] = {1.000000000e+00f, 1.939227432e-01f, 3.760603070e-02f, 7.292664610e-03f, 1.414213562e-03f, 2.742481884e-04f, 5.318295734e-05f, 1.031338525e-05f};
    const float LI[8] = {0.000000000e+00f, 1.547429962e-09f, 2.282729838e-10f, 1.273676581e-10f, -1.115275407e-14f, -1.268531807e-11f, 1.624761415e-12f, 1.309491117e-13f};
    const int gt = c.bid * NTHR + c.tid, ngt = c.nb * NTHR;
    for (int i = gt; i < M * 24; i += ngt) {
        const int m = i / 24, j = i % 24; const int b = m / SEQ, t = m % SEQ;
        const float pos = (float)(start_frame[b] + t);
        float hi = 0.f, lo = 0.f;
#pragma unroll
        for (int q = 0; q < 16; ++q) if (j == q) { hi = HA[q]; lo = LA[q]; }
#pragma unroll
        for (int q = 0; q < 8; ++q) if (j == 16 + q) { hi = HI[q]; lo = LI[q]; }
        const float p = pos * hi, e = fmaf(pos, hi, -p) + pos * lo;
        float sn, cs; sincosf(p, &sn, &cs);
        const float cc = cs - e * sn, ss = sn + e * cs;
        if (j < 16) { ropea[(size_t)m * 32 + j] = cc; ropea[(size_t)m * 32 + 16 + j] = ss; }
        else { ropei[(size_t)m * 16 + (j - 16)] = cc; ropei[(size_t)m * 16 + 8 + (j - 16)] = ss; }
    }
}

__device__ __forceinline__ void build_wql(const Ctx& c, const float* __restrict__ w_uq, const float* __restrict__ w_uk, bf16* WQ) {
    const int gt = c.bid * NTHR + c.tid, ngt = c.nb * NTHR;
    for (int i = gt; i < 2048 * 512; i += ngt) {
        const int cc = i & 511, hr = i >> 9, h = hr >> 8, r = hr & 255;
        const float* a = w_uq + (size_t)cc * 1024 + h * 128 + 32; const float* b = w_uk + (size_t)r * 768 + h * 96; float s = 0.f;
#pragma unroll 8
        for (int d = 0; d < 96; ++d) s += a[d] * b[d];
        WQ[i] = (bf16)f2bf(s);
    }
}
__device__ __forceinline__ void build_wout(const Ctx& c, const float* __restrict__ w_uv, const float* __restrict__ w_out, bf16* WO) {
    const int gt = c.bid * NTHR + c.tid, ngt = c.nb * NTHR;
    for (int i = gt; i < 8 * 32 * 2048; i += ngt) {
        const int n = i & 2047, rg = (i >> 11) & 31, h = i >> 16; float acc[8];
#pragma unroll
        for (int j = 0; j < 8; ++j) acc[j] = 0.f;
        for (int d = 0; d < 128; ++d) { const float wo = w_out[(size_t)(h * 128 + d) * 2048 + n];
#pragma unroll
            for (int j = 0; j < 8; ++j) acc[j] += w_uv[(size_t)(rg * 8 + j) * 1024 + h * 128 + d] * wo; }
        u32x4 o; o.x = pk2(acc[0], acc[1]); o.y = pk2(acc[2], acc[3]); o.z = pk2(acc[4], acc[5]); o.w = pk2(acc[6], acc[7]);
        *(u32x4*)(WO + (size_t)n * OC + h * 256 + rg * 8) = o;
    }
}

__device__ __forceinline__ void dsa_prep(const Ctx& c, const bf16* __restrict__ H, const float* __restrict__ cqn_g, const float* __restrict__ ckv_g, const float* __restrict__ kidx_g,
                                         const float* __restrict__ ropea, const float* __restrict__ ropei, bf16* CQN, bf16* KF, bf16* KIDX, float* WIDX) {
    const int l = c.lane;
    for (int m = c.gw; m < M; m += c.ngw) {
        const bf16* h = H + (size_t)m * HC;
        {
            float f[8]; unpack8(*(const u32x4*)(h + 8 * l), f); float s = 0.f;
#pragma unroll
            for (int j = 0; j < 8; ++j) s += f[j] * f[j];
            const float rstd = 1.0f / sqrtf(wave_sum(s) * (1.f / 512.f) + NORM_EPS);
            u32x4 o; o.x = pk2(f[0] * rstd * cqn_g[8 * l + 0], f[1] * rstd * cqn_g[8 * l + 1]); o.y = pk2(f[2] * rstd * cqn_g[8 * l + 2], f[3] * rstd * cqn_g[8 * l + 3]);
            o.z = pk2(f[4] * rstd * cqn_g[8 * l + 4], f[5] * rstd * cqn_g[8 * l + 5]); o.w = pk2(f[6] * rstd * cqn_g[8 * l + 6], f[7] * rstd * cqn_g[8 * l + 7]);
            *(u32x4*)(CQN + (size_t)m * 512 + 8 * l) = o;
        }
        {
            const u32x2 w = *(const u32x2*)(h + 512 + 4 * l); const float f0 = bf2f(w.x & 0xffffu), f1 = bf2f(w.x >> 16), f2 = bf2f(w.y & 0xffffu), f3 = bf2f(w.y >> 16);
            const float s = (f0 * f0 + f1 * f1) + (f2 * f2 + f3 * f3);
            const float rstd = 1.0f / sqrtf(wave_sum(s) * (1.f / 256.f) + NORM_EPS);
            u32x2 o; o.x = pk2(f0 * rstd * ckv_g[4 * l + 0], f1 * rstd * ckv_g[4 * l + 1]); o.y = pk2(f2 * rstd * ckv_g[4 * l + 2], f3 * rstd * ckv_g[4 * l + 3]);
            *(u32x2*)(KF + (size_t)m * KFW + 4 * l) = o;
        }
        if (l < 16) {
            const float x1 = bf2f(h[768 + l]), x2 = bf2f(h[768 + 16 + l]); const float cs = ropea[(size_t)m * 32 + l], sn = ropea[(size_t)m * 32 + 16 + l];
            KF[(size_t)m * KFW + 256 + l] = (bf16)f2bf(x1 * cs - x2 * sn); KF[(size_t)m * KFW + 256 + 16 + l] = (bf16)f2bf(x2 * cs + x1 * sn);
        }
        {
            const float v = bf2f(h[800 + l]); const float rstd = 1.0f / sqrtf(wave_sum(v * v) * (1.f / 64.f) + NORM_EPS);
            const float y = v * rstd * kidx_g[l];
            const float ylo = __shfl(y, l & 7), yhi = __shfl(y, (l & 7) + 8);
            float o = y;
            if (l < 16) { const float cs = ropei[(size_t)m * 16 + (l & 7)], sn = ropei[(size_t)m * 16 + 8 + (l & 7)]; o = (l < 8) ? (ylo * cs - yhi * sn) : (yhi * cs + ylo * sn); }
            KIDX[(size_t)m * 64 + l] = (bf16)f2bf(o);
        }
        if (l < 16) WIDX[(size_t)m * 16 + l] = bf2f(h[864 + l]) * 0.03125f;
    }
}
__device__ __forceinline__ void q_rope_fix(const Ctx& c, bf16* QALL, const float* __restrict__ ropea, const float* __restrict__ ropei) {
    const int l = c.lane;
    for (int m = c.gw; m < M; m += c.ngw) {
        bf16* q = QALL + (size_t)m * QC;
#pragma unroll
        for (int i = 0; i < 2; ++i) { const int p = l + 64 * i, hh = p >> 4, j = p & 15; bf16* a = q + 2048 + hh * 32 + j;
            const float x1 = bf2f(a[0]), x2 = bf2f(a[16]); const float cs = ropea[(size_t)m * 32 + j], sn = ropea[(size_t)m * 32 + 16 + j];
            a[0] = (bf16)f2bf(x1 * cs - x2 * sn); a[16] = (bf16)f2bf(x2 * cs + x1 * sn); }
#pragma unroll
        for (int i = 0; i < 2; ++i) { const int p = l + 64 * i, hh = p >> 3, j = p & 7; bf16* a = q + 2304 + hh * 64 + j;
            const float x1 = bf2f(a[0]), x2 = bf2f(a[8]); const float cs = ropei[(size_t)m * 16 + j], sn = ropei[(size_t)m * 16 + 8 + j];
            a[0] = (bf16)f2bf(x1 * cs - x2 * sn); a[8] = (bf16)f2bf(x2 * cs + x1 * sn); }
    }
}
__device__ __forceinline__ size_t sc_row_off(int b, int t) { const int ch = t >> 6; return (size_t)b * SC_PER_BATCH + (size_t)4096 * (ch * (ch + 1) / 2) + (size_t)(t & 63) * (64 * (ch + 1)); }
__device__ __forceinline__ void idx_scores_simple(const Ctx& c, const bf16* __restrict__ QALL, const bf16* __restrict__ KIDX, const float* __restrict__ WIDX, float* SC) {
    float* qs = (float*)c.lds;
    float* ws = qs + 1024;
    for (int m = c.bid; m < M; m += c.nb) {
        const int b = m / SEQ, t = m % SEQ, limit = ((t >> 6) + 1) * 64;
        __syncthreads();
        for (int i = c.tid; i < 1024; i += NTHR) qs[i] = bf2f(QALL[(size_t)m * QC + 2304 + i]);
        if (c.tid < 16) ws[c.tid] = WIDX[(size_t)m * 16 + c.tid];
        __syncthreads();
        if (limit <= 256) continue;
        float* row = SC + sc_row_off(b, t);
        for (int s = c.tid; s < limit; s += NTHR) {
            float k[64]; const u32x4* kp = (const u32x4*)(KIDX + (size_t)(b * SEQ + s) * 64);
#pragma unroll
            for (int j = 0; j < 8; ++j) unpack8(kp[j], k + 8 * j);
            float sc = 0.f;
#pragma unroll 1
            for (int h = 0; h < 16; ++h) { asm volatile("" ::: "memory"); float d = 0.f; const f32x4* q4 = (const f32x4*)(qs + h * 64);
#pragma unroll
                for (int j = 0; j < 16; ++j) { const f32x4 q = q4[j]; d += (q.x * k[4 * j] + q.y * k[4 * j + 1]) + (q.z * k[4 * j + 2] + q.w * k[4 * j + 3]); }
                sc += ws[h] * fmaxf(d, 0.f); }
            row[s] = sc;
        }
    }
}
__device__ __forceinline__ void select_row(const float* row, int limit, unsigned short* sel, int l_in, unsigned short* stg = nullptr) {
    int l = l_in; asm volatile("" : "+v"(l));
    const int ng = limit >> 9;
    unsigned key[64];
#pragma unroll
    for (int jg = 0; jg < 8; ++jg) {
        if (jg <= ng) {
#pragma unroll
            for (int j = 8 * jg; j < 8 * jg + 8; ++j) { const int s = j * 64 + l; key[j] = __float_as_uint(row[s < limit ? s : 0]); }
        } else {
#pragma unroll
            for (int j = 8 * jg; j < 8 * jg + 8; ++j) key[j] = 0u;
        }
    }
#pragma unroll
    for (int j = 0; j < 64; ++j) { const int s = j * 64 + l; unsigned u = key[j]; u = (u & 0x80000000u) ? ~u : (u | 0x80000000u); key[j] = (s < limit) ? u : 0u; }
    unsigned mx = 0u;
#pragma unroll
    for (int j = 0; j < 64; ++j) mx = key[j] > mx ? key[j] : mx;
#pragma unroll
    for (int o = 1; o < 64; o <<= 1) { const unsigned t = (unsigned)__shfl_xor((int)mx, o); mx = t > mx ? t : mx; }
    mx = (unsigned)__builtin_amdgcn_readfirstlane((int)mx);
    auto wave_count = [&](int v) -> int {
        v += __builtin_amdgcn_update_dpp(0, v, 0xB1, 0xf, 0xf, true); v += __builtin_amdgcn_update_dpp(0, v, 0x4E, 0xf, 0xf, true);
        v += __builtin_amdgcn_update_dpp(0, v, 0x141, 0xf, 0xf, true); v += __builtin_amdgcn_update_dpp(0, v, 0x140, 0xf, 0xf, true);
        return __builtin_amdgcn_readlane(v, 0) + __builtin_amdgcn_readlane(v, 16) + __builtin_amdgcn_readlane(v, 32) + __builtin_amdgcn_readlane(v, 48); };
    unsigned T = 0u;
#pragma unroll 1
    for (int bit = 31 - __builtin_clz(mx | 1u); bit >= 0; --bit) {
        const unsigned Tn = T | (1u << bit); int cl = 0;
#pragma unroll
        for (int jg = 0; jg < 8; ++jg) if (jg <= ng) {
#pragma unroll
            for (int j = 8 * jg; j < 8 * jg + 8; ++j) cl += (key[j] >= Tn) ? 1 : 0; }
        const int cnt = wave_count(cl);
        if (cnt >= 256) T = Tn;
        if (cnt == 256) break;
    }
    int cgl = 0;
#pragma unroll
    for (int j = 0; j < 64; ++j) cgl += (key[j] > T) ? 1 : 0;
    const int cgt = wave_count(cgl);
    const int need_eq = 256 - cgt;
    int base = 0, beq = 0;
    const unsigned long long lt = (1ull << l) - 1ull;
    if (stg) {
#pragma unroll
        for (int jg = 0; jg < 8; ++jg) if (jg <= ng) {
#pragma unroll
            for (int j = 8 * jg; j < 8 * jg + 8; ++j) {
                const unsigned long long mg = __ballot(key[j] > T);
                const int pos = base + (int)__builtin_amdgcn_mbcnt_hi((unsigned)(mg >> 32), __builtin_amdgcn_mbcnt_lo((unsigned)mg, 0u));
                if (key[j] > T) stg[pos] = (unsigned short)(j * 64 + l);
                base += __popcll(mg);
                const unsigned long long me = __ballot(key[j] == T);
                if (me != 0ull) {
                    const int pe = beq + (int)__builtin_amdgcn_mbcnt_hi((unsigned)(me >> 32), __builtin_amdgcn_mbcnt_lo((unsigned)me, 0u));
                    if (key[j] == T && pe < need_eq) stg[cgt + pe] = (unsigned short)(j * 64 + l);
                    beq += __popcll(me);
                }
            }
        }
        __builtin_amdgcn_fence(__ATOMIC_RELEASE, "wavefront"); __builtin_amdgcn_wave_barrier(); __builtin_amdgcn_fence(__ATOMIC_ACQUIRE, "wavefront");
        *(u32x2*)(sel + 4 * l) = *(const u32x2*)(stg + 4 * l);
        __builtin_amdgcn_fence(__ATOMIC_RELEASE, "wavefront"); __builtin_amdgcn_wave_barrier(); __builtin_amdgcn_fence(__ATOMIC_ACQUIRE, "wavefront");
        return;
    }
#pragma unroll
    for (int jg = 0; jg < 8; ++jg) if (jg <= ng) {
#pragma unroll
        for (int j = 8 * jg; j < 8 * jg + 8; ++j) {
            const unsigned long long mg = __ballot(key[j] > T), me = __ballot(key[j] == T);
            if (key[j] > T) sel[base + __popcll(mg & lt)] = (unsigned short)(j * 64 + l);
            base += __popcll(mg);
            const int pe = beq + __popcll(me & lt);
            if (key[j] == T && pe < need_eq) sel[cgt + pe] = (unsigned short)(j * 64 + l);
            beq += __popcll(me);
        }
    }
}
__device__ __forceinline__ void topk_select(const Ctx& c, const float* __restrict__ SC, bf16* SEL  ) {
    const int l = c.lane;
    for (int m = c.gw; m < M; m += c.ngw) {
        const int b = m / SEQ, t = m % SEQ, limit = ((t >> 6) + 1) * 64;
        unsigned short* sel = (unsigned short*)SEL + (size_t)m * 256;
        if (limit <= 256) { for (int i = l; i < 256; i += 64) sel[i] = (unsigned short)(i < limit ? i : 0); continue; }
        select_row(SC + sc_row_off(b, t), limit, sel, l);
    }
}
__device__ __forceinline__ void dsa_attn_simple(const Ctx& c, const bf16* __restrict__ QALL, const bf16* __restrict__ KF, const bf16* __restrict__ SEL, bf16* OLY, int mmax = M) {
    float* qf = (float*)c.lds;
    float* P = qf + 8 * 288;
    int* sl = (int*)(P + 8 * 256);
    const float scale = 0.08838834764831845f;
    for (int m = c.bid; m < mmax; m += c.nb) {
        const int b = m / SEQ, t = m % SEQ, limit = ((t >> 6) + 1) * 64, cnt = limit < 256 ? limit : 256;
        __syncthreads();
        for (int i = c.tid; i < 8 * 288; i += NTHR) { const int h = i / 288, d = i % 288; qf[i] = bf2f(d < 256 ? QALL[(size_t)m * QC + h * 256 + d] : QALL[(size_t)m * QC + 2048 + h * 32 + (d - 256)]); }
        if (c.tid < 256) sl[c.tid] = (int)((const unsigned short*)SEL)[(size_t)m * 256 + c.tid];
        __syncthreads();
        if (c.tid < 256) {
            float acc[8];
#pragma unroll
            for (int h = 0; h < 8; ++h) acc[h] = 0.f;
            if (c.tid < cnt) {
                const u32x4* kp = (const u32x4*)(KF + (size_t)(b * SEQ + sl[c.tid]) * KFW);
                for (int ch = 0; ch < 36; ++ch) { float k[8]; unpack8(kp[ch], k);
#pragma unroll
                    for (int h = 0; h < 8; ++h) { const float* q = qf + h * 288 + ch * 8;
#pragma unroll
                        for (int j = 0; j < 8; ++j) acc[h] += k[j] * q[j]; } }
            }
#pragma unroll
            for (int h = 0; h < 8; ++h) P[h * 256 + c.tid] = (c.tid < cnt) ? acc[h] * scale : -INFINITY;
        }
        __syncthreads();
        {
            const int h = c.wave; float v[4]; float mx = -INFINITY;
#pragma unroll
            for (int i = 0; i < 4; ++i) { v[i] = P[h * 256 + c.lane + 64 * i]; mx = fmaxf(mx, v[i]); }
            mx = wave_max(mx); float s = 0.f;
#pragma unroll
            for (int i = 0; i < 4; ++i) { v[i] = __expf(v[i] - mx); s += v[i]; }
            s = wave_sum(s); const float inv = 1.f / s;
#pragma unroll
            for (int i = 0; i < 4; ++i) P[h * 256 + c.lane + 64 * i] = v[i] * inv;
        }
        __syncthreads();
        {
            const int r = c.tid & 255, hg = c.tid >> 8; float o[4] = {0.f, 0.f, 0.f, 0.f};
            for (int i = 0; i < cnt; ++i) { const float v = bf2f(KF[(size_t)(b * SEQ + sl[i]) * KFW + r]);
#pragma unroll
                for (int hh = 0; hh < 4; ++hh) o[hh] += P[(hg * 4 + hh) * 256 + i] * v; }
#pragma unroll
            for (int hh = 0; hh < 4; ++hh) OLY[(size_t)m * OC + (hg * 4 + hh) * 256 + r] = (bf16)f2bf(o[hh]);
        }
    }
}
__device__ __forceinline__ void xattn_simple(const Ctx& c, const bf16* __restrict__ XQ, const bf16* __restrict__ KVBIG, int layer, bf16* XO) {
    float* qf = (float*)c.lds;
    float* P = qf + 512;
    const float scale = 0.08838834764831845f;
    for (int m = c.bid; m < M; m += c.nb) {
        const int b = m / SEQ;
        const bf16* kvb = KVBIG + (size_t)(layer * 2048 + b * 256) * 4096 + layer * 1024;
        __syncthreads();
        qf[c.tid] = bf2f(XQ[(size_t)m * 512 + c.tid]);
        __syncthreads();
        {
            const int j = c.tid & 255, hp = c.tid >> 8;
#pragma unroll
            for (int hh = 0; hh < 2; ++hh) { const int h = hp * 2 + hh; const u32x4* kp = (const u32x4*)(kvb + (size_t)j * 4096 + h * 128); float d = 0.f;
                for (int ch = 0; ch < 16; ++ch) { float k[8]; unpack8(kp[ch], k);
#pragma unroll
                    for (int e = 0; e < 8; ++e) d += k[e] * qf[h * 128 + ch * 8 + e]; }
                P[h * 256 + j] = d * scale; }
        }
        __syncthreads();
        if (c.wave < 4) { const int h = c.wave; float v[4]; float mx = -INFINITY;
#pragma unroll
            for (int i = 0; i < 4; ++i) { v[i] = P[h * 256 + c.lane + 64 * i]; mx = fmaxf(mx, v[i]); }
            mx = wave_max(mx); float s = 0.f;
#pragma unroll
            for (int i = 0; i < 4; ++i) { v[i] = __expf(v[i] - mx); s += v[i]; }
            s = wave_sum(s); const float inv = 1.f / s;
#pragma unroll
            for (int i = 0; i < 4; ++i) P[h * 256 + c.lane + 64 * i] = v[i] * inv; }
        __syncthreads();
        {   const int h = c.tid >> 7; float o = 0.f;
            for (int j = 0; j < 256; ++j) o += P[h * 256 + j] * bf2f(kvb[(size_t)j * 4096 + 512 + c.tid]);
            XO[(size_t)m * 512 + c.tid] = (bf16)f2bf(o); }
    }
}
typedef short bf16x8 __attribute__((ext_vector_type(8)));
typedef short bf16x4 __attribute__((ext_vector_type(4)));
__device__ __forceinline__ bf16x4 tr_read4(const unsigned char* p) { return __builtin_amdgcn_ds_read_tr16_b64_v4i16((LAS bf16x4*)p); }
__device__ __forceinline__ bf16x8 cat8(bf16x4 a, bf16x4 b) { return __builtin_shufflevector(a, b, 0, 1, 2, 3, 4, 5, 6, 7); }
__device__ __forceinline__ bf16x8 pack_p8(const f32x4 a, const f32x4 b) {
    u32x4 w; w.x = pg8::cvt_pk_bf16(a[0], a[1]); w.y = pg8::cvt_pk_bf16(a[2], a[3]); w.z = pg8::cvt_pk_bf16(b[0], b[1]); w.w = pg8::cvt_pk_bf16(b[2], b[3]);
    return __builtin_bit_cast(bf16x8, w);
}
__device__ __forceinline__ bf16x8 rope_frag(const bf16x8 xf, const bf16x8 pf, const float* cs, const float* sn, bool lo) {
    float x[8], p[8]; unpack8(__builtin_bit_cast(u32x4, xf), x); unpack8(__builtin_bit_cast(u32x4, pf), p);
    const float sg = lo ? -1.f : 1.f; float o[8];
#pragma unroll
    for (int j = 0; j < 8; ++j) o[j] = x[j] * cs[j] + sg * p[j] * sn[j];
    u32x4 w; w.x = pg8::cvt_pk_bf16(o[0], o[1]); w.y = pg8::cvt_pk_bf16(o[2], o[3]); w.z = pg8::cvt_pk_bf16(o[4], o[5]); w.w = pg8::cvt_pk_bf16(o[6], o[7]);
    return __builtin_bit_cast(bf16x8, w);
}
__device__ __forceinline__ bf16x8 xchg_frag(const bf16x8 v, int lane_xor) { u32x4 u = __builtin_bit_cast(u32x4, v); u32x4 r;
    r.x = (unsigned)__shfl_xor((int)u.x, lane_xor); r.y = (unsigned)__shfl_xor((int)u.y, lane_xor); r.z = (unsigned)__shfl_xor((int)u.z, lane_xor); r.w = (unsigned)__shfl_xor((int)u.w, lane_xor); return __builtin_bit_cast(bf16x8, r); }
constexpr int XA_PITCH = 272;
__device__ __forceinline__ void xattn_mfma(const Ctx& c, const bf16* __restrict__ XQ, const bf16* __restrict__ KVBIG, int layer, bf16* XO) {
    unsigned char* Kl = c.lds; unsigned char* Vl = c.lds + 256 * XA_PITCH;
    const int l = c.lane, n16 = l & 15, g = l >> 4;
    const float scale = 0.08838834764831845f * 1.4426950408889634f;
    for (int unit = c.bid; unit < 256; unit += c.nb) {
        const int b = unit >> 5, h = (unit >> 3) & 3, qc = unit & 7;
        const bf16* kvb = KVBIG + (size_t)(layer * 2048 + b * 256) * 4096 + layer * 1024 + h * 128;
        __syncthreads();
        for (int i = c.tid; i < 4096; i += NTHR) { const int row = i >> 4, ch = i & 15;
            *(u32x4*)(Kl + row * XA_PITCH + ch * 16) = *(const u32x4*)(kvb + (size_t)row * 4096 + ch * 8);
            *(u32x4*)(Vl + row * XA_PITCH + ch * 16) = *(const u32x4*)(kvb + (size_t)row * 4096 + 512 + ch * 8); }
        __syncthreads();
#pragma unroll 1
        for (int g4 = 0; g4 < 4; ++g4) {
            const size_t m = (size_t)b * SEQ + qc * 512 + c.wave * 64 + g4 * 16 + n16;
            bf16x8 Qb[4];
#pragma unroll
            for (int kk = 0; kk < 4; ++kk) Qb[kk] = *(const bf16x8*)(XQ + m * 512 + h * 128 + 32 * kk + 8 * g);
            f32x4 S[16];
#pragma unroll
            for (int j = 0; j < 16; ++j) { S[j] = (f32x4){0.f, 0.f, 0.f, 0.f};
#pragma unroll
                for (int kk = 0; kk < 4; ++kk) { const bf16x8 A = *(const bf16x8*)(Kl + (16 * j + n16) * XA_PITCH + (32 * kk + 8 * g) * 2);
                    S[j] = __builtin_amdgcn_mfma_f32_16x16x32_bf16(A, Qb[kk], S[j], 0, 0, 0); } }
            float mx = -INFINITY;
#pragma unroll
            for (int j = 0; j < 16; ++j) mx = fmaxf(mx, fmaxf(fmaxf(S[j][0], S[j][1]), fmaxf(S[j][2], S[j][3])));
            mx = fmaxf(mx, __shfl_xor(mx, 16)); mx = fmaxf(mx, __shfl_xor(mx, 32));
            float sum = 0.f; const float mo = mx * scale;
#pragma unroll
            for (int j = 0; j < 16; ++j) {
#pragma unroll
                for (int r = 0; r < 4; ++r) { const float p = __builtin_amdgcn_exp2f(S[j][r] * scale - mo); S[j][r] = p; sum += p; } }
            sum += __shfl_xor(sum, 16); sum += __shfl_xor(sum, 32);
            const float inv = 1.f / sum;
            bf16x8 Pb[8];
#pragma unroll
            for (int jj = 0; jj < 8; ++jj) Pb[jj] = pack_p8(S[2 * jj], S[2 * jj + 1]);
            const int q4 = n16 >> 2, p4 = l & 3;
#pragma unroll
            for (int dt = 0; dt < 8; ++dt) { f32x4 O = (f32x4){0.f, 0.f, 0.f, 0.f};
#pragma unroll
                for (int jj = 0; jj < 8; ++jj) { const unsigned char* vp = Vl + (32 * jj + 4 * g + q4) * XA_PITCH + (16 * dt) * 2 + 8 * p4;
                    const bf16x8 A = cat8(tr_read4(vp), tr_read4(vp + 16 * XA_PITCH));
                    O = __builtin_amdgcn_mfma_f32_16x16x32_bf16(A, Pb[jj], O, 0, 0, 0); }
                u32x2 w; w.x = pg8::cvt_pk_bf16(O[0] * inv, O[1] * inv); w.y = pg8::cvt_pk_bf16(O[2] * inv, O[3] * inv);
                *(u32x2*)(XO + m * 512 + h * 128 + 16 * dt + 4 * g) = w; }
        }
    }
}
__device__ __forceinline__ void diag_cmp_bf16(const Ctx& c, const bf16* A, int lda, const bf16* B, int ldb, int rows, int cols, float* acc) {
    float d2 = 0.f, a2 = 0.f;
    const size_t n = (size_t)rows * cols;
    for (size_t i = (size_t)c.bid * NTHR + c.tid; i < n; i += (size_t)c.nb * NTHR) { const size_t r = i / cols, cc = i % cols; const float a = bf2f(A[r * lda + cc]), b = bf2f(B[r * ldb + cc]); d2 += (a - b) * (a - b); a2 += a * a; }
    d2 = wave_sum(d2); a2 = wave_sum(a2);
    if (c.lane == 0) { atomicAdd(acc, d2); atomicAdd(acc + 1, a2); }
}
constexpr int DA_PITCH = 528, DA_WAVE_BYTES = 32 * DA_PITCH;
__device__ __forceinline__ void dsa_attn_mfma(const Ctx& c, const bf16* __restrict__ QALL, const bf16* __restrict__ KF, const bf16* __restrict__ SEL, const float* __restrict__ ROPEA, bf16* OLY, int m_first, int m_stride, int m_end) {
    unsigned char* Vw = c.lds + c.wave * DA_WAVE_BYTES;
    const int l = c.lane, n16 = l & 15, g = l >> 4, q4 = n16 >> 2, p4 = l & 3, hh = n16 & 7;
    const float scale = 0.08838834764831845f * 1.4426950408889634f;
#pragma unroll 1
    for (int m = m_first; m < m_end; m += m_stride) {
        const int b = m / SEQ, t = m % SEQ, limit = ((t >> 6) + 1) * 64, cnt = limit < 256 ? limit : 256, nblk = cnt >> 5;
        const bf16* qrow = QALL + (size_t)m * QC;
        bf16x8 Qb[9];
#pragma unroll
        for (int kk = 0; kk < 8; ++kk) Qb[kk] = *(const bf16x8*)(qrow + hh * 256 + 32 * kk + 8 * g);
        Qb[8] = *(const bf16x8*)(qrow + 2048 + hh * 32 + 8 * g);
        {
            const bf16x8 pf = xchg_frag(Qb[8], 32); float cs[8], sn[8];
            const f32x4 c0 = *(const f32x4*)(ROPEA + (size_t)m * 32 + 8 * (g & 1)), c1 = *(const f32x4*)(ROPEA + (size_t)m * 32 + 8 * (g & 1) + 4), s0 = *(const f32x4*)(ROPEA + (size_t)m * 32 + 16 + 8 * (g & 1)), s1 = *(const f32x4*)(ROPEA + (size_t)m * 32 + 16 + 8 * (g & 1) + 4);
            cs[0] = c0.x; cs[1] = c0.y; cs[2] = c0.z; cs[3] = c0.w; cs[4] = c1.x; cs[5] = c1.y; cs[6] = c1.z; cs[7] = c1.w; sn[0] = s0.x; sn[1] = s0.y; sn[2] = s0.z; sn[3] = s0.w; sn[4] = s1.x; sn[5] = s1.y; sn[6] = s1.z; sn[7] = s1.w;
            Qb[8] = rope_frag(Qb[8], pf, cs, sn, g < 2); }
        f32x4 O[16];
#pragma unroll
        for (int dt = 0; dt < 16; ++dt) O[dt] = (f32x4){0.f, 0.f, 0.f, 0.f};
        float mrun = -INFINITY, lrun = 0.f;
        const unsigned short* selp = (const unsigned short*)SEL + (size_t)m * 256;
        const bf16* kfb = KF + (size_t)b * SEQ * KFW;
        bf16x8 K0[9], K1[9];
#define DA_GATHER(BLK) do { const int s0_ = selp[32 * (BLK) + n16], s1_ = selp[32 * (BLK) + 16 + n16]; \
            const bf16* r0_ = kfb + (size_t)s0_ * KFW + 8 * g; const bf16* r1_ = kfb + (size_t)s1_ * KFW + 8 * g; \
            _Pragma("unroll") for (int kk = 0; kk < 9; ++kk) { K0[kk] = *(const bf16x8*)(r0_ + 32 * kk); K1[kk] = *(const bf16x8*)(r1_ + 32 * kk); } } while (0)
        DA_GATHER(0);
#pragma unroll 1
        for (int blk = 0; blk < nblk; ++blk) {
            f32x4 S0 = (f32x4){0.f, 0.f, 0.f, 0.f}, S1 = (f32x4){0.f, 0.f, 0.f, 0.f};
#pragma unroll
            for (int kk = 0; kk < 9; ++kk) { S0 = __builtin_amdgcn_mfma_f32_16x16x32_bf16(K0[kk], Qb[kk], S0, 0, 0, 0); S1 = __builtin_amdgcn_mfma_f32_16x16x32_bf16(K1[kk], Qb[kk], S1, 0, 0, 0); }
#pragma unroll
            for (int kk = 0; kk < 8; ++kk) { *(bf16x8*)(Vw + n16 * DA_PITCH + (32 * kk + 8 * g) * 2) = K0[kk]; *(bf16x8*)(Vw + (16 + n16) * DA_PITCH + (32 * kk + 8 * g) * 2) = K1[kk]; }
            __builtin_amdgcn_sched_barrier(0);
            if (blk + 1 < nblk) DA_GATHER(blk + 1);
            __builtin_amdgcn_sched_barrier(0);
            float bm = fmaxf(fmaxf(fmaxf(S0[0], S0[1]), fmaxf(S0[2], S0[3])), fmaxf(fmaxf(S1[0], S1[1]), fmaxf(S1[2], S1[3])));
            bm = fmaxf(bm, __shfl_xor(bm, 16)); bm = fmaxf(bm, __shfl_xor(bm, 32));
            const float mnew = fmaxf(mrun, bm), alpha = __builtin_amdgcn_exp2f((mrun - mnew) * scale), mo = mnew * scale; mrun = mnew;
            float ps = 0.f;
#pragma unroll
            for (int r = 0; r < 4; ++r) { S0[r] = __builtin_amdgcn_exp2f(S0[r] * scale - mo); S1[r] = __builtin_amdgcn_exp2f(S1[r] * scale - mo); ps += S0[r] + S1[r]; }
            lrun = lrun * alpha + ps;
            const bf16x8 Pb = pack_p8(S0, S1);
#pragma unroll
            for (int dt = 0; dt < 16; ++dt) { O[dt] = O[dt] * alpha;
                const unsigned char* vp = Vw + (4 * g + q4) * DA_PITCH + (16 * dt) * 2 + 8 * p4;
                const bf16x8 A = cat8(tr_read4(vp), tr_read4(vp + 16 * DA_PITCH));
                O[dt] = __builtin_amdgcn_mfma_f32_16x16x32_bf16(A, Pb, O[dt], 0, 0, 0); }
        }
#undef DA_GATHER
        lrun += __shfl_xor(lrun, 16); lrun += __shfl_xor(lrun, 32);
        const float inv = 1.f / lrun;
        if (n16 < 8) {
            bf16* orow = OLY + (size_t)m * OC + n16 * 256 + 4 * g;
#pragma unroll
            for (int dt = 0; dt < 16; ++dt) { u32x2 w; w.x = pg8::cvt_pk_bf16(O[dt][0] * inv, O[dt][1] * inv); w.y = pg8::cvt_pk_bf16(O[dt][2] * inv, O[dt][3] * inv); *(u32x2*)(orow + 16 * dt) = w; }
        }
    }
}
__device__ __forceinline__ void dsa_attn_queue(const Ctx& c, const bf16* __restrict__ QALL, const bf16* __restrict__ KF, const bf16* __restrict__ SEL, const float* __restrict__ ROPEA, bf16* OLY, unsigned* counter, volatile LAS unsigned* slot) {
    for (;;) {
        __syncthreads();
        if (c.tid == 0) *slot = __hip_atomic_fetch_add(counter, 1u, __ATOMIC_RELAXED, __HIP_MEMORY_SCOPE_AGENT);
        __syncthreads();
        const int chunk = (int)*slot;
        if (chunk >= M / 16) break;
        dsa_attn_mfma(c, QALL, KF, SEL, ROPEA, OLY, chunk * 16 + c.wave, 8, chunk * 16 + 16);
    }
}
__device__ __forceinline__ float relu1(float x) { const int b = __builtin_bit_cast(int, x); return __builtin_bit_cast(float, b > 0 ? b : 0); }
__device__ __forceinline__ void idx_topk_mfma(const Ctx& c, const bf16* __restrict__ QALL, const bf16* __restrict__ KIDX, const float* __restrict__ WIDX, const float* __restrict__ ROPEI, float* scr, bf16* SEL, int nitems) {
    const int l = c.lane, n16 = l & 15, g = l >> 4, qg = c.wave & 3, kh = c.wave >> 2;
#pragma unroll 1
    for (int item = c.bid; item < nitems; item += c.nb) {
        const int b = item >> 5, pr = item & 31;
#pragma unroll 1
        for (int which = 0; which < 2; ++which) {
            const int ch = which ? 63 - pr : pr, L = 64 * (ch + 1), t0 = 64 * ch;
            if (L > 256) {
            const size_t m = (size_t)b * SEQ + t0 + 16 * qg + n16;
            float* srow = scr + (size_t)(16 * qg + n16) * L + 4 * g;
            const int nt = L >> 5, j0 = kh * nt, j1 = j0 + nt;
            const bf16* kp = KIDX + ((size_t)b * SEQ + n16) * 64 + 8 * g;
            {
                bf16x8 Qi[16][2]; float w[16];
                { const bf16* qp = QALL + m * QC + 2304 + 8 * g;
#pragma unroll
                  for (int h = 0; h < 16; ++h) { Qi[h][0] = *(const bf16x8*)(qp + h * 64); Qi[h][1] = *(const bf16x8*)(qp + h * 64 + 32); }
                  {
                      float cs[8], sn[8]; const f32x4 c0 = *(const f32x4*)(ROPEI + m * 16), c1 = *(const f32x4*)(ROPEI + m * 16 + 4), s0 = *(const f32x4*)(ROPEI + m * 16 + 8), s1 = *(const f32x4*)(ROPEI + m * 16 + 12);
                      cs[0] = c0.x; cs[1] = c0.y; cs[2] = c0.z; cs[3] = c0.w; cs[4] = c1.x; cs[5] = c1.y; cs[6] = c1.z; cs[7] = c1.w; sn[0] = s0.x; sn[1] = s0.y; sn[2] = s0.z; sn[3] = s0.w; sn[4] = s1.x; sn[5] = s1.y; sn[6] = s1.z; sn[7] = s1.w;
#pragma unroll
                      for (int h = 0; h < 16; ++h) { const bf16x8 pf = xchg_frag(Qi[h][0], 16); const bf16x8 rf = rope_frag(Qi[h][0], pf, cs, sn, g == 0); if (g < 2) Qi[h][0] = rf; } }
                  const f32x4* wp = (const f32x4*)(WIDX + m * 16);
#pragma unroll
                  for (int q = 0; q < 4; ++q) { const f32x4 v = wp[q]; w[4 * q] = v.x; w[4 * q + 1] = v.y; w[4 * q + 2] = v.z; w[4 * q + 3] = v.w; } }
                bf16x8 Ka = *(const bf16x8*)(kp + (size_t)j0 * 1024), Kb = *(const bf16x8*)(kp + (size_t)j0 * 1024 + 32);
#pragma unroll 1
                for (int j = j0; j < j1; ++j) {
                    const int jn = (j + 1 < j1) ? j + 1 : j;
                    const bf16x8 Na = *(const bf16x8*)(kp + (size_t)jn * 1024), Nb = *(const bf16x8*)(kp + (size_t)jn * 1024 + 32);
                    f32x2 s01 = (f32x2){0.f, 0.f}, s23 = (f32x2){0.f, 0.f};
                    f32x4 a = __builtin_amdgcn_mfma_f32_16x16x32_bf16(Ka, Qi[0][0], (f32x4){0.f, 0.f, 0.f, 0.f}, 0, 0, 0); a = __builtin_amdgcn_mfma_f32_16x16x32_bf16(Kb, Qi[0][1], a, 0, 0, 0);
#pragma unroll
                    for (int h = 0; h < 16; ++h) { f32x4 an = a;
                        if (h < 15) { an = __builtin_amdgcn_mfma_f32_16x16x32_bf16(Ka, Qi[h + 1][0], (f32x4){0.f, 0.f, 0.f, 0.f}, 0, 0, 0); an = __builtin_amdgcn_mfma_f32_16x16x32_bf16(Kb, Qi[h + 1][1], an, 0, 0, 0); }
                        const f32x2 wv = (f32x2){w[h], w[h]};
                        s01 = (f32x2){relu1(a[0]), relu1(a[1])} * wv + s01; s23 = (f32x2){relu1(a[2]), relu1(a[3])} * wv + s23; a = an; }
                    *(f32x4*)(srow + 16 * j) = (f32x4){s01.x, s01.y, s23.x, s23.y};
                    Ka = Na; Kb = Nb;
                }
            }
            }
            asm volatile("s_waitcnt vmcnt(0)" ::: "memory");
            __syncthreads();
            __builtin_amdgcn_fence(__ATOMIC_ACQUIRE, "agent");
            asm volatile("s_waitcnt vmcnt(0)" ::: "memory");
#pragma unroll 1
            for (int i = 0; i < 8; ++i) {
                const int ql = c.wave * 8 + i;
                unsigned short* sel = (unsigned short*)SEL + ((size_t)b * SEQ + t0 + ql) * 256;
                if (L <= 256) { for (int k = l; k < 256; k += 64) sel[k] = (unsigned short)(k < L ? k : 0); }
                else select_row(scr + (size_t)ql * L, L, sel, l, (unsigned short*)(c.lds + c.wave * 512));
            }
            __syncthreads();
        }
    }
}
__device__ __forceinline__ void diag_cmp_sel(const Ctx& c, const bf16* SA, const bf16* SB, int nbatch, float* acc) {
    unsigned* bm = (unsigned*)(c.lds + c.wave * 512);
    float miss = 0.f, tot = 0.f;
    for (int m = c.gw; m < nbatch * SEQ; m += c.ngw) {
        const int t = m % SEQ; if (t < 256) continue;
        bm[c.lane] = 0u; bm[64 + c.lane] = 0u;
        __builtin_amdgcn_fence(__ATOMIC_RELEASE, "wavefront"); __builtin_amdgcn_wave_barrier();
        for (int i = c.lane; i < 256; i += 64) { const unsigned s = ((const unsigned short*)SA)[(size_t)m * 256 + i]; atomicOr(&bm[s >> 5], 1u << (s & 31)); }
        __builtin_amdgcn_fence(__ATOMIC_RELEASE, "wavefront"); __builtin_amdgcn_wave_barrier(); __builtin_amdgcn_fence(__ATOMIC_ACQUIRE, "wavefront");
        for (int i = c.lane; i < 256; i += 64) { const unsigned s = ((const unsigned short*)SB)[(size_t)m * 256 + i]; miss += ((bm[s >> 5] >> (s & 31)) & 1u) ? 0.f : 1.f; tot += 1.f; }
        __builtin_amdgcn_fence(__ATOMIC_RELEASE, "wavefront"); __builtin_amdgcn_wave_barrier();
    }
    miss = wave_sum(miss); tot = wave_sum(tot);
    if (c.lane == 0) { atomicAdd(acc, miss); atomicAdd(acc + 1, tot); }
}
__device__ __forceinline__ void idx_topk_lds(const Ctx& c, const bf16* __restrict__ QALL, const bf16* __restrict__ KIDX, const float* __restrict__ WIDX, const float* __restrict__ ROPEI, u32x4* qscr, bf16* SEL, int nitems) {
    float* SCL = (float*)c.lds;
    f32x4* WL = (f32x4*)(c.lds + 131072);
    const int w8 = c.wave;
#pragma unroll 1
    for (int item = c.bid; item < nitems; item += c.nb) {
        const int b = item >> 5, pr = item & 31;
#pragma unroll 1
        for (int which = 0; which < 2; ++which) {
            int l = c.lane; asm volatile("" : "+v"(l));
            const int n16 = l & 15, g = l >> 4;
            const int ch = which ? 63 - pr : pr, L = 64 * (ch + 1), t0 = 64 * ch;
            if (L <= 256) {
#pragma unroll 1
                for (int i = 0; i < 8; ++i) { unsigned short* sel = (unsigned short*)SEL + ((size_t)b * SEQ + t0 + w8 * 8 + i) * 256; for (int k = l; k < 256; k += 64) sel[k] = (unsigned short)(k < L ? k : 0); }
                continue;
            }
            __syncthreads();
            if (w8 < 4) {
                const size_t m = (size_t)b * SEQ + t0 + 16 * w8 + n16;
                const bf16* qp = QALL + m * QC + 2304 + 8 * g;
                float cs[8], sn[8]; const f32x4 c0 = *(const f32x4*)(ROPEI + m * 16), c1 = *(const f32x4*)(ROPEI + m * 16 + 4), s0 = *(const f32x4*)(ROPEI + m * 16 + 8), s1 = *(const f32x4*)(ROPEI + m * 16 + 12);
                cs[0] = c0.x; cs[1] = c0.y; cs[2] = c0.z; cs[3] = c0.w; cs[4] = c1.x; cs[5] = c1.y; cs[6] = c1.z; cs[7] = c1.w; sn[0] = s0.x; sn[1] = s0.y; sn[2] = s0.z; sn[3] = s0.w; sn[4] = s1.x; sn[5] = s1.y; sn[6] = s1.z; sn[7] = s1.w;
#pragma unroll 4
                for (int h = 0; h < 16; ++h) { bf16x8 f0 = *(const bf16x8*)(qp + h * 64); const bf16x8 f1 = *(const bf16x8*)(qp + h * 64 + 32);
                    const bf16x8 pf = xchg_frag(f0, 16); const bf16x8 rf = rope_frag(f0, pf, cs, sn, g == 0); if (g < 2) f0 = rf;
                    qscr[(w8 * 64 + l) * 32 + h * 2] = __builtin_bit_cast(u32x4, f0); qscr[(w8 * 64 + l) * 32 + h * 2 + 1] = __builtin_bit_cast(u32x4, f1); }
            }
            asm volatile("s_waitcnt vmcnt(0)" ::: "memory");
            __syncthreads();
            __builtin_amdgcn_fence(__ATOMIC_ACQUIRE, "agent"); asm volatile("s_waitcnt vmcnt(0)" ::: "memory");
            const bf16* kp = KIDX + ((size_t)b * SEQ + n16) * 64 + 8 * g;
            const int ntile = L >> 4;
#pragma unroll 1
            for (int qsub = 0; qsub < 8; ++qsub) {
                asm volatile("" ::: "memory");
                bf16x8 Qi[16][2];
                { const int srcl = g * 16 + (qsub & 1) * 8 + (n16 & 7); const u32x4* fp = qscr + (size_t)((qsub >> 1) * 64 + srcl) * 32;
#pragma unroll
                  for (int h = 0; h < 16; ++h) { Qi[h][0] = __builtin_bit_cast(bf16x8, fp[h * 2]); Qi[h][1] = __builtin_bit_cast(bf16x8, fp[h * 2 + 1]); }
                  if (w8 == 0 && l < 32) WL[l] = *(const f32x4*)(WIDX + ((size_t)b * SEQ + t0 + 8 * qsub + (l >> 2)) * 16 + 4 * (l & 3)); }
                __syncthreads();
                const f32x4* wq = WL + (n16 & 7) * 4;
                float* srow = SCL + (n16 & 7) * 4096 + 4 * g;
                int j = w8;
                bf16x8 Ka = *(const bf16x8*)(kp + (size_t)j * 1024), Kb = *(const bf16x8*)(kp + (size_t)j * 1024 + 32);
#pragma unroll 1
                for (; j < ntile; j += 8) {
                    const int jn = (j + 8 < ntile) ? j + 8 : j;
                    const bf16x8 Na = *(const bf16x8*)(kp + (size_t)jn * 1024), Nb = *(const bf16x8*)(kp + (size_t)jn * 1024 + 32);
                    f32x2 s01 = (f32x2){0.f, 0.f}, s23 = (f32x2){0.f, 0.f};
                    f32x4 a = __builtin_amdgcn_mfma_f32_16x16x32_bf16(Ka, Qi[0][0], (f32x4){0.f, 0.f, 0.f, 0.f}, 0, 0, 0); a = __builtin_amdgcn_mfma_f32_16x16x32_bf16(Kb, Qi[0][1], a, 0, 0, 0);
#pragma unroll
                    for (int h4 = 0; h4 < 4; ++h4) { const f32x4 w4 = wq[h4];
#pragma unroll
                        for (int hh = 0; hh < 4; ++hh) { const int h = 4 * h4 + hh; f32x4 an = a;
                            if (h < 15) { an = __builtin_amdgcn_mfma_f32_16x16x32_bf16(Ka, Qi[h + 1][0], (f32x4){0.f, 0.f, 0.f, 0.f}, 0, 0, 0); an = __builtin_amdgcn_mfma_f32_16x16x32_bf16(Kb, Qi[h + 1][1], an, 0, 0, 0); }
                            const f32x2 wv = (f32x2){w4[hh], w4[hh]};
                            s01 = (f32x2){relu1(a[0]), relu1(a[1])} * wv + s01; s23 = (f32x2){relu1(a[2]), relu1(a[3])} * wv + s23; a = an; } }
                    if (n16 < 8) *(f32x4*)(srow + 16 * j) = (f32x4){s01.x, s01.y, s23.x, s23.y};
                    Ka = Na; Kb = Nb;
                }
                __syncthreads();
                select_row(SCL + w8 * 4096, L, (unsigned short*)SEL + ((size_t)b * SEQ + t0 + 8 * qsub + w8) * 256, l);
                __syncthreads();
            }
        }
    }
}
#if DIAG == 7
__device__ __forceinline__ void select_row_v1(const float* row, int limit, unsigned short* sel, int l_in) {
    int l = l_in; asm volatile("" : "+v"(l));
    const int ng = limit >> 9;
    unsigned key[64];
#pragma unroll
    for (int j = 0; j < 64; ++j) { const int s = j * 64 + l; unsigned u = 0u; if (s < limit) { u = __float_as_uint(row[s]); u = (u & 0x80000000u) ? ~u : (u | 0x80000000u); } key[j] = u; }
    unsigned mx = 0u;
#pragma unroll
    for (int j = 0; j < 64; ++j) mx = key[j] > mx ? key[j] : mx;
#pragma unroll
    for (int o = 1; o < 64; o <<= 1) { const unsigned t = (unsigned)__shfl_xor((int)mx, o); mx = t > mx ? t : mx; }
    mx = (unsigned)__builtin_amdgcn_readfirstlane((int)mx);
    unsigned T = 0u;
#pragma unroll 1
    for (int bit = 31 - __builtin_clz(mx | 1u); bit >= 0; --bit) {
        const unsigned Tn = T | (1u << bit); int cnt = 0;
#pragma unroll
        for (int jg = 0; jg < 8; ++jg) if (jg <= ng) {
#pragma unroll
            for (int j = 8 * jg; j < 8 * jg + 8; ++j) cnt += __popcll(__ballot(key[j] >= Tn)); }
        if (cnt >= 256) T = Tn;
        if (cnt == 256) break;
    }
    int cgt = 0;
#pragma unroll
    for (int j = 0; j < 64; ++j) cgt += __popcll(__ballot(key[j] > T));
    const int need_eq = 256 - cgt;
    int base = 0, beq = 0;
    const unsigned long long lt = (1ull << l) - 1ull;
#pragma unroll
    for (int jg = 0; jg < 8; ++jg) if (jg <= ng) {
#pragma unroll
        for (int j = 8 * jg; j < 8 * jg + 8; ++j) {
            const unsigned long long mg = __ballot(key[j] > T), me = __ballot(key[j] == T);
            if (key[j] > T) sel[base + __popcll(mg & lt)] = (unsigned short)(j * 64 + l);
            base += __popcll(mg);
            const int pe = beq + __popcll(me & lt);
            if (key[j] == T && pe < need_eq) sel[cgt + pe] = (unsigned short)(j * 64 + l);
            beq += __popcll(me);
        }
    }
}
__device__ __forceinline__ void idx_topk_v1(const Ctx& c, const bf16* __restrict__ QALL, const bf16* __restrict__ KIDX, const float* __restrict__ WIDX, float* scr, bf16* SEL, int nitems) {
    const int l = c.lane, n16 = l & 15, g = l >> 4, qg = c.wave & 3, kh = c.wave >> 2;
#pragma unroll 1
    for (int item = c.bid; item < nitems; item += c.nb) {
        const int b = item >> 5, pr = item & 31;
#pragma unroll 1
        for (int which = 0; which < 2; ++which) {
            const int ch = which ? 63 - pr : pr, L = 64 * (ch + 1), t0 = 64 * ch;
            if (L > 256) {
            const size_t m = (size_t)b * SEQ + t0 + 16 * qg + n16;
            float* srow = scr + (size_t)(16 * qg + n16) * L + 4 * g;
            const int nt = L >> 5, j0 = kh * nt, j1 = j0 + nt;
            const bf16* kp = KIDX + ((size_t)b * SEQ + n16) * 64 + 8 * g;
#pragma unroll 1
            for (int hp = 0; hp < 2; ++hp) {
                bf16x8 Qi[8][2]; float w[8];
                { const bf16* qp = QALL + m * QC + 2304 + hp * 512 + 8 * g;
#pragma unroll
                  for (int h = 0; h < 8; ++h) { Qi[h][0] = *(const bf16x8*)(qp + h * 64); Qi[h][1] = *(const bf16x8*)(qp + h * 64 + 32); }
                  const f32x4* wp = (const f32x4*)(WIDX + m * 16 + hp * 8);
#pragma unroll
                  for (int q = 0; q < 2; ++q) { const f32x4 v = wp[q]; w[4 * q] = v.x; w[4 * q + 1] = v.y; w[4 * q + 2] = v.z; w[4 * q + 3] = v.w; } }
                if (hp) { asm volatile("s_waitcnt vmcnt(0)" ::: "memory"); __builtin_amdgcn_fence(__ATOMIC_ACQUIRE, "agent"); asm volatile("s_waitcnt vmcnt(0)" ::: "memory"); }
                bf16x8 Ka = *(const bf16x8*)(kp + (size_t)j0 * 1024), Kb = *(const bf16x8*)(kp + (size_t)j0 * 1024 + 32);
                f32x4 pv = (f32x4){0.f, 0.f, 0.f, 0.f}; if (hp) pv = *(const f32x4*)(srow + 16 * j0);
#pragma unroll 1
                for (int j = j0; j < j1; ++j) {
                    const int jn = (j + 1 < j1) ? j + 1 : j;
                    const bf16x8 Na = *(const bf16x8*)(kp + (size_t)jn * 1024), Nb = *(const bf16x8*)(kp + (size_t)jn * 1024 + 32);
                    f32x4 pn = (f32x4){0.f, 0.f, 0.f, 0.f}; if (hp) pn = *(const f32x4*)(srow + 16 * jn);
                    f32x4 sc = pv;
#pragma unroll
                    for (int h = 0; h < 8; ++h) { f32x4 a = __builtin_amdgcn_mfma_f32_16x16x32_bf16(Ka, Qi[h][0], (f32x4){0.f, 0.f, 0.f, 0.f}, 0, 0, 0); a = __builtin_amdgcn_mfma_f32_16x16x32_bf16(Kb, Qi[h][1], a, 0, 0, 0);
                        sc[0] += w[h] * fmaxf(a[0], 0.f); sc[1] += w[h] * fmaxf(a[1], 0.f); sc[2] += w[h] * fmaxf(a[2], 0.f); sc[3] += w[h] * fmaxf(a[3], 0.f); }
                    *(f32x4*)(srow + 16 * j) = sc;
                    Ka = Na; Kb = Nb; pv = pn;
                }
            }
            }
            asm volatile("s_waitcnt vmcnt(0)" ::: "memory");
            __syncthreads();
            __builtin_amdgcn_fence(__ATOMIC_ACQUIRE, "agent");
            asm volatile("s_waitcnt vmcnt(0)" ::: "memory");
#pragma unroll 1
            for (int i = 0; i < 8; ++i) {
                const int ql = c.wave * 8 + i;
                unsigned short* sel = (unsigned short*)SEL + ((size_t)b * SEQ + t0 + ql) * 256;
                if (L <= 256) { for (int k = l; k < 256; k += 64) sel[k] = (unsigned short)(k < L ? k : 0); }
                else select_row_v1(scr + (size_t)ql * L, L, sel, l);
            }
            __syncthreads();
        }
    }
}
#endif
constexpr int RW_TB = 32;
struct RwkvP { const float *mu, *w0, *w2, *a0, *a2, *g2, *k_k, *k_a, *r_k, *ln_w, *ln_b; };
__device__ __forceinline__ void rwkv_phase(const Ctx& c, const bf16* __restrict__ H, const RwkvP P, bf16* OLY) {
    float* A_WR = (float*)c.lds;
    float* A_K2 = A_WR + RW_TB * 64;
    float* A_V = A_K2 + RW_TB * 64;
    float* A_W = A_V + RW_TB * 64;
    float* A_NKK = A_W + RW_TB * 64;
    float* A_B = A_NKK + RW_TB * 64;
    float* A_G = A_B + RW_TB * 64;
    float* A_OUT = A_G + RW_TB * 64;
    float* L_TW = A_OUT + RW_TB * 64;
    float* L_AL = L_TW + RW_TB * 64;
    float* L_SG = L_AL + RW_TB * 64;
    float* SC1 = L_SG + RW_TB * 160; float* SC2 = SC1 + RW_TB; float* SC3 = SC2 + RW_TB;
    const int l = c.lane, w = c.wave;
    for (int item = c.bid; item < NB * 16; item += c.nb) {
        const int b = item >> 4, h = item & 15, hk = h * 64 + l;
        const float w0v = P.w0[hk], a0v = P.a0[hk], kkv = P.k_k[hk], kav = P.k_a[hk], rkv = P.r_k[hk], lnw = P.ln_w[hk], lnb = P.ln_b[hk];
        float S[8];
#pragma unroll
        for (int i = 0; i < 8; ++i) S[i] = 0.f;
        const int srow = w * 8 + (l >> 3), sj = l & 7;
        for (int t0 = 0; t0 < SEQ; t0 += RW_TB) {
            __syncthreads();
            for (int idx = c.tid; idx < RW_TB * 480; idx += NTHR) {
                const int t = idx / 480, cc = idx % 480; int col; float* dst;
                if (cc < 64) { col = 880 + h * 64 + cc; dst = A_WR + t * 64 + cc; }
                else if (cc < 128) { col = 1904 + h * 64 + (cc - 64); dst = A_K2 + t * 64 + (cc - 64); }
                else if (cc < 192) { col = 2928 + h * 64 + (cc - 128); dst = A_V + t * 64 + (cc - 128); }
                else if (cc < 256) { col = 3952 + (cc - 192); dst = L_TW + t * 64 + (cc - 192); }
                else if (cc < 320) { col = 4016 + (cc - 256); dst = L_AL + t * 64 + (cc - 256); }
                else { col = 4080 + (cc - 320); dst = L_SG + t * 160 + (cc - 320); }
                const size_t m = (size_t)b * SEQ + t0 + t;
                const float x = bf2f(H[m * HC + col]); const float xp = (t0 + t > 0) ? bf2f(H[(m - 1) * HC + col]) : 0.f;
                float hm = x + (xp - x) * P.mu[col - 880];
                if (cc >= 192 && cc < 256) hm = tanhf(hm); else if (cc >= 320) hm = sigmoidf_(hm);
                *dst = hm;
            }
            __syncthreads();
            {
                float wl[RW_TB / 8], al[RW_TB / 8], gg[RW_TB / 8];
#pragma unroll
                for (int i = 0; i < RW_TB / 8; ++i) { wl[i] = 0.f; al[i] = 0.f; gg[i] = 0.f; }
                for (int j = 0; j < 64; ++j) { const float w2v = P.w2[(size_t)j * 1024 + hk], a2v = P.a2[(size_t)j * 1024 + hk];
#pragma unroll
                    for (int i = 0; i < RW_TB / 8; ++i) { wl[i] += L_TW[(w + 8 * i) * 64 + j] * w2v; al[i] += L_AL[(w + 8 * i) * 64 + j] * a2v; } }
                for (int j = 0; j < 160; ++j) { const float g2v = P.g2[(size_t)j * 1024 + hk];
#pragma unroll
                    for (int i = 0; i < RW_TB / 8; ++i) gg[i] += L_SG[(w + 8 * i) * 160 + j] * g2v; }
#pragma unroll
                for (int i = 0; i < RW_TB / 8; ++i) {
                    const int t = w + 8 * i, o = t * 64 + l;
                    const float dec = __expf(-0.6065306597126334f * sigmoidf_(w0v + wl[i]));
                    const float a = sigmoidf_(a0v + al[i]);
                    const float kr = A_K2[o], r = A_WR[o];
                    float kk = kr * kkv; const float nrm = wave_sum(kk * kk); kk = kk * (1.0f / sqrtf(fmaxf(nrm, 1e-24f)));
                    const float k2 = kr * (1.f + (a - 1.f) * kav), bb = kk * a;
                    const float s1 = wave_sum(bb * r), s2 = wave_sum(k2 * r), s3 = wave_sum(r * k2 * rkv);
                    A_W[o] = dec; A_NKK[o] = -kk; A_B[o] = bb; A_K2[o] = k2; A_WR[o] = dec * r; A_G[o] = gg[i];
                    if (l == 0) { SC1[t] = s1; SC2[t] = s2; SC3[t] = s3; }
                }
            }
            __syncthreads();
            for (int t = 0; t < RW_TB; ++t) {
                const f32x4* pw = (const f32x4*)(A_W + t * 64 + 8 * sj); const f32x4* pn = (const f32x4*)(A_NKK + t * 64 + 8 * sj); const f32x4* pb = (const f32x4*)(A_B + t * 64 + 8 * sj);
                const f32x4* pk = (const f32x4*)(A_K2 + t * 64 + 8 * sj); const f32x4* pr = (const f32x4*)(A_WR + t * 64 + 8 * sj);
                const f32x4 w0_ = pw[0], w1_ = pw[1], n0 = pn[0], n1 = pn[1], b0 = pb[0], b1 = pb[1], k0 = pk[0], k1 = pk[1], r0 = pr[0], r1 = pr[1];
                const float vv = A_V[t * 64 + srow], s1 = SC1[t], s2 = SC2[t];
                float sa = (S[0] * n0.x + S[1] * n0.y) + (S[2] * n0.z + S[3] * n0.w) + (S[4] * n1.x + S[5] * n1.y) + (S[6] * n1.z + S[7] * n1.w);
                float p = (S[0] * r0.x + S[1] * r0.y) + (S[2] * r0.z + S[3] * r0.w) + (S[4] * r1.x + S[5] * r1.y) + (S[6] * r1.z + S[7] * r1.w);
                sa += __shfl_xor(sa, 1); p += __shfl_xor(p, 1); sa += __shfl_xor(sa, 2); p += __shfl_xor(p, 2); sa += __shfl_xor(sa, 4); p += __shfl_xor(p, 4);
                S[0] = S[0] * w0_.x + (sa * b0.x + vv * k0.x); S[1] = S[1] * w0_.y + (sa * b0.y + vv * k0.y); S[2] = S[2] * w0_.z + (sa * b0.z + vv * k0.z); S[3] = S[3] * w0_.w + (sa * b0.w + vv * k0.w);
                S[4] = S[4] * w1_.x + (sa * b1.x + vv * k1.x); S[5] = S[5] * w1_.y + (sa * b1.y + vv * k1.y); S[6] = S[6] * w1_.z + (sa * b1.z + vv * k1.z); S[7] = S[7] * w1_.w + (sa * b1.w + vv * k1.w);
                if (sj == 0) A_OUT[t * 64 + srow] = p + sa * s1 + vv * s2;
            }
            __syncthreads();
#pragma unroll
            for (int i = 0; i < RW_TB / 8; ++i) {
                const int t = w + 8 * i, o = t * 64 + l;
                const float x = A_OUT[o]; const float mean = wave_sum(x) * (1.f / 64.f); const float dx = x - mean; const float var = wave_sum(dx * dx) * (1.f / 64.f);
                float y = dx * (1.0f / sqrtf(var + 64e-5f)) * lnw + lnb;
                y = (y + SC3[t] * A_V[o]) * A_G[o];
                OLY[((size_t)b * SEQ + t0 + t) * OC + 2048 + hk] = (bf16)f2bf(y);
            }
        }
    }
}

constexpr int S5_TB = 16;
struct S5P { const float *lam_re, *lam_im, *log_dt, *b_re, *b_im, *c_re, *c_im, *d; };
__device__ __forceinline__ float gelu_tanh(float y) { return 0.5f * y * (1.f + tanhf(0.7978845608028654f * (y + 0.044715f * y * y * y))); }
__device__ __forceinline__ void s5_phase(const Ctx& c, const bf16* __restrict__ U, const S5P P, bf16* Z) {
    constexpr int PERW = 256 + 2 * S5_TB * 65 + 2 * 64 * 16;
    float* UU = (float*)c.lds + c.wave * PERW;
    float* XSr = UU + 256; float* XSi = XSr + S5_TB * 65;
    float* CTr = XSi + S5_TB * 65; float* CTi = CTr + 64 * 16;
    const int l = c.lane;
    for (int item = c.bid; item < NB * 16; item += c.nb) {
        const int b = item >> 4, g = (item & 15) * 8 + c.wave;
        __syncthreads();
        float lbr, lbi, Br[16], Bi[16];
        {
            const float lr = fminf(P.lam_re[g * 64 + l], -1e-4f), li = P.lam_im[g * 64 + l], dt = expf(P.log_dt[g]);
            const float e = expf(lr * dt); lbr = e * cosf(li * dt); lbi = e * sinf(li * dt);
            const float nr = lbr - 1.f, ni = lbi, den = 1.f / (lr * lr + li * li);
            const float cr = (nr * lr + ni * li) * den, ci = (ni * lr - nr * li) * den;
#pragma unroll
            for (int i = 0; i < 16; ++i) { const float br = P.b_re[(size_t)(g * 64 + l) * 16 + i], bi = P.b_im[(size_t)(g * 64 + l) * 16 + i]; Br[i] = cr * br - ci * bi; Bi[i] = cr * bi + ci * br; }
#pragma unroll
            for (int o = 0; o < 16; ++o) { CTr[l * 16 + o] = P.c_re[(size_t)(g * 16 + o) * 64 + l]; CTi[l * 16 + o] = P.c_im[(size_t)(g * 16 + o) * 64 + l]; }
        }
        float dsk[4];
#pragma unroll
        for (int e = 0; e < 4; ++e) dsk[e] = P.d[g * 16 + (l >> 4) * 4 + e];
        float xr = 0.f, xi = 0.f;
        for (int t0 = 0; t0 < SEQ; t0 += S5_TB) {
            __syncthreads();
            { const int row = l >> 2, q = l & 3; const u32x2 w2 = *(const u32x2*)(U + ((size_t)b * SEQ + t0 + row) * D + g * 16 + 4 * q);
              float* d = UU + row * 16 + 4 * q; d[0] = bf2f(w2.x & 0xffffu); d[1] = bf2f(w2.x >> 16); d[2] = bf2f(w2.y & 0xffffu); d[3] = bf2f(w2.y >> 16); }
            __syncthreads();
            for (int t = 0; t < S5_TB; ++t) {
                const f32x4* up = (const f32x4*)(UU + t * 16); const f32x4 u0 = up[0], u1 = up[1], u2 = up[2], u3 = up[3];
                const float u[16] = {u0.x, u0.y, u0.z, u0.w, u1.x, u1.y, u1.z, u1.w, u2.x, u2.y, u2.z, u2.w, u3.x, u3.y, u3.z, u3.w};
                float bur = 0.f, bui = 0.f;
#pragma unroll
                for (int i = 0; i < 16; ++i) { bur += Br[i] * u[i]; bui += Bi[i] * u[i]; }
                const float nxr = lbr * xr - lbi * xi + bur, nxi = lbr * xi + lbi * xr + bui; xr = nxr; xi = nxi;
                XSr[t * 65 + l] = xr; XSi[t * 65 + l] = xi;
            }
            __syncthreads();
            {   const int t = l & 15, oq = l >> 4; float y[4] = {0.f, 0.f, 0.f, 0.f};
                for (int p = 0; p < 64; ++p) { const float a = XSr[t * 65 + p], bb = XSi[t * 65 + p]; const f32x4 cr = *(const f32x4*)(CTr + p * 16 + oq * 4), ci = *(const f32x4*)(CTi + p * 16 + oq * 4);
                    y[0] += a * cr.x - bb * ci.x; y[1] += a * cr.y - bb * ci.y; y[2] += a * cr.z - bb * ci.z; y[3] += a * cr.w - bb * ci.w; }
                float z[4];
#pragma unroll
                for (int e = 0; e < 4; ++e) z[e] = gelu_tanh(y[e] + dsk[e] * UU[t * 16 + oq * 4 + e]);
                u32x2 o; o.x = pk2(z[0], z[1]); o.y = pk2(z[2], z[3]);
                *(u32x2*)(Z + ((size_t)b * SEQ + t0 + t) * D + g * 16 + oq * 4) = o; }
        }
    }
}
template <int CTRL> __device__ __forceinline__ float dpp_mov(float v) { return __builtin_bit_cast(float, __builtin_amdgcn_update_dpp(0, __builtin_bit_cast(int, v), CTRL, 0xf, 0xf, true)); }
__device__ __forceinline__ float sum8(float v) { v += dpp_mov<0xB1>(v); v += dpp_mov<0x4E>(v); v += dpp_mov<0x141>(v); return v; }
__device__ __forceinline__ float wave_sum_fast(float v) { v += dpp_mov<0xB1>(v); v += dpp_mov<0x4E>(v); v += dpp_mov<0x141>(v); v += dpp_mov<0x140>(v); v += __shfl_xor(v, 16); v += __shfl_xor(v, 32); return v; }
__device__ __forceinline__ float fast_tanh(float x) { const float e = __expf(2.f * x); return 1.f - 2.f / (e + 1.f); }
__device__ __forceinline__ void rwkv_lora_prep(const Ctx& c, const bf16* __restrict__ H, const float* __restrict__ mu, bf16* LX) {
    const int l = c.lane;
    for (int m = c.gw; m < M; m += c.ngw) {
        if (l < 36) {
            const int col = 3952 + 8 * l; const int t = m % SEQ;
            float x[8], p[8]; unpack8(*(const u32x4*)(H + (size_t)m * HC + col), x);
            if (t > 0) unpack8(*(const u32x4*)(H + (size_t)(m - 1) * HC + col), p); else {
#pragma unroll
                for (int j = 0; j < 8; ++j) p[j] = 0.f; }
            const f32x4 m0 = *(const f32x4*)(mu + 3072 + 8 * l), m1 = *(const f32x4*)(mu + 3072 + 8 * l + 4);
            const float mv[8] = {m0.x, m0.y, m0.z, m0.w, m1.x, m1.y, m1.z, m1.w};
            float hm[8];
#pragma unroll
            for (int j = 0; j < 8; ++j) { float v = x[j] + (p[j] - x[j]) * mv[j]; if (l < 8) v = fast_tanh(v); else if (l >= 16) v = sigmoidf_(v); hm[j] = v; }
            u32x4 o; o.x = pg8::cvt_pk_bf16(hm[0], hm[1]); o.y = pg8::cvt_pk_bf16(hm[2], hm[3]); o.z = pg8::cvt_pk_bf16(hm[4], hm[5]); o.w = pg8::cvt_pk_bf16(hm[6], hm[7]);
            *(u32x4*)(LX + (size_t)m * 288 + 8 * l) = o;
        }
    }
}
constexpr int RW2_RAWP = 384;
constexpr int RW2_TWP = 144, RW2_SGP = 336;
__device__ __forceinline__ void rwkv_phase2(const Ctx& c, const bf16* __restrict__ H, const bf16* __restrict__ LX, const RwkvP P, bf16* OUT, int ldo, int coloff, int wb = NB) {
    unsigned char* RAW = c.lds;
    float* A_WR = (float*)(c.lds + 12800);
    float* A_K2 = A_WR + 2048; float* A_V = A_K2 + 2048; float* A_W = A_V + 2048; float* A_NKK = A_W + 2048; float* A_B = A_NKK + 2048; float* A_G = A_B + 2048; float* A_OUT = A_G + 2048;
    float* LO_W = A_OUT + 2048; float* LO_A = LO_W + 2048; float* PR3 = LO_A + 2048;
    unsigned char* L_TW = (unsigned char*)(PR3 + 2048); unsigned char* L_AL = L_TW + 32 * RW2_TWP; unsigned char* L_SG = L_AL + 32 * RW2_TWP;
    float* MU = (float*)(L_SG + 32 * RW2_SGP); float* SC3 = MU + 480 + 64;
    unsigned char* G2T = (unsigned char*)(SC3 + 32);
    float* SCP = (float*)(G2T + 64 * RW2_SGP);
    float* GN = SCP + 128; float* CST = GN + 64;
    float* PR0 = (float*)L_TW; float* PR1 = PR0 + 2048; float* PR2 = A_OUT;
    const int l = c.lane, w = c.wave, n16 = l & 15, g = l >> 4;
#pragma unroll 1
    for (int item = c.bid; item < NB * 16; item += c.nb) {
        const int b = item >> 4, h = item & 15, hk = h * 64 + l;
        __syncthreads();
        if (w < 7) { const float* src = w == 0 ? P.w0 : w == 1 ? P.a0 : w == 2 ? P.k_k : w == 3 ? P.k_a : w == 4 ? P.r_k : w == 5 ? P.ln_w : P.ln_b; CST[w * 64 + l] = src[hk]; }
        for (int i = c.tid; i < 160 * 64; i += NTHR) { const int j = i >> 6, kcl = i & 63; *(unsigned short*)(G2T + kcl * RW2_SGP + j * 2) = (unsigned short)f2bf(P.g2[(size_t)j * 1024 + h * 64 + kcl]); }
        for (int i = c.tid; i < 192; i += NTHR) { const int mi = i < 64 ? h * 64 + i : i < 128 ? 1024 + h * 64 + (i - 64) : 2048 + h * 64 + (i - 128); MU[i] = P.mu[mi]; }
        const int tt = w >> 2, nt = w & 3;
        bf16x8 W2B[2], A2B[2];
        { const int kc = h * 64 + 16 * nt + n16;
          auto ldfrag = [&](const float* Wp, int kk) -> bf16x8 { float f[8]; int gq = g, kq = kc; asm volatile("" : "+v"(gq), "+v"(kq));
              const float* wp = Wp + (size_t)(32 * kk + 8 * gq) * 1024 + kq;
#pragma unroll
              for (int q = 0; q < 8; ++q) f[q] = wp[q * 1024];
              u32x4 u; u.x = pk2(f[0], f[1]); u.y = pk2(f[2], f[3]); u.z = pk2(f[4], f[5]); u.w = pk2(f[6], f[7]);
              asm volatile("" : "+v"(u));
              return __builtin_bit_cast(bf16x8, u); };
          W2B[0] = ldfrag(P.w2, 0); W2B[1] = ldfrag(P.w2, 1); A2B[0] = ldfrag(P.a2, 0); A2B[1] = ldfrag(P.a2, 1);
        }
        f32x2 S[4];
#pragma unroll
        for (int i = 0; i < 4; ++i) S[i] = (f32x2){0.f, 0.f};
        const int srow = w * 8 + (l >> 3), sj = l & 7;
        u32x4 raw[4];
#define RW2_LOAD(T0) do { _Pragma("unroll") for (int k = 0; k < 4; ++k) { const int q_ = c.tid + 512 * k; raw[k] = (u32x4){0u, 0u, 0u, 0u}; \
            if (q_ < 792) { const int cq_ = q_ % 24, tg = (T0) - 1 + q_ / 24; const int rc_ = (cq_ < 8 ? 880 : cq_ < 16 ? 1904 - 64 : 2928 - 128) + h * 64 + cq_ * 8; \
                if (tg >= 0) raw[k] = *(const u32x4*)(H + ((size_t)b * SEQ + tg) * HC + rc_); } \
            else if (q_ < 1944) { const int e_ = q_ - 792; raw[k] = *(const u32x4*)(LX + ((size_t)b * SEQ + (T0) + e_ / 36) * 288 + (e_ % 36) * 8); } } } while (0)
        RW2_LOAD(0);
#pragma unroll 1
        for (int t0 = 0; t0 < SEQ; t0 += 32) {
            __syncthreads();
#pragma unroll
            for (int k = 0; k < 4; ++k) { const int q_ = c.tid + 512 * k;
                if (q_ < 792) *(u32x4*)(RAW + (q_ / 24) * RW2_RAWP + (q_ % 24) * 16) = raw[k];
                else if (q_ < 1944) { const int e_ = q_ - 792, t_ = e_ / 36, p_ = e_ % 36;
                    unsigned char* d_ = p_ < 8 ? L_TW + t_ * RW2_TWP + p_ * 16 : p_ < 16 ? L_AL + t_ * RW2_TWP + (p_ - 8) * 16 : L_SG + t_ * RW2_SGP + (p_ - 16) * 16; *(u32x4*)d_ = raw[k]; } }
            if (t0 + 32 < SEQ) RW2_LOAD(t0 + 32);
            __syncthreads();
            if (c.tid < 384) {
                const int cpi = c.tid % 96, qb = c.tid / 96, cp = cpi * 2, tb = qb * 8;
                const float mu0 = MU[cp], mu1 = MU[cp + 1];
                unsigned xb = *(const unsigned*)(RAW + tb * RW2_RAWP + cp * 2);
                float p0 = bf2f(xb & 0xffffu), p1 = bf2f(xb >> 16);
                float* dst = (cp < 64 ? A_WR + cp : cp < 128 ? A_K2 + (cp - 64) : A_V + (cp - 128)) + tb * 64;
#pragma unroll
                for (int t = 0; t < 8; ++t) { const unsigned xa = *(const unsigned*)(RAW + (tb + t + 1) * RW2_RAWP + cp * 2); const float x0 = bf2f(xa & 0xffffu), x1 = bf2f(xa >> 16);
                    *(f32x2*)(dst + t * 64) = (f32x2){x0 + (p0 - x0) * mu0, x1 + (p1 - x1) * mu1}; p0 = x0; p1 = x1; }
            }
            __syncthreads();
            {
                f32x4 aw = (f32x4){0.f, 0.f, 0.f, 0.f}, aa = aw, ag = aw;
#pragma unroll
                for (int kk = 0; kk < 2; ++kk) { const bf16x8 At = *(const bf16x8*)(L_TW + (16 * tt + n16) * RW2_TWP + (32 * kk + 8 * g) * 2), Aa = *(const bf16x8*)(L_AL + (16 * tt + n16) * RW2_TWP + (32 * kk + 8 * g) * 2);
                    aw = __builtin_amdgcn_mfma_f32_16x16x32_bf16(At, W2B[kk], aw, 0, 0, 0); aa = __builtin_amdgcn_mfma_f32_16x16x32_bf16(Aa, A2B[kk], aa, 0, 0, 0); }
#pragma unroll
                for (int kk = 0; kk < 5; ++kk) { const bf16x8 Ag = *(const bf16x8*)(L_SG + (16 * tt + n16) * RW2_SGP + (32 * kk + 8 * g) * 2); const bf16x8 Gb = *(const bf16x8*)(G2T + (16 * nt + n16) * RW2_SGP + (32 * kk + 8 * g) * 2); ag = __builtin_amdgcn_mfma_f32_16x16x32_bf16(Ag, Gb, ag, 0, 0, 0); }
#pragma unroll
                for (int r = 0; r < 4; ++r) { const int o = (16 * tt + 4 * g + r) * 64 + 16 * nt + n16; LO_W[o] = aw[r]; LO_A[o] = aa[r]; A_G[o] = ag[r]; }
            }
            __syncthreads();
#pragma unroll 2
            for (int i = 0; i < 4; ++i) {
                const int t = w + 8 * i, o = t * 64 + l;
                const float w0v = CST[l], a0v = CST[64 + l], kkv = CST[128 + l], kav = CST[192 + l], rkv = CST[256 + l];
                const float dec = __expf(-0.6065306597126334f * sigmoidf_(w0v + LO_W[o]));
                const float a = sigmoidf_(a0v + LO_A[o]);
                const float kr = A_K2[o], r = A_WR[o];
                const float kk0 = kr * kkv, k2 = kr * (1.f + (a - 1.f) * kav), bb0 = kk0 * a, k2r = k2 * r;
                A_W[o] = dec; A_NKK[o] = -kk0; A_B[o] = bb0; A_K2[o] = k2; A_WR[o] = dec * r;
                PR0[o] = kk0 * kk0; PR1[o] = bb0 * r; PR2[o] = k2r; PR3[o] = k2r * rkv;
            }
            __syncthreads();
            {
                const int t = c.tid >> 4, q = (c.tid >> 2) & 3, qu = c.tid & 3;
                const float* src = (q == 0 ? PR0 : q == 1 ? PR1 : q == 2 ? PR2 : PR3) + t * 64 + 16 * qu;
                const f32x4 v0 = *(const f32x4*)src, v1 = *(const f32x4*)(src + 4), v2 = *(const f32x4*)(src + 8), v3 = *(const f32x4*)(src + 12);
                float sm = ((v0.x + v0.y) + (v0.z + v0.w)) + ((v1.x + v1.y) + (v1.z + v1.w)) + ((v2.x + v2.y) + (v2.z + v2.w)) + ((v3.x + v3.y) + (v3.z + v3.w));
                sm += dpp_mov<0xB1>(sm); sm += dpp_mov<0x4E>(sm);
                if (qu == 0) SCP[t * 4 + q] = (q == 0) ? 1.0f / fmaxf(sm, 1e-24f) : sm;
            }
            __syncthreads();
            {
                f32x4 n0, n1, r0, r1, w0_, w1_, b0, b1, k0, k1, sp; float vv;
                const unsigned char* pk_ = (const unsigned char*)A_WR + 32 * sj;
                const unsigned char* pv_ = (const unsigned char*)A_WR + 4 * srow;
                const unsigned char* ps_ = (const unsigned char*)SCP;
                constexpr int O_WR = 0, O_K2 = 8192, O_V = 16384, O_W = 24576, O_NKK = 32768, O_B = 40960, O_OUT = 57344;
#define RW2_LD_DOT(T) do { n0 = *(const f32x4*)(pk_ + O_NKK + (T) * 256); n1 = *(const f32x4*)(pk_ + O_NKK + (T) * 256 + 16); r0 = *(const f32x4*)(pk_ + O_WR + (T) * 256); r1 = *(const f32x4*)(pk_ + O_WR + (T) * 256 + 16); } while (0)
#define RW2_LD_UPD(T) do { w0_ = *(const f32x4*)(pk_ + O_W + (T) * 256); w1_ = *(const f32x4*)(pk_ + O_W + (T) * 256 + 16); b0 = *(const f32x4*)(pk_ + O_B + (T) * 256); b1 = *(const f32x4*)(pk_ + O_B + (T) * 256 + 16); \
                    k0 = *(const f32x4*)(pk_ + O_K2 + (T) * 256); k1 = *(const f32x4*)(pk_ + O_K2 + (T) * 256 + 16); vv = *(const float*)(pv_ + O_V + (T) * 256); sp = *(const f32x4*)(ps_ + (T) * 16); } while (0)
#define RW2_STEP(T) do { \
                    f32x2 sa2 = S[0] * (f32x2){n0.x, n0.y}; sa2 = S[1] * (f32x2){n0.z, n0.w} + sa2; sa2 = S[2] * (f32x2){n1.x, n1.y} + sa2; sa2 = S[3] * (f32x2){n1.z, n1.w} + sa2; \
                    f32x2 p2 = S[0] * (f32x2){r0.x, r0.y}; p2 = S[1] * (f32x2){r0.z, r0.w} + p2; p2 = S[2] * (f32x2){r1.x, r1.y} + p2; p2 = S[3] * (f32x2){r1.z, r1.w} + p2; \
                    __builtin_amdgcn_sched_barrier(0); RW2_LD_DOT((T) + 1); __builtin_amdgcn_sched_barrier(0); \
                    const float sa = sum8(sa2.x + sa2.y) * sp.x, p = sum8(p2.x + p2.y); \
                    const f32x2 sav = (f32x2){sa, sa}, vvv = (f32x2){vv, vv}; \
                    S[0] = S[0] * (f32x2){w0_.x, w0_.y} + (sav * (f32x2){b0.x, b0.y} + vvv * (f32x2){k0.x, k0.y}); \
                    S[1] = S[1] * (f32x2){w0_.z, w0_.w} + (sav * (f32x2){b0.z, b0.w} + vvv * (f32x2){k0.z, k0.w}); \
                    S[2] = S[2] * (f32x2){w1_.x, w1_.y} + (sav * (f32x2){b1.x, b1.y} + vvv * (f32x2){k1.x, k1.y}); \
                    S[3] = S[3] * (f32x2){w1_.z, w1_.w} + (sav * (f32x2){b1.z, b1.w} + vvv * (f32x2){k1.z, k1.w}); \
                    const float ov = p + sa * sp.y + vv * sp.z; \
                    __builtin_amdgcn_sched_barrier(0); RW2_LD_UPD((T) + 1); *(float*)(const_cast<unsigned char*>(pv_) + O_OUT + (T) * 256) = ov;        __builtin_amdgcn_sched_barrier(0); } while (0)
                RW2_LD_DOT(0); RW2_LD_UPD(0);
#pragma unroll 1
                for (int t4 = 0; t4 < 8; ++t4) {
                    RW2_STEP(0); RW2_STEP(1); RW2_STEP(2); RW2_STEP(3);
                    pk_ += 1024; pv_ += 1024; ps_ += 64;
                }
#undef RW2_LD_DOT
#undef RW2_LD_UPD
#undef RW2_STEP
            }
            __syncthreads();
            {
                const int t = c.tid >> 3, q = (c.tid >> 2) & 1, qu = c.tid & 3;
                if (c.tid < 256) {
                    const float* src = A_OUT + t * 64 + 16 * qu; float sm = 0.f;
#pragma unroll
                    for (int e = 0; e < 4; ++e) { const f32x4 v = *(const f32x4*)(src + 4 * e); sm += q ? ((v.x * v.x + v.y * v.y) + (v.z * v.z + v.w * v.w)) : ((v.x + v.y) + (v.z + v.w)); }
                    sm += dpp_mov<0xB1>(sm); sm += dpp_mov<0x4E>(sm);
                    const float other = dpp_mov<0x141>(sm);
                    if ((c.tid & 7) == 0) { const float mean = sm * (1.f / 64.f), var = fmaxf(other * (1.f / 64.f) - mean * mean, 0.f); GN[t * 2] = mean; GN[t * 2 + 1] = 1.0f / sqrtf(var + 64e-5f); }
                }
            }
            __syncthreads();
#pragma unroll
            for (int i = 0; i < 4; ++i) {
                const int t = w + 8 * i, o = t * 64 + l;
                float y = (A_OUT[o] - GN[t * 2]) * GN[t * 2 + 1] * CST[320 + l] + CST[384 + l];
                y = (y + SCP[t * 4 + 3] * A_V[o]) * A_G[o];
                if (b < wb) OUT[((size_t)b * SEQ + t0 + t) * ldo + coloff + hk] = (bf16)f2bf(y);
            }
        }
#undef RW2_LOAD
    }
}
constexpr int S5B_BUP = 132 * 4, S5B_XP = 272;
constexpr int S5B_WAVE = 16 * S5B_BUP + 16 * S5B_XP;
__device__ __forceinline__ void wave_lds_sync() { __builtin_amdgcn_fence(__ATOMIC_RELEASE, "wavefront"); __builtin_amdgcn_wave_barrier(); __builtin_amdgcn_fence(__ATOMIC_ACQUIRE, "wavefront"); }
__device__ __forceinline__ void s5_phase2(const Ctx& c, const bf16* __restrict__ U, const S5P P, bf16* Z) {
    if (c.wave >= 4) return;
    float* BU = (float*)(c.lds + c.wave * S5B_WAVE); unsigned char* XB = c.lds + c.wave * S5B_WAVE + 16 * S5B_BUP;
    const int l = c.lane, n16 = l & 15, g = l >> 4;
#pragma unroll 1
    for (int item = c.bid; item < 256; item += c.nb) {
        const int b = item >> 5, grp = (item & 31) * 4 + c.wave;
        float lbr, lbi;
        { const float lr = fminf(P.lam_re[grp * 64 + l], -1e-4f), li = P.lam_im[grp * 64 + l], dt = expf(P.log_dt[grp]);
          const float e = expf(lr * dt); lbr = e * cosf(li * dt); lbi = e * sinf(li * dt);
          const float nr = lbr - 1.f, ni = lbi, den = 1.f / (lr * lr + li * li);
          BU[l] = (nr * lr + ni * li) * den; BU[64 + l] = (ni * lr - nr * li) * den; }
        wave_lds_sync();
        bf16x4 Bre[4], Bim[4];
#pragma unroll
        for (int nt = 0; nt < 4; ++nt) { const int p = 16 * nt + n16; const float cr = BU[p], ci = BU[64 + p];
            const f32x4 br = *(const f32x4*)(P.b_re + (size_t)(grp * 64 + p) * 16 + 4 * g), bi = *(const f32x4*)(P.b_im + (size_t)(grp * 64 + p) * 16 + 4 * g);
            u32x2 wr, wi; wr.x = pk2(cr * br.x - ci * bi.x, cr * br.y - ci * bi.y); wr.y = pk2(cr * br.z - ci * bi.z, cr * br.w - ci * bi.w);
            wi.x = pk2(cr * bi.x + ci * br.x, cr * bi.y + ci * br.y); wi.y = pk2(cr * bi.z + ci * br.z, cr * bi.w + ci * br.w);
            Bre[nt] = __builtin_bit_cast(bf16x4, wr); Bim[nt] = __builtin_bit_cast(bf16x4, wi); }
        wave_lds_sync();
        bf16x8 Cf[4];
#pragma unroll
        for (int kk = 0; kk < 4; ++kk) { const int k0 = 32 * kk + 8 * g; const float sg = (kk < 2) ? 1.f : -1.f;
            const float* src = ((kk < 2) ? P.c_re : P.c_im) + (size_t)(grp * 16 + n16) * 64 + (k0 & 63);
            const f32x4 v0 = *(const f32x4*)src, v1 = *(const f32x4*)(src + 4);
            u32x4 w; w.x = pk2(sg * v0.x, sg * v0.y); w.y = pk2(sg * v0.z, sg * v0.w); w.z = pk2(sg * v1.x, sg * v1.y); w.w = pk2(sg * v1.z, sg * v1.w); Cf[kk] = __builtin_bit_cast(bf16x8, w); }
        const float dsk = P.d[grp * 16 + n16];
        float xr = 0.f, xi = 0.f;
        const bf16* ub = U + (size_t)b * SEQ * D + grp * 16;
        u32x2 ua[4]; unsigned short ue[4][4];
#define S5B_LOAD(k, T0) do { ua[k] = *(const u32x2*)(ub + (size_t)((T0) + n16) * D + 4 * g); _Pragma("unroll") for (int r = 0; r < 4; ++r) ue[k][r] = ub[(size_t)((T0) + 4 * g + r) * D + n16]; } while (0)
#pragma unroll
        for (int k = 0; k < 4; ++k) S5B_LOAD(k, 16 * k);
#pragma unroll 1
        for (int t0 = 0; t0 < SEQ; t0 += 64) {
#pragma unroll
            for (int k = 0; k < 4; ++k) {
                const int tb = t0 + 16 * k;
                const bf16x4 A = __builtin_bit_cast(bf16x4, ua[k]);
                float uf[4];
#pragma unroll
                for (int r = 0; r < 4; ++r) uf[r] = bf2f(ue[k][r]);
                if (tb + 64 < SEQ) S5B_LOAD(k, tb + 64);
#pragma unroll
                for (int nt = 0; nt < 4; ++nt) {
                    const f32x4 ar = __builtin_amdgcn_mfma_f32_16x16x16bf16_1k(A, Bre[nt], (f32x4){0.f, 0.f, 0.f, 0.f}, 0, 0, 0);
                    const f32x4 ai = __builtin_amdgcn_mfma_f32_16x16x16bf16_1k(A, Bim[nt], (f32x4){0.f, 0.f, 0.f, 0.f}, 0, 0, 0);
#pragma unroll
                    for (int r = 0; r < 4; ++r) { BU[(4 * g + r) * 132 + 16 * nt + n16] = ar[r]; BU[(4 * g + r) * 132 + 64 + 16 * nt + n16] = ai[r]; }
                }
                wave_lds_sync();
#pragma unroll 4
                for (int t = 0; t < 16; ++t) {
                    const float br = BU[t * 132 + l], bi = BU[t * 132 + 64 + l];
                    const float nxr = lbr * xr - lbi * xi + br, nxi = lbr * xi + lbi * xr + bi; xr = nxr; xi = nxi;
                    *(unsigned short*)(XB + t * S5B_XP + l * 2) = (unsigned short)f2bf(xr); *(unsigned short*)(XB + t * S5B_XP + 128 + l * 2) = (unsigned short)f2bf(xi);
                }
                wave_lds_sync();
                f32x4 y = (f32x4){0.f, 0.f, 0.f, 0.f};
#pragma unroll
                for (int kk = 0; kk < 4; ++kk) { const bf16x8 Ax = *(const bf16x8*)(XB + n16 * S5B_XP + (32 * kk + 8 * g) * 2); y = __builtin_amdgcn_mfma_f32_16x16x32_bf16(Ax, Cf[kk], y, 0, 0, 0); }
#pragma unroll
                for (int r = 0; r < 4; ++r) Z[((size_t)b * SEQ + tb + 4 * g + r) * D + grp * 16 + n16] = (bf16)f2bf(gelu_tanh(y[r] + dsk * uf[r]));
                wave_lds_sync();
            }
        }
#undef S5B_LOAD
    }
}
struct Args { const void* in[45]; float* out; unsigned char* ws; int ph_lo, ph_hi; };
static_assert(sizeof(Args) == 45 * 8 + 8 + 8 + 8, "Args has no padding");
constexpr int PH_EVEN = 9, PH_ODD = 4, PH_COMMON = 13;
constexpr int NPHASES = 2 * (1 + PH_EVEN + PH_COMMON) + 2 * (1 + PH_ODD + PH_COMMON) + 1;

__global__ void __launch_bounds__(NTHR, 2) mega(Args args) {
    extern __shared__ __attribute__((aligned(16))) unsigned char lds[];
    volatile LAS unsigned* MISC = (volatile LAS unsigned*)((LAS unsigned char*)lds + MISC_OFF);
    if (threadIdx.x < 64) MISC[threadIdx.x] = 0u;
    __syncthreads();
    unsigned char* ws = args.ws;
    XcdBarrier bar = xcd_barrier_post((unsigned*)(ws + WS_CTL) + 4096, MISC + 8, gridDim.x);
    const int half = (int)gridDim.x >> 1;
    XcdBarrier bar2 = bar; if ((int)blockIdx.x >= half) bar2 = xcd_barrier_post((unsigned*)(ws + WS_CTL) + 8192, MISC + 10, gridDim.x - half);
    const int lo = args.ph_lo, hi = args.ph_hi;
    int pid = 0;
#define PH_BEGIN if (pid >= lo && pid < hi) { Ctx c; { int t_ = threadIdx.x, b_ = blockIdx.x; asm volatile("" : "+v"(t_)); asm volatile("" : "+s"(b_)); c.lds = lds; c.tid = t_; c.lane = t_ & 63; c.wave = __builtin_amdgcn_readfirstlane(t_ >> 6); c.bid = b_; { int n_ = gridDim.x; asm volatile("" : "+s"(n_)); c.nb = n_; } c.gw = c.bid * NWAVES + c.wave; c.ngw = c.nb * NWAVES; }
#define PH_END } if (pid >= lo && pid + 1 < hi) { xcd_barrier(bar); if (DBL & 2048) xcd_barrier(bar); } ++pid;
#define IN_F(i) (*(const float* const __attribute__((address_space(4)))*)(KARGS() + 8 * (i)))

    typedef const unsigned char __attribute__((address_space(4)))* kptr_t;
#define KARGS() ({ kptr_t p_ = (kptr_t)__builtin_amdgcn_kernarg_segment_ptr(); asm volatile("" : "+s"(p_)); p_; })
#define WSP(off) ((*(unsigned char* const __attribute__((address_space(4)))*)(KARGS() + 368)) + (off))
#define X ((float*)(*(float* const __attribute__((address_space(4)))*)(KARGS() + 360)))
#define ROPEA ((float*)WSP(WS_ROPEA))
#define ROPEI ((float*)WSP(WS_ROPEI))
#define KVBIG ((bf16*)WSP(WS_KVBIG))
#define WKV ((bf16*)WSP(WS_WKV))
#define W_IN ((bf16*)WSP(WS_WMIX + WMIX_IN))
#define WQ ((bf16*)WSP(WS_WMIX + WMIX_Q))
#define WOUT ((bf16*)WSP(WS_WMIX + WMIX_OUT))
#define WO_IN ((bf16*)WSP(WS_WMIX + WMIX_O_IN))
#define WO_GLU ((bf16*)WSP(WS_WMIX + WMIX_O_GLU))
#define WO_OUT ((bf16*)WSP(WS_WMIX + WMIX_O_OUT))
#define WXQ ((bf16*)WSP(WS_WXQ))
#define WXO ((bf16*)WSP(WS_WXO))
#define WUP ((bf16*)WSP(WS_WUP))
#define WDN ((bf16*)WSP(WS_WDN))
#define CQN ((bf16*)WSP(WS_CQN))
#define KF ((bf16*)WSP(WS_KF))
#define KIDX ((bf16*)WSP(WS_KIDX))
#define WIDX ((float*)WSP(WS_WIDX))
#define SEL ((bf16*)WSP(WS_SEL))
#define Hb ((bf16*)WSP(WS_R1))
#define SC ((float*)WSP(WS_R1))
#define HID ((bf16*)WSP(WS_R1))
#define Ub ((bf16*)WSP(WS_R1))
#define YC ((bf16*)WSP(WS_R1 + (size_t)M * D * 2))
#define XN ((bf16*)WSP(WS_R2))
#define QALL ((bf16*)X)
#define OLY ((bf16*)WSP(WS_R3))
#define Zb ((bf16*)WSP(WS_R3))
#define XQ ((bf16*)WSP(WS_R3))
#define XO ((bf16*)WSP(WS_R3 + (size_t)M * 512 * 2))
#define MEMN ((bf16*)WSP(WS_R3))
    LAS unsigned char* glds = (LAS unsigned char*)lds;

#define RS_A ((unsigned long long*)WSP(WS_CTL + 131072))
#define RS_B ((unsigned long long*)WSP(WS_CTL + 393216))
#define RS_C ((unsigned long long*)WSP(WS_CTL + 655360))
    for (int layer = 0; layer < DEPTH; ++layer) {
        const int li = layer >> 1;
        PH_BEGIN
            if ((layer & 1) == 0) {
                conv_mat(c, IN_F(13) + (size_t)li * 2048 * EVEN_COLS, 2048, EVEN_COLS, EVEN_COLS, HC, W_IN, 2048, 0, 0, IN_F(3) + layer * D);
                build_wql(c, IN_F(18) + (size_t)li * 512 * 1024, IN_F(19) + (size_t)li * 256 * 768, WQ);
                for (int h = 0; h < 8; ++h) conv_mat(c, IN_F(18) + (size_t)li * 512 * 1024 + h * 128, 512, 1024, 32, 32, WQ, 512, 2048 + h * 32, 0);
                conv_mat(c, IN_F(21) + (size_t)li * 512 * 1024, 512, 1024, 1024, 1024, WQ, 512, 2304, 0);
                build_wout(c, IN_F(20) + (size_t)li * 256 * 1024, IN_F(14) + (size_t)li * 2048 * 2048, WOUT);
                conv_mat(c, IN_F(14) + (size_t)li * 2048 * 2048 + (size_t)1024 * 2048, 1024, 2048, 2048, 2048, WOUT, OC, 0, 2048);
            } else {
                conv_mat(c, IN_F(33) + (size_t)li * 2048 * 2048, 2048, 2048, 2048, 2048, WO_IN, 2048, 0, 0, IN_F(3) + layer * D);
                conv_mat(c, IN_F(43) + (size_t)li * 2048 * 2048, 2048, 2048, 2048, 2048, WO_GLU, 2048, 0, 0);
                conv_mat(c, IN_F(34) + (size_t)li * 2048 * 2048, 2048, 2048, 2048, 2048, WO_OUT, 2048, 0, 0);
            }
            conv_mat(c, IN_F(8) + (size_t)layer * 2048 * 512, 2048, 512, 512, 512, WXQ, 2048, 0, 0, IN_F(4) + layer * D);
            conv_mat(c, IN_F(10) + (size_t)layer * 512 * 2048, 512, 2048, 2048, 2048, WXO, 512, 0, 0);
            { unsigned long long* ra = RS_A; unsigned long long* rb = RS_B; for (int i = c.bid * NTHR + c.tid; i < M; i += c.nb * NTHR) { ra[i] = 0ull; rb[i] = 0ull; } }
            if (layer == 0) {
                for (int l2 = 0; l2 < 4; ++l2) {
                    conv_mat(c, IN_F(9) + (size_t)l2 * 2048 * 1024, 2048, 1024, 1024, 1024, WKV, 2048, l2 * 1024, 0);
                    norm_rows_bf16(c, IN_F(1), IN_F(5) + l2 * D, MEMN + (size_t)l2 * MEMR * D, MEMR);
                }
                rope_tables(c, (const int*)IN_F(2), ROPEA, ROPEI);
                cast_rows_ss(c, IN_F(0), XN, RS_C, M);
            }
        PH_END
        if ((layer & 1) == 0) {
            PH_BEGIN
                { pg8::Gemm g{XN, W_IN, 2048, 2048, 2048}; pg8::StaticOrder S; S.init(128, HC / 256, c.nb, c.bid); pg8::EpiBf16<0> E{Hb, HC, RS_C};
                  pg8::gemm_phase<pg8::EpiBf16<0>, pg8::StaticOrder, true, true>(glds, g, S, E);
                  if (DBL & 1024) { __syncthreads(); pg8::gemm_phase<pg8::EpiBf16<0>, pg8::StaticOrder, true, true>(glds, g, S, E); } }
                if (layer == 0) { __syncthreads(); pg8::Gemm g{MEMN, WKV, 2048, 2048, 2048}; pg8::KvOrder S{c.nb, c.bid}; pg8::EpiBf16<0> E{KVBIG, 4096, nullptr};
                  pg8::gemm_phase<pg8::EpiBf16<0>, pg8::KvOrder, true, true>(glds, g, S, E); }
            PH_END
            PH_BEGIN
                rwkv_lora_prep(c, Hb, IN_F(22) + li * B_COLS, (bf16*)WSP(WS_END + 96 * MiB));
            PH_END
            PH_BEGIN
                if (c.bid < half) {
                    Ctx r = c; r.nb = half; r.ngw = half * NWAVES;
                    const RwkvP P{IN_F(22) + li * B_COLS, IN_F(23) + li * 1024, IN_F(24) + (size_t)li * 65536, IN_F(25) + li * 1024, IN_F(26) + (size_t)li * 65536, IN_F(27) + (size_t)li * 163840,
                                  IN_F(28) + li * 1024, IN_F(29) + li * 1024, IN_F(30) + li * 1024, IN_F(31) + li * 1024, IN_F(32) + li * 1024};
#if DIAG == 4
                    rwkv_phase(r, Hb, P, OLY);
                    rwkv_phase2(r, Hb, (const bf16*)WSP(WS_END + 96 * MiB), P, (bf16*)WSP(WS_END + 116 * MiB), 1024, 0, 1);
#else
                    rwkv_phase2(r, Hb, (const bf16*)WSP(WS_END + 96 * MiB), P, OLY, OC, 2048);
#endif
                    __syncthreads();
                    conv_mat(r, IN_F(12) + (size_t)layer * FFN * 2048, FFN, 2048, 2048, 2048, WDN, FFN, 0, 0);
                } else {
                    Ctx d = c; d.bid = c.bid - half; d.nb = c.nb - half; d.gw = d.bid * NWAVES + d.wave; d.ngw = d.nb * NWAVES;
                    dsa_prep(d, Hb, IN_F(15) + li * 512, IN_F(16) + li * 256, IN_F(17) + li * 64, ROPEA, ROPEI, CQN, KF, KIDX, WIDX);
                    xcd_barrier(bar2);
                    { pg8::Gemm g{CQN, WQ, 512, 512, 512}; pg8::StaticOrder S; S.init(128, QC / 256, d.nb, d.bid); pg8::EpiBf16<0> E{QALL, QC, nullptr};
                      pg8::gemm_phase<pg8::EpiBf16<0>, pg8::StaticOrder, true, true>(glds, g, S, E); }
                    xcd_barrier(bar2);
                    idx_topk_mfma(d, QALL, KIDX, WIDX, ROPEI, (float*)(d.bid < 32 ? WSP(WS_CQN + (size_t)d.bid * MiB) : WSP(WS_END + (size_t)(d.bid - 32) * MiB)), SEL, 256);
                    conv_mat(d, IN_F(11) + (size_t)layer * 2048 * FFN, 2048, FFN, FFN, FFN, WUP, 2048, 0, 0, IN_F(6) + layer * D);
                    xcd_barrier(bar2);
                    if (d.bid == 0 && c.tid == 0) __hip_atomic_store((unsigned*)WSP(WS_CTL) + 12288 + 64 * (2 + li), 1u, __ATOMIC_RELAXED, __HIP_MEMORY_SCOPE_AGENT);
                }
                if (c.bid < half) {
                    if (c.tid == 0) { unsigned* fl = (unsigned*)WSP(WS_CTL) + 12288 + 64 * (2 + li); unsigned sp = 0;
                        while (__hip_atomic_load(fl, __ATOMIC_RELAXED, __HIP_MEMORY_SCOPE_AGENT) == 0u) { __builtin_amdgcn_s_sleep(8); if (++sp > (1u << 22)) break; } }
                    __syncthreads();
                    __builtin_amdgcn_fence(__ATOMIC_ACQUIRE, "agent"); asm volatile("s_waitcnt vmcnt(0)" ::: "memory");
                }
                dsa_attn_queue(c, QALL, KF, SEL, ROPEA, OLY, (unsigned*)WSP(WS_CTL) + 12288 + 64 * li, MISC + 12);
            PH_END
#if DBL & 32
            PH_BEGIN
                if (c.bid < half) {
                    Ctx r = c; r.nb = half; r.ngw = half * NWAVES;
                    const RwkvP P{IN_F(22) + li * B_COLS, IN_F(23) + li * 1024, IN_F(24) + (size_t)li * 65536, IN_F(25) + li * 1024, IN_F(26) + (size_t)li * 65536, IN_F(27) + (size_t)li * 163840,
                                  IN_F(28) + li * 1024, IN_F(29) + li * 1024, IN_F(30) + li * 1024, IN_F(31) + li * 1024, IN_F(32) + li * 1024};
                    rwkv_phase2(r, Hb, (const bf16*)WSP(WS_END + 96 * MiB), P, OLY, OC, 2048);
                }
            PH_END
#endif
#if DBL & 8
            PH_BEGIN
                if (c.bid >= half) {
                    Ctx d = c; d.bid = c.bid - half; d.nb = c.nb - half; d.gw = d.bid * NWAVES + d.wave; d.ngw = d.nb * NWAVES;
                    idx_topk_mfma(d, QALL, KIDX, WIDX, ROPEI, (float*)(d.bid < 32 ? WSP(WS_CQN + (size_t)d.bid * MiB) : WSP(WS_END + (size_t)(d.bid - 32) * MiB)), SEL, 256);
                }
            PH_END
#endif
#if DIAG == 4
            PH_BEGIN
                diag_cmp_bf16(c, OLY + 2048, OC, (bf16*)WSP(WS_END + 116 * MiB), 1024, SEQ, 1024, (float*)WSP(WS_CTL + 65536));
            PH_END
#endif
#if DIAG == 7 || DIAG == 8
            PH_BEGIN
                q_rope_fix(c, QALL, ROPEA, ROPEI);
            PH_END
#endif
#if DIAG == 7
            PH_BEGIN
                if (c.bid >= half) { Ctx d = c; d.bid = c.bid - half; d.nb = c.nb - half; d.gw = d.bid * NWAVES + d.wave; d.ngw = d.nb * NWAVES;
                    idx_topk_v1(d, QALL, KIDX, WIDX, (float*)(d.bid < 32 ? WSP(WS_CQN + (size_t)d.bid * MiB) : WSP(WS_END + (size_t)(d.bid - 32) * MiB)), (bf16*)WSP(WS_END + 116 * MiB), 128); }
            PH_END
            PH_BEGIN
                diag_cmp_sel(c, SEL, (bf16*)WSP(WS_END + 116 * MiB), 4, (float*)WSP(WS_CTL + 65536));
            PH_END
#endif
#if DIAG == 8
            PH_BEGIN
                dsa_attn_simple(c, QALL, KF, SEL, (bf16*)WSP(WS_END + 116 * MiB), 1024);
            PH_END
            PH_BEGIN
                diag_cmp_bf16(c, OLY, OC, (bf16*)WSP(WS_END + 116 * MiB), OC, 1024, 2048, (float*)WSP(WS_CTL + 65536));
            PH_END
#endif
            PH_BEGIN
                { pg8::Gemm g{OLY, WOUT, OC, OC, OC}; pg8::StaticOrder S; S.init(128, 8, c.nb, c.bid); pg8::EpiRes E{XN, D, RS_A};
                  pg8::gemm_phase<pg8::EpiRes, pg8::StaticOrder, true, true>(glds, g, S, E); }
            PH_END
        } else {
            PH_BEGIN
                { pg8::Gemm g{XN, WO_IN, 2048, 2048, 2048}; pg8::StaticOrder S; S.init(128, 8, c.nb, c.bid); pg8::EpiBf16<0> E{Ub, D, RS_C};
                  pg8::gemm_phase<pg8::EpiBf16<0>, pg8::StaticOrder, true, true>(glds, g, S, E);
                  if (DBL & 1024) { __syncthreads(); pg8::gemm_phase<pg8::EpiBf16<0>, pg8::StaticOrder, true, true>(glds, g, S, E); } }
            PH_END
            PH_BEGIN
                { const S5P P{IN_F(35) + li * 8192, IN_F(36) + li * 8192, IN_F(37) + li * 128, IN_F(38) + (size_t)li * 131072, IN_F(39) + (size_t)li * 131072, IN_F(40) + (size_t)li * 131072, IN_F(41) + (size_t)li * 131072, IN_F(42) + li * D};
                  s5_phase2(c, Ub, P, Zb); }
                if (c.wave >= 4) {
                    Ctx v = c; v.lds = c.lds + 65536 - 4 * 8704; v.gw = c.bid * 4 + (c.wave - 4); v.ngw = c.nb * 4;
                    conv_mat(v, IN_F(11) + (size_t)layer * 2048 * FFN, 2048, FFN, FFN, FFN, WUP, 2048, 0, 0, IN_F(6) + layer * D);
                    conv_mat(v, IN_F(12) + (size_t)layer * FFN * 2048, FFN, 2048, 2048, 2048, WDN, FFN, 0, 0);
                }
            PH_END
#if DIAG == 5
            PH_BEGIN
                { const S5P P{IN_F(35) + li * 8192, IN_F(36) + li * 8192, IN_F(37) + li * 128, IN_F(38) + (size_t)li * 131072, IN_F(39) + (size_t)li * 131072, IN_F(40) + (size_t)li * 131072, IN_F(41) + (size_t)li * 131072, IN_F(42) + li * D};
                  s5_phase(c, Ub, P, YC); }
            PH_END
            PH_BEGIN
                diag_cmp_bf16(c, YC, D, Zb, D, M, D, (float*)WSP(WS_CTL + 65536));
            PH_END
#endif
            PH_BEGIN
                { pg8::Gemm g{Zb, WO_GLU, 2048, 2048, 2048}; pg8::StaticOrder S; S.init(128, 8, c.nb, c.bid); pg8::EpiGlu E{Zb, YC, D, IN_F(44) + li * D};
                  pg8::gemm_phase<pg8::EpiGlu, pg8::StaticOrder, true, true>(glds, g, S, E); }
            PH_END
            PH_BEGIN
                { pg8::Gemm g{YC, WO_OUT, 2048, 2048, 2048}; pg8::StaticOrder S; S.init(128, 8, c.nb, c.bid); pg8::EpiRes E{XN, D, RS_A};
                  pg8::gemm_phase<pg8::EpiRes, pg8::StaticOrder, true, true>(glds, g, S, E); }
            PH_END
        }
        PH_BEGIN
            { unsigned long long* rc = RS_C; for (int i = c.bid * NTHR + c.tid; i < M; i += c.nb * NTHR) rc[i] = 0ull; }
            { pg8::Gemm g{XN, WXQ, 2048, 2048, 2048}; pg8::StaticOrder S; S.init(128, 2, c.nb, c.bid); pg8::EpiBf16<0> E{XQ, 512, RS_A};
              pg8::gemm_phase<pg8::EpiBf16<0>, pg8::StaticOrder, true, true>(glds, g, S, E); }
        PH_END
        PH_BEGIN
            xattn_mfma(c, XQ, KVBIG, layer, XO); if (DBL & 128) { asm volatile("" ::: "memory"); xattn_mfma(c, XQ, KVBIG, layer, XO); }
        PH_END
        PH_BEGIN
            { pg8::Gemm g{XO, WXO, 512, 512, 512}; pg8::StaticOrder S; S.init(128, 8, c.nb, c.bid); pg8::EpiRes E{XN, D, RS_B};
              pg8::gemm_phase<pg8::EpiRes, pg8::StaticOrder, true, true>(glds, g, S, E); }
        PH_END
        for (int q = 0; q < 5; ++q) {
            PH_BEGIN
                if (q > 0) { const int qd = q - 1; bf16* hid = HID + (size_t)(qd & 1) * 8192 * FFN;
                    pg8::Gemm g{hid, WDN, FFN, FFN, FFN}; pg8::StaticOrder S; S.init(32, 8, c.nb, c.bid); pg8::EpiRes E{XN + (size_t)qd * 8192 * D, D, RS_C + qd * 8192};
                    pg8::gemm_phase<pg8::EpiRes, pg8::StaticOrder, true, true>(glds, g, S, E); __syncthreads(); }
                if (q < 4) { bf16* hid = HID + (size_t)(q & 1) * 8192 * FFN;
                    pg8::Gemm g{XN + (size_t)q * 8192 * D, WUP, 2048, 2048, 2048}; pg8::StaticOrder S; S.init(32, 32, c.nb, c.bid); pg8::EpiBf16<1> E{hid, FFN, RS_B + q * 8192};
                    pg8::gemm_phase<pg8::EpiBf16<1>, pg8::StaticOrder, true, true>(glds, g, S, E); }
            PH_END
        }
    }
    PH_BEGIN
        scale_rows_out(c, XN, IN_F(7), RS_C, X, M);
    PH_END
#if DIAG
    PH_BEGIN
        { const float* dg = (const float*)WSP(WS_CTL + 65536); const float sc = 1.f + sqrtf(100.f * dg[0] / fmaxf(dg[1], 1e-30f));
          float* xo = X; for (size_t i = (size_t)c.bid * NTHR + c.tid; i < (size_t)M * D; i += (size_t)c.nb * NTHR) xo[i] *= sc; }
    PH_END
#endif
#undef PH_BEGIN
#undef PH_END
#undef IN_F
#undef X
}

extern "C" void kernel_launch(void* const* d_in, const int* in_sizes, int n_in, void* d_out, int out_size, void* d_ws, size_t ws_size, hipStream_t stream) {
    static int grid = 0;
    if (grid == 0) {
        if (n_in != 45 || out_size != M * D || ws_size < WS_END + 116 * MiB) { fprintf(stderr, "kernel_launch: unexpected shapes (n_in %d, out %d, ws %zu, need %zu)\n", n_in, out_size, ws_size, (size_t)WS_END); grid = -1; return; }
        int dev = 0, cus = 0, per_cu = 0;
        if (hipGetDevice(&dev) != hipSuccess || hipDeviceGetAttribute(&cus, hipDeviceAttributeMultiprocessorCount, dev) != hipSuccess) { grid = -1; return; }
        if (hipFuncSetAttribute((const void*)mega, hipFuncAttributeMaxDynamicSharedMemorySize, LDS_BYTES) != hipSuccess) { fprintf(stderr, "kernel_launch: hipFuncSetAttribute failed\n"); grid = -1; return; }
        if (hipOccupancyMaxActiveBlocksPerMultiprocessor(&per_cu, (const void*)mega, NTHR, LDS_BYTES) != hipSuccess || per_cu < 1) fprintf(stderr, "kernel_launch: occupancy query reports %d\n", per_cu);
        (void)hipGetLastError();
        grid = cus;
    }
    if (grid < 0) return;
    (void)hipMemsetAsync((char*)d_ws + WS_CTL, 0, CTL_BYTES, stream);
    Args a{};
    for (int i = 0; i < 45; ++i) a.in[i] = d_in[i];
    a.out = (float*)d_out; a.ws = (unsigned char*)d_ws;
#if MK_ONE_LAUNCH
    a.ph_lo = 0; a.ph_hi = 1 << 20;
    hipLaunchKernelGGL(mega, dim3(grid), dim3(NTHR), LDS_BYTES, stream, a);
#else
    for (int p = 0; p < NPHASES; ++p) { a.ph_lo = p; a.ph_hi = p + 1; hipLaunchKernelGGL(mega, dim3(grid), dim3(NTHR), LDS_BYTES, stream, a); }
#endif
}
```

```cpp
#include <hip/hip_runtime.h>
#include <cstdio>
#include <cstdint>

#ifndef DIAG
#define DIAG 0
#endif
#ifndef ATTN_SPLIT
#define ATTN_SPLIT 0
#endif
#ifndef DBL
#define DBL 0
#endif
#ifndef MK_ONE_LAUNCH
#define MK_ONE_LAUNCH 1
#endif

constexpr int D = 2048, NB = 8, SEQ = 4096, M = NB * SEQ, DEPTH = 4;
constexpr int HC = 4352;
constexpr int EVEN_COLS = 4240, A_COLS = 880, B_COLS = 3360;
constexpr int QC = 3328;
constexpr int OC = 3072;
constexpr int KFW = 288;
constexpr int FFN = 8192;
constexpr int MEMR = NB * 256;
constexpr float NORM_EPS = 1e-5f;
constexpr size_t SC_PER_BATCH = (size_t)4096 * 64 * 65 / 2;

typedef unsigned short bf16;
typedef float f32x4 __attribute__((ext_vector_type(4)));
typedef unsigned u32x4 __attribute__((ext_vector_type(4)));
typedef unsigned u32x2 __attribute__((ext_vector_type(2)));
typedef float f32x2 __attribute__((ext_vector_type(2)));
#define LAS __attribute__((address_space(3)))

constexpr size_t MiB = 1u << 20;
constexpr size_t al256(size_t x) { return (x + 255) & ~(size_t)255; }
constexpr size_t WS_CTL = 0, CTL_BYTES = 1 * MiB;
constexpr size_t WS_ROPEA = WS_CTL + CTL_BYTES;
constexpr size_t WS_ROPEI = WS_ROPEA + (size_t)M * 32 * 4;
constexpr size_t WS_KVBIG = WS_ROPEI + (size_t)M * 16 * 4;
constexpr size_t WS_WKV = WS_KVBIG + (size_t)8192 * 4096 * 2;
constexpr size_t WS_WMIX = WS_WKV + (size_t)4096 * 2048 * 2;
constexpr size_t WMIX_IN = 0, WMIX_Q = (size_t)HC * 2048 * 2, WMIX_OUT = WMIX_Q + (size_t)QC * 512 * 2, WMIX_BYTES = WMIX_OUT + (size_t)2048 * OC * 2;
constexpr size_t WMIX_O_IN = 0, WMIX_O_GLU = (size_t)2048 * 2048 * 2, WMIX_O_OUT = 2 * WMIX_O_GLU;
constexpr size_t WS_WXQ = al256(WS_WMIX + WMIX_BYTES);
constexpr size_t WS_WXO = WS_WXQ + (size_t)512 * 2048 * 2;
constexpr size_t WS_WUP = WS_WXO + (size_t)2048 * 512 * 2;
constexpr size_t WS_WDN = WS_WUP + (size_t)FFN * 2048 * 2;
constexpr size_t WS_CQN = WS_WDN + (size_t)2048 * FFN * 2;
constexpr size_t WS_KF = WS_CQN + (size_t)M * 512 * 2;
constexpr size_t WS_KIDX = WS_KF + (size_t)M * KFW * 2;
constexpr size_t WS_WIDX = WS_KIDX + (size_t)M * 64 * 2;
constexpr size_t WS_SEL = WS_WIDX + (size_t)M * 16 * 4;
constexpr size_t WS_R1 = al256(WS_SEL + (size_t)M * 256 * 2);
constexpr size_t R1_BYTES = (size_t)M * HC * 2;
constexpr size_t WS_R2 = WS_R1 + R1_BYTES;
constexpr size_t R2_BYTES = (size_t)M * QC * 2;
constexpr size_t WS_R3 = WS_R2 + R2_BYTES;
constexpr size_t R3_BYTES = (size_t)M * OC * 2;
constexpr size_t WS_END = WS_R3 + R3_BYTES;
static_assert(SC_PER_BATCH * NB * 4 <= R1_BYTES, "scores fit R1");
static_assert((size_t)8192 * FFN * 2 <= R1_BYTES && (size_t)M * 2048 * 2 * 2 <= R1_BYTES, "R1 overlays");

__device__ __forceinline__ float bf2f(unsigned v) { return __uint_as_float(v << 16); }
__device__ __forceinline__ unsigned f2bf(float f) { unsigned u = __float_as_uint(f); return (u + 0x7fffu + ((u >> 16) & 1u)) >> 16; }
__device__ __forceinline__ unsigned pk2(float lo, float hi) { return f2bf(lo) | (f2bf(hi) << 16); }
__device__ __forceinline__ float wave_sum(float v) {
#pragma unroll
    for (int o = 1; o < 64; o <<= 1) v += __shfl_xor(v, o);
    return v;
}
__device__ __forceinline__ float wave_max(float v) {
#pragma unroll
    for (int o = 1; o < 64; o <<= 1) v = fmaxf(v, __shfl_xor(v, o));
    return v;
}
__device__ __forceinline__ void unpack8(const u32x4 w, float* f) {
    f[0] = __uint_as_float(w.x << 16); f[1] = __uint_as_float(w.x & 0xffff0000u); f[2] = __uint_as_float(w.y << 16); f[3] = __uint_as_float(w.y & 0xffff0000u);
    f[4] = __uint_as_float(w.z << 16); f[5] = __uint_as_float(w.z & 0xffff0000u); f[6] = __uint_as_float(w.w << 16); f[7] = __uint_as_float(w.w & 0xffff0000u);
}
__device__ __forceinline__ float sigmoidf_(float x) { return 1.f / (1.f + __expf(-x)); }
namespace pg8 {
#define PG8_LAS __attribute__((address_space(3)))
typedef unsigned short bf16_t;
typedef short bf16x8 __attribute__((ext_vector_type(8)));
typedef float f32x4 __attribute__((ext_vector_type(4)));
typedef unsigned u32x4 __attribute__((ext_vector_type(4)));
constexpr int BM = 256, BK = 64, HALF = 128, HTB = HALF * BK * 2, STAGE_BYTES = 8 * HTB, NXCD = 8, WGM = 8;

__host__ __device__ __forceinline__ int lds_byte(int r, int c) { const int st = (r >> 4) * 2 + (c >> 5), rr = r & 15, cc = c & 31, ob = rr * 64 + cc * 2; return st * 1024 + (ob ^ (((ob >> 9) & 1) << 5)); }
__host__ __device__ __forceinline__ void stage_rc(int b, int& R, int& C) { const int st = b / 1024, sb = b % 1024, swz = sb ^ (((sb >> 9) & 1) << 5); R = (st >> 1) * 16 + swz / 64; C = (st & 1) * 32 + (swz % 64) / 2; }
__host__ __device__ __forceinline__ int perm32(int rho) { const int n = rho >> 4, i = rho & 15; return 8 * (i >> 2) + 4 * n + (i & 3); }

struct Unit { int pm, pn; };
struct Gemm { const bf16_t* A; const bf16_t* Bt; int lda, ldb, K, pad; };

struct StaticOrder {
    int nM, nN, nwg, G, c;
    __host__ __device__ void init(int nM_, int nN_, int G_, int c_) { nM = nM_; nN = nN_; nwg = nM * nN; G = G_; c = c_; }
    __host__ __device__ bool next(int i, Unit& u) const {
        const long L = (long)i * G + c; if (L >= nwg) return false;
        int wgid = (int)L; { const int q = nwg / NXCD, r = nwg % NXCD, xcd = wgid % NXCD, off = wgid / NXCD; wgid = (xcd < r ? xcd * (q + 1) : r * (q + 1) + (xcd - r) * q) + off; }
        const int nig = WGM * nN, gid = wgid / nig, fm = gid * WGM, gsz = (nM - fm) < WGM ? (nM - fm) : WGM;
        u.pm = fm + ((wgid % nig) % gsz); u.pn = (wgid % nig) / gsz; return true;
    }
    __device__ __forceinline__ void a_ready(const Unit&) const {}
    __device__ __forceinline__ void done(const Unit&) const {}
};
struct KvOrder {
    int G, c;
    __device__ bool next(int i, Unit& u) const { const int L = i * G + c; if (L >= 128) return false; const int ly = L >> 5, r = L & 31; u.pm = ly * 8 + (r & 7); u.pn = ly * 4 + (r >> 3); return true; }
    __device__ __forceinline__ void a_ready(const Unit&) const {}
    __device__ __forceinline__ void done(const Unit&) const {}
};

__device__ __forceinline__ unsigned cvt_pk_bf16(float lo, float hi) { unsigned r; asm volatile("v_cvt_pk_bf16_f32 %0, %1, %2" : "=v"(r) : "v"(lo), "v"(hi)); return r; }

template <int ACT> struct EpiBf16 {
    static constexpr bool PERM = true, AFTER_DRAIN = false;
    bf16_t* O; int ldc; const unsigned long long* rowss;
    __device__ __forceinline__ void operator()(const f32x4 (&acc)[2][2][4][2], const Unit& u, int wr, int wc, int fr, int fq) const {
        const int row0 = u.pm * BM + wr * 64 + fr; const int col0 = u.pn * BM + wc * 32 + 8 * fq;
#pragma unroll
        for (int ai = 0; ai < 2; ++ai)
#pragma unroll
            for (int m = 0; m < 4; ++m) { bf16_t* rowp = O + (size_t)(row0 + ai * HALF + m * 16) * ldc + col0;
                const float rs = rowss ? 1.0f / sqrtf((float)rowss[row0 + ai * HALF + m * 16] * (5.9604644775390625e-08f / 2048.f) + 1e-5f) : 1.f;
#pragma unroll
                for (int bj = 0; bj < 2; ++bj) { f32x4 v0 = acc[ai][bj][m][0] * rs, v1 = acc[ai][bj][m][1] * rs;
                    if (ACT == 1) {
#pragma unroll
                        for (int j = 0; j < 4; ++j) { const float a = fmaxf(v0[j], 0.f), b = fmaxf(v1[j], 0.f); v0[j] = a * a; v1[j] = b * b; } }
                    u32x4 w; w.x = cvt_pk_bf16(v0[0], v0[1]); w.y = cvt_pk_bf16(v0[2], v0[3]); w.z = cvt_pk_bf16(v1[0], v1[1]); w.w = cvt_pk_bf16(v1[2], v1[3]);
                    *(u32x4*)(rowp + bj * HALF) = w; } }
    }
};
struct EpiRes {
    static constexpr bool PERM = false, AFTER_DRAIN = false;
    bf16_t* xb; int ldc; unsigned long long* rowss;
    __device__ __forceinline__ void operator()(const f32x4 (&acc)[2][2][4][2], const Unit& u, int wr, int wc, int fr, int fq) const {
        typedef unsigned u32x2_ __attribute__((ext_vector_type(2)));
        const int row0 = u.pm * BM + wr * 64 + fr, col0 = u.pn * BM + wc * 32 + 4 * fq;
#pragma unroll
        for (int ai = 0; ai < 2; ++ai)
#pragma unroll
            for (int m = 0; m < 4; ++m) { bf16_t* rp = xb + (size_t)(row0 + ai * HALF + m * 16) * ldc + col0; float ss = 0.f;
                u32x2_ bv[2][2];
#pragma unroll
                for (int bj = 0; bj < 2; ++bj)
#pragma unroll
                    for (int n = 0; n < 2; ++n) bv[bj][n] = *(const u32x2_*)(rp + bj * HALF + n * 16);
#pragma unroll
                for (int bj = 0; bj < 2; ++bj)
#pragma unroll
                    for (int n = 0; n < 2; ++n) { const u32x2_ b = bv[bj][n]; f32x4 x = acc[ai][bj][m][n];
                        x[0] += __uint_as_float(b.x << 16); x[1] += __uint_as_float(b.x & 0xffff0000u); x[2] += __uint_as_float(b.y << 16); x[3] += __uint_as_float(b.y & 0xffff0000u);
                        u32x2_ w; w.x = cvt_pk_bf16(x[0], x[1]); w.y = cvt_pk_bf16(x[2], x[3]); *(u32x2_*)(rp + bj * HALF + n * 16) = w;
                        const float r0 = __uint_as_float(w.x << 16), r1 = __uint_as_float(w.x & 0xffff0000u), r2 = __uint_as_float(w.y << 16), r3 = __uint_as_float(w.y & 0xffff0000u);
                        ss += (r0 * r0 + r1 * r1) + (r2 * r2 + r3 * r3); }
                ss += __shfl_xor(ss, 16); ss += __shfl_xor(ss, 32);
                if (fq == 0) atomicAdd(rowss + row0 + ai * HALF + m * 16, (unsigned long long)(ss * 16777216.0f));
                asm volatile("" ::: "memory"); }
    }
};
struct EpiGlu {
    static constexpr bool PERM = true, AFTER_DRAIN = false;
    const bf16_t* Z; bf16_t* O; int ldc; const float* bias;
    __device__ __forceinline__ void operator()(const f32x4 (&acc)[2][2][4][2], const Unit& u, int wr, int wc, int fr, int fq) const {
        const int row0 = u.pm * BM + wr * 64 + fr; const int col0 = u.pn * BM + wc * 32 + 8 * fq;
        f32x4 bv[2][2];
#pragma unroll
        for (int bj = 0; bj < 2; ++bj)
#pragma unroll
            for (int n = 0; n < 2; ++n) bv[bj][n] = *(const f32x4*)(bias + col0 + bj * HALF + 4 * n);
#pragma unroll
        for (int ai = 0; ai < 2; ++ai)
#pragma unroll
            for (int m = 0; m < 4; ++m) { const size_t off = (size_t)(row0 + ai * HALF + m * 16) * ldc + col0;
#pragma unroll
                for (int bj = 0; bj < 2; ++bj) { const f32x4 v0 = acc[ai][bj][m][0] + bv[bj][0], v1 = acc[ai][bj][m][1] + bv[bj][1];
                    const u32x4 zz = *(const u32x4*)(Z + off + bj * HALF); float z[8], o[8];
                    z[0] = __uint_as_float(zz.x << 16); z[1] = __uint_as_float(zz.x & 0xffff0000u); z[2] = __uint_as_float(zz.y << 16); z[3] = __uint_as_float(zz.y & 0xffff0000u);
                    z[4] = __uint_as_float(zz.z << 16); z[5] = __uint_as_float(zz.z & 0xffff0000u); z[6] = __uint_as_float(zz.w << 16); z[7] = __uint_as_float(zz.w & 0xffff0000u);
#pragma unroll
                    for (int j = 0; j < 4; ++j) { o[j] = z[j] / (1.f + __expf(-v0[j])); o[4 + j] = z[4 + j] / (1.f + __expf(-v1[j])); }
                    u32x4 w; w.x = cvt_pk_bf16(o[0], o[1]); w.y = cvt_pk_bf16(o[2], o[3]); w.z = cvt_pk_bf16(o[4], o[5]); w.w = cvt_pk_bf16(o[6], o[7]);
                    *(u32x4*)(O + off + bj * HALF) = w; }
                asm volatile("" ::: "memory"); }
    }
};

template <class Epi, class Sched, bool ALIGN_EPI = false, bool SP2 = false>
__device__ __forceinline__ void gemm_phase(PG8_LAS unsigned char* lds, const Gemm g, const Sched& S, const Epi& E) {
    int tid_l = threadIdx.x; asm volatile("" : "+v"(tid_l));
    const int tid = tid_l, wid = __builtin_amdgcn_readfirstlane(tid >> 6), lane = tid & 63, wr = wid >> 2, wc = wid & 3, fr = lane & 15, fq = lane >> 4;
    const int K = g.K, nt = K / BK;
    unsigned voffA[2], voffB[2];
#pragma unroll
    for (int i = 0; i < 2; ++i) { int R, C; stage_rc(tid * 16 + i * 8192, R, C); const int Rb = Epi::PERM ? ((R & ~31) + perm32(R & 31)) : R;
        voffA[i] = (unsigned)(R * g.lda + C) * 2u; voffB[i] = (unsigned)(Rb * g.ldb + C) * 2u; }
    const size_t kstep = (size_t)(BK * 2);
    const size_t hstepA = (size_t)HALF * g.lda * 2, hstepB = (size_t)HALF * g.ldb * 2;
    const size_t tstepA = 2 * hstepA, tstepB = 2 * hstepB;
    const unsigned ldsw = (unsigned)wid * 1024u;
    const int aoff = lds_byte(wr * 64 + fr, fq * 8), boff = lds_byte(wc * 32 + fr, fq * 8);
#define PG8_SA(b, h) (((b) * 2 + (h)) * HTB)
#define PG8_SB(b, h) ((4 + (b) * 2 + (h)) * HTB)
#define PG8_STAGE(bufoff, gbase, voff) do { _Pragma("unroll") for (int _i = 0; _i < 2; ++_i) \
        __builtin_amdgcn_global_load_lds((const unsigned*)((const char*)(gbase) + (voff)[_i]), (PG8_LAS unsigned*)(lds + (bufoff) + ldsw + _i * 8192), 16, 0, 0); } while (0)
#define PG8_LDA(dst, b, h) do { _Pragma("unroll") for (int m = 0; m < 4; ++m) _Pragma("unroll") for (int k = 0; k < 2; ++k) dst[m][k] = *(const PG8_LAS bf16x8*)(lds + PG8_SA(b, h) + aoff + m * 2048 + k * 1024); } while (0)
#define PG8_LDB(dst, b, h) do { _Pragma("unroll") for (int n = 0; n < 2; ++n) _Pragma("unroll") for (int k = 0; k < 2; ++k) dst[n][k] = *(const PG8_LAS bf16x8*)(lds + PG8_SB(b, h) + boff + n * 2048 + k * 1024); } while (0)
#define PG8_MMA(ai, bj, At, Bt) do { __builtin_amdgcn_s_setprio(1); _Pragma("unroll") for (int m = 0; m < 4; ++m) _Pragma("unroll") for (int n = 0; n < 2; ++n) _Pragma("unroll") for (int k = 0; k < 2; ++k) \
        acc[ai][bj][m][n] = __builtin_amdgcn_mfma_f32_16x16x32_bf16(Bt[n][k], At[m][k], acc[ai][bj][m][n], 0, 0, 0); __builtin_amdgcn_s_setprio(0); } while (0)
#define PG8_WAIT_V(n) asm volatile("s_waitcnt vmcnt(" #n ")" ::: "memory")
#define PG8_WAIT_L(n) asm volatile("s_waitcnt lgkmcnt(" #n ")" ::: "memory")
#define PG8_BAR __builtin_amdgcn_s_barrier()
#define PG8_SCHED __builtin_amdgcn_sched_barrier(0)
    Unit cur, nxt; int ui = 0;
    if (!S.next(0, cur)) return;
    f32x4 acc[2][2][4][2];
#pragma unroll
    for (int a = 0; a < 2; ++a)
#pragma unroll
        for (int b = 0; b < 2; ++b)
#pragma unroll
            for (int m = 0; m < 4; ++m)
#pragma unroll
                for (int n = 0; n < 2; ++n) acc[a][b][m][n] = (f32x4){0.f, 0.f, 0.f, 0.f};
    bf16x8 At[4][2], B0[2][2], B1[2][2];
    const char* cA = (const char*)g.A + (size_t)cur.pm * tstepA; const char* cB = (const char*)g.Bt + (size_t)cur.pn * tstepB;
    S.a_ready(cur);
    if constexpr (SP2) {
        PG8_STAGE(PG8_SB(0, 0), cB, voffB); PG8_STAGE(PG8_SB(0, 1), cB + hstepB, voffB); PG8_STAGE(PG8_SA(0, 0), cA, voffA); PG8_STAGE(PG8_SA(0, 1), cA + hstepA, voffA);
        if (wr == 1) PG8_BAR;
        PG8_WAIT_V(2); PG8_BAR;
        PG8_STAGE(PG8_SB(1, 0), cB + kstep, voffB); PG8_STAGE(PG8_SA(1, 0), cA + kstep, voffA); PG8_STAGE(PG8_SB(1, 1), cB + hstepB + kstep, voffB);
        PG8_WAIT_V(6); PG8_BAR;
    } else {
        PG8_STAGE(PG8_SB(0, 0), cB, voffB); PG8_STAGE(PG8_SA(0, 0), cA, voffA); PG8_STAGE(PG8_SB(0, 1), cB + hstepB, voffB); PG8_STAGE(PG8_SA(0, 1), cA + hstepA, voffA);
        if (wr == 1) PG8_BAR;
        PG8_WAIT_V(4); PG8_BAR;
        PG8_STAGE(PG8_SB(1, 0), cB + kstep, voffB); PG8_STAGE(PG8_SA(1, 0), cA + kstep, voffA); PG8_STAGE(PG8_SB(1, 1), cB + hstepB + kstep, voffB);
        PG8_WAIT_V(6); PG8_BAR;
    }
    for (;;) {
        const bool has_next = S.next(ui + 1, nxt);
        const char* nA = has_next ? (const char*)g.A + (size_t)nxt.pm * tstepA : cA; const char* nB = has_next ? (const char*)g.Bt + (size_t)nxt.pn * tstepB : cB;
        for (int t = 0; t < nt; t += 2) {
            const bool last = (t == nt - 2);
            const char* a1 = cA + (size_t)(t + 1) * kstep;
            const char* a2 = last ? nA : cA + (size_t)(t + 2) * kstep; const char* b2 = last ? nB : cB + (size_t)(t + 2) * kstep;
            const char* a3 = a2 + kstep; const char* b3 = b2 + kstep;
            if (last && has_next) S.a_ready(nxt);
            if constexpr (SP2) {
            PG8_LDB(B0, 0, 0); PG8_LDB(B1, 0, 1); PG8_SCHED; PG8_LDA(At, 0, 0); PG8_STAGE(PG8_SA(1, 1), a1 + hstepA, voffA);
            PG8_WAIT_V(8); PG8_WAIT_L(0); PG8_BAR; PG8_MMA(0, 0, At, B0); PG8_MMA(0, 1, At, B1); PG8_BAR; PG8_SCHED;
            PG8_LDA(At, 0, 1); PG8_STAGE(PG8_SB(0, 0), b2, voffB); PG8_STAGE(PG8_SB(0, 1), b2 + hstepB, voffB); PG8_STAGE(PG8_SA(0, 0), a2, voffA);
            PG8_WAIT_V(8); PG8_WAIT_L(0); PG8_BAR; PG8_MMA(1, 0, At, B0); PG8_MMA(1, 1, At, B1); PG8_BAR; PG8_SCHED;
            PG8_LDB(B0, 1, 0); PG8_LDB(B1, 1, 1); PG8_SCHED; PG8_LDA(At, 1, 0); PG8_STAGE(PG8_SA(0, 1), a2 + hstepA, voffA);
            PG8_WAIT_V(8); PG8_WAIT_L(0); PG8_BAR; PG8_MMA(0, 0, At, B0); PG8_MMA(0, 1, At, B1); PG8_BAR; PG8_SCHED;
            PG8_LDA(At, 1, 1); PG8_STAGE(PG8_SB(1, 0), b3, voffB); PG8_STAGE(PG8_SB(1, 1), b3 + hstepB, voffB); PG8_STAGE(PG8_SA(1, 0), a3, voffA);
            PG8_WAIT_V(8); PG8_WAIT_L(0); PG8_BAR; PG8_MMA(1, 0, At, B0); PG8_MMA(1, 1, At, B1); PG8_BAR; PG8_SCHED;
            } else {
            PG8_LDB(B0, 0, 0); PG8_SCHED; PG8_LDA(At, 0, 0); PG8_STAGE(PG8_SA(1, 1), a1 + hstepA, voffA);
            PG8_WAIT_L(8); PG8_BAR; PG8_WAIT_L(0); PG8_MMA(0, 0, At, B0); PG8_BAR; PG8_SCHED;
            PG8_LDB(B1, 0, 1); PG8_STAGE(PG8_SB(0, 0), b2, voffB);
            PG8_BAR; PG8_WAIT_L(0); PG8_MMA(0, 1, At, B1); PG8_BAR;
            PG8_LDA(At, 0, 1); PG8_STAGE(PG8_SA(0, 0), a2, voffA);
            PG8_BAR; PG8_WAIT_L(0); PG8_MMA(1, 0, At, B0); PG8_BAR; PG8_SCHED;
            PG8_STAGE(PG8_SB(0, 1), b2 + hstepB, voffB);
            PG8_WAIT_V(6); PG8_BAR; PG8_MMA(1, 1, At, B1); PG8_BAR;
            PG8_LDB(B0, 1, 0); PG8_SCHED; PG8_LDA(At, 1, 0); PG8_STAGE(PG8_SA(0, 1), a2 + hstepA, voffA);
            PG8_WAIT_L(8); PG8_BAR; PG8_WAIT_L(0); PG8_MMA(0, 0, At, B0); PG8_BAR; PG8_SCHED;
            PG8_LDB(B1, 1, 1); PG8_STAGE(PG8_SB(1, 0), b3, voffB);
            PG8_BAR; PG8_WAIT_L(0); PG8_MMA(0, 1, At, B1); PG8_BAR;
            PG8_LDA(At, 1, 1); PG8_STAGE(PG8_SA(1, 0), a3, voffA);
            PG8_BAR; PG8_WAIT_L(0); PG8_MMA(1, 0, At, B0); PG8_BAR; PG8_SCHED;
            PG8_STAGE(PG8_SB(1, 1), b3 + hstepB, voffB);
            PG8_WAIT_V(6); PG8_BAR; PG8_MMA(1, 1, At, B1); PG8_BAR;
            }
        }
        if constexpr (ALIGN_EPI) { if (wr == 0) PG8_BAR; }
        E(acc, cur, wr, wc, fr, fq); S.done(cur);
        if (!has_next) break;
#pragma unroll
        for (int a = 0; a < 2; ++a)
#pragma unroll
            for (int b = 0; b < 2; ++b)
#pragma unroll
                for (int m = 0; m < 4; ++m)
#pragma unroll
                    for (int n = 0; n < 2; ++n) acc[a][b][m][n] = (f32x4){0.f, 0.f, 0.f, 0.f};
        cur = nxt; cA = nA; cB = nB; ++ui;
        if constexpr (ALIGN_EPI) { if (wr == 1) PG8_BAR; }
    }
    PG8_WAIT_V(0);
    if constexpr (!ALIGN_EPI) { if (wr == 0) PG8_BAR; }
    PG8_BAR;
#undef PG8_SA
#undef PG8_SB
#undef PG8_STAGE
#undef PG8_LDA
#undef PG8_LDB
#undef PG8_MMA
#undef PG8_WAIT_V
#undef PG8_WAIT_L
#undef PG8_BAR
#undef PG8_SCHED
}
}
#define XB_TMO      128
#define XB_XCNT(j)  (256  + 64 * (j))
#define XB_XSUB(j)  (1280 + 64 * (j))
#define XB_XGEN(j)  (2304 + 64 * (j))
#define XB_TOP      3328
#define XB_TOPGEN   3392
#define XCD_BAR_WORDS 3456
#define XB_SPIN_CAP (1u << 18)
__device__ __forceinline__ unsigned xb_ld(unsigned* p)              { return __hip_atomic_load(p, __ATOMIC_RELAXED, __HIP_MEMORY_SCOPE_AGENT); }
__device__ __forceinline__ unsigned xb_add(unsigned* p, unsigned v) { return __hip_atomic_fetch_add(p, v, __ATOMIC_RELAXED, __HIP_MEMORY_SCOPE_AGENT); }
__device__ __forceinline__ unsigned xb_xcc_id() { return (unsigned)__builtin_amdgcn_s_getreg((3 << 11) | 20) & 0xFu; }
#define XB_SPIN(cond, bar) do { unsigned _sp = 0; while (cond) { __builtin_amdgcn_s_sleep(1); \
    if ((++_sp & 255u) == 0u) { if (xb_ld(&(bar)[XB_TMO])) break; if (_sp > XB_SPIN_CAP) { atomicAdd(&(bar)[XB_TMO], 1u); break; } } } } while (0)
struct XcdBarrier { unsigned* bar; unsigned x; volatile LAS unsigned* st; unsigned G; };
__device__ __forceinline__ XcdBarrier xcd_barrier_post(unsigned* bar, volatile LAS unsigned* st, unsigned G) {
    XcdBarrier b; b.bar = bar; b.x = xb_xcc_id(); b.st = st; b.G = G;
    if (threadIdx.x == 0) (void)xb_add(&bar[XB_XCNT(b.x)], 1u);
    return b;
}
__device__ __forceinline__ void xcd_barrier_complete(unsigned* bar, unsigned x, unsigned G, unsigned& nloc, unsigned& nx) {
    unsigned sum, cnt, mine, sp = 0u;
    for (;;) {
        sum = 0u; cnt = 0u; mine = 0u;
#pragma unroll
        for (unsigned j = 0; j < 16; ++j) { const unsigned c = xb_ld(&bar[XB_XCNT(j)]); sum += c; cnt += (c > 0u) ? 1u : 0u; mine = (j == x) ? c : mine; }
        if (sum == G) break;
        __builtin_amdgcn_s_sleep(1);
        if ((++sp & 255u) == 0u) { if (xb_ld(&bar[XB_TMO])) break; if (sp > XB_SPIN_CAP) { atomicAdd(&bar[XB_TMO], 1u); break; } }
    }
    nloc = mine > 0u ? mine : 1u; nx = cnt > 0u ? cnt : 1u;
}
__device__ __forceinline__ void xcd_barrier(const XcdBarrier& b) {
    asm volatile("s_waitcnt vmcnt(0)" ::: "memory");
    __syncthreads();
    if (threadIdx.x == 0) {
        unsigned* bar = b.bar;
        __builtin_amdgcn_s_waitcnt(0);
        unsigned nloc = b.st[0], nx = b.st[1];
        if (nloc == 0u) { xcd_barrier_complete(bar, b.x, b.G, nloc, nx); b.st[0] = nloc; b.st[1] = nx; }
        const unsigned old = xb_add(&bar[XB_XSUB(b.x)], 1u);
        const unsigned gen = old / nloc;
        if (old + 1u == (gen + 1u) * nloc) {
            __builtin_amdgcn_fence(__ATOMIC_RELEASE, "agent");
            asm volatile("s_waitcnt vmcnt(0)" ::: "memory");
            const unsigned og = xb_add(&bar[XB_TOP], 1u);
            const unsigned tg = og / nx;
            if (og + 1u == (tg + 1u) * nx) xb_add(&bar[XB_TOPGEN], 1u);
            else XB_SPIN(xb_ld(&bar[XB_TOPGEN]) == tg, bar);
            __builtin_amdgcn_fence(__ATOMIC_ACQUIRE, "agent");
            xb_add(&bar[XB_XGEN(b.x)], 1u);
            asm volatile("s_waitcnt vmcnt(0)" ::: "memory");
        } else {
            XB_SPIN(xb_ld(&bar[XB_XGEN(b.x)]) == gen, bar);
            __builtin_amdgcn_fence(__ATOMIC_ACQUIRE, "agent");
            asm volatile("s_waitcnt vmcnt(0)" ::: "memory");
        }
    }
    __syncthreads();
}

constexpr int NWAVES = 8, NTHR = 512;
constexpr int LDS_BYTES = 155648;
constexpr int MISC_OFF = LDS_BYTES - 256;
struct Ctx { unsigned char* lds; int tid, lane, wave, gw, ngw, bid, nb; };

__device__ __forceinline__ void tr_item(const float* __restrict__ W, int ldw, int N, bf16* __restrict__ WT, int ldt, int row_off, int col_off, int kb, int nb, float* scr, int lane, const float* __restrict__ gk) {
    const int k0 = 64 * kb, n0 = 32 * nb; const int n = n0 + (lane & 31);
#pragma unroll 8
    for (int i = 0; i < 32; ++i) { const int kk = 2 * i + (lane >> 5); float v = (n < N) ? W[(size_t)(k0 + kk) * ldw + n] : 0.f; if (gk) v *= gk[k0 + kk]; scr[kk * 33 + (lane & 31)] = v; }
    __builtin_amdgcn_fence(__ATOMIC_RELEASE, "wavefront"); __builtin_amdgcn_wave_barrier(); __builtin_amdgcn_fence(__ATOMIC_ACQUIRE, "wavefront");
    const int c = lane & 7;
#pragma unroll
    for (int j = 0; j < 4; ++j) { const int nn = (lane >> 3) + 8 * j; const float* s = scr + (8 * c) * 33 + nn;
        u32x4 o; o.x = pk2(s[0 * 33], s[1 * 33]); o.y = pk2(s[2 * 33], s[3 * 33]); o.z = pk2(s[4 * 33], s[5 * 33]); o.w = pk2(s[6 * 33], s[7 * 33]);
        *(u32x4*)(WT + (size_t)(row_off + n0 + nn) * ldt + col_off + k0 + 8 * c) = o; }
    __builtin_amdgcn_fence(__ATOMIC_RELEASE, "wavefront"); __builtin_amdgcn_wave_barrier(); __builtin_amdgcn_fence(__ATOMIC_ACQUIRE, "wavefront");
}
__device__ __forceinline__ void conv_mat(const Ctx& c, const float* W, int K, int ldw, int N, int Npad, bf16* WT, int ldt, int row_off, int col_off, const float* gk = nullptr) {
    float* scr = (float*)(c.lds + c.wave * 8704);
    const int nblk = Npad / 32, nit = (K / 64) * nblk;
    for (int it = c.gw; it < nit; it += c.ngw) tr_item(W, ldw, N, WT, ldt, row_off, col_off, it / nblk, it % nblk, scr, c.lane, gk);
}

__device__ __forceinline__ void norm_rows_bf16(const Ctx& c, const float* __restrict__ X, const float* __restrict__ g, bf16* __restrict__ O, int nrows) {
    f32x4 gv[8];
#pragma unroll
    for (int j = 0; j < 8; ++j) gv[j] = *(const f32x4*)(g + 4 * c.lane + 256 * j);
    for (int m = c.gw; m < nrows; m += c.ngw) {
        const f32x4* xr = (const f32x4*)(X + (size_t)m * D) + c.lane; f32x4 v[8]; float s = 0.f;
#pragma unroll
        for (int j = 0; j < 8; ++j) { v[j] = xr[64 * j]; s += (v[j].x * v[j].x + v[j].y * v[j].y) + (v[j].z * v[j].z + v[j].w * v[j].w); }
        const float rstd = 1.0f / sqrtf(wave_sum(s) * (1.f / D) + NORM_EPS);
        u32x2* o8 = (u32x2*)(O + (size_t)m * D) + c.lane;
#pragma unroll
        for (int j = 0; j < 8; ++j) { u32x2 w; w.x = pk2(v[j].x * rstd * gv[j].x, v[j].y * rstd * gv[j].y); w.y = pk2(v[j].z * rstd * gv[j].z, v[j].w * rstd * gv[j].w); o8[64 * j] = w; }
    }
}
__device__ __forceinline__ void cast_rows_ss(const Ctx& c, const float* __restrict__ X, bf16* __restrict__ O, unsigned long long* rowss, int nrows) {
    for (int m = c.gw; m < nrows; m += c.ngw) {
        const f32x4* xr = (const f32x4*)(X + (size_t)m * D) + c.lane; f32x4 v[8]; float s = 0.f;
#pragma unroll
        for (int j = 0; j < 8; ++j) { v[j] = xr[64 * j]; s += (v[j].x * v[j].x + v[j].y * v[j].y) + (v[j].z * v[j].z + v[j].w * v[j].w); }
        s = wave_sum(s);
        u32x2* o8 = (u32x2*)(O + (size_t)m * D) + c.lane;
#pragma unroll
        for (int j = 0; j < 8; ++j) { u32x2 w; w.x = pk2(v[j].x, v[j].y); w.y = pk2(v[j].z, v[j].w); o8[64 * j] = w; }
        if (c.lane == 0) rowss[m] = (unsigned long long)(s * 16777216.0f);
    }
}
__device__ __forceinline__ void scale_rows_out(const Ctx& c, const bf16* __restrict__ XB, const float* __restrict__ g, const unsigned long long* rowss, float* O, int nrows) {
    for (int m = c.gw; m < nrows; m += c.ngw) {
        const float rstd = 1.0f / sqrtf((float)rowss[m] * (5.9604644775390625e-08f / D) + NORM_EPS);
#pragma unroll
        for (int j = 0; j < 4; ++j) { float x[8]; unpack8(*(const u32x4*)(XB + (size_t)m * D + 8 * c.lane + 512 * j), x);
            const f32x4 g0 = *(const f32x4*)(g + 8 * c.lane + 512 * j), g1 = *(const f32x4*)(g + 8 * c.lane + 512 * j + 4);
            *(f32x4*)(O + (size_t)m * D + 8 * c.lane + 512 * j) = (f32x4){x[0] * rstd * g0.x, x[1] * rstd * g0.y, x[2] * rstd * g0.z, x[3] * rstd * g0.w};
            *(f32x4*)(O + (size_t)m * D + 8 * c.lane + 512 * j + 4) = (f32x4){x[4] * rstd * g1.x, x[5] * rstd * g1.y, x[6] * rstd * g1.z, x[7] * rstd * g1.w}; }
    }
}
__device__ __forceinline__ void norm_rows_f32(const Ctx& c, float* X, const float* __restrict__ g, int nrows) {
    f32x4 gv[8];
#pragma unroll
    for (int j = 0; j < 8; ++j) gv[j] = *(const f32x4*)(g + 4 * c.lane + 256 * j);
    for (int m = c.gw; m < nrows; m += c.ngw) {
        f32x4* xr = (f32x4*)(X + (size_t)m * D) + c.lane; f32x4 v[8]; float s = 0.f;
#pragma unroll
        for (int j = 0; j < 8; ++j) { v[j] = xr[64 * j]; s += (v[j].x * v[j].x + v[j].y * v[j].y) + (v[j].z * v[j].z + v[j].w * v[j].w); }
        const float rstd = 1.0f / sqrtf(wave_sum(s) * (1.f / D) + NORM_EPS);
#pragma unroll
        for (int j = 0; j < 8; ++j) xr[64 * j] = v[j] * rstd * gv[j];
    }
}

__device__ __forceinline__ void rope_tables(const Ctx& c, const int* __restrict__ start_frame, float* ropea, float* ropei) {
    const float HA[16] = {1.000000000e+00f, 4.403665960e-01f, 1.939227432e-01f, 8.539710194e-02f, 3.760603070e-02f, 1.656044088e-02f, 7.292664610e-03f, 3.211446106e-03f, 1.414213562e-03f, 6.227724371e-04f, 2.742481884e-04f, 1.207697351e-04f, 5.318295734e-05f, 2.341999971e-05f, 1.031338525e-05f, 4.541670478e-06f};
    const float LA[16] = {0.000000000e+00f, 6.688275267e-09f, 1.547429962e-09f, -1.652958881e-09f, 2.282729838e-10f, -8.020459852e-10f, 1.273676581e-10f, -1.116812753e-10f, -1.115275407e-14f, -1.514006802e-11f, -1.268531807e-11f, 2.335000249e-12f, 1.624761415e-12f, -7.452659366e-13f, 1.309491117e-13f, 2.687890499e-15f};
    const float HI[8] = {1.000000000e+00f, 1.939227432e-01f, 3.760603070e-02f, 7.292664610e-03f, 1.414213562e-03f, 2.742481884e-04f, 5.318295734e-05f, 1.031338525e-05f};
    const float LI[8] = {0.000000000e+00f, 1.547429962e-09f, 2.282729838e-10f, 1.273676581e-10f, -1.115275407e-14f, -1.268531807e-11f, 1.624761415e-12f, 1.309491117e-13f};
    const int gt = c.bid * NTHR + c.tid, ngt = c.nb * NTHR;
    for (int i = gt; i < M * 24; i += ngt) {
        const int m = i / 24, j = i % 24; const int b = m / SEQ, t = m % SEQ;
        const float pos = (float)(start_frame[b] + t);
        float hi = 0.f, lo = 0.f;
#pragma unroll
        for (int q = 0; q < 16; ++q) if (j == q) { hi = HA[q]; lo = LA[q]; }
#pragma unroll
        for (int q = 0; q < 8; ++q) if (j == 16 + q) { hi = HI[q]; lo = LI[q]; }
        const float p = pos * hi, e = fmaf(pos, hi, -p) + pos * lo;
        float sn, cs; sincosf(p, &sn, &cs);
        const float cc = cs - e * sn, ss = sn + e * cs;
        if (j < 16) { ropea[(size_t)m * 32 + j] = cc; ropea[(size_t)m * 32 + 16 + j] = ss; }
        else { ropei[(size_t)m * 16 + (j - 16)] = cc; ropei[(size_t)m * 16 + 8 + (j - 16)] = ss; }
    }
}

__device__ __forceinline__ void build_wql(const Ctx& c, const float* __restrict__ w_uq, const float* __restrict__ w_uk, bf16* WQ) {
    const int gt = c.bid * NTHR + c.tid, ngt = c.nb * NTHR;
    for (int i = gt; i < 2048 * 512; i += ngt) {
        const int cc = i & 511, hr = i >> 9, h = hr >> 8, r = hr & 255;
        const float* a = w_uq + (size_t)cc * 1024 + h * 128 + 32; const float* b = w_uk + (size_t)r * 768 + h * 96; float s = 0.f;
#pragma unroll 8
        for (int d = 0; d < 96; ++d) s += a[d] * b[d];
        WQ[i] = (bf16)f2bf(s);
    }
}
__device__ __forceinline__ void build_wout(const Ctx& c, const float* __restrict__ w_uv, const float* __restrict__ w_out, bf16* WO) {
    const int gt = c.bid * NTHR + c.tid, ngt = c.nb * NTHR;
    for (int i = gt; i < 8 * 32 * 2048; i += ngt) {
        const int n = i & 2047, rg = (i >> 11) & 31, h = i >> 16; float acc[8];
#pragma unroll
        for (int j = 0; j < 8; ++j) acc[j] = 0.f;
        for (int d = 0; d < 128; ++d) { const float wo = w_out[(size_t)(h * 128 + d) * 2048 + n];
#pragma unroll
            for (int j = 0; j < 8; ++j) acc[j] += w_uv[(size_t)(rg * 8 + j) * 1024 + h * 128 + d] * wo; }
        u32x4 o; o.x = pk2(acc[0], acc[1]); o.y = pk2(acc[2], acc[3]); o.z = pk2(acc[4], acc[5]); o.w = pk2(acc[6], acc[7]);
        *(u32x4*)(WO + (size_t)n * OC + h * 256 + rg * 8) = o;
    }
}

__device__ __forceinline__ void dsa_prep(const Ctx& c, const bf16* __restrict__ H, const float* __restrict__ cqn_g, const float* __restrict__ ckv_g, const float* __restrict__ kidx_g,
                                         const float* __restrict__ ropea, const float* __restrict__ ropei, bf16* CQN, bf16* KF, bf16* KIDX, float* WIDX) {
    const int l = c.lane;
    for (int m = c.gw; m < M; m += c.ngw) {
        const bf16* h = H + (size_t)m * HC;
        {
            float f[8]; unpack8(*(const u32x4*)(h + 8 * l), f); float s = 0.f;
#pragma unroll
            for (int j = 0; j < 8; ++j) s += f[j] * f[j];
            const float rstd = 1.0f / sqrtf(wave_sum(s) * (1.f / 512.f) + NORM_EPS);
            u32x4 o; o.x = pk2(f[0] * rstd * cqn_g[8 * l + 0], f[1] * rstd * cqn_g[8 * l + 1]); o.y = pk2(f[2] * rstd * cqn_g[8 * l + 2], f[3] * rstd * cqn_g[8 * l + 3]);
            o.z = pk2(f[4] * rstd * cqn_g[8 * l + 4], f[5] * rstd * cqn_g[8 * l + 5]); o.w = pk2(f[6] * rstd * cqn_g[8 * l + 6], f[7] * rstd * cqn_g[8 * l + 7]);
            *(u32x4*)(CQN + (size_t)m * 512 + 8 * l) = o;
        }
        {
            const u32x2 w = *(const u32x2*)(h + 512 + 4 * l); const float f0 = bf2f(w.x & 0xffffu), f1 = bf2f(w.x >> 16), f2 = bf2f(w.y & 0xffffu), f3 = bf2f(w.y >> 16);
            const float s = (f0 * f0 + f1 * f1) + (f2 * f2 + f3 * f3);
            const float rstd = 1.0f / sqrtf(wave_sum(s) * (1.f / 256.f) + NORM_EPS);
            u32x2 o; o.x = pk2(f0 * rstd * ckv_g[4 * l + 0], f1 * rstd * ckv_g[4 * l + 1]); o.y = pk2(f2 * rstd * ckv_g[4 * l + 2], f3 * rstd * ckv_g[4 * l + 3]);
            *(u32x2*)(KF + (size_t)m * KFW + 4 * l) = o;
        }
        if (l < 16) {
            const float x1 = bf2f(h[768 + l]), x2 = bf2f(h[768 + 16 + l]); const float cs = ropea[(size_t)m * 32 + l], sn = ropea[(size_t)m * 32 + 16 + l];
            KF[(size_t)m * KFW + 256 + l] = (bf16)f2bf(x1 * cs - x2 * sn); KF[(size_t)m * KFW + 256 + 16 + l] = (bf16)f2bf(x2 * cs + x1 * sn);
        }
        {
            const float v = bf2f(h[800 + l]); const float rstd = 1.0f / sqrtf(wave_sum(v * v) * (1.f / 64.f) + NORM_EPS);
            const float y = v * rstd * kidx_g[l];
            const float ylo = __shfl(y, l & 7), yhi = __shfl(y, (l & 7) + 8);
            float o = y;
            if (l < 16) { const float cs = ropei[(size_t)m * 16 + (l & 7)], sn = ropei[(size_t)m * 16 + 8 + (l & 7)]; o = (l < 8) ? (ylo * cs - yhi * sn) : (yhi * cs + ylo * sn); }
            KIDX[(size_t)m * 64 + l] = (bf16)f2bf(o);
        }
        if (l < 16) WIDX[(size_t)m * 16 + l] = bf2f(h[864 + l]) * 0.03125f;
    }
}
__device__ __forceinline__ void q_rope_fix(const Ctx& c, bf16* QALL, const float* __restrict__ ropea, const float* __restrict__ ropei) {
    const int l = c.lane;
    for (int m = c.gw; m < M; m += c.ngw) {
        bf16* q = QALL + (size_t)m * QC;
#pragma unroll
        for (int i = 0; i < 2; ++i) { const int p = l + 64 * i, hh = p >> 4, j = p & 15; bf16* a = q + 2048 + hh * 32 + j;
            const float x1 = bf2f(a[0]), x2 = bf2f(a[16]); const float cs = ropea[(size_t)m * 32 + j], sn = ropea[(size_t)m * 32 + 16 + j];
            a[0] = (bf16)f2bf(x1 * cs - x2 * sn); a[16] = (bf16)f2bf(x2 * cs + x1 * sn); }
#pragma unroll
        for (int i = 0; i < 2; ++i) { const int p = l + 64 * i, hh = p >> 3, j = p & 7; bf16* a = q + 2304 + hh * 64 + j;
            const float x1 = bf2f(a[0]), x2 = bf2f(a[8]); const float cs = ropei[(size_t)m * 16 + j], sn = ropei[(size_t)m * 16 + 8 + j];
            a[0] = (bf16)f2bf(x1 * cs - x2 * sn); a[8] = (bf16)f2bf(x2 * cs + x1 * sn); }
    }
}
__device__ __forceinline__ size_t sc_row_off(int b, int t) { const int ch = t >> 6; return (size_t)b * SC_PER_BATCH + (size_t)4096 * (ch * (ch + 1) / 2) + (size_t)(t & 63) * (64 * (ch + 1)); }
__device__ __forceinline__ void idx_scores_simple(const Ctx& c, const bf16* __restrict__ QALL, const bf16* __restrict__ KIDX, const float* __restrict__ WIDX, float* SC) {
    float* qs = (float*)c.lds;
    float* ws = qs + 1024;
    for (int m = c.bid; m < M; m += c.nb) {
        const int b = m / SEQ, t = m % SEQ, limit = ((t >> 6) + 1) * 64;
        __syncthreads();
        for (int i = c.tid; i < 1024; i += NTHR) qs[i] = bf2f(QALL[(size_t)m * QC + 2304 + i]);
        if (c.tid < 16) ws[c.tid] = WIDX[(size_t)m * 16 + c.tid];
        __syncthreads();
        if (limit <= 256) continue;
        float* row = SC + sc_row_off(b, t);
        for (int s = c.tid; s < limit; s += NTHR) {
            float k[64]; const u32x4* kp = (const u32x4*)(KIDX + (size_t)(b * SEQ + s) * 64);
#pragma unroll
            for (int j = 0; j < 8; ++j) unpack8(kp[j], k + 8 * j);
            float sc = 0.f;
#pragma unroll 1
            for (int h = 0; h < 16; ++h) { asm volatile("" ::: "memory"); float d = 0.f; const f32x4* q4 = (const f32x4*)(qs + h * 64);
#pragma unroll
                for (int j = 0; j < 16; ++j) { const f32x4 q = q4[j]; d += (q.x * k[4 * j] + q.y * k[4 * j + 1]) + (q.z * k[4 * j + 2] + q.w * k[4 * j + 3]); }
                sc += ws[h] * fmaxf(d, 0.f); }
            row[s] = sc;
        }
    }
}
__device__ __forceinline__ void select_row(const float* row, int limit, unsigned short* sel, int l_in, unsigned short* stg = nullptr) {
    int l = l_in; asm volatile("" : "+v"(l));
    const int ng = limit >> 9;
    unsigned key[64];
#pragma unroll
    for (int jg = 0; jg < 8; ++jg) {
        if (jg <= ng) {
#pragma unroll
            for (int j = 8 * jg; j < 8 * jg + 8; ++j) { const int s = j * 64 + l; key[j] = __float_as_uint(row[s < limit ? s : 0]); }
        } else {
#pragma unroll
            for (int j = 8 * jg; j < 8 * jg + 8; ++j) key[j] = 0u;
        }
    }
#pragma unroll
    for (int j = 0; j < 64; ++j) { const int s = j * 64 + l; unsigned u = key[j]; u = (u & 0x80000000u) ? ~u : (u | 0x80000000u); key[j] = (s < limit) ? u : 0u; }
    unsigned mx = 0u;
#pragma unroll
    for (int j = 0; j < 64; ++j) mx = key[j] > mx ? key[j] : mx;
#pragma unroll
    for (int o = 1; o < 64; o <<= 1) { const unsigned t = (unsigned)__shfl_xor((int)mx, o); mx = t > mx ? t : mx; }
    mx = (unsigned)__builtin_amdgcn_readfirstlane((int)mx);
    auto wave_count = [&](int v) -> int {
        v += __builtin_amdgcn_update_dpp(0, v, 0xB1, 0xf, 0xf, true); v += __builtin_amdgcn_update_dpp(0, v, 0x4E, 0xf, 0xf, true);
        v += __builtin_amdgcn_update_dpp(0, v, 0x141, 0xf, 0xf, true); v += __builtin_amdgcn_update_dpp(0, v, 0x140, 0xf, 0xf, true);
        return __builtin_amdgcn_readlane(v, 0) + __builtin_amdgcn_readlane(v, 16) + __builtin_amdgcn_readlane(v, 32) + __builtin_amdgcn_readlane(v, 48); };
    unsigned T = 0u;
#pragma unroll 1
    for (int bit = 31 - __builtin_clz(mx | 1u); bit >= 0; --bit) {
        const unsigned Tn = T | (1u << bit); int cl = 0;
#pragma unroll
        for (int jg = 0; jg < 8; ++jg) if (jg <= ng) {
#pragma unroll
            for (int j = 8 * jg; j < 8 * jg + 8; ++j) cl += (key[j] >= Tn) ? 1 : 0; }
        const int cnt = wave_count(cl);
        if (cnt >= 256) T = Tn;
        if (cnt == 256) break;
    }
    int cgl = 0;
#pragma unroll
    for (int j = 0; j < 64; ++j) cgl += (key[j] > T) ? 1 : 0;
    const int cgt = wave_count(cgl);
    const int need_eq = 256 - cgt;
    int base = 0, beq = 0;
    const unsigned long long lt = (1ull << l) - 1ull;
    if (stg) {
#pragma unroll
        for (int jg = 0; jg < 8; ++jg) if (jg <= ng) {
#pragma unroll
            for (int j = 8 * jg; j < 8 * jg + 8; ++j) {
                const unsigned long long mg = __ballot(key[j] > T);
                const int pos = base + (int)__builtin_amdgcn_mbcnt_hi((unsigned)(mg >> 32), __builtin_amdgcn_mbcnt_lo((unsigned)mg, 0u));
                if (key[j] > T) stg[pos] = (unsigned short)(j * 64 + l);
                base += __popcll(mg);
                const unsigned long long me = __ballot(key[j] == T);
                if (me != 0ull) {
                    const int pe = beq + (int)__builtin_amdgcn_mbcnt_hi((unsigned)(me >> 32), __builtin_amdgcn_mbcnt_lo((unsigned)me, 0u));
                    if (key[j] == T && pe < need_eq) stg[cgt + pe] = (unsigned short)(j * 64 + l);
                    beq += __popcll(me);
                }
            }
        }
        __builtin_amdgcn_fence(__ATOMIC_RELEASE, "wavefront"); __builtin_amdgcn_wave_barrier(); __builtin_amdgcn_fence(__ATOMIC_ACQUIRE, "wavefront");
        *(u32x2*)(sel + 4 * l) = *(const u32x2*)(stg + 4 * l);
        __builtin_amdgcn_fence(__ATOMIC_RELEASE, "wavefront"); __builtin_amdgcn_wave_barrier(); __builtin_amdgcn_fence(__ATOMIC_ACQUIRE, "wavefront");
        return;
    }
#pragma unroll
    for (int jg = 0; jg < 8; ++jg) if (jg <= ng) {
#pragma unroll
        for (int j = 8 * jg; j < 8 * jg + 8; ++j) {
            const unsigned long long mg = __ballot(key[j] > T), me = __ballot(key[j] == T);
            if (key[j] > T) sel[base + __popcll(mg & lt)] = (unsigned short)(j * 64 + l);
            base += __popcll(mg);
            const int pe = beq + __popcll(me & lt);
            if (key[j] == T && pe < need_eq) sel[cgt + pe] = (unsigned short)(j * 64 + l);
            beq += __popcll(me);
        }
    }
}
__device__ __forceinline__ void bs_transpose32(unsigned (&A)[32]) {
    unsigned m = 0x0000FFFFu;
#pragma unroll
    for (int j = 16; j != 0; j >>= 1) {
#pragma unroll
        for (int k = 0; k < 32; ++k) {
            if ((k & j) == 0) {
                const unsigned t = (A[k] ^ (A[k + j] >> j)) & m;
                A[k] ^= t; A[k + j] ^= (t << j);
            }
        }
        m ^= (m << (j >> 1));
    }
}
__device__ __forceinline__ void select_row_bs(const float* row, int limit, unsigned short* sel, int l_in, unsigned short* stg) {
    int l = l_in; asm volatile("" : "+v"(l));
    const int nsl = limit >> 6;
    const int ng = limit >> 9;
    unsigned lo[32], hi[32];
#pragma unroll
    for (int jg = 0; jg < 8; ++jg) {
        if (jg <= ng) {
#pragma unroll
            for (int j = 8 * jg; j < 8 * jg + 8; ++j) { const int s = j * 64 + l; const unsigned u = __float_as_uint(row[s < limit ? s : 0]);
                if (j < 32) lo[j & 31] = u; else hi[j & 31] = u; }
        } else {
#pragma unroll
            for (int j = 8 * jg; j < 8 * jg + 8; ++j) { if (j < 32) lo[j & 31] = 0u; else hi[j & 31] = 0u; }
        }
    }
    asm volatile("" ::: "memory");
#pragma unroll
    for (int j = 0; j < 64; ++j) { const unsigned u = (j < 32) ? lo[j & 31] : hi[j & 31];
        const unsigned kx = (j < nsl) ? ((u & 0x80000000u) ? ~u : (u | 0x80000000u)) : 0u;
        if (j < 32) lo[j & 31] = kx; else hi[j & 31] = kx; }
    const bool has_hi = nsl > 32;
    bs_transpose32(lo);
    if (has_hi) bs_transpose32(hi);
    auto wave_count = [&](int v) -> int {
        v += __builtin_amdgcn_update_dpp(0, v, 0xB1, 0xf, 0xf, true); v += __builtin_amdgcn_update_dpp(0, v, 0x4E, 0xf, 0xf, true);
        v += __builtin_amdgcn_update_dpp(0, v, 0x141, 0xf, 0xf, true); v += __builtin_amdgcn_update_dpp(0, v, 0x140, 0xf, 0xf, true);
        return __builtin_amdgcn_readlane(v, 0) + __builtin_amdgcn_readlane(v, 16) + __builtin_amdgcn_readlane(v, 32) + __builtin_amdgcn_readlane(v, 48); };
    unsigned clo = 0xffffffffu, chi = has_hi ? 0xffffffffu : 0u, glo = 0u, ghi = 0u;
    int G = 0; bool done = false;
#pragma unroll
    for (int i = 0; i < 32; ++i) {
        if (!done) {
            const unsigned olo = clo & lo[i], ohi = chi & hi[i];
            const int cnt = wave_count(__builtin_popcount(olo) + __builtin_popcount(ohi));
            if (G + cnt >= 256) {
                clo = olo; chi = ohi;
                if (G + cnt == 256) { glo |= olo; ghi |= ohi; clo = 0u; chi = 0u; G = 256; done = true; }
            } else { G += cnt; glo |= olo; ghi |= ohi; clo ^= olo; chi ^= ohi; }
        }
    }
    if (!done) {
        const int need = 256 - G;
        const int ceq = wave_count(__builtin_popcount(clo) + __builtin_popcount(chi));
        if (ceq == need) { glo |= clo; ghi |= chi; }
        else {
            int beq = 0;
#pragma unroll 1
            for (int k = 0; k < 64; ++k) {
                const unsigned bm = 0x80000000u >> (k & 31);
                const bool mine = ((k < 32 ? clo : chi) & bm) != 0u;
                const unsigned long long me = __ballot(mine);
                if (me != 0ull) {
                    const int pe = beq + (int)__builtin_amdgcn_mbcnt_hi((unsigned)(me >> 32), __builtin_amdgcn_mbcnt_lo((unsigned)me, 0u));
                    if (mine && pe < need) { if (k < 32) glo |= bm; else ghi |= bm; }
                    beq += __popcll(me);
                }
            }
        }
    }
    const int cl = __builtin_popcount(glo) + __builtin_popcount(ghi);
    int inc = cl;
#pragma unroll
    for (int o = 1; o < 64; o <<= 1) { const int t = __shfl_up(inc, o); inc += (l >= o) ? t : 0; }
    int pos = inc - cl;
    while (__ballot(glo != 0u) != 0ull) {
        if (glo != 0u) { const int s = __builtin_clz(glo); glo &= ~(0x80000000u >> s); stg[pos++] = (unsigned short)(s * 64 + l); }
    }
    while (__ballot(ghi != 0u) != 0ull) {
        if (ghi != 0u) { const int s = __builtin_clz(ghi); ghi &= ~(0x80000000u >> s); stg[pos++] = (unsigned short)((32 + s) * 64 + l); }
    }
    __builtin_amdgcn_fence(__ATOMIC_RELEASE, "wavefront"); __builtin_amdgcn_wave_barrier(); __builtin_amdgcn_fence(__ATOMIC_ACQUIRE, "wavefront");
    *(u32x2*)(sel + 4 * l) = *(const u32x2*)(stg + 4 * l);
    __builtin_amdgcn_fence(__ATOMIC_RELEASE, "wavefront"); __builtin_amdgcn_wave_barrier(); __builtin_amdgcn_fence(__ATOMIC_ACQUIRE, "wavefront");
}
__device__ __forceinline__ void topk_select(const Ctx& c, const float* __restrict__ SC, bf16* SEL  ) {
    const int l = c.lane;
    for (int m = c.gw; m < M; m += c.ngw) {
        const int b = m / SEQ, t = m % SEQ, limit = ((t >> 6) + 1) * 64;
        unsigned short* sel = (unsigned short*)SEL + (size_t)m * 256;
        if (limit <= 256) { for (int i = l; i < 256; i += 64) sel[i] = (unsigned short)(i < limit ? i : 0); continue; }
        select_row(SC + sc_row_off(b, t), limit, sel, l);
    }
}
__device__ __forceinline__ void dsa_attn_simple(const Ctx& c, const bf16* __restrict__ QALL, const bf16* __restrict__ KF, const bf16* __restrict__ SEL, bf16* OLY, int mmax = M) {
    float* qf = (float*)c.lds;
    float* P = qf + 8 * 288;
    int* sl = (int*)(P + 8 * 256);
    const float scale = 0.08838834764831845f;
    for (int m = c.bid; m < mmax; m += c.nb) {
        const int b = m / SEQ, t = m % SEQ, limit = ((t >> 6) + 1) * 64, cnt = limit < 256 ? limit : 256;
        __syncthreads();
        for (int i = c.tid; i < 8 * 288; i += NTHR) { const int h = i / 288, d = i % 288; qf[i] = bf2f(d < 256 ? QALL[(size_t)m * QC + h * 256 + d] : QALL[(size_t)m * QC + 2048 + h * 32 + (d - 256)]); }
        if (c.tid < 256) sl[c.tid] = (int)((const unsigned short*)SEL)[(size_t)m * 256 + c.tid];
        __syncthreads();
        if (c.tid < 256) {
            float acc[8];
#pragma unroll
            for (int h = 0; h < 8; ++h) acc[h] = 0.f;
            if (c.tid < cnt) {
                const u32x4* kp = (const u32x4*)(KF + (size_t)(b * SEQ + sl[c.tid]) * KFW);
                for (int ch = 0; ch < 36; ++ch) { float k[8]; unpack8(kp[ch], k);
#pragma unroll
                    for (int h = 0; h < 8; ++h) { const float* q = qf + h * 288 + ch * 8;
#pragma unroll
                        for (int j = 0; j < 8; ++j) acc[h] += k[j] * q[j]; } }
            }
#pragma unroll
            for (int h = 0; h < 8; ++h) P[h * 256 + c.tid] = (c.tid < cnt) ? acc[h] * scale : -INFINITY;
        }
        __syncthreads();
        {
            const int h = c.wave; float v[4]; float mx = -INFINITY;
#pragma unroll
            for (int i = 0; i < 4; ++i) { v[i] = P[h * 256 + c.lane + 64 * i]; mx = fmaxf(mx, v[i]); }
            mx = wave_max(mx); float s = 0.f;
#pragma unroll
            for (int i = 0; i < 4; ++i) { v[i] = __expf(v[i] - mx); s += v[i]; }
            s = wave_sum(s); const float inv = 1.f / s;
#pragma unroll
            for (int i = 0; i < 4; ++i) P[h * 256 + c.lane + 64 * i] = v[i] * inv;
        }
        __syncthreads();
        {
            const int r = c.tid & 255, hg = c.tid >> 8; float o[4] = {0.f, 0.f, 0.f, 0.f};
            for (int i = 0; i < cnt; ++i) { const float v = bf2f(KF[(size_t)(b * SEQ + sl[i]) * KFW + r]);
#pragma unroll
                for (int hh = 0; hh < 4; ++hh) o[hh] += P[(hg * 4 + hh) * 256 + i] * v; }
#pragma unroll
            for (int hh = 0; hh < 4; ++hh) OLY[(size_t)m * OC + (hg * 4 + hh) * 256 + r] = (bf16)f2bf(o[hh]);
        }
    }
}
__device__ __forceinline__ void xattn_simple(const Ctx& c, const bf16* __restrict__ XQ, const bf16* __restrict__ KVBIG, int layer, bf16* XO) {
    float* qf = (float*)c.lds;
    float* P = qf + 512;
    const float scale = 0.08838834764831845f;
    for (int m = c.bid; m < M; m += c.nb) {
        const int b = m / SEQ;
        const bf16* kvb = KVBIG + (size_t)(layer * 2048 + b * 256) * 4096 + layer * 1024;
        __syncthreads();
        qf[c.tid] = bf2f(XQ[(size_t)m * 512 + c.tid]);
        __syncthreads();
        {
            const int j = c.tid & 255, hp = c.tid >> 8;
#pragma unroll
            for (int hh = 0; hh < 2; ++hh) { const int h = hp * 2 + hh; const u32x4* kp = (const u32x4*)(kvb + (size_t)j * 4096 + h * 128); float d = 0.f;
                for (int ch = 0; ch < 16; ++ch) { float k[8]; unpack8(kp[ch], k);
#pragma unroll
                    for (int e = 0; e < 8; ++e) d += k[e] * qf[h * 128 + ch * 8 + e]; }
                P[h * 256 + j] = d * scale; }
        }
        __syncthreads();
        if (c.wave < 4) { const int h = c.wave; float v[4]; float mx = -INFINITY;
#pragma unroll
            for (int i = 0; i < 4; ++i) { v[i] = P[h * 256 + c.lane + 64 * i]; mx = fmaxf(mx, v[i]); }
            mx = wave_max(mx); float s = 0.f;
#pragma unroll
            for (int i = 0; i < 4; ++i) { v[i] = __expf(v[i] - mx); s += v[i]; }
            s = wave_sum(s); const float inv = 1.f / s;
#pragma unroll
            for (int i = 0; i < 4; ++i) P[h * 256 + c.lane + 64 * i] = v[i] * inv; }
        __syncthreads();
        {   const int h = c.tid >> 7; float o = 0.f;
            for (int j = 0; j < 256; ++j) o += P[h * 256 + j] * bf2f(kvb[(size_t)j * 4096 + 512 + c.tid]);
            XO[(size_t)m * 512 + c.tid] = (bf16)f2bf(o); }
    }
}
typedef short bf16x8 __attribute__((ext_vector_type(8)));
typedef short bf16x4 __attribute__((ext_vector_type(4)));
__device__ __forceinline__ bf16x4 tr_read4(const unsigned char* p) { return __builtin_amdgcn_ds_read_tr16_b64_v4i16((LAS bf16x4*)p); }
__device__ __forceinline__ bf16x8 cat8(bf16x4 a, bf16x4 b) { return __builtin_shufflevector(a, b, 0, 1, 2, 3, 4, 5, 6, 7); }
__device__ __forceinline__ bf16x8 pack_p8(const f32x4 a, const f32x4 b) {
    u32x4 w; w.x = pg8::cvt_pk_bf16(a[0], a[1]); w.y = pg8::cvt_pk_bf16(a[2], a[3]); w.z = pg8::cvt_pk_bf16(b[0], b[1]); w.w = pg8::cvt_pk_bf16(b[2], b[3]);
    return __builtin_bit_cast(bf16x8, w);
}
__device__ __forceinline__ bf16x8 rope_frag(const bf16x8 xf, const bf16x8 pf, const float* cs, const float* sn, bool lo) {
    float x[8], p[8]; unpack8(__builtin_bit_cast(u32x4, xf), x); unpack8(__builtin_bit_cast(u32x4, pf), p);
    const float sg = lo ? -1.f : 1.f; float o[8];
#pragma unroll
    for (int j = 0; j < 8; ++j) o[j] = x[j] * cs[j] + sg * p[j] * sn[j];
    u32x4 w; w.x = pg8::cvt_pk_bf16(o[0], o[1]); w.y = pg8::cvt_pk_bf16(o[2], o[3]); w.z = pg8::cvt_pk_bf16(o[4], o[5]); w.w = pg8::cvt_pk_bf16(o[6], o[7]);
    return __builtin_bit_cast(bf16x8, w);
}
__device__ __forceinline__ bf16x8 xchg_frag(const bf16x8 v, int lane_xor) { u32x4 u = __builtin_bit_cast(u32x4, v); u32x4 r;
    r.x = (unsigned)__shfl_xor((int)u.x, lane_xor); r.y = (unsigned)__shfl_xor((int)u.y, lane_xor); r.z = (unsigned)__shfl_xor((int)u.z, lane_xor); r.w = (unsigned)__shfl_xor((int)u.w, lane_xor); return __builtin_bit_cast(bf16x8, r); }
constexpr int XA_PITCH = 272;
__device__ __forceinline__ void xattn_mfma(const Ctx& c, const bf16* __restrict__ XQ, const bf16* __restrict__ KVBIG, int layer, bf16* XO) {
    unsigned char* Kl = c.lds; unsigned char* Vl = c.lds + 256 * XA_PITCH;
    const int l = c.lane, n16 = l & 15, g = l >> 4;
    const float scale = 0.08838834764831845f * 1.4426950408889634f;
    for (int unit = c.bid; unit < 256; unit += c.nb) {
        const int b = unit >> 5, h = (unit >> 3) & 3, qc = unit & 7;
        const bf16* kvb = KVBIG + (size_t)(layer * 2048 + b * 256) * 4096 + layer * 1024 + h * 128;
        __syncthreads();
        for (int i = c.tid; i < 4096; i += NTHR) { const int row = i >> 4, ch = i & 15;
            *(u32x4*)(Kl + row * XA_PITCH + ch * 16) = *(const u32x4*)(kvb + (size_t)row * 4096 + ch * 8);
            *(u32x4*)(Vl + row * XA_PITCH + ch * 16) = *(const u32x4*)(kvb + (size_t)row * 4096 + 512 + ch * 8); }
        __syncthreads();
#pragma unroll 1
        for (int g4 = 0; g4 < 4; ++g4) {
            const size_t m = (size_t)b * SEQ + qc * 512 + c.wave * 64 + g4 * 16 + n16;
            bf16x8 Qb[4];
#pragma unroll
            for (int kk = 0; kk < 4; ++kk) Qb[kk] = *(const bf16x8*)(XQ + m * 512 + h * 128 + 32 * kk + 8 * g);
            f32x4 S[16];
#pragma unroll
            for (int j = 0; j < 16; ++j) { S[j] = (f32x4){0.f, 0.f, 0.f, 0.f};
#pragma unroll
                for (int kk = 0; kk < 4; ++kk) { const bf16x8 A = *(const bf16x8*)(Kl + (16 * j + n16) * XA_PITCH + (32 * kk + 8 * g) * 2);
                    S[j] = __builtin_amdgcn_mfma_f32_16x16x32_bf16(A, Qb[kk], S[j], 0, 0, 0); } }
            float mx = -INFINITY;
#pragma unroll
            for (int j = 0; j < 16; ++j) mx = fmaxf(mx, fmaxf(fmaxf(S[j][0], S[j][1]), fmaxf(S[j][2], S[j][3])));
            mx = fmaxf(mx, __shfl_xor(mx, 16)); mx = fmaxf(mx, __shfl_xor(mx, 32));
            float sum = 0.f; const float mo = mx * scale;
#pragma unroll
            for (int j = 0; j < 16; ++j) {
#pragma unroll
                for (int r = 0; r < 4; ++r) { const float p = __builtin_amdgcn_exp2f(S[j][r] * scale - mo); S[j][r] = p; sum += p; } }
            sum += __shfl_xor(sum, 16); sum += __shfl_xor(sum, 32);
            const float inv = 1.f / sum;
            bf16x8 Pb[8];
#pragma unroll
            for (int jj = 0; jj < 8; ++jj) Pb[jj] = pack_p8(S[2 * jj], S[2 * jj + 1]);
            const int q4 = n16 >> 2, p4 = l & 3;
#pragma unroll
            for (int dt = 0; dt < 8; ++dt) { f32x4 O = (f32x4){0.f, 0.f, 0.f, 0.f};
#pragma unroll
                for (int jj = 0; jj < 8; ++jj) { const unsigned char* vp = Vl + (32 * jj + 4 * g + q4) * XA_PITCH + (16 * dt) * 2 + 8 * p4;
                    const bf16x8 A = cat8(tr_read4(vp), tr_read4(vp + 16 * XA_PITCH));
                    O = __builtin_amdgcn_mfma_f32_16x16x32_bf16(A, Pb[jj], O, 0, 0, 0); }
                u32x2 w; w.x = pg8::cvt_pk_bf16(O[0] * inv, O[1] * inv); w.y = pg8::cvt_pk_bf16(O[2] * inv, O[3] * inv);
                *(u32x2*)(XO + m * 512 + h * 128 + 16 * dt + 4 * g) = w; }
        }
    }
}
__device__ __forceinline__ void diag_cmp_bf16(const Ctx& c, const bf16* A, int lda, const bf16* B, int ldb, int rows, int cols, float* acc) {
    float d2 = 0.f, a2 = 0.f;
    const size_t n = (size_t)rows * cols;
    for (size_t i = (size_t)c.bid * NTHR + c.tid; i < n; i += (size_t)c.nb * NTHR) { const size_t r = i / cols, cc = i % cols; const float a = bf2f(A[r * lda + cc]), b = bf2f(B[r * ldb + cc]); d2 += (a - b) * (a - b); a2 += a * a; }
    d2 = wave_sum(d2); a2 = wave_sum(a2);
    if (c.lane == 0) { atomicAdd(acc, d2); atomicAdd(acc + 1, a2); }
}
constexpr int DA_PITCH = 528, DA_WAVE_BYTES = 32 * DA_PITCH;
__device__ __forceinline__ void dsa_attn_mfma(const Ctx& c, const bf16* __restrict__ QALL, const bf16* __restrict__ KF, const bf16* __restrict__ SEL, const float* __restrict__ ROPEA, bf16* OLY, int m_first, int m_stride, int m_end) {
    unsigned char* Vw = c.lds + c.wave * DA_WAVE_BYTES;
    const int l = c.lane, n16 = l & 15, g = l >> 4, q4 = n16 >> 2, p4 = l & 3, hh = n16 & 7;
    const float scale = 0.08838834764831845f * 1.4426950408889634f;
#pragma unroll 1
    for (int m = m_first; m < m_end; m += m_stride) {
        const int b = m / SEQ, t = m % SEQ, limit = ((t >> 6) + 1) * 64, cnt = limit < 256 ? limit : 256, nblk = cnt >> 5;
        const bf16* qrow = QALL + (size_t)m * QC;
        bf16x8 Qb[9];
#pragma unroll
        for (int kk = 0; kk < 8; ++kk) Qb[kk] = *(const bf16x8*)(qrow + hh * 256 + 32 * kk + 8 * g);
        Qb[8] = *(const bf16x8*)(qrow + 2048 + hh * 32 + 8 * g);
        {
            const bf16x8 pf = xchg_frag(Qb[8], 32); float cs[8], sn[8];
            const f32x4 c0 = *(const f32x4*)(ROPEA + (size_t)m * 32 + 8 * (g & 1)), c1 = *(const f32x4*)(ROPEA + (size_t)m * 32 + 8 * (g & 1) + 4), s0 = *(const f32x4*)(ROPEA + (size_t)m * 32 + 16 + 8 * (g & 1)), s1 = *(const f32x4*)(ROPEA + (size_t)m * 32 + 16 + 8 * (g & 1) + 4);
            cs[0] = c0.x; cs[1] = c0.y; cs[2] = c0.z; cs[3] = c0.w; cs[4] = c1.x; cs[5] = c1.y; cs[6] = c1.z; cs[7] = c1.w; sn[0] = s0.x; sn[1] = s0.y; sn[2] = s0.z; sn[3] = s0.w; sn[4] = s1.x; sn[5] = s1.y; sn[6] = s1.z; sn[7] = s1.w;
            Qb[8] = rope_frag(Qb[8], pf, cs, sn, g < 2); }
        f32x4 O[16];
#pragma unroll
        for (int dt = 0; dt < 16; ++dt) O[dt] = (f32x4){0.f, 0.f, 0.f, 0.f};
        float mrun = -INFINITY, lrun = 0.f;
        const unsigned short* selp = (const unsigned short*)SEL + (size_t)m * 256;
        const bf16* kfb = KF + (size_t)b * SEQ * KFW;
        bf16x8 K0[9], K1[9];
#define DA_GATHER(BLK) do { const int s0_ = selp[32 * (BLK) + n16], s1_ = selp[32 * (BLK) + 16 + n16]; \
            const bf16* r0_ = kfb + (size_t)s0_ * KFW + 8 * g; const bf16* r1_ = kfb + (size_t)s1_ * KFW + 8 * g; \
            _Pragma("unroll") for (int kk = 0; kk < 9; ++kk) { K0[kk] = *(const bf16x8*)(r0_ + 32 * kk); K1[kk] = *(const bf16x8*)(r1_ + 32 * kk); } } while (0)
        DA_GATHER(0);
#pragma unroll 1
        for (int blk = 0; blk < nblk; ++blk) {
            f32x4 S0 = (f32x4){0.f, 0.f, 0.f, 0.f}, S1 = (f32x4){0.f, 0.f, 0.f, 0.f};
#pragma unroll
            for (int kk = 0; kk < 9; ++kk) { S0 = __builtin_amdgcn_mfma_f32_16x16x32_bf16(K0[kk], Qb[kk], S0, 0, 0, 0); S1 = __builtin_amdgcn_mfma_f32_16x16x32_bf16(K1[kk], Qb[kk], S1, 0, 0, 0); }
#pragma unroll
            for (int kk = 0; kk < 8; ++kk) { *(bf16x8*)(Vw + n16 * DA_PITCH + (32 * kk + 8 * g) * 2) = K0[kk]; *(bf16x8*)(Vw + (16 + n16) * DA_PITCH + (32 * kk + 8 * g) * 2) = K1[kk]; }
            __builtin_amdgcn_sched_barrier(0);
            if (blk + 1 < nblk) DA_GATHER(blk + 1);
            __builtin_amdgcn_sched_barrier(0);
            float bm = fmaxf(fmaxf(fmaxf(S0[0], S0[1]), fmaxf(S0[2], S0[3])), fmaxf(fmaxf(S1[0], S1[1]), fmaxf(S1[2], S1[3])));
            bm = fmaxf(bm, __shfl_xor(bm, 16)); bm = fmaxf(bm, __shfl_xor(bm, 32));
            const float mnew = fmaxf(mrun, bm), alpha = __builtin_amdgcn_exp2f((mrun - mnew) * scale), mo = mnew * scale; mrun = mnew;
            float ps = 0.f;
#pragma unroll
            for (int r = 0; r < 4; ++r) { S0[r] = __builtin_amdgcn_exp2f(S0[r] * scale - mo); S1[r] = __builtin_amdgcn_exp2f(S1[r] * scale - mo); ps += S0[r] + S1[r]; }
            lrun = lrun * alpha + ps;
            const bf16x8 Pb = pack_p8(S0, S1);
#pragma unroll
            for (int dt = 0; dt < 16; ++dt) { O[dt] = O[dt] * alpha;
                const unsigned char* vp = Vw + (4 * g + q4) * DA_PITCH + (16 * dt) * 2 + 8 * p4;
                const bf16x8 A = cat8(tr_read4(vp), tr_read4(vp + 16 * DA_PITCH));
                O[dt] = __builtin_amdgcn_mfma_f32_16x16x32_bf16(A, Pb, O[dt], 0, 0, 0); }
        }
#undef DA_GATHER
        lrun += __shfl_xor(lrun, 16); lrun += __shfl_xor(lrun, 32);
        const float inv = 1.f / lrun;
        if (n16 < 8) {
            bf16* orow = OLY + (size_t)m * OC + n16 * 256 + 4 * g;
#pragma unroll
            for (int dt = 0; dt < 16; ++dt) { u32x2 w; w.x = pg8::cvt_pk_bf16(O[dt][0] * inv, O[dt][1] * inv); w.y = pg8::cvt_pk_bf16(O[dt][2] * inv, O[dt][3] * inv); *(u32x2*)(orow + 16 * dt) = w; }
        }
    }
}
__device__ __forceinline__ void dsa_attn_queue(const Ctx& c, const bf16* __restrict__ QALL, const bf16* __restrict__ KF, const bf16* __restrict__ SEL, const float* __restrict__ ROPEA, bf16* OLY, unsigned* counter, volatile LAS unsigned* slot) {
    for (;;) {
        __syncthreads();
        if (c.tid == 0) *slot = __hip_atomic_fetch_add(counter, 1u, __ATOMIC_RELAXED, __HIP_MEMORY_SCOPE_AGENT);
        __syncthreads();
        const int chunk = (int)*slot;
        if (chunk >= M / 16) break;
        dsa_attn_mfma(c, QALL, KF, SEL, ROPEA, OLY, chunk * 16 + c.wave, 8, chunk * 16 + 16);
    }
}
__device__ __forceinline__ float relu1(float x) { const int b = __builtin_bit_cast(int, x); return __builtin_bit_cast(float, b > 0 ? b : 0); }
__device__ __forceinline__ void idx_topk_mfma(const Ctx& c, const bf16* __restrict__ QALL, const bf16* __restrict__ KIDX, const float* __restrict__ WIDX, const float* __restrict__ ROPEI, float* scr, bf16* SEL, int nitems) {
    const int l = c.lane, n16 = l & 15, g = l >> 4, qg = c.wave & 3, kh = c.wave >> 2;
#pragma unroll 1
    for (int item = c.bid; item < nitems; item += c.nb) {
        const int b = item >> 5, pr = item & 31;
#pragma unroll 1
        for (int which = 0; which < 2; ++which) {
            const int ch = which ? 63 - pr : pr, L = 64 * (ch + 1), t0 = 64 * ch;
            if (L > 256) {
            const size_t m = (size_t)b * SEQ + t0 + 16 * qg + n16;
            float* srow = scr + (size_t)(16 * qg + n16) * L + 4 * g;
            const int nt = L >> 5, j0 = kh * nt, j1 = j0 + nt;
            const bf16* kp = KIDX + ((size_t)b * SEQ + n16) * 64 + 8 * g;
            {
                bf16x8 Qi[16][2]; float w[16];
                { const bf16* qp = QALL + m * QC + 2304 + 8 * g;
#pragma unroll
                  for (int h = 0; h < 16; ++h) { Qi[h][0] = *(const bf16x8*)(qp + h * 64); Qi[h][1] = *(const bf16x8*)(qp + h * 64 + 32); }
                  {
                      float cs[8], sn[8]; const f32x4 c0 = *(const f32x4*)(ROPEI + m * 16), c1 = *(const f32x4*)(ROPEI + m * 16 + 4), s0 = *(const f32x4*)(ROPEI + m * 16 + 8), s1 = *(const f32x4*)(ROPEI + m * 16 + 12);
                      cs[0] = c0.x; cs[1] = c0.y; cs[2] = c0.z; cs[3] = c0.w; cs[4] = c1.x; cs[5] = c1.y; cs[6] = c1.z; cs[7] = c1.w; sn[0] = s0.x; sn[1] = s0.y; sn[2] = s0.z; sn[3] = s0.w; sn[4] = s1.x; sn[5] = s1.y; sn[6] = s1.z; sn[7] = s1.w;
#pragma unroll
                      for (int h = 0; h < 16; ++h) { const bf16x8 pf = xchg_frag(Qi[h][0], 16); const bf16x8 rf = rope_frag(Qi[h][0], pf, cs, sn, g == 0); if (g < 2) Qi[h][0] = rf; } }
                  const f32x4* wp = (const f32x4*)(WIDX + m * 16);
#pragma unroll
                  for (int q = 0; q < 4; ++q) { const f32x4 v = wp[q]; w[4 * q] = v.x; w[4 * q + 1] = v.y; w[4 * q + 2] = v.z; w[4 * q + 3] = v.w; } }
                bf16x8 Ka = *(const bf16x8*)(kp + (size_t)j0 * 1024), Kb = *(const bf16x8*)(kp + (size_t)j0 * 1024 + 32);
#pragma unroll 1
                for (int j = j0; j < j1; ++j) {
                    const int jn = (j + 1 < j1) ? j + 1 : j;
                    const bf16x8 Na = *(const bf16x8*)(kp + (size_t)jn * 1024), Nb = *(const bf16x8*)(kp + (size_t)jn * 1024 + 32);
                    f32x2 s01 = (f32x2){0.f, 0.f}, s23 = (f32x2){0.f, 0.f};
                    f32x4 a = __builtin_amdgcn_mfma_f32_16x16x32_bf16(Ka, Qi[0][0], (f32x4){0.f, 0.f, 0.f, 0.f}, 0, 0, 0); a = __builtin_amdgcn_mfma_f32_16x16x32_bf16(Kb, Qi[0][1], a, 0, 0, 0);
#pragma unroll
                    for (int h = 0; h < 16; ++h) { f32x4 an = a;
                        if (h < 15) { an = __builtin_amdgcn_mfma_f32_16x16x32_bf16(Ka, Qi[h + 1][0], (f32x4){0.f, 0.f, 0.f, 0.f}, 0, 0, 0); an = __builtin_amdgcn_mfma_f32_16x16x32_bf16(Kb, Qi[h + 1][1], an, 0, 0, 0); }
                        const f32x2 wv = (f32x2){w[h], w[h]};
                        s01 = (f32x2){relu1(a[0]), relu1(a[1])} * wv + s01; s23 = (f32x2){relu1(a[2]), relu1(a[3])} * wv + s23; a = an; }
                    *(f32x4*)(srow + 16 * j) = (f32x4){s01.x, s01.y, s23.x, s23.y};
                    Ka = Na; Kb = Nb;
                }
            }
            }
            asm volatile("s_waitcnt vmcnt(0)" ::: "memory");
            __syncthreads();
            __builtin_amdgcn_fence(__ATOMIC_ACQUIRE, "agent");
            asm volatile("s_waitcnt vmcnt(0)" ::: "memory");
#pragma unroll 1
            for (int i = 0; i < 8; ++i) {
                const int ql = c.wave * 8 + i;
                unsigned short* sel = (unsigned short*)SEL + ((size_t)b * SEQ + t0 + ql) * 256;
                if (L <= 256) { for (int k = l; k < 256; k += 64) sel[k] = (unsigned short)(k < L ? k : 0); }
                else select_row_bs(scr + (size_t)ql * L, L, sel, l, (unsigned short*)(c.lds + c.wave * 512));
            }
            __syncthreads();
        }
    }
}
__device__ __forceinline__ void diag_cmp_sel(const Ctx& c, const bf16* SA, const bf16* SB, int nbatch, float* acc) {
    unsigned* bm = (unsigned*)(c.lds + c.wave * 512);
    float miss = 0.f, tot = 0.f;
    for (int m = c.gw; m < nbatch * SEQ; m += c.ngw) {
        const int t = m % SEQ; if (t < 256) continue;
        bm[c.lane] = 0u; bm[64 + c.lane] = 0u;
        __builtin_amdgcn_fence(__ATOMIC_RELEASE, "wavefront"); __builtin_amdgcn_wave_barrier();
        for (int i = c.lane; i < 256; i += 64) { const unsigned s = ((const unsigned short*)SA)[(size_t)m * 256 + i]; atomicOr(&bm[s >> 5], 1u << (s & 31)); }
        __builtin_amdgcn_fence(__ATOMIC_RELEASE, "wavefront"); __builtin_amdgcn_wave_barrier(); __builtin_amdgcn_fence(__ATOMIC_ACQUIRE, "wavefront");
        for (int i = c.lane; i < 256; i += 64) { const unsigned s = ((const unsigned short*)SB)[(size_t)m * 256 + i]; miss += ((bm[s >> 5] >> (s & 31)) & 1u) ? 0.f : 1.f; tot += 1.f; }
        __builtin_amdgcn_fence(__ATOMIC_RELEASE, "wavefront"); __builtin_amdgcn_wave_barrier();
    }
    miss = wave_sum(miss); tot = wave_sum(tot);
    if (c.lane == 0) { atomicAdd(acc, miss); atomicAdd(acc + 1, tot); }
}
__device__ __forceinline__ void idx_topk_lds(const Ctx& c, const bf16* __restrict__ QALL, const bf16* __restrict__ KIDX, const float* __restrict__ WIDX, const float* __restrict__ ROPEI, u32x4* qscr, bf16* SEL, int nitems) {
    float* SCL = (float*)c.lds;
    f32x4* WL = (f32x4*)(c.lds + 131072);
    const int w8 = c.wave;
#pragma unroll 1
    for (int item = c.bid; item < nitems; item += c.nb) {
        const int b = item >> 5, pr = item & 31;
#pragma unroll 1
        for (int which = 0; which < 2; ++which) {
            int l = c.lane; asm volatile("" : "+v"(l));
            const int n16 = l & 15, g = l >> 4;
            const int ch = which ? 63 - pr : pr, L = 64 * (ch + 1), t0 = 64 * ch;
            if (L <= 256) {
#pragma unroll 1
                for (int i = 0; i < 8; ++i) { unsigned short* sel = (unsigned short*)SEL + ((size_t)b * SEQ + t0 + w8 * 8 + i) * 256; for (int k = l; k < 256; k += 64) sel[k] = (unsigned short)(k < L ? k : 0); }
                continue;
            }
            __syncthreads();
            if (w8 < 4) {
                const size_t m = (size_t)b * SEQ + t0 + 16 * w8 + n16;
                const bf16* qp = QALL + m * QC + 2304 + 8 * g;
                float cs[8], sn[8]; const f32x4 c0 = *(const f32x4*)(ROPEI + m * 16), c1 = *(const f32x4*)(ROPEI + m * 16 + 4), s0 = *(const f32x4*)(ROPEI + m * 16 + 8), s1 = *(const f32x4*)(ROPEI + m * 16 + 12);
                cs[0] = c0.x; cs[1] = c0.y; cs[2] = c0.z; cs[3] = c0.w; cs[4] = c1.x; cs[5] = c1.y; cs[6] = c1.z; cs[7] = c1.w; sn[0] = s0.x; sn[1] = s0.y; sn[2] = s0.z; sn[3] = s0.w; sn[4] = s1.x; sn[5] = s1.y; sn[6] = s1.z; sn[7] = s1.w;
#pragma unroll 4
                for (int h = 0; h < 16; ++h) { bf16x8 f0 = *(const bf16x8*)(qp + h * 64); const bf16x8 f1 = *(const bf16x8*)(qp + h * 64 + 32);
                    const bf16x8 pf = xchg_frag(f0, 16); const bf16x8 rf = rope_frag(f0, pf, cs, sn, g == 0); if (g < 2) f0 = rf;
                    qscr[(w8 * 64 + l) * 32 + h * 2] = __builtin_bit_cast(u32x4, f0); qscr[(w8 * 64 + l) * 32 + h * 2 + 1] = __builtin_bit_cast(u32x4, f1); }
            }
            asm volatile("s_waitcnt vmcnt(0)" ::: "memory");
            __syncthreads();
            __builtin_amdgcn_fence(__ATOMIC_ACQUIRE, "agent"); asm volatile("s_waitcnt vmcnt(0)" ::: "memory");
            const bf16* kp = KIDX + ((size_t)b * SEQ + n16) * 64 + 8 * g;
            const int ntile = L >> 4;
#pragma unroll 1
            for (int qsub = 0; qsub < 8; ++qsub) {
                asm volatile("" ::: "memory");
                bf16x8 Qi[16][2];
                { const int srcl = g * 16 + (qsub & 1) * 8 + (n16 & 7); const u32x4* fp = qscr + (size_t)((qsub >> 1) * 64 + srcl) * 32;
#pragma unroll
                  for (int h = 0; h < 16; ++h) { Qi[h][0] = __builtin_bit_cast(bf16x8, fp[h * 2]); Qi[h][1] = __builtin_bit_cast(bf16x8, fp[h * 2 + 1]); }
                  if (w8 == 0 && l < 32) WL[l] = *(const f32x4*)(WIDX + ((size_t)b * SEQ + t0 + 8 * qsub + (l >> 2)) * 16 + 4 * (l & 3)); }
                __syncthreads();
                const f32x4* wq = WL + (n16 & 7) * 4;
                float* srow = SCL + (n16 & 7) * 4096 + 4 * g;
                int j = w8;
                bf16x8 Ka = *(const bf16x8*)(kp + (size_t)j * 1024), Kb = *(const bf16x8*)(kp + (size_t)j * 1024 + 32);
#pragma unroll 1
                for (; j < ntile; j += 8) {
                    const int jn = (j + 8 < ntile) ? j + 8 : j;
                    const bf16x8 Na = *(const bf16x8*)(kp + (size_t)jn * 1024), Nb = *(const bf16x8*)(kp + (size_t)jn * 1024 + 32);
                    f32x2 s01 = (f32x2){0.f, 0.f}, s23 = (f32x2){0.f, 0.f};
                    f32x4 a = __builtin_amdgcn_mfma_f32_16x16x32_bf16(Ka, Qi[0][0], (f32x4){0.f, 0.f, 0.f, 0.f}, 0, 0, 0); a = __builtin_amdgcn_mfma_f32_16x16x32_bf16(Kb, Qi[0][1], a, 0, 0, 0);
#pragma unroll
                    for (int h4 = 0; h4 < 4; ++h4) { const f32x4 w4 = wq[h4];
#pragma unroll
                        for (int hh = 0; hh < 4; ++hh) { const int h = 4 * h4 + hh; f32x4 an = a;
                            if (h < 15) { an = __builtin_amdgcn_mfma_f32_16x16x32_bf16(Ka, Qi[h + 1][0], (f32x4){0.f, 0.f, 0.f, 0.f}, 0, 0, 0); an = __builtin_amdgcn_mfma_f32_16x16x32_bf16(Kb, Qi[h + 1][1], an, 0, 0, 0); }
                            const f32x2 wv = (f32x2){w4[hh], w4[hh]};
                            s01 = (f32x2){relu1(a[0]), relu1(a[1])} * wv + s01; s23 = (f32x2){relu1(a[2]), relu1(a[3])} * wv + s23; a = an; } }
                    if (n16 < 8) *(f32x4*)(srow + 16 * j) = (f32x4){s01.x, s01.y, s23.x, s23.y};
                    Ka = Na; Kb = Nb;
                }
                __syncthreads();
                select_row(SCL + w8 * 4096, L, (unsigned short*)SEL + ((size_t)b * SEQ + t0 + 8 * qsub + w8) * 256, l);
                __syncthreads();
            }
        }
    }
}
#if DIAG == 7
__device__ __forceinline__ void select_row_v1(const float* row, int limit, unsigned short* sel, int l_in) {
    int l = l_in; asm volatile("" : "+v"(l));
    const int ng = limit >> 9;
    unsigned key[64];
#pragma unroll
    for (int j = 0; j < 64; ++j) { const int s = j * 64 + l; unsigned u = 0u; if (s < limit) { u = __float_as_uint(row[s]); u = (u & 0x80000000u) ? ~u : (u | 0x80000000u); } key[j] = u; }
    unsigned mx = 0u;
#pragma unroll
    for (int j = 0; j < 64; ++j) mx = key[j] > mx ? key[j] : mx;
#pragma unroll
    for (int o = 1; o < 64; o <<= 1) { const unsigned t = (unsigned)__shfl_xor((int)mx, o); mx = t > mx ? t : mx; }
    mx = (unsigned)__builtin_amdgcn_readfirstlane((int)mx);
    unsigned T = 0u;
#pragma unroll 1
    for (int bit = 31 - __builtin_clz(mx | 1u); bit >= 0; --bit) {
        const unsigned Tn = T | (1u << bit); int cnt = 0;
#pragma unroll
        for (int jg = 0; jg < 8; ++jg) if (jg <= ng) {
#pragma unroll
            for (int j = 8 * jg; j < 8 * jg + 8; ++j) cnt += __popcll(__ballot(key[j] >= Tn)); }
        if (cnt >= 256) T = Tn;
        if (cnt == 256) break;
    }
    int cgt = 0;
#pragma unroll
    for (int j = 0; j < 64; ++j) cgt += __popcll(__ballot(key[j] > T));
    const int need_eq = 256 - cgt;
    int base = 0, beq = 0;
    const unsigned long long lt = (1ull << l) - 1ull;
#pragma unroll
    for (int jg = 0; jg < 8; ++jg) if (jg <= ng) {
#pragma unroll
        for (int j = 8 * jg; j < 8 * jg + 8; ++j) {
            const unsigned long long mg = __ballot(key[j] > T), me = __ballot(key[j] == T);
            if (key[j] > T) sel[base + __popcll(mg & lt)] = (unsigned short)(j * 64 + l);
            base += __popcll(mg);
            const int pe = beq + __popcll(me & lt);
            if (key[j] == T && pe < need_eq) sel[cgt + pe] = (unsigned short)(j * 64 + l);
            beq += __popcll(me);
        }
    }
}
__device__ __forceinline__ void idx_topk_v1(const Ctx& c, const bf16* __restrict__ QALL, const bf16* __restrict__ KIDX, const float* __restrict__ WIDX, float* scr, bf16* SEL, int nitems) {
    const int l = c.lane, n16 = l & 15, g = l >> 4, qg = c.wave & 3, kh = c.wave >> 2;
#pragma unroll 1
    for (int item = c.bid; item < nitems; item += c.nb) {
        const int b = item >> 5, pr = item & 31;
#pragma unroll 1
        for (int which = 0; which < 2; ++which) {
            const int ch = which ? 63 - pr : pr, L = 64 * (ch + 1), t0 = 64 * ch;
            if (L > 256) {
            const size_t m = (size_t)b * SEQ + t0 + 16 * qg + n16;
            float* srow = scr + (size_t)(16 * qg + n16) * L + 4 * g;
            const int nt = L >> 5, j0 = kh * nt, j1 = j0 + nt;
            const bf16* kp = KIDX + ((size_t)b * SEQ + n16) * 64 + 8 * g;
#pragma unroll 1
            for (int hp = 0; hp < 2; ++hp) {
                bf16x8 Qi[8][2]; float w[8];
                { const bf16* qp = QALL + m * QC + 2304 + hp * 512 + 8 * g;
#pragma unroll
                  for (int h = 0; h < 8; ++h) { Qi[h][0] = *(const bf16x8*)(qp + h * 64); Qi[h][1] = *(const bf16x8*)(qp + h * 64 + 32); }
                  const f32x4* wp = (const f32x4*)(WIDX + m * 16 + hp * 8);
#pragma unroll
                  for (int q = 0; q < 2; ++q) { const f32x4 v = wp[q]; w[4 * q] = v.x; w[4 * q + 1] = v.y; w[4 * q + 2] = v.z; w[4 * q + 3] = v.w; } }
                if (hp) { asm volatile("s_waitcnt vmcnt(0)" ::: "memory"); __builtin_amdgcn_fence(__ATOMIC_ACQUIRE, "agent"); asm volatile("s_waitcnt vmcnt(0)" ::: "memory"); }
                bf16x8 Ka = *(const bf16x8*)(kp + (size_t)j0 * 1024), Kb = *(const bf16x8*)(kp + (size_t)j0 * 1024 + 32);
                f32x4 pv = (f32x4){0.f, 0.f, 0.f, 0.f}; if (hp) pv = *(const f32x4*)(srow + 16 * j0);
#pragma unroll 1
                for (int j = j0; j < j1; ++j) {
                    const int jn = (j + 1 < j1) ? j + 1 : j;
                    const bf16x8 Na = *(const bf16x8*)(kp + (size_t)jn * 1024), Nb = *(const bf16x8*)(kp + (size_t)jn * 1024 + 32);
                    f32x4 pn = (f32x4){0.f, 0.f, 0.f, 0.f}; if (hp) pn = *(const f32x4*)(srow + 16 * jn);
                    f32x4 sc = pv;
#pragma unroll
                    for (int h = 0; h < 8; ++h) { f32x4 a = __builtin_amdgcn_mfma_f32_16x16x32_bf16(Ka, Qi[h][0], (f32x4){0.f, 0.f, 0.f, 0.f}, 0, 0, 0); a = __builtin_amdgcn_mfma_f32_16x16x32_bf16(Kb, Qi[h][1], a, 0, 0, 0);
                        sc[0] += w[h] * fmaxf(a[0], 0.f); sc[1] += w[h] * fmaxf(a[1], 0.f); sc[2] += w[h] * fmaxf(a[2], 0.f); sc[3] += w[h] * fmaxf(a[3], 0.f); }
                    *(f32x4*)(srow + 16 * j) = sc;
                    Ka = Na; Kb = Nb; pv = pn;
                }
            }
            }
            asm volatile("s_waitcnt vmcnt(0)" ::: "memory");
            __syncthreads();
            __builtin_amdgcn_fence(__ATOMIC_ACQUIRE, "agent");
            asm volatile("s_waitcnt vmcnt(0)" ::: "memory");
#pragma unroll 1
            for (int i = 0; i < 8; ++i) {
                const int ql = c.wave * 8 + i;
                unsigned short* sel = (unsigned short*)SEL + ((size_t)b * SEQ + t0 + ql) * 256;
                if (L <= 256) { for (int k = l; k < 256; k += 64) sel[k] = (unsigned short)(k < L ? k : 0); }
                else select_row_v1(scr + (size_t)ql * L, L, sel, l);
            }
            __syncthreads();
        }
    }
}
#endif
constexpr int RW_TB = 32;
struct RwkvP { const float *mu, *w0, *w2, *a0, *a2, *g2, *k_k, *k_a, *r_k, *ln_w, *ln_b; };
__device__ __forceinline__ void rwkv_phase(const Ctx& c, const bf16* __restrict__ H, const RwkvP P, bf16* OLY) {
    float* A_WR = (float*)c.lds;
    float* A_K2 = A_WR + RW_TB * 64;
    float* A_V = A_K2 + RW_TB * 64;
    float* A_W = A_V + RW_TB * 64;
    float* A_NKK = A_W + RW_TB * 64;
    float* A_B = A_NKK + RW_TB * 64;
    float* A_G = A_B + RW_TB * 64;
    float* A_OUT = A_G + RW_TB * 64;
    float* L_TW = A_OUT + RW_TB * 64;
    float* L_AL = L_TW + RW_TB * 64;
    float* L_SG = L_AL + RW_TB * 64;
    float* SC1 = L_SG + RW_TB * 160; float* SC2 = SC1 + RW_TB; float* SC3 = SC2 + RW_TB;
    const int l = c.lane, w = c.wave;
    for (int item = c.bid; item < NB * 16; item += c.nb) {
        const int b = item >> 4, h = item & 15, hk = h * 64 + l;
        const float w0v = P.w0[hk], a0v = P.a0[hk], kkv = P.k_k[hk], kav = P.k_a[hk], rkv = P.r_k[hk], lnw = P.ln_w[hk], lnb = P.ln_b[hk];
        float S[8];
#pragma unroll
        for (int i = 0; i < 8; ++i) S[i] = 0.f;
        const int srow = w * 8 + (l >> 3), sj = l & 7;
        for (int t0 = 0; t0 < SEQ; t0 += RW_TB) {
            __syncthreads();
            for (int idx = c.tid; idx < RW_TB * 480; idx += NTHR) {
                const int t = idx / 480, cc = idx % 480; int col; float* dst;
                if (cc < 64) { col = 880 + h * 64 + cc; dst = A_WR + t * 64 + cc; }
                else if (cc < 128) { col = 1904 + h * 64 + (cc - 64); dst = A_K2 + t * 64 + (cc - 64); }
                else if (cc < 192) { col = 2928 + h * 64 + (cc - 128); dst = A_V + t * 64 + (cc - 128); }
                else if (cc < 256) { col = 3952 + (cc - 192); dst = L_TW + t * 64 + (cc - 192); }
                else if (cc < 320) { col = 4016 + (cc - 256); dst = L_AL + t * 64 + (cc - 256); }
                else { col = 4080 + (cc - 320); dst = L_SG + t * 160 + (cc - 320); }
                const size_t m = (size_t)b * SEQ + t0 + t;
                const float x = bf2f(H[m * HC + col]); const float xp = (t0 + t > 0) ? bf2f(H[(m - 1) * HC + col]) : 0.f;
                float hm = x + (xp - x) * P.mu[col - 880];
                if (cc >= 192 && cc < 256) hm = tanhf(hm); else if (cc >= 320) hm = sigmoidf_(hm);
                *dst = hm;
            }
            __syncthreads();
            {
                float wl[RW_TB / 8], al[RW_TB / 8], gg[RW_TB / 8];
#pragma unroll
                for (int i = 0; i < RW_TB / 8; ++i) { wl[i] = 0.f; al[i] = 0.f; gg[i] = 0.f; }
                for (int j = 0; j < 64; ++j) { const float w2v = P.w2[(size_t)j * 1024 + hk], a2v = P.a2[(size_t)j * 1024 + hk];
#pragma unroll
                    for (int i = 0; i < RW_TB / 8; ++i) { wl[i] += L_TW[(w + 8 * i) * 64 + j] * w2v; al[i] += L_AL[(w + 8 * i) * 64 + j] * a2v; } }
                for (int j = 0; j < 160; ++j) { const float g2v = P.g2[(size_t)j * 1024 + hk];
#pragma unroll
                    for (int i = 0; i < RW_TB / 8; ++i) gg[i] += L_SG[(w + 8 * i) * 160 + j] * g2v; }
#pragma unroll
                for (int i = 0; i < RW_TB / 8; ++i) {
                    const int t = w + 8 * i, o = t * 64 + l;
                    const float dec = __expf(-0.6065306597126334f * sigmoidf_(w0v + wl[i]));
                    const float a = sigmoidf_(a0v + al[i]);
                    const float kr = A_K2[o], r = A_WR[o];
                    float kk = kr * kkv; const float nrm = wave_sum(kk * kk); kk = kk * (1.0f / sqrtf(fmaxf(nrm, 1e-24f)));
                    const float k2 = kr * (1.f + (a - 1.f) * kav), bb = kk * a;
                    const float s1 = wave_sum(bb * r), s2 = wave_sum(k2 * r), s3 = wave_sum(r * k2 * rkv);
                    A_W[o] = dec; A_NKK[o] = -kk; A_B[o] = bb; A_K2[o] = k2; A_WR[o] = dec * r; A_G[o] = gg[i];
                    if (l == 0) { SC1[t] = s1; SC2[t] = s2; SC3[t] = s3; }
                }
            }
            __syncthreads();
            for (int t = 0; t < RW_TB; ++t) {
                const f32x4* pw = (const f32x4*)(A_W + t * 64 + 8 * sj); const f32x4* pn = (const f32x4*)(A_NKK + t * 64 + 8 * sj); const f32x4* pb = (const f32x4*)(A_B + t * 64 + 8 * sj);
                const f32x4* pk = (const f32x4*)(A_K2 + t * 64 + 8 * sj); const f32x4* pr = (const f32x4*)(A_WR + t * 64 + 8 * sj);
                const f32x4 w0_ = pw[0], w1_ = pw[1], n0 = pn[0], n1 = pn[1], b0 = pb[0], b1 = pb[1], k0 = pk[0], k1 = pk[1], r0 = pr[0], r1 = pr[1];
                const float vv = A_V[t * 64 + srow], s1 = SC1[t], s2 = SC2[t];
                float sa = (S[0] * n0.x + S[1] * n0.y) + (S[2] * n0.z + S[3] * n0.w) + (S[4] * n1.x + S[5] * n1.y) + (S[6] * n1.z + S[7] * n1.w);
                float p = (S[0] * r0.x + S[1] * r0.y) + (S[2] * r0.z + S[3] * r0.w) + (S[4] * r1.x + S[5] * r1.y) + (S[6] * r1.z + S[7] * r1.w);
                sa += __shfl_xor(sa, 1); p += __shfl_xor(p, 1); sa += __shfl_xor(sa, 2); p += __shfl_xor(p, 2); sa += __shfl_xor(sa, 4); p += __shfl_xor(p, 4);
                S[0] = S[0] * w0_.x + (sa * b0.x + vv * k0.x); S[1] = S[1] * w0_.y + (sa * b0.y + vv * k0.y); S[2] = S[2] * w0_.z + (sa * b0.z + vv * k0.z); S[3] = S[3] * w0_.w + (sa * b0.w + vv * k0.w);
                S[4] = S[4] * w1_.x + (sa * b1.x + vv * k1.x); S[5] = S[5] * w1_.y + (sa * b1.y + vv * k1.y); S[6] = S[6] * w1_.z + (sa * b1.z + vv * k1.z); S[7] = S[7] * w1_.w + (sa * b1.w + vv * k1.w);
                if (sj == 0) A_OUT[t * 64 + srow] = p + sa * s1 + vv * s2;
            }
            __syncthreads();
#pragma unroll
            for (int i = 0; i < RW_TB / 8; ++i) {
                const int t = w + 8 * i, o = t * 64 + l;
                const float x = A_OUT[o]; const float mean = wave_sum(x) * (1.f / 64.f); const float dx = x - mean; const float var = wave_sum(dx * dx) * (1.f / 64.f);
                float y = dx * (1.0f / sqrtf(var + 64e-5f)) * lnw + lnb;
                y = (y + SC3[t] * A_V[o]) * A_G[o];
                OLY[((size_t)b * SEQ + t0 + t) * OC + 2048 + hk] = (bf16)f2bf(y);
            }
        }
    }
}

constexpr int S5_TB = 16;
struct S5P { const float *lam_re, *lam_im, *log_dt, *b_re, *b_im, *c_re, *c_im, *d; };
__device__ __forceinline__ float gelu_tanh(float y) { return 0.5f * y * (1.f + tanhf(0.7978845608028654f * (y + 0.044715f * y * y * y))); }
__device__ __forceinline__ void s5_phase(const Ctx& c, const bf16* __restrict__ U, const S5P P, bf16* Z) {
    constexpr int PERW = 256 + 2 * S5_TB * 65 + 2 * 64 * 16;
    float* UU = (float*)c.lds + c.wave * PERW;
    float* XSr = UU + 256; float* XSi = XSr + S5_TB * 65;
    float* CTr = XSi + S5_TB * 65; float* CTi = CTr + 64 * 16;
    const int l = c.lane;
    for (int item = c.bid; item < NB * 16; item += c.nb) {
        const int b = item >> 4, g = (item & 15) * 8 + c.wave;
        __syncthreads();
        float lbr, lbi, Br[16], Bi[16];
        {
            const float lr = fminf(P.lam_re[g * 64 + l], -1e-4f), li = P.lam_im[g * 64 + l], dt = expf(P.log_dt[g]);
            const float e = expf(lr * dt); lbr = e * cosf(li * dt); lbi = e * sinf(li * dt);
            const float nr = lbr - 1.f, ni = lbi, den = 1.f / (lr * lr + li * li);
            const float cr = (nr * lr + ni * li) * den, ci = (ni * lr - nr * li) * den;
#pragma unroll
            for (int i = 0; i < 16; ++i) { const float br = P.b_re[(size_t)(g * 64 + l) * 16 + i], bi = P.b_im[(size_t)(g * 64 + l) * 16 + i]; Br[i] = cr * br - ci * bi; Bi[i] = cr * bi + ci * br; }
#pragma unroll
            for (int o = 0; o < 16; ++o) { CTr[l * 16 + o] = P.c_re[(size_t)(g * 16 + o) * 64 + l]; CTi[l * 16 + o] = P.c_im[(size_t)(g * 16 + o) * 64 + l]; }
        }
        float dsk[4];
#pragma unroll
        for (int e = 0; e < 4; ++e) dsk[e] = P.d[g * 16 + (l >> 4) * 4 + e];
        float xr = 0.f, xi = 0.f;
        for (int t0 = 0; t0 < SEQ; t0 += S5_TB) {
            __syncthreads();
            { const int row = l >> 2, q = l & 3; const u32x2 w2 = *(const u32x2*)(U + ((size_t)b * SEQ + t0 + row) * D + g * 16 + 4 * q);
              float* d = UU + row * 16 + 4 * q; d[0] = bf2f(w2.x & 0xffffu); d[1] = bf2f(w2.x >> 16); d[2] = bf2f(w2.y & 0xffffu); d[3] = bf2f(w2.y >> 16); }
            __syncthreads();
            for (int t = 0; t < S5_TB; ++t) {
                const f32x4* up = (const f32x4*)(UU + t * 16); const f32x4 u0 = up[0], u1 = up[1], u2 = up[2], u3 = up[3];
                const float u[16] = {u0.x, u0.y, u0.z, u0.w, u1.x, u1.y, u1.z, u1.w, u2.x, u2.y, u2.z, u2.w, u3.x, u3.y, u3.z, u3.w};
                float bur = 0.f, bui = 0.f;
#pragma unroll
                for (int i = 0; i < 16; ++i) { bur += Br[i] * u[i]; bui += Bi[i] * u[i]; }
                const float nxr = lbr * xr - lbi * xi + bur, nxi = lbr * xi + lbi * xr + bui; xr = nxr; xi = nxi;
                XSr[t * 65 + l] = xr; XSi[t * 65 + l] = xi;
            }
            __syncthreads();
            {   const int t = l & 15, oq = l >> 4; float y[4] = {0.f, 0.f, 0.f, 0.f};
                for (int p = 0; p < 64; ++p) { const float a = XSr[t * 65 + p], bb = XSi[t * 65 + p]; const f32x4 cr = *(const f32x4*)(CTr + p * 16 + oq * 4), ci = *(const f32x4*)(CTi + p * 16 + oq * 4);
                    y[0] += a * cr.x - bb * ci.x; y[1] += a * cr.y - bb * ci.y; y[2] += a * cr.z - bb * ci.z; y[3] += a * cr.w - bb * ci.w; }
                float z[4];
#pragma unroll
                for (int e = 0; e < 4; ++e) z[e] = gelu_tanh(y[e] + dsk[e] * UU[t * 16 + oq * 4 + e]);
                u32x2 o; o.x = pk2(z[0], z[1]); o.y = pk2(z[2], z[3]);
                *(u32x2*)(Z + ((size_t)b * SEQ + t0 + t) * D + g * 16 + oq * 4) = o; }
        }
    }
}
template <int CTRL> __device__ __forceinline__ float dpp_mov(float v) { return __builtin_bit_cast(float, __builtin_amdgcn_update_dpp(0, __builtin_bit_cast(int, v), CTRL, 0xf, 0xf, true)); }
__device__ __forceinline__ float sum8(float v) { v += dpp_mov<0xB1>(v); v += dpp_mov<0x4E>(v); v += dpp_mov<0x141>(v); return v; }
__device__ __forceinline__ float wave_sum_fast(float v) { v += dpp_mov<0xB1>(v); v += dpp_mov<0x4E>(v); v += dpp_mov<0x141>(v); v += dpp_mov<0x140>(v); v += __shfl_xor(v, 16); v += __shfl_xor(v, 32); return v; }
__device__ __forceinline__ float fast_tanh(float x) { const float e = __expf(2.f * x); return 1.f - 2.f / (e + 1.f); }
__device__ __forceinline__ void rwkv_lora_prep(const Ctx& c, const bf16* __restrict__ H, const float* __restrict__ mu, bf16* LX) {
    const int l = c.lane;
    for (int m = c.gw; m < M; m += c.ngw) {
        if (l < 36) {
            const int col = 3952 + 8 * l; const int t = m % SEQ;
            float x[8], p[8]; unpack8(*(const u32x4*)(H + (size_t)m * HC + col), x);
            if (t > 0) unpack8(*(const u32x4*)(H + (size_t)(m - 1) * HC + col), p); else {
#pragma unroll
                for (int j = 0; j < 8; ++j) p[j] = 0.f; }
            const f32x4 m0 = *(const f32x4*)(mu + 3072 + 8 * l), m1 = *(const f32x4*)(mu + 3072 + 8 * l + 4);
            const float mv[8] = {m0.x, m0.y, m0.z, m0.w, m1.x, m1.y, m1.z, m1.w};
            float hm[8];
#pragma unroll
            for (int j = 0; j < 8; ++j) { float v = x[j] + (p[j] - x[j]) * mv[j]; if (l < 8) v = fast_tanh(v); else if (l >= 16) v = sigmoidf_(v); hm[j] = v; }
            u32x4 o; o.x = pg8::cvt_pk_bf16(hm[0], hm[1]); o.y = pg8::cvt_pk_bf16(hm[2], hm[3]); o.z = pg8::cvt_pk_bf16(hm[4], hm[5]); o.w = pg8::cvt_pk_bf16(hm[6], hm[7]);
            *(u32x4*)(LX + (size_t)m * 288 + 8 * l) = o;
        }
    }
}
constexpr int RW2_RAWP = 384;
constexpr int RW2_TWP = 144, RW2_SGP = 336;
__device__ __forceinline__ void rwkv_phase2(const Ctx& c, const bf16* __restrict__ H, const bf16* __restrict__ LX, const RwkvP P, bf16* OUT, int ldo, int coloff, int wb = NB) {
    unsigned char* RAW = c.lds;
    float* A_WR = (float*)(c.lds + 12800);
    float* A_K2 = A_WR + 2048; float* A_V = A_K2 + 2048; float* A_W = A_V + 2048; float* A_NKK = A_W + 2048; float* A_B = A_NKK + 2048; float* A_G = A_B + 2048; float* A_OUT = A_G + 2048;
    float* LO_W = A_OUT + 2048; float* LO_A = LO_W + 2048; float* PR3 = LO_A + 2048;
    unsigned char* L_TW = (unsigned char*)(PR3 + 2048); unsigned char* L_AL = L_TW + 32 * RW2_TWP; unsigned char* L_SG = L_AL + 32 * RW2_TWP;
    float* MU = (float*)(L_SG + 32 * RW2_SGP); float* SC3 = MU + 480 + 64;
    unsigned char* G2T = (unsigned char*)(SC3 + 32);
    float* SCP = (float*)(G2T + 64 * RW2_SGP);
    float* GN = SCP + 128; float* CST = GN + 64;
    float* PR0 = (float*)L_TW; float* PR1 = PR0 + 2048; float* PR2 = A_OUT;
    const int l = c.lane, w = c.wave, n16 = l & 15, g = l >> 4;
#pragma unroll 1
    for (int item = c.bid; item < NB * 16; item += c.nb) {
        const int b = item >> 4, h = item & 15, hk = h * 64 + l;
        __syncthreads();
        if (w < 7) { const float* src = w == 0 ? P.w0 : w == 1 ? P.a0 : w == 2 ? P.k_k : w == 3 ? P.k_a : w == 4 ? P.r_k : w == 5 ? P.ln_w : P.ln_b; CST[w * 64 + l] = src[hk]; }
        for (int i = c.tid; i < 160 * 64; i += NTHR) { const int j = i >> 6, kcl = i & 63; *(unsigned short*)(G2T + kcl * RW2_SGP + j * 2) = (unsigned short)f2bf(P.g2[(size_t)j * 1024 + h * 64 + kcl]); }
        for (int i = c.tid; i < 192; i += NTHR) { const int mi = i < 64 ? h * 64 + i : i < 128 ? 1024 + h * 64 + (i - 64) : 2048 + h * 64 + (i - 128); MU[i] = P.mu[mi]; }
        const int tt = w >> 2, nt = w & 3;
        bf16x8 W2B[2], A2B[2];
        { const int kc = h * 64 + 16 * nt + n16;
          auto ldfrag = [&](const float* Wp, int kk) -> bf16x8 { float f[8]; int gq = g, kq = kc; asm volatile("" : "+v"(gq), "+v"(kq));
              const float* wp = Wp + (size_t)(32 * kk + 8 * gq) * 1024 + kq;
#pragma unroll
              for (int q = 0; q < 8; ++q) f[q] = wp[q * 1024];
              u32x4 u; u.x = pk2(f[0], f[1]); u.y = pk2(f[2], f[3]); u.z = pk2(f[4], f[5]); u.w = pk2(f[6], f[7]);
              asm volatile("" : "+v"(u));
              return __builtin_bit_cast(bf16x8, u); };
          W2B[0] = ldfrag(P.w2, 0); W2B[1] = ldfrag(P.w2, 1); A2B[0] = ldfrag(P.a2, 0); A2B[1] = ldfrag(P.a2, 1);
        }
        f32x2 S[4];
#pragma unroll
        for (int i = 0; i < 4; ++i) S[i] = (f32x2){0.f, 0.f};
        const int srow = w * 8 + (l >> 3), sj = l & 7;
        u32x4 raw[4];
#define RW2_LOAD(T0) do { _Pragma("unroll") for (int k = 0; k < 4; ++k) { const int q_ = c.tid + 512 * k; raw[k] = (u32x4){0u, 0u, 0u, 0u}; \
            if (q_ < 792) { const int cq_ = q_ % 24, tg = (T0) - 1 + q_ / 24; const int rc_ = (cq_ < 8 ? 880 : cq_ < 16 ? 1904 - 64 : 2928 - 128) + h * 64 + cq_ * 8; \
                if (tg >= 0) raw[k] = *(const u32x4*)(H + ((size_t)b * SEQ + tg) * HC + rc_); } \
            else if (q_ < 1944) { const int e_ = q_ - 792; raw[k] = *(const u32x4*)(LX + ((size_t)b * SEQ + (T0) + e_ / 36) * 288 + (e_ % 36) * 8); } } } while (0)
        RW2_LOAD(0);
#pragma unroll 1
        for (int t0 = 0; t0 < SEQ; t0 += 32) {
            __syncthreads();
#pragma unroll
            for (int k = 0; k < 4; ++k) { const int q_ = c.tid + 512 * k;
                if (q_ < 792) *(u32x4*)(RAW + (q_ / 24) * RW2_RAWP + (q_ % 24) * 16) = raw[k];
                else if (q_ < 1944) { const int e_ = q_ - 792, t_ = e_ / 36, p_ = e_ % 36;
                    unsigned char* d_ = p_ < 8 ? L_TW + t_ * RW2_TWP + p_ * 16 : p_ < 16 ? L_AL + t_ * RW2_TWP + (p_ - 8) * 16 : L_SG + t_ * RW2_SGP + (p_ - 16) * 16; *(u32x4*)d_ = raw[k]; } }
            if (t0 + 32 < SEQ) RW2_LOAD(t0 + 32);
            __syncthreads();
            if (c.tid < 384) {
                const int cpi = c.tid % 96, qb = c.tid / 96, cp = cpi * 2, tb = qb * 8;
                const float mu0 = MU[cp], mu1 = MU[cp + 1];
                unsigned xb = *(const unsigned*)(RAW + tb * RW2_RAWP + cp * 2);
                float p0 = bf2f(xb & 0xffffu), p1 = bf2f(xb >> 16);
                float* dst = (cp < 64 ? A_WR + cp : cp < 128 ? A_K2 + (cp - 64) : A_V + (cp - 128)) + tb * 64;
#pragma unroll
                for (int t = 0; t < 8; ++t) { const unsigned xa = *(const unsigned*)(RAW + (tb + t + 1) * RW2_RAWP + cp * 2); const float x0 = bf2f(xa & 0xffffu), x1 = bf2f(xa >> 16);
                    *(f32x2*)(dst + t * 64) = (f32x2){x0 + (p0 - x0) * mu0, x1 + (p1 - x1) * mu1}; p0 = x0; p1 = x1; }
            }
            __syncthreads();
            {
                f32x4 aw = (f32x4){0.f, 0.f, 0.f, 0.f}, aa = aw, ag = aw;
#pragma unroll
                for (int kk = 0; kk < 2; ++kk) { const bf16x8 At = *(const bf16x8*)(L_TW + (16 * tt + n16) * RW2_TWP + (32 * kk + 8 * g) * 2), Aa = *(const bf16x8*)(L_AL + (16 * tt + n16) * RW2_TWP + (32 * kk + 8 * g) * 2);
                    aw = __builtin_amdgcn_mfma_f32_16x16x32_bf16(At, W2B[kk], aw, 0, 0, 0); aa = __builtin_amdgcn_mfma_f32_16x16x32_bf16(Aa, A2B[kk], aa, 0, 0, 0); }
#pragma unroll
                for (int kk = 0; kk < 5; ++kk) { const bf16x8 Ag = *(const bf16x8*)(L_SG + (16 * tt + n16) * RW2_SGP + (32 * kk + 8 * g) * 2); const bf16x8 Gb = *(const bf16x8*)(G2T + (16 * nt + n16) * RW2_SGP + (32 * kk + 8 * g) * 2); ag = __builtin_amdgcn_mfma_f32_16x16x32_bf16(Ag, Gb, ag, 0, 0, 0); }
#pragma unroll
                for (int r = 0; r < 4; ++r) { const int o = (16 * tt + 4 * g + r) * 64 + 16 * nt + n16; LO_W[o] = aw[r]; LO_A[o] = aa[r]; A_G[o] = ag[r]; }
            }
            __syncthreads();
#pragma unroll 2
            for (int i = 0; i < 4; ++i) {
                const int t = w + 8 * i, o = t * 64 + l;
                const float w0v = CST[l], a0v = CST[64 + l], kkv = CST[128 + l], kav = CST[192 + l], rkv = CST[256 + l];
                const float dec = __expf(-0.6065306597126334f * sigmoidf_(w0v + LO_W[o]));
                const float a = sigmoidf_(a0v + LO_A[o]);
                const float kr = A_K2[o], r = A_WR[o];
                const float kk0 = kr * kkv, k2 = kr * (1.f + (a - 1.f) * kav), bb0 = kk0 * a, k2r = k2 * r;
                A_W[o] = dec; A_NKK[o] = -kk0; A_B[o] = bb0; A_K2[o] = k2; A_WR[o] = dec * r;
                PR0[o] = kk0 * kk0; PR1[o] = bb0 * r; PR2[o] = k2r; PR3[o] = k2r * rkv;
            }
            __syncthreads();
            {
                const int t = c.tid >> 4, q = (c.tid >> 2) & 3, qu = c.tid & 3;
                const float* src = (q == 0 ? PR0 : q == 1 ? PR1 : q == 2 ? PR2 : PR3) + t * 64 + 16 * qu;
                const f32x4 v0 = *(const f32x4*)src, v1 = *(const f32x4*)(src + 4), v2 = *(const f32x4*)(src + 8), v3 = *(const f32x4*)(src + 12);
                float sm = ((v0.x + v0.y) + (v0.z + v0.w)) + ((v1.x + v1.y) + (v1.z + v1.w)) + ((v2.x + v2.y) + (v2.z + v2.w)) + ((v3.x + v3.y) + (v3.z + v3.w));
                sm += dpp_mov<0xB1>(sm); sm += dpp_mov<0x4E>(sm);
                if (qu == 0) SCP[t * 4 + q] = (q == 0) ? 1.0f / fmaxf(sm, 1e-24f) : sm;
            }
            __syncthreads();
            {
                f32x4 n0, n1, r0, r1, w0_, w1_, b0, b1, k0, k1, sp; float vv;
                const unsigned char* pk_ = (const unsigned char*)A_WR + 32 * sj;
                const unsigned char* pv_ = (const unsigned char*)A_WR + 4 * srow;
                const unsigned char* ps_ = (const unsigned char*)SCP;
                constexpr int O_WR = 0, O_K2 = 8192, O_V = 16384, O_W = 24576, O_NKK = 32768, O_B = 40960, O_OUT = 57344;
#define RW2_LD_DOT(T) do { n0 = *(const f32x4*)(pk_ + O_NKK + (T) * 256); n1 = *(const f32x4*)(pk_ + O_NKK + (T) * 256 + 16); r0 = *(const f32x4*)(pk_ + O_WR + (T) * 256); r1 = *(const f32x4*)(pk_ + O_WR + (T) * 256 + 16); } while (0)
#define RW2_LD_UPD(T) do { w0_ = *(const f32x4*)(pk_ + O_W + (T) * 256); w1_ = *(const f32x4*)(pk_ + O_W + (T) * 256 + 16); b0 = *(const f32x4*)(pk_ + O_B + (T) * 256); b1 = *(const f32x4*)(pk_ + O_B + (T) * 256 + 16); \
                    k0 = *(const f32x4*)(pk_ + O_K2 + (T) * 256); k1 = *(const f32x4*)(pk_ + O_K2 + (T) * 256 + 16); vv = *(const float*)(pv_ + O_V + (T) * 256); sp = *(const f32x4*)(ps_ + (T) * 16); } while (0)
#define RW2_STEP(T) do { \
                    f32x2 sa2 = S[0] * (f32x2){n0.x, n0.y}; sa2 = S[1] * (f32x2){n0.z, n0.w} + sa2; sa2 = S[2] * (f32x2){n1.x, n1.y} + sa2; sa2 = S[3] * (f32x2){n1.z, n1.w} + sa2; \
                    f32x2 p2 = S[0] * (f32x2){r0.x, r0.y}; p2 = S[1] * (f32x2){r0.z, r0.w} + p2; p2 = S[2] * (f32x2){r1.x, r1.y} + p2; p2 = S[3] * (f32x2){r1.z, r1.w} + p2; \
                    __builtin_amdgcn_sched_barrier(0); RW2_LD_DOT((T) + 1); __builtin_amdgcn_sched_barrier(0); \
                    const float sa = sum8(sa2.x + sa2.y) * sp.x, p = sum8(p2.x + p2.y); \
                    const f32x2 sav = (f32x2){sa, sa}, vvv = (f32x2){vv, vv}; \
                    S[0] = S[0] * (f32x2){w0_.x, w0_.y} + (sav * (f32x2){b0.x, b0.y} + vvv * (f32x2){k0.x, k0.y}); \
                    S[1] = S[1] * (f32x2){w0_.z, w0_.w} + (sav * (f32x2){b0.z, b0.w} + vvv * (f32x2){k0.z, k0.w}); \
                    S[2] = S[2] * (f32x2){w1_.x, w1_.y} + (sav * (f32x2){b1.x, b1.y} + vvv * (f32x2){k1.x, k1.y}); \
                    S[3] = S[3] * (f32x2){w1_.z, w1_.w} + (sav * (f32x2){b1.z, b1.w} + vvv * (f32x2){k1.z, k1.w}); \
                    const float ov = p + sa * sp.y + vv * sp.z; \
                    __builtin_amdgcn_sched_barrier(0); RW2_LD_UPD((T) + 1); *(float*)(const_cast<unsigned char*>(pv_) + O_OUT + (T) * 256) = ov;        __builtin_amdgcn_sched_barrier(0); } while (0)
                RW2_LD_DOT(0); RW2_LD_UPD(0);
#pragma unroll 1
                for (int t4 = 0; t4 < 8; ++t4) {
                    RW2_STEP(0); RW2_STEP(1); RW2_STEP(2); RW2_STEP(3);
                    pk_ += 1024; pv_ += 1024; ps_ += 64;
                }
#undef RW2_LD_DOT
#undef RW2_LD_UPD
#undef RW2_STEP
            }
            __syncthreads();
            {
                const int t = c.tid >> 3, q = (c.tid >> 2) & 1, qu = c.tid & 3;
                if (c.tid < 256) {
                    const float* src = A_OUT + t * 64 + 16 * qu; float sm = 0.f;
#pragma unroll
                    for (int e = 0; e < 4; ++e) { const f32x4 v = *(const f32x4*)(src + 4 * e); sm += q ? ((v.x * v.x + v.y * v.y) + (v.z * v.z + v.w * v.w)) : ((v.x + v.y) + (v.z + v.w)); }
                    sm += dpp_mov<0xB1>(sm); sm += dpp_mov<0x4E>(sm);
                    const float other = dpp_mov<0x141>(sm);
                    if ((c.tid & 7) == 0) { const float mean = sm * (1.f / 64.f), var = fmaxf(other * (1.f / 64.f) - mean * mean, 0.f); GN[t * 2] = mean; GN[t * 2 + 1] = 1.0f / sqrtf(var + 64e-5f); }
                }
            }
            __syncthreads();
#pragma unroll
            for (int i = 0; i < 4; ++i) {
                const int t = w + 8 * i, o = t * 64 + l;
                float y = (A_OUT[o] - GN[t * 2]) * GN[t * 2 + 1] * CST[320 + l] + CST[384 + l];
                y = (y + SCP[t * 4 + 3] * A_V[o]) * A_G[o];
                if (b < wb) OUT[((size_t)b * SEQ + t0 + t) * ldo + coloff + hk] = (bf16)f2bf(y);
            }
        }
#undef RW2_LOAD
    }
}
constexpr int S5B_BUP = 132 * 4, S5B_XP = 272;
constexpr int S5B_WAVE = 16 * S5B_BUP + 16 * S5B_XP;
__device__ __forceinline__ void wave_lds_sync() { __builtin_amdgcn_fence(__ATOMIC_RELEASE, "wavefront"); __builtin_amdgcn_wave_barrier(); __builtin_amdgcn_fence(__ATOMIC_ACQUIRE, "wavefront"); }
__device__ __forceinline__ void s5_phase2(const Ctx& c, const bf16* __restrict__ U, const S5P P, bf16* Z) {
    if (c.wave >= 4) return;
    float* BU = (float*)(c.lds + c.wave * S5B_WAVE); unsigned char* XB = c.lds + c.wave * S5B_WAVE + 16 * S5B_BUP;
    const int l = c.lane, n16 = l & 15, g = l >> 4;
#pragma unroll 1
    for (int item = c.bid; item < 256; item += c.nb) {
        const int b = item >> 5, grp = (item & 31) * 4 + c.wave;
        float lbr, lbi;
        { const float lr = fminf(P.lam_re[grp * 64 + l], -1e-4f), li = P.lam_im[grp * 64 + l], dt = expf(P.log_dt[grp]);
          const float e = expf(lr * dt); lbr = e * cosf(li * dt); lbi = e * sinf(li * dt);
          const float nr = lbr - 1.f, ni = lbi, den = 1.f / (lr * lr + li * li);
          BU[l] = (nr * lr + ni * li) * den; BU[64 + l] = (ni * lr - nr * li) * den; }
        wave_lds_sync();
        bf16x4 Bre[4], Bim[4];
#pragma unroll
        for (int nt = 0; nt < 4; ++nt) { const int p = 16 * nt + n16; const float cr = BU[p], ci = BU[64 + p];
            const f32x4 br = *(const f32x4*)(P.b_re + (size_t)(grp * 64 + p) * 16 + 4 * g), bi = *(const f32x4*)(P.b_im + (size_t)(grp * 64 + p) * 16 + 4 * g);
            u32x2 wr, wi; wr.x = pk2(cr * br.x - ci * bi.x, cr * br.y - ci * bi.y); wr.y = pk2(cr * br.z - ci * bi.z, cr * br.w - ci * bi.w);
            wi.x = pk2(cr * bi.x + ci * br.x, cr * bi.y + ci * br.y); wi.y = pk2(cr * bi.z + ci * br.z, cr * bi.w + ci * br.w);
            Bre[nt] = __builtin_bit_cast(bf16x4, wr); Bim[nt] = __builtin_bit_cast(bf16x4, wi); }
        wave_lds_sync();
        bf16x8 Cf[4];
#pragma unroll
        for (int kk = 0; kk < 4; ++kk) { const int k0 = 32 * kk + 8 * g; const float sg = (kk < 2) ? 1.f : -1.f;
            const float* src = ((kk < 2) ? P.c_re : P.c_im) + (size_t)(grp * 16 + n16) * 64 + (k0 & 63);
            const f32x4 v0 = *(const f32x4*)src, v1 = *(const f32x4*)(src + 4);
            u32x4 w; w.x = pk2(sg * v0.x, sg * v0.y); w.y = pk2(sg * v0.z, sg * v0.w); w.z = pk2(sg * v1.x, sg * v1.y); w.w = pk2(sg * v1.z, sg * v1.w); Cf[kk] = __builtin_bit_cast(bf16x8, w); }
        const float dsk = P.d[grp * 16 + n16];
        float xr = 0.f, xi = 0.f;
        const bf16* ub = U + (size_t)b * SEQ * D + grp * 16;
        u32x2 ua[4]; unsigned short ue[4][4];
#define S5B_LOAD(k, T0) do { ua[k] = *(const u32x2*)(ub + (size_t)((T0) + n16) * D + 4 * g); _Pragma("unroll") for (int r = 0; r < 4; ++r) ue[k][r] = ub[(size_t)((T0) + 4 * g + r) * D + n16]; } while (0)
#pragma unroll
        for (int k = 0; k < 4; ++k) S5B_LOAD(k, 16 * k);
#pragma unroll 1
        for (int t0 = 0; t0 < SEQ; t0 += 64) {
#pragma unroll
            for (int k = 0; k < 4; ++k) {
                const int tb = t0 + 16 * k;
                const bf16x4 A = __builtin_bit_cast(bf16x4, ua[k]);
                float uf[4];
#pragma unroll
                for (int r = 0; r < 4; ++r) uf[r] = bf2f(ue[k][r]);
                if (tb + 64 < SEQ) S5B_LOAD(k, tb + 64);
#pragma unroll
                for (int nt = 0; nt < 4; ++nt) {
                    const f32x4 ar = __builtin_amdgcn_mfma_f32_16x16x16bf16_1k(A, Bre[nt], (f32x4){0.f, 0.f, 0.f, 0.f}, 0, 0, 0);
                    const f32x4 ai = __builtin_amdgcn_mfma_f32_16x16x16bf16_1k(A, Bim[nt], (f32x4){0.f, 0.f, 0.f, 0.f}, 0, 0, 0);
#pragma unroll
                    for (int r = 0; r < 4; ++r) { BU[(4 * g + r) * 132 + 16 * nt + n16] = ar[r]; BU[(4 * g + r) * 132 + 64 + 16 * nt + n16] = ai[r]; }
                }
                wave_lds_sync();
#pragma unroll 4
                for (int t = 0; t < 16; ++t) {
                    const float br = BU[t * 132 + l], bi = BU[t * 132 + 64 + l];
                    const float nxr = lbr * xr - lbi * xi + br, nxi = lbr * xi + lbi * xr + bi; xr = nxr; xi = nxi;
                    *(unsigned short*)(XB + t * S5B_XP + l * 2) = (unsigned short)f2bf(xr); *(unsigned short*)(XB + t * S5B_XP + 128 + l * 2) = (unsigned short)f2bf(xi);
                }
                wave_lds_sync();
                f32x4 y = (f32x4){0.f, 0.f, 0.f, 0.f};
#pragma unroll
                for (int kk = 0; kk < 4; ++kk) { const bf16x8 Ax = *(const bf16x8*)(XB + n16 * S5B_XP + (32 * kk + 8 * g) * 2); y = __builtin_amdgcn_mfma_f32_16x16x32_bf16(Ax, Cf[kk], y, 0, 0, 0); }
#pragma unroll
                for (int r = 0; r < 4; ++r) Z[((size_t)b * SEQ + tb + 4 * g + r) * D + grp * 16 + n16] = (bf16)f2bf(gelu_tanh(y[r] + dsk * uf[r]));
                wave_lds_sync();
            }
        }
#undef S5B_LOAD
    }
}
struct Args { const void* in[45]; float* out; unsigned char* ws; int ph_lo, ph_hi; };
static_assert(sizeof(Args) == 45 * 8 + 8 + 8 + 8, "Args has no padding");
constexpr int PH_EVEN = 9, PH_ODD = 4, PH_COMMON = 13;
constexpr int NPHASES = 2 * (1 + PH_EVEN + PH_COMMON) + 2 * (1 + PH_ODD + PH_COMMON) + 1;

__global__ void __launch_bounds__(NTHR, 2) mega(Args args) {
    extern __shared__ __attribute__((aligned(16))) unsigned char lds[];
    volatile LAS unsigned* MISC = (volatile LAS unsigned*)((LAS unsigned char*)lds + MISC_OFF);
    if (threadIdx.x < 64) MISC[threadIdx.x] = 0u;
    __syncthreads();
    unsigned char* ws = args.ws;
    XcdBarrier bar = xcd_barrier_post((unsigned*)(ws + WS_CTL) + 4096, MISC + 8, gridDim.x);
    const int half = (int)gridDim.x >> 1;
    XcdBarrier bar2 = bar; if ((int)blockIdx.x >= half) bar2 = xcd_barrier_post((unsigned*)(ws + WS_CTL) + 8192, MISC + 10, gridDim.x - half);
    const int lo = args.ph_lo, hi = args.ph_hi;
    int pid = 0;
#define PH_BEGIN if (pid >= lo && pid < hi) { Ctx c; { int t_ = threadIdx.x, b_ = blockIdx.x; asm volatile("" : "+v"(t_)); asm volatile("" : "+s"(b_)); c.lds = lds; c.tid = t_; c.lane = t_ & 63; c.wave = __builtin_amdgcn_readfirstlane(t_ >> 6); c.bid = b_; { int n_ = gridDim.x; asm volatile("" : "+s"(n_)); c.nb = n_; } c.gw = c.bid * NWAVES + c.wave; c.ngw = c.nb * NWAVES; }
#define PH_END } if (pid >= lo && pid + 1 < hi) { xcd_barrier(bar); if (DBL & 2048) xcd_barrier(bar); } ++pid;
#define IN_F(i) (*(const float* const __attribute__((address_space(4)))*)(KARGS() + 8 * (i)))

    typedef const unsigned char __attribute__((address_space(4)))* kptr_t;
#define KARGS() ({ kptr_t p_ = (kptr_t)__builtin_amdgcn_kernarg_segment_ptr(); asm volatile("" : "+s"(p_)); p_; })
#define WSP(off) ((*(unsigned char* const __attribute__((address_space(4)))*)(KARGS() + 368)) + (off))
#define X ((float*)(*(float* const __attribute__((address_space(4)))*)(KARGS() + 360)))
#define ROPEA ((float*)WSP(WS_ROPEA))
#define ROPEI ((float*)WSP(WS_ROPEI))
#define KVBIG ((bf16*)WSP(WS_KVBIG))
#define WKV ((bf16*)WSP(WS_WKV))
#define W_IN ((bf16*)WSP(WS_WMIX + WMIX_IN))
#define WQ ((bf16*)WSP(WS_WMIX + WMIX_Q))
#define WOUT ((bf16*)WSP(WS_WMIX + WMIX_OUT))
#define WO_IN ((bf16*)WSP(WS_WMIX + WMIX_O_IN))
#define WO_GLU ((bf16*)WSP(WS_WMIX + WMIX_O_GLU))
#define WO_OUT ((bf16*)WSP(WS_WMIX + WMIX_O_OUT))
#define WXQ ((bf16*)WSP(WS_WXQ))
#define WXO ((bf16*)WSP(WS_WXO))
#define WUP ((bf16*)WSP(WS_WUP))
#define WDN ((bf16*)WSP(WS_WDN))
#define CQN ((bf16*)WSP(WS_CQN))
#define KF ((bf16*)WSP(WS_KF))
#define KIDX ((bf16*)WSP(WS_KIDX))
#define WIDX ((float*)WSP(WS_WIDX))
#define SEL ((bf16*)WSP(WS_SEL))
#define Hb ((bf16*)WSP(WS_R1))
#define SC ((float*)WSP(WS_R1))
#define HID ((bf16*)WSP(WS_R1))
#define Ub ((bf16*)WSP(WS_R1))
#define YC ((bf16*)WSP(WS_R1 + (size_t)M * D * 2))
#define XN ((bf16*)WSP(WS_R2))
#define QALL ((bf16*)X)
#define OLY ((bf16*)WSP(WS_R3))
#define Zb ((bf16*)WSP(WS_R3))
#define XQ ((bf16*)WSP(WS_R3))
#define XO ((bf16*)WSP(WS_R3 + (size_t)M * 512 * 2))
#define MEMN ((bf16*)WSP(WS_R3))
    LAS unsigned char* glds = (LAS unsigned char*)lds;

#define RS_A ((unsigned long long*)WSP(WS_CTL + 131072))
#define RS_B ((unsigned long long*)WSP(WS_CTL + 393216))
#define RS_C ((unsigned long long*)WSP(WS_CTL + 655360))
    for (int layer = 0; layer < DEPTH; ++layer) {
        const int li = layer >> 1;
        PH_BEGIN
            if ((layer & 1) == 0) {
                conv_mat(c, IN_F(13) + (size_t)li * 2048 * EVEN_COLS, 2048, EVEN_COLS, EVEN_COLS, HC, W_IN, 2048, 0, 0, IN_F(3) + layer * D);
                build_wql(c, IN_F(18) + (size_t)li * 512 * 1024, IN_F(19) + (size_t)li * 256 * 768, WQ);
                for (int h = 0; h < 8; ++h) conv_mat(c, IN_F(18) + (size_t)li * 512 * 1024 + h * 128, 512, 1024, 32, 32, WQ, 512, 2048 + h * 32, 0);
                conv_mat(c, IN_F(21) + (size_t)li * 512 * 1024, 512, 1024, 1024, 1024, WQ, 512, 2304, 0);
                build_wout(c, IN_F(20) + (size_t)li * 256 * 1024, IN_F(14) + (size_t)li * 2048 * 2048, WOUT);
                conv_mat(c, IN_F(14) + (size_t)li * 2048 * 2048 + (size_t)1024 * 2048, 1024, 2048, 2048, 2048, WOUT, OC, 0, 2048);
            } else {
                conv_mat(c, IN_F(33) + (size_t)li * 2048 * 2048, 2048, 2048, 2048, 2048, WO_IN, 2048, 0, 0, IN_F(3) + layer * D);
                conv_mat(c, IN_F(43) + (size_t)li * 2048 * 2048, 2048, 2048, 2048, 2048, WO_GLU, 2048, 0, 0);
                conv_mat(c, IN_F(34) + (size_t)li * 2048 * 2048, 2048, 2048, 2048, 2048, WO_OUT, 2048, 0, 0);
            }
            conv_mat(c, IN_F(8) + (size_t)layer * 2048 * 512, 2048, 512, 512, 512, WXQ, 2048, 0, 0, IN_F(4) + layer * D);
            conv_mat(c, IN_F(10) + (size_t)layer * 512 * 2048, 512, 2048, 2048, 2048, WXO, 512, 0, 0);
            { unsigned long long* ra = RS_A; unsigned long long* rb = RS_B; for (int i = c.bid * NTHR + c.tid; i < M; i += c.nb * NTHR) { ra[i] = 0ull; rb[i] = 0ull; } }
            if (layer == 0) {
                for (int l2 = 0; l2 < 4; ++l2) {
                    conv_mat(c, IN_F(9) + (size_t)l2 * 2048 * 1024, 2048, 1024, 1024, 1024, WKV, 2048, l2 * 1024, 0);
                    norm_rows_bf16(c, IN_F(1), IN_F(5) + l2 * D, MEMN + (size_t)l2 * MEMR * D, MEMR);
                }
                rope_tables(c, (const int*)IN_F(2), ROPEA, ROPEI);
                cast_rows_ss(c, IN_F(0), XN, RS_C, M);
            }
        PH_END
        if ((layer & 1) == 0) {
            PH_BEGIN
                { pg8::Gemm g{XN, W_IN, 2048, 2048, 2048}; pg8::StaticOrder S; S.init(128, HC / 256, c.nb, c.bid); pg8::EpiBf16<0> E{Hb, HC, RS_C};
                  pg8::gemm_phase<pg8::EpiBf16<0>, pg8::StaticOrder, true, true>(glds, g, S, E);
                  if (DBL & 1024) { __syncthreads(); pg8::gemm_phase<pg8::EpiBf16<0>, pg8::StaticOrder, true, true>(glds, g, S, E); } }
                if (layer == 0) { __syncthreads(); pg8::Gemm g{MEMN, WKV, 2048, 2048, 2048}; pg8::KvOrder S{c.nb, c.bid}; pg8::EpiBf16<0> E{KVBIG, 4096, nullptr};
                  pg8::gemm_phase<pg8::EpiBf16<0>, pg8::KvOrder, true, true>(glds, g, S, E); }
            PH_END
            PH_BEGIN
                rwkv_lora_prep(c, Hb, IN_F(22) + li * B_COLS, (bf16*)WSP(WS_END + 96 * MiB));
            PH_END
            PH_BEGIN
                if (c.bid < half) {
                    Ctx r = c; r.nb = half; r.ngw = half * NWAVES;
                    const RwkvP P{IN_F(22) + li * B_COLS, IN_F(23) + li * 1024, IN_F(24) + (size_t)li * 65536, IN_F(25) + li * 1024, IN_F(26) + (size_t)li * 65536, IN_F(27) + (size_t)li * 163840,
                                  IN_F(28) + li * 1024, IN_F(29) + li * 1024, IN_F(30) + li * 1024, IN_F(31) + li * 1024, IN_F(32) + li * 1024};
#if DIAG == 4
                    rwkv_phase(r, Hb, P, OLY);
                    rwkv_phase2(r, Hb, (const bf16*)WSP(WS_END + 96 * MiB), P, (bf16*)WSP(WS_END + 116 * MiB), 1024, 0, 1);
#else
                    rwkv_phase2(r, Hb, (const bf16*)WSP(WS_END + 96 * MiB), P, OLY, OC, 2048);
#endif
                    __syncthreads();
                    conv_mat(r, IN_F(12) + (size_t)layer * FFN * 2048, FFN, 2048, 2048, 2048, WDN, FFN, 0, 0);
                } else {
                    Ctx d = c; d.bid = c.bid - half; d.nb = c.nb - half; d.gw = d.bid * NWAVES + d.wave; d.ngw = d.nb * NWAVES;
                    dsa_prep(d, Hb, IN_F(15) + li * 512, IN_F(16) + li * 256, IN_F(17) + li * 64, ROPEA, ROPEI, CQN, KF, KIDX, WIDX);
                    xcd_barrier(bar2);
                    { pg8::Gemm g{CQN, WQ, 512, 512, 512}; pg8::StaticOrder S; S.init(128, QC / 256, d.nb, d.bid); pg8::EpiBf16<0> E{QALL, QC, nullptr};
                      pg8::gemm_phase<pg8::EpiBf16<0>, pg8::StaticOrder, true, true>(glds, g, S, E); }
                    xcd_barrier(bar2);
                    idx_topk_mfma(d, QALL, KIDX, WIDX, ROPEI, (float*)(d.bid < 32 ? WSP(WS_CQN + (size_t)d.bid * MiB) : WSP(WS_END + (size_t)(d.bid - 32) * MiB)), SEL, 256);
                    conv_mat(d, IN_F(11) + (size_t)layer * 2048 * FFN, 2048, FFN, FFN, FFN, WUP, 2048, 0, 0, IN_F(6) + layer * D);
                    xcd_barrier(bar2);
                    if (d.bid == 0 && c.tid == 0) __hip_atomic_store((unsigned*)WSP(WS_CTL) + 12288 + 64 * (2 + li), 1u, __ATOMIC_RELAXED, __HIP_MEMORY_SCOPE_AGENT);
                }
                if (c.bid < half) {
                    if (c.tid == 0) { unsigned* fl = (unsigned*)WSP(WS_CTL) + 12288 + 64 * (2 + li); unsigned sp = 0;
                        while (__hip_atomic_load(fl, __ATOMIC_RELAXED, __HIP_MEMORY_SCOPE_AGENT) == 0u) { __builtin_amdgcn_s_sleep(8); if (++sp > (1u << 22)) break; } }
                    __syncthreads();
                    __builtin_amdgcn_fence(__ATOMIC_ACQUIRE, "agent"); asm volatile("s_waitcnt vmcnt(0)" ::: "memory");
                }
                dsa_attn_queue(c, QALL, KF, SEL, ROPEA, OLY, (unsigned*)WSP(WS_CTL) + 12288 + 64 * li, MISC + 12);
            PH_END
#if DBL & 32
            PH_BEGIN
                if (c.bid < half) {
                    Ctx r = c; r.nb = half; r.ngw = half * NWAVES;
                    const RwkvP P{IN_F(22) + li * B_COLS, IN_F(23) + li * 1024, IN_F(24) + (size_t)li * 65536, IN_F(25) + li * 1024, IN_F(26) + (size_t)li * 65536, IN_F(27) + (size_t)li * 163840,
                                  IN_F(28) + li * 1024, IN_F(29) + li * 1024, IN_F(30) + li * 1024, IN_F(31) + li * 1024, IN_F(32) + li * 1024};
                    rwkv_phase2(r, Hb, (const bf16*)WSP(WS_END + 96 * MiB), P, OLY, OC, 2048);
                }
            PH_END
#endif
#if DBL & 8
            PH_BEGIN
                if (c.bid >= half) {
                    Ctx d = c; d.bid = c.bid - half; d.nb = c.nb - half; d.gw = d.bid * NWAVES + d.wave; d.ngw = d.nb * NWAVES;
                    idx_topk_mfma(d, QALL, KIDX, WIDX, ROPEI, (float*)(d.bid < 32 ? WSP(WS_CQN + (size_t)d.bid * MiB) : WSP(WS_END + (size_t)(d.bid - 32) * MiB)), SEL, 256);
                }
            PH_END
#endif
#if DIAG == 4
            PH_BEGIN
                diag_cmp_bf16(c, OLY + 2048, OC, (bf16*)WSP(WS_END + 116 * MiB), 1024, SEQ, 1024, (float*)WSP(WS_CTL + 65536));
            PH_END
#endif
#if DIAG == 7 || DIAG == 8
            PH_BEGIN
                q_rope_fix(c, QALL, ROPEA, ROPEI);
            PH_END
#endif
#if DIAG == 7
            PH_BEGIN
                if (c.bid >= half) { Ctx d = c; d.bid = c.bid - half; d.nb = c.nb - half; d.gw = d.bid * NWAVES + d.wave; d.ngw = d.nb * NWAVES;
                    idx_topk_v1(d, QALL, KIDX, WIDX, (float*)(d.bid < 32 ? WSP(WS_CQN + (size_t)d.bid * MiB) : WSP(WS_END + (size_t)(d.bid - 32) * MiB)), (bf16*)WSP(WS_END + 116 * MiB), 128); }
            PH_END
            PH_BEGIN
                diag_cmp_sel(c, SEL, (bf16*)WSP(WS_END + 116 * MiB), 4, (float*)WSP(WS_CTL + 65536));
            PH_END
#endif
#if DIAG == 8
            PH_BEGIN
                dsa_attn_simple(c, QALL, KF, SEL, (bf16*)WSP(WS_END + 116 * MiB), 1024);
            PH_END
            PH_BEGIN
                diag_cmp_bf16(c, OLY, OC, (bf16*)WSP(WS_END + 116 * MiB), OC, 1024, 2048, (float*)WSP(WS_CTL + 65536));
            PH_END
#endif
            PH_BEGIN
                { pg8::Gemm g{OLY, WOUT, OC, OC, OC}; pg8::StaticOrder S; S.init(128, 8, c.nb, c.bid); pg8::EpiRes E{XN, D, RS_A};
                  pg8::gemm_phase<pg8::EpiRes, pg8::StaticOrder, true, true>(glds, g, S, E); }
            PH_END
        } else {
            PH_BEGIN
                { pg8::Gemm g{XN, WO_IN, 2048, 2048, 2048}; pg8::StaticOrder S; S.init(128, 8, c.nb, c.bid); pg8::EpiBf16<0> E{Ub, D, RS_C};
                  pg8::gemm_phase<pg8::EpiBf16<0>, pg8::StaticOrder, true, true>(glds, g, S, E);
                  if (DBL & 1024) { __syncthreads(); pg8::gemm_phase<pg8::EpiBf16<0>, pg8::StaticOrder, true, true>(glds, g, S, E); } }
            PH_END
            PH_BEGIN
                { const S5P P{IN_F(35) + li * 8192, IN_F(36) + li * 8192, IN_F(37) + li * 128, IN_F(38) + (size_t)li * 131072, IN_F(39) + (size_t)li * 131072, IN_F(40) + (size_t)li * 131072, IN_F(41) + (size_t)li * 131072, IN_F(42) + li * D};
                  s5_phase2(c, Ub, P, Zb); }
                if (c.wave >= 4) {
                    Ctx v = c; v.lds = c.lds + 65536 - 4 * 8704; v.gw = c.bid * 4 + (c.wave - 4); v.ngw = c.nb * 4;
                    conv_mat(v, IN_F(11) + (size_t)layer * 2048 * FFN, 2048, FFN, FFN, FFN, WUP, 2048, 0, 0, IN_F(6) + layer * D);
                    conv_mat(v, IN_F(12) + (size_t)layer * FFN * 2048, FFN, 2048, 2048, 2048, WDN, FFN, 0, 0);
                }
            PH_END
#if DIAG == 5
            PH_BEGIN
                { const S5P P{IN_F(35) + li * 8192, IN_F(36) + li * 8192, IN_F(37) + li * 128, IN_F(38) + (size_t)li * 131072, IN_F(39) + (size_t)li * 131072, IN_F(40) + (size_t)li * 131072, IN_F(41) + (size_t)li * 131072, IN_F(42) + li * D};
                  s5_phase(c, Ub, P, YC); }
            PH_END
            PH_BEGIN
                diag_cmp_bf16(c, YC, D, Zb, D, M, D, (float*)WSP(WS_CTL + 65536));
            PH_END
#endif
            PH_BEGIN
                { pg8::Gemm g{Zb, WO_GLU, 2048, 2048, 2048}; pg8::StaticOrder S; S.init(128, 8, c.nb, c.bid); pg8::EpiGlu E{Zb, YC, D, IN_F(44) + li * D};
                  pg8::gemm_phase<pg8::EpiGlu, pg8::StaticOrder, true, true>(glds, g, S, E); }
            PH_END
            PH_BEGIN
                { pg8::Gemm g{YC, WO_OUT, 2048, 2048, 2048}; pg8::StaticOrder S; S.init(128, 8, c.nb, c.bid); pg8::EpiRes E{XN, D, RS_A};
                  pg8::gemm_phase<pg8::EpiRes, pg8::StaticOrder, true, true>(glds, g, S, E); }
            PH_END
        }
        PH_BEGIN
            { unsigned long long* rc = RS_C; for (int i = c.bid * NTHR + c.tid; i < M; i += c.nb * NTHR) rc[i] = 0ull; }
            { pg8::Gemm g{XN, WXQ, 2048, 2048, 2048}; pg8::StaticOrder S; S.init(128, 2, c.nb, c.bid); pg8::EpiBf16<0> E{XQ, 512, RS_A};
              pg8::gemm_phase<pg8::EpiBf16<0>, pg8::StaticOrder, true, true>(glds, g, S, E); }
        PH_END
        PH_BEGIN
            xattn_mfma(c, XQ, KVBIG, layer, XO); if (DBL & 128) { asm volatile("" ::: "memory"); xattn_mfma(c, XQ, KVBIG, layer, XO); }
        PH_END
        PH_BEGIN
            { pg8::Gemm g{XO, WXO, 512, 512, 512}; pg8::StaticOrder S; S.init(128, 8, c.nb, c.bid); pg8::EpiRes E{XN, D, RS_B};
              pg8::gemm_phase<pg8::EpiRes, pg8::StaticOrder, true, true>(glds, g, S, E); }
        PH_END
        for (int q = 0; q < 5; ++q) {
            PH_BEGIN
                if (q > 0) { const int qd = q - 1; bf16* hid = HID + (size_t)(qd & 1) * 8192 * FFN;
                    pg8::Gemm g{hid, WDN, FFN, FFN, FFN}; pg8::StaticOrder S; S.init(32, 8, c.nb, c.bid); pg8::EpiRes E{XN + (size_t)qd * 8192 * D, D, RS_C + qd * 8192};
                    pg8::gemm_phase<pg8::EpiRes, pg8::StaticOrder, true, true>(glds, g, S, E); __syncthreads(); }
                if (q < 4) { bf16* hid = HID + (size_t)(q & 1) * 8192 * FFN;
                    pg8::Gemm g{XN + (size_t)q * 8192 * D, WUP, 2048, 2048, 2048}; pg8::StaticOrder S; S.init(32, 32, c.nb, c.bid); pg8::EpiBf16<1> E{hid, FFN, RS_B + q * 8192};
                    pg8::gemm_phase<pg8::EpiBf16<1>, pg8::StaticOrder, true, true>(glds, g, S, E); }
            PH_END
        }
    }
    PH_BEGIN
        scale_rows_out(c, XN, IN_F(7), RS_C, X, M);
    PH_END
#if DIAG
    PH_BEGIN
        { const float* dg = (const float*)WSP(WS_CTL + 65536); const float sc = 1.f + sqrtf(100.f * dg[0] / fmaxf(dg[1], 1e-30f));
          float* xo = X; for (size_t i = (size_t)c.bid * NTHR + c.tid; i < (size_t)M * D; i += (size_t)c.nb * NTHR) xo[i] *= sc; }
    PH_END
#endif
#undef PH_BEGIN
#undef PH_END
#undef IN_F
#undef X
}

extern "C" void kernel_launch(void* const* d_in, const int* in_sizes, int n_in, void* d_out, int out_size, void* d_ws, size_t ws_size, hipStream_t stream) {
    static int grid = 0;
    if (grid == 0) {
        if (n_in != 45 || out_size != M * D || ws_size < WS_END + 116 * MiB) { fprintf(stderr, "kernel_launch: unexpected shapes (n_in %d, out %d, ws %zu, need %zu)\n", n_in, out_size, ws_size, (size_t)WS_END); grid = -1; return; }
        int dev = 0, cus = 0, per_cu = 0;
        if (hipGetDevice(&dev) != hipSuccess || hipDeviceGetAttribute(&cus, hipDeviceAttributeMultiprocessorCount, dev) != hipSuccess) { grid = -1; return; }
        if (hipFuncSetAttribute((const void*)mega, hipFuncAttributeMaxDynamicSharedMemorySize, LDS_BYTES) != hipSuccess) { fprintf(stderr, "kernel_launch: hipFuncSetAttribute failed\n"); grid = -1; return; }
        if (hipOccupancyMaxActiveBlocksPerMultiprocessor(&per_cu, (const void*)mega, NTHR, LDS_BYTES) != hipSuccess || per_cu < 1) fprintf(stderr, "kernel_launch: occupancy query reports %d\n", per_cu);
        (void)hipGetLastError();
        grid = cus;
    }
    if (grid < 0) return;
    (void)hipMemsetAsync((char*)d_ws + WS_CTL, 0, CTL_BYTES, stream);
    Args a{};
    for (int i = 0; i < 45; ++i) a.in[i] = d_in[i];
    a.out = (float*)d_out; a.ws = (unsigned char*)d_ws;
#if MK_ONE_LAUNCH
    a.ph_lo = 0; a.ph_hi = 1 << 20;
    hipLaunchKernelGGL(mega, dim3(grid), dim3(NTHR), LDS_BYTES, stream, a);
#else
    for (int p = 0; p < NPHASES; ++p) { a.ph_lo = p; a.ph_hi = p + 1; hipLaunchKernelGGL(mega, dim3(grid), dim3(NTHR), LDS_BYTES, stream, a); }
#endif
}
```

```cpp
#include <hip/hip_runtime.h>
#include <cstdio>
#include <cstdint>

#ifndef DIAG
#define DIAG 0
#endif
#ifndef ATTN_SPLIT
#define ATTN_SPLIT 0
#endif
#ifndef DBL
#define DBL 0
#endif
#ifndef MK_ONE_LAUNCH
#define MK_ONE_LAUNCH 1
#endif

constexpr int D = 2048, NB = 8, SEQ = 4096, M = NB * SEQ, DEPTH = 4;
constexpr int HC = 4352;
constexpr int EVEN_COLS = 4240, A_COLS = 880, B_COLS = 3360;
constexpr int QC = 3328;
constexpr int OC = 3072;
constexpr int KFW = 288;
constexpr int FFN = 8192;
constexpr int MEMR = NB * 256;
constexpr float NORM_EPS = 1e-5f;
constexpr size_t SC_PER_BATCH = (size_t)4096 * 64 * 65 / 2;

typedef unsigned short bf16;
typedef float f32x4 __attribute__((ext_vector_type(4)));
typedef unsigned u32x4 __attribute__((ext_vector_type(4)));
typedef unsigned u32x2 __attribute__((ext_vector_type(2)));
typedef float f32x2 __attribute__((ext_vector_type(2)));
#define LAS __attribute__((address_space(3)))

constexpr size_t MiB = 1u << 20;
constexpr size_t al256(size_t x) { return (x + 255) & ~(size_t)255; }
constexpr size_t WS_CTL = 0, CTL_BYTES = 1 * MiB;
constexpr size_t WS_ROPEA = WS_CTL + CTL_BYTES;
constexpr size_t WS_ROPEI = WS_ROPEA + (size_t)M * 32 * 4;
constexpr size_t WS_KVBIG = WS_ROPEI + (size_t)M * 16 * 4;
constexpr size_t WS_WKV = WS_KVBIG + (size_t)8192 * 4096 * 2;
constexpr size_t WS_WMIX = WS_WKV + (size_t)4096 * 2048 * 2;
constexpr size_t WMIX_IN = 0, WMIX_Q = (size_t)HC * 2048 * 2, WMIX_OUT = WMIX_Q + (size_t)QC * 512 * 2, WMIX_BYTES = WMIX_OUT + (size_t)2048 * OC * 2;
constexpr size_t WMIX_O_IN = 0, WMIX_O_GLU = (size_t)2048 * 2048 * 2, WMIX_O_OUT = 2 * WMIX_O_GLU;
constexpr size_t WS_WXQ = al256(WS_WMIX + WMIX_BYTES);
constexpr size_t WS_WXO = WS_WXQ + (size_t)512 * 2048 * 2;
constexpr size_t WS_WUP = WS_WXO + (size_t)2048 * 512 * 2;
constexpr size_t WS_WDN = WS_WUP + (size_t)FFN * 2048 * 2;
constexpr size_t WS_CQN = WS_WDN + (size_t)2048 * FFN * 2;
constexpr size_t WS_KF = WS_CQN + (size_t)M * 512 * 2;
constexpr size_t WS_KIDX = WS_KF + (size_t)M * KFW * 2;
constexpr size_t WS_WIDX = WS_KIDX + (size_t)M * 64 * 2;
constexpr size_t WS_SEL = WS_WIDX + (size_t)M * 16 * 4;
constexpr size_t WS_R1 = al256(WS_SEL + (size_t)M * 256 * 2);
constexpr size_t R1_BYTES = (size_t)M * HC * 2;
constexpr size_t WS_R2 = WS_R1 + R1_BYTES;
constexpr size_t R2_BYTES = (size_t)M * QC * 2;
constexpr size_t WS_R3 = WS_R2 + R2_BYTES;
constexpr size_t R3_BYTES = (size_t)M * OC * 2;
constexpr size_t WS_END = WS_R3 + R3_BYTES;
static_assert(SC_PER_BATCH * NB * 4 <= R1_BYTES, "scores fit R1");
static_assert((size_t)8192 * FFN * 2 <= R1_BYTES && (size_t)M * 2048 * 2 * 2 <= R1_BYTES, "R1 overlays");

__device__ __forceinline__ float bf2f(unsigned v) { return __uint_as_float(v << 16); }
__device__ __forceinline__ unsigned f2bf(float f) { unsigned u = __float_as_uint(f); return (u + 0x7fffu + ((u >> 16) & 1u)) >> 16; }
__device__ __forceinline__ unsigned pk2(float lo, float hi) { return f2bf(lo) | (f2bf(hi) << 16); }
__device__ __forceinline__ float wave_sum(float v) {
#pragma unroll
    for (int o = 1; o < 64; o <<= 1) v += __shfl_xor(v, o);
    return v;
}
__device__ __forceinline__ float wave_max(float v) {
#pragma unroll
    for (int o = 1; o < 64; o <<= 1) v = fmaxf(v, __shfl_xor(v, o));
    return v;
}
__device__ __forceinline__ void unpack8(const u32x4 w, float* f) {
    f[0] = __uint_as_float(w.x << 16); f[1] = __uint_as_float(w.x & 0xffff0000u); f[2] = __uint_as_float(w.y << 16); f[3] = __uint_as_float(w.y & 0xffff0000u);
    f[4] = __uint_as_float(w.z << 16); f[5] = __uint_as_float(w.z & 0xffff0000u); f[6] = __uint_as_float(w.w << 16); f[7] = __uint_as_float(w.w & 0xffff0000u);
}
__device__ __forceinline__ float sigmoidf_(float x) { return 1.f / (1.f + __expf(-x)); }
namespace pg8 {
#define PG8_LAS __attribute__((address_space(3)))
typedef unsigned short bf16_t;
typedef short bf16x8 __attribute__((ext_vector_type(8)));
typedef float f32x4 __attribute__((ext_vector_type(4)));
typedef unsigned u32x4 __attribute__((ext_vector_type(4)));
constexpr int BM = 256, BK = 64, HALF = 128, HTB = HALF * BK * 2, STAGE_BYTES = 8 * HTB, NXCD = 8, WGM = 8;

__host__ __device__ __forceinline__ int lds_byte(int r, int c) { const int st = (r >> 4) * 2 + (c >> 5), rr = r & 15, cc = c & 31, ob = rr * 64 + cc * 2; return st * 1024 + (ob ^ (((ob >> 9) & 1) << 5)); }
__host__ __device__ __forceinline__ void stage_rc(int b, int& R, int& C) { const int st = b / 1024, sb = b % 1024, swz = sb ^ (((sb >> 9) & 1) << 5); R = (st >> 1) * 16 + swz / 64; C = (st & 1) * 32 + (swz % 64) / 2; }
__host__ __device__ __forceinline__ int perm32(int rho) { const int n = rho >> 4, i = rho & 15; return 8 * (i >> 2) + 4 * n + (i & 3); }

struct Unit { int pm, pn; };
struct Gemm { const bf16_t* A; const bf16_t* Bt; int lda, ldb, K, pad; };

struct StaticOrder {
    int nM, nN, nwg, G, c;
    __host__ __device__ void init(int nM_, int nN_, int G_, int c_) { nM = nM_; nN = nN_; nwg = nM * nN; G = G_; c = c_; }
    __host__ __device__ bool next(int i, Unit& u) const {
        const long L = (long)i * G + c; if (L >= nwg) return false;
        int wgid = (int)L; { const int q = nwg / NXCD, r = nwg % NXCD, xcd = wgid % NXCD, off = wgid / NXCD; wgid = (xcd < r ? xcd * (q + 1) : r * (q + 1) + (xcd - r) * q) + off; }
        const int nig = WGM * nN, gid = wgid / nig, fm = gid * WGM, gsz = (nM - fm) < WGM ? (nM - fm) : WGM;
        u.pm = fm + ((wgid % nig) % gsz); u.pn = (wgid % nig) / gsz; return true;
    }
    __device__ __forceinline__ void a_ready(const Unit&) const {}
    __device__ __forceinline__ void done(const Unit&) const {}
};
struct KvOrder {
    int G, c;
    __device__ bool next(int i, Unit& u) const { const int L = i * G + c; if (L >= 128) return false; const int ly = L >> 5, r = L & 31; u.pm = ly * 8 + (r & 7); u.pn = ly * 4 + (r >> 3); return true; }
    __device__ __forceinline__ void a_ready(const Unit&) const {}
    __device__ __forceinline__ void done(const Unit&) const {}
};

__device__ __forceinline__ unsigned cvt_pk_bf16(float lo, float hi) { unsigned r; asm volatile("v_cvt_pk_bf16_f32 %0, %1, %2" : "=v"(r) : "v"(lo), "v"(hi)); return r; }

template <int ACT> struct EpiBf16 {
    static constexpr bool PERM = true, AFTER_DRAIN = false;
    bf16_t* O; int ldc; const unsigned long long* rowss;
    __device__ __forceinline__ void operator()(const f32x4 (&acc)[2][2][4][2], const Unit& u, int wr, int wc, int fr, int fq) const {
        const int row0 = u.pm * BM + wr * 64 + fr; const int col0 = u.pn * BM + wc * 32 + 8 * fq;
#pragma unroll
        for (int ai = 0; ai < 2; ++ai)
#pragma unroll
            for (int m = 0; m < 4; ++m) { bf16_t* rowp = O + (size_t)(row0 + ai * HALF + m * 16) * ldc + col0;
                const float rs = rowss ? 1.0f / sqrtf((float)rowss[row0 + ai * HALF + m * 16] * (5.9604644775390625e-08f / 2048.f) + 1e-5f) : 1.f;
#pragma unroll
                for (int bj = 0; bj < 2; ++bj) { f32x4 v0 = acc[ai][bj][m][0] * rs, v1 = acc[ai][bj][m][1] * rs;
                    if (ACT == 1) {
#pragma unroll
                        for (int j = 0; j < 4; ++j) { const float a = fmaxf(v0[j], 0.f), b = fmaxf(v1[j], 0.f); v0[j] = a * a; v1[j] = b * b; } }
                    u32x4 w; w.x = cvt_pk_bf16(v0[0], v0[1]); w.y = cvt_pk_bf16(v0[2], v0[3]); w.z = cvt_pk_bf16(v1[0], v1[1]); w.w = cvt_pk_bf16(v1[2], v1[3]);
                    *(u32x4*)(rowp + bj * HALF) = w; } }
    }
};
struct EpiRes {
    static constexpr bool PERM = false, AFTER_DRAIN = false;
    bf16_t* xb; int ldc; unsigned long long* rowss;
    __device__ __forceinline__ void operator()(const f32x4 (&acc)[2][2][4][2], const Unit& u, int wr, int wc, int fr, int fq) const {
        typedef unsigned u32x2_ __attribute__((ext_vector_type(2)));
        const int row0 = u.pm * BM + wr * 64 + fr, col0 = u.pn * BM + wc * 32 + 4 * fq;
#pragma unroll
        for (int ai = 0; ai < 2; ++ai)
#pragma unroll
            for (int m = 0; m < 4; ++m) { bf16_t* rp = xb + (size_t)(row0 + ai * HALF + m * 16) * ldc + col0; float ss = 0.f;
                u32x2_ bv[2][2];
#pragma unroll
                for (int bj = 0; bj < 2; ++bj)
#pragma unroll
                    for (int n = 0; n < 2; ++n) bv[bj][n] = *(const u32x2_*)(rp + bj * HALF + n * 16);
#pragma unroll
                for (int bj = 0; bj < 2; ++bj)
#pragma unroll
                    for (int n = 0; n < 2; ++n) { const u32x2_ b = bv[bj][n]; f32x4 x = acc[ai][bj][m][n];
                        x[0] += __uint_as_float(b.x << 16); x[1] += __uint_as_float(b.x & 0xffff0000u); x[2] += __uint_as_float(b.y << 16); x[3] += __uint_as_float(b.y & 0xffff0000u);
                        u32x2_ w; w.x = cvt_pk_bf16(x[0], x[1]); w.y = cvt_pk_bf16(x[2], x[3]); *(u32x2_*)(rp + bj * HALF + n * 16) = w;
                        const float r0 = __uint_as_float(w.x << 16), r1 = __uint_as_float(w.x & 0xffff0000u), r2 = __uint_as_float(w.y << 16), r3 = __uint_as_float(w.y & 0xffff0000u);
                        ss += (r0 * r0 + r1 * r1) + (r2 * r2 + r3 * r3); }
                ss += __shfl_xor(ss, 16); ss += __shfl_xor(ss, 32);
                if (fq == 0) atomicAdd(rowss + row0 + ai * HALF + m * 16, (unsigned long long)(ss * 16777216.0f));
                asm volatile("" ::: "memory"); }
    }
};
struct EpiGlu {
    static constexpr bool PERM = true, AFTER_DRAIN = false;
    const bf16_t* Z; bf16_t* O; int ldc; const float* bias;
    __device__ __forceinline__ void operator()(const f32x4 (&acc)[2][2][4][2], const Unit& u, int wr, int wc, int fr, int fq) const {
        const int row0 = u.pm * BM + wr * 64 + fr; const int col0 = u.pn * BM + wc * 32 + 8 * fq;
        f32x4 bv[2][2];
#pragma unroll
        for (int bj = 0; bj < 2; ++bj)
#pragma unroll
            for (int n = 0; n < 2; ++n) bv[bj][n] = *(const f32x4*)(bias + col0 + bj * HALF + 4 * n);
#pragma unroll
        for (int ai = 0; ai < 2; ++ai)
#pragma unroll
            for (int m = 0; m < 4; ++m) { const size_t off = (size_t)(row0 + ai * HALF + m * 16) * ldc + col0;
#pragma unroll
                for (int bj = 0; bj < 2; ++bj) { const f32x4 v0 = acc[ai][bj][m][0] + bv[bj][0], v1 = acc[ai][bj][m][1] + bv[bj][1];
                    const u32x4 zz = *(const u32x4*)(Z + off + bj * HALF); float z[8], o[8];
                    z[0] = __uint_as_float(zz.x << 16); z[1] = __uint_as_float(zz.x & 0xffff0000u); z[2] = __uint_as_float(zz.y << 16); z[3] = __uint_as_float(zz.y & 0xffff0000u);
                    z[4] = __uint_as_float(zz.z << 16); z[5] = __uint_as_float(zz.z & 0xffff0000u); z[6] = __uint_as_float(zz.w << 16); z[7] = __uint_as_float(zz.w & 0xffff0000u);
#pragma unroll
                    for (int j = 0; j < 4; ++j) { o[j] = z[j] / (1.f + __expf(-v0[j])); o[4 + j] = z[4 + j] / (1.f + __expf(-v1[j])); }
                    u32x4 w; w.x = cvt_pk_bf16(o[0], o[1]); w.y = cvt_pk_bf16(o[2], o[3]); w.z = cvt_pk_bf16(o[4], o[5]); w.w = cvt_pk_bf16(o[6], o[7]);
                    *(u32x4*)(O + off + bj * HALF) = w; }
                asm volatile("" ::: "memory"); }
    }
};

template <class Epi, class Sched, bool ALIGN_EPI = false, bool SP2 = false>
__device__ __forceinline__ void gemm_phase(PG8_LAS unsigned char* lds, const Gemm g, const Sched& S, const Epi& E) {
    int tid_l = threadIdx.x; asm volatile("" : "+v"(tid_l));
    const int tid = tid_l, wid = __builtin_amdgcn_readfirstlane(tid >> 6), lane = tid & 63, wr = wid >> 2, wc = wid & 3, fr = lane & 15, fq = lane >> 4;
    const int K = g.K, nt = K / BK;
    unsigned voffA[2], voffB[2];
#pragma unroll
    for (int i = 0; i < 2; ++i) { int R, C; stage_rc(tid * 16 + i * 8192, R, C); const int Rb = Epi::PERM ? ((R & ~31) + perm32(R & 31)) : R;
        voffA[i] = (unsigned)(R * g.lda + C) * 2u; voffB[i] = (unsigned)(Rb * g.ldb + C) * 2u; }
    const size_t kstep = (size_t)(BK * 2);
    const size_t hstepA = (size_t)HALF * g.lda * 2, hstepB = (size_t)HALF * g.ldb * 2;
    const size_t tstepA = 2 * hstepA, tstepB = 2 * hstepB;
    const unsigned ldsw = (unsigned)wid * 1024u;
    const int aoff = lds_byte(wr * 64 + fr, fq * 8), boff = lds_byte(wc * 32 + fr, fq * 8);
#define PG8_SA(b, h) (((b) * 2 + (h)) * HTB)
#define PG8_SB(b, h) ((4 + (b) * 2 + (h)) * HTB)
#define PG8_STAGE(bufoff, gbase, voff) do { _Pragma("unroll") for (int _i = 0; _i < 2; ++_i) \
        __builtin_amdgcn_global_load_lds((const unsigned*)((const char*)(gbase) + (voff)[_i]), (PG8_LAS unsigned*)(lds + (bufoff) + ldsw + _i * 8192), 16, 0, 0); } while (0)
#define PG8_LDA(dst, b, h) do { _Pragma("unroll") for (int m = 0; m < 4; ++m) _Pragma("unroll") for (int k = 0; k < 2; ++k) dst[m][k] = *(const PG8_LAS bf16x8*)(lds + PG8_SA(b, h) + aoff + m * 2048 + k * 1024); } while (0)
#define PG8_LDB(dst, b, h) do { _Pragma("unroll") for (int n = 0; n < 2; ++n) _Pragma("unroll") for (int k = 0; k < 2; ++k) dst[n][k] = *(const PG8_LAS bf16x8*)(lds + PG8_SB(b, h) + boff + n * 2048 + k * 1024); } while (0)
#define PG8_MMA(ai, bj, At, Bt) do { __builtin_amdgcn_s_setprio(1); _Pragma("unroll") for (int m = 0; m < 4; ++m) _Pragma("unroll") for (int n = 0; n < 2; ++n) _Pragma("unroll") for (int k = 0; k < 2; ++k) \
        acc[ai][bj][m][n] = __builtin_amdgcn_mfma_f32_16x16x32_bf16(Bt[n][k], At[m][k], acc[ai][bj][m][n], 0, 0, 0); __builtin_amdgcn_s_setprio(0); } while (0)
#define PG8_WAIT_V(n) asm volatile("s_waitcnt vmcnt(" #n ")" ::: "memory")
#define PG8_WAIT_L(n) asm volatile("s_waitcnt lgkmcnt(" #n ")" ::: "memory")
#define PG8_BAR __builtin_amdgcn_s_barrier()
#define PG8_SCHED __builtin_amdgcn_sched_barrier(0)
    Unit cur, nxt; int ui = 0;
    if (!S.next(0, cur)) return;
    f32x4 acc[2][2][4][2];
#pragma unroll
    for (int a = 0; a < 2; ++a)
#pragma unroll
        for (int b = 0; b < 2; ++b)
#pragma unroll
            for (int m = 0; m < 4; ++m)
#pragma unroll
                for (int n = 0; n < 2; ++n) acc[a][b][m][n] = (f32x4){0.f, 0.f, 0.f, 0.f};
    bf16x8 At[4][2], B0[2][2], B1[2][2];
    const char* cA = (const char*)g.A + (size_t)cur.pm * tstepA; const char* cB = (const char*)g.Bt + (size_t)cur.pn * tstepB;
    S.a_ready(cur);
    if constexpr (SP2) {
        PG8_STAGE(PG8_SB(0, 0), cB, voffB); PG8_STAGE(PG8_SB(0, 1), cB + hstepB, voffB); PG8_STAGE(PG8_SA(0, 0), cA, voffA); PG8_STAGE(PG8_SA(0, 1), cA + hstepA, voffA);
        if (wr == 1) PG8_BAR;
        PG8_WAIT_V(2); PG8_BAR;
        PG8_STAGE(PG8_SB(1, 0), cB + kstep, voffB); PG8_STAGE(PG8_SA(1, 0), cA + kstep, voffA); PG8_STAGE(PG8_SB(1, 1), cB + hstepB + kstep, voffB);
        PG8_WAIT_V(6); PG8_BAR;
    } else {
        PG8_STAGE(PG8_SB(0, 0), cB, voffB); PG8_STAGE(PG8_SA(0, 0), cA, voffA); PG8_STAGE(PG8_SB(0, 1), cB + hstepB, voffB); PG8_STAGE(PG8_SA(0, 1), cA + hstepA, voffA);
        if (wr == 1) PG8_BAR;
        PG8_WAIT_V(4); PG8_BAR;
        PG8_STAGE(PG8_SB(1, 0), cB + kstep, voffB); PG8_STAGE(PG8_SA(1, 0), cA + kstep, voffA); PG8_STAGE(PG8_SB(1, 1), cB + hstepB + kstep, voffB);
        PG8_WAIT_V(6); PG8_BAR;
    }
    for (;;) {
        const bool has_next = S.next(ui + 1, nxt);
        const char* nA = has_next ? (const char*)g.A + (size_t)nxt.pm * tstepA : cA; const char* nB = has_next ? (const char*)g.Bt + (size_t)nxt.pn * tstepB : cB;
        for (int t = 0; t < nt; t += 2) {
            const bool last = (t == nt - 2);
            const char* a1 = cA + (size_t)(t + 1) * kstep;
            const char* a2 = last ? nA : cA + (size_t)(t + 2) * kstep; const char* b2 = last ? nB : cB + (size_t)(t + 2) * kstep;
            const char* a3 = a2 + kstep; const char* b3 = b2 + kstep;
            if (last && has_next) S.a_ready(nxt);
            if constexpr (SP2) {
            PG8_LDB(B0, 0, 0); PG8_LDB(B1, 0, 1); PG8_SCHED; PG8_LDA(At, 0, 0); PG8_STAGE(PG8_SA(1, 1), a1 + hstepA, voffA);
            PG8_WAIT_V(8); PG8_WAIT_L(0); PG8_BAR; PG8_MMA(0, 0, At, B0); PG8_MMA(0, 1, At, B1); PG8_BAR; PG8_SCHED;
            PG8_LDA(At, 0, 1); PG8_STAGE(PG8_SB(0, 0), b2, voffB); PG8_STAGE(PG8_SB(0, 1), b2 + hstepB, voffB); PG8_STAGE(PG8_SA(0, 0), a2, voffA);
            PG8_WAIT_V(8); PG8_WAIT_L(0); PG8_BAR; PG8_MMA(1, 0, At, B0); PG8_MMA(1, 1, At, B1); PG8_BAR; PG8_SCHED;
            PG8_LDB(B0, 1, 0); PG8_LDB(B1, 1, 1); PG8_SCHED; PG8_LDA(At, 1, 0); PG8_STAGE(PG8_SA(0, 1), a2 + hstepA, voffA);
            PG8_WAIT_V(8); PG8_WAIT_L(0); PG8_BAR; PG8_MMA(0, 0, At, B0); PG8_MMA(0, 1, At, B1); PG8_BAR; PG8_SCHED;
            PG8_LDA(At, 1, 1); PG8_STAGE(PG8_SB(1, 0), b3, voffB); PG8_STAGE(PG8_SB(1, 1), b3 + hstepB, voffB); PG8_STAGE(PG8_SA(1, 0), a3, voffA);
            PG8_WAIT_V(8); PG8_WAIT_L(0); PG8_BAR; PG8_MMA(1, 0, At, B0); PG8_MMA(1, 1, At, B1); PG8_BAR; PG8_SCHED;
            } else {
            PG8_LDB(B0, 0, 0); PG8_SCHED; PG8_LDA(At, 0, 0); PG8_STAGE(PG8_SA(1, 1), a1 + hstepA, voffA);
            PG8_WAIT_L(8); PG8_BAR; PG8_WAIT_L(0); PG8_MMA(0, 0, At, B0); PG8_BAR; PG8_SCHED;
            PG8_LDB(B1, 0, 1); PG8_STAGE(PG8_SB(0, 0), b2, voffB);
            PG8_BAR; PG8_WAIT_L(0); PG8_MMA(0, 1, At, B1); PG8_BAR;
            PG8_LDA(At, 0, 1); PG8_STAGE(PG8_SA(0, 0), a2, voffA);
            PG8_BAR; PG8_WAIT_L(0); PG8_MMA(1, 0, At, B0); PG8_BAR; PG8_SCHED;
            PG8_STAGE(PG8_SB(0, 1), b2 + hstepB, voffB);
            PG8_WAIT_V(6); PG8_BAR; PG8_MMA(1, 1, At, B1); PG8_BAR;
            PG8_LDB(B0, 1, 0); PG8_SCHED; PG8_LDA(At, 1, 0); PG8_STAGE(PG8_SA(0, 1), a2 + hstepA, voffA);
            PG8_WAIT_L(8); PG8_BAR; PG8_WAIT_L(0); PG8_MMA(0, 0, At, B0); PG8_BAR; PG8_SCHED;
            PG8_LDB(B1, 1, 1); PG8_STAGE(PG8_SB(1, 0), b3, voffB);
            PG8_BAR; PG8_WAIT_L(0); PG8_MMA(0, 1, At, B1); PG8_BAR;
            PG8_LDA(At, 1, 1); PG8_STAGE(PG8_SA(1, 0), a3, voffA);
            PG8_BAR; PG8_WAIT_L(0); PG8_MMA(1, 0, At, B0); PG8_BAR; PG8_SCHED;
            PG8_STAGE(PG8_SB(1, 1), b3 + hstepB, voffB);
            PG8_WAIT_V(6); PG8_BAR; PG8_MMA(1, 1, At, B1); PG8_BAR;
            }
        }
        if constexpr (ALIGN_EPI) { if (wr == 0) PG8_BAR; }
        E(acc, cur, wr, wc, fr, fq); S.done(cur);
        if (!has_next) break;
#pragma unroll
        for (int a = 0; a < 2; ++a)
#pragma unroll
            for (int b = 0; b < 2; ++b)
#pragma unroll
                for (int m = 0; m < 4; ++m)
#pragma unroll
                    for (int n = 0; n < 2; ++n) acc[a][b][m][n] = (f32x4){0.f, 0.f, 0.f, 0.f};
        cur = nxt; cA = nA; cB = nB; ++ui;
        if constexpr (ALIGN_EPI) { if (wr == 1) PG8_BAR; }
    }
    PG8_WAIT_V(0);
    if constexpr (!ALIGN_EPI) { if (wr == 0) PG8_BAR; }
    PG8_BAR;
#undef PG8_SA
#undef PG8_SB
#undef PG8_STAGE
#undef PG8_LDA
#undef PG8_LDB
#undef PG8_MMA
#undef PG8_WAIT_V
#undef PG8_WAIT_L
#undef PG8_BAR
#undef PG8_SCHED
}
}
#define XB_TMO      128
#define XB_XCNT(j)  (256  + 64 * (j))
#define XB_XSUB(j)  (1280 + 64 * (j))
#define XB_XGEN(j)  (2304 + 64 * (j))
#define XB_TOP      3328
#define XB_TOPGEN   3392
#define XCD_BAR_WORDS 3456
#define XB_SPIN_CAP (1u << 18)
__device__ __forceinline__ unsigned xb_ld(unsigned* p)              { return __hip_atomic_load(p, __ATOMIC_RELAXED, __HIP_MEMORY_SCOPE_AGENT); }
__device__ __forceinline__ unsigned xb_add(unsigned* p, unsigned v) { return __hip_atomic_fetch_add(p, v, __ATOMIC_RELAXED, __HIP_MEMORY_SCOPE_AGENT); }
__device__ __forceinline__ unsigned xb_xcc_id() { return (unsigned)__builtin_amdgcn_s_getreg((3 << 11) | 20) & 0xFu; }
#define XB_SPIN(cond, bar) do { unsigned _sp = 0; while (cond) { __builtin_amdgcn_s_sleep(1); \
    if ((++_sp & 255u) == 0u) { if (xb_ld(&(bar)[XB_TMO])) break; if (_sp > XB_SPIN_CAP) { atomicAdd(&(bar)[XB_TMO], 1u); break; } } } } while (0)
struct XcdBarrier { unsigned* bar; unsigned x; volatile LAS unsigned* st; unsigned G; };
__device__ __forceinline__ XcdBarrier xcd_barrier_post(unsigned* bar, volatile LAS unsigned* st, unsigned G) {
    XcdBarrier b; b.bar = bar; b.x = xb_xcc_id(); b.st = st; b.G = G;
    if (threadIdx.x == 0) (void)xb_add(&bar[XB_XCNT(b.x)], 1u);
    return b;
}
__device__ __forceinline__ void xcd_barrier_complete(unsigned* bar, unsigned x, unsigned G, unsigned& nloc, unsigned& nx) {
    unsigned sum, cnt, mine, sp = 0u;
    for (;;) {
        sum = 0u; cnt = 0u; mine = 0u;
#pragma unroll
        for (unsigned j = 0; j < 16; ++j) { const unsigned c = xb_ld(&bar[XB_XCNT(j)]); sum += c; cnt += (c > 0u) ? 1u : 0u; mine = (j == x) ? c : mine; }
        if (sum == G) break;
        __builtin_amdgcn_s_sleep(1);
        if ((++sp & 255u) == 0u) { if (xb_ld(&bar[XB_TMO])) break; if (sp > XB_SPIN_CAP) { atomicAdd(&bar[XB_TMO], 1u); break; } }
    }
    nloc = mine > 0u ? mine : 1u; nx = cnt > 0u ? cnt : 1u;
}
__device__ __forceinline__ void xcd_barrier(const XcdBarrier& b) {
    asm volatile("s_waitcnt vmcnt(0)" ::: "memory");
    __syncthreads();
    if (threadIdx.x == 0) {
        unsigned* bar = b.bar;
        __builtin_amdgcn_s_waitcnt(0);
        unsigned nloc = b.st[0], nx = b.st[1];
        if (nloc == 0u) { xcd_barrier_complete(bar, b.x, b.G, nloc, nx); b.st[0] = nloc; b.st[1] = nx; }
        const unsigned old = xb_add(&bar[XB_XSUB(b.x)], 1u);
        const unsigned gen = old / nloc;
        if (old + 1u == (gen + 1u) * nloc) {
            __builtin_amdgcn_fence(__ATOMIC_RELEASE, "agent");
            asm volatile("s_waitcnt vmcnt(0)" ::: "memory");
            const unsigned og = xb_add(&bar[XB_TOP], 1u);
            const unsigned tg = og / nx;
            if (og + 1u == (tg + 1u) * nx) xb_add(&bar[XB_TOPGEN], 1u);
            else XB_SPIN(xb_ld(&bar[XB_TOPGEN]) == tg, bar);
            __builtin_amdgcn_fence(__ATOMIC_ACQUIRE, "agent");
            xb_add(&bar[XB_XGEN(b.x)], 1u);
            asm volatile("s_waitcnt vmcnt(0)" ::: "memory");
        } else {
            XB_SPIN(xb_ld(&bar[XB_XGEN(b.x)]) == gen, bar);
            __builtin_amdgcn_fence(__ATOMIC_ACQUIRE, "agent");
            asm volatile("s_waitcnt vmcnt(0)" ::: "memory");
        }
    }
    __syncthreads();
}

constexpr int NWAVES = 8, NTHR = 512;
constexpr int LDS_BYTES = 155648;
constexpr int MISC_OFF = LDS_BYTES - 256;
struct Ctx { unsigned char* lds; int tid, lane, wave, gw, ngw, bid, nb; };

__device__ __forceinline__ void tr_item(const float* __restrict__ W, int ldw, int N, bf16* __restrict__ WT, int ldt, int row_off, int col_off, int kb, int nb, float* scr, int lane, const float* __restrict__ gk) {
    const int k0 = 64 * kb, n0 = 32 * nb; const int n = n0 + (lane & 31);
    float v[32];
    const float* wp = W + (size_t)(k0 + (lane >> 5)) * ldw + (n < N ? n : 0);
#pragma unroll
    for (int i = 0; i < 32; ++i) v[i] = wp[(size_t)(2 * i) * ldw];
    if (gk) {
#pragma unroll
        for (int i = 0; i < 32; ++i) v[i] *= gk[k0 + 2 * i + (lane >> 5)];
    }
#pragma unroll
    for (int i = 0; i < 32; ++i) { const int kk = 2 * i + (lane >> 5); scr[kk * 33 + (lane & 31)] = (n < N) ? v[i] : 0.f; }
    __builtin_amdgcn_fence(__ATOMIC_RELEASE, "wavefront"); __builtin_amdgcn_wave_barrier(); __builtin_amdgcn_fence(__ATOMIC_ACQUIRE, "wavefront");
    const int c = lane & 7;
#pragma unroll
    for (int j = 0; j < 4; ++j) { const int nn = (lane >> 3) + 8 * j; const float* s = scr + (8 * c) * 33 + nn;
        u32x4 o; o.x = pk2(s[0 * 33], s[1 * 33]); o.y = pk2(s[2 * 33], s[3 * 33]); o.z = pk2(s[4 * 33], s[5 * 33]); o.w = pk2(s[6 * 33], s[7 * 33]);
        *(u32x4*)(WT + (size_t)(row_off + n0 + nn) * ldt + col_off + k0 + 8 * c) = o; }
    __builtin_amdgcn_fence(__ATOMIC_RELEASE, "wavefront"); __builtin_amdgcn_wave_barrier(); __builtin_amdgcn_fence(__ATOMIC_ACQUIRE, "wavefront");
}
__device__ __forceinline__ void conv_mat(const Ctx& c, const float* W, int K, int ldw, int N, int Npad, bf16* WT, int ldt, int row_off, int col_off, const float* gk = nullptr) {
    float* scr = (float*)(c.lds + c.wave * 8704);
    const int nblk = Npad / 32, nit = (K / 64) * nblk;
    for (int it = c.gw; it < nit; it += c.ngw) tr_item(W, ldw, N, WT, ldt, row_off, col_off, it / nblk, it % nblk, scr, c.lane, gk);
}

__device__ __forceinline__ void norm_rows_bf16(const Ctx& c, const float* __restrict__ X, const float* __restrict__ g, bf16* __restrict__ O, int nrows) {
    f32x4 gv[8];
#pragma unroll
    for (int j = 0; j < 8; ++j) gv[j] = *(const f32x4*)(g + 4 * c.lane + 256 * j);
    for (int m = c.gw; m < nrows; m += c.ngw) {
        const f32x4* xr = (const f32x4*)(X + (size_t)m * D) + c.lane; f32x4 v[8]; float s = 0.f;
#pragma unroll
        for (int j = 0; j < 8; ++j) { v[j] = xr[64 * j]; s += (v[j].x * v[j].x + v[j].y * v[j].y) + (v[j].z * v[j].z + v[j].w * v[j].w); }
        const float rstd = 1.0f / sqrtf(wave_sum(s) * (1.f / D) + NORM_EPS);
        u32x2* o8 = (u32x2*)(O + (size_t)m * D) + c.lane;
#pragma unroll
        for (int j = 0; j < 8; ++j) { u32x2 w; w.x = pk2(v[j].x * rstd * gv[j].x, v[j].y * rstd * gv[j].y); w.y = pk2(v[j].z * rstd * gv[j].z, v[j].w * rstd * gv[j].w); o8[64 * j] = w; }
    }
}
__device__ __forceinline__ void cast_rows_ss(const Ctx& c, const float* __restrict__ X, bf16* __restrict__ O, unsigned long long* rowss, int nrows) {
    for (int m = c.gw; m < nrows; m += c.ngw) {
        const f32x4* xr = (const f32x4*)(X + (size_t)m * D) + c.lane; f32x4 v[8]; float s = 0.f;
#pragma unroll
        for (int j = 0; j < 8; ++j) { v[j] = xr[64 * j]; s += (v[j].x * v[j].x + v[j].y * v[j].y) + (v[j].z * v[j].z + v[j].w * v[j].w); }
        s = wave_sum(s);
        u32x2* o8 = (u32x2*)(O + (size_t)m * D) + c.lane;
#pragma unroll
        for (int j = 0; j < 8; ++j) { u32x2 w; w.x = pk2(v[j].x, v[j].y); w.y = pk2(v[j].z, v[j].w); o8[64 * j] = w; }
        if (c.lane == 0) rowss[m] = (unsigned long long)(s * 16777216.0f);
    }
}
__device__ __forceinline__ void scale_rows_out(const Ctx& c, const bf16* __restrict__ XB, const float* __restrict__ g, const unsigned long long* rowss, float* O, int nrows) {
    for (int m = c.gw; m < nrows; m += c.ngw) {
        const float rstd = 1.0f / sqrtf((float)rowss[m] * (5.9604644775390625e-08f / D) + NORM_EPS);
#pragma unroll
        for (int j = 0; j < 4; ++j) { float x[8]; unpack8(*(const u32x4*)(XB + (size_t)m * D + 8 * c.lane + 512 * j), x);
            const f32x4 g0 = *(const f32x4*)(g + 8 * c.lane + 512 * j), g1 = *(const f32x4*)(g + 8 * c.lane + 512 * j + 4);
            *(f32x4*)(O + (size_t)m * D + 8 * c.lane + 512 * j) = (f32x4){x[0] * rstd * g0.x, x[1] * rstd * g0.y, x[2] * rstd * g0.z, x[3] * rstd * g0.w};
            *(f32x4*)(O + (size_t)m * D + 8 * c.lane + 512 * j + 4) = (f32x4){x[4] * rstd * g1.x, x[5] * rstd * g1.y, x[6] * rstd * g1.z, x[7] * rstd * g1.w}; }
    }
}
__device__ __forceinline__ void norm_rows_f32(const Ctx& c, float* X, const float* __restrict__ g, int nrows) {
    f32x4 gv[8];
#pragma unroll
    for (int j = 0; j < 8; ++j) gv[j] = *(const f32x4*)(g + 4 * c.lane + 256 * j);
    for (int m = c.gw; m < nrows; m += c.ngw) {
        f32x4* xr = (f32x4*)(X + (size_t)m * D) + c.lane; f32x4 v[8]; float s = 0.f;
#pragma unroll
        for (int j = 0; j < 8; ++j) { v[j] = xr[64 * j]; s += (v[j].x * v[j].x + v[j].y * v[j].y) + (v[j].z * v[j].z + v[j].w * v[j].w); }
        const float rstd = 1.0f / sqrtf(wave_sum(s) * (1.f / D) + NORM_EPS);
#pragma unroll
        for (int j = 0; j < 8; ++j) xr[64 * j] = v[j] * rstd * gv[j];
    }
}

__device__ __forceinline__ void rope_tables(const Ctx& c, const int* __restrict__ start_frame, float* ropea, float* ropei) {
    const float HA[16] = {1.000000000e+00f, 4.403665960e-01f, 1.939227432e-01f, 8.539710194e-02f, 3.760603070e-02f, 1.656044088e-02f, 7.292664610e-03f, 3.211446106e-03f, 1.414213562e-03f, 6.227724371e-04f, 2.742481884e-04f, 1.207697351e-04f, 5.318295734e-05f, 2.341999971e-05f, 1.031338525e-05f, 4.541670478e-06f};
    const float LA[16] = {0.000000000e+00f, 6.688275267e-09f, 1.547429962e-09f, -1.652958881e-09f, 2.282729838e-10f, -8.020459852e-10f, 1.273676581e-10f, -1.116812753e-10f, -1.115275407e-14f, -1.514006802e-11f, -1.268531807e-11f, 2.335000249e-12f, 1.624761415e-12f, -7.452659366e-13f, 1.309491117e-13f, 2.687890499e-15f};
    const float HI[8] = {1.000000000e+00f, 1.939227432e-01f, 3.760603070e-02f, 7.292664610e-03f, 1.414213562e-03f, 2.742481884e-04f, 5.318295734e-05f, 1.031338525e-05f};
    const float LI[8] = {0.000000000e+00f, 1.547429962e-09f, 2.282729838e-10f, 1.273676581e-10f, -1.115275407e-14f, -1.268531807e-11f, 1.624761415e-12f, 1.309491117e-13f};
    const int gt = c.bid * NTHR + c.tid, ngt = c.nb * NTHR;
    for (int i = gt; i < M * 24; i += ngt) {
        const int m = i / 24, j = i % 24; const int b = m / SEQ, t = m % SEQ;
        const float pos = (float)(start_frame[b] + t);
        float hi = 0.f, lo = 0.f;
#pragma unroll
        for (int q = 0; q < 16; ++q) if (j == q) { hi = HA[q]; lo = LA[q]; }
#pragma unroll
        for (int q = 0; q < 8; ++q) if (j == 16 + q) { hi = HI[q]; lo = LI[q]; }
        const float p = pos * hi, e = fmaf(pos, hi, -p) + pos * lo;
        float sn, cs; sincosf(p, &sn, &cs);
        const float cc = cs - e * sn, ss = sn + e * cs;
        if (j < 16) { ropea[(size_t)m * 32 + j] = cc; ropea[(size_t)m * 32 + 16 + j] = ss; }
        else { ropei[(size_t)m * 16 + (j - 16)] = cc; ropei[(size_t)m * 16 + 8 + (j - 16)] = ss; }
    }
}

__device__ __forceinline__ void build_wql(const Ctx& c, const float* __restrict__ w_uq, const float* __restrict__ w_uk, bf16* WQ) {
    const int gt = c.bid * NTHR + c.tid, ngt = c.nb * NTHR;
    for (int i = gt; i < 2048 * 512; i += ngt) {
        const int cc = i & 511, hr = i >> 9, h = hr >> 8, r = hr & 255;
        const float* a = w_uq + (size_t)cc * 1024 + h * 128 + 32; const float* b = w_uk + (size_t)r * 768 + h * 96; float s = 0.f;
#pragma unroll 8
        for (int d = 0; d < 96; ++d) s += a[d] * b[d];
        WQ[i] = (bf16)f2bf(s);
    }
}
__device__ __forceinline__ void build_wout(const Ctx& c, const float* __restrict__ w_uv, const float* __restrict__ w_out, bf16* WO) {
    const int gt = c.bid * NTHR + c.tid, ngt = c.nb * NTHR;
    for (int i = gt; i < 8 * 32 * 2048; i += ngt) {
        const int n = i & 2047, rg = (i >> 11) & 31, h = i >> 16; float acc[8];
#pragma unroll
        for (int j = 0; j < 8; ++j) acc[j] = 0.f;
        for (int d = 0; d < 128; ++d) { const float wo = w_out[(size_t)(h * 128 + d) * 2048 + n];
#pragma unroll
            for (int j = 0; j < 8; ++j) acc[j] += w_uv[(size_t)(rg * 8 + j) * 1024 + h * 128 + d] * wo; }
        u32x4 o; o.x = pk2(acc[0], acc[1]); o.y = pk2(acc[2], acc[3]); o.z = pk2(acc[4], acc[5]); o.w = pk2(acc[6], acc[7]);
        *(u32x4*)(WO + (size_t)n * OC + h * 256 + rg * 8) = o;
    }
}

__device__ __forceinline__ void dsa_prep(const Ctx& c, const bf16* __restrict__ H, const float* __restrict__ cqn_g, const float* __restrict__ ckv_g, const float* __restrict__ kidx_g,
                                         const float* __restrict__ ropea, const float* __restrict__ ropei, bf16* CQN, bf16* KF, bf16* KIDX, float* WIDX) {
    const int l = c.lane;
    for (int m = c.gw; m < M; m += c.ngw) {
        const bf16* h = H + (size_t)m * HC;
        {
            float f[8]; unpack8(*(const u32x4*)(h + 8 * l), f); float s = 0.f;
#pragma unroll
            for (int j = 0; j < 8; ++j) s += f[j] * f[j];
            const float rstd = 1.0f / sqrtf(wave_sum(s) * (1.f / 512.f) + NORM_EPS);
            u32x4 o; o.x = pk2(f[0] * rstd * cqn_g[8 * l + 0], f[1] * rstd * cqn_g[8 * l + 1]); o.y = pk2(f[2] * rstd * cqn_g[8 * l + 2], f[3] * rstd * cqn_g[8 * l + 3]);
            o.z = pk2(f[4] * rstd * cqn_g[8 * l + 4], f[5] * rstd * cqn_g[8 * l + 5]); o.w = pk2(f[6] * rstd * cqn_g[8 * l + 6], f[7] * rstd * cqn_g[8 * l + 7]);
            *(u32x4*)(CQN + (size_t)m * 512 + 8 * l) = o;
        }
        {
            const u32x2 w = *(const u32x2*)(h + 512 + 4 * l); const float f0 = bf2f(w.x & 0xffffu), f1 = bf2f(w.x >> 16), f2 = bf2f(w.y & 0xffffu), f3 = bf2f(w.y >> 16);
            const float s = (f0 * f0 + f1 * f1) + (f2 * f2 + f3 * f3);
            const float rstd = 1.0f / sqrtf(wave_sum(s) * (1.f / 256.f) + NORM_EPS);
            u32x2 o; o.x = pk2(f0 * rstd * ckv_g[4 * l + 0], f1 * rstd * ckv_g[4 * l + 1]); o.y = pk2(f2 * rstd * ckv_g[4 * l + 2], f3 * rstd * ckv_g[4 * l + 3]);
            *(u32x2*)(KF + (size_t)m * KFW + 4 * l) = o;
        }
        if (l < 16) {
            const float x1 = bf2f(h[768 + l]), x2 = bf2f(h[768 + 16 + l]); const float cs = ropea[(size_t)m * 32 + l], sn = ropea[(size_t)m * 32 + 16 + l];
            KF[(size_t)m * KFW + 256 + l] = (bf16)f2bf(x1 * cs - x2 * sn); KF[(size_t)m * KFW + 256 + 16 + l] = (bf16)f2bf(x2 * cs + x1 * sn);
        }
        {
            const float v = bf2f(h[800 + l]); const float rstd = 1.0f / sqrtf(wave_sum(v * v) * (1.f / 64.f) + NORM_EPS);
            const float y = v * rstd * kidx_g[l];
            const float ylo = __shfl(y, l & 7), yhi = __shfl(y, (l & 7) + 8);
            float o = y;
            if (l < 16) { const float cs = ropei[(size_t)m * 16 + (l & 7)], sn = ropei[(size_t)m * 16 + 8 + (l & 7)]; o = (l < 8) ? (ylo * cs - yhi * sn) : (yhi * cs + ylo * sn); }
            KIDX[(size_t)m * 64 + l] = (bf16)f2bf(o);
        }
        if (l < 16) WIDX[(size_t)m * 16 + l] = bf2f(h[864 + l]) * 0.03125f;
    }
}
__device__ __forceinline__ void q_rope_fix(const Ctx& c, bf16* QALL, const float* __restrict__ ropea, const float* __restrict__ ropei) {
    const int l = c.lane;
    for (int m = c.gw; m < M; m += c.ngw) {
        bf16* q = QALL + (size_t)m * QC;
#pragma unroll
        for (int i = 0; i < 2; ++i) { const int p = l + 64 * i, hh = p >> 4, j = p & 15; bf16* a = q + 2048 + hh * 32 + j;
            const float x1 = bf2f(a[0]), x2 = bf2f(a[16]); const float cs = ropea[(size_t)m * 32 + j], sn = ropea[(size_t)m * 32 + 16 + j];
            a[0] = (bf16)f2bf(x1 * cs - x2 * sn); a[16] = (bf16)f2bf(x2 * cs + x1 * sn); }
#pragma unroll
        for (int i = 0; i < 2; ++i) { const int p = l + 64 * i, hh = p >> 3, j = p & 7; bf16* a = q + 2304 + hh * 64 + j;
            const float x1 = bf2f(a[0]), x2 = bf2f(a[8]); const float cs = ropei[(size_t)m * 16 + j], sn = ropei[(size_t)m * 16 + 8 + j];
            a[0] = (bf16)f2bf(x1 * cs - x2 * sn); a[8] = (bf16)f2bf(x2 * cs + x1 * sn); }
    }
}
__device__ __forceinline__ size_t sc_row_off(int b, int t) { const int ch = t >> 6; return (size_t)b * SC_PER_BATCH + (size_t)4096 * (ch * (ch + 1) / 2) + (size_t)(t & 63) * (64 * (ch + 1)); }
__device__ __forceinline__ void idx_scores_simple(const Ctx& c, const bf16* __restrict__ QALL, const bf16* __restrict__ KIDX, const float* __restrict__ WIDX, float* SC) {
    float* qs = (float*)c.lds;
    float* ws = qs + 1024;
    for (int m = c.bid; m < M; m += c.nb) {
        const int b = m / SEQ, t = m % SEQ, limit = ((t >> 6) + 1) * 64;
        __syncthreads();
        for (int i = c.tid; i < 1024; i += NTHR) qs[i] = bf2f(QALL[(size_t)m * QC + 2304 + i]);
        if (c.tid < 16) ws[c.tid] = WIDX[(size_t)m * 16 + c.tid];
        __syncthreads();
        if (limit <= 256) continue;
        float* row = SC + sc_row_off(b, t);
        for (int s = c.tid; s < limit; s += NTHR) {
            float k[64]; const u32x4* kp = (const u32x4*)(KIDX + (size_t)(b * SEQ + s) * 64);
#pragma unroll
            for (int j = 0; j < 8; ++j) unpack8(kp[j], k + 8 * j);
            float sc = 0.f;
#pragma unroll 1
            for (int h = 0; h < 16; ++h) { asm volatile("" ::: "memory"); float d = 0.f; const f32x4* q4 = (const f32x4*)(qs + h * 64);
#pragma unroll
                for (int j = 0; j < 16; ++j) { const f32x4 q = q4[j]; d += (q.x * k[4 * j] + q.y * k[4 * j + 1]) + (q.z * k[4 * j + 2] + q.w * k[4 * j + 3]); }
                sc += ws[h] * fmaxf(d, 0.f); }
            row[s] = sc;
        }
    }
}
__device__ __forceinline__ void select_row(const float* row, int limit, unsigned short* sel, int l_in, unsigned short* stg = nullptr) {
    int l = l_in; asm volatile("" : "+v"(l));
    const int ng = limit >> 9;
    unsigned key[64];
#pragma unroll
    for (int jg = 0; jg < 8; ++jg) {
        if (jg <= ng) {
#pragma unroll
            for (int j = 8 * jg; j < 8 * jg + 8; ++j) { const int s = j * 64 + l; key[j] = __float_as_uint(row[s < limit ? s : 0]); }
        } else {
#pragma unroll
            for (int j = 8 * jg; j < 8 * jg + 8; ++j) key[j] = 0u;
        }
    }
#pragma unroll
    for (int j = 0; j < 64; ++j) { const int s = j * 64 + l; unsigned u = key[j]; u = (u & 0x80000000u) ? ~u : (u | 0x80000000u); key[j] = (s < limit) ? u : 0u; }
    unsigned mx = 0u;
#pragma unroll
    for (int j = 0; j < 64; ++j) mx = key[j] > mx ? key[j] : mx;
#pragma unroll
    for (int o = 1; o < 64; o <<= 1) { const unsigned t = (unsigned)__shfl_xor((int)mx, o); mx = t > mx ? t : mx; }
    mx = (unsigned)__builtin_amdgcn_readfirstlane((int)mx);
    auto wave_count = [&](int v) -> int {
        v += __builtin_amdgcn_update_dpp(0, v, 0xB1, 0xf, 0xf, true); v += __builtin_amdgcn_update_dpp(0, v, 0x4E, 0xf, 0xf, true);
        v += __builtin_amdgcn_update_dpp(0, v, 0x141, 0xf, 0xf, true); v += __builtin_amdgcn_update_dpp(0, v, 0x140, 0xf, 0xf, true);
        return __builtin_amdgcn_readlane(v, 0) + __builtin_amdgcn_readlane(v, 16) + __builtin_amdgcn_readlane(v, 32) + __builtin_amdgcn_readlane(v, 48); };
    unsigned T = 0u;
#pragma unroll 1
    for (int bit = 31 - __builtin_clz(mx | 1u); bit >= 0; --bit) {
        const unsigned Tn = T | (1u << bit); int cl = 0;
#pragma unroll
        for (int jg = 0; jg < 8; ++jg) if (jg <= ng) {
#pragma unroll
            for (int j = 8 * jg; j < 8 * jg + 8; ++j) cl += (key[j] >= Tn) ? 1 : 0; }
        const int cnt = wave_count(cl);
        if (cnt >= 256) T = Tn;
        if (cnt == 256) break;
    }
    int cgl = 0;
#pragma unroll
    for (int j = 0; j < 64; ++j) cgl += (key[j] > T) ? 1 : 0;
    const int cgt = wave_count(cgl);
    const int need_eq = 256 - cgt;
    int base = 0, beq = 0;
    const unsigned long long lt = (1ull << l) - 1ull;
    if (stg) {
#pragma unroll
        for (int jg = 0; jg < 8; ++jg) if (jg <= ng) {
#pragma unroll
            for (int j = 8 * jg; j < 8 * jg + 8; ++j) {
                const unsigned long long mg = __ballot(key[j] > T);
                const int pos = base + (int)__builtin_amdgcn_mbcnt_hi((unsigned)(mg >> 32), __builtin_amdgcn_mbcnt_lo((unsigned)mg, 0u));
                if (key[j] > T) stg[pos] = (unsigned short)(j * 64 + l);
                base += __popcll(mg);
                const unsigned long long me = __ballot(key[j] == T);
                if (me != 0ull) {
                    const int pe = beq + (int)__builtin_amdgcn_mbcnt_hi((unsigned)(me >> 32), __builtin_amdgcn_mbcnt_lo((unsigned)me, 0u));
                    if (key[j] == T && pe < need_eq) stg[cgt + pe] = (unsigned short)(j * 64 + l);
                    beq += __popcll(me);
                }
            }
        }
        __builtin_amdgcn_fence(__ATOMIC_RELEASE, "wavefront"); __builtin_amdgcn_wave_barrier(); __builtin_amdgcn_fence(__ATOMIC_ACQUIRE, "wavefront");
        *(u32x2*)(sel + 4 * l) = *(const u32x2*)(stg + 4 * l);
        __builtin_amdgcn_fence(__ATOMIC_RELEASE, "wavefront"); __builtin_amdgcn_wave_barrier(); __builtin_amdgcn_fence(__ATOMIC_ACQUIRE, "wavefront");
        return;
    }
#pragma unroll
    for (int jg = 0; jg < 8; ++jg) if (jg <= ng) {
#pragma unroll
        for (int j = 8 * jg; j < 8 * jg + 8; ++j) {
            const unsigned long long mg = __ballot(key[j] > T), me = __ballot(key[j] == T);
            if (key[j] > T) sel[base + __popcll(mg & lt)] = (unsigned short)(j * 64 + l);
            base += __popcll(mg);
            const int pe = beq + __popcll(me & lt);
            if (key[j] == T && pe < need_eq) sel[cgt + pe] = (unsigned short)(j * 64 + l);
            beq += __popcll(me);
        }
    }
}
__device__ __forceinline__ void bs_transpose32(unsigned (&A)[32]) {
    unsigned m = 0x0000FFFFu;
#pragma unroll
    for (int j = 16; j != 0; j >>= 1) {
#pragma unroll
        for (int k = 0; k < 32; ++k) {
            if ((k & j) == 0) {
                const unsigned t = (A[k] ^ (A[k + j] >> j)) & m;
                A[k] ^= t; A[k + j] ^= (t << j);
            }
        }
        m ^= (m << (j >> 1));
    }
}
__device__ __forceinline__ void select_row_bs(const float* row, int limit, unsigned short* sel, int l_in, unsigned short* stg) {
    int l = l_in; asm volatile("" : "+v"(l));
    const int nsl = limit >> 6;
    const int ng = limit >> 9;
    unsigned lo[32], hi[32];
#pragma unroll
    for (int jg = 0; jg < 8; ++jg) {
        if (jg <= ng) {
#pragma unroll
            for (int j = 8 * jg; j < 8 * jg + 8; ++j) { const int s = j * 64 + l; const unsigned u = __float_as_uint(row[s < limit ? s : 0]);
                if (j < 32) lo[j & 31] = u; else hi[j & 31] = u; }
        } else {
#pragma unroll
            for (int j = 8 * jg; j < 8 * jg + 8; ++j) { if (j < 32) lo[j & 31] = 0u; else hi[j & 31] = 0u; }
        }
    }
    asm volatile("" ::: "memory");
#pragma unroll
    for (int j = 0; j < 64; ++j) { const unsigned u = (j < 32) ? lo[j & 31] : hi[j & 31];
        const unsigned kx = (j < nsl) ? ((u & 0x80000000u) ? ~u : (u | 0x80000000u)) : 0u;
        if (j < 32) lo[j & 31] = kx; else hi[j & 31] = kx; }
    const bool has_hi = nsl > 32;
    bs_transpose32(lo);
    if (has_hi) bs_transpose32(hi);
    auto wave_count = [&](int v) -> int {
        v += __builtin_amdgcn_update_dpp(0, v, 0xB1, 0xf, 0xf, true); v += __builtin_amdgcn_update_dpp(0, v, 0x4E, 0xf, 0xf, true);
        v += __builtin_amdgcn_update_dpp(0, v, 0x141, 0xf, 0xf, true); v += __builtin_amdgcn_update_dpp(0, v, 0x140, 0xf, 0xf, true);
        return __builtin_amdgcn_readlane(v, 0) + __builtin_amdgcn_readlane(v, 16) + __builtin_amdgcn_readlane(v, 32) + __builtin_amdgcn_readlane(v, 48); };
    unsigned clo = 0xffffffffu, chi = has_hi ? 0xffffffffu : 0u, glo = 0u, ghi = 0u;
    int G = 0;
#pragma unroll
    for (int i = 0; i < 32; ++i) {
        const unsigned olo = clo & lo[i], ohi = chi & hi[i];
        const int tot = G + wave_count(__builtin_popcount(olo) + __builtin_popcount(ohi));
        const bool take = tot >= 256;
        const unsigned mt = take ? 0u : 0xffffffffu;
        G = take ? G : tot;
        glo |= olo & mt; ghi |= ohi & mt;
        clo = olo ^ (clo & mt); chi = ohi ^ (chi & mt);
        if (tot == 256) break;
    }
    {
        const int need = 256 - G;
        const int ceq = wave_count(__builtin_popcount(clo) + __builtin_popcount(chi));
        if (ceq == need) { glo |= clo; ghi |= chi; }
        else {
            int beq = 0;
#pragma unroll 1
            for (int k = 0; k < 64; ++k) {
                const unsigned bm = 0x80000000u >> (k & 31);
                const bool mine = ((k < 32 ? clo : chi) & bm) != 0u;
                const unsigned long long me = __ballot(mine);
                if (me != 0ull) {
                    const int pe = beq + (int)__builtin_amdgcn_mbcnt_hi((unsigned)(me >> 32), __builtin_amdgcn_mbcnt_lo((unsigned)me, 0u));
                    if (mine && pe < need) { if (k < 32) glo |= bm; else ghi |= bm; }
                    beq += __popcll(me);
                }
            }
        }
    }
    const int cl = __builtin_popcount(glo) + __builtin_popcount(ghi);
    int inc = cl;
#pragma unroll
    for (int o = 1; o < 64; o <<= 1) { const int t = __shfl_up(inc, o); inc += (l >= o) ? t : 0; }
    int pos = inc - cl;
    while (__ballot(glo != 0u) != 0ull) {
        if (glo != 0u) { const int s = __builtin_clz(glo); glo &= ~(0x80000000u >> s); stg[pos++] = (unsigned short)(s * 64 + l); }
    }
    while (__ballot(ghi != 0u) != 0ull) {
        if (ghi != 0u) { const int s = __builtin_clz(ghi); ghi &= ~(0x80000000u >> s); stg[pos++] = (unsigned short)((32 + s) * 64 + l); }
    }
    __builtin_amdgcn_fence(__ATOMIC_RELEASE, "wavefront"); __builtin_amdgcn_wave_barrier(); __builtin_amdgcn_fence(__ATOMIC_ACQUIRE, "wavefront");
    *(u32x2*)(sel + 4 * l) = *(const u32x2*)(stg + 4 * l);
    __builtin_amdgcn_fence(__ATOMIC_RELEASE, "wavefront"); __builtin_amdgcn_wave_barrier(); __builtin_amdgcn_fence(__ATOMIC_ACQUIRE, "wavefront");
}
__device__ __forceinline__ void topk_select(const Ctx& c, const float* __restrict__ SC, bf16* SEL  ) {
    const int l = c.lane;
    for (int m = c.gw; m < M; m += c.ngw) {
        const int b = m / SEQ, t = m % SEQ, limit = ((t >> 6) + 1) * 64;
        unsigned short* sel = (unsigned short*)SEL + (size_t)m * 256;
        if (limit <= 256) { for (int i = l; i < 256; i += 64) sel[i] = (unsigned short)(i < limit ? i : 0); continue; }
        select_row(SC + sc_row_off(b, t), limit, sel, l);
    }
}
__device__ __forceinline__ void dsa_attn_simple(const Ctx& c, const bf16* __restrict__ QALL, const bf16* __restrict__ KF, const bf16* __restrict__ SEL, bf16* OLY, int mmax = M) {
    float* qf = (float*)c.lds;
    float* P = qf + 8 * 288;
    int* sl = (int*)(P + 8 * 256);
    const float scale = 0.08838834764831845f;
    for (int m = c.bid; m < mmax; m += c.nb) {
        const int b = m / SEQ, t = m % SEQ, limit = ((t >> 6) + 1) * 64, cnt = limit < 256 ? limit : 256;
        __syncthreads();
        for (int i = c.tid; i < 8 * 288; i += NTHR) { const int h = i / 288, d = i % 288; qf[i] = bf2f(d < 256 ? QALL[(size_t)m * QC + h * 256 + d] : QALL[(size_t)m * QC + 2048 + h * 32 + (d - 256)]); }
        if (c.tid < 256) sl[c.tid] = (int)((const unsigned short*)SEL)[(size_t)m * 256 + c.tid];
        __syncthreads();
        if (c.tid < 256) {
            float acc[8];
#pragma unroll
            for (int h = 0; h < 8; ++h) acc[h] = 0.f;
            if (c.tid < cnt) {
                const u32x4* kp = (const u32x4*)(KF + (size_t)(b * SEQ + sl[c.tid]) * KFW);
                for (int ch = 0; ch < 36; ++ch) { float k[8]; unpack8(kp[ch], k);
#pragma unroll
                    for (int h = 0; h < 8; ++h) { const float* q = qf + h * 288 + ch * 8;
#pragma unroll
                        for (int j = 0; j < 8; ++j) acc[h] += k[j] * q[j]; } }
            }
#pragma unroll
            for (int h = 0; h < 8; ++h) P[h * 256 + c.tid] = (c.tid < cnt) ? acc[h] * scale : -INFINITY;
        }
        __syncthreads();
        {
            const int h = c.wave; float v[4]; float mx = -INFINITY;
#pragma unroll
            for (int i = 0; i < 4; ++i) { v[i] = P[h * 256 + c.lane + 64 * i]; mx = fmaxf(mx, v[i]); }
            mx = wave_max(mx); float s = 0.f;
#pragma unroll
            for (int i = 0; i < 4; ++i) { v[i] = __expf(v[i] - mx); s += v[i]; }
            s = wave_sum(s); const float inv = 1.f / s;
#pragma unroll
            for (int i = 0; i < 4; ++i) P[h * 256 + c.lane + 64 * i] = v[i] * inv;
        }
        __syncthreads();
        {
            const int r = c.tid & 255, hg = c.tid >> 8; float o[4] = {0.f, 0.f, 0.f, 0.f};
            for (int i = 0; i < cnt; ++i) { const float v = bf2f(KF[(size_t)(b * SEQ + sl[i]) * KFW + r]);
#pragma unroll
                for (int hh = 0; hh < 4; ++hh) o[hh] += P[(hg * 4 + hh) * 256 + i] * v; }
#pragma unroll
            for (int hh = 0; hh < 4; ++hh) OLY[(size_t)m * OC + (hg * 4 + hh) * 256 + r] = (bf16)f2bf(o[hh]);
        }
    }
}
__device__ __forceinline__ void xattn_simple(const Ctx& c, const bf16* __restrict__ XQ, const bf16* __restrict__ KVBIG, int layer, bf16* XO) {
    float* qf = (float*)c.lds;
    float* P = qf + 512;
    const float scale = 0.08838834764831845f;
    for (int m = c.bid; m < M; m += c.nb) {
        const int b = m / SEQ;
        const bf16* kvb = KVBIG + (size_t)(layer * 2048 + b * 256) * 4096 + layer * 1024;
        __syncthreads();
        qf[c.tid] = bf2f(XQ[(size_t)m * 512 + c.tid]);
        __syncthreads();
        {
            const int j = c.tid & 255, hp = c.tid >> 8;
#pragma unroll
            for (int hh = 0; hh < 2; ++hh) { const int h = hp * 2 + hh; const u32x4* kp = (const u32x4*)(kvb + (size_t)j * 4096 + h * 128); float d = 0.f;
                for (int ch = 0; ch < 16; ++ch) { float k[8]; unpack8(kp[ch], k);
#pragma unroll
                    for (int e = 0; e < 8; ++e) d += k[e] * qf[h * 128 + ch * 8 + e]; }
                P[h * 256 + j] = d * scale; }
        }
        __syncthreads();
        if (c.wave < 4) { const int h = c.wave; float v[4]; float mx = -INFINITY;
#pragma unroll
            for (int i = 0; i < 4; ++i) { v[i] = P[h * 256 + c.lane + 64 * i]; mx = fmaxf(mx, v[i]); }
            mx = wave_max(mx); float s = 0.f;
#pragma unroll
            for (int i = 0; i < 4; ++i) { v[i] = __expf(v[i] - mx); s += v[i]; }
            s = wave_sum(s); const float inv = 1.f / s;
#pragma unroll
            for (int i = 0; i < 4; ++i) P[h * 256 + c.lane + 64 * i] = v[i] * inv; }
        __syncthreads();
        {   const int h = c.tid >> 7; float o = 0.f;
            for (int j = 0; j < 256; ++j) o += P[h * 256 + j] * bf2f(kvb[(size_t)j * 4096 + 512 + c.tid]);
            XO[(size_t)m * 512 + c.tid] = (bf16)f2bf(o); }
    }
}
typedef short bf16x8 __attribute__((ext_vector_type(8)));
typedef short bf16x4 __attribute__((ext_vector_type(4)));
__device__ __forceinline__ bf16x4 tr_read4(const unsigned char* p) { return __builtin_amdgcn_ds_read_tr16_b64_v4i16((LAS bf16x4*)p); }
__device__ __forceinline__ bf16x8 cat8(bf16x4 a, bf16x4 b) { return __builtin_shufflevector(a, b, 0, 1, 2, 3, 4, 5, 6, 7); }
__device__ __forceinline__ bf16x8 pack_p8(const f32x4 a, const f32x4 b) {
    u32x4 w; w.x = pg8::cvt_pk_bf16(a[0], a[1]); w.y = pg8::cvt_pk_bf16(a[2], a[3]); w.z = pg8::cvt_pk_bf16(b[0], b[1]); w.w = pg8::cvt_pk_bf16(b[2], b[3]);
    return __builtin_bit_cast(bf16x8, w);
}
__device__ __forceinline__ bf16x8 rope_frag(const bf16x8 xf, const bf16x8 pf, const float* cs, const float* sn, bool lo) {
    float x[8], p[8]; unpack8(__builtin_bit_cast(u32x4, xf), x); unpack8(__builtin_bit_cast(u32x4, pf), p);
    const float sg = lo ? -1.f : 1.f; float o[8];
#pragma unroll
    for (int j = 0; j < 8; ++j) o[j] = x[j] * cs[j] + sg * p[j] * sn[j];
    u32x4 w; w.x = pg8::cvt_pk_bf16(o[0], o[1]); w.y = pg8::cvt_pk_bf16(o[2], o[3]); w.z = pg8::cvt_pk_bf16(o[4], o[5]); w.w = pg8::cvt_pk_bf16(o[6], o[7]);
    return __builtin_bit_cast(bf16x8, w);
}
__device__ __forceinline__ bf16x8 xchg_frag(const bf16x8 v, int lane_xor) { u32x4 u = __builtin_bit_cast(u32x4, v); u32x4 r;
    r.x = (unsigned)__shfl_xor((int)u.x, lane_xor); r.y = (unsigned)__shfl_xor((int)u.y, lane_xor); r.z = (unsigned)__shfl_xor((int)u.z, lane_xor); r.w = (unsigned)__shfl_xor((int)u.w, lane_xor); return __builtin_bit_cast(bf16x8, r); }
constexpr int XA_PITCH = 272;
__device__ __forceinline__ void xattn_mfma(const Ctx& c, const bf16* __restrict__ XQ, const bf16* __restrict__ KVBIG, int layer, bf16* XO) {
    unsigned char* Kl = c.lds; unsigned char* Vl = c.lds + 256 * XA_PITCH;
    const int l = c.lane, n16 = l & 15, g = l >> 4;
    const float scale = 0.08838834764831845f * 1.4426950408889634f;
    for (int unit = c.bid; unit < 256; unit += c.nb) {
        const int b = unit >> 5, h = (unit >> 3) & 3, qc = unit & 7;
        const bf16* kvb = KVBIG + (size_t)(layer * 2048 + b * 256) * 4096 + layer * 1024 + h * 128;
        __syncthreads();
        for (int i = c.tid; i < 4096; i += NTHR) { const int row = i >> 4, ch = i & 15;
            *(u32x4*)(Kl + row * XA_PITCH + ch * 16) = *(const u32x4*)(kvb + (size_t)row * 4096 + ch * 8);
            *(u32x4*)(Vl + row * XA_PITCH + ch * 16) = *(const u32x4*)(kvb + (size_t)row * 4096 + 512 + ch * 8); }
        __syncthreads();
#pragma unroll 1
        for (int g4 = 0; g4 < 4; ++g4) {
            const size_t m = (size_t)b * SEQ + qc * 512 + c.wave * 64 + g4 * 16 + n16;
            bf16x8 Qb[4];
#pragma unroll
            for (int kk = 0; kk < 4; ++kk) Qb[kk] = *(const bf16x8*)(XQ + m * 512 + h * 128 + 32 * kk + 8 * g);
            f32x4 S[16];
#pragma unroll
            for (int j = 0; j < 16; ++j) { S[j] = (f32x4){0.f, 0.f, 0.f, 0.f};
#pragma unroll
                for (int kk = 0; kk < 4; ++kk) { const bf16x8 A = *(const bf16x8*)(Kl + (16 * j + n16) * XA_PITCH + (32 * kk + 8 * g) * 2);
                    S[j] = __builtin_amdgcn_mfma_f32_16x16x32_bf16(A, Qb[kk], S[j], 0, 0, 0); } }
            float mx = -INFINITY;
#pragma unroll
            for (int j = 0; j < 16; ++j) mx = fmaxf(mx, fmaxf(fmaxf(S[j][0], S[j][1]), fmaxf(S[j][2], S[j][3])));
            mx = fmaxf(mx, __shfl_xor(mx, 16)); mx = fmaxf(mx, __shfl_xor(mx, 32));
            float sum = 0.f; const float mo = mx * scale;
#pragma unroll
            for (int j = 0; j < 16; ++j) {
#pragma unroll
                for (int r = 0; r < 4; ++r) { const float p = __builtin_amdgcn_exp2f(S[j][r] * scale - mo); S[j][r] = p; sum += p; } }
            sum += __shfl_xor(sum, 16); sum += __shfl_xor(sum, 32);
            const float inv = 1.f / sum;
            bf16x8 Pb[8];
#pragma unroll
            for (int jj = 0; jj < 8; ++jj) Pb[jj] = pack_p8(S[2 * jj], S[2 * jj + 1]);
            const int q4 = n16 >> 2, p4 = l & 3;
#pragma unroll
            for (int dt = 0; dt < 8; ++dt) { f32x4 O = (f32x4){0.f, 0.f, 0.f, 0.f};
#pragma unroll
                for (int jj = 0; jj < 8; ++jj) { const unsigned char* vp = Vl + (32 * jj + 4 * g + q4) * XA_PITCH + (16 * dt) * 2 + 8 * p4;
                    const bf16x8 A = cat8(tr_read4(vp), tr_read4(vp + 16 * XA_PITCH));
                    O = __builtin_amdgcn_mfma_f32_16x16x32_bf16(A, Pb[jj], O, 0, 0, 0); }
                u32x2 w; w.x = pg8::cvt_pk_bf16(O[0] * inv, O[1] * inv); w.y = pg8::cvt_pk_bf16(O[2] * inv, O[3] * inv);
                *(u32x2*)(XO + m * 512 + h * 128 + 16 * dt + 4 * g) = w; }
        }
    }
}
__device__ __forceinline__ void diag_cmp_bf16(const Ctx& c, const bf16* A, int lda, const bf16* B, int ldb, int rows, int cols, float* acc) {
    float d2 = 0.f, a2 = 0.f;
    const size_t n = (size_t)rows * cols;
    for (size_t i = (size_t)c.bid * NTHR + c.tid; i < n; i += (size_t)c.nb * NTHR) { const size_t r = i / cols, cc = i % cols; const float a = bf2f(A[r * lda + cc]), b = bf2f(B[r * ldb + cc]); d2 += (a - b) * (a - b); a2 += a * a; }
    d2 = wave_sum(d2); a2 = wave_sum(a2);
    if (c.lane == 0) { atomicAdd(acc, d2); atomicAdd(acc + 1, a2); }
}
constexpr int DA_PITCH = 528, DA_WAVE_BYTES = 32 * DA_PITCH;
__device__ __forceinline__ void dsa_attn_mfma(const Ctx& c, const bf16* __restrict__ QALL, const bf16* __restrict__ KF, const bf16* __restrict__ SEL, const float* __restrict__ ROPEA, bf16* OLY, int m_first, int m_stride, int m_end) {
    unsigned char* Vw = c.lds + c.wave * DA_WAVE_BYTES;
    const int l = c.lane, n16 = l & 15, g = l >> 4, q4 = n16 >> 2, p4 = l & 3, hh = n16 & 7;
    const float scale = 0.08838834764831845f * 1.4426950408889634f;
#pragma unroll 1
    for (int m = m_first; m < m_end; m += m_stride) {
        const int b = m / SEQ, t = m % SEQ, limit = ((t >> 6) + 1) * 64, cnt = limit < 256 ? limit : 256, nblk = cnt >> 5;
        const bf16* qrow = QALL + (size_t)m * QC;
        bf16x8 Qb[9];
#pragma unroll
        for (int kk = 0; kk < 8; ++kk) Qb[kk] = *(const bf16x8*)(qrow + hh * 256 + 32 * kk + 8 * g);
        Qb[8] = *(const bf16x8*)(qrow + 2048 + hh * 32 + 8 * g);
        {
            const bf16x8 pf = xchg_frag(Qb[8], 32); float cs[8], sn[8];
            const f32x4 c0 = *(const f32x4*)(ROPEA + (size_t)m * 32 + 8 * (g & 1)), c1 = *(const f32x4*)(ROPEA + (size_t)m * 32 + 8 * (g & 1) + 4), s0 = *(const f32x4*)(ROPEA + (size_t)m * 32 + 16 + 8 * (g & 1)), s1 = *(const f32x4*)(ROPEA + (size_t)m * 32 + 16 + 8 * (g & 1) + 4);
            cs[0] = c0.x; cs[1] = c0.y; cs[2] = c0.z; cs[3] = c0.w; cs[4] = c1.x; cs[5] = c1.y; cs[6] = c1.z; cs[7] = c1.w; sn[0] = s0.x; sn[1] = s0.y; sn[2] = s0.z; sn[3] = s0.w; sn[4] = s1.x; sn[5] = s1.y; sn[6] = s1.z; sn[7] = s1.w;
            Qb[8] = rope_frag(Qb[8], pf, cs, sn, g < 2); }
        f32x4 O[16];
#pragma unroll
        for (int dt = 0; dt < 16; ++dt) O[dt] = (f32x4){0.f, 0.f, 0.f, 0.f};
        float mrun = -INFINITY, lrun = 0.f;
        const unsigned short* selp = (const unsigned short*)SEL + (size_t)m * 256;
        const bf16* kfb = KF + (size_t)b * SEQ * KFW;
        bf16x8 K0[9], K1[9];
#define DA_GATHER(BLK) do { const int s0_ = selp[32 * (BLK) + n16], s1_ = selp[32 * (BLK) + 16 + n16]; \
            const bf16* r0_ = kfb + (size_t)s0_ * KFW + 8 * g; const bf16* r1_ = kfb + (size_t)s1_ * KFW + 8 * g; \
            _Pragma("unroll") for (int kk = 0; kk < 9; ++kk) { K0[kk] = *(const bf16x8*)(r0_ + 32 * kk); K1[kk] = *(const bf16x8*)(r1_ + 32 * kk); } } while (0)
        DA_GATHER(0);
#pragma unroll 1
        for (int blk = 0; blk < nblk; ++blk) {
            f32x4 S0 = (f32x4){0.f, 0.f, 0.f, 0.f}, S1 = (f32x4){0.f, 0.f, 0.f, 0.f};
#pragma unroll
            for (int kk = 0; kk < 9; ++kk) { S0 = __builtin_amdgcn_mfma_f32_16x16x32_bf16(K0[kk], Qb[kk], S0, 0, 0, 0); S1 = __builtin_amdgcn_mfma_f32_16x16x32_bf16(K1[kk], Qb[kk], S1, 0, 0, 0); }
#pragma unroll
            for (int kk = 0; kk < 8; ++kk) { *(bf16x8*)(Vw + n16 * DA_PITCH + (32 * kk + 8 * g) * 2) = K0[kk]; *(bf16x8*)(Vw + (16 + n16) * DA_PITCH + (32 * kk + 8 * g) * 2) = K1[kk]; }
            __builtin_amdgcn_sched_barrier(0);
            if (blk + 1 < nblk) DA_GATHER(blk + 1);
            __builtin_amdgcn_sched_barrier(0);
            float bm = fmaxf(fmaxf(fmaxf(S0[0], S0[1]), fmaxf(S0[2], S0[3])), fmaxf(fmaxf(S1[0], S1[1]), fmaxf(S1[2], S1[3])));
            bm = fmaxf(bm, __shfl_xor(bm, 16)); bm = fmaxf(bm, __shfl_xor(bm, 32));
            const float mnew = fmaxf(mrun, bm), alpha = __builtin_amdgcn_exp2f((mrun - mnew) * scale), mo = mnew * scale; mrun = mnew;
            float ps = 0.f;
#pragma unroll
            for (int r = 0; r < 4; ++r) { S0[r] = __builtin_amdgcn_exp2f(S0[r] * scale - mo); S1[r] = __builtin_amdgcn_exp2f(S1[r] * scale - mo); ps += S0[r] + S1[r]; }
            lrun = lrun * alpha + ps;
            const bf16x8 Pb = pack_p8(S0, S1);
#pragma unroll
            for (int dt = 0; dt < 16; ++dt) { O[dt] = O[dt] * alpha;
                const unsigned char* vp = Vw + (4 * g + q4) * DA_PITCH + (16 * dt) * 2 + 8 * p4;
                const bf16x8 A = cat8(tr_read4(vp), tr_read4(vp + 16 * DA_PITCH));
                O[dt] = __builtin_amdgcn_mfma_f32_16x16x32_bf16(A, Pb, O[dt], 0, 0, 0); }
        }
#undef DA_GATHER
        lrun += __shfl_xor(lrun, 16); lrun += __shfl_xor(lrun, 32);
        const float inv = 1.f / lrun;
        if (n16 < 8) {
            bf16* orow = OLY + (size_t)m * OC + n16 * 256 + 4 * g;
#pragma unroll
            for (int dt = 0; dt < 16; ++dt) { u32x2 w; w.x = pg8::cvt_pk_bf16(O[dt][0] * inv, O[dt][1] * inv); w.y = pg8::cvt_pk_bf16(O[dt][2] * inv, O[dt][3] * inv); *(u32x2*)(orow + 16 * dt) = w; }
        }
    }
}
__device__ __forceinline__ void dsa_attn_queue(const Ctx& c, const bf16* __restrict__ QALL, const bf16* __restrict__ KF, const bf16* __restrict__ SEL, const float* __restrict__ ROPEA, bf16* OLY, unsigned* counter, volatile LAS unsigned* slot) {
    for (;;) {
        __syncthreads();
        if (c.tid == 0) *slot = __hip_atomic_fetch_add(counter, 1u, __ATOMIC_RELAXED, __HIP_MEMORY_SCOPE_AGENT);
        __syncthreads();
        const int chunk = (int)*slot;
        if (chunk >= M / 16) break;
        dsa_attn_mfma(c, QALL, KF, SEL, ROPEA, OLY, chunk * 16 + c.wave, 8, chunk * 16 + 16);
    }
}
__device__ __forceinline__ float relu1(float x) { const int b = __builtin_bit_cast(int, x); return __builtin_bit_cast(float, b > 0 ? b : 0); }
__device__ __forceinline__ void idx_topk_mfma(const Ctx& c, const bf16* __restrict__ QALL, const bf16* __restrict__ KIDX, const float* __restrict__ WIDX, const float* __restrict__ ROPEI, float* scr, bf16* SEL, int nitems) {
    const int l = c.lane, n16 = l & 15, g = l >> 4, qg = c.wave & 3, kh = c.wave >> 2;
#pragma unroll 1
    for (int item = c.bid; item < nitems; item += c.nb) {
        const int b = item >> 5, pr = item & 31;
#pragma unroll 1
        for (int which = 0; which < 2; ++which) {
            const int ch = which ? 63 - pr : pr, L = 64 * (ch + 1), t0 = 64 * ch;
            if (L > 256) {
            const size_t m = (size_t)b * SEQ + t0 + 16 * qg + n16;
            float* srow = scr + (size_t)(16 * qg + n16) * L + 4 * g;
            const int nt = L >> 5, j0 = kh * nt, j1 = j0 + nt;
            const bf16* kp = KIDX + ((size_t)b * SEQ + n16) * 64 + 8 * g;
            {
                bf16x8 Qi[16][2]; float w[16];
                { const bf16* qp = QALL + m * QC + 2304 + 8 * g;
#pragma unroll
                  for (int h = 0; h < 16; ++h) { Qi[h][0] = *(const bf16x8*)(qp + h * 64); Qi[h][1] = *(const bf16x8*)(qp + h * 64 + 32); }
                  {
                      float cs[8], sn[8]; const f32x4 c0 = *(const f32x4*)(ROPEI + m * 16), c1 = *(const f32x4*)(ROPEI + m * 16 + 4), s0 = *(const f32x4*)(ROPEI + m * 16 + 8), s1 = *(const f32x4*)(ROPEI + m * 16 + 12);
                      cs[0] = c0.x; cs[1] = c0.y; cs[2] = c0.z; cs[3] = c0.w; cs[4] = c1.x; cs[5] = c1.y; cs[6] = c1.z; cs[7] = c1.w; sn[0] = s0.x; sn[1] = s0.y; sn[2] = s0.z; sn[3] = s0.w; sn[4] = s1.x; sn[5] = s1.y; sn[6] = s1.z; sn[7] = s1.w;
#pragma unroll
                      for (int h = 0; h < 16; ++h) { const bf16x8 pf = xchg_frag(Qi[h][0], 16); const bf16x8 rf = rope_frag(Qi[h][0], pf, cs, sn, g == 0); if (g < 2) Qi[h][0] = rf; } }
                  const f32x4* wp = (const f32x4*)(WIDX + m * 16);
#pragma unroll
                  for (int q = 0; q < 4; ++q) { const f32x4 v = wp[q]; w[4 * q] = v.x; w[4 * q + 1] = v.y; w[4 * q + 2] = v.z; w[4 * q + 3] = v.w; } }
                bf16x8 Ka = *(const bf16x8*)(kp + (size_t)j0 * 1024), Kb = *(const bf16x8*)(kp + (size_t)j0 * 1024 + 32);
#pragma unroll 1
                for (int j = j0; j < j1; ++j) {
                    const int jn = (j + 1 < j1) ? j + 1 : j;
                    const bf16x8 Na = *(const bf16x8*)(kp + (size_t)jn * 1024), Nb = *(const bf16x8*)(kp + (size_t)jn * 1024 + 32);
                    f32x2 s01 = (f32x2){0.f, 0.f}, s23 = (f32x2){0.f, 0.f};
                    f32x4 a = __builtin_amdgcn_mfma_f32_16x16x32_bf16(Ka, Qi[0][0], (f32x4){0.f, 0.f, 0.f, 0.f}, 0, 0, 0); a = __builtin_amdgcn_mfma_f32_16x16x32_bf16(Kb, Qi[0][1], a, 0, 0, 0);
#pragma unroll
                    for (int h = 0; h < 16; ++h) { f32x4 an = a;
                        if (h < 15) { an = __builtin_amdgcn_mfma_f32_16x16x32_bf16(Ka, Qi[h + 1][0], (f32x4){0.f, 0.f, 0.f, 0.f}, 0, 0, 0); an = __builtin_amdgcn_mfma_f32_16x16x32_bf16(Kb, Qi[h + 1][1], an, 0, 0, 0); }
                        const f32x2 wv = (f32x2){w[h], w[h]};
                        s01 = (f32x2){relu1(a[0]), relu1(a[1])} * wv + s01; s23 = (f32x2){relu1(a[2]), relu1(a[3])} * wv + s23; a = an; }
                    *(f32x4*)(srow + 16 * j) = (f32x4){s01.x, s01.y, s23.x, s23.y};
                    Ka = Na; Kb = Nb;
                }
            }
            }
            asm volatile("s_waitcnt vmcnt(0)" ::: "memory");
            __syncthreads();
            __builtin_amdgcn_fence(__ATOMIC_ACQUIRE, "agent");
            asm volatile("s_waitcnt vmcnt(0)" ::: "memory");
#pragma unroll 1
            for (int i = 0; i < 8; ++i) {
                const int ql = c.wave * 8 + i;
                unsigned short* sel = (unsigned short*)SEL + ((size_t)b * SEQ + t0 + ql) * 256;
                if (L <= 256) { for (int k = l; k < 256; k += 64) sel[k] = (unsigned short)(k < L ? k : 0); }
                else select_row_bs(scr + (size_t)ql * L, L, sel, l, (unsigned short*)(c.lds + c.wave * 512));
            }
            __syncthreads();
        }
    }
}
__device__ __forceinline__ void diag_cmp_sel(const Ctx& c, const bf16* SA, const bf16* SB, int nbatch, float* acc) {
    unsigned* bm = (unsigned*)(c.lds + c.wave * 512);
    float miss = 0.f, tot = 0.f;
    for (int m = c.gw; m < nbatch * SEQ; m += c.ngw) {
        const int t = m % SEQ; if (t < 256) continue;
        bm[c.lane] = 0u; bm[64 + c.lane] = 0u;
        __builtin_amdgcn_fence(__ATOMIC_RELEASE, "wavefront"); __builtin_amdgcn_wave_barrier();
        for (int i = c.lane; i < 256; i += 64) { const unsigned s = ((const unsigned short*)SA)[(size_t)m * 256 + i]; atomicOr(&bm[s >> 5], 1u << (s & 31)); }
        __builtin_amdgcn_fence(__ATOMIC_RELEASE, "wavefront"); __builtin_amdgcn_wave_barrier(); __builtin_amdgcn_fence(__ATOMIC_ACQUIRE, "wavefront");
        for (int i = c.lane; i < 256; i += 64) { const unsigned s = ((const unsigned short*)SB)[(size_t)m * 256 + i]; miss += ((bm[s >> 5] >> (s & 31)) & 1u) ? 0.f : 1.f; tot += 1.f; }
        __builtin_amdgcn_fence(__ATOMIC_RELEASE, "wavefront"); __builtin_amdgcn_wave_barrier();
    }
    miss = wave_sum(miss); tot = wave_sum(tot);
    if (c.lane == 0) { atomicAdd(acc, miss); atomicAdd(acc + 1, tot); }
}
__device__ __forceinline__ void idx_topk_lds(const Ctx& c, const bf16* __restrict__ QALL, const bf16* __restrict__ KIDX, const float* __restrict__ WIDX, const float* __restrict__ ROPEI, u32x4* qscr, bf16* SEL, int nitems) {
    float* SCL = (float*)c.lds;
    f32x4* WL = (f32x4*)(c.lds + 131072);
    const int w8 = c.wave;
#pragma unroll 1
    for (int item = c.bid; item < nitems; item += c.nb) {
        const int b = item >> 5, pr = item & 31;
#pragma unroll 1
        for (int which = 0; which < 2; ++which) {
            int l = c.lane; asm volatile("" : "+v"(l));
            const int n16 = l & 15, g = l >> 4;
            const int ch = which ? 63 - pr : pr, L = 64 * (ch + 1), t0 = 64 * ch;
            if (L <= 256) {
#pragma unroll 1
                for (int i = 0; i < 8; ++i) { unsigned short* sel = (unsigned short*)SEL + ((size_t)b * SEQ + t0 + w8 * 8 + i) * 256; for (int k = l; k < 256; k += 64) sel[k] = (unsigned short)(k < L ? k : 0); }
                continue;
            }
            __syncthreads();
            if (w8 < 4) {
                const size_t m = (size_t)b * SEQ + t0 + 16 * w8 + n16;
                const bf16* qp = QALL + m * QC + 2304 + 8 * g;
                float cs[8], sn[8]; const f32x4 c0 = *(const f32x4*)(ROPEI + m * 16), c1 = *(const f32x4*)(ROPEI + m * 16 + 4), s0 = *(const f32x4*)(ROPEI + m * 16 + 8), s1 = *(const f32x4*)(ROPEI + m * 16 + 12);
                cs[0] = c0.x; cs[1] = c0.y; cs[2] = c0.z; cs[3] = c0.w; cs[4] = c1.x; cs[5] = c1.y; cs[6] = c1.z; cs[7] = c1.w; sn[0] = s0.x; sn[1] = s0.y; sn[2] = s0.z; sn[3] = s0.w; sn[4] = s1.x; sn[5] = s1.y; sn[6] = s1.z; sn[7] = s1.w;
#pragma unroll 4
                for (int h = 0; h < 16; ++h) { bf16x8 f0 = *(const bf16x8*)(qp + h * 64); const bf16x8 f1 = *(const bf16x8*)(qp + h * 64 + 32);
                    const bf16x8 pf = xchg_frag(f0, 16); const bf16x8 rf = rope_frag(f0, pf, cs, sn, g == 0); if (g < 2) f0 = rf;
                    qscr[(w8 * 64 + l) * 32 + h * 2] = __builtin_bit_cast(u32x4, f0); qscr[(w8 * 64 + l) * 32 + h * 2 + 1] = __builtin_bit_cast(u32x4, f1); }
            }
            asm volatile("s_waitcnt vmcnt(0)" ::: "memory");
            __syncthreads();
            __builtin_amdgcn_fence(__ATOMIC_ACQUIRE, "agent"); asm volatile("s_waitcnt vmcnt(0)" ::: "memory");
            const bf16* kp = KIDX + ((size_t)b * SEQ + n16) * 64 + 8 * g;
            const int ntile = L >> 4;
#pragma unroll 1
            for (int qsub = 0; qsub < 8; ++qsub) {
                asm volatile("" ::: "memory");
                bf16x8 Qi[16][2];
                { const int srcl = g * 16 + (qsub & 1) * 8 + (n16 & 7); const u32x4* fp = qscr + (size_t)((qsub >> 1) * 64 + srcl) * 32;
#pragma unroll
                  for (int h = 0; h < 16; ++h) { Qi[h][0] = __builtin_bit_cast(bf16x8, fp[h * 2]); Qi[h][1] = __builtin_bit_cast(bf16x8, fp[h * 2 + 1]); }
                  if (w8 == 0 && l < 32) WL[l] = *(const f32x4*)(WIDX + ((size_t)b * SEQ + t0 + 8 * qsub + (l >> 2)) * 16 + 4 * (l & 3)); }
                __syncthreads();
                const f32x4* wq = WL + (n16 & 7) * 4;
                float* srow = SCL + (n16 & 7) * 4096 + 4 * g;
                int j = w8;
                bf16x8 Ka = *(const bf16x8*)(kp + (size_t)j * 1024), Kb = *(const bf16x8*)(kp + (size_t)j * 1024 + 32);
#pragma unroll 1
                for (; j < ntile; j += 8) {
                    const int jn = (j + 8 < ntile) ? j + 8 : j;
                    const bf16x8 Na = *(const bf16x8*)(kp + (size_t)jn * 1024), Nb = *(const bf16x8*)(kp + (size_t)jn * 1024 + 32);
                    f32x2 s01 = (f32x2){0.f, 0.f}, s23 = (f32x2){0.f, 0.f};
                    f32x4 a = __builtin_amdgcn_mfma_f32_16x16x32_bf16(Ka, Qi[0][0], (f32x4){0.f, 0.f, 0.f, 0.f}, 0, 0, 0); a = __builtin_amdgcn_mfma_f32_16x16x32_bf16(Kb, Qi[0][1], a, 0, 0, 0);
#pragma unroll
                    for (int h4 = 0; h4 < 4; ++h4) { const f32x4 w4 = wq[h4];
#pragma unroll
                        for (int hh = 0; hh < 4; ++hh) { const int h = 4 * h4 + hh; f32x4 an = a;
                            if (h < 15) { an = __builtin_amdgcn_mfma_f32_16x16x32_bf16(Ka, Qi[h + 1][0], (f32x4){0.f, 0.f, 0.f, 0.f}, 0, 0, 0); an = __builtin_amdgcn_mfma_f32_16x16x32_bf16(Kb, Qi[h + 1][1], an, 0, 0, 0); }
                            const f32x2 wv = (f32x2){w4[hh], w4[hh]};
                            s01 = (f32x2){relu1(a[0]), relu1(a[1])} * wv + s01; s23 = (f32x2){relu1(a[2]), relu1(a[3])} * wv + s23; a = an; } }
                    if (n16 < 8) *(f32x4*)(srow + 16 * j) = (f32x4){s01.x, s01.y, s23.x, s23.y};
                    Ka = Na; Kb = Nb;
                }
                __syncthreads();
                select_row(SCL + w8 * 4096, L, (unsigned short*)SEL + ((size_t)b * SEQ + t0 + 8 * qsub + w8) * 256, l);
                __syncthreads();
            }
        }
    }
}
#if DIAG == 7
__device__ __forceinline__ void select_row_v1(const float* row, int limit, unsigned short* sel, int l_in) {
    int l = l_in; asm volatile("" : "+v"(l));
    const int ng = limit >> 9;
    unsigned key[64];
#pragma unroll
    for (int j = 0; j < 64; ++j) { const int s = j * 64 + l; unsigned u = 0u; if (s < limit) { u = __float_as_uint(row[s]); u = (u & 0x80000000u) ? ~u : (u | 0x80000000u); } key[j] = u; }
    unsigned mx = 0u;
#pragma unroll
    for (int j = 0; j < 64; ++j) mx = key[j] > mx ? key[j] : mx;
#pragma unroll
    for (int o = 1; o < 64; o <<= 1) { const unsigned t = (unsigned)__shfl_xor((int)mx, o); mx = t > mx ? t : mx; }
    mx = (unsigned)__builtin_amdgcn_readfirstlane((int)mx);
    unsigned T = 0u;
#pragma unroll 1
    for (int bit = 31 - __builtin_clz(mx | 1u); bit >= 0; --bit) {
        const unsigned Tn = T | (1u << bit); int cnt = 0;
#pragma unroll
        for (int jg = 0; jg < 8; ++jg) if (jg <= ng) {
#pragma unroll
            for (int j = 8 * jg; j < 8 * jg + 8; ++j) cnt += __popcll(__ballot(key[j] >= Tn)); }
        if (cnt >= 256) T = Tn;
        if (cnt == 256) break;
    }
    int cgt = 0;
#pragma unroll
    for (int j = 0; j < 64; ++j) cgt += __popcll(__ballot(key[j] > T));
    const int need_eq = 256 - cgt;
    int base = 0, beq = 0;
    const unsigned long long lt = (1ull << l) - 1ull;
#pragma unroll
    for (int jg = 0; jg < 8; ++jg) if (jg <= ng) {
#pragma unroll
        for (int j = 8 * jg; j < 8 * jg + 8; ++j) {
            const unsigned long long mg = __ballot(key[j] > T), me = __ballot(key[j] == T);
            if (key[j] > T) sel[base + __popcll(mg & lt)] = (unsigned short)(j * 64 + l);
            base += __popcll(mg);
            const int pe = beq + __popcll(me & lt);
            if (key[j] == T && pe < need_eq) sel[cgt + pe] = (unsigned short)(j * 64 + l);
            beq += __popcll(me);
        }
    }
}
__device__ __forceinline__ void idx_topk_v1(const Ctx& c, const bf16* __restrict__ QALL, const bf16* __restrict__ KIDX, const float* __restrict__ WIDX, float* scr, bf16* SEL, int nitems) {
    const int l = c.lane, n16 = l & 15, g = l >> 4, qg = c.wave & 3, kh = c.wave >> 2;
#pragma unroll 1
    for (int item = c.bid; item < nitems; item += c.nb) {
        const int b = item >> 5, pr = item & 31;
#pragma unroll 1
        for (int which = 0; which < 2; ++which) {
            const int ch = which ? 63 - pr : pr, L = 64 * (ch + 1), t0 = 64 * ch;
            if (L > 256) {
            const size_t m = (size_t)b * SEQ + t0 + 16 * qg + n16;
            float* srow = scr + (size_t)(16 * qg + n16) * L + 4 * g;
            const int nt = L >> 5, j0 = kh * nt, j1 = j0 + nt;
            const bf16* kp = KIDX + ((size_t)b * SEQ + n16) * 64 + 8 * g;
#pragma unroll 1
            for (int hp = 0; hp < 2; ++hp) {
                bf16x8 Qi[8][2]; float w[8];
                { const bf16* qp = QALL + m * QC + 2304 + hp * 512 + 8 * g;
#pragma unroll
                  for (int h = 0; h < 8; ++h) { Qi[h][0] = *(const bf16x8*)(qp + h * 64); Qi[h][1] = *(const bf16x8*)(qp + h * 64 + 32); }
                  const f32x4* wp = (const f32x4*)(WIDX + m * 16 + hp * 8);
#pragma unroll
                  for (int q = 0; q < 2; ++q) { const f32x4 v = wp[q]; w[4 * q] = v.x; w[4 * q + 1] = v.y; w[4 * q + 2] = v.z; w[4 * q + 3] = v.w; } }
                if (hp) { asm volatile("s_waitcnt vmcnt(0)" ::: "memory"); __builtin_amdgcn_fence(__ATOMIC_ACQUIRE, "agent"); asm volatile("s_waitcnt vmcnt(0)" ::: "memory"); }
                bf16x8 Ka = *(const bf16x8*)(kp + (size_t)j0 * 1024), Kb = *(const bf16x8*)(kp + (size_t)j0 * 1024 + 32);
                f32x4 pv = (f32x4){0.f, 0.f, 0.f, 0.f}; if (hp) pv = *(const f32x4*)(srow + 16 * j0);
#pragma unroll 1
                for (int j = j0; j < j1; ++j) {
                    const int jn = (j + 1 < j1) ? j + 1 : j;
                    const bf16x8 Na = *(const bf16x8*)(kp + (size_t)jn * 1024), Nb = *(const bf16x8*)(kp + (size_t)jn * 1024 + 32);
                    f32x4 pn = (f32x4){0.f, 0.f, 0.f, 0.f}; if (hp) pn = *(const f32x4*)(srow + 16 * jn);
                    f32x4 sc = pv;
#pragma unroll
                    for (int h = 0; h < 8; ++h) { f32x4 a = __builtin_amdgcn_mfma_f32_16x16x32_bf16(Ka, Qi[h][0], (f32x4){0.f, 0.f, 0.f, 0.f}, 0, 0, 0); a = __builtin_amdgcn_mfma_f32_16x16x32_bf16(Kb, Qi[h][1], a, 0, 0, 0);
                        sc[0] += w[h] * fmaxf(a[0], 0.f); sc[1] += w[h] * fmaxf(a[1], 0.f); sc[2] += w[h] * fmaxf(a[2], 0.f); sc[3] += w[h] * fmaxf(a[3], 0.f); }
                    *(f32x4*)(srow + 16 * j) = sc;
                    Ka = Na; Kb = Nb; pv = pn;
                }
            }
            }
            asm volatile("s_waitcnt vmcnt(0)" ::: "memory");
            __syncthreads();
            __builtin_amdgcn_fence(__ATOMIC_ACQUIRE, "agent");
            asm volatile("s_waitcnt vmcnt(0)" ::: "memory");
#pragma unroll 1
            for (int i = 0; i < 8; ++i) {
                const int ql = c.wave * 8 + i;
                unsigned short* sel = (unsigned short*)SEL + ((size_t)b * SEQ + t0 + ql) * 256;
                if (L <= 256) { for (int k = l; k < 256; k += 64) sel[k] = (unsigned short)(k < L ? k : 0); }
                else select_row_v1(scr + (size_t)ql * L, L, sel, l);
            }
            __syncthreads();
        }
    }
}
#endif
constexpr int RW_TB = 32;
struct RwkvP { const float *mu, *w0, *w2, *a0, *a2, *g2, *k_k, *k_a, *r_k, *ln_w, *ln_b; };
__device__ __forceinline__ void rwkv_phase(const Ctx& c, const bf16* __restrict__ H, const RwkvP P, bf16* OLY) {
    float* A_WR = (float*)c.lds;
    float* A_K2 = A_WR + RW_TB * 64;
    float* A_V = A_K2 + RW_TB * 64;
    float* A_W = A_V + RW_TB * 64;
    float* A_NKK = A_W + RW_TB * 64;
    float* A_B = A_NKK + RW_TB * 64;
    float* A_G = A_B + RW_TB * 64;
    float* A_OUT = A_G + RW_TB * 64;
    float* L_TW = A_OUT + RW_TB * 64;
    float* L_AL = L_TW + RW_TB * 64;
    float* L_SG = L_AL + RW_TB * 64;
    float* SC1 = L_SG + RW_TB * 160; float* SC2 = SC1 + RW_TB; float* SC3 = SC2 + RW_TB;
    const int l = c.lane, w = c.wave;
    for (int item = c.bid; item < NB * 16; item += c.nb) {
        const int b = item >> 4, h = item & 15, hk = h * 64 + l;
        const float w0v = P.w0[hk], a0v = P.a0[hk], kkv = P.k_k[hk], kav = P.k_a[hk], rkv = P.r_k[hk], lnw = P.ln_w[hk], lnb = P.ln_b[hk];
        float S[8];
#pragma unroll
        for (int i = 0; i < 8; ++i) S[i] = 0.f;
        const int srow = w * 8 + (l >> 3), sj = l & 7;
        for (int t0 = 0; t0 < SEQ; t0 += RW_TB) {
            __syncthreads();
            for (int idx = c.tid; idx < RW_TB * 480; idx += NTHR) {
                const int t = idx / 480, cc = idx % 480; int col; float* dst;
                if (cc < 64) { col = 880 + h * 64 + cc; dst = A_WR + t * 64 + cc; }
                else if (cc < 128) { col = 1904 + h * 64 + (cc - 64); dst = A_K2 + t * 64 + (cc - 64); }
                else if (cc < 192) { col = 2928 + h * 64 + (cc - 128); dst = A_V + t * 64 + (cc - 128); }
                else if (cc < 256) { col = 3952 + (cc - 192); dst = L_TW + t * 64 + (cc - 192); }
                else if (cc < 320) { col = 4016 + (cc - 256); dst = L_AL + t * 64 + (cc - 256); }
                else { col = 4080 + (cc - 320); dst = L_SG + t * 160 + (cc - 320); }
                const size_t m = (size_t)b * SEQ + t0 + t;
                const float x = bf2f(H[m * HC + col]); const float xp = (t0 + t > 0) ? bf2f(H[(m - 1) * HC + col]) : 0.f;
                float hm = x + (xp - x) * P.mu[col - 880];
                if (cc >= 192 && cc < 256) hm = tanhf(hm); else if (cc >= 320) hm = sigmoidf_(hm);
                *dst = hm;
            }
            __syncthreads();
            {
                float wl[RW_TB / 8], al[RW_TB / 8], gg[RW_TB / 8];
#pragma unroll
                for (int i = 0; i < RW_TB / 8; ++i) { wl[i] = 0.f; al[i] = 0.f; gg[i] = 0.f; }
                for (int j = 0; j < 64; ++j) { const float w2v = P.w2[(size_t)j * 1024 + hk], a2v = P.a2[(size_t)j * 1024 + hk];
#pragma unroll
                    for (int i = 0; i < RW_TB / 8; ++i) { wl[i] += L_TW[(w + 8 * i) * 64 + j] * w2v; al[i] += L_AL[(w + 8 * i) * 64 + j] * a2v; } }
                for (int j = 0; j < 160; ++j) { const float g2v = P.g2[(size_t)j * 1024 + hk];
#pragma unroll
                    for (int i = 0; i < RW_TB / 8; ++i) gg[i] += L_SG[(w + 8 * i) * 160 + j] * g2v; }
#pragma unroll
                for (int i = 0; i < RW_TB / 8; ++i) {
                    const int t = w + 8 * i, o = t * 64 + l;
                    const float dec = __expf(-0.6065306597126334f * sigmoidf_(w0v + wl[i]));
                    const float a = sigmoidf_(a0v + al[i]);
                    const float kr = A_K2[o], r = A_WR[o];
                    float kk = kr * kkv; const float nrm = wave_sum(kk * kk); kk = kk * (1.0f / sqrtf(fmaxf(nrm, 1e-24f)));
                    const float k2 = kr * (1.f + (a - 1.f) * kav), bb = kk * a;
                    const float s1 = wave_sum(bb * r), s2 = wave_sum(k2 * r), s3 = wave_sum(r * k2 * rkv);
                    A_W[o] = dec; A_NKK[o] = -kk; A_B[o] = bb; A_K2[o] = k2; A_WR[o] = dec * r; A_G[o] = gg[i];
                    if (l == 0) { SC1[t] = s1; SC2[t] = s2; SC3[t] = s3; }
                }
            }
            __syncthreads();
            for (int t = 0; t < RW_TB; ++t) {
                const f32x4* pw = (const f32x4*)(A_W + t * 64 + 8 * sj); const f32x4* pn = (const f32x4*)(A_NKK + t * 64 + 8 * sj); const f32x4* pb = (const f32x4*)(A_B + t * 64 + 8 * sj);
                const f32x4* pk = (const f32x4*)(A_K2 + t * 64 + 8 * sj); const f32x4* pr = (const f32x4*)(A_WR + t * 64 + 8 * sj);
                const f32x4 w0_ = pw[0], w1_ = pw[1], n0 = pn[0], n1 = pn[1], b0 = pb[0], b1 = pb[1], k0 = pk[0], k1 = pk[1], r0 = pr[0], r1 = pr[1];
                const float vv = A_V[t * 64 + srow], s1 = SC1[t], s2 = SC2[t];
                float sa = (S[0] * n0.x + S[1] * n0.y) + (S[2] * n0.z + S[3] * n0.w) + (S[4] * n1.x + S[5] * n1.y) + (S[6] * n1.z + S[7] * n1.w);
                float p = (S[0] * r0.x + S[1] * r0.y) + (S[2] * r0.z + S[3] * r0.w) + (S[4] * r1.x + S[5] * r1.y) + (S[6] * r1.z + S[7] * r1.w);
                sa += __shfl_xor(sa, 1); p += __shfl_xor(p, 1); sa += __shfl_xor(sa, 2); p += __shfl_xor(p, 2); sa += __shfl_xor(sa, 4); p += __shfl_xor(p, 4);
                S[0] = S[0] * w0_.x + (sa * b0.x + vv * k0.x); S[1] = S[1] * w0_.y + (sa * b0.y + vv * k0.y); S[2] = S[2] * w0_.z + (sa * b0.z + vv * k0.z); S[3] = S[3] * w0_.w + (sa * b0.w + vv * k0.w);
                S[4] = S[4] * w1_.x + (sa * b1.x + vv * k1.x); S[5] = S[5] * w1_.y + (sa * b1.y + vv * k1.y); S[6] = S[6] * w1_.z + (sa * b1.z + vv * k1.z); S[7] = S[7] * w1_.w + (sa * b1.w + vv * k1.w);
                if (sj == 0) A_OUT[t * 64 + srow] = p + sa * s1 + vv * s2;
            }
            __syncthreads();
#pragma unroll
            for (int i = 0; i < RW_TB / 8; ++i) {
                const int t = w + 8 * i, o = t * 64 + l;
                const float x = A_OUT[o]; const float mean = wave_sum(x) * (1.f / 64.f); const float dx = x - mean; const float var = wave_sum(dx * dx) * (1.f / 64.f);
                float y = dx * (1.0f / sqrtf(var + 64e-5f)) * lnw + lnb;
                y = (y + SC3[t] * A_V[o]) * A_G[o];
                OLY[((size_t)b * SEQ + t0 + t) * OC + 2048 + hk] = (bf16)f2bf(y);
            }
        }
    }
}

constexpr int S5_TB = 16;
struct S5P { const float *lam_re, *lam_im, *log_dt, *b_re, *b_im, *c_re, *c_im, *d; };
__device__ __forceinline__ float gelu_tanh(float y) { return 0.5f * y * (1.f + tanhf(0.7978845608028654f * (y + 0.044715f * y * y * y))); }
__device__ __forceinline__ void s5_phase(const Ctx& c, const bf16* __restrict__ U, const S5P P, bf16* Z) {
    constexpr int PERW = 256 + 2 * S5_TB * 65 + 2 * 64 * 16;
    float* UU = (float*)c.lds + c.wave * PERW;
    float* XSr = UU + 256; float* XSi = XSr + S5_TB * 65;
    float* CTr = XSi + S5_TB * 65; float* CTi = CTr + 64 * 16;
    const int l = c.lane;
    for (int item = c.bid; item < NB * 16; item += c.nb) {
        const int b = item >> 4, g = (item & 15) * 8 + c.wave;
        __syncthreads();
        float lbr, lbi, Br[16], Bi[16];
        {
            const float lr = fminf(P.lam_re[g * 64 + l], -1e-4f), li = P.lam_im[g * 64 + l], dt = expf(P.log_dt[g]);
            const float e = expf(lr * dt); lbr = e * cosf(li * dt); lbi = e * sinf(li * dt);
            const float nr = lbr - 1.f, ni = lbi, den = 1.f / (lr * lr + li * li);
            const float cr = (nr * lr + ni * li) * den, ci = (ni * lr - nr * li) * den;
#pragma unroll
            for (int i = 0; i < 16; ++i) { const float br = P.b_re[(size_t)(g * 64 + l) * 16 + i], bi = P.b_im[(size_t)(g * 64 + l) * 16 + i]; Br[i] = cr * br - ci * bi; Bi[i] = cr * bi + ci * br; }
#pragma unroll
            for (int o = 0; o < 16; ++o) { CTr[l * 16 + o] = P.c_re[(size_t)(g * 16 + o) * 64 + l]; CTi[l * 16 + o] = P.c_im[(size_t)(g * 16 + o) * 64 + l]; }
        }
        float dsk[4];
#pragma unroll
        for (int e = 0; e < 4; ++e) dsk[e] = P.d[g * 16 + (l >> 4) * 4 + e];
        float xr = 0.f, xi = 0.f;
        for (int t0 = 0; t0 < SEQ; t0 += S5_TB) {
            __syncthreads();
            { const int row = l >> 2, q = l & 3; const u32x2 w2 = *(const u32x2*)(U + ((size_t)b * SEQ + t0 + row) * D + g * 16 + 4 * q);
              float* d = UU + row * 16 + 4 * q; d[0] = bf2f(w2.x & 0xffffu); d[1] = bf2f(w2.x >> 16); d[2] = bf2f(w2.y & 0xffffu); d[3] = bf2f(w2.y >> 16); }
            __syncthreads();
            for (int t = 0; t < S5_TB; ++t) {
                const f32x4* up = (const f32x4*)(UU + t * 16); const f32x4 u0 = up[0], u1 = up[1], u2 = up[2], u3 = up[3];
                const float u[16] = {u0.x, u0.y, u0.z, u0.w, u1.x, u1.y, u1.z, u1.w, u2.x, u2.y, u2.z, u2.w, u3.x, u3.y, u3.z, u3.w};
                float bur = 0.f, bui = 0.f;
#pragma unroll
                for (int i = 0; i < 16; ++i) { bur += Br[i] * u[i]; bui += Bi[i] * u[i]; }
                const float nxr = lbr * xr - lbi * xi + bur, nxi = lbr * xi + lbi * xr + bui; xr = nxr; xi = nxi;
                XSr[t * 65 + l] = xr; XSi[t * 65 + l] = xi;
            }
            __syncthreads();
            {   const int t = l & 15, oq = l >> 4; float y[4] = {0.f, 0.f, 0.f, 0.f};
                for (int p = 0; p < 64; ++p) { const float a = XSr[t * 65 + p], bb = XSi[t * 65 + p]; const f32x4 cr = *(const f32x4*)(CTr + p * 16 + oq * 4), ci = *(const f32x4*)(CTi + p * 16 + oq * 4);
                    y[0] += a * cr.x - bb * ci.x; y[1] += a * cr.y - bb * ci.y; y[2] += a * cr.z - bb * ci.z; y[3] += a * cr.w - bb * ci.w; }
                float z[4];
#pragma unroll
                for (int e = 0; e < 4; ++e) z[e] = gelu_tanh(y[e] + dsk[e] * UU[t * 16 + oq * 4 + e]);
                u32x2 o; o.x = pk2(z[0], z[1]); o.y = pk2(z[2], z[3]);
                *(u32x2*)(Z + ((size_t)b * SEQ + t0 + t) * D + g * 16 + oq * 4) = o; }
        }
    }
}
template <int CTRL> __device__ __forceinline__ float dpp_mov(float v) { return __builtin_bit_cast(float, __builtin_amdgcn_update_dpp(0, __builtin_bit_cast(int, v), CTRL, 0xf, 0xf, true)); }
__device__ __forceinline__ float sum8(float v) { v += dpp_mov<0xB1>(v); v += dpp_mov<0x4E>(v); v += dpp_mov<0x141>(v); return v; }
__device__ __forceinline__ float wave_sum_fast(float v) { v += dpp_mov<0xB1>(v); v += dpp_mov<0x4E>(v); v += dpp_mov<0x141>(v); v += dpp_mov<0x140>(v); v += __shfl_xor(v, 16); v += __shfl_xor(v, 32); return v; }
__device__ __forceinline__ float fast_tanh(float x) { const float e = __expf(2.f * x); return 1.f - 2.f / (e + 1.f); }
__device__ __forceinline__ void rwkv_lora_prep(const Ctx& c, const bf16* __restrict__ H, const float* __restrict__ mu, bf16* LX) {
    const int l = c.lane;
    for (int m = c.gw; m < M; m += c.ngw) {
        if (l < 36) {
            const int col = 3952 + 8 * l; const int t = m % SEQ;
            float x[8], p[8]; unpack8(*(const u32x4*)(H + (size_t)m * HC + col), x);
            if (t > 0) unpack8(*(const u32x4*)(H + (size_t)(m - 1) * HC + col), p); else {
#pragma unroll
                for (int j = 0; j < 8; ++j) p[j] = 0.f; }
            const f32x4 m0 = *(const f32x4*)(mu + 3072 + 8 * l), m1 = *(const f32x4*)(mu + 3072 + 8 * l + 4);
            const float mv[8] = {m0.x, m0.y, m0.z, m0.w, m1.x, m1.y, m1.z, m1.w};
            float hm[8];
#pragma unroll
            for (int j = 0; j < 8; ++j) { float v = x[j] + (p[j] - x[j]) * mv[j]; if (l < 8) v = fast_tanh(v); else if (l >= 16) v = sigmoidf_(v); hm[j] = v; }
            u32x4 o; o.x = pg8::cvt_pk_bf16(hm[0], hm[1]); o.y = pg8::cvt_pk_bf16(hm[2], hm[3]); o.z = pg8::cvt_pk_bf16(hm[4], hm[5]); o.w = pg8::cvt_pk_bf16(hm[6], hm[7]);
            *(u32x4*)(LX + (size_t)m * 288 + 8 * l) = o;
        }
    }
}
constexpr int RW2_RAWP = 384;
constexpr int RW2_TWP = 144, RW2_SGP = 336;
__device__ __forceinline__ void rwkv_phase2(const Ctx& c, const bf16* __restrict__ H, const bf16* __restrict__ LX, const RwkvP P, bf16* OUT, int ldo, int coloff, int wb = NB) {
    unsigned char* RAW = c.lds;
    float* A_WR = (float*)(c.lds + 12800);
    float* A_K2 = A_WR + 2048; float* A_V = A_K2 + 2048; float* A_W = A_V + 2048; float* A_NKK = A_W + 2048; float* A_B = A_NKK + 2048; float* A_G = A_B + 2048; float* A_OUT = A_G + 2048;
    float* LO_W = A_OUT + 2048; float* LO_A = LO_W + 2048; float* PR3 = LO_A + 2048;
    unsigned char* L_TW = (unsigned char*)(PR3 + 2048); unsigned char* L_AL = L_TW + 32 * RW2_TWP; unsigned char* L_SG = L_AL + 32 * RW2_TWP;
    float* MU = (float*)(L_SG + 32 * RW2_SGP); float* SC3 = MU + 480 + 64;
    unsigned char* G2T = (unsigned char*)(SC3 + 32);
    float* SCP = (float*)(G2T + 64 * RW2_SGP);
    float* GN = SCP + 128; float* CST = GN + 64;
    float* PR0 = (float*)L_TW; float* PR1 = PR0 + 2048; float* PR2 = A_OUT;
    const int l = c.lane, w = c.wave, n16 = l & 15, g = l >> 4;
#pragma unroll 1
    for (int item = c.bid; item < NB * 16; item += c.nb) {
        const int b = item >> 4, h = item & 15, hk = h * 64 + l;
        __syncthreads();
        if (w < 7) { const float* src = w == 0 ? P.w0 : w == 1 ? P.a0 : w == 2 ? P.k_k : w == 3 ? P.k_a : w == 4 ? P.r_k : w == 5 ? P.ln_w : P.ln_b; CST[w * 64 + l] = src[hk]; }
        for (int i = c.tid; i < 160 * 64; i += NTHR) { const int j = i >> 6, kcl = i & 63; *(unsigned short*)(G2T + kcl * RW2_SGP + j * 2) = (unsigned short)f2bf(P.g2[(size_t)j * 1024 + h * 64 + kcl]); }
        for (int i = c.tid; i < 192; i += NTHR) { const int mi = i < 64 ? h * 64 + i : i < 128 ? 1024 + h * 64 + (i - 64) : 2048 + h * 64 + (i - 128); MU[i] = P.mu[mi]; }
        const int tt = w >> 2, nt = w & 3;
        bf16x8 W2B[2], A2B[2];
        { const int kc = h * 64 + 16 * nt + n16;
          auto ldfrag = [&](const float* Wp, int kk) -> bf16x8 { float f[8]; int gq = g, kq = kc; asm volatile("" : "+v"(gq), "+v"(kq));
              const float* wp = Wp + (size_t)(32 * kk + 8 * gq) * 1024 + kq;
#pragma unroll
              for (int q = 0; q < 8; ++q) f[q] = wp[q * 1024];
              u32x4 u; u.x = pk2(f[0], f[1]); u.y = pk2(f[2], f[3]); u.z = pk2(f[4], f[5]); u.w = pk2(f[6], f[7]);
              asm volatile("" : "+v"(u));
              return __builtin_bit_cast(bf16x8, u); };
          W2B[0] = ldfrag(P.w2, 0); W2B[1] = ldfrag(P.w2, 1); A2B[0] = ldfrag(P.a2, 0); A2B[1] = ldfrag(P.a2, 1);
        }
        f32x2 S[4];
#pragma unroll
        for (int i = 0; i < 4; ++i) S[i] = (f32x2){0.f, 0.f};
        const int srow = w * 8 + (l >> 3), sj = l & 7;
        u32x4 raw[4];
#define RW2_LOAD(T0) do { _Pragma("unroll") for (int k = 0; k < 4; ++k) { const int q_ = c.tid + 512 * k; raw[k] = (u32x4){0u, 0u, 0u, 0u}; \
            if (q_ < 792) { const int cq_ = q_ % 24, tg = (T0) - 1 + q_ / 24; const int rc_ = (cq_ < 8 ? 880 : cq_ < 16 ? 1904 - 64 : 2928 - 128) + h * 64 + cq_ * 8; \
                if (tg >= 0) raw[k] = *(const u32x4*)(H + ((size_t)b * SEQ + tg) * HC + rc_); } \
            else if (q_ < 1944) { const int e_ = q_ - 792; raw[k] = *(const u32x4*)(LX + ((size_t)b * SEQ + (T0) + e_ / 36) * 288 + (e_ % 36) * 8); } } } while (0)
        RW2_LOAD(0);
#pragma unroll 1
        for (int t0 = 0; t0 < SEQ; t0 += 32) {
            __syncthreads();
#pragma unroll
            for (int k = 0; k < 4; ++k) { const int q_ = c.tid + 512 * k;
                if (q_ < 792) *(u32x4*)(RAW + (q_ / 24) * RW2_RAWP + (q_ % 24) * 16) = raw[k];
                else if (q_ < 1944) { const int e_ = q_ - 792, t_ = e_ / 36, p_ = e_ % 36;
                    unsigned char* d_ = p_ < 8 ? L_TW + t_ * RW2_TWP + p_ * 16 : p_ < 16 ? L_AL + t_ * RW2_TWP + (p_ - 8) * 16 : L_SG + t_ * RW2_SGP + (p_ - 16) * 16; *(u32x4*)d_ = raw[k]; } }
            if (t0 + 32 < SEQ) RW2_LOAD(t0 + 32);
            __syncthreads();
            if (c.tid < 384) {
                const int cpi = c.tid % 96, qb = c.tid / 96, cp = cpi * 2, tb = qb * 8;
                const float mu0 = MU[cp], mu1 = MU[cp + 1];
                unsigned xb = *(const unsigned*)(RAW + tb * RW2_RAWP + cp * 2);
                float p0 = bf2f(xb & 0xffffu), p1 = bf2f(xb >> 16);
                float* dst = (cp < 64 ? A_WR + cp : cp < 128 ? A_K2 + (cp - 64) : A_V + (cp - 128)) + tb * 64;
#pragma unroll
                for (int t = 0; t < 8; ++t) { const unsigned xa = *(const unsigned*)(RAW + (tb + t + 1) * RW2_RAWP + cp * 2); const float x0 = bf2f(xa & 0xffffu), x1 = bf2f(xa >> 16);
                    *(f32x2*)(dst + t * 64) = (f32x2){x0 + (p0 - x0) * mu0, x1 + (p1 - x1) * mu1}; p0 = x0; p1 = x1; }
            }
            __syncthreads();
            {
                f32x4 aw = (f32x4){0.f, 0.f, 0.f, 0.f}, aa = aw, ag = aw;
#pragma unroll
                for (int kk = 0; kk < 2; ++kk) { const bf16x8 At = *(const bf16x8*)(L_TW + (16 * tt + n16) * RW2_TWP + (32 * kk + 8 * g) * 2), Aa = *(const bf16x8*)(L_AL + (16 * tt + n16) * RW2_TWP + (32 * kk + 8 * g) * 2);
                    aw = __builtin_amdgcn_mfma_f32_16x16x32_bf16(At, W2B[kk], aw, 0, 0, 0); aa = __builtin_amdgcn_mfma_f32_16x16x32_bf16(Aa, A2B[kk], aa, 0, 0, 0); }
#pragma unroll
                for (int kk = 0; kk < 5; ++kk) { const bf16x8 Ag = *(const bf16x8*)(L_SG + (16 * tt + n16) * RW2_SGP + (32 * kk + 8 * g) * 2); const bf16x8 Gb = *(const bf16x8*)(G2T + (16 * nt + n16) * RW2_SGP + (32 * kk + 8 * g) * 2); ag = __builtin_amdgcn_mfma_f32_16x16x32_bf16(Ag, Gb, ag, 0, 0, 0); }
#pragma unroll
                for (int r = 0; r < 4; ++r) { const int o = (16 * tt + 4 * g + r) * 64 + 16 * nt + n16; LO_W[o] = aw[r]; LO_A[o] = aa[r]; A_G[o] = ag[r]; }
            }
            __syncthreads();
#pragma unroll 2
            for (int i = 0; i < 4; ++i) {
                const int t = w + 8 * i, o = t * 64 + l;
                const float w0v = CST[l], a0v = CST[64 + l], kkv = CST[128 + l], kav = CST[192 + l], rkv = CST[256 + l];
                const float dec = __expf(-0.6065306597126334f * sigmoidf_(w0v + LO_W[o]));
                const float a = sigmoidf_(a0v + LO_A[o]);
                const float kr = A_K2[o], r = A_WR[o];
                const float kk0 = kr * kkv, k2 = kr * (1.f + (a - 1.f) * kav), bb0 = kk0 * a, k2r = k2 * r;
                A_W[o] = dec; A_NKK[o] = -kk0; A_B[o] = bb0; A_K2[o] = k2; A_WR[o] = dec * r;
                PR0[o] = kk0 * kk0; PR1[o] = bb0 * r; PR2[o] = k2r; PR3[o] = k2r * rkv;
            }
            __syncthreads();
            {
                const int t = c.tid >> 4, q = (c.tid >> 2) & 3, qu = c.tid & 3;
                const float* src = (q == 0 ? PR0 : q == 1 ? PR1 : q == 2 ? PR2 : PR3) + t * 64 + 16 * qu;
                const f32x4 v0 = *(const f32x4*)src, v1 = *(const f32x4*)(src + 4), v2 = *(const f32x4*)(src + 8), v3 = *(const f32x4*)(src + 12);
                float sm = ((v0.x + v0.y) + (v0.z + v0.w)) + ((v1.x + v1.y) + (v1.z + v1.w)) + ((v2.x + v2.y) + (v2.z + v2.w)) + ((v3.x + v3.y) + (v3.z + v3.w));
                sm += dpp_mov<0xB1>(sm); sm += dpp_mov<0x4E>(sm);
                if (qu == 0) SCP[t * 4 + q] = (q == 0) ? 1.0f / fmaxf(sm, 1e-24f) : sm;
            }
            __syncthreads();
            {
                f32x4 n0, n1, r0, r1, w0_, w1_, b0, b1, k0, k1, sp; float vv;
                const unsigned char* pk_ = (const unsigned char*)A_WR + 32 * sj;
                const unsigned char* pv_ = (const unsigned char*)A_WR + 4 * srow;
                const unsigned char* ps_ = (const unsigned char*)SCP;
                constexpr int O_WR = 0, O_K2 = 8192, O_V = 16384, O_W = 24576, O_NKK = 32768, O_B = 40960, O_OUT = 57344;
#define RW2_LD_DOT(T) do { n0 = *(const f32x4*)(pk_ + O_NKK + (T) * 256); n1 = *(const f32x4*)(pk_ + O_NKK + (T) * 256 + 16); r0 = *(const f32x4*)(pk_ + O_WR + (T) * 256); r1 = *(const f32x4*)(pk_ + O_WR + (T) * 256 + 16); } while (0)
#define RW2_LD_UPD(T) do { w0_ = *(const f32x4*)(pk_ + O_W + (T) * 256); w1_ = *(const f32x4*)(pk_ + O_W + (T) * 256 + 16); b0 = *(const f32x4*)(pk_ + O_B + (T) * 256); b1 = *(const f32x4*)(pk_ + O_B + (T) * 256 + 16); \
                    k0 = *(const f32x4*)(pk_ + O_K2 + (T) * 256); k1 = *(const f32x4*)(pk_ + O_K2 + (T) * 256 + 16); vv = *(const float*)(pv_ + O_V + (T) * 256); sp = *(const f32x4*)(ps_ + (T) * 16); } while (0)
#define RW2_STEP(T) do { \
                    f32x2 sa2 = S[0] * (f32x2){n0.x, n0.y}; sa2 = S[1] * (f32x2){n0.z, n0.w} + sa2; sa2 = S[2] * (f32x2){n1.x, n1.y} + sa2; sa2 = S[3] * (f32x2){n1.z, n1.w} + sa2; \
                    f32x2 p2 = S[0] * (f32x2){r0.x, r0.y}; p2 = S[1] * (f32x2){r0.z, r0.w} + p2; p2 = S[2] * (f32x2){r1.x, r1.y} + p2; p2 = S[3] * (f32x2){r1.z, r1.w} + p2; \
                    __builtin_amdgcn_sched_barrier(0); RW2_LD_DOT((T) + 1); __builtin_amdgcn_sched_barrier(0); \
                    const float sa = sum8(sa2.x + sa2.y) * sp.x, p = sum8(p2.x + p2.y); \
                    const f32x2 sav = (f32x2){sa, sa}, vvv = (f32x2){vv, vv}; \
                    S[0] = S[0] * (f32x2){w0_.x, w0_.y} + (sav * (f32x2){b0.x, b0.y} + vvv * (f32x2){k0.x, k0.y}); \
                    S[1] = S[1] * (f32x2){w0_.z, w0_.w} + (sav * (f32x2){b0.z, b0.w} + vvv * (f32x2){k0.z, k0.w}); \
                    S[2] = S[2] * (f32x2){w1_.x, w1_.y} + (sav * (f32x2){b1.x, b1.y} + vvv * (f32x2){k1.x, k1.y}); \
                    S[3] = S[3] * (f32x2){w1_.z, w1_.w} + (sav * (f32x2){b1.z, b1.w} + vvv * (f32x2){k1.z, k1.w}); \
                    const float ov = p + sa * sp.y + vv * sp.z; \
                    __builtin_amdgcn_sched_barrier(0); RW2_LD_UPD((T) + 1); *(float*)(const_cast<unsigned char*>(pv_) + O_OUT + (T) * 256) = ov;        __builtin_amdgcn_sched_barrier(0); } while (0)
                RW2_LD_DOT(0); RW2_LD_UPD(0);
#pragma unroll 1
                for (int t4 = 0; t4 < 8; ++t4) {
                    RW2_STEP(0); RW2_STEP(1); RW2_STEP(2); RW2_STEP(3);
                    pk_ += 1024; pv_ += 1024; ps_ += 64;
                }
#undef RW2_LD_DOT
#undef RW2_LD_UPD
#undef RW2_STEP
            }
            __syncthreads();
            {
                const int t = c.tid >> 3, q = (c.tid >> 2) & 1, qu = c.tid & 3;
                if (c.tid < 256) {
                    const float* src = A_OUT + t * 64 + 16 * qu; float sm = 0.f;
#pragma unroll
                    for (int e = 0; e < 4; ++e) { const f32x4 v = *(const f32x4*)(src + 4 * e); sm += q ? ((v.x * v.x + v.y * v.y) + (v.z * v.z + v.w * v.w)) : ((v.x + v.y) + (v.z + v.w)); }
                    sm += dpp_mov<0xB1>(sm); sm += dpp_mov<0x4E>(sm);
                    const float other = dpp_mov<0x141>(sm);
                    if ((c.tid & 7) == 0) { const float mean = sm * (1.f / 64.f), var = fmaxf(other * (1.f / 64.f) - mean * mean, 0.f); GN[t * 2] = mean; GN[t * 2 + 1] = 1.0f / sqrtf(var + 64e-5f); }
                }
            }
            __syncthreads();
#pragma unroll
            for (int i = 0; i < 4; ++i) {
                const int t = w + 8 * i, o = t * 64 + l;
                float y = (A_OUT[o] - GN[t * 2]) * GN[t * 2 + 1] * CST[320 + l] + CST[384 + l];
                y = (y + SCP[t * 4 + 3] * A_V[o]) * A_G[o];
                if (b < wb) OUT[((size_t)b * SEQ + t0 + t) * ldo + coloff + hk] = (bf16)f2bf(y);
            }
        }
#undef RW2_LOAD
    }
}
constexpr int S5B_BUP = 132 * 4, S5B_XP = 272;
constexpr int S5B_WAVE = 16 * S5B_BUP + 16 * S5B_XP;
__device__ __forceinline__ void wave_lds_sync() { __builtin_amdgcn_fence(__ATOMIC_RELEASE, "wavefront"); __builtin_amdgcn_wave_barrier(); __builtin_amdgcn_fence(__ATOMIC_ACQUIRE, "wavefront"); }
__device__ __forceinline__ void s5_phase2(const Ctx& c, const bf16* __restrict__ U, const S5P P, bf16* Z) {
    if (c.wave >= 4) return;
    float* BU = (float*)(c.lds + c.wave * S5B_WAVE); unsigned char* XB = c.lds + c.wave * S5B_WAVE + 16 * S5B_BUP;
    const int l = c.lane, n16 = l & 15, g = l >> 4;
#pragma unroll 1
    for (int item = c.bid; item < 256; item += c.nb) {
        const int b = item >> 5, grp = (item & 31) * 4 + c.wave;
        float lbr, lbi;
        { const float lr = fminf(P.lam_re[grp * 64 + l], -1e-4f), li = P.lam_im[grp * 64 + l], dt = expf(P.log_dt[grp]);
          const float e = expf(lr * dt); lbr = e * cosf(li * dt); lbi = e * sinf(li * dt);
          const float nr = lbr - 1.f, ni = lbi, den = 1.f / (lr * lr + li * li);
          BU[l] = (nr * lr + ni * li) * den; BU[64 + l] = (ni * lr - nr * li) * den; }
        wave_lds_sync();
        bf16x4 Bre[4], Bim[4];
#pragma unroll
        for (int nt = 0; nt < 4; ++nt) { const int p = 16 * nt + n16; const float cr = BU[p], ci = BU[64 + p];
            const f32x4 br = *(const f32x4*)(P.b_re + (size_t)(grp * 64 + p) * 16 + 4 * g), bi = *(const f32x4*)(P.b_im + (size_t)(grp * 64 + p) * 16 + 4 * g);
            u32x2 wr, wi; wr.x = pk2(cr * br.x - ci * bi.x, cr * br.y - ci * bi.y); wr.y = pk2(cr * br.z - ci * bi.z, cr * br.w - ci * bi.w);
            wi.x = pk2(cr * bi.x + ci * br.x, cr * bi.y + ci * br.y); wi.y = pk2(cr * bi.z + ci * br.z, cr * bi.w + ci * br.w);
            Bre[nt] = __builtin_bit_cast(bf16x4, wr); Bim[nt] = __builtin_bit_cast(bf16x4, wi); }
        wave_lds_sync();
        bf16x8 Cf[4];
#pragma unroll
        for (int kk = 0; kk < 4; ++kk) { const int k0 = 32 * kk + 8 * g; const float sg = (kk < 2) ? 1.f : -1.f;
            const float* src = ((kk < 2) ? P.c_re : P.c_im) + (size_t)(grp * 16 + n16) * 64 + (k0 & 63);
            const f32x4 v0 = *(const f32x4*)src, v1 = *(const f32x4*)(src + 4);
            u32x4 w; w.x = pk2(sg * v0.x, sg * v0.y); w.y = pk2(sg * v0.z, sg * v0.w); w.z = pk2(sg * v1.x, sg * v1.y); w.w = pk2(sg * v1.z, sg * v1.w); Cf[kk] = __builtin_bit_cast(bf16x8, w); }
        const float dsk = P.d[grp * 16 + n16];
        float xr = 0.f, xi = 0.f;
        const bf16* ub = U + (size_t)b * SEQ * D + grp * 16;
        u32x2 ua[4]; unsigned short ue[4][4];
#define S5B_LOAD(k, T0) do { ua[k] = *(const u32x2*)(ub + (size_t)((T0) + n16) * D + 4 * g); _Pragma("unroll") for (int r = 0; r < 4; ++r) ue[k][r] = ub[(size_t)((T0) + 4 * g + r) * D + n16]; } while (0)
#pragma unroll
        for (int k = 0; k < 4; ++k) S5B_LOAD(k, 16 * k);
#pragma unroll 1
        for (int t0 = 0; t0 < SEQ; t0 += 64) {
#pragma unroll
            for (int k = 0; k < 4; ++k) {
                const int tb = t0 + 16 * k;
                const bf16x4 A = __builtin_bit_cast(bf16x4, ua[k]);
                float uf[4];
#pragma unroll
                for (int r = 0; r < 4; ++r) uf[r] = bf2f(ue[k][r]);
                if (tb + 64 < SEQ) S5B_LOAD(k, tb + 64);
#pragma unroll
                for (int nt = 0; nt < 4; ++nt) {
                    const f32x4 ar = __builtin_amdgcn_mfma_f32_16x16x16bf16_1k(A, Bre[nt], (f32x4){0.f, 0.f, 0.f, 0.f}, 0, 0, 0);
                    const f32x4 ai = __builtin_amdgcn_mfma_f32_16x16x16bf16_1k(A, Bim[nt], (f32x4){0.f, 0.f, 0.f, 0.f}, 0, 0, 0);
#pragma unroll
                    for (int r = 0; r < 4; ++r) { BU[(4 * g + r) * 132 + 16 * nt + n16] = ar[r]; BU[(4 * g + r) * 132 + 64 + 16 * nt + n16] = ai[r]; }
                }
                wave_lds_sync();
#pragma unroll 4
                for (int t = 0; t < 16; ++t) {
                    const float br = BU[t * 132 + l], bi = BU[t * 132 + 64 + l];
                    const float nxr = lbr * xr - lbi * xi + br, nxi = lbr * xi + lbi * xr + bi; xr = nxr; xi = nxi;
                    *(unsigned short*)(XB + t * S5B_XP + l * 2) = (unsigned short)f2bf(xr); *(unsigned short*)(XB + t * S5B_XP + 128 + l * 2) = (unsigned short)f2bf(xi);
                }
                wave_lds_sync();
                f32x4 y = (f32x4){0.f, 0.f, 0.f, 0.f};
#pragma unroll
                for (int kk = 0; kk < 4; ++kk) { const bf16x8 Ax = *(const bf16x8*)(XB + n16 * S5B_XP + (32 * kk + 8 * g) * 2); y = __builtin_amdgcn_mfma_f32_16x16x32_bf16(Ax, Cf[kk], y, 0, 0, 0); }
#pragma unroll
                for (int r = 0; r < 4; ++r) Z[((size_t)b * SEQ + tb + 4 * g + r) * D + grp * 16 + n16] = (bf16)f2bf(gelu_tanh(y[r] + dsk * uf[r]));
                wave_lds_sync();
            }
        }
#undef S5B_LOAD
    }
}
struct Args { const void* in[45]; float* out; unsigned char* ws; int ph_lo, ph_hi; };
static_assert(sizeof(Args) == 45 * 8 + 8 + 8 + 8, "Args has no padding");
constexpr int PH_EVEN = 9, PH_ODD = 4, PH_COMMON = 13;
constexpr int NPHASES = 2 * (1 + PH_EVEN + PH_COMMON) + 2 * (1 + PH_ODD + PH_COMMON) + 1;

__global__ void __launch_bounds__(NTHR, 2) mega(Args args) {
    extern __shared__ __attribute__((aligned(16))) unsigned char lds[];
    volatile LAS unsigned* MISC = (volatile LAS unsigned*)((LAS unsigned char*)lds + MISC_OFF);
    if (threadIdx.x < 64) MISC[threadIdx.x] = 0u;
    __syncthreads();
    unsigned char* ws = args.ws;
    XcdBarrier bar = xcd_barrier_post((unsigned*)(ws + WS_CTL) + 4096, MISC + 8, gridDim.x);
    const int half = (int)gridDim.x >> 1;
    XcdBarrier bar2 = bar; if ((int)blockIdx.x >= half) bar2 = xcd_barrier_post((unsigned*)(ws + WS_CTL) + 8192, MISC + 10, gridDim.x - half);
    const int lo = args.ph_lo, hi = args.ph_hi;
    int pid = 0;
#define PH_BEGIN if (pid >= lo && pid < hi) { Ctx c; { int t_ = threadIdx.x, b_ = blockIdx.x; asm volatile("" : "+v"(t_)); asm volatile("" : "+s"(b_)); c.lds = lds; c.tid = t_; c.lane = t_ & 63; c.wave = __builtin_amdgcn_readfirstlane(t_ >> 6); c.bid = b_; { int n_ = gridDim.x; asm volatile("" : "+s"(n_)); c.nb = n_; } c.gw = c.bid * NWAVES + c.wave; c.ngw = c.nb * NWAVES; }
#define PH_END } if (pid >= lo && pid + 1 < hi) { xcd_barrier(bar); if (DBL & 2048) xcd_barrier(bar); } ++pid;
#define IN_F(i) (*(const float* const __attribute__((address_space(4)))*)(KARGS() + 8 * (i)))

    typedef const unsigned char __attribute__((address_space(4)))* kptr_t;
#define KARGS() ({ kptr_t p_ = (kptr_t)__builtin_amdgcn_kernarg_segment_ptr(); asm volatile("" : "+s"(p_)); p_; })
#define WSP(off) ((*(unsigned char* const __attribute__((address_space(4)))*)(KARGS() + 368)) + (off))
#define X ((float*)(*(float* const __attribute__((address_space(4)))*)(KARGS() + 360)))
#define ROPEA ((float*)WSP(WS_ROPEA))
#define ROPEI ((float*)WSP(WS_ROPEI))
#define KVBIG ((bf16*)WSP(WS_KVBIG))
#define WKV ((bf16*)WSP(WS_WKV))
#define W_IN ((bf16*)WSP(WS_WMIX + WMIX_IN))
#define WQ ((bf16*)WSP(WS_WMIX + WMIX_Q))
#define WOUT ((bf16*)WSP(WS_WMIX + WMIX_OUT))
#define WO_IN ((bf16*)WSP(WS_WMIX + WMIX_O_IN))
#define WO_GLU ((bf16*)WSP(WS_WMIX + WMIX_O_GLU))
#define WO_OUT ((bf16*)WSP(WS_WMIX + WMIX_O_OUT))
#define WXQ ((bf16*)WSP(WS_WXQ))
#define WXO ((bf16*)WSP(WS_WXO))
#define WUP ((bf16*)WSP(WS_WUP))
#define WDN ((bf16*)WSP(WS_WDN))
#define CQN ((bf16*)WSP(WS_CQN))
#define KF ((bf16*)WSP(WS_KF))
#define KIDX ((bf16*)WSP(WS_KIDX))
#define WIDX ((float*)WSP(WS_WIDX))
#define SEL ((bf16*)WSP(WS_SEL))
#define Hb ((bf16*)WSP(WS_R1))
#define SC ((float*)WSP(WS_R1))
#define HID ((bf16*)WSP(WS_R1))
#define Ub ((bf16*)WSP(WS_R1))
#define YC ((bf16*)WSP(WS_R1 + (size_t)M * D * 2))
#define XN ((bf16*)WSP(WS_R2))
#define QALL ((bf16*)X)
#define OLY ((bf16*)WSP(WS_R3))
#define Zb ((bf16*)WSP(WS_R3))
#define XQ ((bf16*)WSP(WS_R3))
#define XO ((bf16*)WSP(WS_R3 + (size_t)M * 512 * 2))
#define MEMN ((bf16*)WSP(WS_R3))
    LAS unsigned char* glds = (LAS unsigned char*)lds;

#define RS_A ((unsigned long long*)WSP(WS_CTL + 131072))
#define RS_B ((unsigned long long*)WSP(WS_CTL + 393216))
#define RS_C ((unsigned long long*)WSP(WS_CTL + 655360))
    for (int layer = 0; layer < DEPTH; ++layer) {
        const int li = layer >> 1;
        PH_BEGIN
            if ((layer & 1) == 0) {
                conv_mat(c, IN_F(13) + (size_t)li * 2048 * EVEN_COLS, 2048, EVEN_COLS, EVEN_COLS, HC, W_IN, 2048, 0, 0, IN_F(3) + layer * D);
                build_wql(c, IN_F(18) + (size_t)li * 512 * 1024, IN_F(19) + (size_t)li * 256 * 768, WQ);
                for (int h = 0; h < 8; ++h) conv_mat(c, IN_F(18) + (size_t)li * 512 * 1024 + h * 128, 512, 1024, 32, 32, WQ, 512, 2048 + h * 32, 0);
                conv_mat(c, IN_F(21) + (size_t)li * 512 * 1024, 512, 1024, 1024, 1024, WQ, 512, 2304, 0);
                build_wout(c, IN_F(20) + (size_t)li * 256 * 1024, IN_F(14) + (size_t)li * 2048 * 2048, WOUT);
                conv_mat(c, IN_F(14) + (size_t)li * 2048 * 2048 + (size_t)1024 * 2048, 1024, 2048, 2048, 2048, WOUT, OC, 0, 2048);
            } else {
                conv_mat(c, IN_F(33) + (size_t)li * 2048 * 2048, 2048, 2048, 2048, 2048, WO_IN, 2048, 0, 0, IN_F(3) + layer * D);
                conv_mat(c, IN_F(43) + (size_t)li * 2048 * 2048, 2048, 2048, 2048, 2048, WO_GLU, 2048, 0, 0);
                conv_mat(c, IN_F(34) + (size_t)li * 2048 * 2048, 2048, 2048, 2048, 2048, WO_OUT, 2048, 0, 0);
            }
            conv_mat(c, IN_F(8) + (size_t)layer * 2048 * 512, 2048, 512, 512, 512, WXQ, 2048, 0, 0, IN_F(4) + layer * D);
            conv_mat(c, IN_F(10) + (size_t)layer * 512 * 2048, 512, 2048, 2048, 2048, WXO, 512, 0, 0);
            { unsigned long long* ra = RS_A; unsigned long long* rb = RS_B; for (int i = c.bid * NTHR + c.tid; i < M; i += c.nb * NTHR) { ra[i] = 0ull; rb[i] = 0ull; } }
            if (layer == 0) {
                for (int l2 = 0; l2 < 4; ++l2) {
                    conv_mat(c, IN_F(9) + (size_t)l2 * 2048 * 1024, 2048, 1024, 1024, 1024, WKV, 2048, l2 * 1024, 0);
                    norm_rows_bf16(c, IN_F(1), IN_F(5) + l2 * D, MEMN + (size_t)l2 * MEMR * D, MEMR);
                }
                rope_tables(c, (const int*)IN_F(2), ROPEA, ROPEI);
                cast_rows_ss(c, IN_F(0), XN, RS_C, M);
            }
        PH_END
        if ((layer & 1) == 0) {
            PH_BEGIN
                { pg8::Gemm g{XN, W_IN, 2048, 2048, 2048}; pg8::StaticOrder S; S.init(128, HC / 256, c.nb, c.bid); pg8::EpiBf16<0> E{Hb, HC, RS_C};
                  pg8::gemm_phase<pg8::EpiBf16<0>, pg8::StaticOrder, true, true>(glds, g, S, E);
                  if (DBL & 1024) { __syncthreads(); pg8::gemm_phase<pg8::EpiBf16<0>, pg8::StaticOrder, true, true>(glds, g, S, E); } }
                if (layer == 0) { __syncthreads(); pg8::Gemm g{MEMN, WKV, 2048, 2048, 2048}; pg8::KvOrder S{c.nb, c.bid}; pg8::EpiBf16<0> E{KVBIG, 4096, nullptr};
                  pg8::gemm_phase<pg8::EpiBf16<0>, pg8::KvOrder, true, true>(glds, g, S, E); }
            PH_END
            PH_BEGIN
                rwkv_lora_prep(c, Hb, IN_F(22) + li * B_COLS, (bf16*)WSP(WS_END + 96 * MiB));
            PH_END
            PH_BEGIN
                if (c.bid < half) {
                    Ctx r = c; r.nb = half; r.ngw = half * NWAVES;
                    const RwkvP P{IN_F(22) + li * B_COLS, IN_F(23) + li * 1024, IN_F(24) + (size_t)li * 65536, IN_F(25) + li * 1024, IN_F(26) + (size_t)li * 65536, IN_F(27) + (size_t)li * 163840,
                                  IN_F(28) + li * 1024, IN_F(29) + li * 1024, IN_F(30) + li * 1024, IN_F(31) + li * 1024, IN_F(32) + li * 1024};
#if DIAG == 4
                    rwkv_phase(r, Hb, P, OLY);
                    rwkv_phase2(r, Hb, (const bf16*)WSP(WS_END + 96 * MiB), P, (bf16*)WSP(WS_END + 116 * MiB), 1024, 0, 1);
#else
                    rwkv_phase2(r, Hb, (const bf16*)WSP(WS_END + 96 * MiB), P, OLY, OC, 2048);
#endif
                    __syncthreads();
                    conv_mat(r, IN_F(12) + (size_t)layer * FFN * 2048, FFN, 2048, 2048, 2048, WDN, FFN, 0, 0);
                } else {
                    Ctx d = c; d.bid = c.bid - half; d.nb = c.nb - half; d.gw = d.bid * NWAVES + d.wave; d.ngw = d.nb * NWAVES;
                    dsa_prep(d, Hb, IN_F(15) + li * 512, IN_F(16) + li * 256, IN_F(17) + li * 64, ROPEA, ROPEI, CQN, KF, KIDX, WIDX);
                    xcd_barrier(bar2);
                    { pg8::Gemm g{CQN, WQ, 512, 512, 512}; pg8::StaticOrder S; S.init(128, QC / 256, d.nb, d.bid); pg8::EpiBf16<0> E{QALL, QC, nullptr};
                      pg8::gemm_phase<pg8::EpiBf16<0>, pg8::StaticOrder, true, true>(glds, g, S, E); }
                    xcd_barrier(bar2);
                    idx_topk_mfma(d, QALL, KIDX, WIDX, ROPEI, (float*)(d.bid < 32 ? WSP(WS_CQN + (size_t)d.bid * MiB) : WSP(WS_END + (size_t)(d.bid - 32) * MiB)), SEL, 256);
                    conv_mat(d, IN_F(11) + (size_t)layer * 2048 * FFN, 2048, FFN, FFN, FFN, WUP, 2048, 0, 0, IN_F(6) + layer * D);
                    xcd_barrier(bar2);
                    if (d.bid == 0 && c.tid == 0) __hip_atomic_store((unsigned*)WSP(WS_CTL) + 12288 + 64 * (2 + li), 1u, __ATOMIC_RELAXED, __HIP_MEMORY_SCOPE_AGENT);
                }
                if (c.bid < half) {
                    if (c.tid == 0) { unsigned* fl = (unsigned*)WSP(WS_CTL) + 12288 + 64 * (2 + li); unsigned sp = 0;
                        while (__hip_atomic_load(fl, __ATOMIC_RELAXED, __HIP_MEMORY_SCOPE_AGENT) == 0u) { __builtin_amdgcn_s_sleep(8); if (++sp > (1u << 22)) break; } }
                    __syncthreads();
                    __builtin_amdgcn_fence(__ATOMIC_ACQUIRE, "agent"); asm volatile("s_waitcnt vmcnt(0)" ::: "memory");
                }
                dsa_attn_queue(c, QALL, KF, SEL, ROPEA, OLY, (unsigned*)WSP(WS_CTL) + 12288 + 64 * li, MISC + 12);
            PH_END
#if DBL & 32
            PH_BEGIN
                if (c.bid < half) {
                    Ctx r = c; r.nb = half; r.ngw = half * NWAVES;
                    const RwkvP P{IN_F(22) + li * B_COLS, IN_F(23) + li * 1024, IN_F(24) + (size_t)li * 65536, IN_F(25) + li * 1024, IN_F(26) + (size_t)li * 65536, IN_F(27) + (size_t)li * 163840,
                                  IN_F(28) + li * 1024, IN_F(29) + li * 1024, IN_F(30) + li * 1024, IN_F(31) + li * 1024, IN_F(32) + li * 1024};
                    rwkv_phase2(r, Hb, (const bf16*)WSP(WS_END + 96 * MiB), P, OLY, OC, 2048);
                }
            PH_END
#endif
#if DBL & 8
            PH_BEGIN
                if (c.bid >= half) {
                    Ctx d = c; d.bid = c.bid - half; d.nb = c.nb - half; d.gw = d.bid * NWAVES + d.wave; d.ngw = d.nb * NWAVES;
                    idx_topk_mfma(d, QALL, KIDX, WIDX, ROPEI, (float*)(d.bid < 32 ? WSP(WS_CQN + (size_t)d.bid * MiB) : WSP(WS_END + (size_t)(d.bid - 32) * MiB)), SEL, 256);
                }
            PH_END
#endif
#if DIAG == 4
            PH_BEGIN
                diag_cmp_bf16(c, OLY + 2048, OC, (bf16*)WSP(WS_END + 116 * MiB), 1024, SEQ, 1024, (float*)WSP(WS_CTL + 65536));
            PH_END
#endif
#if DIAG == 7 || DIAG == 8
            PH_BEGIN
                q_rope_fix(c, QALL, ROPEA, ROPEI);
            PH_END
#endif
#if DIAG == 7
            PH_BEGIN
                if (c.bid >= half) { Ctx d = c; d.bid = c.bid - half; d.nb = c.nb - half; d.gw = d.bid * NWAVES + d.wave; d.ngw = d.nb * NWAVES;
                    idx_topk_v1(d, QALL, KIDX, WIDX, (float*)(d.bid < 32 ? WSP(WS_CQN + (size_t)d.bid * MiB) : WSP(WS_END + (size_t)(d.bid - 32) * MiB)), (bf16*)WSP(WS_END + 116 * MiB), 128); }
            PH_END
            PH_BEGIN
                diag_cmp_sel(c, SEL, (bf16*)WSP(WS_END + 116 * MiB), 4, (float*)WSP(WS_CTL + 65536));
            PH_END
#endif
#if DIAG == 8
            PH_BEGIN
                dsa_attn_simple(c, QALL, KF, SEL, (bf16*)WSP(WS_END + 116 * MiB), 1024);
            PH_END
            PH_BEGIN
                diag_cmp_bf16(c, OLY, OC, (bf16*)WSP(WS_END + 116 * MiB), OC, 1024, 2048, (float*)WSP(WS_CTL + 65536));
            PH_END
#endif
            PH_BEGIN
                { pg8::Gemm g{OLY, WOUT, OC, OC, OC}; pg8::StaticOrder S; S.init(128, 8, c.nb, c.bid); pg8::EpiRes E{XN, D, RS_A};
                  pg8::gemm_phase<pg8::EpiRes, pg8::StaticOrder, true, true>(glds, g, S, E); }
            PH_END
        } else {
            PH_BEGIN
                { pg8::Gemm g{XN, WO_IN, 2048, 2048, 2048}; pg8::StaticOrder S; S.init(128, 8, c.nb, c.bid); pg8::EpiBf16<0> E{Ub, D, RS_C};
                  pg8::gemm_phase<pg8::EpiBf16<0>, pg8::StaticOrder, true, true>(glds, g, S, E);
                  if (DBL & 1024) { __syncthreads(); pg8::gemm_phase<pg8::EpiBf16<0>, pg8::StaticOrder, true, true>(glds, g, S, E); } }
            PH_END
            PH_BEGIN
                { const S5P P{IN_F(35) + li * 8192, IN_F(36) + li * 8192, IN_F(37) + li * 128, IN_F(38) + (size_t)li * 131072, IN_F(39) + (size_t)li * 131072, IN_F(40) + (size_t)li * 131072, IN_F(41) + (size_t)li * 131072, IN_F(42) + li * D};
                  s5_phase2(c, Ub, P, Zb); }
                if (c.wave >= 4) {
                    Ctx v = c; v.lds = c.lds + 65536 - 4 * 8704; v.gw = c.bid * 4 + (c.wave - 4); v.ngw = c.nb * 4;
                    conv_mat(v, IN_F(11) + (size_t)layer * 2048 * FFN, 2048, FFN, FFN, FFN, WUP, 2048, 0, 0, IN_F(6) + layer * D);
                    conv_mat(v, IN_F(12) + (size_t)layer * FFN * 2048, FFN, 2048, 2048, 2048, WDN, FFN, 0, 0);
                }
            PH_END
#if DIAG == 5
            PH_BEGIN
                { const S5P P{IN_F(35) + li * 8192, IN_F(36) + li * 8192, IN_F(37) + li * 128, IN_F(38) + (size_t)li * 131072, IN_F(39) + (size_t)li * 131072, IN_F(40) + (size_t)li * 131072, IN_F(41) + (size_t)li * 131072, IN_F(42) + li * D};
                  s5_phase(c, Ub, P, YC); }
            PH_END
            PH_BEGIN
                diag_cmp_bf16(c, YC, D, Zb, D, M, D, (float*)WSP(WS_CTL + 65536));
            PH_END
#endif
            PH_BEGIN
                { pg8::Gemm g{Zb, WO_GLU, 2048, 2048, 2048}; pg8::StaticOrder S; S.init(128, 8, c.nb, c.bid); pg8::EpiGlu E{Zb, YC, D, IN_F(44) + li * D};
                  pg8::gemm_phase<pg8::EpiGlu, pg8::StaticOrder, true, true>(glds, g, S, E); }
            PH_END
            PH_BEGIN
                { pg8::Gemm g{YC, WO_OUT, 2048, 2048, 2048}; pg8::StaticOrder S; S.init(128, 8, c.nb, c.bid); pg8::EpiRes E{XN, D, RS_A};
                  pg8::gemm_phase<pg8::EpiRes, pg8::StaticOrder, true, true>(glds, g, S, E); }
            PH_END
        }
        PH_BEGIN
            { unsigned long long* rc = RS_C; for (int i = c.bid * NTHR + c.tid; i < M; i += c.nb * NTHR) rc[i] = 0ull; }
            { pg8::Gemm g{XN, WXQ, 2048, 2048, 2048}; pg8::StaticOrder S; S.init(128, 2, c.nb, c.bid); pg8::EpiBf16<0> E{XQ, 512, RS_A};
              pg8::gemm_phase<pg8::EpiBf16<0>, pg8::StaticOrder, true, true>(glds, g, S, E); }
        PH_END
        PH_BEGIN
            xattn_mfma(c, XQ, KVBIG, layer, XO); if (DBL & 128) { asm volatile("" ::: "memory"); xattn_mfma(c, XQ, KVBIG, layer, XO); }
        PH_END
        PH_BEGIN
            { pg8::Gemm g{XO, WXO, 512, 512, 512}; pg8::StaticOrder S; S.init(128, 8, c.nb, c.bid); pg8::EpiRes E{XN, D, RS_B};
              pg8::gemm_phase<pg8::EpiRes, pg8::StaticOrder, true, true>(glds, g, S, E); }
        PH_END
        for (int q = 0; q < 5; ++q) {
            PH_BEGIN
                if (q > 0) { const int qd = q - 1; bf16* hid = HID + (size_t)(qd & 1) * 8192 * FFN;
                    pg8::Gemm g{hid, WDN, FFN, FFN, FFN}; pg8::StaticOrder S; S.init(32, 8, c.nb, c.bid); pg8::EpiRes E{XN + (size_t)qd * 8192 * D, D, RS_C + qd * 8192};
                    pg8::gemm_phase<pg8::EpiRes, pg8::StaticOrder, true, true>(glds, g, S, E); __syncthreads(); }
                if (q < 4) { bf16* hid = HID + (size_t)(q & 1) * 8192 * FFN;
                    pg8::Gemm g{XN + (size_t)q * 8192 * D, WUP, 2048, 2048, 2048}; pg8::StaticOrder S; S.init(32, 32, c.nb, c.bid); pg8::EpiBf16<1> E{hid, FFN, RS_B + q * 8192};
                    pg8::gemm_phase<pg8::EpiBf16<1>, pg8::StaticOrder, true, true>(glds, g, S, E); }
            PH_END
        }
    }
    PH_BEGIN
        scale_rows_out(c, XN, IN_F(7), RS_C, X, M);
    PH_END
#if DIAG
    PH_BEGIN
        { const float* dg = (const float*)WSP(WS_CTL + 65536); const float sc = 1.f + sqrtf(100.f * dg[0] / fmaxf(dg[1], 1e-30f));
          float* xo = X; for (size_t i = (size_t)c.bid * NTHR + c.tid; i < (size_t)M * D; i += (size_t)c.nb * NTHR) xo[i] *= sc; }
    PH_END
#endif
#undef PH_BEGIN
#undef PH_END
#undef IN_F
#undef X
}

extern "C" void kernel_launch(void* const* d_in, const int* in_sizes, int n_in, void* d_out, int out_size, void* d_ws, size_t ws_size, hipStream_t stream) {
    static int grid = 0;
    if (grid == 0) {
        if (n_in != 45 || out_size != M * D || ws_size < WS_END + 116 * MiB) { fprintf(stderr, "kernel_launch: unexpected shapes (n_in %d, out %d, ws %zu, need %zu)\n", n_in, out_size, ws_size, (size_t)WS_END); grid = -1; return; }
        int dev = 0, cus = 0, per_cu = 0;
        if (hipGetDevice(&dev) != hipSuccess || hipDeviceGetAttribute(&cus, hipDeviceAttributeMultiprocessorCount, dev) != hipSuccess) { grid = -1; return; }
        if (hipFuncSetAttribute((const void*)mega, hipFuncAttributeMaxDynamicSharedMemorySize, LDS_BYTES) != hipSuccess) { fprintf(stderr, "kernel_launch: hipFuncSetAttribute failed\n"); grid = -1; return; }
        if (hipOccupancyMaxActiveBlocksPerMultiprocessor(&per_cu, (const void*)mega, NTHR, LDS_BYTES) != hipSuccess || per_cu < 1) fprintf(stderr, "kernel_launch: occupancy query reports %d\n", per_cu);
        (void)hipGetLastError();
        grid = cus;
    }
    if (grid < 0) return;
    (void)hipMemsetAsync((char*)d_ws + WS_CTL, 0, CTL_BYTES, stream);
    Args a{};
    for (int i = 0; i < 45; ++i) a.in[i] = d_in[i];
    a.out = (float*)d_out; a.ws = (unsigned char*)d_ws;
#if MK_ONE_LAUNCH
    a.ph_lo = 0; a.ph_hi = 1 << 20;
    hipLaunchKernelGGL(mega, dim3(grid), dim3(NTHR), LDS_BYTES, stream, a);
#else
    for (int p = 0; p < NPHASES; ++p) { a.ph_lo = p; a.ph_hi = p + 1; hipLaunchKernelGGL(mega, dim3(grid), dim3(NTHR), LDS_BYTES, stream, a); }
#endif
}
```

```cpp
#include <hip/hip_runtime.h>
#include <cstdio>
#include <cstdint>

#ifndef DIAG
#define DIAG 0
#endif
#ifndef ATTN_SPLIT
#define ATTN_SPLIT 0
#endif
#ifndef DBL
#define DBL 0
#endif
#ifndef MK_ONE_LAUNCH
#define MK_ONE_LAUNCH 1
#endif

constexpr int D = 2048, NB = 8, SEQ = 4096, M = NB * SEQ, DEPTH = 4;
constexpr int HC = 4352;
constexpr int EVEN_COLS = 4240, A_COLS = 880, B_COLS = 3360;
constexpr int QC = 3328;
constexpr int OC = 3072;
constexpr int KFW = 288;
constexpr int FFN = 8192;
constexpr int MEMR = NB * 256;
constexpr float NORM_EPS = 1e-5f;
constexpr size_t SC_PER_BATCH = (size_t)4096 * 64 * 65 / 2;

typedef unsigned short bf16;
typedef float f32x4 __attribute__((ext_vector_type(4)));
typedef unsigned u32x4 __attribute__((ext_vector_type(4)));
typedef unsigned u32x2 __attribute__((ext_vector_type(2)));
typedef float f32x2 __attribute__((ext_vector_type(2)));
#define LAS __attribute__((address_space(3)))

constexpr size_t MiB = 1u << 20;
constexpr size_t al256(size_t x) { return (x + 255) & ~(size_t)255; }
constexpr size_t WS_CTL = 0, CTL_BYTES = 1 * MiB;
constexpr size_t WS_ROPEA = WS_CTL + CTL_BYTES;
constexpr size_t WS_ROPEI = WS_ROPEA + (size_t)M * 32 * 4;
constexpr size_t WS_KVBIG = WS_ROPEI + (size_t)M * 16 * 4;
constexpr size_t WS_WKV = WS_KVBIG + (size_t)8192 * 4096 * 2;
constexpr size_t WS_WMIX = WS_WKV + (size_t)4096 * 2048 * 2;
constexpr size_t WMIX_IN = 0, WMIX_Q = (size_t)HC * 2048 * 2, WMIX_OUT = WMIX_Q + (size_t)QC * 512 * 2, WMIX_BYTES = WMIX_OUT + (size_t)2048 * OC * 2;
constexpr size_t WMIX_O_IN = 0, WMIX_O_GLU = (size_t)2048 * 2048 * 2, WMIX_O_OUT = 2 * WMIX_O_GLU;
constexpr size_t WS_WXQ = al256(WS_WMIX + WMIX_BYTES);
constexpr size_t WS_WXO = WS_WXQ + (size_t)512 * 2048 * 2;
constexpr size_t WS_WUP = WS_WXO + (size_t)2048 * 512 * 2;
constexpr size_t WS_WDN = WS_WUP + (size_t)FFN * 2048 * 2;
constexpr size_t WS_CQN = WS_WDN + (size_t)2048 * FFN * 2;
constexpr size_t WS_KF = WS_CQN + (size_t)M * 512 * 2;
constexpr size_t WS_KIDX = WS_KF + (size_t)M * KFW * 2;
constexpr size_t WS_WIDX = WS_KIDX + (size_t)M * 64 * 2;
constexpr size_t WS_SEL = WS_WIDX + (size_t)M * 16 * 4;
constexpr size_t WS_R1 = al256(WS_SEL + (size_t)M * 256 * 2);
constexpr size_t R1_BYTES = (size_t)M * HC * 2;
constexpr size_t WS_R2 = WS_R1 + R1_BYTES;
constexpr size_t R2_BYTES = (size_t)M * QC * 2;
constexpr size_t WS_R3 = WS_R2 + R2_BYTES;
constexpr size_t R3_BYTES = (size_t)M * OC * 2;
constexpr size_t WS_END = WS_R3 + R3_BYTES;
static_assert(SC_PER_BATCH * NB * 4 <= R1_BYTES, "scores fit R1");
static_assert((size_t)8192 * FFN * 2 <= R1_BYTES && (size_t)M * 2048 * 2 * 2 <= R1_BYTES, "R1 overlays");

__device__ __forceinline__ float bf2f(unsigned v) { return __uint_as_float(v << 16); }
__device__ __forceinline__ unsigned f2bf(float f) { unsigned u = __float_as_uint(f); return (u + 0x7fffu + ((u >> 16) & 1u)) >> 16; }
__device__ __forceinline__ unsigned pk2(float lo, float hi) { return f2bf(lo) | (f2bf(hi) << 16); }
__device__ __forceinline__ float wave_sum(float v) {
#pragma unroll
    for (int o = 1; o < 64; o <<= 1) v += __shfl_xor(v, o);
    return v;
}
__device__ __forceinline__ float wave_max(float v) {
#pragma unroll
    for (int o = 1; o < 64; o <<= 1) v = fmaxf(v, __shfl_xor(v, o));
    return v;
}
__device__ __forceinline__ void unpack8(const u32x4 w, float* f) {
    f[0] = __uint_as_float(w.x << 16); f[1] = __uint_as_float(w.x & 0xffff0000u); f[2] = __uint_as_float(w.y << 16); f[3] = __uint_as_float(w.y & 0xffff0000u);
    f[4] = __uint_as_float(w.z << 16); f[5] = __uint_as_float(w.z & 0xffff0000u); f[6] = __uint_as_float(w.w << 16); f[7] = __uint_as_float(w.w & 0xffff0000u);
}
__device__ __forceinline__ float sigmoidf_(float x) { return 1.f / (1.f + __expf(-x)); }
namespace pg8 {
#define PG8_LAS __attribute__((address_space(3)))
typedef unsigned short bf16_t;
typedef short bf16x8 __attribute__((ext_vector_type(8)));
typedef float f32x4 __attribute__((ext_vector_type(4)));
typedef unsigned u32x4 __attribute__((ext_vector_type(4)));
constexpr int BM = 256, BK = 64, HALF = 128, HTB = HALF * BK * 2, STAGE_BYTES = 8 * HTB, NXCD = 8, WGM = 8;

__host__ __device__ __forceinline__ int lds_byte(int r, int c) { const int st = (r >> 4) * 2 + (c >> 5), rr = r & 15, cc = c & 31, ob = rr * 64 + cc * 2; return st * 1024 + (ob ^ (((ob >> 9) & 1) << 5)); }
__host__ __device__ __forceinline__ void stage_rc(int b, int& R, int& C) { const int st = b / 1024, sb = b % 1024, swz = sb ^ (((sb >> 9) & 1) << 5); R = (st >> 1) * 16 + swz / 64; C = (st & 1) * 32 + (swz % 64) / 2; }
__host__ __device__ __forceinline__ int perm32(int rho) { const int n = rho >> 4, i = rho & 15; return 8 * (i >> 2) + 4 * n + (i & 3); }

struct Unit { int pm, pn; };
struct Gemm { const bf16_t* A; const bf16_t* Bt; int lda, ldb, K, pad; };

struct StaticOrder {
    int nM, nN, nwg, G, c;
    __host__ __device__ void init(int nM_, int nN_, int G_, int c_) { nM = nM_; nN = nN_; nwg = nM * nN; G = G_; c = c_; }
    __host__ __device__ bool next(int i, Unit& u) const {
        const long L = (long)i * G + c; if (L >= nwg) return false;
        int wgid = (int)L; { const int q = nwg / NXCD, r = nwg % NXCD, xcd = wgid % NXCD, off = wgid / NXCD; wgid = (xcd < r ? xcd * (q + 1) : r * (q + 1) + (xcd - r) * q) + off; }
        const int nig = WGM * nN, gid = wgid / nig, fm = gid * WGM, gsz = (nM - fm) < WGM ? (nM - fm) : WGM;
        u.pm = fm + ((wgid % nig) % gsz); u.pn = (wgid % nig) / gsz; return true;
    }
    __device__ __forceinline__ void a_ready(const Unit&) const {}
    __device__ __forceinline__ void done(const Unit&) const {}
};
struct KvOrder {
    int G, c;
    __device__ bool next(int i, Unit& u) const { const int L = i * G + c; if (L >= 128) return false; const int ly = L >> 5, r = L & 31; u.pm = ly * 8 + (r & 7); u.pn = ly * 4 + (r >> 3); return true; }
    __device__ __forceinline__ void a_ready(const Unit&) const {}
    __device__ __forceinline__ void done(const Unit&) const {}
};

__device__ __forceinline__ unsigned cvt_pk_bf16(float lo, float hi) { unsigned r; asm volatile("v_cvt_pk_bf16_f32 %0, %1, %2" : "=v"(r) : "v"(lo), "v"(hi)); return r; }

template <int ACT> struct EpiBf16 {
    static constexpr bool PERM = true, AFTER_DRAIN = false;
    bf16_t* O; int ldc; const unsigned long long* rowss;
    __device__ __forceinline__ void operator()(const f32x4 (&acc)[2][2][4][2], const Unit& u, int wr, int wc, int fr, int fq) const {
        const int row0 = u.pm * BM + wr * 64 + fr; const int col0 = u.pn * BM + wc * 32 + 8 * fq;
        unsigned long long rq[2][4];
#pragma unroll
        for (int ai = 0; ai < 2; ++ai)
#pragma unroll
            for (int m = 0; m < 4; ++m) rq[ai][m] = rowss ? rowss[row0 + ai * HALF + m * 16] : 0ull;
#pragma unroll
        for (int ai = 0; ai < 2; ++ai)
#pragma unroll
            for (int m = 0; m < 4; ++m) { bf16_t* rowp = O + (size_t)(row0 + ai * HALF + m * 16) * ldc + col0;
                const float rs = rowss ? 1.0f / sqrtf((float)rq[ai][m] * (5.9604644775390625e-08f / 2048.f) + 1e-5f) : 1.f;
#pragma unroll
                for (int bj = 0; bj < 2; ++bj) { f32x4 v0 = acc[ai][bj][m][0] * rs, v1 = acc[ai][bj][m][1] * rs;
                    if (ACT == 1) {
#pragma unroll
                        for (int j = 0; j < 4; ++j) { const float a = fmaxf(v0[j], 0.f), b = fmaxf(v1[j], 0.f); v0[j] = a * a; v1[j] = b * b; } }
                    u32x4 w; w.x = cvt_pk_bf16(v0[0], v0[1]); w.y = cvt_pk_bf16(v0[2], v0[3]); w.z = cvt_pk_bf16(v1[0], v1[1]); w.w = cvt_pk_bf16(v1[2], v1[3]);
                    *(u32x4*)(rowp + bj * HALF) = w; } }
    }
};
struct EpiRes {
    static constexpr bool PERM = false, AFTER_DRAIN = false;
    bf16_t* xb; int ldc; unsigned long long* rowss;
    __device__ __forceinline__ void operator()(const f32x4 (&acc)[2][2][4][2], const Unit& u, int wr, int wc, int fr, int fq) const {
        typedef unsigned u32x2_ __attribute__((ext_vector_type(2)));
        const int row0 = u.pm * BM + wr * 64 + fr, col0 = u.pn * BM + wc * 32 + 4 * fq;
#pragma unroll
        for (int ai = 0; ai < 2; ++ai) {
            u32x2_ bv[4][2][2];
#pragma unroll
            for (int m = 0; m < 4; ++m) { const bf16_t* rp = xb + (size_t)(row0 + ai * HALF + m * 16) * ldc + col0;
#pragma unroll
                for (int bj = 0; bj < 2; ++bj)
#pragma unroll
                    for (int n = 0; n < 2; ++n) bv[m][bj][n] = *(const u32x2_*)(rp + bj * HALF + n * 16); }
#pragma unroll
            for (int m = 0; m < 4; ++m) { bf16_t* rp = xb + (size_t)(row0 + ai * HALF + m * 16) * ldc + col0; float ss = 0.f;
#pragma unroll
                for (int bj = 0; bj < 2; ++bj)
#pragma unroll
                    for (int n = 0; n < 2; ++n) { const u32x2_ b = bv[m][bj][n]; f32x4 x = acc[ai][bj][m][n];
                        x[0] += __uint_as_float(b.x << 16); x[1] += __uint_as_float(b.x & 0xffff0000u); x[2] += __uint_as_float(b.y << 16); x[3] += __uint_as_float(b.y & 0xffff0000u);
                        u32x2_ w; w.x = cvt_pk_bf16(x[0], x[1]); w.y = cvt_pk_bf16(x[2], x[3]); *(u32x2_*)(rp + bj * HALF + n * 16) = w;
                        const float r0 = __uint_as_float(w.x << 16), r1 = __uint_as_float(w.x & 0xffff0000u), r2 = __uint_as_float(w.y << 16), r3 = __uint_as_float(w.y & 0xffff0000u);
                        ss += (r0 * r0 + r1 * r1) + (r2 * r2 + r3 * r3); }
                ss += __shfl_xor(ss, 16); ss += __shfl_xor(ss, 32);
                if (fq == 0) atomicAdd(rowss + row0 + ai * HALF + m * 16, (unsigned long long)(ss * 16777216.0f)); }
            asm volatile("" ::: "memory"); }
    }
};
struct EpiGlu {
    static constexpr bool PERM = true, AFTER_DRAIN = false;
    const bf16_t* Z; bf16_t* O; int ldc; const float* bias;
    __device__ __forceinline__ void operator()(const f32x4 (&acc)[2][2][4][2], const Unit& u, int wr, int wc, int fr, int fq) const {
        const int row0 = u.pm * BM + wr * 64 + fr; const int col0 = u.pn * BM + wc * 32 + 8 * fq;
        f32x4 bv[2][2];
#pragma unroll
        for (int bj = 0; bj < 2; ++bj)
#pragma unroll
            for (int n = 0; n < 2; ++n) bv[bj][n] = *(const f32x4*)(bias + col0 + bj * HALF + 4 * n);
#pragma unroll
        for (int ai = 0; ai < 2; ++ai) {
            u32x4 zq[4][2];
#pragma unroll
            for (int m = 0; m < 4; ++m)
#pragma unroll
                for (int bj = 0; bj < 2; ++bj) zq[m][bj] = *(const u32x4*)(Z + (size_t)(row0 + ai * HALF + m * 16) * ldc + col0 + bj * HALF);
#pragma unroll
            for (int m = 0; m < 4; ++m) { const size_t off = (size_t)(row0 + ai * HALF + m * 16) * ldc + col0;
#pragma unroll
                for (int bj = 0; bj < 2; ++bj) { const f32x4 v0 = acc[ai][bj][m][0] + bv[bj][0], v1 = acc[ai][bj][m][1] + bv[bj][1];
                    const u32x4 zz = zq[m][bj]; float z[8], o[8];
                    z[0] = __uint_as_float(zz.x << 16); z[1] = __uint_as_float(zz.x & 0xffff0000u); z[2] = __uint_as_float(zz.y << 16); z[3] = __uint_as_float(zz.y & 0xffff0000u);
                    z[4] = __uint_as_float(zz.z << 16); z[5] = __uint_as_float(zz.z & 0xffff0000u); z[6] = __uint_as_float(zz.w << 16); z[7] = __uint_as_float(zz.w & 0xffff0000u);
#pragma unroll
                    for (int j = 0; j < 4; ++j) { o[j] = z[j] / (1.f + __expf(-v0[j])); o[4 + j] = z[4 + j] / (1.f + __expf(-v1[j])); }
                    u32x4 w; w.x = cvt_pk_bf16(o[0], o[1]); w.y = cvt_pk_bf16(o[2], o[3]); w.z = cvt_pk_bf16(o[4], o[5]); w.w = cvt_pk_bf16(o[6], o[7]);
                    *(u32x4*)(O + off + bj * HALF) = w; } }
            asm volatile("" ::: "memory"); }
    }
};

template <class Epi, class Sched, bool ALIGN_EPI = false, bool SP2 = false>
__device__ __forceinline__ void gemm_phase(PG8_LAS unsigned char* lds, const Gemm g, const Sched& S, const Epi& E) {
    int tid_l = threadIdx.x; asm volatile("" : "+v"(tid_l));
    const int tid = tid_l, wid = __builtin_amdgcn_readfirstlane(tid >> 6), lane = tid & 63, wr = wid >> 2, wc = wid & 3, fr = lane & 15, fq = lane >> 4;
    const int K = g.K, nt = K / BK;
    unsigned voffA[2], voffB[2];
#pragma unroll
    for (int i = 0; i < 2; ++i) { int R, C; stage_rc(tid * 16 + i * 8192, R, C); const int Rb = Epi::PERM ? ((R & ~31) + perm32(R & 31)) : R;
        voffA[i] = (unsigned)(R * g.lda + C) * 2u; voffB[i] = (unsigned)(Rb * g.ldb + C) * 2u; }
    const size_t kstep = (size_t)(BK * 2);
    const size_t hstepA = (size_t)HALF * g.lda * 2, hstepB = (size_t)HALF * g.ldb * 2;
    const size_t tstepA = 2 * hstepA, tstepB = 2 * hstepB;
    const unsigned ldsw = (unsigned)wid * 1024u;
    const int aoff = lds_byte(wr * 64 + fr, fq * 8), boff = lds_byte(wc * 32 + fr, fq * 8);
#define PG8_SA(b, h) (((b) * 2 + (h)) * HTB)
#define PG8_SB(b, h) ((4 + (b) * 2 + (h)) * HTB)
#define PG8_STAGE(bufoff, gbase, voff) do { _Pragma("unroll") for (int _i = 0; _i < 2; ++_i) \
        __builtin_amdgcn_global_load_lds((const unsigned*)((const char*)(gbase) + (voff)[_i]), (PG8_LAS unsigned*)(lds + (bufoff) + ldsw + _i * 8192), 16, 0, 0); } while (0)
#define PG8_LDA(dst, b, h) do { _Pragma("unroll") for (int m = 0; m < 4; ++m) _Pragma("unroll") for (int k = 0; k < 2; ++k) dst[m][k] = *(const PG8_LAS bf16x8*)(lds + PG8_SA(b, h) + aoff + m * 2048 + k * 1024); } while (0)
#define PG8_LDB(dst, b, h) do { _Pragma("unroll") for (int n = 0; n < 2; ++n) _Pragma("unroll") for (int k = 0; k < 2; ++k) dst[n][k] = *(const PG8_LAS bf16x8*)(lds + PG8_SB(b, h) + boff + n * 2048 + k * 1024); } while (0)
#define PG8_MMA(ai, bj, At, Bt) do { __builtin_amdgcn_s_setprio(1); _Pragma("unroll") for (int m = 0; m < 4; ++m) _Pragma("unroll") for (int n = 0; n < 2; ++n) _Pragma("unroll") for (int k = 0; k < 2; ++k) \
        acc[ai][bj][m][n] = __builtin_amdgcn_mfma_f32_16x16x32_bf16(Bt[n][k], At[m][k], acc[ai][bj][m][n], 0, 0, 0); __builtin_amdgcn_s_setprio(0); } while (0)
#define PG8_WAIT_V(n) asm volatile("s_waitcnt vmcnt(" #n ")" ::: "memory")
#define PG8_WAIT_L(n) asm volatile("s_waitcnt lgkmcnt(" #n ")" ::: "memory")
#define PG8_BAR __builtin_amdgcn_s_barrier()
#define PG8_SCHED __builtin_amdgcn_sched_barrier(0)
    Unit cur, nxt; int ui = 0;
    if (!S.next(0, cur)) return;
    f32x4 acc[2][2][4][2];
#pragma unroll
    for (int a = 0; a < 2; ++a)
#pragma unroll
        for (int b = 0; b < 2; ++b)
#pragma unroll
            for (int m = 0; m < 4; ++m)
#pragma unroll
                for (int n = 0; n < 2; ++n) acc[a][b][m][n] = (f32x4){0.f, 0.f, 0.f, 0.f};
    bf16x8 At[4][2], B0[2][2], B1[2][2];
    const char* cA = (const char*)g.A + (size_t)cur.pm * tstepA; const char* cB = (const char*)g.Bt + (size_t)cur.pn * tstepB;
    S.a_ready(cur);
    if constexpr (SP2) {
        PG8_STAGE(PG8_SB(0, 0), cB, voffB); PG8_STAGE(PG8_SB(0, 1), cB + hstepB, voffB); PG8_STAGE(PG8_SA(0, 0), cA, voffA); PG8_STAGE(PG8_SA(0, 1), cA + hstepA, voffA);
        if (wr == 1) PG8_BAR;
        PG8_WAIT_V(2); PG8_BAR;
        PG8_STAGE(PG8_SB(1, 0), cB + kstep, voffB); PG8_STAGE(PG8_SA(1, 0), cA + kstep, voffA); PG8_STAGE(PG8_SB(1, 1), cB + hstepB + kstep, voffB);
        PG8_WAIT_V(6); PG8_BAR;
    } else {
        PG8_STAGE(PG8_SB(0, 0), cB, voffB); PG8_STAGE(PG8_SA(0, 0), cA, voffA); PG8_STAGE(PG8_SB(0, 1), cB + hstepB, voffB); PG8_STAGE(PG8_SA(0, 1), cA + hstepA, voffA);
        if (wr == 1) PG8_BAR;
        PG8_WAIT_V(4); PG8_BAR;
        PG8_STAGE(PG8_SB(1, 0), cB + kstep, voffB); PG8_STAGE(PG8_SA(1, 0), cA + kstep, voffA); PG8_STAGE(PG8_SB(1, 1), cB + hstepB + kstep, voffB);
        PG8_WAIT_V(6); PG8_BAR;
    }
    for (;;) {
        const bool has_next = S.next(ui + 1, nxt);
        const char* nA = has_next ? (const char*)g.A + (size_t)nxt.pm * tstepA : cA; const char* nB = has_next ? (const char*)g.Bt + (size_t)nxt.pn * tstepB : cB;
        for (int t = 0; t < nt; t += 2) {
            const bool last = (t == nt - 2);
            const char* a1 = cA + (size_t)(t + 1) * kstep;
            const char* a2 = last ? nA : cA + (size_t)(t + 2) * kstep; const char* b2 = last ? nB : cB + (size_t)(t + 2) * kstep;
            const char* a3 = a2 + kstep; const char* b3 = b2 + kstep;
            if (last && has_next) S.a_ready(nxt);
            if constexpr (SP2) {
            PG8_LDB(B0, 0, 0); PG8_LDB(B1, 0, 1); PG8_SCHED; PG8_LDA(At, 0, 0); PG8_STAGE(PG8_SA(1, 1), a1 + hstepA, voffA);
            PG8_WAIT_V(8); PG8_WAIT_L(0); PG8_BAR; PG8_MMA(0, 0, At, B0); PG8_MMA(0, 1, At, B1); PG8_BAR; PG8_SCHED;
            PG8_LDA(At, 0, 1); PG8_STAGE(PG8_SB(0, 0), b2, voffB); PG8_STAGE(PG8_SB(0, 1), b2 + hstepB, voffB); PG8_STAGE(PG8_SA(0, 0), a2, voffA);
            PG8_WAIT_V(8); PG8_WAIT_L(0); PG8_BAR; PG8_MMA(1, 0, At, B0); PG8_MMA(1, 1, At, B1); PG8_BAR; PG8_SCHED;
            PG8_LDB(B0, 1, 0); PG8_LDB(B1, 1, 1); PG8_SCHED; PG8_LDA(At, 1, 0); PG8_STAGE(PG8_SA(0, 1), a2 + hstepA, voffA);
            PG8_WAIT_V(8); PG8_WAIT_L(0); PG8_BAR; PG8_MMA(0, 0, At, B0); PG8_MMA(0, 1, At, B1); PG8_BAR; PG8_SCHED;
            PG8_LDA(At, 1, 1); PG8_STAGE(PG8_SB(1, 0), b3, voffB); PG8_STAGE(PG8_SB(1, 1), b3 + hstepB, voffB); PG8_STAGE(PG8_SA(1, 0), a3, voffA);
            PG8_WAIT_V(8); PG8_WAIT_L(0); PG8_BAR; PG8_MMA(1, 0, At, B0); PG8_MMA(1, 1, At, B1); PG8_BAR; PG8_SCHED;
            } else {
            PG8_LDB(B0, 0, 0); PG8_SCHED; PG8_LDA(At, 0, 0); PG8_STAGE(PG8_SA(1, 1), a1 + hstepA, voffA);
            PG8_WAIT_L(8); PG8_BAR; PG8_WAIT_L(0); PG8_MMA(0, 0, At, B0); PG8_BAR; PG8_SCHED;
            PG8_LDB(B1, 0, 1); PG8_STAGE(PG8_SB(0, 0), b2, voffB);
            PG8_BAR; PG8_WAIT_L(0); PG8_MMA(0, 1, At, B1); PG8_BAR;
            PG8_LDA(At, 0, 1); PG8_STAGE(PG8_SA(0, 0), a2, voffA);
            PG8_BAR; PG8_WAIT_L(0); PG8_MMA(1, 0, At, B0); PG8_BAR; PG8_SCHED;
            PG8_STAGE(PG8_SB(0, 1), b2 + hstepB, voffB);
            PG8_WAIT_V(6); PG8_BAR; PG8_MMA(1, 1, At, B1); PG8_BAR;
            PG8_LDB(B0, 1, 0); PG8_SCHED; PG8_LDA(At, 1, 0); PG8_STAGE(PG8_SA(0, 1), a2 + hstepA, voffA);
            PG8_WAIT_L(8); PG8_BAR; PG8_WAIT_L(0); PG8_MMA(0, 0, At, B0); PG8_BAR; PG8_SCHED;
            PG8_LDB(B1, 1, 1); PG8_STAGE(PG8_SB(1, 0), b3, voffB);
            PG8_BAR; PG8_WAIT_L(0); PG8_MMA(0, 1, At, B1); PG8_BAR;
            PG8_LDA(At, 1, 1); PG8_STAGE(PG8_SA(1, 0), a3, voffA);
            PG8_BAR; PG8_WAIT_L(0); PG8_MMA(1, 0, At, B0); PG8_BAR; PG8_SCHED;
            PG8_STAGE(PG8_SB(1, 1), b3 + hstepB, voffB);
            PG8_WAIT_V(6); PG8_BAR; PG8_MMA(1, 1, At, B1); PG8_BAR;
            }
        }
        if constexpr (ALIGN_EPI) { if (wr == 0) PG8_BAR; }
        E(acc, cur, wr, wc, fr, fq); S.done(cur);
        if (!has_next) break;
#pragma unroll
        for (int a = 0; a < 2; ++a)
#pragma unroll
            for (int b = 0; b < 2; ++b)
#pragma unroll
                for (int m = 0; m < 4; ++m)
#pragma unroll
                    for (int n = 0; n < 2; ++n) acc[a][b][m][n] = (f32x4){0.f, 0.f, 0.f, 0.f};
        cur = nxt; cA = nA; cB = nB; ++ui;
        if constexpr (ALIGN_EPI) { if (wr == 1) PG8_BAR; }
    }
    PG8_WAIT_V(0);
    if constexpr (!ALIGN_EPI) { if (wr == 0) PG8_BAR; }
    PG8_BAR;
#undef PG8_SA
#undef PG8_SB
#undef PG8_STAGE
#undef PG8_LDA
#undef PG8_LDB
#undef PG8_MMA
#undef PG8_WAIT_V
#undef PG8_WAIT_L
#undef PG8_BAR
#undef PG8_SCHED
}
}
#define XB_TMO      128
#define XB_XCNT(j)  (256  + 64 * (j))
#define XB_XSUB(j)  (1280 + 64 * (j))
#define XB_XGEN(j)  (2304 + 64 * (j))
#define XB_TOP      3328
#define XB_TOPGEN   3392
#define XCD_BAR_WORDS 3456
#define XB_SPIN_CAP (1u << 18)
__device__ __forceinline__ unsigned xb_ld(unsigned* p)              { return __hip_atomic_load(p, __ATOMIC_RELAXED, __HIP_MEMORY_SCOPE_AGENT); }
__device__ __forceinline__ unsigned xb_add(unsigned* p, unsigned v) { return __hip_atomic_fetch_add(p, v, __ATOMIC_RELAXED, __HIP_MEMORY_SCOPE_AGENT); }
__device__ __forceinline__ unsigned xb_xcc_id() { return (unsigned)__builtin_amdgcn_s_getreg((3 << 11) | 20) & 0xFu; }
#define XB_SPIN(cond, bar) do { unsigned _sp = 0; while (cond) { __builtin_amdgcn_s_sleep(1); \
    if ((++_sp & 255u) == 0u) { if (xb_ld(&(bar)[XB_TMO])) break; if (_sp > XB_SPIN_CAP) { atomicAdd(&(bar)[XB_TMO], 1u); break; } } } } while (0)
struct XcdBarrier { unsigned* bar; unsigned x; volatile LAS unsigned* st; unsigned G; };
__device__ __forceinline__ XcdBarrier xcd_barrier_post(unsigned* bar, volatile LAS unsigned* st, unsigned G) {
    XcdBarrier b; b.bar = bar; b.x = xb_xcc_id(); b.st = st; b.G = G;
    if (threadIdx.x == 0) (void)xb_add(&bar[XB_XCNT(b.x)], 1u);
    return b;
}
__device__ __forceinline__ void xcd_barrier_complete(unsigned* bar, unsigned x, unsigned G, unsigned& nloc, unsigned& nx) {
    unsigned sum, cnt, mine, sp = 0u;
    for (;;) {
        sum = 0u; cnt = 0u; mine = 0u;
#pragma unroll
        for (unsigned j = 0; j < 16; ++j) { const unsigned c = xb_ld(&bar[XB_XCNT(j)]); sum += c; cnt += (c > 0u) ? 1u : 0u; mine = (j == x) ? c : mine; }
        if (sum == G) break;
        __builtin_amdgcn_s_sleep(1);
        if ((++sp & 255u) == 0u) { if (xb_ld(&bar[XB_TMO])) break; if (sp > XB_SPIN_CAP) { atomicAdd(&bar[XB_TMO], 1u); break; } }
    }
    nloc = mine > 0u ? mine : 1u; nx = cnt > 0u ? cnt : 1u;
}
__device__ __forceinline__ void xcd_barrier(const XcdBarrier& b) {
    asm volatile("s_waitcnt vmcnt(0)" ::: "memory");
    __syncthreads();
    if (threadIdx.x == 0) {
        unsigned* bar = b.bar;
        __builtin_amdgcn_s_waitcnt(0);
        unsigned nloc = b.st[0], nx = b.st[1];
        if (nloc == 0u) { xcd_barrier_complete(bar, b.x, b.G, nloc, nx); b.st[0] = nloc; b.st[1] = nx; }
        const unsigned old = xb_add(&bar[XB_XSUB(b.x)], 1u);
        const unsigned gen = old / nloc;
        if (old + 1u == (gen + 1u) * nloc) {
            __builtin_amdgcn_fence(__ATOMIC_RELEASE, "agent");
            asm volatile("s_waitcnt vmcnt(0)" ::: "memory");
            const unsigned og = xb_add(&bar[XB_TOP], 1u);
            const unsigned tg = og / nx;
            if (og + 1u == (tg + 1u) * nx) xb_add(&bar[XB_TOPGEN], 1u);
            else XB_SPIN(xb_ld(&bar[XB_TOPGEN]) == tg, bar);
            __builtin_amdgcn_fence(__ATOMIC_ACQUIRE, "agent");
            xb_add(&bar[XB_XGEN(b.x)], 1u);
            asm volatile("s_waitcnt vmcnt(0)" ::: "memory");
        } else {
            XB_SPIN(xb_ld(&bar[XB_XGEN(b.x)]) == gen, bar);
            __builtin_amdgcn_fence(__ATOMIC_ACQUIRE, "agent");
            asm volatile("s_waitcnt vmcnt(0)" ::: "memory");
        }
    }
    __syncthreads();
}

constexpr int NWAVES = 8, NTHR = 512;
constexpr int LDS_BYTES = 155648;
constexpr int MISC_OFF = LDS_BYTES - 256;
struct Ctx { unsigned char* lds; int tid, lane, wave, gw, ngw, bid, nb; };

__device__ __forceinline__ void tr_item(const float* __restrict__ W, int ldw, int N, bf16* __restrict__ WT, int ldt, int row_off, int col_off, int kb, int nb, float* scr, int lane, const float* __restrict__ gk) {
    const int k0 = 64 * kb, n0 = 32 * nb; const int n = n0 + (lane & 31);
    float v[32];
    const float* wp = W + (size_t)(k0 + (lane >> 5)) * ldw + (n < N ? n : 0);
#pragma unroll
    for (int i = 0; i < 32; ++i) v[i] = wp[(size_t)(2 * i) * ldw];
    if (gk) {
#pragma unroll
        for (int i = 0; i < 32; ++i) v[i] *= gk[k0 + 2 * i + (lane >> 5)];
    }
#pragma unroll
    for (int i = 0; i < 32; ++i) { const int kk = 2 * i + (lane >> 5); scr[kk * 33 + (lane & 31)] = (n < N) ? v[i] : 0.f; }
    __builtin_amdgcn_fence(__ATOMIC_RELEASE, "wavefront"); __builtin_amdgcn_wave_barrier(); __builtin_amdgcn_fence(__ATOMIC_ACQUIRE, "wavefront");
    const int c = lane & 7;
#pragma unroll
    for (int j = 0; j < 4; ++j) { const int nn = (lane >> 3) + 8 * j; const float* s = scr + (8 * c) * 33 + nn;
        u32x4 o; o.x = pk2(s[0 * 33], s[1 * 33]); o.y = pk2(s[2 * 33], s[3 * 33]); o.z = pk2(s[4 * 33], s[5 * 33]); o.w = pk2(s[6 * 33], s[7 * 33]);
        *(u32x4*)(WT + (size_t)(row_off + n0 + nn) * ldt + col_off + k0 + 8 * c) = o; }
    __builtin_amdgcn_fence(__ATOMIC_RELEASE, "wavefront"); __builtin_amdgcn_wave_barrier(); __builtin_amdgcn_fence(__ATOMIC_ACQUIRE, "wavefront");
}
__device__ __forceinline__ void conv_mat(const Ctx& c, const float* W, int K, int ldw, int N, int Npad, bf16* WT, int ldt, int row_off, int col_off, const float* gk = nullptr) {
    float* scr = (float*)(c.lds + c.wave * 8704);
    const int nblk = Npad / 32, nit = (K / 64) * nblk;
    for (int it = c.gw; it < nit; it += c.ngw) tr_item(W, ldw, N, WT, ldt, row_off, col_off, it / nblk, it % nblk, scr, c.lane, gk);
}

__device__ __forceinline__ void norm_rows_bf16(const Ctx& c, const float* __restrict__ X, const float* __restrict__ g, bf16* __restrict__ O, int nrows) {
    f32x4 gv[8];
#pragma unroll
    for (int j = 0; j < 8; ++j) gv[j] = *(const f32x4*)(g + 4 * c.lane + 256 * j);
    for (int m = c.gw; m < nrows; m += c.ngw) {
        const f32x4* xr = (const f32x4*)(X + (size_t)m * D) + c.lane; f32x4 v[8]; float s = 0.f;
#pragma unroll
        for (int j = 0; j < 8; ++j) { v[j] = xr[64 * j]; s += (v[j].x * v[j].x + v[j].y * v[j].y) + (v[j].z * v[j].z + v[j].w * v[j].w); }
        const float rstd = 1.0f / sqrtf(wave_sum(s) * (1.f / D) + NORM_EPS);
        u32x2* o8 = (u32x2*)(O + (size_t)m * D) + c.lane;
#pragma unroll
        for (int j = 0; j < 8; ++j) { u32x2 w; w.x = pk2(v[j].x * rstd * gv[j].x, v[j].y * rstd * gv[j].y); w.y = pk2(v[j].z * rstd * gv[j].z, v[j].w * rstd * gv[j].w); o8[64 * j] = w; }
    }
}
__device__ __forceinline__ void cast_rows_ss(const Ctx& c, const float* __restrict__ X, bf16* __restrict__ O, unsigned long long* rowss, int nrows) {
    for (int m = c.gw; m < nrows; m += c.ngw) {
        const f32x4* xr = (const f32x4*)(X + (size_t)m * D) + c.lane; f32x4 v[8]; float s = 0.f;
#pragma unroll
        for (int j = 0; j < 8; ++j) { v[j] = xr[64 * j]; s += (v[j].x * v[j].x + v[j].y * v[j].y) + (v[j].z * v[j].z + v[j].w * v[j].w); }
        s = wave_sum(s);
        u32x2* o8 = (u32x2*)(O + (size_t)m * D) + c.lane;
#pragma unroll
        for (int j = 0; j < 8; ++j) { u32x2 w; w.x = pk2(v[j].x, v[j].y); w.y = pk2(v[j].z, v[j].w); o8[64 * j] = w; }
        if (c.lane == 0) rowss[m] = (unsigned long long)(s * 16777216.0f);
    }
}
__device__ __forceinline__ void scale_rows_out(const Ctx& c, const bf16* __restrict__ XB, const float* __restrict__ g, const unsigned long long* rowss, float* O, int nrows) {
    for (int m = c.gw; m < nrows; m += c.ngw) {
        const float rstd = 1.0f / sqrtf((float)rowss[m] * (5.9604644775390625e-08f / D) + NORM_EPS);
#pragma unroll
        for (int j = 0; j < 4; ++j) { float x[8]; unpack8(*(const u32x4*)(XB + (size_t)m * D + 8 * c.lane + 512 * j), x);
            const f32x4 g0 = *(const f32x4*)(g + 8 * c.lane + 512 * j), g1 = *(const f32x4*)(g + 8 * c.lane + 512 * j + 4);
            *(f32x4*)(O + (size_t)m * D + 8 * c.lane + 512 * j) = (f32x4){x[0] * rstd * g0.x, x[1] * rstd * g0.y, x[2] * rstd * g0.z, x[3] * rstd * g0.w};
            *(f32x4*)(O + (size_t)m * D + 8 * c.lane + 512 * j + 4) = (f32x4){x[4] * rstd * g1.x, x[5] * rstd * g1.y, x[6] * rstd * g1.z, x[7] * rstd * g1.w}; }
    }
}
__device__ __forceinline__ void norm_rows_f32(const Ctx& c, float* X, const float* __restrict__ g, int nrows) {
    f32x4 gv[8];
#pragma unroll
    for (int j = 0; j < 8; ++j) gv[j] = *(const f32x4*)(g + 4 * c.lane + 256 * j);
    for (int m = c.gw; m < nrows; m += c.ngw) {
        f32x4* xr = (f32x4*)(X + (size_t)m * D) + c.lane; f32x4 v[8]; float s = 0.f;
#pragma unroll
        for (int j = 0; j < 8; ++j) { v[j] = xr[64 * j]; s += (v[j].x * v[j].x + v[j].y * v[j].y) + (v[j].z * v[j].z + v[j].w * v[j].w); }
        const float rstd = 1.0f / sqrtf(wave_sum(s) * (1.f / D) + NORM_EPS);
#pragma unroll
        for (int j = 0; j < 8; ++j) xr[64 * j] = v[j] * rstd * gv[j];
    }
}

__device__ __forceinline__ void rope_tables(const Ctx& c, const int* __restrict__ start_frame, float* ropea, float* ropei) {
    const float HA[16] = {1.000000000e+00f, 4.403665960e-01f, 1.939227432e-01f, 8.539710194e-02f, 3.760603070e-02f, 1.656044088e-02f, 7.292664610e-03f, 3.211446106e-03f, 1.414213562e-03f, 6.227724371e-04f, 2.742481884e-04f, 1.207697351e-04f, 5.318295734e-05f, 2.341999971e-05f, 1.031338525e-05f, 4.541670478e-06f};
    const float LA[16] = {0.000000000e+00f, 6.688275267e-09f, 1.547429962e-09f, -1.652958881e-09f, 2.282729838e-10f, -8.020459852e-10f, 1.273676581e-10f, -1.116812753e-10f, -1.115275407e-14f, -1.514006802e-11f, -1.268531807e-11f, 2.335000249e-12f, 1.624761415e-12f, -7.452659366e-13f, 1.309491117e-13f, 2.687890499e-15f};
    const float HI[8] = {1.000000000e+00f, 1.939227432e-01f, 3.760603070e-02f, 7.292664610e-03f, 1.414213562e-03f, 2.742481884e-04f, 5.318295734e-05f, 1.031338525e-05f};
    const float LI[8] = {0.000000000e+00f, 1.547429962e-09f, 2.282729838e-10f, 1.273676581e-10f, -1.115275407e-14f, -1.268531807e-11f, 1.624761415e-12f, 1.309491117e-13f};
    const int gt = c.bid * NTHR + c.tid, ngt = c.nb * NTHR;
    for (int i = gt; i < M * 24; i += ngt) {
        const int m = i / 24, j = i % 24; const int b = m / SEQ, t = m % SEQ;
        const float pos = (float)(start_frame[b] + t);
        float hi = 0.f, lo = 0.f;
#pragma unroll
        for (int q = 0; q < 16; ++q) if (j == q) { hi = HA[q]; lo = LA[q]; }
#pragma unroll
        for (int q = 0; q < 8; ++q) if (j == 16 + q) { hi = HI[q]; lo = LI[q]; }
        const float p = pos * hi, e = fmaf(pos, hi, -p) + pos * lo;
        float sn, cs; sincosf(p, &sn, &cs);
        const float cc = cs - e * sn, ss = sn + e * cs;
        if (j < 16) { ropea[(size_t)m * 32 + j] = cc; ropea[(size_t)m * 32 + 16 + j] = ss; }
        else { ropei[(size_t)m * 16 + (j - 16)] = cc; ropei[(size_t)m * 16 + 8 + (j - 16)] = ss; }
    }
}

__device__ __forceinline__ void build_wql(const Ctx& c, const float* __restrict__ w_uq, const float* __restrict__ w_uk, bf16* WQ) {
    const int gt = c.bid * NTHR + c.tid, ngt = c.nb * NTHR;
    for (int i = gt; i < 2048 * 512; i += ngt) {
        const int cc = i & 511, hr = i >> 9, h = hr >> 8, r = hr & 255;
        const float* a = w_uq + (size_t)cc * 1024 + h * 128 + 32; const float* b = w_uk + (size_t)r * 768 + h * 96; float s = 0.f;
#pragma unroll 8
        for (int d = 0; d < 96; ++d) s += a[d] * b[d];
        WQ[i] = (bf16)f2bf(s);
    }
}
__device__ __forceinline__ void build_wout(const Ctx& c, const float* __restrict__ w_uv, const float* __restrict__ w_out, bf16* WO) {
    const int gt = c.bid * NTHR + c.tid, ngt = c.nb * NTHR;
    for (int i = gt; i < 8 * 32 * 2048; i += ngt) {
        const int n = i & 2047, rg = (i >> 11) & 31, h = i >> 16; float acc[8];
#pragma unroll
        for (int j = 0; j < 8; ++j) acc[j] = 0.f;
        for (int d = 0; d < 128; ++d) { const float wo = w_out[(size_t)(h * 128 + d) * 2048 + n];
#pragma unroll
            for (int j = 0; j < 8; ++j) acc[j] += w_uv[(size_t)(rg * 8 + j) * 1024 + h * 128 + d] * wo; }
        u32x4 o; o.x = pk2(acc[0], acc[1]); o.y = pk2(acc[2], acc[3]); o.z = pk2(acc[4], acc[5]); o.w = pk2(acc[6], acc[7]);
        *(u32x4*)(WO + (size_t)n * OC + h * 256 + rg * 8) = o;
    }
}

__device__ __forceinline__ void dsa_prep(const Ctx& c, const bf16* __restrict__ H, const float* __restrict__ cqn_g, const float* __restrict__ ckv_g, const float* __restrict__ kidx_g,
                                         const float* __restrict__ ropea, const float* __restrict__ ropei, bf16* CQN, bf16* KF, bf16* KIDX, float* WIDX) {
    const int l = c.lane;
    for (int m = c.gw; m < M; m += c.ngw) {
        const bf16* h = H + (size_t)m * HC;
        {
            float f[8]; unpack8(*(const u32x4*)(h + 8 * l), f); float s = 0.f;
#pragma unroll
            for (int j = 0; j < 8; ++j) s += f[j] * f[j];
            const float rstd = 1.0f / sqrtf(wave_sum(s) * (1.f / 512.f) + NORM_EPS);
            u32x4 o; o.x = pk2(f[0] * rstd * cqn_g[8 * l + 0], f[1] * rstd * cqn_g[8 * l + 1]); o.y = pk2(f[2] * rstd * cqn_g[8 * l + 2], f[3] * rstd * cqn_g[8 * l + 3]);
            o.z = pk2(f[4] * rstd * cqn_g[8 * l + 4], f[5] * rstd * cqn_g[8 * l + 5]); o.w = pk2(f[6] * rstd * cqn_g[8 * l + 6], f[7] * rstd * cqn_g[8 * l + 7]);
            *(u32x4*)(CQN + (size_t)m * 512 + 8 * l) = o;
        }
        {
            const u32x2 w = *(const u32x2*)(h + 512 + 4 * l); const float f0 = bf2f(w.x & 0xffffu), f1 = bf2f(w.x >> 16), f2 = bf2f(w.y & 0xffffu), f3 = bf2f(w.y >> 16);
            const float s = (f0 * f0 + f1 * f1) + (f2 * f2 + f3 * f3);
            const float rstd = 1.0f / sqrtf(wave_sum(s) * (1.f / 256.f) + NORM_EPS);
            u32x2 o; o.x = pk2(f0 * rstd * ckv_g[4 * l + 0], f1 * rstd * ckv_g[4 * l + 1]); o.y = pk2(f2 * rstd * ckv_g[4 * l + 2], f3 * rstd * ckv_g[4 * l + 3]);
            *(u32x2*)(KF + (size_t)m * KFW + 4 * l) = o;
        }
        if (l < 16) {
            const float x1 = bf2f(h[768 + l]), x2 = bf2f(h[768 + 16 + l]); const float cs = ropea[(size_t)m * 32 + l], sn = ropea[(size_t)m * 32 + 16 + l];
            KF[(size_t)m * KFW + 256 + l] = (bf16)f2bf(x1 * cs - x2 * sn); KF[(size_t)m * KFW + 256 + 16 + l] = (bf16)f2bf(x2 * cs + x1 * sn);
        }
        {
            const float v = bf2f(h[800 + l]); const float rstd = 1.0f / sqrtf(wave_sum(v * v) * (1.f / 64.f) + NORM_EPS);
            const float y = v * rstd * kidx_g[l];
            const float ylo = __shfl(y, l & 7), yhi = __shfl(y, (l & 7) + 8);
            float o = y;
            if (l < 16) { const float cs = ropei[(size_t)m * 16 + (l & 7)], sn = ropei[(size_t)m * 16 + 8 + (l & 7)]; o = (l < 8) ? (ylo * cs - yhi * sn) : (yhi * cs + ylo * sn); }
            KIDX[(size_t)m * 64 + l] = (bf16)f2bf(o);
        }
        if (l < 16) WIDX[(size_t)m * 16 + l] = bf2f(h[864 + l]) * 0.03125f;
    }
}
__device__ __forceinline__ void q_rope_fix(const Ctx& c, bf16* QALL, const float* __restrict__ ropea, const float* __restrict__ ropei) {
    const int l = c.lane;
    for (int m = c.gw; m < M; m += c.ngw) {
        bf16* q = QALL + (size_t)m * QC;
#pragma unroll
        for (int i = 0; i < 2; ++i) { const int p = l + 64 * i, hh = p >> 4, j = p & 15; bf16* a = q + 2048 + hh * 32 + j;
            const float x1 = bf2f(a[0]), x2 = bf2f(a[16]); const float cs = ropea[(size_t)m * 32 + j], sn = ropea[(size_t)m * 32 + 16 + j];
            a[0] = (bf16)f2bf(x1 * cs - x2 * sn); a[16] = (bf16)f2bf(x2 * cs + x1 * sn); }
#pragma unroll
        for (int i = 0; i < 2; ++i) { const int p = l + 64 * i, hh = p >> 3, j = p & 7; bf16* a = q + 2304 + hh * 64 + j;
            const float x1 = bf2f(a[0]), x2 = bf2f(a[8]); const float cs = ropei[(size_t)m * 16 + j], sn = ropei[(size_t)m * 16 + 8 + j];
            a[0] = (bf16)f2bf(x1 * cs - x2 * sn); a[8] = (bf16)f2bf(x2 * cs + x1 * sn); }
    }
}
__device__ __forceinline__ size_t sc_row_off(int b, int t) { const int ch = t >> 6; return (size_t)b * SC_PER_BATCH + (size_t)4096 * (ch * (ch + 1) / 2) + (size_t)(t & 63) * (64 * (ch + 1)); }
__device__ __forceinline__ void idx_scores_simple(const Ctx& c, const bf16* __restrict__ QALL, const bf16* __restrict__ KIDX, const float* __restrict__ WIDX, float* SC) {
    float* qs = (float*)c.lds;
    float* ws = qs + 1024;
    for (int m = c.bid; m < M; m += c.nb) {
        const int b = m / SEQ, t = m % SEQ, limit = ((t >> 6) + 1) * 64;
        __syncthreads();
        for (int i = c.tid; i < 1024; i += NTHR) qs[i] = bf2f(QALL[(size_t)m * QC + 2304 + i]);
        if (c.tid < 16) ws[c.tid] = WIDX[(size_t)m * 16 + c.tid];
        __syncthreads();
        if (limit <= 256) continue;
        float* row = SC + sc_row_off(b, t);
        for (int s = c.tid; s < limit; s += NTHR) {
            float k[64]; const u32x4* kp = (const u32x4*)(KIDX + (size_t)(b * SEQ + s) * 64);
#pragma unroll
            for (int j = 0; j < 8; ++j) unpack8(kp[j], k + 8 * j);
            float sc = 0.f;
#pragma unroll 1
            for (int h = 0; h < 16; ++h) { asm volatile("" ::: "memory"); float d = 0.f; const f32x4* q4 = (const f32x4*)(qs + h * 64);
#pragma unroll
                for (int j = 0; j < 16; ++j) { const f32x4 q = q4[j]; d += (q.x * k[4 * j] + q.y * k[4 * j + 1]) + (q.z * k[4 * j + 2] + q.w * k[4 * j + 3]); }
                sc += ws[h] * fmaxf(d, 0.f); }
            row[s] = sc;
        }
    }
}
__device__ __forceinline__ void select_row(const float* row, int limit, unsigned short* sel, int l_in, unsigned short* stg = nullptr) {
    int l = l_in; asm volatile("" : "+v"(l));
    const int ng = limit >> 9;
    unsigned key[64];
#pragma unroll
    for (int jg = 0; jg < 8; ++jg) {
        if (jg <= ng) {
#pragma unroll
            for (int j = 8 * jg; j < 8 * jg + 8; ++j) { const int s = j * 64 + l; key[j] = __float_as_uint(row[s < limit ? s : 0]); }
        } else {
#pragma unroll
            for (int j = 8 * jg; j < 8 * jg + 8; ++j) key[j] = 0u;
        }
    }
#pragma unroll
    for (int j = 0; j < 64; ++j) { const int s = j * 64 + l; unsigned u = key[j]; u = (u & 0x80000000u) ? ~u : (u | 0x80000000u); key[j] = (s < limit) ? u : 0u; }
    unsigned mx = 0u;
#pragma unroll
    for (int j = 0; j < 64; ++j) mx = key[j] > mx ? key[j] : mx;
#pragma unroll
    for (int o = 1; o < 64; o <<= 1) { const unsigned t = (unsigned)__shfl_xor((int)mx, o); mx = t > mx ? t : mx; }
    mx = (unsigned)__builtin_amdgcn_readfirstlane((int)mx);
    auto wave_count = [&](int v) -> int {
        v += __builtin_amdgcn_update_dpp(0, v, 0xB1, 0xf, 0xf, true); v += __builtin_amdgcn_update_dpp(0, v, 0x4E, 0xf, 0xf, true);
        v += __builtin_amdgcn_update_dpp(0, v, 0x141, 0xf, 0xf, true); v += __builtin_amdgcn_update_dpp(0, v, 0x140, 0xf, 0xf, true);
        return __builtin_amdgcn_readlane(v, 0) + __builtin_amdgcn_readlane(v, 16) + __builtin_amdgcn_readlane(v, 32) + __builtin_amdgcn_readlane(v, 48); };
    unsigned T = 0u;
#pragma unroll 1
    for (int bit = 31 - __builtin_clz(mx | 1u); bit >= 0; --bit) {
        const unsigned Tn = T | (1u << bit); int cl = 0;
#pragma unroll
        for (int jg = 0; jg < 8; ++jg) if (jg <= ng) {
#pragma unroll
            for (int j = 8 * jg; j < 8 * jg + 8; ++j) cl += (key[j] >= Tn) ? 1 : 0; }
        const int cnt = wave_count(cl);
        if (cnt >= 256) T = Tn;
        if (cnt == 256) break;
    }
    int cgl = 0;
#pragma unroll
    for (int j = 0; j < 64; ++j) cgl += (key[j] > T) ? 1 : 0;
    const int cgt = wave_count(cgl);
    const int need_eq = 256 - cgt;
    int base = 0, beq = 0;
    const unsigned long long lt = (1ull << l) - 1ull;
    if (stg) {
#pragma unroll
        for (int jg = 0; jg < 8; ++jg) if (jg <= ng) {
#pragma unroll
            for (int j = 8 * jg; j < 8 * jg + 8; ++j) {
                const unsigned long long mg = __ballot(key[j] > T);
                const int pos = base + (int)__builtin_amdgcn_mbcnt_hi((unsigned)(mg >> 32), __builtin_amdgcn_mbcnt_lo((unsigned)mg, 0u));
                if (key[j] > T) stg[pos] = (unsigned short)(j * 64 + l);
                base += __popcll(mg);
                const unsigned long long me = __ballot(key[j] == T);
                if (me != 0ull) {
                    const int pe = beq + (int)__builtin_amdgcn_mbcnt_hi((unsigned)(me >> 32), __builtin_amdgcn_mbcnt_lo((unsigned)me, 0u));
                    if (key[j] == T && pe < need_eq) stg[cgt + pe] = (unsigned short)(j * 64 + l);
                    beq += __popcll(me);
                }
            }
        }
        __builtin_amdgcn_fence(__ATOMIC_RELEASE, "wavefront"); __builtin_amdgcn_wave_barrier(); __builtin_amdgcn_fence(__ATOMIC_ACQUIRE, "wavefront");
        *(u32x2*)(sel + 4 * l) = *(const u32x2*)(stg + 4 * l);
        __builtin_amdgcn_fence(__ATOMIC_RELEASE, "wavefront"); __builtin_amdgcn_wave_barrier(); __builtin_amdgcn_fence(__ATOMIC_ACQUIRE, "wavefront");
        return;
    }
#pragma unroll
    for (int jg = 0; jg < 8; ++jg) if (jg <= ng) {
#pragma unroll
        for (int j = 8 * jg; j < 8 * jg + 8; ++j) {
            const unsigned long long mg = __ballot(key[j] > T), me = __ballot(key[j] == T);
            if (key[j] > T) sel[base + __popcll(mg & lt)] = (unsigned short)(j * 64 + l);
            base += __popcll(mg);
            const int pe = beq + __popcll(me & lt);
            if (key[j] == T && pe < need_eq) sel[cgt + pe] = (unsigned short)(j * 64 + l);
            beq += __popcll(me);
        }
    }
}
__device__ __forceinline__ void bs_transpose32(unsigned (&A)[32]) {
    unsigned m = 0x0000FFFFu;
#pragma unroll
    for (int j = 16; j != 0; j >>= 1) {
#pragma unroll
        for (int k = 0; k < 32; ++k) {
            if ((k & j) == 0) {
                const unsigned t = (A[k] ^ (A[k + j] >> j)) & m;
                A[k] ^= t; A[k + j] ^= (t << j);
            }
        }
        m ^= (m << (j >> 1));
    }
}
__device__ __forceinline__ void select_row_bs(const float* row, int limit, unsigned short* sel, int l_in, unsigned short* stg) {
    int l = l_in; asm volatile("" : "+v"(l));
    const int nsl = limit >> 6;
    const int ng = limit >> 9;
    unsigned lo[32], hi[32];
#pragma unroll
    for (int jg = 0; jg < 8; ++jg) {
        if (jg <= ng) {
#pragma unroll
            for (int j = 8 * jg; j < 8 * jg + 8; ++j) { const int s = j * 64 + l; const unsigned u = __float_as_uint(row[s < limit ? s : 0]);
                if (j < 32) lo[j & 31] = u; else hi[j & 31] = u; }
        } else {
#pragma unroll
            for (int j = 8 * jg; j < 8 * jg + 8; ++j) { if (j < 32) lo[j & 31] = 0u; else hi[j & 31] = 0u; }
        }
    }
    asm volatile("" ::: "memory");
#pragma unroll
    for (int j = 0; j < 64; ++j) { const unsigned u = (j < 32) ? lo[j & 31] : hi[j & 31];
        const unsigned kx = (j < nsl) ? ((u & 0x80000000u) ? ~u : (u | 0x80000000u)) : 0u;
        if (j < 32) lo[j & 31] = kx; else hi[j & 31] = kx; }
    const bool has_hi = nsl > 32;
    bs_transpose32(lo);
    if (has_hi) bs_transpose32(hi);
    auto wave_count = [&](int v) -> int {
        v += __builtin_amdgcn_update_dpp(0, v, 0xB1, 0xf, 0xf, true); v += __builtin_amdgcn_update_dpp(0, v, 0x4E, 0xf, 0xf, true);
        v += __builtin_amdgcn_update_dpp(0, v, 0x141, 0xf, 0xf, true); v += __builtin_amdgcn_update_dpp(0, v, 0x140, 0xf, 0xf, true);
        return __builtin_amdgcn_readlane(v, 0) + __builtin_amdgcn_readlane(v, 16) + __builtin_amdgcn_readlane(v, 32) + __builtin_amdgcn_readlane(v, 48); };
    unsigned clo = 0xffffffffu, chi = has_hi ? 0xffffffffu : 0u, glo = 0u, ghi = 0u;
    int G = 0;
#pragma unroll
    for (int i = 0; i < 32; ++i) {
        const unsigned olo = clo & lo[i], ohi = chi & hi[i];
        const int tot = G + wave_count(__builtin_popcount(olo) + __builtin_popcount(ohi));
        const bool take = tot >= 256;
        const unsigned mt = take ? 0u : 0xffffffffu;
        G = take ? G : tot;
        glo |= olo & mt; ghi |= ohi & mt;
        clo = olo ^ (clo & mt); chi = ohi ^ (chi & mt);
        if (tot == 256) break;
    }
    {
        const int need = 256 - G;
        const int ceq = wave_count(__builtin_popcount(clo) + __builtin_popcount(chi));
        if (ceq == need) { glo |= clo; ghi |= chi; }
        else {
            int beq = 0;
#pragma unroll 1
            for (int k = 0; k < 64; ++k) {
                const unsigned bm = 0x80000000u >> (k & 31);
                const bool mine = ((k < 32 ? clo : chi) & bm) != 0u;
                const unsigned long long me = __ballot(mine);
                if (me != 0ull) {
                    const int pe = beq + (int)__builtin_amdgcn_mbcnt_hi((unsigned)(me >> 32), __builtin_amdgcn_mbcnt_lo((unsigned)me, 0u));
                    if (mine && pe < need) { if (k < 32) glo |= bm; else ghi |= bm; }
                    beq += __popcll(me);
                }
            }
        }
    }
    const int cl = __builtin_popcount(glo) + __builtin_popcount(ghi);
    int inc = cl;
#pragma unroll
    for (int o = 1; o < 64; o <<= 1) { const int t = __shfl_up(inc, o); inc += (l >= o) ? t : 0; }
    int pos = inc - cl;
    while (__ballot(glo != 0u) != 0ull) {
        if (glo != 0u) { const int s = __builtin_clz(glo); glo &= ~(0x80000000u >> s); stg[pos++] = (unsigned short)(s * 64 + l); }
    }
    while (__ballot(ghi != 0u) != 0ull) {
        if (ghi != 0u) { const int s = __builtin_clz(ghi); ghi &= ~(0x80000000u >> s); stg[pos++] = (unsigned short)((32 + s) * 64 + l); }
    }
    __builtin_amdgcn_fence(__ATOMIC_RELEASE, "wavefront"); __builtin_amdgcn_wave_barrier(); __builtin_amdgcn_fence(__ATOMIC_ACQUIRE, "wavefront");
    *(u32x2*)(sel + 4 * l) = *(const u32x2*)(stg + 4 * l);
    __builtin_amdgcn_fence(__ATOMIC_RELEASE, "wavefront"); __builtin_amdgcn_wave_barrier(); __builtin_amdgcn_fence(__ATOMIC_ACQUIRE, "wavefront");
}
__device__ __forceinline__ void topk_select(const Ctx& c, const float* __restrict__ SC, bf16* SEL  ) {
    const int l = c.lane;
    for (int m = c.gw; m < M; m += c.ngw) {
        const int b = m / SEQ, t = m % SEQ, limit = ((t >> 6) + 1) * 64;
        unsigned short* sel = (unsigned short*)SEL + (size_t)m * 256;
        if (limit <= 256) { for (int i = l; i < 256; i += 64) sel[i] = (unsigned short)(i < limit ? i : 0); continue; }
        select_row(SC + sc_row_off(b, t), limit, sel, l);
    }
}
__device__ __forceinline__ void dsa_attn_simple(const Ctx& c, const bf16* __restrict__ QALL, const bf16* __restrict__ KF, const bf16* __restrict__ SEL, bf16* OLY, int mmax = M) {
    float* qf = (float*)c.lds;
    float* P = qf + 8 * 288;
    int* sl = (int*)(P + 8 * 256);
    const float scale = 0.08838834764831845f;
    for (int m = c.bid; m < mmax; m += c.nb) {
        const int b = m / SEQ, t = m % SEQ, limit = ((t >> 6) + 1) * 64, cnt = limit < 256 ? limit : 256;
        __syncthreads();
        for (int i = c.tid; i < 8 * 288; i += NTHR) { const int h = i / 288, d = i % 288; qf[i] = bf2f(d < 256 ? QALL[(size_t)m * QC + h * 256 + d] : QALL[(size_t)m * QC + 2048 + h * 32 + (d - 256)]); }
        if (c.tid < 256) sl[c.tid] = (int)((const unsigned short*)SEL)[(size_t)m * 256 + c.tid];
        __syncthreads();
        if (c.tid < 256) {
            float acc[8];
#pragma unroll
            for (int h = 0; h < 8; ++h) acc[h] = 0.f;
            if (c.tid < cnt) {
                const u32x4* kp = (const u32x4*)(KF + (size_t)(b * SEQ + sl[c.tid]) * KFW);
                for (int ch = 0; ch < 36; ++ch) { float k[8]; unpack8(kp[ch], k);
#pragma unroll
                    for (int h = 0; h < 8; ++h) { const float* q = qf + h * 288 + ch * 8;
#pragma unroll
                        for (int j = 0; j < 8; ++j) acc[h] += k[j] * q[j]; } }
            }
#pragma unroll
            for (int h = 0; h < 8; ++h) P[h * 256 + c.tid] = (c.tid < cnt) ? acc[h] * scale : -INFINITY;
        }
        __syncthreads();
        {
            const int h = c.wave; float v[4]; float mx = -INFINITY;
#pragma unroll
            for (int i = 0; i < 4; ++i) { v[i] = P[h * 256 + c.lane + 64 * i]; mx = fmaxf(mx, v[i]); }
            mx = wave_max(mx); float s = 0.f;
#pragma unroll
            for (int i = 0; i < 4; ++i) { v[i] = __expf(v[i] - mx); s += v[i]; }
            s = wave_sum(s); const float inv = 1.f / s;
#pragma unroll
            for (int i = 0; i < 4; ++i) P[h * 256 + c.lane + 64 * i] = v[i] * inv;
        }
        __syncthreads();
        {
            const int r = c.tid & 255, hg = c.tid >> 8; float o[4] = {0.f, 0.f, 0.f, 0.f};
            for (int i = 0; i < cnt; ++i) { const float v = bf2f(KF[(size_t)(b * SEQ + sl[i]) * KFW + r]);
#pragma unroll
                for (int hh = 0; hh < 4; ++hh) o[hh] += P[(hg * 4 + hh) * 256 + i] * v; }
#pragma unroll
            for (int hh = 0; hh < 4; ++hh) OLY[(size_t)m * OC + (hg * 4 + hh) * 256 + r] = (bf16)f2bf(o[hh]);
        }
    }
}
__device__ __forceinline__ void xattn_simple(const Ctx& c, const bf16* __restrict__ XQ, const bf16* __restrict__ KVBIG, int layer, bf16* XO) {
    float* qf = (float*)c.lds;
    float* P = qf + 512;
    const float scale = 0.08838834764831845f;
    for (int m = c.bid; m < M; m += c.nb) {
        const int b = m / SEQ;
        const bf16* kvb = KVBIG + (size_t)(layer * 2048 + b * 256) * 4096 + layer * 1024;
        __syncthreads();
        qf[c.tid] = bf2f(XQ[(size_t)m * 512 + c.tid]);
        __syncthreads();
        {
            const int j = c.tid & 255, hp = c.tid >> 8;
#pragma unroll
            for (int hh = 0; hh < 2; ++hh) { const int h = hp * 2 + hh; const u32x4* kp = (const u32x4*)(kvb + (size_t)j * 4096 + h * 128); float d = 0.f;
                for (int ch = 0; ch < 16; ++ch) { float k[8]; unpack8(kp[ch], k);
#pragma unroll
                    for (int e = 0; e < 8; ++e) d += k[e] * qf[h * 128 + ch * 8 + e]; }
                P[h * 256 + j] = d * scale; }
        }
        __syncthreads();
        if (c.wave < 4) { const int h = c.wave; float v[4]; float mx = -INFINITY;
#pragma unroll
            for (int i = 0; i < 4; ++i) { v[i] = P[h * 256 + c.lane + 64 * i]; mx = fmaxf(mx, v[i]); }
            mx = wave_max(mx); float s = 0.f;
#pragma unroll
            for (int i = 0; i < 4; ++i) { v[i] = __expf(v[i] - mx); s += v[i]; }
            s = wave_sum(s); const float inv = 1.f / s;
#pragma unroll
            for (int i = 0; i < 4; ++i) P[h * 256 + c.lane + 64 * i] = v[i] * inv; }
        __syncthreads();
        {   const int h = c.tid >> 7; float o = 0.f;
            for (int j = 0; j < 256; ++j) o += P[h * 256 + j] * bf2f(kvb[(size_t)j * 4096 + 512 + c.tid]);
            XO[(size_t)m * 512 + c.tid] = (bf16)f2bf(o); }
    }
}
typedef short bf16x8 __attribute__((ext_vector_type(8)));
typedef short bf16x4 __attribute__((ext_vector_type(4)));
__device__ __forceinline__ bf16x4 tr_read4(const unsigned char* p) { return __builtin_amdgcn_ds_read_tr16_b64_v4i16((LAS bf16x4*)p); }
__device__ __forceinline__ bf16x8 cat8(bf16x4 a, bf16x4 b) { return __builtin_shufflevector(a, b, 0, 1, 2, 3, 4, 5, 6, 7); }
__device__ __forceinline__ bf16x8 pack_p8(const f32x4 a, const f32x4 b) {
    u32x4 w; w.x = pg8::cvt_pk_bf16(a[0], a[1]); w.y = pg8::cvt_pk_bf16(a[2], a[3]); w.z = pg8::cvt_pk_bf16(b[0], b[1]); w.w = pg8::cvt_pk_bf16(b[2], b[3]);
    return __builtin_bit_cast(bf16x8, w);
}
__device__ __forceinline__ bf16x8 rope_frag(const bf16x8 xf, const bf16x8 pf, const float* cs, const float* sn, bool lo) {
    float x[8], p[8]; unpack8(__builtin_bit_cast(u32x4, xf), x); unpack8(__builtin_bit_cast(u32x4, pf), p);
    const float sg = lo ? -1.f : 1.f; float o[8];
#pragma unroll
    for (int j = 0; j < 8; ++j) o[j] = x[j] * cs[j] + sg * p[j] * sn[j];
    u32x4 w; w.x = pg8::cvt_pk_bf16(o[0], o[1]); w.y = pg8::cvt_pk_bf16(o[2], o[3]); w.z = pg8::cvt_pk_bf16(o[4], o[5]); w.w = pg8::cvt_pk_bf16(o[6], o[7]);
    return __builtin_bit_cast(bf16x8, w);
}
__device__ __forceinline__ bf16x8 xchg_frag(const bf16x8 v, int lane_xor) { u32x4 u = __builtin_bit_cast(u32x4, v); u32x4 r;
    r.x = (unsigned)__shfl_xor((int)u.x, lane_xor); r.y = (unsigned)__shfl_xor((int)u.y, lane_xor); r.z = (unsigned)__shfl_xor((int)u.z, lane_xor); r.w = (unsigned)__shfl_xor((int)u.w, lane_xor); return __builtin_bit_cast(bf16x8, r); }
constexpr int XA_PITCH = 272;
__device__ __forceinline__ void xattn_mfma(const Ctx& c, const bf16* __restrict__ XQ, const bf16* __restrict__ KVBIG, int layer, bf16* XO) {
    unsigned char* Kl = c.lds; unsigned char* Vl = c.lds + 256 * XA_PITCH;
    const int l = c.lane, n16 = l & 15, g = l >> 4;
    const float scale = 0.08838834764831845f * 1.4426950408889634f;
    for (int unit = c.bid; unit < 256; unit += c.nb) {
        const int b = unit >> 5, h = (unit >> 3) & 3, qc = unit & 7;
        const bf16* kvb = KVBIG + (size_t)(layer * 2048 + b * 256) * 4096 + layer * 1024 + h * 128;
        __syncthreads();
        for (int i = c.tid; i < 4096; i += NTHR) { const int row = i >> 4, ch = i & 15;
            *(u32x4*)(Kl + row * XA_PITCH + ch * 16) = *(const u32x4*)(kvb + (size_t)row * 4096 + ch * 8);
            *(u32x4*)(Vl + row * XA_PITCH + ch * 16) = *(const u32x4*)(kvb + (size_t)row * 4096 + 512 + ch * 8); }
        __syncthreads();
#pragma unroll 1
        for (int g4 = 0; g4 < 4; ++g4) {
            const size_t m = (size_t)b * SEQ + qc * 512 + c.wave * 64 + g4 * 16 + n16;
            bf16x8 Qb[4];
#pragma unroll
            for (int kk = 0; kk < 4; ++kk) Qb[kk] = *(const bf16x8*)(XQ + m * 512 + h * 128 + 32 * kk + 8 * g);
            f32x4 S[16];
#pragma unroll
            for (int j = 0; j < 16; ++j) { S[j] = (f32x4){0.f, 0.f, 0.f, 0.f};
#pragma unroll
                for (int kk = 0; kk < 4; ++kk) { const bf16x8 A = *(const bf16x8*)(Kl + (16 * j + n16) * XA_PITCH + (32 * kk + 8 * g) * 2);
                    S[j] = __builtin_amdgcn_mfma_f32_16x16x32_bf16(A, Qb[kk], S[j], 0, 0, 0); } }
            float mx = -INFINITY;
#pragma unroll
            for (int j = 0; j < 16; ++j) mx = fmaxf(mx, fmaxf(fmaxf(S[j][0], S[j][1]), fmaxf(S[j][2], S[j][3])));
            mx = fmaxf(mx, __shfl_xor(mx, 16)); mx = fmaxf(mx, __shfl_xor(mx, 32));
            float sum = 0.f; const float mo = mx * scale;
#pragma unroll
            for (int j = 0; j < 16; ++j) {
#pragma unroll
                for (int r = 0; r < 4; ++r) { const float p = __builtin_amdgcn_exp2f(S[j][r] * scale - mo); S[j][r] = p; sum += p; } }
            sum += __shfl_xor(sum, 16); sum += __shfl_xor(sum, 32);
            const float inv = 1.f / sum;
            bf16x8 Pb[8];
#pragma unroll
            for (int jj = 0; jj < 8; ++jj) Pb[jj] = pack_p8(S[2 * jj], S[2 * jj + 1]);
            const int q4 = n16 >> 2, p4 = l & 3;
#pragma unroll
            for (int dt = 0; dt < 8; ++dt) { f32x4 O = (f32x4){0.f, 0.f, 0.f, 0.f};
#pragma unroll
                for (int jj = 0; jj < 8; ++jj) { const unsigned char* vp = Vl + (32 * jj + 4 * g + q4) * XA_PITCH + (16 * dt) * 2 + 8 * p4;
                    const bf16x8 A = cat8(tr_read4(vp), tr_read4(vp + 16 * XA_PITCH));
                    O = __builtin_amdgcn_mfma_f32_16x16x32_bf16(A, Pb[jj], O, 0, 0, 0); }
                u32x2 w; w.x = pg8::cvt_pk_bf16(O[0] * inv, O[1] * inv); w.y = pg8::cvt_pk_bf16(O[2] * inv, O[3] * inv);
                *(u32x2*)(XO + m * 512 + h * 128 + 16 * dt + 4 * g) = w; }
        }
    }
}
__device__ __forceinline__ void diag_cmp_bf16(const Ctx& c, const bf16* A, int lda, const bf16* B, int ldb, int rows, int cols, float* acc) {
    float d2 = 0.f, a2 = 0.f;
    const size_t n = (size_t)rows * cols;
    for (size_t i = (size_t)c.bid * NTHR + c.tid; i < n; i += (size_t)c.nb * NTHR) { const size_t r = i / cols, cc = i % cols; const float a = bf2f(A[r * lda + cc]), b = bf2f(B[r * ldb + cc]); d2 += (a - b) * (a - b); a2 += a * a; }
    d2 = wave_sum(d2); a2 = wave_sum(a2);
    if (c.lane == 0) { atomicAdd(acc, d2); atomicAdd(acc + 1, a2); }
}
constexpr int DA_PITCH = 528, DA_WAVE_BYTES = 32 * DA_PITCH;
__device__ __forceinline__ void dsa_attn_mfma(const Ctx& c, const bf16* __restrict__ QALL, const bf16* __restrict__ KF, const bf16* __restrict__ SEL, const float* __restrict__ ROPEA, bf16* OLY, int m_first, int m_stride, int m_end) {
    unsigned char* Vw = c.lds + c.wave * DA_WAVE_BYTES;
    const int l = c.lane, n16 = l & 15, g = l >> 4, q4 = n16 >> 2, p4 = l & 3, hh = n16 & 7;
    const float scale = 0.08838834764831845f * 1.4426950408889634f;
#pragma unroll 1
    for (int m = m_first; m < m_end; m += m_stride) {
        const int b = m / SEQ, t = m % SEQ, limit = ((t >> 6) + 1) * 64, cnt = limit < 256 ? limit : 256, nblk = cnt >> 5;
        const bf16* qrow = QALL + (size_t)m * QC;
        bf16x8 Qb[9];
#pragma unroll
        for (int kk = 0; kk < 8; ++kk) Qb[kk] = *(const bf16x8*)(qrow + hh * 256 + 32 * kk + 8 * g);
        Qb[8] = *(const bf16x8*)(qrow + 2048 + hh * 32 + 8 * g);
        {
            const bf16x8 pf = xchg_frag(Qb[8], 32); float cs[8], sn[8];
            const f32x4 c0 = *(const f32x4*)(ROPEA + (size_t)m * 32 + 8 * (g & 1)), c1 = *(const f32x4*)(ROPEA + (size_t)m * 32 + 8 * (g & 1) + 4), s0 = *(const f32x4*)(ROPEA + (size_t)m * 32 + 16 + 8 * (g & 1)), s1 = *(const f32x4*)(ROPEA + (size_t)m * 32 + 16 + 8 * (g & 1) + 4);
            cs[0] = c0.x; cs[1] = c0.y; cs[2] = c0.z; cs[3] = c0.w; cs[4] = c1.x; cs[5] = c1.y; cs[6] = c1.z; cs[7] = c1.w; sn[0] = s0.x; sn[1] = s0.y; sn[2] = s0.z; sn[3] = s0.w; sn[4] = s1.x; sn[5] = s1.y; sn[6] = s1.z; sn[7] = s1.w;
            Qb[8] = rope_frag(Qb[8], pf, cs, sn, g < 2); }
        f32x4 O[16];
#pragma unroll
        for (int dt = 0; dt < 16; ++dt) O[dt] = (f32x4){0.f, 0.f, 0.f, 0.f};
        float mrun = -INFINITY, lrun = 0.f;
        const unsigned short* selp = (const unsigned short*)SEL + (size_t)m * 256;
        const bf16* kfb = KF + (size_t)b * SEQ * KFW;
        bf16x8 K0[9], K1[9];
#define DA_GATHER(BLK) do { const int s0_ = selp[32 * (BLK) + n16], s1_ = selp[32 * (BLK) + 16 + n16]; \
            const bf16* r0_ = kfb + (size_t)s0_ * KFW + 8 * g; const bf16* r1_ = kfb + (size_t)s1_ * KFW + 8 * g; \
            _Pragma("unroll") for (int kk = 0; kk < 9; ++kk) { K0[kk] = *(const bf16x8*)(r0_ + 32 * kk); K1[kk] = *(const bf16x8*)(r1_ + 32 * kk); } } while (0)
        DA_GATHER(0);
#pragma unroll 1
        for (int blk = 0; blk < nblk; ++blk) {
            f32x4 S0 = (f32x4){0.f, 0.f, 0.f, 0.f}, S1 = (f32x4){0.f, 0.f, 0.f, 0.f};
#pragma unroll
            for (int kk = 0; kk < 9; ++kk) { S0 = __builtin_amdgcn_mfma_f32_16x16x32_bf16(K0[kk], Qb[kk], S0, 0, 0, 0); S1 = __builtin_amdgcn_mfma_f32_16x16x32_bf16(K1[kk], Qb[kk], S1, 0, 0, 0); }
#pragma unroll
            for (int kk = 0; kk < 8; ++kk) { *(bf16x8*)(Vw + n16 * DA_PITCH + (32 * kk + 8 * g) * 2) = K0[kk]; *(bf16x8*)(Vw + (16 + n16) * DA_PITCH + (32 * kk + 8 * g) * 2) = K1[kk]; }
            __builtin_amdgcn_sched_barrier(0);
            if (blk + 1 < nblk) DA_GATHER(blk + 1);
            __builtin_amdgcn_sched_barrier(0);
            float bm = fmaxf(fmaxf(fmaxf(S0[0], S0[1]), fmaxf(S0[2], S0[3])), fmaxf(fmaxf(S1[0], S1[1]), fmaxf(S1[2], S1[3])));
            bm = fmaxf(bm, __shfl_xor(bm, 16)); bm = fmaxf(bm, __shfl_xor(bm, 32));
            const float mnew = fmaxf(mrun, bm), alpha = __builtin_amdgcn_exp2f((mrun - mnew) * scale), mo = mnew * scale; mrun = mnew;
            float ps = 0.f;
#pragma unroll
            for (int r = 0; r < 4; ++r) { S0[r] = __builtin_amdgcn_exp2f(S0[r] * scale - mo); S1[r] = __builtin_amdgcn_exp2f(S1[r] * scale - mo); ps += S0[r] + S1[r]; }
            lrun = lrun * alpha + ps;
            const bf16x8 Pb = pack_p8(S0, S1);
#pragma unroll
            for (int dt = 0; dt < 16; ++dt) { O[dt] = O[dt] * alpha;
                const unsigned char* vp = Vw + (4 * g + q4) * DA_PITCH + (16 * dt) * 2 + 8 * p4;
                const bf16x8 A = cat8(tr_read4(vp), tr_read4(vp + 16 * DA_PITCH));
                O[dt] = __builtin_amdgcn_mfma_f32_16x16x32_bf16(A, Pb, O[dt], 0, 0, 0); }
        }
#undef DA_GATHER
        lrun += __shfl_xor(lrun, 16); lrun += __shfl_xor(lrun, 32);
        const float inv = 1.f / lrun;
        if (n16 < 8) {
            bf16* orow = OLY + (size_t)m * OC + n16 * 256 + 4 * g;
#pragma unroll
            for (int dt = 0; dt < 16; ++dt) { u32x2 w; w.x = pg8::cvt_pk_bf16(O[dt][0] * inv, O[dt][1] * inv); w.y = pg8::cvt_pk_bf16(O[dt][2] * inv, O[dt][3] * inv); *(u32x2*)(orow + 16 * dt) = w; }
        }
    }
}
__device__ __forceinline__ void dsa_attn_queue(const Ctx& c, const bf16* __restrict__ QALL, const bf16* __restrict__ KF, const bf16* __restrict__ SEL, const float* __restrict__ ROPEA, bf16* OLY, unsigned* counter, volatile LAS unsigned* slot) {
    for (;;) {
        __syncthreads();
        if (c.tid == 0) *slot = __hip_atomic_fetch_add(counter, 1u, __ATOMIC_RELAXED, __HIP_MEMORY_SCOPE_AGENT);
        __syncthreads();
        const int chunk = (int)*slot;
        if (chunk >= M / 16) break;
        dsa_attn_mfma(c, QALL, KF, SEL, ROPEA, OLY, chunk * 16 + c.wave, 8, chunk * 16 + 16);
    }
}
__device__ __forceinline__ float relu1(float x) { const int b = __builtin_bit_cast(int, x); return __builtin_bit_cast(float, b > 0 ? b : 0); }
__device__ __forceinline__ void idx_topk_mfma(const Ctx& c, const bf16* __restrict__ QALL, const bf16* __restrict__ KIDX, const float* __restrict__ WIDX, const float* __restrict__ ROPEI, float* scr, bf16* SEL, int nitems) {
    const int l = c.lane, n16 = l & 15, g = l >> 4, qg = c.wave & 3, kh = c.wave >> 2;
#pragma unroll 1
    for (int item = c.bid; item < nitems; item += c.nb) {
        const int b = item >> 5, pr = item & 31;
#pragma unroll 1
        for (int which = 0; which < 2; ++which) {
            const int ch = which ? 63 - pr : pr, L = 64 * (ch + 1), t0 = 64 * ch;
            if (L > 256) {
            const size_t m = (size_t)b * SEQ + t0 + 16 * qg + n16;
            float* srow = scr + (size_t)(16 * qg + n16) * L + 4 * g;
            const int nt = L >> 5, j0 = kh * nt, j1 = j0 + nt;
            const bf16* kp = KIDX + ((size_t)b * SEQ + n16) * 64 + 8 * g;
            {
                bf16x8 Qi[16][2]; float w[16];
                { const bf16* qp = QALL + m * QC + 2304 + 8 * g;
#pragma unroll
                  for (int h = 0; h < 16; ++h) { Qi[h][0] = *(const bf16x8*)(qp + h * 64); Qi[h][1] = *(const bf16x8*)(qp + h * 64 + 32); }
                  {
                      float cs[8], sn[8]; const f32x4 c0 = *(const f32x4*)(ROPEI + m * 16), c1 = *(const f32x4*)(ROPEI + m * 16 + 4), s0 = *(const f32x4*)(ROPEI + m * 16 + 8), s1 = *(const f32x4*)(ROPEI + m * 16 + 12);
                      cs[0] = c0.x; cs[1] = c0.y; cs[2] = c0.z; cs[3] = c0.w; cs[4] = c1.x; cs[5] = c1.y; cs[6] = c1.z; cs[7] = c1.w; sn[0] = s0.x; sn[1] = s0.y; sn[2] = s0.z; sn[3] = s0.w; sn[4] = s1.x; sn[5] = s1.y; sn[6] = s1.z; sn[7] = s1.w;
#pragma unroll
                      for (int h = 0; h < 16; ++h) { const bf16x8 pf = xchg_frag(Qi[h][0], 16); const bf16x8 rf = rope_frag(Qi[h][0], pf, cs, sn, g == 0); if (g < 2) Qi[h][0] = rf; } }
                  const f32x4* wp = (const f32x4*)(WIDX + m * 16);
#pragma unroll
                  for (int q = 0; q < 4; ++q) { const f32x4 v = wp[q]; w[4 * q] = v.x; w[4 * q + 1] = v.y; w[4 * q + 2] = v.z; w[4 * q + 3] = v.w; } }
                bf16x8 Ka = *(const bf16x8*)(kp + (size_t)j0 * 1024), Kb = *(const bf16x8*)(kp + (size_t)j0 * 1024 + 32);
#pragma unroll 1
                for (int j = j0; j < j1; ++j) {
                    const int jn = (j + 1 < j1) ? j + 1 : j;
                    const bf16x8 Na = *(const bf16x8*)(kp + (size_t)jn * 1024), Nb = *(const bf16x8*)(kp + (size_t)jn * 1024 + 32);
                    f32x2 s01 = (f32x2){0.f, 0.f}, s23 = (f32x2){0.f, 0.f};
                    f32x4 a = __builtin_amdgcn_mfma_f32_16x16x32_bf16(Ka, Qi[0][0], (f32x4){0.f, 0.f, 0.f, 0.f}, 0, 0, 0); a = __builtin_amdgcn_mfma_f32_16x16x32_bf16(Kb, Qi[0][1], a, 0, 0, 0);
#pragma unroll
                    for (int h = 0; h < 16; ++h) { f32x4 an = a;
                        if (h < 15) { an = __builtin_amdgcn_mfma_f32_16x16x32_bf16(Ka, Qi[h + 1][0], (f32x4){0.f, 0.f, 0.f, 0.f}, 0, 0, 0); an = __builtin_amdgcn_mfma_f32_16x16x32_bf16(Kb, Qi[h + 1][1], an, 0, 0, 0); }
                        const f32x2 wv = (f32x2){w[h], w[h]};
                        s01 = (f32x2){relu1(a[0]), relu1(a[1])} * wv + s01; s23 = (f32x2){relu1(a[2]), relu1(a[3])} * wv + s23; a = an; }
                    *(f32x4*)(srow + 16 * j) = (f32x4){s01.x, s01.y, s23.x, s23.y};
                    Ka = Na; Kb = Nb;
                }
            }
            }
            asm volatile("s_waitcnt vmcnt(0)" ::: "memory");
            __syncthreads();
            __builtin_amdgcn_fence(__ATOMIC_ACQUIRE, "agent");
            asm volatile("s_waitcnt vmcnt(0)" ::: "memory");
#pragma unroll 1
            for (int i = 0; i < 8; ++i) {
                const int ql = c.wave * 8 + i;
                unsigned short* sel = (unsigned short*)SEL + ((size_t)b * SEQ + t0 + ql) * 256;
                if (L <= 256) { for (int k = l; k < 256; k += 64) sel[k] = (unsigned short)(k < L ? k : 0); }
                else select_row_bs(scr + (size_t)ql * L, L, sel, l, (unsigned short*)(c.lds + c.wave * 512));
            }
            __syncthreads();
        }
    }
}
__device__ __forceinline__ void diag_cmp_sel(const Ctx& c, const bf16* SA, const bf16* SB, int nbatch, float* acc) {
    unsigned* bm = (unsigned*)(c.lds + c.wave * 512);
    float miss = 0.f, tot = 0.f;
    for (int m = c.gw; m < nbatch * SEQ; m += c.ngw) {
        const int t = m % SEQ; if (t < 256) continue;
        bm[c.lane] = 0u; bm[64 + c.lane] = 0u;
        __builtin_amdgcn_fence(__ATOMIC_RELEASE, "wavefront"); __builtin_amdgcn_wave_barrier();
        for (int i = c.lane; i < 256; i += 64) { const unsigned s = ((const unsigned short*)SA)[(size_t)m * 256 + i]; atomicOr(&bm[s >> 5], 1u << (s & 31)); }
        __builtin_amdgcn_fence(__ATOMIC_RELEASE, "wavefront"); __builtin_amdgcn_wave_barrier(); __builtin_amdgcn_fence(__ATOMIC_ACQUIRE, "wavefront");
        for (int i = c.lane; i < 256; i += 64) { const unsigned s = ((const unsigned short*)SB)[(size_t)m * 256 + i]; miss += ((bm[s >> 5] >> (s & 31)) & 1u) ? 0.f : 1.f; tot += 1.f; }
        __builtin_amdgcn_fence(__ATOMIC_RELEASE, "wavefront"); __builtin_amdgcn_wave_barrier();
    }
    miss = wave_sum(miss); tot = wave_sum(tot);
    if (c.lane == 0) { atomicAdd(acc, miss); atomicAdd(acc + 1, tot); }
}
__device__ __forceinline__ void idx_topk_lds(const Ctx& c, const bf16* __restrict__ QALL, const bf16* __restrict__ KIDX, const float* __restrict__ WIDX, const float* __restrict__ ROPEI, u32x4* qscr, bf16* SEL, int nitems) {
    float* SCL = (float*)c.lds;
    f32x4* WL = (f32x4*)(c.lds + 131072);
    const int w8 = c.wave;
#pragma unroll 1
    for (int item = c.bid; item < nitems; item += c.nb) {
        const int b = item >> 5, pr = item & 31;
#pragma unroll 1
        for (int which = 0; which < 2; ++which) {
            int l = c.lane; asm volatile("" : "+v"(l));
            const int n16 = l & 15, g = l >> 4;
            const int ch = which ? 63 - pr : pr, L = 64 * (ch + 1), t0 = 64 * ch;
            if (L <= 256) {
#pragma unroll 1
                for (int i = 0; i < 8; ++i) { unsigned short* sel = (unsigned short*)SEL + ((size_t)b * SEQ + t0 + w8 * 8 + i) * 256; for (int k = l; k < 256; k += 64) sel[k] = (unsigned short)(k < L ? k : 0); }
                continue;
            }
            __syncthreads();
            if (w8 < 4) {
                const size_t m = (size_t)b * SEQ + t0 + 16 * w8 + n16;
                const bf16* qp = QALL + m * QC + 2304 + 8 * g;
                float cs[8], sn[8]; const f32x4 c0 = *(const f32x4*)(ROPEI + m * 16), c1 = *(const f32x4*)(ROPEI + m * 16 + 4), s0 = *(const f32x4*)(ROPEI + m * 16 + 8), s1 = *(const f32x4*)(ROPEI + m * 16 + 12);
                cs[0] = c0.x; cs[1] = c0.y; cs[2] = c0.z; cs[3] = c0.w; cs[4] = c1.x; cs[5] = c1.y; cs[6] = c1.z; cs[7] = c1.w; sn[0] = s0.x; sn[1] = s0.y; sn[2] = s0.z; sn[3] = s0.w; sn[4] = s1.x; sn[5] = s1.y; sn[6] = s1.z; sn[7] = s1.w;
#pragma unroll 4
                for (int h = 0; h < 16; ++h) { bf16x8 f0 = *(const bf16x8*)(qp + h * 64); const bf16x8 f1 = *(const bf16x8*)(qp + h * 64 + 32);
                    const bf16x8 pf = xchg_frag(f0, 16); const bf16x8 rf = rope_frag(f0, pf, cs, sn, g == 0); if (g < 2) f0 = rf;
                    qscr[(w8 * 64 + l) * 32 + h * 2] = __builtin_bit_cast(u32x4, f0); qscr[(w8 * 64 + l) * 32 + h * 2 + 1] = __builtin_bit_cast(u32x4, f1); }
            }
            asm volatile("s_waitcnt vmcnt(0)" ::: "memory");
            __syncthreads();
            __builtin_amdgcn_fence(__ATOMIC_ACQUIRE, "agent"); asm volatile("s_waitcnt vmcnt(0)" ::: "memory");
            const bf16* kp = KIDX + ((size_t)b * SEQ + n16) * 64 + 8 * g;
            const int ntile = L >> 4;
#pragma unroll 1
            for (int qsub = 0; qsub < 8; ++qsub) {
                asm volatile("" ::: "memory");
                bf16x8 Qi[16][2];
                { const int srcl = g * 16 + (qsub & 1) * 8 + (n16 & 7); const u32x4* fp = qscr + (size_t)((qsub >> 1) * 64 + srcl) * 32;
#pragma unroll
                  for (int h = 0; h < 16; ++h) { Qi[h][0] = __builtin_bit_cast(bf16x8, fp[h * 2]); Qi[h][1] = __builtin_bit_cast(bf16x8, fp[h * 2 + 1]); }
                  if (w8 == 0 && l < 32) WL[l] = *(const f32x4*)(WIDX + ((size_t)b * SEQ + t0 + 8 * qsub + (l >> 2)) * 16 + 4 * (l & 3)); }
                __syncthreads();
                const f32x4* wq = WL + (n16 & 7) * 4;
                float* srow = SCL + (n16 & 7) * 4096 + 4 * g;
                int j = w8;
                bf16x8 Ka = *(const bf16x8*)(kp + (size_t)j * 1024), Kb = *(const bf16x8*)(kp + (size_t)j * 1024 + 32);
#pragma unroll 1
                for (; j < ntile; j += 8) {
                    const int jn = (j + 8 < ntile) ? j + 8 : j;
                    const bf16x8 Na = *(const bf16x8*)(kp + (size_t)jn * 1024), Nb = *(const bf16x8*)(kp + (size_t)jn * 1024 + 32);
                    f32x2 s01 = (f32x2){0.f, 0.f}, s23 = (f32x2){0.f, 0.f};
                    f32x4 a = __builtin_amdgcn_mfma_f32_16x16x32_bf16(Ka, Qi[0][0], (f32x4){0.f, 0.f, 0.f, 0.f}, 0, 0, 0); a = __builtin_amdgcn_mfma_f32_16x16x32_bf16(Kb, Qi[0][1], a, 0, 0, 0);
#pragma unroll
                    for (int h4 = 0; h4 < 4; ++h4) { const f32x4 w4 = wq[h4];
#pragma unroll
                        for (int hh = 0; hh < 4; ++hh) { const int h = 4 * h4 + hh; f32x4 an = a;
                            if (h < 15) { an = __builtin_amdgcn_mfma_f32_16x16x32_bf16(Ka, Qi[h + 1][0], (f32x4){0.f, 0.f, 0.f, 0.f}, 0, 0, 0); an = __builtin_amdgcn_mfma_f32_16x16x32_bf16(Kb, Qi[h + 1][1], an, 0, 0, 0); }
                            const f32x2 wv = (f32x2){w4[hh], w4[hh]};
                            s01 = (f32x2){relu1(a[0]), relu1(a[1])} * wv + s01; s23 = (f32x2){relu1(a[2]), relu1(a[3])} * wv + s23; a = an; } }
                    if (n16 < 8) *(f32x4*)(srow + 16 * j) = (f32x4){s01.x, s01.y, s23.x, s23.y};
                    Ka = Na; Kb = Nb;
                }
                __syncthreads();
                select_row(SCL + w8 * 4096, L, (unsigned short*)SEL + ((size_t)b * SEQ + t0 + 8 * qsub + w8) * 256, l);
                __syncthreads();
            }
        }
    }
}
#if DIAG == 7
__device__ __forceinline__ void select_row_v1(const float* row, int limit, unsigned short* sel, int l_in) {
    int l = l_in; asm volatile("" : "+v"(l));
    const int ng = limit >> 9;
    unsigned key[64];
#pragma unroll
    for (int j = 0; j < 64; ++j) { const int s = j * 64 + l; unsigned u = 0u; if (s < limit) { u = __float_as_uint(row[s]); u = (u & 0x80000000u) ? ~u : (u | 0x80000000u); } key[j] = u; }
    unsigned mx = 0u;
#pragma unroll
    for (int j = 0; j < 64; ++j) mx = key[j] > mx ? key[j] : mx;
#pragma unroll
    for (int o = 1; o < 64; o <<= 1) { const unsigned t = (unsigned)__shfl_xor((int)mx, o); mx = t > mx ? t : mx; }
    mx = (unsigned)__builtin_amdgcn_readfirstlane((int)mx);
    unsigned T = 0u;
#pragma unroll 1
    for (int bit = 31 - __builtin_clz(mx | 1u); bit >= 0; --bit) {
        const unsigned Tn = T | (1u << bit); int cnt = 0;
#pragma unroll
        for (int jg = 0; jg < 8; ++jg) if (jg <= ng) {
#pragma unroll
            for (int j = 8 * jg; j < 8 * jg + 8; ++j) cnt += __popcll(__ballot(key[j] >= Tn)); }
        if (cnt >= 256) T = Tn;
        if (cnt == 256) break;
    }
    int cgt = 0;
#pragma unroll
    for (int j = 0; j < 64; ++j) cgt += __popcll(__ballot(key[j] > T));
    const int need_eq = 256 - cgt;
    int base = 0, beq = 0;
    const unsigned long long lt = (1ull << l) - 1ull;
#pragma unroll
    for (int jg = 0; jg < 8; ++jg) if (jg <= ng) {
#pragma unroll
        for (int j = 8 * jg; j < 8 * jg + 8; ++j) {
            const unsigned long long mg = __ballot(key[j] > T), me = __ballot(key[j] == T);
            if (key[j] > T) sel[base + __popcll(mg & lt)] = (unsigned short)(j * 64 + l);
            base += __popcll(mg);
            const int pe = beq + __popcll(me & lt);
            if (key[j] == T && pe < need_eq) sel[cgt + pe] = (unsigned short)(j * 64 + l);
            beq += __popcll(me);
        }
    }
}
__device__ __forceinline__ void idx_topk_v1(const Ctx& c, const bf16* __restrict__ QALL, const bf16* __restrict__ KIDX, const float* __restrict__ WIDX, float* scr, bf16* SEL, int nitems) {
    const int l = c.lane, n16 = l & 15, g = l >> 4, qg = c.wave & 3, kh = c.wave >> 2;
#pragma unroll 1
    for (int item = c.bid; item < nitems; item += c.nb) {
        const int b = item >> 5, pr = item & 31;
#pragma unroll 1
        for (int which = 0; which < 2; ++which) {
            const int ch = which ? 63 - pr : pr, L = 64 * (ch + 1), t0 = 64 * ch;
            if (L > 256) {
            const size_t m = (size_t)b * SEQ + t0 + 16 * qg + n16;
            float* srow = scr + (size_t)(16 * qg + n16) * L + 4 * g;
            const int nt = L >> 5, j0 = kh * nt, j1 = j0 + nt;
            const bf16* kp = KIDX + ((size_t)b * SEQ + n16) * 64 + 8 * g;
#pragma unroll 1
            for (int hp = 0; hp < 2; ++hp) {
                bf16x8 Qi[8][2]; float w[8];
                { const bf16* qp = QALL + m * QC + 2304 + hp * 512 + 8 * g;
#pragma unroll
                  for (int h = 0; h < 8; ++h) { Qi[h][0] = *(const bf16x8*)(qp + h * 64); Qi[h][1] = *(const bf16x8*)(qp + h * 64 + 32); }
                  const f32x4* wp = (const f32x4*)(WIDX + m * 16 + hp * 8);
#pragma unroll
                  for (int q = 0; q < 2; ++q) { const f32x4 v = wp[q]; w[4 * q] = v.x; w[4 * q + 1] = v.y; w[4 * q + 2] = v.z; w[4 * q + 3] = v.w; } }
                if (hp) { asm volatile("s_waitcnt vmcnt(0)" ::: "memory"); __builtin_amdgcn_fence(__ATOMIC_ACQUIRE, "agent"); asm volatile("s_waitcnt vmcnt(0)" ::: "memory"); }
                bf16x8 Ka = *(const bf16x8*)(kp + (size_t)j0 * 1024), Kb = *(const bf16x8*)(kp + (size_t)j0 * 1024 + 32);
                f32x4 pv = (f32x4){0.f, 0.f, 0.f, 0.f}; if (hp) pv = *(const f32x4*)(srow + 16 * j0);
#pragma unroll 1
                for (int j = j0; j < j1; ++j) {
                    const int jn = (j + 1 < j1) ? j + 1 : j;
                    const bf16x8 Na = *(const bf16x8*)(kp + (size_t)jn * 1024), Nb = *(const bf16x8*)(kp + (size_t)jn * 1024 + 32);
                    f32x4 pn = (f32x4){0.f, 0.f, 0.f, 0.f}; if (hp) pn = *(const f32x4*)(srow + 16 * jn);
                    f32x4 sc = pv;
#pragma unroll
                    for (int h = 0; h < 8; ++h) { f32x4 a = __builtin_amdgcn_mfma_f32_16x16x32_bf16(Ka, Qi[h][0], (f32x4){0.f, 0.f, 0.f, 0.f}, 0, 0, 0); a = __builtin_amdgcn_mfma_f32_16x16x32_bf16(Kb, Qi[h][1], a, 0, 0, 0);
                        sc[0] += w[h] * fmaxf(a[0], 0.f); sc[1] += w[h] * fmaxf(a[1], 0.f); sc[2] += w[h] * fmaxf(a[2], 0.f); sc[3] += w[h] * fmaxf(a[3], 0.f); }
                    *(f32x4*)(srow + 16 * j) = sc;
                    Ka = Na; Kb = Nb; pv = pn;
                }
            }
            }
            asm volatile("s_waitcnt vmcnt(0)" ::: "memory");
            __syncthreads();
            __builtin_amdgcn_fence(__ATOMIC_ACQUIRE, "agent");
            asm volatile("s_waitcnt vmcnt(0)" ::: "memory");
#pragma unroll 1
            for (int i = 0; i < 8; ++i) {
                const int ql = c.wave * 8 + i;
                unsigned short* sel = (unsigned short*)SEL + ((size_t)b * SEQ + t0 + ql) * 256;
                if (L <= 256) { for (int k = l; k < 256; k += 64) sel[k] = (unsigned short)(k < L ? k : 0); }
                else select_row_v1(scr + (size_t)ql * L, L, sel, l);
            }
            __syncthreads();
        }
    }
}
#endif
constexpr int RW_TB = 32;
struct RwkvP { const float *mu, *w0, *w2, *a0, *a2, *g2, *k_k, *k_a, *r_k, *ln_w, *ln_b; };
__device__ __forceinline__ void rwkv_phase(const Ctx& c, const bf16* __restrict__ H, const RwkvP P, bf16* OLY) {
    float* A_WR = (float*)c.lds;
    float* A_K2 = A_WR + RW_TB * 64;
    float* A_V = A_K2 + RW_TB * 64;
    float* A_W = A_V + RW_TB * 64;
    float* A_NKK = A_W + RW_TB * 64;
    float* A_B = A_NKK + RW_TB * 64;
    float* A_G = A_B + RW_TB * 64;
    float* A_OUT = A_G + RW_TB * 64;
    float* L_TW = A_OUT + RW_TB * 64;
    float* L_AL = L_TW + RW_TB * 64;
    float* L_SG = L_AL + RW_TB * 64;
    float* SC1 = L_SG + RW_TB * 160; float* SC2 = SC1 + RW_TB; float* SC3 = SC2 + RW_TB;
    const int l = c.lane, w = c.wave;
    for (int item = c.bid; item < NB * 16; item += c.nb) {
        const int b = item >> 4, h = item & 15, hk = h * 64 + l;
        const float w0v = P.w0[hk], a0v = P.a0[hk], kkv = P.k_k[hk], kav = P.k_a[hk], rkv = P.r_k[hk], lnw = P.ln_w[hk], lnb = P.ln_b[hk];
        float S[8];
#pragma unroll
        for (int i = 0; i < 8; ++i) S[i] = 0.f;
        const int srow = w * 8 + (l >> 3), sj = l & 7;
        for (int t0 = 0; t0 < SEQ; t0 += RW_TB) {
            __syncthreads();
            for (int idx = c.tid; idx < RW_TB * 480; idx += NTHR) {
                const int t = idx / 480, cc = idx % 480; int col; float* dst;
                if (cc < 64) { col = 880 + h * 64 + cc; dst = A_WR + t * 64 + cc; }
                else if (cc < 128) { col = 1904 + h * 64 + (cc - 64); dst = A_K2 + t * 64 + (cc - 64); }
                else if (cc < 192) { col = 2928 + h * 64 + (cc - 128); dst = A_V + t * 64 + (cc - 128); }
                else if (cc < 256) { col = 3952 + (cc - 192); dst = L_TW + t * 64 + (cc - 192); }
                else if (cc < 320) { col = 4016 + (cc - 256); dst = L_AL + t * 64 + (cc - 256); }
                else { col = 4080 + (cc - 320); dst = L_SG + t * 160 + (cc - 320); }
                const size_t m = (size_t)b * SEQ + t0 + t;
                const float x = bf2f(H[m * HC + col]); const float xp = (t0 + t > 0) ? bf2f(H[(m - 1) * HC + col]) : 0.f;
                float hm = x + (xp - x) * P.mu[col - 880];
                if (cc >= 192 && cc < 256) hm = tanhf(hm); else if (cc >= 320) hm = sigmoidf_(hm);
                *dst = hm;
            }
            __syncthreads();
            {
                float wl[RW_TB / 8], al[RW_TB / 8], gg[RW_TB / 8];
#pragma unroll
                for (int i = 0; i < RW_TB / 8; ++i) { wl[i] = 0.f; al[i] = 0.f; gg[i] = 0.f; }
                for (int j = 0; j < 64; ++j) { const float w2v = P.w2[(size_t)j * 1024 + hk], a2v = P.a2[(size_t)j * 1024 + hk];
#pragma unroll
                    for (int i = 0; i < RW_TB / 8; ++i) { wl[i] += L_TW[(w + 8 * i) * 64 + j] * w2v; al[i] += L_AL[(w + 8 * i) * 64 + j] * a2v; } }
                for (int j = 0; j < 160; ++j) { const float g2v = P.g2[(size_t)j * 1024 + hk];
#pragma unroll
                    for (int i = 0; i < RW_TB / 8; ++i) gg[i] += L_SG[(w + 8 * i) * 160 + j] * g2v; }
#pragma unroll
                for (int i = 0; i < RW_TB / 8; ++i) {
                    const int t = w + 8 * i, o = t * 64 + l;
                    const float dec = __expf(-0.6065306597126334f * sigmoidf_(w0v + wl[i]));
                    const float a = sigmoidf_(a0v + al[i]);
                    const float kr = A_K2[o], r = A_WR[o];
                    float kk = kr * kkv; const float nrm = wave_sum(kk * kk); kk = kk * (1.0f / sqrtf(fmaxf(nrm, 1e-24f)));
                    const float k2 = kr * (1.f + (a - 1.f) * kav), bb = kk * a;
                    const float s1 = wave_sum(bb * r), s2 = wave_sum(k2 * r), s3 = wave_sum(r * k2 * rkv);
                    A_W[o] = dec; A_NKK[o] = -kk; A_B[o] = bb; A_K2[o] = k2; A_WR[o] = dec * r; A_G[o] = gg[i];
                    if (l == 0) { SC1[t] = s1; SC2[t] = s2; SC3[t] = s3; }
                }
            }
            __syncthreads();
            for (int t = 0; t < RW_TB; ++t) {
                const f32x4* pw = (const f32x4*)(A_W + t * 64 + 8 * sj); const f32x4* pn = (const f32x4*)(A_NKK + t * 64 + 8 * sj); const f32x4* pb = (const f32x4*)(A_B + t * 64 + 8 * sj);
                const f32x4* pk = (const f32x4*)(A_K2 + t * 64 + 8 * sj); const f32x4* pr = (const f32x4*)(A_WR + t * 64 + 8 * sj);
                const f32x4 w0_ = pw[0], w1_ = pw[1], n0 = pn[0], n1 = pn[1], b0 = pb[0], b1 = pb[1], k0 = pk[0], k1 = pk[1], r0 = pr[0], r1 = pr[1];
                const float vv = A_V[t * 64 + srow], s1 = SC1[t], s2 = SC2[t];
                float sa = (S[0] * n0.x + S[1] * n0.y) + (S[2] * n0.z + S[3] * n0.w) + (S[4] * n1.x + S[5] * n1.y) + (S[6] * n1.z + S[7] * n1.w);
                float p = (S[0] * r0.x + S[1] * r0.y) + (S[2] * r0.z + S[3] * r0.w) + (S[4] * r1.x + S[5] * r1.y) + (S[6] * r1.z + S[7] * r1.w);
                sa += __shfl_xor(sa, 1); p += __shfl_xor(p, 1); sa += __shfl_xor(sa, 2); p += __shfl_xor(p, 2); sa += __shfl_xor(sa, 4); p += __shfl_xor(p, 4);
                S[0] = S[0] * w0_.x + (sa * b0.x + vv * k0.x); S[1] = S[1] * w0_.y + (sa * b0.y + vv * k0.y); S[2] = S[2] * w0_.z + (sa * b0.z + vv * k0.z); S[3] = S[3] * w0_.w + (sa * b0.w + vv * k0.w);
                S[4] = S[4] * w1_.x + (sa * b1.x + vv * k1.x); S[5] = S[5] * w1_.y + (sa * b1.y + vv * k1.y); S[6] = S[6] * w1_.z + (sa * b1.z + vv * k1.z); S[7] = S[7] * w1_.w + (sa * b1.w + vv * k1.w);
                if (sj == 0) A_OUT[t * 64 + srow] = p + sa * s1 + vv * s2;
            }
            __syncthreads();
#pragma unroll
            for (int i = 0; i < RW_TB / 8; ++i) {
                const int t = w + 8 * i, o = t * 64 + l;
                const float x = A_OUT[o]; const float mean = wave_sum(x) * (1.f / 64.f); const float dx = x - mean; const float var = wave_sum(dx * dx) * (1.f / 64.f);
                float y = dx * (1.0f / sqrtf(var + 64e-5f)) * lnw + lnb;
                y = (y + SC3[t] * A_V[o]) * A_G[o];
                OLY[((size_t)b * SEQ + t0 + t) * OC + 2048 + hk] = (bf16)f2bf(y);
            }
        }
    }
}

constexpr int S5_TB = 16;
struct S5P { const float *lam_re, *lam_im, *log_dt, *b_re, *b_im, *c_re, *c_im, *d; };
__device__ __forceinline__ float gelu_tanh(float y) { return 0.5f * y * (1.f + tanhf(0.7978845608028654f * (y + 0.044715f * y * y * y))); }
__device__ __forceinline__ void s5_phase(const Ctx& c, const bf16* __restrict__ U, const S5P P, bf16* Z) {
    constexpr int PERW = 256 + 2 * S5_TB * 65 + 2 * 64 * 16;
    float* UU = (float*)c.lds + c.wave * PERW;
    float* XSr = UU + 256; float* XSi = XSr + S5_TB * 65;
    float* CTr = XSi + S5_TB * 65; float* CTi = CTr + 64 * 16;
    const int l = c.lane;
    for (int item = c.bid; item < NB * 16; item += c.nb) {
        const int b = item >> 4, g = (item & 15) * 8 + c.wave;
        __syncthreads();
        float lbr, lbi, Br[16], Bi[16];
        {
            const float lr = fminf(P.lam_re[g * 64 + l], -1e-4f), li = P.lam_im[g * 64 + l], dt = expf(P.log_dt[g]);
            const float e = expf(lr * dt); lbr = e * cosf(li * dt); lbi = e * sinf(li * dt);
            const float nr = lbr - 1.f, ni = lbi, den = 1.f / (lr * lr + li * li);
            const float cr = (nr * lr + ni * li) * den, ci = (ni * lr - nr * li) * den;
#pragma unroll
            for (int i = 0; i < 16; ++i) { const float br = P.b_re[(size_t)(g * 64 + l) * 16 + i], bi = P.b_im[(size_t)(g * 64 + l) * 16 + i]; Br[i] = cr * br - ci * bi; Bi[i] = cr * bi + ci * br; }
#pragma unroll
            for (int o = 0; o < 16; ++o) { CTr[l * 16 + o] = P.c_re[(size_t)(g * 16 + o) * 64 + l]; CTi[l * 16 + o] = P.c_im[(size_t)(g * 16 + o) * 64 + l]; }
        }
        float dsk[4];
#pragma unroll
        for (int e = 0; e < 4; ++e) dsk[e] = P.d[g * 16 + (l >> 4) * 4 + e];
        float xr = 0.f, xi = 0.f;
        for (int t0 = 0; t0 < SEQ; t0 += S5_TB) {
            __syncthreads();
            { const int row = l >> 2, q = l & 3; const u32x2 w2 = *(const u32x2*)(U + ((size_t)b * SEQ + t0 + row) * D + g * 16 + 4 * q);
              float* d = UU + row * 16 + 4 * q; d[0] = bf2f(w2.x & 0xffffu); d[1] = bf2f(w2.x >> 16); d[2] = bf2f(w2.y & 0xffffu); d[3] = bf2f(w2.y >> 16); }
            __syncthreads();
            for (int t = 0; t < S5_TB; ++t) {
                const f32x4* up = (const f32x4*)(UU + t * 16); const f32x4 u0 = up[0], u1 = up[1], u2 = up[2], u3 = up[3];
                const float u[16] = {u0.x, u0.y, u0.z, u0.w, u1.x, u1.y, u1.z, u1.w, u2.x, u2.y, u2.z, u2.w, u3.x, u3.y, u3.z, u3.w};
                float bur = 0.f, bui = 0.f;
#pragma unroll
                for (int i = 0; i < 16; ++i) { bur += Br[i] * u[i]; bui += Bi[i] * u[i]; }
                const float nxr = lbr * xr - lbi * xi + bur, nxi = lbr * xi + lbi * xr + bui; xr = nxr; xi = nxi;
                XSr[t * 65 + l] = xr; XSi[t * 65 + l] = xi;
            }
            __syncthreads();
            {   const int t = l & 15, oq = l >> 4; float y[4] = {0.f, 0.f, 0.f, 0.f};
                for (int p = 0; p < 64; ++p) { const float a = XSr[t * 65 + p], bb = XSi[t * 65 + p]; const f32x4 cr = *(const f32x4*)(CTr + p * 16 + oq * 4), ci = *(const f32x4*)(CTi + p * 16 + oq * 4);
                    y[0] += a * cr.x - bb * ci.x; y[1] += a * cr.y - bb * ci.y; y[2] += a * cr.z - bb * ci.z; y[3] += a * cr.w - bb * ci.w; }
                float z[4];
#pragma unroll
                for (int e = 0; e < 4; ++e) z[e] = gelu_tanh(y[e] + dsk[e] * UU[t * 16 + oq * 4 + e]);
                u32x2 o; o.x = pk2(z[0], z[1]); o.y = pk2(z[2], z[3]);
                *(u32x2*)(Z + ((size_t)b * SEQ + t0 + t) * D + g * 16 + oq * 4) = o; }
        }
    }
}
template <int CTRL> __device__ __forceinline__ float dpp_mov(float v) { return __builtin_bit_cast(float, __builtin_amdgcn_update_dpp(0, __builtin_bit_cast(int, v), CTRL, 0xf, 0xf, true)); }
__device__ __forceinline__ float sum8(float v) { v += dpp_mov<0xB1>(v); v += dpp_mov<0x4E>(v); v += dpp_mov<0x141>(v); return v; }
__device__ __forceinline__ float wave_sum_fast(float v) { v += dpp_mov<0xB1>(v); v += dpp_mov<0x4E>(v); v += dpp_mov<0x141>(v); v += dpp_mov<0x140>(v); v += __shfl_xor(v, 16); v += __shfl_xor(v, 32); return v; }
__device__ __forceinline__ float fast_tanh(float x) { const float e = __expf(2.f * x); return 1.f - 2.f / (e + 1.f); }
__device__ __forceinline__ void rwkv_lora_prep(const Ctx& c, const bf16* __restrict__ H, const float* __restrict__ mu, bf16* LX) {
    const int l = c.lane;
    for (int m = c.gw; m < M; m += c.ngw) {
        if (l < 36) {
            const int col = 3952 + 8 * l; const int t = m % SEQ;
            float x[8], p[8]; unpack8(*(const u32x4*)(H + (size_t)m * HC + col), x);
            if (t > 0) unpack8(*(const u32x4*)(H + (size_t)(m - 1) * HC + col), p); else {
#pragma unroll
                for (int j = 0; j < 8; ++j) p[j] = 0.f; }
            const f32x4 m0 = *(const f32x4*)(mu + 3072 + 8 * l), m1 = *(const f32x4*)(mu + 3072 + 8 * l + 4);
            const float mv[8] = {m0.x, m0.y, m0.z, m0.w, m1.x, m1.y, m1.z, m1.w};
            float hm[8];
#pragma unroll
            for (int j = 0; j < 8; ++j) { float v = x[j] + (p[j] - x[j]) * mv[j]; if (l < 8) v = fast_tanh(v); else if (l >= 16) v = sigmoidf_(v); hm[j] = v; }
            u32x4 o; o.x = pg8::cvt_pk_bf16(hm[0], hm[1]); o.y = pg8::cvt_pk_bf16(hm[2], hm[3]); o.z = pg8::cvt_pk_bf16(hm[4], hm[5]); o.w = pg8::cvt_pk_bf16(hm[6], hm[7]);
            *(u32x4*)(LX + (size_t)m * 288 + 8 * l) = o;
        }
    }
}
constexpr int RW2_RAWP = 384;
constexpr int RW2_TWP = 144, RW2_SGP = 336;
__device__ __forceinline__ void rwkv_phase2(const Ctx& c, const bf16* __restrict__ H, const bf16* __restrict__ LX, const RwkvP P, bf16* OUT, int ldo, int coloff, int wb = NB) {
    unsigned char* RAW = c.lds;
    float* A_WR = (float*)(c.lds + 12800);
    float* A_K2 = A_WR + 2048; float* A_V = A_K2 + 2048; float* A_W = A_V + 2048; float* A_NKK = A_W + 2048; float* A_B = A_NKK + 2048; float* A_G = A_B + 2048; float* A_OUT = A_G + 2048;
    float* LO_W = A_OUT + 2048; float* LO_A = LO_W + 2048; float* PR3 = LO_A + 2048;
    unsigned char* L_TW = (unsigned char*)(PR3 + 2048); unsigned char* L_AL = L_TW + 32 * RW2_TWP; unsigned char* L_SG = L_AL + 32 * RW2_TWP;
    float* MU = (float*)(L_SG + 32 * RW2_SGP); float* SC3 = MU + 480 + 64;
    unsigned char* G2T = (unsigned char*)(SC3 + 32);
    float* SCP = (float*)(G2T + 64 * RW2_SGP);
    float* GN = SCP + 128; float* CST = GN + 64;
    float* PR0 = (float*)L_TW; float* PR1 = PR0 + 2048; float* PR2 = A_OUT;
    const int l = c.lane, w = c.wave, n16 = l & 15, g = l >> 4;
#pragma unroll 1
    for (int item = c.bid; item < NB * 16; item += c.nb) {
        const int b = item >> 4, h = item & 15, hk = h * 64 + l;
        __syncthreads();
        if (w < 7) { const float* src = w == 0 ? P.w0 : w == 1 ? P.a0 : w == 2 ? P.k_k : w == 3 ? P.k_a : w == 4 ? P.r_k : w == 5 ? P.ln_w : P.ln_b; CST[w * 64 + l] = src[hk]; }
        for (int i = c.tid; i < 160 * 64; i += NTHR) { const int j = i >> 6, kcl = i & 63; *(unsigned short*)(G2T + kcl * RW2_SGP + j * 2) = (unsigned short)f2bf(P.g2[(size_t)j * 1024 + h * 64 + kcl]); }
        for (int i = c.tid; i < 192; i += NTHR) { const int mi = i < 64 ? h * 64 + i : i < 128 ? 1024 + h * 64 + (i - 64) : 2048 + h * 64 + (i - 128); MU[i] = P.mu[mi]; }
        const int tt = w >> 2, nt = w & 3;
        bf16x8 W2B[2], A2B[2];
        { const int kc = h * 64 + 16 * nt + n16;
          auto ldfrag = [&](const float* Wp, int kk) -> bf16x8 { float f[8]; int gq = g, kq = kc; asm volatile("" : "+v"(gq), "+v"(kq));
              const float* wp = Wp + (size_t)(32 * kk + 8 * gq) * 1024 + kq;
#pragma unroll
              for (int q = 0; q < 8; ++q) f[q] = wp[q * 1024];
              u32x4 u; u.x = pk2(f[0], f[1]); u.y = pk2(f[2], f[3]); u.z = pk2(f[4], f[5]); u.w = pk2(f[6], f[7]);
              asm volatile("" : "+v"(u));
              return __builtin_bit_cast(bf16x8, u); };
          W2B[0] = ldfrag(P.w2, 0); W2B[1] = ldfrag(P.w2, 1); A2B[0] = ldfrag(P.a2, 0); A2B[1] = ldfrag(P.a2, 1);
        }
        f32x2 S[4];
#pragma unroll
        for (int i = 0; i < 4; ++i) S[i] = (f32x2){0.f, 0.f};
        const int srow = w * 8 + (l >> 3), sj = l & 7;
        u32x4 raw[4];
#define RW2_LOAD(T0) do { _Pragma("unroll") for (int k = 0; k < 4; ++k) { const int q_ = c.tid + 512 * k; raw[k] = (u32x4){0u, 0u, 0u, 0u}; \
            if (q_ < 792) { const int cq_ = q_ % 24, tg = (T0) - 1 + q_ / 24; const int rc_ = (cq_ < 8 ? 880 : cq_ < 16 ? 1904 - 64 : 2928 - 128) + h * 64 + cq_ * 8; \
                if (tg >= 0) raw[k] = *(const u32x4*)(H + ((size_t)b * SEQ + tg) * HC + rc_); } \
            else if (q_ < 1944) { const int e_ = q_ - 792; raw[k] = *(const u32x4*)(LX + ((size_t)b * SEQ + (T0) + e_ / 36) * 288 + (e_ % 36) * 8); } } } while (0)
        RW2_LOAD(0);
#pragma unroll 1
        for (int t0 = 0; t0 < SEQ; t0 += 32) {
            __syncthreads();
#pragma unroll
            for (int k = 0; k < 4; ++k) { const int q_ = c.tid + 512 * k;
                if (q_ < 792) *(u32x4*)(RAW + (q_ / 24) * RW2_RAWP + (q_ % 24) * 16) = raw[k];
                else if (q_ < 1944) { const int e_ = q_ - 792, t_ = e_ / 36, p_ = e_ % 36;
                    unsigned char* d_ = p_ < 8 ? L_TW + t_ * RW2_TWP + p_ * 16 : p_ < 16 ? L_AL + t_ * RW2_TWP + (p_ - 8) * 16 : L_SG + t_ * RW2_SGP + (p_ - 16) * 16; *(u32x4*)d_ = raw[k]; } }
            if (t0 + 32 < SEQ) RW2_LOAD(t0 + 32);
            __syncthreads();
            if (c.tid < 384) {
                const int cpi = c.tid % 96, qb = c.tid / 96, cp = cpi * 2, tb = qb * 8;
                const float mu0 = MU[cp], mu1 = MU[cp + 1];
                unsigned xb = *(const unsigned*)(RAW + tb * RW2_RAWP + cp * 2);
                float p0 = bf2f(xb & 0xffffu), p1 = bf2f(xb >> 16);
                float* dst = (cp < 64 ? A_WR + cp : cp < 128 ? A_K2 + (cp - 64) : A_V + (cp - 128)) + tb * 64;
#pragma unroll
                for (int t = 0; t < 8; ++t) { const unsigned xa = *(const unsigned*)(RAW + (tb + t + 1) * RW2_RAWP + cp * 2); const float x0 = bf2f(xa & 0xffffu), x1 = bf2f(xa >> 16);
                    *(f32x2*)(dst + t * 64) = (f32x2){x0 + (p0 - x0) * mu0, x1 + (p1 - x1) * mu1}; p0 = x0; p1 = x1; }
            }
            __syncthreads();
            {
                f32x4 aw = (f32x4){0.f, 0.f, 0.f, 0.f}, aa = aw, ag = aw;
#pragma unroll
                for (int kk = 0; kk < 2; ++kk) { const bf16x8 At = *(const bf16x8*)(L_TW + (16 * tt + n16) * RW2_TWP + (32 * kk + 8 * g) * 2), Aa = *(const bf16x8*)(L_AL + (16 * tt + n16) * RW2_TWP + (32 * kk + 8 * g) * 2);
                    aw = __builtin_amdgcn_mfma_f32_16x16x32_bf16(At, W2B[kk], aw, 0, 0, 0); aa = __builtin_amdgcn_mfma_f32_16x16x32_bf16(Aa, A2B[kk], aa, 0, 0, 0); }
#pragma unroll
                for (int kk = 0; kk < 5; ++kk) { const bf16x8 Ag = *(const bf16x8*)(L_SG + (16 * tt + n16) * RW2_SGP + (32 * kk + 8 * g) * 2); const bf16x8 Gb = *(const bf16x8*)(G2T + (16 * nt + n16) * RW2_SGP + (32 * kk + 8 * g) * 2); ag = __builtin_amdgcn_mfma_f32_16x16x32_bf16(Ag, Gb, ag, 0, 0, 0); }
#pragma unroll
                for (int r = 0; r < 4; ++r) { const int o = (16 * tt + 4 * g + r) * 64 + 16 * nt + n16; LO_W[o] = aw[r]; LO_A[o] = aa[r]; A_G[o] = ag[r]; }
            }
            __syncthreads();
#pragma unroll 2
            for (int i = 0; i < 4; ++i) {
                const int t = w + 8 * i, o = t * 64 + l;
                const float w0v = CST[l], a0v = CST[64 + l], kkv = CST[128 + l], kav = CST[192 + l], rkv = CST[256 + l];
                const float dec = __expf(-0.6065306597126334f * sigmoidf_(w0v + LO_W[o]));
                const float a = sigmoidf_(a0v + LO_A[o]);
                const float kr = A_K2[o], r = A_WR[o];
                const float kk0 = kr * kkv, k2 = kr * (1.f + (a - 1.f) * kav), bb0 = kk0 * a, k2r = k2 * r;
                A_W[o] = dec; A_NKK[o] = -kk0; A_B[o] = bb0; A_K2[o] = k2; A_WR[o] = dec * r;
                PR0[o] = kk0 * kk0; PR1[o] = bb0 * r; PR2[o] = k2r; PR3[o] = k2r * rkv;
            }
            __syncthreads();
            {
                const int t = c.tid >> 4, q = (c.tid >> 2) & 3, qu = c.tid & 3;
                const float* src = (q == 0 ? PR0 : q == 1 ? PR1 : q == 2 ? PR2 : PR3) + t * 64 + 16 * qu;
                const f32x4 v0 = *(const f32x4*)src, v1 = *(const f32x4*)(src + 4), v2 = *(const f32x4*)(src + 8), v3 = *(const f32x4*)(src + 12);
                float sm = ((v0.x + v0.y) + (v0.z + v0.w)) + ((v1.x + v1.y) + (v1.z + v1.w)) + ((v2.x + v2.y) + (v2.z + v2.w)) + ((v3.x + v3.y) + (v3.z + v3.w));
                sm += dpp_mov<0xB1>(sm); sm += dpp_mov<0x4E>(sm);
                if (qu == 0) SCP[t * 4 + q] = (q == 0) ? 1.0f / fmaxf(sm, 1e-24f) : sm;
            }
            __syncthreads();
            {
                f32x4 n0, n1, r0, r1, w0_, w1_, b0, b1, k0, k1, sp; float vv;
                const unsigned char* pk_ = (const unsigned char*)A_WR + 32 * sj;
                const unsigned char* pv_ = (const unsigned char*)A_WR + 4 * srow;
                const unsigned char* ps_ = (const unsigned char*)SCP;
                constexpr int O_WR = 0, O_K2 = 8192, O_V = 16384, O_W = 24576, O_NKK = 32768, O_B = 40960, O_OUT = 57344;
#define RW2_LD_DOT(T) do { n0 = *(const f32x4*)(pk_ + O_NKK + (T) * 256); n1 = *(const f32x4*)(pk_ + O_NKK + (T) * 256 + 16); r0 = *(const f32x4*)(pk_ + O_WR + (T) * 256); r1 = *(const f32x4*)(pk_ + O_WR + (T) * 256 + 16); } while (0)
#define RW2_LD_UPD(T) do { w0_ = *(const f32x4*)(pk_ + O_W + (T) * 256); w1_ = *(const f32x4*)(pk_ + O_W + (T) * 256 + 16); b0 = *(const f32x4*)(pk_ + O_B + (T) * 256); b1 = *(const f32x4*)(pk_ + O_B + (T) * 256 + 16); \
                    k0 = *(const f32x4*)(pk_ + O_K2 + (T) * 256); k1 = *(const f32x4*)(pk_ + O_K2 + (T) * 256 + 16); vv = *(const float*)(pv_ + O_V + (T) * 256); sp = *(const f32x4*)(ps_ + (T) * 16); } while (0)
#define RW2_STEP(T) do { \
                    f32x2 sa2 = S[0] * (f32x2){n0.x, n0.y}; sa2 = S[1] * (f32x2){n0.z, n0.w} + sa2; sa2 = S[2] * (f32x2){n1.x, n1.y} + sa2; sa2 = S[3] * (f32x2){n1.z, n1.w} + sa2; \
                    f32x2 p2 = S[0] * (f32x2){r0.x, r0.y}; p2 = S[1] * (f32x2){r0.z, r0.w} + p2; p2 = S[2] * (f32x2){r1.x, r1.y} + p2; p2 = S[3] * (f32x2){r1.z, r1.w} + p2; \
                    __builtin_amdgcn_sched_barrier(0); RW2_LD_DOT((T) + 1); __builtin_amdgcn_sched_barrier(0); \
                    const float sa = sum8(sa2.x + sa2.y) * sp.x, p = sum8(p2.x + p2.y); \
                    const f32x2 sav = (f32x2){sa, sa}, vvv = (f32x2){vv, vv}; \
                    S[0] = S[0] * (f32x2){w0_.x, w0_.y} + (sav * (f32x2){b0.x, b0.y} + vvv * (f32x2){k0.x, k0.y}); \
                    S[1] = S[1] * (f32x2){w0_.z, w0_.w} + (sav * (f32x2){b0.z, b0.w} + vvv * (f32x2){k0.z, k0.w}); \
                    S[2] = S[2] * (f32x2){w1_.x, w1_.y} + (sav * (f32x2){b1.x, b1.y} + vvv * (f32x2){k1.x, k1.y}); \
                    S[3] = S[3] * (f32x2){w1_.z, w1_.w} + (sav * (f32x2){b1.z, b1.w} + vvv * (f32x2){k1.z, k1.w}); \
                    const float ov = p + sa * sp.y + vv * sp.z; \
                    __builtin_amdgcn_sched_barrier(0); RW2_LD_UPD((T) + 1); *(float*)(const_cast<unsigned char*>(pv_) + O_OUT + (T) * 256) = ov;        __builtin_amdgcn_sched_barrier(0); } while (0)
                RW2_LD_DOT(0); RW2_LD_UPD(0);
#pragma unroll 1
                for (int t4 = 0; t4 < 8; ++t4) {
                    RW2_STEP(0); RW2_STEP(1); RW2_STEP(2); RW2_STEP(3);
                    pk_ += 1024; pv_ += 1024; ps_ += 64;
                }
#undef RW2_LD_DOT
#undef RW2_LD_UPD
#undef RW2_STEP
            }
            __syncthreads();
            {
                const int t = c.tid >> 3, q = (c.tid >> 2) & 1, qu = c.tid & 3;
                if (c.tid < 256) {
                    const float* src = A_OUT + t * 64 + 16 * qu; float sm = 0.f;
#pragma unroll
                    for (int e = 0; e < 4; ++e) { const f32x4 v = *(const f32x4*)(src + 4 * e); sm += q ? ((v.x * v.x + v.y * v.y) + (v.z * v.z + v.w * v.w)) : ((v.x + v.y) + (v.z + v.w)); }
                    sm += dpp_mov<0xB1>(sm); sm += dpp_mov<0x4E>(sm);
                    const float other = dpp_mov<0x141>(sm);
                    if ((c.tid & 7) == 0) { const float mean = sm * (1.f / 64.f), var = fmaxf(other * (1.f / 64.f) - mean * mean, 0.f); GN[t * 2] = mean; GN[t * 2 + 1] = 1.0f / sqrtf(var + 64e-5f); }
                }
            }
            __syncthreads();
#pragma unroll
            for (int i = 0; i < 4; ++i) {
                const int t = w + 8 * i, o = t * 64 + l;
                float y = (A_OUT[o] - GN[t * 2]) * GN[t * 2 + 1] * CST[320 + l] + CST[384 + l];
                y = (y + SCP[t * 4 + 3] * A_V[o]) * A_G[o];
                if (b < wb) OUT[((size_t)b * SEQ + t0 + t) * ldo + coloff + hk] = (bf16)f2bf(y);
            }
        }
#undef RW2_LOAD
    }
}
constexpr int S5B_BUP = 132 * 4, S5B_XP = 272;
constexpr int S5B_WAVE = 16 * S5B_BUP + 16 * S5B_XP;
__device__ __forceinline__ void wave_lds_sync() { __builtin_amdgcn_fence(__ATOMIC_RELEASE, "wavefront"); __builtin_amdgcn_wave_barrier(); __builtin_amdgcn_fence(__ATOMIC_ACQUIRE, "wavefront"); }
__device__ __forceinline__ float gelu_fast(float y) { const float u2 = 1.5957691216057308f * (y + 0.044715f * y * y * y); return y * __builtin_amdgcn_rcpf(1.f + __expf(-u2)); }
__device__ __forceinline__ void s5_phase2(const Ctx& c, const bf16* __restrict__ U, const S5P P, bf16* Z) {
    if (c.wave >= 4) return;
    float* BU = (float*)(c.lds + c.wave * S5B_WAVE); unsigned char* XB = c.lds + c.wave * S5B_WAVE + 16 * S5B_BUP;
    const int l = c.lane, n16 = l & 15, g = l >> 4;
#pragma unroll 1
    for (int item = c.bid; item < 256; item += c.nb) {
        const int b = item >> 5, grp = (item & 31) * 4 + c.wave;
        float lbr, lbi;
        { const float lr = fminf(P.lam_re[grp * 64 + l], -1e-4f), li = P.lam_im[grp * 64 + l], dt = expf(P.log_dt[grp]);
          const float e = expf(lr * dt); lbr = e * cosf(li * dt); lbi = e * sinf(li * dt);
          const float nr = lbr - 1.f, ni = lbi, den = 1.f / (lr * lr + li * li);
          BU[l] = (nr * lr + ni * li) * den; BU[64 + l] = (ni * lr - nr * li) * den; }
        wave_lds_sync();
        bf16x4 Bre[4], Bim[4];
#pragma unroll
        for (int nt = 0; nt < 4; ++nt) { const int p = 16 * nt + n16; const float cr = BU[p], ci = BU[64 + p];
            const f32x4 br = *(const f32x4*)(P.b_re + (size_t)(grp * 64 + p) * 16 + 4 * g), bi = *(const f32x4*)(P.b_im + (size_t)(grp * 64 + p) * 16 + 4 * g);
            u32x2 wr, wi; wr.x = pk2(cr * br.x - ci * bi.x, cr * br.y - ci * bi.y); wr.y = pk2(cr * br.z - ci * bi.z, cr * br.w - ci * bi.w);
            wi.x = pk2(cr * bi.x + ci * br.x, cr * bi.y + ci * br.y); wi.y = pk2(cr * bi.z + ci * br.z, cr * bi.w + ci * br.w);
            Bre[nt] = __builtin_bit_cast(bf16x4, wr); Bim[nt] = __builtin_bit_cast(bf16x4, wi); }
        wave_lds_sync();
        bf16x8 Cf[4];
#pragma unroll
        for (int kk = 0; kk < 4; ++kk) { const int p0 = 16 * kk + 4 * g;
            const f32x4 vr = *(const f32x4*)(P.c_re + (size_t)(grp * 16 + n16) * 64 + p0), vi = *(const f32x4*)(P.c_im + (size_t)(grp * 16 + n16) * 64 + p0);
            u32x4 w; w.x = pk2(vr.x, -vi.x); w.y = pk2(vr.y, -vi.y); w.z = pk2(vr.z, -vi.z); w.w = pk2(vr.w, -vi.w); Cf[kk] = __builtin_bit_cast(bf16x8, w); }
        bf16x4 Df; { const float dsk = P.d[grp * 16 + n16]; const int kq = n16 - 4 * g; u32x2 w; w.x = pk2(kq == 0 ? dsk : 0.f, kq == 1 ? dsk : 0.f); w.y = pk2(kq == 2 ? dsk : 0.f, kq == 3 ? dsk : 0.f); Df = __builtin_bit_cast(bf16x4, w); }
        f32x2 xs = (f32x2){0.f, 0.f};
        const bf16* ub = U + (size_t)b * SEQ * D + grp * 16;
        u32x2 ua[4];
#define S5B_LOAD(k, T0) do { ua[k] = *(const u32x2*)(ub + (size_t)((T0) + n16) * D + 4 * g); } while (0)
#pragma unroll
        for (int k = 0; k < 4; ++k) S5B_LOAD(k, 16 * k);
#pragma unroll 1
        for (int t0 = 0; t0 < SEQ; t0 += 64) {
#pragma unroll
            for (int k = 0; k < 4; ++k) {
                const int tb = t0 + 16 * k;
                const bf16x4 A = __builtin_bit_cast(bf16x4, ua[k]);
                { const int tn = (tb + 64 < SEQ) ? tb + 64 : tb; S5B_LOAD(k, tn); }
                const f32x4 yd = __builtin_amdgcn_mfma_f32_16x16x16bf16_1k(A, Df, (f32x4){0.f, 0.f, 0.f, 0.f}, 0, 0, 0);
#pragma unroll
                for (int nt = 0; nt < 4; ++nt) {
                    const f32x4 ar = __builtin_amdgcn_mfma_f32_16x16x16bf16_1k(A, Bre[nt], (f32x4){0.f, 0.f, 0.f, 0.f}, 0, 0, 0);
                    const f32x4 ai = __builtin_amdgcn_mfma_f32_16x16x16bf16_1k(A, Bim[nt], (f32x4){0.f, 0.f, 0.f, 0.f}, 0, 0, 0);
#pragma unroll
                    for (int r = 0; r < 4; ++r) *(f32x2*)(BU + (4 * g + r) * 132 + 2 * (16 * nt + n16)) = (f32x2){ar[r], ai[r]};
                }
                wave_lds_sync();
#pragma unroll 4
                for (int t = 0; t < 16; ++t) {
                    const f32x2 bu = *(const f32x2*)(BU + t * 132 + 2 * l);
                    const f32x2 tq = (f32x2){lbr, lbr} * xs + bu;
                    xs = (f32x2){-lbi, lbi} * (f32x2){xs.y, xs.x} + tq;
                    *(unsigned*)(XB + t * S5B_XP + l * 4) = pg8::cvt_pk_bf16(xs.x, xs.y);
                }
                wave_lds_sync();
                f32x4 y = (f32x4){0.f, 0.f, 0.f, 0.f};
#pragma unroll
                for (int kk = 0; kk < 4; ++kk) { const bf16x8 Ax = *(const bf16x8*)(XB + n16 * S5B_XP + (32 * kk + 8 * g) * 2); y = __builtin_amdgcn_mfma_f32_16x16x32_bf16(Ax, Cf[kk], y, 0, 0, 0); }
#pragma unroll
                for (int r = 0; r < 4; ++r) Z[((size_t)b * SEQ + tb + 4 * g + r) * D + grp * 16 + n16] = (bf16)f2bf(gelu_fast(y[r] + yd[r]));
                wave_lds_sync();
            }
        }
#undef S5B_LOAD
    }
}
struct Args { const void* in[45]; float* out; unsigned char* ws; int ph_lo, ph_hi; };
static_assert(sizeof(Args) == 45 * 8 + 8 + 8 + 8, "Args has no padding");
constexpr int PH_EVEN = 9, PH_ODD = 4, PH_COMMON = 13;
constexpr int NPHASES = 2 * (1 + PH_EVEN + PH_COMMON) + 2 * (1 + PH_ODD + PH_COMMON) + 1;

__global__ void __launch_bounds__(NTHR, 2) mega(Args args) {
    extern __shared__ __attribute__((aligned(16))) unsigned char lds[];
    volatile LAS unsigned* MISC = (volatile LAS unsigned*)((LAS unsigned char*)lds + MISC_OFF);
    if (threadIdx.x < 64) MISC[threadIdx.x] = 0u;
    __syncthreads();
    unsigned char* ws = args.ws;
    XcdBarrier bar = xcd_barrier_post((unsigned*)(ws + WS_CTL) + 4096, MISC + 8, gridDim.x);
    const int half = (int)gridDim.x >> 1;
    XcdBarrier bar2 = bar; if ((int)blockIdx.x >= half) bar2 = xcd_barrier_post((unsigned*)(ws + WS_CTL) + 8192, MISC + 10, gridDim.x - half);
    const int lo = args.ph_lo, hi = args.ph_hi;
    int pid = 0;
#define PH_BEGIN if (pid >= lo && pid < hi) { Ctx c; { int t_ = threadIdx.x, b_ = blockIdx.x; asm volatile("" : "+v"(t_)); asm volatile("" : "+s"(b_)); c.lds = lds; c.tid = t_; c.lane = t_ & 63; c.wave = __builtin_amdgcn_readfirstlane(t_ >> 6); c.bid = b_; { int n_ = gridDim.x; asm volatile("" : "+s"(n_)); c.nb = n_; } c.gw = c.bid * NWAVES + c.wave; c.ngw = c.nb * NWAVES; }
#define PH_END } if (pid >= lo && pid + 1 < hi) { xcd_barrier(bar); if (DBL & 2048) xcd_barrier(bar); } ++pid;
#define IN_F(i) (*(const float* const __attribute__((address_space(4)))*)(KARGS() + 8 * (i)))

    typedef const unsigned char __attribute__((address_space(4)))* kptr_t;
#define KARGS() ({ kptr_t p_ = (kptr_t)__builtin_amdgcn_kernarg_segment_ptr(); asm volatile("" : "+s"(p_)); p_; })
#define WSP(off) ((*(unsigned char* const __attribute__((address_space(4)))*)(KARGS() + 368)) + (off))
#define X ((float*)(*(float* const __attribute__((address_space(4)))*)(KARGS() + 360)))
#define ROPEA ((float*)WSP(WS_ROPEA))
#define ROPEI ((float*)WSP(WS_ROPEI))
#define KVBIG ((bf16*)WSP(WS_KVBIG))
#define WKV ((bf16*)WSP(WS_WKV))
#define W_IN ((bf16*)WSP(WS_WMIX + WMIX_IN))
#define WQ ((bf16*)WSP(WS_WMIX + WMIX_Q))
#define WOUT ((bf16*)WSP(WS_WMIX + WMIX_OUT))
#define WO_IN ((bf16*)WSP(WS_WMIX + WMIX_O_IN))
#define WO_GLU ((bf16*)WSP(WS_WMIX + WMIX_O_GLU))
#define WO_OUT ((bf16*)WSP(WS_WMIX + WMIX_O_OUT))
#define WXQ ((bf16*)WSP(WS_WXQ))
#define WXO ((bf16*)WSP(WS_WXO))
#define WUP ((bf16*)WSP(WS_WUP))
#define WDN ((bf16*)WSP(WS_WDN))
#define CQN ((bf16*)WSP(WS_CQN))
#define KF ((bf16*)WSP(WS_KF))
#define KIDX ((bf16*)WSP(WS_KIDX))
#define WIDX ((float*)WSP(WS_WIDX))
#define SEL ((bf16*)WSP(WS_SEL))
#define Hb ((bf16*)WSP(WS_R1))
#define SC ((float*)WSP(WS_R1))
#define HID ((bf16*)WSP(WS_R1))
#define Ub ((bf16*)WSP(WS_R1))
#define YC ((bf16*)WSP(WS_R1 + (size_t)M * D * 2))
#define XN ((bf16*)WSP(WS_R2))
#define QALL ((bf16*)X)
#define OLY ((bf16*)WSP(WS_R3))
#define Zb ((bf16*)WSP(WS_R3))
#define XQ ((bf16*)WSP(WS_R3))
#define XO ((bf16*)WSP(WS_R3 + (size_t)M * 512 * 2))
#define MEMN ((bf16*)WSP(WS_R3))
    LAS unsigned char* glds = (LAS unsigned char*)lds;

#define RS_A ((unsigned long long*)WSP(WS_CTL + 131072))
#define RS_B ((unsigned long long*)WSP(WS_CTL + 393216))
#define RS_C ((unsigned long long*)WSP(WS_CTL + 655360))
    for (int layer = 0; layer < DEPTH; ++layer) {
        const int li = layer >> 1;
        PH_BEGIN
            if ((layer & 1) == 0) {
                conv_mat(c, IN_F(13) + (size_t)li * 2048 * EVEN_COLS, 2048, EVEN_COLS, EVEN_COLS, HC, W_IN, 2048, 0, 0, IN_F(3) + layer * D);
                build_wql(c, IN_F(18) + (size_t)li * 512 * 1024, IN_F(19) + (size_t)li * 256 * 768, WQ);
                for (int h = 0; h < 8; ++h) conv_mat(c, IN_F(18) + (size_t)li * 512 * 1024 + h * 128, 512, 1024, 32, 32, WQ, 512, 2048 + h * 32, 0);
                conv_mat(c, IN_F(21) + (size_t)li * 512 * 1024, 512, 1024, 1024, 1024, WQ, 512, 2304, 0);
                build_wout(c, IN_F(20) + (size_t)li * 256 * 1024, IN_F(14) + (size_t)li * 2048 * 2048, WOUT);
                conv_mat(c, IN_F(14) + (size_t)li * 2048 * 2048 + (size_t)1024 * 2048, 1024, 2048, 2048, 2048, WOUT, OC, 0, 2048);
            } else {
                conv_mat(c, IN_F(33) + (size_t)li * 2048 * 2048, 2048, 2048, 2048, 2048, WO_IN, 2048, 0, 0, IN_F(3) + layer * D);
                conv_mat(c, IN_F(43) + (size_t)li * 2048 * 2048, 2048, 2048, 2048, 2048, WO_GLU, 2048, 0, 0);
                conv_mat(c, IN_F(34) + (size_t)li * 2048 * 2048, 2048, 2048, 2048, 2048, WO_OUT, 2048, 0, 0);
            }
            conv_mat(c, IN_F(8) + (size_t)layer * 2048 * 512, 2048, 512, 512, 512, WXQ, 2048, 0, 0, IN_F(4) + layer * D);
            conv_mat(c, IN_F(10) + (size_t)layer * 512 * 2048, 512, 2048, 2048, 2048, WXO, 512, 0, 0);
            { unsigned long long* ra = RS_A; unsigned long long* rb = RS_B; for (int i = c.bid * NTHR + c.tid; i < M; i += c.nb * NTHR) { ra[i] = 0ull; rb[i] = 0ull; } }
            if (layer == 0) {
                for (int l2 = 0; l2 < 4; ++l2) {
                    conv_mat(c, IN_F(9) + (size_t)l2 * 2048 * 1024, 2048, 1024, 1024, 1024, WKV, 2048, l2 * 1024, 0);
                    norm_rows_bf16(c, IN_F(1), IN_F(5) + l2 * D, MEMN + (size_t)l2 * MEMR * D, MEMR);
                }
                rope_tables(c, (const int*)IN_F(2), ROPEA, ROPEI);
                cast_rows_ss(c, IN_F(0), XN, RS_C, M);
            }
        PH_END
        if ((layer & 1) == 0) {
            PH_BEGIN
                { pg8::Gemm g{XN, W_IN, 2048, 2048, 2048}; pg8::StaticOrder S; S.init(128, HC / 256, c.nb, c.bid); pg8::EpiBf16<0> E{Hb, HC, RS_C};
                  pg8::gemm_phase<pg8::EpiBf16<0>, pg8::StaticOrder, true, true>(glds, g, S, E);
                  if (DBL & 1024) { __syncthreads(); pg8::gemm_phase<pg8::EpiBf16<0>, pg8::StaticOrder, true, true>(glds, g, S, E); } }
                if (layer == 0) { __syncthreads(); pg8::Gemm g{MEMN, WKV, 2048, 2048, 2048}; pg8::KvOrder S{c.nb, c.bid}; pg8::EpiBf16<0> E{KVBIG, 4096, nullptr};
                  pg8::gemm_phase<pg8::EpiBf16<0>, pg8::KvOrder, true, true>(glds, g, S, E); }
            PH_END
            PH_BEGIN
                rwkv_lora_prep(c, Hb, IN_F(22) + li * B_COLS, (bf16*)WSP(WS_END + 96 * MiB));
            PH_END
            PH_BEGIN
                if (c.bid < half) {
                    Ctx r = c; r.nb = half; r.ngw = half * NWAVES;
                    const RwkvP P{IN_F(22) + li * B_COLS, IN_F(23) + li * 1024, IN_F(24) + (size_t)li * 65536, IN_F(25) + li * 1024, IN_F(26) + (size_t)li * 65536, IN_F(27) + (size_t)li * 163840,
                                  IN_F(28) + li * 1024, IN_F(29) + li * 1024, IN_F(30) + li * 1024, IN_F(31) + li * 1024, IN_F(32) + li * 1024};
#if DIAG == 4
                    rwkv_phase(r, Hb, P, OLY);
                    rwkv_phase2(r, Hb, (const bf16*)WSP(WS_END + 96 * MiB), P, (bf16*)WSP(WS_END + 116 * MiB), 1024, 0, 1);
#else
                    rwkv_phase2(r, Hb, (const bf16*)WSP(WS_END + 96 * MiB), P, OLY, OC, 2048);
#endif
                    __syncthreads();
                    conv_mat(r, IN_F(12) + (size_t)layer * FFN * 2048, FFN, 2048, 2048, 2048, WDN, FFN, 0, 0);
                } else {
                    Ctx d = c; d.bid = c.bid - half; d.nb = c.nb - half; d.gw = d.bid * NWAVES + d.wave; d.ngw = d.nb * NWAVES;
                    dsa_prep(d, Hb, IN_F(15) + li * 512, IN_F(16) + li * 256, IN_F(17) + li * 64, ROPEA, ROPEI, CQN, KF, KIDX, WIDX);
                    xcd_barrier(bar2);
                    { pg8::Gemm g{CQN, WQ, 512, 512, 512}; pg8::StaticOrder S; S.init(128, QC / 256, d.nb, d.bid); pg8::EpiBf16<0> E{QALL, QC, nullptr};
                      pg8::gemm_phase<pg8::EpiBf16<0>, pg8::StaticOrder, true, true>(glds, g, S, E); }
                    xcd_barrier(bar2);
                    idx_topk_mfma(d, QALL, KIDX, WIDX, ROPEI, (float*)(d.bid < 32 ? WSP(WS_CQN + (size_t)d.bid * MiB) : WSP(WS_END + (size_t)(d.bid - 32) * MiB)), SEL, 256);
                    conv_mat(d, IN_F(11) + (size_t)layer * 2048 * FFN, 2048, FFN, FFN, FFN, WUP, 2048, 0, 0, IN_F(6) + layer * D);
                    xcd_barrier(bar2);
                    if (d.bid == 0 && c.tid == 0) __hip_atomic_store((unsigned*)WSP(WS_CTL) + 12288 + 64 * (2 + li), 1u, __ATOMIC_RELAXED, __HIP_MEMORY_SCOPE_AGENT);
                }
                if (c.bid < half) {
                    if (c.tid == 0) { unsigned* fl = (unsigned*)WSP(WS_CTL) + 12288 + 64 * (2 + li); unsigned sp = 0;
                        while (__hip_atomic_load(fl, __ATOMIC_RELAXED, __HIP_MEMORY_SCOPE_AGENT) == 0u) { __builtin_amdgcn_s_sleep(8); if (++sp > (1u << 22)) break; } }
                    __syncthreads();
                    __builtin_amdgcn_fence(__ATOMIC_ACQUIRE, "agent"); asm volatile("s_waitcnt vmcnt(0)" ::: "memory");
                }
                dsa_attn_queue(c, QALL, KF, SEL, ROPEA, OLY, (unsigned*)WSP(WS_CTL) + 12288 + 64 * li, MISC + 12);
            PH_END
#if DBL & 32
            PH_BEGIN
                if (c.bid < half) {
                    Ctx r = c; r.nb = half; r.ngw = half * NWAVES;
                    const RwkvP P{IN_F(22) + li * B_COLS, IN_F(23) + li * 1024, IN_F(24) + (size_t)li * 65536, IN_F(25) + li * 1024, IN_F(26) + (size_t)li * 65536, IN_F(27) + (size_t)li * 163840,
                                  IN_F(28) + li * 1024, IN_F(29) + li * 1024, IN_F(30) + li * 1024, IN_F(31) + li * 1024, IN_F(32) + li * 1024};
                    rwkv_phase2(r, Hb, (const bf16*)WSP(WS_END + 96 * MiB), P, OLY, OC, 2048);
                }
            PH_END
#endif
#if DBL & 8
            PH_BEGIN
                if (c.bid >= half) {
                    Ctx d = c; d.bid = c.bid - half; d.nb = c.nb - half; d.gw = d.bid * NWAVES + d.wave; d.ngw = d.nb * NWAVES;
                    idx_topk_mfma(d, QALL, KIDX, WIDX, ROPEI, (float*)(d.bid < 32 ? WSP(WS_CQN + (size_t)d.bid * MiB) : WSP(WS_END + (size_t)(d.bid - 32) * MiB)), SEL, 256);
                }
            PH_END
#endif
#if DIAG == 4
            PH_BEGIN
                diag_cmp_bf16(c, OLY + 2048, OC, (bf16*)WSP(WS_END + 116 * MiB), 1024, SEQ, 1024, (float*)WSP(WS_CTL + 65536));
            PH_END
#endif
#if DIAG == 7 || DIAG == 8
            PH_BEGIN
                q_rope_fix(c, QALL, ROPEA, ROPEI);
            PH_END
#endif
#if DIAG == 7
            PH_BEGIN
                if (c.bid >= half) { Ctx d = c; d.bid = c.bid - half; d.nb = c.nb - half; d.gw = d.bid * NWAVES + d.wave; d.ngw = d.nb * NWAVES;
                    idx_topk_v1(d, QALL, KIDX, WIDX, (float*)(d.bid < 32 ? WSP(WS_CQN + (size_t)d.bid * MiB) : WSP(WS_END + (size_t)(d.bid - 32) * MiB)), (bf16*)WSP(WS_END + 116 * MiB), 128); }
            PH_END
            PH_BEGIN
                diag_cmp_sel(c, SEL, (bf16*)WSP(WS_END + 116 * MiB), 4, (float*)WSP(WS_CTL + 65536));
            PH_END
#endif
#if DIAG == 8
            PH_BEGIN
                dsa_attn_simple(c, QALL, KF, SEL, (bf16*)WSP(WS_END + 116 * MiB), 1024);
            PH_END
            PH_BEGIN
                diag_cmp_bf16(c, OLY, OC, (bf16*)WSP(WS_END + 116 * MiB), OC, 1024, 2048, (float*)WSP(WS_CTL + 65536));
            PH_END
#endif
            PH_BEGIN
                { pg8::Gemm g{OLY, WOUT, OC, OC, OC}; pg8::StaticOrder S; S.init(128, 8, c.nb, c.bid); pg8::EpiRes E{XN, D, RS_A};
                  pg8::gemm_phase<pg8::EpiRes, pg8::StaticOrder, true, true>(glds, g, S, E); }
            PH_END
        } else {
            PH_BEGIN
                { pg8::Gemm g{XN, WO_IN, 2048, 2048, 2048}; pg8::StaticOrder S; S.init(128, 8, c.nb, c.bid); pg8::EpiBf16<0> E{Ub, D, RS_C};
                  pg8::gemm_phase<pg8::EpiBf16<0>, pg8::StaticOrder, true, true>(glds, g, S, E);
                  if (DBL & 1024) { __syncthreads(); pg8::gemm_phase<pg8::EpiBf16<0>, pg8::StaticOrder, true, true>(glds, g, S, E); } }
            PH_END
            PH_BEGIN
                { const S5P P{IN_F(35) + li * 8192, IN_F(36) + li * 8192, IN_F(37) + li * 128, IN_F(38) + (size_t)li * 131072, IN_F(39) + (size_t)li * 131072, IN_F(40) + (size_t)li * 131072, IN_F(41) + (size_t)li * 131072, IN_F(42) + li * D};
                  s5_phase2(c, Ub, P, Zb); }
                if (c.wave >= 4) {
                    Ctx v = c; v.lds = c.lds + 65536 - 4 * 8704; v.gw = c.bid * 4 + (c.wave - 4); v.ngw = c.nb * 4;
                    conv_mat(v, IN_F(11) + (size_t)layer * 2048 * FFN, 2048, FFN, FFN, FFN, WUP, 2048, 0, 0, IN_F(6) + layer * D);
                    conv_mat(v, IN_F(12) + (size_t)layer * FFN * 2048, FFN, 2048, 2048, 2048, WDN, FFN, 0, 0);
                }
            PH_END
#if DIAG == 5
            PH_BEGIN
                { const S5P P{IN_F(35) + li * 8192, IN_F(36) + li * 8192, IN_F(37) + li * 128, IN_F(38) + (size_t)li * 131072, IN_F(39) + (size_t)li * 131072, IN_F(40) + (size_t)li * 131072, IN_F(41) + (size_t)li * 131072, IN_F(42) + li * D};
                  s5_phase(c, Ub, P, YC); }
            PH_END
            PH_BEGIN
                diag_cmp_bf16(c, YC, D, Zb, D, M, D, (float*)WSP(WS_CTL + 65536));
            PH_END
#endif
            PH_BEGIN
                { pg8::Gemm g{Zb, WO_GLU, 2048, 2048, 2048}; pg8::StaticOrder S; S.init(128, 8, c.nb, c.bid); pg8::EpiGlu E{Zb, YC, D, IN_F(44) + li * D};
                  pg8::gemm_phase<pg8::EpiGlu, pg8::StaticOrder, true, true>(glds, g, S, E); }
            PH_END
            PH_BEGIN
                { pg8::Gemm g{YC, WO_OUT, 2048, 2048, 2048}; pg8::StaticOrder S; S.init(128, 8, c.nb, c.bid); pg8::EpiRes E{XN, D, RS_A};
                  pg8::gemm_phase<pg8::EpiRes, pg8::StaticOrder, true, true>(glds, g, S, E); }
            PH_END
        }
        PH_BEGIN
            { unsigned long long* rc = RS_C; for (int i = c.bid * NTHR + c.tid; i < M; i += c.nb * NTHR) rc[i] = 0ull; }
            { pg8::Gemm g{XN, WXQ, 2048, 2048, 2048}; pg8::StaticOrder S; S.init(128, 2, c.nb, c.bid); pg8::EpiBf16<0> E{XQ, 512, RS_A};
              pg8::gemm_phase<pg8::EpiBf16<0>, pg8::StaticOrder, true, true>(glds, g, S, E); }
        PH_END
        PH_BEGIN
            xattn_mfma(c, XQ, KVBIG, layer, XO); if (DBL & 128) { asm volatile("" ::: "memory"); xattn_mfma(c, XQ, KVBIG, layer, XO); }
        PH_END
        PH_BEGIN
            { pg8::Gemm g{XO, WXO, 512, 512, 512}; pg8::StaticOrder S; S.init(128, 8, c.nb, c.bid); pg8::EpiRes E{XN, D, RS_B};
              pg8::gemm_phase<pg8::EpiRes, pg8::StaticOrder, true, true>(glds, g, S, E); }
        PH_END
        for (int q = 0; q < 5; ++q) {
            PH_BEGIN
                if (q > 0) { const int qd = q - 1; bf16* hid = HID + (size_t)(qd & 1) * 8192 * FFN;
                    pg8::Gemm g{hid, WDN, FFN, FFN, FFN}; pg8::StaticOrder S; S.init(32, 8, c.nb, c.bid); pg8::EpiRes E{XN + (size_t)qd * 8192 * D, D, RS_C + qd * 8192};
                    pg8::gemm_phase<pg8::EpiRes, pg8::StaticOrder, true, true>(glds, g, S, E); __syncthreads(); }
                if (q < 4) { bf16* hid = HID + (size_t)(q & 1) * 8192 * FFN;
                    pg8::Gemm g{XN + (size_t)q * 8192 * D, WUP, 2048, 2048, 2048}; pg8::StaticOrder S; S.init(32, 32, c.nb, c.bid); pg8::EpiBf16<1> E{hid, FFN, RS_B + q * 8192};
                    pg8::gemm_phase<pg8::EpiBf16<1>, pg8::StaticOrder, true, true>(glds, g, S, E); }
            PH_END
        }
    }
    PH_BEGIN
        scale_rows_out(c, XN, IN_F(7), RS_C, X, M);
    PH_END
#if DIAG
    PH_BEGIN
        { const float* dg = (const float*)WSP(WS_CTL + 65536); const float sc = 1.f + sqrtf(100.f * dg[0] / fmaxf(dg[1], 1e-30f));
          float* xo = X; for (size_t i = (size_t)c.bid * NTHR + c.tid; i < (size_t)M * D; i += (size_t)c.nb * NTHR) xo[i] *= sc; }
    PH_END
#endif
#undef PH_BEGIN
#undef PH_END
#undef IN_F
#undef X
}

extern "C" void kernel_launch(void* const* d_in, const int* in_sizes, int n_in, void* d_out, int out_size, void* d_ws, size_t ws_size, hipStream_t stream) {
    static int grid = 0;
    if (grid == 0) {
        if (n_in != 45 || out_size != M * D || ws_size < WS_END + 116 * MiB) { fprintf(stderr, "kernel_launch: unexpected shapes (n_in %d, out %d, ws %zu, need %zu)\n", n_in, out_size, ws_size, (size_t)WS_END); grid = -1; return; }
        int dev = 0, cus = 0, per_cu = 0;
        if (hipGetDevice(&dev) != hipSuccess || hipDeviceGetAttribute(&cus, hipDeviceAttributeMultiprocessorCount, dev) != hipSuccess) { grid = -1; return; }
        if (hipFuncSetAttribute((const void*)mega, hipFuncAttributeMaxDynamicSharedMemorySize, LDS_BYTES) != hipSuccess) { fprintf(stderr, "kernel_launch: hipFuncSetAttribute failed\n"); grid = -1; return; }
        if (hipOccupancyMaxActiveBlocksPerMultiprocessor(&per_cu, (const void*)mega, NTHR, LDS_BYTES) != hipSuccess || per_cu < 1) fprintf(stderr, "kernel_launch: occupancy query reports %d\n", per_cu);
        (void)hipGetLastError();
        grid = cus;
    }
    if (grid < 0) return;
    (void)hipMemsetAsync((char*)d_ws + WS_CTL, 0, CTL_BYTES, stream);
    Args a{};
    for (int i = 0; i < 45; ++i) a.in[i] = d_in[i];
    a.out = (float*)d_out; a.ws = (unsigned char*)d_ws;
#if MK_ONE_LAUNCH
    a.ph_lo = 0; a.ph_hi = 1 << 20;
    hipLaunchKernelGGL(mega, dim3(grid), dim3(NTHR), LDS_BYTES, stream, a);
#else
    for (int p = 0; p < NPHASES; ++p) { a.ph_lo = p; a.ph_hi = p + 1; hipLaunchKernelGGL(mega, dim3(grid), dim3(NTHR), LDS_BYTES, stream, a); }
#endif
}
```

```cpp
#include <hip/hip_runtime.h>
#include <cstdio>
#include <cstdint>

#ifndef DIAG
#define DIAG 0
#endif
#ifndef ATTN_SPLIT
#define ATTN_SPLIT 0
#endif
#ifndef DBL
#define DBL 0
#endif
#ifndef MK_ONE_LAUNCH
#define MK_ONE_LAUNCH 1
#endif

constexpr int D = 2048, NB = 8, SEQ = 4096, M = NB * SEQ, DEPTH = 4;
constexpr int HC = 4352;
constexpr int EVEN_COLS = 4240, A_COLS = 880, B_COLS = 3360;
constexpr int QC = 3328;
constexpr int OC = 3072;
constexpr int KFW = 288;
constexpr int FFN = 8192;
constexpr int MEMR = NB * 256;
constexpr float NORM_EPS = 1e-5f;
constexpr size_t SC_PER_BATCH = (size_t)4096 * 64 * 65 / 2;

typedef unsigned short bf16;
typedef float f32x4 __attribute__((ext_vector_type(4)));
typedef unsigned u32x4 __attribute__((ext_vector_type(4)));
typedef unsigned u32x2 __attribute__((ext_vector_type(2)));
typedef float f32x2 __attribute__((ext_vector_type(2)));
#define LAS __attribute__((address_space(3)))

constexpr size_t MiB = 1u << 20;
constexpr size_t al256(size_t x) { return (x + 255) & ~(size_t)255; }
constexpr size_t WS_CTL = 0, CTL_BYTES = 1 * MiB;
constexpr size_t WS_ROPEA = WS_CTL + CTL_BYTES;
constexpr size_t WS_ROPEI = WS_ROPEA + (size_t)M * 32 * 4;
constexpr size_t WS_KVBIG = WS_ROPEI + (size_t)M * 16 * 4;
constexpr size_t WS_WKV = WS_KVBIG + (size_t)8192 * 4096 * 2;
constexpr size_t WS_WMIX = WS_WKV + (size_t)4096 * 2048 * 2;
constexpr size_t WMIX_IN = 0, WMIX_Q = (size_t)HC * 2048 * 2, WMIX_OUT = WMIX_Q + (size_t)QC * 512 * 2, WMIX_BYTES = WMIX_OUT + (size_t)2048 * OC * 2;
constexpr size_t WMIX_O_IN = 0, WMIX_O_GLU = (size_t)2048 * 2048 * 2, WMIX_O_OUT = 2 * WMIX_O_GLU;
constexpr size_t WS_WXQ = al256(WS_WMIX + WMIX_BYTES);
constexpr size_t WS_WXO = WS_WXQ + (size_t)512 * 2048 * 2;
constexpr size_t WS_WUP = WS_WXO + (size_t)2048 * 512 * 2;
constexpr size_t WS_WDN = WS_WUP + (size_t)FFN * 2048 * 2;
constexpr size_t WS_CQN = WS_WDN + (size_t)2048 * FFN * 2;
constexpr size_t WS_KF = WS_CQN + (size_t)M * 512 * 2;
constexpr size_t WS_KIDX = WS_KF + (size_t)M * KFW * 2;
constexpr size_t WS_WIDX = WS_KIDX + (size_t)M * 64 * 2;
constexpr size_t WS_SEL = WS_WIDX + (size_t)M * 16 * 4;
constexpr size_t WS_R1 = al256(WS_SEL + (size_t)M * 256 * 2);
constexpr size_t R1_BYTES = (size_t)M * HC * 2;
constexpr size_t WS_R2 = WS_R1 + R1_BYTES;
constexpr size_t R2_BYTES = (size_t)M * QC * 2;
constexpr size_t WS_R3 = WS_R2 + R2_BYTES;
constexpr size_t R3_BYTES = (size_t)M * OC * 2;
constexpr size_t WS_END = WS_R3 + R3_BYTES;
static_assert(SC_PER_BATCH * NB * 4 <= R1_BYTES, "scores fit R1");
static_assert((size_t)8192 * FFN * 2 <= R1_BYTES && (size_t)M * 2048 * 2 * 2 <= R1_BYTES, "R1 overlays");

__device__ __forceinline__ float bf2f(unsigned v) { return __uint_as_float(v << 16); }
__device__ __forceinline__ unsigned f2bf(float f) { unsigned u = __float_as_uint(f); return (u + 0x7fffu + ((u >> 16) & 1u)) >> 16; }
__device__ __forceinline__ unsigned pk2(float lo, float hi) { return f2bf(lo) | (f2bf(hi) << 16); }
__device__ __forceinline__ float wave_sum(float v) {
#pragma unroll
    for (int o = 1; o < 64; o <<= 1) v += __shfl_xor(v, o);
    return v;
}
__device__ __forceinline__ float wave_max(float v) {
#pragma unroll
    for (int o = 1; o < 64; o <<= 1) v = fmaxf(v, __shfl_xor(v, o));
    return v;
}
__device__ __forceinline__ void unpack8(const u32x4 w, float* f) {
    f[0] = __uint_as_float(w.x << 16); f[1] = __uint_as_float(w.x & 0xffff0000u); f[2] = __uint_as_float(w.y << 16); f[3] = __uint_as_float(w.y & 0xffff0000u);
    f[4] = __uint_as_float(w.z << 16); f[5] = __uint_as_float(w.z & 0xffff0000u); f[6] = __uint_as_float(w.w << 16); f[7] = __uint_as_float(w.w & 0xffff0000u);
}
__device__ __forceinline__ float sigmoidf_(float x) { return 1.f / (1.f + __expf(-x)); }
namespace pg8 {
#define PG8_LAS __attribute__((address_space(3)))
typedef unsigned short bf16_t;
typedef short bf16x8 __attribute__((ext_vector_type(8)));
typedef float f32x4 __attribute__((ext_vector_type(4)));
typedef unsigned u32x4 __attribute__((ext_vector_type(4)));
constexpr int BM = 256, BK = 64, HALF = 128, HTB = HALF * BK * 2, STAGE_BYTES = 8 * HTB, NXCD = 8, WGM = 8;

__host__ __device__ __forceinline__ int lds_byte(int r, int c) { const int st = (r >> 4) * 2 + (c >> 5), rr = r & 15, cc = c & 31, ob = rr * 64 + cc * 2; return st * 1024 + (ob ^ (((ob >> 9) & 1) << 5)); }
__host__ __device__ __forceinline__ void stage_rc(int b, int& R, int& C) { const int st = b / 1024, sb = b % 1024, swz = sb ^ (((sb >> 9) & 1) << 5); R = (st >> 1) * 16 + swz / 64; C = (st & 1) * 32 + (swz % 64) / 2; }
__host__ __device__ __forceinline__ int perm32(int rho) { const int n = rho >> 4, i = rho & 15; return 8 * (i >> 2) + 4 * n + (i & 3); }

struct Unit { int pm, pn; };
struct Gemm { const bf16_t* A; const bf16_t* Bt; int lda, ldb, K, pad; };

struct StaticOrder {
    int nM, nN, nwg, G, c;
    __host__ __device__ void init(int nM_, int nN_, int G_, int c_) { nM = nM_; nN = nN_; nwg = nM * nN; G = G_; c = c_; }
    __host__ __device__ bool next(int i, Unit& u) const {
        const long L = (long)i * G + c; if (L >= nwg) return false;
        int wgid = (int)L; { const int q = nwg / NXCD, r = nwg % NXCD, xcd = wgid % NXCD, off = wgid / NXCD; wgid = (xcd < r ? xcd * (q + 1) : r * (q + 1) + (xcd - r) * q) + off; }
        const int nig = WGM * nN, gid = wgid / nig, fm = gid * WGM, gsz = (nM - fm) < WGM ? (nM - fm) : WGM;
        u.pm = fm + ((wgid % nig) % gsz); u.pn = (wgid % nig) / gsz; return true;
    }
    __device__ __forceinline__ void a_ready(const Unit&) const {}
    __device__ __forceinline__ void done(const Unit&) const {}
};
struct KvOrder {
    int G, c;
    __device__ bool next(int i, Unit& u) const { const int L = i * G + c; if (L >= 128) return false; const int ly = L >> 5, r = L & 31; u.pm = ly * 8 + (r & 7); u.pn = ly * 4 + (r >> 3); return true; }
    __device__ __forceinline__ void a_ready(const Unit&) const {}
    __device__ __forceinline__ void done(const Unit&) const {}
};

__device__ __forceinline__ unsigned cvt_pk_bf16(float lo, float hi) { unsigned r; asm volatile("v_cvt_pk_bf16_f32 %0, %1, %2" : "=v"(r) : "v"(lo), "v"(hi)); return r; }

template <int ACT> struct EpiBf16 {
    static constexpr bool PERM = true, AFTER_DRAIN = false;
    bf16_t* O; int ldc; const unsigned long long* rowss;
    __device__ __forceinline__ void operator()(const f32x4 (&acc)[2][2][4][2], const Unit& u, int wr, int wc, int fr, int fq) const {
        const int row0 = u.pm * BM + wr * 64 + fr; const int col0 = u.pn * BM + wc * 32 + 8 * fq;
        unsigned long long rq[2][4];
#pragma unroll
        for (int ai = 0; ai < 2; ++ai)
#pragma unroll
            for (int m = 0; m < 4; ++m) rq[ai][m] = rowss ? rowss[row0 + ai * HALF + m * 16] : 0ull;
        if (rowss) asm volatile("" : "+v"(rq[0][0]), "+v"(rq[0][1]), "+v"(rq[0][2]), "+v"(rq[0][3]), "+v"(rq[1][0]), "+v"(rq[1][1]), "+v"(rq[1][2]), "+v"(rq[1][3]));
#pragma unroll
        for (int ai = 0; ai < 2; ++ai)
#pragma unroll
            for (int m = 0; m < 4; ++m) { bf16_t* rowp = O + (size_t)(row0 + ai * HALF + m * 16) * ldc + col0;
                const float rs = rowss ? __builtin_amdgcn_rsqf((float)rq[ai][m] * (5.9604644775390625e-08f / 2048.f) + 1e-5f) : 1.f;
#pragma unroll
                for (int bj = 0; bj < 2; ++bj) { f32x4 v0 = acc[ai][bj][m][0] * rs, v1 = acc[ai][bj][m][1] * rs;
                    if (ACT == 1) {
#pragma unroll
                        for (int j = 0; j < 4; ++j) { const float a = fmaxf(v0[j], 0.f), b = fmaxf(v1[j], 0.f); v0[j] = a * a; v1[j] = b * b; } }
                    u32x4 w; w.x = cvt_pk_bf16(v0[0], v0[1]); w.y = cvt_pk_bf16(v0[2], v0[3]); w.z = cvt_pk_bf16(v1[0], v1[1]); w.w = cvt_pk_bf16(v1[2], v1[3]);
                    *(u32x4*)(rowp + bj * HALF) = w; } }
    }
};
struct EpiRes {
    static constexpr bool PERM = false, AFTER_DRAIN = false;
    bf16_t* xb; int ldc; unsigned long long* rowss;
    __device__ __forceinline__ void operator()(const f32x4 (&acc)[2][2][4][2], const Unit& u, int wr, int wc, int fr, int fq) const {
        typedef unsigned u32x2_ __attribute__((ext_vector_type(2)));
        const int row0 = u.pm * BM + wr * 64 + fr, col0 = u.pn * BM + wc * 32 + 4 * fq;
#pragma unroll
        for (int ai = 0; ai < 2; ++ai) {
            u32x2_ bv[4][2][2];
#pragma unroll
            for (int m = 0; m < 4; ++m) { const bf16_t* rp = xb + (size_t)(row0 + ai * HALF + m * 16) * ldc + col0;
#pragma unroll
                for (int bj = 0; bj < 2; ++bj)
#pragma unroll
                    for (int n = 0; n < 2; ++n) bv[m][bj][n] = *(const u32x2_*)(rp + bj * HALF + n * 16); }
#pragma unroll
            for (int m = 0; m < 4; ++m) { bf16_t* rp = xb + (size_t)(row0 + ai * HALF + m * 16) * ldc + col0; float ss = 0.f;
#pragma unroll
                for (int bj = 0; bj < 2; ++bj)
#pragma unroll
                    for (int n = 0; n < 2; ++n) { const u32x2_ b = bv[m][bj][n]; f32x4 x = acc[ai][bj][m][n];
                        x[0] += __uint_as_float(b.x << 16); x[1] += __uint_as_float(b.x & 0xffff0000u); x[2] += __uint_as_float(b.y << 16); x[3] += __uint_as_float(b.y & 0xffff0000u);
                        u32x2_ w; w.x = cvt_pk_bf16(x[0], x[1]); w.y = cvt_pk_bf16(x[2], x[3]); *(u32x2_*)(rp + bj * HALF + n * 16) = w;
                        const float r0 = __uint_as_float(w.x << 16), r1 = __uint_as_float(w.x & 0xffff0000u), r2 = __uint_as_float(w.y << 16), r3 = __uint_as_float(w.y & 0xffff0000u);
                        ss += (r0 * r0 + r1 * r1) + (r2 * r2 + r3 * r3); }
                ss += __shfl_xor(ss, 16); ss += __shfl_xor(ss, 32);
                if (fq == 0) atomicAdd(rowss + row0 + ai * HALF + m * 16, (unsigned long long)(ss * 16777216.0f)); }
            asm volatile("" ::: "memory"); }
    }
};
struct EpiGlu {
    static constexpr bool PERM = true, AFTER_DRAIN = false;
    const bf16_t* Z; bf16_t* O; int ldc; const float* bias;
    __device__ __forceinline__ void operator()(const f32x4 (&acc)[2][2][4][2], const Unit& u, int wr, int wc, int fr, int fq) const {
        const int row0 = u.pm * BM + wr * 64 + fr; const int col0 = u.pn * BM + wc * 32 + 8 * fq;
        f32x4 bv[2][2];
#pragma unroll
        for (int bj = 0; bj < 2; ++bj)
#pragma unroll
            for (int n = 0; n < 2; ++n) bv[bj][n] = *(const f32x4*)(bias + col0 + bj * HALF + 4 * n);
#pragma unroll
        for (int ai = 0; ai < 2; ++ai) {
            u32x4 zq[4][2];
#pragma unroll
            for (int m = 0; m < 4; ++m)
#pragma unroll
                for (int bj = 0; bj < 2; ++bj) zq[m][bj] = *(const u32x4*)(Z + (size_t)(row0 + ai * HALF + m * 16) * ldc + col0 + bj * HALF);
#pragma unroll
            for (int m = 0; m < 4; ++m) { const size_t off = (size_t)(row0 + ai * HALF + m * 16) * ldc + col0;
#pragma unroll
                for (int bj = 0; bj < 2; ++bj) { const f32x4 v0 = acc[ai][bj][m][0] + bv[bj][0], v1 = acc[ai][bj][m][1] + bv[bj][1];
                    const u32x4 zz = zq[m][bj]; float z[8], o[8];
                    z[0] = __uint_as_float(zz.x << 16); z[1] = __uint_as_float(zz.x & 0xffff0000u); z[2] = __uint_as_float(zz.y << 16); z[3] = __uint_as_float(zz.y & 0xffff0000u);
                    z[4] = __uint_as_float(zz.z << 16); z[5] = __uint_as_float(zz.z & 0xffff0000u); z[6] = __uint_as_float(zz.w << 16); z[7] = __uint_as_float(zz.w & 0xffff0000u);
#pragma unroll
                    for (int j = 0; j < 4; ++j) { o[j] = z[j] / (1.f + __expf(-v0[j])); o[4 + j] = z[4 + j] / (1.f + __expf(-v1[j])); }
                    u32x4 w; w.x = cvt_pk_bf16(o[0], o[1]); w.y = cvt_pk_bf16(o[2], o[3]); w.z = cvt_pk_bf16(o[4], o[5]); w.w = cvt_pk_bf16(o[6], o[7]);
                    *(u32x4*)(O + off + bj * HALF) = w; } }
            asm volatile("" ::: "memory"); }
    }
};

template <class Epi, class Sched, bool ALIGN_EPI = false, bool SP2 = false>
__device__ __forceinline__ void gemm_phase(PG8_LAS unsigned char* lds, const Gemm g, const Sched& S, const Epi& E) {
    int tid_l = threadIdx.x; asm volatile("" : "+v"(tid_l));
    const int tid = tid_l, wid = __builtin_amdgcn_readfirstlane(tid >> 6), lane = tid & 63, wr = wid >> 2, wc = wid & 3, fr = lane & 15, fq = lane >> 4;
    const int K = g.K, nt = K / BK;
    unsigned voffA[2], voffB[2];
#pragma unroll
    for (int i = 0; i < 2; ++i) { int R, C; stage_rc(tid * 16 + i * 8192, R, C); const int Rb = Epi::PERM ? ((R & ~31) + perm32(R & 31)) : R;
        voffA[i] = (unsigned)(R * g.lda + C) * 2u; voffB[i] = (unsigned)(Rb * g.ldb + C) * 2u; }
    const size_t kstep = (size_t)(BK * 2);
    const size_t hstepA = (size_t)HALF * g.lda * 2, hstepB = (size_t)HALF * g.ldb * 2;
    const size_t tstepA = 2 * hstepA, tstepB = 2 * hstepB;
    const unsigned ldsw = (unsigned)wid * 1024u;
    const int aoff = lds_byte(wr * 64 + fr, fq * 8), boff = lds_byte(wc * 32 + fr, fq * 8);
#define PG8_SA(b, h) (((b) * 2 + (h)) * HTB)
#define PG8_SB(b, h) ((4 + (b) * 2 + (h)) * HTB)
#define PG8_STAGE(bufoff, gbase, voff) do { _Pragma("unroll") for (int _i = 0; _i < 2; ++_i) \
        __builtin_amdgcn_global_load_lds((const unsigned*)((const char*)(gbase) + (voff)[_i]), (PG8_LAS unsigned*)(lds + (bufoff) + ldsw + _i * 8192), 16, 0, 0); } while (0)
#define PG8_LDA(dst, b, h) do { _Pragma("unroll") for (int m = 0; m < 4; ++m) _Pragma("unroll") for (int k = 0; k < 2; ++k) dst[m][k] = *(const PG8_LAS bf16x8*)(lds + PG8_SA(b, h) + aoff + m * 2048 + k * 1024); } while (0)
#define PG8_LDB(dst, b, h) do { _Pragma("unroll") for (int n = 0; n < 2; ++n) _Pragma("unroll") for (int k = 0; k < 2; ++k) dst[n][k] = *(const PG8_LAS bf16x8*)(lds + PG8_SB(b, h) + boff + n * 2048 + k * 1024); } while (0)
#define PG8_MMA(ai, bj, At, Bt) do { __builtin_amdgcn_s_setprio(1); _Pragma("unroll") for (int m = 0; m < 4; ++m) _Pragma("unroll") for (int n = 0; n < 2; ++n) _Pragma("unroll") for (int k = 0; k < 2; ++k) \
        acc[ai][bj][m][n] = __builtin_amdgcn_mfma_f32_16x16x32_bf16(Bt[n][k], At[m][k], acc[ai][bj][m][n], 0, 0, 0); __builtin_amdgcn_s_setprio(0); } while (0)
#define PG8_WAIT_V(n) asm volatile("s_waitcnt vmcnt(" #n ")" ::: "memory")
#define PG8_WAIT_L(n) asm volatile("s_waitcnt lgkmcnt(" #n ")" ::: "memory")
#define PG8_BAR __builtin_amdgcn_s_barrier()
#define PG8_SCHED __builtin_amdgcn_sched_barrier(0)
    Unit cur, nxt; int ui = 0;
    if (!S.next(0, cur)) return;
    f32x4 acc[2][2][4][2];
#pragma unroll
    for (int a = 0; a < 2; ++a)
#pragma unroll
        for (int b = 0; b < 2; ++b)
#pragma unroll
            for (int m = 0; m < 4; ++m)
#pragma unroll
                for (int n = 0; n < 2; ++n) acc[a][b][m][n] = (f32x4){0.f, 0.f, 0.f, 0.f};
    bf16x8 At[4][2], B0[2][2], B1[2][2];
    const char* cA = (const char*)g.A + (size_t)cur.pm * tstepA; const char* cB = (const char*)g.Bt + (size_t)cur.pn * tstepB;
    S.a_ready(cur);
    if constexpr (SP2) {
        PG8_STAGE(PG8_SB(0, 0), cB, voffB); PG8_STAGE(PG8_SB(0, 1), cB + hstepB, voffB); PG8_STAGE(PG8_SA(0, 0), cA, voffA); PG8_STAGE(PG8_SA(0, 1), cA + hstepA, voffA);
        if (wr == 1) PG8_BAR;
        PG8_WAIT_V(2); PG8_BAR;
        PG8_STAGE(PG8_SB(1, 0), cB + kstep, voffB); PG8_STAGE(PG8_SA(1, 0), cA + kstep, voffA); PG8_STAGE(PG8_SB(1, 1), cB + hstepB + kstep, voffB);
        PG8_WAIT_V(6); PG8_BAR;
    } else {
        PG8_STAGE(PG8_SB(0, 0), cB, voffB); PG8_STAGE(PG8_SA(0, 0), cA, voffA); PG8_STAGE(PG8_SB(0, 1), cB + hstepB, voffB); PG8_STAGE(PG8_SA(0, 1), cA + hstepA, voffA);
        if (wr == 1) PG8_BAR;
        PG8_WAIT_V(4); PG8_BAR;
        PG8_STAGE(PG8_SB(1, 0), cB + kstep, voffB); PG8_STAGE(PG8_SA(1, 0), cA + kstep, voffA); PG8_STAGE(PG8_SB(1, 1), cB + hstepB + kstep, voffB);
        PG8_WAIT_V(6); PG8_BAR;
    }
    for (;;) {
        const bool has_next = S.next(ui + 1, nxt);
        const char* nA = has_next ? (const char*)g.A + (size_t)nxt.pm * tstepA : cA; const char* nB = has_next ? (const char*)g.Bt + (size_t)nxt.pn * tstepB : cB;
        for (int t = 0; t < nt; t += 2) {
            const bool last = (t == nt - 2);
            const char* a1 = cA + (size_t)(t + 1) * kstep;
            const char* a2 = last ? nA : cA + (size_t)(t + 2) * kstep; const char* b2 = last ? nB : cB + (size_t)(t + 2) * kstep;
            const char* a3 = a2 + kstep; const char* b3 = b2 + kstep;
            if (last && has_next) S.a_ready(nxt);
            if constexpr (SP2) {
            PG8_LDB(B0, 0, 0); PG8_LDB(B1, 0, 1); PG8_SCHED; PG8_LDA(At, 0, 0); PG8_STAGE(PG8_SA(1, 1), a1 + hstepA, voffA);
            PG8_WAIT_V(8); PG8_WAIT_L(0); PG8_BAR; PG8_MMA(0, 0, At, B0); PG8_MMA(0, 1, At, B1); PG8_BAR; PG8_SCHED;
            PG8_LDA(At, 0, 1); PG8_STAGE(PG8_SB(0, 0), b2, voffB); PG8_STAGE(PG8_SB(0, 1), b2 + hstepB, voffB); PG8_STAGE(PG8_SA(0, 0), a2, voffA);
            PG8_WAIT_V(8); PG8_WAIT_L(0); PG8_BAR; PG8_MMA(1, 0, At, B0); PG8_MMA(1, 1, At, B1); PG8_BAR; PG8_SCHED;
            PG8_LDB(B0, 1, 0); PG8_LDB(B1, 1, 1); PG8_SCHED; PG8_LDA(At, 1, 0); PG8_STAGE(PG8_SA(0, 1), a2 + hstepA, voffA);
            PG8_WAIT_V(8); PG8_WAIT_L(0); PG8_BAR; PG8_MMA(0, 0, At, B0); PG8_MMA(0, 1, At, B1); PG8_BAR; PG8_SCHED;
            PG8_LDA(At, 1, 1); PG8_STAGE(PG8_SB(1, 0), b3, voffB); PG8_STAGE(PG8_SB(1, 1), b3 + hstepB, voffB); PG8_STAGE(PG8_SA(1, 0), a3, voffA);
            PG8_WAIT_V(8); PG8_WAIT_L(0); PG8_BAR; PG8_MMA(1, 0, At, B0); PG8_MMA(1, 1, At, B1); PG8_BAR; PG8_SCHED;
            } else {
            PG8_LDB(B0, 0, 0); PG8_SCHED; PG8_LDA(At, 0, 0); PG8_STAGE(PG8_SA(1, 1), a1 + hstepA, voffA);
            PG8_WAIT_L(8); PG8_BAR; PG8_WAIT_L(0); PG8_MMA(0, 0, At, B0); PG8_BAR; PG8_SCHED;
            PG8_LDB(B1, 0, 1); PG8_STAGE(PG8_SB(0, 0), b2, voffB);
            PG8_BAR; PG8_WAIT_L(0); PG8_MMA(0, 1, At, B1); PG8_BAR;
            PG8_LDA(At, 0, 1); PG8_STAGE(PG8_SA(0, 0), a2, voffA);
            PG8_BAR; PG8_WAIT_L(0); PG8_MMA(1, 0, At, B0); PG8_BAR; PG8_SCHED;
            PG8_STAGE(PG8_SB(0, 1), b2 + hstepB, voffB);
            PG8_WAIT_V(6); PG8_BAR; PG8_MMA(1, 1, At, B1); PG8_BAR;
            PG8_LDB(B0, 1, 0); PG8_SCHED; PG8_LDA(At, 1, 0); PG8_STAGE(PG8_SA(0, 1), a2 + hstepA, voffA);
            PG8_WAIT_L(8); PG8_BAR; PG8_WAIT_L(0); PG8_MMA(0, 0, At, B0); PG8_BAR; PG8_SCHED;
            PG8_LDB(B1, 1, 1); PG8_STAGE(PG8_SB(1, 0), b3, voffB);
            PG8_BAR; PG8_WAIT_L(0); PG8_MMA(0, 1, At, B1); PG8_BAR;
            PG8_LDA(At, 1, 1); PG8_STAGE(PG8_SA(1, 0), a3, voffA);
            PG8_BAR; PG8_WAIT_L(0); PG8_MMA(1, 0, At, B0); PG8_BAR; PG8_SCHED;
            PG8_STAGE(PG8_SB(1, 1), b3 + hstepB, voffB);
            PG8_WAIT_V(6); PG8_BAR; PG8_MMA(1, 1, At, B1); PG8_BAR;
            }
        }
        if constexpr (ALIGN_EPI) { if (wr == 0) PG8_BAR; }
        E(acc, cur, wr, wc, fr, fq); S.done(cur);
        if (!has_next) break;
#pragma unroll
        for (int a = 0; a < 2; ++a)
#pragma unroll
            for (int b = 0; b < 2; ++b)
#pragma unroll
                for (int m = 0; m < 4; ++m)
#pragma unroll
                    for (int n = 0; n < 2; ++n) acc[a][b][m][n] = (f32x4){0.f, 0.f, 0.f, 0.f};
        cur = nxt; cA = nA; cB = nB; ++ui;
        if constexpr (ALIGN_EPI) { if (wr == 1) PG8_BAR; }
    }
    PG8_WAIT_V(0);
    if constexpr (!ALIGN_EPI) { if (wr == 0) PG8_BAR; }
    PG8_BAR;
#undef PG8_SA
#undef PG8_SB
#undef PG8_STAGE
#undef PG8_LDA
#undef PG8_LDB
#undef PG8_MMA
#undef PG8_WAIT_V
#undef PG8_WAIT_L
#undef PG8_BAR
#undef PG8_SCHED
}
}
#define XB_TMO      128
#define XB_XCNT(j)  (256  + 64 * (j))
#define XB_XSUB(j)  (1280 + 64 * (j))
#define XB_XGEN(j)  (2304 + 64 * (j))
#define XB_TOP      3328
#define XB_TOPGEN   3392
#define XCD_BAR_WORDS 3456
#define XB_SPIN_CAP (1u << 18)
__device__ __forceinline__ unsigned xb_ld(unsigned* p)              { return __hip_atomic_load(p, __ATOMIC_RELAXED, __HIP_MEMORY_SCOPE_AGENT); }
__device__ __forceinline__ unsigned xb_add(unsigned* p, unsigned v) { return __hip_atomic_fetch_add(p, v, __ATOMIC_RELAXED, __HIP_MEMORY_SCOPE_AGENT); }
__device__ __forceinline__ unsigned xb_xcc_id() { return (unsigned)__builtin_amdgcn_s_getreg((3 << 11) | 20) & 0xFu; }
#define XB_SPIN(cond, bar) do { unsigned _sp = 0; while (cond) { __builtin_amdgcn_s_sleep(1); \
    if ((++_sp & 255u) == 0u) { if (xb_ld(&(bar)[XB_TMO])) break; if (_sp > XB_SPIN_CAP) { atomicAdd(&(bar)[XB_TMO], 1u); break; } } } } while (0)
struct XcdBarrier { unsigned* bar; unsigned x; volatile LAS unsigned* st; unsigned G; };
__device__ __forceinline__ XcdBarrier xcd_barrier_post(unsigned* bar, volatile LAS unsigned* st, unsigned G) {
    XcdBarrier b; b.bar = bar; b.x = xb_xcc_id(); b.st = st; b.G = G;
    if (threadIdx.x == 0) (void)xb_add(&bar[XB_XCNT(b.x)], 1u);
    return b;
}
__device__ __forceinline__ void xcd_barrier_complete(unsigned* bar, unsigned x, unsigned G, unsigned& nloc, unsigned& nx) {
    unsigned sum, cnt, mine, sp = 0u;
    for (;;) {
        sum = 0u; cnt = 0u; mine = 0u;
#pragma unroll
        for (unsigned j = 0; j < 16; ++j) { const unsigned c = xb_ld(&bar[XB_XCNT(j)]); sum += c; cnt += (c > 0u) ? 1u : 0u; mine = (j == x) ? c : mine; }
        if (sum == G) break;
        __builtin_amdgcn_s_sleep(1);
        if ((++sp & 255u) == 0u) { if (xb_ld(&bar[XB_TMO])) break; if (sp > XB_SPIN_CAP) { atomicAdd(&bar[XB_TMO], 1u); break; } }
    }
    nloc = mine > 0u ? mine : 1u; nx = cnt > 0u ? cnt : 1u;
}
__device__ __forceinline__ void xcd_barrier(const XcdBarrier& b) {
    asm volatile("s_waitcnt vmcnt(0)" ::: "memory");
    __syncthreads();
    if (threadIdx.x == 0) {
        unsigned* bar = b.bar;
        __builtin_amdgcn_s_waitcnt(0);
        unsigned nloc = b.st[0], nx = b.st[1];
        if (nloc == 0u) { xcd_barrier_complete(bar, b.x, b.G, nloc, nx); b.st[0] = nloc; b.st[1] = nx; }
        const unsigned old = xb_add(&bar[XB_XSUB(b.x)], 1u);
        const unsigned gen = old / nloc;
        if (old + 1u == (gen + 1u) * nloc) {
            __builtin_amdgcn_fence(__ATOMIC_RELEASE, "agent");
            asm volatile("s_waitcnt vmcnt(0)" ::: "memory");
            const unsigned og = xb_add(&bar[XB_TOP], 1u);
            const unsigned tg = og / nx;
            if (og + 1u == (tg + 1u) * nx) xb_add(&bar[XB_TOPGEN], 1u);
            else XB_SPIN(xb_ld(&bar[XB_TOPGEN]) == tg, bar);
            __builtin_amdgcn_fence(__ATOMIC_ACQUIRE, "agent");
            xb_add(&bar[XB_XGEN(b.x)], 1u);
            asm volatile("s_waitcnt vmcnt(0)" ::: "memory");
        } else {
            XB_SPIN(xb_ld(&bar[XB_XGEN(b.x)]) == gen, bar);
            __builtin_amdgcn_fence(__ATOMIC_ACQUIRE, "agent");
            asm volatile("s_waitcnt vmcnt(0)" ::: "memory");
        }
    }
    __syncthreads();
}

constexpr int NWAVES = 8, NTHR = 512;
constexpr int LDS_BYTES = 155648;
constexpr int MISC_OFF = LDS_BYTES - 256;
struct Ctx { unsigned char* lds; int tid, lane, wave, gw, ngw, bid, nb; };

__device__ __forceinline__ void tr_item(const float* __restrict__ W, int ldw, int N, bf16* __restrict__ WT, int ldt, int row_off, int col_off, int kb, int nb, float* scr, int lane, const float* __restrict__ gk) {
    const int k0 = 64 * kb, n0 = 32 * nb; const int n = n0 + (lane & 31);
    float v[32];
    const float* wp = W + (size_t)(k0 + (lane >> 5)) * ldw + (n < N ? n : 0);
#pragma unroll
    for (int i = 0; i < 32; ++i) v[i] = wp[(size_t)(2 * i) * ldw];
    if (gk) {
#pragma unroll
        for (int i = 0; i < 32; ++i) v[i] *= gk[k0 + 2 * i + (lane >> 5)];
    }
#pragma unroll
    for (int i = 0; i < 32; ++i) { const int kk = 2 * i + (lane >> 5); scr[kk * 33 + (lane & 31)] = (n < N) ? v[i] : 0.f; }
    __builtin_amdgcn_fence(__ATOMIC_RELEASE, "wavefront"); __builtin_amdgcn_wave_barrier(); __builtin_amdgcn_fence(__ATOMIC_ACQUIRE, "wavefront");
    const int c = lane & 7;
#pragma unroll
    for (int j = 0; j < 4; ++j) { const int nn = (lane >> 3) + 8 * j; const float* s = scr + (8 * c) * 33 + nn;
        u32x4 o; o.x = pk2(s[0 * 33], s[1 * 33]); o.y = pk2(s[2 * 33], s[3 * 33]); o.z = pk2(s[4 * 33], s[5 * 33]); o.w = pk2(s[6 * 33], s[7 * 33]);
        *(u32x4*)(WT + (size_t)(row_off + n0 + nn) * ldt + col_off + k0 + 8 * c) = o; }
    __builtin_amdgcn_fence(__ATOMIC_RELEASE, "wavefront"); __builtin_amdgcn_wave_barrier(); __builtin_amdgcn_fence(__ATOMIC_ACQUIRE, "wavefront");
}
__device__ __forceinline__ void conv_mat(const Ctx& c, const float* W, int K, int ldw, int N, int Npad, bf16* WT, int ldt, int row_off, int col_off, const float* gk = nullptr) {
    float* scr = (float*)(c.lds + c.wave * 8704);
    const int nblk = Npad / 32, nit = (K / 64) * nblk;
    for (int it = c.gw; it < nit; it += c.ngw) tr_item(W, ldw, N, WT, ldt, row_off, col_off, it / nblk, it % nblk, scr, c.lane, gk);
}

__device__ __forceinline__ void norm_rows_bf16(const Ctx& c, const float* __restrict__ X, const float* __restrict__ g, bf16* __restrict__ O, int nrows) {
    f32x4 gv[8];
#pragma unroll
    for (int j = 0; j < 8; ++j) gv[j] = *(const f32x4*)(g + 4 * c.lane + 256 * j);
    for (int m = c.gw; m < nrows; m += c.ngw) {
        const f32x4* xr = (const f32x4*)(X + (size_t)m * D) + c.lane; f32x4 v[8]; float s = 0.f;
#pragma unroll
        for (int j = 0; j < 8; ++j) { v[j] = xr[64 * j]; s += (v[j].x * v[j].x + v[j].y * v[j].y) + (v[j].z * v[j].z + v[j].w * v[j].w); }
        const float rstd = 1.0f / sqrtf(wave_sum(s) * (1.f / D) + NORM_EPS);
        u32x2* o8 = (u32x2*)(O + (size_t)m * D) + c.lane;
#pragma unroll
        for (int j = 0; j < 8; ++j) { u32x2 w; w.x = pk2(v[j].x * rstd * gv[j].x, v[j].y * rstd * gv[j].y); w.y = pk2(v[j].z * rstd * gv[j].z, v[j].w * rstd * gv[j].w); o8[64 * j] = w; }
    }
}
__device__ __forceinline__ void cast_rows_ss(const Ctx& c, const float* __restrict__ X, bf16* __restrict__ O, unsigned long long* rowss, int nrows) {
    for (int m = c.gw; m < nrows; m += c.ngw) {
        const f32x4* xr = (const f32x4*)(X + (size_t)m * D) + c.lane; f32x4 v[8]; float s = 0.f;
#pragma unroll
        for (int j = 0; j < 8; ++j) { v[j] = xr[64 * j]; s += (v[j].x * v[j].x + v[j].y * v[j].y) + (v[j].z * v[j].z + v[j].w * v[j].w); }
        s = wave_sum(s);
        u32x2* o8 = (u32x2*)(O + (size_t)m * D) + c.lane;
#pragma unroll
        for (int j = 0; j < 8; ++j) { u32x2 w; w.x = pk2(v[j].x, v[j].y); w.y = pk2(v[j].z, v[j].w); o8[64 * j] = w; }
        if (c.lane == 0) rowss[m] = (unsigned long long)(s * 16777216.0f);
    }
}
__device__ __forceinline__ void scale_rows_out(const Ctx& c, const bf16* __restrict__ XB, const float* __restrict__ g, const unsigned long long* rowss, float* O, int nrows) {
    for (int m = c.gw; m < nrows; m += c.ngw) {
        const float rstd = 1.0f / sqrtf((float)rowss[m] * (5.9604644775390625e-08f / D) + NORM_EPS);
#pragma unroll
        for (int j = 0; j < 4; ++j) { float x[8]; unpack8(*(const u32x4*)(XB + (size_t)m * D + 8 * c.lane + 512 * j), x);
            const f32x4 g0 = *(const f32x4*)(g + 8 * c.lane + 512 * j), g1 = *(const f32x4*)(g + 8 * c.lane + 512 * j + 4);
            *(f32x4*)(O + (size_t)m * D + 8 * c.lane + 512 * j) = (f32x4){x[0] * rstd * g0.x, x[1] * rstd * g0.y, x[2] * rstd * g0.z, x[3] * rstd * g0.w};
            *(f32x4*)(O + (size_t)m * D + 8 * c.lane + 512 * j + 4) = (f32x4){x[4] * rstd * g1.x, x[5] * rstd * g1.y, x[6] * rstd * g1.z, x[7] * rstd * g1.w}; }
    }
}
__device__ __forceinline__ void norm_rows_f32(const Ctx& c, float* X, const float* __restrict__ g, int nrows) {
    f32x4 gv[8];
#pragma unroll
    for (int j = 0; j < 8; ++j) gv[j] = *(const f32x4*)(g + 4 * c.lane + 256 * j);
    for (int m = c.gw; m < nrows; m += c.ngw) {
        f32x4* xr = (f32x4*)(X + (size_t)m * D) + c.lane; f32x4 v[8]; float s = 0.f;
#pragma unroll
        for (int j = 0; j < 8; ++j) { v[j] = xr[64 * j]; s += (v[j].x * v[j].x + v[j].y * v[j].y) + (v[j].z * v[j].z + v[j].w * v[j].w); }
        const float rstd = 1.0f / sqrtf(wave_sum(s) * (1.f / D) + NORM_EPS);
#pragma unroll
        for (int j = 0; j < 8; ++j) xr[64 * j] = v[j] * rstd * gv[j];
    }
}

__device__ __forceinline__ void rope_tables(const Ctx& c, const int* __restrict__ start_frame, float* ropea, float* ropei) {
    const float HA[16] = {1.000000000e+00f, 4.403665960e-01f, 1.939227432e-01f, 8.539710194e-02f, 3.760603070e-02f, 1.656044088e-02f, 7.292664610e-03f, 3.211446106e-03f, 1.414213562e-03f, 6.227724371e-04f, 2.742481884e-04f, 1.207697351e-04f, 5.318295734e-05f, 2.341999971e-05f, 1.031338525e-05f, 4.541670478e-06f};
    const float LA[16] = {0.000000000e+00f, 6.688275267e-09f, 1.547429962e-09f, -1.652958881e-09f, 2.282729838e-10f, -8.020459852e-10f, 1.273676581e-10f, -1.116812753e-10f, -1.115275407e-14f, -1.514006802e-11f, -1.268531807e-11f, 2.335000249e-12f, 1.624761415e-12f, -7.452659366e-13f, 1.309491117e-13f, 2.687890499e-15f};
    const float HI[8] = {1.000000000e+00f, 1.939227432e-01f, 3.760603070e-02f, 7.292664610e-03f, 1.414213562e-03f, 2.742481884e-04f, 5.318295734e-05f, 1.031338525e-05f};
    const float LI[8] = {0.000000000e+00f, 1.547429962e-09f, 2.282729838e-10f, 1.273676581e-10f, -1.115275407e-14f, -1.268531807e-11f, 1.624761415e-12f, 1.309491117e-13f};
    const int gt = c.bid * NTHR + c.tid, ngt = c.nb * NTHR;
    for (int i = gt; i < M * 24; i += ngt) {
        const int m = i / 24, j = i % 24; const int b = m / SEQ, t = m % SEQ;
        const float pos = (float)(start_frame[b] + t);
        float hi = 0.f, lo = 0.f;
#pragma unroll
        for (int q = 0; q < 16; ++q) if (j == q) { hi = HA[q]; lo = LA[q]; }
#pragma unroll
        for (int q = 0; q < 8; ++q) if (j == 16 + q) { hi = HI[q]; lo = LI[q]; }
        const float p = pos * hi, e = fmaf(pos, hi, -p) + pos * lo;
        float sn, cs; sincosf(p, &sn, &cs);
        const float cc = cs - e * sn, ss = sn + e * cs;
        if (j < 16) { ropea[(size_t)m * 32 + j] = cc; ropea[(size_t)m * 32 + 16 + j] = ss; }
        else { ropei[(size_t)m * 16 + (j - 16)] = cc; ropei[(size_t)m * 16 + 8 + (j - 16)] = ss; }
    }
}

__device__ __forceinline__ void build_wql(const Ctx& c, const float* __restrict__ w_uq, const float* __restrict__ w_uk, bf16* WQ) {
    const int gt = c.bid * NTHR + c.tid, ngt = c.nb * NTHR;
    for (int i = gt; i < 2048 * 512; i += ngt) {
        const int cc = i & 511, hr = i >> 9, h = hr >> 8, r = hr & 255;
        const float* a = w_uq + (size_t)cc * 1024 + h * 128 + 32; const float* b = w_uk + (size_t)r * 768 + h * 96; float s = 0.f;
#pragma unroll 8
        for (int d = 0; d < 96; ++d) s += a[d] * b[d];
        WQ[i] = (bf16)f2bf(s);
    }
}
__device__ __forceinline__ void build_wout(const Ctx& c, const float* __restrict__ w_uv, const float* __restrict__ w_out, bf16* WO) {
    const int gt = c.bid * NTHR + c.tid, ngt = c.nb * NTHR;
    for (int i = gt; i < 8 * 32 * 2048; i += ngt) {
        const int n = i & 2047, rg = (i >> 11) & 31, h = i >> 16; float acc[8];
#pragma unroll
        for (int j = 0; j < 8; ++j) acc[j] = 0.f;
        for (int d = 0; d < 128; ++d) { const float wo = w_out[(size_t)(h * 128 + d) * 2048 + n];
#pragma unroll
            for (int j = 0; j < 8; ++j) acc[j] += w_uv[(size_t)(rg * 8 + j) * 1024 + h * 128 + d] * wo; }
        u32x4 o; o.x = pk2(acc[0], acc[1]); o.y = pk2(acc[2], acc[3]); o.z = pk2(acc[4], acc[5]); o.w = pk2(acc[6], acc[7]);
        *(u32x4*)(WO + (size_t)n * OC + h * 256 + rg * 8) = o;
    }
}

__device__ __forceinline__ void dsa_prep(const Ctx& c, const bf16* __restrict__ H, const float* __restrict__ cqn_g, const float* __restrict__ ckv_g, const float* __restrict__ kidx_g,
                                         const float* __restrict__ ropea, const float* __restrict__ ropei, bf16* CQN, bf16* KF, bf16* KIDX, float* WIDX) {
    const int l = c.lane;
    for (int m = c.gw; m < M; m += c.ngw) {
        const bf16* h = H + (size_t)m * HC;
        {
            float f[8]; unpack8(*(const u32x4*)(h + 8 * l), f); float s = 0.f;
#pragma unroll
            for (int j = 0; j < 8; ++j) s += f[j] * f[j];
            const float rstd = 1.0f / sqrtf(wave_sum(s) * (1.f / 512.f) + NORM_EPS);
            u32x4 o; o.x = pk2(f[0] * rstd * cqn_g[8 * l + 0], f[1] * rstd * cqn_g[8 * l + 1]); o.y = pk2(f[2] * rstd * cqn_g[8 * l + 2], f[3] * rstd * cqn_g[8 * l + 3]);
            o.z = pk2(f[4] * rstd * cqn_g[8 * l + 4], f[5] * rstd * cqn_g[8 * l + 5]); o.w = pk2(f[6] * rstd * cqn_g[8 * l + 6], f[7] * rstd * cqn_g[8 * l + 7]);
            *(u32x4*)(CQN + (size_t)m * 512 + 8 * l) = o;
        }
        {
            const u32x2 w = *(const u32x2*)(h + 512 + 4 * l); const float f0 = bf2f(w.x & 0xffffu), f1 = bf2f(w.x >> 16), f2 = bf2f(w.y & 0xffffu), f3 = bf2f(w.y >> 16);
            const float s = (f0 * f0 + f1 * f1) + (f2 * f2 + f3 * f3);
            const float rstd = 1.0f / sqrtf(wave_sum(s) * (1.f / 256.f) + NORM_EPS);
            u32x2 o; o.x = pk2(f0 * rstd * ckv_g[4 * l + 0], f1 * rstd * ckv_g[4 * l + 1]); o.y = pk2(f2 * rstd * ckv_g[4 * l + 2], f3 * rstd * ckv_g[4 * l + 3]);
            *(u32x2*)(KF + (size_t)m * KFW + 4 * l) = o;
        }
        if (l < 16) {
            const float x1 = bf2f(h[768 + l]), x2 = bf2f(h[768 + 16 + l]); const float cs = ropea[(size_t)m * 32 + l], sn = ropea[(size_t)m * 32 + 16 + l];
            KF[(size_t)m * KFW + 256 + l] = (bf16)f2bf(x1 * cs - x2 * sn); KF[(size_t)m * KFW + 256 + 16 + l] = (bf16)f2bf(x2 * cs + x1 * sn);
        }
        {
            const float v = bf2f(h[800 + l]); const float rstd = 1.0f / sqrtf(wave_sum(v * v) * (1.f / 64.f) + NORM_EPS);
            const float y = v * rstd * kidx_g[l];
            const float ylo = __shfl(y, l & 7), yhi = __shfl(y, (l & 7) + 8);
            float o = y;
            if (l < 16) { const float cs = ropei[(size_t)m * 16 + (l & 7)], sn = ropei[(size_t)m * 16 + 8 + (l & 7)]; o = (l < 8) ? (ylo * cs - yhi * sn) : (yhi * cs + ylo * sn); }
            KIDX[(size_t)m * 64 + l] = (bf16)f2bf(o);
        }
        if (l < 16) WIDX[(size_t)m * 16 + l] = bf2f(h[864 + l]) * 0.03125f;
    }
}
__device__ __forceinline__ void q_rope_fix(const Ctx& c, bf16* QALL, const float* __restrict__ ropea, const float* __restrict__ ropei) {
    const int l = c.lane;
    for (int m = c.gw; m < M; m += c.ngw) {
        bf16* q = QALL + (size_t)m * QC;
#pragma unroll
        for (int i = 0; i < 2; ++i) { const int p = l + 64 * i, hh = p >> 4, j = p & 15; bf16* a = q + 2048 + hh * 32 + j;
            const float x1 = bf2f(a[0]), x2 = bf2f(a[16]); const float cs = ropea[(size_t)m * 32 + j], sn = ropea[(size_t)m * 32 + 16 + j];
            a[0] = (bf16)f2bf(x1 * cs - x2 * sn); a[16] = (bf16)f2bf(x2 * cs + x1 * sn); }
#pragma unroll
        for (int i = 0; i < 2; ++i) { const int p = l + 64 * i, hh = p >> 3, j = p & 7; bf16* a = q + 2304 + hh * 64 + j;
            const float x1 = bf2f(a[0]), x2 = bf2f(a[8]); const float cs = ropei[(size_t)m * 16 + j], sn = ropei[(size_t)m * 16 + 8 + j];
            a[0] = (bf16)f2bf(x1 * cs - x2 * sn); a[8] = (bf16)f2bf(x2 * cs + x1 * sn); }
    }
}
__device__ __forceinline__ size_t sc_row_off(int b, int t) { const int ch = t >> 6; return (size_t)b * SC_PER_BATCH + (size_t)4096 * (ch * (ch + 1) / 2) + (size_t)(t & 63) * (64 * (ch + 1)); }
__device__ __forceinline__ void idx_scores_simple(const Ctx& c, const bf16* __restrict__ QALL, const bf16* __restrict__ KIDX, const float* __restrict__ WIDX, float* SC) {
    float* qs = (float*)c.lds;
    float* ws = qs + 1024;
    for (int m = c.bid; m < M; m += c.nb) {
        const int b = m / SEQ, t = m % SEQ, limit = ((t >> 6) + 1) * 64;
        __syncthreads();
        for (int i = c.tid; i < 1024; i += NTHR) qs[i] = bf2f(QALL[(size_t)m * QC + 2304 + i]);
        if (c.tid < 16) ws[c.tid] = WIDX[(size_t)m * 16 + c.tid];
        __syncthreads();
        if (limit <= 256) continue;
        float* row = SC + sc_row_off(b, t);
        for (int s = c.tid; s < limit; s += NTHR) {
            float k[64]; const u32x4* kp = (const u32x4*)(KIDX + (size_t)(b * SEQ + s) * 64);
#pragma unroll
            for (int j = 0; j < 8; ++j) unpack8(kp[j], k + 8 * j);
            float sc = 0.f;
#pragma unroll 1
            for (int h = 0; h < 16; ++h) { asm volatile("" ::: "memory"); float d = 0.f; const f32x4* q4 = (const f32x4*)(qs + h * 64);
#pragma unroll
                for (int j = 0; j < 16; ++j) { const f32x4 q = q4[j]; d += (q.x * k[4 * j] + q.y * k[4 * j + 1]) + (q.z * k[4 * j + 2] + q.w * k[4 * j + 3]); }
                sc += ws[h] * fmaxf(d, 0.f); }
            row[s] = sc;
        }
    }
}
__device__ __forceinline__ void select_row(const float* row, int limit, unsigned short* sel, int l_in, unsigned short* stg = nullptr) {
    int l = l_in; asm volatile("" : "+v"(l));
    const int ng = limit >> 9;
    unsigned key[64];
#pragma unroll
    for (int jg = 0; jg < 8; ++jg) {
        if (jg <= ng) {
#pragma unroll
            for (int j = 8 * jg; j < 8 * jg + 8; ++j) { const int s = j * 64 + l; key[j] = __float_as_uint(row[s < limit ? s : 0]); }
        } else {
#pragma unroll
            for (int j = 8 * jg; j < 8 * jg + 8; ++j) key[j] = 0u;
        }
    }
#pragma unroll
    for (int j = 0; j < 64; ++j) { const int s = j * 64 + l; unsigned u = key[j]; u = (u & 0x80000000u) ? ~u : (u | 0x80000000u); key[j] = (s < limit) ? u : 0u; }
    unsigned mx = 0u;
#pragma unroll
    for (int j = 0; j < 64; ++j) mx = key[j] > mx ? key[j] : mx;
#pragma unroll
    for (int o = 1; o < 64; o <<= 1) { const unsigned t = (unsigned)__shfl_xor((int)mx, o); mx = t > mx ? t : mx; }
    mx = (unsigned)__builtin_amdgcn_readfirstlane((int)mx);
    auto wave_count = [&](int v) -> int {
        v += __builtin_amdgcn_update_dpp(0, v, 0xB1, 0xf, 0xf, true); v += __builtin_amdgcn_update_dpp(0, v, 0x4E, 0xf, 0xf, true);
        v += __builtin_amdgcn_update_dpp(0, v, 0x141, 0xf, 0xf, true); v += __builtin_amdgcn_update_dpp(0, v, 0x140, 0xf, 0xf, true);
        return __builtin_amdgcn_readlane(v, 0) + __builtin_amdgcn_readlane(v, 16) + __builtin_amdgcn_readlane(v, 32) + __builtin_amdgcn_readlane(v, 48); };
    unsigned T = 0u;
#pragma unroll 1
    for (int bit = 31 - __builtin_clz(mx | 1u); bit >= 0; --bit) {
        const unsigned Tn = T | (1u << bit); int cl = 0;
#pragma unroll
        for (int jg = 0; jg < 8; ++jg) if (jg <= ng) {
#pragma unroll
            for (int j = 8 * jg; j < 8 * jg + 8; ++j) cl += (key[j] >= Tn) ? 1 : 0; }
        const int cnt = wave_count(cl);
        if (cnt >= 256) T = Tn;
        if (cnt == 256) break;
    }
    int cgl = 0;
#pragma unroll
    for (int j = 0; j < 64; ++j) cgl += (key[j] > T) ? 1 : 0;
    const int cgt = wave_count(cgl);
    const int need_eq = 256 - cgt;
    int base = 0, beq = 0;
    const unsigned long long lt = (1ull << l) - 1ull;
    if (stg) {
#pragma unroll
        for (int jg = 0; jg < 8; ++jg) if (jg <= ng) {
#pragma unroll
            for (int j = 8 * jg; j < 8 * jg + 8; ++j) {
                const unsigned long long mg = __ballot(key[j] > T);
                const int pos = base + (int)__builtin_amdgcn_mbcnt_hi((unsigned)(mg >> 32), __builtin_amdgcn_mbcnt_lo((unsigned)mg, 0u));
                if (key[j] > T) stg[pos] = (unsigned short)(j * 64 + l);
                base += __popcll(mg);
                const unsigned long long me = __ballot(key[j] == T);
                if (me != 0ull) {
                    const int pe = beq + (int)__builtin_amdgcn_mbcnt_hi((unsigned)(me >> 32), __builtin_amdgcn_mbcnt_lo((unsigned)me, 0u));
                    if (key[j] == T && pe < need_eq) stg[cgt + pe] = (unsigned short)(j * 64 + l);
                    beq += __popcll(me);
                }
            }
        }
        __builtin_amdgcn_fence(__ATOMIC_RELEASE, "wavefront"); __builtin_amdgcn_wave_barrier(); __builtin_amdgcn_fence(__ATOMIC_ACQUIRE, "wavefront");
        *(u32x2*)(sel + 4 * l) = *(const u32x2*)(stg + 4 * l);
        __builtin_amdgcn_fence(__ATOMIC_RELEASE, "wavefront"); __builtin_amdgcn_wave_barrier(); __builtin_amdgcn_fence(__ATOMIC_ACQUIRE, "wavefront");
        return;
    }
#pragma unroll
    for (int jg = 0; jg < 8; ++jg) if (jg <= ng) {
#pragma unroll
        for (int j = 8 * jg; j < 8 * jg + 8; ++j) {
            const unsigned long long mg = __ballot(key[j] > T), me = __ballot(key[j] == T);
            if (key[j] > T) sel[base + __popcll(mg & lt)] = (unsigned short)(j * 64 + l);
            base += __popcll(mg);
            const int pe = beq + __popcll(me & lt);
            if (key[j] == T && pe < need_eq) sel[cgt + pe] = (unsigned short)(j * 64 + l);
            beq += __popcll(me);
        }
    }
}
__device__ __forceinline__ void bs_transpose32(unsigned (&A)[32]) {
    unsigned m = 0x0000FFFFu;
#pragma unroll
    for (int j = 16; j != 0; j >>= 1) {
#pragma unroll
        for (int k = 0; k < 32; ++k) {
            if ((k & j) == 0) {
                const unsigned t = (A[k] ^ (A[k + j] >> j)) & m;
                A[k] ^= t; A[k + j] ^= (t << j);
            }
        }
        m ^= (m << (j >> 1));
    }
}
__device__ __forceinline__ void select_row_bs(const float* row, int limit, unsigned short* sel, int l_in, unsigned short* stg) {
    int l = l_in; asm volatile("" : "+v"(l));
    const int nsl = limit >> 6;
    const int ng = limit >> 9;
    unsigned lo[32], hi[32];
#pragma unroll
    for (int jg = 0; jg < 8; ++jg) {
        if (jg <= ng) {
#pragma unroll
            for (int j = 8 * jg; j < 8 * jg + 8; ++j) { const int s = j * 64 + l; const unsigned u = __float_as_uint(row[s < limit ? s : 0]);
                if (j < 32) lo[j & 31] = u; else hi[j & 31] = u; }
        } else {
#pragma unroll
            for (int j = 8 * jg; j < 8 * jg + 8; ++j) { if (j < 32) lo[j & 31] = 0u; else hi[j & 31] = 0u; }
        }
    }
    asm volatile("" ::: "memory");
#pragma unroll
    for (int j = 0; j < 64; ++j) { const unsigned u = (j < 32) ? lo[j & 31] : hi[j & 31];
        const unsigned kx = (j < nsl) ? ((u & 0x80000000u) ? ~u : (u | 0x80000000u)) : 0u;
        if (j < 32) lo[j & 31] = kx; else hi[j & 31] = kx; }
    const bool has_hi = nsl > 32;
    bs_transpose32(lo);
    if (has_hi) bs_transpose32(hi);
    auto wave_count = [&](int v) -> int {
        v += __builtin_amdgcn_update_dpp(0, v, 0xB1, 0xf, 0xf, true); v += __builtin_amdgcn_update_dpp(0, v, 0x4E, 0xf, 0xf, true);
        v += __builtin_amdgcn_update_dpp(0, v, 0x141, 0xf, 0xf, true); v += __builtin_amdgcn_update_dpp(0, v, 0x140, 0xf, 0xf, true);
        return __builtin_amdgcn_readlane(v, 0) + __builtin_amdgcn_readlane(v, 16) + __builtin_amdgcn_readlane(v, 32) + __builtin_amdgcn_readlane(v, 48); };
    unsigned clo = 0xffffffffu, chi = has_hi ? 0xffffffffu : 0u, glo = 0u, ghi = 0u;
    int G = 0;
#pragma unroll
    for (int i = 0; i < 32; ++i) {
        const unsigned olo = clo & lo[i], ohi = chi & hi[i];
        const int tot = G + wave_count(__builtin_popcount(olo) + __builtin_popcount(ohi));
        const bool take = tot >= 256;
        const unsigned mt = take ? 0u : 0xffffffffu;
        G = take ? G : tot;
        glo |= olo & mt; ghi |= ohi & mt;
        clo = olo ^ (clo & mt); chi = ohi ^ (chi & mt);
        if (tot == 256) break;
    }
    {
        const int need = 256 - G;
        const int ceq = wave_count(__builtin_popcount(clo) + __builtin_popcount(chi));
        if (ceq == need) { glo |= clo; ghi |= chi; }
        else {
            int beq = 0;
#pragma unroll 1
            for (int k = 0; k < 64; ++k) {
                const unsigned bm = 0x80000000u >> (k & 31);
                const bool mine = ((k < 32 ? clo : chi) & bm) != 0u;
                const unsigned long long me = __ballot(mine);
                if (me != 0ull) {
                    const int pe = beq + (int)__builtin_amdgcn_mbcnt_hi((unsigned)(me >> 32), __builtin_amdgcn_mbcnt_lo((unsigned)me, 0u));
                    if (mine && pe < need) { if (k < 32) glo |= bm; else ghi |= bm; }
                    beq += __popcll(me);
                }
            }
        }
    }
    const int cl = __builtin_popcount(glo) + __builtin_popcount(ghi);
    int inc = cl;
#pragma unroll
    for (int o = 1; o < 64; o <<= 1) { const int t = __shfl_up(inc, o); inc += (l >= o) ? t : 0; }
    int pos = inc - cl;
    while (__ballot(glo != 0u) != 0ull) {
        if (glo != 0u) { const int s = __builtin_clz(glo); glo &= ~(0x80000000u >> s); stg[pos++] = (unsigned short)(s * 64 + l); }
    }
    while (__ballot(ghi != 0u) != 0ull) {
        if (ghi != 0u) { const int s = __builtin_clz(ghi); ghi &= ~(0x80000000u >> s); stg[pos++] = (unsigned short)((32 + s) * 64 + l); }
    }
    __builtin_amdgcn_fence(__ATOMIC_RELEASE, "wavefront"); __builtin_amdgcn_wave_barrier(); __builtin_amdgcn_fence(__ATOMIC_ACQUIRE, "wavefront");
    *(u32x2*)(sel + 4 * l) = *(const u32x2*)(stg + 4 * l);
    __builtin_amdgcn_fence(__ATOMIC_RELEASE, "wavefront"); __builtin_amdgcn_wave_barrier(); __builtin_amdgcn_fence(__ATOMIC_ACQUIRE, "wavefront");
}
__device__ __forceinline__ void topk_select(const Ctx& c, const float* __restrict__ SC, bf16* SEL  ) {
    const int l = c.lane;
    for (int m = c.gw; m < M; m += c.ngw) {
        const int b = m / SEQ, t = m % SEQ, limit = ((t >> 6) + 1) * 64;
        unsigned short* sel = (unsigned short*)SEL + (size_t)m * 256;
        if (limit <= 256) { for (int i = l; i < 256; i += 64) sel[i] = (unsigned short)(i < limit ? i : 0); continue; }
        select_row(SC + sc_row_off(b, t), limit, sel, l);
    }
}
__device__ __forceinline__ void dsa_attn_simple(const Ctx& c, const bf16* __restrict__ QALL, const bf16* __restrict__ KF, const bf16* __restrict__ SEL, bf16* OLY, int mmax = M) {
    float* qf = (float*)c.lds;
    float* P = qf + 8 * 288;
    int* sl = (int*)(P + 8 * 256);
    const float scale = 0.08838834764831845f;
    for (int m = c.bid; m < mmax; m += c.nb) {
        const int b = m / SEQ, t = m % SEQ, limit = ((t >> 6) + 1) * 64, cnt = limit < 256 ? limit : 256;
        __syncthreads();
        for (int i = c.tid; i < 8 * 288; i += NTHR) { const int h = i / 288, d = i % 288; qf[i] = bf2f(d < 256 ? QALL[(size_t)m * QC + h * 256 + d] : QALL[(size_t)m * QC + 2048 + h * 32 + (d - 256)]); }
        if (c.tid < 256) sl[c.tid] = (int)((const unsigned short*)SEL)[(size_t)m * 256 + c.tid];
        __syncthreads();
        if (c.tid < 256) {
            float acc[8];
#pragma unroll
            for (int h = 0; h < 8; ++h) acc[h] = 0.f;
            if (c.tid < cnt) {
                const u32x4* kp = (const u32x4*)(KF + (size_t)(b * SEQ + sl[c.tid]) * KFW);
                for (int ch = 0; ch < 36; ++ch) { float k[8]; unpack8(kp[ch], k);
#pragma unroll
                    for (int h = 0; h < 8; ++h) { const float* q = qf + h * 288 + ch * 8;
#pragma unroll
                        for (int j = 0; j < 8; ++j) acc[h] += k[j] * q[j]; } }
            }
#pragma unroll
            for (int h = 0; h < 8; ++h) P[h * 256 + c.tid] = (c.tid < cnt) ? acc[h] * scale : -INFINITY;
        }
        __syncthreads();
        {
            const int h = c.wave; float v[4]; float mx = -INFINITY;
#pragma unroll
            for (int i = 0; i < 4; ++i) { v[i] = P[h * 256 + c.lane + 64 * i]; mx = fmaxf(mx, v[i]); }
            mx = wave_max(mx); float s = 0.f;
#pragma unroll
            for (int i = 0; i < 4; ++i) { v[i] = __expf(v[i] - mx); s += v[i]; }
            s = wave_sum(s); const float inv = 1.f / s;
#pragma unroll
            for (int i = 0; i < 4; ++i) P[h * 256 + c.lane + 64 * i] = v[i] * inv;
        }
        __syncthreads();
        {
            const int r = c.tid & 255, hg = c.tid >> 8; float o[4] = {0.f, 0.f, 0.f, 0.f};
            for (int i = 0; i < cnt; ++i) { const float v = bf2f(KF[(size_t)(b * SEQ + sl[i]) * KFW + r]);
#pragma unroll
                for (int hh = 0; hh < 4; ++hh) o[hh] += P[(hg * 4 + hh) * 256 + i] * v; }
#pragma unroll
            for (int hh = 0; hh < 4; ++hh) OLY[(size_t)m * OC + (hg * 4 + hh) * 256 + r] = (bf16)f2bf(o[hh]);
        }
    }
}
__device__ __forceinline__ void xattn_simple(const Ctx& c, const bf16* __restrict__ XQ, const bf16* __restrict__ KVBIG, int layer, bf16* XO) {
    float* qf = (float*)c.lds;
    float* P = qf + 512;
    const float scale = 0.08838834764831845f;
    for (int m = c.bid; m < M; m += c.nb) {
        const int b = m / SEQ;
        const bf16* kvb = KVBIG + (size_t)(layer * 2048 + b * 256) * 4096 + layer * 1024;
        __syncthreads();
        qf[c.tid] = bf2f(XQ[(size_t)m * 512 + c.tid]);
        __syncthreads();
        {
            const int j = c.tid & 255, hp = c.tid >> 8;
#pragma unroll
            for (int hh = 0; hh < 2; ++hh) { const int h = hp * 2 + hh; const u32x4* kp = (const u32x4*)(kvb + (size_t)j * 4096 + h * 128); float d = 0.f;
                for (int ch = 0; ch < 16; ++ch) { float k[8]; unpack8(kp[ch], k);
#pragma unroll
                    for (int e = 0; e < 8; ++e) d += k[e] * qf[h * 128 + ch * 8 + e]; }
                P[h * 256 + j] = d * scale; }
        }
        __syncthreads();
        if (c.wave < 4) { const int h = c.wave; float v[4]; float mx = -INFINITY;
#pragma unroll
            for (int i = 0; i < 4; ++i) { v[i] = P[h * 256 + c.lane + 64 * i]; mx = fmaxf(mx, v[i]); }
            mx = wave_max(mx); float s = 0.f;
#pragma unroll
            for (int i = 0; i < 4; ++i) { v[i] = __expf(v[i] - mx); s += v[i]; }
            s = wave_sum(s); const float inv = 1.f / s;
#pragma unroll
            for (int i = 0; i < 4; ++i) P[h * 256 + c.lane + 64 * i] = v[i] * inv; }
        __syncthreads();
        {   const int h = c.tid >> 7; float o = 0.f;
            for (int j = 0; j < 256; ++j) o += P[h * 256 + j] * bf2f(kvb[(size_t)j * 4096 + 512 + c.tid]);
            XO[(size_t)m * 512 + c.tid] = (bf16)f2bf(o); }
    }
}
typedef short bf16x8 __attribute__((ext_vector_type(8)));
typedef short bf16x4 __attribute__((ext_vector_type(4)));
__device__ __forceinline__ bf16x4 tr_read4(const unsigned char* p) { return __builtin_amdgcn_ds_read_tr16_b64_v4i16((LAS bf16x4*)p); }
__device__ __forceinline__ bf16x8 cat8(bf16x4 a, bf16x4 b) { return __builtin_shufflevector(a, b, 0, 1, 2, 3, 4, 5, 6, 7); }
__device__ __forceinline__ bf16x8 pack_p8(const f32x4 a, const f32x4 b) {
    u32x4 w; w.x = pg8::cvt_pk_bf16(a[0], a[1]); w.y = pg8::cvt_pk_bf16(a[2], a[3]); w.z = pg8::cvt_pk_bf16(b[0], b[1]); w.w = pg8::cvt_pk_bf16(b[2], b[3]);
    return __builtin_bit_cast(bf16x8, w);
}
__device__ __forceinline__ bf16x8 rope_frag(const bf16x8 xf, const bf16x8 pf, const float* cs, const float* sn, bool lo) {
    float x[8], p[8]; unpack8(__builtin_bit_cast(u32x4, xf), x); unpack8(__builtin_bit_cast(u32x4, pf), p);
    const float sg = lo ? -1.f : 1.f; float o[8];
#pragma unroll
    for (int j = 0; j < 8; ++j) o[j] = x[j] * cs[j] + sg * p[j] * sn[j];
    u32x4 w; w.x = pg8::cvt_pk_bf16(o[0], o[1]); w.y = pg8::cvt_pk_bf16(o[2], o[3]); w.z = pg8::cvt_pk_bf16(o[4], o[5]); w.w = pg8::cvt_pk_bf16(o[6], o[7]);
    return __builtin_bit_cast(bf16x8, w);
}
__device__ __forceinline__ bf16x8 xchg_frag(const bf16x8 v, int lane_xor) { u32x4 u = __builtin_bit_cast(u32x4, v); u32x4 r;
    r.x = (unsigned)__shfl_xor((int)u.x, lane_xor); r.y = (unsigned)__shfl_xor((int)u.y, lane_xor); r.z = (unsigned)__shfl_xor((int)u.z, lane_xor); r.w = (unsigned)__shfl_xor((int)u.w, lane_xor); return __builtin_bit_cast(bf16x8, r); }
constexpr int XA_PITCH = 272;
__device__ __forceinline__ void xattn_mfma(const Ctx& c, const bf16* __restrict__ XQ, const bf16* __restrict__ KVBIG, int layer, bf16* XO) {
    unsigned char* Kl = c.lds; unsigned char* Vl = c.lds + 256 * XA_PITCH;
    const int l = c.lane, n16 = l & 15, g = l >> 4;
    const float scale = 0.08838834764831845f * 1.4426950408889634f;
    for (int unit = c.bid; unit < 256; unit += c.nb) {
        const int b = unit >> 5, h = (unit >> 3) & 3, qc = unit & 7;
        const bf16* kvb = KVBIG + (size_t)(layer * 2048 + b * 256) * 4096 + layer * 1024 + h * 128;
        __syncthreads();
        for (int i = c.tid; i < 4096; i += NTHR) { const int row = i >> 4, ch = i & 15;
            *(u32x4*)(Kl + row * XA_PITCH + ch * 16) = *(const u32x4*)(kvb + (size_t)row * 4096 + ch * 8);
            *(u32x4*)(Vl + row * XA_PITCH + ch * 16) = *(const u32x4*)(kvb + (size_t)row * 4096 + 512 + ch * 8); }
        __syncthreads();
#pragma unroll 1
        for (int g4 = 0; g4 < 4; ++g4) {
            const size_t m = (size_t)b * SEQ + qc * 512 + c.wave * 64 + g4 * 16 + n16;
            bf16x8 Qb[4];
#pragma unroll
            for (int kk = 0; kk < 4; ++kk) Qb[kk] = *(const bf16x8*)(XQ + m * 512 + h * 128 + 32 * kk + 8 * g);
            f32x4 S[16];
#pragma unroll
            for (int j = 0; j < 16; ++j) { S[j] = (f32x4){0.f, 0.f, 0.f, 0.f};
#pragma unroll
                for (int kk = 0; kk < 4; ++kk) { const bf16x8 A = *(const bf16x8*)(Kl + (16 * j + n16) * XA_PITCH + (32 * kk + 8 * g) * 2);
                    S[j] = __builtin_amdgcn_mfma_f32_16x16x32_bf16(A, Qb[kk], S[j], 0, 0, 0); } }
            float mx = -INFINITY;
#pragma unroll
            for (int j = 0; j < 16; ++j) mx = fmaxf(mx, fmaxf(fmaxf(S[j][0], S[j][1]), fmaxf(S[j][2], S[j][3])));
            mx = fmaxf(mx, __shfl_xor(mx, 16)); mx = fmaxf(mx, __shfl_xor(mx, 32));
            float sum = 0.f; const float mo = mx * scale;
#pragma unroll
            for (int j = 0; j < 16; ++j) {
#pragma unroll
                for (int r = 0; r < 4; ++r) { const float p = __builtin_amdgcn_exp2f(S[j][r] * scale - mo); S[j][r] = p; sum += p; } }
            sum += __shfl_xor(sum, 16); sum += __shfl_xor(sum, 32);
            const float inv = 1.f / sum;
            bf16x8 Pb[8];
#pragma unroll
            for (int jj = 0; jj < 8; ++jj) Pb[jj] = pack_p8(S[2 * jj], S[2 * jj + 1]);
            const int q4 = n16 >> 2, p4 = l & 3;
#pragma unroll
            for (int dt = 0; dt < 8; ++dt) { f32x4 O = (f32x4){0.f, 0.f, 0.f, 0.f};
#pragma unroll
                for (int jj = 0; jj < 8; ++jj) { const unsigned char* vp = Vl + (32 * jj + 4 * g + q4) * XA_PITCH + (16 * dt) * 2 + 8 * p4;
                    const bf16x8 A = cat8(tr_read4(vp), tr_read4(vp + 16 * XA_PITCH));
                    O = __builtin_amdgcn_mfma_f32_16x16x32_bf16(A, Pb[jj], O, 0, 0, 0); }
                u32x2 w; w.x = pg8::cvt_pk_bf16(O[0] * inv, O[1] * inv); w.y = pg8::cvt_pk_bf16(O[2] * inv, O[3] * inv);
                *(u32x2*)(XO + m * 512 + h * 128 + 16 * dt + 4 * g) = w; }
        }
    }
}
__device__ __forceinline__ void diag_cmp_bf16(const Ctx& c, const bf16* A, int lda, const bf16* B, int ldb, int rows, int cols, float* acc) {
    float d2 = 0.f, a2 = 0.f;
    const size_t n = (size_t)rows * cols;
    for (size_t i = (size_t)c.bid * NTHR + c.tid; i < n; i += (size_t)c.nb * NTHR) { const size_t r = i / cols, cc = i % cols; const float a = bf2f(A[r * lda + cc]), b = bf2f(B[r * ldb + cc]); d2 += (a - b) * (a - b); a2 += a * a; }
    d2 = wave_sum(d2); a2 = wave_sum(a2);
    if (c.lane == 0) { atomicAdd(acc, d2); atomicAdd(acc + 1, a2); }
}
constexpr int DA_PITCH = 528, DA_WAVE_BYTES = 32 * DA_PITCH;
__device__ __forceinline__ void dsa_attn_mfma(const Ctx& c, const bf16* __restrict__ QALL, const bf16* __restrict__ KF, const bf16* __restrict__ SEL, const float* __restrict__ ROPEA, bf16* OLY, int m_first, int m_stride, int m_end) {
    unsigned char* Vw = c.lds + c.wave * DA_WAVE_BYTES;
    const int l = c.lane, n16 = l & 15, g = l >> 4, q4 = n16 >> 2, p4 = l & 3, hh = n16 & 7;
    const float scale = 0.08838834764831845f * 1.4426950408889634f;
#pragma unroll 1
    for (int m = m_first; m < m_end; m += m_stride) {
        const int b = m / SEQ, t = m % SEQ, limit = ((t >> 6) + 1) * 64, cnt = limit < 256 ? limit : 256, nblk = cnt >> 5;
        const bf16* qrow = QALL + (size_t)m * QC;
        bf16x8 Qb[9];
#pragma unroll
        for (int kk = 0; kk < 8; ++kk) Qb[kk] = *(const bf16x8*)(qrow + hh * 256 + 32 * kk + 8 * g);
        Qb[8] = *(const bf16x8*)(qrow + 2048 + hh * 32 + 8 * g);
        {
            const bf16x8 pf = xchg_frag(Qb[8], 32); float cs[8], sn[8];
            const f32x4 c0 = *(const f32x4*)(ROPEA + (size_t)m * 32 + 8 * (g & 1)), c1 = *(const f32x4*)(ROPEA + (size_t)m * 32 + 8 * (g & 1) + 4), s0 = *(const f32x4*)(ROPEA + (size_t)m * 32 + 16 + 8 * (g & 1)), s1 = *(const f32x4*)(ROPEA + (size_t)m * 32 + 16 + 8 * (g & 1) + 4);
            cs[0] = c0.x; cs[1] = c0.y; cs[2] = c0.z; cs[3] = c0.w; cs[4] = c1.x; cs[5] = c1.y; cs[6] = c1.z; cs[7] = c1.w; sn[0] = s0.x; sn[1] = s0.y; sn[2] = s0.z; sn[3] = s0.w; sn[4] = s1.x; sn[5] = s1.y; sn[6] = s1.z; sn[7] = s1.w;
            Qb[8] = rope_frag(Qb[8], pf, cs, sn, g < 2); }
        f32x4 O[16];
#pragma unroll
        for (int dt = 0; dt < 16; ++dt) O[dt] = (f32x4){0.f, 0.f, 0.f, 0.f};
        float mrun = -INFINITY, lrun = 0.f;
        const unsigned short* selp = (const unsigned short*)SEL + (size_t)m * 256;
        const bf16* kfb = KF + (size_t)b * SEQ * KFW;
        bf16x8 K0[9], K1[9];
        int sx0, sx1;
#define DA_IDX(BLK) do { sx0 = selp[32 * (BLK) + n16]; sx1 = selp[32 * (BLK) + 16 + n16]; } while (0)
#define DA_GATHER() do { const bf16* r0_ = kfb + (size_t)sx0 * KFW + 8 * g; const bf16* r1_ = kfb + (size_t)sx1 * KFW + 8 * g; \
            _Pragma("unroll") for (int kk = 0; kk < 9; ++kk) { K0[kk] = *(const bf16x8*)(r0_ + 32 * kk); K1[kk] = *(const bf16x8*)(r1_ + 32 * kk); } } while (0)
        DA_IDX(0); DA_GATHER(); DA_IDX(nblk > 1 ? 1 : 0);
#pragma unroll 1
        for (int blk = 0; blk < nblk; ++blk) {
            f32x4 S0 = (f32x4){0.f, 0.f, 0.f, 0.f}, S1 = (f32x4){0.f, 0.f, 0.f, 0.f};
#pragma unroll
            for (int kk = 0; kk < 9; ++kk) { S0 = __builtin_amdgcn_mfma_f32_16x16x32_bf16(K0[kk], Qb[kk], S0, 0, 0, 0); S1 = __builtin_amdgcn_mfma_f32_16x16x32_bf16(K1[kk], Qb[kk], S1, 0, 0, 0); }
#pragma unroll
            for (int kk = 0; kk < 8; ++kk) { *(bf16x8*)(Vw + n16 * DA_PITCH + (32 * kk + 8 * g) * 2) = K0[kk]; *(bf16x8*)(Vw + (16 + n16) * DA_PITCH + (32 * kk + 8 * g) * 2) = K1[kk]; }
            __builtin_amdgcn_sched_barrier(0);
            if (blk + 1 < nblk) { DA_GATHER(); DA_IDX(blk + 2 < nblk ? blk + 2 : blk + 1); }
            __builtin_amdgcn_sched_barrier(0);
            float bm = fmaxf(fmaxf(fmaxf(S0[0], S0[1]), fmaxf(S0[2], S0[3])), fmaxf(fmaxf(S1[0], S1[1]), fmaxf(S1[2], S1[3])));
            bm = fmaxf(bm, __shfl_xor(bm, 16)); bm = fmaxf(bm, __shfl_xor(bm, 32));
            const float mnew = fmaxf(mrun, bm), alpha = __builtin_amdgcn_exp2f((mrun - mnew) * scale), mo = mnew * scale; mrun = mnew;
            float ps = 0.f;
#pragma unroll
            for (int r = 0; r < 4; ++r) { S0[r] = __builtin_amdgcn_exp2f(S0[r] * scale - mo); S1[r] = __builtin_amdgcn_exp2f(S1[r] * scale - mo); ps += S0[r] + S1[r]; }
            lrun = lrun * alpha + ps;
            const bf16x8 Pb = pack_p8(S0, S1);
#pragma unroll
            for (int dt = 0; dt < 16; ++dt) { O[dt] = O[dt] * alpha;
                const unsigned char* vp = Vw + (4 * g + q4) * DA_PITCH + (16 * dt) * 2 + 8 * p4;
                const bf16x8 A = cat8(tr_read4(vp), tr_read4(vp + 16 * DA_PITCH));
                O[dt] = __builtin_amdgcn_mfma_f32_16x16x32_bf16(A, Pb, O[dt], 0, 0, 0); }
        }
#undef DA_GATHER
#undef DA_IDX
        lrun += __shfl_xor(lrun, 16); lrun += __shfl_xor(lrun, 32);
        const float inv = 1.f / lrun;
        if (n16 < 8) {
            bf16* orow = OLY + (size_t)m * OC + n16 * 256 + 4 * g;
#pragma unroll
            for (int dt = 0; dt < 16; ++dt) { u32x2 w; w.x = pg8::cvt_pk_bf16(O[dt][0] * inv, O[dt][1] * inv); w.y = pg8::cvt_pk_bf16(O[dt][2] * inv, O[dt][3] * inv); *(u32x2*)(orow + 16 * dt) = w; }
        }
    }
}
__device__ __forceinline__ void dsa_attn_queue(const Ctx& c, const bf16* __restrict__ QALL, const bf16* __restrict__ KF, const bf16* __restrict__ SEL, const float* __restrict__ ROPEA, bf16* OLY, unsigned* counter, volatile LAS unsigned* slot) {
    for (;;) {
        __syncthreads();
        if (c.tid == 0) *slot = __hip_atomic_fetch_add(counter, 1u, __ATOMIC_RELAXED, __HIP_MEMORY_SCOPE_AGENT);
        __syncthreads();
        const int chunk = (int)*slot;
        if (chunk >= M / 16) break;
        dsa_attn_mfma(c, QALL, KF, SEL, ROPEA, OLY, chunk * 16 + c.wave, 8, chunk * 16 + 16);
    }
}
__device__ __forceinline__ float relu1(float x) { const int b = __builtin_bit_cast(int, x); return __builtin_bit_cast(float, b > 0 ? b : 0); }
__device__ __forceinline__ void idx_topk_mfma(const Ctx& c, const bf16* __restrict__ QALL, const bf16* __restrict__ KIDX, const float* __restrict__ WIDX, const float* __restrict__ ROPEI, float* scr, bf16* SEL, int nitems) {
    const int l = c.lane, n16 = l & 15, g = l >> 4, qg = c.wave & 3, kh = c.wave >> 2;
#pragma unroll 1
    for (int item = c.bid; item < nitems; item += c.nb) {
        const int b = item >> 5, pr = item & 31;
#pragma unroll 1
        for (int which = 0; which < 2; ++which) {
            const int ch = which ? 63 - pr : pr, L = 64 * (ch + 1), t0 = 64 * ch;
            if (L > 256) {
            const size_t m = (size_t)b * SEQ + t0 + 16 * qg + n16;
            float* srow = scr + (size_t)(16 * qg + n16) * L + 4 * g;
            const int nt = L >> 5, j0 = kh * nt, j1 = j0 + nt;
            const bf16* kp = KIDX + ((size_t)b * SEQ + n16) * 64 + 8 * g;
            {
                bf16x8 Qi[16][2]; float w[16];
                { const bf16* qp = QALL + m * QC + 2304 + 8 * g;
#pragma unroll
                  for (int h = 0; h < 16; ++h) { Qi[h][0] = *(const bf16x8*)(qp + h * 64); Qi[h][1] = *(const bf16x8*)(qp + h * 64 + 32); }
                  {
                      float cs[8], sn[8]; const f32x4 c0 = *(const f32x4*)(ROPEI + m * 16), c1 = *(const f32x4*)(ROPEI + m * 16 + 4), s0 = *(const f32x4*)(ROPEI + m * 16 + 8), s1 = *(const f32x4*)(ROPEI + m * 16 + 12);
                      cs[0] = c0.x; cs[1] = c0.y; cs[2] = c0.z; cs[3] = c0.w; cs[4] = c1.x; cs[5] = c1.y; cs[6] = c1.z; cs[7] = c1.w; sn[0] = s0.x; sn[1] = s0.y; sn[2] = s0.z; sn[3] = s0.w; sn[4] = s1.x; sn[5] = s1.y; sn[6] = s1.z; sn[7] = s1.w;
#pragma unroll
                      for (int h = 0; h < 16; ++h) { const bf16x8 pf = xchg_frag(Qi[h][0], 16); const bf16x8 rf = rope_frag(Qi[h][0], pf, cs, sn, g == 0); if (g < 2) Qi[h][0] = rf; } }
                  const f32x4* wp = (const f32x4*)(WIDX + m * 16);
#pragma unroll
                  for (int q = 0; q < 4; ++q) { const f32x4 v = wp[q]; w[4 * q] = v.x; w[4 * q + 1] = v.y; w[4 * q + 2] = v.z; w[4 * q + 3] = v.w; } }
                bf16x8 Ka = *(const bf16x8*)(kp + (size_t)j0 * 1024), Kb = *(const bf16x8*)(kp + (size_t)j0 * 1024 + 32);
#pragma unroll 1
                for (int j = j0; j < j1; ++j) {
                    const int jn = (j + 1 < j1) ? j + 1 : j;
                    const bf16x8 Na = *(const bf16x8*)(kp + (size_t)jn * 1024), Nb = *(const bf16x8*)(kp + (size_t)jn * 1024 + 32);
                    f32x2 s01 = (f32x2){0.f, 0.f}, s23 = (f32x2){0.f, 0.f};
                    f32x4 a = __builtin_amdgcn_mfma_f32_16x16x32_bf16(Ka, Qi[0][0], (f32x4){0.f, 0.f, 0.f, 0.f}, 0, 0, 0); a = __builtin_amdgcn_mfma_f32_16x16x32_bf16(Kb, Qi[0][1], a, 0, 0, 0);
#pragma unroll
                    for (int h = 0; h < 16; ++h) { f32x4 an = a;
                        if (h < 15) { an = __builtin_amdgcn_mfma_f32_16x16x32_bf16(Ka, Qi[h + 1][0], (f32x4){0.f, 0.f, 0.f, 0.f}, 0, 0, 0); an = __builtin_amdgcn_mfma_f32_16x16x32_bf16(Kb, Qi[h + 1][1], an, 0, 0, 0); }
                        const f32x2 wv = (f32x2){w[h], w[h]};
                        s01 = (f32x2){relu1(a[0]), relu1(a[1])} * wv + s01; s23 = (f32x2){relu1(a[2]), relu1(a[3])} * wv + s23; a = an; }
                    *(f32x4*)(srow + 16 * j) = (f32x4){s01.x, s01.y, s23.x, s23.y};
                    Ka = Na; Kb = Nb;
                }
            }
            }
            asm volatile("s_waitcnt vmcnt(0)" ::: "memory");
            __syncthreads();
            __builtin_amdgcn_fence(__ATOMIC_ACQUIRE, "agent");
            asm volatile("s_waitcnt vmcnt(0)" ::: "memory");
#pragma unroll 1
            for (int i = 0; i < 8; ++i) {
                const int ql = c.wave * 8 + i;
                unsigned short* sel = (unsigned short*)SEL + ((size_t)b * SEQ + t0 + ql) * 256;
                if (L <= 256) { for (int k = l; k < 256; k += 64) sel[k] = (unsigned short)(k < L ? k : 0); }
                else select_row_bs(scr + (size_t)ql * L, L, sel, l, (unsigned short*)(c.lds + c.wave * 512));
            }
            __syncthreads();
        }
    }
}
__device__ __forceinline__ void diag_cmp_sel(const Ctx& c, const bf16* SA, const bf16* SB, int nbatch, float* acc) {
    unsigned* bm = (unsigned*)(c.lds + c.wave * 512);
    float miss = 0.f, tot = 0.f;
    for (int m = c.gw; m < nbatch * SEQ; m += c.ngw) {
        const int t = m % SEQ; if (t < 256) continue;
        bm[c.lane] = 0u; bm[64 + c.lane] = 0u;
        __builtin_amdgcn_fence(__ATOMIC_RELEASE, "wavefront"); __builtin_amdgcn_wave_barrier();
        for (int i = c.lane; i < 256; i += 64) { const unsigned s = ((const unsigned short*)SA)[(size_t)m * 256 + i]; atomicOr(&bm[s >> 5], 1u << (s & 31)); }
        __builtin_amdgcn_fence(__ATOMIC_RELEASE, "wavefront"); __builtin_amdgcn_wave_barrier(); __builtin_amdgcn_fence(__ATOMIC_ACQUIRE, "wavefront");
        for (int i = c.lane; i < 256; i += 64) { const unsigned s = ((const unsigned short*)SB)[(size_t)m * 256 + i]; miss += ((bm[s >> 5] >> (s & 31)) & 1u) ? 0.f : 1.f; tot += 1.f; }
        __builtin_amdgcn_fence(__ATOMIC_RELEASE, "wavefront"); __builtin_amdgcn_wave_barrier();
    }
    miss = wave_sum(miss); tot = wave_sum(tot);
    if (c.lane == 0) { atomicAdd(acc, miss); atomicAdd(acc + 1, tot); }
}
__device__ __forceinline__ void idx_topk_lds(const Ctx& c, const bf16* __restrict__ QALL, const bf16* __restrict__ KIDX, const float* __restrict__ WIDX, const float* __restrict__ ROPEI, u32x4* qscr, bf16* SEL, int nitems) {
    float* SCL = (float*)c.lds;
    f32x4* WL = (f32x4*)(c.lds + 131072);
    const int w8 = c.wave;
#pragma unroll 1
    for (int item = c.bid; item < nitems; item += c.nb) {
        const int b = item >> 5, pr = item & 31;
#pragma unroll 1
        for (int which = 0; which < 2; ++which) {
            int l = c.lane; asm volatile("" : "+v"(l));
            const int n16 = l & 15, g = l >> 4;
            const int ch = which ? 63 - pr : pr, L = 64 * (ch + 1), t0 = 64 * ch;
            if (L <= 256) {
#pragma unroll 1
                for (int i = 0; i < 8; ++i) { unsigned short* sel = (unsigned short*)SEL + ((size_t)b * SEQ + t0 + w8 * 8 + i) * 256; for (int k = l; k < 256; k += 64) sel[k] = (unsigned short)(k < L ? k : 0); }
                continue;
            }
            __syncthreads();
            if (w8 < 4) {
                const size_t m = (size_t)b * SEQ + t0 + 16 * w8 + n16;
                const bf16* qp = QALL + m * QC + 2304 + 8 * g;
                float cs[8], sn[8]; const f32x4 c0 = *(const f32x4*)(ROPEI + m * 16), c1 = *(const f32x4*)(ROPEI + m * 16 + 4), s0 = *(const f32x4*)(ROPEI + m * 16 + 8), s1 = *(const f32x4*)(ROPEI + m * 16 + 12);
                cs[0] = c0.x; cs[1] = c0.y; cs[2] = c0.z; cs[3] = c0.w; cs[4] = c1.x; cs[5] = c1.y; cs[6] = c1.z; cs[7] = c1.w; sn[0] = s0.x; sn[1] = s0.y; sn[2] = s0.z; sn[3] = s0.w; sn[4] = s1.x; sn[5] = s1.y; sn[6] = s1.z; sn[7] = s1.w;
#pragma unroll 4
                for (int h = 0; h < 16; ++h) { bf16x8 f0 = *(const bf16x8*)(qp + h * 64); const bf16x8 f1 = *(const bf16x8*)(qp + h * 64 + 32);
                    const bf16x8 pf = xchg_frag(f0, 16); const bf16x8 rf = rope_frag(f0, pf, cs, sn, g == 0); if (g < 2) f0 = rf;
                    qscr[(w8 * 64 + l) * 32 + h * 2] = __builtin_bit_cast(u32x4, f0); qscr[(w8 * 64 + l) * 32 + h * 2 + 1] = __builtin_bit_cast(u32x4, f1); }
            }
            asm volatile("s_waitcnt vmcnt(0)" ::: "memory");
            __syncthreads();
            __builtin_amdgcn_fence(__ATOMIC_ACQUIRE, "agent"); asm volatile("s_waitcnt vmcnt(0)" ::: "memory");
            const bf16* kp = KIDX + ((size_t)b * SEQ + n16) * 64 + 8 * g;
            const int ntile = L >> 4;
#pragma unroll 1
            for (int qsub = 0; qsub < 8; ++qsub) {
                asm volatile("" ::: "memory");
                bf16x8 Qi[16][2];
                { const int srcl = g * 16 + (qsub & 1) * 8 + (n16 & 7); const u32x4* fp = qscr + (size_t)((qsub >> 1) * 64 + srcl) * 32;
#pragma unroll
                  for (int h = 0; h < 16; ++h) { Qi[h][0] = __builtin_bit_cast(bf16x8, fp[h * 2]); Qi[h][1] = __builtin_bit_cast(bf16x8, fp[h * 2 + 1]); }
                  if (w8 == 0 && l < 32) WL[l] = *(const f32x4*)(WIDX + ((size_t)b * SEQ + t0 + 8 * qsub + (l >> 2)) * 16 + 4 * (l & 3)); }
                __syncthreads();
                const f32x4* wq = WL + (n16 & 7) * 4;
                float* srow = SCL + (n16 & 7) * 4096 + 4 * g;
                int j = w8;
                bf16x8 Ka = *(const bf16x8*)(kp + (size_t)j * 1024), Kb = *(const bf16x8*)(kp + (size_t)j * 1024 + 32);
#pragma unroll 1
                for (; j < ntile; j += 8) {
                    const int jn = (j + 8 < ntile) ? j + 8 : j;
                    const bf16x8 Na = *(const bf16x8*)(kp + (size_t)jn * 1024), Nb = *(const bf16x8*)(kp + (size_t)jn * 1024 + 32);
                    f32x2 s01 = (f32x2){0.f, 0.f}, s23 = (f32x2){0.f, 0.f};
                    f32x4 a = __builtin_amdgcn_mfma_f32_16x16x32_bf16(Ka, Qi[0][0], (f32x4){0.f, 0.f, 0.f, 0.f}, 0, 0, 0); a = __builtin_amdgcn_mfma_f32_16x16x32_bf16(Kb, Qi[0][1], a, 0, 0, 0);
#pragma unroll
                    for (int h4 = 0; h4 < 4; ++h4) { const f32x4 w4 = wq[h4];
#pragma unroll
                        for (int hh = 0; hh < 4; ++hh) { const int h = 4 * h4 + hh; f32x4 an = a;
                            if (h < 15) { an = __builtin_amdgcn_mfma_f32_16x16x32_bf16(Ka, Qi[h + 1][0], (f32x4){0.f, 0.f, 0.f, 0.f}, 0, 0, 0); an = __builtin_amdgcn_mfma_f32_16x16x32_bf16(Kb, Qi[h + 1][1], an, 0, 0, 0); }
                            const f32x2 wv = (f32x2){w4[hh], w4[hh]};
                            s01 = (f32x2){relu1(a[0]), relu1(a[1])} * wv + s01; s23 = (f32x2){relu1(a[2]), relu1(a[3])} * wv + s23; a = an; } }
                    if (n16 < 8) *(f32x4*)(srow + 16 * j) = (f32x4){s01.x, s01.y, s23.x, s23.y};
                    Ka = Na; Kb = Nb;
                }
                __syncthreads();
                select_row(SCL + w8 * 4096, L, (unsigned short*)SEL + ((size_t)b * SEQ + t0 + 8 * qsub + w8) * 256, l);
                __syncthreads();
            }
        }
    }
}
#if DIAG == 7
__device__ __forceinline__ void select_row_v1(const float* row, int limit, unsigned short* sel, int l_in) {
    int l = l_in; asm volatile("" : "+v"(l));
    const int ng = limit >> 9;
    unsigned key[64];
#pragma unroll
    for (int j = 0; j < 64; ++j) { const int s = j * 64 + l; unsigned u = 0u; if (s < limit) { u = __float_as_uint(row[s]); u = (u & 0x80000000u) ? ~u : (u | 0x80000000u); } key[j] = u; }
    unsigned mx = 0u;
#pragma unroll
    for (int j = 0; j < 64; ++j) mx = key[j] > mx ? key[j] : mx;
#pragma unroll
    for (int o = 1; o < 64; o <<= 1) { const unsigned t = (unsigned)__shfl_xor((int)mx, o); mx = t > mx ? t : mx; }
    mx = (unsigned)__builtin_amdgcn_readfirstlane((int)mx);
    unsigned T = 0u;
#pragma unroll 1
    for (int bit = 31 - __builtin_clz(mx | 1u); bit >= 0; --bit) {
        const unsigned Tn = T | (1u << bit); int cnt = 0;
#pragma unroll
        for (int jg = 0; jg < 8; ++jg) if (jg <= ng) {
#pragma unroll
            for (int j = 8 * jg; j < 8 * jg + 8; ++j) cnt += __popcll(__ballot(key[j] >= Tn)); }
        if (cnt >= 256) T = Tn;
        if (cnt == 256) break;
    }
    int cgt = 0;
#pragma unroll
    for (int j = 0; j < 64; ++j) cgt += __popcll(__ballot(key[j] > T));
    const int need_eq = 256 - cgt;
    int base = 0, beq = 0;
    const unsigned long long lt = (1ull << l) - 1ull;
#pragma unroll
    for (int jg = 0; jg < 8; ++jg) if (jg <= ng) {
#pragma unroll
        for (int j = 8 * jg; j < 8 * jg + 8; ++j) {
            const unsigned long long mg = __ballot(key[j] > T), me = __ballot(key[j] == T);
            if (key[j] > T) sel[base + __popcll(mg & lt)] = (unsigned short)(j * 64 + l);
            base += __popcll(mg);
            const int pe = beq + __popcll(me & lt);
            if (key[j] == T && pe < need_eq) sel[cgt + pe] = (unsigned short)(j * 64 + l);
            beq += __popcll(me);
        }
    }
}
__device__ __forceinline__ void idx_topk_v1(const Ctx& c, const bf16* __restrict__ QALL, const bf16* __restrict__ KIDX, const float* __restrict__ WIDX, float* scr, bf16* SEL, int nitems) {
    const int l = c.lane, n16 = l & 15, g = l >> 4, qg = c.wave & 3, kh = c.wave >> 2;
#pragma unroll 1
    for (int item = c.bid; item < nitems; item += c.nb) {
        const int b = item >> 5, pr = item & 31;
#pragma unroll 1
        for (int which = 0; which < 2; ++which) {
            const int ch = which ? 63 - pr : pr, L = 64 * (ch + 1), t0 = 64 * ch;
            if (L > 256) {
            const size_t m = (size_t)b * SEQ + t0 + 16 * qg + n16;
            float* srow = scr + (size_t)(16 * qg + n16) * L + 4 * g;
            const int nt = L >> 5, j0 = kh * nt, j1 = j0 + nt;
            const bf16* kp = KIDX + ((size_t)b * SEQ + n16) * 64 + 8 * g;
#pragma unroll 1
            for (int hp = 0; hp < 2; ++hp) {
                bf16x8 Qi[8][2]; float w[8];
                { const bf16* qp = QALL + m * QC + 2304 + hp * 512 + 8 * g;
#pragma unroll
                  for (int h = 0; h < 8; ++h) { Qi[h][0] = *(const bf16x8*)(qp + h * 64); Qi[h][1] = *(const bf16x8*)(qp + h * 64 + 32); }
                  const f32x4* wp = (const f32x4*)(WIDX + m * 16 + hp * 8);
#pragma unroll
                  for (int q = 0; q < 2; ++q) { const f32x4 v = wp[q]; w[4 * q] = v.x; w[4 * q + 1] = v.y; w[4 * q + 2] = v.z; w[4 * q + 3] = v.w; } }
                if (hp) { asm volatile("s_waitcnt vmcnt(0)" ::: "memory"); __builtin_amdgcn_fence(__ATOMIC_ACQUIRE, "agent"); asm volatile("s_waitcnt vmcnt(0)" ::: "memory"); }
                bf16x8 Ka = *(const bf16x8*)(kp + (size_t)j0 * 1024), Kb = *(const bf16x8*)(kp + (size_t)j0 * 1024 + 32);
                f32x4 pv = (f32x4){0.f, 0.f, 0.f, 0.f}; if (hp) pv = *(const f32x4*)(srow + 16 * j0);
#pragma unroll 1
                for (int j = j0; j < j1; ++j) {
                    const int jn = (j + 1 < j1) ? j + 1 : j;
                    const bf16x8 Na = *(const bf16x8*)(kp + (size_t)jn * 1024), Nb = *(const bf16x8*)(kp + (size_t)jn * 1024 + 32);
                    f32x4 pn = (f32x4){0.f, 0.f, 0.f, 0.f}; if (hp) pn = *(const f32x4*)(srow + 16 * jn);
                    f32x4 sc = pv;
#pragma unroll
                    for (int h = 0; h < 8; ++h) { f32x4 a = __builtin_amdgcn_mfma_f32_16x16x32_bf16(Ka, Qi[h][0], (f32x4){0.f, 0.f, 0.f, 0.f}, 0, 0, 0); a = __builtin_amdgcn_mfma_f32_16x16x32_bf16(Kb, Qi[h][1], a, 0, 0, 0);
                        sc[0] += w[h] * fmaxf(a[0], 0.f); sc[1] += w[h] * fmaxf(a[1], 0.f); sc[2] += w[h] * fmaxf(a[2], 0.f); sc[3] += w[h] * fmaxf(a[3], 0.f); }
                    *(f32x4*)(srow + 16 * j) = sc;
                    Ka = Na; Kb = Nb; pv = pn;
                }
            }
            }
            asm volatile("s_waitcnt vmcnt(0)" ::: "memory");
            __syncthreads();
            __builtin_amdgcn_fence(__ATOMIC_ACQUIRE, "agent");
            asm volatile("s_waitcnt vmcnt(0)" ::: "memory");
#pragma unroll 1
            for (int i = 0; i < 8; ++i) {
                const int ql = c.wave * 8 + i;
                unsigned short* sel = (unsigned short*)SEL + ((size_t)b * SEQ + t0 + ql) * 256;
                if (L <= 256) { for (int k = l; k < 256; k += 64) sel[k] = (unsigned short)(k < L ? k : 0); }
                else select_row_v1(scr + (size_t)ql * L, L, sel, l);
            }
            __syncthreads();
        }
    }
}
#endif
constexpr int RW_TB = 32;
struct RwkvP { const float *mu, *w0, *w2, *a0, *a2, *g2, *k_k, *k_a, *r_k, *ln_w, *ln_b; };
__device__ __forceinline__ void rwkv_phase(const Ctx& c, const bf16* __restrict__ H, const RwkvP P, bf16* OLY) {
    float* A_WR = (float*)c.lds;
    float* A_K2 = A_WR + RW_TB * 64;
    float* A_V = A_K2 + RW_TB * 64;
    float* A_W = A_V + RW_TB * 64;
    float* A_NKK = A_W + RW_TB * 64;
    float* A_B = A_NKK + RW_TB * 64;
    float* A_G = A_B + RW_TB * 64;
    float* A_OUT = A_G + RW_TB * 64;
    float* L_TW = A_OUT + RW_TB * 64;
    float* L_AL = L_TW + RW_TB * 64;
    float* L_SG = L_AL + RW_TB * 64;
    float* SC1 = L_SG + RW_TB * 160; float* SC2 = SC1 + RW_TB; float* SC3 = SC2 + RW_TB;
    const int l = c.lane, w = c.wave;
    for (int item = c.bid; item < NB * 16; item += c.nb) {
        const int b = item >> 4, h = item & 15, hk = h * 64 + l;
        const float w0v = P.w0[hk], a0v = P.a0[hk], kkv = P.k_k[hk], kav = P.k_a[hk], rkv = P.r_k[hk], lnw = P.ln_w[hk], lnb = P.ln_b[hk];
        float S[8];
#pragma unroll
        for (int i = 0; i < 8; ++i) S[i] = 0.f;
        const int srow = w * 8 + (l >> 3), sj = l & 7;
        for (int t0 = 0; t0 < SEQ; t0 += RW_TB) {
            __syncthreads();
            for (int idx = c.tid; idx < RW_TB * 480; idx += NTHR) {
                const int t = idx / 480, cc = idx % 480; int col; float* dst;
                if (cc < 64) { col = 880 + h * 64 + cc; dst = A_WR + t * 64 + cc; }
                else if (cc < 128) { col = 1904 + h * 64 + (cc - 64); dst = A_K2 + t * 64 + (cc - 64); }
                else if (cc < 192) { col = 2928 + h * 64 + (cc - 128); dst = A_V + t * 64 + (cc - 128); }
                else if (cc < 256) { col = 3952 + (cc - 192); dst = L_TW + t * 64 + (cc - 192); }
                else if (cc < 320) { col = 4016 + (cc - 256); dst = L_AL + t * 64 + (cc - 256); }
                else { col = 4080 + (cc - 320); dst = L_SG + t * 160 + (cc - 320); }
                const size_t m = (size_t)b * SEQ + t0 + t;
                const float x = bf2f(H[m * HC + col]); const float xp = (t0 + t > 0) ? bf2f(H[(m - 1) * HC + col]) : 0.f;
                float hm = x + (xp - x) * P.mu[col - 880];
                if (cc >= 192 && cc < 256) hm = tanhf(hm); else if (cc >= 320) hm = sigmoidf_(hm);
                *dst = hm;
            }
            __syncthreads();
            {
                float wl[RW_TB / 8], al[RW_TB / 8], gg[RW_TB / 8];
#pragma unroll
                for (int i = 0; i < RW_TB / 8; ++i) { wl[i] = 0.f; al[i] = 0.f; gg[i] = 0.f; }
                for (int j = 0; j < 64; ++j) { const float w2v = P.w2[(size_t)j * 1024 + hk], a2v = P.a2[(size_t)j * 1024 + hk];
#pragma unroll
                    for (int i = 0; i < RW_TB / 8; ++i) { wl[i] += L_TW[(w + 8 * i) * 64 + j] * w2v; al[i] += L_AL[(w + 8 * i) * 64 + j] * a2v; } }
                for (int j = 0; j < 160; ++j) { const float g2v = P.g2[(size_t)j * 1024 + hk];
#pragma unroll
                    for (int i = 0; i < RW_TB / 8; ++i) gg[i] += L_SG[(w + 8 * i) * 160 + j] * g2v; }
#pragma unroll
                for (int i = 0; i < RW_TB / 8; ++i) {
                    const int t = w + 8 * i, o = t * 64 + l;
                    const float dec = __expf(-0.6065306597126334f * sigmoidf_(w0v + wl[i]));
                    const float a = sigmoidf_(a0v + al[i]);
                    const float kr = A_K2[o], r = A_WR[o];
                    float kk = kr * kkv; const float nrm = wave_sum(kk * kk); kk = kk * (1.0f / sqrtf(fmaxf(nrm, 1e-24f)));
                    const float k2 = kr * (1.f + (a - 1.f) * kav), bb = kk * a;
                    const float s1 = wave_sum(bb * r), s2 = wave_sum(k2 * r), s3 = wave_sum(r * k2 * rkv);
                    A_W[o] = dec; A_NKK[o] = -kk; A_B[o] = bb; A_K2[o] = k2; A_WR[o] = dec * r; A_G[o] = gg[i];
                    if (l == 0) { SC1[t] = s1; SC2[t] = s2; SC3[t] = s3; }
                }
            }
            __syncthreads();
            for (int t = 0; t < RW_TB; ++t) {
                const f32x4* pw = (const f32x4*)(A_W + t * 64 + 8 * sj); const f32x4* pn = (const f32x4*)(A_NKK + t * 64 + 8 * sj); const f32x4* pb = (const f32x4*)(A_B + t * 64 + 8 * sj);
                const f32x4* pk = (const f32x4*)(A_K2 + t * 64 + 8 * sj); const f32x4* pr = (const f32x4*)(A_WR + t * 64 + 8 * sj);
                const f32x4 w0_ = pw[0], w1_ = pw[1], n0 = pn[0], n1 = pn[1], b0 = pb[0], b1 = pb[1], k0 = pk[0], k1 = pk[1], r0 = pr[0], r1 = pr[1];
                const float vv = A_V[t * 64 + srow], s1 = SC1[t], s2 = SC2[t];
                float sa = (S[0] * n0.x + S[1] * n0.y) + (S[2] * n0.z + S[3] * n0.w) + (S[4] * n1.x + S[5] * n1.y) + (S[6] * n1.z + S[7] * n1.w);
                float p = (S[0] * r0.x + S[1] * r0.y) + (S[2] * r0.z + S[3] * r0.w) + (S[4] * r1.x + S[5] * r1.y) + (S[6] * r1.z + S[7] * r1.w);
                sa += __shfl_xor(sa, 1); p += __shfl_xor(p, 1); sa += __shfl_xor(sa, 2); p += __shfl_xor(p, 2); sa += __shfl_xor(sa, 4); p += __shfl_xor(p, 4);
                S[0] = S[0] * w0_.x + (sa * b0.x + vv * k0.x); S[1] = S[1] * w0_.y + (sa * b0.y + vv * k0.y); S[2] = S[2] * w0_.z + (sa * b0.z + vv * k0.z); S[3] = S[3] * w0_.w + (sa * b0.w + vv * k0.w);
                S[4] = S[4] * w1_.x + (sa * b1.x + vv * k1.x); S[5] = S[5] * w1_.y + (sa * b1.y + vv * k1.y); S[6] = S[6] * w1_.z + (sa * b1.z + vv * k1.z); S[7] = S[7] * w1_.w + (sa * b1.w + vv * k1.w);
                if (sj == 0) A_OUT[t * 64 + srow] = p + sa * s1 + vv * s2;
            }
            __syncthreads();
#pragma unroll
            for (int i = 0; i < RW_TB / 8; ++i) {
                const int t = w + 8 * i, o = t * 64 + l;
                const float x = A_OUT[o]; const float mean = wave_sum(x) * (1.f / 64.f); const float dx = x - mean; const float var = wave_sum(dx * dx) * (1.f / 64.f);
                float y = dx * (1.0f / sqrtf(var + 64e-5f)) * lnw + lnb;
                y = (y + SC3[t] * A_V[o]) * A_G[o];
                OLY[((size_t)b * SEQ + t0 + t) * OC + 2048 + hk] = (bf16)f2bf(y);
            }
        }
    }
}

constexpr int S5_TB = 16;
struct S5P { const float *lam_re, *lam_im, *log_dt, *b_re, *b_im, *c_re, *c_im, *d; };
__device__ __forceinline__ float gelu_tanh(float y) { return 0.5f * y * (1.f + tanhf(0.7978845608028654f * (y + 0.044715f * y * y * y))); }
__device__ __forceinline__ void s5_phase(const Ctx& c, const bf16* __restrict__ U, const S5P P, bf16* Z) {
    constexpr int PERW = 256 + 2 * S5_TB * 65 + 2 * 64 * 16;
    float* UU = (float*)c.lds + c.wave * PERW;
    float* XSr = UU + 256; float* XSi = XSr + S5_TB * 65;
    float* CTr = XSi + S5_TB * 65; float* CTi = CTr + 64 * 16;
    const int l = c.lane;
    for (int item = c.bid; item < NB * 16; item += c.nb) {
        const int b = item >> 4, g = (item & 15) * 8 + c.wave;
        __syncthreads();
        float lbr, lbi, Br[16], Bi[16];
        {
            const float lr = fminf(P.lam_re[g * 64 + l], -1e-4f), li = P.lam_im[g * 64 + l], dt = expf(P.log_dt[g]);
            const float e = expf(lr * dt); lbr = e * cosf(li * dt); lbi = e * sinf(li * dt);
            const float nr = lbr - 1.f, ni = lbi, den = 1.f / (lr * lr + li * li);
            const float cr = (nr * lr + ni * li) * den, ci = (ni * lr - nr * li) * den;
#pragma unroll
            for (int i = 0; i < 16; ++i) { const float br = P.b_re[(size_t)(g * 64 + l) * 16 + i], bi = P.b_im[(size_t)(g * 64 + l) * 16 + i]; Br[i] = cr * br - ci * bi; Bi[i] = cr * bi + ci * br; }
#pragma unroll
            for (int o = 0; o < 16; ++o) { CTr[l * 16 + o] = P.c_re[(size_t)(g * 16 + o) * 64 + l]; CTi[l * 16 + o] = P.c_im[(size_t)(g * 16 + o) * 64 + l]; }
        }
        float dsk[4];
#pragma unroll
        for (int e = 0; e < 4; ++e) dsk[e] = P.d[g * 16 + (l >> 4) * 4 + e];
        float xr = 0.f, xi = 0.f;
        for (int t0 = 0; t0 < SEQ; t0 += S5_TB) {
            __syncthreads();
            { const int row = l >> 2, q = l & 3; const u32x2 w2 = *(const u32x2*)(U + ((size_t)b * SEQ + t0 + row) * D + g * 16 + 4 * q);
              float* d = UU + row * 16 + 4 * q; d[0] = bf2f(w2.x & 0xffffu); d[1] = bf2f(w2.x >> 16); d[2] = bf2f(w2.y & 0xffffu); d[3] = bf2f(w2.y >> 16); }
            __syncthreads();
            for (int t = 0; t < S5_TB; ++t) {
                const f32x4* up = (const f32x4*)(UU + t * 16); const f32x4 u0 = up[0], u1 = up[1], u2 = up[2], u3 = up[3];
                const float u[16] = {u0.x, u0.y, u0.z, u0.w, u1.x, u1.y, u1.z, u1.w, u2.x, u2.y, u2.z, u2.w, u3.x, u3.y, u3.z, u3.w};
                float bur = 0.f, bui = 0.f;
#pragma unroll
                for (int i = 0; i < 16; ++i) { bur += Br[i] * u[i]; bui += Bi[i] * u[i]; }
                const float nxr = lbr * xr - lbi * xi + bur, nxi = lbr * xi + lbi * xr + bui; xr = nxr; xi = nxi;
                XSr[t * 65 + l] = xr; XSi[t * 65 + l] = xi;
            }
            __syncthreads();
            {   const int t = l & 15, oq = l >> 4; float y[4] = {0.f, 0.f, 0.f, 0.f};
                for (int p = 0; p < 64; ++p) { const float a = XSr[t * 65 + p], bb = XSi[t * 65 + p]; const f32x4 cr = *(const f32x4*)(CTr + p * 16 + oq * 4), ci = *(const f32x4*)(CTi + p * 16 + oq * 4);
                    y[0] += a * cr.x - bb * ci.x; y[1] += a * cr.y - bb * ci.y; y[2] += a * cr.z - bb * ci.z; y[3] += a * cr.w - bb * ci.w; }
                float z[4];
#pragma unroll
                for (int e = 0; e < 4; ++e) z[e] = gelu_tanh(y[e] + dsk[e] * UU[t * 16 + oq * 4 + e]);
                u32x2 o; o.x = pk2(z[0], z[1]); o.y = pk2(z[2], z[3]);
                *(u32x2*)(Z + ((size_t)b * SEQ + t0 + t) * D + g * 16 + oq * 4) = o; }
        }
    }
}
template <int CTRL> __device__ __forceinline__ float dpp_mov(float v) { return __builtin_bit_cast(float, __builtin_amdgcn_update_dpp(0, __builtin_bit_cast(int, v), CTRL, 0xf, 0xf, true)); }
__device__ __forceinline__ float sum8(float v) { v += dpp_mov<0xB1>(v); v += dpp_mov<0x4E>(v); v += dpp_mov<0x141>(v); return v; }
__device__ __forceinline__ float wave_sum_fast(float v) { v += dpp_mov<0xB1>(v); v += dpp_mov<0x4E>(v); v += dpp_mov<0x141>(v); v += dpp_mov<0x140>(v); v += __shfl_xor(v, 16); v += __shfl_xor(v, 32); return v; }
__device__ __forceinline__ float fast_tanh(float x) { const float e = __expf(2.f * x); return 1.f - 2.f / (e + 1.f); }
__device__ __forceinline__ void rwkv_lora_prep(const Ctx& c, const bf16* __restrict__ H, const float* __restrict__ mu, bf16* LX) {
    const int l = c.lane;
    for (int m = c.gw; m < M; m += c.ngw) {
        if (l < 36) {
            const int col = 3952 + 8 * l; const int t = m % SEQ;
            float x[8], p[8]; unpack8(*(const u32x4*)(H + (size_t)m * HC + col), x);
            if (t > 0) unpack8(*(const u32x4*)(H + (size_t)(m - 1) * HC + col), p); else {
#pragma unroll
                for (int j = 0; j < 8; ++j) p[j] = 0.f; }
            const f32x4 m0 = *(const f32x4*)(mu + 3072 + 8 * l), m1 = *(const f32x4*)(mu + 3072 + 8 * l + 4);
            const float mv[8] = {m0.x, m0.y, m0.z, m0.w, m1.x, m1.y, m1.z, m1.w};
            float hm[8];
#pragma unroll
            for (int j = 0; j < 8; ++j) { float v = x[j] + (p[j] - x[j]) * mv[j]; if (l < 8) v = fast_tanh(v); else if (l >= 16) v = sigmoidf_(v); hm[j] = v; }
            u32x4 o; o.x = pg8::cvt_pk_bf16(hm[0], hm[1]); o.y = pg8::cvt_pk_bf16(hm[2], hm[3]); o.z = pg8::cvt_pk_bf16(hm[4], hm[5]); o.w = pg8::cvt_pk_bf16(hm[6], hm[7]);
            *(u32x4*)(LX + (size_t)m * 288 + 8 * l) = o;
        }
    }
}
constexpr int RW2_RAWP = 384;
constexpr int RW2_TWP = 144, RW2_SGP = 336;
__device__ __forceinline__ void rwkv_phase2(const Ctx& c, const bf16* __restrict__ H, const bf16* __restrict__ LX, const RwkvP P, bf16* OUT, int ldo, int coloff, int wb = NB) {
    unsigned char* RAW = c.lds;
    float* A_WR = (float*)(c.lds + 12800);
    float* A_K2 = A_WR + 2048; float* A_V = A_K2 + 2048; float* A_W = A_V + 2048; float* A_NKK = A_W + 2048; float* A_B = A_NKK + 2048; float* A_G = A_B + 2048; float* A_OUT = A_G + 2048;
    float* LO_W = A_OUT + 2048; float* LO_A = LO_W + 2048; float* PR3 = LO_A + 2048;
    unsigned char* L_TW = (unsigned char*)(PR3 + 2048); unsigned char* L_AL = L_TW + 32 * RW2_TWP; unsigned char* L_SG = L_AL + 32 * RW2_TWP;
    float* MU = (float*)(L_SG + 32 * RW2_SGP); float* SC3 = MU + 480 + 64;
    unsigned char* G2T = (unsigned char*)(SC3 + 32);
    float* SCP = (float*)(G2T + 64 * RW2_SGP);
    float* GN = SCP + 128; float* CST = GN + 64;
    float* PR0 = (float*)L_TW; float* PR1 = PR0 + 2048; float* PR2 = A_OUT;
    const int l = c.lane, w = c.wave, n16 = l & 15, g = l >> 4;
#pragma unroll 1
    for (int item = c.bid; item < NB * 16; item += c.nb) {
        const int b = item >> 4, h = item & 15, hk = h * 64 + l;
        __syncthreads();
        if (w < 7) { const float* src = w == 0 ? P.w0 : w == 1 ? P.a0 : w == 2 ? P.k_k : w == 3 ? P.k_a : w == 4 ? P.r_k : w == 5 ? P.ln_w : P.ln_b; CST[w * 64 + l] = src[hk]; }
        for (int i = c.tid; i < 160 * 64; i += NTHR) { const int j = i >> 6, kcl = i & 63; *(unsigned short*)(G2T + kcl * RW2_SGP + j * 2) = (unsigned short)f2bf(P.g2[(size_t)j * 1024 + h * 64 + kcl]); }
        for (int i = c.tid; i < 192; i += NTHR) { const int mi = i < 64 ? h * 64 + i : i < 128 ? 1024 + h * 64 + (i - 64) : 2048 + h * 64 + (i - 128); MU[i] = P.mu[mi]; }
        const int tt = w >> 2, nt = w & 3;
        bf16x8 W2B[2], A2B[2];
        { const int kc = h * 64 + 16 * nt + n16;
          auto ldfrag = [&](const float* Wp, int kk) -> bf16x8 { float f[8]; int gq = g, kq = kc; asm volatile("" : "+v"(gq), "+v"(kq));
              const float* wp = Wp + (size_t)(32 * kk + 8 * gq) * 1024 + kq;
#pragma unroll
              for (int q = 0; q < 8; ++q) f[q] = wp[q * 1024];
              u32x4 u; u.x = pk2(f[0], f[1]); u.y = pk2(f[2], f[3]); u.z = pk2(f[4], f[5]); u.w = pk2(f[6], f[7]);
              asm volatile("" : "+v"(u));
              return __builtin_bit_cast(bf16x8, u); };
          W2B[0] = ldfrag(P.w2, 0); W2B[1] = ldfrag(P.w2, 1); A2B[0] = ldfrag(P.a2, 0); A2B[1] = ldfrag(P.a2, 1);
        }
        f32x2 S[4];
#pragma unroll
        for (int i = 0; i < 4; ++i) S[i] = (f32x2){0.f, 0.f};
        const int srow = w * 8 + (l >> 3), sj = l & 7;
        u32x4 raw[4];
#define RW2_LOAD(T0) do { _Pragma("unroll") for (int k = 0; k < 4; ++k) { const int q_ = c.tid + 512 * k; \
            const int cq_ = q_ % 24; int tg = (T0) - 1 + q_ / 24; tg = tg < 0 ? 0 : tg; const int rc_ = (cq_ < 8 ? 880 : cq_ < 16 ? 1904 - 64 : 2928 - 128) + h * 64 + cq_ * 8; \
            int e_ = q_ - 792; e_ = (e_ < 0 || e_ >= 1152) ? 0 : e_; \
            const bf16* src_ = (q_ < 792) ? H + ((size_t)b * SEQ + tg) * HC + rc_ : LX + ((size_t)b * SEQ + (T0) + e_ / 36) * 288 + (e_ % 36) * 8; \
            raw[k] = *(const u32x4*)src_; } } while (0)
        RW2_LOAD(0);
#pragma unroll 1
        for (int t0 = 0; t0 < SEQ; t0 += 32) {
            __syncthreads();
#pragma unroll
            for (int k = 0; k < 4; ++k) { const int q_ = c.tid + 512 * k;
                if (q_ < 792) *(u32x4*)(RAW + (q_ / 24) * RW2_RAWP + (q_ % 24) * 16) = (t0 == 0 && q_ < 24) ? (u32x4){0u, 0u, 0u, 0u} : raw[k];
                else if (q_ < 1944) { const int e_ = q_ - 792, t_ = e_ / 36, p_ = e_ % 36;
                    unsigned char* d_ = p_ < 8 ? L_TW + t_ * RW2_TWP + p_ * 16 : p_ < 16 ? L_AL + t_ * RW2_TWP + (p_ - 8) * 16 : L_SG + t_ * RW2_SGP + (p_ - 16) * 16; *(u32x4*)d_ = raw[k]; } }
            { const int tn_ = (t0 + 32 < SEQ) ? t0 + 32 : t0; RW2_LOAD(tn_); }
            __syncthreads();
            if (c.tid < 384) {
                const int cpi = c.tid % 96, qb = c.tid / 96, cp = cpi * 2, tb = qb * 8;
                const float mu0 = MU[cp], mu1 = MU[cp + 1];
                unsigned xb = *(const unsigned*)(RAW + tb * RW2_RAWP + cp * 2);
                float p0 = bf2f(xb & 0xffffu), p1 = bf2f(xb >> 16);
                float* dst = (cp < 64 ? A_WR + cp : cp < 128 ? A_K2 + (cp - 64) : A_V + (cp - 128)) + tb * 64;
#pragma unroll
                for (int t = 0; t < 8; ++t) { const unsigned xa = *(const unsigned*)(RAW + (tb + t + 1) * RW2_RAWP + cp * 2); const float x0 = bf2f(xa & 0xffffu), x1 = bf2f(xa >> 16);
                    *(f32x2*)(dst + t * 64) = (f32x2){x0 + (p0 - x0) * mu0, x1 + (p1 - x1) * mu1}; p0 = x0; p1 = x1; }
            }
            __syncthreads();
            {
                f32x4 aw = (f32x4){0.f, 0.f, 0.f, 0.f}, aa = aw, ag = aw;
#pragma unroll
                for (int kk = 0; kk < 2; ++kk) { const bf16x8 At = *(const bf16x8*)(L_TW + (16 * tt + n16) * RW2_TWP + (32 * kk + 8 * g) * 2), Aa = *(const bf16x8*)(L_AL + (16 * tt + n16) * RW2_TWP + (32 * kk + 8 * g) * 2);
                    aw = __builtin_amdgcn_mfma_f32_16x16x32_bf16(At, W2B[kk], aw, 0, 0, 0); aa = __builtin_amdgcn_mfma_f32_16x16x32_bf16(Aa, A2B[kk], aa, 0, 0, 0); }
#pragma unroll
                for (int kk = 0; kk < 5; ++kk) { const bf16x8 Ag = *(const bf16x8*)(L_SG + (16 * tt + n16) * RW2_SGP + (32 * kk + 8 * g) * 2); const bf16x8 Gb = *(const bf16x8*)(G2T + (16 * nt + n16) * RW2_SGP + (32 * kk + 8 * g) * 2); ag = __builtin_amdgcn_mfma_f32_16x16x32_bf16(Ag, Gb, ag, 0, 0, 0); }
#pragma unroll
                for (int r = 0; r < 4; ++r) { const int o = (16 * tt + 4 * g + r) * 64 + 16 * nt + n16; LO_W[o] = aw[r]; LO_A[o] = aa[r]; A_G[o] = ag[r]; }
            }
            __syncthreads();
#pragma unroll 2
            for (int i = 0; i < 4; ++i) {
                const int t = w + 8 * i, o = t * 64 + l;
                const float w0v = CST[l], a0v = CST[64 + l], kkv = CST[128 + l], kav = CST[192 + l], rkv = CST[256 + l];
                const float dec = __expf(-0.6065306597126334f * sigmoidf_(w0v + LO_W[o]));
                const float a = sigmoidf_(a0v + LO_A[o]);
                const float kr = A_K2[o], r = A_WR[o];
                const float kk0 = kr * kkv, k2 = kr * (1.f + (a - 1.f) * kav), bb0 = kk0 * a, k2r = k2 * r;
                A_W[o] = dec; A_NKK[o] = -kk0; A_B[o] = bb0; A_K2[o] = k2; A_WR[o] = dec * r;
                PR0[o] = kk0 * kk0; PR1[o] = bb0 * r; PR2[o] = k2r; PR3[o] = k2r * rkv;
            }
            __syncthreads();
            {
                const int t = c.tid >> 4, q = (c.tid >> 2) & 3, qu = c.tid & 3;
                const float* src = (q == 0 ? PR0 : q == 1 ? PR1 : q == 2 ? PR2 : PR3) + t * 64 + 16 * qu;
                const f32x4 v0 = *(const f32x4*)src, v1 = *(const f32x4*)(src + 4), v2 = *(const f32x4*)(src + 8), v3 = *(const f32x4*)(src + 12);
                float sm = ((v0.x + v0.y) + (v0.z + v0.w)) + ((v1.x + v1.y) + (v1.z + v1.w)) + ((v2.x + v2.y) + (v2.z + v2.w)) + ((v3.x + v3.y) + (v3.z + v3.w));
                sm += dpp_mov<0xB1>(sm); sm += dpp_mov<0x4E>(sm);
                if (qu == 0) SCP[t * 4 + q] = (q == 0) ? 1.0f / fmaxf(sm, 1e-24f) : sm;
            }
            __syncthreads();
            {
                f32x4 n0, n1, r0, r1, w0_, w1_, b0, b1, k0, k1, sp; float vv;
                const unsigned char* pk_ = (const unsigned char*)A_WR + 32 * sj;
                const unsigned char* pv_ = (const unsigned char*)A_WR + 4 * srow;
                const unsigned char* ps_ = (const unsigned char*)SCP;
                constexpr int O_WR = 0, O_K2 = 8192, O_V = 16384, O_W = 24576, O_NKK = 32768, O_B = 40960, O_OUT = 57344;
#define RW2_LD_DOT(T) do { n0 = *(const f32x4*)(pk_ + O_NKK + (T) * 256); n1 = *(const f32x4*)(pk_ + O_NKK + (T) * 256 + 16); r0 = *(const f32x4*)(pk_ + O_WR + (T) * 256); r1 = *(const f32x4*)(pk_ + O_WR + (T) * 256 + 16); } while (0)
#define RW2_LD_UPD(T) do { w0_ = *(const f32x4*)(pk_ + O_W + (T) * 256); w1_ = *(const f32x4*)(pk_ + O_W + (T) * 256 + 16); b0 = *(const f32x4*)(pk_ + O_B + (T) * 256); b1 = *(const f32x4*)(pk_ + O_B + (T) * 256 + 16); \
                    k0 = *(const f32x4*)(pk_ + O_K2 + (T) * 256); k1 = *(const f32x4*)(pk_ + O_K2 + (T) * 256 + 16); vv = *(const float*)(pv_ + O_V + (T) * 256); sp = *(const f32x4*)(ps_ + (T) * 16); } while (0)
#define RW2_STEP(T) do { \
                    f32x2 sa2 = S[0] * (f32x2){n0.x, n0.y}; sa2 = S[1] * (f32x2){n0.z, n0.w} + sa2; sa2 = S[2] * (f32x2){n1.x, n1.y} + sa2; sa2 = S[3] * (f32x2){n1.z, n1.w} + sa2; \
                    f32x2 p2 = S[0] * (f32x2){r0.x, r0.y}; p2 = S[1] * (f32x2){r0.z, r0.w} + p2; p2 = S[2] * (f32x2){r1.x, r1.y} + p2; p2 = S[3] * (f32x2){r1.z, r1.w} + p2; \
                    __builtin_amdgcn_sched_barrier(0); RW2_LD_DOT((T) + 1); __builtin_amdgcn_sched_barrier(0); \
                    const float sa = sum8(sa2.x + sa2.y) * sp.x, p = sum8(p2.x + p2.y); \
                    const f32x2 sav = (f32x2){sa, sa}, vvv = (f32x2){vv, vv}; \
                    S[0] = S[0] * (f32x2){w0_.x, w0_.y} + (sav * (f32x2){b0.x, b0.y} + vvv * (f32x2){k0.x, k0.y}); \
                    S[1] = S[1] * (f32x2){w0_.z, w0_.w} + (sav * (f32x2){b0.z, b0.w} + vvv * (f32x2){k0.z, k0.w}); \
                    S[2] = S[2] * (f32x2){w1_.x, w1_.y} + (sav * (f32x2){b1.x, b1.y} + vvv * (f32x2){k1.x, k1.y}); \
                    S[3] = S[3] * (f32x2){w1_.z, w1_.w} + (sav * (f32x2){b1.z, b1.w} + vvv * (f32x2){k1.z, k1.w}); \
                    const float ov = p + sa * sp.y + vv * sp.z; \
                    __builtin_amdgcn_sched_barrier(0); RW2_LD_UPD((T) + 1); *(float*)(const_cast<unsigned char*>(pv_) + O_OUT + (T) * 256) = ov;        __builtin_amdgcn_sched_barrier(0); } while (0)
                RW2_LD_DOT(0); RW2_LD_UPD(0);
#pragma unroll 1
                for (int t4 = 0; t4 < 8; ++t4) {
                    RW2_STEP(0); RW2_STEP(1); RW2_STEP(2); RW2_STEP(3);
                    pk_ += 1024; pv_ += 1024; ps_ += 64;
                }
#undef RW2_LD_DOT
#undef RW2_LD_UPD
#undef RW2_STEP
            }
            __syncthreads();
            {
                const int t = c.tid >> 3, q = (c.tid >> 2) & 1, qu = c.tid & 3;
                if (c.tid < 256) {
                    const float* src = A_OUT + t * 64 + 16 * qu; float sm = 0.f;
#pragma unroll
                    for (int e = 0; e < 4; ++e) { const f32x4 v = *(const f32x4*)(src + 4 * e); sm += q ? ((v.x * v.x + v.y * v.y) + (v.z * v.z + v.w * v.w)) : ((v.x + v.y) + (v.z + v.w)); }
                    sm += dpp_mov<0xB1>(sm); sm += dpp_mov<0x4E>(sm);
                    const float other = dpp_mov<0x141>(sm);
                    if ((c.tid & 7) == 0) { const float mean = sm * (1.f / 64.f), var = fmaxf(other * (1.f / 64.f) - mean * mean, 0.f); GN[t * 2] = mean; GN[t * 2 + 1] = 1.0f / sqrtf(var + 64e-5f); }
                }
            }
            __syncthreads();
#pragma unroll
            for (int i = 0; i < 4; ++i) {
                const int t = w + 8 * i, o = t * 64 + l;
                float y = (A_OUT[o] - GN[t * 2]) * GN[t * 2 + 1] * CST[320 + l] + CST[384 + l];
                y = (y + SCP[t * 4 + 3] * A_V[o]) * A_G[o];
                if (b < wb) OUT[((size_t)b * SEQ + t0 + t) * ldo + coloff + hk] = (bf16)f2bf(y);
            }
        }
#undef RW2_LOAD
    }
}
constexpr int S5B_BUP = 132 * 4, S5B_XP = 272;
constexpr int S5B_WAVE = 16 * S5B_BUP + 16 * S5B_XP;
__device__ __forceinline__ void wave_lds_sync() { __builtin_amdgcn_fence(__ATOMIC_RELEASE, "wavefront"); __builtin_amdgcn_wave_barrier(); __builtin_amdgcn_fence(__ATOMIC_ACQUIRE, "wavefront"); }
__device__ __forceinline__ float gelu_fast(float y) { const float u2 = 1.5957691216057308f * (y + 0.044715f * y * y * y); return y * __builtin_amdgcn_rcpf(1.f + __expf(-u2)); }
__device__ __forceinline__ void s5_phase2(const Ctx& c, const bf16* __restrict__ U, const S5P P, bf16* Z) {
    if (c.wave >= 4) return;
    float* BU = (float*)(c.lds + c.wave * S5B_WAVE); unsigned char* XB = c.lds + c.wave * S5B_WAVE + 16 * S5B_BUP;
    const int l = c.lane, n16 = l & 15, g = l >> 4;
#pragma unroll 1
    for (int item = c.bid; item < 256; item += c.nb) {
        const int b = item >> 5, grp = (item & 31) * 4 + c.wave;
        float lbr, lbi;
        { const float lr = fminf(P.lam_re[grp * 64 + l], -1e-4f), li = P.lam_im[grp * 64 + l], dt = expf(P.log_dt[grp]);
          const float e = expf(lr * dt); lbr = e * cosf(li * dt); lbi = e * sinf(li * dt);
          const float nr = lbr - 1.f, ni = lbi, den = 1.f / (lr * lr + li * li);
          BU[l] = (nr * lr + ni * li) * den; BU[64 + l] = (ni * lr - nr * li) * den; }
        wave_lds_sync();
        bf16x4 Bre[4], Bim[4];
#pragma unroll
        for (int nt = 0; nt < 4; ++nt) { const int p = 16 * nt + n16; const float cr = BU[p], ci = BU[64 + p];
            const f32x4 br = *(const f32x4*)(P.b_re + (size_t)(grp * 64 + p) * 16 + 4 * g), bi = *(const f32x4*)(P.b_im + (size_t)(grp * 64 + p) * 16 + 4 * g);
            u32x2 wr, wi; wr.x = pk2(cr * br.x - ci * bi.x, cr * br.y - ci * bi.y); wr.y = pk2(cr * br.z - ci * bi.z, cr * br.w - ci * bi.w);
            wi.x = pk2(cr * bi.x + ci * br.x, cr * bi.y + ci * br.y); wi.y = pk2(cr * bi.z + ci * br.z, cr * bi.w + ci * br.w);
            Bre[nt] = __builtin_bit_cast(bf16x4, wr); Bim[nt] = __builtin_bit_cast(bf16x4, wi); }
        wave_lds_sync();
        bf16x8 Cf[4];
#pragma unroll
        for (int kk = 0; kk < 4; ++kk) { const int p0 = 16 * kk + 4 * g;
            const f32x4 vr = *(const f32x4*)(P.c_re + (size_t)(grp * 16 + n16) * 64 + p0), vi = *(const f32x4*)(P.c_im + (size_t)(grp * 16 + n16) * 64 + p0);
            u32x4 w; w.x = pk2(vr.x, -vi.x); w.y = pk2(vr.y, -vi.y); w.z = pk2(vr.z, -vi.z); w.w = pk2(vr.w, -vi.w); Cf[kk] = __builtin_bit_cast(bf16x8, w); }
        bf16x4 Df; { const float dsk = P.d[grp * 16 + n16]; const int kq = n16 - 4 * g; u32x2 w; w.x = pk2(kq == 0 ? dsk : 0.f, kq == 1 ? dsk : 0.f); w.y = pk2(kq == 2 ? dsk : 0.f, kq == 3 ? dsk : 0.f); Df = __builtin_bit_cast(bf16x4, w); }
        f32x2 xs = (f32x2){0.f, 0.f};
        const bf16* ub = U + (size_t)b * SEQ * D + grp * 16;
        u32x2 ua[4];
#define S5B_LOAD(k, T0) do { ua[k] = *(const u32x2*)(ub + (size_t)((T0) + n16) * D + 4 * g); } while (0)
#pragma unroll
        for (int k = 0; k < 4; ++k) S5B_LOAD(k, 16 * k);
#pragma unroll 1
        for (int t0 = 0; t0 < SEQ; t0 += 64) {
#pragma unroll
            for (int k = 0; k < 4; ++k) {
                const int tb = t0 + 16 * k;
                const bf16x4 A = __builtin_bit_cast(bf16x4, ua[k]);
                { const int tn = (tb + 64 < SEQ) ? tb + 64 : tb; S5B_LOAD(k, tn); }
                const f32x4 yd = __builtin_amdgcn_mfma_f32_16x16x16bf16_1k(A, Df, (f32x4){0.f, 0.f, 0.f, 0.f}, 0, 0, 0);
#pragma unroll
                for (int nt = 0; nt < 4; ++nt) {
                    const f32x4 ar = __builtin_amdgcn_mfma_f32_16x16x16bf16_1k(A, Bre[nt], (f32x4){0.f, 0.f, 0.f, 0.f}, 0, 0, 0);
                    const f32x4 ai = __builtin_amdgcn_mfma_f32_16x16x16bf16_1k(A, Bim[nt], (f32x4){0.f, 0.f, 0.f, 0.f}, 0, 0, 0);
#pragma unroll
                    for (int r = 0; r < 4; ++r) *(f32x2*)(BU + (4 * g + r) * 132 + 2 * (16 * nt + n16)) = (f32x2){ar[r], ai[r]};
                }
                wave_lds_sync();
#pragma unroll 4
                for (int t = 0; t < 16; ++t) {
                    const f32x2 bu = *(const f32x2*)(BU + t * 132 + 2 * l);
                    const f32x2 tq = (f32x2){lbr, lbr} * xs + bu;
                    xs = (f32x2){-lbi, lbi} * (f32x2){xs.y, xs.x} + tq;
                    *(unsigned*)(XB + t * S5B_XP + l * 4) = pg8::cvt_pk_bf16(xs.x, xs.y);
                }
                wave_lds_sync();
                f32x4 y = (f32x4){0.f, 0.f, 0.f, 0.f};
#pragma unroll
                for (int kk = 0; kk < 4; ++kk) { const bf16x8 Ax = *(const bf16x8*)(XB + n16 * S5B_XP + (32 * kk + 8 * g) * 2); y = __builtin_amdgcn_mfma_f32_16x16x32_bf16(Ax, Cf[kk], y, 0, 0, 0); }
#pragma unroll
                for (int r = 0; r < 4; ++r) Z[((size_t)b * SEQ + tb + 4 * g + r) * D + grp * 16 + n16] = (bf16)f2bf(gelu_fast(y[r] + yd[r]));
                wave_lds_sync();
            }
        }
#undef S5B_LOAD
    }
}
struct Args { const void* in[45]; float* out; unsigned char* ws; int ph_lo, ph_hi; };
static_assert(sizeof(Args) == 45 * 8 + 8 + 8 + 8, "Args has no padding");
constexpr int PH_EVEN = 9, PH_ODD = 4, PH_COMMON = 13;
constexpr int NPHASES = 2 * (1 + PH_EVEN + PH_COMMON) + 2 * (1 + PH_ODD + PH_COMMON) + 1;

__global__ void __launch_bounds__(NTHR, 2) mega(Args args) {
    extern __shared__ __attribute__((aligned(16))) unsigned char lds[];
    volatile LAS unsigned* MISC = (volatile LAS unsigned*)((LAS unsigned char*)lds + MISC_OFF);
    if (threadIdx.x < 64) MISC[threadIdx.x] = 0u;
    __syncthreads();
    unsigned char* ws = args.ws;
    XcdBarrier bar = xcd_barrier_post((unsigned*)(ws + WS_CTL) + 4096, MISC + 8, gridDim.x);
    const int half = (int)gridDim.x >> 1;
    XcdBarrier bar2 = bar; if ((int)blockIdx.x >= half) bar2 = xcd_barrier_post((unsigned*)(ws + WS_CTL) + 8192, MISC + 10, gridDim.x - half);
    const int lo = args.ph_lo, hi = args.ph_hi;
    int pid = 0;
#define PH_BEGIN if (pid >= lo && pid < hi) { Ctx c; { int t_ = threadIdx.x, b_ = blockIdx.x; asm volatile("" : "+v"(t_)); asm volatile("" : "+s"(b_)); c.lds = lds; c.tid = t_; c.lane = t_ & 63; c.wave = __builtin_amdgcn_readfirstlane(t_ >> 6); c.bid = b_; { int n_ = gridDim.x; asm volatile("" : "+s"(n_)); c.nb = n_; } c.gw = c.bid * NWAVES + c.wave; c.ngw = c.nb * NWAVES; }
#define PH_END } if (pid >= lo && pid + 1 < hi) { xcd_barrier(bar); if (DBL & 2048) xcd_barrier(bar); } ++pid;
#define IN_F(i) (*(const float* const __attribute__((address_space(4)))*)(KARGS() + 8 * (i)))

    typedef const unsigned char __attribute__((address_space(4)))* kptr_t;
#define KARGS() ({ kptr_t p_ = (kptr_t)__builtin_amdgcn_kernarg_segment_ptr(); asm volatile("" : "+s"(p_)); p_; })
#define WSP(off) ((*(unsigned char* const __attribute__((address_space(4)))*)(KARGS() + 368)) + (off))
#define X ((float*)(*(float* const __attribute__((address_space(4)))*)(KARGS() + 360)))
#define ROPEA ((float*)WSP(WS_ROPEA))
#define ROPEI ((float*)WSP(WS_ROPEI))
#define KVBIG ((bf16*)WSP(WS_KVBIG))
#define WKV ((bf16*)WSP(WS_WKV))
#define W_IN ((bf16*)WSP(WS_WMIX + WMIX_IN))
#define WQ ((bf16*)WSP(WS_WMIX + WMIX_Q))
#define WOUT ((bf16*)WSP(WS_WMIX + WMIX_OUT))
#define WO_IN ((bf16*)WSP(WS_WMIX + WMIX_O_IN))
#define WO_GLU ((bf16*)WSP(WS_WMIX + WMIX_O_GLU))
#define WO_OUT ((bf16*)WSP(WS_WMIX + WMIX_O_OUT))
#define WXQ ((bf16*)WSP(WS_WXQ))
#define WXO ((bf16*)WSP(WS_WXO))
#define WUP ((bf16*)WSP(WS_WUP))
#define WDN ((bf16*)WSP(WS_WDN))
#define CQN ((bf16*)WSP(WS_CQN))
#define KF ((bf16*)WSP(WS_KF))
#define KIDX ((bf16*)WSP(WS_KIDX))
#define WIDX ((float*)WSP(WS_WIDX))
#define SEL ((bf16*)WSP(WS_SEL))
#define Hb ((bf16*)WSP(WS_R1))
#define SC ((float*)WSP(WS_R1))
#define HID ((bf16*)WSP(WS_R1))
#define Ub ((bf16*)WSP(WS_R1))
#define YC ((bf16*)WSP(WS_R1 + (size_t)M * D * 2))
#define XN ((bf16*)WSP(WS_R2))
#define QALL ((bf16*)X)
#define OLY ((bf16*)WSP(WS_R3))
#define Zb ((bf16*)WSP(WS_R3))
#define XQ ((bf16*)WSP(WS_R3))
#define XO ((bf16*)WSP(WS_R3 + (size_t)M * 512 * 2))
#define MEMN ((bf16*)WSP(WS_R3))
    LAS unsigned char* glds = (LAS unsigned char*)lds;

#define RS_A ((unsigned long long*)WSP(WS_CTL + 131072))
#define RS_B ((unsigned long long*)WSP(WS_CTL + 393216))
#define RS_C ((unsigned long long*)WSP(WS_CTL + 655360))
    for (int layer = 0; layer < DEPTH; ++layer) {
        const int li = layer >> 1;
        PH_BEGIN
            if ((layer & 1) == 0) {
                conv_mat(c, IN_F(13) + (size_t)li * 2048 * EVEN_COLS, 2048, EVEN_COLS, EVEN_COLS, HC, W_IN, 2048, 0, 0, IN_F(3) + layer * D);
                build_wql(c, IN_F(18) + (size_t)li * 512 * 1024, IN_F(19) + (size_t)li * 256 * 768, WQ);
                for (int h = 0; h < 8; ++h) conv_mat(c, IN_F(18) + (size_t)li * 512 * 1024 + h * 128, 512, 1024, 32, 32, WQ, 512, 2048 + h * 32, 0);
                conv_mat(c, IN_F(21) + (size_t)li * 512 * 1024, 512, 1024, 1024, 1024, WQ, 512, 2304, 0);
                build_wout(c, IN_F(20) + (size_t)li * 256 * 1024, IN_F(14) + (size_t)li * 2048 * 2048, WOUT);
                conv_mat(c, IN_F(14) + (size_t)li * 2048 * 2048 + (size_t)1024 * 2048, 1024, 2048, 2048, 2048, WOUT, OC, 0, 2048);
            } else {
                conv_mat(c, IN_F(33) + (size_t)li * 2048 * 2048, 2048, 2048, 2048, 2048, WO_IN, 2048, 0, 0, IN_F(3) + layer * D);
                conv_mat(c, IN_F(43) + (size_t)li * 2048 * 2048, 2048, 2048, 2048, 2048, WO_GLU, 2048, 0, 0);
                conv_mat(c, IN_F(34) + (size_t)li * 2048 * 2048, 2048, 2048, 2048, 2048, WO_OUT, 2048, 0, 0);
            }
            conv_mat(c, IN_F(8) + (size_t)layer * 2048 * 512, 2048, 512, 512, 512, WXQ, 2048, 0, 0, IN_F(4) + layer * D);
            conv_mat(c, IN_F(10) + (size_t)layer * 512 * 2048, 512, 2048, 2048, 2048, WXO, 512, 0, 0);
            { unsigned long long* ra = RS_A; unsigned long long* rb = RS_B; for (int i = c.bid * NTHR + c.tid; i < M; i += c.nb * NTHR) { ra[i] = 0ull; rb[i] = 0ull; } }
            if (layer == 0) {
                for (int l2 = 0; l2 < 4; ++l2) {
                    conv_mat(c, IN_F(9) + (size_t)l2 * 2048 * 1024, 2048, 1024, 1024, 1024, WKV, 2048, l2 * 1024, 0);
                    norm_rows_bf16(c, IN_F(1), IN_F(5) + l2 * D, MEMN + (size_t)l2 * MEMR * D, MEMR);
                }
                rope_tables(c, (const int*)IN_F(2), ROPEA, ROPEI);
                cast_rows_ss(c, IN_F(0), XN, RS_C, M);
            }
        PH_END
        if ((layer & 1) == 0) {
            PH_BEGIN
                { pg8::Gemm g{XN, W_IN, 2048, 2048, 2048}; pg8::StaticOrder S; S.init(128, HC / 256, c.nb, c.bid); pg8::EpiBf16<0> E{Hb, HC, RS_C};
                  pg8::gemm_phase<pg8::EpiBf16<0>, pg8::StaticOrder, true, true>(glds, g, S, E);
                  if (DBL & 1024) { __syncthreads(); pg8::gemm_phase<pg8::EpiBf16<0>, pg8::StaticOrder, true, true>(glds, g, S, E); } }
                if (layer == 0) { __syncthreads(); pg8::Gemm g{MEMN, WKV, 2048, 2048, 2048}; pg8::KvOrder S{c.nb, c.bid}; pg8::EpiBf16<0> E{KVBIG, 4096, nullptr};
                  pg8::gemm_phase<pg8::EpiBf16<0>, pg8::KvOrder, true, true>(glds, g, S, E); }
            PH_END
            PH_BEGIN
                rwkv_lora_prep(c, Hb, IN_F(22) + li * B_COLS, (bf16*)WSP(WS_END + 96 * MiB));
            PH_END
            PH_BEGIN
                if (c.bid < half) {
                    Ctx r = c; r.nb = half; r.ngw = half * NWAVES;
                    const RwkvP P{IN_F(22) + li * B_COLS, IN_F(23) + li * 1024, IN_F(24) + (size_t)li * 65536, IN_F(25) + li * 1024, IN_F(26) + (size_t)li * 65536, IN_F(27) + (size_t)li * 163840,
                                  IN_F(28) + li * 1024, IN_F(29) + li * 1024, IN_F(30) + li * 1024, IN_F(31) + li * 1024, IN_F(32) + li * 1024};
#if DIAG == 4
                    rwkv_phase(r, Hb, P, OLY);
                    rwkv_phase2(r, Hb, (const bf16*)WSP(WS_END + 96 * MiB), P, (bf16*)WSP(WS_END + 116 * MiB), 1024, 0, 1);
#else
                    rwkv_phase2(r, Hb, (const bf16*)WSP(WS_END + 96 * MiB), P, OLY, OC, 2048);
#endif
                    __syncthreads();
                    conv_mat(r, IN_F(12) + (size_t)layer * FFN * 2048, FFN, 2048, 2048, 2048, WDN, FFN, 0, 0);
                } else {
                    Ctx d = c; d.bid = c.bid - half; d.nb = c.nb - half; d.gw = d.bid * NWAVES + d.wave; d.ngw = d.nb * NWAVES;
                    dsa_prep(d, Hb, IN_F(15) + li * 512, IN_F(16) + li * 256, IN_F(17) + li * 64, ROPEA, ROPEI, CQN, KF, KIDX, WIDX);
                    xcd_barrier(bar2);
                    { pg8::Gemm g{CQN, WQ, 512, 512, 512}; pg8::StaticOrder S; S.init(128, QC / 256, d.nb, d.bid); pg8::EpiBf16<0> E{QALL, QC, nullptr};
                      pg8::gemm_phase<pg8::EpiBf16<0>, pg8::StaticOrder, true, true>(glds, g, S, E); }
                    xcd_barrier(bar2);
                    idx_topk_mfma(d, QALL, KIDX, WIDX, ROPEI, (float*)(d.bid < 32 ? WSP(WS_CQN + (size_t)d.bid * MiB) : WSP(WS_END + (size_t)(d.bid - 32) * MiB)), SEL, 256);
                    conv_mat(d, IN_F(11) + (size_t)layer * 2048 * FFN, 2048, FFN, FFN, FFN, WUP, 2048, 0, 0, IN_F(6) + layer * D);
                    xcd_barrier(bar2);
                    if (d.bid == 0 && c.tid == 0) __hip_atomic_store((unsigned*)WSP(WS_CTL) + 12288 + 64 * (2 + li), 1u, __ATOMIC_RELAXED, __HIP_MEMORY_SCOPE_AGENT);
                }
                if (c.bid < half) {
                    if (c.tid == 0) { unsigned* fl = (unsigned*)WSP(WS_CTL) + 12288 + 64 * (2 + li); unsigned sp = 0;
                        while (__hip_atomic_load(fl, __ATOMIC_RELAXED, __HIP_MEMORY_SCOPE_AGENT) == 0u) { __builtin_amdgcn_s_sleep(8); if (++sp > (1u << 22)) break; } }
                    __syncthreads();
                    __builtin_amdgcn_fence(__ATOMIC_ACQUIRE, "agent"); asm volatile("s_waitcnt vmcnt(0)" ::: "memory");
                }
                dsa_attn_queue(c, QALL, KF, SEL, ROPEA, OLY, (unsigned*)WSP(WS_CTL) + 12288 + 64 * li, MISC + 12);
            PH_END
#if DBL & 32
            PH_BEGIN
                if (c.bid < half) {
                    Ctx r = c; r.nb = half; r.ngw = half * NWAVES;
                    const RwkvP P{IN_F(22) + li * B_COLS, IN_F(23) + li * 1024, IN_F(24) + (size_t)li * 65536, IN_F(25) + li * 1024, IN_F(26) + (size_t)li * 65536, IN_F(27) + (size_t)li * 163840,
                                  IN_F(28) + li * 1024, IN_F(29) + li * 1024, IN_F(30) + li * 1024, IN_F(31) + li * 1024, IN_F(32) + li * 1024};
                    rwkv_phase2(r, Hb, (const bf16*)WSP(WS_END + 96 * MiB), P, OLY, OC, 2048);
                }
            PH_END
#endif
#if DBL & 8
            PH_BEGIN
                if (c.bid >= half) {
                    Ctx d = c; d.bid = c.bid - half; d.nb = c.nb - half; d.gw = d.bid * NWAVES + d.wave; d.ngw = d.nb * NWAVES;
                    idx_topk_mfma(d, QALL, KIDX, WIDX, ROPEI, (float*)(d.bid < 32 ? WSP(WS_CQN + (size_t)d.bid * MiB) : WSP(WS_END + (size_t)(d.bid - 32) * MiB)), SEL, 256);
                }
            PH_END
#endif
#if DIAG == 4
            PH_BEGIN
                diag_cmp_bf16(c, OLY + 2048, OC, (bf16*)WSP(WS_END + 116 * MiB), 1024, SEQ, 1024, (float*)WSP(WS_CTL + 65536));
            PH_END
#endif
#if DIAG == 7 || DIAG == 8
            PH_BEGIN
                q_rope_fix(c, QALL, ROPEA, ROPEI);
            PH_END
#endif
#if DIAG == 7
            PH_BEGIN
                if (c.bid >= half) { Ctx d = c; d.bid = c.bid - half; d.nb = c.nb - half; d.gw = d.bid * NWAVES + d.wave; d.ngw = d.nb * NWAVES;
                    idx_topk_v1(d, QALL, KIDX, WIDX, (float*)(d.bid < 32 ? WSP(WS_CQN + (size_t)d.bid * MiB) : WSP(WS_END + (size_t)(d.bid - 32) * MiB)), (bf16*)WSP(WS_END + 116 * MiB), 128); }
            PH_END
            PH_BEGIN
                diag_cmp_sel(c, SEL, (bf16*)WSP(WS_END + 116 * MiB), 4, (float*)WSP(WS_CTL + 65536));
            PH_END
#endif
#if DIAG == 8
            PH_BEGIN
                dsa_attn_simple(c, QALL, KF, SEL, (bf16*)WSP(WS_END + 116 * MiB), 1024);
            PH_END
            PH_BEGIN
                diag_cmp_bf16(c, OLY, OC, (bf16*)WSP(WS_END + 116 * MiB), OC, 1024, 2048, (float*)WSP(WS_CTL + 65536));
            PH_END
#endif
            PH_BEGIN
                { pg8::Gemm g{OLY, WOUT, OC, OC, OC}; pg8::StaticOrder S; S.init(128, 8, c.nb, c.bid); pg8::EpiRes E{XN, D, RS_A};
                  pg8::gemm_phase<pg8::EpiRes, pg8::StaticOrder, true, true>(glds, g, S, E); }
            PH_END
        } else {
            PH_BEGIN
                { pg8::Gemm g{XN, WO_IN, 2048, 2048, 2048}; pg8::StaticOrder S; S.init(128, 8, c.nb, c.bid); pg8::EpiBf16<0> E{Ub, D, RS_C};
                  pg8::gemm_phase<pg8::EpiBf16<0>, pg8::StaticOrder, true, true>(glds, g, S, E);
                  if (DBL & 1024) { __syncthreads(); pg8::gemm_phase<pg8::EpiBf16<0>, pg8::StaticOrder, true, true>(glds, g, S, E); } }
            PH_END
            PH_BEGIN
                { const S5P P{IN_F(35) + li * 8192, IN_F(36) + li * 8192, IN_F(37) + li * 128, IN_F(38) + (size_t)li * 131072, IN_F(39) + (size_t)li * 131072, IN_F(40) + (size_t)li * 131072, IN_F(41) + (size_t)li * 131072, IN_F(42) + li * D};
                  s5_phase2(c, Ub, P, Zb); }
                if (c.wave >= 4) {
                    Ctx v = c; v.lds = c.lds + 65536 - 4 * 8704; v.gw = c.bid * 4 + (c.wave - 4); v.ngw = c.nb * 4;
                    conv_mat(v, IN_F(11) + (size_t)layer * 2048 * FFN, 2048, FFN, FFN, FFN, WUP, 2048, 0, 0, IN_F(6) + layer * D);
                    conv_mat(v, IN_F(12) + (size_t)layer * FFN * 2048, FFN, 2048, 2048, 2048, WDN, FFN, 0, 0);
                }
            PH_END
#if DIAG == 5
            PH_BEGIN
                { const S5P P{IN_F(35) + li * 8192, IN_F(36) + li * 8192, IN_F(37) + li * 128, IN_F(38) + (size_t)li * 131072, IN_F(39) + (size_t)li * 131072, IN_F(40) + (size_t)li * 131072, IN_F(41) + (size_t)li * 131072, IN_F(42) + li * D};
                  s5_phase(c, Ub, P, YC); }
            PH_END
            PH_BEGIN
                diag_cmp_bf16(c, YC, D, Zb, D, M, D, (float*)WSP(WS_CTL + 65536));
            PH_END
#endif
            PH_BEGIN
                { pg8::Gemm g{Zb, WO_GLU, 2048, 2048, 2048}; pg8::StaticOrder S; S.init(128, 8, c.nb, c.bid); pg8::EpiGlu E{Zb, YC, D, IN_F(44) + li * D};
                  pg8::gemm_phase<pg8::EpiGlu, pg8::StaticOrder, true, true>(glds, g, S, E); }
            PH_END
            PH_BEGIN
                { pg8::Gemm g{YC, WO_OUT, 2048, 2048, 2048}; pg8::StaticOrder S; S.init(128, 8, c.nb, c.bid); pg8::EpiRes E{XN, D, RS_A};
                  pg8::gemm_phase<pg8::EpiRes, pg8::StaticOrder, true, true>(glds, g, S, E); }
            PH_END
        }
        PH_BEGIN
            { unsigned long long* rc = RS_C; for (int i = c.bid * NTHR + c.tid; i < M; i += c.nb * NTHR) rc[i] = 0ull; }
            { pg8::Gemm g{XN, WXQ, 2048, 2048, 2048}; pg8::StaticOrder S; S.init(128, 2, c.nb, c.bid); pg8::EpiBf16<0> E{XQ, 512, RS_A};
              pg8::gemm_phase<pg8::EpiBf16<0>, pg8::StaticOrder, true, true>(glds, g, S, E); }
        PH_END
        PH_BEGIN
            xattn_mfma(c, XQ, KVBIG, layer, XO); if (DBL & 128) { asm volatile("" ::: "memory"); xattn_mfma(c, XQ, KVBIG, layer, XO); }
        PH_END
        PH_BEGIN
            { pg8::Gemm g{XO, WXO, 512, 512, 512}; pg8::StaticOrder S; S.init(128, 8, c.nb, c.bid); pg8::EpiRes E{XN, D, RS_B};
              pg8::gemm_phase<pg8::EpiRes, pg8::StaticOrder, true, true>(glds, g, S, E); }
        PH_END
        for (int q = 0; q < 5; ++q) {
            PH_BEGIN
                if (q > 0) { const int qd = q - 1; bf16* hid = HID + (size_t)(qd & 1) * 8192 * FFN;
                    pg8::Gemm g{hid, WDN, FFN, FFN, FFN}; pg8::StaticOrder S; S.init(32, 8, c.nb, c.bid); pg8::EpiRes E{XN + (size_t)qd * 8192 * D, D, RS_C + qd * 8192};
                    pg8::gemm_phase<pg8::EpiRes, pg8::StaticOrder, true, true>(glds, g, S, E); __syncthreads(); }
                if (q < 4) { bf16* hid = HID + (size_t)(q & 1) * 8192 * FFN;
                    pg8::Gemm g{XN + (size_t)q * 8192 * D, WUP, 2048, 2048, 2048}; pg8::StaticOrder S; S.init(32, 32, c.nb, c.bid); pg8::EpiBf16<1> E{hid, FFN, RS_B + q * 8192};
                    pg8::gemm_phase<pg8::EpiBf16<1>, pg8::StaticOrder, true, true>(glds, g, S, E); }
            PH_END
        }
    }
    PH_BEGIN
        scale_rows_out(c, XN, IN_F(7), RS_C, X, M);
    PH_END
#if DIAG
    PH_BEGIN
        { const float* dg = (const float*)WSP(WS_CTL + 65536); const float sc = 1.f + sqrtf(100.f * dg[0] / fmaxf(dg[1], 1e-30f));
          float* xo = X; for (size_t i = (size_t)c.bid * NTHR + c.tid; i < (size_t)M * D; i += (size_t)c.nb * NTHR) xo[i] *= sc; }
    PH_END
#endif
#undef PH_BEGIN
#undef PH_END
#undef IN_F
#undef X
}

extern "C" void kernel_launch(void* const* d_in, const int* in_sizes, int n_in, void* d_out, int out_size, void* d_ws, size_t ws_size, hipStream_t stream) {
    static int grid = 0;
    if (grid == 0) {
        if (n_in != 45 || out_size != M * D || ws_size < WS_END + 116 * MiB) { fprintf(stderr, "kernel_launch: unexpected shapes (n_in %d, out %d, ws %zu, need %zu)\n", n_in, out_size, ws_size, (size_t)WS_END); grid = -1; return; }
        int dev = 0, cus = 0, per_cu = 0;
        if (hipGetDevice(&dev) != hipSuccess || hipDeviceGetAttribute(&cus, hipDeviceAttributeMultiprocessorCount, dev) != hipSuccess) { grid = -1; return; }
        if (hipFuncSetAttribute((const void*)mega, hipFuncAttributeMaxDynamicSharedMemorySize, LDS_BYTES) != hipSuccess) { fprintf(stderr, "kernel_launch: hipFuncSetAttribute failed\n"); grid = -1; return; }
        if (hipOccupancyMaxActiveBlocksPerMultiprocessor(&per_cu, (const void*)mega, NTHR, LDS_BYTES) != hipSuccess || per_cu < 1) fprintf(stderr, "kernel_launch: occupancy query reports %d\n", per_cu);
        (void)hipGetLastError();
        grid = cus;
    }
    if (grid < 0) return;
    (void)hipMemsetAsync((char*)d_ws + WS_CTL, 0, CTL_BYTES, stream);
    Args a{};
    for (int i = 0; i < 45; ++i) a.in[i] = d_in[i];
    a.out = (float*)d_out; a.ws = (unsigned char*)d_ws;
#if MK_ONE_LAUNCH
    a.ph_lo = 0; a.ph_hi = 1 << 20;
    hipLaunchKernelGGL(mega, dim3(grid), dim3(NTHR), LDS_BYTES, stream, a);
#else
    for (int p = 0; p < NPHASES; ++p) { a.ph_lo = p; a.ph_hi = p + 1; hipLaunchKernelGGL(mega, dim3(grid), dim3(NTHR), LDS_BYTES, stream, a); }
#endif
}
```

```cpp
#include <hip/hip_runtime.h>
#include <cstdio>
#include <cstdint>

#ifndef DIAG
#define DIAG 0
#endif
#ifndef ATTN_SPLIT
#define ATTN_SPLIT 0
#endif
#ifndef DBL
#define DBL 0
#endif
#ifndef MK_ONE_LAUNCH
#define MK_ONE_LAUNCH 1
#endif

constexpr int D = 2048, NB = 8, SEQ = 4096, M = NB * SEQ, DEPTH = 4;
constexpr int HC = 4352;
constexpr int EVEN_COLS = 4240, A_COLS = 880, B_COLS = 3360;
constexpr int QC = 3328;
constexpr int OC = 3072;
constexpr int KFW = 288;
constexpr int FFN = 8192;
constexpr int MEMR = NB * 256;
constexpr float NORM_EPS = 1e-5f;
constexpr size_t SC_PER_BATCH = (size_t)4096 * 64 * 65 / 2;

typedef unsigned short bf16;
typedef float f32x4 __attribute__((ext_vector_type(4)));
typedef unsigned u32x4 __attribute__((ext_vector_type(4)));
typedef unsigned u32x2 __attribute__((ext_vector_type(2)));
typedef float f32x2 __attribute__((ext_vector_type(2)));
#define LAS __attribute__((address_space(3)))

constexpr size_t MiB = 1u << 20;
constexpr size_t al256(size_t x) { return (x + 255) & ~(size_t)255; }
constexpr size_t WS_CTL = 0, CTL_BYTES = 1 * MiB;
constexpr size_t WS_ROPEA = WS_CTL + CTL_BYTES;
constexpr size_t WS_ROPEI = WS_ROPEA + (size_t)M * 32 * 4;
constexpr size_t WS_KVBIG = WS_ROPEI + (size_t)M * 16 * 4;
constexpr size_t WS_WKV = WS_KVBIG + (size_t)8192 * 4096 * 2;
constexpr size_t WS_WMIX = WS_WKV + (size_t)4096 * 2048 * 2;
constexpr size_t WMIX_IN = 0, WMIX_Q = (size_t)HC * 2048 * 2, WMIX_OUT = WMIX_Q + (size_t)QC * 512 * 2, WMIX_BYTES = WMIX_OUT + (size_t)2048 * OC * 2;
constexpr size_t WMIX_O_IN = 0, WMIX_O_GLU = (size_t)2048 * 2048 * 2, WMIX_O_OUT = 2 * WMIX_O_GLU;
constexpr size_t WS_WXQ = al256(WS_WMIX + WMIX_BYTES);
constexpr size_t WS_WXO = WS_WXQ + (size_t)512 * 2048 * 2;
constexpr size_t WS_WUP = WS_WXO + (size_t)2048 * 512 * 2;
constexpr size_t WS_WDN = WS_WUP + (size_t)FFN * 2048 * 2;
constexpr size_t WS_CQN = WS_WDN + (size_t)2048 * FFN * 2;
constexpr size_t WS_KF = WS_CQN + (size_t)M * 512 * 2;
constexpr size_t WS_KIDX = WS_KF + (size_t)M * KFW * 2;
constexpr size_t WS_WIDX = WS_KIDX + (size_t)M * 64 * 2;
constexpr size_t WS_SEL = WS_WIDX + (size_t)M * 16 * 4;
constexpr size_t WS_R1 = al256(WS_SEL + (size_t)M * 256 * 2);
constexpr size_t R1_BYTES = (size_t)M * HC * 2;
constexpr size_t WS_R2 = WS_R1 + R1_BYTES;
constexpr size_t R2_BYTES = (size_t)M * QC * 2;
constexpr size_t WS_R3 = WS_R2 + R2_BYTES;
constexpr size_t R3_BYTES = (size_t)M * OC * 2;
constexpr size_t WS_END = WS_R3 + R3_BYTES;
static_assert(SC_PER_BATCH * NB * 4 <= R1_BYTES, "scores fit R1");
static_assert((size_t)8192 * FFN * 2 <= R1_BYTES && (size_t)M * 2048 * 2 * 2 <= R1_BYTES, "R1 overlays");

__device__ __forceinline__ float bf2f(unsigned v) { return __uint_as_float(v << 16); }
__device__ __forceinline__ unsigned f2bf(float f) { unsigned u = __float_as_uint(f); return (u + 0x7fffu + ((u >> 16) & 1u)) >> 16; }
__device__ __forceinline__ unsigned pk2(float lo, float hi) { return f2bf(lo) | (f2bf(hi) << 16); }
__device__ __forceinline__ float wave_sum(float v) {
#pragma unroll
    for (int o = 1; o < 64; o <<= 1) v += __shfl_xor(v, o);
    return v;
}
__device__ __forceinline__ float wave_max(float v) {
#pragma unroll
    for (int o = 1; o < 64; o <<= 1) v = fmaxf(v, __shfl_xor(v, o));
    return v;
}
__device__ __forceinline__ void unpack8(const u32x4 w, float* f) {
    f[0] = __uint_as_float(w.x << 16); f[1] = __uint_as_float(w.x & 0xffff0000u); f[2] = __uint_as_float(w.y << 16); f[3] = __uint_as_float(w.y & 0xffff0000u);
    f[4] = __uint_as_float(w.z << 16); f[5] = __uint_as_float(w.z & 0xffff0000u); f[6] = __uint_as_float(w.w << 16); f[7] = __uint_as_float(w.w & 0xffff0000u);
}
__device__ __forceinline__ float sigmoidf_(float x) { return __builtin_amdgcn_rcpf(1.f + __expf(-x)); }
namespace pg8 {
#define PG8_LAS __attribute__((address_space(3)))
typedef unsigned short bf16_t;
typedef short bf16x8 __attribute__((ext_vector_type(8)));
typedef float f32x4 __attribute__((ext_vector_type(4)));
typedef unsigned u32x4 __attribute__((ext_vector_type(4)));
constexpr int BM = 256, BK = 64, HALF = 128, HTB = HALF * BK * 2, STAGE_BYTES = 8 * HTB, NXCD = 8, WGM = 8;

__host__ __device__ __forceinline__ int lds_byte(int r, int c) { const int st = (r >> 4) * 2 + (c >> 5), rr = r & 15, cc = c & 31, ob = rr * 64 + cc * 2; return st * 1024 + (ob ^ (((ob >> 9) & 1) << 5)); }
__host__ __device__ __forceinline__ void stage_rc(int b, int& R, int& C) { const int st = b / 1024, sb = b % 1024, swz = sb ^ (((sb >> 9) & 1) << 5); R = (st >> 1) * 16 + swz / 64; C = (st & 1) * 32 + (swz % 64) / 2; }
__host__ __device__ __forceinline__ int perm32(int rho) { const int n = rho >> 4, i = rho & 15; return 8 * (i >> 2) + 4 * n + (i & 3); }

struct Unit { int pm, pn; };
struct Gemm { const bf16_t* A; const bf16_t* Bt; int lda, ldb, K, pad; };

struct StaticOrder {
    int nM, nN, nwg, G, c;
    __host__ __device__ void init(int nM_, int nN_, int G_, int c_) { nM = nM_; nN = nN_; nwg = nM * nN; G = G_; c = c_; }
    __host__ __device__ bool next(int i, Unit& u) const {
        const long L = (long)i * G + c; if (L >= nwg) return false;
        int wgid = (int)L; { const int q = nwg / NXCD, r = nwg % NXCD, xcd = wgid % NXCD, off = wgid / NXCD; wgid = (xcd < r ? xcd * (q + 1) : r * (q + 1) + (xcd - r) * q) + off; }
        const int nig = WGM * nN, gid = wgid / nig, fm = gid * WGM, gsz = (nM - fm) < WGM ? (nM - fm) : WGM;
        u.pm = fm + ((wgid % nig) % gsz); u.pn = (wgid % nig) / gsz; return true;
    }
    __device__ __forceinline__ void a_ready(const Unit&) const {}
    __device__ __forceinline__ void done(const Unit&) const {}
};
struct KvOrder {
    int G, c;
    __device__ bool next(int i, Unit& u) const { const int L = i * G + c; if (L >= 128) return false; const int ly = L >> 5, r = L & 31; u.pm = ly * 8 + (r & 7); u.pn = ly * 4 + (r >> 3); return true; }
    __device__ __forceinline__ void a_ready(const Unit&) const {}
    __device__ __forceinline__ void done(const Unit&) const {}
};

__device__ __forceinline__ unsigned cvt_pk_bf16(float lo, float hi) { unsigned r; asm volatile("v_cvt_pk_bf16_f32 %0, %1, %2" : "=v"(r) : "v"(lo), "v"(hi)); return r; }

template <int ACT> struct EpiBf16 {
    static constexpr bool PERM = true, AFTER_DRAIN = false;
    bf16_t* O; int ldc; const unsigned long long* rowss;
    __device__ __forceinline__ void operator()(const f32x4 (&acc)[2][2][4][2], const Unit& u, int wr, int wc, int fr, int fq) const {
        const int row0 = u.pm * BM + wr * 64 + fr; const int col0 = u.pn * BM + wc * 32 + 8 * fq;
        unsigned long long rq[2][4];
#pragma unroll
        for (int ai = 0; ai < 2; ++ai)
#pragma unroll
            for (int m = 0; m < 4; ++m) rq[ai][m] = rowss ? rowss[row0 + ai * HALF + m * 16] : 0ull;
        if (rowss) asm volatile("" : "+v"(rq[0][0]), "+v"(rq[0][1]), "+v"(rq[0][2]), "+v"(rq[0][3]), "+v"(rq[1][0]), "+v"(rq[1][1]), "+v"(rq[1][2]), "+v"(rq[1][3]));
#pragma unroll
        for (int ai = 0; ai < 2; ++ai)
#pragma unroll
            for (int m = 0; m < 4; ++m) { bf16_t* rowp = O + (size_t)(row0 + ai * HALF + m * 16) * ldc + col0;
                const float rs = rowss ? __builtin_amdgcn_rsqf((float)rq[ai][m] * (5.9604644775390625e-08f / 2048.f) + 1e-5f) : 1.f;
#pragma unroll
                for (int bj = 0; bj < 2; ++bj) { f32x4 v0 = acc[ai][bj][m][0] * rs, v1 = acc[ai][bj][m][1] * rs;
                    if (ACT == 1) {
#pragma unroll
                        for (int j = 0; j < 4; ++j) { const float a = fmaxf(v0[j], 0.f), b = fmaxf(v1[j], 0.f); v0[j] = a * a; v1[j] = b * b; } }
                    u32x4 w; w.x = cvt_pk_bf16(v0[0], v0[1]); w.y = cvt_pk_bf16(v0[2], v0[3]); w.z = cvt_pk_bf16(v1[0], v1[1]); w.w = cvt_pk_bf16(v1[2], v1[3]);
                    *(u32x4*)(rowp + bj * HALF) = w; } }
    }
};
struct EpiRes {
    static constexpr bool PERM = false, AFTER_DRAIN = false;
    bf16_t* xb; int ldc; unsigned long long* rowss;
    __device__ __forceinline__ void operator()(const f32x4 (&acc)[2][2][4][2], const Unit& u, int wr, int wc, int fr, int fq) const {
        typedef unsigned u32x2_ __attribute__((ext_vector_type(2)));
        const int row0 = u.pm * BM + wr * 64 + fr, col0 = u.pn * BM + wc * 32 + 4 * fq;
#pragma unroll
        for (int ai = 0; ai < 2; ++ai) {
            u32x2_ bv[4][2][2];
#pragma unroll
            for (int m = 0; m < 4; ++m) { const bf16_t* rp = xb + (size_t)(row0 + ai * HALF + m * 16) * ldc + col0;
#pragma unroll
                for (int bj = 0; bj < 2; ++bj)
#pragma unroll
                    for (int n = 0; n < 2; ++n) bv[m][bj][n] = *(const u32x2_*)(rp + bj * HALF + n * 16); }
#pragma unroll
            for (int m = 0; m < 4; ++m) { bf16_t* rp = xb + (size_t)(row0 + ai * HALF + m * 16) * ldc + col0; float ss = 0.f;
#pragma unroll
                for (int bj = 0; bj < 2; ++bj)
#pragma unroll
                    for (int n = 0; n < 2; ++n) { const u32x2_ b = bv[m][bj][n]; f32x4 x = acc[ai][bj][m][n];
                        x[0] += __uint_as_float(b.x << 16); x[1] += __uint_as_float(b.x & 0xffff0000u); x[2] += __uint_as_float(b.y << 16); x[3] += __uint_as_float(b.y & 0xffff0000u);
                        u32x2_ w; w.x = cvt_pk_bf16(x[0], x[1]); w.y = cvt_pk_bf16(x[2], x[3]); *(u32x2_*)(rp + bj * HALF + n * 16) = w;
                        const float r0 = __uint_as_float(w.x << 16), r1 = __uint_as_float(w.x & 0xffff0000u), r2 = __uint_as_float(w.y << 16), r3 = __uint_as_float(w.y & 0xffff0000u);
                        ss += (r0 * r0 + r1 * r1) + (r2 * r2 + r3 * r3); }
                ss += __shfl_xor(ss, 16); ss += __shfl_xor(ss, 32);
                if (fq == 0) atomicAdd(rowss + row0 + ai * HALF + m * 16, (unsigned long long)(ss * 16777216.0f)); }
            asm volatile("" ::: "memory"); }
    }
};
struct EpiGlu {
    static constexpr bool PERM = true, AFTER_DRAIN = false;
    const bf16_t* Z; bf16_t* O; int ldc; const float* bias;
    __device__ __forceinline__ void operator()(const f32x4 (&acc)[2][2][4][2], const Unit& u, int wr, int wc, int fr, int fq) const {
        const int row0 = u.pm * BM + wr * 64 + fr; const int col0 = u.pn * BM + wc * 32 + 8 * fq;
        f32x4 bv[2][2];
#pragma unroll
        for (int bj = 0; bj < 2; ++bj)
#pragma unroll
            for (int n = 0; n < 2; ++n) bv[bj][n] = *(const f32x4*)(bias + col0 + bj * HALF + 4 * n);
#pragma unroll
        for (int ai = 0; ai < 2; ++ai) {
            u32x4 zq[4][2];
#pragma unroll
            for (int m = 0; m < 4; ++m)
#pragma unroll
                for (int bj = 0; bj < 2; ++bj) zq[m][bj] = *(const u32x4*)(Z + (size_t)(row0 + ai * HALF + m * 16) * ldc + col0 + bj * HALF);
#pragma unroll
            for (int m = 0; m < 4; ++m) { const size_t off = (size_t)(row0 + ai * HALF + m * 16) * ldc + col0;
#pragma unroll
                for (int bj = 0; bj < 2; ++bj) { const f32x4 v0 = acc[ai][bj][m][0] + bv[bj][0], v1 = acc[ai][bj][m][1] + bv[bj][1];
                    const u32x4 zz = zq[m][bj]; float z[8], o[8];
                    z[0] = __uint_as_float(zz.x << 16); z[1] = __uint_as_float(zz.x & 0xffff0000u); z[2] = __uint_as_float(zz.y << 16); z[3] = __uint_as_float(zz.y & 0xffff0000u);
                    z[4] = __uint_as_float(zz.z << 16); z[5] = __uint_as_float(zz.z & 0xffff0000u); z[6] = __uint_as_float(zz.w << 16); z[7] = __uint_as_float(zz.w & 0xffff0000u);
#pragma unroll
                    for (int j = 0; j < 4; ++j) { o[j] = z[j] * __builtin_amdgcn_rcpf(1.f + __expf(-v0[j])); o[4 + j] = z[4 + j] * __builtin_amdgcn_rcpf(1.f + __expf(-v1[j])); }
                    u32x4 w; w.x = cvt_pk_bf16(o[0], o[1]); w.y = cvt_pk_bf16(o[2], o[3]); w.z = cvt_pk_bf16(o[4], o[5]); w.w = cvt_pk_bf16(o[6], o[7]);
                    *(u32x4*)(O + off + bj * HALF) = w; } }
            asm volatile("" ::: "memory"); }
    }
};

template <class Epi, class Sched, bool ALIGN_EPI = false, bool SP2 = false>
__device__ __forceinline__ void gemm_phase(PG8_LAS unsigned char* lds, const Gemm g, const Sched& S, const Epi& E) {
    int tid_l = threadIdx.x; asm volatile("" : "+v"(tid_l));
    const int tid = tid_l, wid = __builtin_amdgcn_readfirstlane(tid >> 6), lane = tid & 63, wr = wid >> 2, wc = wid & 3, fr = lane & 15, fq = lane >> 4;
    const int K = g.K, nt = K / BK;
    unsigned voffA[2], voffB[2];
#pragma unroll
    for (int i = 0; i < 2; ++i) { int R, C; stage_rc(tid * 16 + i * 8192, R, C); const int Rb = Epi::PERM ? ((R & ~31) + perm32(R & 31)) : R;
        voffA[i] = (unsigned)(R * g.lda + C) * 2u; voffB[i] = (unsigned)(Rb * g.ldb + C) * 2u; }
    const size_t kstep = (size_t)(BK * 2);
    const size_t hstepA = (size_t)HALF * g.lda * 2, hstepB = (size_t)HALF * g.ldb * 2;
    const size_t tstepA = 2 * hstepA, tstepB = 2 * hstepB;
    const unsigned ldsw = (unsigned)wid * 1024u;
    const int aoff = lds_byte(wr * 64 + fr, fq * 8), boff = lds_byte(wc * 32 + fr, fq * 8);
#define PG8_SA(b, h) (((b) * 2 + (h)) * HTB)
#define PG8_SB(b, h) ((4 + (b) * 2 + (h)) * HTB)
#define PG8_STAGE(bufoff, gbase, voff) do { _Pragma("unroll") for (int _i = 0; _i < 2; ++_i) \
        __builtin_amdgcn_global_load_lds((const unsigned*)((const char*)(gbase) + (voff)[_i]), (PG8_LAS unsigned*)(lds + (bufoff) + ldsw + _i * 8192), 16, 0, 0); } while (0)
#define PG8_LDA(dst, b, h) do { _Pragma("unroll") for (int m = 0; m < 4; ++m) _Pragma("unroll") for (int k = 0; k < 2; ++k) dst[m][k] = *(const PG8_LAS bf16x8*)(lds + PG8_SA(b, h) + aoff + m * 2048 + k * 1024); } while (0)
#define PG8_LDB(dst, b, h) do { _Pragma("unroll") for (int n = 0; n < 2; ++n) _Pragma("unroll") for (int k = 0; k < 2; ++k) dst[n][k] = *(const PG8_LAS bf16x8*)(lds + PG8_SB(b, h) + boff + n * 2048 + k * 1024); } while (0)
#define PG8_MMA(ai, bj, At, Bt) do { __builtin_amdgcn_s_setprio(1); _Pragma("unroll") for (int m = 0; m < 4; ++m) _Pragma("unroll") for (int n = 0; n < 2; ++n) _Pragma("unroll") for (int k = 0; k < 2; ++k) \
        acc[ai][bj][m][n] = __builtin_amdgcn_mfma_f32_16x16x32_bf16(Bt[n][k], At[m][k], acc[ai][bj][m][n], 0, 0, 0); __builtin_amdgcn_s_setprio(0); } while (0)
#define PG8_WAIT_V(n) asm volatile("s_waitcnt vmcnt(" #n ")" ::: "memory")
#define PG8_WAIT_L(n) asm volatile("s_waitcnt lgkmcnt(" #n ")" ::: "memory")
#define PG8_BAR __builtin_amdgcn_s_barrier()
#define PG8_SCHED __builtin_amdgcn_sched_barrier(0)
    Unit cur, nxt; int ui = 0;
    if (!S.next(0, cur)) return;
    f32x4 acc[2][2][4][2];
#pragma unroll
    for (int a = 0; a < 2; ++a)
#pragma unroll
        for (int b = 0; b < 2; ++b)
#pragma unroll
            for (int m = 0; m < 4; ++m)
#pragma unroll
                for (int n = 0; n < 2; ++n) acc[a][b][m][n] = (f32x4){0.f, 0.f, 0.f, 0.f};
    bf16x8 At[4][2], B0[2][2], B1[2][2];
    const char* cA = (const char*)g.A + (size_t)cur.pm * tstepA; const char* cB = (const char*)g.Bt + (size_t)cur.pn * tstepB;
    S.a_ready(cur);
    if constexpr (SP2) {
        PG8_STAGE(PG8_SB(0, 0), cB, voffB); PG8_STAGE(PG8_SB(0, 1), cB + hstepB, voffB); PG8_STAGE(PG8_SA(0, 0), cA, voffA); PG8_STAGE(PG8_SA(0, 1), cA + hstepA, voffA);
        if (wr == 1) PG8_BAR;
        PG8_WAIT_V(2); PG8_BAR;
        PG8_STAGE(PG8_SB(1, 0), cB + kstep, voffB); PG8_STAGE(PG8_SA(1, 0), cA + kstep, voffA); PG8_STAGE(PG8_SB(1, 1), cB + hstepB + kstep, voffB);
        PG8_WAIT_V(6); PG8_BAR;
    } else {
        PG8_STAGE(PG8_SB(0, 0), cB, voffB); PG8_STAGE(PG8_SA(0, 0), cA, voffA); PG8_STAGE(PG8_SB(0, 1), cB + hstepB, voffB); PG8_STAGE(PG8_SA(0, 1), cA + hstepA, voffA);
        if (wr == 1) PG8_BAR;
        PG8_WAIT_V(4); PG8_BAR;
        PG8_STAGE(PG8_SB(1, 0), cB + kstep, voffB); PG8_STAGE(PG8_SA(1, 0), cA + kstep, voffA); PG8_STAGE(PG8_SB(1, 1), cB + hstepB + kstep, voffB);
        PG8_WAIT_V(6); PG8_BAR;
    }
    for (;;) {
        const bool has_next = S.next(ui + 1, nxt);
        const char* nA = has_next ? (const char*)g.A + (size_t)nxt.pm * tstepA : cA; const char* nB = has_next ? (const char*)g.Bt + (size_t)nxt.pn * tstepB : cB;
        for (int t = 0; t < nt; t += 2) {
            const bool last = (t == nt - 2);
            const char* a1 = cA + (size_t)(t + 1) * kstep;
            const char* a2 = last ? nA : cA + (size_t)(t + 2) * kstep; const char* b2 = last ? nB : cB + (size_t)(t + 2) * kstep;
            const char* a3 = a2 + kstep; const char* b3 = b2 + kstep;
            if (last && has_next) S.a_ready(nxt);
            if constexpr (SP2) {
            PG8_LDB(B0, 0, 0); PG8_LDB(B1, 0, 1); PG8_SCHED; PG8_LDA(At, 0, 0); PG8_STAGE(PG8_SA(1, 1), a1 + hstepA, voffA);
            PG8_WAIT_V(8); PG8_WAIT_L(0); PG8_BAR; PG8_MMA(0, 0, At, B0); PG8_MMA(0, 1, At, B1); PG8_BAR; PG8_SCHED;
            PG8_LDA(At, 0, 1); PG8_STAGE(PG8_SB(0, 0), b2, voffB); PG8_STAGE(PG8_SB(0, 1), b2 + hstepB, voffB); PG8_STAGE(PG8_SA(0, 0), a2, voffA);
            PG8_WAIT_V(8); PG8_WAIT_L(0); PG8_BAR; PG8_MMA(1, 0, At, B0); PG8_MMA(1, 1, At, B1); PG8_BAR; PG8_SCHED;
            PG8_LDB(B0, 1, 0); PG8_LDB(B1, 1, 1); PG8_SCHED; PG8_LDA(At, 1, 0); PG8_STAGE(PG8_SA(0, 1), a2 + hstepA, voffA);
            PG8_WAIT_V(8); PG8_WAIT_L(0); PG8_BAR; PG8_MMA(0, 0, At, B0); PG8_MMA(0, 1, At, B1); PG8_BAR; PG8_SCHED;
            PG8_LDA(At, 1, 1); PG8_STAGE(PG8_SB(1, 0), b3, voffB); PG8_STAGE(PG8_SB(1, 1), b3 + hstepB, voffB); PG8_STAGE(PG8_SA(1, 0), a3, voffA);
            PG8_WAIT_V(8); PG8_WAIT_L(0); PG8_BAR; PG8_MMA(1, 0, At, B0); PG8_MMA(1, 1, At, B1); PG8_BAR; PG8_SCHED;
            } else {
            PG8_LDB(B0, 0, 0); PG8_SCHED; PG8_LDA(At, 0, 0); PG8_STAGE(PG8_SA(1, 1), a1 + hstepA, voffA);
            PG8_WAIT_L(8); PG8_BAR; PG8_WAIT_L(0); PG8_MMA(0, 0, At, B0); PG8_BAR; PG8_SCHED;
            PG8_LDB(B1, 0, 1); PG8_STAGE(PG8_SB(0, 0), b2, voffB);
            PG8_BAR; PG8_WAIT_L(0); PG8_MMA(0, 1, At, B1); PG8_BAR;
            PG8_LDA(At, 0, 1); PG8_STAGE(PG8_SA(0, 0), a2, voffA);
            PG8_BAR; PG8_WAIT_L(0); PG8_MMA(1, 0, At, B0); PG8_BAR; PG8_SCHED;
            PG8_STAGE(PG8_SB(0, 1), b2 + hstepB, voffB);
            PG8_WAIT_V(6); PG8_BAR; PG8_MMA(1, 1, At, B1); PG8_BAR;
            PG8_LDB(B0, 1, 0); PG8_SCHED; PG8_LDA(At, 1, 0); PG8_STAGE(PG8_SA(0, 1), a2 + hstepA, voffA);
            PG8_WAIT_L(8); PG8_BAR; PG8_WAIT_L(0); PG8_MMA(0, 0, At, B0); PG8_BAR; PG8_SCHED;
            PG8_LDB(B1, 1, 1); PG8_STAGE(PG8_SB(1, 0), b3, voffB);
            PG8_BAR; PG8_WAIT_L(0); PG8_MMA(0, 1, At, B1); PG8_BAR;
            PG8_LDA(At, 1, 1); PG8_STAGE(PG8_SA(1, 0), a3, voffA);
            PG8_BAR; PG8_WAIT_L(0); PG8_MMA(1, 0, At, B0); PG8_BAR; PG8_SCHED;
            PG8_STAGE(PG8_SB(1, 1), b3 + hstepB, voffB);
            PG8_WAIT_V(6); PG8_BAR; PG8_MMA(1, 1, At, B1); PG8_BAR;
            }
        }
        if constexpr (ALIGN_EPI) { if (wr == 0) PG8_BAR; }
        E(acc, cur, wr, wc, fr, fq); S.done(cur);
        if (!has_next) break;
#pragma unroll
        for (int a = 0; a < 2; ++a)
#pragma unroll
            for (int b = 0; b < 2; ++b)
#pragma unroll
                for (int m = 0; m < 4; ++m)
#pragma unroll
                    for (int n = 0; n < 2; ++n) acc[a][b][m][n] = (f32x4){0.f, 0.f, 0.f, 0.f};
        cur = nxt; cA = nA; cB = nB; ++ui;
        if constexpr (ALIGN_EPI) { if (wr == 1) PG8_BAR; }
    }
    PG8_WAIT_V(0);
    if constexpr (!ALIGN_EPI) { if (wr == 0) PG8_BAR; }
    PG8_BAR;
#undef PG8_SA
#undef PG8_SB
#undef PG8_STAGE
#undef PG8_LDA
#undef PG8_LDB
#undef PG8_MMA
#undef PG8_WAIT_V
#undef PG8_WAIT_L
#undef PG8_BAR
#undef PG8_SCHED
}
}
#define XB_TMO      128
#define XB_XCNT(j)  (256  + 64 * (j))
#define XB_XSUB(j)  (1280 + 64 * (j))
#define XB_XGEN(j)  (2304 + 64 * (j))
#define XB_TOP      3328
#define XB_TOPGEN   3392
#define XCD_BAR_WORDS 3456
#define XB_SPIN_CAP (1u << 18)
__device__ __forceinline__ unsigned xb_ld(unsigned* p)              { return __hip_atomic_load(p, __ATOMIC_RELAXED, __HIP_MEMORY_SCOPE_AGENT); }
__device__ __forceinline__ unsigned xb_add(unsigned* p, unsigned v) { return __hip_atomic_fetch_add(p, v, __ATOMIC_RELAXED, __HIP_MEMORY_SCOPE_AGENT); }
__device__ __forceinline__ unsigned xb_xcc_id() { return (unsigned)__builtin_amdgcn_s_getreg((3 << 11) | 20) & 0xFu; }
#define XB_SPIN(cond, bar) do { unsigned _sp = 0; while (cond) { __builtin_amdgcn_s_sleep(1); \
    if ((++_sp & 255u) == 0u) { if (xb_ld(&(bar)[XB_TMO])) break; if (_sp > XB_SPIN_CAP) { atomicAdd(&(bar)[XB_TMO], 1u); break; } } } } while (0)
struct XcdBarrier { unsigned* bar; unsigned x; volatile LAS unsigned* st; unsigned G; };
__device__ __forceinline__ XcdBarrier xcd_barrier_post(unsigned* bar, volatile LAS unsigned* st, unsigned G) {
    XcdBarrier b; b.bar = bar; b.x = xb_xcc_id(); b.st = st; b.G = G;
    if (threadIdx.x == 0) (void)xb_add(&bar[XB_XCNT(b.x)], 1u);
    return b;
}
__device__ __forceinline__ void xcd_barrier_complete(unsigned* bar, unsigned x, unsigned G, unsigned& nloc, unsigned& nx) {
    unsigned sum, cnt, mine, sp = 0u;
    for (;;) {
        sum = 0u; cnt = 0u; mine = 0u;
#pragma unroll
        for (unsigned j = 0; j < 16; ++j) { const unsigned c = xb_ld(&bar[XB_XCNT(j)]); sum += c; cnt += (c > 0u) ? 1u : 0u; mine = (j == x) ? c : mine; }
        if (sum == G) break;
        __builtin_amdgcn_s_sleep(1);
        if ((++sp & 255u) == 0u) { if (xb_ld(&bar[XB_TMO])) break; if (sp > XB_SPIN_CAP) { atomicAdd(&bar[XB_TMO], 1u); break; } }
    }
    nloc = mine > 0u ? mine : 1u; nx = cnt > 0u ? cnt : 1u;
}
__device__ __forceinline__ void xcd_barrier(const XcdBarrier& b) {
    asm volatile("s_waitcnt vmcnt(0)" ::: "memory");
    __syncthreads();
    if (threadIdx.x == 0) {
        unsigned* bar = b.bar;
        __builtin_amdgcn_s_waitcnt(0);
        unsigned nloc = b.st[0], nx = b.st[1];
        if (nloc == 0u) { xcd_barrier_complete(bar, b.x, b.G, nloc, nx); b.st[0] = nloc; b.st[1] = nx; }
        const unsigned old = xb_add(&bar[XB_XSUB(b.x)], 1u);
        const unsigned gen = old / nloc;
        if (old + 1u == (gen + 1u) * nloc) {
            __builtin_amdgcn_fence(__ATOMIC_RELEASE, "agent");
            asm volatile("s_waitcnt vmcnt(0)" ::: "memory");
            const unsigned og = xb_add(&bar[XB_TOP], 1u);
            const unsigned tg = og / nx;
            if (og + 1u == (tg + 1u) * nx) xb_add(&bar[XB_TOPGEN], 1u);
            else XB_SPIN(xb_ld(&bar[XB_TOPGEN]) == tg, bar);
            __builtin_amdgcn_fence(__ATOMIC_ACQUIRE, "agent");
            xb_add(&bar[XB_XGEN(b.x)], 1u);
            asm volatile("s_waitcnt vmcnt(0)" ::: "memory");
        } else {
            XB_SPIN(xb_ld(&bar[XB_XGEN(b.x)]) == gen, bar);
            __builtin_amdgcn_fence(__ATOMIC_ACQUIRE, "agent");
            asm volatile("s_waitcnt vmcnt(0)" ::: "memory");
        }
    }
    __syncthreads();
}

constexpr int NWAVES = 8, NTHR = 512;
constexpr int LDS_BYTES = 155648;
constexpr int MISC_OFF = LDS_BYTES - 256;
struct Ctx { unsigned char* lds; int tid, lane, wave, gw, ngw, bid, nb; };

__device__ __forceinline__ void tr_item(const float* __restrict__ W, int ldw, int N, bf16* __restrict__ WT, int ldt, int row_off, int col_off, int kb, int nb, float* scr, int lane, const float* __restrict__ gk) {
    const int k0 = 64 * kb, n0 = 32 * nb; const int n = n0 + (lane & 31);
    float v[32];
    const float* wp = W + (size_t)(k0 + (lane >> 5)) * ldw + (n < N ? n : 0);
#pragma unroll
    for (int i = 0; i < 32; ++i) v[i] = wp[(size_t)(2 * i) * ldw];
    asm volatile("" : "+v"(v[0]), "+v"(v[1]), "+v"(v[2]), "+v"(v[3]), "+v"(v[4]), "+v"(v[5]), "+v"(v[6]), "+v"(v[7]), "+v"(v[8]), "+v"(v[9]), "+v"(v[10]), "+v"(v[11]), "+v"(v[12]), "+v"(v[13]), "+v"(v[14]), "+v"(v[15]));
    asm volatile("" : "+v"(v[16]), "+v"(v[17]), "+v"(v[18]), "+v"(v[19]), "+v"(v[20]), "+v"(v[21]), "+v"(v[22]), "+v"(v[23]), "+v"(v[24]), "+v"(v[25]), "+v"(v[26]), "+v"(v[27]), "+v"(v[28]), "+v"(v[29]), "+v"(v[30]), "+v"(v[31]));
    const float msk = (n < N) ? 1.f : 0.f;
    if (gk) {
        float gv[32];
#pragma unroll
        for (int i = 0; i < 32; ++i) gv[i] = gk[k0 + 2 * i + (lane >> 5)];
#pragma unroll
        for (int i = 0; i < 32; ++i) v[i] *= gv[i];
    }
#pragma unroll
    for (int i = 0; i < 32; ++i) { const int kk = 2 * i + (lane >> 5); scr[kk * 33 + (lane & 31)] = v[i] * msk; }
    __builtin_amdgcn_fence(__ATOMIC_RELEASE, "wavefront"); __builtin_amdgcn_wave_barrier(); __builtin_amdgcn_fence(__ATOMIC_ACQUIRE, "wavefront");
    const int c = lane & 7;
#pragma unroll
    for (int j = 0; j < 4; ++j) { const int nn = (lane >> 3) + 8 * j; const float* s = scr + (8 * c) * 33 + nn;
        u32x4 o; o.x = pk2(s[0 * 33], s[1 * 33]); o.y = pk2(s[2 * 33], s[3 * 33]); o.z = pk2(s[4 * 33], s[5 * 33]); o.w = pk2(s[6 * 33], s[7 * 33]);
        *(u32x4*)(WT + (size_t)(row_off + n0 + nn) * ldt + col_off + k0 + 8 * c) = o; }
    __builtin_amdgcn_fence(__ATOMIC_RELEASE, "wavefront"); __builtin_amdgcn_wave_barrier(); __builtin_amdgcn_fence(__ATOMIC_ACQUIRE, "wavefront");
}
__device__ __forceinline__ void conv_mat(const Ctx& c, const float* W, int K, int ldw, int N, int Npad, bf16* WT, int ldt, int row_off, int col_off, const float* gk = nullptr) {
    float* scr = (float*)(c.lds + c.wave * 8704);
    const int nblk = Npad / 32, nit = (K / 64) * nblk;
    for (int it = c.gw; it < nit; it += c.ngw) tr_item(W, ldw, N, WT, ldt, row_off, col_off, it / nblk, it % nblk, scr, c.lane, gk);
}

__device__ __forceinline__ void norm_rows_bf16(const Ctx& c, const float* __restrict__ X, const float* __restrict__ g, bf16* __restrict__ O, int nrows) {
    f32x4 gv[8];
#pragma unroll
    for (int j = 0; j < 8; ++j) gv[j] = *(const f32x4*)(g + 4 * c.lane + 256 * j);
    for (int m = c.gw; m < nrows; m += c.ngw) {
        const f32x4* xr = (const f32x4*)(X + (size_t)m * D) + c.lane; f32x4 v[8]; float s = 0.f;
#pragma unroll
        for (int j = 0; j < 8; ++j) { v[j] = xr[64 * j]; s += (v[j].x * v[j].x + v[j].y * v[j].y) + (v[j].z * v[j].z + v[j].w * v[j].w); }
        const float rstd = 1.0f / sqrtf(wave_sum(s) * (1.f / D) + NORM_EPS);
        u32x2* o8 = (u32x2*)(O + (size_t)m * D) + c.lane;
#pragma unroll
        for (int j = 0; j < 8; ++j) { u32x2 w; w.x = pk2(v[j].x * rstd * gv[j].x, v[j].y * rstd * gv[j].y); w.y = pk2(v[j].z * rstd * gv[j].z, v[j].w * rstd * gv[j].w); o8[64 * j] = w; }
    }
}
__device__ __forceinline__ void cast_rows_ss(const Ctx& c, const float* __restrict__ X, bf16* __restrict__ O, unsigned long long* rowss, int nrows) {
    for (int m = c.gw; m < nrows; m += c.ngw) {
        const f32x4* xr = (const f32x4*)(X + (size_t)m * D) + c.lane; f32x4 v[8]; float s = 0.f;
#pragma unroll
        for (int j = 0; j < 8; ++j) { v[j] = xr[64 * j]; s += (v[j].x * v[j].x + v[j].y * v[j].y) + (v[j].z * v[j].z + v[j].w * v[j].w); }
        s = wave_sum(s);
        u32x2* o8 = (u32x2*)(O + (size_t)m * D) + c.lane;
#pragma unroll
        for (int j = 0; j < 8; ++j) { u32x2 w; w.x = pk2(v[j].x, v[j].y); w.y = pk2(v[j].z, v[j].w); o8[64 * j] = w; }
        if (c.lane == 0) rowss[m] = (unsigned long long)(s * 16777216.0f);
    }
}
__device__ __forceinline__ void scale_rows_out(const Ctx& c, const bf16* __restrict__ XB, const float* __restrict__ g, const unsigned long long* rowss, float* O, int nrows) {
    for (int m = c.gw; m < nrows; m += c.ngw) {
        const float rstd = 1.0f / sqrtf((float)rowss[m] * (5.9604644775390625e-08f / D) + NORM_EPS);
#pragma unroll
        for (int j = 0; j < 4; ++j) { float x[8]; unpack8(*(const u32x4*)(XB + (size_t)m * D + 8 * c.lane + 512 * j), x);
            const f32x4 g0 = *(const f32x4*)(g + 8 * c.lane + 512 * j), g1 = *(const f32x4*)(g + 8 * c.lane + 512 * j + 4);
            *(f32x4*)(O + (size_t)m * D + 8 * c.lane + 512 * j) = (f32x4){x[0] * rstd * g0.x, x[1] * rstd * g0.y, x[2] * rstd * g0.z, x[3] * rstd * g0.w};
            *(f32x4*)(O + (size_t)m * D + 8 * c.lane + 512 * j + 4) = (f32x4){x[4] * rstd * g1.x, x[5] * rstd * g1.y, x[6] * rstd * g1.z, x[7] * rstd * g1.w}; }
    }
}
__device__ __forceinline__ void norm_rows_f32(const Ctx& c, float* X, const float* __restrict__ g, int nrows) {
    f32x4 gv[8];
#pragma unroll
    for (int j = 0; j < 8; ++j) gv[j] = *(const f32x4*)(g + 4 * c.lane + 256 * j);
    for (int m = c.gw; m < nrows; m += c.ngw) {
        f32x4* xr = (f32x4*)(X + (size_t)m * D) + c.lane; f32x4 v[8]; float s = 0.f;
#pragma unroll
        for (int j = 0; j < 8; ++j) { v[j] = xr[64 * j]; s += (v[j].x * v[j].x + v[j].y * v[j].y) + (v[j].z * v[j].z + v[j].w * v[j].w); }
        const float rstd = 1.0f / sqrtf(wave_sum(s) * (1.f / D) + NORM_EPS);
#pragma unroll
        for (int j = 0; j < 8; ++j) xr[64 * j] = v[j] * rstd * gv[j];
    }
}

__device__ __forceinline__ void rope_tables(const Ctx& c, const int* __restrict__ start_frame, float* ropea, float* ropei) {
    const float HA[16] = {1.000000000e+00f, 4.403665960e-01f, 1.939227432e-01f, 8.539710194e-02f, 3.760603070e-02f, 1.656044088e-02f, 7.292664610e-03f, 3.211446106e-03f, 1.414213562e-03f, 6.227724371e-04f, 2.742481884e-04f, 1.207697351e-04f, 5.318295734e-05f, 2.341999971e-05f, 1.031338525e-05f, 4.541670478e-06f};
    const float LA[16] = {0.000000000e+00f, 6.688275267e-09f, 1.547429962e-09f, -1.652958881e-09f, 2.282729838e-10f, -8.020459852e-10f, 1.273676581e-10f, -1.116812753e-10f, -1.115275407e-14f, -1.514006802e-11f, -1.268531807e-11f, 2.335000249e-12f, 1.624761415e-12f, -7.452659366e-13f, 1.309491117e-13f, 2.687890499e-15f};
    const float HI[8] = {1.000000000e+00f, 1.939227432e-01f, 3.760603070e-02f, 7.292664610e-03f, 1.414213562e-03f, 2.742481884e-04f, 5.318295734e-05f, 1.031338525e-05f};
    const float LI[8] = {0.000000000e+00f, 1.547429962e-09f, 2.282729838e-10f, 1.273676581e-10f, -1.115275407e-14f, -1.268531807e-11f, 1.624761415e-12f, 1.309491117e-13f};
    const int gt = c.bid * NTHR + c.tid, ngt = c.nb * NTHR;
    for (int i = gt; i < M * 24; i += ngt) {
        const int m = i / 24, j = i % 24; const int b = m / SEQ, t = m % SEQ;
        const float pos = (float)(start_frame[b] + t);
        float hi = 0.f, lo = 0.f;
#pragma unroll
        for (int q = 0; q < 16; ++q) if (j == q) { hi = HA[q]; lo = LA[q]; }
#pragma unroll
        for (int q = 0; q < 8; ++q) if (j == 16 + q) { hi = HI[q]; lo = LI[q]; }
        const float p = pos * hi, e = fmaf(pos, hi, -p) + pos * lo;
        float sn, cs; sincosf(p, &sn, &cs);
        const float cc = cs - e * sn, ss = sn + e * cs;
        if (j < 16) { ropea[(size_t)m * 32 + j] = cc; ropea[(size_t)m * 32 + 16 + j] = ss; }
        else { ropei[(size_t)m * 16 + (j - 16)] = cc; ropei[(size_t)m * 16 + 8 + (j - 16)] = ss; }
    }
}

__device__ __forceinline__ void build_wql(const Ctx& c, const float* __restrict__ w_uq, const float* __restrict__ w_uk, bf16* WQ) {
    const int gt = c.bid * NTHR + c.tid, ngt = c.nb * NTHR;
    for (int i = gt; i < 2048 * 512; i += ngt) {
        const int cc = i & 511, hr = i >> 9, h = hr >> 8, r = hr & 255;
        const float* a = w_uq + (size_t)cc * 1024 + h * 128 + 32; const float* b = w_uk + (size_t)r * 768 + h * 96; float s = 0.f;
#pragma unroll 8
        for (int d = 0; d < 96; ++d) s += a[d] * b[d];
        WQ[i] = (bf16)f2bf(s);
    }
}
__device__ __forceinline__ void build_wout(const Ctx& c, const float* __restrict__ w_uv, const float* __restrict__ w_out, bf16* WO) {
    const int gt = c.bid * NTHR + c.tid, ngt = c.nb * NTHR;
    for (int i = gt; i < 8 * 32 * 2048; i += ngt) {
        const int n = i & 2047, rg = (i >> 11) & 31, h = i >> 16; float acc[8];
#pragma unroll
        for (int j = 0; j < 8; ++j) acc[j] = 0.f;
        for (int d = 0; d < 128; ++d) { const float wo = w_out[(size_t)(h * 128 + d) * 2048 + n];
#pragma unroll
            for (int j = 0; j < 8; ++j) acc[j] += w_uv[(size_t)(rg * 8 + j) * 1024 + h * 128 + d] * wo; }
        u32x4 o; o.x = pk2(acc[0], acc[1]); o.y = pk2(acc[2], acc[3]); o.z = pk2(acc[4], acc[5]); o.w = pk2(acc[6], acc[7]);
        *(u32x4*)(WO + (size_t)n * OC + h * 256 + rg * 8) = o;
    }
}

__device__ __forceinline__ void dsa_prep(const Ctx& c, const bf16* __restrict__ H, const float* __restrict__ cqn_g, const float* __restrict__ ckv_g, const float* __restrict__ kidx_g,
                                         const float* __restrict__ ropea, const float* __restrict__ ropei, bf16* CQN, bf16* KF, bf16* KIDX, float* WIDX) {
    const int l = c.lane;
    for (int m = c.gw; m < M; m += c.ngw) {
        const bf16* h = H + (size_t)m * HC;
        {
            float f[8]; unpack8(*(const u32x4*)(h + 8 * l), f); float s = 0.f;
#pragma unroll
            for (int j = 0; j < 8; ++j) s += f[j] * f[j];
            const float rstd = 1.0f / sqrtf(wave_sum(s) * (1.f / 512.f) + NORM_EPS);
            u32x4 o; o.x = pk2(f[0] * rstd * cqn_g[8 * l + 0], f[1] * rstd * cqn_g[8 * l + 1]); o.y = pk2(f[2] * rstd * cqn_g[8 * l + 2], f[3] * rstd * cqn_g[8 * l + 3]);
            o.z = pk2(f[4] * rstd * cqn_g[8 * l + 4], f[5] * rstd * cqn_g[8 * l + 5]); o.w = pk2(f[6] * rstd * cqn_g[8 * l + 6], f[7] * rstd * cqn_g[8 * l + 7]);
            *(u32x4*)(CQN + (size_t)m * 512 + 8 * l) = o;
        }
        {
            const u32x2 w = *(const u32x2*)(h + 512 + 4 * l); const float f0 = bf2f(w.x & 0xffffu), f1 = bf2f(w.x >> 16), f2 = bf2f(w.y & 0xffffu), f3 = bf2f(w.y >> 16);
            const float s = (f0 * f0 + f1 * f1) + (f2 * f2 + f3 * f3);
            const float rstd = 1.0f / sqrtf(wave_sum(s) * (1.f / 256.f) + NORM_EPS);
            u32x2 o; o.x = pk2(f0 * rstd * ckv_g[4 * l + 0], f1 * rstd * ckv_g[4 * l + 1]); o.y = pk2(f2 * rstd * ckv_g[4 * l + 2], f3 * rstd * ckv_g[4 * l + 3]);
            *(u32x2*)(KF + (size_t)m * KFW + 4 * l) = o;
        }
        if (l < 16) {
            const float x1 = bf2f(h[768 + l]), x2 = bf2f(h[768 + 16 + l]); const float cs = ropea[(size_t)m * 32 + l], sn = ropea[(size_t)m * 32 + 16 + l];
            KF[(size_t)m * KFW + 256 + l] = (bf16)f2bf(x1 * cs - x2 * sn); KF[(size_t)m * KFW + 256 + 16 + l] = (bf16)f2bf(x2 * cs + x1 * sn);
        }
        {
            const float v = bf2f(h[800 + l]); const float rstd = 1.0f / sqrtf(wave_sum(v * v) * (1.f / 64.f) + NORM_EPS);
            const float y = v * rstd * kidx_g[l];
            const float ylo = __shfl(y, l & 7), yhi = __shfl(y, (l & 7) + 8);
            float o = y;
            if (l < 16) { const float cs = ropei[(size_t)m * 16 + (l & 7)], sn = ropei[(size_t)m * 16 + 8 + (l & 7)]; o = (l < 8) ? (ylo * cs - yhi * sn) : (yhi * cs + ylo * sn); }
            KIDX[(size_t)m * 64 + l] = (bf16)f2bf(o);
        }
        if (l < 16) WIDX[(size_t)m * 16 + l] = bf2f(h[864 + l]) * 0.03125f;
    }
}
__device__ __forceinline__ void q_rope_fix(const Ctx& c, bf16* QALL, const float* __restrict__ ropea, const float* __restrict__ ropei) {
    const int l = c.lane;
    for (int m = c.gw; m < M; m += c.ngw) {
        bf16* q = QALL + (size_t)m * QC;
#pragma unroll
        for (int i = 0; i < 2; ++i) { const int p = l + 64 * i, hh = p >> 4, j = p & 15; bf16* a = q + 2048 + hh * 32 + j;
            const float x1 = bf2f(a[0]), x2 = bf2f(a[16]); const float cs = ropea[(size_t)m * 32 + j], sn = ropea[(size_t)m * 32 + 16 + j];
            a[0] = (bf16)f2bf(x1 * cs - x2 * sn); a[16] = (bf16)f2bf(x2 * cs + x1 * sn); }
#pragma unroll
        for (int i = 0; i < 2; ++i) { const int p = l + 64 * i, hh = p >> 3, j = p & 7; bf16* a = q + 2304 + hh * 64 + j;
            const float x1 = bf2f(a[0]), x2 = bf2f(a[8]); const float cs = ropei[(size_t)m * 16 + j], sn = ropei[(size_t)m * 16 + 8 + j];
            a[0] = (bf16)f2bf(x1 * cs - x2 * sn); a[8] = (bf16)f2bf(x2 * cs + x1 * sn); }
    }
}
__device__ __forceinline__ size_t sc_row_off(int b, int t) { const int ch = t >> 6; return (size_t)b * SC_PER_BATCH + (size_t)4096 * (ch * (ch + 1) / 2) + (size_t)(t & 63) * (64 * (ch + 1)); }
__device__ __forceinline__ void idx_scores_simple(const Ctx& c, const bf16* __restrict__ QALL, const bf16* __restrict__ KIDX, const float* __restrict__ WIDX, float* SC) {
    float* qs = (float*)c.lds;
    float* ws = qs + 1024;
    for (int m = c.bid; m < M; m += c.nb) {
        const int b = m / SEQ, t = m % SEQ, limit = ((t >> 6) + 1) * 64;
        __syncthreads();
        for (int i = c.tid; i < 1024; i += NTHR) qs[i] = bf2f(QALL[(size_t)m * QC + 2304 + i]);
        if (c.tid < 16) ws[c.tid] = WIDX[(size_t)m * 16 + c.tid];
        __syncthreads();
        if (limit <= 256) continue;
        float* row = SC + sc_row_off(b, t);
        for (int s = c.tid; s < limit; s += NTHR) {
            float k[64]; const u32x4* kp = (const u32x4*)(KIDX + (size_t)(b * SEQ + s) * 64);
#pragma unroll
            for (int j = 0; j < 8; ++j) unpack8(kp[j], k + 8 * j);
            float sc = 0.f;
#pragma unroll 1
            for (int h = 0; h < 16; ++h) { asm volatile("" ::: "memory"); float d = 0.f; const f32x4* q4 = (const f32x4*)(qs + h * 64);
#pragma unroll
                for (int j = 0; j < 16; ++j) { const f32x4 q = q4[j]; d += (q.x * k[4 * j] + q.y * k[4 * j + 1]) + (q.z * k[4 * j + 2] + q.w * k[4 * j + 3]); }
                sc += ws[h] * fmaxf(d, 0.f); }
            row[s] = sc;
        }
    }
}
__device__ __forceinline__ void select_row(const float* row, int limit, unsigned short* sel, int l_in, unsigned short* stg = nullptr) {
    int l = l_in; asm volatile("" : "+v"(l));
    const int ng = limit >> 9;
    unsigned key[64];
#pragma unroll
    for (int jg = 0; jg < 8; ++jg) {
        if (jg <= ng) {
#pragma unroll
            for (int j = 8 * jg; j < 8 * jg + 8; ++j) { const int s = j * 64 + l; key[j] = __float_as_uint(row[s < limit ? s : 0]); }
        } else {
#pragma unroll
            for (int j = 8 * jg; j < 8 * jg + 8; ++j) key[j] = 0u;
        }
    }
#pragma unroll
    for (int j = 0; j < 64; ++j) { const int s = j * 64 + l; unsigned u = key[j]; u = (u & 0x80000000u) ? ~u : (u | 0x80000000u); key[j] = (s < limit) ? u : 0u; }
    unsigned mx = 0u;
#pragma unroll
    for (int j = 0; j < 64; ++j) mx = key[j] > mx ? key[j] : mx;
#pragma unroll
    for (int o = 1; o < 64; o <<= 1) { const unsigned t = (unsigned)__shfl_xor((int)mx, o); mx = t > mx ? t : mx; }
    mx = (unsigned)__builtin_amdgcn_readfirstlane((int)mx);
    auto wave_count = [&](int v) -> int {
        v += __builtin_amdgcn_update_dpp(0, v, 0xB1, 0xf, 0xf, true); v += __builtin_amdgcn_update_dpp(0, v, 0x4E, 0xf, 0xf, true);
        v += __builtin_amdgcn_update_dpp(0, v, 0x141, 0xf, 0xf, true); v += __builtin_amdgcn_update_dpp(0, v, 0x140, 0xf, 0xf, true);
        return __builtin_amdgcn_readlane(v, 0) + __builtin_amdgcn_readlane(v, 16) + __builtin_amdgcn_readlane(v, 32) + __builtin_amdgcn_readlane(v, 48); };
    unsigned T = 0u;
#pragma unroll 1
    for (int bit = 31 - __builtin_clz(mx | 1u); bit >= 0; --bit) {
        const unsigned Tn = T | (1u << bit); int cl = 0;
#pragma unroll
        for (int jg = 0; jg < 8; ++jg) if (jg <= ng) {
#pragma unroll
            for (int j = 8 * jg; j < 8 * jg + 8; ++j) cl += (key[j] >= Tn) ? 1 : 0; }
        const int cnt = wave_count(cl);
        if (cnt >= 256) T = Tn;
        if (cnt == 256) break;
    }
    int cgl = 0;
#pragma unroll
    for (int j = 0; j < 64; ++j) cgl += (key[j] > T) ? 1 : 0;
    const int cgt = wave_count(cgl);
    const int need_eq = 256 - cgt;
    int base = 0, beq = 0;
    const unsigned long long lt = (1ull << l) - 1ull;
    if (stg) {
#pragma unroll
        for (int jg = 0; jg < 8; ++jg) if (jg <= ng) {
#pragma unroll
            for (int j = 8 * jg; j < 8 * jg + 8; ++j) {
                const unsigned long long mg = __ballot(key[j] > T);
                const int pos = base + (int)__builtin_amdgcn_mbcnt_hi((unsigned)(mg >> 32), __builtin_amdgcn_mbcnt_lo((unsigned)mg, 0u));
                if (key[j] > T) stg[pos] = (unsigned short)(j * 64 + l);
                base += __popcll(mg);
                const unsigned long long me = __ballot(key[j] == T);
                if (me != 0ull) {
                    const int pe = beq + (int)__builtin_amdgcn_mbcnt_hi((unsigned)(me >> 32), __builtin_amdgcn_mbcnt_lo((unsigned)me, 0u));
                    if (key[j] == T && pe < need_eq) stg[cgt + pe] = (unsigned short)(j * 64 + l);
                    beq += __popcll(me);
                }
            }
        }
        __builtin_amdgcn_fence(__ATOMIC_RELEASE, "wavefront"); __builtin_amdgcn_wave_barrier(); __builtin_amdgcn_fence(__ATOMIC_ACQUIRE, "wavefront");
        *(u32x2*)(sel + 4 * l) = *(const u32x2*)(stg + 4 * l);
        __builtin_amdgcn_fence(__ATOMIC_RELEASE, "wavefront"); __builtin_amdgcn_wave_barrier(); __builtin_amdgcn_fence(__ATOMIC_ACQUIRE, "wavefront");
        return;
    }
#pragma unroll
    for (int jg = 0; jg < 8; ++jg) if (jg <= ng) {
#pragma unroll
        for (int j = 8 * jg; j < 8 * jg + 8; ++j) {
            const unsigned long long mg = __ballot(key[j] > T), me = __ballot(key[j] == T);
            if (key[j] > T) sel[base + __popcll(mg & lt)] = (unsigned short)(j * 64 + l);
            base += __popcll(mg);
            const int pe = beq + __popcll(me & lt);
            if (key[j] == T && pe < need_eq) sel[cgt + pe] = (unsigned short)(j * 64 + l);
            beq += __popcll(me);
        }
    }
}
__device__ __forceinline__ void bs_transpose32(unsigned (&A)[32]) {
    unsigned m = 0x0000FFFFu;
#pragma unroll
    for (int j = 16; j != 0; j >>= 1) {
#pragma unroll
        for (int k = 0; k < 32; ++k) {
            if ((k & j) == 0) {
                const unsigned t = (A[k] ^ (A[k + j] >> j)) & m;
                A[k] ^= t; A[k + j] ^= (t << j);
            }
        }
        m ^= (m << (j >> 1));
    }
}
__device__ __forceinline__ void select_row_bs(const float* row, int limit, unsigned short* sel, int l_in, unsigned short* stg) {
    int l = l_in; asm volatile("" : "+v"(l));
    const int nsl = limit >> 6;
    const int ng = limit >> 9;
    unsigned lo[32], hi[32];
#pragma unroll
    for (int jg = 0; jg < 8; ++jg) {
        if (jg <= ng) {
#pragma unroll
            for (int j = 8 * jg; j < 8 * jg + 8; ++j) { const int s = j * 64 + l; const unsigned u = __float_as_uint(row[s < limit ? s : 0]);
                if (j < 32) lo[j & 31] = u; else hi[j & 31] = u; }
        } else {
#pragma unroll
            for (int j = 8 * jg; j < 8 * jg + 8; ++j) { if (j < 32) lo[j & 31] = 0u; else hi[j & 31] = 0u; }
        }
    }
    asm volatile("" ::: "memory");
#pragma unroll
    for (int j = 0; j < 64; ++j) { const unsigned u = (j < 32) ? lo[j & 31] : hi[j & 31];
        const unsigned kx = (j < nsl) ? ((u & 0x80000000u) ? ~u : (u | 0x80000000u)) : 0u;
        if (j < 32) lo[j & 31] = kx; else hi[j & 31] = kx; }
    const bool has_hi = nsl > 32;
    bs_transpose32(lo);
    if (has_hi) bs_transpose32(hi);
    auto wave_count = [&](int v) -> int {
        v += __builtin_amdgcn_update_dpp(0, v, 0xB1, 0xf, 0xf, true); v += __builtin_amdgcn_update_dpp(0, v, 0x4E, 0xf, 0xf, true);
        v += __builtin_amdgcn_update_dpp(0, v, 0x141, 0xf, 0xf, true); v += __builtin_amdgcn_update_dpp(0, v, 0x140, 0xf, 0xf, true);
        return __builtin_amdgcn_readlane(v, 0) + __builtin_amdgcn_readlane(v, 16) + __builtin_amdgcn_readlane(v, 32) + __builtin_amdgcn_readlane(v, 48); };
    unsigned clo = 0xffffffffu, chi = has_hi ? 0xffffffffu : 0u, glo = 0u, ghi = 0u;
    int G = 0;
#pragma unroll
    for (int i = 0; i < 32; ++i) {
        const unsigned olo = clo & lo[i], ohi = chi & hi[i];
        const int tot = G + wave_count(__builtin_popcount(olo) + __builtin_popcount(ohi));
        const bool take = tot >= 256;
        const unsigned mt = take ? 0u : 0xffffffffu;
        G = take ? G : tot;
        glo |= olo & mt; ghi |= ohi & mt;
        clo = olo ^ (clo & mt); chi = ohi ^ (chi & mt);
        if (tot == 256) break;
    }
    {
        const int need = 256 - G;
        const int ceq = wave_count(__builtin_popcount(clo) + __builtin_popcount(chi));
        if (ceq == need) { glo |= clo; ghi |= chi; }
        else {
            int beq = 0;
#pragma unroll 1
            for (int k = 0; k < 64; ++k) {
                const unsigned bm = 0x80000000u >> (k & 31);
                const bool mine = ((k < 32 ? clo : chi) & bm) != 0u;
                const unsigned long long me = __ballot(mine);
                if (me != 0ull) {
                    const int pe = beq + (int)__builtin_amdgcn_mbcnt_hi((unsigned)(me >> 32), __builtin_amdgcn_mbcnt_lo((unsigned)me, 0u));
                    if (mine && pe < need) { if (k < 32) glo |= bm; else ghi |= bm; }
                    beq += __popcll(me);
                }
            }
        }
    }
    const int cl = __builtin_popcount(glo) + __builtin_popcount(ghi);
    int inc = cl;
#pragma unroll
    for (int o = 1; o < 64; o <<= 1) { const int t = __shfl_up(inc, o); inc += (l >= o) ? t : 0; }
    int pos = inc - cl;
    while (__ballot(glo != 0u) != 0ull) {
        if (glo != 0u) { const int s = __builtin_clz(glo); glo &= ~(0x80000000u >> s); stg[pos++] = (unsigned short)(s * 64 + l); }
    }
    while (__ballot(ghi != 0u) != 0ull) {
        if (ghi != 0u) { const int s = __builtin_clz(ghi); ghi &= ~(0x80000000u >> s); stg[pos++] = (unsigned short)((32 + s) * 64 + l); }
    }
    __builtin_amdgcn_fence(__ATOMIC_RELEASE, "wavefront"); __builtin_amdgcn_wave_barrier(); __builtin_amdgcn_fence(__ATOMIC_ACQUIRE, "wavefront");
    *(u32x2*)(sel + 4 * l) = *(const u32x2*)(stg + 4 * l);
    __builtin_amdgcn_fence(__ATOMIC_RELEASE, "wavefront"); __builtin_amdgcn_wave_barrier(); __builtin_amdgcn_fence(__ATOMIC_ACQUIRE, "wavefront");
}
__device__ __forceinline__ void topk_select(const Ctx& c, const float* __restrict__ SC, bf16* SEL  ) {
    const int l = c.lane;
    for (int m = c.gw; m < M; m += c.ngw) {
        const int b = m / SEQ, t = m % SEQ, limit = ((t >> 6) + 1) * 64;
        unsigned short* sel = (unsigned short*)SEL + (size_t)m * 256;
        if (limit <= 256) { for (int i = l; i < 256; i += 64) sel[i] = (unsigned short)(i < limit ? i : 0); continue; }
        select_row(SC + sc_row_off(b, t), limit, sel, l);
    }
}
__device__ __forceinline__ void dsa_attn_simple(const Ctx& c, const bf16* __restrict__ QALL, const bf16* __restrict__ KF, const bf16* __restrict__ SEL, bf16* OLY, int mmax = M) {
    float* qf = (float*)c.lds;
    float* P = qf + 8 * 288;
    int* sl = (int*)(P + 8 * 256);
    const float scale = 0.08838834764831845f;
    for (int m = c.bid; m < mmax; m += c.nb) {
        const int b = m / SEQ, t = m % SEQ, limit = ((t >> 6) + 1) * 64, cnt = limit < 256 ? limit : 256;
        __syncthreads();
        for (int i = c.tid; i < 8 * 288; i += NTHR) { const int h = i / 288, d = i % 288; qf[i] = bf2f(d < 256 ? QALL[(size_t)m * QC + h * 256 + d] : QALL[(size_t)m * QC + 2048 + h * 32 + (d - 256)]); }
        if (c.tid < 256) sl[c.tid] = (int)((const unsigned short*)SEL)[(size_t)m * 256 + c.tid];
        __syncthreads();
        if (c.tid < 256) {
            float acc[8];
#pragma unroll
            for (int h = 0; h < 8; ++h) acc[h] = 0.f;
            if (c.tid < cnt) {
                const u32x4* kp = (const u32x4*)(KF + (size_t)(b * SEQ + sl[c.tid]) * KFW);
                for (int ch = 0; ch < 36; ++ch) { float k[8]; unpack8(kp[ch], k);
#pragma unroll
                    for (int h = 0; h < 8; ++h) { const float* q = qf + h * 288 + ch * 8;
#pragma unroll
                        for (int j = 0; j < 8; ++j) acc[h] += k[j] * q[j]; } }
            }
#pragma unroll
            for (int h = 0; h < 8; ++h) P[h * 256 + c.tid] = (c.tid < cnt) ? acc[h] * scale : -INFINITY;
        }
        __syncthreads();
        {
            const int h = c.wave; float v[4]; float mx = -INFINITY;
#pragma unroll
            for (int i = 0; i < 4; ++i) { v[i] = P[h * 256 + c.lane + 64 * i]; mx = fmaxf(mx, v[i]); }
            mx = wave_max(mx); float s = 0.f;
#pragma unroll
            for (int i = 0; i < 4; ++i) { v[i] = __expf(v[i] - mx); s += v[i]; }
            s = wave_sum(s); const float inv = 1.f / s;
#pragma unroll
            for (int i = 0; i < 4; ++i) P[h * 256 + c.lane + 64 * i] = v[i] * inv;
        }
        __syncthreads();
        {
            const int r = c.tid & 255, hg = c.tid >> 8; float o[4] = {0.f, 0.f, 0.f, 0.f};
            for (int i = 0; i < cnt; ++i) { const float v = bf2f(KF[(size_t)(b * SEQ + sl[i]) * KFW + r]);
#pragma unroll
                for (int hh = 0; hh < 4; ++hh) o[hh] += P[(hg * 4 + hh) * 256 + i] * v; }
#pragma unroll
            for (int hh = 0; hh < 4; ++hh) OLY[(size_t)m * OC + (hg * 4 + hh) * 256 + r] = (bf16)f2bf(o[hh]);
        }
    }
}
__device__ __forceinline__ void xattn_simple(const Ctx& c, const bf16* __restrict__ XQ, const bf16* __restrict__ KVBIG, int layer, bf16* XO) {
    float* qf = (float*)c.lds;
    float* P = qf + 512;
    const float scale = 0.08838834764831845f;
    for (int m = c.bid; m < M; m += c.nb) {
        const int b = m / SEQ;
        const bf16* kvb = KVBIG + (size_t)(layer * 2048 + b * 256) * 4096 + layer * 1024;
        __syncthreads();
        qf[c.tid] = bf2f(XQ[(size_t)m * 512 + c.tid]);
        __syncthreads();
        {
            const int j = c.tid & 255, hp = c.tid >> 8;
#pragma unroll
            for (int hh = 0; hh < 2; ++hh) { const int h = hp * 2 + hh; const u32x4* kp = (const u32x4*)(kvb + (size_t)j * 4096 + h * 128); float d = 0.f;
                for (int ch = 0; ch < 16; ++ch) { float k[8]; unpack8(kp[ch], k);
#pragma unroll
                    for (int e = 0; e < 8; ++e) d += k[e] * qf[h * 128 + ch * 8 + e]; }
                P[h * 256 + j] = d * scale; }
        }
        __syncthreads();
        if (c.wave < 4) { const int h = c.wave; float v[4]; float mx = -INFINITY;
#pragma unroll
            for (int i = 0; i < 4; ++i) { v[i] = P[h * 256 + c.lane + 64 * i]; mx = fmaxf(mx, v[i]); }
            mx = wave_max(mx); float s = 0.f;
#pragma unroll
            for (int i = 0; i < 4; ++i) { v[i] = __expf(v[i] - mx); s += v[i]; }
            s = wave_sum(s); const float inv = 1.f / s;
#pragma unroll
            for (int i = 0; i < 4; ++i) P[h * 256 + c.lane + 64 * i] = v[i] * inv; }
        __syncthreads();
        {   const int h = c.tid >> 7; float o = 0.f;
            for (int j = 0; j < 256; ++j) o += P[h * 256 + j] * bf2f(kvb[(size_t)j * 4096 + 512 + c.tid]);
            XO[(size_t)m * 512 + c.tid] = (bf16)f2bf(o); }
    }
}
__device__ __forceinline__ float x16_max(float v) { const unsigned u = __builtin_bit_cast(unsigned, v); auto r = __builtin_amdgcn_permlane16_swap(u, u, false, false); return fmaxf(__builtin_bit_cast(float, (unsigned)r[0]), __builtin_bit_cast(float, (unsigned)r[1])); }
__device__ __forceinline__ float x32_max(float v) { const unsigned u = __builtin_bit_cast(unsigned, v); auto r = __builtin_amdgcn_permlane32_swap(u, u, false, false); return fmaxf(__builtin_bit_cast(float, (unsigned)r[0]), __builtin_bit_cast(float, (unsigned)r[1])); }
__device__ __forceinline__ float x16_sum(float v) { const unsigned u = __builtin_bit_cast(unsigned, v); auto r = __builtin_amdgcn_permlane16_swap(u, u, false, false); return __builtin_bit_cast(float, (unsigned)r[0]) + __builtin_bit_cast(float, (unsigned)r[1]); }
__device__ __forceinline__ float x32_sum(float v) { const unsigned u = __builtin_bit_cast(unsigned, v); auto r = __builtin_amdgcn_permlane32_swap(u, u, false, false); return __builtin_bit_cast(float, (unsigned)r[0]) + __builtin_bit_cast(float, (unsigned)r[1]); }
typedef short bf16x8 __attribute__((ext_vector_type(8)));
typedef short bf16x4 __attribute__((ext_vector_type(4)));
__device__ __forceinline__ bf16x4 tr_read4(const unsigned char* p) { return __builtin_amdgcn_ds_read_tr16_b64_v4i16((LAS bf16x4*)p); }
__device__ __forceinline__ bf16x8 cat8(bf16x4 a, bf16x4 b) { return __builtin_shufflevector(a, b, 0, 1, 2, 3, 4, 5, 6, 7); }
__device__ __forceinline__ bf16x8 pack_p8(const f32x4 a, const f32x4 b) {
    u32x4 w; w.x = pg8::cvt_pk_bf16(a[0], a[1]); w.y = pg8::cvt_pk_bf16(a[2], a[3]); w.z = pg8::cvt_pk_bf16(b[0], b[1]); w.w = pg8::cvt_pk_bf16(b[2], b[3]);
    return __builtin_bit_cast(bf16x8, w);
}
__device__ __forceinline__ bf16x8 rope_frag(const bf16x8 xf, const bf16x8 pf, const float* cs, const float* sn, bool lo) {
    float x[8], p[8]; unpack8(__builtin_bit_cast(u32x4, xf), x); unpack8(__builtin_bit_cast(u32x4, pf), p);
    const float sg = lo ? -1.f : 1.f; float o[8];
#pragma unroll
    for (int j = 0; j < 8; ++j) o[j] = x[j] * cs[j] + sg * p[j] * sn[j];
    u32x4 w; w.x = pg8::cvt_pk_bf16(o[0], o[1]); w.y = pg8::cvt_pk_bf16(o[2], o[3]); w.z = pg8::cvt_pk_bf16(o[4], o[5]); w.w = pg8::cvt_pk_bf16(o[6], o[7]);
    return __builtin_bit_cast(bf16x8, w);
}
__device__ __forceinline__ bf16x8 xchg_frag(const bf16x8 v, int lane_xor) { u32x4 u = __builtin_bit_cast(u32x4, v); u32x4 r;
    r.x = (unsigned)__shfl_xor((int)u.x, lane_xor); r.y = (unsigned)__shfl_xor((int)u.y, lane_xor); r.z = (unsigned)__shfl_xor((int)u.z, lane_xor); r.w = (unsigned)__shfl_xor((int)u.w, lane_xor); return __builtin_bit_cast(bf16x8, r); }
constexpr int XA_PITCH = 272;
__device__ __forceinline__ void xattn_mfma(const Ctx& c, const bf16* __restrict__ XQ, const bf16* __restrict__ KVBIG, int layer, bf16* XO) {
    unsigned char* Kl = c.lds; unsigned char* Vl = c.lds + 256 * XA_PITCH;
    const int l = c.lane, n16 = l & 15, g = l >> 4;
    const float scale = 0.08838834764831845f * 1.4426950408889634f;
    for (int unit = c.bid; unit < 256; unit += c.nb) {
        const int b = unit >> 5, h = (unit >> 3) & 3, qc = unit & 7;
        const bf16* kvb = KVBIG + (size_t)(layer * 2048 + b * 256) * 4096 + layer * 1024 + h * 128;
        __syncthreads();
        {
            u32x4 kq[8], vq[8];
#pragma unroll
            for (int j = 0; j < 8; ++j) { const int i = c.tid + NTHR * j, row = i >> 4, ch = i & 15; kq[j] = *(const u32x4*)(kvb + (size_t)row * 4096 + ch * 8); vq[j] = *(const u32x4*)(kvb + (size_t)row * 4096 + 512 + ch * 8); }
#pragma unroll
            for (int j = 0; j < 8; ++j) { const int i = c.tid + NTHR * j, row = i >> 4, ch = i & 15; *(u32x4*)(Kl + row * XA_PITCH + ch * 16) = kq[j]; *(u32x4*)(Vl + row * XA_PITCH + ch * 16) = vq[j]; }
        }
        __syncthreads();
#pragma unroll 1
        for (int g4 = 0; g4 < 4; ++g4) {
            const size_t m = (size_t)b * SEQ + qc * 512 + c.wave * 64 + g4 * 16 + n16;
            bf16x8 Qb[4];
#pragma unroll
            for (int kk = 0; kk < 4; ++kk) Qb[kk] = *(const bf16x8*)(XQ + m * 512 + h * 128 + 32 * kk + 8 * g);
            f32x4 S[16];
#pragma unroll
            for (int j = 0; j < 16; ++j) { S[j] = (f32x4){0.f, 0.f, 0.f, 0.f};
#pragma unroll
                for (int kk = 0; kk < 4; ++kk) { const bf16x8 A = *(const bf16x8*)(Kl + (16 * j + n16) * XA_PITCH + (32 * kk + 8 * g) * 2);
                    S[j] = __builtin_amdgcn_mfma_f32_16x16x32_bf16(A, Qb[kk], S[j], 0, 0, 0); } }
            float mx = -INFINITY;
#pragma unroll
            for (int j = 0; j < 16; ++j) mx = fmaxf(mx, fmaxf(fmaxf(S[j][0], S[j][1]), fmaxf(S[j][2], S[j][3])));
            mx = x32_max(x16_max(mx));
            float sum = 0.f; const float mo = mx * scale;
#pragma unroll
            for (int j = 0; j < 16; ++j) {
#pragma unroll
                for (int r = 0; r < 4; ++r) { const float p = __builtin_amdgcn_exp2f(S[j][r] * scale - mo); S[j][r] = p; sum += p; } }
            sum = x32_sum(x16_sum(sum));
            const float inv = 1.f / sum;
            bf16x8 Pb[8];
#pragma unroll
            for (int jj = 0; jj < 8; ++jj) Pb[jj] = pack_p8(S[2 * jj], S[2 * jj + 1]);
            const int q4 = n16 >> 2, p4 = l & 3;
#pragma unroll
            for (int dt = 0; dt < 8; ++dt) { f32x4 O = (f32x4){0.f, 0.f, 0.f, 0.f};
#pragma unroll
                for (int jj = 0; jj < 8; ++jj) { const unsigned char* vp = Vl + (32 * jj + 4 * g + q4) * XA_PITCH + (16 * dt) * 2 + 8 * p4;
                    const bf16x8 A = cat8(tr_read4(vp), tr_read4(vp + 16 * XA_PITCH));
                    O = __builtin_amdgcn_mfma_f32_16x16x32_bf16(A, Pb[jj], O, 0, 0, 0); }
                u32x2 w; w.x = pg8::cvt_pk_bf16(O[0] * inv, O[1] * inv); w.y = pg8::cvt_pk_bf16(O[2] * inv, O[3] * inv);
                *(u32x2*)(XO + m * 512 + h * 128 + 16 * dt + 4 * g) = w; }
        }
    }
}
__device__ __forceinline__ void diag_cmp_bf16(const Ctx& c, const bf16* A, int lda, const bf16* B, int ldb, int rows, int cols, float* acc) {
    float d2 = 0.f, a2 = 0.f;
    const size_t n = (size_t)rows * cols;
    for (size_t i = (size_t)c.bid * NTHR + c.tid; i < n; i += (size_t)c.nb * NTHR) { const size_t r = i / cols, cc = i % cols; const float a = bf2f(A[r * lda + cc]), b = bf2f(B[r * ldb + cc]); d2 += (a - b) * (a - b); a2 += a * a; }
    d2 = wave_sum(d2); a2 = wave_sum(a2);
    if (c.lane == 0) { atomicAdd(acc, d2); atomicAdd(acc + 1, a2); }
}
constexpr int DA_PITCH = 528, DA_WAVE_BYTES = 32 * DA_PITCH;
__device__ __forceinline__ void dsa_attn_mfma(const Ctx& c, const bf16* __restrict__ QALL, const bf16* __restrict__ KF, const bf16* __restrict__ SEL, const float* __restrict__ ROPEA, bf16* OLY, int m_first, int m_stride, int m_end) {
    unsigned char* Vw = c.lds + c.wave * DA_WAVE_BYTES;
    const int l = c.lane, n16 = l & 15, g = l >> 4, q4 = n16 >> 2, p4 = l & 3, hh = n16 & 7;
    const float scale = 0.08838834764831845f * 1.4426950408889634f;
#pragma unroll 1
    for (int m = m_first; m < m_end; m += m_stride) {
        const int b = m / SEQ, t = m % SEQ, limit = ((t >> 6) + 1) * 64, cnt = limit < 256 ? limit : 256, nblk = cnt >> 5;
        const bf16* qrow = QALL + (size_t)m * QC;
        bf16x8 Qb[9];
#pragma unroll
        for (int kk = 0; kk < 8; ++kk) Qb[kk] = *(const bf16x8*)(qrow + hh * 256 + 32 * kk + 8 * g);
        Qb[8] = *(const bf16x8*)(qrow + 2048 + hh * 32 + 8 * g);
        {
            const bf16x8 pf = xchg_frag(Qb[8], 32); float cs[8], sn[8];
            const f32x4 c0 = *(const f32x4*)(ROPEA + (size_t)m * 32 + 8 * (g & 1)), c1 = *(const f32x4*)(ROPEA + (size_t)m * 32 + 8 * (g & 1) + 4), s0 = *(const f32x4*)(ROPEA + (size_t)m * 32 + 16 + 8 * (g & 1)), s1 = *(const f32x4*)(ROPEA + (size_t)m * 32 + 16 + 8 * (g & 1) + 4);
            cs[0] = c0.x; cs[1] = c0.y; cs[2] = c0.z; cs[3] = c0.w; cs[4] = c1.x; cs[5] = c1.y; cs[6] = c1.z; cs[7] = c1.w; sn[0] = s0.x; sn[1] = s0.y; sn[2] = s0.z; sn[3] = s0.w; sn[4] = s1.x; sn[5] = s1.y; sn[6] = s1.z; sn[7] = s1.w;
            Qb[8] = rope_frag(Qb[8], pf, cs, sn, g < 2); }
        f32x4 O[16];
#pragma unroll
        for (int dt = 0; dt < 16; ++dt) O[dt] = (f32x4){0.f, 0.f, 0.f, 0.f};
        float mrun = -INFINITY, lrun = 0.f;
        const unsigned short* selp = (const unsigned short*)SEL + (size_t)m * 256;
        const bf16* kfb = KF + (size_t)b * SEQ * KFW;
        bf16x8 K0[9], K1[9];
        int sx0, sx1;
#define DA_IDX(BLK) do { sx0 = selp[32 * (BLK) + n16]; sx1 = selp[32 * (BLK) + 16 + n16]; } while (0)
#define DA_GATHER() do { const bf16* r0_ = kfb + (size_t)sx0 * KFW + 8 * g; const bf16* r1_ = kfb + (size_t)sx1 * KFW + 8 * g; \
            _Pragma("unroll") for (int kk = 0; kk < 9; ++kk) { K0[kk] = *(const bf16x8*)(r0_ + 32 * kk); K1[kk] = *(const bf16x8*)(r1_ + 32 * kk); } } while (0)
        DA_IDX(0); DA_GATHER(); DA_IDX(nblk > 1 ? 1 : 0);
#pragma unroll 1
        for (int blk = 0; blk < nblk; ++blk) {
            f32x4 S0 = (f32x4){0.f, 0.f, 0.f, 0.f}, S1 = (f32x4){0.f, 0.f, 0.f, 0.f};
#pragma unroll
            for (int kk = 0; kk < 9; ++kk) { S0 = __builtin_amdgcn_mfma_f32_16x16x32_bf16(K0[kk], Qb[kk], S0, 0, 0, 0); S1 = __builtin_amdgcn_mfma_f32_16x16x32_bf16(K1[kk], Qb[kk], S1, 0, 0, 0); }
#pragma unroll
            for (int kk = 0; kk < 8; ++kk) { *(bf16x8*)(Vw + n16 * DA_PITCH + (32 * kk + 8 * g) * 2) = K0[kk]; *(bf16x8*)(Vw + (16 + n16) * DA_PITCH + (32 * kk + 8 * g) * 2) = K1[kk]; }
            __builtin_amdgcn_sched_barrier(0);
            if (blk + 1 < nblk) { DA_GATHER(); DA_IDX(blk + 2 < nblk ? blk + 2 : blk + 1); }
            __builtin_amdgcn_sched_barrier(0);
            float bm = fmaxf(fmaxf(fmaxf(S0[0], S0[1]), fmaxf(S0[2], S0[3])), fmaxf(fmaxf(S1[0], S1[1]), fmaxf(S1[2], S1[3])));
            bm = x32_max(x16_max(bm));
            const float mnew = fmaxf(mrun, bm), alpha = __builtin_amdgcn_exp2f((mrun - mnew) * scale), mo = mnew * scale; mrun = mnew;
            float ps = 0.f;
#pragma unroll
            for (int r = 0; r < 4; ++r) { S0[r] = __builtin_amdgcn_exp2f(S0[r] * scale - mo); S1[r] = __builtin_amdgcn_exp2f(S1[r] * scale - mo); ps += S0[r] + S1[r]; }
            lrun = lrun * alpha + ps;
            const bf16x8 Pb = pack_p8(S0, S1);
#pragma unroll
            for (int dt = 0; dt < 16; ++dt) { O[dt] = O[dt] * alpha;
                const unsigned char* vp = Vw + (4 * g + q4) * DA_PITCH + (16 * dt) * 2 + 8 * p4;
                const bf16x8 A = cat8(tr_read4(vp), tr_read4(vp + 16 * DA_PITCH));
                O[dt] = __builtin_amdgcn_mfma_f32_16x16x32_bf16(A, Pb, O[dt], 0, 0, 0); }
        }
#undef DA_GATHER
#undef DA_IDX
        lrun = x32_sum(x16_sum(lrun));
        const float inv = 1.f / lrun;
        if (n16 < 8) {
            bf16* orow = OLY + (size_t)m * OC + n16 * 256 + 4 * g;
#pragma unroll
            for (int dt = 0; dt < 16; ++dt) { u32x2 w; w.x = pg8::cvt_pk_bf16(O[dt][0] * inv, O[dt][1] * inv); w.y = pg8::cvt_pk_bf16(O[dt][2] * inv, O[dt][3] * inv); *(u32x2*)(orow + 16 * dt) = w; }
        }
    }
}
__device__ __forceinline__ void dsa_attn_queue(const Ctx& c, const bf16* __restrict__ QALL, const bf16* __restrict__ KF, const bf16* __restrict__ SEL, const float* __restrict__ ROPEA, bf16* OLY, unsigned* counter, volatile LAS unsigned* slot) {
    for (;;) {
        __syncthreads();
        if (c.tid == 0) *slot = __hip_atomic_fetch_add(counter, 1u, __ATOMIC_RELAXED, __HIP_MEMORY_SCOPE_AGENT);
        __syncthreads();
        const int chunk = (int)*slot;
        if (chunk >= M / 16) break;
        dsa_attn_mfma(c, QALL, KF, SEL, ROPEA, OLY, chunk * 16 + c.wave, 8, chunk * 16 + 16);
    }
}
__device__ __forceinline__ float relu1(float x) { const int b = __builtin_bit_cast(int, x); return __builtin_bit_cast(float, b > 0 ? b : 0); }
__device__ __forceinline__ void idx_topk_mfma(const Ctx& c, const bf16* __restrict__ QALL, const bf16* __restrict__ KIDX, const float* __restrict__ WIDX, const float* __restrict__ ROPEI, float* scr, bf16* SEL, int nitems) {
    const int l = c.lane, n16 = l & 15, g = l >> 4, qg = c.wave & 3, kh = c.wave >> 2;
#pragma unroll 1
    for (int item = c.bid; item < nitems; item += c.nb) {
        const int b = item >> 5, pr = item & 31;
#pragma unroll 1
        for (int which = 0; which < 2; ++which) {
            const int ch = which ? 63 - pr : pr, L = 64 * (ch + 1), t0 = 64 * ch;
            if (L > 256) {
            const size_t m = (size_t)b * SEQ + t0 + 16 * qg + n16;
            float* srow = scr + (size_t)(16 * qg + n16) * L + 4 * g;
            const int nt = L >> 5, j0 = kh * nt, j1 = j0 + nt;
            const bf16* kp = KIDX + ((size_t)b * SEQ + n16) * 64 + 8 * g;
            {
                bf16x8 Qi[16][2]; float w[16];
                { const bf16* qp = QALL + m * QC + 2304 + 8 * g;
#pragma unroll
                  for (int h = 0; h < 16; ++h) { Qi[h][0] = *(const bf16x8*)(qp + h * 64); Qi[h][1] = *(const bf16x8*)(qp + h * 64 + 32); }
                  {
                      float cs[8], sn[8]; const f32x4 c0 = *(const f32x4*)(ROPEI + m * 16), c1 = *(const f32x4*)(ROPEI + m * 16 + 4), s0 = *(const f32x4*)(ROPEI + m * 16 + 8), s1 = *(const f32x4*)(ROPEI + m * 16 + 12);
                      cs[0] = c0.x; cs[1] = c0.y; cs[2] = c0.z; cs[3] = c0.w; cs[4] = c1.x; cs[5] = c1.y; cs[6] = c1.z; cs[7] = c1.w; sn[0] = s0.x; sn[1] = s0.y; sn[2] = s0.z; sn[3] = s0.w; sn[4] = s1.x; sn[5] = s1.y; sn[6] = s1.z; sn[7] = s1.w;
#pragma unroll
                      for (int h = 0; h < 16; ++h) { const bf16x8 pf = xchg_frag(Qi[h][0], 16); const bf16x8 rf = rope_frag(Qi[h][0], pf, cs, sn, g == 0); if (g < 2) Qi[h][0] = rf; } }
                  const f32x4* wp = (const f32x4*)(WIDX + m * 16);
#pragma unroll
                  for (int q = 0; q < 4; ++q) { const f32x4 v = wp[q]; w[4 * q] = v.x; w[4 * q + 1] = v.y; w[4 * q + 2] = v.z; w[4 * q + 3] = v.w; } }
                bf16x8 Ka = *(const bf16x8*)(kp + (size_t)j0 * 1024), Kb = *(const bf16x8*)(kp + (size_t)j0 * 1024 + 32);
#pragma unroll 1
                for (int j = j0; j < j1; ++j) {
                    const int jn = (j + 1 < j1) ? j + 1 : j;
                    const bf16x8 Na = *(const bf16x8*)(kp + (size_t)jn * 1024), Nb = *(const bf16x8*)(kp + (size_t)jn * 1024 + 32);
                    f32x2 s01 = (f32x2){0.f, 0.f}, s23 = (f32x2){0.f, 0.f};
                    f32x4 a = __builtin_amdgcn_mfma_f32_16x16x32_bf16(Ka, Qi[0][0], (f32x4){0.f, 0.f, 0.f, 0.f}, 0, 0, 0); a = __builtin_amdgcn_mfma_f32_16x16x32_bf16(Kb, Qi[0][1], a, 0, 0, 0);
#pragma unroll
                    for (int h = 0; h < 16; ++h) { f32x4 an = a;
                        if (h < 15) { an = __builtin_amdgcn_mfma_f32_16x16x32_bf16(Ka, Qi[h + 1][0], (f32x4){0.f, 0.f, 0.f, 0.f}, 0, 0, 0); an = __builtin_amdgcn_mfma_f32_16x16x32_bf16(Kb, Qi[h + 1][1], an, 0, 0, 0); }
                        const f32x2 wv = (f32x2){w[h], w[h]};
                        s01 = (f32x2){relu1(a[0]), relu1(a[1])} * wv + s01; s23 = (f32x2){relu1(a[2]), relu1(a[3])} * wv + s23; a = an; }
                    *(f32x4*)(srow + 16 * j) = (f32x4){s01.x, s01.y, s23.x, s23.y};
                    Ka = Na; Kb = Nb;
                }
            }
            }
            asm volatile("s_waitcnt vmcnt(0)" ::: "memory");
            __syncthreads();
            __builtin_amdgcn_fence(__ATOMIC_ACQUIRE, "agent");
            asm volatile("s_waitcnt vmcnt(0)" ::: "memory");
#pragma unroll 1
            for (int i = 0; i < 8; ++i) {
                const int ql = c.wave * 8 + i;
                unsigned short* sel = (unsigned short*)SEL + ((size_t)b * SEQ + t0 + ql) * 256;
                if (L <= 256) { for (int k = l; k < 256; k += 64) sel[k] = (unsigned short)(k < L ? k : 0); }
                else select_row_bs(scr + (size_t)ql * L, L, sel, l, (unsigned short*)(c.lds + c.wave * 512));
            }
            __syncthreads();
        }
    }
}
__device__ __forceinline__ void diag_cmp_sel(const Ctx& c, const bf16* SA, const bf16* SB, int nbatch, float* acc) {
    unsigned* bm = (unsigned*)(c.lds + c.wave * 512);
    float miss = 0.f, tot = 0.f;
    for (int m = c.gw; m < nbatch * SEQ; m += c.ngw) {
        const int t = m % SEQ; if (t < 256) continue;
        bm[c.lane] = 0u; bm[64 + c.lane] = 0u;
        __builtin_amdgcn_fence(__ATOMIC_RELEASE, "wavefront"); __builtin_amdgcn_wave_barrier();
        for (int i = c.lane; i < 256; i += 64) { const unsigned s = ((const unsigned short*)SA)[(size_t)m * 256 + i]; atomicOr(&bm[s >> 5], 1u << (s & 31)); }
        __builtin_amdgcn_fence(__ATOMIC_RELEASE, "wavefront"); __builtin_amdgcn_wave_barrier(); __builtin_amdgcn_fence(__ATOMIC_ACQUIRE, "wavefront");
        for (int i = c.lane; i < 256; i += 64) { const unsigned s = ((const unsigned short*)SB)[(size_t)m * 256 + i]; miss += ((bm[s >> 5] >> (s & 31)) & 1u) ? 0.f : 1.f; tot += 1.f; }
        __builtin_amdgcn_fence(__ATOMIC_RELEASE, "wavefront"); __builtin_amdgcn_wave_barrier();
    }
    miss = wave_sum(miss); tot = wave_sum(tot);
    if (c.lane == 0) { atomicAdd(acc, miss); atomicAdd(acc + 1, tot); }
}
__device__ __forceinline__ void idx_topk_lds(const Ctx& c, const bf16* __restrict__ QALL, const bf16* __restrict__ KIDX, const float* __restrict__ WIDX, const float* __restrict__ ROPEI, u32x4* qscr, bf16* SEL, int nitems) {
    float* SCL = (float*)c.lds;
    f32x4* WL = (f32x4*)(c.lds + 131072);
    const int w8 = c.wave;
#pragma unroll 1
    for (int item = c.bid; item < nitems; item += c.nb) {
        const int b = item >> 5, pr = item & 31;
#pragma unroll 1
        for (int which = 0; which < 2; ++which) {
            int l = c.lane; asm volatile("" : "+v"(l));
            const int n16 = l & 15, g = l >> 4;
            const int ch = which ? 63 - pr : pr, L = 64 * (ch + 1), t0 = 64 * ch;
            if (L <= 256) {
#pragma unroll 1
                for (int i = 0; i < 8; ++i) { unsigned short* sel = (unsigned short*)SEL + ((size_t)b * SEQ + t0 + w8 * 8 + i) * 256; for (int k = l; k < 256; k += 64) sel[k] = (unsigned short)(k < L ? k : 0); }
                continue;
            }
            __syncthreads();
            if (w8 < 4) {
                const size_t m = (size_t)b * SEQ + t0 + 16 * w8 + n16;
                const bf16* qp = QALL + m * QC + 2304 + 8 * g;
                float cs[8], sn[8]; const f32x4 c0 = *(const f32x4*)(ROPEI + m * 16), c1 = *(const f32x4*)(ROPEI + m * 16 + 4), s0 = *(const f32x4*)(ROPEI + m * 16 + 8), s1 = *(const f32x4*)(ROPEI + m * 16 + 12);
                cs[0] = c0.x; cs[1] = c0.y; cs[2] = c0.z; cs[3] = c0.w; cs[4] = c1.x; cs[5] = c1.y; cs[6] = c1.z; cs[7] = c1.w; sn[0] = s0.x; sn[1] = s0.y; sn[2] = s0.z; sn[3] = s0.w; sn[4] = s1.x; sn[5] = s1.y; sn[6] = s1.z; sn[7] = s1.w;
#pragma unroll 4
                for (int h = 0; h < 16; ++h) { bf16x8 f0 = *(const bf16x8*)(qp + h * 64); const bf16x8 f1 = *(const bf16x8*)(qp + h * 64 + 32);
                    const bf16x8 pf = xchg_frag(f0, 16); const bf16x8 rf = rope_frag(f0, pf, cs, sn, g == 0); if (g < 2) f0 = rf;
                    qscr[(w8 * 64 + l) * 32 + h * 2] = __builtin_bit_cast(u32x4, f0); qscr[(w8 * 64 + l) * 32 + h * 2 + 1] = __builtin_bit_cast(u32x4, f1); }
            }
            asm volatile("s_waitcnt vmcnt(0)" ::: "memory");
            __syncthreads();
            __builtin_amdgcn_fence(__ATOMIC_ACQUIRE, "agent"); asm volatile("s_waitcnt vmcnt(0)" ::: "memory");
            const bf16* kp = KIDX + ((size_t)b * SEQ + n16) * 64 + 8 * g;
            const int ntile = L >> 4;
#pragma unroll 1
            for (int qsub = 0; qsub < 8; ++qsub) {
                asm volatile("" ::: "memory");
                bf16x8 Qi[16][2];
                { const int srcl = g * 16 + (qsub & 1) * 8 + (n16 & 7); const u32x4* fp = qscr + (size_t)((qsub >> 1) * 64 + srcl) * 32;
#pragma unroll
                  for (int h = 0; h < 16; ++h) { Qi[h][0] = __builtin_bit_cast(bf16x8, fp[h * 2]); Qi[h][1] = __builtin_bit_cast(bf16x8, fp[h * 2 + 1]); }
                  if (w8 == 0 && l < 32) WL[l] = *(const f32x4*)(WIDX + ((size_t)b * SEQ + t0 + 8 * qsub + (l >> 2)) * 16 + 4 * (l & 3)); }
                __syncthreads();
                const f32x4* wq = WL + (n16 & 7) * 4;
                float* srow = SCL + (n16 & 7) * 4096 + 4 * g;
                int j = w8;
                bf16x8 Ka = *(const bf16x8*)(kp + (size_t)j * 1024), Kb = *(const bf16x8*)(kp + (size_t)j * 1024 + 32);
#pragma unroll 1
                for (; j < ntile; j += 8) {
                    const int jn = (j + 8 < ntile) ? j + 8 : j;
                    const bf16x8 Na = *(const bf16x8*)(kp + (size_t)jn * 1024), Nb = *(const bf16x8*)(kp + (size_t)jn * 1024 + 32);
                    f32x2 s01 = (f32x2){0.f, 0.f}, s23 = (f32x2){0.f, 0.f};
                    f32x4 a = __builtin_amdgcn_mfma_f32_16x16x32_bf16(Ka, Qi[0][0], (f32x4){0.f, 0.f, 0.f, 0.f}, 0, 0, 0); a = __builtin_amdgcn_mfma_f32_16x16x32_bf16(Kb, Qi[0][1], a, 0, 0, 0);
#pragma unroll
                    for (int h4 = 0; h4 < 4; ++h4) { const f32x4 w4 = wq[h4];
#pragma unroll
                        for (int hh = 0; hh < 4; ++hh) { const int h = 4 * h4 + hh; f32x4 an = a;
                            if (h < 15) { an = __builtin_amdgcn_mfma_f32_16x16x32_bf16(Ka, Qi[h + 1][0], (f32x4){0.f, 0.f, 0.f, 0.f}, 0, 0, 0); an = __builtin_amdgcn_mfma_f32_16x16x32_bf16(Kb, Qi[h + 1][1], an, 0, 0, 0); }
                            const f32x2 wv = (f32x2){w4[hh], w4[hh]};
                            s01 = (f32x2){relu1(a[0]), relu1(a[1])} * wv + s01; s23 = (f32x2){relu1(a[2]), relu1(a[3])} * wv + s23; a = an; } }
                    if (n16 < 8) *(f32x4*)(srow + 16 * j) = (f32x4){s01.x, s01.y, s23.x, s23.y};
                    Ka = Na; Kb = Nb;
                }
                __syncthreads();
                select_row(SCL + w8 * 4096, L, (unsigned short*)SEL + ((size_t)b * SEQ + t0 + 8 * qsub + w8) * 256, l);
                __syncthreads();
            }
        }
    }
}
#if DIAG == 7
__device__ __forceinline__ void select_row_v1(const float* row, int limit, unsigned short* sel, int l_in) {
    int l = l_in; asm volatile("" : "+v"(l));
    const int ng = limit >> 9;
    unsigned key[64];
#pragma unroll
    for (int j = 0; j < 64; ++j) { const int s = j * 64 + l; unsigned u = 0u; if (s < limit) { u = __float_as_uint(row[s]); u = (u & 0x80000000u) ? ~u : (u | 0x80000000u); } key[j] = u; }
    unsigned mx = 0u;
#pragma unroll
    for (int j = 0; j < 64; ++j) mx = key[j] > mx ? key[j] : mx;
#pragma unroll
    for (int o = 1; o < 64; o <<= 1) { const unsigned t = (unsigned)__shfl_xor((int)mx, o); mx = t > mx ? t : mx; }
    mx = (unsigned)__builtin_amdgcn_readfirstlane((int)mx);
    unsigned T = 0u;
#pragma unroll 1
    for (int bit = 31 - __builtin_clz(mx | 1u); bit >= 0; --bit) {
        const unsigned Tn = T | (1u << bit); int cnt = 0;
#pragma unroll
        for (int jg = 0; jg < 8; ++jg) if (jg <= ng) {
#pragma unroll
            for (int j = 8 * jg; j < 8 * jg + 8; ++j) cnt += __popcll(__ballot(key[j] >= Tn)); }
        if (cnt >= 256) T = Tn;
        if (cnt == 256) break;
    }
    int cgt = 0;
#pragma unroll
    for (int j = 0; j < 64; ++j) cgt += __popcll(__ballot(key[j] > T));
    const int need_eq = 256 - cgt;
    int base = 0, beq = 0;
    const unsigned long long lt = (1ull << l) - 1ull;
#pragma unroll
    for (int jg = 0; jg < 8; ++jg) if (jg <= ng) {
#pragma unroll
        for (int j = 8 * jg; j < 8 * jg + 8; ++j) {
            const unsigned long long mg = __ballot(key[j] > T), me = __ballot(key[j] == T);
            if (key[j] > T) sel[base + __popcll(mg & lt)] = (unsigned short)(j * 64 + l);
            base += __popcll(mg);
            const int pe = beq + __popcll(me & lt);
            if (key[j] == T && pe < need_eq) sel[cgt + pe] = (unsigned short)(j * 64 + l);
            beq += __popcll(me);
        }
    }
}
__device__ __forceinline__ void idx_topk_v1(const Ctx& c, const bf16* __restrict__ QALL, const bf16* __restrict__ KIDX, const float* __restrict__ WIDX, float* scr, bf16* SEL, int nitems) {
    const int l = c.lane, n16 = l & 15, g = l >> 4, qg = c.wave & 3, kh = c.wave >> 2;
#pragma unroll 1
    for (int item = c.bid; item < nitems; item += c.nb) {
        const int b = item >> 5, pr = item & 31;
#pragma unroll 1
        for (int which = 0; which < 2; ++which) {
            const int ch = which ? 63 - pr : pr, L = 64 * (ch + 1), t0 = 64 * ch;
            if (L > 256) {
            const size_t m = (size_t)b * SEQ + t0 + 16 * qg + n16;
            float* srow = scr + (size_t)(16 * qg + n16) * L + 4 * g;
            const int nt = L >> 5, j0 = kh * nt, j1 = j0 + nt;
            const bf16* kp = KIDX + ((size_t)b * SEQ + n16) * 64 + 8 * g;
#pragma unroll 1
            for (int hp = 0; hp < 2; ++hp) {
                bf16x8 Qi[8][2]; float w[8];
                { const bf16* qp = QALL + m * QC + 2304 + hp * 512 + 8 * g;
#pragma unroll
                  for (int h = 0; h < 8; ++h) { Qi[h][0] = *(const bf16x8*)(qp + h * 64); Qi[h][1] = *(const bf16x8*)(qp + h * 64 + 32); }
                  const f32x4* wp = (const f32x4*)(WIDX + m * 16 + hp * 8);
#pragma unroll
                  for (int q = 0; q < 2; ++q) { const f32x4 v = wp[q]; w[4 * q] = v.x; w[4 * q + 1] = v.y; w[4 * q + 2] = v.z; w[4 * q + 3] = v.w; } }
                if (hp) { asm volatile("s_waitcnt vmcnt(0)" ::: "memory"); __builtin_amdgcn_fence(__ATOMIC_ACQUIRE, "agent"); asm volatile("s_waitcnt vmcnt(0)" ::: "memory"); }
                bf16x8 Ka = *(const bf16x8*)(kp + (size_t)j0 * 1024), Kb = *(const bf16x8*)(kp + (size_t)j0 * 1024 + 32);
                f32x4 pv = (f32x4){0.f, 0.f, 0.f, 0.f}; if (hp) pv = *(const f32x4*)(srow + 16 * j0);
#pragma unroll 1
                for (int j = j0; j < j1; ++j) {
                    const int jn = (j + 1 < j1) ? j + 1 : j;
                    const bf16x8 Na = *(const bf16x8*)(kp + (size_t)jn * 1024), Nb = *(const bf16x8*)(kp + (size_t)jn * 1024 + 32);
                    f32x4 pn = (f32x4){0.f, 0.f, 0.f, 0.f}; if (hp) pn = *(const f32x4*)(srow + 16 * jn);
                    f32x4 sc = pv;
#pragma unroll
                    for (int h = 0; h < 8; ++h) { f32x4 a = __builtin_amdgcn_mfma_f32_16x16x32_bf16(Ka, Qi[h][0], (f32x4){0.f, 0.f, 0.f, 0.f}, 0, 0, 0); a = __builtin_amdgcn_mfma_f32_16x16x32_bf16(Kb, Qi[h][1], a, 0, 0, 0);
                        sc[0] += w[h] * fmaxf(a[0], 0.f); sc[1] += w[h] * fmaxf(a[1], 0.f); sc[2] += w[h] * fmaxf(a[2], 0.f); sc[3] += w[h] * fmaxf(a[3], 0.f); }
                    *(f32x4*)(srow + 16 * j) = sc;
                    Ka = Na; Kb = Nb; pv = pn;
                }
            }
            }
            asm volatile("s_waitcnt vmcnt(0)" ::: "memory");
            __syncthreads();
            __builtin_amdgcn_fence(__ATOMIC_ACQUIRE, "agent");
            asm volatile("s_waitcnt vmcnt(0)" ::: "memory");
#pragma unroll 1
            for (int i = 0; i < 8; ++i) {
                const int ql = c.wave * 8 + i;
                unsigned short* sel = (unsigned short*)SEL + ((size_t)b * SEQ + t0 + ql) * 256;
                if (L <= 256) { for (int k = l; k < 256; k += 64) sel[k] = (unsigned short)(k < L ? k : 0); }
                else select_row_v1(scr + (size_t)ql * L, L, sel, l);
            }
            __syncthreads();
        }
    }
}
#endif
constexpr int RW_TB = 32;
struct RwkvP { const float *mu, *w0, *w2, *a0, *a2, *g2, *k_k, *k_a, *r_k, *ln_w, *ln_b; };
__device__ __forceinline__ void rwkv_phase(const Ctx& c, const bf16* __restrict__ H, const RwkvP P, bf16* OLY) {
    float* A_WR = (float*)c.lds;
    float* A_K2 = A_WR + RW_TB * 64;
    float* A_V = A_K2 + RW_TB * 64;
    float* A_W = A_V + RW_TB * 64;
    float* A_NKK = A_W + RW_TB * 64;
    float* A_B = A_NKK + RW_TB * 64;
    float* A_G = A_B + RW_TB * 64;
    float* A_OUT = A_G + RW_TB * 64;
    float* L_TW = A_OUT + RW_TB * 64;
    float* L_AL = L_TW + RW_TB * 64;
    float* L_SG = L_AL + RW_TB * 64;
    float* SC1 = L_SG + RW_TB * 160; float* SC2 = SC1 + RW_TB; float* SC3 = SC2 + RW_TB;
    const int l = c.lane, w = c.wave;
    for (int item = c.bid; item < NB * 16; item += c.nb) {
        const int b = item >> 4, h = item & 15, hk = h * 64 + l;
        const float w0v = P.w0[hk], a0v = P.a0[hk], kkv = P.k_k[hk], kav = P.k_a[hk], rkv = P.r_k[hk], lnw = P.ln_w[hk], lnb = P.ln_b[hk];
        float S[8];
#pragma unroll
        for (int i = 0; i < 8; ++i) S[i] = 0.f;
        const int srow = w * 8 + (l >> 3), sj = l & 7;
        for (int t0 = 0; t0 < SEQ; t0 += RW_TB) {
            __syncthreads();
            for (int idx = c.tid; idx < RW_TB * 480; idx += NTHR) {
                const int t = idx / 480, cc = idx % 480; int col; float* dst;
                if (cc < 64) { col = 880 + h * 64 + cc; dst = A_WR + t * 64 + cc; }
                else if (cc < 128) { col = 1904 + h * 64 + (cc - 64); dst = A_K2 + t * 64 + (cc - 64); }
                else if (cc < 192) { col = 2928 + h * 64 + (cc - 128); dst = A_V + t * 64 + (cc - 128); }
                else if (cc < 256) { col = 3952 + (cc - 192); dst = L_TW + t * 64 + (cc - 192); }
                else if (cc < 320) { col = 4016 + (cc - 256); dst = L_AL + t * 64 + (cc - 256); }
                else { col = 4080 + (cc - 320); dst = L_SG + t * 160 + (cc - 320); }
                const size_t m = (size_t)b * SEQ + t0 + t;
                const float x = bf2f(H[m * HC + col]); const float xp = (t0 + t > 0) ? bf2f(H[(m - 1) * HC + col]) : 0.f;
                float hm = x + (xp - x) * P.mu[col - 880];
                if (cc >= 192 && cc < 256) hm = tanhf(hm); else if (cc >= 320) hm = sigmoidf_(hm);
                *dst = hm;
            }
            __syncthreads();
            {
                float wl[RW_TB / 8], al[RW_TB / 8], gg[RW_TB / 8];
#pragma unroll
                for (int i = 0; i < RW_TB / 8; ++i) { wl[i] = 0.f; al[i] = 0.f; gg[i] = 0.f; }
                for (int j = 0; j < 64; ++j) { const float w2v = P.w2[(size_t)j * 1024 + hk], a2v = P.a2[(size_t)j * 1024 + hk];
#pragma unroll
                    for (int i = 0; i < RW_TB / 8; ++i) { wl[i] += L_TW[(w + 8 * i) * 64 + j] * w2v; al[i] += L_AL[(w + 8 * i) * 64 + j] * a2v; } }
                for (int j = 0; j < 160; ++j) { const float g2v = P.g2[(size_t)j * 1024 + hk];
#pragma unroll
                    for (int i = 0; i < RW_TB / 8; ++i) gg[i] += L_SG[(w + 8 * i) * 160 + j] * g2v; }
#pragma unroll
                for (int i = 0; i < RW_TB / 8; ++i) {
                    const int t = w + 8 * i, o = t * 64 + l;
                    const float dec = __expf(-0.6065306597126334f * sigmoidf_(w0v + wl[i]));
                    const float a = sigmoidf_(a0v + al[i]);
                    const float kr = A_K2[o], r = A_WR[o];
                    float kk = kr * kkv; const float nrm = wave_sum(kk * kk); kk = kk * (1.0f / sqrtf(fmaxf(nrm, 1e-24f)));
                    const float k2 = kr * (1.f + (a - 1.f) * kav), bb = kk * a;
                    const float s1 = wave_sum(bb * r), s2 = wave_sum(k2 * r), s3 = wave_sum(r * k2 * rkv);
                    A_W[o] = dec; A_NKK[o] = -kk; A_B[o] = bb; A_K2[o] = k2; A_WR[o] = dec * r; A_G[o] = gg[i];
                    if (l == 0) { SC1[t] = s1; SC2[t] = s2; SC3[t] = s3; }
                }
            }
            __syncthreads();
            for (int t = 0; t < RW_TB; ++t) {
                const f32x4* pw = (const f32x4*)(A_W + t * 64 + 8 * sj); const f32x4* pn = (const f32x4*)(A_NKK + t * 64 + 8 * sj); const f32x4* pb = (const f32x4*)(A_B + t * 64 + 8 * sj);
                const f32x4* pk = (const f32x4*)(A_K2 + t * 64 + 8 * sj); const f32x4* pr = (const f32x4*)(A_WR + t * 64 + 8 * sj);
                const f32x4 w0_ = pw[0], w1_ = pw[1], n0 = pn[0], n1 = pn[1], b0 = pb[0], b1 = pb[1], k0 = pk[0], k1 = pk[1], r0 = pr[0], r1 = pr[1];
                const float vv = A_V[t * 64 + srow], s1 = SC1[t], s2 = SC2[t];
                float sa = (S[0] * n0.x + S[1] * n0.y) + (S[2] * n0.z + S[3] * n0.w) + (S[4] * n1.x + S[5] * n1.y) + (S[6] * n1.z + S[7] * n1.w);
                float p = (S[0] * r0.x + S[1] * r0.y) + (S[2] * r0.z + S[3] * r0.w) + (S[4] * r1.x + S[5] * r1.y) + (S[6] * r1.z + S[7] * r1.w);
                sa += __shfl_xor(sa, 1); p += __shfl_xor(p, 1); sa += __shfl_xor(sa, 2); p += __shfl_xor(p, 2); sa += __shfl_xor(sa, 4); p += __shfl_xor(p, 4);
                S[0] = S[0] * w0_.x + (sa * b0.x + vv * k0.x); S[1] = S[1] * w0_.y + (sa * b0.y + vv * k0.y); S[2] = S[2] * w0_.z + (sa * b0.z + vv * k0.z); S[3] = S[3] * w0_.w + (sa * b0.w + vv * k0.w);
                S[4] = S[4] * w1_.x + (sa * b1.x + vv * k1.x); S[5] = S[5] * w1_.y + (sa * b1.y + vv * k1.y); S[6] = S[6] * w1_.z + (sa * b1.z + vv * k1.z); S[7] = S[7] * w1_.w + (sa * b1.w + vv * k1.w);
                if (sj == 0) A_OUT[t * 64 + srow] = p + sa * s1 + vv * s2;
            }
            __syncthreads();
#pragma unroll
            for (int i = 0; i < RW_TB / 8; ++i) {
                const int t = w + 8 * i, o = t * 64 + l;
                const float x = A_OUT[o]; const float mean = wave_sum(x) * (1.f / 64.f); const float dx = x - mean; const float var = wave_sum(dx * dx) * (1.f / 64.f);
                float y = dx * (1.0f / sqrtf(var + 64e-5f)) * lnw + lnb;
                y = (y + SC3[t] * A_V[o]) * A_G[o];
                OLY[((size_t)b * SEQ + t0 + t) * OC + 2048 + hk] = (bf16)f2bf(y);
            }
        }
    }
}

constexpr int S5_TB = 16;
struct S5P { const float *lam_re, *lam_im, *log_dt, *b_re, *b_im, *c_re, *c_im, *d; };
__device__ __forceinline__ float gelu_tanh(float y) { return 0.5f * y * (1.f + tanhf(0.7978845608028654f * (y + 0.044715f * y * y * y))); }
__device__ __forceinline__ void s5_phase(const Ctx& c, const bf16* __restrict__ U, const S5P P, bf16* Z) {
    constexpr int PERW = 256 + 2 * S5_TB * 65 + 2 * 64 * 16;
    float* UU = (float*)c.lds + c.wave * PERW;
    float* XSr = UU + 256; float* XSi = XSr + S5_TB * 65;
    float* CTr = XSi + S5_TB * 65; float* CTi = CTr + 64 * 16;
    const int l = c.lane;
    for (int item = c.bid; item < NB * 16; item += c.nb) {
        const int b = item >> 4, g = (item & 15) * 8 + c.wave;
        __syncthreads();
        float lbr, lbi, Br[16], Bi[16];
        {
            const float lr = fminf(P.lam_re[g * 64 + l], -1e-4f), li = P.lam_im[g * 64 + l], dt = expf(P.log_dt[g]);
            const float e = expf(lr * dt); lbr = e * cosf(li * dt); lbi = e * sinf(li * dt);
            const float nr = lbr - 1.f, ni = lbi, den = 1.f / (lr * lr + li * li);
            const float cr = (nr * lr + ni * li) * den, ci = (ni * lr - nr * li) * den;
#pragma unroll
            for (int i = 0; i < 16; ++i) { const float br = P.b_re[(size_t)(g * 64 + l) * 16 + i], bi = P.b_im[(size_t)(g * 64 + l) * 16 + i]; Br[i] = cr * br - ci * bi; Bi[i] = cr * bi + ci * br; }
#pragma unroll
            for (int o = 0; o < 16; ++o) { CTr[l * 16 + o] = P.c_re[(size_t)(g * 16 + o) * 64 + l]; CTi[l * 16 + o] = P.c_im[(size_t)(g * 16 + o) * 64 + l]; }
        }
        float dsk[4];
#pragma unroll
        for (int e = 0; e < 4; ++e) dsk[e] = P.d[g * 16 + (l >> 4) * 4 + e];
        float xr = 0.f, xi = 0.f;
        for (int t0 = 0; t0 < SEQ; t0 += S5_TB) {
            __syncthreads();
            { const int row = l >> 2, q = l & 3; const u32x2 w2 = *(const u32x2*)(U + ((size_t)b * SEQ + t0 + row) * D + g * 16 + 4 * q);
              float* d = UU + row * 16 + 4 * q; d[0] = bf2f(w2.x & 0xffffu); d[1] = bf2f(w2.x >> 16); d[2] = bf2f(w2.y & 0xffffu); d[3] = bf2f(w2.y >> 16); }
            __syncthreads();
            for (int t = 0; t < S5_TB; ++t) {
                const f32x4* up = (const f32x4*)(UU + t * 16); const f32x4 u0 = up[0], u1 = up[1], u2 = up[2], u3 = up[3];
                const float u[16] = {u0.x, u0.y, u0.z, u0.w, u1.x, u1.y, u1.z, u1.w, u2.x, u2.y, u2.z, u2.w, u3.x, u3.y, u3.z, u3.w};
                float bur = 0.f, bui = 0.f;
#pragma unroll
                for (int i = 0; i < 16; ++i) { bur += Br[i] * u[i]; bui += Bi[i] * u[i]; }
                const float nxr = lbr * xr - lbi * xi + bur, nxi = lbr * xi + lbi * xr + bui; xr = nxr; xi = nxi;
                XSr[t * 65 + l] = xr; XSi[t * 65 + l] = xi;
            }
            __syncthreads();
            {   const int t = l & 15, oq = l >> 4; float y[4] = {0.f, 0.f, 0.f, 0.f};
                for (int p = 0; p < 64; ++p) { const float a = XSr[t * 65 + p], bb = XSi[t * 65 + p]; const f32x4 cr = *(const f32x4*)(CTr + p * 16 + oq * 4), ci = *(const f32x4*)(CTi + p * 16 + oq * 4);
                    y[0] += a * cr.x - bb * ci.x; y[1] += a * cr.y - bb * ci.y; y[2] += a * cr.z - bb * ci.z; y[3] += a * cr.w - bb * ci.w; }
                float z[4];
#pragma unroll
                for (int e = 0; e < 4; ++e) z[e] = gelu_tanh(y[e] + dsk[e] * UU[t * 16 + oq * 4 + e]);
                u32x2 o; o.x = pk2(z[0], z[1]); o.y = pk2(z[2], z[3]);
                *(u32x2*)(Z + ((size_t)b * SEQ + t0 + t) * D + g * 16 + oq * 4) = o; }
        }
    }
}
template <int CTRL> __device__ __forceinline__ float dpp_mov(float v) { return __builtin_bit_cast(float, __builtin_amdgcn_update_dpp(0, __builtin_bit_cast(int, v), CTRL, 0xf, 0xf, true)); }
__device__ __forceinline__ float sum8(float v) { v += dpp_mov<0xB1>(v); v += dpp_mov<0x4E>(v); v += dpp_mov<0x141>(v); return v; }
__device__ __forceinline__ float wave_sum_fast(float v) { v += dpp_mov<0xB1>(v); v += dpp_mov<0x4E>(v); v += dpp_mov<0x141>(v); v += dpp_mov<0x140>(v); v += __shfl_xor(v, 16); v += __shfl_xor(v, 32); return v; }
__device__ __forceinline__ float fast_tanh(float x) { const float e = __expf(2.f * x); return 1.f - 2.f * __builtin_amdgcn_rcpf(e + 1.f); }
__device__ __forceinline__ void rwkv_lora_prep(const Ctx& c, const bf16* __restrict__ H, const float* __restrict__ mu, bf16* LX) {
    const int l = c.lane;
    for (int m = c.gw; m < M; m += c.ngw) {
        if (l < 36) {
            const int col = 3952 + 8 * l; const int t = m % SEQ;
            float x[8], p[8]; unpack8(*(const u32x4*)(H + (size_t)m * HC + col), x);
            if (t > 0) unpack8(*(const u32x4*)(H + (size_t)(m - 1) * HC + col), p); else {
#pragma unroll
                for (int j = 0; j < 8; ++j) p[j] = 0.f; }
            const f32x4 m0 = *(const f32x4*)(mu + 3072 + 8 * l), m1 = *(const f32x4*)(mu + 3072 + 8 * l + 4);
            const float mv[8] = {m0.x, m0.y, m0.z, m0.w, m1.x, m1.y, m1.z, m1.w};
            float hm[8];
#pragma unroll
            for (int j = 0; j < 8; ++j) { float v = x[j] + (p[j] - x[j]) * mv[j]; if (l < 8) v = fast_tanh(v); else if (l >= 16) v = sigmoidf_(v); hm[j] = v; }
            u32x4 o; o.x = pg8::cvt_pk_bf16(hm[0], hm[1]); o.y = pg8::cvt_pk_bf16(hm[2], hm[3]); o.z = pg8::cvt_pk_bf16(hm[4], hm[5]); o.w = pg8::cvt_pk_bf16(hm[6], hm[7]);
            *(u32x4*)(LX + (size_t)m * 288 + 8 * l) = o;
        }
    }
}
constexpr int RW2_RAWP = 384;
constexpr int RW2_TWP = 144, RW2_SGP = 336;
__device__ __forceinline__ void rwkv_phase2(const Ctx& c, const bf16* __restrict__ H, const bf16* __restrict__ LX, const RwkvP P, bf16* OUT, int ldo, int coloff, int wb = NB) {
    unsigned char* RAW = c.lds;
    float* A_WR = (float*)(c.lds + 12800);
    float* A_K2 = A_WR + 2048; float* A_V = A_K2 + 2048; float* A_W = A_V + 2048; float* A_NKK = A_W + 2048; float* A_B = A_NKK + 2048; float* A_G = A_B + 2048; float* A_OUT = A_G + 2048;
    float* LO_W = A_OUT + 2048; float* LO_A = LO_W + 2048; float* PR3 = LO_A + 2048;
    unsigned char* L_TW = (unsigned char*)(PR3 + 2048); unsigned char* L_AL = L_TW + 32 * RW2_TWP; unsigned char* L_SG = L_AL + 32 * RW2_TWP;
    float* MU = (float*)(L_SG + 32 * RW2_SGP); float* SC3 = MU + 480 + 64;
    unsigned char* G2T = (unsigned char*)(SC3 + 32);
    float* SCP = (float*)(G2T + 64 * RW2_SGP);
    float* GN = SCP + 128; float* CST = GN + 64;
    float* PR0 = (float*)L_TW; float* PR1 = PR0 + 2048; float* PR2 = A_OUT;
    const int l = c.lane, w = c.wave, n16 = l & 15, g = l >> 4;
#pragma unroll 1
    for (int item = c.bid; item < NB * 16; item += c.nb) {
        const int b = item >> 4, h = item & 15, hk = h * 64 + l;
        __syncthreads();
        if (w < 7) { const float* src = w == 0 ? P.w0 : w == 1 ? P.a0 : w == 2 ? P.k_k : w == 3 ? P.k_a : w == 4 ? P.r_k : w == 5 ? P.ln_w : P.ln_b; CST[w * 64 + l] = src[hk]; }
#pragma unroll 1
        for (int qb = 0; qb < 20; qb += 5) {
            float gq[5];
#pragma unroll
            for (int q = 0; q < 5; ++q) { const int i = c.tid + NTHR * (qb + q); gq[q] = P.g2[(size_t)(i >> 6) * 1024 + h * 64 + (i & 63)]; }
#pragma unroll
            for (int q = 0; q < 5; ++q) { const int i = c.tid + NTHR * (qb + q); *(unsigned short*)(G2T + (i & 63) * RW2_SGP + (i >> 6) * 2) = (unsigned short)f2bf(gq[q]); }
        }
        for (int i = c.tid; i < 192; i += NTHR) { const int mi = i < 64 ? h * 64 + i : i < 128 ? 1024 + h * 64 + (i - 64) : 2048 + h * 64 + (i - 128); MU[i] = P.mu[mi]; }
        const int tt = w >> 2, nt = w & 3;
        bf16x8 W2B[2], A2B[2];
        { const int kc = h * 64 + 16 * nt + n16;
          auto ldfrag = [&](const float* Wp, int kk) -> bf16x8 { float f[8]; int gq = g, kq = kc; asm volatile("" : "+v"(gq), "+v"(kq));
              const float* wp = Wp + (size_t)(32 * kk + 8 * gq) * 1024 + kq;
#pragma unroll
              for (int q = 0; q < 8; ++q) f[q] = wp[q * 1024];
              u32x4 u; u.x = pk2(f[0], f[1]); u.y = pk2(f[2], f[3]); u.z = pk2(f[4], f[5]); u.w = pk2(f[6], f[7]);
              asm volatile("" : "+v"(u));
              return __builtin_bit_cast(bf16x8, u); };
          W2B[0] = ldfrag(P.w2, 0); W2B[1] = ldfrag(P.w2, 1); A2B[0] = ldfrag(P.a2, 0); A2B[1] = ldfrag(P.a2, 1);
        }
        f32x2 S[4];
#pragma unroll
        for (int i = 0; i < 4; ++i) S[i] = (f32x2){0.f, 0.f};
        const int srow = w * 8 + (l >> 3), sj = l & 7;
        u32x4 raw[4];
#define RW2_LOAD(T0) do { _Pragma("unroll") for (int k = 0; k < 4; ++k) { const int q_ = c.tid + 512 * k; \
            const int cq_ = q_ % 24; int tg = (T0) - 1 + q_ / 24; tg = tg < 0 ? 0 : tg; const int rc_ = (cq_ < 8 ? 880 : cq_ < 16 ? 1904 - 64 : 2928 - 128) + h * 64 + cq_ * 8; \
            int e_ = q_ - 792; e_ = (e_ < 0 || e_ >= 1152) ? 0 : e_; \
            const bf16* src_ = (q_ < 792) ? H + ((size_t)b * SEQ + tg) * HC + rc_ : LX + ((size_t)b * SEQ + (T0) + e_ / 36) * 288 + (e_ % 36) * 8; \
            raw[k] = *(const u32x4*)src_; } } while (0)
        RW2_LOAD(0);
#pragma unroll 1
        for (int t0 = 0; t0 < SEQ; t0 += 32) {
            __syncthreads();
#pragma unroll
            for (int k = 0; k < 4; ++k) { const int q_ = c.tid + 512 * k;
                if (q_ < 792) *(u32x4*)(RAW + (q_ / 24) * RW2_RAWP + (q_ % 24) * 16) = (t0 == 0 && q_ < 24) ? (u32x4){0u, 0u, 0u, 0u} : raw[k];
                else if (q_ < 1944) { const int e_ = q_ - 792, t_ = e_ / 36, p_ = e_ % 36;
                    unsigned char* d_ = p_ < 8 ? L_TW + t_ * RW2_TWP + p_ * 16 : p_ < 16 ? L_AL + t_ * RW2_TWP + (p_ - 8) * 16 : L_SG + t_ * RW2_SGP + (p_ - 16) * 16; *(u32x4*)d_ = raw[k]; } }
            { const int tn_ = (t0 + 32 < SEQ) ? t0 + 32 : t0; RW2_LOAD(tn_); }
            __syncthreads();
            if (c.tid < 384) {
                const int cpi = c.tid % 96, qb = c.tid / 96, cp = cpi * 2, tb = qb * 8;
                const float mu0 = MU[cp], mu1 = MU[cp + 1];
                unsigned xb = *(const unsigned*)(RAW + tb * RW2_RAWP + cp * 2);
                float p0 = bf2f(xb & 0xffffu), p1 = bf2f(xb >> 16);
                float* dst = (cp < 64 ? A_WR + cp : cp < 128 ? A_K2 + (cp - 64) : A_V + (cp - 128)) + tb * 64;
#pragma unroll
                for (int t = 0; t < 8; ++t) { const unsigned xa = *(const unsigned*)(RAW + (tb + t + 1) * RW2_RAWP + cp * 2); const float x0 = bf2f(xa & 0xffffu), x1 = bf2f(xa >> 16);
                    *(f32x2*)(dst + t * 64) = (f32x2){x0 + (p0 - x0) * mu0, x1 + (p1 - x1) * mu1}; p0 = x0; p1 = x1; }
            }
            __syncthreads();
            {
                f32x4 aw = (f32x4){0.f, 0.f, 0.f, 0.f}, aa = aw, ag = aw;
#pragma unroll
                for (int kk = 0; kk < 2; ++kk) { const bf16x8 At = *(const bf16x8*)(L_TW + (16 * tt + n16) * RW2_TWP + (32 * kk + 8 * g) * 2), Aa = *(const bf16x8*)(L_AL + (16 * tt + n16) * RW2_TWP + (32 * kk + 8 * g) * 2);
                    aw = __builtin_amdgcn_mfma_f32_16x16x32_bf16(At, W2B[kk], aw, 0, 0, 0); aa = __builtin_amdgcn_mfma_f32_16x16x32_bf16(Aa, A2B[kk], aa, 0, 0, 0); }
#pragma unroll
                for (int kk = 0; kk < 5; ++kk) { const bf16x8 Ag = *(const bf16x8*)(L_SG + (16 * tt + n16) * RW2_SGP + (32 * kk + 8 * g) * 2); const bf16x8 Gb = *(const bf16x8*)(G2T + (16 * nt + n16) * RW2_SGP + (32 * kk + 8 * g) * 2); ag = __builtin_amdgcn_mfma_f32_16x16x32_bf16(Ag, Gb, ag, 0, 0, 0); }
#pragma unroll
                for (int r = 0; r < 4; ++r) { const int o = (16 * tt + 4 * g + r) * 64 + 16 * nt + n16; LO_W[o] = aw[r]; LO_A[o] = aa[r]; A_G[o] = ag[r]; }
            }
            __syncthreads();
#pragma unroll 2
            for (int i = 0; i < 4; ++i) {
                const int t = w + 8 * i, o = t * 64 + l;
                const float w0v = CST[l], a0v = CST[64 + l], kkv = CST[128 + l], kav = CST[192 + l], rkv = CST[256 + l];
                const float dec = __expf(-0.6065306597126334f * sigmoidf_(w0v + LO_W[o]));
                const float a = sigmoidf_(a0v + LO_A[o]);
                const float kr = A_K2[o], r = A_WR[o];
                const float kk0 = kr * kkv, k2 = kr * (1.f + (a - 1.f) * kav), bb0 = kk0 * a, k2r = k2 * r;
                A_W[o] = dec; A_NKK[o] = -kk0; A_B[o] = bb0; A_K2[o] = k2; A_WR[o] = dec * r;
                PR0[o] = kk0 * kk0; PR1[o] = bb0 * r; PR2[o] = k2r; PR3[o] = k2r * rkv;
            }
            __syncthreads();
            {
                const int t = c.tid >> 4, q = (c.tid >> 2) & 3, qu = c.tid & 3;
                const float* src = (q == 0 ? PR0 : q == 1 ? PR1 : q == 2 ? PR2 : PR3) + t * 64 + 16 * qu;
                const f32x4 v0 = *(const f32x4*)src, v1 = *(const f32x4*)(src + 4), v2 = *(const f32x4*)(src + 8), v3 = *(const f32x4*)(src + 12);
                float sm = ((v0.x + v0.y) + (v0.z + v0.w)) + ((v1.x + v1.y) + (v1.z + v1.w)) + ((v2.x + v2.y) + (v2.z + v2.w)) + ((v3.x + v3.y) + (v3.z + v3.w));
                sm += dpp_mov<0xB1>(sm); sm += dpp_mov<0x4E>(sm);
                if (qu == 0) SCP[t * 4 + q] = (q == 0) ? 1.0f / fmaxf(sm, 1e-24f) : sm;
            }
            __syncthreads();
            {
                f32x4 n0, n1, r0, r1, w0_, w1_, b0, b1, k0, k1, sp; float vv;
                const unsigned char* pk_ = (const unsigned char*)A_WR + 32 * sj;
                const unsigned char* pv_ = (const unsigned char*)A_WR + 4 * srow;
                const unsigned char* ps_ = (const unsigned char*)SCP;
                constexpr int O_WR = 0, O_K2 = 8192, O_V = 16384, O_W = 24576, O_NKK = 32768, O_B = 40960, O_OUT = 57344;
#define RW2_LD_DOT(T) do { n0 = *(const f32x4*)(pk_ + O_NKK + (T) * 256); n1 = *(const f32x4*)(pk_ + O_NKK + (T) * 256 + 16); r0 = *(const f32x4*)(pk_ + O_WR + (T) * 256); r1 = *(const f32x4*)(pk_ + O_WR + (T) * 256 + 16); } while (0)
#define RW2_LD_UPD(T) do { w0_ = *(const f32x4*)(pk_ + O_W + (T) * 256); w1_ = *(const f32x4*)(pk_ + O_W + (T) * 256 + 16); b0 = *(const f32x4*)(pk_ + O_B + (T) * 256); b1 = *(const f32x4*)(pk_ + O_B + (T) * 256 + 16); \
                    k0 = *(const f32x4*)(pk_ + O_K2 + (T) * 256); k1 = *(const f32x4*)(pk_ + O_K2 + (T) * 256 + 16); vv = *(const float*)(pv_ + O_V + (T) * 256); sp = *(const f32x4*)(ps_ + (T) * 16); } while (0)
#define RW2_STEP(T) do { \
                    f32x2 sa2 = S[0] * (f32x2){n0.x, n0.y}; sa2 = S[1] * (f32x2){n0.z, n0.w} + sa2; sa2 = S[2] * (f32x2){n1.x, n1.y} + sa2; sa2 = S[3] * (f32x2){n1.z, n1.w} + sa2; \
                    f32x2 p2 = S[0] * (f32x2){r0.x, r0.y}; p2 = S[1] * (f32x2){r0.z, r0.w} + p2; p2 = S[2] * (f32x2){r1.x, r1.y} + p2; p2 = S[3] * (f32x2){r1.z, r1.w} + p2; \
                    __builtin_amdgcn_sched_barrier(0); RW2_LD_DOT((T) + 1); __builtin_amdgcn_sched_barrier(0); \
                    const float sa = sum8(sa2.x + sa2.y) * sp.x, p = sum8(p2.x + p2.y); \
                    const f32x2 sav = (f32x2){sa, sa}, vvv = (f32x2){vv, vv}; \
                    S[0] = S[0] * (f32x2){w0_.x, w0_.y} + (sav * (f32x2){b0.x, b0.y} + vvv * (f32x2){k0.x, k0.y}); \
                    S[1] = S[1] * (f32x2){w0_.z, w0_.w} + (sav * (f32x2){b0.z, b0.w} + vvv * (f32x2){k0.z, k0.w}); \
                    S[2] = S[2] * (f32x2){w1_.x, w1_.y} + (sav * (f32x2){b1.x, b1.y} + vvv * (f32x2){k1.x, k1.y}); \
                    S[3] = S[3] * (f32x2){w1_.z, w1_.w} + (sav * (f32x2){b1.z, b1.w} + vvv * (f32x2){k1.z, k1.w}); \
                    const float ov = p + sa * sp.y + vv * sp.z; \
                    __builtin_amdgcn_sched_barrier(0); RW2_LD_UPD((T) + 1); *(float*)(const_cast<unsigned char*>(pv_) + O_OUT + (T) * 256) = ov;        __builtin_amdgcn_sched_barrier(0); } while (0)
                RW2_LD_DOT(0); RW2_LD_UPD(0);
#pragma unroll 1
                for (int t4 = 0; t4 < 8; ++t4) {
                    RW2_STEP(0); RW2_STEP(1); RW2_STEP(2); RW2_STEP(3);
                    pk_ += 1024; pv_ += 1024; ps_ += 64;
                }
#undef RW2_LD_DOT
#undef RW2_LD_UPD
#undef RW2_STEP
            }
            __syncthreads();
            {
                const int t = c.tid >> 3, q = (c.tid >> 2) & 1, qu = c.tid & 3;
                if (c.tid < 256) {
                    const float* src = A_OUT + t * 64 + 16 * qu; float sm = 0.f;
#pragma unroll
                    for (int e = 0; e < 4; ++e) { const f32x4 v = *(const f32x4*)(src + 4 * e); sm += q ? ((v.x * v.x + v.y * v.y) + (v.z * v.z + v.w * v.w)) : ((v.x + v.y) + (v.z + v.w)); }
                    sm += dpp_mov<0xB1>(sm); sm += dpp_mov<0x4E>(sm);
                    const float other = dpp_mov<0x141>(sm);
                    if ((c.tid & 7) == 0) { const float mean = sm * (1.f / 64.f), var = fmaxf(other * (1.f / 64.f) - mean * mean, 0.f); GN[t * 2] = mean; GN[t * 2 + 1] = 1.0f / sqrtf(var + 64e-5f); }
                }
            }
            __syncthreads();
#pragma unroll
            for (int i = 0; i < 4; ++i) {
                const int t = w + 8 * i, o = t * 64 + l;
                float y = (A_OUT[o] - GN[t * 2]) * GN[t * 2 + 1] * CST[320 + l] + CST[384 + l];
                y = (y + SCP[t * 4 + 3] * A_V[o]) * A_G[o];
                if (b < wb) OUT[((size_t)b * SEQ + t0 + t) * ldo + coloff + hk] = (bf16)f2bf(y);
            }
        }
#undef RW2_LOAD
    }
}
constexpr int S5B_BUP = 132 * 4, S5B_XP = 272;
constexpr int S5B_WAVE = 16 * S5B_BUP + 16 * S5B_XP;
__device__ __forceinline__ void wave_lds_sync() { __builtin_amdgcn_fence(__ATOMIC_RELEASE, "wavefront"); __builtin_amdgcn_wave_barrier(); __builtin_amdgcn_fence(__ATOMIC_ACQUIRE, "wavefront"); }
__device__ __forceinline__ float gelu_fast(float y) { const float u2 = 1.5957691216057308f * (y + 0.044715f * y * y * y); return y * __builtin_amdgcn_rcpf(1.f + __expf(-u2)); }
__device__ __forceinline__ void s5_phase2(const Ctx& c, const bf16* __restrict__ U, const S5P P, bf16* Z) {
    if (c.wave >= 4) return;
    float* BU = (float*)(c.lds + c.wave * S5B_WAVE); unsigned char* XB = c.lds + c.wave * S5B_WAVE + 16 * S5B_BUP;
    const int l = c.lane, n16 = l & 15, g = l >> 4;
#pragma unroll 1
    for (int item = c.bid; item < 256; item += c.nb) {
        const int b = item >> 5, grp = (item & 31) * 4 + c.wave;
        float lbr, lbi;
        { const float lr = fminf(P.lam_re[grp * 64 + l], -1e-4f), li = P.lam_im[grp * 64 + l], dt = expf(P.log_dt[grp]);
          const float e = expf(lr * dt); lbr = e * cosf(li * dt); lbi = e * sinf(li * dt);
          const float nr = lbr - 1.f, ni = lbi, den = 1.f / (lr * lr + li * li);
          BU[l] = (nr * lr + ni * li) * den; BU[64 + l] = (ni * lr - nr * li) * den; }
        wave_lds_sync();
        bf16x4 Bre[4], Bim[4];
#pragma unroll
        for (int nt = 0; nt < 4; ++nt) { const int p = 16 * nt + n16; const float cr = BU[p], ci = BU[64 + p];
            const f32x4 br = *(const f32x4*)(P.b_re + (size_t)(grp * 64 + p) * 16 + 4 * g), bi = *(const f32x4*)(P.b_im + (size_t)(grp * 64 + p) * 16 + 4 * g);
            u32x2 wr, wi; wr.x = pk2(cr * br.x - ci * bi.x, cr * br.y - ci * bi.y); wr.y = pk2(cr * br.z - ci * bi.z, cr * br.w - ci * bi.w);
            wi.x = pk2(cr * bi.x + ci * br.x, cr * bi.y + ci * br.y); wi.y = pk2(cr * bi.z + ci * br.z, cr * bi.w + ci * br.w);
            Bre[nt] = __builtin_bit_cast(bf16x4, wr); Bim[nt] = __builtin_bit_cast(bf16x4, wi); }
        wave_lds_sync();
        bf16x8 Cf[4];
#pragma unroll
        for (int kk = 0; kk < 4; ++kk) { const int p0 = 16 * kk + 4 * g;
            const f32x4 vr = *(const f32x4*)(P.c_re + (size_t)(grp * 16 + n16) * 64 + p0), vi = *(const f32x4*)(P.c_im + (size_t)(grp * 16 + n16) * 64 + p0);
            u32x4 w; w.x = pk2(vr.x, -vi.x); w.y = pk2(vr.y, -vi.y); w.z = pk2(vr.z, -vi.z); w.w = pk2(vr.w, -vi.w); Cf[kk] = __builtin_bit_cast(bf16x8, w); }
        bf16x4 Df; { const float dsk = P.d[grp * 16 + n16]; const int kq = n16 - 4 * g; u32x2 w; w.x = pk2(kq == 0 ? dsk : 0.f, kq == 1 ? dsk : 0.f); w.y = pk2(kq == 2 ? dsk : 0.f, kq == 3 ? dsk : 0.f); Df = __builtin_bit_cast(bf16x4, w); }
        f32x2 xs = (f32x2){0.f, 0.f};
        const bf16* ub = U + (size_t)b * SEQ * D + grp * 16;
        u32x2 ua[4];
#define S5B_LOAD(k, T0) do { ua[k] = *(const u32x2*)(ub + (size_t)((T0) + n16) * D + 4 * g); } while (0)
#pragma unroll
        for (int k = 0; k < 4; ++k) S5B_LOAD(k, 16 * k);
#pragma unroll 1
        for (int t0 = 0; t0 < SEQ; t0 += 64) {
#pragma unroll
            for (int k = 0; k < 4; ++k) {
                const int tb = t0 + 16 * k;
                const bf16x4 A = __builtin_bit_cast(bf16x4, ua[k]);
                { const int tn = (tb + 64 < SEQ) ? tb + 64 : tb; S5B_LOAD(k, tn); }
                const f32x4 yd = __builtin_amdgcn_mfma_f32_16x16x16bf16_1k(A, Df, (f32x4){0.f, 0.f, 0.f, 0.f}, 0, 0, 0);
#pragma unroll
                for (int nt = 0; nt < 4; ++nt) {
                    const f32x4 ar = __builtin_amdgcn_mfma_f32_16x16x16bf16_1k(A, Bre[nt], (f32x4){0.f, 0.f, 0.f, 0.f}, 0, 0, 0);
                    const f32x4 ai = __builtin_amdgcn_mfma_f32_16x16x16bf16_1k(A, Bim[nt], (f32x4){0.f, 0.f, 0.f, 0.f}, 0, 0, 0);
#pragma unroll
                    for (int r = 0; r < 4; ++r) *(f32x2*)(BU + (4 * g + r) * 132 + 2 * (16 * nt + n16)) = (f32x2){ar[r], ai[r]};
                }
                wave_lds_sync();
#pragma unroll 4
                for (int t = 0; t < 16; ++t) {
                    const f32x2 bu = *(const f32x2*)(BU + t * 132 + 2 * l);
                    const f32x2 tq = (f32x2){lbr, lbr} * xs + bu;
                    xs = (f32x2){-lbi, lbi} * (f32x2){xs.y, xs.x} + tq;
                    *(unsigned*)(XB + t * S5B_XP + l * 4) = pg8::cvt_pk_bf16(xs.x, xs.y);
                }
                wave_lds_sync();
                f32x4 y = (f32x4){0.f, 0.f, 0.f, 0.f};
#pragma unroll
                for (int kk = 0; kk < 4; ++kk) { const bf16x8 Ax = *(const bf16x8*)(XB + n16 * S5B_XP + (32 * kk + 8 * g) * 2); y = __builtin_amdgcn_mfma_f32_16x16x32_bf16(Ax, Cf[kk], y, 0, 0, 0); }
#pragma unroll
                for (int r = 0; r < 4; ++r) Z[((size_t)b * SEQ + tb + 4 * g + r) * D + grp * 16 + n16] = (bf16)f2bf(gelu_fast(y[r] + yd[r]));
                wave_lds_sync();
            }
        }
#undef S5B_LOAD
    }
}
struct Args { const void* in[45]; float* out; unsigned char* ws; int ph_lo, ph_hi; };
static_assert(sizeof(Args) == 45 * 8 + 8 + 8 + 8, "Args has no padding");
constexpr int PH_EVEN = 9, PH_ODD = 4, PH_COMMON = 13;
constexpr int NPHASES = 2 * (1 + PH_EVEN + PH_COMMON) + 2 * (1 + PH_ODD + PH_COMMON) + 1;

__global__ void __launch_bounds__(NTHR, 2) mega(Args args) {
    extern __shared__ __attribute__((aligned(16))) unsigned char lds[];
    volatile LAS unsigned* MISC = (volatile LAS unsigned*)((LAS unsigned char*)lds + MISC_OFF);
    if (threadIdx.x < 64) MISC[threadIdx.x] = 0u;
    __syncthreads();
    unsigned char* ws = args.ws;
    XcdBarrier bar = xcd_barrier_post((unsigned*)(ws + WS_CTL) + 4096, MISC + 8, gridDim.x);
    const int half = (int)gridDim.x >> 1;
    XcdBarrier bar2 = bar; if ((int)blockIdx.x >= half) bar2 = xcd_barrier_post((unsigned*)(ws + WS_CTL) + 8192, MISC + 10, gridDim.x - half);
    const int lo = args.ph_lo, hi = args.ph_hi;
    int pid = 0;
#define PH_BEGIN if (pid >= lo && pid < hi) { Ctx c; { int t_ = threadIdx.x, b_ = blockIdx.x; asm volatile("" : "+v"(t_)); asm volatile("" : "+s"(b_)); c.lds = lds; c.tid = t_; c.lane = t_ & 63; c.wave = __builtin_amdgcn_readfirstlane(t_ >> 6); c.bid = b_; { int n_ = gridDim.x; asm volatile("" : "+s"(n_)); c.nb = n_; } c.gw = c.bid * NWAVES + c.wave; c.ngw = c.nb * NWAVES; }
#define PH_END } if (pid >= lo && pid + 1 < hi) { xcd_barrier(bar); if (DBL & 2048) xcd_barrier(bar); } ++pid;
#define IN_F(i) (*(const float* const __attribute__((address_space(4)))*)(KARGS() + 8 * (i)))

    typedef const unsigned char __attribute__((address_space(4)))* kptr_t;
#define KARGS() ({ kptr_t p_ = (kptr_t)__builtin_amdgcn_kernarg_segment_ptr(); asm volatile("" : "+s"(p_)); p_; })
#define WSP(off) ((*(unsigned char* const __attribute__((address_space(4)))*)(KARGS() + 368)) + (off))
#define X ((float*)(*(float* const __attribute__((address_space(4)))*)(KARGS() + 360)))
#define ROPEA ((float*)WSP(WS_ROPEA))
#define ROPEI ((float*)WSP(WS_ROPEI))
#define KVBIG ((bf16*)WSP(WS_KVBIG))
#define WKV ((bf16*)WSP(WS_WKV))
#define W_IN ((bf16*)WSP(WS_WMIX + WMIX_IN))
#define WQ ((bf16*)WSP(WS_WMIX + WMIX_Q))
#define WOUT ((bf16*)WSP(WS_WMIX + WMIX_OUT))
#define WO_IN ((bf16*)WSP(WS_WMIX + WMIX_O_IN))
#define WO_GLU ((bf16*)WSP(WS_WMIX + WMIX_O_GLU))
#define WO_OUT ((bf16*)WSP(WS_WMIX + WMIX_O_OUT))
#define WXQ ((bf16*)WSP(WS_WXQ))
#define WXO ((bf16*)WSP(WS_WXO))
#define WUP ((bf16*)WSP(WS_WUP))
#define WDN ((bf16*)WSP(WS_WDN))
#define CQN ((bf16*)WSP(WS_CQN))
#define KF ((bf16*)WSP(WS_KF))
#define KIDX ((bf16*)WSP(WS_KIDX))
#define WIDX ((float*)WSP(WS_WIDX))
#define SEL ((bf16*)WSP(WS_SEL))
#define Hb ((bf16*)WSP(WS_R1))
#define SC ((float*)WSP(WS_R1))
#define HID ((bf16*)WSP(WS_R1))
#define Ub ((bf16*)WSP(WS_R1))
#define YC ((bf16*)WSP(WS_R1 + (size_t)M * D * 2))
#define XN ((bf16*)WSP(WS_R2))
#define QALL ((bf16*)X)
#define OLY ((bf16*)WSP(WS_R3))
#define Zb ((bf16*)WSP(WS_R3))
#define XQ ((bf16*)WSP(WS_R3))
#define XO ((bf16*)WSP(WS_R3 + (size_t)M * 512 * 2))
#define MEMN ((bf16*)WSP(WS_R3))
    LAS unsigned char* glds = (LAS unsigned char*)lds;

#define RS_A ((unsigned long long*)WSP(WS_CTL + 131072))
#define RS_B ((unsigned long long*)WSP(WS_CTL + 393216))
#define RS_C ((unsigned long long*)WSP(WS_CTL + 655360))
    for (int layer = 0; layer < DEPTH; ++layer) {
        const int li = layer >> 1;
        PH_BEGIN
            if ((layer & 1) == 0) {
                conv_mat(c, IN_F(13) + (size_t)li * 2048 * EVEN_COLS, 2048, EVEN_COLS, EVEN_COLS, HC, W_IN, 2048, 0, 0, IN_F(3) + layer * D);
                build_wql(c, IN_F(18) + (size_t)li * 512 * 1024, IN_F(19) + (size_t)li * 256 * 768, WQ);
                for (int h = 0; h < 8; ++h) conv_mat(c, IN_F(18) + (size_t)li * 512 * 1024 + h * 128, 512, 1024, 32, 32, WQ, 512, 2048 + h * 32, 0);
                conv_mat(c, IN_F(21) + (size_t)li * 512 * 1024, 512, 1024, 1024, 1024, WQ, 512, 2304, 0);
                build_wout(c, IN_F(20) + (size_t)li * 256 * 1024, IN_F(14) + (size_t)li * 2048 * 2048, WOUT);
                conv_mat(c, IN_F(14) + (size_t)li * 2048 * 2048 + (size_t)1024 * 2048, 1024, 2048, 2048, 2048, WOUT, OC, 0, 2048);
            } else {
                conv_mat(c, IN_F(33) + (size_t)li * 2048 * 2048, 2048, 2048, 2048, 2048, WO_IN, 2048, 0, 0, IN_F(3) + layer * D);
                conv_mat(c, IN_F(43) + (size_t)li * 2048 * 2048, 2048, 2048, 2048, 2048, WO_GLU, 2048, 0, 0);
                conv_mat(c, IN_F(34) + (size_t)li * 2048 * 2048, 2048, 2048, 2048, 2048, WO_OUT, 2048, 0, 0);
            }
            conv_mat(c, IN_F(8) + (size_t)layer * 2048 * 512, 2048, 512, 512, 512, WXQ, 2048, 0, 0, IN_F(4) + layer * D);
            conv_mat(c, IN_F(10) + (size_t)layer * 512 * 2048, 512, 2048, 2048, 2048, WXO, 512, 0, 0);
            { unsigned long long* ra = RS_A; unsigned long long* rb = RS_B; for (int i = c.bid * NTHR + c.tid; i < M; i += c.nb * NTHR) { ra[i] = 0ull; rb[i] = 0ull; } }
            if (layer == 0) {
                for (int l2 = 0; l2 < 4; ++l2) {
                    conv_mat(c, IN_F(9) + (size_t)l2 * 2048 * 1024, 2048, 1024, 1024, 1024, WKV, 2048, l2 * 1024, 0);
                    norm_rows_bf16(c, IN_F(1), IN_F(5) + l2 * D, MEMN + (size_t)l2 * MEMR * D, MEMR);
                }
                rope_tables(c, (const int*)IN_F(2), ROPEA, ROPEI);
                cast_rows_ss(c, IN_F(0), XN, RS_C, M);
            }
        PH_END
        if ((layer & 1) == 0) {
            PH_BEGIN
                { pg8::Gemm g{XN, W_IN, 2048, 2048, 2048}; pg8::StaticOrder S; S.init(128, HC / 256, c.nb, c.bid); pg8::EpiBf16<0> E{Hb, HC, RS_C};
                  pg8::gemm_phase<pg8::EpiBf16<0>, pg8::StaticOrder, true, true>(glds, g, S, E);
                  if (DBL & 1024) { __syncthreads(); pg8::gemm_phase<pg8::EpiBf16<0>, pg8::StaticOrder, true, true>(glds, g, S, E); } }
                if (layer == 0) { __syncthreads(); pg8::Gemm g{MEMN, WKV, 2048, 2048, 2048}; pg8::KvOrder S{c.nb, c.bid}; pg8::EpiBf16<0> E{KVBIG, 4096, nullptr};
                  pg8::gemm_phase<pg8::EpiBf16<0>, pg8::KvOrder, true, true>(glds, g, S, E); }
            PH_END
            PH_BEGIN
                rwkv_lora_prep(c, Hb, IN_F(22) + li * B_COLS, (bf16*)WSP(WS_END + 96 * MiB));
            PH_END
            PH_BEGIN
                if (c.bid < half) {
                    Ctx r = c; r.nb = half; r.ngw = half * NWAVES;
                    const RwkvP P{IN_F(22) + li * B_COLS, IN_F(23) + li * 1024, IN_F(24) + (size_t)li * 65536, IN_F(25) + li * 1024, IN_F(26) + (size_t)li * 65536, IN_F(27) + (size_t)li * 163840,
                                  IN_F(28) + li * 1024, IN_F(29) + li * 1024, IN_F(30) + li * 1024, IN_F(31) + li * 1024, IN_F(32) + li * 1024};
#if DIAG == 4
                    rwkv_phase(r, Hb, P, OLY);
                    rwkv_phase2(r, Hb, (const bf16*)WSP(WS_END + 96 * MiB), P, (bf16*)WSP(WS_END + 116 * MiB), 1024, 0, 1);
#else
                    rwkv_phase2(r, Hb, (const bf16*)WSP(WS_END + 96 * MiB), P, OLY, OC, 2048);
#endif
                    __syncthreads();
                    conv_mat(r, IN_F(12) + (size_t)layer * FFN * 2048, FFN, 2048, 2048, 2048, WDN, FFN, 0, 0);
                } else {
                    Ctx d = c; d.bid = c.bid - half; d.nb = c.nb - half; d.gw = d.bid * NWAVES + d.wave; d.ngw = d.nb * NWAVES;
                    dsa_prep(d, Hb, IN_F(15) + li * 512, IN_F(16) + li * 256, IN_F(17) + li * 64, ROPEA, ROPEI, CQN, KF, KIDX, WIDX);
                    xcd_barrier(bar2);
                    { pg8::Gemm g{CQN, WQ, 512, 512, 512}; pg8::StaticOrder S; S.init(128, QC / 256, d.nb, d.bid); pg8::EpiBf16<0> E{QALL, QC, nullptr};
                      pg8::gemm_phase<pg8::EpiBf16<0>, pg8::StaticOrder, true, true>(glds, g, S, E); }
                    xcd_barrier(bar2);
                    idx_topk_mfma(d, QALL, KIDX, WIDX, ROPEI, (float*)(d.bid < 32 ? WSP(WS_CQN + (size_t)d.bid * MiB) : WSP(WS_END + (size_t)(d.bid - 32) * MiB)), SEL, 256);
                    conv_mat(d, IN_F(11) + (size_t)layer * 2048 * FFN, 2048, FFN, FFN, FFN, WUP, 2048, 0, 0, IN_F(6) + layer * D);
                    xcd_barrier(bar2);
                    if (d.bid == 0 && c.tid == 0) __hip_atomic_store((unsigned*)WSP(WS_CTL) + 12288 + 64 * (2 + li), 1u, __ATOMIC_RELAXED, __HIP_MEMORY_SCOPE_AGENT);
                }
                if (c.bid < half) {
                    if (c.tid == 0) { unsigned* fl = (unsigned*)WSP(WS_CTL) + 12288 + 64 * (2 + li); unsigned sp = 0;
                        while (__hip_atomic_load(fl, __ATOMIC_RELAXED, __HIP_MEMORY_SCOPE_AGENT) == 0u) { __builtin_amdgcn_s_sleep(8); if (++sp > (1u << 22)) break; } }
                    __syncthreads();
                    __builtin_amdgcn_fence(__ATOMIC_ACQUIRE, "agent"); asm volatile("s_waitcnt vmcnt(0)" ::: "memory");
                }
                dsa_attn_queue(c, QALL, KF, SEL, ROPEA, OLY, (unsigned*)WSP(WS_CTL) + 12288 + 64 * li, MISC + 12);
            PH_END
#if DBL & 32
            PH_BEGIN
                if (c.bid < half) {
                    Ctx r = c; r.nb = half; r.ngw = half * NWAVES;
                    const RwkvP P{IN_F(22) + li * B_COLS, IN_F(23) + li * 1024, IN_F(24) + (size_t)li * 65536, IN_F(25) + li * 1024, IN_F(26) + (size_t)li * 65536, IN_F(27) + (size_t)li * 163840,
                                  IN_F(28) + li * 1024, IN_F(29) + li * 1024, IN_F(30) + li * 1024, IN_F(31) + li * 1024, IN_F(32) + li * 1024};
                    rwkv_phase2(r, Hb, (const bf16*)WSP(WS_END + 96 * MiB), P, OLY, OC, 2048);
                }
            PH_END
#endif
#if DBL & 8
            PH_BEGIN
                if (c.bid >= half) {
                    Ctx d = c; d.bid = c.bid - half; d.nb = c.nb - half; d.gw = d.bid * NWAVES + d.wave; d.ngw = d.nb * NWAVES;
                    idx_topk_mfma(d, QALL, KIDX, WIDX, ROPEI, (float*)(d.bid < 32 ? WSP(WS_CQN + (size_t)d.bid * MiB) : WSP(WS_END + (size_t)(d.bid - 32) * MiB)), SEL, 256);
                }
            PH_END
#endif
#if DIAG == 4
            PH_BEGIN
                diag_cmp_bf16(c, OLY + 2048, OC, (bf16*)WSP(WS_END + 116 * MiB), 1024, SEQ, 1024, (float*)WSP(WS_CTL + 65536));
            PH_END
#endif
#if DIAG == 7 || DIAG == 8
            PH_BEGIN
                q_rope_fix(c, QALL, ROPEA, ROPEI);
            PH_END
#endif
#if DIAG == 7
            PH_BEGIN
                if (c.bid >= half) { Ctx d = c; d.bid = c.bid - half; d.nb = c.nb - half; d.gw = d.bid * NWAVES + d.wave; d.ngw = d.nb * NWAVES;
                    idx_topk_v1(d, QALL, KIDX, WIDX, (float*)(d.bid < 32 ? WSP(WS_CQN + (size_t)d.bid * MiB) : WSP(WS_END + (size_t)(d.bid - 32) * MiB)), (bf16*)WSP(WS_END + 116 * MiB), 128); }
            PH_END
            PH_BEGIN
                diag_cmp_sel(c, SEL, (bf16*)WSP(WS_END + 116 * MiB), 4, (float*)WSP(WS_CTL + 65536));
            PH_END
#endif
#if DIAG == 8
            PH_BEGIN
                dsa_attn_simple(c, QALL, KF, SEL, (bf16*)WSP(WS_END + 116 * MiB), 1024);
            PH_END
            PH_BEGIN
                diag_cmp_bf16(c, OLY, OC, (bf16*)WSP(WS_END + 116 * MiB), OC, 1024, 2048, (float*)WSP(WS_CTL + 65536));
            PH_END
#endif
            PH_BEGIN
                { pg8::Gemm g{OLY, WOUT, OC, OC, OC}; pg8::StaticOrder S; S.init(128, 8, c.nb, c.bid); pg8::EpiRes E{XN, D, RS_A};
                  pg8::gemm_phase<pg8::EpiRes, pg8::StaticOrder, true, true>(glds, g, S, E); }
            PH_END
        } else {
            PH_BEGIN
                { pg8::Gemm g{XN, WO_IN, 2048, 2048, 2048}; pg8::StaticOrder S; S.init(128, 8, c.nb, c.bid); pg8::EpiBf16<0> E{Ub, D, RS_C};
                  pg8::gemm_phase<pg8::EpiBf16<0>, pg8::StaticOrder, true, true>(glds, g, S, E);
                  if (DBL & 1024) { __syncthreads(); pg8::gemm_phase<pg8::EpiBf16<0>, pg8::StaticOrder, true, true>(glds, g, S, E); } }
            PH_END
            PH_BEGIN
                { const S5P P{IN_F(35) + li * 8192, IN_F(36) + li * 8192, IN_F(37) + li * 128, IN_F(38) + (size_t)li * 131072, IN_F(39) + (size_t)li * 131072, IN_F(40) + (size_t)li * 131072, IN_F(41) + (size_t)li * 131072, IN_F(42) + li * D};
                  s5_phase2(c, Ub, P, Zb); }
                if (c.wave >= 4) {
                    Ctx v = c; v.lds = c.lds + 65536 - 4 * 8704; v.gw = c.bid * 4 + (c.wave - 4); v.ngw = c.nb * 4;
                    conv_mat(v, IN_F(11) + (size_t)layer * 2048 * FFN, 2048, FFN, FFN, FFN, WUP, 2048, 0, 0, IN_F(6) + layer * D);
                    conv_mat(v, IN_F(12) + (size_t)layer * FFN * 2048, FFN, 2048, 2048, 2048, WDN, FFN, 0, 0);
                }
            PH_END
#if DIAG == 5
            PH_BEGIN
                { const S5P P{IN_F(35) + li * 8192, IN_F(36) + li * 8192, IN_F(37) + li * 128, IN_F(38) + (size_t)li * 131072, IN_F(39) + (size_t)li * 131072, IN_F(40) + (size_t)li * 131072, IN_F(41) + (size_t)li * 131072, IN_F(42) + li * D};
                  s5_phase(c, Ub, P, YC); }
            PH_END
            PH_BEGIN
                diag_cmp_bf16(c, YC, D, Zb, D, M, D, (float*)WSP(WS_CTL + 65536));
            PH_END
#endif
            PH_BEGIN
                { pg8::Gemm g{Zb, WO_GLU, 2048, 2048, 2048}; pg8::StaticOrder S; S.init(128, 8, c.nb, c.bid); pg8::EpiGlu E{Zb, YC, D, IN_F(44) + li * D};
                  pg8::gemm_phase<pg8::EpiGlu, pg8::StaticOrder, true, true>(glds, g, S, E); }
            PH_END
            PH_BEGIN
                { pg8::Gemm g{YC, WO_OUT, 2048, 2048, 2048}; pg8::StaticOrder S; S.init(128, 8, c.nb, c.bid); pg8::EpiRes E{XN, D, RS_A};
                  pg8::gemm_phase<pg8::EpiRes, pg8::StaticOrder, true, true>(glds, g, S, E); }
            PH_END
        }
        PH_BEGIN
            { unsigned long long* rc = RS_C; for (int i = c.bid * NTHR + c.tid; i < M; i += c.nb * NTHR) rc[i] = 0ull; }
            { pg8::Gemm g{XN, WXQ, 2048, 2048, 2048}; pg8::StaticOrder S; S.init(128, 2, c.nb, c.bid); pg8::EpiBf16<0> E{XQ, 512, RS_A};
              pg8::gemm_phase<pg8::EpiBf16<0>, pg8::StaticOrder, true, true>(glds, g, S, E); }
        PH_END
        PH_BEGIN
            xattn_mfma(c, XQ, KVBIG, layer, XO); if (DBL & 128) { asm volatile("" ::: "memory"); xattn_mfma(c, XQ, KVBIG, layer, XO); }
        PH_END
        PH_BEGIN
            { pg8::Gemm g{XO, WXO, 512, 512, 512}; pg8::StaticOrder S; S.init(128, 8, c.nb, c.bid); pg8::EpiRes E{XN, D, RS_B};
              pg8::gemm_phase<pg8::EpiRes, pg8::StaticOrder, true, true>(glds, g, S, E); }
        PH_END
        for (int q = 0; q < 5; ++q) {
            PH_BEGIN
                if (q > 0) { const int qd = q - 1; bf16* hid = HID + (size_t)(qd & 1) * 8192 * FFN;
                    pg8::Gemm g{hid, WDN, FFN, FFN, FFN}; pg8::StaticOrder S; S.init(32, 8, c.nb, c.bid); pg8::EpiRes E{XN + (size_t)qd * 8192 * D, D, RS_C + qd * 8192};
                    pg8::gemm_phase<pg8::EpiRes, pg8::StaticOrder, true, true>(glds, g, S, E); __syncthreads(); }
                if (q < 4) { bf16* hid = HID + (size_t)(q & 1) * 8192 * FFN;
                    pg8::Gemm g{XN + (size_t)q * 8192 * D, WUP, 2048, 2048, 2048}; pg8::StaticOrder S; S.init(32, 32, c.nb, c.bid); pg8::EpiBf16<1> E{hid, FFN, RS_B + q * 8192};
                    pg8::gemm_phase<pg8::EpiBf16<1>, pg8::StaticOrder, true, true>(glds, g, S, E); }
            PH_END
        }
    }
    PH_BEGIN
        scale_rows_out(c, XN, IN_F(7), RS_C, X, M);
    PH_END
#if DIAG
    PH_BEGIN
        { const float* dg = (const float*)WSP(WS_CTL + 65536); const float sc = 1.f + sqrtf(100.f * dg[0] / fmaxf(dg[1], 1e-30f));
          float* xo = X; for (size_t i = (size_t)c.bid * NTHR + c.tid; i < (size_t)M * D; i += (size_t)c.nb * NTHR) xo[i] *= sc; }
    PH_END
#endif
#undef PH_BEGIN
#undef PH_END
#undef IN_F
#undef X
}

extern "C" void kernel_launch(void* const* d_in, const int* in_sizes, int n_in, void* d_out, int out_size, void* d_ws, size_t ws_size, hipStream_t stream) {
    static int grid = 0;
    if (grid == 0) {
        if (n_in != 45 || out_size != M * D || ws_size < WS_END + 116 * MiB) { fprintf(stderr, "kernel_launch: unexpected shapes (n_in %d, out %d, ws %zu, need %zu)\n", n_in, out_size, ws_size, (size_t)WS_END); grid = -1; return; }
        int dev = 0, cus = 0, per_cu = 0;
        if (hipGetDevice(&dev) != hipSuccess || hipDeviceGetAttribute(&cus, hipDeviceAttributeMultiprocessorCount, dev) != hipSuccess) { grid = -1; return; }
        if (hipFuncSetAttribute((const void*)mega, hipFuncAttributeMaxDynamicSharedMemorySize, LDS_BYTES) != hipSuccess) { fprintf(stderr, "kernel_launch: hipFuncSetAttribute failed\n"); grid = -1; return; }
        if (hipOccupancyMaxActiveBlocksPerMultiprocessor(&per_cu, (const void*)mega, NTHR, LDS_BYTES) != hipSuccess || per_cu < 1) fprintf(stderr, "kernel_launch: occupancy query reports %d\n", per_cu);
        (void)hipGetLastError();
        grid = cus;
    }
    if (grid < 0) return;
    (void)hipMemsetAsync((char*)d_ws + WS_CTL, 0, CTL_BYTES, stream);
    Args a{};
    for (int i = 0; i < 45; ++i) a.in[i] = d_in[i];
    a.out = (float*)d_out; a.ws = (unsigned char*)d_ws;
#if MK_ONE_LAUNCH
    a.ph_lo = 0; a.ph_hi = 1 << 20;
    hipLaunchKernelGGL(mega, dim3(grid), dim3(NTHR), LDS_BYTES, stream, a);
#else
    for (int p = 0; p < NPHASES; ++p) { a.ph_lo = p; a.ph_hi = p + 1; hipLaunchKernelGGL(mega, dim3(grid), dim3(NTHR), LDS_BYTES, stream, a); }
#endif
}
```

```cpp
#include <hip/hip_runtime.h>
#include <cstdio>
#include <cstdint>

#ifndef DIAG
#define DIAG 0
#endif
#ifndef ATTN_SPLIT
#define ATTN_SPLIT 0
#endif
#ifndef DBL
#define DBL 0
#endif
#ifndef MK_ONE_LAUNCH
#define MK_ONE_LAUNCH 1
#endif

constexpr int D = 2048, NB = 8, SEQ = 4096, M = NB * SEQ, DEPTH = 4;
constexpr int HC = 4352;
constexpr int EVEN_COLS = 4240, A_COLS = 880, B_COLS = 3360;
constexpr int QC = 3328;
constexpr int OC = 3072;
constexpr int KFW = 288;
constexpr int FFN = 8192;
constexpr int MEMR = NB * 256;
constexpr float NORM_EPS = 1e-5f;
constexpr size_t SC_PER_BATCH = (size_t)4096 * 64 * 65 / 2;

typedef unsigned short bf16;
typedef float f32x4 __attribute__((ext_vector_type(4)));
typedef unsigned u32x4 __attribute__((ext_vector_type(4)));
typedef unsigned u32x2 __attribute__((ext_vector_type(2)));
typedef float f32x2 __attribute__((ext_vector_type(2)));
#define LAS __attribute__((address_space(3)))

constexpr size_t MiB = 1u << 20;
constexpr size_t al256(size_t x) { return (x + 255) & ~(size_t)255; }
constexpr size_t WS_CTL = 0, CTL_BYTES = 1 * MiB;
constexpr size_t WS_ROPEA = WS_CTL + CTL_BYTES;
constexpr size_t WS_ROPEI = WS_ROPEA + (size_t)M * 32 * 4;
constexpr size_t WS_KVBIG = WS_ROPEI + (size_t)M * 16 * 4;
constexpr size_t WS_WKV = WS_KVBIG + (size_t)8192 * 4096 * 2;
constexpr size_t WS_WMIX = WS_WKV + (size_t)4096 * 2048 * 2;
constexpr size_t WMIX_IN = 0, WMIX_Q = (size_t)HC * 2048 * 2, WMIX_OUT = WMIX_Q + (size_t)QC * 512 * 2, WMIX_BYTES = WMIX_OUT + (size_t)2048 * OC * 2;
constexpr size_t WMIX_O_IN = 0, WMIX_O_GLU = (size_t)2048 * 2048 * 2, WMIX_O_OUT = 2 * WMIX_O_GLU;
constexpr size_t WS_WXQ = al256(WS_WMIX + WMIX_BYTES);
constexpr size_t WS_WXO = WS_WXQ + (size_t)512 * 2048 * 2;
constexpr size_t WS_WUP = WS_WXO + (size_t)2048 * 512 * 2;
constexpr size_t WS_WDN = WS_WUP + (size_t)FFN * 2048 * 2;
constexpr size_t WS_CQN = WS_WDN + (size_t)2048 * FFN * 2;
constexpr size_t WS_KF = WS_CQN + (size_t)M * 512 * 2;
constexpr size_t WS_KIDX = WS_KF + (size_t)M * KFW * 2;
constexpr size_t WS_WIDX = WS_KIDX + (size_t)M * 64 * 2;
constexpr size_t WS_SEL = WS_WIDX + (size_t)M * 16 * 4;
constexpr size_t WS_R1 = al256(WS_SEL + (size_t)M * 256 * 2);
constexpr size_t R1_BYTES = (size_t)M * HC * 2;
constexpr size_t WS_R2 = WS_R1 + R1_BYTES;
constexpr size_t R2_BYTES = (size_t)M * QC * 2;
constexpr size_t WS_R3 = WS_R2 + R2_BYTES;
constexpr size_t R3_BYTES = (size_t)M * OC * 2;
constexpr size_t WS_END = WS_R3 + R3_BYTES;
static_assert(SC_PER_BATCH * NB * 4 <= R1_BYTES, "scores fit R1");
static_assert((size_t)8192 * FFN * 2 <= R1_BYTES && (size_t)M * 2048 * 2 * 2 <= R1_BYTES, "R1 overlays");

__device__ __forceinline__ float bf2f(unsigned v) { return __uint_as_float(v << 16); }
__device__ __forceinline__ unsigned f2bf(float f) { unsigned u = __float_as_uint(f); return (u + 0x7fffu + ((u >> 16) & 1u)) >> 16; }
__device__ __forceinline__ unsigned pk2(float lo, float hi) { return f2bf(lo) | (f2bf(hi) << 16); }
__device__ __forceinline__ float wave_sum(float v) {
#pragma unroll
    for (int o = 1; o < 64; o <<= 1) v += __shfl_xor(v, o);
    return v;
}
__device__ __forceinline__ float wave_max(float v) {
#pragma unroll
    for (int o = 1; o < 64; o <<= 1) v = fmaxf(v, __shfl_xor(v, o));
    return v;
}
__device__ __forceinline__ void unpack8(const u32x4 w, float* f) {
    f[0] = __uint_as_float(w.x << 16); f[1] = __uint_as_float(w.x & 0xffff0000u); f[2] = __uint_as_float(w.y << 16); f[3] = __uint_as_float(w.y & 0xffff0000u);
    f[4] = __uint_as_float(w.z << 16); f[5] = __uint_as_float(w.z & 0xffff0000u); f[6] = __uint_as_float(w.w << 16); f[7] = __uint_as_float(w.w & 0xffff0000u);
}
__device__ __forceinline__ float sigmoidf_(float x) { return __builtin_amdgcn_rcpf(1.f + __expf(-x)); }
namespace pg8 {
#define PG8_LAS __attribute__((address_space(3)))
typedef unsigned short bf16_t;
typedef short bf16x8 __attribute__((ext_vector_type(8)));
typedef float f32x4 __attribute__((ext_vector_type(4)));
typedef unsigned u32x4 __attribute__((ext_vector_type(4)));
constexpr int BM = 256, BK = 64, HALF = 128, HTB = HALF * BK * 2, STAGE_BYTES = 8 * HTB, NXCD = 8, WGM = 8;

__host__ __device__ __forceinline__ int lds_byte(int r, int c) { const int st = (r >> 4) * 2 + (c >> 5), rr = r & 15, cc = c & 31, ob = rr * 64 + cc * 2; return st * 1024 + (ob ^ (((ob >> 9) & 1) << 5)); }
__host__ __device__ __forceinline__ void stage_rc(int b, int& R, int& C) { const int st = b / 1024, sb = b % 1024, swz = sb ^ (((sb >> 9) & 1) << 5); R = (st >> 1) * 16 + swz / 64; C = (st & 1) * 32 + (swz % 64) / 2; }
__host__ __device__ __forceinline__ int perm32(int rho) { const int n = rho >> 4, i = rho & 15; return 8 * (i >> 2) + 4 * n + (i & 3); }

struct Unit { int pm, pn; };
struct Gemm { const bf16_t* A; const bf16_t* Bt; int lda, ldb, K, pad; };

struct StaticOrder {
    int nM, nN, nwg, G, c;
    __host__ __device__ void init(int nM_, int nN_, int G_, int c_) { nM = nM_; nN = nN_; nwg = nM * nN; G = G_; c = c_; }
    __host__ __device__ bool next(int i, Unit& u) const {
        const long L = (long)i * G + c; if (L >= nwg) return false;
        int wgid = (int)L; { const int q = nwg / NXCD, r = nwg % NXCD, xcd = wgid % NXCD, off = wgid / NXCD; wgid = (xcd < r ? xcd * (q + 1) : r * (q + 1) + (xcd - r) * q) + off; }
        const int nig = WGM * nN, gid = wgid / nig, fm = gid * WGM, gsz = (nM - fm) < WGM ? (nM - fm) : WGM;
        u.pm = fm + ((wgid % nig) % gsz); u.pn = (wgid % nig) / gsz; return true;
    }
    __device__ __forceinline__ void a_ready(const Unit&) const {}
    __device__ __forceinline__ void done(const Unit&) const {}
};
struct KvOrder {
    int G, c;
    __device__ bool next(int i, Unit& u) const { const int L = i * G + c; if (L >= 128) return false; const int ly = L >> 5, r = L & 31; u.pm = ly * 8 + (r & 7); u.pn = ly * 4 + (r >> 3); return true; }
    __device__ __forceinline__ void a_ready(const Unit&) const {}
    __device__ __forceinline__ void done(const Unit&) const {}
};

__device__ __forceinline__ unsigned cvt_pk_bf16(float lo, float hi) { unsigned r; asm volatile("v_cvt_pk_bf16_f32 %0, %1, %2" : "=v"(r) : "v"(lo), "v"(hi)); return r; }

template <int ACT> struct EpiBf16 {
    static constexpr bool PERM = true, AFTER_DRAIN = false;
    bf16_t* O; int ldc; const unsigned long long* rowss;
    __device__ __forceinline__ void operator()(const f32x4 (&acc)[2][2][4][2], const Unit& u, int wr, int wc, int fr, int fq) const {
        const int row0 = u.pm * BM + wr * 64 + fr; const int col0 = u.pn * BM + wc * 32 + 8 * fq;
        unsigned long long rq[2][4];
#pragma unroll
        for (int ai = 0; ai < 2; ++ai)
#pragma unroll
            for (int m = 0; m < 4; ++m) rq[ai][m] = rowss ? rowss[row0 + ai * HALF + m * 16] : 0ull;
        if (rowss) asm volatile("" : "+v"(rq[0][0]), "+v"(rq[0][1]), "+v"(rq[0][2]), "+v"(rq[0][3]), "+v"(rq[1][0]), "+v"(rq[1][1]), "+v"(rq[1][2]), "+v"(rq[1][3]));
#pragma unroll
        for (int ai = 0; ai < 2; ++ai)
#pragma unroll
            for (int m = 0; m < 4; ++m) { bf16_t* rowp = O + (size_t)(row0 + ai * HALF + m * 16) * ldc + col0;
                const float rs = rowss ? __builtin_amdgcn_rsqf((float)rq[ai][m] * (5.9604644775390625e-08f / 2048.f) + 1e-5f) : 1.f;
#pragma unroll
                for (int bj = 0; bj < 2; ++bj) { f32x4 v0 = acc[ai][bj][m][0] * rs, v1 = acc[ai][bj][m][1] * rs;
                    if (ACT == 1) {
#pragma unroll
                        for (int j = 0; j < 4; ++j) { const float a = fmaxf(v0[j], 0.f), b = fmaxf(v1[j], 0.f); v0[j] = a * a; v1[j] = b * b; } }
                    u32x4 w; w.x = cvt_pk_bf16(v0[0], v0[1]); w.y = cvt_pk_bf16(v0[2], v0[3]); w.z = cvt_pk_bf16(v1[0], v1[1]); w.w = cvt_pk_bf16(v1[2], v1[3]);
                    *(u32x4*)(rowp + bj * HALF) = w; } }
    }
};
struct EpiRes {
    static constexpr bool PERM = false, AFTER_DRAIN = false;
    bf16_t* xb; int ldc; unsigned long long* rowss;
    __device__ __forceinline__ void operator()(const f32x4 (&acc)[2][2][4][2], const Unit& u, int wr, int wc, int fr, int fq) const {
        typedef unsigned u32x2_ __attribute__((ext_vector_type(2)));
        const int row0 = u.pm * BM + wr * 64 + fr, col0 = u.pn * BM + wc * 32 + 4 * fq;
#pragma unroll
        for (int ai = 0; ai < 2; ++ai) {
            u32x2_ bv[4][2][2];
#pragma unroll
            for (int m = 0; m < 4; ++m) { const bf16_t* rp = xb + (size_t)(row0 + ai * HALF + m * 16) * ldc + col0;
#pragma unroll
                for (int bj = 0; bj < 2; ++bj)
#pragma unroll
                    for (int n = 0; n < 2; ++n) bv[m][bj][n] = *(const u32x2_*)(rp + bj * HALF + n * 16); }
#pragma unroll
            for (int m = 0; m < 4; ++m) { bf16_t* rp = xb + (size_t)(row0 + ai * HALF + m * 16) * ldc + col0; float ss = 0.f;
#pragma unroll
                for (int bj = 0; bj < 2; ++bj)
#pragma unroll
                    for (int n = 0; n < 2; ++n) { const u32x2_ b = bv[m][bj][n]; f32x4 x = acc[ai][bj][m][n];
                        x[0] += __uint_as_float(b.x << 16); x[1] += __uint_as_float(b.x & 0xffff0000u); x[2] += __uint_as_float(b.y << 16); x[3] += __uint_as_float(b.y & 0xffff0000u);
                        u32x2_ w; w.x = cvt_pk_bf16(x[0], x[1]); w.y = cvt_pk_bf16(x[2], x[3]); *(u32x2_*)(rp + bj * HALF + n * 16) = w;
                        const float r0 = __uint_as_float(w.x << 16), r1 = __uint_as_float(w.x & 0xffff0000u), r2 = __uint_as_float(w.y << 16), r3 = __uint_as_float(w.y & 0xffff0000u);
                        ss += (r0 * r0 + r1 * r1) + (r2 * r2 + r3 * r3); }
                ss += __shfl_xor(ss, 16); ss += __shfl_xor(ss, 32);
                if (fq == 0) atomicAdd(rowss + row0 + ai * HALF + m * 16, (unsigned long long)(ss * 16777216.0f)); }
            asm volatile("" ::: "memory"); }
    }
};
struct EpiGlu {
    static constexpr bool PERM = true, AFTER_DRAIN = false;
    const bf16_t* Z; bf16_t* O; int ldc; const float* bias;
    __device__ __forceinline__ void operator()(const f32x4 (&acc)[2][2][4][2], const Unit& u, int wr, int wc, int fr, int fq) const {
        const int row0 = u.pm * BM + wr * 64 + fr; const int col0 = u.pn * BM + wc * 32 + 8 * fq;
        f32x4 bv[2][2];
#pragma unroll
        for (int bj = 0; bj < 2; ++bj)
#pragma unroll
            for (int n = 0; n < 2; ++n) bv[bj][n] = *(const f32x4*)(bias + col0 + bj * HALF + 4 * n);
#pragma unroll
        for (int ai = 0; ai < 2; ++ai) {
            u32x4 zq[4][2];
#pragma unroll
            for (int m = 0; m < 4; ++m)
#pragma unroll
                for (int bj = 0; bj < 2; ++bj) zq[m][bj] = *(const u32x4*)(Z + (size_t)(row0 + ai * HALF + m * 16) * ldc + col0 + bj * HALF);
#pragma unroll
            for (int m = 0; m < 4; ++m) { const size_t off = (size_t)(row0 + ai * HALF + m * 16) * ldc + col0;
#pragma unroll
                for (int bj = 0; bj < 2; ++bj) { const f32x4 v0 = acc[ai][bj][m][0] + bv[bj][0], v1 = acc[ai][bj][m][1] + bv[bj][1];
                    const u32x4 zz = zq[m][bj]; float z[8], o[8];
                    z[0] = __uint_as_float(zz.x << 16); z[1] = __uint_as_float(zz.x & 0xffff0000u); z[2] = __uint_as_float(zz.y << 16); z[3] = __uint_as_float(zz.y & 0xffff0000u);
                    z[4] = __uint_as_float(zz.z << 16); z[5] = __uint_as_float(zz.z & 0xffff0000u); z[6] = __uint_as_float(zz.w << 16); z[7] = __uint_as_float(zz.w & 0xffff0000u);
#pragma unroll
                    for (int j = 0; j < 4; ++j) { o[j] = z[j] * __builtin_amdgcn_rcpf(1.f + __expf(-v0[j])); o[4 + j] = z[4 + j] * __builtin_amdgcn_rcpf(1.f + __expf(-v1[j])); }
                    u32x4 w; w.x = cvt_pk_bf16(o[0], o[1]); w.y = cvt_pk_bf16(o[2], o[3]); w.z = cvt_pk_bf16(o[4], o[5]); w.w = cvt_pk_bf16(o[6], o[7]);
                    *(u32x4*)(O + off + bj * HALF) = w; } }
            asm volatile("" ::: "memory"); }
    }
};

template <class Epi, class Sched, bool ALIGN_EPI = false, bool SP2 = false>
__device__ __forceinline__ void gemm_phase(PG8_LAS unsigned char* lds, const Gemm g, const Sched& S, const Epi& E) {
    int tid_l = threadIdx.x; asm volatile("" : "+v"(tid_l));
    const int tid = tid_l, wid = __builtin_amdgcn_readfirstlane(tid >> 6), lane = tid & 63, wr = wid >> 2, wc = wid & 3, fr = lane & 15, fq = lane >> 4;
    const int K = g.K, nt = K / BK;
    unsigned voffA[2], voffB[2];
#pragma unroll
    for (int i = 0; i < 2; ++i) { int R, C; stage_rc(tid * 16 + i * 8192, R, C); const int Rb = Epi::PERM ? ((R & ~31) + perm32(R & 31)) : R;
        voffA[i] = (unsigned)(R * g.lda + C) * 2u; voffB[i] = (unsigned)(Rb * g.ldb + C) * 2u; }
    const size_t kstep = (size_t)(BK * 2);
    const size_t hstepA = (size_t)HALF * g.lda * 2, hstepB = (size_t)HALF * g.ldb * 2;
    const size_t tstepA = 2 * hstepA, tstepB = 2 * hstepB;
    const unsigned ldsw = (unsigned)wid * 1024u;
    const int aoff = lds_byte(wr * 64 + fr, fq * 8), boff = lds_byte(wc * 32 + fr, fq * 8);
#define PG8_SA(b, h) (((b) * 2 + (h)) * HTB)
#define PG8_SB(b, h) ((4 + (b) * 2 + (h)) * HTB)
#define PG8_STAGE(bufoff, gbase, voff) do { _Pragma("unroll") for (int _i = 0; _i < 2; ++_i) \
        __builtin_amdgcn_global_load_lds((const unsigned*)((const char*)(gbase) + (voff)[_i]), (PG8_LAS unsigned*)(lds + (bufoff) + ldsw + _i * 8192), 16, 0, 0); } while (0)
#define PG8_LDA(dst, b, h) do { _Pragma("unroll") for (int m = 0; m < 4; ++m) _Pragma("unroll") for (int k = 0; k < 2; ++k) dst[m][k] = *(const PG8_LAS bf16x8*)(lds + PG8_SA(b, h) + aoff + m * 2048 + k * 1024); } while (0)
#define PG8_LDB(dst, b, h) do { _Pragma("unroll") for (int n = 0; n < 2; ++n) _Pragma("unroll") for (int k = 0; k < 2; ++k) dst[n][k] = *(const PG8_LAS bf16x8*)(lds + PG8_SB(b, h) + boff + n * 2048 + k * 1024); } while (0)
#define PG8_MMA(ai, bj, At, Bt) do { __builtin_amdgcn_s_setprio(1); _Pragma("unroll") for (int m = 0; m < 4; ++m) _Pragma("unroll") for (int n = 0; n < 2; ++n) _Pragma("unroll") for (int k = 0; k < 2; ++k) \
        acc[ai][bj][m][n] = __builtin_amdgcn_mfma_f32_16x16x32_bf16(Bt[n][k], At[m][k], acc[ai][bj][m][n], 0, 0, 0); __builtin_amdgcn_s_setprio(0); } while (0)
#define PG8_WAIT_V(n) asm volatile("s_waitcnt vmcnt(" #n ")" ::: "memory")
#define PG8_WAIT_L(n) asm volatile("s_waitcnt lgkmcnt(" #n ")" ::: "memory")
#define PG8_BAR __builtin_amdgcn_s_barrier()
#define PG8_SCHED __builtin_amdgcn_sched_barrier(0)
    Unit cur, nxt; int ui = 0;
    if (!S.next(0, cur)) return;
    f32x4 acc[2][2][4][2];
#pragma unroll
    for (int a = 0; a < 2; ++a)
#pragma unroll
        for (int b = 0; b < 2; ++b)
#pragma unroll
            for (int m = 0; m < 4; ++m)
#pragma unroll
                for (int n = 0; n < 2; ++n) acc[a][b][m][n] = (f32x4){0.f, 0.f, 0.f, 0.f};
    bf16x8 At[4][2], B0[2][2], B1[2][2];
    const char* cA = (const char*)g.A + (size_t)cur.pm * tstepA; const char* cB = (const char*)g.Bt + (size_t)cur.pn * tstepB;
    S.a_ready(cur);
    if constexpr (SP2) {
        PG8_STAGE(PG8_SB(0, 0), cB, voffB); PG8_STAGE(PG8_SB(0, 1), cB + hstepB, voffB); PG8_STAGE(PG8_SA(0, 0), cA, voffA); PG8_STAGE(PG8_SA(0, 1), cA + hstepA, voffA);
        if (wr == 1) PG8_BAR;
        PG8_WAIT_V(2); PG8_BAR;
        PG8_STAGE(PG8_SB(1, 0), cB + kstep, voffB); PG8_STAGE(PG8_SA(1, 0), cA + kstep, voffA); PG8_STAGE(PG8_SB(1, 1), cB + hstepB + kstep, voffB);
        PG8_WAIT_V(6); PG8_BAR;
    } else {
        PG8_STAGE(PG8_SB(0, 0), cB, voffB); PG8_STAGE(PG8_SA(0, 0), cA, voffA); PG8_STAGE(PG8_SB(0, 1), cB + hstepB, voffB); PG8_STAGE(PG8_SA(0, 1), cA + hstepA, voffA);
        if (wr == 1) PG8_BAR;
        PG8_WAIT_V(4); PG8_BAR;
        PG8_STAGE(PG8_SB(1, 0), cB + kstep, voffB); PG8_STAGE(PG8_SA(1, 0), cA + kstep, voffA); PG8_STAGE(PG8_SB(1, 1), cB + hstepB + kstep, voffB);
        PG8_WAIT_V(6); PG8_BAR;
    }
    for (;;) {
        const bool has_next = S.next(ui + 1, nxt);
        const char* nA = has_next ? (const char*)g.A + (size_t)nxt.pm * tstepA : cA; const char* nB = has_next ? (const char*)g.Bt + (size_t)nxt.pn * tstepB : cB;
        for (int t = 0; t < nt; t += 2) {
            const bool last = (t == nt - 2);
            const char* a1 = cA + (size_t)(t + 1) * kstep;
            const char* a2 = last ? nA : cA + (size_t)(t + 2) * kstep; const char* b2 = last ? nB : cB + (size_t)(t + 2) * kstep;
            const char* a3 = a2 + kstep; const char* b3 = b2 + kstep;
            if (last && has_next) S.a_ready(nxt);
            if constexpr (SP2) {
            PG8_LDB(B0, 0, 0); PG8_LDB(B1, 0, 1); PG8_SCHED; PG8_LDA(At, 0, 0); PG8_STAGE(PG8_SA(1, 1), a1 + hstepA, voffA);
            PG8_WAIT_V(8); PG8_WAIT_L(0); PG8_BAR; PG8_MMA(0, 0, At, B0); PG8_MMA(0, 1, At, B1); PG8_BAR; PG8_SCHED;
            PG8_LDA(At, 0, 1); PG8_STAGE(PG8_SB(0, 0), b2, voffB); PG8_STAGE(PG8_SB(0, 1), b2 + hstepB, voffB); PG8_STAGE(PG8_SA(0, 0), a2, voffA);
            PG8_WAIT_V(8); PG8_WAIT_L(0); PG8_BAR; PG8_MMA(1, 0, At, B0); PG8_MMA(1, 1, At, B1); PG8_BAR; PG8_SCHED;
            PG8_LDB(B0, 1, 0); PG8_LDB(B1, 1, 1); PG8_SCHED; PG8_LDA(At, 1, 0); PG8_STAGE(PG8_SA(0, 1), a2 + hstepA, voffA);
            PG8_WAIT_V(8); PG8_WAIT_L(0); PG8_BAR; PG8_MMA(0, 0, At, B0); PG8_MMA(0, 1, At, B1); PG8_BAR; PG8_SCHED;
            PG8_LDA(At, 1, 1); PG8_STAGE(PG8_SB(1, 0), b3, voffB); PG8_STAGE(PG8_SB(1, 1), b3 + hstepB, voffB); PG8_STAGE(PG8_SA(1, 0), a3, voffA);
            PG8_WAIT_V(8); PG8_WAIT_L(0); PG8_BAR; PG8_MMA(1, 0, At, B0); PG8_MMA(1, 1, At, B1); PG8_BAR; PG8_SCHED;
            } else {
            PG8_LDB(B0, 0, 0); PG8_SCHED; PG8_LDA(At, 0, 0); PG8_STAGE(PG8_SA(1, 1), a1 + hstepA, voffA);
            PG8_WAIT_L(8); PG8_BAR; PG8_WAIT_L(0); PG8_MMA(0, 0, At, B0); PG8_BAR; PG8_SCHED;
            PG8_LDB(B1, 0, 1); PG8_STAGE(PG8_SB(0, 0), b2, voffB);
            PG8_BAR; PG8_WAIT_L(0); PG8_MMA(0, 1, At, B1); PG8_BAR;
            PG8_LDA(At, 0, 1); PG8_STAGE(PG8_SA(0, 0), a2, voffA);
            PG8_BAR; PG8_WAIT_L(0); PG8_MMA(1, 0, At, B0); PG8_BAR; PG8_SCHED;
            PG8_STAGE(PG8_SB(0, 1), b2 + hstepB, voffB);
            PG8_WAIT_V(6); PG8_BAR; PG8_MMA(1, 1, At, B1); PG8_BAR;
            PG8_LDB(B0, 1, 0); PG8_SCHED; PG8_LDA(At, 1, 0); PG8_STAGE(PG8_SA(0, 1), a2 + hstepA, voffA);
            PG8_WAIT_L(8); PG8_BAR; PG8_WAIT_L(0); PG8_MMA(0, 0, At, B0); PG8_BAR; PG8_SCHED;
            PG8_LDB(B1, 1, 1); PG8_STAGE(PG8_SB(1, 0), b3, voffB);
            PG8_BAR; PG8_WAIT_L(0); PG8_MMA(0, 1, At, B1); PG8_BAR;
            PG8_LDA(At, 1, 1); PG8_STAGE(PG8_SA(1, 0), a3, voffA);
            PG8_BAR; PG8_WAIT_L(0); PG8_MMA(1, 0, At, B0); PG8_BAR; PG8_SCHED;
            PG8_STAGE(PG8_SB(1, 1), b3 + hstepB, voffB);
            PG8_WAIT_V(6); PG8_BAR; PG8_MMA(1, 1, At, B1); PG8_BAR;
            }
        }
        if constexpr (ALIGN_EPI) { if (wr == 0) PG8_BAR; }
        E(acc, cur, wr, wc, fr, fq); S.done(cur);
        if (!has_next) break;
#pragma unroll
        for (int a = 0; a < 2; ++a)
#pragma unroll
            for (int b = 0; b < 2; ++b)
#pragma unroll
                for (int m = 0; m < 4; ++m)
#pragma unroll
                    for (int n = 0; n < 2; ++n) acc[a][b][m][n] = (f32x4){0.f, 0.f, 0.f, 0.f};
        cur = nxt; cA = nA; cB = nB; ++ui;
        if constexpr (ALIGN_EPI) { if (wr == 1) PG8_BAR; }
    }
    PG8_WAIT_V(0);
    if constexpr (!ALIGN_EPI) { if (wr == 0) PG8_BAR; }
    PG8_BAR;
#undef PG8_SA
#undef PG8_SB
#undef PG8_STAGE
#undef PG8_LDA
#undef PG8_LDB
#undef PG8_MMA
#undef PG8_WAIT_V
#undef PG8_WAIT_L
#undef PG8_BAR
#undef PG8_SCHED
}
}
#define XB_TMO      128
#define XB_XCNT(j)  (256  + 64 * (j))
#define XB_XSUB(j)  (1280 + 64 * (j))
#define XB_XGEN(j)  (2304 + 64 * (j))
#define XB_TOP      3328
#define XB_TOPGEN   3392
#define XCD_BAR_WORDS 3456
#define XB_SPIN_CAP (1u << 18)
__device__ __forceinline__ unsigned xb_ld(unsigned* p)              { return __hip_atomic_load(p, __ATOMIC_RELAXED, __HIP_MEMORY_SCOPE_AGENT); }
__device__ __forceinline__ unsigned xb_add(unsigned* p, unsigned v) { return __hip_atomic_fetch_add(p, v, __ATOMIC_RELAXED, __HIP_MEMORY_SCOPE_AGENT); }
__device__ __forceinline__ unsigned xb_xcc_id() { return (unsigned)__builtin_amdgcn_s_getreg((3 << 11) | 20) & 0xFu; }
#define XB_SPIN(cond, bar) do { unsigned _sp = 0; while (cond) { __builtin_amdgcn_s_sleep(1); \
    if ((++_sp & 255u) == 0u) { if (xb_ld(&(bar)[XB_TMO])) break; if (_sp > XB_SPIN_CAP) { atomicAdd(&(bar)[XB_TMO], 1u); break; } } } } while (0)
struct XcdBarrier { unsigned* bar; unsigned x; volatile LAS unsigned* st; unsigned G; };
__device__ __forceinline__ XcdBarrier xcd_barrier_post(unsigned* bar, volatile LAS unsigned* st, unsigned G) {
    XcdBarrier b; b.bar = bar; b.x = xb_xcc_id(); b.st = st; b.G = G;
    if (threadIdx.x == 0) (void)xb_add(&bar[XB_XCNT(b.x)], 1u);
    return b;
}
__device__ __forceinline__ void xcd_barrier_complete(unsigned* bar, unsigned x, unsigned G, unsigned& nloc, unsigned& nx) {
    unsigned sum, cnt, mine, sp = 0u;
    for (;;) {
        sum = 0u; cnt = 0u; mine = 0u;
#pragma unroll
        for (unsigned j = 0; j < 16; ++j) { const unsigned c = xb_ld(&bar[XB_XCNT(j)]); sum += c; cnt += (c > 0u) ? 1u : 0u; mine = (j == x) ? c : mine; }
        if (sum == G) break;
        __builtin_amdgcn_s_sleep(1);
        if ((++sp & 255u) == 0u) { if (xb_ld(&bar[XB_TMO])) break; if (sp > XB_SPIN_CAP) { atomicAdd(&bar[XB_TMO], 1u); break; } }
    }
    nloc = mine > 0u ? mine : 1u; nx = cnt > 0u ? cnt : 1u;
}
__device__ __forceinline__ void xcd_barrier(const XcdBarrier& b) {
    asm volatile("s_waitcnt vmcnt(0)" ::: "memory");
    __syncthreads();
    if (threadIdx.x == 0) {
        unsigned* bar = b.bar;
        __builtin_amdgcn_s_waitcnt(0);
        unsigned nloc = b.st[0], nx = b.st[1];
        if (nloc == 0u) { xcd_barrier_complete(bar, b.x, b.G, nloc, nx); b.st[0] = nloc; b.st[1] = nx; }
        const unsigned old = xb_add(&bar[XB_XSUB(b.x)], 1u);
        const unsigned gen = old / nloc;
        if (old + 1u == (gen + 1u) * nloc) {
            __builtin_amdgcn_fence(__ATOMIC_RELEASE, "agent");
            asm volatile("s_waitcnt vmcnt(0)" ::: "memory");
            const unsigned og = xb_add(&bar[XB_TOP], 1u);
            const unsigned tg = og / nx;
            if (og + 1u == (tg + 1u) * nx) xb_add(&bar[XB_TOPGEN], 1u);
            else XB_SPIN(xb_ld(&bar[XB_TOPGEN]) == tg, bar);
            __builtin_amdgcn_fence(__ATOMIC_ACQUIRE, "agent");
            xb_add(&bar[XB_XGEN(b.x)], 1u);
            asm volatile("s_waitcnt vmcnt(0)" ::: "memory");
        } else {
            XB_SPIN(xb_ld(&bar[XB_XGEN(b.x)]) == gen, bar);
            __builtin_amdgcn_fence(__ATOMIC_ACQUIRE, "agent");
            asm volatile("s_waitcnt vmcnt(0)" ::: "memory");
        }
    }
    __syncthreads();
}

constexpr int NWAVES = 8, NTHR = 512;
constexpr int LDS_BYTES = 155648;
constexpr int MISC_OFF = LDS_BYTES - 256;
struct Ctx { unsigned char* lds; int tid, lane, wave, gw, ngw, bid, nb; };

__device__ __forceinline__ void tr_item(const float* __restrict__ W, int ldw, int N, bf16* __restrict__ WT, int ldt, int row_off, int col_off, int kb, int nb, float* scr, int lane, const float* __restrict__ gk) {
    const int k0 = 64 * kb, n0 = 32 * nb; const int n = n0 + (lane & 31);
    float v[32];
    const float* wp = W + (size_t)(k0 + (lane >> 5)) * ldw + (n < N ? n : 0);
#pragma unroll
    for (int i = 0; i < 32; ++i) v[i] = wp[(size_t)(2 * i) * ldw];
    asm volatile("" : "+v"(v[0]), "+v"(v[1]), "+v"(v[2]), "+v"(v[3]), "+v"(v[4]), "+v"(v[5]), "+v"(v[6]), "+v"(v[7]), "+v"(v[8]), "+v"(v[9]), "+v"(v[10]), "+v"(v[11]), "+v"(v[12]), "+v"(v[13]), "+v"(v[14]), "+v"(v[15]));
    asm volatile("" : "+v"(v[16]), "+v"(v[17]), "+v"(v[18]), "+v"(v[19]), "+v"(v[20]), "+v"(v[21]), "+v"(v[22]), "+v"(v[23]), "+v"(v[24]), "+v"(v[25]), "+v"(v[26]), "+v"(v[27]), "+v"(v[28]), "+v"(v[29]), "+v"(v[30]), "+v"(v[31]));
    const float msk = (n < N) ? 1.f : 0.f;
    if (gk) {
        float gv[32];
#pragma unroll
        for (int i = 0; i < 32; ++i) gv[i] = gk[k0 + 2 * i + (lane >> 5)];
#pragma unroll
        for (int i = 0; i < 32; ++i) v[i] *= gv[i];
    }
#pragma unroll
    for (int i = 0; i < 32; ++i) { const int kk = 2 * i + (lane >> 5); scr[kk * 33 + (lane & 31)] = v[i] * msk; }
    __builtin_amdgcn_fence(__ATOMIC_RELEASE, "wavefront"); __builtin_amdgcn_wave_barrier(); __builtin_amdgcn_fence(__ATOMIC_ACQUIRE, "wavefront");
    const int c = lane & 7;
#pragma unroll
    for (int j = 0; j < 4; ++j) { const int nn = (lane >> 3) + 8 * j; const float* s = scr + (8 * c) * 33 + nn;
        u32x4 o; o.x = pk2(s[0 * 33], s[1 * 33]); o.y = pk2(s[2 * 33], s[3 * 33]); o.z = pk2(s[4 * 33], s[5 * 33]); o.w = pk2(s[6 * 33], s[7 * 33]);
        *(u32x4*)(WT + (size_t)(row_off + n0 + nn) * ldt + col_off + k0 + 8 * c) = o; }
    __builtin_amdgcn_fence(__ATOMIC_RELEASE, "wavefront"); __builtin_amdgcn_wave_barrier(); __builtin_amdgcn_fence(__ATOMIC_ACQUIRE, "wavefront");
}
__device__ __forceinline__ void conv_mat(const Ctx& c, const float* W, int K, int ldw, int N, int Npad, bf16* WT, int ldt, int row_off, int col_off, const float* gk = nullptr) {
    float* scr = (float*)(c.lds + c.wave * 8704);
    const int nblk = Npad / 32, nit = (K / 64) * nblk;
    for (int it = c.gw; it < nit; it += c.ngw) tr_item(W, ldw, N, WT, ldt, row_off, col_off, it / nblk, it % nblk, scr, c.lane, gk);
}

__device__ __forceinline__ void norm_rows_bf16(const Ctx& c, const float* __restrict__ X, const float* __restrict__ g, bf16* __restrict__ O, int nrows) {
    f32x4 gv[8];
#pragma unroll
    for (int j = 0; j < 8; ++j) gv[j] = *(const f32x4*)(g + 4 * c.lane + 256 * j);
    for (int m = c.gw; m < nrows; m += c.ngw) {
        const f32x4* xr = (const f32x4*)(X + (size_t)m * D) + c.lane; f32x4 v[8]; float s = 0.f;
#pragma unroll
        for (int j = 0; j < 8; ++j) { v[j] = xr[64 * j]; s += (v[j].x * v[j].x + v[j].y * v[j].y) + (v[j].z * v[j].z + v[j].w * v[j].w); }
        const float rstd = 1.0f / sqrtf(wave_sum(s) * (1.f / D) + NORM_EPS);
        u32x2* o8 = (u32x2*)(O + (size_t)m * D) + c.lane;
#pragma unroll
        for (int j = 0; j < 8; ++j) { u32x2 w; w.x = pk2(v[j].x * rstd * gv[j].x, v[j].y * rstd * gv[j].y); w.y = pk2(v[j].z * rstd * gv[j].z, v[j].w * rstd * gv[j].w); o8[64 * j] = w; }
    }
}
__device__ __forceinline__ void cast_rows_ss(const Ctx& c, const float* __restrict__ X, bf16* __restrict__ O, unsigned long long* rowss, int nrows) {
    for (int m = c.gw; m < nrows; m += c.ngw) {
        const f32x4* xr = (const f32x4*)(X + (size_t)m * D) + c.lane; f32x4 v[8]; float s = 0.f;
#pragma unroll
        for (int j = 0; j < 8; ++j) { v[j] = xr[64 * j]; s += (v[j].x * v[j].x + v[j].y * v[j].y) + (v[j].z * v[j].z + v[j].w * v[j].w); }
        s = wave_sum(s);
        u32x2* o8 = (u32x2*)(O + (size_t)m * D) + c.lane;
#pragma unroll
        for (int j = 0; j < 8; ++j) { u32x2 w; w.x = pk2(v[j].x, v[j].y); w.y = pk2(v[j].z, v[j].w); o8[64 * j] = w; }
        if (c.lane == 0) rowss[m] = (unsigned long long)(s * 16777216.0f);
    }
}
__device__ __forceinline__ void scale_rows_out(const Ctx& c, const bf16* __restrict__ XB, const float* __restrict__ g, const unsigned long long* rowss, float* O, int nrows) {
    for (int m = c.gw; m < nrows; m += c.ngw) {
        const float rstd = 1.0f / sqrtf((float)rowss[m] * (5.9604644775390625e-08f / D) + NORM_EPS);
#pragma unroll
        for (int j = 0; j < 4; ++j) { float x[8]; unpack8(*(const u32x4*)(XB + (size_t)m * D + 8 * c.lane + 512 * j), x);
            const f32x4 g0 = *(const f32x4*)(g + 8 * c.lane + 512 * j), g1 = *(const f32x4*)(g + 8 * c.lane + 512 * j + 4);
            *(f32x4*)(O + (size_t)m * D + 8 * c.lane + 512 * j) = (f32x4){x[0] * rstd * g0.x, x[1] * rstd * g0.y, x[2] * rstd * g0.z, x[3] * rstd * g0.w};
            *(f32x4*)(O + (size_t)m * D + 8 * c.lane + 512 * j + 4) = (f32x4){x[4] * rstd * g1.x, x[5] * rstd * g1.y, x[6] * rstd * g1.z, x[7] * rstd * g1.w}; }
    }
}
__device__ __forceinline__ void norm_rows_f32(const Ctx& c, float* X, const float* __restrict__ g, int nrows) {
    f32x4 gv[8];
#pragma unroll
    for (int j = 0; j < 8; ++j) gv[j] = *(const f32x4*)(g + 4 * c.lane + 256 * j);
    for (int m = c.gw; m < nrows; m += c.ngw) {
        f32x4* xr = (f32x4*)(X + (size_t)m * D) + c.lane; f32x4 v[8]; float s = 0.f;
#pragma unroll
        for (int j = 0; j < 8; ++j) { v[j] = xr[64 * j]; s += (v[j].x * v[j].x + v[j].y * v[j].y) + (v[j].z * v[j].z + v[j].w * v[j].w); }
        const float rstd = 1.0f / sqrtf(wave_sum(s) * (1.f / D) + NORM_EPS);
#pragma unroll
        for (int j = 0; j < 8; ++j) xr[64 * j] = v[j] * rstd * gv[j];
    }
}

__device__ __forceinline__ void rope_tables(const Ctx& c, const int* __restrict__ start_frame, float* ropea, float* ropei) {
    const float HA[16] = {1.000000000e+00f, 4.403665960e-01f, 1.939227432e-01f, 8.539710194e-02f, 3.760603070e-02f, 1.656044088e-02f, 7.292664610e-03f, 3.211446106e-03f, 1.414213562e-03f, 6.227724371e-04f, 2.742481884e-04f, 1.207697351e-04f, 5.318295734e-05f, 2.341999971e-05f, 1.031338525e-05f, 4.541670478e-06f};
    const float LA[16] = {0.000000000e+00f, 6.688275267e-09f, 1.547429962e-09f, -1.652958881e-09f, 2.282729838e-10f, -8.020459852e-10f, 1.273676581e-10f, -1.116812753e-10f, -1.115275407e-14f, -1.514006802e-11f, -1.268531807e-11f, 2.335000249e-12f, 1.624761415e-12f, -7.452659366e-13f, 1.309491117e-13f, 2.687890499e-15f};
    const float HI[8] = {1.000000000e+00f, 1.939227432e-01f, 3.760603070e-02f, 7.292664610e-03f, 1.414213562e-03f, 2.742481884e-04f, 5.318295734e-05f, 1.031338525e-05f};
    const float LI[8] = {0.000000000e+00f, 1.547429962e-09f, 2.282729838e-10f, 1.273676581e-10f, -1.115275407e-14f, -1.268531807e-11f, 1.624761415e-12f, 1.309491117e-13f};
    const int gt = c.bid * NTHR + c.tid, ngt = c.nb * NTHR;
    for (int i = gt; i < M * 24; i += ngt) {
        const int m = i / 24, j = i % 24; const int b = m / SEQ, t = m % SEQ;
        const float pos = (float)(start_frame[b] + t);
        float hi = 0.f, lo = 0.f;
#pragma unroll
        for (int q = 0; q < 16; ++q) if (j == q) { hi = HA[q]; lo = LA[q]; }
#pragma unroll
        for (int q = 0; q < 8; ++q) if (j == 16 + q) { hi = HI[q]; lo = LI[q]; }
        const float p = pos * hi, e = fmaf(pos, hi, -p) + pos * lo;
        float sn, cs; sincosf(p, &sn, &cs);
        const float cc = cs - e * sn, ss = sn + e * cs;
        if (j < 16) { ropea[(size_t)m * 32 + j] = cc; ropea[(size_t)m * 32 + 16 + j] = ss; }
        else { ropei[(size_t)m * 16 + (j - 16)] = cc; ropei[(size_t)m * 16 + 8 + (j - 16)] = ss; }
    }
}

__device__ __forceinline__ void build_wql(const Ctx& c, const float* __restrict__ w_uq, const float* __restrict__ w_uk, bf16* WQ) {
    const int gt = c.bid * NTHR + c.tid, ngt = c.nb * NTHR;
    for (int i = gt; i < 2048 * 512; i += ngt) {
        const int cc = i & 511, hr = i >> 9, h = hr >> 8, r = hr & 255;
        const float* a = w_uq + (size_t)cc * 1024 + h * 128 + 32; const float* b = w_uk + (size_t)r * 768 + h * 96; float s = 0.f;
#pragma unroll 8
        for (int d = 0; d < 96; ++d) s += a[d] * b[d];
        WQ[i] = (bf16)f2bf(s);
    }
}
__device__ __forceinline__ void build_wout(const Ctx& c, const float* __restrict__ w_uv, const float* __restrict__ w_out, bf16* WO) {
    const int gt = c.bid * NTHR + c.tid, ngt = c.nb * NTHR;
    for (int i = gt; i < 8 * 32 * 2048; i += ngt) {
        const int n = i & 2047, rg = (i >> 11) & 31, h = i >> 16; float acc[8];
#pragma unroll
        for (int j = 0; j < 8; ++j) acc[j] = 0.f;
        for (int d = 0; d < 128; ++d) { const float wo = w_out[(size_t)(h * 128 + d) * 2048 + n];
#pragma unroll
            for (int j = 0; j < 8; ++j) acc[j] += w_uv[(size_t)(rg * 8 + j) * 1024 + h * 128 + d] * wo; }
        u32x4 o; o.x = pk2(acc[0], acc[1]); o.y = pk2(acc[2], acc[3]); o.z = pk2(acc[4], acc[5]); o.w = pk2(acc[6], acc[7]);
        *(u32x4*)(WO + (size_t)n * OC + h * 256 + rg * 8) = o;
    }
}

__device__ __forceinline__ void dsa_prep(const Ctx& c, const bf16* __restrict__ H, const float* __restrict__ cqn_g, const float* __restrict__ ckv_g, const float* __restrict__ kidx_g,
                                         const float* __restrict__ ropea, const float* __restrict__ ropei, bf16* CQN, bf16* KF, bf16* KIDX, float* WIDX) {
    const int l = c.lane;
    for (int m = c.gw; m < M; m += c.ngw) {
        const bf16* h = H + (size_t)m * HC;
        {
            float f[8]; unpack8(*(const u32x4*)(h + 8 * l), f); float s = 0.f;
#pragma unroll
            for (int j = 0; j < 8; ++j) s += f[j] * f[j];
            const float rstd = 1.0f / sqrtf(wave_sum(s) * (1.f / 512.f) + NORM_EPS);
            u32x4 o; o.x = pk2(f[0] * rstd * cqn_g[8 * l + 0], f[1] * rstd * cqn_g[8 * l + 1]); o.y = pk2(f[2] * rstd * cqn_g[8 * l + 2], f[3] * rstd * cqn_g[8 * l + 3]);
            o.z = pk2(f[4] * rstd * cqn_g[8 * l + 4], f[5] * rstd * cqn_g[8 * l + 5]); o.w = pk2(f[6] * rstd * cqn_g[8 * l + 6], f[7] * rstd * cqn_g[8 * l + 7]);
            *(u32x4*)(CQN + (size_t)m * 512 + 8 * l) = o;
        }
        {
            const u32x2 w = *(const u32x2*)(h + 512 + 4 * l); const float f0 = bf2f(w.x & 0xffffu), f1 = bf2f(w.x >> 16), f2 = bf2f(w.y & 0xffffu), f3 = bf2f(w.y >> 16);
            const float s = (f0 * f0 + f1 * f1) + (f2 * f2 + f3 * f3);
            const float rstd = 1.0f / sqrtf(wave_sum(s) * (1.f / 256.f) + NORM_EPS);
            u32x2 o; o.x = pk2(f0 * rstd * ckv_g[4 * l + 0], f1 * rstd * ckv_g[4 * l + 1]); o.y = pk2(f2 * rstd * ckv_g[4 * l + 2], f3 * rstd * ckv_g[4 * l + 3]);
            *(u32x2*)(KF + (size_t)m * KFW + 4 * l) = o;
        }
        if (l < 16) {
            const float x1 = bf2f(h[768 + l]), x2 = bf2f(h[768 + 16 + l]); const float cs = ropea[(size_t)m * 32 + l], sn = ropea[(size_t)m * 32 + 16 + l];
            KF[(size_t)m * KFW + 256 + l] = (bf16)f2bf(x1 * cs - x2 * sn); KF[(size_t)m * KFW + 256 + 16 + l] = (bf16)f2bf(x2 * cs + x1 * sn);
        }
        {
            const float v = bf2f(h[800 + l]); const float rstd = 1.0f / sqrtf(wave_sum(v * v) * (1.f / 64.f) + NORM_EPS);
            const float y = v * rstd * kidx_g[l];
            const float ylo = __shfl(y, l & 7), yhi = __shfl(y, (l & 7) + 8);
            float o = y;
            if (l < 16) { const float cs = ropei[(size_t)m * 16 + (l & 7)], sn = ropei[(size_t)m * 16 + 8 + (l & 7)]; o = (l < 8) ? (ylo * cs - yhi * sn) : (yhi * cs + ylo * sn); }
            KIDX[(size_t)m * 64 + l] = (bf16)f2bf(o);
        }
        if (l < 16) WIDX[(size_t)m * 16 + l] = bf2f(h[864 + l]) * 0.03125f;
    }
}
__device__ __forceinline__ void q_rope_fix(const Ctx& c, bf16* QALL, const float* __restrict__ ropea, const float* __restrict__ ropei) {
    const int l = c.lane;
    for (int m = c.gw; m < M; m += c.ngw) {
        bf16* q = QALL + (size_t)m * QC;
#pragma unroll
        for (int i = 0; i < 2; ++i) { const int p = l + 64 * i, hh = p >> 4, j = p & 15; bf16* a = q + 2048 + hh * 32 + j;
            const float x1 = bf2f(a[0]), x2 = bf2f(a[16]); const float cs = ropea[(size_t)m * 32 + j], sn = ropea[(size_t)m * 32 + 16 + j];
            a[0] = (bf16)f2bf(x1 * cs - x2 * sn); a[16] = (bf16)f2bf(x2 * cs + x1 * sn); }
#pragma unroll
        for (int i = 0; i < 2; ++i) { const int p = l + 64 * i, hh = p >> 3, j = p & 7; bf16* a = q + 2304 + hh * 64 + j;
            const float x1 = bf2f(a[0]), x2 = bf2f(a[8]); const float cs = ropei[(size_t)m * 16 + j], sn = ropei[(size_t)m * 16 + 8 + j];
            a[0] = (bf16)f2bf(x1 * cs - x2 * sn); a[8] = (bf16)f2bf(x2 * cs + x1 * sn); }
    }
}
__device__ __forceinline__ size_t sc_row_off(int b, int t) { const int ch = t >> 6; return (size_t)b * SC_PER_BATCH + (size_t)4096 * (ch * (ch + 1) / 2) + (size_t)(t & 63) * (64 * (ch + 1)); }
__device__ __forceinline__ void idx_scores_simple(const Ctx& c, const bf16* __restrict__ QALL, const bf16* __restrict__ KIDX, const float* __restrict__ WIDX, float* SC) {
    float* qs = (float*)c.lds;
    float* ws = qs + 1024;
    for (int m = c.bid; m < M; m += c.nb) {
        const int b = m / SEQ, t = m % SEQ, limit = ((t >> 6) + 1) * 64;
        __syncthreads();
        for (int i = c.tid; i < 1024; i += NTHR) qs[i] = bf2f(QALL[(size_t)m * QC + 2304 + i]);
        if (c.tid < 16) ws[c.tid] = WIDX[(size_t)m * 16 + c.tid];
        __syncthreads();
        if (limit <= 256) continue;
        float* row = SC + sc_row_off(b, t);
        for (int s = c.tid; s < limit; s += NTHR) {
            float k[64]; const u32x4* kp = (const u32x4*)(KIDX + (size_t)(b * SEQ + s) * 64);
#pragma unroll
            for (int j = 0; j < 8; ++j) unpack8(kp[j], k + 8 * j);
            float sc = 0.f;
#pragma unroll 1
            for (int h = 0; h < 16; ++h) { asm volatile("" ::: "memory"); float d = 0.f; const f32x4* q4 = (const f32x4*)(qs + h * 64);
#pragma unroll
                for (int j = 0; j < 16; ++j) { const f32x4 q = q4[j]; d += (q.x * k[4 * j] + q.y * k[4 * j + 1]) + (q.z * k[4 * j + 2] + q.w * k[4 * j + 3]); }
                sc += ws[h] * fmaxf(d, 0.f); }
            row[s] = sc;
        }
    }
}
__device__ __forceinline__ void select_row(const float* row, int limit, unsigned short* sel, int l_in, unsigned short* stg = nullptr) {
    int l = l_in; asm volatile("" : "+v"(l));
    const int ng = limit >> 9;
    unsigned key[64];
#pragma unroll
    for (int jg = 0; jg < 8; ++jg) {
        if (jg <= ng) {
#pragma unroll
            for (int j = 8 * jg; j < 8 * jg + 8; ++j) { const int s = j * 64 + l; key[j] = __float_as_uint(row[s < limit ? s : 0]); }
        } else {
#pragma unroll
            for (int j = 8 * jg; j < 8 * jg + 8; ++j) key[j] = 0u;
        }
    }
#pragma unroll
    for (int j = 0; j < 64; ++j) { const int s = j * 64 + l; unsigned u = key[j]; u = (u & 0x80000000u) ? ~u : (u | 0x80000000u); key[j] = (s < limit) ? u : 0u; }
    unsigned mx = 0u;
#pragma unroll
    for (int j = 0; j < 64; ++j) mx = key[j] > mx ? key[j] : mx;
#pragma unroll
    for (int o = 1; o < 64; o <<= 1) { const unsigned t = (unsigned)__shfl_xor((int)mx, o); mx = t > mx ? t : mx; }
    mx = (unsigned)__builtin_amdgcn_readfirstlane((int)mx);
    auto wave_count = [&](int v) -> int {
        v += __builtin_amdgcn_update_dpp(0, v, 0xB1, 0xf, 0xf, true); v += __builtin_amdgcn_update_dpp(0, v, 0x4E, 0xf, 0xf, true);
        v += __builtin_amdgcn_update_dpp(0, v, 0x141, 0xf, 0xf, true); v += __builtin_amdgcn_update_dpp(0, v, 0x140, 0xf, 0xf, true);
        return __builtin_amdgcn_readlane(v, 0) + __builtin_amdgcn_readlane(v, 16) + __builtin_amdgcn_readlane(v, 32) + __builtin_amdgcn_readlane(v, 48); };
    unsigned T = 0u;
#pragma unroll 1
    for (int bit = 31 - __builtin_clz(mx | 1u); bit >= 0; --bit) {
        const unsigned Tn = T | (1u << bit); int cl = 0;
#pragma unroll
        for (int jg = 0; jg < 8; ++jg) if (jg <= ng) {
#pragma unroll
            for (int j = 8 * jg; j < 8 * jg + 8; ++j) cl += (key[j] >= Tn) ? 1 : 0; }
        const int cnt = wave_count(cl);
        if (cnt >= 256) T = Tn;
        if (cnt == 256) break;
    }
    int cgl = 0;
#pragma unroll
    for (int j = 0; j < 64; ++j) cgl += (key[j] > T) ? 1 : 0;
    const int cgt = wave_count(cgl);
    const int need_eq = 256 - cgt;
    int base = 0, beq = 0;
    const unsigned long long lt = (1ull << l) - 1ull;
    if (stg) {
#pragma unroll
        for (int jg = 0; jg < 8; ++jg) if (jg <= ng) {
#pragma unroll
            for (int j = 8 * jg; j < 8 * jg + 8; ++j) {
                const unsigned long long mg = __ballot(key[j] > T);
                const int pos = base + (int)__builtin_amdgcn_mbcnt_hi((unsigned)(mg >> 32), __builtin_amdgcn_mbcnt_lo((unsigned)mg, 0u));
                if (key[j] > T) stg[pos] = (unsigned short)(j * 64 + l);
                base += __popcll(mg);
                const unsigned long long me = __ballot(key[j] == T);
                if (me != 0ull) {
                    const int pe = beq + (int)__builtin_amdgcn_mbcnt_hi((unsigned)(me >> 32), __builtin_amdgcn_mbcnt_lo((unsigned)me, 0u));
                    if (key[j] == T && pe < need_eq) stg[cgt + pe] = (unsigned short)(j * 64 + l);
                    beq += __popcll(me);
                }
            }
        }
        __builtin_amdgcn_fence(__ATOMIC_RELEASE, "wavefront"); __builtin_amdgcn_wave_barrier(); __builtin_amdgcn_fence(__ATOMIC_ACQUIRE, "wavefront");
        *(u32x2*)(sel + 4 * l) = *(const u32x2*)(stg + 4 * l);
        __builtin_amdgcn_fence(__ATOMIC_RELEASE, "wavefront"); __builtin_amdgcn_wave_barrier(); __builtin_amdgcn_fence(__ATOMIC_ACQUIRE, "wavefront");
        return;
    }
#pragma unroll
    for (int jg = 0; jg < 8; ++jg) if (jg <= ng) {
#pragma unroll
        for (int j = 8 * jg; j < 8 * jg + 8; ++j) {
            const unsigned long long mg = __ballot(key[j] > T), me = __ballot(key[j] == T);
            if (key[j] > T) sel[base + __popcll(mg & lt)] = (unsigned short)(j * 64 + l);
            base += __popcll(mg);
            const int pe = beq + __popcll(me & lt);
            if (key[j] == T && pe < need_eq) sel[cgt + pe] = (unsigned short)(j * 64 + l);
            beq += __popcll(me);
        }
    }
}
__device__ __forceinline__ void bs_transpose32(unsigned (&A)[32]) {
    unsigned m = 0x0000FFFFu;
#pragma unroll
    for (int j = 16; j != 0; j >>= 1) {
#pragma unroll
        for (int k = 0; k < 32; ++k) {
            if ((k & j) == 0) {
                const unsigned t = (A[k] ^ (A[k + j] >> j)) & m;
                A[k] ^= t; A[k + j] ^= (t << j);
            }
        }
        m ^= (m << (j >> 1));
    }
}
__device__ __forceinline__ void select_row_bs(const float* row, int limit, unsigned short* sel, int l_in, unsigned short* stg) {
    int l = l_in; asm volatile("" : "+v"(l));
    const int nsl = limit >> 6;
    const int ng = limit >> 9;
    unsigned lo[32], hi[32];
#pragma unroll
    for (int jg = 0; jg < 8; ++jg) {
        if (jg <= ng) {
#pragma unroll
            for (int j = 8 * jg; j < 8 * jg + 8; ++j) { const int s = j * 64 + l; const unsigned u = __float_as_uint(row[s < limit ? s : 0]);
                if (j < 32) lo[j & 31] = u; else hi[j & 31] = u; }
        } else {
#pragma unroll
            for (int j = 8 * jg; j < 8 * jg + 8; ++j) { if (j < 32) lo[j & 31] = 0u; else hi[j & 31] = 0u; }
        }
    }
    asm volatile("" ::: "memory");
#pragma unroll
    for (int j = 0; j < 64; ++j) { const unsigned u = (j < 32) ? lo[j & 31] : hi[j & 31];
        const unsigned kx = (j < nsl) ? ((u & 0x80000000u) ? ~u : (u | 0x80000000u)) : 0u;
        if (j < 32) lo[j & 31] = kx; else hi[j & 31] = kx; }
    const bool has_hi = nsl > 32;
    bs_transpose32(lo);
    if (has_hi) bs_transpose32(hi);
    auto wave_count = [&](int v) -> int {
        v += __builtin_amdgcn_update_dpp(0, v, 0xB1, 0xf, 0xf, true); v += __builtin_amdgcn_update_dpp(0, v, 0x4E, 0xf, 0xf, true);
        v += __builtin_amdgcn_update_dpp(0, v, 0x141, 0xf, 0xf, true); v += __builtin_amdgcn_update_dpp(0, v, 0x140, 0xf, 0xf, true);
        return __builtin_amdgcn_readlane(v, 0) + __builtin_amdgcn_readlane(v, 16) + __builtin_amdgcn_readlane(v, 32) + __builtin_amdgcn_readlane(v, 48); };
    unsigned clo = 0xffffffffu, chi = has_hi ? 0xffffffffu : 0u, glo = 0u, ghi = 0u;
    int G = 0;
#pragma unroll
    for (int i = 0; i < 32; ++i) {
        const unsigned olo = clo & lo[i], ohi = chi & hi[i];
        const int tot = G + wave_count(__builtin_popcount(olo) + __builtin_popcount(ohi));
        const bool take = tot >= 256;
        const unsigned mt = take ? 0u : 0xffffffffu;
        G = take ? G : tot;
        glo |= olo & mt; ghi |= ohi & mt;
        clo = olo ^ (clo & mt); chi = ohi ^ (chi & mt);
        if (tot == 256) break;
    }
    {
        const int need = 256 - G;
        const int ceq = wave_count(__builtin_popcount(clo) + __builtin_popcount(chi));
        if (ceq == need) { glo |= clo; ghi |= chi; }
        else {
            int beq = 0;
#pragma unroll 1
            for (int k = 0; k < 64; ++k) {
                const unsigned bm = 0x80000000u >> (k & 31);
                const bool mine = ((k < 32 ? clo : chi) & bm) != 0u;
                const unsigned long long me = __ballot(mine);
                if (me != 0ull) {
                    const int pe = beq + (int)__builtin_amdgcn_mbcnt_hi((unsigned)(me >> 32), __builtin_amdgcn_mbcnt_lo((unsigned)me, 0u));
                    if (mine && pe < need) { if (k < 32) glo |= bm; else ghi |= bm; }
                    beq += __popcll(me);
                }
            }
        }
    }
    const int cl = __builtin_popcount(glo) + __builtin_popcount(ghi);
    int inc = cl;
#pragma unroll
    for (int o = 1; o < 64; o <<= 1) { const int t = __shfl_up(inc, o); inc += (l >= o) ? t : 0; }
    int pos = inc - cl;
    while (__ballot(glo != 0u) != 0ull) {
        if (glo != 0u) { const int s = __builtin_clz(glo); glo &= ~(0x80000000u >> s); stg[pos++] = (unsigned short)(s * 64 + l); }
    }
    while (__ballot(ghi != 0u) != 0ull) {
        if (ghi != 0u) { const int s = __builtin_clz(ghi); ghi &= ~(0x80000000u >> s); stg[pos++] = (unsigned short)((32 + s) * 64 + l); }
    }
    __builtin_amdgcn_fence(__ATOMIC_RELEASE, "wavefront"); __builtin_amdgcn_wave_barrier(); __builtin_amdgcn_fence(__ATOMIC_ACQUIRE, "wavefront");
    *(u32x2*)(sel + 4 * l) = *(const u32x2*)(stg + 4 * l);
    __builtin_amdgcn_fence(__ATOMIC_RELEASE, "wavefront"); __builtin_amdgcn_wave_barrier(); __builtin_amdgcn_fence(__ATOMIC_ACQUIRE, "wavefront");
}
__device__ __forceinline__ void topk_select(const Ctx& c, const float* __restrict__ SC, bf16* SEL  ) {
    const int l = c.lane;
    for (int m = c.gw; m < M; m += c.ngw) {
        const int b = m / SEQ, t = m % SEQ, limit = ((t >> 6) + 1) * 64;
        unsigned short* sel = (unsigned short*)SEL + (size_t)m * 256;
        if (limit <= 256) { for (int i = l; i < 256; i += 64) sel[i] = (unsigned short)(i < limit ? i : 0); continue; }
        select_row(SC + sc_row_off(b, t), limit, sel, l);
    }
}
__device__ __forceinline__ void dsa_attn_simple(const Ctx& c, const bf16* __restrict__ QALL, const bf16* __restrict__ KF, const bf16* __restrict__ SEL, bf16* OLY, int mmax = M) {
    float* qf = (float*)c.lds;
    float* P = qf + 8 * 288;
    int* sl = (int*)(P + 8 * 256);
    const float scale = 0.08838834764831845f;
    for (int m = c.bid; m < mmax; m += c.nb) {
        const int b = m / SEQ, t = m % SEQ, limit = ((t >> 6) + 1) * 64, cnt = limit < 256 ? limit : 256;
        __syncthreads();
        for (int i = c.tid; i < 8 * 288; i += NTHR) { const int h = i / 288, d = i % 288; qf[i] = bf2f(d < 256 ? QALL[(size_t)m * QC + h * 256 + d] : QALL[(size_t)m * QC + 2048 + h * 32 + (d - 256)]); }
        if (c.tid < 256) sl[c.tid] = (int)((const unsigned short*)SEL)[(size_t)m * 256 + c.tid];
        __syncthreads();
        if (c.tid < 256) {
            float acc[8];
#pragma unroll
            for (int h = 0; h < 8; ++h) acc[h] = 0.f;
            if (c.tid < cnt) {
                const u32x4* kp = (const u32x4*)(KF + (size_t)(b * SEQ + sl[c.tid]) * KFW);
                for (int ch = 0; ch < 36; ++ch) { float k[8]; unpack8(kp[ch], k);
#pragma unroll
                    for (int h = 0; h < 8; ++h) { const float* q = qf + h * 288 + ch * 8;
#pragma unroll
                        for (int j = 0; j < 8; ++j) acc[h] += k[j] * q[j]; } }
            }
#pragma unroll
            for (int h = 0; h < 8; ++h) P[h * 256 + c.tid] = (c.tid < cnt) ? acc[h] * scale : -INFINITY;
        }
        __syncthreads();
        {
            const int h = c.wave; float v[4]; float mx = -INFINITY;
#pragma unroll
            for (int i = 0; i < 4; ++i) { v[i] = P[h * 256 + c.lane + 64 * i]; mx = fmaxf(mx, v[i]); }
            mx = wave_max(mx); float s = 0.f;
#pragma unroll
            for (int i = 0; i < 4; ++i) { v[i] = __expf(v[i] - mx); s += v[i]; }
            s = wave_sum(s); const float inv = 1.f / s;
#pragma unroll
            for (int i = 0; i < 4; ++i) P[h * 256 + c.lane + 64 * i] = v[i] * inv;
        }
        __syncthreads();
        {
            const int r = c.tid & 255, hg = c.tid >> 8; float o[4] = {0.f, 0.f, 0.f, 0.f};
            for (int i = 0; i < cnt; ++i) { const float v = bf2f(KF[(size_t)(b * SEQ + sl[i]) * KFW + r]);
#pragma unroll
                for (int hh = 0; hh < 4; ++hh) o[hh] += P[(hg * 4 + hh) * 256 + i] * v; }
#pragma unroll
            for (int hh = 0; hh < 4; ++hh) OLY[(size_t)m * OC + (hg * 4 + hh) * 256 + r] = (bf16)f2bf(o[hh]);
        }
    }
}
__device__ __forceinline__ void xattn_simple(const Ctx& c, const bf16* __restrict__ XQ, const bf16* __restrict__ KVBIG, int layer, bf16* XO) {
    float* qf = (float*)c.lds;
    float* P = qf + 512;
    const float scale = 0.08838834764831845f;
    for (int m = c.bid; m < M; m += c.nb) {
        const int b = m / SEQ;
        const bf16* kvb = KVBIG + (size_t)(layer * 2048 + b * 256) * 4096 + layer * 1024;
        __syncthreads();
        qf[c.tid] = bf2f(XQ[(size_t)m * 512 + c.tid]);
        __syncthreads();
        {
            const int j = c.tid & 255, hp = c.tid >> 8;
#pragma unroll
            for (int hh = 0; hh < 2; ++hh) { const int h = hp * 2 + hh; const u32x4* kp = (const u32x4*)(kvb + (size_t)j * 4096 + h * 128); float d = 0.f;
                for (int ch = 0; ch < 16; ++ch) { float k[8]; unpack8(kp[ch], k);
#pragma unroll
                    for (int e = 0; e < 8; ++e) d += k[e] * qf[h * 128 + ch * 8 + e]; }
                P[h * 256 + j] = d * scale; }
        }
        __syncthreads();
        if (c.wave < 4) { const int h = c.wave; float v[4]; float mx = -INFINITY;
#pragma unroll
            for (int i = 0; i < 4; ++i) { v[i] = P[h * 256 + c.lane + 64 * i]; mx = fmaxf(mx, v[i]); }
            mx = wave_max(mx); float s = 0.f;
#pragma unroll
            for (int i = 0; i < 4; ++i) { v[i] = __expf(v[i] - mx); s += v[i]; }
            s = wave_sum(s); const float inv = 1.f / s;
#pragma unroll
            for (int i = 0; i < 4; ++i) P[h * 256 + c.lane + 64 * i] = v[i] * inv; }
        __syncthreads();
        {   const int h = c.tid >> 7; float o = 0.f;
            for (int j = 0; j < 256; ++j) o += P[h * 256 + j] * bf2f(kvb[(size_t)j * 4096 + 512 + c.tid]);
            XO[(size_t)m * 512 + c.tid] = (bf16)f2bf(o); }
    }
}
__device__ __forceinline__ float x16_max(float v) { const unsigned u = __builtin_bit_cast(unsigned, v); auto r = __builtin_amdgcn_permlane16_swap(u, u, false, false); return fmaxf(__builtin_bit_cast(float, (unsigned)r[0]), __builtin_bit_cast(float, (unsigned)r[1])); }
__device__ __forceinline__ float x32_max(float v) { const unsigned u = __builtin_bit_cast(unsigned, v); auto r = __builtin_amdgcn_permlane32_swap(u, u, false, false); return fmaxf(__builtin_bit_cast(float, (unsigned)r[0]), __builtin_bit_cast(float, (unsigned)r[1])); }
__device__ __forceinline__ float x16_sum(float v) { const unsigned u = __builtin_bit_cast(unsigned, v); auto r = __builtin_amdgcn_permlane16_swap(u, u, false, false); return __builtin_bit_cast(float, (unsigned)r[0]) + __builtin_bit_cast(float, (unsigned)r[1]); }
__device__ __forceinline__ float x32_sum(float v) { const unsigned u = __builtin_bit_cast(unsigned, v); auto r = __builtin_amdgcn_permlane32_swap(u, u, false, false); return __builtin_bit_cast(float, (unsigned)r[0]) + __builtin_bit_cast(float, (unsigned)r[1]); }
typedef short bf16x8 __attribute__((ext_vector_type(8)));
typedef short bf16x4 __attribute__((ext_vector_type(4)));
__device__ __forceinline__ bf16x4 tr_read4(const unsigned char* p) { return __builtin_amdgcn_ds_read_tr16_b64_v4i16((LAS bf16x4*)p); }
__device__ __forceinline__ bf16x8 cat8(bf16x4 a, bf16x4 b) { return __builtin_shufflevector(a, b, 0, 1, 2, 3, 4, 5, 6, 7); }
__device__ __forceinline__ bf16x8 pack_p8(const f32x4 a, const f32x4 b) {
    u32x4 w; w.x = pg8::cvt_pk_bf16(a[0], a[1]); w.y = pg8::cvt_pk_bf16(a[2], a[3]); w.z = pg8::cvt_pk_bf16(b[0], b[1]); w.w = pg8::cvt_pk_bf16(b[2], b[3]);
    return __builtin_bit_cast(bf16x8, w);
}
__device__ __forceinline__ bf16x8 rope_frag(const bf16x8 xf, const bf16x8 pf, const float* cs, const float* sn, bool lo) {
    float x[8], p[8]; unpack8(__builtin_bit_cast(u32x4, xf), x); unpack8(__builtin_bit_cast(u32x4, pf), p);
    const float sg = lo ? -1.f : 1.f; float o[8];
#pragma unroll
    for (int j = 0; j < 8; ++j) o[j] = x[j] * cs[j] + sg * p[j] * sn[j];
    u32x4 w; w.x = pg8::cvt_pk_bf16(o[0], o[1]); w.y = pg8::cvt_pk_bf16(o[2], o[3]); w.z = pg8::cvt_pk_bf16(o[4], o[5]); w.w = pg8::cvt_pk_bf16(o[6], o[7]);
    return __builtin_bit_cast(bf16x8, w);
}
__device__ __forceinline__ bf16x8 xchg_frag(const bf16x8 v, int lane_xor) { u32x4 u = __builtin_bit_cast(u32x4, v); u32x4 r;
    r.x = (unsigned)__shfl_xor((int)u.x, lane_xor); r.y = (unsigned)__shfl_xor((int)u.y, lane_xor); r.z = (unsigned)__shfl_xor((int)u.z, lane_xor); r.w = (unsigned)__shfl_xor((int)u.w, lane_xor); return __builtin_bit_cast(bf16x8, r); }
constexpr int XA_PITCH = 272;
__device__ __forceinline__ void xattn_mfma(const Ctx& c, const bf16* __restrict__ XQ, const bf16* __restrict__ KVBIG, int layer, bf16* XO) {
    unsigned char* Kl = c.lds; unsigned char* Vl = c.lds + 256 * XA_PITCH;
    const int l = c.lane, n16 = l & 15, g = l >> 4;
    const float scale = 0.08838834764831845f * 1.4426950408889634f;
    for (int unit = c.bid; unit < 256; unit += c.nb) {
        const int b = unit >> 5, h = (unit >> 3) & 3, qc = unit & 7;
        const bf16* kvb = KVBIG + (size_t)(layer * 2048 + b * 256) * 4096 + layer * 1024 + h * 128;
        __syncthreads();
        {
            u32x4 kq[8], vq[8];
#pragma unroll
            for (int j = 0; j < 8; ++j) { const int i = c.tid + NTHR * j, row = i >> 4, ch = i & 15; kq[j] = *(const u32x4*)(kvb + (size_t)row * 4096 + ch * 8); vq[j] = *(const u32x4*)(kvb + (size_t)row * 4096 + 512 + ch * 8); }
#pragma unroll
            for (int j = 0; j < 8; ++j) { const int i = c.tid + NTHR * j, row = i >> 4, ch = i & 15; *(u32x4*)(Kl + row * XA_PITCH + ch * 16) = kq[j]; *(u32x4*)(Vl + row * XA_PITCH + ch * 16) = vq[j]; }
        }
        __syncthreads();
#pragma unroll 1
        for (int g4 = 0; g4 < 4; ++g4) {
            const size_t m = (size_t)b * SEQ + qc * 512 + c.wave * 64 + g4 * 16 + n16;
            bf16x8 Qb[4];
#pragma unroll
            for (int kk = 0; kk < 4; ++kk) Qb[kk] = *(const bf16x8*)(XQ + m * 512 + h * 128 + 32 * kk + 8 * g);
            f32x4 S[16];
#pragma unroll
            for (int j = 0; j < 16; ++j) { S[j] = (f32x4){0.f, 0.f, 0.f, 0.f};
#pragma unroll
                for (int kk = 0; kk < 4; ++kk) { const bf16x8 A = *(const bf16x8*)(Kl + (16 * j + n16) * XA_PITCH + (32 * kk + 8 * g) * 2);
                    S[j] = __builtin_amdgcn_mfma_f32_16x16x32_bf16(A, Qb[kk], S[j], 0, 0, 0); } }
            float mx = -INFINITY;
#pragma unroll
            for (int j = 0; j < 16; ++j) mx = fmaxf(mx, fmaxf(fmaxf(S[j][0], S[j][1]), fmaxf(S[j][2], S[j][3])));
            mx = x32_max(x16_max(mx));
            float sum = 0.f; const float mo = mx * scale;
#pragma unroll
            for (int j = 0; j < 16; ++j) {
#pragma unroll
                for (int r = 0; r < 4; ++r) { const float p = __builtin_amdgcn_exp2f(S[j][r] * scale - mo); S[j][r] = p; sum += p; } }
            sum = x32_sum(x16_sum(sum));
            const float inv = 1.f / sum;
            bf16x8 Pb[8];
#pragma unroll
            for (int jj = 0; jj < 8; ++jj) Pb[jj] = pack_p8(S[2 * jj], S[2 * jj + 1]);
            const int q4 = n16 >> 2, p4 = l & 3;
#pragma unroll
            for (int dt = 0; dt < 8; ++dt) { f32x4 O = (f32x4){0.f, 0.f, 0.f, 0.f};
#pragma unroll
                for (int jj = 0; jj < 8; ++jj) { const unsigned char* vp = Vl + (32 * jj + 4 * g + q4) * XA_PITCH + (16 * dt) * 2 + 8 * p4;
                    const bf16x8 A = cat8(tr_read4(vp), tr_read4(vp + 16 * XA_PITCH));
                    O = __builtin_amdgcn_mfma_f32_16x16x32_bf16(A, Pb[jj], O, 0, 0, 0); }
                u32x2 w; w.x = pg8::cvt_pk_bf16(O[0] * inv, O[1] * inv); w.y = pg8::cvt_pk_bf16(O[2] * inv, O[3] * inv);
                *(u32x2*)(XO + m * 512 + h * 128 + 16 * dt + 4 * g) = w; }
        }
    }
}
__device__ __forceinline__ void diag_cmp_bf16(const Ctx& c, const bf16* A, int lda, const bf16* B, int ldb, int rows, int cols, float* acc) {
    float d2 = 0.f, a2 = 0.f;
    const size_t n = (size_t)rows * cols;
    for (size_t i = (size_t)c.bid * NTHR + c.tid; i < n; i += (size_t)c.nb * NTHR) { const size_t r = i / cols, cc = i % cols; const float a = bf2f(A[r * lda + cc]), b = bf2f(B[r * ldb + cc]); d2 += (a - b) * (a - b); a2 += a * a; }
    d2 = wave_sum(d2); a2 = wave_sum(a2);
    if (c.lane == 0) { atomicAdd(acc, d2); atomicAdd(acc + 1, a2); }
}
constexpr int DA_PITCH = 528, DA_WAVE_BYTES = 32 * DA_PITCH;
__device__ __forceinline__ void dsa_attn_mfma(const Ctx& c, const bf16* __restrict__ QALL, const bf16* __restrict__ KF, const bf16* __restrict__ SEL, const float* __restrict__ ROPEA, bf16* OLY, int m_first, int m_stride, int m_end) {
    unsigned char* Vw = c.lds + c.wave * DA_WAVE_BYTES;
    const int l = c.lane, n16 = l & 15, g = l >> 4, q4 = n16 >> 2, p4 = l & 3, hh = n16 & 7;
    const float scale = 0.08838834764831845f * 1.4426950408889634f;
#pragma unroll 1
    for (int m = m_first; m < m_end; m += m_stride) {
        const int b = m / SEQ, t = m % SEQ, limit = ((t >> 6) + 1) * 64, cnt = limit < 256 ? limit : 256, nblk = cnt >> 5;
        const bf16* qrow = QALL + (size_t)m * QC;
        bf16x8 Qb[9];
#pragma unroll
        for (int kk = 0; kk < 8; ++kk) Qb[kk] = *(const bf16x8*)(qrow + hh * 256 + 32 * kk + 8 * g);
        Qb[8] = *(const bf16x8*)(qrow + 2048 + hh * 32 + 8 * g);
        {
            const bf16x8 pf = xchg_frag(Qb[8], 32); float cs[8], sn[8];
            const f32x4 c0 = *(const f32x4*)(ROPEA + (size_t)m * 32 + 8 * (g & 1)), c1 = *(const f32x4*)(ROPEA + (size_t)m * 32 + 8 * (g & 1) + 4), s0 = *(const f32x4*)(ROPEA + (size_t)m * 32 + 16 + 8 * (g & 1)), s1 = *(const f32x4*)(ROPEA + (size_t)m * 32 + 16 + 8 * (g & 1) + 4);
            cs[0] = c0.x; cs[1] = c0.y; cs[2] = c0.z; cs[3] = c0.w; cs[4] = c1.x; cs[5] = c1.y; cs[6] = c1.z; cs[7] = c1.w; sn[0] = s0.x; sn[1] = s0.y; sn[2] = s0.z; sn[3] = s0.w; sn[4] = s1.x; sn[5] = s1.y; sn[6] = s1.z; sn[7] = s1.w;
            Qb[8] = rope_frag(Qb[8], pf, cs, sn, g < 2); }
        f32x4 O[16];
#pragma unroll
        for (int dt = 0; dt < 16; ++dt) O[dt] = (f32x4){0.f, 0.f, 0.f, 0.f};
        float mrun = -INFINITY, lrun = 0.f;
        const unsigned short* selp = (const unsigned short*)SEL + (size_t)m * 256;
        const bf16* kfb = KF + (size_t)b * SEQ * KFW;
        bf16x8 K0[9], K1[9];
        int sx0, sx1;
#define DA_IDX(BLK) do { sx0 = selp[32 * (BLK) + n16]; sx1 = selp[32 * (BLK) + 16 + n16]; } while (0)
#define DA_GATHER() do { const bf16* r0_ = kfb + (size_t)sx0 * KFW + 8 * g; const bf16* r1_ = kfb + (size_t)sx1 * KFW + 8 * g; \
            _Pragma("unroll") for (int kk = 0; kk < 9; ++kk) { K0[kk] = *(const bf16x8*)(r0_ + 32 * kk); K1[kk] = *(const bf16x8*)(r1_ + 32 * kk); } } while (0)
        DA_IDX(0); DA_GATHER(); DA_IDX(nblk > 1 ? 1 : 0);
#pragma unroll 1
        for (int blk = 0; blk < nblk; ++blk) {
            f32x4 S0 = (f32x4){0.f, 0.f, 0.f, 0.f}, S1 = (f32x4){0.f, 0.f, 0.f, 0.f};
#pragma unroll
            for (int kk = 0; kk < 9; ++kk) { S0 = __builtin_amdgcn_mfma_f32_16x16x32_bf16(K0[kk], Qb[kk], S0, 0, 0, 0); S1 = __builtin_amdgcn_mfma_f32_16x16x32_bf16(K1[kk], Qb[kk], S1, 0, 0, 0); }
#pragma unroll
            for (int kk = 0; kk < 8; ++kk) { *(bf16x8*)(Vw + n16 * DA_PITCH + (32 * kk + 8 * g) * 2) = K0[kk]; *(bf16x8*)(Vw + (16 + n16) * DA_PITCH + (32 * kk + 8 * g) * 2) = K1[kk]; }
            __builtin_amdgcn_sched_barrier(0);
            if (blk + 1 < nblk) { DA_GATHER(); DA_IDX(blk + 2 < nblk ? blk + 2 : blk + 1); }
            __builtin_amdgcn_sched_barrier(0);
            float bm = fmaxf(fmaxf(fmaxf(S0[0], S0[1]), fmaxf(S0[2], S0[3])), fmaxf(fmaxf(S1[0], S1[1]), fmaxf(S1[2], S1[3])));
            bm = x32_max(x16_max(bm));
            const float mnew = fmaxf(mrun, bm), alpha = __builtin_amdgcn_exp2f((mrun - mnew) * scale), mo = mnew * scale; mrun = mnew;
            float ps = 0.f;
#pragma unroll
            for (int r = 0; r < 4; ++r) { S0[r] = __builtin_amdgcn_exp2f(S0[r] * scale - mo); S1[r] = __builtin_amdgcn_exp2f(S1[r] * scale - mo); ps += S0[r] + S1[r]; }
            lrun = lrun * alpha + ps;
            const bf16x8 Pb = pack_p8(S0, S1);
#pragma unroll
            for (int dt = 0; dt < 16; ++dt) { O[dt] = O[dt] * alpha;
                const unsigned char* vp = Vw + (4 * g + q4) * DA_PITCH + (16 * dt) * 2 + 8 * p4;
                const bf16x8 A = cat8(tr_read4(vp), tr_read4(vp + 16 * DA_PITCH));
                O[dt] = __builtin_amdgcn_mfma_f32_16x16x32_bf16(A, Pb, O[dt], 0, 0, 0); }
        }
#undef DA_GATHER
#undef DA_IDX
        lrun = x32_sum(x16_sum(lrun));
        const float inv = 1.f / lrun;
        if (n16 < 8) {
            bf16* orow = OLY + (size_t)m * OC + n16 * 256 + 4 * g;
#pragma unroll
            for (int dt = 0; dt < 16; ++dt) { u32x2 w; w.x = pg8::cvt_pk_bf16(O[dt][0] * inv, O[dt][1] * inv); w.y = pg8::cvt_pk_bf16(O[dt][2] * inv, O[dt][3] * inv); *(u32x2*)(orow + 16 * dt) = w; }
        }
    }
}
__device__ __forceinline__ void dsa_attn_queue(const Ctx& c, const bf16* __restrict__ QALL, const bf16* __restrict__ KF, const bf16* __restrict__ SEL, const float* __restrict__ ROPEA, bf16* OLY, unsigned* counter, volatile LAS unsigned* slot) {
    for (;;) {
        __syncthreads();
        if (c.tid == 0) *slot = __hip_atomic_fetch_add(counter, 1u, __ATOMIC_RELAXED, __HIP_MEMORY_SCOPE_AGENT);
        __syncthreads();
        const int chunk = (int)*slot;
        if (chunk >= M / 16) break;
        dsa_attn_mfma(c, QALL, KF, SEL, ROPEA, OLY, chunk * 16 + c.wave, 8, chunk * 16 + 16);
    }
}
__device__ __forceinline__ float relu1(float x) { const int b = __builtin_bit_cast(int, x); return __builtin_bit_cast(float, b > 0 ? b : 0); }
__device__ __forceinline__ void idx_topk_mfma(const Ctx& c, const bf16* __restrict__ QALL, const bf16* __restrict__ KIDX, const float* __restrict__ WIDX, const float* __restrict__ ROPEI, float* scr, bf16* SEL, int nitems) {
    const int l = c.lane, n16 = l & 15, g = l >> 4, qg = c.wave & 3, kh = c.wave >> 2;
#pragma unroll 1
    for (int item = c.bid; item < nitems; item += c.nb) {
        const int b = item >> 5, pr = item & 31;
#pragma unroll 1
        for (int which = 0; which < 2; ++which) {
            const int ch = which ? 63 - pr : pr, L = 64 * (ch + 1), t0 = 64 * ch;
            if (L > 256) {
            const size_t m = (size_t)b * SEQ + t0 + 16 * qg + n16;
            float* srow = scr + (size_t)(16 * qg + n16) * L + 4 * g;
            const int nt = L >> 5, j0 = kh * nt, j1 = j0 + nt;
            const bf16* kp = KIDX + ((size_t)b * SEQ + n16) * 64 + 8 * g;
            {
                bf16x8 Qi[16][2]; float w[16];
                { const bf16* qp = QALL + m * QC + 2304 + 8 * g;
#pragma unroll
                  for (int h = 0; h < 16; ++h) { Qi[h][0] = *(const bf16x8*)(qp + h * 64); Qi[h][1] = *(const bf16x8*)(qp + h * 64 + 32); }
                  {
                      float cs[8], sn[8]; const f32x4 c0 = *(const f32x4*)(ROPEI + m * 16), c1 = *(const f32x4*)(ROPEI + m * 16 + 4), s0 = *(const f32x4*)(ROPEI + m * 16 + 8), s1 = *(const f32x4*)(ROPEI + m * 16 + 12);
                      cs[0] = c0.x; cs[1] = c0.y; cs[2] = c0.z; cs[3] = c0.w; cs[4] = c1.x; cs[5] = c1.y; cs[6] = c1.z; cs[7] = c1.w; sn[0] = s0.x; sn[1] = s0.y; sn[2] = s0.z; sn[3] = s0.w; sn[4] = s1.x; sn[5] = s1.y; sn[6] = s1.z; sn[7] = s1.w;
#pragma unroll
                      for (int h = 0; h < 16; ++h) { const bf16x8 pf = xchg_frag(Qi[h][0], 16); const bf16x8 rf = rope_frag(Qi[h][0], pf, cs, sn, g == 0); if (g < 2) Qi[h][0] = rf; } }
                  const f32x4* wp = (const f32x4*)(WIDX + m * 16);
#pragma unroll
                  for (int q = 0; q < 4; ++q) { const f32x4 v = wp[q]; w[4 * q] = v.x; w[4 * q + 1] = v.y; w[4 * q + 2] = v.z; w[4 * q + 3] = v.w; } }
                bf16x8 Ka = *(const bf16x8*)(kp + (size_t)j0 * 1024), Kb = *(const bf16x8*)(kp + (size_t)j0 * 1024 + 32);
#pragma unroll 1
                for (int j = j0; j < j1; ++j) {
                    const int jn = (j + 1 < j1) ? j + 1 : j;
                    const bf16x8 Na = *(const bf16x8*)(kp + (size_t)jn * 1024), Nb = *(const bf16x8*)(kp + (size_t)jn * 1024 + 32);
                    f32x2 s01 = (f32x2){0.f, 0.f}, s23 = (f32x2){0.f, 0.f};
                    f32x4 a = __builtin_amdgcn_mfma_f32_16x16x32_bf16(Ka, Qi[0][0], (f32x4){0.f, 0.f, 0.f, 0.f}, 0, 0, 0); a = __builtin_amdgcn_mfma_f32_16x16x32_bf16(Kb, Qi[0][1], a, 0, 0, 0);
#pragma unroll
                    for (int h = 0; h < 16; ++h) { f32x4 an = a;
                        if (h < 15) { an = __builtin_amdgcn_mfma_f32_16x16x32_bf16(Ka, Qi[h + 1][0], (f32x4){0.f, 0.f, 0.f, 0.f}, 0, 0, 0); an = __builtin_amdgcn_mfma_f32_16x16x32_bf16(Kb, Qi[h + 1][1], an, 0, 0, 0); }
                        const f32x2 wv = (f32x2){w[h], w[h]};
                        s01 = (f32x2){relu1(a[0]), relu1(a[1])} * wv + s01; s23 = (f32x2){relu1(a[2]), relu1(a[3])} * wv + s23; a = an; }
                    *(f32x4*)(srow + 16 * j) = (f32x4){s01.x, s01.y, s23.x, s23.y};
                    Ka = Na; Kb = Nb;
                }
            }
            }
            asm volatile("s_waitcnt vmcnt(0)" ::: "memory");
            __syncthreads();
            __builtin_amdgcn_fence(__ATOMIC_ACQUIRE, "agent");
            asm volatile("s_waitcnt vmcnt(0)" ::: "memory");
#pragma unroll 1
            for (int i = 0; i < 8; ++i) {
                const int ql = c.wave * 8 + i;
                unsigned short* sel = (unsigned short*)SEL + ((size_t)b * SEQ + t0 + ql) * 256;
                if (L <= 256) { for (int k = l; k < 256; k += 64) sel[k] = (unsigned short)(k < L ? k : 0); }
                else select_row_bs(scr + (size_t)ql * L, L, sel, l, (unsigned short*)(c.lds + c.wave * 512));
            }
            __syncthreads();
        }
    }
}
__device__ __forceinline__ void diag_cmp_sel(const Ctx& c, const bf16* SA, const bf16* SB, int nbatch, float* acc) {
    unsigned* bm = (unsigned*)(c.lds + c.wave * 512);
    float miss = 0.f, tot = 0.f;
    for (int m = c.gw; m < nbatch * SEQ; m += c.ngw) {
        const int t = m % SEQ; if (t < 256) continue;
        bm[c.lane] = 0u; bm[64 + c.lane] = 0u;
        __builtin_amdgcn_fence(__ATOMIC_RELEASE, "wavefront"); __builtin_amdgcn_wave_barrier();
        for (int i = c.lane; i < 256; i += 64) { const unsigned s = ((const unsigned short*)SA)[(size_t)m * 256 + i]; atomicOr(&bm[s >> 5], 1u << (s & 31)); }
        __builtin_amdgcn_fence(__ATOMIC_RELEASE, "wavefront"); __builtin_amdgcn_wave_barrier(); __builtin_amdgcn_fence(__ATOMIC_ACQUIRE, "wavefront");
        for (int i = c.lane; i < 256; i += 64) { const unsigned s = ((const unsigned short*)SB)[(size_t)m * 256 + i]; miss += ((bm[s >> 5] >> (s & 31)) & 1u) ? 0.f : 1.f; tot += 1.f; }
        __builtin_amdgcn_fence(__ATOMIC_RELEASE, "wavefront"); __builtin_amdgcn_wave_barrier();
    }
    miss = wave_sum(miss); tot = wave_sum(tot);
    if (c.lane == 0) { atomicAdd(acc, miss); atomicAdd(acc + 1, tot); }
}
__device__ __forceinline__ void idx_topk_lds(const Ctx& c, const bf16* __restrict__ QALL, const bf16* __restrict__ KIDX, const float* __restrict__ WIDX, const float* __restrict__ ROPEI, u32x4* qscr, bf16* SEL, int nitems) {
    float* SCL = (float*)c.lds;
    f32x4* WL = (f32x4*)(c.lds + 131072);
    const int w8 = c.wave;
#pragma unroll 1
    for (int item = c.bid; item < nitems; item += c.nb) {
        const int b = item >> 5, pr = item & 31;
#pragma unroll 1
        for (int which = 0; which < 2; ++which) {
            int l = c.lane; asm volatile("" : "+v"(l));
            const int n16 = l & 15, g = l >> 4;
            const int ch = which ? 63 - pr : pr, L = 64 * (ch + 1), t0 = 64 * ch;
            if (L <= 256) {
#pragma unroll 1
                for (int i = 0; i < 8; ++i) { unsigned short* sel = (unsigned short*)SEL + ((size_t)b * SEQ + t0 + w8 * 8 + i) * 256; for (int k = l; k < 256; k += 64) sel[k] = (unsigned short)(k < L ? k : 0); }
                continue;
            }
            __syncthreads();
            if (w8 < 4) {
                const size_t m = (size_t)b * SEQ + t0 + 16 * w8 + n16;
                const bf16* qp = QALL + m * QC + 2304 + 8 * g;
                float cs[8], sn[8]; const f32x4 c0 = *(const f32x4*)(ROPEI + m * 16), c1 = *(const f32x4*)(ROPEI + m * 16 + 4), s0 = *(const f32x4*)(ROPEI + m * 16 + 8), s1 = *(const f32x4*)(ROPEI + m * 16 + 12);
                cs[0] = c0.x; cs[1] = c0.y; cs[2] = c0.z; cs[3] = c0.w; cs[4] = c1.x; cs[5] = c1.y; cs[6] = c1.z; cs[7] = c1.w; sn[0] = s0.x; sn[1] = s0.y; sn[2] = s0.z; sn[3] = s0.w; sn[4] = s1.x; sn[5] = s1.y; sn[6] = s1.z; sn[7] = s1.w;
#pragma unroll 4
                for (int h = 0; h < 16; ++h) { bf16x8 f0 = *(const bf16x8*)(qp + h * 64); const bf16x8 f1 = *(const bf16x8*)(qp + h * 64 + 32);
                    const bf16x8 pf = xchg_frag(f0, 16); const bf16x8 rf = rope_frag(f0, pf, cs, sn, g == 0); if (g < 2) f0 = rf;
                    qscr[(w8 * 64 + l) * 32 + h * 2] = __builtin_bit_cast(u32x4, f0); qscr[(w8 * 64 + l) * 32 + h * 2 + 1] = __builtin_bit_cast(u32x4, f1); }
            }
            asm volatile("s_waitcnt vmcnt(0)" ::: "memory");
            __syncthreads();
            __builtin_amdgcn_fence(__ATOMIC_ACQUIRE, "agent"); asm volatile("s_waitcnt vmcnt(0)" ::: "memory");
            const bf16* kp = KIDX + ((size_t)b * SEQ + n16) * 64 + 8 * g;
            const int ntile = L >> 4;
#pragma unroll 1
            for (int qsub = 0; qsub < 8; ++qsub) {
                asm volatile("" ::: "memory");
                bf16x8 Qi[16][2];
                { const int srcl = g * 16 + (qsub & 1) * 8 + (n16 & 7); const u32x4* fp = qscr + (size_t)((qsub >> 1) * 64 + srcl) * 32;
#pragma unroll
                  for (int h = 0; h < 16; ++h) { Qi[h][0] = __builtin_bit_cast(bf16x8, fp[h * 2]); Qi[h][1] = __builtin_bit_cast(bf16x8, fp[h * 2 + 1]); }
                  if (w8 == 0 && l < 32) WL[l] = *(const f32x4*)(WIDX + ((size_t)b * SEQ + t0 + 8 * qsub + (l >> 2)) * 16 + 4 * (l & 3)); }
                __syncthreads();
                const f32x4* wq = WL + (n16 & 7) * 4;
                float* srow = SCL + (n16 & 7) * 4096 + 4 * g;
                int j = w8;
                bf16x8 Ka = *(const bf16x8*)(kp + (size_t)j * 1024), Kb = *(const bf16x8*)(kp + (size_t)j * 1024 + 32);
#pragma unroll 1
                for (; j < ntile; j += 8) {
                    const int jn = (j + 8 < ntile) ? j + 8 : j;
                    const bf16x8 Na = *(const bf16x8*)(kp + (size_t)jn * 1024), Nb = *(const bf16x8*)(kp + (size_t)jn * 1024 + 32);
                    f32x2 s01 = (f32x2){0.f, 0.f}, s23 = (f32x2){0.f, 0.f};
                    f32x4 a = __builtin_amdgcn_mfma_f32_16x16x32_bf16(Ka, Qi[0][0], (f32x4){0.f, 0.f, 0.f, 0.f}, 0, 0, 0); a = __builtin_amdgcn_mfma_f32_16x16x32_bf16(Kb, Qi[0][1], a, 0, 0, 0);
#pragma unroll
                    for (int h4 = 0; h4 < 4; ++h4) { const f32x4 w4 = wq[h4];
#pragma unroll
                        for (int hh = 0; hh < 4; ++hh) { const int h = 4 * h4 + hh; f32x4 an = a;
                            if (h < 15) { an = __builtin_amdgcn_mfma_f32_16x16x32_bf16(Ka, Qi[h + 1][0], (f32x4){0.f, 0.f, 0.f, 0.f}, 0, 0, 0); an = __builtin_amdgcn_mfma_f32_16x16x32_bf16(Kb, Qi[h + 1][1], an, 0, 0, 0); }
                            const f32x2 wv = (f32x2){w4[hh], w4[hh]};
                            s01 = (f32x2){relu1(a[0]), relu1(a[1])} * wv + s01; s23 = (f32x2){relu1(a[2]), relu1(a[3])} * wv + s23; a = an; } }
                    if (n16 < 8) *(f32x4*)(srow + 16 * j) = (f32x4){s01.x, s01.y, s23.x, s23.y};
                    Ka = Na; Kb = Nb;
                }
                __syncthreads();
                select_row(SCL + w8 * 4096, L, (unsigned short*)SEL + ((size_t)b * SEQ + t0 + 8 * qsub + w8) * 256, l);
                __syncthreads();
            }
        }
    }
}
#if DIAG == 7
__device__ __forceinline__ void select_row_v1(const float* row, int limit, unsigned short* sel, int l_in) {
    int l = l_in; asm volatile("" : "+v"(l));
    const int ng = limit >> 9;
    unsigned key[64];
#pragma unroll
    for (int j = 0; j < 64; ++j) { const int s = j * 64 + l; unsigned u = 0u; if (s < limit) { u = __float_as_uint(row[s]); u = (u & 0x80000000u) ? ~u : (u | 0x80000000u); } key[j] = u; }
    unsigned mx = 0u;
#pragma unroll
    for (int j = 0; j < 64; ++j) mx = key[j] > mx ? key[j] : mx;
#pragma unroll
    for (int o = 1; o < 64; o <<= 1) { const unsigned t = (unsigned)__shfl_xor((int)mx, o); mx = t > mx ? t : mx; }
    mx = (unsigned)__builtin_amdgcn_readfirstlane((int)mx);
    unsigned T = 0u;
#pragma unroll 1
    for (int bit = 31 - __builtin_clz(mx | 1u); bit >= 0; --bit) {
        const unsigned Tn = T | (1u << bit); int cnt = 0;
#pragma unroll
        for (int jg = 0; jg < 8; ++jg) if (jg <= ng) {
#pragma unroll
            for (int j = 8 * jg; j < 8 * jg + 8; ++j) cnt += __popcll(__ballot(key[j] >= Tn)); }
        if (cnt >= 256) T = Tn;
        if (cnt == 256) break;
    }
    int cgt = 0;
#pragma unroll
    for (int j = 0; j < 64; ++j) cgt += __popcll(__ballot(key[j] > T));
    const int need_eq = 256 - cgt;
    int base = 0, beq = 0;
    const unsigned long long lt = (1ull << l) - 1ull;
#pragma unroll
    for (int jg = 0; jg < 8; ++jg) if (jg <= ng) {
#pragma unroll
        for (int j = 8 * jg; j < 8 * jg + 8; ++j) {
            const unsigned long long mg = __ballot(key[j] > T), me = __ballot(key[j] == T);
            if (key[j] > T) sel[base + __popcll(mg & lt)] = (unsigned short)(j * 64 + l);
            base += __popcll(mg);
            const int pe = beq + __popcll(me & lt);
            if (key[j] == T && pe < need_eq) sel[cgt + pe] = (unsigned short)(j * 64 + l);
            beq += __popcll(me);
        }
    }
}
__device__ __forceinline__ void idx_topk_v1(const Ctx& c, const bf16* __restrict__ QALL, const bf16* __restrict__ KIDX, const float* __restrict__ WIDX, float* scr, bf16* SEL, int nitems) {
    const int l = c.lane, n16 = l & 15, g = l >> 4, qg = c.wave & 3, kh = c.wave >> 2;
#pragma unroll 1
    for (int item = c.bid; item < nitems; item += c.nb) {
        const int b = item >> 5, pr = item & 31;
#pragma unroll 1
        for (int which = 0; which < 2; ++which) {
            const int ch = which ? 63 - pr : pr, L = 64 * (ch + 1), t0 = 64 * ch;
            if (L > 256) {
            const size_t m = (size_t)b * SEQ + t0 + 16 * qg + n16;
            float* srow = scr + (size_t)(16 * qg + n16) * L + 4 * g;
            const int nt = L >> 5, j0 = kh * nt, j1 = j0 + nt;
            const bf16* kp = KIDX + ((size_t)b * SEQ + n16) * 64 + 8 * g;
#pragma unroll 1
            for (int hp = 0; hp < 2; ++hp) {
                bf16x8 Qi[8][2]; float w[8];
                { const bf16* qp = QALL + m * QC + 2304 + hp * 512 + 8 * g;
#pragma unroll
                  for (int h = 0; h < 8; ++h) { Qi[h][0] = *(const bf16x8*)(qp + h * 64); Qi[h][1] = *(const bf16x8*)(qp + h * 64 + 32); }
                  const f32x4* wp = (const f32x4*)(WIDX + m * 16 + hp * 8);
#pragma unroll
                  for (int q = 0; q < 2; ++q) { const f32x4 v = wp[q]; w[4 * q] = v.x; w[4 * q + 1] = v.y; w[4 * q + 2] = v.z; w[4 * q + 3] = v.w; } }
                if (hp) { asm volatile("s_waitcnt vmcnt(0)" ::: "memory"); __builtin_amdgcn_fence(__ATOMIC_ACQUIRE, "agent"); asm volatile("s_waitcnt vmcnt(0)" ::: "memory"); }
                bf16x8 Ka = *(const bf16x8*)(kp + (size_t)j0 * 1024), Kb = *(const bf16x8*)(kp + (size_t)j0 * 1024 + 32);
                f32x4 pv = (f32x4){0.f, 0.f, 0.f, 0.f}; if (hp) pv = *(const f32x4*)(srow + 16 * j0);
#pragma unroll 1
                for (int j = j0; j < j1; ++j) {
                    const int jn = (j + 1 < j1) ? j + 1 : j;
                    const bf16x8 Na = *(const bf16x8*)(kp + (size_t)jn * 1024), Nb = *(const bf16x8*)(kp + (size_t)jn * 1024 + 32);
                    f32x4 pn = (f32x4){0.f, 0.f, 0.f, 0.f}; if (hp) pn = *(const f32x4*)(srow + 16 * jn);
                    f32x4 sc = pv;
#pragma unroll
                    for (int h = 0; h < 8; ++h) { f32x4 a = __builtin_amdgcn_mfma_f32_16x16x32_bf16(Ka, Qi[h][0], (f32x4){0.f, 0.f, 0.f, 0.f}, 0, 0, 0); a = __builtin_amdgcn_mfma_f32_16x16x32_bf16(Kb, Qi[h][1], a, 0, 0, 0);
                        sc[0] += w[h] * fmaxf(a[0], 0.f); sc[1] += w[h] * fmaxf(a[1], 0.f); sc[2] += w[h] * fmaxf(a[2], 0.f); sc[3] += w[h] * fmaxf(a[3], 0.f); }
                    *(f32x4*)(srow + 16 * j) = sc;
                    Ka = Na; Kb = Nb; pv = pn;
                }
            }
            }
            asm volatile("s_waitcnt vmcnt(0)" ::: "memory");
            __syncthreads();
            __builtin_amdgcn_fence(__ATOMIC_ACQUIRE, "agent");
            asm volatile("s_waitcnt vmcnt(0)" ::: "memory");
#pragma unroll 1
            for (int i = 0; i < 8; ++i) {
                const int ql = c.wave * 8 + i;
                unsigned short* sel = (unsigned short*)SEL + ((size_t)b * SEQ + t0 + ql) * 256;
                if (L <= 256) { for (int k = l; k < 256; k += 64) sel[k] = (unsigned short)(k < L ? k : 0); }
                else select_row_v1(scr + (size_t)ql * L, L, sel, l);
            }
            __syncthreads();
        }
    }
}
#endif
constexpr int RW_TB = 32;
struct RwkvP { const float *mu, *w0, *w2, *a0, *a2, *g2, *k_k, *k_a, *r_k, *ln_w, *ln_b; };
__device__ __forceinline__ void rwkv_phase(const Ctx& c, const bf16* __restrict__ H, const RwkvP P, bf16* OLY) {
    float* A_WR = (float*)c.lds;
    float* A_K2 = A_WR + RW_TB * 64;
    float* A_V = A_K2 + RW_TB * 64;
    float* A_W = A_V + RW_TB * 64;
    float* A_NKK = A_W + RW_TB * 64;
    float* A_B = A_NKK + RW_TB * 64;
    float* A_G = A_B + RW_TB * 64;
    float* A_OUT = A_G + RW_TB * 64;
    float* L_TW = A_OUT + RW_TB * 64;
    float* L_AL = L_TW + RW_TB * 64;
    float* L_SG = L_AL + RW_TB * 64;
    float* SC1 = L_SG + RW_TB * 160; float* SC2 = SC1 + RW_TB; float* SC3 = SC2 + RW_TB;
    const int l = c.lane, w = c.wave;
    for (int item = c.bid; item < NB * 16; item += c.nb) {
        const int b = item >> 4, h = item & 15, hk = h * 64 + l;
        const float w0v = P.w0[hk], a0v = P.a0[hk], kkv = P.k_k[hk], kav = P.k_a[hk], rkv = P.r_k[hk], lnw = P.ln_w[hk], lnb = P.ln_b[hk];
        float S[8];
#pragma unroll
        for (int i = 0; i < 8; ++i) S[i] = 0.f;
        const int srow = w * 8 + (l >> 3), sj = l & 7;
        for (int t0 = 0; t0 < SEQ; t0 += RW_TB) {
            __syncthreads();
            for (int idx = c.tid; idx < RW_TB * 480; idx += NTHR) {
                const int t = idx / 480, cc = idx % 480; int col; float* dst;
                if (cc < 64) { col = 880 + h * 64 + cc; dst = A_WR + t * 64 + cc; }
                else if (cc < 128) { col = 1904 + h * 64 + (cc - 64); dst = A_K2 + t * 64 + (cc - 64); }
                else if (cc < 192) { col = 2928 + h * 64 + (cc - 128); dst = A_V + t * 64 + (cc - 128); }
                else if (cc < 256) { col = 3952 + (cc - 192); dst = L_TW + t * 64 + (cc - 192); }
                else if (cc < 320) { col = 4016 + (cc - 256); dst = L_AL + t * 64 + (cc - 256); }
                else { col = 4080 + (cc - 320); dst = L_SG + t * 160 + (cc - 320); }
                const size_t m = (size_t)b * SEQ + t0 + t;
                const float x = bf2f(H[m * HC + col]); const float xp = (t0 + t > 0) ? bf2f(H[(m - 1) * HC + col]) : 0.f;
                float hm = x + (xp - x) * P.mu[col - 880];
                if (cc >= 192 && cc < 256) hm = tanhf(hm); else if (cc >= 320) hm = sigmoidf_(hm);
                *dst = hm;
            }
            __syncthreads();
            {
                float wl[RW_TB / 8], al[RW_TB / 8], gg[RW_TB / 8];
#pragma unroll
                for (int i = 0; i < RW_TB / 8; ++i) { wl[i] = 0.f; al[i] = 0.f; gg[i] = 0.f; }
                for (int j = 0; j < 64; ++j) { const float w2v = P.w2[(size_t)j * 1024 + hk], a2v = P.a2[(size_t)j * 1024 + hk];
#pragma unroll
                    for (int i = 0; i < RW_TB / 8; ++i) { wl[i] += L_TW[(w + 8 * i) * 64 + j] * w2v; al[i] += L_AL[(w + 8 * i) * 64 + j] * a2v; } }
                for (int j = 0; j < 160; ++j) { const float g2v = P.g2[(size_t)j * 1024 + hk];
#pragma unroll
                    for (int i = 0; i < RW_TB / 8; ++i) gg[i] += L_SG[(w + 8 * i) * 160 + j] * g2v; }
#pragma unroll
                for (int i = 0; i < RW_TB / 8; ++i) {
                    const int t = w + 8 * i, o = t * 64 + l;
                    const float dec = __expf(-0.6065306597126334f * sigmoidf_(w0v + wl[i]));
                    const float a = sigmoidf_(a0v + al[i]);
                    const float kr = A_K2[o], r = A_WR[o];
                    float kk = kr * kkv; const float nrm = wave_sum(kk * kk); kk = kk * (1.0f / sqrtf(fmaxf(nrm, 1e-24f)));
                    const float k2 = kr * (1.f + (a - 1.f) * kav), bb = kk * a;
                    const float s1 = wave_sum(bb * r), s2 = wave_sum(k2 * r), s3 = wave_sum(r * k2 * rkv);
                    A_W[o] = dec; A_NKK[o] = -kk; A_B[o] = bb; A_K2[o] = k2; A_WR[o] = dec * r; A_G[o] = gg[i];
                    if (l == 0) { SC1[t] = s1; SC2[t] = s2; SC3[t] = s3; }
                }
            }
            __syncthreads();
            for (int t = 0; t < RW_TB; ++t) {
                const f32x4* pw = (const f32x4*)(A_W + t * 64 + 8 * sj); const f32x4* pn = (const f32x4*)(A_NKK + t * 64 + 8 * sj); const f32x4* pb = (const f32x4*)(A_B + t * 64 + 8 * sj);
                const f32x4* pk = (const f32x4*)(A_K2 + t * 64 + 8 * sj); const f32x4* pr = (const f32x4*)(A_WR + t * 64 + 8 * sj);
                const f32x4 w0_ = pw[0], w1_ = pw[1], n0 = pn[0], n1 = pn[1], b0 = pb[0], b1 = pb[1], k0 = pk[0], k1 = pk[1], r0 = pr[0], r1 = pr[1];
                const float vv = A_V[t * 64 + srow], s1 = SC1[t], s2 = SC2[t];
                float sa = (S[0] * n0.x + S[1] * n0.y) + (S[2] * n0.z + S[3] * n0.w) + (S[4] * n1.x + S[5] * n1.y) + (S[6] * n1.z + S[7] * n1.w);
                float p = (S[0] * r0.x + S[1] * r0.y) + (S[2] * r0.z + S[3] * r0.w) + (S[4] * r1.x + S[5] * r1.y) + (S[6] * r1.z + S[7] * r1.w);
                sa += __shfl_xor(sa, 1); p += __shfl_xor(p, 1); sa += __shfl_xor(sa, 2); p += __shfl_xor(p, 2); sa += __shfl_xor(sa, 4); p += __shfl_xor(p, 4);
                S[0] = S[0] * w0_.x + (sa * b0.x + vv * k0.x); S[1] = S[1] * w0_.y + (sa * b0.y + vv * k0.y); S[2] = S[2] * w0_.z + (sa * b0.z + vv * k0.z); S[3] = S[3] * w0_.w + (sa * b0.w + vv * k0.w);
                S[4] = S[4] * w1_.x + (sa * b1.x + vv * k1.x); S[5] = S[5] * w1_.y + (sa * b1.y + vv * k1.y); S[6] = S[6] * w1_.z + (sa * b1.z + vv * k1.z); S[7] = S[7] * w1_.w + (sa * b1.w + vv * k1.w);
                if (sj == 0) A_OUT[t * 64 + srow] = p + sa * s1 + vv * s2;
            }
            __syncthreads();
#pragma unroll
            for (int i = 0; i < RW_TB / 8; ++i) {
                const int t = w + 8 * i, o = t * 64 + l;
                const float x = A_OUT[o]; const float mean = wave_sum(x) * (1.f / 64.f); const float dx = x - mean; const float var = wave_sum(dx * dx) * (1.f / 64.f);
                float y = dx * (1.0f / sqrtf(var + 64e-5f)) * lnw + lnb;
                y = (y + SC3[t] * A_V[o]) * A_G[o];
                OLY[((size_t)b * SEQ + t0 + t) * OC + 2048 + hk] = (bf16)f2bf(y);
            }
        }
    }
}

constexpr int S5_TB = 16;
struct S5P { const float *lam_re, *lam_im, *log_dt, *b_re, *b_im, *c_re, *c_im, *d; };
__device__ __forceinline__ float gelu_tanh(float y) { return 0.5f * y * (1.f + tanhf(0.7978845608028654f * (y + 0.044715f * y * y * y))); }
__device__ __forceinline__ void s5_phase(const Ctx& c, const bf16* __restrict__ U, const S5P P, bf16* Z) {
    constexpr int PERW = 256 + 2 * S5_TB * 65 + 2 * 64 * 16;
    float* UU = (float*)c.lds + c.wave * PERW;
    float* XSr = UU + 256; float* XSi = XSr + S5_TB * 65;
    float* CTr = XSi + S5_TB * 65; float* CTi = CTr + 64 * 16;
    const int l = c.lane;
    for (int item = c.bid; item < NB * 16; item += c.nb) {
        const int b = item >> 4, g = (item & 15) * 8 + c.wave;
        __syncthreads();
        float lbr, lbi, Br[16], Bi[16];
        {
            const float lr = fminf(P.lam_re[g * 64 + l], -1e-4f), li = P.lam_im[g * 64 + l], dt = expf(P.log_dt[g]);
            const float e = expf(lr * dt); lbr = e * cosf(li * dt); lbi = e * sinf(li * dt);
            const float nr = lbr - 1.f, ni = lbi, den = 1.f / (lr * lr + li * li);
            const float cr = (nr * lr + ni * li) * den, ci = (ni * lr - nr * li) * den;
#pragma unroll
            for (int i = 0; i < 16; ++i) { const float br = P.b_re[(size_t)(g * 64 + l) * 16 + i], bi = P.b_im[(size_t)(g * 64 + l) * 16 + i]; Br[i] = cr * br - ci * bi; Bi[i] = cr * bi + ci * br; }
#pragma unroll
            for (int o = 0; o < 16; ++o) { CTr[l * 16 + o] = P.c_re[(size_t)(g * 16 + o) * 64 + l]; CTi[l * 16 + o] = P.c_im[(size_t)(g * 16 + o) * 64 + l]; }
        }
        float dsk[4];
#pragma unroll
        for (int e = 0; e < 4; ++e) dsk[e] = P.d[g * 16 + (l >> 4) * 4 + e];
        float xr = 0.f, xi = 0.f;
        for (int t0 = 0; t0 < SEQ; t0 += S5_TB) {
            __syncthreads();
            { const int row = l >> 2, q = l & 3; const u32x2 w2 = *(const u32x2*)(U + ((size_t)b * SEQ + t0 + row) * D + g * 16 + 4 * q);
              float* d = UU + row * 16 + 4 * q; d[0] = bf2f(w2.x & 0xffffu); d[1] = bf2f(w2.x >> 16); d[2] = bf2f(w2.y & 0xffffu); d[3] = bf2f(w2.y >> 16); }
            __syncthreads();
            for (int t = 0; t < S5_TB; ++t) {
                const f32x4* up = (const f32x4*)(UU + t * 16); const f32x4 u0 = up[0], u1 = up[1], u2 = up[2], u3 = up[3];
                const float u[16] = {u0.x, u0.y, u0.z, u0.w, u1.x, u1.y, u1.z, u1.w, u2.x, u2.y, u2.z, u2.w, u3.x, u3.y, u3.z, u3.w};
                float bur = 0.f, bui = 0.f;
#pragma unroll
                for (int i = 0; i < 16; ++i) { bur += Br[i] * u[i]; bui += Bi[i] * u[i]; }
                const float nxr = lbr * xr - lbi * xi + bur, nxi = lbr * xi + lbi * xr + bui; xr = nxr; xi = nxi;
                XSr[t * 65 + l] = xr; XSi[t * 65 + l] = xi;
            }
            __syncthreads();
            {   const int t = l & 15, oq = l >> 4; float y[4] = {0.f, 0.f, 0.f, 0.f};
                for (int p = 0; p < 64; ++p) { const float a = XSr[t * 65 + p], bb = XSi[t * 65 + p]; const f32x4 cr = *(const f32x4*)(CTr + p * 16 + oq * 4), ci = *(const f32x4*)(CTi + p * 16 + oq * 4);
                    y[0] += a * cr.x - bb * ci.x; y[1] += a * cr.y - bb * ci.y; y[2] += a * cr.z - bb * ci.z; y[3] += a * cr.w - bb * ci.w; }
                float z[4];
#pragma unroll
                for (int e = 0; e < 4; ++e) z[e] = gelu_tanh(y[e] + dsk[e] * UU[t * 16 + oq * 4 + e]);
                u32x2 o; o.x = pk2(z[0], z[1]); o.y = pk2(z[2], z[3]);
                *(u32x2*)(Z + ((size_t)b * SEQ + t0 + t) * D + g * 16 + oq * 4) = o; }
        }
    }
}
template <int CTRL> __device__ __forceinline__ float dpp_mov(float v) { return __builtin_bit_cast(float, __builtin_amdgcn_update_dpp(0, __builtin_bit_cast(int, v), CTRL, 0xf, 0xf, true)); }
__device__ __forceinline__ float sum8(float v) { v += dpp_mov<0xB1>(v); v += dpp_mov<0x4E>(v); v += dpp_mov<0x141>(v); return v; }
__device__ __forceinline__ float wave_sum_fast(float v) { v += dpp_mov<0xB1>(v); v += dpp_mov<0x4E>(v); v += dpp_mov<0x141>(v); v += dpp_mov<0x140>(v); v += __shfl_xor(v, 16); v += __shfl_xor(v, 32); return v; }
__device__ __forceinline__ float fast_tanh(float x) { const float e = __expf(2.f * x); return 1.f - 2.f * __builtin_amdgcn_rcpf(e + 1.f); }
__device__ __forceinline__ void rwkv_lora_prep(const Ctx& c, const bf16* __restrict__ H, const float* __restrict__ mu, bf16* LX) {
    const int l = c.lane;
    const int per = (M + c.ngw - 1) / c.ngw;
    const int mA = c.gw * per, mE = (mA + per < M) ? mA + per : M;
    if (l < 36 && mA < M) {
        const int col = 3952 + 8 * l;
        const f32x4 m0 = *(const f32x4*)(mu + 3072 + 8 * l), m1 = *(const f32x4*)(mu + 3072 + 8 * l + 4);
        const float mv[8] = {m0.x, m0.y, m0.z, m0.w, m1.x, m1.y, m1.z, m1.w};
        float p[8];
        if ((mA % SEQ) > 0) unpack8(*(const u32x4*)(H + (size_t)(mA - 1) * HC + col), p); else {
#pragma unroll
            for (int j = 0; j < 8; ++j) p[j] = 0.f; }
#pragma unroll 1
        for (int mb = mA; mb < mE; mb += 8) {
            u32x4 rq[8];
#pragma unroll
            for (int i = 0; i < 8; ++i) { const int mm = (mb + i < mE) ? mb + i : mE - 1; rq[i] = *(const u32x4*)(H + (size_t)mm * HC + col); }
#pragma unroll
            for (int i = 0; i < 8; ++i) { const int m = mb + i;
                if (m < mE) {
                    float x[8]; unpack8(rq[i], x);
                    if ((m % SEQ) == 0) {
#pragma unroll
                        for (int j = 0; j < 8; ++j) p[j] = 0.f; }
                    float hm[8];
#pragma unroll
                    for (int j = 0; j < 8; ++j) { float v = x[j] + (p[j] - x[j]) * mv[j]; if (l < 8) v = fast_tanh(v); else if (l >= 16) v = sigmoidf_(v); hm[j] = v; p[j] = x[j]; }
                    u32x4 o; o.x = pg8::cvt_pk_bf16(hm[0], hm[1]); o.y = pg8::cvt_pk_bf16(hm[2], hm[3]); o.z = pg8::cvt_pk_bf16(hm[4], hm[5]); o.w = pg8::cvt_pk_bf16(hm[6], hm[7]);
                    *(u32x4*)(LX + (size_t)m * 288 + 8 * l) = o;
                }
            }
        }
    }
}
constexpr int RW2_RAWP = 384;
constexpr int RW2_TWP = 144, RW2_SGP = 336;
__device__ __forceinline__ void rwkv_phase2(const Ctx& c, const bf16* __restrict__ H, const bf16* __restrict__ LX, const RwkvP P, bf16* OUT, int ldo, int coloff, int wb = NB) {
    unsigned char* RAW = c.lds;
    float* A_WR = (float*)(c.lds + 12800);
    float* A_K2 = A_WR + 2048; float* A_V = A_K2 + 2048; float* A_W = A_V + 2048; float* A_NKK = A_W + 2048; float* A_B = A_NKK + 2048; float* A_G = A_B + 2048; float* A_OUT = A_G + 2048;
    float* LO_W = A_OUT + 2048; float* LO_A = LO_W + 2048; float* PR3 = LO_A + 2048;
    unsigned char* L_TW = (unsigned char*)(PR3 + 2048); unsigned char* L_AL = L_TW + 32 * RW2_TWP; unsigned char* L_SG = L_AL + 32 * RW2_TWP;
    float* MU = (float*)(L_SG + 32 * RW2_SGP); float* SC3 = MU + 480 + 64;
    unsigned char* G2T = (unsigned char*)(SC3 + 32);
    float* SCP = (float*)(G2T + 64 * RW2_SGP);
    float* GN = SCP + 128; float* CST = GN + 64;
    float* PR0 = (float*)L_TW; float* PR1 = PR0 + 2048; float* PR2 = A_OUT;
    const int l = c.lane, w = c.wave, n16 = l & 15, g = l >> 4;
#pragma unroll 1
    for (int item = c.bid; item < NB * 16; item += c.nb) {
        const int b = item >> 4, h = item & 15, hk = h * 64 + l;
        __syncthreads();
        if (w < 7) { const float* src = w == 0 ? P.w0 : w == 1 ? P.a0 : w == 2 ? P.k_k : w == 3 ? P.k_a : w == 4 ? P.r_k : w == 5 ? P.ln_w : P.ln_b; CST[w * 64 + l] = src[hk]; }
#pragma unroll 1
        for (int qb = 0; qb < 20; qb += 5) {
            float gq[5];
#pragma unroll
            for (int q = 0; q < 5; ++q) { const int i = c.tid + NTHR * (qb + q); gq[q] = P.g2[(size_t)(i >> 6) * 1024 + h * 64 + (i & 63)]; }
#pragma unroll
            for (int q = 0; q < 5; ++q) { const int i = c.tid + NTHR * (qb + q); *(unsigned short*)(G2T + (i & 63) * RW2_SGP + (i >> 6) * 2) = (unsigned short)f2bf(gq[q]); }
        }
        for (int i = c.tid; i < 192; i += NTHR) { const int mi = i < 64 ? h * 64 + i : i < 128 ? 1024 + h * 64 + (i - 64) : 2048 + h * 64 + (i - 128); MU[i] = P.mu[mi]; }
        const int tt = w >> 2, nt = w & 3;
        bf16x8 W2B[2], A2B[2];
        { const int kc = h * 64 + 16 * nt + n16;
          auto ldfrag = [&](const float* Wp, int kk) -> bf16x8 { float f[8]; int gq = g, kq = kc; asm volatile("" : "+v"(gq), "+v"(kq));
              const float* wp = Wp + (size_t)(32 * kk + 8 * gq) * 1024 + kq;
#pragma unroll
              for (int q = 0; q < 8; ++q) f[q] = wp[q * 1024];
              u32x4 u; u.x = pk2(f[0], f[1]); u.y = pk2(f[2], f[3]); u.z = pk2(f[4], f[5]); u.w = pk2(f[6], f[7]);
              asm volatile("" : "+v"(u));
              return __builtin_bit_cast(bf16x8, u); };
          W2B[0] = ldfrag(P.w2, 0); W2B[1] = ldfrag(P.w2, 1); A2B[0] = ldfrag(P.a2, 0); A2B[1] = ldfrag(P.a2, 1);
        }
        f32x2 S[4];
#pragma unroll
        for (int i = 0; i < 4; ++i) S[i] = (f32x2){0.f, 0.f};
        const int srow = w * 8 + (l >> 3), sj = l & 7;
        u32x4 raw[4];
#define RW2_LOAD(T0) do { _Pragma("unroll") for (int k = 0; k < 4; ++k) { const int q_ = c.tid + 512 * k; \
            const int cq_ = q_ % 24; int tg = (T0) - 1 + q_ / 24; tg = tg < 0 ? 0 : tg; const int rc_ = (cq_ < 8 ? 880 : cq_ < 16 ? 1904 - 64 : 2928 - 128) + h * 64 + cq_ * 8; \
            int e_ = q_ - 792; e_ = (e_ < 0 || e_ >= 1152) ? 0 : e_; \
            const bf16* src_ = (q_ < 792) ? H + ((size_t)b * SEQ + tg) * HC + rc_ : LX + ((size_t)b * SEQ + (T0) + e_ / 36) * 288 + (e_ % 36) * 8; \
            raw[k] = *(const u32x4*)src_; } } while (0)
        RW2_LOAD(0);
#pragma unroll 1
        for (int t0 = 0; t0 < SEQ; t0 += 32) {
            __syncthreads();
#pragma unroll
            for (int k = 0; k < 4; ++k) { const int q_ = c.tid + 512 * k;
                if (q_ < 792) *(u32x4*)(RAW + (q_ / 24) * RW2_RAWP + (q_ % 24) * 16) = (t0 == 0 && q_ < 24) ? (u32x4){0u, 0u, 0u, 0u} : raw[k];
                else if (q_ < 1944) { const int e_ = q_ - 792, t_ = e_ / 36, p_ = e_ % 36;
                    unsigned char* d_ = p_ < 8 ? L_TW + t_ * RW2_TWP + p_ * 16 : p_ < 16 ? L_AL + t_ * RW2_TWP + (p_ - 8) * 16 : L_SG + t_ * RW2_SGP + (p_ - 16) * 16; *(u32x4*)d_ = raw[k]; } }
            { const int tn_ = (t0 + 32 < SEQ) ? t0 + 32 : t0; RW2_LOAD(tn_); }
            __syncthreads();
            if (c.tid < 384) {
                const int cpi = c.tid % 96, qb = c.tid / 96, cp = cpi * 2, tb = qb * 8;
                const float mu0 = MU[cp], mu1 = MU[cp + 1];
                unsigned xb = *(const unsigned*)(RAW + tb * RW2_RAWP + cp * 2);
                float p0 = bf2f(xb & 0xffffu), p1 = bf2f(xb >> 16);
                float* dst = (cp < 64 ? A_WR + cp : cp < 128 ? A_K2 + (cp - 64) : A_V + (cp - 128)) + tb * 64;
#pragma unroll
                for (int t = 0; t < 8; ++t) { const unsigned xa = *(const unsigned*)(RAW + (tb + t + 1) * RW2_RAWP + cp * 2); const float x0 = bf2f(xa & 0xffffu), x1 = bf2f(xa >> 16);
                    *(f32x2*)(dst + t * 64) = (f32x2){x0 + (p0 - x0) * mu0, x1 + (p1 - x1) * mu1}; p0 = x0; p1 = x1; }
            }
            __syncthreads();
            {
                f32x4 aw = (f32x4){0.f, 0.f, 0.f, 0.f}, aa = aw, ag = aw;
#pragma unroll
                for (int kk = 0; kk < 2; ++kk) { const bf16x8 At = *(const bf16x8*)(L_TW + (16 * tt + n16) * RW2_TWP + (32 * kk + 8 * g) * 2), Aa = *(const bf16x8*)(L_AL + (16 * tt + n16) * RW2_TWP + (32 * kk + 8 * g) * 2);
                    aw = __builtin_amdgcn_mfma_f32_16x16x32_bf16(At, W2B[kk], aw, 0, 0, 0); aa = __builtin_amdgcn_mfma_f32_16x16x32_bf16(Aa, A2B[kk], aa, 0, 0, 0); }
#pragma unroll
                for (int kk = 0; kk < 5; ++kk) { const bf16x8 Ag = *(const bf16x8*)(L_SG + (16 * tt + n16) * RW2_SGP + (32 * kk + 8 * g) * 2); const bf16x8 Gb = *(const bf16x8*)(G2T + (16 * nt + n16) * RW2_SGP + (32 * kk + 8 * g) * 2); ag = __builtin_amdgcn_mfma_f32_16x16x32_bf16(Ag, Gb, ag, 0, 0, 0); }
#pragma unroll
                for (int r = 0; r < 4; ++r) { const int o = (16 * tt + 4 * g + r) * 64 + 16 * nt + n16; LO_W[o] = aw[r]; LO_A[o] = aa[r]; A_G[o] = ag[r]; }
            }
            __syncthreads();
#pragma unroll 2
            for (int i = 0; i < 4; ++i) {
                const int t = w + 8 * i, o = t * 64 + l;
                const float w0v = CST[l], a0v = CST[64 + l], kkv = CST[128 + l], kav = CST[192 + l], rkv = CST[256 + l];
                const float dec = __expf(-0.6065306597126334f * sigmoidf_(w0v + LO_W[o]));
                const float a = sigmoidf_(a0v + LO_A[o]);
                const float kr = A_K2[o], r = A_WR[o];
                const float kk0 = kr * kkv, k2 = kr * (1.f + (a - 1.f) * kav), bb0 = kk0 * a, k2r = k2 * r;
                A_W[o] = dec; A_NKK[o] = -kk0; A_B[o] = bb0; A_K2[o] = k2; A_WR[o] = dec * r;
                PR0[o] = kk0 * kk0; PR1[o] = bb0 * r; PR2[o] = k2r; PR3[o] = k2r * rkv;
            }
            __syncthreads();
            {
                const int t = c.tid >> 4, q = (c.tid >> 2) & 3, qu = c.tid & 3;
                const float* src = (q == 0 ? PR0 : q == 1 ? PR1 : q == 2 ? PR2 : PR3) + t * 64 + 16 * qu;
                const f32x4 v0 = *(const f32x4*)src, v1 = *(const f32x4*)(src + 4), v2 = *(const f32x4*)(src + 8), v3 = *(const f32x4*)(src + 12);
                float sm = ((v0.x + v0.y) + (v0.z + v0.w)) + ((v1.x + v1.y) + (v1.z + v1.w)) + ((v2.x + v2.y) + (v2.z + v2.w)) + ((v3.x + v3.y) + (v3.z + v3.w));
                sm += dpp_mov<0xB1>(sm); sm += dpp_mov<0x4E>(sm);
                if (qu == 0) SCP[t * 4 + q] = (q == 0) ? 1.0f / fmaxf(sm, 1e-24f) : sm;
            }
            __syncthreads();
            {
                f32x4 n0, n1, r0, r1, w0_, w1_, b0, b1, k0, k1, sp; float vv;
                const unsigned char* pk_ = (const unsigned char*)A_WR + 32 * sj;
                const unsigned char* pv_ = (const unsigned char*)A_WR + 4 * srow;
                const unsigned char* ps_ = (const unsigned char*)SCP;
                constexpr int O_WR = 0, O_K2 = 8192, O_V = 16384, O_W = 24576, O_NKK = 32768, O_B = 40960, O_OUT = 57344;
#define RW2_LD_DOT(T) do { n0 = *(const f32x4*)(pk_ + O_NKK + (T) * 256); n1 = *(const f32x4*)(pk_ + O_NKK + (T) * 256 + 16); r0 = *(const f32x4*)(pk_ + O_WR + (T) * 256); r1 = *(const f32x4*)(pk_ + O_WR + (T) * 256 + 16); } while (0)
#define RW2_LD_UPD(T) do { w0_ = *(const f32x4*)(pk_ + O_W + (T) * 256); w1_ = *(const f32x4*)(pk_ + O_W + (T) * 256 + 16); b0 = *(const f32x4*)(pk_ + O_B + (T) * 256); b1 = *(const f32x4*)(pk_ + O_B + (T) * 256 + 16); \
                    k0 = *(const f32x4*)(pk_ + O_K2 + (T) * 256); k1 = *(const f32x4*)(pk_ + O_K2 + (T) * 256 + 16); vv = *(const float*)(pv_ + O_V + (T) * 256); sp = *(const f32x4*)(ps_ + (T) * 16); } while (0)
#define RW2_STEP(T) do { \
                    f32x2 sa2 = S[0] * (f32x2){n0.x, n0.y}; sa2 = S[1] * (f32x2){n0.z, n0.w} + sa2; sa2 = S[2] * (f32x2){n1.x, n1.y} + sa2; sa2 = S[3] * (f32x2){n1.z, n1.w} + sa2; \
                    f32x2 p2 = S[0] * (f32x2){r0.x, r0.y}; p2 = S[1] * (f32x2){r0.z, r0.w} + p2; p2 = S[2] * (f32x2){r1.x, r1.y} + p2; p2 = S[3] * (f32x2){r1.z, r1.w} + p2; \
                    __builtin_amdgcn_sched_barrier(0); RW2_LD_DOT((T) + 1); __builtin_amdgcn_sched_barrier(0); \
                    const float sa = sum8(sa2.x + sa2.y) * sp.x, p = sum8(p2.x + p2.y); \
                    const f32x2 sav = (f32x2){sa, sa}, vvv = (f32x2){vv, vv}; \
                    S[0] = S[0] * (f32x2){w0_.x, w0_.y} + (sav * (f32x2){b0.x, b0.y} + vvv * (f32x2){k0.x, k0.y}); \
                    S[1] = S[1] * (f32x2){w0_.z, w0_.w} + (sav * (f32x2){b0.z, b0.w} + vvv * (f32x2){k0.z, k0.w}); \
                    S[2] = S[2] * (f32x2){w1_.x, w1_.y} + (sav * (f32x2){b1.x, b1.y} + vvv * (f32x2){k1.x, k1.y}); \
                    S[3] = S[3] * (f32x2){w1_.z, w1_.w} + (sav * (f32x2){b1.z, b1.w} + vvv * (f32x2){k1.z, k1.w}); \
                    const float ov = p + sa * sp.y + vv * sp.z; \
                    __builtin_amdgcn_sched_barrier(0); RW2_LD_UPD((T) + 1); *(float*)(const_cast<unsigned char*>(pv_) + O_OUT + (T) * 256) = ov;        __builtin_amdgcn_sched_barrier(0); } while (0)
                RW2_LD_DOT(0); RW2_LD_UPD(0);
#pragma unroll 1
                for (int t4 = 0; t4 < 8; ++t4) {
                    RW2_STEP(0); RW2_STEP(1); RW2_STEP(2); RW2_STEP(3);
                    pk_ += 1024; pv_ += 1024; ps_ += 64;
                }
#undef RW2_LD_DOT
#undef RW2_LD_UPD
#undef RW2_STEP
            }
            __syncthreads();
            {
                const int t = c.tid >> 3, q = (c.tid >> 2) & 1, qu = c.tid & 3;
                if (c.tid < 256) {
                    const float* src = A_OUT + t * 64 + 16 * qu; float sm = 0.f;
#pragma unroll
                    for (int e = 0; e < 4; ++e) { const f32x4 v = *(const f32x4*)(src + 4 * e); sm += q ? ((v.x * v.x + v.y * v.y) + (v.z * v.z + v.w * v.w)) : ((v.x + v.y) + (v.z + v.w)); }
                    sm += dpp_mov<0xB1>(sm); sm += dpp_mov<0x4E>(sm);
                    const float other = dpp_mov<0x141>(sm);
                    if ((c.tid & 7) == 0) { const float mean = sm * (1.f / 64.f), var = fmaxf(other * (1.f / 64.f) - mean * mean, 0.f); GN[t * 2] = mean; GN[t * 2 + 1] = 1.0f / sqrtf(var + 64e-5f); }
                }
            }
            __syncthreads();
#pragma unroll
            for (int i = 0; i < 4; ++i) {
                const int t = w + 8 * i, o = t * 64 + l;
                float y = (A_OUT[o] - GN[t * 2]) * GN[t * 2 + 1] * CST[320 + l] + CST[384 + l];
                y = (y + SCP[t * 4 + 3] * A_V[o]) * A_G[o];
                if (b < wb) OUT[((size_t)b * SEQ + t0 + t) * ldo + coloff + hk] = (bf16)f2bf(y);
            }
        }
#undef RW2_LOAD
    }
}
constexpr int S5B_BUP = 132 * 4, S5B_XP = 272;
constexpr int S5B_WAVE = 16 * S5B_BUP + 16 * S5B_XP;
__device__ __forceinline__ void wave_lds_sync() { __builtin_amdgcn_fence(__ATOMIC_RELEASE, "wavefront"); __builtin_amdgcn_wave_barrier(); __builtin_amdgcn_fence(__ATOMIC_ACQUIRE, "wavefront"); }
__device__ __forceinline__ float gelu_fast(float y) { const float u2 = 1.5957691216057308f * (y + 0.044715f * y * y * y); return y * __builtin_amdgcn_rcpf(1.f + __expf(-u2)); }
__device__ __forceinline__ void s5_phase2(const Ctx& c, const bf16* __restrict__ U, const S5P P, bf16* Z) {
    if (c.wave >= 4) return;
    float* BU = (float*)(c.lds + c.wave * S5B_WAVE); unsigned char* XB = c.lds + c.wave * S5B_WAVE + 16 * S5B_BUP;
    const int l = c.lane, n16 = l & 15, g = l >> 4;
#pragma unroll 1
    for (int item = c.bid; item < 256; item += c.nb) {
        const int b = item >> 5, grp = (item & 31) * 4 + c.wave;
        float lbr, lbi;
        { const float lr = fminf(P.lam_re[grp * 64 + l], -1e-4f), li = P.lam_im[grp * 64 + l], dt = expf(P.log_dt[grp]);
          const float e = expf(lr * dt); lbr = e * cosf(li * dt); lbi = e * sinf(li * dt);
          const float nr = lbr - 1.f, ni = lbi, den = 1.f / (lr * lr + li * li);
          BU[l] = (nr * lr + ni * li) * den; BU[64 + l] = (ni * lr - nr * li) * den; }
        wave_lds_sync();
        bf16x4 Bre[4], Bim[4];
#pragma unroll
        for (int nt = 0; nt < 4; ++nt) { const int p = 16 * nt + n16; const float cr = BU[p], ci = BU[64 + p];
            const f32x4 br = *(const f32x4*)(P.b_re + (size_t)(grp * 64 + p) * 16 + 4 * g), bi = *(const f32x4*)(P.b_im + (size_t)(grp * 64 + p) * 16 + 4 * g);
            u32x2 wr, wi; wr.x = pk2(cr * br.x - ci * bi.x, cr * br.y - ci * bi.y); wr.y = pk2(cr * br.z - ci * bi.z, cr * br.w - ci * bi.w);
            wi.x = pk2(cr * bi.x + ci * br.x, cr * bi.y + ci * br.y); wi.y = pk2(cr * bi.z + ci * br.z, cr * bi.w + ci * br.w);
            Bre[nt] = __builtin_bit_cast(bf16x4, wr); Bim[nt] = __builtin_bit_cast(bf16x4, wi); }
        wave_lds_sync();
        bf16x8 Cf[4];
#pragma unroll
        for (int kk = 0; kk < 4; ++kk) { const int p0 = 16 * kk + 4 * g;
            const f32x4 vr = *(const f32x4*)(P.c_re + (size_t)(grp * 16 + n16) * 64 + p0), vi = *(const f32x4*)(P.c_im + (size_t)(grp * 16 + n16) * 64 + p0);
            u32x4 w; w.x = pk2(vr.x, -vi.x); w.y = pk2(vr.y, -vi.y); w.z = pk2(vr.z, -vi.z); w.w = pk2(vr.w, -vi.w); Cf[kk] = __builtin_bit_cast(bf16x8, w); }
        bf16x4 Df; { const float dsk = P.d[grp * 16 + n16]; const int kq = n16 - 4 * g; u32x2 w; w.x = pk2(kq == 0 ? dsk : 0.f, kq == 1 ? dsk : 0.f); w.y = pk2(kq == 2 ? dsk : 0.f, kq == 3 ? dsk : 0.f); Df = __builtin_bit_cast(bf16x4, w); }
        f32x2 xs = (f32x2){0.f, 0.f};
        const bf16* ub = U + (size_t)b * SEQ * D + grp * 16;
        u32x2 ua[4];
#define S5B_LOAD(k, T0) do { ua[k] = *(const u32x2*)(ub + (size_t)((T0) + n16) * D + 4 * g); } while (0)
#pragma unroll
        for (int k = 0; k < 4; ++k) S5B_LOAD(k, 16 * k);
#pragma unroll 1
        for (int t0 = 0; t0 < SEQ; t0 += 64) {
#pragma unroll
            for (int k = 0; k < 4; ++k) {
                const int tb = t0 + 16 * k;
                const bf16x4 A = __builtin_bit_cast(bf16x4, ua[k]);
                { const int tn = (tb + 64 < SEQ) ? tb + 64 : tb; S5B_LOAD(k, tn); }
                const f32x4 yd = __builtin_amdgcn_mfma_f32_16x16x16bf16_1k(A, Df, (f32x4){0.f, 0.f, 0.f, 0.f}, 0, 0, 0);
#pragma unroll
                for (int nt = 0; nt < 4; ++nt) {
                    const f32x4 ar = __builtin_amdgcn_mfma_f32_16x16x16bf16_1k(A, Bre[nt], (f32x4){0.f, 0.f, 0.f, 0.f}, 0, 0, 0);
                    const f32x4 ai = __builtin_amdgcn_mfma_f32_16x16x16bf16_1k(A, Bim[nt], (f32x4){0.f, 0.f, 0.f, 0.f}, 0, 0, 0);
#pragma unroll
                    for (int r = 0; r < 4; ++r) *(f32x2*)(BU + (4 * g + r) * 132 + 2 * (16 * nt + n16)) = (f32x2){ar[r], ai[r]};
                }
                wave_lds_sync();
#pragma unroll 4
                for (int t = 0; t < 16; ++t) {
                    const f32x2 bu = *(const f32x2*)(BU + t * 132 + 2 * l);
                    const f32x2 tq = (f32x2){lbr, lbr} * xs + bu;
                    xs = (f32x2){-lbi, lbi} * (f32x2){xs.y, xs.x} + tq;
                    *(unsigned*)(XB + t * S5B_XP + l * 4) = pg8::cvt_pk_bf16(xs.x, xs.y);
                }
                wave_lds_sync();
                f32x4 y = (f32x4){0.f, 0.f, 0.f, 0.f};
#pragma unroll
                for (int kk = 0; kk < 4; ++kk) { const bf16x8 Ax = *(const bf16x8*)(XB + n16 * S5B_XP + (32 * kk + 8 * g) * 2); y = __builtin_amdgcn_mfma_f32_16x16x32_bf16(Ax, Cf[kk], y, 0, 0, 0); }
#pragma unroll
                for (int r = 0; r < 4; ++r) Z[((size_t)b * SEQ + tb + 4 * g + r) * D + grp * 16 + n16] = (bf16)f2bf(gelu_fast(y[r] + yd[r]));
                wave_lds_sync();
            }
        }
#undef S5B_LOAD
    }
}
struct Args { const void* in[45]; float* out; unsigned char* ws; int ph_lo, ph_hi; };
static_assert(sizeof(Args) == 45 * 8 + 8 + 8 + 8, "Args has no padding");
constexpr int PH_EVEN = 9, PH_ODD = 4, PH_COMMON = 13;
constexpr int NPHASES = 2 * (1 + PH_EVEN + PH_COMMON) + 2 * (1 + PH_ODD + PH_COMMON) + 1;

__global__ void __launch_bounds__(NTHR, 2) mega(Args args) {
    extern __shared__ __attribute__((aligned(16))) unsigned char lds[];
    volatile LAS unsigned* MISC = (volatile LAS unsigned*)((LAS unsigned char*)lds + MISC_OFF);
    if (threadIdx.x < 64) MISC[threadIdx.x] = 0u;
    __syncthreads();
    unsigned char* ws = args.ws;
    XcdBarrier bar = xcd_barrier_post((unsigned*)(ws + WS_CTL) + 4096, MISC + 8, gridDim.x);
    const int half = (int)gridDim.x >> 1;
    XcdBarrier bar2 = bar; if ((int)blockIdx.x >= half) bar2 = xcd_barrier_post((unsigned*)(ws + WS_CTL) + 8192, MISC + 10, gridDim.x - half);
    const int lo = args.ph_lo, hi = args.ph_hi;
    int pid = 0;
#define PH_BEGIN if (pid >= lo && pid < hi) { Ctx c; { int t_ = threadIdx.x, b_ = blockIdx.x; asm volatile("" : "+v"(t_)); asm volatile("" : "+s"(b_)); c.lds = lds; c.tid = t_; c.lane = t_ & 63; c.wave = __builtin_amdgcn_readfirstlane(t_ >> 6); c.bid = b_; { int n_ = gridDim.x; asm volatile("" : "+s"(n_)); c.nb = n_; } c.gw = c.bid * NWAVES + c.wave; c.ngw = c.nb * NWAVES; }
#define PH_END } if (pid >= lo && pid + 1 < hi) { xcd_barrier(bar); if (DBL & 2048) xcd_barrier(bar); } ++pid;
#define IN_F(i) (*(const float* const __attribute__((address_space(4)))*)(KARGS() + 8 * (i)))

    typedef const unsigned char __attribute__((address_space(4)))* kptr_t;
#define KARGS() ({ kptr_t p_ = (kptr_t)__builtin_amdgcn_kernarg_segment_ptr(); asm volatile("" : "+s"(p_)); p_; })
#define WSP(off) ((*(unsigned char* const __attribute__((address_space(4)))*)(KARGS() + 368)) + (off))
#define X ((float*)(*(float* const __attribute__((address_space(4)))*)(KARGS() + 360)))
#define ROPEA ((float*)WSP(WS_ROPEA))
#define ROPEI ((float*)WSP(WS_ROPEI))
#define KVBIG ((bf16*)WSP(WS_KVBIG))
#define WKV ((bf16*)WSP(WS_WKV))
#define W_IN ((bf16*)WSP(WS_WMIX + WMIX_IN))
#define WQ ((bf16*)WSP(WS_WMIX + WMIX_Q))
#define WOUT ((bf16*)WSP(WS_WMIX + WMIX_OUT))
#define WO_IN ((bf16*)WSP(WS_WMIX + WMIX_O_IN))
#define WO_GLU ((bf16*)WSP(WS_WMIX + WMIX_O_GLU))
#define WO_OUT ((bf16*)WSP(WS_WMIX + WMIX_O_OUT))
#define WXQ ((bf16*)WSP(WS_WXQ))
#define WXO ((bf16*)WSP(WS_WXO))
#define WUP ((bf16*)WSP(WS_WUP))
#define WDN ((bf16*)WSP(WS_WDN))
#define CQN ((bf16*)WSP(WS_CQN))
#define KF ((bf16*)WSP(WS_KF))
#define KIDX ((bf16*)WSP(WS_KIDX))
#define WIDX ((float*)WSP(WS_WIDX))
#define SEL ((bf16*)WSP(WS_SEL))
#define Hb ((bf16*)WSP(WS_R1))
#define SC ((float*)WSP(WS_R1))
#define HID ((bf16*)WSP(WS_R1))
#define Ub ((bf16*)WSP(WS_R1))
#define YC ((bf16*)WSP(WS_R1 + (size_t)M * D * 2))
#define XN ((bf16*)WSP(WS_R2))
#define QALL ((bf16*)X)
#define OLY ((bf16*)WSP(WS_R3))
#define Zb ((bf16*)WSP(WS_R3))
#define XQ ((bf16*)WSP(WS_R3))
#define XO ((bf16*)WSP(WS_R3 + (size_t)M * 512 * 2))
#define MEMN ((bf16*)WSP(WS_R3))
    LAS unsigned char* glds = (LAS unsigned char*)lds;

#define RS_A ((unsigned long long*)WSP(WS_CTL + 131072))
#define RS_B ((unsigned long long*)WSP(WS_CTL + 393216))
#define RS_C ((unsigned long long*)WSP(WS_CTL + 655360))
    for (int layer = 0; layer < DEPTH; ++layer) {
        const int li = layer >> 1;
        PH_BEGIN
            if ((layer & 1) == 0) {
                conv_mat(c, IN_F(13) + (size_t)li * 2048 * EVEN_COLS, 2048, EVEN_COLS, EVEN_COLS, HC, W_IN, 2048, 0, 0, IN_F(3) + layer * D);
                build_wql(c, IN_F(18) + (size_t)li * 512 * 1024, IN_F(19) + (size_t)li * 256 * 768, WQ);
                for (int h = 0; h < 8; ++h) conv_mat(c, IN_F(18) + (size_t)li * 512 * 1024 + h * 128, 512, 1024, 32, 32, WQ, 512, 2048 + h * 32, 0);
                conv_mat(c, IN_F(21) + (size_t)li * 512 * 1024, 512, 1024, 1024, 1024, WQ, 512, 2304, 0);
                build_wout(c, IN_F(20) + (size_t)li * 256 * 1024, IN_F(14) + (size_t)li * 2048 * 2048, WOUT);
                conv_mat(c, IN_F(14) + (size_t)li * 2048 * 2048 + (size_t)1024 * 2048, 1024, 2048, 2048, 2048, WOUT, OC, 0, 2048);
            } else {
                conv_mat(c, IN_F(33) + (size_t)li * 2048 * 2048, 2048, 2048, 2048, 2048, WO_IN, 2048, 0, 0, IN_F(3) + layer * D);
                conv_mat(c, IN_F(43) + (size_t)li * 2048 * 2048, 2048, 2048, 2048, 2048, WO_GLU, 2048, 0, 0);
                conv_mat(c, IN_F(34) + (size_t)li * 2048 * 2048, 2048, 2048, 2048, 2048, WO_OUT, 2048, 0, 0);
            }
            conv_mat(c, IN_F(8) + (size_t)layer * 2048 * 512, 2048, 512, 512, 512, WXQ, 2048, 0, 0, IN_F(4) + layer * D);
            conv_mat(c, IN_F(10) + (size_t)layer * 512 * 2048, 512, 2048, 2048, 2048, WXO, 512, 0, 0);
            { unsigned long long* ra = RS_A; unsigned long long* rb = RS_B; for (int i = c.bid * NTHR + c.tid; i < M; i += c.nb * NTHR) { ra[i] = 0ull; rb[i] = 0ull; } }
            if (layer == 0) {
                for (int l2 = 0; l2 < 4; ++l2) {
                    conv_mat(c, IN_F(9) + (size_t)l2 * 2048 * 1024, 2048, 1024, 1024, 1024, WKV, 2048, l2 * 1024, 0);
                    norm_rows_bf16(c, IN_F(1), IN_F(5) + l2 * D, MEMN + (size_t)l2 * MEMR * D, MEMR);
                }
                rope_tables(c, (const int*)IN_F(2), ROPEA, ROPEI);
                cast_rows_ss(c, IN_F(0), XN, RS_C, M);
            }
        PH_END
        if ((layer & 1) == 0) {
            PH_BEGIN
                { pg8::Gemm g{XN, W_IN, 2048, 2048, 2048}; pg8::StaticOrder S; S.init(128, HC / 256, c.nb, c.bid); pg8::EpiBf16<0> E{Hb, HC, RS_C};
                  pg8::gemm_phase<pg8::EpiBf16<0>, pg8::StaticOrder, true, true>(glds, g, S, E);
                  if (DBL & 1024) { __syncthreads(); pg8::gemm_phase<pg8::EpiBf16<0>, pg8::StaticOrder, true, true>(glds, g, S, E); } }
                if (layer == 0) { __syncthreads(); pg8::Gemm g{MEMN, WKV, 2048, 2048, 2048}; pg8::KvOrder S{c.nb, c.bid}; pg8::EpiBf16<0> E{KVBIG, 4096, nullptr};
                  pg8::gemm_phase<pg8::EpiBf16<0>, pg8::KvOrder, true, true>(glds, g, S, E); }
            PH_END
            PH_BEGIN
                rwkv_lora_prep(c, Hb, IN_F(22) + li * B_COLS, (bf16*)WSP(WS_END + 96 * MiB));
            PH_END
            PH_BEGIN
                if (c.bid < half) {
                    Ctx r = c; r.nb = half; r.ngw = half * NWAVES;
                    const RwkvP P{IN_F(22) + li * B_COLS, IN_F(23) + li * 1024, IN_F(24) + (size_t)li * 65536, IN_F(25) + li * 1024, IN_F(26) + (size_t)li * 65536, IN_F(27) + (size_t)li * 163840,
                                  IN_F(28) + li * 1024, IN_F(29) + li * 1024, IN_F(30) + li * 1024, IN_F(31) + li * 1024, IN_F(32) + li * 1024};
#if DIAG == 4
                    rwkv_phase(r, Hb, P, OLY);
                    rwkv_phase2(r, Hb, (const bf16*)WSP(WS_END + 96 * MiB), P, (bf16*)WSP(WS_END + 116 * MiB), 1024, 0, 1);
#else
                    rwkv_phase2(r, Hb, (const bf16*)WSP(WS_END + 96 * MiB), P, OLY, OC, 2048);
#endif
                    __syncthreads();
                    conv_mat(r, IN_F(12) + (size_t)layer * FFN * 2048, FFN, 2048, 2048, 2048, WDN, FFN, 0, 0);
                } else {
                    Ctx d = c; d.bid = c.bid - half; d.nb = c.nb - half; d.gw = d.bid * NWAVES + d.wave; d.ngw = d.nb * NWAVES;
                    dsa_prep(d, Hb, IN_F(15) + li * 512, IN_F(16) + li * 256, IN_F(17) + li * 64, ROPEA, ROPEI, CQN, KF, KIDX, WIDX);
                    xcd_barrier(bar2);
                    { pg8::Gemm g{CQN, WQ, 512, 512, 512}; pg8::StaticOrder S; S.init(128, QC / 256, d.nb, d.bid); pg8::EpiBf16<0> E{QALL, QC, nullptr};
                      pg8::gemm_phase<pg8::EpiBf16<0>, pg8::StaticOrder, true, true>(glds, g, S, E); }
                    xcd_barrier(bar2);
                    idx_topk_mfma(d, QALL, KIDX, WIDX, ROPEI, (float*)(d.bid < 32 ? WSP(WS_CQN + (size_t)d.bid * MiB) : WSP(WS_END + (size_t)(d.bid - 32) * MiB)), SEL, 256);
                    conv_mat(d, IN_F(11) + (size_t)layer * 2048 * FFN, 2048, FFN, FFN, FFN, WUP, 2048, 0, 0, IN_F(6) + layer * D);
                    xcd_barrier(bar2);
                    if (d.bid == 0 && c.tid == 0) __hip_atomic_store((unsigned*)WSP(WS_CTL) + 12288 + 64 * (2 + li), 1u, __ATOMIC_RELAXED, __HIP_MEMORY_SCOPE_AGENT);
                }
                if (c.bid < half) {
                    if (c.tid == 0) { unsigned* fl = (unsigned*)WSP(WS_CTL) + 12288 + 64 * (2 + li); unsigned sp = 0;
                        while (__hip_atomic_load(fl, __ATOMIC_RELAXED, __HIP_MEMORY_SCOPE_AGENT) == 0u) { __builtin_amdgcn_s_sleep(8); if (++sp > (1u << 22)) break; } }
                    __syncthreads();
                    __builtin_amdgcn_fence(__ATOMIC_ACQUIRE, "agent"); asm volatile("s_waitcnt vmcnt(0)" ::: "memory");
                }
                dsa_attn_queue(c, QALL, KF, SEL, ROPEA, OLY, (unsigned*)WSP(WS_CTL) + 12288 + 64 * li, MISC + 12);
            PH_END
#if DBL & 32
            PH_BEGIN
                if (c.bid < half) {
                    Ctx r = c; r.nb = half; r.ngw = half * NWAVES;
                    const RwkvP P{IN_F(22) + li * B_COLS, IN_F(23) + li * 1024, IN_F(24) + (size_t)li * 65536, IN_F(25) + li * 1024, IN_F(26) + (size_t)li * 65536, IN_F(27) + (size_t)li * 163840,
                                  IN_F(28) + li * 1024, IN_F(29) + li * 1024, IN_F(30) + li * 1024, IN_F(31) + li * 1024, IN_F(32) + li * 1024};
                    rwkv_phase2(r, Hb, (const bf16*)WSP(WS_END + 96 * MiB), P, OLY, OC, 2048);
                }
            PH_END
#endif
#if DBL & 8
            PH_BEGIN
                if (c.bid >= half) {
                    Ctx d = c; d.bid = c.bid - half; d.nb = c.nb - half; d.gw = d.bid * NWAVES + d.wave; d.ngw = d.nb * NWAVES;
                    idx_topk_mfma(d, QALL, KIDX, WIDX, ROPEI, (float*)(d.bid < 32 ? WSP(WS_CQN + (size_t)d.bid * MiB) : WSP(WS_END + (size_t)(d.bid - 32) * MiB)), SEL, 256);
                }
            PH_END
#endif
#if DIAG == 4
            PH_BEGIN
                diag_cmp_bf16(c, OLY + 2048, OC, (bf16*)WSP(WS_END + 116 * MiB), 1024, SEQ, 1024, (float*)WSP(WS_CTL + 65536));
            PH_END
#endif
#if DIAG == 7 || DIAG == 8
            PH_BEGIN
                q_rope_fix(c, QALL, ROPEA, ROPEI);
            PH_END
#endif
#if DIAG == 7
            PH_BEGIN
                if (c.bid >= half) { Ctx d = c; d.bid = c.bid - half; d.nb = c.nb - half; d.gw = d.bid * NWAVES + d.wave; d.ngw = d.nb * NWAVES;
                    idx_topk_v1(d, QALL, KIDX, WIDX, (float*)(d.bid < 32 ? WSP(WS_CQN + (size_t)d.bid * MiB) : WSP(WS_END + (size_t)(d.bid - 32) * MiB)), (bf16*)WSP(WS_END + 116 * MiB), 128); }
            PH_END
            PH_BEGIN
                diag_cmp_sel(c, SEL, (bf16*)WSP(WS_END + 116 * MiB), 4, (float*)WSP(WS_CTL + 65536));
            PH_END
#endif
#if DIAG == 8
            PH_BEGIN
                dsa_attn_simple(c, QALL, KF, SEL, (bf16*)WSP(WS_END + 116 * MiB), 1024);
            PH_END
            PH_BEGIN
                diag_cmp_bf16(c, OLY, OC, (bf16*)WSP(WS_END + 116 * MiB), OC, 1024, 2048, (float*)WSP(WS_CTL + 65536));
            PH_END
#endif
            PH_BEGIN
                { pg8::Gemm g{OLY, WOUT, OC, OC, OC}; pg8::StaticOrder S; S.init(128, 8, c.nb, c.bid); pg8::EpiRes E{XN, D, RS_A};
                  pg8::gemm_phase<pg8::EpiRes, pg8::StaticOrder, true, true>(glds, g, S, E); }
            PH_END
        } else {
            PH_BEGIN
                { pg8::Gemm g{XN, WO_IN, 2048, 2048, 2048}; pg8::StaticOrder S; S.init(128, 8, c.nb, c.bid); pg8::EpiBf16<0> E{Ub, D, RS_C};
                  pg8::gemm_phase<pg8::EpiBf16<0>, pg8::StaticOrder, true, true>(glds, g, S, E);
                  if (DBL & 1024) { __syncthreads(); pg8::gemm_phase<pg8::EpiBf16<0>, pg8::StaticOrder, true, true>(glds, g, S, E); } }
            PH_END
            PH_BEGIN
                { const S5P P{IN_F(35) + li * 8192, IN_F(36) + li * 8192, IN_F(37) + li * 128, IN_F(38) + (size_t)li * 131072, IN_F(39) + (size_t)li * 131072, IN_F(40) + (size_t)li * 131072, IN_F(41) + (size_t)li * 131072, IN_F(42) + li * D};
                  s5_phase2(c, Ub, P, Zb); }
                if (c.wave >= 4) {
                    Ctx v = c; v.lds = c.lds + 65536 - 4 * 8704; v.gw = c.bid * 4 + (c.wave - 4); v.ngw = c.nb * 4;
                    conv_mat(v, IN_F(11) + (size_t)layer * 2048 * FFN, 2048, FFN, FFN, FFN, WUP, 2048, 0, 0, IN_F(6) + layer * D);
                    conv_mat(v, IN_F(12) + (size_t)layer * FFN * 2048, FFN, 2048, 2048, 2048, WDN, FFN, 0, 0);
                }
            PH_END
#if DIAG == 5
            PH_BEGIN
                { const S5P P{IN_F(35) + li * 8192, IN_F(36) + li * 8192, IN_F(37) + li * 128, IN_F(38) + (size_t)li * 131072, IN_F(39) + (size_t)li * 131072, IN_F(40) + (size_t)li * 131072, IN_F(41) + (size_t)li * 131072, IN_F(42) + li * D};
                  s5_phase(c, Ub, P, YC); }
            PH_END
            PH_BEGIN
                diag_cmp_bf16(c, YC, D, Zb, D, M, D, (float*)WSP(WS_CTL + 65536));
            PH_END
#endif
            PH_BEGIN
                { pg8::Gemm g{Zb, WO_GLU, 2048, 2048, 2048}; pg8::StaticOrder S; S.init(128, 8, c.nb, c.bid); pg8::EpiGlu E{Zb, YC, D, IN_F(44) + li * D};
                  pg8::gemm_phase<pg8::EpiGlu, pg8::StaticOrder, true, true>(glds, g, S, E); }
            PH_END
            PH_BEGIN
                { pg8::Gemm g{YC, WO_OUT, 2048, 2048, 2048}; pg8::StaticOrder S; S.init(128, 8, c.nb, c.bid); pg8::EpiRes E{XN, D, RS_A};
                  pg8::gemm_phase<pg8::EpiRes, pg8::StaticOrder, true, true>(glds, g, S, E); }
            PH_END
        }
        PH_BEGIN
            { unsigned long long* rc = RS_C; for (int i = c.bid * NTHR + c.tid; i < M; i += c.nb * NTHR) rc[i] = 0ull; }
            { pg8::Gemm g{XN, WXQ, 2048, 2048, 2048}; pg8::StaticOrder S; S.init(128, 2, c.nb, c.bid); pg8::EpiBf16<0> E{XQ, 512, RS_A};
              pg8::gemm_phase<pg8::EpiBf16<0>, pg8::StaticOrder, true, true>(glds, g, S, E); }
        PH_END
        PH_BEGIN
            xattn_mfma(c, XQ, KVBIG, layer, XO); if (DBL & 128) { asm volatile("" ::: "memory"); xattn_mfma(c, XQ, KVBIG, layer, XO); }
        PH_END
        PH_BEGIN
            { pg8::Gemm g{XO, WXO, 512, 512, 512}; pg8::StaticOrder S; S.init(128, 8, c.nb, c.bid); pg8::EpiRes E{XN, D, RS_B};
              pg8::gemm_phase<pg8::EpiRes, pg8::StaticOrder, true, true>(glds, g, S, E); }
        PH_END
        for (int q = 0; q < 5; ++q) {
            PH_BEGIN
                if (q > 0) { const int qd = q - 1; bf16* hid = HID + (size_t)(qd & 1) * 8192 * FFN;
                    pg8::Gemm g{hid, WDN, FFN, FFN, FFN}; pg8::StaticOrder S; S.init(32, 8, c.nb, c.bid); pg8::EpiRes E{XN + (size_t)qd * 8192 * D, D, RS_C + qd * 8192};
                    pg8::gemm_phase<pg8::EpiRes, pg8::StaticOrder, true, true>(glds, g, S, E); __syncthreads(); }
                if (q < 4) { bf16* hid = HID + (size_t)(q & 1) * 8192 * FFN;
                    pg8::Gemm g{XN + (size_t)q * 8192 * D, WUP, 2048, 2048, 2048}; pg8::StaticOrder S; S.init(32, 32, c.nb, c.bid); pg8::EpiBf16<1> E{hid, FFN, RS_B + q * 8192};
                    pg8::gemm_phase<pg8::EpiBf16<1>, pg8::StaticOrder, true, true>(glds, g, S, E); }
            PH_END
        }
    }
    PH_BEGIN
        scale_rows_out(c, XN, IN_F(7), RS_C, X, M);
    PH_END
#if DIAG
    PH_BEGIN
        { const float* dg = (const float*)WSP(WS_CTL + 65536); const float sc = 1.f + sqrtf(100.f * dg[0] / fmaxf(dg[1], 1e-30f));
          float* xo = X; for (size_t i = (size_t)c.bid * NTHR + c.tid; i < (size_t)M * D; i += (size_t)c.nb * NTHR) xo[i] *= sc; }
    PH_END
#endif
#undef PH_BEGIN
#undef PH_END
#undef IN_F
#undef X
}

extern "C" void kernel_launch(void* const* d_in, const int* in_sizes, int n_in, void* d_out, int out_size, void* d_ws, size_t ws_size, hipStream_t stream) {
    static int grid = 0;
    if (grid == 0) {
        if (n_in != 45 || out_size != M * D || ws_size < WS_END + 116 * MiB) { fprintf(stderr, "kernel_launch: unexpected shapes (n_in %d, out %d, ws %zu, need %zu)\n", n_in, out_size, ws_size, (size_t)WS_END); grid = -1; return; }
        int dev = 0, cus = 0, per_cu = 0;
        if (hipGetDevice(&dev) != hipSuccess || hipDeviceGetAttribute(&cus, hipDeviceAttributeMultiprocessorCount, dev) != hipSuccess) { grid = -1; return; }
        if (hipFuncSetAttribute((const void*)mega, hipFuncAttributeMaxDynamicSharedMemorySize, LDS_BYTES) != hipSuccess) { fprintf(stderr, "kernel_launch: hipFuncSetAttribute failed\n"); grid = -1; return; }
        if (hipOccupancyMaxActiveBlocksPerMultiprocessor(&per_cu, (const void*)mega, NTHR, LDS_BYTES) != hipSuccess || per_cu < 1) fprintf(stderr, "kernel_launch: occupancy query reports %d\n", per_cu);
        (void)hipGetLastError();
        grid = cus;
    }
    if (grid < 0) return;
    (void)hipMemsetAsync((char*)d_ws + WS_CTL, 0, CTL_BYTES, stream);
    Args a{};
    for (int i = 0; i < 45; ++i) a.in[i] = d_in[i];
    a.out = (float*)d_out; a.ws = (unsigned char*)d_ws;
#if MK_ONE_LAUNCH
    a.ph_lo = 0; a.ph_hi = 1 << 20;
    hipLaunchKernelGGL(mega, dim3(grid), dim3(NTHR), LDS_BYTES, stream, a);
#else
    for (int p = 0; p < NPHASES; ++p) { a.ph_lo = p; a.ph_hi = p + 1; hipLaunchKernelGGL(mega, dim3(grid), dim3(NTHR), LDS_BYTES, stream, a); }
#endif
}
```

```cpp
#include <hip/hip_runtime.h>
#include <cstdio>
#include <cstdint>

#ifndef DIAG
#define DIAG 0
#endif
#ifndef ATTN_SPLIT
#define ATTN_SPLIT 0
#endif
#ifndef DBL
#define DBL 0
#endif
#ifndef MK_ONE_LAUNCH
#define MK_ONE_LAUNCH 1
#endif

constexpr int D = 2048, NB = 8, SEQ = 4096, M = NB * SEQ, DEPTH = 4;
constexpr int HC = 4352;
constexpr int EVEN_COLS = 4240, A_COLS = 880, B_COLS = 3360;
constexpr int QC = 3328;
constexpr int OC = 3072;
constexpr int KFW = 288;
constexpr int FFN = 8192;
constexpr int MEMR = NB * 256;
constexpr float NORM_EPS = 1e-5f;
constexpr size_t SC_PER_BATCH = (size_t)4096 * 64 * 65 / 2;

typedef unsigned short bf16;
typedef float f32x4 __attribute__((ext_vector_type(4)));
typedef unsigned u32x4 __attribute__((ext_vector_type(4)));
typedef unsigned u32x2 __attribute__((ext_vector_type(2)));
typedef float f32x2 __attribute__((ext_vector_type(2)));
#define LAS __attribute__((address_space(3)))

constexpr size_t MiB = 1u << 20;
constexpr size_t al256(size_t x) { return (x + 255) & ~(size_t)255; }
constexpr size_t WS_CTL = 0, CTL_BYTES = 1 * MiB;
constexpr size_t WS_ROPEA = WS_CTL + CTL_BYTES;
constexpr size_t WS_ROPEI = WS_ROPEA + (size_t)M * 32 * 4;
constexpr size_t WS_KVBIG = WS_ROPEI + (size_t)M * 16 * 4;
constexpr size_t WS_WKV = WS_KVBIG + (size_t)8192 * 4096 * 2;
constexpr size_t WS_WMIX = WS_WKV + (size_t)4096 * 2048 * 2;
constexpr size_t WMIX_IN = 0, WMIX_Q = (size_t)HC * 2048 * 2, WMIX_OUT = WMIX_Q + (size_t)QC * 512 * 2, WMIX_BYTES = WMIX_OUT + (size_t)2048 * OC * 2;
constexpr size_t WMIX_O_IN = 0, WMIX_O_GLU = (size_t)2048 * 2048 * 2, WMIX_O_OUT = 2 * WMIX_O_GLU;
constexpr size_t WS_WXQ = al256(WS_WMIX + WMIX_BYTES);
constexpr size_t WS_WXO = WS_WXQ + (size_t)512 * 2048 * 2;
constexpr size_t WS_WUP = WS_WXO + (size_t)2048 * 512 * 2;
constexpr size_t WS_WDN = WS_WUP + (size_t)FFN * 2048 * 2;
constexpr size_t WS_CQN = WS_WDN + (size_t)2048 * FFN * 2;
constexpr size_t WS_KF = WS_CQN + (size_t)M * 512 * 2;
constexpr size_t WS_KIDX = WS_KF + (size_t)M * KFW * 2;
constexpr size_t WS_WIDX = WS_KIDX + (size_t)M * 64 * 2;
constexpr size_t WS_SEL = WS_WIDX + (size_t)M * 16 * 4;
constexpr size_t WS_R1 = al256(WS_SEL + (size_t)M * 256 * 2);
constexpr size_t R1_BYTES = (size_t)M * HC * 2;
constexpr size_t WS_R2 = WS_R1 + R1_BYTES;
constexpr size_t R2_BYTES = (size_t)M * QC * 2;
constexpr size_t WS_R3 = WS_R2 + R2_BYTES;
constexpr size_t R3_BYTES = (size_t)M * OC * 2;
constexpr size_t WS_END = WS_R3 + R3_BYTES;
static_assert(SC_PER_BATCH * NB * 4 <= R1_BYTES, "scores fit R1");
static_assert((size_t)8192 * FFN * 2 <= R1_BYTES && (size_t)M * 2048 * 2 * 2 <= R1_BYTES, "R1 overlays");

__device__ __forceinline__ float bf2f(unsigned v) { return __uint_as_float(v << 16); }
__device__ __forceinline__ unsigned f2bf(float f) { unsigned u = __float_as_uint(f); return (u + 0x7fffu + ((u >> 16) & 1u)) >> 16; }
__device__ __forceinline__ unsigned pk2(float lo, float hi) { return f2bf(lo) | (f2bf(hi) << 16); }
__device__ __forceinline__ float wave_sum(float v) {
#pragma unroll
    for (int o = 1; o < 64; o <<= 1) v += __shfl_xor(v, o);
    return v;
}
__device__ __forceinline__ float wave_max(float v) {
#pragma unroll
    for (int o = 1; o < 64; o <<= 1) v = fmaxf(v, __shfl_xor(v, o));
    return v;
}
__device__ __forceinline__ void unpack8(const u32x4 w, float* f) {
    f[0] = __uint_as_float(w.x << 16); f[1] = __uint_as_float(w.x & 0xffff0000u); f[2] = __uint_as_float(w.y << 16); f[3] = __uint_as_float(w.y & 0xffff0000u);
    f[4] = __uint_as_float(w.z << 16); f[5] = __uint_as_float(w.z & 0xffff0000u); f[6] = __uint_as_float(w.w << 16); f[7] = __uint_as_float(w.w & 0xffff0000u);
}
__device__ __forceinline__ float sigmoidf_(float x) { return __builtin_amdgcn_rcpf(1.f + __expf(-x)); }
namespace pg8 {
#define PG8_LAS __attribute__((address_space(3)))
typedef unsigned short bf16_t;
typedef short bf16x8 __attribute__((ext_vector_type(8)));
typedef float f32x4 __attribute__((ext_vector_type(4)));
typedef unsigned u32x4 __attribute__((ext_vector_type(4)));
constexpr int BM = 256, BK = 64, HALF = 128, HTB = HALF * BK * 2, STAGE_BYTES = 8 * HTB, NXCD = 8, WGM = 8;

__host__ __device__ __forceinline__ int lds_byte(int r, int c) { const int st = (r >> 4) * 2 + (c >> 5), rr = r & 15, cc = c & 31, ob = rr * 64 + cc * 2; return st * 1024 + (ob ^ (((ob >> 9) & 1) << 5)); }
__host__ __device__ __forceinline__ void stage_rc(int b, int& R, int& C) { const int st = b / 1024, sb = b % 1024, swz = sb ^ (((sb >> 9) & 1) << 5); R = (st >> 1) * 16 + swz / 64; C = (st & 1) * 32 + (swz % 64) / 2; }
__host__ __device__ __forceinline__ int perm32(int rho) { const int n = rho >> 4, i = rho & 15; return 8 * (i >> 2) + 4 * n + (i & 3); }

struct Unit { int pm, pn; };
struct Gemm { const bf16_t* A; const bf16_t* Bt; int lda, ldb, K, pad; };

struct StaticOrder {
    int nM, nN, nwg, G, c;
    __host__ __device__ void init(int nM_, int nN_, int G_, int c_) { nM = nM_; nN = nN_; nwg = nM * nN; G = G_; c = c_; }
    __host__ __device__ bool next(int i, Unit& u) const {
        const long L = (long)i * G + c; if (L >= nwg) return false;
        int wgid = (int)L; { const int q = nwg / NXCD, r = nwg % NXCD, xcd = wgid % NXCD, off = wgid / NXCD; wgid = (xcd < r ? xcd * (q + 1) : r * (q + 1) + (xcd - r) * q) + off; }
        const int nig = WGM * nN, gid = wgid / nig, fm = gid * WGM, gsz = (nM - fm) < WGM ? (nM - fm) : WGM;
        u.pm = fm + ((wgid % nig) % gsz); u.pn = (wgid % nig) / gsz; return true;
    }
    __device__ __forceinline__ void a_ready(const Unit&) const {}
    __device__ __forceinline__ void done(const Unit&) const {}
};
struct KvOrder {
    int G, c;
    __device__ bool next(int i, Unit& u) const { const int L = i * G + c; if (L >= 128) return false; const int ly = L >> 5, r = L & 31; u.pm = ly * 8 + (r & 7); u.pn = ly * 4 + (r >> 3); return true; }
    __device__ __forceinline__ void a_ready(const Unit&) const {}
    __device__ __forceinline__ void done(const Unit&) const {}
};

__device__ __forceinline__ unsigned cvt_pk_bf16(float lo, float hi) { unsigned r; asm volatile("v_cvt_pk_bf16_f32 %0, %1, %2" : "=v"(r) : "v"(lo), "v"(hi)); return r; }

template <int ACT> struct EpiBf16 {
    static constexpr bool PERM = true, AFTER_DRAIN = false;
    bf16_t* O; int ldc; const unsigned long long* rowss;
    __device__ __forceinline__ void operator()(const f32x4 (&acc)[2][2][4][2], const Unit& u, int wr, int wc, int fr, int fq) const {
        const int row0 = u.pm * BM + wr * 64 + fr; const int col0 = u.pn * BM + wc * 32 + 8 * fq;
        unsigned long long rq[2][4];
#pragma unroll
        for (int ai = 0; ai < 2; ++ai)
#pragma unroll
            for (int m = 0; m < 4; ++m) rq[ai][m] = rowss ? rowss[row0 + ai * HALF + m * 16] : 0ull;
        if (rowss) asm volatile("" : "+v"(rq[0][0]), "+v"(rq[0][1]), "+v"(rq[0][2]), "+v"(rq[0][3]), "+v"(rq[1][0]), "+v"(rq[1][1]), "+v"(rq[1][2]), "+v"(rq[1][3]));
#pragma unroll
        for (int ai = 0; ai < 2; ++ai)
#pragma unroll
            for (int m = 0; m < 4; ++m) { bf16_t* rowp = O + (size_t)(row0 + ai * HALF + m * 16) * ldc + col0;
                const float rs = rowss ? __builtin_amdgcn_rsqf((float)rq[ai][m] * (5.9604644775390625e-08f / 2048.f) + 1e-5f) : 1.f;
#pragma unroll
                for (int bj = 0; bj < 2; ++bj) { f32x4 v0 = acc[ai][bj][m][0] * rs, v1 = acc[ai][bj][m][1] * rs;
                    if (ACT == 1) {
#pragma unroll
                        for (int j = 0; j < 4; ++j) { const float a = fmaxf(v0[j], 0.f), b = fmaxf(v1[j], 0.f); v0[j] = a * a; v1[j] = b * b; } }
                    u32x4 w; w.x = cvt_pk_bf16(v0[0], v0[1]); w.y = cvt_pk_bf16(v0[2], v0[3]); w.z = cvt_pk_bf16(v1[0], v1[1]); w.w = cvt_pk_bf16(v1[2], v1[3]);
                    *(u32x4*)(rowp + bj * HALF) = w; } }
    }
};
struct EpiRes {
    static constexpr bool PERM = false, AFTER_DRAIN = false;
    bf16_t* xb; int ldc; unsigned long long* rowss;
    __device__ __forceinline__ void operator()(const f32x4 (&acc)[2][2][4][2], const Unit& u, int wr, int wc, int fr, int fq) const {
        typedef unsigned u32x2_ __attribute__((ext_vector_type(2)));
        const int row0 = u.pm * BM + wr * 64 + fr, col0 = u.pn * BM + wc * 32 + 4 * fq;
#pragma unroll
        for (int ai = 0; ai < 2; ++ai) {
            u32x2_ bv[4][2][2];
#pragma unroll
            for (int m = 0; m < 4; ++m) { const bf16_t* rp = xb + (size_t)(row0 + ai * HALF + m * 16) * ldc + col0;
#pragma unroll
                for (int bj = 0; bj < 2; ++bj)
#pragma unroll
                    for (int n = 0; n < 2; ++n) bv[m][bj][n] = *(const u32x2_*)(rp + bj * HALF + n * 16); }
#pragma unroll
            for (int m = 0; m < 4; ++m) { bf16_t* rp = xb + (size_t)(row0 + ai * HALF + m * 16) * ldc + col0; float ss = 0.f;
#pragma unroll
                for (int bj = 0; bj < 2; ++bj)
#pragma unroll
                    for (int n = 0; n < 2; ++n) { const u32x2_ b = bv[m][bj][n]; f32x4 x = acc[ai][bj][m][n];
                        x[0] += __uint_as_float(b.x << 16); x[1] += __uint_as_float(b.x & 0xffff0000u); x[2] += __uint_as_float(b.y << 16); x[3] += __uint_as_float(b.y & 0xffff0000u);
                        u32x2_ w; w.x = cvt_pk_bf16(x[0], x[1]); w.y = cvt_pk_bf16(x[2], x[3]); *(u32x2_*)(rp + bj * HALF + n * 16) = w;
                        const float r0 = __uint_as_float(w.x << 16), r1 = __uint_as_float(w.x & 0xffff0000u), r2 = __uint_as_float(w.y << 16), r3 = __uint_as_float(w.y & 0xffff0000u);
                        ss += (r0 * r0 + r1 * r1) + (r2 * r2 + r3 * r3); }
                ss += __shfl_xor(ss, 16); ss += __shfl_xor(ss, 32);
                if (fq == 0) atomicAdd(rowss + row0 + ai * HALF + m * 16, (unsigned long long)(ss * 16777216.0f)); }
            asm volatile("" ::: "memory"); }
    }
};
struct EpiGlu {
    static constexpr bool PERM = true, AFTER_DRAIN = false;
    const bf16_t* Z; bf16_t* O; int ldc; const float* bias;
    __device__ __forceinline__ void operator()(const f32x4 (&acc)[2][2][4][2], const Unit& u, int wr, int wc, int fr, int fq) const {
        const int row0 = u.pm * BM + wr * 64 + fr; const int col0 = u.pn * BM + wc * 32 + 8 * fq;
        f32x4 bv[2][2];
#pragma unroll
        for (int bj = 0; bj < 2; ++bj)
#pragma unroll
            for (int n = 0; n < 2; ++n) bv[bj][n] = *(const f32x4*)(bias + col0 + bj * HALF + 4 * n);
#pragma unroll
        for (int ai = 0; ai < 2; ++ai) {
            u32x4 zq[4][2];
#pragma unroll
            for (int m = 0; m < 4; ++m)
#pragma unroll
                for (int bj = 0; bj < 2; ++bj) zq[m][bj] = *(const u32x4*)(Z + (size_t)(row0 + ai * HALF + m * 16) * ldc + col0 + bj * HALF);
#pragma unroll
            for (int m = 0; m < 4; ++m) { const size_t off = (size_t)(row0 + ai * HALF + m * 16) * ldc + col0;
#pragma unroll
                for (int bj = 0; bj < 2; ++bj) { const f32x4 v0 = acc[ai][bj][m][0] + bv[bj][0], v1 = acc[ai][bj][m][1] + bv[bj][1];
                    const u32x4 zz = zq[m][bj]; float z[8], o[8];
                    z[0] = __uint_as_float(zz.x << 16); z[1] = __uint_as_float(zz.x & 0xffff0000u); z[2] = __uint_as_float(zz.y << 16); z[3] = __uint_as_float(zz.y & 0xffff0000u);
                    z[4] = __uint_as_float(zz.z << 16); z[5] = __uint_as_float(zz.z & 0xffff0000u); z[6] = __uint_as_float(zz.w << 16); z[7] = __uint_as_float(zz.w & 0xffff0000u);
#pragma unroll
                    for (int j = 0; j < 4; ++j) { o[j] = z[j] * __builtin_amdgcn_rcpf(1.f + __expf(-v0[j])); o[4 + j] = z[4 + j] * __builtin_amdgcn_rcpf(1.f + __expf(-v1[j])); }
                    u32x4 w; w.x = cvt_pk_bf16(o[0], o[1]); w.y = cvt_pk_bf16(o[2], o[3]); w.z = cvt_pk_bf16(o[4], o[5]); w.w = cvt_pk_bf16(o[6], o[7]);
                    *(u32x4*)(O + off + bj * HALF) = w; } }
            asm volatile("" ::: "memory"); }
    }
};

template <class Epi, class Sched, bool ALIGN_EPI = false, bool SP2 = false>
__device__ __forceinline__ void gemm_phase(PG8_LAS unsigned char* lds, const Gemm g, const Sched& S, const Epi& E) {
    int tid_l = threadIdx.x; asm volatile("" : "+v"(tid_l));
    const int tid = tid_l, wid = __builtin_amdgcn_readfirstlane(tid >> 6), lane = tid & 63, wr = wid >> 2, wc = wid & 3, fr = lane & 15, fq = lane >> 4;
    const int K = g.K, nt = K / BK;
    unsigned voffA[2], voffB[2];
#pragma unroll
    for (int i = 0; i < 2; ++i) { int R, C; stage_rc(tid * 16 + i * 8192, R, C); const int Rb = Epi::PERM ? ((R & ~31) + perm32(R & 31)) : R;
        voffA[i] = (unsigned)(R * g.lda + C) * 2u; voffB[i] = (unsigned)(Rb * g.ldb + C) * 2u; }
    const size_t kstep = (size_t)(BK * 2);
    const size_t hstepA = (size_t)HALF * g.lda * 2, hstepB = (size_t)HALF * g.ldb * 2;
    const size_t tstepA = 2 * hstepA, tstepB = 2 * hstepB;
    const unsigned ldsw = (unsigned)wid * 1024u;
    const int aoff = lds_byte(wr * 64 + fr, fq * 8), boff = lds_byte(wc * 32 + fr, fq * 8);
#define PG8_SA(b, h) (((b) * 2 + (h)) * HTB)
#define PG8_SB(b, h) ((4 + (b) * 2 + (h)) * HTB)
#define PG8_STAGE(bufoff, gbase, voff) do { _Pragma("unroll") for (int _i = 0; _i < 2; ++_i) \
        __builtin_amdgcn_global_load_lds((const unsigned*)((const char*)(gbase) + (voff)[_i]), (PG8_LAS unsigned*)(lds + (bufoff) + ldsw + _i * 8192), 16, 0, 0); } while (0)
#define PG8_LDA(dst, b, h) do { _Pragma("unroll") for (int m = 0; m < 4; ++m) _Pragma("unroll") for (int k = 0; k < 2; ++k) dst[m][k] = *(const PG8_LAS bf16x8*)(lds + PG8_SA(b, h) + aoff + m * 2048 + k * 1024); } while (0)
#define PG8_LDB(dst, b, h) do { _Pragma("unroll") for (int n = 0; n < 2; ++n) _Pragma("unroll") for (int k = 0; k < 2; ++k) dst[n][k] = *(const PG8_LAS bf16x8*)(lds + PG8_SB(b, h) + boff + n * 2048 + k * 1024); } while (0)
#define PG8_MMA(ai, bj, At, Bt) do { __builtin_amdgcn_s_setprio(1); _Pragma("unroll") for (int m = 0; m < 4; ++m) _Pragma("unroll") for (int n = 0; n < 2; ++n) _Pragma("unroll") for (int k = 0; k < 2; ++k) \
        acc[ai][bj][m][n] = __builtin_amdgcn_mfma_f32_16x16x32_bf16(Bt[n][k], At[m][k], acc[ai][bj][m][n], 0, 0, 0); __builtin_amdgcn_s_setprio(0); } while (0)
#define PG8_WAIT_V(n) asm volatile("s_waitcnt vmcnt(" #n ")" ::: "memory")
#define PG8_WAIT_L(n) asm volatile("s_waitcnt lgkmcnt(" #n ")" ::: "memory")
#define PG8_BAR __builtin_amdgcn_s_barrier()
#define PG8_SCHED __builtin_amdgcn_sched_barrier(0)
    Unit cur, nxt; int ui = 0;
    if (!S.next(0, cur)) return;
    f32x4 acc[2][2][4][2];
#pragma unroll
    for (int a = 0; a < 2; ++a)
#pragma unroll
        for (int b = 0; b < 2; ++b)
#pragma unroll
            for (int m = 0; m < 4; ++m)
#pragma unroll
                for (int n = 0; n < 2; ++n) acc[a][b][m][n] = (f32x4){0.f, 0.f, 0.f, 0.f};
    bf16x8 At[4][2], B0[2][2], B1[2][2];
    const char* cA = (const char*)g.A + (size_t)cur.pm * tstepA; const char* cB = (const char*)g.Bt + (size_t)cur.pn * tstepB;
    S.a_ready(cur);
    if constexpr (SP2) {
        PG8_STAGE(PG8_SB(0, 0), cB, voffB); PG8_STAGE(PG8_SB(0, 1), cB + hstepB, voffB); PG8_STAGE(PG8_SA(0, 0), cA, voffA); PG8_STAGE(PG8_SA(0, 1), cA + hstepA, voffA);
        if (wr == 1) PG8_BAR;
        PG8_WAIT_V(2); PG8_BAR;
        PG8_STAGE(PG8_SB(1, 0), cB + kstep, voffB); PG8_STAGE(PG8_SA(1, 0), cA + kstep, voffA); PG8_STAGE(PG8_SB(1, 1), cB + hstepB + kstep, voffB);
        PG8_WAIT_V(6); PG8_BAR;
    } else {
        PG8_STAGE(PG8_SB(0, 0), cB, voffB); PG8_STAGE(PG8_SA(0, 0), cA, voffA); PG8_STAGE(PG8_SB(0, 1), cB + hstepB, voffB); PG8_STAGE(PG8_SA(0, 1), cA + hstepA, voffA);
        if (wr == 1) PG8_BAR;
        PG8_WAIT_V(4); PG8_BAR;
        PG8_STAGE(PG8_SB(1, 0), cB + kstep, voffB); PG8_STAGE(PG8_SA(1, 0), cA + kstep, voffA); PG8_STAGE(PG8_SB(1, 1), cB + hstepB + kstep, voffB);
        PG8_WAIT_V(6); PG8_BAR;
    }
    for (;;) {
        const bool has_next = S.next(ui + 1, nxt);
        const char* nA = has_next ? (const char*)g.A + (size_t)nxt.pm * tstepA : cA; const char* nB = has_next ? (const char*)g.Bt + (size_t)nxt.pn * tstepB : cB;
        for (int t = 0; t < nt; t += 2) {
            const bool last = (t == nt - 2);
            const char* a1 = cA + (size_t)(t + 1) * kstep;
            const char* a2 = last ? nA : cA + (size_t)(t + 2) * kstep; const char* b2 = last ? nB : cB + (size_t)(t + 2) * kstep;
            const char* a3 = a2 + kstep; const char* b3 = b2 + kstep;
            if (last && has_next) S.a_ready(nxt);
            if constexpr (SP2) {
            PG8_LDB(B0, 0, 0); PG8_LDB(B1, 0, 1); PG8_SCHED; PG8_LDA(At, 0, 0); PG8_STAGE(PG8_SA(1, 1), a1 + hstepA, voffA);
            PG8_WAIT_V(8); PG8_WAIT_L(0); PG8_BAR; PG8_MMA(0, 0, At, B0); PG8_MMA(0, 1, At, B1); PG8_BAR; PG8_SCHED;
            PG8_LDA(At, 0, 1); PG8_STAGE(PG8_SB(0, 0), b2, voffB); PG8_STAGE(PG8_SB(0, 1), b2 + hstepB, voffB); PG8_STAGE(PG8_SA(0, 0), a2, voffA);
            PG8_WAIT_V(8); PG8_WAIT_L(0); PG8_BAR; PG8_MMA(1, 0, At, B0); PG8_MMA(1, 1, At, B1); PG8_BAR; PG8_SCHED;
            PG8_LDB(B0, 1, 0); PG8_LDB(B1, 1, 1); PG8_SCHED; PG8_LDA(At, 1, 0); PG8_STAGE(PG8_SA(0, 1), a2 + hstepA, voffA);
            PG8_WAIT_V(8); PG8_WAIT_L(0); PG8_BAR; PG8_MMA(0, 0, At, B0); PG8_MMA(0, 1, At, B1); PG8_BAR; PG8_SCHED;
            PG8_LDA(At, 1, 1); PG8_STAGE(PG8_SB(1, 0), b3, voffB); PG8_STAGE(PG8_SB(1, 1), b3 + hstepB, voffB); PG8_STAGE(PG8_SA(1, 0), a3, voffA);
            PG8_WAIT_V(8); PG8_WAIT_L(0); PG8_BAR; PG8_MMA(1, 0, At, B0); PG8_MMA(1, 1, At, B1); PG8_BAR; PG8_SCHED;
            } else {
            PG8_LDB(B0, 0, 0); PG8_SCHED; PG8_LDA(At, 0, 0); PG8_STAGE(PG8_SA(1, 1), a1 + hstepA, voffA);
            PG8_WAIT_L(8); PG8_BAR; PG8_WAIT_L(0); PG8_MMA(0, 0, At, B0); PG8_BAR; PG8_SCHED;
            PG8_LDB(B1, 0, 1); PG8_STAGE(PG8_SB(0, 0), b2, voffB);
            PG8_BAR; PG8_WAIT_L(0); PG8_MMA(0, 1, At, B1); PG8_BAR;
            PG8_LDA(At, 0, 1); PG8_STAGE(PG8_SA(0, 0), a2, voffA);
            PG8_BAR; PG8_WAIT_L(0); PG8_MMA(1, 0, At, B0); PG8_BAR; PG8_SCHED;
            PG8_STAGE(PG8_SB(0, 1), b2 + hstepB, voffB);
            PG8_WAIT_V(6); PG8_BAR; PG8_MMA(1, 1, At, B1); PG8_BAR;
            PG8_LDB(B0, 1, 0); PG8_SCHED; PG8_LDA(At, 1, 0); PG8_STAGE(PG8_SA(0, 1), a2 + hstepA, voffA);
            PG8_WAIT_L(8); PG8_BAR; PG8_WAIT_L(0); PG8_MMA(0, 0, At, B0); PG8_BAR; PG8_SCHED;
            PG8_LDB(B1, 1, 1); PG8_STAGE(PG8_SB(1, 0), b3, voffB);
            PG8_BAR; PG8_WAIT_L(0); PG8_MMA(0, 1, At, B1); PG8_BAR;
            PG8_LDA(At, 1, 1); PG8_STAGE(PG8_SA(1, 0), a3, voffA);
            PG8_BAR; PG8_WAIT_L(0); PG8_MMA(1, 0, At, B0); PG8_BAR; PG8_SCHED;
            PG8_STAGE(PG8_SB(1, 1), b3 + hstepB, voffB);
            PG8_WAIT_V(6); PG8_BAR; PG8_MMA(1, 1, At, B1); PG8_BAR;
            }
        }
        if constexpr (ALIGN_EPI) { if (wr == 0) PG8_BAR; }
        E(acc, cur, wr, wc, fr, fq); S.done(cur);
        if (!has_next) break;
#pragma unroll
        for (int a = 0; a < 2; ++a)
#pragma unroll
            for (int b = 0; b < 2; ++b)
#pragma unroll
                for (int m = 0; m < 4; ++m)
#pragma unroll
                    for (int n = 0; n < 2; ++n) acc[a][b][m][n] = (f32x4){0.f, 0.f, 0.f, 0.f};
        cur = nxt; cA = nA; cB = nB; ++ui;
        if constexpr (ALIGN_EPI) { if (wr == 1) PG8_BAR; }
    }
    PG8_WAIT_V(0);
    if constexpr (!ALIGN_EPI) { if (wr == 0) PG8_BAR; }
    PG8_BAR;
#undef PG8_SA
#undef PG8_SB
#undef PG8_STAGE
#undef PG8_LDA
#undef PG8_LDB
#undef PG8_MMA
#undef PG8_WAIT_V
#undef PG8_WAIT_L
#undef PG8_BAR
#undef PG8_SCHED
}
}
#define XB_TMO      128
#define XB_XCNT(j)  (256  + 64 * (j))
#define XB_XSUB(j)  (1280 + 64 * (j))
#define XB_XGEN(j)  (2304 + 64 * (j))
#define XB_TOP      3328
#define XB_TOPGEN   3392
#define XCD_BAR_WORDS 3456
#define XB_SPIN_CAP (1u << 18)
__device__ __forceinline__ unsigned xb_ld(unsigned* p)              { return __hip_atomic_load(p, __ATOMIC_RELAXED, __HIP_MEMORY_SCOPE_AGENT); }
__device__ __forceinline__ unsigned xb_add(unsigned* p, unsigned v) { return __hip_atomic_fetch_add(p, v, __ATOMIC_RELAXED, __HIP_MEMORY_SCOPE_AGENT); }
__device__ __forceinline__ unsigned xb_xcc_id() { return (unsigned)__builtin_amdgcn_s_getreg((3 << 11) | 20) & 0xFu; }
#define XB_SPIN(cond, bar) do { unsigned _sp = 0; while (cond) { __builtin_amdgcn_s_sleep(1); \
    if ((++_sp & 255u) == 0u) { if (xb_ld(&(bar)[XB_TMO])) break; if (_sp > XB_SPIN_CAP) { atomicAdd(&(bar)[XB_TMO], 1u); break; } } } } while (0)
struct XcdBarrier { unsigned* bar; unsigned x; volatile LAS unsigned* st; unsigned G; };
__device__ __forceinline__ XcdBarrier xcd_barrier_post(unsigned* bar, volatile LAS unsigned* st, unsigned G) {
    XcdBarrier b; b.bar = bar; b.x = xb_xcc_id(); b.st = st; b.G = G;
    if (threadIdx.x == 0) (void)xb_add(&bar[XB_XCNT(b.x)], 1u);
    return b;
}
__device__ __forceinline__ void xcd_barrier_complete(unsigned* bar, unsigned x, unsigned G, unsigned& nloc, unsigned& nx) {
    unsigned sum, cnt, mine, sp = 0u;
    for (;;) {
        sum = 0u; cnt = 0u; mine = 0u;
#pragma unroll
        for (unsigned j = 0; j < 16; ++j) { const unsigned c = xb_ld(&bar[XB_XCNT(j)]); sum += c; cnt += (c > 0u) ? 1u : 0u; mine = (j == x) ? c : mine; }
        if (sum == G) break;
        __builtin_amdgcn_s_sleep(1);
        if ((++sp & 255u) == 0u) { if (xb_ld(&bar[XB_TMO])) break; if (sp > XB_SPIN_CAP) { atomicAdd(&bar[XB_TMO], 1u); break; } }
    }
    nloc = mine > 0u ? mine : 1u; nx = cnt > 0u ? cnt : 1u;
}
__device__ __forceinline__ void xcd_barrier(const XcdBarrier& b) {
    asm volatile("s_waitcnt vmcnt(0)" ::: "memory");
    __syncthreads();
    if (threadIdx.x == 0) {
        unsigned* bar = b.bar;
        __builtin_amdgcn_s_waitcnt(0);
        unsigned nloc = b.st[0], nx = b.st[1];
        if (nloc == 0u) { xcd_barrier_complete(bar, b.x, b.G, nloc, nx); b.st[0] = nloc; b.st[1] = nx; }
        const unsigned old = xb_add(&bar[XB_XSUB(b.x)], 1u);
        const unsigned gen = old / nloc;
        if (old + 1u == (gen + 1u) * nloc) {
            __builtin_amdgcn_fence(__ATOMIC_RELEASE, "agent");
            asm volatile("s_waitcnt vmcnt(0)" ::: "memory");
            const unsigned og = xb_add(&bar[XB_TOP], 1u);
            const unsigned tg = og / nx;
            if (og + 1u == (tg + 1u) * nx) xb_add(&bar[XB_TOPGEN], 1u);
            else XB_SPIN(xb_ld(&bar[XB_TOPGEN]) == tg, bar);
            __builtin_amdgcn_fence(__ATOMIC_ACQUIRE, "agent");
            xb_add(&bar[XB_XGEN(b.x)], 1u);
            asm volatile("s_waitcnt vmcnt(0)" ::: "memory");
        } else {
            XB_SPIN(xb_ld(&bar[XB_XGEN(b.x)]) == gen, bar);
            __builtin_amdgcn_fence(__ATOMIC_ACQUIRE, "agent");
            asm volatile("s_waitcnt vmcnt(0)" ::: "memory");
        }
    }
    __syncthreads();
}

constexpr int NWAVES = 8, NTHR = 512;
constexpr int LDS_BYTES = 155648;
constexpr int MISC_OFF = LDS_BYTES - 256;
struct Ctx { unsigned char* lds; int tid, lane, wave, gw, ngw, bid, nb; };

__device__ __forceinline__ void tr_item(const float* __restrict__ W, int ldw, int N, bf16* __restrict__ WT, int ldt, int row_off, int col_off, int kb, int nb, float* scr, int lane, const float* __restrict__ gk) {
    const int k0 = 64 * kb, n0 = 32 * nb; const int n = n0 + (lane & 31);
    float v[32];
    const float* wp = W + (size_t)(k0 + (lane >> 5)) * ldw + (n < N ? n : 0);
#pragma unroll
    for (int i = 0; i < 32; ++i) v[i] = wp[(size_t)(2 * i) * ldw];
    asm volatile("" : "+v"(v[0]), "+v"(v[1]), "+v"(v[2]), "+v"(v[3]), "+v"(v[4]), "+v"(v[5]), "+v"(v[6]), "+v"(v[7]), "+v"(v[8]), "+v"(v[9]), "+v"(v[10]), "+v"(v[11]), "+v"(v[12]), "+v"(v[13]), "+v"(v[14]), "+v"(v[15]));
    asm volatile("" : "+v"(v[16]), "+v"(v[17]), "+v"(v[18]), "+v"(v[19]), "+v"(v[20]), "+v"(v[21]), "+v"(v[22]), "+v"(v[23]), "+v"(v[24]), "+v"(v[25]), "+v"(v[26]), "+v"(v[27]), "+v"(v[28]), "+v"(v[29]), "+v"(v[30]), "+v"(v[31]));
    const float msk = (n < N) ? 1.f : 0.f;
    if (gk) {
        float gv[32];
#pragma unroll
        for (int i = 0; i < 32; ++i) gv[i] = gk[k0 + 2 * i + (lane >> 5)];
#pragma unroll
        for (int i = 0; i < 32; ++i) v[i] *= gv[i];
    }
#pragma unroll
    for (int i = 0; i < 32; ++i) { const int kk = 2 * i + (lane >> 5); scr[kk * 33 + (lane & 31)] = v[i] * msk; }
    __builtin_amdgcn_fence(__ATOMIC_RELEASE, "wavefront"); __builtin_amdgcn_wave_barrier(); __builtin_amdgcn_fence(__ATOMIC_ACQUIRE, "wavefront");
    const int c = lane & 7;
#pragma unroll
    for (int j = 0; j < 4; ++j) { const int nn = (lane >> 3) + 8 * j; const float* s = scr + (8 * c) * 33 + nn;
        u32x4 o; o.x = pk2(s[0 * 33], s[1 * 33]); o.y = pk2(s[2 * 33], s[3 * 33]); o.z = pk2(s[4 * 33], s[5 * 33]); o.w = pk2(s[6 * 33], s[7 * 33]);
        *(u32x4*)(WT + (size_t)(row_off + n0 + nn) * ldt + col_off + k0 + 8 * c) = o; }
    __builtin_amdgcn_fence(__ATOMIC_RELEASE, "wavefront"); __builtin_amdgcn_wave_barrier(); __builtin_amdgcn_fence(__ATOMIC_ACQUIRE, "wavefront");
}
__device__ __forceinline__ void conv_mat(const Ctx& c, const float* W, int K, int ldw, int N, int Npad, bf16* WT, int ldt, int row_off, int col_off, const float* gk = nullptr) {
    float* scr = (float*)(c.lds + c.wave * 8704);
    const int nblk = Npad / 32, nit = (K / 64) * nblk;
    for (int it = c.gw; it < nit; it += c.ngw) tr_item(W, ldw, N, WT, ldt, row_off, col_off, it / nblk, it % nblk, scr, c.lane, gk);
}

__device__ __forceinline__ void norm_rows_bf16(const Ctx& c, const float* __restrict__ X, const float* __restrict__ g, bf16* __restrict__ O, int nrows) {
    f32x4 gv[8];
#pragma unroll
    for (int j = 0; j < 8; ++j) gv[j] = *(const f32x4*)(g + 4 * c.lane + 256 * j);
    for (int m = c.gw; m < nrows; m += c.ngw) {
        const f32x4* xr = (const f32x4*)(X + (size_t)m * D) + c.lane; f32x4 v[8]; float s = 0.f;
#pragma unroll
        for (int j = 0; j < 8; ++j) { v[j] = xr[64 * j]; s += (v[j].x * v[j].x + v[j].y * v[j].y) + (v[j].z * v[j].z + v[j].w * v[j].w); }
        const float rstd = 1.0f / sqrtf(wave_sum(s) * (1.f / D) + NORM_EPS);
        u32x2* o8 = (u32x2*)(O + (size_t)m * D) + c.lane;
#pragma unroll
        for (int j = 0; j < 8; ++j) { u32x2 w; w.x = pk2(v[j].x * rstd * gv[j].x, v[j].y * rstd * gv[j].y); w.y = pk2(v[j].z * rstd * gv[j].z, v[j].w * rstd * gv[j].w); o8[64 * j] = w; }
    }
}
__device__ __forceinline__ void cast_rows_ss(const Ctx& c, const float* __restrict__ X, bf16* __restrict__ O, unsigned long long* rowss, int nrows) {
    for (int m = c.gw; m < nrows; m += c.ngw) {
        const f32x4* xr = (const f32x4*)(X + (size_t)m * D) + c.lane; f32x4 v[8]; float s = 0.f;
#pragma unroll
        for (int j = 0; j < 8; ++j) { v[j] = xr[64 * j]; s += (v[j].x * v[j].x + v[j].y * v[j].y) + (v[j].z * v[j].z + v[j].w * v[j].w); }
        s = wave_sum(s);
        u32x2* o8 = (u32x2*)(O + (size_t)m * D) + c.lane;
#pragma unroll
        for (int j = 0; j < 8; ++j) { u32x2 w; w.x = pk2(v[j].x, v[j].y); w.y = pk2(v[j].z, v[j].w); o8[64 * j] = w; }
        if (c.lane == 0) rowss[m] = (unsigned long long)(s * 16777216.0f);
    }
}
__device__ __forceinline__ void scale_rows_out(const Ctx& c, const bf16* __restrict__ XB, const float* __restrict__ g, const unsigned long long* rowss, float* O, int nrows) {
    for (int m = c.gw; m < nrows; m += c.ngw) {
        const float rstd = 1.0f / sqrtf((float)rowss[m] * (5.9604644775390625e-08f / D) + NORM_EPS);
#pragma unroll
        for (int j = 0; j < 4; ++j) { float x[8]; unpack8(*(const u32x4*)(XB + (size_t)m * D + 8 * c.lane + 512 * j), x);
            const f32x4 g0 = *(const f32x4*)(g + 8 * c.lane + 512 * j), g1 = *(const f32x4*)(g + 8 * c.lane + 512 * j + 4);
            *(f32x4*)(O + (size_t)m * D + 8 * c.lane + 512 * j) = (f32x4){x[0] * rstd * g0.x, x[1] * rstd * g0.y, x[2] * rstd * g0.z, x[3] * rstd * g0.w};
            *(f32x4*)(O + (size_t)m * D + 8 * c.lane + 512 * j + 4) = (f32x4){x[4] * rstd * g1.x, x[5] * rstd * g1.y, x[6] * rstd * g1.z, x[7] * rstd * g1.w}; }
    }
}
__device__ __forceinline__ void norm_rows_f32(const Ctx& c, float* X, const float* __restrict__ g, int nrows) {
    f32x4 gv[8];
#pragma unroll
    for (int j = 0; j < 8; ++j) gv[j] = *(const f32x4*)(g + 4 * c.lane + 256 * j);
    for (int m = c.gw; m < nrows; m += c.ngw) {
        f32x4* xr = (f32x4*)(X + (size_t)m * D) + c.lane; f32x4 v[8]; float s = 0.f;
#pragma unroll
        for (int j = 0; j < 8; ++j) { v[j] = xr[64 * j]; s += (v[j].x * v[j].x + v[j].y * v[j].y) + (v[j].z * v[j].z + v[j].w * v[j].w); }
        const float rstd = 1.0f / sqrtf(wave_sum(s) * (1.f / D) + NORM_EPS);
#pragma unroll
        for (int j = 0; j < 8; ++j) xr[64 * j] = v[j] * rstd * gv[j];
    }
}

__device__ __forceinline__ void rope_tables(const Ctx& c, const int* __restrict__ start_frame, float* ropea, float* ropei) {
    const float HA[16] = {1.000000000e+00f, 4.403665960e-01f, 1.939227432e-01f, 8.539710194e-02f, 3.760603070e-02f, 1.656044088e-02f, 7.292664610e-03f, 3.211446106e-03f, 1.414213562e-03f, 6.227724371e-04f, 2.742481884e-04f, 1.207697351e-04f, 5.318295734e-05f, 2.341999971e-05f, 1.031338525e-05f, 4.541670478e-06f};
    const float LA[16] = {0.000000000e+00f, 6.688275267e-09f, 1.547429962e-09f, -1.652958881e-09f, 2.282729838e-10f, -8.020459852e-10f, 1.273676581e-10f, -1.116812753e-10f, -1.115275407e-14f, -1.514006802e-11f, -1.268531807e-11f, 2.335000249e-12f, 1.624761415e-12f, -7.452659366e-13f, 1.309491117e-13f, 2.687890499e-15f};
    const float HI[8] = {1.000000000e+00f, 1.939227432e-01f, 3.760603070e-02f, 7.292664610e-03f, 1.414213562e-03f, 2.742481884e-04f, 5.318295734e-05f, 1.031338525e-05f};
    const float LI[8] = {0.000000000e+00f, 1.547429962e-09f, 2.282729838e-10f, 1.273676581e-10f, -1.115275407e-14f, -1.268531807e-11f, 1.624761415e-12f, 1.309491117e-13f};
    const int gt = c.bid * NTHR + c.tid, ngt = c.nb * NTHR;
    for (int i = gt; i < M * 24; i += ngt) {
        const int m = i / 24, j = i % 24; const int b = m / SEQ, t = m % SEQ;
        const float pos = (float)(start_frame[b] + t);
        float hi = 0.f, lo = 0.f;
#pragma unroll
        for (int q = 0; q < 16; ++q) if (j == q) { hi = HA[q]; lo = LA[q]; }
#pragma unroll
        for (int q = 0; q < 8; ++q) if (j == 16 + q) { hi = HI[q]; lo = LI[q]; }
        const float p = pos * hi, e = fmaf(pos, hi, -p) + pos * lo;
        float sn, cs; sincosf(p, &sn, &cs);
        const float cc = cs - e * sn, ss = sn + e * cs;
        if (j < 16) { ropea[(size_t)m * 32 + j] = cc; ropea[(size_t)m * 32 + 16 + j] = ss; }
        else { ropei[(size_t)m * 16 + (j - 16)] = cc; ropei[(size_t)m * 16 + 8 + (j - 16)] = ss; }
    }
}

__device__ __forceinline__ void build_wql(const Ctx& c, const float* __restrict__ w_uq, const float* __restrict__ w_uk, bf16* WQ) {
    const int gt = c.bid * NTHR + c.tid, ngt = c.nb * NTHR;
    for (int i = gt; i < 2048 * 512; i += ngt) {
        const int cc = i & 511, hr = i >> 9, h = hr >> 8, r = hr & 255;
        const float* a = w_uq + (size_t)cc * 1024 + h * 128 + 32; const float* b = w_uk + (size_t)r * 768 + h * 96; float s = 0.f;
#pragma unroll 8
        for (int d = 0; d < 96; ++d) s += a[d] * b[d];
        WQ[i] = (bf16)f2bf(s);
    }
}
__device__ __forceinline__ void build_wout(const Ctx& c, const float* __restrict__ w_uv, const float* __restrict__ w_out, bf16* WO) {
    const int gt = c.bid * NTHR + c.tid, ngt = c.nb * NTHR;
    for (int i = gt; i < 8 * 32 * 2048; i += ngt) {
        const int n = i & 2047, rg = (i >> 11) & 31, h = i >> 16; float acc[8];
#pragma unroll
        for (int j = 0; j < 8; ++j) acc[j] = 0.f;
        for (int d = 0; d < 128; ++d) { const float wo = w_out[(size_t)(h * 128 + d) * 2048 + n];
#pragma unroll
            for (int j = 0; j < 8; ++j) acc[j] += w_uv[(size_t)(rg * 8 + j) * 1024 + h * 128 + d] * wo; }
        u32x4 o; o.x = pk2(acc[0], acc[1]); o.y = pk2(acc[2], acc[3]); o.z = pk2(acc[4], acc[5]); o.w = pk2(acc[6], acc[7]);
        *(u32x4*)(WO + (size_t)n * OC + h * 256 + rg * 8) = o;
    }
}

__device__ __forceinline__ void dsa_prep(const Ctx& c, const bf16* __restrict__ H, const float* __restrict__ cqn_g, const float* __restrict__ ckv_g, const float* __restrict__ kidx_g,
                                         const float* __restrict__ ropea, const float* __restrict__ ropei, bf16* CQN, bf16* KF, bf16* KIDX, float* WIDX) {
    const int l = c.lane;
    struct Tok { u32x4 cq; u32x2 ckv; unsigned short r1, r2, ki, wi; float csa, sna, csi, sni; };
    auto ld = [&](int m) -> Tok { Tok t; const bf16* h = H + (size_t)m * HC; const int l15 = l & 15, l7 = l & 7;
        t.cq = *(const u32x4*)(h + 8 * l); t.ckv = *(const u32x2*)(h + 512 + 4 * l); t.r1 = h[768 + l15]; t.r2 = h[768 + 16 + l15]; t.ki = h[800 + l]; t.wi = h[864 + l15];
        t.csa = ropea[(size_t)m * 32 + l15]; t.sna = ropea[(size_t)m * 32 + 16 + l15]; t.csi = ropei[(size_t)m * 16 + l7]; t.sni = ropei[(size_t)m * 16 + 8 + l7]; return t; };
    auto proc = [&](int m, const Tok& t) {
        {
            float f[8]; unpack8(t.cq, f); float s = 0.f;
#pragma unroll
            for (int j = 0; j < 8; ++j) s += f[j] * f[j];
            const float rstd = 1.0f / sqrtf(wave_sum(s) * (1.f / 512.f) + NORM_EPS);
            u32x4 o; o.x = pk2(f[0] * rstd * cqn_g[8 * l + 0], f[1] * rstd * cqn_g[8 * l + 1]); o.y = pk2(f[2] * rstd * cqn_g[8 * l + 2], f[3] * rstd * cqn_g[8 * l + 3]);
            o.z = pk2(f[4] * rstd * cqn_g[8 * l + 4], f[5] * rstd * cqn_g[8 * l + 5]); o.w = pk2(f[6] * rstd * cqn_g[8 * l + 6], f[7] * rstd * cqn_g[8 * l + 7]);
            *(u32x4*)(CQN + (size_t)m * 512 + 8 * l) = o;
        }
        {
            const u32x2 w = t.ckv; const float f0 = bf2f(w.x & 0xffffu), f1 = bf2f(w.x >> 16), f2 = bf2f(w.y & 0xffffu), f3 = bf2f(w.y >> 16);
            const float s = (f0 * f0 + f1 * f1) + (f2 * f2 + f3 * f3);
            const float rstd = 1.0f / sqrtf(wave_sum(s) * (1.f / 256.f) + NORM_EPS);
            u32x2 o; o.x = pk2(f0 * rstd * ckv_g[4 * l + 0], f1 * rstd * ckv_g[4 * l + 1]); o.y = pk2(f2 * rstd * ckv_g[4 * l + 2], f3 * rstd * ckv_g[4 * l + 3]);
            *(u32x2*)(KF + (size_t)m * KFW + 4 * l) = o;
        }
        if (l < 16) {
            const float x1 = bf2f(t.r1), x2 = bf2f(t.r2); const float cs = t.csa, sn = t.sna;
            KF[(size_t)m * KFW + 256 + l] = (bf16)f2bf(x1 * cs - x2 * sn); KF[(size_t)m * KFW + 256 + 16 + l] = (bf16)f2bf(x2 * cs + x1 * sn);
        }
        {
            const float v = bf2f(t.ki); const float rstd = 1.0f / sqrtf(wave_sum(v * v) * (1.f / 64.f) + NORM_EPS);
            const float y = v * rstd * kidx_g[l];
            const float ylo = __shfl(y, l & 7), yhi = __shfl(y, (l & 7) + 8);
            float o = y;
            if (l < 16) { const float cs = t.csi, sn = t.sni; o = (l < 8) ? (ylo * cs - yhi * sn) : (yhi * cs + ylo * sn); }
            KIDX[(size_t)m * 64 + l] = (bf16)f2bf(o);
        }
        if (l < 16) WIDX[(size_t)m * 16 + l] = bf2f(t.wi) * 0.03125f;
    };
    for (int m = c.gw; m < M; m += 2 * c.ngw) {
        const int m2 = m + c.ngw; const bool two = m2 < M;
        const Tok ta = ld(m); const Tok tb = ld(two ? m2 : m);
        proc(m, ta);
        if (two) proc(m2, tb);
    }
}
__device__ __forceinline__ void q_rope_fix(const Ctx& c, bf16* QALL, const float* __restrict__ ropea, const float* __restrict__ ropei) {
    const int l = c.lane;
    for (int m = c.gw; m < M; m += c.ngw) {
        bf16* q = QALL + (size_t)m * QC;
#pragma unroll
        for (int i = 0; i < 2; ++i) { const int p = l + 64 * i, hh = p >> 4, j = p & 15; bf16* a = q + 2048 + hh * 32 + j;
            const float x1 = bf2f(a[0]), x2 = bf2f(a[16]); const float cs = ropea[(size_t)m * 32 + j], sn = ropea[(size_t)m * 32 + 16 + j];
            a[0] = (bf16)f2bf(x1 * cs - x2 * sn); a[16] = (bf16)f2bf(x2 * cs + x1 * sn); }
#pragma unroll
        for (int i = 0; i < 2; ++i) { const int p = l + 64 * i, hh = p >> 3, j = p & 7; bf16* a = q + 2304 + hh * 64 + j;
            const float x1 = bf2f(a[0]), x2 = bf2f(a[8]); const float cs = ropei[(size_t)m * 16 + j], sn = ropei[(size_t)m * 16 + 8 + j];
            a[0] = (bf16)f2bf(x1 * cs - x2 * sn); a[8] = (bf16)f2bf(x2 * cs + x1 * sn); }
    }
}
__device__ __forceinline__ size_t sc_row_off(int b, int t) { const int ch = t >> 6; return (size_t)b * SC_PER_BATCH + (size_t)4096 * (ch * (ch + 1) / 2) + (size_t)(t & 63) * (64 * (ch + 1)); }
__device__ __forceinline__ void idx_scores_simple(const Ctx& c, const bf16* __restrict__ QALL, const bf16* __restrict__ KIDX, const float* __restrict__ WIDX, float* SC) {
    float* qs = (float*)c.lds;
    float* ws = qs + 1024;
    for (int m = c.bid; m < M; m += c.nb) {
        const int b = m / SEQ, t = m % SEQ, limit = ((t >> 6) + 1) * 64;
        __syncthreads();
        for (int i = c.tid; i < 1024; i += NTHR) qs[i] = bf2f(QALL[(size_t)m * QC + 2304 + i]);
        if (c.tid < 16) ws[c.tid] = WIDX[(size_t)m * 16 + c.tid];
        __syncthreads();
        if (limit <= 256) continue;
        float* row = SC + sc_row_off(b, t);
        for (int s = c.tid; s < limit; s += NTHR) {
            float k[64]; const u32x4* kp = (const u32x4*)(KIDX + (size_t)(b * SEQ + s) * 64);
#pragma unroll
            for (int j = 0; j < 8; ++j) unpack8(kp[j], k + 8 * j);
            float sc = 0.f;
#pragma unroll 1
            for (int h = 0; h < 16; ++h) { asm volatile("" ::: "memory"); float d = 0.f; const f32x4* q4 = (const f32x4*)(qs + h * 64);
#pragma unroll
                for (int j = 0; j < 16; ++j) { const f32x4 q = q4[j]; d += (q.x * k[4 * j] + q.y * k[4 * j + 1]) + (q.z * k[4 * j + 2] + q.w * k[4 * j + 3]); }
                sc += ws[h] * fmaxf(d, 0.f); }
            row[s] = sc;
        }
    }
}
__device__ __forceinline__ void select_row(const float* row, int limit, unsigned short* sel, int l_in, unsigned short* stg = nullptr) {
    int l = l_in; asm volatile("" : "+v"(l));
    const int ng = limit >> 9;
    unsigned key[64];
#pragma unroll
    for (int jg = 0; jg < 8; ++jg) {
        if (jg <= ng) {
#pragma unroll
            for (int j = 8 * jg; j < 8 * jg + 8; ++j) { const int s = j * 64 + l; key[j] = __float_as_uint(row[s < limit ? s : 0]); }
        } else {
#pragma unroll
            for (int j = 8 * jg; j < 8 * jg + 8; ++j) key[j] = 0u;
        }
    }
#pragma unroll
    for (int j = 0; j < 64; ++j) { const int s = j * 64 + l; unsigned u = key[j]; u = (u & 0x80000000u) ? ~u : (u | 0x80000000u); key[j] = (s < limit) ? u : 0u; }
    unsigned mx = 0u;
#pragma unroll
    for (int j = 0; j < 64; ++j) mx = key[j] > mx ? key[j] : mx;
#pragma unroll
    for (int o = 1; o < 64; o <<= 1) { const unsigned t = (unsigned)__shfl_xor((int)mx, o); mx = t > mx ? t : mx; }
    mx = (unsigned)__builtin_amdgcn_readfirstlane((int)mx);
    auto wave_count = [&](int v) -> int {
        v += __builtin_amdgcn_update_dpp(0, v, 0xB1, 0xf, 0xf, true); v += __builtin_amdgcn_update_dpp(0, v, 0x4E, 0xf, 0xf, true);
        v += __builtin_amdgcn_update_dpp(0, v, 0x141, 0xf, 0xf, true); v += __builtin_amdgcn_update_dpp(0, v, 0x140, 0xf, 0xf, true);
        return __builtin_amdgcn_readlane(v, 0) + __builtin_amdgcn_readlane(v, 16) + __builtin_amdgcn_readlane(v, 32) + __builtin_amdgcn_readlane(v, 48); };
    unsigned T = 0u;
#pragma unroll 1
    for (int bit = 31 - __builtin_clz(mx | 1u); bit >= 0; --bit) {
        const unsigned Tn = T | (1u << bit); int cl = 0;
#pragma unroll
        for (int jg = 0; jg < 8; ++jg) if (jg <= ng) {
#pragma unroll
            for (int j = 8 * jg; j < 8 * jg + 8; ++j) cl += (key[j] >= Tn) ? 1 : 0; }
        const int cnt = wave_count(cl);
        if (cnt >= 256) T = Tn;
        if (cnt == 256) break;
    }
    int cgl = 0;
#pragma unroll
    for (int j = 0; j < 64; ++j) cgl += (key[j] > T) ? 1 : 0;
    const int cgt = wave_count(cgl);
    const int need_eq = 256 - cgt;
    int base = 0, beq = 0;
    const unsigned long long lt = (1ull << l) - 1ull;
    if (stg) {
#pragma unroll
        for (int jg = 0; jg < 8; ++jg) if (jg <= ng) {
#pragma unroll
            for (int j = 8 * jg; j < 8 * jg + 8; ++j) {
                const unsigned long long mg = __ballot(key[j] > T);
                const int pos = base + (int)__builtin_amdgcn_mbcnt_hi((unsigned)(mg >> 32), __builtin_amdgcn_mbcnt_lo((unsigned)mg, 0u));
                if (key[j] > T) stg[pos] = (unsigned short)(j * 64 + l);
                base += __popcll(mg);
                const unsigned long long me = __ballot(key[j] == T);
                if (me != 0ull) {
                    const int pe = beq + (int)__builtin_amdgcn_mbcnt_hi((unsigned)(me >> 32), __builtin_amdgcn_mbcnt_lo((unsigned)me, 0u));
                    if (key[j] == T && pe < need_eq) stg[cgt + pe] = (unsigned short)(j * 64 + l);
                    beq += __popcll(me);
                }
            }
        }
        __builtin_amdgcn_fence(__ATOMIC_RELEASE, "wavefront"); __builtin_amdgcn_wave_barrier(); __builtin_amdgcn_fence(__ATOMIC_ACQUIRE, "wavefront");
        *(u32x2*)(sel + 4 * l) = *(const u32x2*)(stg + 4 * l);
        __builtin_amdgcn_fence(__ATOMIC_RELEASE, "wavefront"); __builtin_amdgcn_wave_barrier(); __builtin_amdgcn_fence(__ATOMIC_ACQUIRE, "wavefront");
        return;
    }
#pragma unroll
    for (int jg = 0; jg < 8; ++jg) if (jg <= ng) {
#pragma unroll
        for (int j = 8 * jg; j < 8 * jg + 8; ++j) {
            const unsigned long long mg = __ballot(key[j] > T), me = __ballot(key[j] == T);
            if (key[j] > T) sel[base + __popcll(mg & lt)] = (unsigned short)(j * 64 + l);
            base += __popcll(mg);
            const int pe = beq + __popcll(me & lt);
            if (key[j] == T && pe < need_eq) sel[cgt + pe] = (unsigned short)(j * 64 + l);
            beq += __popcll(me);
        }
    }
}
__device__ __forceinline__ void bs_transpose32(unsigned (&A)[32]) {
    unsigned m = 0x0000FFFFu;
#pragma unroll
    for (int j = 16; j != 0; j >>= 1) {
#pragma unroll
        for (int k = 0; k < 32; ++k) {
            if ((k & j) == 0) {
                const unsigned t = (A[k] ^ (A[k + j] >> j)) & m;
                A[k] ^= t; A[k + j] ^= (t << j);
            }
        }
        m ^= (m << (j >> 1));
    }
}
__device__ __forceinline__ void select_row_bs(const float* row, int limit, unsigned short* sel, int l_in, unsigned short* stg) {
    int l = l_in; asm volatile("" : "+v"(l));
    const int nsl = limit >> 6;
    const int ng = limit >> 9;
    unsigned lo[32], hi[32];
#pragma unroll
    for (int jg = 0; jg < 8; ++jg) {
        if (jg <= ng) {
#pragma unroll
            for (int j = 8 * jg; j < 8 * jg + 8; ++j) { const int s = j * 64 + l; const unsigned u = __float_as_uint(row[s < limit ? s : 0]);
                if (j < 32) lo[j & 31] = u; else hi[j & 31] = u; }
        } else {
#pragma unroll
            for (int j = 8 * jg; j < 8 * jg + 8; ++j) { if (j < 32) lo[j & 31] = 0u; else hi[j & 31] = 0u; }
        }
    }
    asm volatile("" ::: "memory");
#pragma unroll
    for (int j = 0; j < 64; ++j) { const unsigned u = (j < 32) ? lo[j & 31] : hi[j & 31];
        const unsigned kx = (j < nsl) ? ((u & 0x80000000u) ? ~u : (u | 0x80000000u)) : 0u;
        if (j < 32) lo[j & 31] = kx; else hi[j & 31] = kx; }
    const bool has_hi = nsl > 32;
    bs_transpose32(lo);
    if (has_hi) bs_transpose32(hi);
    auto wave_count = [&](int v) -> int {
        v += __builtin_amdgcn_update_dpp(0, v, 0xB1, 0xf, 0xf, true); v += __builtin_amdgcn_update_dpp(0, v, 0x4E, 0xf, 0xf, true);
        v += __builtin_amdgcn_update_dpp(0, v, 0x141, 0xf, 0xf, true); v += __builtin_amdgcn_update_dpp(0, v, 0x140, 0xf, 0xf, true);
        return __builtin_amdgcn_readlane(v, 0) + __builtin_amdgcn_readlane(v, 16) + __builtin_amdgcn_readlane(v, 32) + __builtin_amdgcn_readlane(v, 48); };
    unsigned clo = 0xffffffffu, chi = has_hi ? 0xffffffffu : 0u, glo = 0u, ghi = 0u;
    int G = 0;
#pragma unroll
    for (int i = 0; i < 32; ++i) {
        const unsigned olo = clo & lo[i], ohi = chi & hi[i];
        const int tot = G + wave_count(__builtin_popcount(olo) + __builtin_popcount(ohi));
        const bool take = tot >= 256;
        const unsigned mt = take ? 0u : 0xffffffffu;
        G = take ? G : tot;
        glo |= olo & mt; ghi |= ohi & mt;
        clo = olo ^ (clo & mt); chi = ohi ^ (chi & mt);
        if (tot == 256) break;
    }
    {
        const int need = 256 - G;
        const int ceq = wave_count(__builtin_popcount(clo) + __builtin_popcount(chi));
        if (ceq == need) { glo |= clo; ghi |= chi; }
        else {
            int beq = 0;
#pragma unroll 1
            for (int k = 0; k < 64; ++k) {
                const unsigned bm = 0x80000000u >> (k & 31);
                const bool mine = ((k < 32 ? clo : chi) & bm) != 0u;
                const unsigned long long me = __ballot(mine);
                if (me != 0ull) {
                    const int pe = beq + (int)__builtin_amdgcn_mbcnt_hi((unsigned)(me >> 32), __builtin_amdgcn_mbcnt_lo((unsigned)me, 0u));
                    if (mine && pe < need) { if (k < 32) glo |= bm; else ghi |= bm; }
                    beq += __popcll(me);
                }
            }
        }
    }
    const int cl = __builtin_popcount(glo) + __builtin_popcount(ghi);
    int inc = cl;
#pragma unroll
    for (int o = 1; o < 64; o <<= 1) { const int t = __shfl_up(inc, o); inc += (l >= o) ? t : 0; }
    int pos = inc - cl;
    while (__ballot(glo != 0u) != 0ull) {
        if (glo != 0u) { const int s = __builtin_clz(glo); glo &= ~(0x80000000u >> s); stg[pos++] = (unsigned short)(s * 64 + l); }
    }
    while (__ballot(ghi != 0u) != 0ull) {
        if (ghi != 0u) { const int s = __builtin_clz(ghi); ghi &= ~(0x80000000u >> s); stg[pos++] = (unsigned short)((32 + s) * 64 + l); }
    }
    __builtin_amdgcn_fence(__ATOMIC_RELEASE, "wavefront"); __builtin_amdgcn_wave_barrier(); __builtin_amdgcn_fence(__ATOMIC_ACQUIRE, "wavefront");
    *(u32x2*)(sel + 4 * l) = *(const u32x2*)(stg + 4 * l);
    __builtin_amdgcn_fence(__ATOMIC_RELEASE, "wavefront"); __builtin_amdgcn_wave_barrier(); __builtin_amdgcn_fence(__ATOMIC_ACQUIRE, "wavefront");
}
__device__ __forceinline__ void topk_select(const Ctx& c, const float* __restrict__ SC, bf16* SEL  ) {
    const int l = c.lane;
    for (int m = c.gw; m < M; m += c.ngw) {
        const int b = m / SEQ, t = m % SEQ, limit = ((t >> 6) + 1) * 64;
        unsigned short* sel = (unsigned short*)SEL + (size_t)m * 256;
        if (limit <= 256) { for (int i = l; i < 256; i += 64) sel[i] = (unsigned short)(i < limit ? i : 0); continue; }
        select_row(SC + sc_row_off(b, t), limit, sel, l);
    }
}
__device__ __forceinline__ void dsa_attn_simple(const Ctx& c, const bf16* __restrict__ QALL, const bf16* __restrict__ KF, const bf16* __restrict__ SEL, bf16* OLY, int mmax = M) {
    float* qf = (float*)c.lds;
    float* P = qf + 8 * 288;
    int* sl = (int*)(P + 8 * 256);
    const float scale = 0.08838834764831845f;
    for (int m = c.bid; m < mmax; m += c.nb) {
        const int b = m / SEQ, t = m % SEQ, limit = ((t >> 6) + 1) * 64, cnt = limit < 256 ? limit : 256;
        __syncthreads();
        for (int i = c.tid; i < 8 * 288; i += NTHR) { const int h = i / 288, d = i % 288; qf[i] = bf2f(d < 256 ? QALL[(size_t)m * QC + h * 256 + d] : QALL[(size_t)m * QC + 2048 + h * 32 + (d - 256)]); }
        if (c.tid < 256) sl[c.tid] = (int)((const unsigned short*)SEL)[(size_t)m * 256 + c.tid];
        __syncthreads();
        if (c.tid < 256) {
            float acc[8];
#pragma unroll
            for (int h = 0; h < 8; ++h) acc[h] = 0.f;
            if (c.tid < cnt) {
                const u32x4* kp = (const u32x4*)(KF + (size_t)(b * SEQ + sl[c.tid]) * KFW);
                for (int ch = 0; ch < 36; ++ch) { float k[8]; unpack8(kp[ch], k);
#pragma unroll
                    for (int h = 0; h < 8; ++h) { const float* q = qf + h * 288 + ch * 8;
#pragma unroll
                        for (int j = 0; j < 8; ++j) acc[h] += k[j] * q[j]; } }
            }
#pragma unroll
            for (int h = 0; h < 8; ++h) P[h * 256 + c.tid] = (c.tid < cnt) ? acc[h] * scale : -INFINITY;
        }
        __syncthreads();
        {
            const int h = c.wave; float v[4]; float mx = -INFINITY;
#pragma unroll
            for (int i = 0; i < 4; ++i) { v[i] = P[h * 256 + c.lane + 64 * i]; mx = fmaxf(mx, v[i]); }
            mx = wave_max(mx); float s = 0.f;
#pragma unroll
            for (int i = 0; i < 4; ++i) { v[i] = __expf(v[i] - mx); s += v[i]; }
            s = wave_sum(s); const float inv = 1.f / s;
#pragma unroll
            for (int i = 0; i < 4; ++i) P[h * 256 + c.lane + 64 * i] = v[i] * inv;
        }
        __syncthreads();
        {
            const int r = c.tid & 255, hg = c.tid >> 8; float o[4] = {0.f, 0.f, 0.f, 0.f};
            for (int i = 0; i < cnt; ++i) { const float v = bf2f(KF[(size_t)(b * SEQ + sl[i]) * KFW + r]);
#pragma unroll
                for (int hh = 0; hh < 4; ++hh) o[hh] += P[(hg * 4 + hh) * 256 + i] * v; }
#pragma unroll
            for (int hh = 0; hh < 4; ++hh) OLY[(size_t)m * OC + (hg * 4 + hh) * 256 + r] = (bf16)f2bf(o[hh]);
        }
    }
}
__device__ __forceinline__ void xattn_simple(const Ctx& c, const bf16* __restrict__ XQ, const bf16* __restrict__ KVBIG, int layer, bf16* XO) {
    float* qf = (float*)c.lds;
    float* P = qf + 512;
    const float scale = 0.08838834764831845f;
    for (int m = c.bid; m < M; m += c.nb) {
        const int b = m / SEQ;
        const bf16* kvb = KVBIG + (size_t)(layer * 2048 + b * 256) * 4096 + layer * 1024;
        __syncthreads();
        qf[c.tid] = bf2f(XQ[(size_t)m * 512 + c.tid]);
        __syncthreads();
        {
            const int j = c.tid & 255, hp = c.tid >> 8;
#pragma unroll
            for (int hh = 0; hh < 2; ++hh) { const int h = hp * 2 + hh; const u32x4* kp = (const u32x4*)(kvb + (size_t)j * 4096 + h * 128); float d = 0.f;
                for (int ch = 0; ch < 16; ++ch) { float k[8]; unpack8(kp[ch], k);
#pragma unroll
                    for (int e = 0; e < 8; ++e) d += k[e] * qf[h * 128 + ch * 8 + e]; }
                P[h * 256 + j] = d * scale; }
        }
        __syncthreads();
        if (c.wave < 4) { const int h = c.wave; float v[4]; float mx = -INFINITY;
#pragma unroll
            for (int i = 0; i < 4; ++i) { v[i] = P[h * 256 + c.lane + 64 * i]; mx = fmaxf(mx, v[i]); }
            mx = wave_max(mx); float s = 0.f;
#pragma unroll
            for (int i = 0; i < 4; ++i) { v[i] = __expf(v[i] - mx); s += v[i]; }
            s = wave_sum(s); const float inv = 1.f / s;
#pragma unroll
            for (int i = 0; i < 4; ++i) P[h * 256 + c.lane + 64 * i] = v[i] * inv; }
        __syncthreads();
        {   const int h = c.tid >> 7; float o = 0.f;
            for (int j = 0; j < 256; ++j) o += P[h * 256 + j] * bf2f(kvb[(size_t)j * 4096 + 512 + c.tid]);
            XO[(size_t)m * 512 + c.tid] = (bf16)f2bf(o); }
    }
}
__device__ __forceinline__ float x16_max(float v) { const unsigned u = __builtin_bit_cast(unsigned, v); auto r = __builtin_amdgcn_permlane16_swap(u, u, false, false); return fmaxf(__builtin_bit_cast(float, (unsigned)r[0]), __builtin_bit_cast(float, (unsigned)r[1])); }
__device__ __forceinline__ float x32_max(float v) { const unsigned u = __builtin_bit_cast(unsigned, v); auto r = __builtin_amdgcn_permlane32_swap(u, u, false, false); return fmaxf(__builtin_bit_cast(float, (unsigned)r[0]), __builtin_bit_cast(float, (unsigned)r[1])); }
__device__ __forceinline__ float x16_sum(float v) { const unsigned u = __builtin_bit_cast(unsigned, v); auto r = __builtin_amdgcn_permlane16_swap(u, u, false, false); return __builtin_bit_cast(float, (unsigned)r[0]) + __builtin_bit_cast(float, (unsigned)r[1]); }
__device__ __forceinline__ float x32_sum(float v) { const unsigned u = __builtin_bit_cast(unsigned, v); auto r = __builtin_amdgcn_permlane32_swap(u, u, false, false); return __builtin_bit_cast(float, (unsigned)r[0]) + __builtin_bit_cast(float, (unsigned)r[1]); }
typedef short bf16x8 __attribute__((ext_vector_type(8)));
typedef short bf16x4 __attribute__((ext_vector_type(4)));
__device__ __forceinline__ bf16x4 tr_read4(const unsigned char* p) { return __builtin_amdgcn_ds_read_tr16_b64_v4i16((LAS bf16x4*)p); }
__device__ __forceinline__ bf16x8 cat8(bf16x4 a, bf16x4 b) { return __builtin_shufflevector(a, b, 0, 1, 2, 3, 4, 5, 6, 7); }
__device__ __forceinline__ bf16x8 pack_p8(const f32x4 a, const f32x4 b) {
    u32x4 w; w.x = pg8::cvt_pk_bf16(a[0], a[1]); w.y = pg8::cvt_pk_bf16(a[2], a[3]); w.z = pg8::cvt_pk_bf16(b[0], b[1]); w.w = pg8::cvt_pk_bf16(b[2], b[3]);
    return __builtin_bit_cast(bf16x8, w);
}
__device__ __forceinline__ bf16x8 rope_frag(const bf16x8 xf, const bf16x8 pf, const float* cs, const float* sn, bool lo) {
    float x[8], p[8]; unpack8(__builtin_bit_cast(u32x4, xf), x); unpack8(__builtin_bit_cast(u32x4, pf), p);
    const float sg = lo ? -1.f : 1.f; float o[8];
#pragma unroll
    for (int j = 0; j < 8; ++j) o[j] = x[j] * cs[j] + sg * p[j] * sn[j];
    u32x4 w; w.x = pg8::cvt_pk_bf16(o[0], o[1]); w.y = pg8::cvt_pk_bf16(o[2], o[3]); w.z = pg8::cvt_pk_bf16(o[4], o[5]); w.w = pg8::cvt_pk_bf16(o[6], o[7]);
    return __builtin_bit_cast(bf16x8, w);
}
__device__ __forceinline__ bf16x8 xchg_frag(const bf16x8 v, int lane_xor) { u32x4 u = __builtin_bit_cast(u32x4, v); u32x4 r;
    r.x = (unsigned)__shfl_xor((int)u.x, lane_xor); r.y = (unsigned)__shfl_xor((int)u.y, lane_xor); r.z = (unsigned)__shfl_xor((int)u.z, lane_xor); r.w = (unsigned)__shfl_xor((int)u.w, lane_xor); return __builtin_bit_cast(bf16x8, r); }
constexpr int XA_PITCH = 272;
__device__ __forceinline__ void xattn_mfma(const Ctx& c, const bf16* __restrict__ XQ, const bf16* __restrict__ KVBIG, int layer, bf16* XO) {
    unsigned char* Kl = c.lds; unsigned char* Vl = c.lds + 256 * XA_PITCH;
    const int l = c.lane, n16 = l & 15, g = l >> 4;
    const float scale = 0.08838834764831845f * 1.4426950408889634f;
    for (int unit = c.bid; unit < 256; unit += c.nb) {
        const int b = unit >> 5, h = (unit >> 3) & 3, qc = unit & 7;
        const bf16* kvb = KVBIG + (size_t)(layer * 2048 + b * 256) * 4096 + layer * 1024 + h * 128;
        __syncthreads();
        {
            u32x4 kq[8], vq[8];
#pragma unroll
            for (int j = 0; j < 8; ++j) { const int i = c.tid + NTHR * j, row = i >> 4, ch = i & 15; kq[j] = *(const u32x4*)(kvb + (size_t)row * 4096 + ch * 8); vq[j] = *(const u32x4*)(kvb + (size_t)row * 4096 + 512 + ch * 8); }
#pragma unroll
            for (int j = 0; j < 8; ++j) { const int i = c.tid + NTHR * j, row = i >> 4, ch = i & 15; *(u32x4*)(Kl + row * XA_PITCH + ch * 16) = kq[j]; *(u32x4*)(Vl + row * XA_PITCH + ch * 16) = vq[j]; }
        }
        __syncthreads();
#pragma unroll 1
        for (int g4 = 0; g4 < 4; ++g4) {
            const size_t m = (size_t)b * SEQ + qc * 512 + c.wave * 64 + g4 * 16 + n16;
            bf16x8 Qb[4];
#pragma unroll
            for (int kk = 0; kk < 4; ++kk) Qb[kk] = *(const bf16x8*)(XQ + m * 512 + h * 128 + 32 * kk + 8 * g);
            f32x4 S[16];
#pragma unroll
            for (int j = 0; j < 16; ++j) { S[j] = (f32x4){0.f, 0.f, 0.f, 0.f};
#pragma unroll
                for (int kk = 0; kk < 4; ++kk) { const bf16x8 A = *(const bf16x8*)(Kl + (16 * j + n16) * XA_PITCH + (32 * kk + 8 * g) * 2);
                    S[j] = __builtin_amdgcn_mfma_f32_16x16x32_bf16(A, Qb[kk], S[j], 0, 0, 0); } }
            float mx = -INFINITY;
#pragma unroll
            for (int j = 0; j < 16; ++j) mx = fmaxf(mx, fmaxf(fmaxf(S[j][0], S[j][1]), fmaxf(S[j][2], S[j][3])));
            mx = x32_max(x16_max(mx));
            float sum = 0.f; const float mo = mx * scale;
#pragma unroll
            for (int j = 0; j < 16; ++j) {
#pragma unroll
                for (int r = 0; r < 4; ++r) { const float p = __builtin_amdgcn_exp2f(S[j][r] * scale - mo); S[j][r] = p; sum += p; } }
            sum = x32_sum(x16_sum(sum));
            const float inv = 1.f / sum;
            bf16x8 Pb[8];
#pragma unroll
            for (int jj = 0; jj < 8; ++jj) Pb[jj] = pack_p8(S[2 * jj], S[2 * jj + 1]);
            const int q4 = n16 >> 2, p4 = l & 3;
#pragma unroll
            for (int dt = 0; dt < 8; ++dt) { f32x4 O = (f32x4){0.f, 0.f, 0.f, 0.f};
#pragma unroll
                for (int jj = 0; jj < 8; ++jj) { const unsigned char* vp = Vl + (32 * jj + 4 * g + q4) * XA_PITCH + (16 * dt) * 2 + 8 * p4;
                    const bf16x8 A = cat8(tr_read4(vp), tr_read4(vp + 16 * XA_PITCH));
                    O = __builtin_amdgcn_mfma_f32_16x16x32_bf16(A, Pb[jj], O, 0, 0, 0); }
                u32x2 w; w.x = pg8::cvt_pk_bf16(O[0] * inv, O[1] * inv); w.y = pg8::cvt_pk_bf16(O[2] * inv, O[3] * inv);
                *(u32x2*)(XO + m * 512 + h * 128 + 16 * dt + 4 * g) = w; }
        }
    }
}
__device__ __forceinline__ void diag_cmp_bf16(const Ctx& c, const bf16* A, int lda, const bf16* B, int ldb, int rows, int cols, float* acc) {
    float d2 = 0.f, a2 = 0.f;
    const size_t n = (size_t)rows * cols;
    for (size_t i = (size_t)c.bid * NTHR + c.tid; i < n; i += (size_t)c.nb * NTHR) { const size_t r = i / cols, cc = i % cols; const float a = bf2f(A[r * lda + cc]), b = bf2f(B[r * ldb + cc]); d2 += (a - b) * (a - b); a2 += a * a; }
    d2 = wave_sum(d2); a2 = wave_sum(a2);
    if (c.lane == 0) { atomicAdd(acc, d2); atomicAdd(acc + 1, a2); }
}
constexpr int DA_PITCH = 528, DA_WAVE_BYTES = 32 * DA_PITCH;
__device__ __forceinline__ void dsa_attn_mfma(const Ctx& c, const bf16* __restrict__ QALL, const bf16* __restrict__ KF, const bf16* __restrict__ SEL, const float* __restrict__ ROPEA, bf16* OLY, int m_first, int m_stride, int m_end) {
    unsigned char* Vw = c.lds + c.wave * DA_WAVE_BYTES;
    const int l = c.lane, n16 = l & 15, g = l >> 4, q4 = n16 >> 2, p4 = l & 3, hh = n16 & 7;
    const float scale = 0.08838834764831845f * 1.4426950408889634f;
#pragma unroll 1
    for (int m = m_first; m < m_end; m += m_stride) {
        const int b = m / SEQ, t = m % SEQ, limit = ((t >> 6) + 1) * 64, cnt = limit < 256 ? limit : 256, nblk = cnt >> 5;
        const bf16* qrow = QALL + (size_t)m * QC;
        bf16x8 Qb[9];
#pragma unroll
        for (int kk = 0; kk < 8; ++kk) Qb[kk] = *(const bf16x8*)(qrow + hh * 256 + 32 * kk + 8 * g);
        Qb[8] = *(const bf16x8*)(qrow + 2048 + hh * 32 + 8 * g);
        {
            const bf16x8 pf = xchg_frag(Qb[8], 32); float cs[8], sn[8];
            const f32x4 c0 = *(const f32x4*)(ROPEA + (size_t)m * 32 + 8 * (g & 1)), c1 = *(const f32x4*)(ROPEA + (size_t)m * 32 + 8 * (g & 1) + 4), s0 = *(const f32x4*)(ROPEA + (size_t)m * 32 + 16 + 8 * (g & 1)), s1 = *(const f32x4*)(ROPEA + (size_t)m * 32 + 16 + 8 * (g & 1) + 4);
            cs[0] = c0.x; cs[1] = c0.y; cs[2] = c0.z; cs[3] = c0.w; cs[4] = c1.x; cs[5] = c1.y; cs[6] = c1.z; cs[7] = c1.w; sn[0] = s0.x; sn[1] = s0.y; sn[2] = s0.z; sn[3] = s0.w; sn[4] = s1.x; sn[5] = s1.y; sn[6] = s1.z; sn[7] = s1.w;
            Qb[8] = rope_frag(Qb[8], pf, cs, sn, g < 2); }
        f32x4 O[16];
#pragma unroll
        for (int dt = 0; dt < 16; ++dt) O[dt] = (f32x4){0.f, 0.f, 0.f, 0.f};
        float mrun = -INFINITY, lrun = 0.f;
        const unsigned short* selp = (const unsigned short*)SEL + (size_t)m * 256;
        const bf16* kfb = KF + (size_t)b * SEQ * KFW;
        bf16x8 K0[9], K1[9];
        int sx0, sx1;
#define DA_IDX(BLK) do { sx0 = selp[32 * (BLK) + n16]; sx1 = selp[32 * (BLK) + 16 + n16]; } while (0)
#define DA_GATHER() do { const bf16* r0_ = kfb + (size_t)sx0 * KFW + 8 * g; const bf16* r1_ = kfb + (size_t)sx1 * KFW + 8 * g; \
            _Pragma("unroll") for (int kk = 0; kk < 9; ++kk) { K0[kk] = *(const bf16x8*)(r0_ + 32 * kk); K1[kk] = *(const bf16x8*)(r1_ + 32 * kk); } } while (0)
        DA_IDX(0); DA_GATHER(); DA_IDX(nblk > 1 ? 1 : 0);
#pragma unroll 1
        for (int blk = 0; blk < nblk; ++blk) {
            f32x4 S0 = (f32x4){0.f, 0.f, 0.f, 0.f}, S1 = (f32x4){0.f, 0.f, 0.f, 0.f};
#pragma unroll
            for (int kk = 0; kk < 9; ++kk) { S0 = __builtin_amdgcn_mfma_f32_16x16x32_bf16(K0[kk], Qb[kk], S0, 0, 0, 0); S1 = __builtin_amdgcn_mfma_f32_16x16x32_bf16(K1[kk], Qb[kk], S1, 0, 0, 0); }
#pragma unroll
            for (int kk = 0; kk < 8; ++kk) { *(bf16x8*)(Vw + n16 * DA_PITCH + (32 * kk + 8 * g) * 2) = K0[kk]; *(bf16x8*)(Vw + (16 + n16) * DA_PITCH + (32 * kk + 8 * g) * 2) = K1[kk]; }
            __builtin_amdgcn_sched_barrier(0);
            if (blk + 1 < nblk) { DA_GATHER(); DA_IDX(blk + 2 < nblk ? blk + 2 : blk + 1); }
            __builtin_amdgcn_sched_barrier(0);
            float bm = fmaxf(fmaxf(fmaxf(S0[0], S0[1]), fmaxf(S0[2], S0[3])), fmaxf(fmaxf(S1[0], S1[1]), fmaxf(S1[2], S1[3])));
            bm = x32_max(x16_max(bm));
            const float mnew = fmaxf(mrun, bm), alpha = __builtin_amdgcn_exp2f((mrun - mnew) * scale), mo = mnew * scale; mrun = mnew;
            float ps = 0.f;
#pragma unroll
            for (int r = 0; r < 4; ++r) { S0[r] = __builtin_amdgcn_exp2f(S0[r] * scale - mo); S1[r] = __builtin_amdgcn_exp2f(S1[r] * scale - mo); ps += S0[r] + S1[r]; }
            lrun = lrun * alpha + ps;
            const bf16x8 Pb = pack_p8(S0, S1);
#pragma unroll
            for (int dt = 0; dt < 16; ++dt) { O[dt] = O[dt] * alpha;
                const unsigned char* vp = Vw + (4 * g + q4) * DA_PITCH + (16 * dt) * 2 + 8 * p4;
                const bf16x8 A = cat8(tr_read4(vp), tr_read4(vp + 16 * DA_PITCH));
                O[dt] = __builtin_amdgcn_mfma_f32_16x16x32_bf16(A, Pb, O[dt], 0, 0, 0); }
        }
#undef DA_GATHER
#undef DA_IDX
        lrun = x32_sum(x16_sum(lrun));
        const float inv = 1.f / lrun;
        if (n16 < 8) {
            bf16* orow = OLY + (size_t)m * OC + n16 * 256 + 4 * g;
#pragma unroll
            for (int dt = 0; dt < 16; ++dt) { u32x2 w; w.x = pg8::cvt_pk_bf16(O[dt][0] * inv, O[dt][1] * inv); w.y = pg8::cvt_pk_bf16(O[dt][2] * inv, O[dt][3] * inv); *(u32x2*)(orow + 16 * dt) = w; }
        }
    }
}
__device__ __forceinline__ void dsa_attn_queue(const Ctx& c, const bf16* __restrict__ QALL, const bf16* __restrict__ KF, const bf16* __restrict__ SEL, const float* __restrict__ ROPEA, bf16* OLY, unsigned* counter, volatile LAS unsigned* slot) {
    for (;;) {
        __syncthreads();
        if (c.tid == 0) *slot = __hip_atomic_fetch_add(counter, 1u, __ATOMIC_RELAXED, __HIP_MEMORY_SCOPE_AGENT);
        __syncthreads();
        const int chunk = (int)*slot;
        if (chunk >= M / 16) break;
        dsa_attn_mfma(c, QALL, KF, SEL, ROPEA, OLY, chunk * 16 + c.wave, 8, chunk * 16 + 16);
    }
}
__device__ __forceinline__ float relu1(float x) { const int b = __builtin_bit_cast(int, x); return __builtin_bit_cast(float, b > 0 ? b : 0); }
__device__ __forceinline__ void idx_topk_mfma(const Ctx& c, const bf16* __restrict__ QALL, const bf16* __restrict__ KIDX, const float* __restrict__ WIDX, const float* __restrict__ ROPEI, float* scr, bf16* SEL, int nitems) {
    const int l = c.lane, n16 = l & 15, g = l >> 4, qg = c.wave & 3, kh = c.wave >> 2;
#pragma unroll 1
    for (int item = c.bid; item < nitems; item += c.nb) {
        const int b = item >> 5, pr = item & 31;
#pragma unroll 1
        for (int which = 0; which < 2; ++which) {
            const int ch = which ? 63 - pr : pr, L = 64 * (ch + 1), t0 = 64 * ch;
            if (L > 256) {
            const size_t m = (size_t)b * SEQ + t0 + 16 * qg + n16;
            float* srow = scr + (size_t)(16 * qg + n16) * L + 4 * g;
            const int nt = L >> 5, j0 = kh * nt, j1 = j0 + nt;
            const bf16* kp = KIDX + ((size_t)b * SEQ + n16) * 64 + 8 * g;
            {
                bf16x8 Qi[16][2]; float w[16];
                { const bf16* qp = QALL + m * QC + 2304 + 8 * g;
#pragma unroll
                  for (int h = 0; h < 16; ++h) { Qi[h][0] = *(const bf16x8*)(qp + h * 64); Qi[h][1] = *(const bf16x8*)(qp + h * 64 + 32); }
                  {
                      float cs[8], sn[8]; const f32x4 c0 = *(const f32x4*)(ROPEI + m * 16), c1 = *(const f32x4*)(ROPEI + m * 16 + 4), s0 = *(const f32x4*)(ROPEI + m * 16 + 8), s1 = *(const f32x4*)(ROPEI + m * 16 + 12);
                      cs[0] = c0.x; cs[1] = c0.y; cs[2] = c0.z; cs[3] = c0.w; cs[4] = c1.x; cs[5] = c1.y; cs[6] = c1.z; cs[7] = c1.w; sn[0] = s0.x; sn[1] = s0.y; sn[2] = s0.z; sn[3] = s0.w; sn[4] = s1.x; sn[5] = s1.y; sn[6] = s1.z; sn[7] = s1.w;
#pragma unroll
                      for (int h = 0; h < 16; ++h) { const bf16x8 pf = xchg_frag(Qi[h][0], 16); const bf16x8 rf = rope_frag(Qi[h][0], pf, cs, sn, g == 0); if (g < 2) Qi[h][0] = rf; } }
                  const f32x4* wp = (const f32x4*)(WIDX + m * 16);
#pragma unroll
                  for (int q = 0; q < 4; ++q) { const f32x4 v = wp[q]; w[4 * q] = v.x; w[4 * q + 1] = v.y; w[4 * q + 2] = v.z; w[4 * q + 3] = v.w; } }
                bf16x8 Ka = *(const bf16x8*)(kp + (size_t)j0 * 1024), Kb = *(const bf16x8*)(kp + (size_t)j0 * 1024 + 32);
#pragma unroll 1
                for (int j = j0; j < j1; ++j) {
                    const int jn = (j + 1 < j1) ? j + 1 : j;
                    const bf16x8 Na = *(const bf16x8*)(kp + (size_t)jn * 1024), Nb = *(const bf16x8*)(kp + (size_t)jn * 1024 + 32);
                    f32x2 s01 = (f32x2){0.f, 0.f}, s23 = (f32x2){0.f, 0.f};
                    f32x4 a = __builtin_amdgcn_mfma_f32_16x16x32_bf16(Ka, Qi[0][0], (f32x4){0.f, 0.f, 0.f, 0.f}, 0, 0, 0); a = __builtin_amdgcn_mfma_f32_16x16x32_bf16(Kb, Qi[0][1], a, 0, 0, 0);
#pragma unroll
                    for (int h = 0; h < 16; ++h) { f32x4 an = a;
                        if (h < 15) { an = __builtin_amdgcn_mfma_f32_16x16x32_bf16(Ka, Qi[h + 1][0], (f32x4){0.f, 0.f, 0.f, 0.f}, 0, 0, 0); an = __builtin_amdgcn_mfma_f32_16x16x32_bf16(Kb, Qi[h + 1][1], an, 0, 0, 0); }
                        const f32x2 wv = (f32x2){w[h], w[h]};
                        s01 = (f32x2){relu1(a[0]), relu1(a[1])} * wv + s01; s23 = (f32x2){relu1(a[2]), relu1(a[3])} * wv + s23; a = an; }
                    *(f32x4*)(srow + 16 * j) = (f32x4){s01.x, s01.y, s23.x, s23.y};
                    Ka = Na; Kb = Nb;
                }
            }
            }
            asm volatile("s_waitcnt vmcnt(0)" ::: "memory");
            __syncthreads();
            __builtin_amdgcn_fence(__ATOMIC_ACQUIRE, "agent");
            asm volatile("s_waitcnt vmcnt(0)" ::: "memory");
#pragma unroll 1
            for (int i = 0; i < 8; ++i) {
                const int ql = c.wave * 8 + i;
                unsigned short* sel = (unsigned short*)SEL + ((size_t)b * SEQ + t0 + ql) * 256;
                if (L <= 256) { for (int k = l; k < 256; k += 64) sel[k] = (unsigned short)(k < L ? k : 0); }
                else select_row_bs(scr + (size_t)ql * L, L, sel, l, (unsigned short*)(c.lds + c.wave * 512));
            }
            __syncthreads();
        }
    }
}
__device__ __forceinline__ void diag_cmp_sel(const Ctx& c, const bf16* SA, const bf16* SB, int nbatch, float* acc) {
    unsigned* bm = (unsigned*)(c.lds + c.wave * 512);
    float miss = 0.f, tot = 0.f;
    for (int m = c.gw; m < nbatch * SEQ; m += c.ngw) {
        const int t = m % SEQ; if (t < 256) continue;
        bm[c.lane] = 0u; bm[64 + c.lane] = 0u;
        __builtin_amdgcn_fence(__ATOMIC_RELEASE, "wavefront"); __builtin_amdgcn_wave_barrier();
        for (int i = c.lane; i < 256; i += 64) { const unsigned s = ((const unsigned short*)SA)[(size_t)m * 256 + i]; atomicOr(&bm[s >> 5], 1u << (s & 31)); }
        __builtin_amdgcn_fence(__ATOMIC_RELEASE, "wavefront"); __builtin_amdgcn_wave_barrier(); __builtin_amdgcn_fence(__ATOMIC_ACQUIRE, "wavefront");
        for (int i = c.lane; i < 256; i += 64) { const unsigned s = ((const unsigned short*)SB)[(size_t)m * 256 + i]; miss += ((bm[s >> 5] >> (s & 31)) & 1u) ? 0.f : 1.f; tot += 1.f; }
        __builtin_amdgcn_fence(__ATOMIC_RELEASE, "wavefront"); __builtin_amdgcn_wave_barrier();
    }
    miss = wave_sum(miss); tot = wave_sum(tot);
    if (c.lane == 0) { atomicAdd(acc, miss); atomicAdd(acc + 1, tot); }
}
__device__ __forceinline__ void idx_topk_lds(const Ctx& c, const bf16* __restrict__ QALL, const bf16* __restrict__ KIDX, const float* __restrict__ WIDX, const float* __restrict__ ROPEI, u32x4* qscr, bf16* SEL, int nitems) {
    float* SCL = (float*)c.lds;
    f32x4* WL = (f32x4*)(c.lds + 131072);
    const int w8 = c.wave;
#pragma unroll 1
    for (int item = c.bid; item < nitems; item += c.nb) {
        const int b = item >> 5, pr = item & 31;
#pragma unroll 1
        for (int which = 0; which < 2; ++which) {
            int l = c.lane; asm volatile("" : "+v"(l));
            const int n16 = l & 15, g = l >> 4;
            const int ch = which ? 63 - pr : pr, L = 64 * (ch + 1), t0 = 64 * ch;
            if (L <= 256) {
#pragma unroll 1
                for (int i = 0; i < 8; ++i) { unsigned short* sel = (unsigned short*)SEL + ((size_t)b * SEQ + t0 + w8 * 8 + i) * 256; for (int k = l; k < 256; k += 64) sel[k] = (unsigned short)(k < L ? k : 0); }
                continue;
            }
            __syncthreads();
            if (w8 < 4) {
                const size_t m = (size_t)b * SEQ + t0 + 16 * w8 + n16;
                const bf16* qp = QALL + m * QC + 2304 + 8 * g;
                float cs[8], sn[8]; const f32x4 c0 = *(const f32x4*)(ROPEI + m * 16), c1 = *(const f32x4*)(ROPEI + m * 16 + 4), s0 = *(const f32x4*)(ROPEI + m * 16 + 8), s1 = *(const f32x4*)(ROPEI + m * 16 + 12);
                cs[0] = c0.x; cs[1] = c0.y; cs[2] = c0.z; cs[3] = c0.w; cs[4] = c1.x; cs[5] = c1.y; cs[6] = c1.z; cs[7] = c1.w; sn[0] = s0.x; sn[1] = s0.y; sn[2] = s0.z; sn[3] = s0.w; sn[4] = s1.x; sn[5] = s1.y; sn[6] = s1.z; sn[7] = s1.w;
#pragma unroll 4
                for (int h = 0; h < 16; ++h) { bf16x8 f0 = *(const bf16x8*)(qp + h * 64); const bf16x8 f1 = *(const bf16x8*)(qp + h * 64 + 32);
                    const bf16x8 pf = xchg_frag(f0, 16); const bf16x8 rf = rope_frag(f0, pf, cs, sn, g == 0); if (g < 2) f0 = rf;
                    qscr[(w8 * 64 + l) * 32 + h * 2] = __builtin_bit_cast(u32x4, f0); qscr[(w8 * 64 + l) * 32 + h * 2 + 1] = __builtin_bit_cast(u32x4, f1); }
            }
            asm volatile("s_waitcnt vmcnt(0)" ::: "memory");
            __syncthreads();
            __builtin_amdgcn_fence(__ATOMIC_ACQUIRE, "agent"); asm volatile("s_waitcnt vmcnt(0)" ::: "memory");
            const bf16* kp = KIDX + ((size_t)b * SEQ + n16) * 64 + 8 * g;
            const int ntile = L >> 4;
#pragma unroll 1
            for (int qsub = 0; qsub < 8; ++qsub) {
                asm volatile("" ::: "memory");
                bf16x8 Qi[16][2];
                { const int srcl = g * 16 + (qsub & 1) * 8 + (n16 & 7); const u32x4* fp = qscr + (size_t)((qsub >> 1) * 64 + srcl) * 32;
#pragma unroll
                  for (int h = 0; h < 16; ++h) { Qi[h][0] = __builtin_bit_cast(bf16x8, fp[h * 2]); Qi[h][1] = __builtin_bit_cast(bf16x8, fp[h * 2 + 1]); }
                  if (w8 == 0 && l < 32) WL[l] = *(const f32x4*)(WIDX + ((size_t)b * SEQ + t0 + 8 * qsub + (l >> 2)) * 16 + 4 * (l & 3)); }
                __syncthreads();
                const f32x4* wq = WL + (n16 & 7) * 4;
                float* srow = SCL + (n16 & 7) * 4096 + 4 * g;
                int j = w8;
                bf16x8 Ka = *(const bf16x8*)(kp + (size_t)j * 1024), Kb = *(const bf16x8*)(kp + (size_t)j * 1024 + 32);
#pragma unroll 1
                for (; j < ntile; j += 8) {
                    const int jn = (j + 8 < ntile) ? j + 8 : j;
                    const bf16x8 Na = *(const bf16x8*)(kp + (size_t)jn * 1024), Nb = *(const bf16x8*)(kp + (size_t)jn * 1024 + 32);
                    f32x2 s01 = (f32x2){0.f, 0.f}, s23 = (f32x2){0.f, 0.f};
                    f32x4 a = __builtin_amdgcn_mfma_f32_16x16x32_bf16(Ka, Qi[0][0], (f32x4){0.f, 0.f, 0.f, 0.f}, 0, 0, 0); a = __builtin_amdgcn_mfma_f32_16x16x32_bf16(Kb, Qi[0][1], a, 0, 0, 0);
#pragma unroll
                    for (int h4 = 0; h4 < 4; ++h4) { const f32x4 w4 = wq[h4];
#pragma unroll
                        for (int hh = 0; hh < 4; ++hh) { const int h = 4 * h4 + hh; f32x4 an = a;
                            if (h < 15) { an = __builtin_amdgcn_mfma_f32_16x16x32_bf16(Ka, Qi[h + 1][0], (f32x4){0.f, 0.f, 0.f, 0.f}, 0, 0, 0); an = __builtin_amdgcn_mfma_f32_16x16x32_bf16(Kb, Qi[h + 1][1], an, 0, 0, 0); }
                            const f32x2 wv = (f32x2){w4[hh], w4[hh]};
                            s01 = (f32x2){relu1(a[0]), relu1(a[1])} * wv + s01; s23 = (f32x2){relu1(a[2]), relu1(a[3])} * wv + s23; a = an; } }
                    if (n16 < 8) *(f32x4*)(srow + 16 * j) = (f32x4){s01.x, s01.y, s23.x, s23.y};
                    Ka = Na; Kb = Nb;
                }
                __syncthreads();
                select_row(SCL + w8 * 4096, L, (unsigned short*)SEL + ((size_t)b * SEQ + t0 + 8 * qsub + w8) * 256, l);
                __syncthreads();
            }
        }
    }
}
#if DIAG == 7
__device__ __forceinline__ void select_row_v1(const float* row, int limit, unsigned short* sel, int l_in) {
    int l = l_in; asm volatile("" : "+v"(l));
    const int ng = limit >> 9;
    unsigned key[64];
#pragma unroll
    for (int j = 0; j < 64; ++j) { const int s = j * 64 + l; unsigned u = 0u; if (s < limit) { u = __float_as_uint(row[s]); u = (u & 0x80000000u) ? ~u : (u | 0x80000000u); } key[j] = u; }
    unsigned mx = 0u;
#pragma unroll
    for (int j = 0; j < 64; ++j) mx = key[j] > mx ? key[j] : mx;
#pragma unroll
    for (int o = 1; o < 64; o <<= 1) { const unsigned t = (unsigned)__shfl_xor((int)mx, o); mx = t > mx ? t : mx; }
    mx = (unsigned)__builtin_amdgcn_readfirstlane((int)mx);
    unsigned T = 0u;
#pragma unroll 1
    for (int bit = 31 - __builtin_clz(mx | 1u); bit >= 0; --bit) {
        const unsigned Tn = T | (1u << bit); int cnt = 0;
#pragma unroll
        for (int jg = 0; jg < 8; ++jg) if (jg <= ng) {
#pragma unroll
            for (int j = 8 * jg; j < 8 * jg + 8; ++j) cnt += __popcll(__ballot(key[j] >= Tn)); }
        if (cnt >= 256) T = Tn;
        if (cnt == 256) break;
    }
    int cgt = 0;
#pragma unroll
    for (int j = 0; j < 64; ++j) cgt += __popcll(__ballot(key[j] > T));
    const int need_eq = 256 - cgt;
    int base = 0, beq = 0;
    const unsigned long long lt = (1ull << l) - 1ull;
#pragma unroll
    for (int jg = 0; jg < 8; ++jg) if (jg <= ng) {
#pragma unroll
        for (int j = 8 * jg; j < 8 * jg + 8; ++j) {
            const unsigned long long mg = __ballot(key[j] > T), me = __ballot(key[j] == T);
            if (key[j] > T) sel[base + __popcll(mg & lt)] = (unsigned short)(j * 64 + l);
            base += __popcll(mg);
            const int pe = beq + __popcll(me & lt);
            if (key[j] == T && pe < need_eq) sel[cgt + pe] = (unsigned short)(j * 64 + l);
            beq += __popcll(me);
        }
    }
}
__device__ __forceinline__ void idx_topk_v1(const Ctx& c, const bf16* __restrict__ QALL, const bf16* __restrict__ KIDX, const float* __restrict__ WIDX, float* scr, bf16* SEL, int nitems) {
    const int l = c.lane, n16 = l & 15, g = l >> 4, qg = c.wave & 3, kh = c.wave >> 2;
#pragma unroll 1
    for (int item = c.bid; item < nitems; item += c.nb) {
        const int b = item >> 5, pr = item & 31;
#pragma unroll 1
        for (int which = 0; which < 2; ++which) {
            const int ch = which ? 63 - pr : pr, L = 64 * (ch + 1), t0 = 64 * ch;
            if (L > 256) {
            const size_t m = (size_t)b * SEQ + t0 + 16 * qg + n16;
            float* srow = scr + (size_t)(16 * qg + n16) * L + 4 * g;
            const int nt = L >> 5, j0 = kh * nt, j1 = j0 + nt;
            const bf16* kp = KIDX + ((size_t)b * SEQ + n16) * 64 + 8 * g;
#pragma unroll 1
            for (int hp = 0; hp < 2; ++hp) {
                bf16x8 Qi[8][2]; float w[8];
                { const bf16* qp = QALL + m * QC + 2304 + hp * 512 + 8 * g;
#pragma unroll
                  for (int h = 0; h < 8; ++h) { Qi[h][0] = *(const bf16x8*)(qp + h * 64); Qi[h][1] = *(const bf16x8*)(qp + h * 64 + 32); }
                  const f32x4* wp = (const f32x4*)(WIDX + m * 16 + hp * 8);
#pragma unroll
                  for (int q = 0; q < 2; ++q) { const f32x4 v = wp[q]; w[4 * q] = v.x; w[4 * q + 1] = v.y; w[4 * q + 2] = v.z; w[4 * q + 3] = v.w; } }
                if (hp) { asm volatile("s_waitcnt vmcnt(0)" ::: "memory"); __builtin_amdgcn_fence(__ATOMIC_ACQUIRE, "agent"); asm volatile("s_waitcnt vmcnt(0)" ::: "memory"); }
                bf16x8 Ka = *(const bf16x8*)(kp + (size_t)j0 * 1024), Kb = *(const bf16x8*)(kp + (size_t)j0 * 1024 + 32);
                f32x4 pv = (f32x4){0.f, 0.f, 0.f, 0.f}; if (hp) pv = *(const f32x4*)(srow + 16 * j0);
#pragma unroll 1
                for (int j = j0; j < j1; ++j) {
                    const int jn = (j + 1 < j1) ? j + 1 : j;
                    const bf16x8 Na = *(const bf16x8*)(kp + (size_t)jn * 1024), Nb = *(const bf16x8*)(kp + (size_t)jn * 1024 + 32);
                    f32x4 pn = (f32x4){0.f, 0.f, 0.f, 0.f}; if (hp) pn = *(const f32x4*)(srow + 16 * jn);
                    f32x4 sc = pv;
#pragma unroll
                    for (int h = 0; h < 8; ++h) { f32x4 a = __builtin_amdgcn_mfma_f32_16x16x32_bf16(Ka, Qi[h][0], (f32x4){0.f, 0.f, 0.f, 0.f}, 0, 0, 0); a = __builtin_amdgcn_mfma_f32_16x16x32_bf16(Kb, Qi[h][1], a, 0, 0, 0);
                        sc[0] += w[h] * fmaxf(a[0], 0.f); sc[1] += w[h] * fmaxf(a[1], 0.f); sc[2] += w[h] * fmaxf(a[2], 0.f); sc[3] += w[h] * fmaxf(a[3], 0.f); }
                    *(f32x4*)(srow + 16 * j) = sc;
                    Ka = Na; Kb = Nb; pv = pn;
                }
            }
            }
            asm volatile("s_waitcnt vmcnt(0)" ::: "memory");
            __syncthreads();
            __builtin_amdgcn_fence(__ATOMIC_ACQUIRE, "agent");
            asm volatile("s_waitcnt vmcnt(0)" ::: "memory");
#pragma unroll 1
            for (int i = 0; i < 8; ++i) {
                const int ql = c.wave * 8 + i;
                unsigned short* sel = (unsigned short*)SEL + ((size_t)b * SEQ + t0 + ql) * 256;
                if (L <= 256) { for (int k = l; k < 256; k += 64) sel[k] = (unsigned short)(k < L ? k : 0); }
                else select_row_v1(scr + (size_t)ql * L, L, sel, l);
            }
            __syncthreads();
        }
    }
}
#endif
constexpr int RW_TB = 32;
struct RwkvP { const float *mu, *w0, *w2, *a0, *a2, *g2, *k_k, *k_a, *r_k, *ln_w, *ln_b; };
__device__ __forceinline__ void rwkv_phase(const Ctx& c, const bf16* __restrict__ H, const RwkvP P, bf16* OLY) {
    float* A_WR = (float*)c.lds;
    float* A_K2 = A_WR + RW_TB * 64;
    float* A_V = A_K2 + RW_TB * 64;
    float* A_W = A_V + RW_TB * 64;
    float* A_NKK = A_W + RW_TB * 64;
    float* A_B = A_NKK + RW_TB * 64;
    float* A_G = A_B + RW_TB * 64;
    float* A_OUT = A_G + RW_TB * 64;
    float* L_TW = A_OUT + RW_TB * 64;
    float* L_AL = L_TW + RW_TB * 64;
    float* L_SG = L_AL + RW_TB * 64;
    float* SC1 = L_SG + RW_TB * 160; float* SC2 = SC1 + RW_TB; float* SC3 = SC2 + RW_TB;
    const int l = c.lane, w = c.wave;
    for (int item = c.bid; item < NB * 16; item += c.nb) {
        const int b = item >> 4, h = item & 15, hk = h * 64 + l;
        const float w0v = P.w0[hk], a0v = P.a0[hk], kkv = P.k_k[hk], kav = P.k_a[hk], rkv = P.r_k[hk], lnw = P.ln_w[hk], lnb = P.ln_b[hk];
        float S[8];
#pragma unroll
        for (int i = 0; i < 8; ++i) S[i] = 0.f;
        const int srow = w * 8 + (l >> 3), sj = l & 7;
        for (int t0 = 0; t0 < SEQ; t0 += RW_TB) {
            __syncthreads();
            for (int idx = c.tid; idx < RW_TB * 480; idx += NTHR) {
                const int t = idx / 480, cc = idx % 480; int col; float* dst;
                if (cc < 64) { col = 880 + h * 64 + cc; dst = A_WR + t * 64 + cc; }
                else if (cc < 128) { col = 1904 + h * 64 + (cc - 64); dst = A_K2 + t * 64 + (cc - 64); }
                else if (cc < 192) { col = 2928 + h * 64 + (cc - 128); dst = A_V + t * 64 + (cc - 128); }
                else if (cc < 256) { col = 3952 + (cc - 192); dst = L_TW + t * 64 + (cc - 192); }
                else if (cc < 320) { col = 4016 + (cc - 256); dst = L_AL + t * 64 + (cc - 256); }
                else { col = 4080 + (cc - 320); dst = L_SG + t * 160 + (cc - 320); }
                const size_t m = (size_t)b * SEQ + t0 + t;
                const float x = bf2f(H[m * HC + col]); const float xp = (t0 + t > 0) ? bf2f(H[(m - 1) * HC + col]) : 0.f;
                float hm = x + (xp - x) * P.mu[col - 880];
                if (cc >= 192 && cc < 256) hm = tanhf(hm); else if (cc >= 320) hm = sigmoidf_(hm);
                *dst = hm;
            }
            __syncthreads();
            {
                float wl[RW_TB / 8], al[RW_TB / 8], gg[RW_TB / 8];
#pragma unroll
                for (int i = 0; i < RW_TB / 8; ++i) { wl[i] = 0.f; al[i] = 0.f; gg[i] = 0.f; }
                for (int j = 0; j < 64; ++j) { const float w2v = P.w2[(size_t)j * 1024 + hk], a2v = P.a2[(size_t)j * 1024 + hk];
#pragma unroll
                    for (int i = 0; i < RW_TB / 8; ++i) { wl[i] += L_TW[(w + 8 * i) * 64 + j] * w2v; al[i] += L_AL[(w + 8 * i) * 64 + j] * a2v; } }
                for (int j = 0; j < 160; ++j) { const float g2v = P.g2[(size_t)j * 1024 + hk];
#pragma unroll
                    for (int i = 0; i < RW_TB / 8; ++i) gg[i] += L_SG[(w + 8 * i) * 160 + j] * g2v; }
#pragma unroll
                for (int i = 0; i < RW_TB / 8; ++i) {
                    const int t = w + 8 * i, o = t * 64 + l;
                    const float dec = __expf(-0.6065306597126334f * sigmoidf_(w0v + wl[i]));
                    const float a = sigmoidf_(a0v + al[i]);
                    const float kr = A_K2[o], r = A_WR[o];
                    float kk = kr * kkv; const float nrm = wave_sum(kk * kk); kk = kk * (1.0f / sqrtf(fmaxf(nrm, 1e-24f)));
                    const float k2 = kr * (1.f + (a - 1.f) * kav), bb = kk * a;
                    const float s1 = wave_sum(bb * r), s2 = wave_sum(k2 * r), s3 = wave_sum(r * k2 * rkv);
                    A_W[o] = dec; A_NKK[o] = -kk; A_B[o] = bb; A_K2[o] = k2; A_WR[o] = dec * r; A_G[o] = gg[i];
                    if (l == 0) { SC1[t] = s1; SC2[t] = s2; SC3[t] = s3; }
                }
            }
            __syncthreads();
            for (int t = 0; t < RW_TB; ++t) {
                const f32x4* pw = (const f32x4*)(A_W + t * 64 + 8 * sj); const f32x4* pn = (const f32x4*)(A_NKK + t * 64 + 8 * sj); const f32x4* pb = (const f32x4*)(A_B + t * 64 + 8 * sj);
                const f32x4* pk = (const f32x4*)(A_K2 + t * 64 + 8 * sj); const f32x4* pr = (const f32x4*)(A_WR + t * 64 + 8 * sj);
                const f32x4 w0_ = pw[0], w1_ = pw[1], n0 = pn[0], n1 = pn[1], b0 = pb[0], b1 = pb[1], k0 = pk[0], k1 = pk[1], r0 = pr[0], r1 = pr[1];
                const float vv = A_V[t * 64 + srow], s1 = SC1[t], s2 = SC2[t];
                float sa = (S[0] * n0.x + S[1] * n0.y) + (S[2] * n0.z + S[3] * n0.w) + (S[4] * n1.x + S[5] * n1.y) + (S[6] * n1.z + S[7] * n1.w);
                float p = (S[0] * r0.x + S[1] * r0.y) + (S[2] * r0.z + S[3] * r0.w) + (S[4] * r1.x + S[5] * r1.y) + (S[6] * r1.z + S[7] * r1.w);
                sa += __shfl_xor(sa, 1); p += __shfl_xor(p, 1); sa += __shfl_xor(sa, 2); p += __shfl_xor(p, 2); sa += __shfl_xor(sa, 4); p += __shfl_xor(p, 4);
                S[0] = S[0] * w0_.x + (sa * b0.x + vv * k0.x); S[1] = S[1] * w0_.y + (sa * b0.y + vv * k0.y); S[2] = S[2] * w0_.z + (sa * b0.z + vv * k0.z); S[3] = S[3] * w0_.w + (sa * b0.w + vv * k0.w);
                S[4] = S[4] * w1_.x + (sa * b1.x + vv * k1.x); S[5] = S[5] * w1_.y + (sa * b1.y + vv * k1.y); S[6] = S[6] * w1_.z + (sa * b1.z + vv * k1.z); S[7] = S[7] * w1_.w + (sa * b1.w + vv * k1.w);
                if (sj == 0) A_OUT[t * 64 + srow] = p + sa * s1 + vv * s2;
            }
            __syncthreads();
#pragma unroll
            for (int i = 0; i < RW_TB / 8; ++i) {
                const int t = w + 8 * i, o = t * 64 + l;
                const float x = A_OUT[o]; const float mean = wave_sum(x) * (1.f / 64.f); const float dx = x - mean; const float var = wave_sum(dx * dx) * (1.f / 64.f);
                float y = dx * (1.0f / sqrtf(var + 64e-5f)) * lnw + lnb;
                y = (y + SC3[t] * A_V[o]) * A_G[o];
                OLY[((size_t)b * SEQ + t0 + t) * OC + 2048 + hk] = (bf16)f2bf(y);
            }
        }
    }
}

constexpr int S5_TB = 16;
struct S5P { const float *lam_re, *lam_im, *log_dt, *b_re, *b_im, *c_re, *c_im, *d; };
__device__ __forceinline__ float gelu_tanh(float y) { return 0.5f * y * (1.f + tanhf(0.7978845608028654f * (y + 0.044715f * y * y * y))); }
__device__ __forceinline__ void s5_phase(const Ctx& c, const bf16* __restrict__ U, const S5P P, bf16* Z) {
    constexpr int PERW = 256 + 2 * S5_TB * 65 + 2 * 64 * 16;
    float* UU = (float*)c.lds + c.wave * PERW;
    float* XSr = UU + 256; float* XSi = XSr + S5_TB * 65;
    float* CTr = XSi + S5_TB * 65; float* CTi = CTr + 64 * 16;
    const int l = c.lane;
    for (int item = c.bid; item < NB * 16; item += c.nb) {
        const int b = item >> 4, g = (item & 15) * 8 + c.wave;
        __syncthreads();
        float lbr, lbi, Br[16], Bi[16];
        {
            const float lr = fminf(P.lam_re[g * 64 + l], -1e-4f), li = P.lam_im[g * 64 + l], dt = expf(P.log_dt[g]);
            const float e = expf(lr * dt); lbr = e * cosf(li * dt); lbi = e * sinf(li * dt);
            const float nr = lbr - 1.f, ni = lbi, den = 1.f / (lr * lr + li * li);
            const float cr = (nr * lr + ni * li) * den, ci = (ni * lr - nr * li) * den;
#pragma unroll
            for (int i = 0; i < 16; ++i) { const float br = P.b_re[(size_t)(g * 64 + l) * 16 + i], bi = P.b_im[(size_t)(g * 64 + l) * 16 + i]; Br[i] = cr * br - ci * bi; Bi[i] = cr * bi + ci * br; }
#pragma unroll
            for (int o = 0; o < 16; ++o) { CTr[l * 16 + o] = P.c_re[(size_t)(g * 16 + o) * 64 + l]; CTi[l * 16 + o] = P.c_im[(size_t)(g * 16 + o) * 64 + l]; }
        }
        float dsk[4];
#pragma unroll
        for (int e = 0; e < 4; ++e) dsk[e] = P.d[g * 16 + (l >> 4) * 4 + e];
        float xr = 0.f, xi = 0.f;
        for (int t0 = 0; t0 < SEQ; t0 += S5_TB) {
            __syncthreads();
            { const int row = l >> 2, q = l & 3; const u32x2 w2 = *(const u32x2*)(U + ((size_t)b * SEQ + t0 + row) * D + g * 16 + 4 * q);
              float* d = UU + row * 16 + 4 * q; d[0] = bf2f(w2.x & 0xffffu); d[1] = bf2f(w2.x >> 16); d[2] = bf2f(w2.y & 0xffffu); d[3] = bf2f(w2.y >> 16); }
            __syncthreads();
            for (int t = 0; t < S5_TB; ++t) {
                const f32x4* up = (const f32x4*)(UU + t * 16); const f32x4 u0 = up[0], u1 = up[1], u2 = up[2], u3 = up[3];
                const float u[16] = {u0.x, u0.y, u0.z, u0.w, u1.x, u1.y, u1.z, u1.w, u2.x, u2.y, u2.z, u2.w, u3.x, u3.y, u3.z, u3.w};
                float bur = 0.f, bui = 0.f;
#pragma unroll
                for (int i = 0; i < 16; ++i) { bur += Br[i] * u[i]; bui += Bi[i] * u[i]; }
                const float nxr = lbr * xr - lbi * xi + bur, nxi = lbr * xi + lbi * xr + bui; xr = nxr; xi = nxi;
                XSr[t * 65 + l] = xr; XSi[t * 65 + l] = xi;
            }
            __syncthreads();
            {   const int t = l & 15, oq = l >> 4; float y[4] = {0.f, 0.f, 0.f, 0.f};
                for (int p = 0; p < 64; ++p) { const float a = XSr[t * 65 + p], bb = XSi[t * 65 + p]; const f32x4 cr = *(const f32x4*)(CTr + p * 16 + oq * 4), ci = *(const f32x4*)(CTi + p * 16 + oq * 4);
                    y[0] += a * cr.x - bb * ci.x; y[1] += a * cr.y - bb * ci.y; y[2] += a * cr.z - bb * ci.z; y[3] += a * cr.w - bb * ci.w; }
                float z[4];
#pragma unroll
                for (int e = 0; e < 4; ++e) z[e] = gelu_tanh(y[e] + dsk[e] * UU[t * 16 + oq * 4 + e]);
                u32x2 o; o.x = pk2(z[0], z[1]); o.y = pk2(z[2], z[3]);
                *(u32x2*)(Z + ((size_t)b * SEQ + t0 + t) * D + g * 16 + oq * 4) = o; }
        }
    }
}
template <int CTRL> __device__ __forceinline__ float dpp_mov(float v) { return __builtin_bit_cast(float, __builtin_amdgcn_update_dpp(0, __builtin_bit_cast(int, v), CTRL, 0xf, 0xf, true)); }
__device__ __forceinline__ float sum8(float v) { v += dpp_mov<0xB1>(v); v += dpp_mov<0x4E>(v); v += dpp_mov<0x141>(v); return v; }
__device__ __forceinline__ float wave_sum_fast(float v) { v += dpp_mov<0xB1>(v); v += dpp_mov<0x4E>(v); v += dpp_mov<0x141>(v); v += dpp_mov<0x140>(v); v += __shfl_xor(v, 16); v += __shfl_xor(v, 32); return v; }
__device__ __forceinline__ float fast_tanh(float x) { const float e = __expf(2.f * x); return 1.f - 2.f * __builtin_amdgcn_rcpf(e + 1.f); }
__device__ __forceinline__ void rwkv_lora_prep(const Ctx& c, const bf16* __restrict__ H, const float* __restrict__ mu, bf16* LX) {
    const int l = c.lane;
    const int per = (M + c.ngw - 1) / c.ngw;
    const int mA = c.gw * per, mE = (mA + per < M) ? mA + per : M;
    if (l < 36 && mA < M) {
        const int col = 3952 + 8 * l;
        const f32x4 m0 = *(const f32x4*)(mu + 3072 + 8 * l), m1 = *(const f32x4*)(mu + 3072 + 8 * l + 4);
        const float mv[8] = {m0.x, m0.y, m0.z, m0.w, m1.x, m1.y, m1.z, m1.w};
        float p[8];
        if ((mA % SEQ) > 0) unpack8(*(const u32x4*)(H + (size_t)(mA - 1) * HC + col), p); else {
#pragma unroll
            for (int j = 0; j < 8; ++j) p[j] = 0.f; }
#pragma unroll 1
        for (int mb = mA; mb < mE; mb += 8) {
            u32x4 rq[8];
#pragma unroll
            for (int i = 0; i < 8; ++i) { const int mm = (mb + i < mE) ? mb + i : mE - 1; rq[i] = *(const u32x4*)(H + (size_t)mm * HC + col); }
#pragma unroll
            for (int i = 0; i < 8; ++i) { const int m = mb + i;
                if (m < mE) {
                    float x[8]; unpack8(rq[i], x);
                    if ((m % SEQ) == 0) {
#pragma unroll
                        for (int j = 0; j < 8; ++j) p[j] = 0.f; }
                    float hm[8];
#pragma unroll
                    for (int j = 0; j < 8; ++j) { float v = x[j] + (p[j] - x[j]) * mv[j]; if (l < 8) v = fast_tanh(v); else if (l >= 16) v = sigmoidf_(v); hm[j] = v; p[j] = x[j]; }
                    u32x4 o; o.x = pg8::cvt_pk_bf16(hm[0], hm[1]); o.y = pg8::cvt_pk_bf16(hm[2], hm[3]); o.z = pg8::cvt_pk_bf16(hm[4], hm[5]); o.w = pg8::cvt_pk_bf16(hm[6], hm[7]);
                    *(u32x4*)(LX + (size_t)m * 288 + 8 * l) = o;
                }
            }
        }
    }
}
constexpr int RW2_RAWP = 384;
constexpr int RW2_TWP = 144, RW2_SGP = 336;
__device__ __forceinline__ void rwkv_phase2(const Ctx& c, const bf16* __restrict__ H, const bf16* __restrict__ LX, const RwkvP P, bf16* OUT, int ldo, int coloff, int wb = NB) {
    unsigned char* RAW = c.lds;
    float* A_WR = (float*)(c.lds + 12800);
    float* A_K2 = A_WR + 2048; float* A_V = A_K2 + 2048; float* A_W = A_V + 2048; float* A_NKK = A_W + 2048; float* A_B = A_NKK + 2048; float* A_G = A_B + 2048; float* A_OUT = A_G + 2048;
    float* LO_W = A_OUT + 2048; float* LO_A = LO_W + 2048; float* PR3 = LO_A + 2048;
    unsigned char* L_TW = (unsigned char*)(PR3 + 2048); unsigned char* L_AL = L_TW + 32 * RW2_TWP; unsigned char* L_SG = L_AL + 32 * RW2_TWP;
    float* MU = (float*)(L_SG + 32 * RW2_SGP); float* SC3 = MU + 480 + 64;
    unsigned char* G2T = (unsigned char*)(SC3 + 32);
    float* SCP = (float*)(G2T + 64 * RW2_SGP);
    float* GN = SCP + 128; float* CST = GN + 64;
    float* PR0 = (float*)L_TW; float* PR1 = PR0 + 2048; float* PR2 = A_OUT;
    const int l = c.lane, w = c.wave, n16 = l & 15, g = l >> 4;
#pragma unroll 1
    for (int item = c.bid; item < NB * 16; item += c.nb) {
        const int b = item >> 4, h = item & 15, hk = h * 64 + l;
        __syncthreads();
        if (w < 7) { const float* src = w == 0 ? P.w0 : w == 1 ? P.a0 : w == 2 ? P.k_k : w == 3 ? P.k_a : w == 4 ? P.r_k : w == 5 ? P.ln_w : P.ln_b; CST[w * 64 + l] = src[hk]; }
#pragma unroll 1
        for (int qb = 0; qb < 20; qb += 5) {
            float gq[5];
#pragma unroll
            for (int q = 0; q < 5; ++q) { const int i = c.tid + NTHR * (qb + q); gq[q] = P.g2[(size_t)(i >> 6) * 1024 + h * 64 + (i & 63)]; }
#pragma unroll
            for (int q = 0; q < 5; ++q) { const int i = c.tid + NTHR * (qb + q); *(unsigned short*)(G2T + (i & 63) * RW2_SGP + (i >> 6) * 2) = (unsigned short)f2bf(gq[q]); }
        }
        for (int i = c.tid; i < 192; i += NTHR) { const int mi = i < 64 ? h * 64 + i : i < 128 ? 1024 + h * 64 + (i - 64) : 2048 + h * 64 + (i - 128); MU[i] = P.mu[mi]; }
        const int tt = w >> 2, nt = w & 3;
        bf16x8 W2B[2], A2B[2];
        { const int kc = h * 64 + 16 * nt + n16;
          auto ldfrag = [&](const float* Wp, int kk) -> bf16x8 { float f[8]; int gq = g, kq = kc; asm volatile("" : "+v"(gq), "+v"(kq));
              const float* wp = Wp + (size_t)(32 * kk + 8 * gq) * 1024 + kq;
#pragma unroll
              for (int q = 0; q < 8; ++q) f[q] = wp[q * 1024];
              u32x4 u; u.x = pk2(f[0], f[1]); u.y = pk2(f[2], f[3]); u.z = pk2(f[4], f[5]); u.w = pk2(f[6], f[7]);
              asm volatile("" : "+v"(u));
              return __builtin_bit_cast(bf16x8, u); };
          W2B[0] = ldfrag(P.w2, 0); W2B[1] = ldfrag(P.w2, 1); A2B[0] = ldfrag(P.a2, 0); A2B[1] = ldfrag(P.a2, 1);
        }
        f32x2 S[4];
#pragma unroll
        for (int i = 0; i < 4; ++i) S[i] = (f32x2){0.f, 0.f};
        const int srow = w * 8 + (l >> 3), sj = l & 7;
        u32x4 raw[4];
#define RW2_LOAD(T0) do { _Pragma("unroll") for (int k = 0; k < 4; ++k) { const int q_ = c.tid + 512 * k; \
            const int cq_ = q_ % 24; int tg = (T0) - 1 + q_ / 24; tg = tg < 0 ? 0 : tg; const int rc_ = (cq_ < 8 ? 880 : cq_ < 16 ? 1904 - 64 : 2928 - 128) + h * 64 + cq_ * 8; \
            int e_ = q_ - 792; e_ = (e_ < 0 || e_ >= 1152) ? 0 : e_; \
            const bf16* src_ = (q_ < 792) ? H + ((size_t)b * SEQ + tg) * HC + rc_ : LX + ((size_t)b * SEQ + (T0) + e_ / 36) * 288 + (e_ % 36) * 8; \
            raw[k] = *(const u32x4*)src_; } } while (0)
        RW2_LOAD(0);
#pragma unroll 1
        for (int t0 = 0; t0 < SEQ; t0 += 32) {
            __syncthreads();
#pragma unroll
            for (int k = 0; k < 4; ++k) { const int q_ = c.tid + 512 * k;
                if (q_ < 792) *(u32x4*)(RAW + (q_ / 24) * RW2_RAWP + (q_ % 24) * 16) = (t0 == 0 && q_ < 24) ? (u32x4){0u, 0u, 0u, 0u} : raw[k];
                else if (q_ < 1944) { const int e_ = q_ - 792, t_ = e_ / 36, p_ = e_ % 36;
                    unsigned char* d_ = p_ < 8 ? L_TW + t_ * RW2_TWP + p_ * 16 : p_ < 16 ? L_AL + t_ * RW2_TWP + (p_ - 8) * 16 : L_SG + t_ * RW2_SGP + (p_ - 16) * 16; *(u32x4*)d_ = raw[k]; } }
            { const int tn_ = (t0 + 32 < SEQ) ? t0 + 32 : t0; RW2_LOAD(tn_); }
            __syncthreads();
            if (c.tid < 384) {
                const int cpi = c.tid % 96, qb = c.tid / 96, cp = cpi * 2, tb = qb * 8;
                const float mu0 = MU[cp], mu1 = MU[cp + 1];
                unsigned xb = *(const unsigned*)(RAW + tb * RW2_RAWP + cp * 2);
                float p0 = bf2f(xb & 0xffffu), p1 = bf2f(xb >> 16);
                float* dst = (cp < 64 ? A_WR + cp : cp < 128 ? A_K2 + (cp - 64) : A_V + (cp - 128)) + tb * 64;
#pragma unroll
                for (int t = 0; t < 8; ++t) { const unsigned xa = *(const unsigned*)(RAW + (tb + t + 1) * RW2_RAWP + cp * 2); const float x0 = bf2f(xa & 0xffffu), x1 = bf2f(xa >> 16);
                    *(f32x2*)(dst + t * 64) = (f32x2){x0 + (p0 - x0) * mu0, x1 + (p1 - x1) * mu1}; p0 = x0; p1 = x1; }
            }
            __syncthreads();
            {
                f32x4 aw = (f32x4){0.f, 0.f, 0.f, 0.f}, aa = aw, ag = aw;
#pragma unroll
                for (int kk = 0; kk < 2; ++kk) { const bf16x8 At = *(const bf16x8*)(L_TW + (16 * tt + n16) * RW2_TWP + (32 * kk + 8 * g) * 2), Aa = *(const bf16x8*)(L_AL + (16 * tt + n16) * RW2_TWP + (32 * kk + 8 * g) * 2);
                    aw = __builtin_amdgcn_mfma_f32_16x16x32_bf16(At, W2B[kk], aw, 0, 0, 0); aa = __builtin_amdgcn_mfma_f32_16x16x32_bf16(Aa, A2B[kk], aa, 0, 0, 0); }
#pragma unroll
                for (int kk = 0; kk < 5; ++kk) { const bf16x8 Ag = *(const bf16x8*)(L_SG + (16 * tt + n16) * RW2_SGP + (32 * kk + 8 * g) * 2); const bf16x8 Gb = *(const bf16x8*)(G2T + (16 * nt + n16) * RW2_SGP + (32 * kk + 8 * g) * 2); ag = __builtin_amdgcn_mfma_f32_16x16x32_bf16(Ag, Gb, ag, 0, 0, 0); }
#pragma unroll
                for (int r = 0; r < 4; ++r) { const int o = (16 * tt + 4 * g + r) * 64 + 16 * nt + n16; LO_W[o] = aw[r]; LO_A[o] = aa[r]; A_G[o] = ag[r]; }
            }
            __syncthreads();
#pragma unroll 2
            for (int i = 0; i < 4; ++i) {
                const int t = w + 8 * i, o = t * 64 + l;
                const float w0v = CST[l], a0v = CST[64 + l], kkv = CST[128 + l], kav = CST[192 + l], rkv = CST[256 + l];
                const float dec = __expf(-0.6065306597126334f * sigmoidf_(w0v + LO_W[o]));
                const float a = sigmoidf_(a0v + LO_A[o]);
                const float kr = A_K2[o], r = A_WR[o];
                const float kk0 = kr * kkv, k2 = kr * (1.f + (a - 1.f) * kav), bb0 = kk0 * a, k2r = k2 * r;
                A_W[o] = dec; A_NKK[o] = -kk0; A_B[o] = bb0; A_K2[o] = k2; A_WR[o] = dec * r;
                PR0[o] = kk0 * kk0; PR1[o] = bb0 * r; PR2[o] = k2r; PR3[o] = k2r * rkv;
            }
            __syncthreads();
            {
                const int t = c.tid >> 4, q = (c.tid >> 2) & 3, qu = c.tid & 3;
                const float* src = (q == 0 ? PR0 : q == 1 ? PR1 : q == 2 ? PR2 : PR3) + t * 64 + 16 * qu;
                const f32x4 v0 = *(const f32x4*)src, v1 = *(const f32x4*)(src + 4), v2 = *(const f32x4*)(src + 8), v3 = *(const f32x4*)(src + 12);
                float sm = ((v0.x + v0.y) + (v0.z + v0.w)) + ((v1.x + v1.y) + (v1.z + v1.w)) + ((v2.x + v2.y) + (v2.z + v2.w)) + ((v3.x + v3.y) + (v3.z + v3.w));
                sm += dpp_mov<0xB1>(sm); sm += dpp_mov<0x4E>(sm);
                if (qu == 0) SCP[t * 4 + q] = (q == 0) ? 1.0f / fmaxf(sm, 1e-24f) : sm;
            }
            __syncthreads();
            {
                f32x4 n0, n1, r0, r1, w0_, w1_, b0, b1, k0, k1, sp; float vv;
                const unsigned char* pk_ = (const unsigned char*)A_WR + 32 * sj;
                const unsigned char* pv_ = (const unsigned char*)A_WR + 4 * srow;
                const unsigned char* ps_ = (const unsigned char*)SCP;
                constexpr int O_WR = 0, O_K2 = 8192, O_V = 16384, O_W = 24576, O_NKK = 32768, O_B = 40960, O_OUT = 57344;
#define RW2_LD_DOT(T) do { n0 = *(const f32x4*)(pk_ + O_NKK + (T) * 256); n1 = *(const f32x4*)(pk_ + O_NKK + (T) * 256 + 16); r0 = *(const f32x4*)(pk_ + O_WR + (T) * 256); r1 = *(const f32x4*)(pk_ + O_WR + (T) * 256 + 16); } while (0)
#define RW2_LD_UPD(T) do { w0_ = *(const f32x4*)(pk_ + O_W + (T) * 256); w1_ = *(const f32x4*)(pk_ + O_W + (T) * 256 + 16); b0 = *(const f32x4*)(pk_ + O_B + (T) * 256); b1 = *(const f32x4*)(pk_ + O_B + (T) * 256 + 16); \
                    k0 = *(const f32x4*)(pk_ + O_K2 + (T) * 256); k1 = *(const f32x4*)(pk_ + O_K2 + (T) * 256 + 16); vv = *(const float*)(pv_ + O_V + (T) * 256); sp = *(const f32x4*)(ps_ + (T) * 16); } while (0)
#define RW2_STEP(T) do { \
                    f32x2 sa2 = S[0] * (f32x2){n0.x, n0.y}; sa2 = S[1] * (f32x2){n0.z, n0.w} + sa2; sa2 = S[2] * (f32x2){n1.x, n1.y} + sa2; sa2 = S[3] * (f32x2){n1.z, n1.w} + sa2; \
                    f32x2 p2 = S[0] * (f32x2){r0.x, r0.y}; p2 = S[1] * (f32x2){r0.z, r0.w} + p2; p2 = S[2] * (f32x2){r1.x, r1.y} + p2; p2 = S[3] * (f32x2){r1.z, r1.w} + p2; \
                    __builtin_amdgcn_sched_barrier(0); RW2_LD_DOT((T) + 1); __builtin_amdgcn_sched_barrier(0); \
                    const float sa = sum8(sa2.x + sa2.y) * sp.x, p = sum8(p2.x + p2.y); \
                    const f32x2 sav = (f32x2){sa, sa}, vvv = (f32x2){vv, vv}; \
                    S[0] = S[0] * (f32x2){w0_.x, w0_.y} + (sav * (f32x2){b0.x, b0.y} + vvv * (f32x2){k0.x, k0.y}); \
                    S[1] = S[1] * (f32x2){w0_.z, w0_.w} + (sav * (f32x2){b0.z, b0.w} + vvv * (f32x2){k0.z, k0.w}); \
                    S[2] = S[2] * (f32x2){w1_.x, w1_.y} + (sav * (f32x2){b1.x, b1.y} + vvv * (f32x2){k1.x, k1.y}); \
                    S[3] = S[3] * (f32x2){w1_.z, w1_.w} + (sav * (f32x2){b1.z, b1.w} + vvv * (f32x2){k1.z, k1.w}); \
                    const float ov = p + sa * sp.y + vv * sp.z; \
                    __builtin_amdgcn_sched_barrier(0); RW2_LD_UPD((T) + 1); *(float*)(const_cast<unsigned char*>(pv_) + O_OUT + (T) * 256) = ov;        __builtin_amdgcn_sched_barrier(0); } while (0)
                RW2_LD_DOT(0); RW2_LD_UPD(0);
#pragma unroll 1
                for (int t4 = 0; t4 < 8; ++t4) {
                    RW2_STEP(0); RW2_STEP(1); RW2_STEP(2); RW2_STEP(3);
                    pk_ += 1024; pv_ += 1024; ps_ += 64;
                }
#undef RW2_LD_DOT
#undef RW2_LD_UPD
#undef RW2_STEP
            }
            __syncthreads();
            {
                const int t = c.tid >> 3, q = (c.tid >> 2) & 1, qu = c.tid & 3;
                if (c.tid < 256) {
                    const float* src = A_OUT + t * 64 + 16 * qu; float sm = 0.f;
#pragma unroll
                    for (int e = 0; e < 4; ++e) { const f32x4 v = *(const f32x4*)(src + 4 * e); sm += q ? ((v.x * v.x + v.y * v.y) + (v.z * v.z + v.w * v.w)) : ((v.x + v.y) + (v.z + v.w)); }
                    sm += dpp_mov<0xB1>(sm); sm += dpp_mov<0x4E>(sm);
                    const float other = dpp_mov<0x141>(sm);
                    if ((c.tid & 7) == 0) { const float mean = sm * (1.f / 64.f), var = fmaxf(other * (1.f / 64.f) - mean * mean, 0.f); GN[t * 2] = mean; GN[t * 2 + 1] = 1.0f / sqrtf(var + 64e-5f); }
                }
            }
            __syncthreads();
#pragma unroll
            for (int i = 0; i < 4; ++i) {
                const int t = w + 8 * i, o = t * 64 + l;
                float y = (A_OUT[o] - GN[t * 2]) * GN[t * 2 + 1] * CST[320 + l] + CST[384 + l];
                y = (y + SCP[t * 4 + 3] * A_V[o]) * A_G[o];
                if (b < wb) OUT[((size_t)b * SEQ + t0 + t) * ldo + coloff + hk] = (bf16)f2bf(y);
            }
        }
#undef RW2_LOAD
    }
}
constexpr int S5B_BUP = 132 * 4, S5B_XP = 272;
constexpr int S5B_WAVE = 16 * S5B_BUP + 16 * S5B_XP;
__device__ __forceinline__ void wave_lds_sync() { __builtin_amdgcn_fence(__ATOMIC_RELEASE, "wavefront"); __builtin_amdgcn_wave_barrier(); __builtin_amdgcn_fence(__ATOMIC_ACQUIRE, "wavefront"); }
__device__ __forceinline__ float gelu_fast(float y) { const float u2 = 1.5957691216057308f * (y + 0.044715f * y * y * y); return y * __builtin_amdgcn_rcpf(1.f + __expf(-u2)); }
__device__ __forceinline__ void s5_phase2(const Ctx& c, const bf16* __restrict__ U, const S5P P, bf16* Z) {
    if (c.wave >= 4) return;
    float* BU = (float*)(c.lds + c.wave * S5B_WAVE); unsigned char* XB = c.lds + c.wave * S5B_WAVE + 16 * S5B_BUP;
    const int l = c.lane, n16 = l & 15, g = l >> 4;
#pragma unroll 1
    for (int item = c.bid; item < 256; item += c.nb) {
        const int b = item >> 5, grp = (item & 31) * 4 + c.wave;
        float lbr, lbi;
        { const float lr = fminf(P.lam_re[grp * 64 + l], -1e-4f), li = P.lam_im[grp * 64 + l], dt = expf(P.log_dt[grp]);
          const float e = expf(lr * dt); lbr = e * cosf(li * dt); lbi = e * sinf(li * dt);
          const float nr = lbr - 1.f, ni = lbi, den = 1.f / (lr * lr + li * li);
          BU[l] = (nr * lr + ni * li) * den; BU[64 + l] = (ni * lr - nr * li) * den; }
        wave_lds_sync();
        bf16x4 Bre[4], Bim[4];
#pragma unroll
        for (int nt = 0; nt < 4; ++nt) { const int p = 16 * nt + n16; const float cr = BU[p], ci = BU[64 + p];
            const f32x4 br = *(const f32x4*)(P.b_re + (size_t)(grp * 64 + p) * 16 + 4 * g), bi = *(const f32x4*)(P.b_im + (size_t)(grp * 64 + p) * 16 + 4 * g);
            u32x2 wr, wi; wr.x = pk2(cr * br.x - ci * bi.x, cr * br.y - ci * bi.y); wr.y = pk2(cr * br.z - ci * bi.z, cr * br.w - ci * bi.w);
            wi.x = pk2(cr * bi.x + ci * br.x, cr * bi.y + ci * br.y); wi.y = pk2(cr * bi.z + ci * br.z, cr * bi.w + ci * br.w);
            Bre[nt] = __builtin_bit_cast(bf16x4, wr); Bim[nt] = __builtin_bit_cast(bf16x4, wi); }
        wave_lds_sync();
        bf16x8 Cf[4];
#pragma unroll
        for (int kk = 0; kk < 4; ++kk) { const int p0 = 16 * kk + 4 * g;
            const f32x4 vr = *(const f32x4*)(P.c_re + (size_t)(grp * 16 + n16) * 64 + p0), vi = *(const f32x4*)(P.c_im + (size_t)(grp * 16 + n16) * 64 + p0);
            u32x4 w; w.x = pk2(vr.x, -vi.x); w.y = pk2(vr.y, -vi.y); w.z = pk2(vr.z, -vi.z); w.w = pk2(vr.w, -vi.w); Cf[kk] = __builtin_bit_cast(bf16x8, w); }
        bf16x4 Df; { const float dsk = P.d[grp * 16 + n16]; const int kq = n16 - 4 * g; u32x2 w; w.x = pk2(kq == 0 ? dsk : 0.f, kq == 1 ? dsk : 0.f); w.y = pk2(kq == 2 ? dsk : 0.f, kq == 3 ? dsk : 0.f); Df = __builtin_bit_cast(bf16x4, w); }
        f32x2 xs = (f32x2){0.f, 0.f};
        const bf16* ub = U + (size_t)b * SEQ * D + grp * 16;
        u32x2 ua[4];
#define S5B_LOAD(k, T0) do { ua[k] = *(const u32x2*)(ub + (size_t)((T0) + n16) * D + 4 * g); } while (0)
#pragma unroll
        for (int k = 0; k < 4; ++k) S5B_LOAD(k, 16 * k);
#pragma unroll 1
        for (int t0 = 0; t0 < SEQ; t0 += 64) {
#pragma unroll
            for (int k = 0; k < 4; ++k) {
                const int tb = t0 + 16 * k;
                const bf16x4 A = __builtin_bit_cast(bf16x4, ua[k]);
                { const int tn = (tb + 64 < SEQ) ? tb + 64 : tb; S5B_LOAD(k, tn); }
                const f32x4 yd = __builtin_amdgcn_mfma_f32_16x16x16bf16_1k(A, Df, (f32x4){0.f, 0.f, 0.f, 0.f}, 0, 0, 0);
#pragma unroll
                for (int nt = 0; nt < 4; ++nt) {
                    const f32x4 ar = __builtin_amdgcn_mfma_f32_16x16x16bf16_1k(A, Bre[nt], (f32x4){0.f, 0.f, 0.f, 0.f}, 0, 0, 0);
                    const f32x4 ai = __builtin_amdgcn_mfma_f32_16x16x16bf16_1k(A, Bim[nt], (f32x4){0.f, 0.f, 0.f, 0.f}, 0, 0, 0);
#pragma unroll
                    for (int r = 0; r < 4; ++r) *(f32x2*)(BU + (4 * g + r) * 132 + 2 * (16 * nt + n16)) = (f32x2){ar[r], ai[r]};
                }
                wave_lds_sync();
#pragma unroll 4
                for (int t = 0; t < 16; ++t) {
                    const f32x2 bu = *(const f32x2*)(BU + t * 132 + 2 * l);
                    const f32x2 tq = (f32x2){lbr, lbr} * xs + bu;
                    xs = (f32x2){-lbi, lbi} * (f32x2){xs.y, xs.x} + tq;
                    *(unsigned*)(XB + t * S5B_XP + l * 4) = pg8::cvt_pk_bf16(xs.x, xs.y);
                }
                wave_lds_sync();
                f32x4 y = (f32x4){0.f, 0.f, 0.f, 0.f};
#pragma unroll
                for (int kk = 0; kk < 4; ++kk) { const bf16x8 Ax = *(const bf16x8*)(XB + n16 * S5B_XP + (32 * kk + 8 * g) * 2); y = __builtin_amdgcn_mfma_f32_16x16x32_bf16(Ax, Cf[kk], y, 0, 0, 0); }
#pragma unroll
                for (int r = 0; r < 4; ++r) Z[((size_t)b * SEQ + tb + 4 * g + r) * D + grp * 16 + n16] = (bf16)f2bf(gelu_fast(y[r] + yd[r]));
                wave_lds_sync();
            }
        }
#undef S5B_LOAD
    }
}
struct Args { const void* in[45]; float* out; unsigned char* ws; int ph_lo, ph_hi; };
static_assert(sizeof(Args) == 45 * 8 + 8 + 8 + 8, "Args has no padding");
constexpr int PH_EVEN = 9, PH_ODD = 4, PH_COMMON = 13;
constexpr int NPHASES = 2 * (1 + PH_EVEN + PH_COMMON) + 2 * (1 + PH_ODD + PH_COMMON) + 1;

__global__ void __launch_bounds__(NTHR, 2) mega(Args args) {
    extern __shared__ __attribute__((aligned(16))) unsigned char lds[];
    volatile LAS unsigned* MISC = (volatile LAS unsigned*)((LAS unsigned char*)lds + MISC_OFF);
    if (threadIdx.x < 64) MISC[threadIdx.x] = 0u;
    __syncthreads();
    unsigned char* ws = args.ws;
    XcdBarrier bar = xcd_barrier_post((unsigned*)(ws + WS_CTL) + 4096, MISC + 8, gridDim.x);
    const int half = (int)gridDim.x >> 1;
    XcdBarrier bar2 = bar; if ((int)blockIdx.x >= half) bar2 = xcd_barrier_post((unsigned*)(ws + WS_CTL) + 8192, MISC + 10, gridDim.x - half);
    const int lo = args.ph_lo, hi = args.ph_hi;
    int pid = 0;
#define PH_BEGIN if (pid >= lo && pid < hi) { Ctx c; { int t_ = threadIdx.x, b_ = blockIdx.x; asm volatile("" : "+v"(t_)); asm volatile("" : "+s"(b_)); c.lds = lds; c.tid = t_; c.lane = t_ & 63; c.wave = __builtin_amdgcn_readfirstlane(t_ >> 6); c.bid = b_; { int n_ = gridDim.x; asm volatile("" : "+s"(n_)); c.nb = n_; } c.gw = c.bid * NWAVES + c.wave; c.ngw = c.nb * NWAVES; }
#define PH_END } if (pid >= lo && pid + 1 < hi) { xcd_barrier(bar); if (DBL & 2048) xcd_barrier(bar); } ++pid;
#define IN_F(i) (*(const float* const __attribute__((address_space(4)))*)(KARGS() + 8 * (i)))

    typedef const unsigned char __attribute__((address_space(4)))* kptr_t;
#define KARGS() ({ kptr_t p_ = (kptr_t)__builtin_amdgcn_kernarg_segment_ptr(); asm volatile("" : "+s"(p_)); p_; })
#define WSP(off) ((*(unsigned char* const __attribute__((address_space(4)))*)(KARGS() + 368)) + (off))
#define X ((float*)(*(float* const __attribute__((address_space(4)))*)(KARGS() + 360)))
#define ROPEA ((float*)WSP(WS_ROPEA))
#define ROPEI ((float*)WSP(WS_ROPEI))
#define KVBIG ((bf16*)WSP(WS_KVBIG))
#define WKV ((bf16*)WSP(WS_WKV))
#define W_IN ((bf16*)WSP(WS_WMIX + WMIX_IN))
#define WQ ((bf16*)WSP(WS_WMIX + WMIX_Q))
#define WOUT ((bf16*)WSP(WS_WMIX + WMIX_OUT))
#define WO_IN ((bf16*)WSP(WS_WMIX + WMIX_O_IN))
#define WO_GLU ((bf16*)WSP(WS_WMIX + WMIX_O_GLU))
#define WO_OUT ((bf16*)WSP(WS_WMIX + WMIX_O_OUT))
#define WXQ ((bf16*)WSP(WS_WXQ))
#define WXO ((bf16*)WSP(WS_WXO))
#define WUP ((bf16*)WSP(WS_WUP))
#define WDN ((bf16*)WSP(WS_WDN))
#define CQN ((bf16*)WSP(WS_CQN))
#define KF ((bf16*)WSP(WS_KF))
#define KIDX ((bf16*)WSP(WS_KIDX))
#define WIDX ((float*)WSP(WS_WIDX))
#define SEL ((bf16*)WSP(WS_SEL))
#define Hb ((bf16*)WSP(WS_R1))
#define SC ((float*)WSP(WS_R1))
#define HID ((bf16*)WSP(WS_R1))
#define Ub ((bf16*)WSP(WS_R1))
#define YC ((bf16*)WSP(WS_R1 + (size_t)M * D * 2))
#define XN ((bf16*)WSP(WS_R2))
#define QALL ((bf16*)X)
#define OLY ((bf16*)WSP(WS_R3))
#define Zb ((bf16*)WSP(WS_R3))
#define XQ ((bf16*)WSP(WS_R3))
#define XO ((bf16*)WSP(WS_R3 + (size_t)M * 512 * 2))
#define MEMN ((bf16*)WSP(WS_R3))
    LAS unsigned char* glds = (LAS unsigned char*)lds;

#define RS_A ((unsigned long long*)WSP(WS_CTL + 131072))
#define RS_B ((unsigned long long*)WSP(WS_CTL + 393216))
#define RS_C ((unsigned long long*)WSP(WS_CTL + 655360))
    for (int layer = 0; layer < DEPTH; ++layer) {
        const int li = layer >> 1;
        PH_BEGIN
            if ((layer & 1) == 0) {
                conv_mat(c, IN_F(13) + (size_t)li * 2048 * EVEN_COLS, 2048, EVEN_COLS, EVEN_COLS, HC, W_IN, 2048, 0, 0, IN_F(3) + layer * D);
                build_wql(c, IN_F(18) + (size_t)li * 512 * 1024, IN_F(19) + (size_t)li * 256 * 768, WQ);
                for (int h = 0; h < 8; ++h) conv_mat(c, IN_F(18) + (size_t)li * 512 * 1024 + h * 128, 512, 1024, 32, 32, WQ, 512, 2048 + h * 32, 0);
                conv_mat(c, IN_F(21) + (size_t)li * 512 * 1024, 512, 1024, 1024, 1024, WQ, 512, 2304, 0);
                build_wout(c, IN_F(20) + (size_t)li * 256 * 1024, IN_F(14) + (size_t)li * 2048 * 2048, WOUT);
                conv_mat(c, IN_F(14) + (size_t)li * 2048 * 2048 + (size_t)1024 * 2048, 1024, 2048, 2048, 2048, WOUT, OC, 0, 2048);
            } else {
                conv_mat(c, IN_F(33) + (size_t)li * 2048 * 2048, 2048, 2048, 2048, 2048, WO_IN, 2048, 0, 0, IN_F(3) + layer * D);
                conv_mat(c, IN_F(43) + (size_t)li * 2048 * 2048, 2048, 2048, 2048, 2048, WO_GLU, 2048, 0, 0);
                conv_mat(c, IN_F(34) + (size_t)li * 2048 * 2048, 2048, 2048, 2048, 2048, WO_OUT, 2048, 0, 0);
            }
            conv_mat(c, IN_F(8) + (size_t)layer * 2048 * 512, 2048, 512, 512, 512, WXQ, 2048, 0, 0, IN_F(4) + layer * D);
            conv_mat(c, IN_F(10) + (size_t)layer * 512 * 2048, 512, 2048, 2048, 2048, WXO, 512, 0, 0);
            { unsigned long long* ra = RS_A; unsigned long long* rb = RS_B; for (int i = c.bid * NTHR + c.tid; i < M; i += c.nb * NTHR) { ra[i] = 0ull; rb[i] = 0ull; } }
            if (layer == 0) {
                for (int l2 = 0; l2 < 4; ++l2) {
                    conv_mat(c, IN_F(9) + (size_t)l2 * 2048 * 1024, 2048, 1024, 1024, 1024, WKV, 2048, l2 * 1024, 0);
                    norm_rows_bf16(c, IN_F(1), IN_F(5) + l2 * D, MEMN + (size_t)l2 * MEMR * D, MEMR);
                }
                rope_tables(c, (const int*)IN_F(2), ROPEA, ROPEI);
                cast_rows_ss(c, IN_F(0), XN, RS_C, M);
            }
        PH_END
        if ((layer & 1) == 0) {
            PH_BEGIN
                { pg8::Gemm g{XN, W_IN, 2048, 2048, 2048}; pg8::StaticOrder S; S.init(128, HC / 256, c.nb, c.bid); pg8::EpiBf16<0> E{Hb, HC, RS_C};
                  pg8::gemm_phase<pg8::EpiBf16<0>, pg8::StaticOrder, true, true>(glds, g, S, E);
                  if (DBL & 1024) { __syncthreads(); pg8::gemm_phase<pg8::EpiBf16<0>, pg8::StaticOrder, true, true>(glds, g, S, E); } }
                if (layer == 0) { __syncthreads(); pg8::Gemm g{MEMN, WKV, 2048, 2048, 2048}; pg8::KvOrder S{c.nb, c.bid}; pg8::EpiBf16<0> E{KVBIG, 4096, nullptr};
                  pg8::gemm_phase<pg8::EpiBf16<0>, pg8::KvOrder, true, true>(glds, g, S, E); }
            PH_END
            PH_BEGIN
                rwkv_lora_prep(c, Hb, IN_F(22) + li * B_COLS, (bf16*)WSP(WS_END + 96 * MiB));
            PH_END
            PH_BEGIN
                if (c.bid < half) {
                    Ctx r = c; r.nb = half; r.ngw = half * NWAVES;
                    const RwkvP P{IN_F(22) + li * B_COLS, IN_F(23) + li * 1024, IN_F(24) + (size_t)li * 65536, IN_F(25) + li * 1024, IN_F(26) + (size_t)li * 65536, IN_F(27) + (size_t)li * 163840,
                                  IN_F(28) + li * 1024, IN_F(29) + li * 1024, IN_F(30) + li * 1024, IN_F(31) + li * 1024, IN_F(32) + li * 1024};
#if DIAG == 4
                    rwkv_phase(r, Hb, P, OLY);
                    rwkv_phase2(r, Hb, (const bf16*)WSP(WS_END + 96 * MiB), P, (bf16*)WSP(WS_END + 116 * MiB), 1024, 0, 1);
#else
                    rwkv_phase2(r, Hb, (const bf16*)WSP(WS_END + 96 * MiB), P, OLY, OC, 2048);
#endif
                    __syncthreads();
                    conv_mat(r, IN_F(12) + (size_t)layer * FFN * 2048, FFN, 2048, 2048, 2048, WDN, FFN, 0, 0);
                } else {
                    Ctx d = c; d.bid = c.bid - half; d.nb = c.nb - half; d.gw = d.bid * NWAVES + d.wave; d.ngw = d.nb * NWAVES;
                    dsa_prep(d, Hb, IN_F(15) + li * 512, IN_F(16) + li * 256, IN_F(17) + li * 64, ROPEA, ROPEI, CQN, KF, KIDX, WIDX);
                    xcd_barrier(bar2);
                    { pg8::Gemm g{CQN, WQ, 512, 512, 512}; pg8::StaticOrder S; S.init(128, QC / 256, d.nb, d.bid); pg8::EpiBf16<0> E{QALL, QC, nullptr};
                      pg8::gemm_phase<pg8::EpiBf16<0>, pg8::StaticOrder, true, true>(glds, g, S, E); }
                    xcd_barrier(bar2);
                    idx_topk_mfma(d, QALL, KIDX, WIDX, ROPEI, (float*)(d.bid < 32 ? WSP(WS_CQN + (size_t)d.bid * MiB) : WSP(WS_END + (size_t)(d.bid - 32) * MiB)), SEL, 256);
                    conv_mat(d, IN_F(11) + (size_t)layer * 2048 * FFN, 2048, FFN, FFN, FFN, WUP, 2048, 0, 0, IN_F(6) + layer * D);
                    xcd_barrier(bar2);
                    if (d.bid == 0 && c.tid == 0) __hip_atomic_store((unsigned*)WSP(WS_CTL) + 12288 + 64 * (2 + li), 1u, __ATOMIC_RELAXED, __HIP_MEMORY_SCOPE_AGENT);
                }
                if (c.bid < half) {
                    if (c.tid == 0) { unsigned* fl = (unsigned*)WSP(WS_CTL) + 12288 + 64 * (2 + li); unsigned sp = 0;
                        while (__hip_atomic_load(fl, __ATOMIC_RELAXED, __HIP_MEMORY_SCOPE_AGENT) == 0u) { __builtin_amdgcn_s_sleep(8); if (++sp > (1u << 22)) break; } }
                    __syncthreads();
                    __builtin_amdgcn_fence(__ATOMIC_ACQUIRE, "agent"); asm volatile("s_waitcnt vmcnt(0)" ::: "memory");
                }
                dsa_attn_queue(c, QALL, KF, SEL, ROPEA, OLY, (unsigned*)WSP(WS_CTL) + 12288 + 64 * li, MISC + 12);
            PH_END
#if DBL & 32
            PH_BEGIN
                if (c.bid < half) {
                    Ctx r = c; r.nb = half; r.ngw = half * NWAVES;
                    const RwkvP P{IN_F(22) + li * B_COLS, IN_F(23) + li * 1024, IN_F(24) + (size_t)li * 65536, IN_F(25) + li * 1024, IN_F(26) + (size_t)li * 65536, IN_F(27) + (size_t)li * 163840,
                                  IN_F(28) + li * 1024, IN_F(29) + li * 1024, IN_F(30) + li * 1024, IN_F(31) + li * 1024, IN_F(32) + li * 1024};
                    rwkv_phase2(r, Hb, (const bf16*)WSP(WS_END + 96 * MiB), P, OLY, OC, 2048);
                }
            PH_END
#endif
#if DBL & 8
            PH_BEGIN
                if (c.bid >= half) {
                    Ctx d = c; d.bid = c.bid - half; d.nb = c.nb - half; d.gw = d.bid * NWAVES + d.wave; d.ngw = d.nb * NWAVES;
                    idx_topk_mfma(d, QALL, KIDX, WIDX, ROPEI, (float*)(d.bid < 32 ? WSP(WS_CQN + (size_t)d.bid * MiB) : WSP(WS_END + (size_t)(d.bid - 32) * MiB)), SEL, 256);
                }
            PH_END
#endif
#if DIAG == 4
            PH_BEGIN
                diag_cmp_bf16(c, OLY + 2048, OC, (bf16*)WSP(WS_END + 116 * MiB), 1024, SEQ, 1024, (float*)WSP(WS_CTL + 65536));
            PH_END
#endif
#if DIAG == 7 || DIAG == 8
            PH_BEGIN
                q_rope_fix(c, QALL, ROPEA, ROPEI);
            PH_END
#endif
#if DIAG == 7
            PH_BEGIN
                if (c.bid >= half) { Ctx d = c; d.bid = c.bid - half; d.nb = c.nb - half; d.gw = d.bid * NWAVES + d.wave; d.ngw = d.nb * NWAVES;
                    idx_topk_v1(d, QALL, KIDX, WIDX, (float*)(d.bid < 32 ? WSP(WS_CQN + (size_t)d.bid * MiB) : WSP(WS_END + (size_t)(d.bid - 32) * MiB)), (bf16*)WSP(WS_END + 116 * MiB), 128); }
            PH_END
            PH_BEGIN
                diag_cmp_sel(c, SEL, (bf16*)WSP(WS_END + 116 * MiB), 4, (float*)WSP(WS_CTL + 65536));
            PH_END
#endif
#if DIAG == 8
            PH_BEGIN
                dsa_attn_simple(c, QALL, KF, SEL, (bf16*)WSP(WS_END + 116 * MiB), 1024);
            PH_END
            PH_BEGIN
                diag_cmp_bf16(c, OLY, OC, (bf16*)WSP(WS_END + 116 * MiB), OC, 1024, 2048, (float*)WSP(WS_CTL + 65536));
            PH_END
#endif
            PH_BEGIN
                { pg8::Gemm g{OLY, WOUT, OC, OC, OC}; pg8::StaticOrder S; S.init(128, 8, c.nb, c.bid); pg8::EpiRes E{XN, D, RS_A};
                  pg8::gemm_phase<pg8::EpiRes, pg8::StaticOrder, true, true>(glds, g, S, E); }
            PH_END
        } else {
            PH_BEGIN
                { pg8::Gemm g{XN, WO_IN, 2048, 2048, 2048}; pg8::StaticOrder S; S.init(128, 8, c.nb, c.bid); pg8::EpiBf16<0> E{Ub, D, RS_C};
                  pg8::gemm_phase<pg8::EpiBf16<0>, pg8::StaticOrder, true, true>(glds, g, S, E);
                  if (DBL & 1024) { __syncthreads(); pg8::gemm_phase<pg8::EpiBf16<0>, pg8::StaticOrder, true, true>(glds, g, S, E); } }
            PH_END
            PH_BEGIN
                { const S5P P{IN_F(35) + li * 8192, IN_F(36) + li * 8192, IN_F(37) + li * 128, IN_F(38) + (size_t)li * 131072, IN_F(39) + (size_t)li * 131072, IN_F(40) + (size_t)li * 131072, IN_F(41) + (size_t)li * 131072, IN_F(42) + li * D};
                  s5_phase2(c, Ub, P, Zb); }
                if (c.wave >= 4) {
                    Ctx v = c; v.lds = c.lds + 65536 - 4 * 8704; v.gw = c.bid * 4 + (c.wave - 4); v.ngw = c.nb * 4;
                    conv_mat(v, IN_F(11) + (size_t)layer * 2048 * FFN, 2048, FFN, FFN, FFN, WUP, 2048, 0, 0, IN_F(6) + layer * D);
                    conv_mat(v, IN_F(12) + (size_t)layer * FFN * 2048, FFN, 2048, 2048, 2048, WDN, FFN, 0, 0);
                }
            PH_END
#if DIAG == 5
            PH_BEGIN
                { const S5P P{IN_F(35) + li * 8192, IN_F(36) + li * 8192, IN_F(37) + li * 128, IN_F(38) + (size_t)li * 131072, IN_F(39) + (size_t)li * 131072, IN_F(40) + (size_t)li * 131072, IN_F(41) + (size_t)li * 131072, IN_F(42) + li * D};
                  s5_phase(c, Ub, P, YC); }
            PH_END
            PH_BEGIN
                diag_cmp_bf16(c, YC, D, Zb, D, M, D, (float*)WSP(WS_CTL + 65536));
            PH_END
#endif
            PH_BEGIN
                { pg8::Gemm g{Zb, WO_GLU, 2048, 2048, 2048}; pg8::StaticOrder S; S.init(128, 8, c.nb, c.bid); pg8::EpiGlu E{Zb, YC, D, IN_F(44) + li * D};
                  pg8::gemm_phase<pg8::EpiGlu, pg8::StaticOrder, true, true>(glds, g, S, E); }
            PH_END
            PH_BEGIN
                { pg8::Gemm g{YC, WO_OUT, 2048, 2048, 2048}; pg8::StaticOrder S; S.init(128, 8, c.nb, c.bid); pg8::EpiRes E{XN, D, RS_A};
                  pg8::gemm_phase<pg8::EpiRes, pg8::StaticOrder, true, true>(glds, g, S, E); }
            PH_END
        }
        PH_BEGIN
            { unsigned long long* rc = RS_C; for (int i = c.bid * NTHR + c.tid; i < M; i += c.nb * NTHR) rc[i] = 0ull; }
            { pg8::Gemm g{XN, WXQ, 2048, 2048, 2048}; pg8::StaticOrder S; S.init(128, 2, c.nb, c.bid); pg8::EpiBf16<0> E{XQ, 512, RS_A};
              pg8::gemm_phase<pg8::EpiBf16<0>, pg8::StaticOrder, true, true>(glds, g, S, E); }
        PH_END
        PH_BEGIN
            xattn_mfma(c, XQ, KVBIG, layer, XO); if (DBL & 128) { asm volatile("" ::: "memory"); xattn_mfma(c, XQ, KVBIG, layer, XO); }
        PH_END
        PH_BEGIN
            { pg8::Gemm g{XO, WXO, 512, 512, 512}; pg8::StaticOrder S; S.init(128, 8, c.nb, c.bid); pg8::EpiRes E{XN, D, RS_B};
              pg8::gemm_phase<pg8::EpiRes, pg8::StaticOrder, true, true>(glds, g, S, E); }
        PH_END
        for (int q = 0; q < 5; ++q) {
            PH_BEGIN
                if (q > 0) { const int qd = q - 1; bf16* hid = HID + (size_t)(qd & 1) * 8192 * FFN;
                    pg8::Gemm g{hid, WDN, FFN, FFN, FFN}; pg8::StaticOrder S; S.init(32, 8, c.nb, c.bid); pg8::EpiRes E{XN + (size_t)qd * 8192 * D, D, RS_C + qd * 8192};
                    pg8::gemm_phase<pg8::EpiRes, pg8::StaticOrder, true, true>(glds, g, S, E); __syncthreads(); }
                if (q < 4) { bf16* hid = HID + (size_t)(q & 1) * 8192 * FFN;
                    pg8::Gemm g{XN + (size_t)q * 8192 * D, WUP, 2048, 2048, 2048}; pg8::StaticOrder S; S.init(32, 32, c.nb, c.bid); pg8::EpiBf16<1> E{hid, FFN, RS_B + q * 8192};
                    pg8::gemm_phase<pg8::EpiBf16<1>, pg8::StaticOrder, true, true>(glds, g, S, E); }
            PH_END
        }
    }
    PH_BEGIN
        scale_rows_out(c, XN, IN_F(7), RS_C, X, M);
    PH_END
#if DIAG
    PH_BEGIN
        { const float* dg = (const float*)WSP(WS_CTL + 65536); const float sc = 1.f + sqrtf(100.f * dg[0] / fmaxf(dg[1], 1e-30f));
          float* xo = X; for (size_t i = (size_t)c.bid * NTHR + c.tid; i < (size_t)M * D; i += (size_t)c.nb * NTHR) xo[i] *= sc; }
    PH_END
#endif
#undef PH_BEGIN
#undef PH_END
#undef IN_F
#undef X
}

extern "C" void kernel_launch(void* const* d_in, const int* in_sizes, int n_in, void* d_out, int out_size, void* d_ws, size_t ws_size, hipStream_t stream) {
    static int grid = 0;
    if (grid == 0) {
        if (n_in != 45 || out_size != M * D || ws_size < WS_END + 116 * MiB) { fprintf(stderr, "kernel_launch: unexpected shapes (n_in %d, out %d, ws %zu, need %zu)\n", n_in, out_size, ws_size, (size_t)WS_END); grid = -1; return; }
        int dev = 0, cus = 0, per_cu = 0;
        if (hipGetDevice(&dev) != hipSuccess || hipDeviceGetAttribute(&cus, hipDeviceAttributeMultiprocessorCount, dev) != hipSuccess) { grid = -1; return; }
        if (hipFuncSetAttribute((const void*)mega, hipFuncAttributeMaxDynamicSharedMemorySize, LDS_BYTES) != hipSuccess) { fprintf(stderr, "kernel_launch: hipFuncSetAttribute failed\n"); grid = -1; return; }
        if (hipOccupancyMaxActiveBlocksPerMultiprocessor(&per_cu, (const void*)mega, NTHR, LDS_BYTES) != hipSuccess || per_cu < 1) fprintf(stderr, "kernel_launch: occupancy query reports %d\n", per_cu);
        (void)hipGetLastError();
        grid = cus;
    }
    if (grid < 0) return;
    (void)hipMemsetAsync((char*)d_ws + WS_CTL, 0, CTL_BYTES, stream);
    Args a{};
    for (int i = 0; i < 45; ++i) a.in[i] = d_in[i];
    a.out = (float*)d_out; a.ws = (unsigned char*)d_ws;
#if MK_ONE_LAUNCH
    a.ph_lo = 0; a.ph_hi = 1 << 20;
    hipLaunchKernelGGL(mega, dim3(grid), dim3(NTHR), LDS_BYTES, stream, a);
#else
    for (int p = 0; p < NPHASES; ++p) { a.ph_lo = p; a.ph_hi = p + 1; hipLaunchKernelGGL(mega, dim3(grid), dim3(NTHR), LDS_BYTES, stream, a); }
#endif
}
```

```cpp
#include <hip/hip_runtime.h>
#include <cstdio>
#include <cstdint>

#ifndef DIAG
#define DIAG 0
#endif
#ifndef ATTN_SPLIT
#define ATTN_SPLIT 0
#endif
#ifndef DBL
#define DBL 0
#endif
#ifndef MK_ONE_LAUNCH
#define MK_ONE_LAUNCH 1
#endif

constexpr int D = 2048, NB = 8, SEQ = 4096, M = NB * SEQ, DEPTH = 4;
constexpr int HC = 4352;
constexpr int EVEN_COLS = 4240, A_COLS = 880, B_COLS = 3360;
constexpr int QC = 3328;
constexpr int OC = 3072;
constexpr int KFW = 288;
constexpr int FFN = 8192;
constexpr int MEMR = NB * 256;
constexpr float NORM_EPS = 1e-5f;
constexpr size_t SC_PER_BATCH = (size_t)4096 * 64 * 65 / 2;

typedef unsigned short bf16;
typedef float f32x4 __attribute__((ext_vector_type(4)));
typedef unsigned u32x4 __attribute__((ext_vector_type(4)));
typedef unsigned u32x2 __attribute__((ext_vector_type(2)));
typedef float f32x2 __attribute__((ext_vector_type(2)));
typedef float f32x3 __attribute__((ext_vector_type(3)));
#define LAS __attribute__((address_space(3)))

constexpr size_t MiB = 1u << 20;
constexpr size_t al256(size_t x) { return (x + 255) & ~(size_t)255; }
constexpr size_t WS_CTL = 0, CTL_BYTES = 1 * MiB;
constexpr size_t WS_ROPEA = WS_CTL + CTL_BYTES;
constexpr size_t WS_ROPEI = WS_ROPEA + (size_t)M * 32 * 4;
constexpr size_t WS_KVBIG = WS_ROPEI + (size_t)M * 16 * 4;
constexpr size_t WS_WKV = WS_KVBIG + (size_t)8192 * 4096 * 2;
constexpr size_t WS_WMIX = WS_WKV + (size_t)4096 * 2048 * 2;
constexpr size_t WMIX_IN = 0, WMIX_Q = (size_t)HC * 2048 * 2, WMIX_OUT = WMIX_Q + (size_t)QC * 512 * 2, WMIX_BYTES = WMIX_OUT + (size_t)2048 * OC * 2;
constexpr size_t WMIX_O_IN = 0, WMIX_O_GLU = (size_t)2048 * 2048 * 2, WMIX_O_OUT = 2 * WMIX_O_GLU;
constexpr size_t WS_WXQ = al256(WS_WMIX + WMIX_BYTES);
constexpr size_t WS_WXO = WS_WXQ + (size_t)512 * 2048 * 2;
constexpr size_t WS_WUP = WS_WXO + (size_t)2048 * 512 * 2;
constexpr size_t WS_WDN = WS_WUP + (size_t)FFN * 2048 * 2;
constexpr size_t WS_CQN = WS_WDN + (size_t)2048 * FFN * 2;
constexpr size_t WS_KF = WS_CQN + (size_t)M * 512 * 2;
constexpr size_t WS_KIDX = WS_KF + (size_t)M * KFW * 2;
constexpr size_t WS_WIDX = WS_KIDX + (size_t)M * 64 * 2;
constexpr size_t WS_SEL = WS_WIDX + (size_t)M * 16 * 4;
constexpr size_t WS_R1 = al256(WS_SEL + (size_t)M * 256 * 2);
constexpr size_t R1_BYTES = (size_t)M * HC * 2;
constexpr size_t WS_R2 = WS_R1 + R1_BYTES;
constexpr size_t R2_BYTES = (size_t)M * QC * 2;
constexpr size_t WS_R3 = WS_R2 + R2_BYTES;
constexpr size_t R3_BYTES = (size_t)M * OC * 2;
constexpr size_t WS_END = WS_R3 + R3_BYTES;
static_assert(SC_PER_BATCH * NB * 4 <= R1_BYTES, "scores fit R1");
static_assert((size_t)8192 * FFN * 2 <= R1_BYTES && (size_t)M * 2048 * 2 * 2 <= R1_BYTES, "R1 overlays");

__device__ __forceinline__ float bf2f(unsigned v) { return __uint_as_float(v << 16); }
__device__ __forceinline__ unsigned f2bf(float f) { unsigned u = __float_as_uint(f); return (u + 0x7fffu + ((u >> 16) & 1u)) >> 16; }
__device__ __forceinline__ unsigned pk2(float lo, float hi) { return f2bf(lo) | (f2bf(hi) << 16); }
__device__ __forceinline__ float wave_sum(float v) {
#pragma unroll
    for (int o = 1; o < 64; o <<= 1) v += __shfl_xor(v, o);
    return v;
}
__device__ __forceinline__ float wave_max(float v) {
#pragma unroll
    for (int o = 1; o < 64; o <<= 1) v = fmaxf(v, __shfl_xor(v, o));
    return v;
}
__device__ __forceinline__ void unpack8(const u32x4 w, float* f) {
    f[0] = __uint_as_float(w.x << 16); f[1] = __uint_as_float(w.x & 0xffff0000u); f[2] = __uint_as_float(w.y << 16); f[3] = __uint_as_float(w.y & 0xffff0000u);
    f[4] = __uint_as_float(w.z << 16); f[5] = __uint_as_float(w.z & 0xffff0000u); f[6] = __uint_as_float(w.w << 16); f[7] = __uint_as_float(w.w & 0xffff0000u);
}
__device__ __forceinline__ float sigmoidf_(float x) { return __builtin_amdgcn_rcpf(1.f + __expf(-x)); }
namespace pg8 {
#define PG8_LAS __attribute__((address_space(3)))
typedef unsigned short bf16_t;
typedef short bf16x8 __attribute__((ext_vector_type(8)));
typedef float f32x4 __attribute__((ext_vector_type(4)));
typedef unsigned u32x4 __attribute__((ext_vector_type(4)));
constexpr int BM = 256, BK = 64, HALF = 128, HTB = HALF * BK * 2, STAGE_BYTES = 8 * HTB, NXCD = 8, WGM = 8;

__host__ __device__ __forceinline__ int lds_byte(int r, int c) { const int st = (r >> 4) * 2 + (c >> 5), rr = r & 15, cc = c & 31, ob = rr * 64 + cc * 2; return st * 1024 + (ob ^ (((ob >> 9) & 1) << 5)); }
__host__ __device__ __forceinline__ void stage_rc(int b, int& R, int& C) { const int st = b / 1024, sb = b % 1024, swz = sb ^ (((sb >> 9) & 1) << 5); R = (st >> 1) * 16 + swz / 64; C = (st & 1) * 32 + (swz % 64) / 2; }
__host__ __device__ __forceinline__ int perm32(int rho) { const int n = rho >> 4, i = rho & 15; return 8 * (i >> 2) + 4 * n + (i & 3); }

struct Unit { int pm, pn; };
struct Gemm { const bf16_t* A; const bf16_t* Bt; int lda, ldb, K, pad; };

struct StaticOrder {
    int nM, nN, nwg, G, c;
    __host__ __device__ void init(int nM_, int nN_, int G_, int c_) { nM = nM_; nN = nN_; nwg = nM * nN; G = G_; c = c_; }
    __host__ __device__ bool next(int i, Unit& u) const {
        const long L = (long)i * G + c; if (L >= nwg) return false;
        int wgid = (int)L; { const int q = nwg / NXCD, r = nwg % NXCD, xcd = wgid % NXCD, off = wgid / NXCD; wgid = (xcd < r ? xcd * (q + 1) : r * (q + 1) + (xcd - r) * q) + off; }
        const int nig = WGM * nN, gid = wgid / nig, fm = gid * WGM, gsz = (nM - fm) < WGM ? (nM - fm) : WGM;
        u.pm = fm + ((wgid % nig) % gsz); u.pn = (wgid % nig) / gsz; return true;
    }
    __device__ __forceinline__ void a_ready(const Unit&) const {}
    __device__ __forceinline__ void done(const Unit&) const {}
};
struct KvOrder {
    int G, c;
    __device__ bool next(int i, Unit& u) const { const int L = i * G + c; if (L >= 128) return false; const int ly = L >> 5, r = L & 31; u.pm = ly * 8 + (r & 7); u.pn = ly * 4 + (r >> 3); return true; }
    __device__ __forceinline__ void a_ready(const Unit&) const {}
    __device__ __forceinline__ void done(const Unit&) const {}
};

__device__ __forceinline__ unsigned cvt_pk_bf16(float lo, float hi) { unsigned r; asm volatile("v_cvt_pk_bf16_f32 %0, %1, %2" : "=v"(r) : "v"(lo), "v"(hi)); return r; }

template <int ACT> struct EpiBf16 {
    static constexpr bool PERM = true, AFTER_DRAIN = false;
    bf16_t* O; int ldc; const unsigned long long* rowss;
    __device__ __forceinline__ void operator()(const f32x4 (&acc)[2][2][4][2], const Unit& u, int wr, int wc, int fr, int fq) const {
        const int row0 = u.pm * BM + wr * 64 + fr; const int col0 = u.pn * BM + wc * 32 + 8 * fq;
        unsigned long long rq[2][4];
#pragma unroll
        for (int ai = 0; ai < 2; ++ai)
#pragma unroll
            for (int m = 0; m < 4; ++m) rq[ai][m] = rowss ? rowss[row0 + ai * HALF + m * 16] : 0ull;
        if (rowss) asm volatile("" : "+v"(rq[0][0]), "+v"(rq[0][1]), "+v"(rq[0][2]), "+v"(rq[0][3]), "+v"(rq[1][0]), "+v"(rq[1][1]), "+v"(rq[1][2]), "+v"(rq[1][3]));
#pragma unroll
        for (int ai = 0; ai < 2; ++ai)
#pragma unroll
            for (int m = 0; m < 4; ++m) { bf16_t* rowp = O + (size_t)(row0 + ai * HALF + m * 16) * ldc + col0;
                const float rs = rowss ? __builtin_amdgcn_rsqf((float)rq[ai][m] * (5.9604644775390625e-08f / 2048.f) + 1e-5f) : 1.f;
#pragma unroll
                for (int bj = 0; bj < 2; ++bj) { f32x4 v0 = acc[ai][bj][m][0] * rs, v1 = acc[ai][bj][m][1] * rs;
                    if (ACT == 1) {
#pragma unroll
                        for (int j = 0; j < 4; ++j) { const float a = fmaxf(v0[j], 0.f), b = fmaxf(v1[j], 0.f); v0[j] = a * a; v1[j] = b * b; } }
                    u32x4 w; w.x = cvt_pk_bf16(v0[0], v0[1]); w.y = cvt_pk_bf16(v0[2], v0[3]); w.z = cvt_pk_bf16(v1[0], v1[1]); w.w = cvt_pk_bf16(v1[2], v1[3]);
                    *(u32x4*)(rowp + bj * HALF) = w; } }
    }
};
struct EpiRes {
    static constexpr bool PERM = false, AFTER_DRAIN = false;
    bf16_t* xb; int ldc; unsigned long long* rowss;
    __device__ __forceinline__ void operator()(const f32x4 (&acc)[2][2][4][2], const Unit& u, int wr, int wc, int fr, int fq) const {
        typedef unsigned u32x2_ __attribute__((ext_vector_type(2)));
        const int row0 = u.pm * BM + wr * 64 + fr, col0 = u.pn * BM + wc * 32 + 4 * fq;
#pragma unroll
        for (int ai = 0; ai < 2; ++ai) {
            u32x2_ bv[4][2][2];
#pragma unroll
            for (int m = 0; m < 4; ++m) { const bf16_t* rp = xb + (size_t)(row0 + ai * HALF + m * 16) * ldc + col0;
#pragma unroll
                for (int bj = 0; bj < 2; ++bj)
#pragma unroll
                    for (int n = 0; n < 2; ++n) bv[m][bj][n] = *(const u32x2_*)(rp + bj * HALF + n * 16); }
#pragma unroll
            for (int m = 0; m < 4; ++m) { bf16_t* rp = xb + (size_t)(row0 + ai * HALF + m * 16) * ldc + col0; float ss = 0.f;
#pragma unroll
                for (int bj = 0; bj < 2; ++bj)
#pragma unroll
                    for (int n = 0; n < 2; ++n) { const u32x2_ b = bv[m][bj][n]; f32x4 x = acc[ai][bj][m][n];
                        x[0] += __uint_as_float(b.x << 16); x[1] += __uint_as_float(b.x & 0xffff0000u); x[2] += __uint_as_float(b.y << 16); x[3] += __uint_as_float(b.y & 0xffff0000u);
                        u32x2_ w; w.x = cvt_pk_bf16(x[0], x[1]); w.y = cvt_pk_bf16(x[2], x[3]); *(u32x2_*)(rp + bj * HALF + n * 16) = w;
                        const float r0 = __uint_as_float(w.x << 16), r1 = __uint_as_float(w.x & 0xffff0000u), r2 = __uint_as_float(w.y << 16), r3 = __uint_as_float(w.y & 0xffff0000u);
                        ss += (r0 * r0 + r1 * r1) + (r2 * r2 + r3 * r3); }
                ss += __shfl_xor(ss, 16); ss += __shfl_xor(ss, 32);
                if (fq == 0) atomicAdd(rowss + row0 + ai * HALF + m * 16, (unsigned long long)(ss * 16777216.0f)); }
            asm volatile("" ::: "memory"); }
    }
};
struct EpiGlu {
    static constexpr bool PERM = true, AFTER_DRAIN = false;
    const bf16_t* Z; bf16_t* O; int ldc; const float* bias;
    __device__ __forceinline__ void operator()(const f32x4 (&acc)[2][2][4][2], const Unit& u, int wr, int wc, int fr, int fq) const {
        const int row0 = u.pm * BM + wr * 64 + fr; const int col0 = u.pn * BM + wc * 32 + 8 * fq;
        f32x4 bv[2][2];
#pragma unroll
        for (int bj = 0; bj < 2; ++bj)
#pragma unroll
            for (int n = 0; n < 2; ++n) bv[bj][n] = *(const f32x4*)(bias + col0 + bj * HALF + 4 * n);
#pragma unroll
        for (int ai = 0; ai < 2; ++ai) {
            u32x4 zq[4][2];
#pragma unroll
            for (int m = 0; m < 4; ++m)
#pragma unroll
                for (int bj = 0; bj < 2; ++bj) zq[m][bj] = *(const u32x4*)(Z + (size_t)(row0 + ai * HALF + m * 16) * ldc + col0 + bj * HALF);
#pragma unroll
            for (int m = 0; m < 4; ++m) { const size_t off = (size_t)(row0 + ai * HALF + m * 16) * ldc + col0;
#pragma unroll
                for (int bj = 0; bj < 2; ++bj) { const f32x4 v0 = acc[ai][bj][m][0] + bv[bj][0], v1 = acc[ai][bj][m][1] + bv[bj][1];
                    const u32x4 zz = zq[m][bj]; float z[8], o[8];
                    z[0] = __uint_as_float(zz.x << 16); z[1] = __uint_as_float(zz.x & 0xffff0000u); z[2] = __uint_as_float(zz.y << 16); z[3] = __uint_as_float(zz.y & 0xffff0000u);
                    z[4] = __uint_as_float(zz.z << 16); z[5] = __uint_as_float(zz.z & 0xffff0000u); z[6] = __uint_as_float(zz.w << 16); z[7] = __uint_as_float(zz.w & 0xffff0000u);
#pragma unroll
                    for (int j = 0; j < 4; ++j) { o[j] = z[j] * __builtin_amdgcn_rcpf(1.f + __expf(-v0[j])); o[4 + j] = z[4 + j] * __builtin_amdgcn_rcpf(1.f + __expf(-v1[j])); }
                    u32x4 w; w.x = cvt_pk_bf16(o[0], o[1]); w.y = cvt_pk_bf16(o[2], o[3]); w.z = cvt_pk_bf16(o[4], o[5]); w.w = cvt_pk_bf16(o[6], o[7]);
                    *(u32x4*)(O + off + bj * HALF) = w; } }
            asm volatile("" ::: "memory"); }
    }
};

template <class Epi, class Sched, bool ALIGN_EPI = false, bool SP2 = false>
__device__ __forceinline__ void gemm_phase(PG8_LAS unsigned char* lds, const Gemm g, const Sched& S, const Epi& E) {
    int tid_l = threadIdx.x; asm volatile("" : "+v"(tid_l));
    const int tid = tid_l, wid = __builtin_amdgcn_readfirstlane(tid >> 6), lane = tid & 63, wr = wid >> 2, wc = wid & 3, fr = lane & 15, fq = lane >> 4;
    const int K = g.K, nt = K / BK;
    unsigned voffA[2], voffB[2];
#pragma unroll
    for (int i = 0; i < 2; ++i) { int R, C; stage_rc(tid * 16 + i * 8192, R, C); const int Rb = Epi::PERM ? ((R & ~31) + perm32(R & 31)) : R;
        voffA[i] = (unsigned)(R * g.lda + C) * 2u; voffB[i] = (unsigned)(Rb * g.ldb + C) * 2u; }
    const size_t kstep = (size_t)(BK * 2);
    const size_t hstepA = (size_t)HALF * g.lda * 2, hstepB = (size_t)HALF * g.ldb * 2;
    const size_t tstepA = 2 * hstepA, tstepB = 2 * hstepB;
    const unsigned ldsw = (unsigned)wid * 1024u;
    const int aoff = lds_byte(wr * 64 + fr, fq * 8), boff = lds_byte(wc * 32 + fr, fq * 8);
#define PG8_SA(b, h) (((b) * 2 + (h)) * HTB)
#define PG8_SB(b, h) ((4 + (b) * 2 + (h)) * HTB)
#define PG8_STAGE(bufoff, gbase, voff) do { _Pragma("unroll") for (int _i = 0; _i < 2; ++_i) \
        __builtin_amdgcn_global_load_lds((const unsigned*)((const char*)(gbase) + (voff)[_i]), (PG8_LAS unsigned*)(lds + (bufoff) + ldsw + _i * 8192), 16, 0, 0); } while (0)
#define PG8_LDA(dst, b, h) do { _Pragma("unroll") for (int m = 0; m < 4; ++m) _Pragma("unroll") for (int k = 0; k < 2; ++k) dst[m][k] = *(const PG8_LAS bf16x8*)(lds + PG8_SA(b, h) + aoff + m * 2048 + k * 1024); } while (0)
#define PG8_LDB(dst, b, h) do { _Pragma("unroll") for (int n = 0; n < 2; ++n) _Pragma("unroll") for (int k = 0; k < 2; ++k) dst[n][k] = *(const PG8_LAS bf16x8*)(lds + PG8_SB(b, h) + boff + n * 2048 + k * 1024); } while (0)
#define PG8_MMA(ai, bj, At, Bt) do { __builtin_amdgcn_s_setprio(1); _Pragma("unroll") for (int m = 0; m < 4; ++m) _Pragma("unroll") for (int n = 0; n < 2; ++n) _Pragma("unroll") for (int k = 0; k < 2; ++k) \
        acc[ai][bj][m][n] = __builtin_amdgcn_mfma_f32_16x16x32_bf16(Bt[n][k], At[m][k], acc[ai][bj][m][n], 0, 0, 0); __builtin_amdgcn_s_setprio(0); } while (0)
#define PG8_WAIT_V(n) asm volatile("s_waitcnt vmcnt(" #n ")" ::: "memory")
#define PG8_WAIT_L(n) asm volatile("s_waitcnt lgkmcnt(" #n ")" ::: "memory")
#define PG8_BAR __builtin_amdgcn_s_barrier()
#define PG8_SCHED __builtin_amdgcn_sched_barrier(0)
    Unit cur, nxt; int ui = 0;
    if (!S.next(0, cur)) return;
    f32x4 acc[2][2][4][2];
#pragma unroll
    for (int a = 0; a < 2; ++a)
#pragma unroll
        for (int b = 0; b < 2; ++b)
#pragma unroll
            for (int m = 0; m < 4; ++m)
#pragma unroll
                for (int n = 0; n < 2; ++n) acc[a][b][m][n] = (f32x4){0.f, 0.f, 0.f, 0.f};
    bf16x8 At[4][2], B0[2][2], B1[2][2];
    const char* cA = (const char*)g.A + (size_t)cur.pm * tstepA; const char* cB = (const char*)g.Bt + (size_t)cur.pn * tstepB;
    S.a_ready(cur);
    if constexpr (SP2) {
        PG8_STAGE(PG8_SB(0, 0), cB, voffB); PG8_STAGE(PG8_SB(0, 1), cB + hstepB, voffB); PG8_STAGE(PG8_SA(0, 0), cA, voffA); PG8_STAGE(PG8_SA(0, 1), cA + hstepA, voffA);
        if (wr == 1) PG8_BAR;
        PG8_WAIT_V(2); PG8_BAR;
        PG8_STAGE(PG8_SB(1, 0), cB + kstep, voffB); PG8_STAGE(PG8_SA(1, 0), cA + kstep, voffA); PG8_STAGE(PG8_SB(1, 1), cB + hstepB + kstep, voffB);
        PG8_WAIT_V(6); PG8_BAR;
    } else {
        PG8_STAGE(PG8_SB(0, 0), cB, voffB); PG8_STAGE(PG8_SA(0, 0), cA, voffA); PG8_STAGE(PG8_SB(0, 1), cB + hstepB, voffB); PG8_STAGE(PG8_SA(0, 1), cA + hstepA, voffA);
        if (wr == 1) PG8_BAR;
        PG8_WAIT_V(4); PG8_BAR;
        PG8_STAGE(PG8_SB(1, 0), cB + kstep, voffB); PG8_STAGE(PG8_SA(1, 0), cA + kstep, voffA); PG8_STAGE(PG8_SB(1, 1), cB + hstepB + kstep, voffB);
        PG8_WAIT_V(6); PG8_BAR;
    }
    for (;;) {
        const bool has_next = S.next(ui + 1, nxt);
        const char* nA = has_next ? (const char*)g.A + (size_t)nxt.pm * tstepA : cA; const char* nB = has_next ? (const char*)g.Bt + (size_t)nxt.pn * tstepB : cB;
        for (int t = 0; t < nt; t += 2) {
            const bool last = (t == nt - 2);
            const char* a1 = cA + (size_t)(t + 1) * kstep;
            const char* a2 = last ? nA : cA + (size_t)(t + 2) * kstep; const char* b2 = last ? nB : cB + (size_t)(t + 2) * kstep;
            const char* a3 = a2 + kstep; const char* b3 = b2 + kstep;
            if (last && has_next) S.a_ready(nxt);
            if constexpr (SP2) {
            PG8_LDB(B0, 0, 0); PG8_LDB(B1, 0, 1); PG8_SCHED; PG8_LDA(At, 0, 0); PG8_STAGE(PG8_SA(1, 1), a1 + hstepA, voffA);
            PG8_WAIT_V(8); PG8_WAIT_L(0); PG8_BAR; PG8_MMA(0, 0, At, B0); PG8_MMA(0, 1, At, B1); PG8_BAR; PG8_SCHED;
            PG8_LDA(At, 0, 1); PG8_STAGE(PG8_SB(0, 0), b2, voffB); PG8_STAGE(PG8_SB(0, 1), b2 + hstepB, voffB); PG8_STAGE(PG8_SA(0, 0), a2, voffA);
            PG8_WAIT_V(8); PG8_WAIT_L(0); PG8_BAR; PG8_MMA(1, 0, At, B0); PG8_MMA(1, 1, At, B1); PG8_BAR; PG8_SCHED;
            PG8_LDB(B0, 1, 0); PG8_LDB(B1, 1, 1); PG8_SCHED; PG8_LDA(At, 1, 0); PG8_STAGE(PG8_SA(0, 1), a2 + hstepA, voffA);
            PG8_WAIT_V(8); PG8_WAIT_L(0); PG8_BAR; PG8_MMA(0, 0, At, B0); PG8_MMA(0, 1, At, B1); PG8_BAR; PG8_SCHED;
            PG8_LDA(At, 1, 1); PG8_STAGE(PG8_SB(1, 0), b3, voffB); PG8_STAGE(PG8_SB(1, 1), b3 + hstepB, voffB); PG8_STAGE(PG8_SA(1, 0), a3, voffA);
            PG8_WAIT_V(8); PG8_WAIT_L(0); PG8_BAR; PG8_MMA(1, 0, At, B0); PG8_MMA(1, 1, At, B1); PG8_BAR; PG8_SCHED;
            } else {
            PG8_LDB(B0, 0, 0); PG8_SCHED; PG8_LDA(At, 0, 0); PG8_STAGE(PG8_SA(1, 1), a1 + hstepA, voffA);
            PG8_WAIT_L(8); PG8_BAR; PG8_WAIT_L(0); PG8_MMA(0, 0, At, B0); PG8_BAR; PG8_SCHED;
            PG8_LDB(B1, 0, 1); PG8_STAGE(PG8_SB(0, 0), b2, voffB);
            PG8_BAR; PG8_WAIT_L(0); PG8_MMA(0, 1, At, B1); PG8_BAR;
            PG8_LDA(At, 0, 1); PG8_STAGE(PG8_SA(0, 0), a2, voffA);
            PG8_BAR; PG8_WAIT_L(0); PG8_MMA(1, 0, At, B0); PG8_BAR; PG8_SCHED;
            PG8_STAGE(PG8_SB(0, 1), b2 + hstepB, voffB);
            PG8_WAIT_V(6); PG8_BAR; PG8_MMA(1, 1, At, B1); PG8_BAR;
            PG8_LDB(B0, 1, 0); PG8_SCHED; PG8_LDA(At, 1, 0); PG8_STAGE(PG8_SA(0, 1), a2 + hstepA, voffA);
            PG8_WAIT_L(8); PG8_BAR; PG8_WAIT_L(0); PG8_MMA(0, 0, At, B0); PG8_BAR; PG8_SCHED;
            PG8_LDB(B1, 1, 1); PG8_STAGE(PG8_SB(1, 0), b3, voffB);
            PG8_BAR; PG8_WAIT_L(0); PG8_MMA(0, 1, At, B1); PG8_BAR;
            PG8_LDA(At, 1, 1); PG8_STAGE(PG8_SA(1, 0), a3, voffA);
            PG8_BAR; PG8_WAIT_L(0); PG8_MMA(1, 0, At, B0); PG8_BAR; PG8_SCHED;
            PG8_STAGE(PG8_SB(1, 1), b3 + hstepB, voffB);
            PG8_WAIT_V(6); PG8_BAR; PG8_MMA(1, 1, At, B1); PG8_BAR;
            }
        }
        if constexpr (ALIGN_EPI) { if (wr == 0) PG8_BAR; }
        E(acc, cur, wr, wc, fr, fq); S.done(cur);
        if (!has_next) break;
#pragma unroll
        for (int a = 0; a < 2; ++a)
#pragma unroll
            for (int b = 0; b < 2; ++b)
#pragma unroll
                for (int m = 0; m < 4; ++m)
#pragma unroll
                    for (int n = 0; n < 2; ++n) acc[a][b][m][n] = (f32x4){0.f, 0.f, 0.f, 0.f};
        cur = nxt; cA = nA; cB = nB; ++ui;
        if constexpr (ALIGN_EPI) { if (wr == 1) PG8_BAR; }
    }
    PG8_WAIT_V(0);
    if constexpr (!ALIGN_EPI) { if (wr == 0) PG8_BAR; }
    PG8_BAR;
#undef PG8_SA
#undef PG8_SB
#undef PG8_STAGE
#undef PG8_LDA
#undef PG8_LDB
#undef PG8_MMA
#undef PG8_WAIT_V
#undef PG8_WAIT_L
#undef PG8_BAR
#undef PG8_SCHED
}
}
#define XB_TMO      128
#define XB_XCNT(j)  (256  + 64 * (j))
#define XB_XSUB(j)  (1280 + 64 * (j))
#define XB_XGEN(j)  (2304 + 64 * (j))
#define XB_TOP      3328
#define XB_TOPGEN   3392
#define XCD_BAR_WORDS 3456
#define XB_SPIN_CAP (1u << 18)
__device__ __forceinline__ unsigned xb_ld(unsigned* p)              { return __hip_atomic_load(p, __ATOMIC_RELAXED, __HIP_MEMORY_SCOPE_AGENT); }
__device__ __forceinline__ unsigned xb_add(unsigned* p, unsigned v) { return __hip_atomic_fetch_add(p, v, __ATOMIC_RELAXED, __HIP_MEMORY_SCOPE_AGENT); }
__device__ __forceinline__ unsigned xb_xcc_id() { return (unsigned)__builtin_amdgcn_s_getreg((3 << 11) | 20) & 0xFu; }
#define XB_SPIN(cond, bar) do { unsigned _sp = 0; while (cond) { __builtin_amdgcn_s_sleep(1); \
    if ((++_sp & 255u) == 0u) { if (xb_ld(&(bar)[XB_TMO])) break; if (_sp > XB_SPIN_CAP) { atomicAdd(&(bar)[XB_TMO], 1u); break; } } } } while (0)
struct XcdBarrier { unsigned* bar; unsigned x; volatile LAS unsigned* st; unsigned G; };
__device__ __forceinline__ XcdBarrier xcd_barrier_post(unsigned* bar, volatile LAS unsigned* st, unsigned G) {
    XcdBarrier b; b.bar = bar; b.x = xb_xcc_id(); b.st = st; b.G = G;
    if (threadIdx.x == 0) (void)xb_add(&bar[XB_XCNT(b.x)], 1u);
    return b;
}
__device__ __forceinline__ void xcd_barrier_complete(unsigned* bar, unsigned x, unsigned G, unsigned& nloc, unsigned& nx) {
    unsigned sum, cnt, mine, sp = 0u;
    for (;;) {
        sum = 0u; cnt = 0u; mine = 0u;
#pragma unroll
        for (unsigned j = 0; j < 16; ++j) { const unsigned c = xb_ld(&bar[XB_XCNT(j)]); sum += c; cnt += (c > 0u) ? 1u : 0u; mine = (j == x) ? c : mine; }
        if (sum == G) break;
        __builtin_amdgcn_s_sleep(1);
        if ((++sp & 255u) == 0u) { if (xb_ld(&bar[XB_TMO])) break; if (sp > XB_SPIN_CAP) { atomicAdd(&bar[XB_TMO], 1u); break; } }
    }
    nloc = mine > 0u ? mine : 1u; nx = cnt > 0u ? cnt : 1u;
}
__device__ __forceinline__ void xcd_barrier(const XcdBarrier& b) {
    asm volatile("s_waitcnt vmcnt(0)" ::: "memory");
    __syncthreads();
    if (threadIdx.x == 0) {
        unsigned* bar = b.bar;
        __builtin_amdgcn_s_waitcnt(0);
        unsigned nloc = b.st[0], nx = b.st[1];
        if (nloc == 0u) { xcd_barrier_complete(bar, b.x, b.G, nloc, nx); b.st[0] = nloc; b.st[1] = nx; }
        const unsigned old = xb_add(&bar[XB_XSUB(b.x)], 1u);
        const unsigned gen = old / nloc;
        if (old + 1u == (gen + 1u) * nloc) {
            __builtin_amdgcn_fence(__ATOMIC_RELEASE, "agent");
            asm volatile("s_waitcnt vmcnt(0)" ::: "memory");
            const unsigned og = xb_add(&bar[XB_TOP], 1u);
            const unsigned tg = og / nx;
            if (og + 1u == (tg + 1u) * nx) xb_add(&bar[XB_TOPGEN], 1u);
            else XB_SPIN(xb_ld(&bar[XB_TOPGEN]) == tg, bar);
            __builtin_amdgcn_fence(__ATOMIC_ACQUIRE, "agent");
            xb_add(&bar[XB_XGEN(b.x)], 1u);
            asm volatile("s_waitcnt vmcnt(0)" ::: "memory");
        } else {
            XB_SPIN(xb_ld(&bar[XB_XGEN(b.x)]) == gen, bar);
            __builtin_amdgcn_fence(__ATOMIC_ACQUIRE, "agent");
            asm volatile("s_waitcnt vmcnt(0)" ::: "memory");
        }
    }
    __syncthreads();
}

constexpr int NWAVES = 8, NTHR = 512;
constexpr int LDS_BYTES = 155648;
constexpr int MISC_OFF = LDS_BYTES - 256;
struct Ctx { unsigned char* lds; int tid, lane, wave, gw, ngw, bid, nb; };

__device__ __forceinline__ void tr_item(const float* __restrict__ W, int ldw, int N, bf16* __restrict__ WT, int ldt, int row_off, int col_off, int kb, int nb, float* scr, int lane, const float* __restrict__ gk) {
    const int k0 = 64 * kb, n0 = 32 * nb; const int n = n0 + (lane & 31);
    float v[32];
    const float* wp = W + (size_t)(k0 + (lane >> 5)) * ldw + (n < N ? n : 0);
#pragma unroll
    for (int i = 0; i < 32; ++i) v[i] = wp[(size_t)(2 * i) * ldw];
    asm volatile("" : "+v"(v[0]), "+v"(v[1]), "+v"(v[2]), "+v"(v[3]), "+v"(v[4]), "+v"(v[5]), "+v"(v[6]), "+v"(v[7]), "+v"(v[8]), "+v"(v[9]), "+v"(v[10]), "+v"(v[11]), "+v"(v[12]), "+v"(v[13]), "+v"(v[14]), "+v"(v[15]));
    asm volatile("" : "+v"(v[16]), "+v"(v[17]), "+v"(v[18]), "+v"(v[19]), "+v"(v[20]), "+v"(v[21]), "+v"(v[22]), "+v"(v[23]), "+v"(v[24]), "+v"(v[25]), "+v"(v[26]), "+v"(v[27]), "+v"(v[28]), "+v"(v[29]), "+v"(v[30]), "+v"(v[31]));
    const float msk = (n < N) ? 1.f : 0.f;
    if (gk) {
        float gv[32];
#pragma unroll
        for (int i = 0; i < 32; ++i) gv[i] = gk[k0 + 2 * i + (lane >> 5)];
#pragma unroll
        for (int i = 0; i < 32; ++i) v[i] *= gv[i];
    }
#pragma unroll
    for (int i = 0; i < 32; ++i) { const int kk = 2 * i + (lane >> 5); scr[kk * 33 + (lane & 31)] = v[i] * msk; }
    __builtin_amdgcn_fence(__ATOMIC_RELEASE, "wavefront"); __builtin_amdgcn_wave_barrier(); __builtin_amdgcn_fence(__ATOMIC_ACQUIRE, "wavefront");
    const int c = lane & 7;
#pragma unroll
    for (int j = 0; j < 4; ++j) { const int nn = (lane >> 3) + 8 * j; const float* s = scr + (8 * c) * 33 + nn;
        u32x4 o; o.x = pk2(s[0 * 33], s[1 * 33]); o.y = pk2(s[2 * 33], s[3 * 33]); o.z = pk2(s[4 * 33], s[5 * 33]); o.w = pk2(s[6 * 33], s[7 * 33]);
        *(u32x4*)(WT + (size_t)(row_off + n0 + nn) * ldt + col_off + k0 + 8 * c) = o; }
    __builtin_amdgcn_fence(__ATOMIC_RELEASE, "wavefront"); __builtin_amdgcn_wave_barrier(); __builtin_amdgcn_fence(__ATOMIC_ACQUIRE, "wavefront");
}
__device__ __forceinline__ void conv_mat(const Ctx& c, const float* W, int K, int ldw, int N, int Npad, bf16* WT, int ldt, int row_off, int col_off, const float* gk = nullptr) {
    float* scr = (float*)(c.lds + c.wave * 8704);
    const int nblk = Npad / 32, nit = (K / 64) * nblk;
    for (int it = c.gw; it < nit; it += c.ngw) tr_item(W, ldw, N, WT, ldt, row_off, col_off, it / nblk, it % nblk, scr, c.lane, gk);
}

__device__ __forceinline__ void norm_rows_bf16(const Ctx& c, const float* __restrict__ X, const float* __restrict__ g, bf16* __restrict__ O, int nrows) {
    f32x4 gv[8];
#pragma unroll
    for (int j = 0; j < 8; ++j) gv[j] = *(const f32x4*)(g + 4 * c.lane + 256 * j);
    for (int m = c.gw; m < nrows; m += c.ngw) {
        const f32x4* xr = (const f32x4*)(X + (size_t)m * D) + c.lane; f32x4 v[8]; float s = 0.f;
#pragma unroll
        for (int j = 0; j < 8; ++j) { v[j] = xr[64 * j]; s += (v[j].x * v[j].x + v[j].y * v[j].y) + (v[j].z * v[j].z + v[j].w * v[j].w); }
        const float rstd = 1.0f / sqrtf(wave_sum(s) * (1.f / D) + NORM_EPS);
        u32x2* o8 = (u32x2*)(O + (size_t)m * D) + c.lane;
#pragma unroll
        for (int j = 0; j < 8; ++j) { u32x2 w; w.x = pk2(v[j].x * rstd * gv[j].x, v[j].y * rstd * gv[j].y); w.y = pk2(v[j].z * rstd * gv[j].z, v[j].w * rstd * gv[j].w); o8[64 * j] = w; }
    }
}
__device__ __forceinline__ void cast_rows_ss(const Ctx& c, const float* __restrict__ X, bf16* __restrict__ O, unsigned long long* rowss, int nrows) {
    for (int m = c.gw; m < nrows; m += c.ngw) {
        const f32x4* xr = (const f32x4*)(X + (size_t)m * D) + c.lane; f32x4 v[8]; float s = 0.f;
#pragma unroll
        for (int j = 0; j < 8; ++j) { v[j] = xr[64 * j]; s += (v[j].x * v[j].x + v[j].y * v[j].y) + (v[j].z * v[j].z + v[j].w * v[j].w); }
        s = wave_sum(s);
        u32x2* o8 = (u32x2*)(O + (size_t)m * D) + c.lane;
#pragma unroll
        for (int j = 0; j < 8; ++j) { u32x2 w; w.x = pk2(v[j].x, v[j].y); w.y = pk2(v[j].z, v[j].w); o8[64 * j] = w; }
        if (c.lane == 0) rowss[m] = (unsigned long long)(s * 16777216.0f);
    }
}
__device__ __forceinline__ void scale_rows_out(const Ctx& c, const bf16* __restrict__ XB, const float* __restrict__ g, const unsigned long long* rowss, float* O, int nrows) {
    for (int m = c.gw; m < nrows; m += c.ngw) {
        const float rstd = 1.0f / sqrtf((float)rowss[m] * (5.9604644775390625e-08f / D) + NORM_EPS);
#pragma unroll
        for (int j = 0; j < 4; ++j) { float x[8]; unpack8(*(const u32x4*)(XB + (size_t)m * D + 8 * c.lane + 512 * j), x);
            const f32x4 g0 = *(const f32x4*)(g + 8 * c.lane + 512 * j), g1 = *(const f32x4*)(g + 8 * c.lane + 512 * j + 4);
            *(f32x4*)(O + (size_t)m * D + 8 * c.lane + 512 * j) = (f32x4){x[0] * rstd * g0.x, x[1] * rstd * g0.y, x[2] * rstd * g0.z, x[3] * rstd * g0.w};
            *(f32x4*)(O + (size_t)m * D + 8 * c.lane + 512 * j + 4) = (f32x4){x[4] * rstd * g1.x, x[5] * rstd * g1.y, x[6] * rstd * g1.z, x[7] * rstd * g1.w}; }
    }
}
__device__ __forceinline__ void norm_rows_f32(const Ctx& c, float* X, const float* __restrict__ g, int nrows) {
    f32x4 gv[8];
#pragma unroll
    for (int j = 0; j < 8; ++j) gv[j] = *(const f32x4*)(g + 4 * c.lane + 256 * j);
    for (int m = c.gw; m < nrows; m += c.ngw) {
        f32x4* xr = (f32x4*)(X + (size_t)m * D) + c.lane; f32x4 v[8]; float s = 0.f;
#pragma unroll
        for (int j = 0; j < 8; ++j) { v[j] = xr[64 * j]; s += (v[j].x * v[j].x + v[j].y * v[j].y) + (v[j].z * v[j].z + v[j].w * v[j].w); }
        const float rstd = 1.0f / sqrtf(wave_sum(s) * (1.f / D) + NORM_EPS);
#pragma unroll
        for (int j = 0; j < 8; ++j) xr[64 * j] = v[j] * rstd * gv[j];
    }
}

__device__ __forceinline__ void rope_tables(const Ctx& c, const int* __restrict__ start_frame, float* ropea, float* ropei) {
    const float HA[16] = {1.000000000e+00f, 4.403665960e-01f, 1.939227432e-01f, 8.539710194e-02f, 3.760603070e-02f, 1.656044088e-02f, 7.292664610e-03f, 3.211446106e-03f, 1.414213562e-03f, 6.227724371e-04f, 2.742481884e-04f, 1.207697351e-04f, 5.318295734e-05f, 2.341999971e-05f, 1.031338525e-05f, 4.541670478e-06f};
    const float LA[16] = {0.000000000e+00f, 6.688275267e-09f, 1.547429962e-09f, -1.652958881e-09f, 2.282729838e-10f, -8.020459852e-10f, 1.273676581e-10f, -1.116812753e-10f, -1.115275407e-14f, -1.514006802e-11f, -1.268531807e-11f, 2.335000249e-12f, 1.624761415e-12f, -7.452659366e-13f, 1.309491117e-13f, 2.687890499e-15f};
    const float HI[8] = {1.000000000e+00f, 1.939227432e-01f, 3.760603070e-02f, 7.292664610e-03f, 1.414213562e-03f, 2.742481884e-04f, 5.318295734e-05f, 1.031338525e-05f};
    const float LI[8] = {0.000000000e+00f, 1.547429962e-09f, 2.282729838e-10f, 1.273676581e-10f, -1.115275407e-14f, -1.268531807e-11f, 1.624761415e-12f, 1.309491117e-13f};
    const int gt = c.bid * NTHR + c.tid, ngt = c.nb * NTHR;
    for (int i = gt; i < M * 24; i += ngt) {
        const int m = i / 24, j = i % 24; const int b = m / SEQ, t = m % SEQ;
        const float pos = (float)(start_frame[b] + t);
        float hi = 0.f, lo = 0.f;
#pragma unroll
        for (int q = 0; q < 16; ++q) if (j == q) { hi = HA[q]; lo = LA[q]; }
#pragma unroll
        for (int q = 0; q < 8; ++q) if (j == 16 + q) { hi = HI[q]; lo = LI[q]; }
        const float p = pos * hi, e = fmaf(pos, hi, -p) + pos * lo;
        float sn, cs; sincosf(p, &sn, &cs);
        const float cc = cs - e * sn, ss = sn + e * cs;
        if (j < 16) { ropea[(size_t)m * 32 + j] = cc; ropea[(size_t)m * 32 + 16 + j] = ss; }
        else { ropei[(size_t)m * 16 + (j - 16)] = cc; ropei[(size_t)m * 16 + 8 + (j - 16)] = ss; }
    }
}

__device__ __forceinline__ void build_wql(const Ctx& c, const float* __restrict__ w_uq, const float* __restrict__ w_uk, bf16* WQ) {
    const int gt = c.bid * NTHR + c.tid, ngt = c.nb * NTHR;
    for (int it = gt; it < 512 * 256; it += ngt) {
        const int cc = it & 511, rb = it >> 9, h = rb >> 5, r0 = (rb & 31) * 8;
        const float* a = w_uq + (size_t)cc * 1024 + h * 128 + 32; const float* bq = w_uk + (size_t)r0 * 768 + h * 96; float s[8];
#pragma unroll
        for (int j = 0; j < 8; ++j) s[j] = 0.f;
#pragma unroll 2
        for (int d4 = 0; d4 < 24; ++d4) { const f32x4 av = *(const f32x4*)(a + 4 * d4);
#pragma unroll
            for (int j = 0; j < 8; ++j) { const f32x4 bv = *(const f32x4*)(bq + (size_t)j * 768 + 4 * d4); s[j] += (av.x * bv.x + av.y * bv.y) + (av.z * bv.z + av.w * bv.w); } }
#pragma unroll
        for (int j = 0; j < 8; ++j) WQ[(size_t)(h * 256 + r0 + j) * 512 + cc] = (bf16)f2bf(s[j]);
    }
}
__device__ __forceinline__ void build_wout(const Ctx& c, const float* __restrict__ w_uv, const float* __restrict__ w_out, bf16* WO) {
    const int gt = c.bid * NTHR + c.tid, ngt = c.nb * NTHR;
    for (int i = gt; i < 8 * 32 * 2048; i += ngt) {
        const int n = i & 2047, rg = (i >> 11) & 31, h = i >> 16; float acc[8];
#pragma unroll
        for (int j = 0; j < 8; ++j) acc[j] = 0.f;
#pragma unroll 2
        for (int d4 = 0; d4 < 32; ++d4) {
            const float* wop = w_out + (size_t)(h * 128 + 4 * d4) * 2048 + n; const float wo0 = wop[0], wo1 = wop[2048], wo2 = wop[4096], wo3 = wop[6144];
#pragma unroll
            for (int j = 0; j < 8; ++j) { const f32x4 u = *(const f32x4*)(w_uv + (size_t)(rg * 8 + j) * 1024 + h * 128 + 4 * d4); acc[j] += (u.x * wo0 + u.y * wo1) + (u.z * wo2 + u.w * wo3); } }
        u32x4 o; o.x = pk2(acc[0], acc[1]); o.y = pk2(acc[2], acc[3]); o.z = pk2(acc[4], acc[5]); o.w = pk2(acc[6], acc[7]);
        *(u32x4*)(WO + (size_t)n * OC + h * 256 + rg * 8) = o;
    }
}

__device__ __forceinline__ void dsa_prep(const Ctx& c, const bf16* __restrict__ H, const float* __restrict__ cqn_g, const float* __restrict__ ckv_g, const float* __restrict__ kidx_g,
                                         const float* __restrict__ ropea, const float* __restrict__ ropei, bf16* CQN, bf16* KF, bf16* KIDX, float* WIDX) {
    const int l = c.lane;
    struct Tok { u32x4 cq; u32x2 ckv; unsigned short r1, r2, ki, wi; float csa, sna, csi, sni; };
    auto ld = [&](int m) -> Tok { Tok t; const bf16* h = H + (size_t)m * HC; const int l15 = l & 15, l7 = l & 7;
        t.cq = *(const u32x4*)(h + 8 * l); t.ckv = *(const u32x2*)(h + 512 + 4 * l); t.r1 = h[768 + l15]; t.r2 = h[768 + 16 + l15]; t.ki = h[800 + l]; t.wi = h[864 + l15];
        t.csa = ropea[(size_t)m * 32 + l15]; t.sna = ropea[(size_t)m * 32 + 16 + l15]; t.csi = ropei[(size_t)m * 16 + l7]; t.sni = ropei[(size_t)m * 16 + 8 + l7]; return t; };
    auto proc = [&](int m, const Tok& t) {
        {
            float f[8]; unpack8(t.cq, f); float s = 0.f;
#pragma unroll
            for (int j = 0; j < 8; ++j) s += f[j] * f[j];
            const float rstd = 1.0f / sqrtf(wave_sum(s) * (1.f / 512.f) + NORM_EPS);
            u32x4 o; o.x = pk2(f[0] * rstd * cqn_g[8 * l + 0], f[1] * rstd * cqn_g[8 * l + 1]); o.y = pk2(f[2] * rstd * cqn_g[8 * l + 2], f[3] * rstd * cqn_g[8 * l + 3]);
            o.z = pk2(f[4] * rstd * cqn_g[8 * l + 4], f[5] * rstd * cqn_g[8 * l + 5]); o.w = pk2(f[6] * rstd * cqn_g[8 * l + 6], f[7] * rstd * cqn_g[8 * l + 7]);
            *(u32x4*)(CQN + (size_t)m * 512 + 8 * l) = o;
        }
        {
            const u32x2 w = t.ckv; const float f0 = bf2f(w.x & 0xffffu), f1 = bf2f(w.x >> 16), f2 = bf2f(w.y & 0xffffu), f3 = bf2f(w.y >> 16);
            const float s = (f0 * f0 + f1 * f1) + (f2 * f2 + f3 * f3);
            const float rstd = 1.0f / sqrtf(wave_sum(s) * (1.f / 256.f) + NORM_EPS);
            u32x2 o; o.x = pk2(f0 * rstd * ckv_g[4 * l + 0], f1 * rstd * ckv_g[4 * l + 1]); o.y = pk2(f2 * rstd * ckv_g[4 * l + 2], f3 * rstd * ckv_g[4 * l + 3]);
            *(u32x2*)(KF + (size_t)m * KFW + 4 * l) = o;
        }
        if (l < 16) {
            const float x1 = bf2f(t.r1), x2 = bf2f(t.r2); const float cs = t.csa, sn = t.sna;
            KF[(size_t)m * KFW + 256 + l] = (bf16)f2bf(x1 * cs - x2 * sn); KF[(size_t)m * KFW + 256 + 16 + l] = (bf16)f2bf(x2 * cs + x1 * sn);
        }
        {
            const float v = bf2f(t.ki); const float rstd = 1.0f / sqrtf(wave_sum(v * v) * (1.f / 64.f) + NORM_EPS);
            const float y = v * rstd * kidx_g[l];
            const float ylo = __shfl(y, l & 7), yhi = __shfl(y, (l & 7) + 8);
            float o = y;
            if (l < 16) { const float cs = t.csi, sn = t.sni; o = (l < 8) ? (ylo * cs - yhi * sn) : (yhi * cs + ylo * sn); }
            KIDX[(size_t)m * 64 + l] = (bf16)f2bf(o);
        }
        if (l < 16) WIDX[(size_t)m * 16 + l] = bf2f(t.wi) * 0.03125f;
    };
    for (int m = c.gw; m < M; m += 2 * c.ngw) {
        const int m2 = m + c.ngw; const bool two = m2 < M;
        const Tok ta = ld(m); const Tok tb = ld(two ? m2 : m);
        proc(m, ta);
        if (two) proc(m2, tb);
    }
}
__device__ __forceinline__ void q_rope_fix(const Ctx& c, bf16* QALL, const float* __restrict__ ropea, const float* __restrict__ ropei) {
    const int l = c.lane;
    for (int m = c.gw; m < M; m += c.ngw) {
        bf16* q = QALL + (size_t)m * QC;
#pragma unroll
        for (int i = 0; i < 2; ++i) { const int p = l + 64 * i, hh = p >> 4, j = p & 15; bf16* a = q + 2048 + hh * 32 + j;
            const float x1 = bf2f(a[0]), x2 = bf2f(a[16]); const float cs = ropea[(size_t)m * 32 + j], sn = ropea[(size_t)m * 32 + 16 + j];
            a[0] = (bf16)f2bf(x1 * cs - x2 * sn); a[16] = (bf16)f2bf(x2 * cs + x1 * sn); }
#pragma unroll
        for (int i = 0; i < 2; ++i) { const int p = l + 64 * i, hh = p >> 3, j = p & 7; bf16* a = q + 2304 + hh * 64 + j;
            const float x1 = bf2f(a[0]), x2 = bf2f(a[8]); const float cs = ropei[(size_t)m * 16 + j], sn = ropei[(size_t)m * 16 + 8 + j];
            a[0] = (bf16)f2bf(x1 * cs - x2 * sn); a[8] = (bf16)f2bf(x2 * cs + x1 * sn); }
    }
}
__device__ __forceinline__ size_t sc_row_off(int b, int t) { const int ch = t >> 6; return (size_t)b * SC_PER_BATCH + (size_t)4096 * (ch * (ch + 1) / 2) + (size_t)(t & 63) * (64 * (ch + 1)); }
__device__ __forceinline__ void idx_scores_simple(const Ctx& c, const bf16* __restrict__ QALL, const bf16* __restrict__ KIDX, const float* __restrict__ WIDX, float* SC) {
    float* qs = (float*)c.lds;
    float* ws = qs + 1024;
    for (int m = c.bid; m < M; m += c.nb) {
        const int b = m / SEQ, t = m % SEQ, limit = ((t >> 6) + 1) * 64;
        __syncthreads();
        for (int i = c.tid; i < 1024; i += NTHR) qs[i] = bf2f(QALL[(size_t)m * QC + 2304 + i]);
        if (c.tid < 16) ws[c.tid] = WIDX[(size_t)m * 16 + c.tid];
        __syncthreads();
        if (limit <= 256) continue;
        float* row = SC + sc_row_off(b, t);
        for (int s = c.tid; s < limit; s += NTHR) {
            float k[64]; const u32x4* kp = (const u32x4*)(KIDX + (size_t)(b * SEQ + s) * 64);
#pragma unroll
            for (int j = 0; j < 8; ++j) unpack8(kp[j], k + 8 * j);
            float sc = 0.f;
#pragma unroll 1
            for (int h = 0; h < 16; ++h) { asm volatile("" ::: "memory"); float d = 0.f; const f32x4* q4 = (const f32x4*)(qs + h * 64);
#pragma unroll
                for (int j = 0; j < 16; ++j) { const f32x4 q = q4[j]; d += (q.x * k[4 * j] + q.y * k[4 * j + 1]) + (q.z * k[4 * j + 2] + q.w * k[4 * j + 3]); }
                sc += ws[h] * fmaxf(d, 0.f); }
            row[s] = sc;
        }
    }
}
__device__ __forceinline__ void select_row(const float* row, int limit, unsigned short* sel, int l_in, unsigned short* stg = nullptr) {
    int l = l_in; asm volatile("" : "+v"(l));
    const int ng = limit >> 9;
    unsigned key[64];
#pragma unroll
    for (int jg = 0; jg < 8; ++jg) {
        if (jg <= ng) {
#pragma unroll
            for (int j = 8 * jg; j < 8 * jg + 8; ++j) { const int s = j * 64 + l; key[j] = __float_as_uint(row[s < limit ? s : 0]); }
        } else {
#pragma unroll
            for (int j = 8 * jg; j < 8 * jg + 8; ++j) key[j] = 0u;
        }
    }
#pragma unroll
    for (int j = 0; j < 64; ++j) { const int s = j * 64 + l; unsigned u = key[j]; u = (u & 0x80000000u) ? ~u : (u | 0x80000000u); key[j] = (s < limit) ? u : 0u; }
    unsigned mx = 0u;
#pragma unroll
    for (int j = 0; j < 64; ++j) mx = key[j] > mx ? key[j] : mx;
#pragma unroll
    for (int o = 1; o < 64; o <<= 1) { const unsigned t = (unsigned)__shfl_xor((int)mx, o); mx = t > mx ? t : mx; }
    mx = (unsigned)__builtin_amdgcn_readfirstlane((int)mx);
    auto wave_count = [&](int v) -> int {
        v += __builtin_amdgcn_update_dpp(0, v, 0xB1, 0xf, 0xf, true); v += __builtin_amdgcn_update_dpp(0, v, 0x4E, 0xf, 0xf, true);
        v += __builtin_amdgcn_update_dpp(0, v, 0x141, 0xf, 0xf, true); v += __builtin_amdgcn_update_dpp(0, v, 0x140, 0xf, 0xf, true);
        return __builtin_amdgcn_readlane(v, 0) + __builtin_amdgcn_readlane(v, 16) + __builtin_amdgcn_readlane(v, 32) + __builtin_amdgcn_readlane(v, 48); };
    unsigned T = 0u;
#pragma unroll 1
    for (int bit = 31 - __builtin_clz(mx | 1u); bit >= 0; --bit) {
        const unsigned Tn = T | (1u << bit); int cl = 0;
#pragma unroll
        for (int jg = 0; jg < 8; ++jg) if (jg <= ng) {
#pragma unroll
            for (int j = 8 * jg; j < 8 * jg + 8; ++j) cl += (key[j] >= Tn) ? 1 : 0; }
        const int cnt = wave_count(cl);
        if (cnt >= 256) T = Tn;
        if (cnt == 256) break;
    }
    int cgl = 0;
#pragma unroll
    for (int j = 0; j < 64; ++j) cgl += (key[j] > T) ? 1 : 0;
    const int cgt = wave_count(cgl);
    const int need_eq = 256 - cgt;
    int base = 0, beq = 0;
    const unsigned long long lt = (1ull << l) - 1ull;
    if (stg) {
#pragma unroll
        for (int jg = 0; jg < 8; ++jg) if (jg <= ng) {
#pragma unroll
            for (int j = 8 * jg; j < 8 * jg + 8; ++j) {
                const unsigned long long mg = __ballot(key[j] > T);
                const int pos = base + (int)__builtin_amdgcn_mbcnt_hi((unsigned)(mg >> 32), __builtin_amdgcn_mbcnt_lo((unsigned)mg, 0u));
                if (key[j] > T) stg[pos] = (unsigned short)(j * 64 + l);
                base += __popcll(mg);
                const unsigned long long me = __ballot(key[j] == T);
                if (me != 0ull) {
                    const int pe = beq + (int)__builtin_amdgcn_mbcnt_hi((unsigned)(me >> 32), __builtin_amdgcn_mbcnt_lo((unsigned)me, 0u));
                    if (key[j] == T && pe < need_eq) stg[cgt + pe] = (unsigned short)(j * 64 + l);
                    beq += __popcll(me);
                }
            }
        }
        __builtin_amdgcn_fence(__ATOMIC_RELEASE, "wavefront"); __builtin_amdgcn_wave_barrier(); __builtin_amdgcn_fence(__ATOMIC_ACQUIRE, "wavefront");
        *(u32x2*)(sel + 4 * l) = *(const u32x2*)(stg + 4 * l);
        __builtin_amdgcn_fence(__ATOMIC_RELEASE, "wavefront"); __builtin_amdgcn_wave_barrier(); __builtin_amdgcn_fence(__ATOMIC_ACQUIRE, "wavefront");
        return;
    }
#pragma unroll
    for (int jg = 0; jg < 8; ++jg) if (jg <= ng) {
#pragma unroll
        for (int j = 8 * jg; j < 8 * jg + 8; ++j) {
            const unsigned long long mg = __ballot(key[j] > T), me = __ballot(key[j] == T);
            if (key[j] > T) sel[base + __popcll(mg & lt)] = (unsigned short)(j * 64 + l);
            base += __popcll(mg);
            const int pe = beq + __popcll(me & lt);
            if (key[j] == T && pe < need_eq) sel[cgt + pe] = (unsigned short)(j * 64 + l);
            beq += __popcll(me);
        }
    }
}
__device__ __forceinline__ void bs_transpose32(unsigned (&A)[32]) {
    unsigned m = 0x0000FFFFu;
#pragma unroll
    for (int j = 16; j != 0; j >>= 1) {
#pragma unroll
        for (int k = 0; k < 32; ++k) {
            if ((k & j) == 0) {
                const unsigned t = (A[k] ^ (A[k + j] >> j)) & m;
                A[k] ^= t; A[k + j] ^= (t << j);
            }
        }
        m ^= (m << (j >> 1));
    }
}
__device__ __forceinline__ void select_row_bs(const float* row, int limit, unsigned short* sel, int l_in, unsigned short* stg) {
    int l = l_in; asm volatile("" : "+v"(l));
    const int nsl = limit >> 6;
    const int ng = limit >> 9;
    unsigned lo[32], hi[32];
#pragma unroll
    for (int jg = 0; jg < 8; ++jg) {
        if (jg <= ng) {
#pragma unroll
            for (int j = 8 * jg; j < 8 * jg + 8; ++j) { const int s = j * 64 + l; const unsigned u = __float_as_uint(row[s < limit ? s : 0]);
                if (j < 32) lo[j & 31] = u; else hi[j & 31] = u; }
        } else {
#pragma unroll
            for (int j = 8 * jg; j < 8 * jg + 8; ++j) { if (j < 32) lo[j & 31] = 0u; else hi[j & 31] = 0u; }
        }
    }
    asm volatile("" ::: "memory");
#pragma unroll
    for (int j = 0; j < 64; ++j) { const unsigned u = (j < 32) ? lo[j & 31] : hi[j & 31];
        const unsigned kx = (j < nsl) ? ((u & 0x80000000u) ? ~u : (u | 0x80000000u)) : 0u;
        if (j < 32) lo[j & 31] = kx; else hi[j & 31] = kx; }
    const bool has_hi = nsl > 32;
    bs_transpose32(lo);
    if (has_hi) bs_transpose32(hi);
    auto wave_count = [&](int v) -> int {
        v += __builtin_amdgcn_update_dpp(0, v, 0xB1, 0xf, 0xf, true); v += __builtin_amdgcn_update_dpp(0, v, 0x4E, 0xf, 0xf, true);
        v += __builtin_amdgcn_update_dpp(0, v, 0x141, 0xf, 0xf, true); v += __builtin_amdgcn_update_dpp(0, v, 0x140, 0xf, 0xf, true);
        return __builtin_amdgcn_readlane(v, 0) + __builtin_amdgcn_readlane(v, 16) + __builtin_amdgcn_readlane(v, 32) + __builtin_amdgcn_readlane(v, 48); };
    unsigned clo = 0xffffffffu, chi = has_hi ? 0xffffffffu : 0u, glo = 0u, ghi = 0u;
    int G = 0;
#pragma unroll
    for (int i = 0; i < 32; ++i) {
        const unsigned olo = clo & lo[i], ohi = chi & hi[i];
        const int tot = G + wave_count(__builtin_popcount(olo) + __builtin_popcount(ohi));
        const bool take = tot >= 256;
        const unsigned mt = take ? 0u : 0xffffffffu;
        G = take ? G : tot;
        glo |= olo & mt; ghi |= ohi & mt;
        clo = olo ^ (clo & mt); chi = ohi ^ (chi & mt);
        if (tot == 256) break;
    }
    {
        const int need = 256 - G;
        const int ceq = wave_count(__builtin_popcount(clo) + __builtin_popcount(chi));
        if (ceq == need) { glo |= clo; ghi |= chi; }
        else {
            int beq = 0;
#pragma unroll 1
            for (int k = 0; k < 64; ++k) {
                const unsigned bm = 0x80000000u >> (k & 31);
                const bool mine = ((k < 32 ? clo : chi) & bm) != 0u;
                const unsigned long long me = __ballot(mine);
                if (me != 0ull) {
                    const int pe = beq + (int)__builtin_amdgcn_mbcnt_hi((unsigned)(me >> 32), __builtin_amdgcn_mbcnt_lo((unsigned)me, 0u));
                    if (mine && pe < need) { if (k < 32) glo |= bm; else ghi |= bm; }
                    beq += __popcll(me);
                }
            }
        }
    }
    const int cl = __builtin_popcount(glo) + __builtin_popcount(ghi);
    int inc = cl;
#pragma unroll
    for (int o = 1; o < 64; o <<= 1) { const int t = __shfl_up(inc, o); inc += (l >= o) ? t : 0; }
    int pos = inc - cl;
    while (__ballot(glo != 0u) != 0ull) {
        if (glo != 0u) { const int s = __builtin_clz(glo); glo &= ~(0x80000000u >> s); stg[pos++] = (unsigned short)(s * 64 + l); }
    }
    while (__ballot(ghi != 0u) != 0ull) {
        if (ghi != 0u) { const int s = __builtin_clz(ghi); ghi &= ~(0x80000000u >> s); stg[pos++] = (unsigned short)((32 + s) * 64 + l); }
    }
    __builtin_amdgcn_fence(__ATOMIC_RELEASE, "wavefront"); __builtin_amdgcn_wave_barrier(); __builtin_amdgcn_fence(__ATOMIC_ACQUIRE, "wavefront");
    *(u32x2*)(sel + 4 * l) = *(const u32x2*)(stg + 4 * l);
    __builtin_amdgcn_fence(__ATOMIC_RELEASE, "wavefront"); __builtin_amdgcn_wave_barrier(); __builtin_amdgcn_fence(__ATOMIC_ACQUIRE, "wavefront");
}
__device__ __forceinline__ void topk_select(const Ctx& c, const float* __restrict__ SC, bf16* SEL  ) {
    const int l = c.lane;
    for (int m = c.gw; m < M; m += c.ngw) {
        const int b = m / SEQ, t = m % SEQ, limit = ((t >> 6) + 1) * 64;
        unsigned short* sel = (unsigned short*)SEL + (size_t)m * 256;
        if (limit <= 256) { for (int i = l; i < 256; i += 64) sel[i] = (unsigned short)(i < limit ? i : 0); continue; }
        select_row(SC + sc_row_off(b, t), limit, sel, l);
    }
}
__device__ __forceinline__ void dsa_attn_simple(const Ctx& c, const bf16* __restrict__ QALL, const bf16* __restrict__ KF, const bf16* __restrict__ SEL, bf16* OLY, int mmax = M) {
    float* qf = (float*)c.lds;
    float* P = qf + 8 * 288;
    int* sl = (int*)(P + 8 * 256);
    const float scale = 0.08838834764831845f;
    for (int m = c.bid; m < mmax; m += c.nb) {
        const int b = m / SEQ, t = m % SEQ, limit = ((t >> 6) + 1) * 64, cnt = limit < 256 ? limit : 256;
        __syncthreads();
        for (int i = c.tid; i < 8 * 288; i += NTHR) { const int h = i / 288, d = i % 288; qf[i] = bf2f(d < 256 ? QALL[(size_t)m * QC + h * 256 + d] : QALL[(size_t)m * QC + 2048 + h * 32 + (d - 256)]); }
        if (c.tid < 256) sl[c.tid] = (int)((const unsigned short*)SEL)[(size_t)m * 256 + c.tid];
        __syncthreads();
        if (c.tid < 256) {
            float acc[8];
#pragma unroll
            for (int h = 0; h < 8; ++h) acc[h] = 0.f;
            if (c.tid < cnt) {
                const u32x4* kp = (const u32x4*)(KF + (size_t)(b * SEQ + sl[c.tid]) * KFW);
                for (int ch = 0; ch < 36; ++ch) { float k[8]; unpack8(kp[ch], k);
#pragma unroll
                    for (int h = 0; h < 8; ++h) { const float* q = qf + h * 288 + ch * 8;
#pragma unroll
                        for (int j = 0; j < 8; ++j) acc[h] += k[j] * q[j]; } }
            }
#pragma unroll
            for (int h = 0; h < 8; ++h) P[h * 256 + c.tid] = (c.tid < cnt) ? acc[h] * scale : -INFINITY;
        }
        __syncthreads();
        {
            const int h = c.wave; float v[4]; float mx = -INFINITY;
#pragma unroll
            for (int i = 0; i < 4; ++i) { v[i] = P[h * 256 + c.lane + 64 * i]; mx = fmaxf(mx, v[i]); }
            mx = wave_max(mx); float s = 0.f;
#pragma unroll
            for (int i = 0; i < 4; ++i) { v[i] = __expf(v[i] - mx); s += v[i]; }
            s = wave_sum(s); const float inv = 1.f / s;
#pragma unroll
            for (int i = 0; i < 4; ++i) P[h * 256 + c.lane + 64 * i] = v[i] * inv;
        }
        __syncthreads();
        {
            const int r = c.tid & 255, hg = c.tid >> 8; float o[4] = {0.f, 0.f, 0.f, 0.f};
            for (int i = 0; i < cnt; ++i) { const float v = bf2f(KF[(size_t)(b * SEQ + sl[i]) * KFW + r]);
#pragma unroll
                for (int hh = 0; hh < 4; ++hh) o[hh] += P[(hg * 4 + hh) * 256 + i] * v; }
#pragma unroll
            for (int hh = 0; hh < 4; ++hh) OLY[(size_t)m * OC + (hg * 4 + hh) * 256 + r] = (bf16)f2bf(o[hh]);
        }
    }
}
__device__ __forceinline__ void xattn_simple(const Ctx& c, const bf16* __restrict__ XQ, const bf16* __restrict__ KVBIG, int layer, bf16* XO) {
    float* qf = (float*)c.lds;
    float* P = qf + 512;
    const float scale = 0.08838834764831845f;
    for (int m = c.bid; m < M; m += c.nb) {
        const int b = m / SEQ;
        const bf16* kvb = KVBIG + (size_t)(layer * 2048 + b * 256) * 4096 + layer * 1024;
        __syncthreads();
        qf[c.tid] = bf2f(XQ[(size_t)m * 512 + c.tid]);
        __syncthreads();
        {
            const int j = c.tid & 255, hp = c.tid >> 8;
#pragma unroll
            for (int hh = 0; hh < 2; ++hh) { const int h = hp * 2 + hh; const u32x4* kp = (const u32x4*)(kvb + (size_t)j * 4096 + h * 128); float d = 0.f;
                for (int ch = 0; ch < 16; ++ch) { float k[8]; unpack8(kp[ch], k);
#pragma unroll
                    for (int e = 0; e < 8; ++e) d += k[e] * qf[h * 128 + ch * 8 + e]; }
                P[h * 256 + j] = d * scale; }
        }
        __syncthreads();
        if (c.wave < 4) { const int h = c.wave; float v[4]; float mx = -INFINITY;
#pragma unroll
            for (int i = 0; i < 4; ++i) { v[i] = P[h * 256 + c.lane + 64 * i]; mx = fmaxf(mx, v[i]); }
            mx = wave_max(mx); float s = 0.f;
#pragma unroll
            for (int i = 0; i < 4; ++i) { v[i] = __expf(v[i] - mx); s += v[i]; }
            s = wave_sum(s); const float inv = 1.f / s;
#pragma unroll
            for (int i = 0; i < 4; ++i) P[h * 256 + c.lane + 64 * i] = v[i] * inv; }
        __syncthreads();
        {   const int h = c.tid >> 7; float o = 0.f;
            for (int j = 0; j < 256; ++j) o += P[h * 256 + j] * bf2f(kvb[(size_t)j * 4096 + 512 + c.tid]);
            XO[(size_t)m * 512 + c.tid] = (bf16)f2bf(o); }
    }
}
__device__ __forceinline__ float x16_max(float v) { const unsigned u = __builtin_bit_cast(unsigned, v); auto r = __builtin_amdgcn_permlane16_swap(u, u, false, false); return fmaxf(__builtin_bit_cast(float, (unsigned)r[0]), __builtin_bit_cast(float, (unsigned)r[1])); }
__device__ __forceinline__ float x32_max(float v) { const unsigned u = __builtin_bit_cast(unsigned, v); auto r = __builtin_amdgcn_permlane32_swap(u, u, false, false); return fmaxf(__builtin_bit_cast(float, (unsigned)r[0]), __builtin_bit_cast(float, (unsigned)r[1])); }
__device__ __forceinline__ float x16_sum(float v) { const unsigned u = __builtin_bit_cast(unsigned, v); auto r = __builtin_amdgcn_permlane16_swap(u, u, false, false); return __builtin_bit_cast(float, (unsigned)r[0]) + __builtin_bit_cast(float, (unsigned)r[1]); }
__device__ __forceinline__ float x32_sum(float v) { const unsigned u = __builtin_bit_cast(unsigned, v); auto r = __builtin_amdgcn_permlane32_swap(u, u, false, false); return __builtin_bit_cast(float, (unsigned)r[0]) + __builtin_bit_cast(float, (unsigned)r[1]); }
typedef short bf16x8 __attribute__((ext_vector_type(8)));
typedef short bf16x4 __attribute__((ext_vector_type(4)));
__device__ __forceinline__ bf16x4 tr_read4(const unsigned char* p) { return __builtin_amdgcn_ds_read_tr16_b64_v4i16((LAS bf16x4*)p); }
__device__ __forceinline__ bf16x8 cat8(bf16x4 a, bf16x4 b) { return __builtin_shufflevector(a, b, 0, 1, 2, 3, 4, 5, 6, 7); }
__device__ __forceinline__ bf16x8 pack_p8(const f32x4 a, const f32x4 b) {
    u32x4 w; w.x = pg8::cvt_pk_bf16(a[0], a[1]); w.y = pg8::cvt_pk_bf16(a[2], a[3]); w.z = pg8::cvt_pk_bf16(b[0], b[1]); w.w = pg8::cvt_pk_bf16(b[2], b[3]);
    return __builtin_bit_cast(bf16x8, w);
}
__device__ __forceinline__ bf16x8 rope_frag(const bf16x8 xf, const bf16x8 pf, const float* cs, const float* sn, bool lo) {
    float x[8], p[8]; unpack8(__builtin_bit_cast(u32x4, xf), x); unpack8(__builtin_bit_cast(u32x4, pf), p);
    const float sg = lo ? -1.f : 1.f; float o[8];
#pragma unroll
    for (int j = 0; j < 8; ++j) o[j] = x[j] * cs[j] + sg * p[j] * sn[j];
    u32x4 w; w.x = pg8::cvt_pk_bf16(o[0], o[1]); w.y = pg8::cvt_pk_bf16(o[2], o[3]); w.z = pg8::cvt_pk_bf16(o[4], o[5]); w.w = pg8::cvt_pk_bf16(o[6], o[7]);
    return __builtin_bit_cast(bf16x8, w);
}
__device__ __forceinline__ bf16x8 xchg_frag(const bf16x8 v, int lane_xor) { u32x4 u = __builtin_bit_cast(u32x4, v); u32x4 r;
    r.x = (unsigned)__shfl_xor((int)u.x, lane_xor); r.y = (unsigned)__shfl_xor((int)u.y, lane_xor); r.z = (unsigned)__shfl_xor((int)u.z, lane_xor); r.w = (unsigned)__shfl_xor((int)u.w, lane_xor); return __builtin_bit_cast(bf16x8, r); }
constexpr int XA_PITCH = 272;
__device__ __forceinline__ void xattn_mfma(const Ctx& c, const bf16* __restrict__ XQ, const bf16* __restrict__ KVBIG, int layer, bf16* XO) {
    unsigned char* Kl = c.lds; unsigned char* Vl = c.lds + 256 * XA_PITCH;
    const int l = c.lane, n16 = l & 15, g = l >> 4;
    const float scale = 0.08838834764831845f * 1.4426950408889634f;
    for (int unit = c.bid; unit < 256; unit += c.nb) {
        const int b = unit >> 5, h = (unit >> 3) & 3, qc = unit & 7;
        const bf16* kvb = KVBIG + (size_t)(layer * 2048 + b * 256) * 4096 + layer * 1024 + h * 128;
        __syncthreads();
        {
            u32x4 kq[8], vq[8];
#pragma unroll
            for (int j = 0; j < 8; ++j) { const int i = c.tid + NTHR * j, row = i >> 4, ch = i & 15; kq[j] = *(const u32x4*)(kvb + (size_t)row * 4096 + ch * 8); vq[j] = *(const u32x4*)(kvb + (size_t)row * 4096 + 512 + ch * 8); }
#pragma unroll
            for (int j = 0; j < 8; ++j) { const int i = c.tid + NTHR * j, row = i >> 4, ch = i & 15; *(u32x4*)(Kl + row * XA_PITCH + ch * 16) = kq[j]; *(u32x4*)(Vl + row * XA_PITCH + ch * 16) = vq[j]; }
        }
        __syncthreads();
#pragma unroll 1
        for (int g4 = 0; g4 < 4; ++g4) {
            const size_t m = (size_t)b * SEQ + qc * 512 + c.wave * 64 + g4 * 16 + n16;
            bf16x8 Qb[4];
#pragma unroll
            for (int kk = 0; kk < 4; ++kk) Qb[kk] = *(const bf16x8*)(XQ + m * 512 + h * 128 + 32 * kk + 8 * g);
            f32x4 S[16];
#pragma unroll
            for (int j = 0; j < 16; ++j) { S[j] = (f32x4){0.f, 0.f, 0.f, 0.f};
#pragma unroll
                for (int kk = 0; kk < 4; ++kk) { const bf16x8 A = *(const bf16x8*)(Kl + (16 * j + n16) * XA_PITCH + (32 * kk + 8 * g) * 2);
                    S[j] = __builtin_amdgcn_mfma_f32_16x16x32_bf16(A, Qb[kk], S[j], 0, 0, 0); } }
            float mx = -INFINITY;
#pragma unroll
            for (int j = 0; j < 16; ++j) mx = fmaxf(mx, fmaxf(fmaxf(S[j][0], S[j][1]), fmaxf(S[j][2], S[j][3])));
            mx = x32_max(x16_max(mx));
            float sum = 0.f; const float mo = mx * scale;
#pragma unroll
            for (int j = 0; j < 16; ++j) {
#pragma unroll
                for (int r = 0; r < 4; ++r) { const float p = __builtin_amdgcn_exp2f(S[j][r] * scale - mo); S[j][r] = p; sum += p; } }
            sum = x32_sum(x16_sum(sum));
            const float inv = 1.f / sum;
            bf16x8 Pb[8];
#pragma unroll
            for (int jj = 0; jj < 8; ++jj) Pb[jj] = pack_p8(S[2 * jj], S[2 * jj + 1]);
            const int q4 = n16 >> 2, p4 = l & 3;
#pragma unroll
            for (int dt = 0; dt < 8; ++dt) { f32x4 O = (f32x4){0.f, 0.f, 0.f, 0.f};
#pragma unroll
                for (int jj = 0; jj < 8; ++jj) { const unsigned char* vp = Vl + (32 * jj + 4 * g + q4) * XA_PITCH + (16 * dt) * 2 + 8 * p4;
                    const bf16x8 A = cat8(tr_read4(vp), tr_read4(vp + 16 * XA_PITCH));
                    O = __builtin_amdgcn_mfma_f32_16x16x32_bf16(A, Pb[jj], O, 0, 0, 0); }
                u32x2 w; w.x = pg8::cvt_pk_bf16(O[0] * inv, O[1] * inv); w.y = pg8::cvt_pk_bf16(O[2] * inv, O[3] * inv);
                *(u32x2*)(XO + m * 512 + h * 128 + 16 * dt + 4 * g) = w; }
        }
    }
}
__device__ __forceinline__ void diag_cmp_bf16(const Ctx& c, const bf16* A, int lda, const bf16* B, int ldb, int rows, int cols, float* acc) {
    float d2 = 0.f, a2 = 0.f;
    const size_t n = (size_t)rows * cols;
    for (size_t i = (size_t)c.bid * NTHR + c.tid; i < n; i += (size_t)c.nb * NTHR) { const size_t r = i / cols, cc = i % cols; const float a = bf2f(A[r * lda + cc]), b = bf2f(B[r * ldb + cc]); d2 += (a - b) * (a - b); a2 += a * a; }
    d2 = wave_sum(d2); a2 = wave_sum(a2);
    if (c.lane == 0) { atomicAdd(acc, d2); atomicAdd(acc + 1, a2); }
}
constexpr int DA_PITCH = 528, DA_WAVE_BYTES = 32 * DA_PITCH;
__device__ __forceinline__ void dsa_attn_mfma(const Ctx& c, const bf16* __restrict__ QALL, const bf16* __restrict__ KF, const bf16* __restrict__ SEL, const float* __restrict__ ROPEA, bf16* OLY, int m_first, int m_stride, int m_end) {
    unsigned char* Vw = c.lds + c.wave * DA_WAVE_BYTES;
    const int l = c.lane, n16 = l & 15, g = l >> 4, q4 = n16 >> 2, p4 = l & 3, hh = n16 & 7;
    const float scale = 0.08838834764831845f * 1.4426950408889634f;
#pragma unroll 1
    for (int m = m_first; m < m_end; m += m_stride) {
        const int b = m / SEQ, t = m % SEQ, limit = ((t >> 6) + 1) * 64, cnt = limit < 256 ? limit : 256, nblk = cnt >> 5;
        const bf16* qrow = QALL + (size_t)m * QC;
        bf16x8 Qb[9];
#pragma unroll
        for (int kk = 0; kk < 8; ++kk) Qb[kk] = *(const bf16x8*)(qrow + hh * 256 + 32 * kk + 8 * g);
        Qb[8] = *(const bf16x8*)(qrow + 2048 + hh * 32 + 8 * g);
        {
            const bf16x8 pf = xchg_frag(Qb[8], 32); float cs[8], sn[8];
            const f32x4 c0 = *(const f32x4*)(ROPEA + (size_t)m * 32 + 8 * (g & 1)), c1 = *(const f32x4*)(ROPEA + (size_t)m * 32 + 8 * (g & 1) + 4), s0 = *(const f32x4*)(ROPEA + (size_t)m * 32 + 16 + 8 * (g & 1)), s1 = *(const f32x4*)(ROPEA + (size_t)m * 32 + 16 + 8 * (g & 1) + 4);
            cs[0] = c0.x; cs[1] = c0.y; cs[2] = c0.z; cs[3] = c0.w; cs[4] = c1.x; cs[5] = c1.y; cs[6] = c1.z; cs[7] = c1.w; sn[0] = s0.x; sn[1] = s0.y; sn[2] = s0.z; sn[3] = s0.w; sn[4] = s1.x; sn[5] = s1.y; sn[6] = s1.z; sn[7] = s1.w;
            Qb[8] = rope_frag(Qb[8], pf, cs, sn, g < 2); }
        f32x4 O[16];
#pragma unroll
        for (int dt = 0; dt < 16; ++dt) O[dt] = (f32x4){0.f, 0.f, 0.f, 0.f};
        float mrun = -INFINITY, lrun = 0.f;
        const unsigned short* selp = (const unsigned short*)SEL + (size_t)m * 256;
        const bf16* kfb = KF + (size_t)b * SEQ * KFW;
        bf16x8 K0[9], K1[9];
        int sx0, sx1;
#define DA_IDX(BLK) do { sx0 = selp[32 * (BLK) + n16]; sx1 = selp[32 * (BLK) + 16 + n16]; } while (0)
#define DA_GATHER() do { const bf16* r0_ = kfb + (size_t)sx0 * KFW + 8 * g; const bf16* r1_ = kfb + (size_t)sx1 * KFW + 8 * g; \
            _Pragma("unroll") for (int kk = 0; kk < 9; ++kk) { K0[kk] = *(const bf16x8*)(r0_ + 32 * kk); K1[kk] = *(const bf16x8*)(r1_ + 32 * kk); } } while (0)
        DA_IDX(0); DA_GATHER(); DA_IDX(nblk > 1 ? 1 : 0);
#pragma unroll 1
        for (int blk = 0; blk < nblk; ++blk) {
            f32x4 S0 = (f32x4){0.f, 0.f, 0.f, 0.f}, S1 = (f32x4){0.f, 0.f, 0.f, 0.f};
#pragma unroll
            for (int kk = 0; kk < 9; ++kk) { S0 = __builtin_amdgcn_mfma_f32_16x16x32_bf16(K0[kk], Qb[kk], S0, 0, 0, 0); S1 = __builtin_amdgcn_mfma_f32_16x16x32_bf16(K1[kk], Qb[kk], S1, 0, 0, 0); }
#pragma unroll
            for (int kk = 0; kk < 8; ++kk) { *(bf16x8*)(Vw + n16 * DA_PITCH + (32 * kk + 8 * g) * 2) = K0[kk]; *(bf16x8*)(Vw + (16 + n16) * DA_PITCH + (32 * kk + 8 * g) * 2) = K1[kk]; }
            __builtin_amdgcn_sched_barrier(0);
            if (blk + 1 < nblk) { DA_GATHER(); DA_IDX(blk + 2 < nblk ? blk + 2 : blk + 1); }
            __builtin_amdgcn_sched_barrier(0);
            float bm = fmaxf(fmaxf(fmaxf(S0[0], S0[1]), fmaxf(S0[2], S0[3])), fmaxf(fmaxf(S1[0], S1[1]), fmaxf(S1[2], S1[3])));
            bm = x32_max(x16_max(bm));
            const float mnew = fmaxf(mrun, bm), alpha = __builtin_amdgcn_exp2f((mrun - mnew) * scale), mo = mnew * scale; mrun = mnew;
            float ps = 0.f;
#pragma unroll
            for (int r = 0; r < 4; ++r) { S0[r] = __builtin_amdgcn_exp2f(S0[r] * scale - mo); S1[r] = __builtin_amdgcn_exp2f(S1[r] * scale - mo); ps += S0[r] + S1[r]; }
            lrun = lrun * alpha + ps;
            const bf16x8 Pb = pack_p8(S0, S1);
#pragma unroll
            for (int dt = 0; dt < 16; ++dt) { O[dt] = O[dt] * alpha;
                const unsigned char* vp = Vw + (4 * g + q4) * DA_PITCH + (16 * dt) * 2 + 8 * p4;
                const bf16x8 A = cat8(tr_read4(vp), tr_read4(vp + 16 * DA_PITCH));
                O[dt] = __builtin_amdgcn_mfma_f32_16x16x32_bf16(A, Pb, O[dt], 0, 0, 0); }
        }
#undef DA_GATHER
#undef DA_IDX
        lrun = x32_sum(x16_sum(lrun));
        const float inv = 1.f / lrun;
        if (n16 < 8) {
            bf16* orow = OLY + (size_t)m * OC + n16 * 256 + 4 * g;
#pragma unroll
            for (int dt = 0; dt < 16; ++dt) { u32x2 w; w.x = pg8::cvt_pk_bf16(O[dt][0] * inv, O[dt][1] * inv); w.y = pg8::cvt_pk_bf16(O[dt][2] * inv, O[dt][3] * inv); *(u32x2*)(orow + 16 * dt) = w; }
        }
    }
}
__device__ __forceinline__ void dsa_attn_queue(const Ctx& c, const bf16* __restrict__ QALL, const bf16* __restrict__ KF, const bf16* __restrict__ SEL, const float* __restrict__ ROPEA, bf16* OLY, unsigned* counter, volatile LAS unsigned* slot) {
    for (;;) {
        __syncthreads();
        if (c.tid == 0) *slot = __hip_atomic_fetch_add(counter, 1u, __ATOMIC_RELAXED, __HIP_MEMORY_SCOPE_AGENT);
        __syncthreads();
        const int chunk = (int)*slot;
        if (chunk >= M / 16) break;
        dsa_attn_mfma(c, QALL, KF, SEL, ROPEA, OLY, chunk * 16 + c.wave, 8, chunk * 16 + 16);
    }
}
__device__ __forceinline__ float relu1(float x) { const int b = __builtin_bit_cast(int, x); return __builtin_bit_cast(float, b > 0 ? b : 0); }
__device__ __forceinline__ void idx_topk_mfma(const Ctx& c, const bf16* __restrict__ QALL, const bf16* __restrict__ KIDX, const float* __restrict__ WIDX, const float* __restrict__ ROPEI, float* scr, bf16* SEL, int nitems) {
    const int l = c.lane, n16 = l & 15, g = l >> 4, qg = c.wave & 3, kh = c.wave >> 2;
#pragma unroll 1
    for (int item = c.bid; item < nitems; item += c.nb) {
        const int b = item >> 5, pr = item & 31;
#pragma unroll 1
        for (int which = 0; which < 2; ++which) {
            const int ch = which ? 63 - pr : pr, L = 64 * (ch + 1), t0 = 64 * ch;
            if (L > 256) {
            const size_t m = (size_t)b * SEQ + t0 + 16 * qg + n16;
            float* srow = scr + (size_t)(16 * qg + n16) * L + 4 * g;
            const int nt = L >> 5, j0 = kh * nt, j1 = j0 + nt;
            const bf16* kp = KIDX + ((size_t)b * SEQ + n16) * 64 + 8 * g;
            {
                bf16x8 Qi[16][2]; float w[16];
                { const bf16* qp = QALL + m * QC + 2304 + 8 * g;
#pragma unroll
                  for (int h = 0; h < 16; ++h) { Qi[h][0] = *(const bf16x8*)(qp + h * 64); Qi[h][1] = *(const bf16x8*)(qp + h * 64 + 32); }
                  {
                      float cs[8], sn[8]; const f32x4 c0 = *(const f32x4*)(ROPEI + m * 16), c1 = *(const f32x4*)(ROPEI + m * 16 + 4), s0 = *(const f32x4*)(ROPEI + m * 16 + 8), s1 = *(const f32x4*)(ROPEI + m * 16 + 12);
                      cs[0] = c0.x; cs[1] = c0.y; cs[2] = c0.z; cs[3] = c0.w; cs[4] = c1.x; cs[5] = c1.y; cs[6] = c1.z; cs[7] = c1.w; sn[0] = s0.x; sn[1] = s0.y; sn[2] = s0.z; sn[3] = s0.w; sn[4] = s1.x; sn[5] = s1.y; sn[6] = s1.z; sn[7] = s1.w;
#pragma unroll
                      for (int h = 0; h < 16; ++h) { const bf16x8 pf = xchg_frag(Qi[h][0], 16); const bf16x8 rf = rope_frag(Qi[h][0], pf, cs, sn, g == 0); if (g < 2) Qi[h][0] = rf; } }
                  const f32x4* wp = (const f32x4*)(WIDX + m * 16);
#pragma unroll
                  for (int q = 0; q < 4; ++q) { const f32x4 v = wp[q]; w[4 * q] = v.x; w[4 * q + 1] = v.y; w[4 * q + 2] = v.z; w[4 * q + 3] = v.w; } }
                bf16x8 Ka = *(const bf16x8*)(kp + (size_t)j0 * 1024), Kb = *(const bf16x8*)(kp + (size_t)j0 * 1024 + 32);
#pragma unroll 1
                for (int j = j0; j < j1; ++j) {
                    const int jn = (j + 1 < j1) ? j + 1 : j;
                    const bf16x8 Na = *(const bf16x8*)(kp + (size_t)jn * 1024), Nb = *(const bf16x8*)(kp + (size_t)jn * 1024 + 32);
                    f32x2 s01 = (f32x2){0.f, 0.f}, s23 = (f32x2){0.f, 0.f};
                    f32x4 a = __builtin_amdgcn_mfma_f32_16x16x32_bf16(Ka, Qi[0][0], (f32x4){0.f, 0.f, 0.f, 0.f}, 0, 0, 0); a = __builtin_amdgcn_mfma_f32_16x16x32_bf16(Kb, Qi[0][1], a, 0, 0, 0);
#pragma unroll
                    for (int h = 0; h < 16; ++h) { f32x4 an = a;
                        if (h < 15) { an = __builtin_amdgcn_mfma_f32_16x16x32_bf16(Ka, Qi[h + 1][0], (f32x4){0.f, 0.f, 0.f, 0.f}, 0, 0, 0); an = __builtin_amdgcn_mfma_f32_16x16x32_bf16(Kb, Qi[h + 1][1], an, 0, 0, 0); }
                        const f32x2 wv = (f32x2){w[h], w[h]};
                        s01 = (f32x2){relu1(a[0]), relu1(a[1])} * wv + s01; s23 = (f32x2){relu1(a[2]), relu1(a[3])} * wv + s23; a = an; }
                    *(f32x4*)(srow + 16 * j) = (f32x4){s01.x, s01.y, s23.x, s23.y};
                    Ka = Na; Kb = Nb;
                }
            }
            }
            asm volatile("s_waitcnt vmcnt(0)" ::: "memory");
            __syncthreads();
            __builtin_amdgcn_fence(__ATOMIC_ACQUIRE, "agent");
            asm volatile("s_waitcnt vmcnt(0)" ::: "memory");
#pragma unroll 1
            for (int i = 0; i < 8; ++i) {
                const int ql = c.wave * 8 + i;
                unsigned short* sel = (unsigned short*)SEL + ((size_t)b * SEQ + t0 + ql) * 256;
                if (L <= 256) { for (int k = l; k < 256; k += 64) sel[k] = (unsigned short)(k < L ? k : 0); }
                else select_row_bs(scr + (size_t)ql * L, L, sel, l, (unsigned short*)(c.lds + c.wave * 512));
            }
            __syncthreads();
        }
    }
}
__device__ __forceinline__ void diag_cmp_sel(const Ctx& c, const bf16* SA, const bf16* SB, int nbatch, float* acc) {
    unsigned* bm = (unsigned*)(c.lds + c.wave * 512);
    float miss = 0.f, tot = 0.f;
    for (int m = c.gw; m < nbatch * SEQ; m += c.ngw) {
        const int t = m % SEQ; if (t < 256) continue;
        bm[c.lane] = 0u; bm[64 + c.lane] = 0u;
        __builtin_amdgcn_fence(__ATOMIC_RELEASE, "wavefront"); __builtin_amdgcn_wave_barrier();
        for (int i = c.lane; i < 256; i += 64) { const unsigned s = ((const unsigned short*)SA)[(size_t)m * 256 + i]; atomicOr(&bm[s >> 5], 1u << (s & 31)); }
        __builtin_amdgcn_fence(__ATOMIC_RELEASE, "wavefront"); __builtin_amdgcn_wave_barrier(); __builtin_amdgcn_fence(__ATOMIC_ACQUIRE, "wavefront");
        for (int i = c.lane; i < 256; i += 64) { const unsigned s = ((const unsigned short*)SB)[(size_t)m * 256 + i]; miss += ((bm[s >> 5] >> (s & 31)) & 1u) ? 0.f : 1.f; tot += 1.f; }
        __builtin_amdgcn_fence(__ATOMIC_RELEASE, "wavefront"); __builtin_amdgcn_wave_barrier();
    }
    miss = wave_sum(miss); tot = wave_sum(tot);
    if (c.lane == 0) { atomicAdd(acc, miss); atomicAdd(acc + 1, tot); }
}
__device__ __forceinline__ void idx_topk_lds(const Ctx& c, const bf16* __restrict__ QALL, const bf16* __restrict__ KIDX, const float* __restrict__ WIDX, const float* __restrict__ ROPEI, u32x4* qscr, bf16* SEL, int nitems) {
    float* SCL = (float*)c.lds;
    f32x4* WL = (f32x4*)(c.lds + 131072);
    const int w8 = c.wave;
#pragma unroll 1
    for (int item = c.bid; item < nitems; item += c.nb) {
        const int b = item >> 5, pr = item & 31;
#pragma unroll 1
        for (int which = 0; which < 2; ++which) {
            int l = c.lane; asm volatile("" : "+v"(l));
            const int n16 = l & 15, g = l >> 4;
            const int ch = which ? 63 - pr : pr, L = 64 * (ch + 1), t0 = 64 * ch;
            if (L <= 256) {
#pragma unroll 1
                for (int i = 0; i < 8; ++i) { unsigned short* sel = (unsigned short*)SEL + ((size_t)b * SEQ + t0 + w8 * 8 + i) * 256; for (int k = l; k < 256; k += 64) sel[k] = (unsigned short)(k < L ? k : 0); }
                continue;
            }
            __syncthreads();
            if (w8 < 4) {
                const size_t m = (size_t)b * SEQ + t0 + 16 * w8 + n16;
                const bf16* qp = QALL + m * QC + 2304 + 8 * g;
                float cs[8], sn[8]; const f32x4 c0 = *(const f32x4*)(ROPEI + m * 16), c1 = *(const f32x4*)(ROPEI + m * 16 + 4), s0 = *(const f32x4*)(ROPEI + m * 16 + 8), s1 = *(const f32x4*)(ROPEI + m * 16 + 12);
                cs[0] = c0.x; cs[1] = c0.y; cs[2] = c0.z; cs[3] = c0.w; cs[4] = c1.x; cs[5] = c1.y; cs[6] = c1.z; cs[7] = c1.w; sn[0] = s0.x; sn[1] = s0.y; sn[2] = s0.z; sn[3] = s0.w; sn[4] = s1.x; sn[5] = s1.y; sn[6] = s1.z; sn[7] = s1.w;
#pragma unroll 4
                for (int h = 0; h < 16; ++h) { bf16x8 f0 = *(const bf16x8*)(qp + h * 64); const bf16x8 f1 = *(const bf16x8*)(qp + h * 64 + 32);
                    const bf16x8 pf = xchg_frag(f0, 16); const bf16x8 rf = rope_frag(f0, pf, cs, sn, g == 0); if (g < 2) f0 = rf;
                    qscr[(w8 * 64 + l) * 32 + h * 2] = __builtin_bit_cast(u32x4, f0); qscr[(w8 * 64 + l) * 32 + h * 2 + 1] = __builtin_bit_cast(u32x4, f1); }
            }
            asm volatile("s_waitcnt vmcnt(0)" ::: "memory");
            __syncthreads();
            __builtin_amdgcn_fence(__ATOMIC_ACQUIRE, "agent"); asm volatile("s_waitcnt vmcnt(0)" ::: "memory");
            const bf16* kp = KIDX + ((size_t)b * SEQ + n16) * 64 + 8 * g;
            const int ntile = L >> 4;
#pragma unroll 1
            for (int qsub = 0; qsub < 8; ++qsub) {
                asm volatile("" ::: "memory");
                bf16x8 Qi[16][2];
                { const int srcl = g * 16 + (qsub & 1) * 8 + (n16 & 7); const u32x4* fp = qscr + (size_t)((qsub >> 1) * 64 + srcl) * 32;
#pragma unroll
                  for (int h = 0; h < 16; ++h) { Qi[h][0] = __builtin_bit_cast(bf16x8, fp[h * 2]); Qi[h][1] = __builtin_bit_cast(bf16x8, fp[h * 2 + 1]); }
                  if (w8 == 0 && l < 32) WL[l] = *(const f32x4*)(WIDX + ((size_t)b * SEQ + t0 + 8 * qsub + (l >> 2)) * 16 + 4 * (l & 3)); }
                __syncthreads();
                const f32x4* wq = WL + (n16 & 7) * 4;
                float* srow = SCL + (n16 & 7) * 4096 + 4 * g;
                int j = w8;
                bf16x8 Ka = *(const bf16x8*)(kp + (size_t)j * 1024), Kb = *(const bf16x8*)(kp + (size_t)j * 1024 + 32);
#pragma unroll 1
                for (; j < ntile; j += 8) {
                    const int jn = (j + 8 < ntile) ? j + 8 : j;
                    const bf16x8 Na = *(const bf16x8*)(kp + (size_t)jn * 1024), Nb = *(const bf16x8*)(kp + (size_t)jn * 1024 + 32);
                    f32x2 s01 = (f32x2){0.f, 0.f}, s23 = (f32x2){0.f, 0.f};
                    f32x4 a = __builtin_amdgcn_mfma_f32_16x16x32_bf16(Ka, Qi[0][0], (f32x4){0.f, 0.f, 0.f, 0.f}, 0, 0, 0); a = __builtin_amdgcn_mfma_f32_16x16x32_bf16(Kb, Qi[0][1], a, 0, 0, 0);
#pragma unroll
                    for (int h4 = 0; h4 < 4; ++h4) { const f32x4 w4 = wq[h4];
#pragma unroll
                        for (int hh = 0; hh < 4; ++hh) { const int h = 4 * h4 + hh; f32x4 an = a;
                            if (h < 15) { an = __builtin_amdgcn_mfma_f32_16x16x32_bf16(Ka, Qi[h + 1][0], (f32x4){0.f, 0.f, 0.f, 0.f}, 0, 0, 0); an = __builtin_amdgcn_mfma_f32_16x16x32_bf16(Kb, Qi[h + 1][1], an, 0, 0, 0); }
                            const f32x2 wv = (f32x2){w4[hh], w4[hh]};
                            s01 = (f32x2){relu1(a[0]), relu1(a[1])} * wv + s01; s23 = (f32x2){relu1(a[2]), relu1(a[3])} * wv + s23; a = an; } }
                    if (n16 < 8) *(f32x4*)(srow + 16 * j) = (f32x4){s01.x, s01.y, s23.x, s23.y};
                    Ka = Na; Kb = Nb;
                }
                __syncthreads();
                select_row(SCL + w8 * 4096, L, (unsigned short*)SEL + ((size_t)b * SEQ + t0 + 8 * qsub + w8) * 256, l);
                __syncthreads();
            }
        }
    }
}
#if DIAG == 7
__device__ __forceinline__ void select_row_v1(const float* row, int limit, unsigned short* sel, int l_in) {
    int l = l_in; asm volatile("" : "+v"(l));
    const int ng = limit >> 9;
    unsigned key[64];
#pragma unroll
    for (int j = 0; j < 64; ++j) { const int s = j * 64 + l; unsigned u = 0u; if (s < limit) { u = __float_as_uint(row[s]); u = (u & 0x80000000u) ? ~u : (u | 0x80000000u); } key[j] = u; }
    unsigned mx = 0u;
#pragma unroll
    for (int j = 0; j < 64; ++j) mx = key[j] > mx ? key[j] : mx;
#pragma unroll
    for (int o = 1; o < 64; o <<= 1) { const unsigned t = (unsigned)__shfl_xor((int)mx, o); mx = t > mx ? t : mx; }
    mx = (unsigned)__builtin_amdgcn_readfirstlane((int)mx);
    unsigned T = 0u;
#pragma unroll 1
    for (int bit = 31 - __builtin_clz(mx | 1u); bit >= 0; --bit) {
        const unsigned Tn = T | (1u << bit); int cnt = 0;
#pragma unroll
        for (int jg = 0; jg < 8; ++jg) if (jg <= ng) {
#pragma unroll
            for (int j = 8 * jg; j < 8 * jg + 8; ++j) cnt += __popcll(__ballot(key[j] >= Tn)); }
        if (cnt >= 256) T = Tn;
        if (cnt == 256) break;
    }
    int cgt = 0;
#pragma unroll
    for (int j = 0; j < 64; ++j) cgt += __popcll(__ballot(key[j] > T));
    const int need_eq = 256 - cgt;
    int base = 0, beq = 0;
    const unsigned long long lt = (1ull << l) - 1ull;
#pragma unroll
    for (int jg = 0; jg < 8; ++jg) if (jg <= ng) {
#pragma unroll
        for (int j = 8 * jg; j < 8 * jg + 8; ++j) {
            const unsigned long long mg = __ballot(key[j] > T), me = __ballot(key[j] == T);
            if (key[j] > T) sel[base + __popcll(mg & lt)] = (unsigned short)(j * 64 + l);
            base += __popcll(mg);
            const int pe = beq + __popcll(me & lt);
            if (key[j] == T && pe < need_eq) sel[cgt + pe] = (unsigned short)(j * 64 + l);
            beq += __popcll(me);
        }
    }
}
__device__ __forceinline__ void idx_topk_v1(const Ctx& c, const bf16* __restrict__ QALL, const bf16* __restrict__ KIDX, const float* __restrict__ WIDX, float* scr, bf16* SEL, int nitems) {
    const int l = c.lane, n16 = l & 15, g = l >> 4, qg = c.wave & 3, kh = c.wave >> 2;
#pragma unroll 1
    for (int item = c.bid; item < nitems; item += c.nb) {
        const int b = item >> 5, pr = item & 31;
#pragma unroll 1
        for (int which = 0; which < 2; ++which) {
            const int ch = which ? 63 - pr : pr, L = 64 * (ch + 1), t0 = 64 * ch;
            if (L > 256) {
            const size_t m = (size_t)b * SEQ + t0 + 16 * qg + n16;
            float* srow = scr + (size_t)(16 * qg + n16) * L + 4 * g;
            const int nt = L >> 5, j0 = kh * nt, j1 = j0 + nt;
            const bf16* kp = KIDX + ((size_t)b * SEQ + n16) * 64 + 8 * g;
#pragma unroll 1
            for (int hp = 0; hp < 2; ++hp) {
                bf16x8 Qi[8][2]; float w[8];
                { const bf16* qp = QALL + m * QC + 2304 + hp * 512 + 8 * g;
#pragma unroll
                  for (int h = 0; h < 8; ++h) { Qi[h][0] = *(const bf16x8*)(qp + h * 64); Qi[h][1] = *(const bf16x8*)(qp + h * 64 + 32); }
                  const f32x4* wp = (const f32x4*)(WIDX + m * 16 + hp * 8);
#pragma unroll
                  for (int q = 0; q < 2; ++q) { const f32x4 v = wp[q]; w[4 * q] = v.x; w[4 * q + 1] = v.y; w[4 * q + 2] = v.z; w[4 * q + 3] = v.w; } }
                if (hp) { asm volatile("s_waitcnt vmcnt(0)" ::: "memory"); __builtin_amdgcn_fence(__ATOMIC_ACQUIRE, "agent"); asm volatile("s_waitcnt vmcnt(0)" ::: "memory"); }
                bf16x8 Ka = *(const bf16x8*)(kp + (size_t)j0 * 1024), Kb = *(const bf16x8*)(kp + (size_t)j0 * 1024 + 32);
                f32x4 pv = (f32x4){0.f, 0.f, 0.f, 0.f}; if (hp) pv = *(const f32x4*)(srow + 16 * j0);
#pragma unroll 1
                for (int j = j0; j < j1; ++j) {
                    const int jn = (j + 1 < j1) ? j + 1 : j;
                    const bf16x8 Na = *(const bf16x8*)(kp + (size_t)jn * 1024), Nb = *(const bf16x8*)(kp + (size_t)jn * 1024 + 32);
                    f32x4 pn = (f32x4){0.f, 0.f, 0.f, 0.f}; if (hp) pn = *(const f32x4*)(srow + 16 * jn);
                    f32x4 sc = pv;
#pragma unroll
                    for (int h = 0; h < 8; ++h) { f32x4 a = __builtin_amdgcn_mfma_f32_16x16x32_bf16(Ka, Qi[h][0], (f32x4){0.f, 0.f, 0.f, 0.f}, 0, 0, 0); a = __builtin_amdgcn_mfma_f32_16x16x32_bf16(Kb, Qi[h][1], a, 0, 0, 0);
                        sc[0] += w[h] * fmaxf(a[0], 0.f); sc[1] += w[h] * fmaxf(a[1], 0.f); sc[2] += w[h] * fmaxf(a[2], 0.f); sc[3] += w[h] * fmaxf(a[3], 0.f); }
                    *(f32x4*)(srow + 16 * j) = sc;
                    Ka = Na; Kb = Nb; pv = pn;
                }
            }
            }
            asm volatile("s_waitcnt vmcnt(0)" ::: "memory");
            __syncthreads();
            __builtin_amdgcn_fence(__ATOMIC_ACQUIRE, "agent");
            asm volatile("s_waitcnt vmcnt(0)" ::: "memory");
#pragma unroll 1
            for (int i = 0; i < 8; ++i) {
                const int ql = c.wave * 8 + i;
                unsigned short* sel = (unsigned short*)SEL + ((size_t)b * SEQ + t0 + ql) * 256;
                if (L <= 256) { for (int k = l; k < 256; k += 64) sel[k] = (unsigned short)(k < L ? k : 0); }
                else select_row_v1(scr + (size_t)ql * L, L, sel, l);
            }
            __syncthreads();
        }
    }
}
#endif
constexpr int RW_TB = 32;
struct RwkvP { const float *mu, *w0, *w2, *a0, *a2, *g2, *k_k, *k_a, *r_k, *ln_w, *ln_b; };
__device__ __forceinline__ void rwkv_phase(const Ctx& c, const bf16* __restrict__ H, const RwkvP P, bf16* OLY) {
    float* A_WR = (float*)c.lds;
    float* A_K2 = A_WR + RW_TB * 64;
    float* A_V = A_K2 + RW_TB * 64;
    float* A_W = A_V + RW_TB * 64;
    float* A_NKK = A_W + RW_TB * 64;
    float* A_B = A_NKK + RW_TB * 64;
    float* A_G = A_B + RW_TB * 64;
    float* A_OUT = A_G + RW_TB * 64;
    float* L_TW = A_OUT + RW_TB * 64;
    float* L_AL = L_TW + RW_TB * 64;
    float* L_SG = L_AL + RW_TB * 64;
    float* SC1 = L_SG + RW_TB * 160; float* SC2 = SC1 + RW_TB; float* SC3 = SC2 + RW_TB;
    const int l = c.lane, w = c.wave;
    for (int item = c.bid; item < NB * 16; item += c.nb) {
        const int b = item >> 4, h = item & 15, hk = h * 64 + l;
        const float w0v = P.w0[hk], a0v = P.a0[hk], kkv = P.k_k[hk], kav = P.k_a[hk], rkv = P.r_k[hk], lnw = P.ln_w[hk], lnb = P.ln_b[hk];
        float S[8];
#pragma unroll
        for (int i = 0; i < 8; ++i) S[i] = 0.f;
        const int srow = w * 8 + (l >> 3), sj = l & 7;
        for (int t0 = 0; t0 < SEQ; t0 += RW_TB) {
            __syncthreads();
            for (int idx = c.tid; idx < RW_TB * 480; idx += NTHR) {
                const int t = idx / 480, cc = idx % 480; int col; float* dst;
                if (cc < 64) { col = 880 + h * 64 + cc; dst = A_WR + t * 64 + cc; }
                else if (cc < 128) { col = 1904 + h * 64 + (cc - 64); dst = A_K2 + t * 64 + (cc - 64); }
                else if (cc < 192) { col = 2928 + h * 64 + (cc - 128); dst = A_V + t * 64 + (cc - 128); }
                else if (cc < 256) { col = 3952 + (cc - 192); dst = L_TW + t * 64 + (cc - 192); }
                else if (cc < 320) { col = 4016 + (cc - 256); dst = L_AL + t * 64 + (cc - 256); }
                else { col = 4080 + (cc - 320); dst = L_SG + t * 160 + (cc - 320); }
                const size_t m = (size_t)b * SEQ + t0 + t;
                const float x = bf2f(H[m * HC + col]); const float xp = (t0 + t > 0) ? bf2f(H[(m - 1) * HC + col]) : 0.f;
                float hm = x + (xp - x) * P.mu[col - 880];
                if (cc >= 192 && cc < 256) hm = tanhf(hm); else if (cc >= 320) hm = sigmoidf_(hm);
                *dst = hm;
            }
            __syncthreads();
            {
                float wl[RW_TB / 8], al[RW_TB / 8], gg[RW_TB / 8];
#pragma unroll
                for (int i = 0; i < RW_TB / 8; ++i) { wl[i] = 0.f; al[i] = 0.f; gg[i] = 0.f; }
                for (int j = 0; j < 64; ++j) { const float w2v = P.w2[(size_t)j * 1024 + hk], a2v = P.a2[(size_t)j * 1024 + hk];
#pragma unroll
                    for (int i = 0; i < RW_TB / 8; ++i) { wl[i] += L_TW[(w + 8 * i) * 64 + j] * w2v; al[i] += L_AL[(w + 8 * i) * 64 + j] * a2v; } }
                for (int j = 0; j < 160; ++j) { const float g2v = P.g2[(size_t)j * 1024 + hk];
#pragma unroll
                    for (int i = 0; i < RW_TB / 8; ++i) gg[i] += L_SG[(w + 8 * i) * 160 + j] * g2v; }
#pragma unroll
                for (int i = 0; i < RW_TB / 8; ++i) {
                    const int t = w + 8 * i, o = t * 64 + l;
                    const float dec = __expf(-0.6065306597126334f * sigmoidf_(w0v + wl[i]));
                    const float a = sigmoidf_(a0v + al[i]);
                    const float kr = A_K2[o], r = A_WR[o];
                    float kk = kr * kkv; const float nrm = wave_sum(kk * kk); kk = kk * (1.0f / sqrtf(fmaxf(nrm, 1e-24f)));
                    const float k2 = kr * (1.f + (a - 1.f) * kav), bb = kk * a;
                    const float s1 = wave_sum(bb * r), s2 = wave_sum(k2 * r), s3 = wave_sum(r * k2 * rkv);
                    A_W[o] = dec; A_NKK[o] = -kk; A_B[o] = bb; A_K2[o] = k2; A_WR[o] = dec * r; A_G[o] = gg[i];
                    if (l == 0) { SC1[t] = s1; SC2[t] = s2; SC3[t] = s3; }
                }
            }
            __syncthreads();
            for (int t = 0; t < RW_TB; ++t) {
                const f32x4* pw = (const f32x4*)(A_W + t * 64 + 8 * sj); const f32x4* pn = (const f32x4*)(A_NKK + t * 64 + 8 * sj); const f32x4* pb = (const f32x4*)(A_B + t * 64 + 8 * sj);
                const f32x4* pk = (const f32x4*)(A_K2 + t * 64 + 8 * sj); const f32x4* pr = (const f32x4*)(A_WR + t * 64 + 8 * sj);
                const f32x4 w0_ = pw[0], w1_ = pw[1], n0 = pn[0], n1 = pn[1], b0 = pb[0], b1 = pb[1], k0 = pk[0], k1 = pk[1], r0 = pr[0], r1 = pr[1];
                const float vv = A_V[t * 64 + srow], s1 = SC1[t], s2 = SC2[t];
                float sa = (S[0] * n0.x + S[1] * n0.y) + (S[2] * n0.z + S[3] * n0.w) + (S[4] * n1.x + S[5] * n1.y) + (S[6] * n1.z + S[7] * n1.w);
                float p = (S[0] * r0.x + S[1] * r0.y) + (S[2] * r0.z + S[3] * r0.w) + (S[4] * r1.x + S[5] * r1.y) + (S[6] * r1.z + S[7] * r1.w);
                sa += __shfl_xor(sa, 1); p += __shfl_xor(p, 1); sa += __shfl_xor(sa, 2); p += __shfl_xor(p, 2); sa += __shfl_xor(sa, 4); p += __shfl_xor(p, 4);
                S[0] = S[0] * w0_.x + (sa * b0.x + vv * k0.x); S[1] = S[1] * w0_.y + (sa * b0.y + vv * k0.y); S[2] = S[2] * w0_.z + (sa * b0.z + vv * k0.z); S[3] = S[3] * w0_.w + (sa * b0.w + vv * k0.w);
                S[4] = S[4] * w1_.x + (sa * b1.x + vv * k1.x); S[5] = S[5] * w1_.y + (sa * b1.y + vv * k1.y); S[6] = S[6] * w1_.z + (sa * b1.z + vv * k1.z); S[7] = S[7] * w1_.w + (sa * b1.w + vv * k1.w);
                if (sj == 0) A_OUT[t * 64 + srow] = p + sa * s1 + vv * s2;
            }
            __syncthreads();
#pragma unroll
            for (int i = 0; i < RW_TB / 8; ++i) {
                const int t = w + 8 * i, o = t * 64 + l;
                const float x = A_OUT[o]; const float mean = wave_sum(x) * (1.f / 64.f); const float dx = x - mean; const float var = wave_sum(dx * dx) * (1.f / 64.f);
                float y = dx * (1.0f / sqrtf(var + 64e-5f)) * lnw + lnb;
                y = (y + SC3[t] * A_V[o]) * A_G[o];
                OLY[((size_t)b * SEQ + t0 + t) * OC + 2048 + hk] = (bf16)f2bf(y);
            }
        }
    }
}

constexpr int S5_TB = 16;
struct S5P { const float *lam_re, *lam_im, *log_dt, *b_re, *b_im, *c_re, *c_im, *d; };
__device__ __forceinline__ float gelu_tanh(float y) { return 0.5f * y * (1.f + tanhf(0.7978845608028654f * (y + 0.044715f * y * y * y))); }
__device__ __forceinline__ void s5_phase(const Ctx& c, const bf16* __restrict__ U, const S5P P, bf16* Z) {
    constexpr int PERW = 256 + 2 * S5_TB * 65 + 2 * 64 * 16;
    float* UU = (float*)c.lds + c.wave * PERW;
    float* XSr = UU + 256; float* XSi = XSr + S5_TB * 65;
    float* CTr = XSi + S5_TB * 65; float* CTi = CTr + 64 * 16;
    const int l = c.lane;
    for (int item = c.bid; item < NB * 16; item += c.nb) {
        const int b = item >> 4, g = (item & 15) * 8 + c.wave;
        __syncthreads();
        float lbr, lbi, Br[16], Bi[16];
        {
            const float lr = fminf(P.lam_re[g * 64 + l], -1e-4f), li = P.lam_im[g * 64 + l], dt = expf(P.log_dt[g]);
            const float e = expf(lr * dt); lbr = e * cosf(li * dt); lbi = e * sinf(li * dt);
            const float nr = lbr - 1.f, ni = lbi, den = 1.f / (lr * lr + li * li);
            const float cr = (nr * lr + ni * li) * den, ci = (ni * lr - nr * li) * den;
#pragma unroll
            for (int i = 0; i < 16; ++i) { const float br = P.b_re[(size_t)(g * 64 + l) * 16 + i], bi = P.b_im[(size_t)(g * 64 + l) * 16 + i]; Br[i] = cr * br - ci * bi; Bi[i] = cr * bi + ci * br; }
#pragma unroll
            for (int o = 0; o < 16; ++o) { CTr[l * 16 + o] = P.c_re[(size_t)(g * 16 + o) * 64 + l]; CTi[l * 16 + o] = P.c_im[(size_t)(g * 16 + o) * 64 + l]; }
        }
        float dsk[4];
#pragma unroll
        for (int e = 0; e < 4; ++e) dsk[e] = P.d[g * 16 + (l >> 4) * 4 + e];
        float xr = 0.f, xi = 0.f;
        for (int t0 = 0; t0 < SEQ; t0 += S5_TB) {
            __syncthreads();
            { const int row = l >> 2, q = l & 3; const u32x2 w2 = *(const u32x2*)(U + ((size_t)b * SEQ + t0 + row) * D + g * 16 + 4 * q);
              float* d = UU + row * 16 + 4 * q; d[0] = bf2f(w2.x & 0xffffu); d[1] = bf2f(w2.x >> 16); d[2] = bf2f(w2.y & 0xffffu); d[3] = bf2f(w2.y >> 16); }
            __syncthreads();
            for (int t = 0; t < S5_TB; ++t) {
                const f32x4* up = (const f32x4*)(UU + t * 16); const f32x4 u0 = up[0], u1 = up[1], u2 = up[2], u3 = up[3];
                const float u[16] = {u0.x, u0.y, u0.z, u0.w, u1.x, u1.y, u1.z, u1.w, u2.x, u2.y, u2.z, u2.w, u3.x, u3.y, u3.z, u3.w};
                float bur = 0.f, bui = 0.f;
#pragma unroll
                for (int i = 0; i < 16; ++i) { bur += Br[i] * u[i]; bui += Bi[i] * u[i]; }
                const float nxr = lbr * xr - lbi * xi + bur, nxi = lbr * xi + lbi * xr + bui; xr = nxr; xi = nxi;
                XSr[t * 65 + l] = xr; XSi[t * 65 + l] = xi;
            }
            __syncthreads();
            {   const int t = l & 15, oq = l >> 4; float y[4] = {0.f, 0.f, 0.f, 0.f};
                for (int p = 0; p < 64; ++p) { const float a = XSr[t * 65 + p], bb = XSi[t * 65 + p]; const f32x4 cr = *(const f32x4*)(CTr + p * 16 + oq * 4), ci = *(const f32x4*)(CTi + p * 16 + oq * 4);
                    y[0] += a * cr.x - bb * ci.x; y[1] += a * cr.y - bb * ci.y; y[2] += a * cr.z - bb * ci.z; y[3] += a * cr.w - bb * ci.w; }
                float z[4];
#pragma unroll
                for (int e = 0; e < 4; ++e) z[e] = gelu_tanh(y[e] + dsk[e] * UU[t * 16 + oq * 4 + e]);
                u32x2 o; o.x = pk2(z[0], z[1]); o.y = pk2(z[2], z[3]);
                *(u32x2*)(Z + ((size_t)b * SEQ + t0 + t) * D + g * 16 + oq * 4) = o; }
        }
    }
}
template <int CTRL> __device__ __forceinline__ float dpp_mov(float v) { return __builtin_bit_cast(float, __builtin_amdgcn_update_dpp(0, __builtin_bit_cast(int, v), CTRL, 0xf, 0xf, true)); }
__device__ __forceinline__ float sum8(float v) { v += dpp_mov<0xB1>(v); v += dpp_mov<0x4E>(v); v += dpp_mov<0x141>(v); return v; }
__device__ __forceinline__ float wave_sum_fast(float v) { v += dpp_mov<0xB1>(v); v += dpp_mov<0x4E>(v); v += dpp_mov<0x141>(v); v += dpp_mov<0x140>(v); v += __shfl_xor(v, 16); v += __shfl_xor(v, 32); return v; }
__device__ __forceinline__ float fast_tanh(float x) { const float e = __expf(2.f * x); return 1.f - 2.f * __builtin_amdgcn_rcpf(e + 1.f); }
__device__ __forceinline__ void rwkv_lora_prep(const Ctx& c, const bf16* __restrict__ H, const float* __restrict__ mu, bf16* LX) {
    const int l = c.lane;
    const int per = (M + c.ngw - 1) / c.ngw;
    const int mA = c.gw * per, mE = (mA + per < M) ? mA + per : M;
    if (l < 36 && mA < M) {
        const int col = 3952 + 8 * l;
        const f32x4 m0 = *(const f32x4*)(mu + 3072 + 8 * l), m1 = *(const f32x4*)(mu + 3072 + 8 * l + 4);
        const float mv[8] = {m0.x, m0.y, m0.z, m0.w, m1.x, m1.y, m1.z, m1.w};
        float p[8];
        if ((mA % SEQ) > 0) unpack8(*(const u32x4*)(H + (size_t)(mA - 1) * HC + col), p); else {
#pragma unroll
            for (int j = 0; j < 8; ++j) p[j] = 0.f; }
#pragma unroll 1
        for (int mb = mA; mb < mE; mb += 8) {
            u32x4 rq[8];
#pragma unroll
            for (int i = 0; i < 8; ++i) { const int mm = (mb + i < mE) ? mb + i : mE - 1; rq[i] = *(const u32x4*)(H + (size_t)mm * HC + col); }
#pragma unroll
            for (int i = 0; i < 8; ++i) { const int m = mb + i;
                if (m < mE) {
                    float x[8]; unpack8(rq[i], x);
                    if ((m % SEQ) == 0) {
#pragma unroll
                        for (int j = 0; j < 8; ++j) p[j] = 0.f; }
                    float hm[8];
#pragma unroll
                    for (int j = 0; j < 8; ++j) { float v = x[j] + (p[j] - x[j]) * mv[j]; if (l < 8) v = fast_tanh(v); else if (l >= 16) v = sigmoidf_(v); hm[j] = v; p[j] = x[j]; }
                    u32x4 o; o.x = pg8::cvt_pk_bf16(hm[0], hm[1]); o.y = pg8::cvt_pk_bf16(hm[2], hm[3]); o.z = pg8::cvt_pk_bf16(hm[4], hm[5]); o.w = pg8::cvt_pk_bf16(hm[6], hm[7]);
                    *(u32x4*)(LX + (size_t)m * 288 + 8 * l) = o;
                }
            }
        }
    }
}
constexpr int RW2_RAWP = 384;
constexpr int RW2_TWP = 144, RW2_SGP = 336;
__device__ __forceinline__ void rwkv_phase2(const Ctx& c, const bf16* __restrict__ H, const bf16* __restrict__ LX, const RwkvP P, bf16* OUT, int ldo, int coloff, int wb = NB) {
    unsigned char* RAW = c.lds;
    float* A_WR = (float*)(c.lds + 12800);
    float* A_K2 = A_WR + 2048; float* A_V = A_K2 + 2048; float* A_W = A_V + 2048; float* A_NKK = A_W + 2048; float* A_B = A_NKK + 2048; float* A_G = A_B + 2048; float* A_OUT = A_G + 2048;
    float* LO_W = A_OUT + 2048; float* LO_A = LO_W + 2048; float* PR3 = LO_A + 2048;
    unsigned char* L_TW = (unsigned char*)(PR3 + 2048); unsigned char* L_AL = L_TW + 32 * RW2_TWP; unsigned char* L_SG = L_AL + 32 * RW2_TWP;
    float* MU = (float*)(L_SG + 32 * RW2_SGP); float* SC3 = MU + 480 + 64;
    unsigned char* G2T = (unsigned char*)(SC3 + 32);
    float* SCP = (float*)(G2T + 64 * RW2_SGP);
    float* GN = SCP + 128; float* CST = GN + 64;
    float* PR0 = (float*)L_TW; float* PR1 = PR0 + 2048; float* PR2 = A_OUT;
    const int l = c.lane, w = c.wave, n16 = l & 15, g = l >> 4;
#pragma unroll 1
    for (int item = c.bid; item < NB * 16; item += c.nb) {
        const int b = item >> 4, h = item & 15, hk = h * 64 + l;
        __syncthreads();
        if (w < 7) { const float* src = w == 0 ? P.w0 : w == 1 ? P.a0 : w == 2 ? P.k_k : w == 3 ? P.k_a : w == 4 ? P.r_k : w == 5 ? P.ln_w : P.ln_b; CST[w * 64 + l] = src[hk]; }
#pragma unroll 1
        for (int qb = 0; qb < 20; qb += 5) {
            float gq[5];
#pragma unroll
            for (int q = 0; q < 5; ++q) { const int i = c.tid + NTHR * (qb + q); gq[q] = P.g2[(size_t)(i >> 6) * 1024 + h * 64 + (i & 63)]; }
#pragma unroll
            for (int q = 0; q < 5; ++q) { const int i = c.tid + NTHR * (qb + q); *(unsigned short*)(G2T + (i & 63) * RW2_SGP + (i >> 6) * 2) = (unsigned short)f2bf(gq[q]); }
        }
        for (int i = c.tid; i < 192; i += NTHR) { const int mi = i < 64 ? h * 64 + i : i < 128 ? 1024 + h * 64 + (i - 64) : 2048 + h * 64 + (i - 128); MU[i] = P.mu[mi]; }
        const int tt = w >> 2, nt = w & 3;
        bf16x8 W2B[2], A2B[2];
        { const int kc = h * 64 + 16 * nt + n16;
          auto ldfrag = [&](const float* Wp, int kk) -> bf16x8 { float f[8]; int gq = g, kq = kc; asm volatile("" : "+v"(gq), "+v"(kq));
              const float* wp = Wp + (size_t)(32 * kk + 8 * gq) * 1024 + kq;
#pragma unroll
              for (int q = 0; q < 8; ++q) f[q] = wp[q * 1024];
              u32x4 u; u.x = pk2(f[0], f[1]); u.y = pk2(f[2], f[3]); u.z = pk2(f[4], f[5]); u.w = pk2(f[6], f[7]);
              asm volatile("" : "+v"(u));
              return __builtin_bit_cast(bf16x8, u); };
          W2B[0] = ldfrag(P.w2, 0); W2B[1] = ldfrag(P.w2, 1); A2B[0] = ldfrag(P.a2, 0); A2B[1] = ldfrag(P.a2, 1);
        }
        f32x2 S[4];
#pragma unroll
        for (int i = 0; i < 4; ++i) S[i] = (f32x2){0.f, 0.f};
        const int srow = w * 8 + (l >> 3), sj = l & 7;
        u32x4 raw[4];
        int goff[4]; unsigned ldst[4];
        { const long offL = (const char*)LX - (const char*)H;
#pragma unroll
          for (int k = 0; k < 4; ++k) { const int q_ = c.tid + 512 * k;
              if (q_ < 792) { const int cq_ = q_ % 24, row_ = q_ / 24; const int rc_ = (cq_ < 8 ? 880 : cq_ < 16 ? 1904 - 64 : 2928 - 128) + h * 64 + cq_ * 8;
                  goff[k] = (int)((((long)b * SEQ + row_ - 1) * HC + rc_) * 2); ldst[k] = (unsigned)((RAW - c.lds) + row_ * RW2_RAWP + cq_ * 16); }
              else { int e_ = q_ - 792; const bool ok_ = e_ < 1152; e_ = ok_ ? e_ : 0; const int t_ = e_ / 36, p_ = e_ % 36;
                  goff[k] = (int)(offL + (((long)b * SEQ + t_) * 288 + p_ * 8) * 2);
                  const unsigned char* d_ = p_ < 8 ? L_TW + t_ * RW2_TWP + p_ * 16 : p_ < 16 ? L_AL + t_ * RW2_TWP + (p_ - 8) * 16 : L_SG + t_ * RW2_SGP + (p_ - 16) * 16;
                  ldst[k] = ok_ ? (unsigned)(d_ - c.lds) : 0xffffffffu; } } }
#define RW2_LOAD(T0) do { _Pragma("unroll") for (int k = 0; k < 4; ++k) { \
            const int sb_ = (k == 0) ? HC * 2 : (k >= 2) ? 576 : ((c.tid + 512 < 792) ? HC * 2 : 576); \
            raw[k] = *(const u32x4*)((const char*)H + (long)(goff[k] + (T0) * sb_)); } } while (0)
        RW2_LOAD(0);
#pragma unroll 1
        for (int t0 = 0; t0 < SEQ; t0 += 32) {
            __syncthreads();
#pragma unroll
            for (int k = 0; k < 4; ++k) {
                u32x4 v_ = raw[k]; if (k == 0 && t0 == 0 && c.tid < 24) v_ = (u32x4){0u, 0u, 0u, 0u};
                if (k < 3 || ldst[k] != 0xffffffffu) *(u32x4*)(c.lds + ldst[k]) = v_; }
            { const int tn_ = (t0 + 32 < SEQ) ? t0 + 32 : t0; RW2_LOAD(tn_); }
            __syncthreads();
            if (c.tid < 384) {
                const int cpi = c.tid % 96, qb = c.tid / 96, cp = cpi * 2, tb = qb * 8;
                const float mu0 = MU[cp], mu1 = MU[cp + 1];
                unsigned xb = *(const unsigned*)(RAW + tb * RW2_RAWP + cp * 2);
                float p0 = bf2f(xb & 0xffffu), p1 = bf2f(xb >> 16);
                float* dst = (cp < 64 ? A_WR + cp : cp < 128 ? A_K2 + (cp - 64) : A_V + (cp - 128)) + tb * 64;
#pragma unroll
                for (int t = 0; t < 8; ++t) { const unsigned xa = *(const unsigned*)(RAW + (tb + t + 1) * RW2_RAWP + cp * 2); const float x0 = bf2f(xa & 0xffffu), x1 = bf2f(xa >> 16);
                    *(f32x2*)(dst + t * 64) = (f32x2){x0 + (p0 - x0) * mu0, x1 + (p1 - x1) * mu1}; p0 = x0; p1 = x1; }
            }
            __syncthreads();
            {
                f32x4 aw = (f32x4){0.f, 0.f, 0.f, 0.f}, aa = aw, ag = aw;
#pragma unroll
                for (int kk = 0; kk < 2; ++kk) { const bf16x8 At = *(const bf16x8*)(L_TW + (16 * tt + n16) * RW2_TWP + (32 * kk + 8 * g) * 2), Aa = *(const bf16x8*)(L_AL + (16 * tt + n16) * RW2_TWP + (32 * kk + 8 * g) * 2);
                    aw = __builtin_amdgcn_mfma_f32_16x16x32_bf16(At, W2B[kk], aw, 0, 0, 0); aa = __builtin_amdgcn_mfma_f32_16x16x32_bf16(Aa, A2B[kk], aa, 0, 0, 0); }
#pragma unroll
                for (int kk = 0; kk < 5; ++kk) { const bf16x8 Ag = *(const bf16x8*)(L_SG + (16 * tt + n16) * RW2_SGP + (32 * kk + 8 * g) * 2); const bf16x8 Gb = *(const bf16x8*)(G2T + (16 * nt + n16) * RW2_SGP + (32 * kk + 8 * g) * 2); ag = __builtin_amdgcn_mfma_f32_16x16x32_bf16(Ag, Gb, ag, 0, 0, 0); }
#pragma unroll
                for (int r = 0; r < 4; ++r) { const int o = (16 * tt + 4 * g + r) * 64 + 16 * nt + n16; LO_W[o] = aw[r]; LO_A[o] = aa[r]; A_G[o] = ag[r]; }
            }
            __syncthreads();
#pragma unroll 2
            for (int i = 0; i < 4; ++i) {
                const int t = w + 8 * i, o = t * 64 + l;
                const float w0v = CST[l], a0v = CST[64 + l], kkv = CST[128 + l], kav = CST[192 + l], rkv = CST[256 + l];
                const float dec = __expf(-0.6065306597126334f * sigmoidf_(w0v + LO_W[o]));
                const float a = sigmoidf_(a0v + LO_A[o]);
                const float kr = A_K2[o], r = A_WR[o];
                const float kk0 = kr * kkv, k2 = kr * (1.f + (a - 1.f) * kav), bb0 = kk0 * a, k2r = k2 * r;
                A_W[o] = dec; A_NKK[o] = -kk0; A_B[o] = bb0; A_K2[o] = k2; A_WR[o] = dec * r;
                PR0[o] = kk0 * kk0; PR1[o] = bb0 * r; PR2[o] = k2r; PR3[o] = k2r * rkv;
            }
            __syncthreads();
            {
                const int t = c.tid >> 4, q = (c.tid >> 2) & 3, qu = c.tid & 3;
                const float* src = (q == 0 ? PR0 : q == 1 ? PR1 : q == 2 ? PR2 : PR3) + t * 64 + 16 * qu;
                const f32x4 v0 = *(const f32x4*)src, v1 = *(const f32x4*)(src + 4), v2 = *(const f32x4*)(src + 8), v3 = *(const f32x4*)(src + 12);
                float sm = ((v0.x + v0.y) + (v0.z + v0.w)) + ((v1.x + v1.y) + (v1.z + v1.w)) + ((v2.x + v2.y) + (v2.z + v2.w)) + ((v3.x + v3.y) + (v3.z + v3.w));
                sm += dpp_mov<0xB1>(sm); sm += dpp_mov<0x4E>(sm);
                if (qu == 0) SCP[t * 4 + q] = (q == 0) ? __builtin_amdgcn_rcpf(fmaxf(sm, 1e-24f)) : sm;
            }
            __syncthreads();
#if DBL & 0x4000
            { f32x2 Ssv[4]; Ssv[0] = S[0]; Ssv[1] = S[1]; Ssv[2] = S[2]; Ssv[3] = S[3];
            {
                f32x4 n0, n1, r0, r1, w0_, w1_, b0, b1, k0, k1; f32x3 sp; float vv;
                const unsigned char* pk_ = (const unsigned char*)A_WR + 32 * sj;
                const unsigned char* pv_ = (const unsigned char*)A_WR + 4 * srow;
                const unsigned char* ps_ = (const unsigned char*)SCP;
                constexpr int O_WR = 0, O_K2 = 8192, O_V = 16384, O_W = 24576, O_NKK = 32768, O_B = 40960, O_OUT = 57344;
#define RW2_LD_DOT(T) do { n0 = *(const f32x4*)(pk_ + O_NKK + (T) * 256); n1 = *(const f32x4*)(pk_ + O_NKK + (T) * 256 + 16); r0 = *(const f32x4*)(pk_ + O_WR + (T) * 256); r1 = *(const f32x4*)(pk_ + O_WR + (T) * 256 + 16); } while (0)
#define RW2_LD_UPD(T) do { w0_ = *(const f32x4*)(pk_ + O_W + (T) * 256); w1_ = *(const f32x4*)(pk_ + O_W + (T) * 256 + 16); b0 = *(const f32x4*)(pk_ + O_B + (T) * 256); b1 = *(const f32x4*)(pk_ + O_B + (T) * 256 + 16); \
                    k0 = *(const f32x4*)(pk_ + O_K2 + (T) * 256); k1 = *(const f32x4*)(pk_ + O_K2 + (T) * 256 + 16); vv = *(const float*)(pv_ + O_V + (T) * 256); sp = *(const f32x3*)(ps_ + (T) * 16); } while (0)
#define RW2_STEP(T) do { \
                    f32x2 sa2 = S[0] * (f32x2){n0.x, n0.y}; sa2 = S[1] * (f32x2){n0.z, n0.w} + sa2; sa2 = S[2] * (f32x2){n1.x, n1.y} + sa2; sa2 = S[3] * (f32x2){n1.z, n1.w} + sa2; \
                    f32x2 p2 = S[0] * (f32x2){r0.x, r0.y}; p2 = S[1] * (f32x2){r0.z, r0.w} + p2; p2 = S[2] * (f32x2){r1.x, r1.y} + p2; p2 = S[3] * (f32x2){r1.z, r1.w} + p2; \
                    __builtin_amdgcn_sched_barrier(0); RW2_LD_DOT((T) + 1); __builtin_amdgcn_sched_barrier(0); \
                    const float sa = sum8(sa2.x + sa2.y) * sp.x, p = sum8(p2.x + p2.y); \
                    const f32x2 sav = (f32x2){sa, sa}, vvv = (f32x2){vv, vv}; \
                    S[0] = S[0] * (f32x2){w0_.x, w0_.y} + (sav * (f32x2){b0.x, b0.y} + vvv * (f32x2){k0.x, k0.y}); \
                    S[1] = S[1] * (f32x2){w0_.z, w0_.w} + (sav * (f32x2){b0.z, b0.w} + vvv * (f32x2){k0.z, k0.w}); \
                    S[2] = S[2] * (f32x2){w1_.x, w1_.y} + (sav * (f32x2){b1.x, b1.y} + vvv * (f32x2){k1.x, k1.y}); \
                    S[3] = S[3] * (f32x2){w1_.z, w1_.w} + (sav * (f32x2){b1.z, b1.w} + vvv * (f32x2){k1.z, k1.w}); \
                    const float ov = p + sa * sp.y + vv * sp.z; \
                    __builtin_amdgcn_sched_barrier(0); RW2_LD_UPD((T) + 1); *(float*)(const_cast<unsigned char*>(pv_) + O_OUT + (T) * 256) = ov;        __builtin_amdgcn_sched_barrier(0); } while (0)
                RW2_LD_DOT(0); RW2_LD_UPD(0);
#pragma unroll 1
                for (int t4 = 0; t4 < 8; ++t4) {
                    RW2_STEP(0); RW2_STEP(1); RW2_STEP(2); RW2_STEP(3);
                    pk_ += 1024; pv_ += 1024; ps_ += 64;
                }
#undef RW2_LD_DOT
#undef RW2_LD_UPD
#undef RW2_STEP
            }
            S[0] = Ssv[0]; S[1] = Ssv[1]; S[2] = Ssv[2]; S[3] = Ssv[3]; asm volatile("" : "+v"(S[0]), "+v"(S[1]), "+v"(S[2]), "+v"(S[3])); __syncthreads(); }
#endif
            {
                f32x4 n0, n1, r0, r1, w0_, w1_, b0, b1, k0, k1; f32x3 sp; float vv;
                const unsigned char* pk_ = (const unsigned char*)A_WR + 32 * sj;
                const unsigned char* pv_ = (const unsigned char*)A_WR + 4 * srow;
                const unsigned char* ps_ = (const unsigned char*)SCP;
                constexpr int O_WR = 0, O_K2 = 8192, O_V = 16384, O_W = 24576, O_NKK = 32768, O_B = 40960, O_OUT = 57344;
#define RW2_LD_DOT(T) do { n0 = *(const f32x4*)(pk_ + O_NKK + (T) * 256); n1 = *(const f32x4*)(pk_ + O_NKK + (T) * 256 + 16); r0 = *(const f32x4*)(pk_ + O_WR + (T) * 256); r1 = *(const f32x4*)(pk_ + O_WR + (T) * 256 + 16); } while (0)
#define RW2_LD_UPD(T) do { w0_ = *(const f32x4*)(pk_ + O_W + (T) * 256); w1_ = *(const f32x4*)(pk_ + O_W + (T) * 256 + 16); b0 = *(const f32x4*)(pk_ + O_B + (T) * 256); b1 = *(const f32x4*)(pk_ + O_B + (T) * 256 + 16); \
                    k0 = *(const f32x4*)(pk_ + O_K2 + (T) * 256); k1 = *(const f32x4*)(pk_ + O_K2 + (T) * 256 + 16); vv = *(const float*)(pv_ + O_V + (T) * 256); sp = *(const f32x3*)(ps_ + (T) * 16); } while (0)
#define RW2_STEP(T) do { \
                    f32x2 sa2 = S[0] * (f32x2){n0.x, n0.y}; sa2 = S[1] * (f32x2){n0.z, n0.w} + sa2; sa2 = S[2] * (f32x2){n1.x, n1.y} + sa2; sa2 = S[3] * (f32x2){n1.z, n1.w} + sa2; \
                    f32x2 p2 = S[0] * (f32x2){r0.x, r0.y}; p2 = S[1] * (f32x2){r0.z, r0.w} + p2; p2 = S[2] * (f32x2){r1.x, r1.y} + p2; p2 = S[3] * (f32x2){r1.z, r1.w} + p2; \
                    __builtin_amdgcn_sched_barrier(0); RW2_LD_DOT((T) + 1); __builtin_amdgcn_sched_barrier(0); \
                    const float sa = sum8(sa2.x + sa2.y) * sp.x, p = sum8(p2.x + p2.y); \
                    const f32x2 sav = (f32x2){sa, sa}, vvv = (f32x2){vv, vv}; \
                    S[0] = S[0] * (f32x2){w0_.x, w0_.y} + (sav * (f32x2){b0.x, b0.y} + vvv * (f32x2){k0.x, k0.y}); \
                    S[1] = S[1] * (f32x2){w0_.z, w0_.w} + (sav * (f32x2){b0.z, b0.w} + vvv * (f32x2){k0.z, k0.w}); \
                    S[2] = S[2] * (f32x2){w1_.x, w1_.y} + (sav * (f32x2){b1.x, b1.y} + vvv * (f32x2){k1.x, k1.y}); \
                    S[3] = S[3] * (f32x2){w1_.z, w1_.w} + (sav * (f32x2){b1.z, b1.w} + vvv * (f32x2){k1.z, k1.w}); \
                    const float ov = p + sa * sp.y + vv * sp.z; \
                    __builtin_amdgcn_sched_barrier(0); RW2_LD_UPD((T) + 1); *(float*)(const_cast<unsigned char*>(pv_) + O_OUT + (T) * 256) = ov;        __builtin_amdgcn_sched_barrier(0); } while (0)
                RW2_LD_DOT(0); RW2_LD_UPD(0);
#pragma unroll 1
                for (int t4 = 0; t4 < 8; ++t4) {
                    RW2_STEP(0); RW2_STEP(1); RW2_STEP(2); RW2_STEP(3);
                    pk_ += 1024; pv_ += 1024; ps_ += 64;
                }
#undef RW2_LD_DOT
#undef RW2_LD_UPD
#undef RW2_STEP
            }
            __syncthreads();
            {
                const int t = c.tid >> 4, part = c.tid & 15;
                const f32x4 v = *(const f32x4*)(A_OUT + t * 64 + 4 * part);
                float s1 = (v.x + v.y) + (v.z + v.w), s2 = (v.x * v.x + v.y * v.y) + (v.z * v.z + v.w * v.w);
                s1 += dpp_mov<0xB1>(s1); s2 += dpp_mov<0xB1>(s2); s1 += dpp_mov<0x4E>(s1); s2 += dpp_mov<0x4E>(s2);
                s1 += dpp_mov<0x141>(s1); s2 += dpp_mov<0x141>(s2); s1 += dpp_mov<0x140>(s1); s2 += dpp_mov<0x140>(s2);
                if (part == 0) { const float mean = s1 * (1.f / 64.f), var = fmaxf(s2 * (1.f / 64.f) - mean * mean, 0.f); GN[t * 2] = mean; GN[t * 2 + 1] = __builtin_amdgcn_rsqf(var + 64e-5f); }
            }
            __syncthreads();
#pragma unroll
            for (int i = 0; i < 4; ++i) {
                const int t = w + 8 * i, o = t * 64 + l;
                float y = (A_OUT[o] - GN[t * 2]) * GN[t * 2 + 1] * CST[320 + l] + CST[384 + l];
                y = (y + SCP[t * 4 + 3] * A_V[o]) * A_G[o];
                if (b < wb) OUT[((size_t)b * SEQ + t0 + t) * ldo + coloff + hk] = (bf16)f2bf(y);
            }
        }
#undef RW2_LOAD
    }
}
constexpr int S5B_BUP = 132 * 4, S5B_XP = 272;
constexpr int S5B_WAVE = 16 * S5B_BUP + 16 * S5B_XP;
__device__ __forceinline__ void wave_lds_sync() { __builtin_amdgcn_fence(__ATOMIC_RELEASE, "wavefront"); __builtin_amdgcn_wave_barrier(); __builtin_amdgcn_fence(__ATOMIC_ACQUIRE, "wavefront"); }
__device__ __forceinline__ float gelu_fast(float y) { const float u2 = 1.5957691216057308f * (y + 0.044715f * y * y * y); return y * __builtin_amdgcn_rcpf(1.f + __expf(-u2)); }
__device__ __forceinline__ void s5_phase2(const Ctx& c, const bf16* __restrict__ U, const S5P P, bf16* Z) {
    if (c.wave >= 4) return;
    float* BU = (float*)(c.lds + c.wave * S5B_WAVE); unsigned char* XB = c.lds + c.wave * S5B_WAVE + 16 * S5B_BUP;
    const int l = c.lane, n16 = l & 15, g = l >> 4;
#pragma unroll 1
    for (int item = c.bid; item < 256; item += c.nb) {
        const int b = item >> 5, grp = (item & 31) * 4 + c.wave;
        float lbr, lbi;
        { const float lr = fminf(P.lam_re[grp * 64 + l], -1e-4f), li = P.lam_im[grp * 64 + l], dt = expf(P.log_dt[grp]);
          const float e = expf(lr * dt); lbr = e * cosf(li * dt); lbi = e * sinf(li * dt);
          const float nr = lbr - 1.f, ni = lbi, den = 1.f / (lr * lr + li * li);
          BU[l] = (nr * lr + ni * li) * den; BU[64 + l] = (ni * lr - nr * li) * den; }
        wave_lds_sync();
        bf16x4 Bre[4], Bim[4];
#pragma unroll
        for (int nt = 0; nt < 4; ++nt) { const int p = 16 * nt + n16; const float cr = BU[p], ci = BU[64 + p];
            const f32x4 br = *(const f32x4*)(P.b_re + (size_t)(grp * 64 + p) * 16 + 4 * g), bi = *(const f32x4*)(P.b_im + (size_t)(grp * 64 + p) * 16 + 4 * g);
            u32x2 wr, wi; wr.x = pk2(cr * br.x - ci * bi.x, cr * br.y - ci * bi.y); wr.y = pk2(cr * br.z - ci * bi.z, cr * br.w - ci * bi.w);
            wi.x = pk2(cr * bi.x + ci * br.x, cr * bi.y + ci * br.y); wi.y = pk2(cr * bi.z + ci * br.z, cr * bi.w + ci * br.w);
            Bre[nt] = __builtin_bit_cast(bf16x4, wr); Bim[nt] = __builtin_bit_cast(bf16x4, wi); }
        wave_lds_sync();
        bf16x8 Cf[4];
#pragma unroll
        for (int kk = 0; kk < 4; ++kk) { const int p0 = 16 * kk + 4 * g;
            const f32x4 vr = *(const f32x4*)(P.c_re + (size_t)(grp * 16 + n16) * 64 + p0), vi = *(const f32x4*)(P.c_im + (size_t)(grp * 16 + n16) * 64 + p0);
            u32x4 w; w.x = pk2(vr.x, -vi.x); w.y = pk2(vr.y, -vi.y); w.z = pk2(vr.z, -vi.z); w.w = pk2(vr.w, -vi.w); Cf[kk] = __builtin_bit_cast(bf16x8, w); }
        bf16x4 Df; { const float dsk = P.d[grp * 16 + n16]; const int kq = n16 - 4 * g; u32x2 w; w.x = pk2(kq == 0 ? dsk : 0.f, kq == 1 ? dsk : 0.f); w.y = pk2(kq == 2 ? dsk : 0.f, kq == 3 ? dsk : 0.f); Df = __builtin_bit_cast(bf16x4, w); }
        f32x2 xs = (f32x2){0.f, 0.f};
        const bf16* ub = U + (size_t)b * SEQ * D + grp * 16;
        u32x2 ua[4];
#define S5B_LOAD(k, T0) do { ua[k] = *(const u32x2*)(ub + (size_t)((T0) + n16) * D + 4 * g); } while (0)
#pragma unroll
        for (int k = 0; k < 4; ++k) S5B_LOAD(k, 16 * k);
#pragma unroll 1
        for (int t0 = 0; t0 < SEQ; t0 += 64) {
#pragma unroll
            for (int k = 0; k < 4; ++k) {
                const int tb = t0 + 16 * k;
                const bf16x4 A = __builtin_bit_cast(bf16x4, ua[k]);
                { const int tn = (tb + 64 < SEQ) ? tb + 64 : tb; S5B_LOAD(k, tn); }
                const f32x4 yd = __builtin_amdgcn_mfma_f32_16x16x16bf16_1k(A, Df, (f32x4){0.f, 0.f, 0.f, 0.f}, 0, 0, 0);
#pragma unroll
                for (int nt = 0; nt < 4; ++nt) {
                    const f32x4 ar = __builtin_amdgcn_mfma_f32_16x16x16bf16_1k(A, Bre[nt], (f32x4){0.f, 0.f, 0.f, 0.f}, 0, 0, 0);
                    const f32x4 ai = __builtin_amdgcn_mfma_f32_16x16x16bf16_1k(A, Bim[nt], (f32x4){0.f, 0.f, 0.f, 0.f}, 0, 0, 0);
#pragma unroll
                    for (int r = 0; r < 4; ++r) *(f32x2*)(BU + (4 * g + r) * 132 + 2 * (16 * nt + n16)) = (f32x2){ar[r], ai[r]};
                }
                wave_lds_sync();
#pragma unroll 4
                for (int t = 0; t < 16; ++t) {
                    const f32x2 bu = *(const f32x2*)(BU + t * 132 + 2 * l);
                    const f32x2 tq = (f32x2){lbr, lbr} * xs + bu;
                    xs = (f32x2){-lbi, lbi} * (f32x2){xs.y, xs.x} + tq;
                    *(unsigned*)(XB + t * S5B_XP + l * 4) = pg8::cvt_pk_bf16(xs.x, xs.y);
                }
                wave_lds_sync();
                f32x4 y = (f32x4){0.f, 0.f, 0.f, 0.f};
#pragma unroll
                for (int kk = 0; kk < 4; ++kk) { const bf16x8 Ax = *(const bf16x8*)(XB + n16 * S5B_XP + (32 * kk + 8 * g) * 2); y = __builtin_amdgcn_mfma_f32_16x16x32_bf16(Ax, Cf[kk], y, 0, 0, 0); }
#pragma unroll
                for (int r = 0; r < 4; ++r) Z[((size_t)b * SEQ + tb + 4 * g + r) * D + grp * 16 + n16] = (bf16)f2bf(gelu_fast(y[r] + yd[r]));
                wave_lds_sync();
            }
        }
#undef S5B_LOAD
    }
}
struct Args { const void* in[45]; float* out; unsigned char* ws; int ph_lo, ph_hi; };
static_assert(sizeof(Args) == 45 * 8 + 8 + 8 + 8, "Args has no padding");
constexpr int PH_EVEN = 9, PH_ODD = 4, PH_COMMON = 13;
constexpr int NPHASES = 2 * (1 + PH_EVEN + PH_COMMON) + 2 * (1 + PH_ODD + PH_COMMON) + 1;

__global__ void __launch_bounds__(NTHR, 2) mega(Args args) {
    extern __shared__ __attribute__((aligned(16))) unsigned char lds[];
    volatile LAS unsigned* MISC = (volatile LAS unsigned*)((LAS unsigned char*)lds + MISC_OFF);
    if (threadIdx.x < 64) MISC[threadIdx.x] = 0u;
    __syncthreads();
    unsigned char* ws = args.ws;
    XcdBarrier bar = xcd_barrier_post((unsigned*)(ws + WS_CTL) + 4096, MISC + 8, gridDim.x);
    const int half = (int)gridDim.x >> 1;
    XcdBarrier bar2 = bar; if ((int)blockIdx.x >= half) bar2 = xcd_barrier_post((unsigned*)(ws + WS_CTL) + 8192, MISC + 10, gridDim.x - half);
    const int lo = args.ph_lo, hi = args.ph_hi;
    int pid = 0;
#define PH_BEGIN if (pid >= lo && pid < hi) { Ctx c; { int t_ = threadIdx.x, b_ = blockIdx.x; asm volatile("" : "+v"(t_)); asm volatile("" : "+s"(b_)); c.lds = lds; c.tid = t_; c.lane = t_ & 63; c.wave = __builtin_amdgcn_readfirstlane(t_ >> 6); c.bid = b_; { int n_ = gridDim.x; asm volatile("" : "+s"(n_)); c.nb = n_; } c.gw = c.bid * NWAVES + c.wave; c.ngw = c.nb * NWAVES; }
#define PH_END } if (pid >= lo && pid + 1 < hi) { xcd_barrier(bar); if (DBL & 2048) xcd_barrier(bar); } ++pid;
#define IN_F(i) (*(const float* const __attribute__((address_space(4)))*)(KARGS() + 8 * (i)))

    typedef const unsigned char __attribute__((address_space(4)))* kptr_t;
#define KARGS() ({ kptr_t p_ = (kptr_t)__builtin_amdgcn_kernarg_segment_ptr(); asm volatile("" : "+s"(p_)); p_; })
#define WSP(off) ((*(unsigned char* const __attribute__((address_space(4)))*)(KARGS() + 368)) + (off))
#define X ((float*)(*(float* const __attribute__((address_space(4)))*)(KARGS() + 360)))
#define ROPEA ((float*)WSP(WS_ROPEA))
#define ROPEI ((float*)WSP(WS_ROPEI))
#define KVBIG ((bf16*)WSP(WS_KVBIG))
#define WKV ((bf16*)WSP(WS_WKV))
#define W_IN ((bf16*)WSP(WS_WMIX + WMIX_IN))
#define WQ ((bf16*)WSP(WS_WMIX + WMIX_Q))
#define WOUT ((bf16*)WSP(WS_WMIX + WMIX_OUT))
#define WO_IN ((bf16*)WSP(WS_WMIX + WMIX_O_IN))
#define WO_GLU ((bf16*)WSP(WS_WMIX + WMIX_O_GLU))
#define WO_OUT ((bf16*)WSP(WS_WMIX + WMIX_O_OUT))
#define WXQ ((bf16*)WSP(WS_WXQ))
#define WXO ((bf16*)WSP(WS_WXO))
#define WUP ((bf16*)WSP(WS_WUP))
#define WDN ((bf16*)WSP(WS_WDN))
#define CQN ((bf16*)WSP(WS_CQN))
#define KF ((bf16*)WSP(WS_KF))
#define KIDX ((bf16*)WSP(WS_KIDX))
#define WIDX ((float*)WSP(WS_WIDX))
#define SEL ((bf16*)WSP(WS_SEL))
#define Hb ((bf16*)WSP(WS_R1))
#define SC ((float*)WSP(WS_R1))
#define HID ((bf16*)WSP(WS_R1))
#define Ub ((bf16*)WSP(WS_R1))
#define YC ((bf16*)WSP(WS_R1 + (size_t)M * D * 2))
#define XN ((bf16*)WSP(WS_R2))
#define QALL ((bf16*)X)
#define OLY ((bf16*)WSP(WS_R3))
#define Zb ((bf16*)WSP(WS_R3))
#define XQ ((bf16*)WSP(WS_R3))
#define XO ((bf16*)WSP(WS_R3 + (size_t)M * 512 * 2))
#define MEMN ((bf16*)WSP(WS_R3))
    LAS unsigned char* glds = (LAS unsigned char*)lds;

#define RS_A ((unsigned long long*)WSP(WS_CTL + 131072))
#define RS_B ((unsigned long long*)WSP(WS_CTL + 393216))
#define RS_C ((unsigned long long*)WSP(WS_CTL + 655360))
    for (int layer = 0; layer < DEPTH; ++layer) {
        const int li = layer >> 1;
        PH_BEGIN
            if ((layer & 1) == 0) {
                conv_mat(c, IN_F(13) + (size_t)li * 2048 * EVEN_COLS, 2048, EVEN_COLS, EVEN_COLS, HC, W_IN, 2048, 0, 0, IN_F(3) + layer * D);
                build_wql(c, IN_F(18) + (size_t)li * 512 * 1024, IN_F(19) + (size_t)li * 256 * 768, WQ);
                for (int h = 0; h < 8; ++h) conv_mat(c, IN_F(18) + (size_t)li * 512 * 1024 + h * 128, 512, 1024, 32, 32, WQ, 512, 2048 + h * 32, 0);
                conv_mat(c, IN_F(21) + (size_t)li * 512 * 1024, 512, 1024, 1024, 1024, WQ, 512, 2304, 0);
                build_wout(c, IN_F(20) + (size_t)li * 256 * 1024, IN_F(14) + (size_t)li * 2048 * 2048, WOUT);
                conv_mat(c, IN_F(14) + (size_t)li * 2048 * 2048 + (size_t)1024 * 2048, 1024, 2048, 2048, 2048, WOUT, OC, 0, 2048);
            } else {
                conv_mat(c, IN_F(33) + (size_t)li * 2048 * 2048, 2048, 2048, 2048, 2048, WO_IN, 2048, 0, 0, IN_F(3) + layer * D);
                conv_mat(c, IN_F(43) + (size_t)li * 2048 * 2048, 2048, 2048, 2048, 2048, WO_GLU, 2048, 0, 0);
                conv_mat(c, IN_F(34) + (size_t)li * 2048 * 2048, 2048, 2048, 2048, 2048, WO_OUT, 2048, 0, 0);
            }
            conv_mat(c, IN_F(8) + (size_t)layer * 2048 * 512, 2048, 512, 512, 512, WXQ, 2048, 0, 0, IN_F(4) + layer * D);
            conv_mat(c, IN_F(10) + (size_t)layer * 512 * 2048, 512, 2048, 2048, 2048, WXO, 512, 0, 0);
            { unsigned long long* ra = RS_A; unsigned long long* rb = RS_B; for (int i = c.bid * NTHR + c.tid; i < M; i += c.nb * NTHR) { ra[i] = 0ull; rb[i] = 0ull; } }
            if (layer == 0) {
                for (int l2 = 0; l2 < 4; ++l2) {
                    conv_mat(c, IN_F(9) + (size_t)l2 * 2048 * 1024, 2048, 1024, 1024, 1024, WKV, 2048, l2 * 1024, 0);
                    norm_rows_bf16(c, IN_F(1), IN_F(5) + l2 * D, MEMN + (size_t)l2 * MEMR * D, MEMR);
                }
                rope_tables(c, (const int*)IN_F(2), ROPEA, ROPEI);
                cast_rows_ss(c, IN_F(0), XN, RS_C, M);
            }
        PH_END
        if ((layer & 1) == 0) {
            PH_BEGIN
                { pg8::Gemm g{XN, W_IN, 2048, 2048, 2048}; pg8::StaticOrder S; S.init(128, HC / 256, c.nb, c.bid); pg8::EpiBf16<0> E{Hb, HC, RS_C};
                  pg8::gemm_phase<pg8::EpiBf16<0>, pg8::StaticOrder, true, true>(glds, g, S, E);
                  if (DBL & 1024) { __syncthreads(); pg8::gemm_phase<pg8::EpiBf16<0>, pg8::StaticOrder, true, true>(glds, g, S, E); } }
                if (layer == 0) { __syncthreads(); pg8::Gemm g{MEMN, WKV, 2048, 2048, 2048}; pg8::KvOrder S{c.nb, c.bid}; pg8::EpiBf16<0> E{KVBIG, 4096, nullptr};
                  pg8::gemm_phase<pg8::EpiBf16<0>, pg8::KvOrder, true, true>(glds, g, S, E); }
            PH_END
            PH_BEGIN
                rwkv_lora_prep(c, Hb, IN_F(22) + li * B_COLS, (bf16*)WSP(WS_END + 96 * MiB));
            PH_END
            PH_BEGIN
                if (c.bid < half) {
                    Ctx r = c; r.nb = half; r.ngw = half * NWAVES;
                    const RwkvP P{IN_F(22) + li * B_COLS, IN_F(23) + li * 1024, IN_F(24) + (size_t)li * 65536, IN_F(25) + li * 1024, IN_F(26) + (size_t)li * 65536, IN_F(27) + (size_t)li * 163840,
                                  IN_F(28) + li * 1024, IN_F(29) + li * 1024, IN_F(30) + li * 1024, IN_F(31) + li * 1024, IN_F(32) + li * 1024};
#if DIAG == 4
                    rwkv_phase(r, Hb, P, OLY);
                    rwkv_phase2(r, Hb, (const bf16*)WSP(WS_END + 96 * MiB), P, (bf16*)WSP(WS_END + 116 * MiB), 1024, 0, 1);
#else
                    rwkv_phase2(r, Hb, (const bf16*)WSP(WS_END + 96 * MiB), P, OLY, OC, 2048);
#endif
                    __syncthreads();
                    conv_mat(r, IN_F(12) + (size_t)layer * FFN * 2048, FFN, 2048, 2048, 2048, WDN, FFN, 0, 0);
                } else {
                    Ctx d = c; d.bid = c.bid - half; d.nb = c.nb - half; d.gw = d.bid * NWAVES + d.wave; d.ngw = d.nb * NWAVES;
                    dsa_prep(d, Hb, IN_F(15) + li * 512, IN_F(16) + li * 256, IN_F(17) + li * 64, ROPEA, ROPEI, CQN, KF, KIDX, WIDX);
                    xcd_barrier(bar2);
                    { pg8::Gemm g{CQN, WQ, 512, 512, 512}; pg8::StaticOrder S; S.init(128, QC / 256, d.nb, d.bid); pg8::EpiBf16<0> E{QALL, QC, nullptr};
                      pg8::gemm_phase<pg8::EpiBf16<0>, pg8::StaticOrder, true, true>(glds, g, S, E); }
                    xcd_barrier(bar2);
                    idx_topk_mfma(d, QALL, KIDX, WIDX, ROPEI, (float*)(d.bid < 32 ? WSP(WS_CQN + (size_t)d.bid * MiB) : WSP(WS_END + (size_t)(d.bid - 32) * MiB)), SEL, 256);
                    conv_mat(d, IN_F(11) + (size_t)layer * 2048 * FFN, 2048, FFN, FFN, FFN, WUP, 2048, 0, 0, IN_F(6) + layer * D);
                    xcd_barrier(bar2);
                    if (d.bid == 0 && c.tid == 0) __hip_atomic_store((unsigned*)WSP(WS_CTL) + 12288 + 64 * (2 + li), 1u, __ATOMIC_RELAXED, __HIP_MEMORY_SCOPE_AGENT);
                }
                if (c.bid < half) {
                    if (c.tid == 0) { unsigned* fl = (unsigned*)WSP(WS_CTL) + 12288 + 64 * (2 + li); unsigned sp = 0;
                        while (__hip_atomic_load(fl, __ATOMIC_RELAXED, __HIP_MEMORY_SCOPE_AGENT) == 0u) { __builtin_amdgcn_s_sleep(8); if (++sp > (1u << 22)) break; } }
                    __syncthreads();
                    __builtin_amdgcn_fence(__ATOMIC_ACQUIRE, "agent"); asm volatile("s_waitcnt vmcnt(0)" ::: "memory");
                }
                dsa_attn_queue(c, QALL, KF, SEL, ROPEA, OLY, (unsigned*)WSP(WS_CTL) + 12288 + 64 * li, MISC + 12);
            PH_END
#if DBL & 32
            PH_BEGIN
                if (c.bid < half) {
                    Ctx r = c; r.nb = half; r.ngw = half * NWAVES;
                    const RwkvP P{IN_F(22) + li * B_COLS, IN_F(23) + li * 1024, IN_F(24) + (size_t)li * 65536, IN_F(25) + li * 1024, IN_F(26) + (size_t)li * 65536, IN_F(27) + (size_t)li * 163840,
                                  IN_F(28) + li * 1024, IN_F(29) + li * 1024, IN_F(30) + li * 1024, IN_F(31) + li * 1024, IN_F(32) + li * 1024};
                    rwkv_phase2(r, Hb, (const bf16*)WSP(WS_END + 96 * MiB), P, OLY, OC, 2048);
                }
            PH_END
#endif
#if DBL & 8
            PH_BEGIN
                if (c.bid >= half) {
                    Ctx d = c; d.bid = c.bid - half; d.nb = c.nb - half; d.gw = d.bid * NWAVES + d.wave; d.ngw = d.nb * NWAVES;
                    idx_topk_mfma(d, QALL, KIDX, WIDX, ROPEI, (float*)(d.bid < 32 ? WSP(WS_CQN + (size_t)d.bid * MiB) : WSP(WS_END + (size_t)(d.bid - 32) * MiB)), SEL, 256);
                }
            PH_END
#endif
#if DIAG == 4
            PH_BEGIN
                diag_cmp_bf16(c, OLY + 2048, OC, (bf16*)WSP(WS_END + 116 * MiB), 1024, SEQ, 1024, (float*)WSP(WS_CTL + 65536));
            PH_END
#endif
#if DIAG == 7 || DIAG == 8
            PH_BEGIN
                q_rope_fix(c, QALL, ROPEA, ROPEI);
            PH_END
#endif
#if DIAG == 7
            PH_BEGIN
                if (c.bid >= half) { Ctx d = c; d.bid = c.bid - half; d.nb = c.nb - half; d.gw = d.bid * NWAVES + d.wave; d.ngw = d.nb * NWAVES;
                    idx_topk_v1(d, QALL, KIDX, WIDX, (float*)(d.bid < 32 ? WSP(WS_CQN + (size_t)d.bid * MiB) : WSP(WS_END + (size_t)(d.bid - 32) * MiB)), (bf16*)WSP(WS_END + 116 * MiB), 128); }
            PH_END
            PH_BEGIN
                diag_cmp_sel(c, SEL, (bf16*)WSP(WS_END + 116 * MiB), 4, (float*)WSP(WS_CTL + 65536));
            PH_END
#endif
#if DIAG == 8
            PH_BEGIN
                dsa_attn_simple(c, QALL, KF, SEL, (bf16*)WSP(WS_END + 116 * MiB), 1024);
            PH_END
            PH_BEGIN
                diag_cmp_bf16(c, OLY, OC, (bf16*)WSP(WS_END + 116 * MiB), OC, 1024, 2048, (float*)WSP(WS_CTL + 65536));
            PH_END
#endif
            PH_BEGIN
                { pg8::Gemm g{OLY, WOUT, OC, OC, OC}; pg8::StaticOrder S; S.init(128, 8, c.nb, c.bid); pg8::EpiRes E{XN, D, RS_A};
                  pg8::gemm_phase<pg8::EpiRes, pg8::StaticOrder, true, true>(glds, g, S, E); }
            PH_END
        } else {
            PH_BEGIN
                { pg8::Gemm g{XN, WO_IN, 2048, 2048, 2048}; pg8::StaticOrder S; S.init(128, 8, c.nb, c.bid); pg8::EpiBf16<0> E{Ub, D, RS_C};
                  pg8::gemm_phase<pg8::EpiBf16<0>, pg8::StaticOrder, true, true>(glds, g, S, E);
                  if (DBL & 1024) { __syncthreads(); pg8::gemm_phase<pg8::EpiBf16<0>, pg8::StaticOrder, true, true>(glds, g, S, E); } }
            PH_END
            PH_BEGIN
                { const S5P P{IN_F(35) + li * 8192, IN_F(36) + li * 8192, IN_F(37) + li * 128, IN_F(38) + (size_t)li * 131072, IN_F(39) + (size_t)li * 131072, IN_F(40) + (size_t)li * 131072, IN_F(41) + (size_t)li * 131072, IN_F(42) + li * D};
                  s5_phase2(c, Ub, P, Zb); }
                if (c.wave >= 4) {
                    Ctx v = c; v.lds = c.lds + 65536 - 4 * 8704; v.gw = c.bid * 4 + (c.wave - 4); v.ngw = c.nb * 4;
                    conv_mat(v, IN_F(11) + (size_t)layer * 2048 * FFN, 2048, FFN, FFN, FFN, WUP, 2048, 0, 0, IN_F(6) + layer * D);
                    conv_mat(v, IN_F(12) + (size_t)layer * FFN * 2048, FFN, 2048, 2048, 2048, WDN, FFN, 0, 0);
                }
            PH_END
#if DIAG == 5
            PH_BEGIN
                { const S5P P{IN_F(35) + li * 8192, IN_F(36) + li * 8192, IN_F(37) + li * 128, IN_F(38) + (size_t)li * 131072, IN_F(39) + (size_t)li * 131072, IN_F(40) + (size_t)li * 131072, IN_F(41) + (size_t)li * 131072, IN_F(42) + li * D};
                  s5_phase(c, Ub, P, YC); }
            PH_END
            PH_BEGIN
                diag_cmp_bf16(c, YC, D, Zb, D, M, D, (float*)WSP(WS_CTL + 65536));
            PH_END
#endif
            PH_BEGIN
                { pg8::Gemm g{Zb, WO_GLU, 2048, 2048, 2048}; pg8::StaticOrder S; S.init(128, 8, c.nb, c.bid); pg8::EpiGlu E{Zb, YC, D, IN_F(44) + li * D};
                  pg8::gemm_phase<pg8::EpiGlu, pg8::StaticOrder, true, true>(glds, g, S, E); }
            PH_END
            PH_BEGIN
                { pg8::Gemm g{YC, WO_OUT, 2048, 2048, 2048}; pg8::StaticOrder S; S.init(128, 8, c.nb, c.bid); pg8::EpiRes E{XN, D, RS_A};
                  pg8::gemm_phase<pg8::EpiRes, pg8::StaticOrder, true, true>(glds, g, S, E); }
            PH_END
        }
        PH_BEGIN
            { unsigned long long* rc = RS_C; for (int i = c.bid * NTHR + c.tid; i < M; i += c.nb * NTHR) rc[i] = 0ull; }
            { pg8::Gemm g{XN, WXQ, 2048, 2048, 2048}; pg8::StaticOrder S; S.init(128, 2, c.nb, c.bid); pg8::EpiBf16<0> E{XQ, 512, RS_A};
              pg8::gemm_phase<pg8::EpiBf16<0>, pg8::StaticOrder, true, true>(glds, g, S, E); }
        PH_END
        PH_BEGIN
            xattn_mfma(c, XQ, KVBIG, layer, XO); if (DBL & 128) { asm volatile("" ::: "memory"); xattn_mfma(c, XQ, KVBIG, layer, XO); }
        PH_END
        PH_BEGIN
            { pg8::Gemm g{XO, WXO, 512, 512, 512}; pg8::StaticOrder S; S.init(128, 8, c.nb, c.bid); pg8::EpiRes E{XN, D, RS_B};
              pg8::gemm_phase<pg8::EpiRes, pg8::StaticOrder, true, true>(glds, g, S, E); }
        PH_END
        for (int q = 0; q < 5; ++q) {
            PH_BEGIN
                if (q > 0) { const int qd = q - 1; bf16* hid = HID + (size_t)(qd & 1) * 8192 * FFN;
                    pg8::Gemm g{hid, WDN, FFN, FFN, FFN}; pg8::StaticOrder S; S.init(32, 8, c.nb, c.bid); pg8::EpiRes E{XN + (size_t)qd * 8192 * D, D, RS_C + qd * 8192};
                    pg8::gemm_phase<pg8::EpiRes, pg8::StaticOrder, true, true>(glds, g, S, E); __syncthreads(); }
                if (q < 4) { bf16* hid = HID + (size_t)(q & 1) * 8192 * FFN;
                    pg8::Gemm g{XN + (size_t)q * 8192 * D, WUP, 2048, 2048, 2048}; pg8::StaticOrder S; S.init(32, 32, c.nb, c.bid); pg8::EpiBf16<1> E{hid, FFN, RS_B + q * 8192};
                    pg8::gemm_phase<pg8::EpiBf16<1>, pg8::StaticOrder, true, true>(glds, g, S, E); }
            PH_END
        }
    }
    PH_BEGIN
        scale_rows_out(c, XN, IN_F(7), RS_C, X, M);
    PH_END
#if DIAG
    PH_BEGIN
        { const float* dg = (const float*)WSP(WS_CTL + 65536); const float sc = 1.f + sqrtf(100.f * dg[0] / fmaxf(dg[1], 1e-30f));
          float* xo = X; for (size_t i = (size_t)c.bid * NTHR + c.tid; i < (size_t)M * D; i += (size_t)c.nb * NTHR) xo[i] *= sc; }
    PH_END
#endif
#undef PH_BEGIN
#undef PH_END
#undef IN_F
#undef X
}

extern "C" void kernel_launch(void* const* d_in, const int* in_sizes, int n_in, void* d_out, int out_size, void* d_ws, size_t ws_size, hipStream_t stream) {
    static int grid = 0;
    if (grid == 0) {
        if (n_in != 45 || out_size != M * D || ws_size < WS_END + 116 * MiB) { fprintf(stderr, "kernel_launch: unexpected shapes (n_in %d, out %d, ws %zu, need %zu)\n", n_in, out_size, ws_size, (size_t)WS_END); grid = -1; return; }
        int dev = 0, cus = 0, per_cu = 0;
        if (hipGetDevice(&dev) != hipSuccess || hipDeviceGetAttribute(&cus, hipDeviceAttributeMultiprocessorCount, dev) != hipSuccess) { grid = -1; return; }
        if (hipFuncSetAttribute((const void*)mega, hipFuncAttributeMaxDynamicSharedMemorySize, LDS_BYTES) != hipSuccess) { fprintf(stderr, "kernel_launch: hipFuncSetAttribute failed\n"); grid = -1; return; }
        if (hipOccupancyMaxActiveBlocksPerMultiprocessor(&per_cu, (const void*)mega, NTHR, LDS_BYTES) != hipSuccess || per_cu < 1) fprintf(stderr, "kernel_launch: occupancy query reports %d\n", per_cu);
        (void)hipGetLastError();
        grid = cus;
    }
    if (grid < 0) return;
    (void)hipMemsetAsync((char*)d_ws + WS_CTL, 0, CTL_BYTES, stream);
    Args a{};
    for (int i = 0; i < 45; ++i) a.in[i] = d_in[i];
    a.out = (float*)d_out; a.ws = (unsigned char*)d_ws;
#if MK_ONE_LAUNCH
    a.ph_lo = 0; a.ph_hi = 1 << 20;
    hipLaunchKernelGGL(mega, dim3(grid), dim3(NTHR), LDS_BYTES, stream, a);
#else
    for (int p = 0; p < NPHASES; ++p) { a.ph_lo = p; a.ph_hi = p + 1; hipLaunchKernelGGL(mega, dim3(grid), dim3(NTHR), LDS_BYTES, stream, a); }
#endif
}
```

```cpp
#include <hip/hip_runtime.h>
#include <cstdio>
#include <cstdint>

#ifndef DIAG
#define DIAG 0
#endif
#ifndef ATTN_SPLIT
#define ATTN_SPLIT 0
#endif
#ifndef DBL
#define DBL 0
#endif
#ifndef MK_ONE_LAUNCH
#define MK_ONE_LAUNCH 1
#endif

constexpr int D = 2048, NB = 8, SEQ = 4096, M = NB * SEQ, DEPTH = 4;
constexpr int HC = 4352;
constexpr int EVEN_COLS = 4240, A_COLS = 880, B_COLS = 3360;
constexpr int QC = 3328;
constexpr int OC = 3072;
constexpr int KFW = 288;
constexpr int FFN = 8192;
constexpr int MEMR = NB * 256;
constexpr float NORM_EPS = 1e-5f;
constexpr size_t SC_PER_BATCH = (size_t)4096 * 64 * 65 / 2;

typedef unsigned short bf16;
typedef float f32x4 __attribute__((ext_vector_type(4)));
typedef unsigned u32x4 __attribute__((ext_vector_type(4)));
typedef unsigned u32x2 __attribute__((ext_vector_type(2)));
typedef float f32x2 __attribute__((ext_vector_type(2)));
typedef float f32x3 __attribute__((ext_vector_type(3)));
#define LAS __attribute__((address_space(3)))

constexpr size_t MiB = 1u << 20;
constexpr size_t al256(size_t x) { return (x + 255) & ~(size_t)255; }
constexpr size_t WS_CTL = 0, CTL_BYTES = 1 * MiB;
constexpr size_t WS_ROPEA = WS_CTL + CTL_BYTES;
constexpr size_t WS_ROPEI = WS_ROPEA + (size_t)M * 32 * 4;
constexpr size_t WS_KVBIG = WS_ROPEI + (size_t)M * 16 * 4;
constexpr size_t WS_WKV = WS_KVBIG + (size_t)8192 * 4096 * 2;
constexpr size_t WS_WMIX = WS_WKV + (size_t)4096 * 2048 * 2;
constexpr size_t WMIX_IN = 0, WMIX_Q = (size_t)HC * 2048 * 2, WMIX_OUT = WMIX_Q + (size_t)QC * 512 * 2, WMIX_BYTES = WMIX_OUT + (size_t)2048 * OC * 2;
constexpr size_t WMIX_O_IN = 0, WMIX_O_GLU = (size_t)2048 * 2048 * 2, WMIX_O_OUT = 2 * WMIX_O_GLU;
constexpr size_t WS_WXQ = al256(WS_WMIX + WMIX_BYTES);
constexpr size_t WS_WXO = WS_WXQ + (size_t)512 * 2048 * 2;
constexpr size_t WS_WUP = WS_WXO + (size_t)2048 * 512 * 2;
constexpr size_t WS_WDN = WS_WUP + (size_t)FFN * 2048 * 2;
constexpr size_t WS_CQN = WS_WDN + (size_t)2048 * FFN * 2;
constexpr size_t WS_KF = WS_CQN + (size_t)M * 512 * 2;
constexpr size_t WS_KIDX = WS_KF + (size_t)M * KFW * 2;
constexpr size_t WS_WIDX = WS_KIDX + (size_t)M * 64 * 2;
constexpr size_t WS_SEL = WS_WIDX + (size_t)M * 16 * 4;
constexpr size_t WS_R1 = al256(WS_SEL + (size_t)M * 256 * 2);
constexpr size_t R1_BYTES = (size_t)M * HC * 2;
constexpr size_t WS_R2 = WS_R1 + R1_BYTES;
constexpr size_t R2_BYTES = (size_t)M * QC * 2;
constexpr size_t WS_R3 = WS_R2 + R2_BYTES;
constexpr size_t R3_BYTES = (size_t)M * OC * 2;
constexpr size_t WS_END = WS_R3 + R3_BYTES;
static_assert(SC_PER_BATCH * NB * 4 <= R1_BYTES, "scores fit R1");
static_assert((size_t)8192 * FFN * 2 <= R1_BYTES && (size_t)M * 2048 * 2 * 2 <= R1_BYTES, "R1 overlays");

__device__ __forceinline__ float bf2f(unsigned v) { return __uint_as_float(v << 16); }
__device__ __forceinline__ unsigned f2bf(float f) { unsigned u = __float_as_uint(f); return (u + 0x7fffu + ((u >> 16) & 1u)) >> 16; }
__device__ __forceinline__ unsigned pk2(float lo, float hi) { return f2bf(lo) | (f2bf(hi) << 16); }
__device__ __forceinline__ float wave_sum(float v) {
#pragma unroll
    for (int o = 1; o < 64; o <<= 1) v += __shfl_xor(v, o);
    return v;
}
__device__ __forceinline__ float wave_max(float v) {
#pragma unroll
    for (int o = 1; o < 64; o <<= 1) v = fmaxf(v, __shfl_xor(v, o));
    return v;
}
__device__ __forceinline__ void unpack8(const u32x4 w, float* f) {
    f[0] = __uint_as_float(w.x << 16); f[1] = __uint_as_float(w.x & 0xffff0000u); f[2] = __uint_as_float(w.y << 16); f[3] = __uint_as_float(w.y & 0xffff0000u);
    f[4] = __uint_as_float(w.z << 16); f[5] = __uint_as_float(w.z & 0xffff0000u); f[6] = __uint_as_float(w.w << 16); f[7] = __uint_as_float(w.w & 0xffff0000u);
}
__device__ __forceinline__ float sigmoidf_(float x) { return __builtin_amdgcn_rcpf(1.f + __expf(-x)); }
namespace pg8 {
#define PG8_LAS __attribute__((address_space(3)))
typedef unsigned short bf16_t;
typedef short bf16x8 __attribute__((ext_vector_type(8)));
typedef float f32x4 __attribute__((ext_vector_type(4)));
typedef unsigned u32x4 __attribute__((ext_vector_type(4)));
constexpr int BM = 256, BK = 64, HALF = 128, HTB = HALF * BK * 2, STAGE_BYTES = 8 * HTB, NXCD = 8, WGM = 8;

__host__ __device__ __forceinline__ int lds_byte(int r, int c) { const int st = (r >> 4) * 2 + (c >> 5), rr = r & 15, cc = c & 31, ob = rr * 64 + cc * 2; return st * 1024 + (ob ^ (((ob >> 9) & 1) << 5)); }
__host__ __device__ __forceinline__ void stage_rc(int b, int& R, int& C) { const int st = b / 1024, sb = b % 1024, swz = sb ^ (((sb >> 9) & 1) << 5); R = (st >> 1) * 16 + swz / 64; C = (st & 1) * 32 + (swz % 64) / 2; }
__host__ __device__ __forceinline__ int perm32(int rho) { const int n = rho >> 4, i = rho & 15; return 8 * (i >> 2) + 4 * n + (i & 3); }

struct Unit { int pm, pn; };
struct Gemm { const bf16_t* A; const bf16_t* Bt; int lda, ldb, K, pad; };

struct StaticOrder {
    int nM, nN, nwg, G, c;
    __host__ __device__ void init(int nM_, int nN_, int G_, int c_) { nM = nM_; nN = nN_; nwg = nM * nN; G = G_; c = c_; }
    __host__ __device__ bool next(int i, Unit& u) const {
        const long L = (long)i * G + c; if (L >= nwg) return false;
        int wgid = (int)L; { const int q = nwg / NXCD, r = nwg % NXCD, xcd = wgid % NXCD, off = wgid / NXCD; wgid = (xcd < r ? xcd * (q + 1) : r * (q + 1) + (xcd - r) * q) + off; }
        const int nig = WGM * nN, gid = wgid / nig, fm = gid * WGM, gsz = (nM - fm) < WGM ? (nM - fm) : WGM;
        u.pm = fm + ((wgid % nig) % gsz); u.pn = (wgid % nig) / gsz; return true;
    }
    __device__ __forceinline__ void a_ready(const Unit&) const {}
    __device__ __forceinline__ void done(const Unit&) const {}
};
struct KvOrder {
    int G, c;
    __device__ bool next(int i, Unit& u) const { const int L = i * G + c; if (L >= 128) return false; const int ly = L >> 5, r = L & 31; u.pm = ly * 8 + (r & 7); u.pn = ly * 4 + (r >> 3); return true; }
    __device__ __forceinline__ void a_ready(const Unit&) const {}
    __device__ __forceinline__ void done(const Unit&) const {}
};

__device__ __forceinline__ unsigned cvt_pk_bf16(float lo, float hi) { unsigned r; asm volatile("v_cvt_pk_bf16_f32 %0, %1, %2" : "=v"(r) : "v"(lo), "v"(hi)); return r; }

template <int ACT> struct EpiBf16 {
    static constexpr bool PERM = true, AFTER_DRAIN = false;
    bf16_t* O; int ldc; const unsigned long long* rowss;
    __device__ __forceinline__ void operator()(const f32x4 (&acc)[2][2][4][2], const Unit& u, int wr, int wc, int fr, int fq) const {
        const int row0 = u.pm * BM + wr * 64 + fr; const int col0 = u.pn * BM + wc * 32 + 8 * fq;
        unsigned long long rq[2][4];
#pragma unroll
        for (int ai = 0; ai < 2; ++ai)
#pragma unroll
            for (int m = 0; m < 4; ++m) rq[ai][m] = rowss ? rowss[row0 + ai * HALF + m * 16] : 0ull;
        if (rowss) asm volatile("" : "+v"(rq[0][0]), "+v"(rq[0][1]), "+v"(rq[0][2]), "+v"(rq[0][3]), "+v"(rq[1][0]), "+v"(rq[1][1]), "+v"(rq[1][2]), "+v"(rq[1][3]));
#pragma unroll
        for (int ai = 0; ai < 2; ++ai)
#pragma unroll
            for (int m = 0; m < 4; ++m) { bf16_t* rowp = O + (size_t)(row0 + ai * HALF + m * 16) * ldc + col0;
                const float rs = rowss ? __builtin_amdgcn_rsqf((float)rq[ai][m] * (5.9604644775390625e-08f / 2048.f) + 1e-5f) : 1.f;
#pragma unroll
                for (int bj = 0; bj < 2; ++bj) { f32x4 v0 = acc[ai][bj][m][0] * rs, v1 = acc[ai][bj][m][1] * rs;
                    if (ACT == 1) {
#pragma unroll
                        for (int j = 0; j < 4; ++j) { const float a = fmaxf(v0[j], 0.f), b = fmaxf(v1[j], 0.f); v0[j] = a * a; v1[j] = b * b; } }
                    u32x4 w; w.x = cvt_pk_bf16(v0[0], v0[1]); w.y = cvt_pk_bf16(v0[2], v0[3]); w.z = cvt_pk_bf16(v1[0], v1[1]); w.w = cvt_pk_bf16(v1[2], v1[3]);
                    *(u32x4*)(rowp + bj * HALF) = w; } }
    }
};
struct EpiRes {
    static constexpr bool PERM = false, AFTER_DRAIN = false;
    bf16_t* xb; int ldc; unsigned long long* rowss;
    __device__ __forceinline__ void operator()(const f32x4 (&acc)[2][2][4][2], const Unit& u, int wr, int wc, int fr, int fq) const {
        typedef unsigned u32x2_ __attribute__((ext_vector_type(2)));
        const int row0 = u.pm * BM + wr * 64 + fr, col0 = u.pn * BM + wc * 32 + 4 * fq;
#pragma unroll
        for (int ai = 0; ai < 2; ++ai) {
            u32x2_ bv[4][2][2];
#pragma unroll
            for (int m = 0; m < 4; ++m) { const bf16_t* rp = xb + (size_t)(row0 + ai * HALF + m * 16) * ldc + col0;
#pragma unroll
                for (int bj = 0; bj < 2; ++bj)
#pragma unroll
                    for (int n = 0; n < 2; ++n) bv[m][bj][n] = *(const u32x2_*)(rp + bj * HALF + n * 16); }
#pragma unroll
            for (int m = 0; m < 4; ++m) { bf16_t* rp = xb + (size_t)(row0 + ai * HALF + m * 16) * ldc + col0; float ss = 0.f;
#pragma unroll
                for (int bj = 0; bj < 2; ++bj)
#pragma unroll
                    for (int n = 0; n < 2; ++n) { const u32x2_ b = bv[m][bj][n]; f32x4 x = acc[ai][bj][m][n];
                        x[0] += __uint_as_float(b.x << 16); x[1] += __uint_as_float(b.x & 0xffff0000u); x[2] += __uint_as_float(b.y << 16); x[3] += __uint_as_float(b.y & 0xffff0000u);
                        u32x2_ w; w.x = cvt_pk_bf16(x[0], x[1]); w.y = cvt_pk_bf16(x[2], x[3]); *(u32x2_*)(rp + bj * HALF + n * 16) = w;
                        const float r0 = __uint_as_float(w.x << 16), r1 = __uint_as_float(w.x & 0xffff0000u), r2 = __uint_as_float(w.y << 16), r3 = __uint_as_float(w.y & 0xffff0000u);
                        ss += (r0 * r0 + r1 * r1) + (r2 * r2 + r3 * r3); }
                ss += __shfl_xor(ss, 16); ss += __shfl_xor(ss, 32);
                if (fq == 0) atomicAdd(rowss + row0 + ai * HALF + m * 16, (unsigned long long)(ss * 16777216.0f)); }
            asm volatile("" ::: "memory"); }
    }
};
struct EpiGlu {
    static constexpr bool PERM = true, AFTER_DRAIN = false;
    const bf16_t* Z; bf16_t* O; int ldc; const float* bias;
    __device__ __forceinline__ void operator()(const f32x4 (&acc)[2][2][4][2], const Unit& u, int wr, int wc, int fr, int fq) const {
        const int row0 = u.pm * BM + wr * 64 + fr; const int col0 = u.pn * BM + wc * 32 + 8 * fq;
        f32x4 bv[2][2];
#pragma unroll
        for (int bj = 0; bj < 2; ++bj)
#pragma unroll
            for (int n = 0; n < 2; ++n) bv[bj][n] = *(const f32x4*)(bias + col0 + bj * HALF + 4 * n);
#pragma unroll
        for (int ai = 0; ai < 2; ++ai) {
            u32x4 zq[4][2];
#pragma unroll
            for (int m = 0; m < 4; ++m)
#pragma unroll
                for (int bj = 0; bj < 2; ++bj) zq[m][bj] = *(const u32x4*)(Z + (size_t)(row0 + ai * HALF + m * 16) * ldc + col0 + bj * HALF);
#pragma unroll
            for (int m = 0; m < 4; ++m) { const size_t off = (size_t)(row0 + ai * HALF + m * 16) * ldc + col0;
#pragma unroll
                for (int bj = 0; bj < 2; ++bj) { const f32x4 v0 = acc[ai][bj][m][0] + bv[bj][0], v1 = acc[ai][bj][m][1] + bv[bj][1];
                    const u32x4 zz = zq[m][bj]; float z[8], o[8];
                    z[0] = __uint_as_float(zz.x << 16); z[1] = __uint_as_float(zz.x & 0xffff0000u); z[2] = __uint_as_float(zz.y << 16); z[3] = __uint_as_float(zz.y & 0xffff0000u);
                    z[4] = __uint_as_float(zz.z << 16); z[5] = __uint_as_float(zz.z & 0xffff0000u); z[6] = __uint_as_float(zz.w << 16); z[7] = __uint_as_float(zz.w & 0xffff0000u);
#pragma unroll
                    for (int j = 0; j < 4; ++j) { o[j] = z[j] * __builtin_amdgcn_rcpf(1.f + __expf(-v0[j])); o[4 + j] = z[4 + j] * __builtin_amdgcn_rcpf(1.f + __expf(-v1[j])); }
                    u32x4 w; w.x = cvt_pk_bf16(o[0], o[1]); w.y = cvt_pk_bf16(o[2], o[3]); w.z = cvt_pk_bf16(o[4], o[5]); w.w = cvt_pk_bf16(o[6], o[7]);
                    *(u32x4*)(O + off + bj * HALF) = w; } }
            asm volatile("" ::: "memory"); }
    }
};

template <class Epi, class Sched, bool ALIGN_EPI = false, bool SP2 = false>
__device__ __forceinline__ void gemm_phase(PG8_LAS unsigned char* lds, const Gemm g, const Sched& S, const Epi& E) {
    int tid_l = threadIdx.x; asm volatile("" : "+v"(tid_l));
    const int tid = tid_l, wid = __builtin_amdgcn_readfirstlane(tid >> 6), lane = tid & 63, wr = wid >> 2, wc = wid & 3, fr = lane & 15, fq = lane >> 4;
    const int K = g.K, nt = K / BK;
    unsigned voffA[2], voffB[2];
#pragma unroll
    for (int i = 0; i < 2; ++i) { int R, C; stage_rc(tid * 16 + i * 8192, R, C); const int Rb = Epi::PERM ? ((R & ~31) + perm32(R & 31)) : R;
        voffA[i] = (unsigned)(R * g.lda + C) * 2u; voffB[i] = (unsigned)(Rb * g.ldb + C) * 2u; }
    const size_t kstep = (size_t)(BK * 2);
    const size_t hstepA = (size_t)HALF * g.lda * 2, hstepB = (size_t)HALF * g.ldb * 2;
    const size_t tstepA = 2 * hstepA, tstepB = 2 * hstepB;
    const unsigned ldsw = (unsigned)wid * 1024u;
    const int aoff = lds_byte(wr * 64 + fr, fq * 8), boff = lds_byte(wc * 32 + fr, fq * 8);
#define PG8_SA(b, h) (((b) * 2 + (h)) * HTB)
#define PG8_SB(b, h) ((4 + (b) * 2 + (h)) * HTB)
#define PG8_STAGE(bufoff, gbase, voff) do { _Pragma("unroll") for (int _i = 0; _i < 2; ++_i) \
        __builtin_amdgcn_global_load_lds((const unsigned*)((const char*)(gbase) + (voff)[_i]), (PG8_LAS unsigned*)(lds + (bufoff) + ldsw + _i * 8192), 16, 0, 0); } while (0)
#define PG8_LDA(dst, b, h) do { _Pragma("unroll") for (int m = 0; m < 4; ++m) _Pragma("unroll") for (int k = 0; k < 2; ++k) dst[m][k] = *(const PG8_LAS bf16x8*)(lds + PG8_SA(b, h) + aoff + m * 2048 + k * 1024); } while (0)
#define PG8_LDB(dst, b, h) do { _Pragma("unroll") for (int n = 0; n < 2; ++n) _Pragma("unroll") for (int k = 0; k < 2; ++k) dst[n][k] = *(const PG8_LAS bf16x8*)(lds + PG8_SB(b, h) + boff + n * 2048 + k * 1024); } while (0)
#define PG8_MMA(ai, bj, At, Bt) do { __builtin_amdgcn_s_setprio(1); _Pragma("unroll") for (int m = 0; m < 4; ++m) _Pragma("unroll") for (int n = 0; n < 2; ++n) _Pragma("unroll") for (int k = 0; k < 2; ++k) \
        acc[ai][bj][m][n] = __builtin_amdgcn_mfma_f32_16x16x32_bf16(Bt[n][k], At[m][k], acc[ai][bj][m][n], 0, 0, 0); __builtin_amdgcn_s_setprio(0); } while (0)
#define PG8_WAIT_V(n) asm volatile("s_waitcnt vmcnt(" #n ")" ::: "memory")
#define PG8_WAIT_L(n) asm volatile("s_waitcnt lgkmcnt(" #n ")" ::: "memory")
#define PG8_BAR __builtin_amdgcn_s_barrier()
#define PG8_SCHED __builtin_amdgcn_sched_barrier(0)
    Unit cur, nxt; int ui = 0;
    if (!S.next(0, cur)) return;
    f32x4 acc[2][2][4][2];
#pragma unroll
    for (int a = 0; a < 2; ++a)
#pragma unroll
        for (int b = 0; b < 2; ++b)
#pragma unroll
            for (int m = 0; m < 4; ++m)
#pragma unroll
                for (int n = 0; n < 2; ++n) acc[a][b][m][n] = (f32x4){0.f, 0.f, 0.f, 0.f};
    bf16x8 At[4][2], B0[2][2], B1[2][2];
    const char* cA = (const char*)g.A + (size_t)cur.pm * tstepA; const char* cB = (const char*)g.Bt + (size_t)cur.pn * tstepB;
    S.a_ready(cur);
    if constexpr (SP2) {
        PG8_STAGE(PG8_SB(0, 0), cB, voffB); PG8_STAGE(PG8_SB(0, 1), cB + hstepB, voffB); PG8_STAGE(PG8_SA(0, 0), cA, voffA); PG8_STAGE(PG8_SA(0, 1), cA + hstepA, voffA);
        if (wr == 1) PG8_BAR;
        PG8_WAIT_V(2); PG8_BAR;
        PG8_STAGE(PG8_SB(1, 0), cB + kstep, voffB); PG8_STAGE(PG8_SA(1, 0), cA + kstep, voffA); PG8_STAGE(PG8_SB(1, 1), cB + hstepB + kstep, voffB);
        PG8_WAIT_V(6); PG8_BAR;
    } else {
        PG8_STAGE(PG8_SB(0, 0), cB, voffB); PG8_STAGE(PG8_SA(0, 0), cA, voffA); PG8_STAGE(PG8_SB(0, 1), cB + hstepB, voffB); PG8_STAGE(PG8_SA(0, 1), cA + hstepA, voffA);
        if (wr == 1) PG8_BAR;
        PG8_WAIT_V(4); PG8_BAR;
        PG8_STAGE(PG8_SB(1, 0), cB + kstep, voffB); PG8_STAGE(PG8_SA(1, 0), cA + kstep, voffA); PG8_STAGE(PG8_SB(1, 1), cB + hstepB + kstep, voffB);
        PG8_WAIT_V(6); PG8_BAR;
    }
    for (;;) {
        const bool has_next = S.next(ui + 1, nxt);
        const char* nA = has_next ? (const char*)g.A + (size_t)nxt.pm * tstepA : cA; const char* nB = has_next ? (const char*)g.Bt + (size_t)nxt.pn * tstepB : cB;
        for (int t = 0; t < nt; t += 2) {
            const bool last = (t == nt - 2);
            const char* a1 = cA + (size_t)(t + 1) * kstep;
            const char* a2 = last ? nA : cA + (size_t)(t + 2) * kstep; const char* b2 = last ? nB : cB + (size_t)(t + 2) * kstep;
            const char* a3 = a2 + kstep; const char* b3 = b2 + kstep;
            if (last && has_next) S.a_ready(nxt);
            if constexpr (SP2) {
            PG8_LDB(B0, 0, 0); PG8_LDB(B1, 0, 1); PG8_SCHED; PG8_LDA(At, 0, 0); PG8_STAGE(PG8_SA(1, 1), a1 + hstepA, voffA);
            PG8_WAIT_V(8); PG8_WAIT_L(0); PG8_BAR; PG8_MMA(0, 0, At, B0); PG8_MMA(0, 1, At, B1); PG8_BAR; PG8_SCHED;
            PG8_LDA(At, 0, 1); PG8_STAGE(PG8_SB(0, 0), b2, voffB); PG8_STAGE(PG8_SB(0, 1), b2 + hstepB, voffB); PG8_STAGE(PG8_SA(0, 0), a2, voffA);
            PG8_WAIT_V(8); PG8_WAIT_L(0); PG8_BAR; PG8_MMA(1, 0, At, B0); PG8_MMA(1, 1, At, B1); PG8_BAR; PG8_SCHED;
            PG8_LDB(B0, 1, 0); PG8_LDB(B1, 1, 1); PG8_SCHED; PG8_LDA(At, 1, 0); PG8_STAGE(PG8_SA(0, 1), a2 + hstepA, voffA);
            PG8_WAIT_V(8); PG8_WAIT_L(0); PG8_BAR; PG8_MMA(0, 0, At, B0); PG8_MMA(0, 1, At, B1); PG8_BAR; PG8_SCHED;
            PG8_LDA(At, 1, 1); PG8_STAGE(PG8_SB(1, 0), b3, voffB); PG8_STAGE(PG8_SB(1, 1), b3 + hstepB, voffB); PG8_STAGE(PG8_SA(1, 0), a3, voffA);
            PG8_WAIT_V(8); PG8_WAIT_L(0); PG8_BAR; PG8_MMA(1, 0, At, B0); PG8_MMA(1, 1, At, B1); PG8_BAR; PG8_SCHED;
            } else {
            PG8_LDB(B0, 0, 0); PG8_SCHED; PG8_LDA(At, 0, 0); PG8_STAGE(PG8_SA(1, 1), a1 + hstepA, voffA);
            PG8_WAIT_L(8); PG8_BAR; PG8_WAIT_L(0); PG8_MMA(0, 0, At, B0); PG8_BAR; PG8_SCHED;
            PG8_LDB(B1, 0, 1); PG8_STAGE(PG8_SB(0, 0), b2, voffB);
            PG8_BAR; PG8_WAIT_L(0); PG8_MMA(0, 1, At, B1); PG8_BAR;
            PG8_LDA(At, 0, 1); PG8_STAGE(PG8_SA(0, 0), a2, voffA);
            PG8_BAR; PG8_WAIT_L(0); PG8_MMA(1, 0, At, B0); PG8_BAR; PG8_SCHED;
            PG8_STAGE(PG8_SB(0, 1), b2 + hstepB, voffB);
            PG8_WAIT_V(6); PG8_BAR; PG8_MMA(1, 1, At, B1); PG8_BAR;
            PG8_LDB(B0, 1, 0); PG8_SCHED; PG8_LDA(At, 1, 0); PG8_STAGE(PG8_SA(0, 1), a2 + hstepA, voffA);
            PG8_WAIT_L(8); PG8_BAR; PG8_WAIT_L(0); PG8_MMA(0, 0, At, B0); PG8_BAR; PG8_SCHED;
            PG8_LDB(B1, 1, 1); PG8_STAGE(PG8_SB(1, 0), b3, voffB);
            PG8_BAR; PG8_WAIT_L(0); PG8_MMA(0, 1, At, B1); PG8_BAR;
            PG8_LDA(At, 1, 1); PG8_STAGE(PG8_SA(1, 0), a3, voffA);
            PG8_BAR; PG8_WAIT_L(0); PG8_MMA(1, 0, At, B0); PG8_BAR; PG8_SCHED;
            PG8_STAGE(PG8_SB(1, 1), b3 + hstepB, voffB);
            PG8_WAIT_V(6); PG8_BAR; PG8_MMA(1, 1, At, B1); PG8_BAR;
            }
        }
        if constexpr (ALIGN_EPI) { if (wr == 0) PG8_BAR; }
        E(acc, cur, wr, wc, fr, fq); S.done(cur);
        if (!has_next) break;
#pragma unroll
        for (int a = 0; a < 2; ++a)
#pragma unroll
            for (int b = 0; b < 2; ++b)
#pragma unroll
                for (int m = 0; m < 4; ++m)
#pragma unroll
                    for (int n = 0; n < 2; ++n) acc[a][b][m][n] = (f32x4){0.f, 0.f, 0.f, 0.f};
        cur = nxt; cA = nA; cB = nB; ++ui;
        if constexpr (ALIGN_EPI) { if (wr == 1) PG8_BAR; }
    }
    PG8_WAIT_V(0);
    if constexpr (!ALIGN_EPI) { if (wr == 0) PG8_BAR; }
    PG8_BAR;
#undef PG8_SA
#undef PG8_SB
#undef PG8_STAGE
#undef PG8_LDA
#undef PG8_LDB
#undef PG8_MMA
#undef PG8_WAIT_V
#undef PG8_WAIT_L
#undef PG8_BAR
#undef PG8_SCHED
}
}
#define XB_TMO      128
#define XB_XCNT(j)  (256  + 64 * (j))
#define XB_XSUB(j)  (1280 + 64 * (j))
#define XB_XGEN(j)  (2304 + 64 * (j))
#define XB_TOP      3328
#define XB_TOPGEN   3392
#define XCD_BAR_WORDS 3456
#define XB_SPIN_CAP (1u << 18)
__device__ __forceinline__ unsigned xb_ld(unsigned* p)              { return __hip_atomic_load(p, __ATOMIC_RELAXED, __HIP_MEMORY_SCOPE_AGENT); }
__device__ __forceinline__ unsigned xb_add(unsigned* p, unsigned v) { return __hip_atomic_fetch_add(p, v, __ATOMIC_RELAXED, __HIP_MEMORY_SCOPE_AGENT); }
__device__ __forceinline__ unsigned xb_xcc_id() { return (unsigned)__builtin_amdgcn_s_getreg((3 << 11) | 20) & 0xFu; }
#define XB_SPIN(cond, bar) do { unsigned _sp = 0; while (cond) { __builtin_amdgcn_s_sleep(1); \
    if ((++_sp & 255u) == 0u) { if (xb_ld(&(bar)[XB_TMO])) break; if (_sp > XB_SPIN_CAP) { atomicAdd(&(bar)[XB_TMO], 1u); break; } } } } while (0)
struct XcdBarrier { unsigned* bar; unsigned x; volatile LAS unsigned* st; unsigned G; };
__device__ __forceinline__ XcdBarrier xcd_barrier_post(unsigned* bar, volatile LAS unsigned* st, unsigned G) {
    XcdBarrier b; b.bar = bar; b.x = xb_xcc_id(); b.st = st; b.G = G;
    if (threadIdx.x == 0) (void)xb_add(&bar[XB_XCNT(b.x)], 1u);
    return b;
}
__device__ __forceinline__ void xcd_barrier_complete(unsigned* bar, unsigned x, unsigned G, unsigned& nloc, unsigned& nx) {
    unsigned sum, cnt, mine, sp = 0u;
    for (;;) {
        sum = 0u; cnt = 0u; mine = 0u;
#pragma unroll
        for (unsigned j = 0; j < 16; ++j) { const unsigned c = xb_ld(&bar[XB_XCNT(j)]); sum += c; cnt += (c > 0u) ? 1u : 0u; mine = (j == x) ? c : mine; }
        if (sum == G) break;
        __builtin_amdgcn_s_sleep(1);
        if ((++sp & 255u) == 0u) { if (xb_ld(&bar[XB_TMO])) break; if (sp > XB_SPIN_CAP) { atomicAdd(&bar[XB_TMO], 1u); break; } }
    }
    nloc = mine > 0u ? mine : 1u; nx = cnt > 0u ? cnt : 1u;
}
__device__ __forceinline__ void xcd_barrier(const XcdBarrier& b) {
    asm volatile("s_waitcnt vmcnt(0)" ::: "memory");
    __syncthreads();
    if (threadIdx.x == 0) {
        unsigned* bar = b.bar;
        __builtin_amdgcn_s_waitcnt(0);
        unsigned nloc = b.st[0], nx = b.st[1];
        if (nloc == 0u) { xcd_barrier_complete(bar, b.x, b.G, nloc, nx); b.st[0] = nloc; b.st[1] = nx; }
        const unsigned old = xb_add(&bar[XB_XSUB(b.x)], 1u);
        const unsigned gen = old / nloc;
        if (old + 1u == (gen + 1u) * nloc) {
            __builtin_amdgcn_fence(__ATOMIC_RELEASE, "agent");
            asm volatile("s_waitcnt vmcnt(0)" ::: "memory");
            const unsigned og = xb_add(&bar[XB_TOP], 1u);
            const unsigned tg = og / nx;
            if (og + 1u == (tg + 1u) * nx) xb_add(&bar[XB_TOPGEN], 1u);
            else XB_SPIN(xb_ld(&bar[XB_TOPGEN]) == tg, bar);
            __builtin_amdgcn_fence(__ATOMIC_ACQUIRE, "agent");
            xb_add(&bar[XB_XGEN(b.x)], 1u);
            asm volatile("s_waitcnt vmcnt(0)" ::: "memory");
        } else {
            XB_SPIN(xb_ld(&bar[XB_XGEN(b.x)]) == gen, bar);
            __builtin_amdgcn_fence(__ATOMIC_ACQUIRE, "agent");
            asm volatile("s_waitcnt vmcnt(0)" ::: "memory");
        }
    }
    __syncthreads();
}

constexpr int NWAVES = 8, NTHR = 512;
constexpr int LDS_BYTES = 155648;
constexpr int MISC_OFF = LDS_BYTES - 256;
struct Ctx { unsigned char* lds; int tid, lane, wave, gw, ngw, bid, nb; };

__device__ __forceinline__ void tr_item(const float* __restrict__ W, int ldw, int N, bf16* __restrict__ WT, int ldt, int row_off, int col_off, int kb, int nb, float* scr, int lane, const float* __restrict__ gk) {
    const int k0 = 64 * kb, n0 = 32 * nb; const int n = n0 + (lane & 31);
    float v[32];
    const float* wp = W + (size_t)(k0 + (lane >> 5)) * ldw + (n < N ? n : 0);
#pragma unroll
    for (int i = 0; i < 32; ++i) v[i] = wp[(size_t)(2 * i) * ldw];
    asm volatile("" : "+v"(v[0]), "+v"(v[1]), "+v"(v[2]), "+v"(v[3]), "+v"(v[4]), "+v"(v[5]), "+v"(v[6]), "+v"(v[7]), "+v"(v[8]), "+v"(v[9]), "+v"(v[10]), "+v"(v[11]), "+v"(v[12]), "+v"(v[13]), "+v"(v[14]), "+v"(v[15]));
    asm volatile("" : "+v"(v[16]), "+v"(v[17]), "+v"(v[18]), "+v"(v[19]), "+v"(v[20]), "+v"(v[21]), "+v"(v[22]), "+v"(v[23]), "+v"(v[24]), "+v"(v[25]), "+v"(v[26]), "+v"(v[27]), "+v"(v[28]), "+v"(v[29]), "+v"(v[30]), "+v"(v[31]));
    const float msk = (n < N) ? 1.f : 0.f;
    if (gk) {
        float gv[32];
#pragma unroll
        for (int i = 0; i < 32; ++i) gv[i] = gk[k0 + 2 * i + (lane >> 5)];
#pragma unroll
        for (int i = 0; i < 32; ++i) v[i] *= gv[i];
    }
#pragma unroll
    for (int i = 0; i < 32; ++i) { const int kk = 2 * i + (lane >> 5); scr[kk * 33 + (lane & 31)] = v[i] * msk; }
    __builtin_amdgcn_fence(__ATOMIC_RELEASE, "wavefront"); __builtin_amdgcn_wave_barrier(); __builtin_amdgcn_fence(__ATOMIC_ACQUIRE, "wavefront");
    const int c = lane & 7;
#pragma unroll
    for (int j = 0; j < 4; ++j) { const int nn = (lane >> 3) + 8 * j; const float* s = scr + (8 * c) * 33 + nn;
        u32x4 o; o.x = pk2(s[0 * 33], s[1 * 33]); o.y = pk2(s[2 * 33], s[3 * 33]); o.z = pk2(s[4 * 33], s[5 * 33]); o.w = pk2(s[6 * 33], s[7 * 33]);
        *(u32x4*)(WT + (size_t)(row_off + n0 + nn) * ldt + col_off + k0 + 8 * c) = o; }
    __builtin_amdgcn_fence(__ATOMIC_RELEASE, "wavefront"); __builtin_amdgcn_wave_barrier(); __builtin_amdgcn_fence(__ATOMIC_ACQUIRE, "wavefront");
}
__device__ __forceinline__ void conv_mat(const Ctx& c, const float* W, int K, int ldw, int N, int Npad, bf16* WT, int ldt, int row_off, int col_off, const float* gk = nullptr) {
    float* scr = (float*)(c.lds + c.wave * 8704);
    const int nblk = Npad / 32, nit = (K / 64) * nblk;
    for (int it = c.gw; it < nit; it += c.ngw) tr_item(W, ldw, N, WT, ldt, row_off, col_off, it / nblk, it % nblk, scr, c.lane, gk);
}

__device__ __forceinline__ void norm_rows_bf16(const Ctx& c, const float* __restrict__ X, const float* __restrict__ g, bf16* __restrict__ O, int nrows) {
    f32x4 gv[8];
#pragma unroll
    for (int j = 0; j < 8; ++j) gv[j] = *(const f32x4*)(g + 4 * c.lane + 256 * j);
    for (int m = c.gw; m < nrows; m += c.ngw) {
        const f32x4* xr = (const f32x4*)(X + (size_t)m * D) + c.lane; f32x4 v[8]; float s = 0.f;
#pragma unroll
        for (int j = 0; j < 8; ++j) { v[j] = xr[64 * j]; s += (v[j].x * v[j].x + v[j].y * v[j].y) + (v[j].z * v[j].z + v[j].w * v[j].w); }
        const float rstd = 1.0f / sqrtf(wave_sum(s) * (1.f / D) + NORM_EPS);
        u32x2* o8 = (u32x2*)(O + (size_t)m * D) + c.lane;
#pragma unroll
        for (int j = 0; j < 8; ++j) { u32x2 w; w.x = pk2(v[j].x * rstd * gv[j].x, v[j].y * rstd * gv[j].y); w.y = pk2(v[j].z * rstd * gv[j].z, v[j].w * rstd * gv[j].w); o8[64 * j] = w; }
    }
}
__device__ __forceinline__ void cast_rows_ss(const Ctx& c, const float* __restrict__ X, bf16* __restrict__ O, unsigned long long* rowss, int nrows) {
    for (int m = c.gw; m < nrows; m += 2 * c.ngw) {
        const int m2 = (m + c.ngw < nrows) ? m + c.ngw : m;
        const f32x4* xr = (const f32x4*)(X + (size_t)m * D) + c.lane; const f32x4* xr2 = (const f32x4*)(X + (size_t)m2 * D) + c.lane; f32x4 v[8], v2[8]; float s = 0.f, s2 = 0.f;
#pragma unroll
        for (int j = 0; j < 8; ++j) { v[j] = xr[64 * j]; v2[j] = xr2[64 * j]; }
#pragma unroll
        for (int j = 0; j < 8; ++j) { s += (v[j].x * v[j].x + v[j].y * v[j].y) + (v[j].z * v[j].z + v[j].w * v[j].w); s2 += (v2[j].x * v2[j].x + v2[j].y * v2[j].y) + (v2[j].z * v2[j].z + v2[j].w * v2[j].w); }
#pragma unroll
        for (int o = 1; o < 64; o <<= 1) { s += __shfl_xor(s, o); s2 += __shfl_xor(s2, o); }
        u32x2* o8 = (u32x2*)(O + (size_t)m * D) + c.lane; u32x2* o82 = (u32x2*)(O + (size_t)m2 * D) + c.lane;
#pragma unroll
        for (int j = 0; j < 8; ++j) { u32x2 w; w.x = pk2(v[j].x, v[j].y); w.y = pk2(v[j].z, v[j].w); o8[64 * j] = w; }
        if (c.lane == 0) rowss[m] = (unsigned long long)(s * 16777216.0f);
        if (m2 != m) {
#pragma unroll
            for (int j = 0; j < 8; ++j) { u32x2 w; w.x = pk2(v2[j].x, v2[j].y); w.y = pk2(v2[j].z, v2[j].w); o82[64 * j] = w; }
            if (c.lane == 0) rowss[m2] = (unsigned long long)(s2 * 16777216.0f);
        }
    }
}
__device__ __forceinline__ void scale_rows_out(const Ctx& c, const bf16* __restrict__ XB, const float* __restrict__ g, const unsigned long long* rowss, float* O, int nrows) {
    for (int m = c.gw; m < nrows; m += 2 * c.ngw) {
        const int m2 = (m + c.ngw < nrows) ? m + c.ngw : m;
        u32x4 xa[4], xb[4];
#pragma unroll
        for (int j = 0; j < 4; ++j) { xa[j] = *(const u32x4*)(XB + (size_t)m * D + 8 * c.lane + 512 * j); xb[j] = *(const u32x4*)(XB + (size_t)m2 * D + 8 * c.lane + 512 * j); }
        const float ra = __builtin_amdgcn_rsqf((float)rowss[m] * (5.9604644775390625e-08f / D) + NORM_EPS), rb = __builtin_amdgcn_rsqf((float)rowss[m2] * (5.9604644775390625e-08f / D) + NORM_EPS);
#pragma unroll
        for (int j = 0; j < 4; ++j) { float x[8]; unpack8(xa[j], x);
            const f32x4 g0 = *(const f32x4*)(g + 8 * c.lane + 512 * j), g1 = *(const f32x4*)(g + 8 * c.lane + 512 * j + 4);
            *(f32x4*)(O + (size_t)m * D + 8 * c.lane + 512 * j) = (f32x4){x[0] * ra * g0.x, x[1] * ra * g0.y, x[2] * ra * g0.z, x[3] * ra * g0.w};
            *(f32x4*)(O + (size_t)m * D + 8 * c.lane + 512 * j + 4) = (f32x4){x[4] * ra * g1.x, x[5] * ra * g1.y, x[6] * ra * g1.z, x[7] * ra * g1.w};
            if (m2 != m) { unpack8(xb[j], x);
                *(f32x4*)(O + (size_t)m2 * D + 8 * c.lane + 512 * j) = (f32x4){x[0] * rb * g0.x, x[1] * rb * g0.y, x[2] * rb * g0.z, x[3] * rb * g0.w};
                *(f32x4*)(O + (size_t)m2 * D + 8 * c.lane + 512 * j + 4) = (f32x4){x[4] * rb * g1.x, x[5] * rb * g1.y, x[6] * rb * g1.z, x[7] * rb * g1.w}; } }
    }
}
__device__ __forceinline__ void norm_rows_f32(const Ctx& c, float* X, const float* __restrict__ g, int nrows) {
    f32x4 gv[8];
#pragma unroll
    for (int j = 0; j < 8; ++j) gv[j] = *(const f32x4*)(g + 4 * c.lane + 256 * j);
    for (int m = c.gw; m < nrows; m += c.ngw) {
        f32x4* xr = (f32x4*)(X + (size_t)m * D) + c.lane; f32x4 v[8]; float s = 0.f;
#pragma unroll
        for (int j = 0; j < 8; ++j) { v[j] = xr[64 * j]; s += (v[j].x * v[j].x + v[j].y * v[j].y) + (v[j].z * v[j].z + v[j].w * v[j].w); }
        const float rstd = 1.0f / sqrtf(wave_sum(s) * (1.f / D) + NORM_EPS);
#pragma unroll
        for (int j = 0; j < 8; ++j) xr[64 * j] = v[j] * rstd * gv[j];
    }
}

__device__ __forceinline__ void rope_tables(const Ctx& c, const int* __restrict__ start_frame, float* ropea, float* ropei) {
    const float HA[16] = {1.000000000e+00f, 4.403665960e-01f, 1.939227432e-01f, 8.539710194e-02f, 3.760603070e-02f, 1.656044088e-02f, 7.292664610e-03f, 3.211446106e-03f, 1.414213562e-03f, 6.227724371e-04f, 2.742481884e-04f, 1.207697351e-04f, 5.318295734e-05f, 2.341999971e-05f, 1.031338525e-05f, 4.541670478e-06f};
    const float LA[16] = {0.000000000e+00f, 6.688275267e-09f, 1.547429962e-09f, -1.652958881e-09f, 2.282729838e-10f, -8.020459852e-10f, 1.273676581e-10f, -1.116812753e-10f, -1.115275407e-14f, -1.514006802e-11f, -1.268531807e-11f, 2.335000249e-12f, 1.624761415e-12f, -7.452659366e-13f, 1.309491117e-13f, 2.687890499e-15f};
    const float HI[8] = {1.000000000e+00f, 1.939227432e-01f, 3.760603070e-02f, 7.292664610e-03f, 1.414213562e-03f, 2.742481884e-04f, 5.318295734e-05f, 1.031338525e-05f};
    const float LI[8] = {0.000000000e+00f, 1.547429962e-09f, 2.282729838e-10f, 1.273676581e-10f, -1.115275407e-14f, -1.268531807e-11f, 1.624761415e-12f, 1.309491117e-13f};
    const int gt = c.bid * NTHR + c.tid, ngt = c.nb * NTHR;
    for (int i = gt; i < M * 24; i += ngt) {
        const int m = i / 24, j = i % 24; const int b = m / SEQ, t = m % SEQ;
        const float pos = (float)(start_frame[b] + t);
        float hi = 0.f, lo = 0.f;
#pragma unroll
        for (int q = 0; q < 16; ++q) if (j == q) { hi = HA[q]; lo = LA[q]; }
#pragma unroll
        for (int q = 0; q < 8; ++q) if (j == 16 + q) { hi = HI[q]; lo = LI[q]; }
        const float p = pos * hi, e = fmaf(pos, hi, -p) + pos * lo;
        float sn, cs; sincosf(p, &sn, &cs);
        const float cc = cs - e * sn, ss = sn + e * cs;
        if (j < 16) { ropea[(size_t)m * 32 + j] = cc; ropea[(size_t)m * 32 + 16 + j] = ss; }
        else { ropei[(size_t)m * 16 + (j - 16)] = cc; ropei[(size_t)m * 16 + 8 + (j - 16)] = ss; }
    }
}

__device__ __forceinline__ void build_wql(const Ctx& c, const float* __restrict__ w_uq, const float* __restrict__ w_uk, bf16* WQ) {
    const int gt = c.bid * NTHR + c.tid, ngt = c.nb * NTHR;
    for (int it = gt; it < 512 * 256; it += ngt) {
        const int cc = it & 511, rb = it >> 9, h = rb >> 5, r0 = (rb & 31) * 8;
        const float* a = w_uq + (size_t)cc * 1024 + h * 128 + 32; const float* bq = w_uk + (size_t)r0 * 768 + h * 96; float s[8];
#pragma unroll
        for (int j = 0; j < 8; ++j) s[j] = 0.f;
#pragma unroll 2
        for (int d4 = 0; d4 < 24; ++d4) { const f32x4 av = *(const f32x4*)(a + 4 * d4);
#pragma unroll
            for (int j = 0; j < 8; ++j) { const f32x4 bv = *(const f32x4*)(bq + (size_t)j * 768 + 4 * d4); s[j] += (av.x * bv.x + av.y * bv.y) + (av.z * bv.z + av.w * bv.w); } }
#pragma unroll
        for (int j = 0; j < 8; ++j) WQ[(size_t)(h * 256 + r0 + j) * 512 + cc] = (bf16)f2bf(s[j]);
    }
}
__device__ __forceinline__ void build_wout(const Ctx& c, const float* __restrict__ w_uv, const float* __restrict__ w_out, bf16* WO) {
    const int gt = c.bid * NTHR + c.tid, ngt = c.nb * NTHR;
    for (int i = gt; i < 8 * 32 * 2048; i += ngt) {
        const int n = i & 2047, rg = (i >> 11) & 31, h = i >> 16; float acc[8];
#pragma unroll
        for (int j = 0; j < 8; ++j) acc[j] = 0.f;
#pragma unroll 2
        for (int d4 = 0; d4 < 32; ++d4) {
            const float* wop = w_out + (size_t)(h * 128 + 4 * d4) * 2048 + n; const float wo0 = wop[0], wo1 = wop[2048], wo2 = wop[4096], wo3 = wop[6144];
#pragma unroll
            for (int j = 0; j < 8; ++j) { const f32x4 u = *(const f32x4*)(w_uv + (size_t)(rg * 8 + j) * 1024 + h * 128 + 4 * d4); acc[j] += (u.x * wo0 + u.y * wo1) + (u.z * wo2 + u.w * wo3); } }
        u32x4 o; o.x = pk2(acc[0], acc[1]); o.y = pk2(acc[2], acc[3]); o.z = pk2(acc[4], acc[5]); o.w = pk2(acc[6], acc[7]);
        *(u32x4*)(WO + (size_t)n * OC + h * 256 + rg * 8) = o;
    }
}

__device__ __forceinline__ void dsa_prep(const Ctx& c, const bf16* __restrict__ H, const float* __restrict__ cqn_g, const float* __restrict__ ckv_g, const float* __restrict__ kidx_g,
                                         const float* __restrict__ ropea, const float* __restrict__ ropei, bf16* CQN, bf16* KF, bf16* KIDX, float* WIDX) {
    const int l = c.lane;
    struct Tok { u32x4 cq; u32x2 ckv; unsigned short r1, r2, ki, wi; float csa, sna, csi, sni; };
    auto ld = [&](int m) -> Tok { Tok t; const bf16* h = H + (size_t)m * HC; const int l15 = l & 15, l7 = l & 7;
        t.cq = *(const u32x4*)(h + 8 * l); t.ckv = *(const u32x2*)(h + 512 + 4 * l); t.r1 = h[768 + l15]; t.r2 = h[768 + 16 + l15]; t.ki = h[800 + l]; t.wi = h[864 + l15];
        t.csa = ropea[(size_t)m * 32 + l15]; t.sna = ropea[(size_t)m * 32 + 16 + l15]; t.csi = ropei[(size_t)m * 16 + l7]; t.sni = ropei[(size_t)m * 16 + 8 + l7]; return t; };
    auto proc = [&](int m, const Tok& t) {
        {
            float f[8]; unpack8(t.cq, f); float s = 0.f;
#pragma unroll
            for (int j = 0; j < 8; ++j) s += f[j] * f[j];
            const float rstd = 1.0f / sqrtf(wave_sum(s) * (1.f / 512.f) + NORM_EPS);
            u32x4 o; o.x = pk2(f[0] * rstd * cqn_g[8 * l + 0], f[1] * rstd * cqn_g[8 * l + 1]); o.y = pk2(f[2] * rstd * cqn_g[8 * l + 2], f[3] * rstd * cqn_g[8 * l + 3]);
            o.z = pk2(f[4] * rstd * cqn_g[8 * l + 4], f[5] * rstd * cqn_g[8 * l + 5]); o.w = pk2(f[6] * rstd * cqn_g[8 * l + 6], f[7] * rstd * cqn_g[8 * l + 7]);
            *(u32x4*)(CQN + (size_t)m * 512 + 8 * l) = o;
        }
        {
            const u32x2 w = t.ckv; const float f0 = bf2f(w.x & 0xffffu), f1 = bf2f(w.x >> 16), f2 = bf2f(w.y & 0xffffu), f3 = bf2f(w.y >> 16);
            const float s = (f0 * f0 + f1 * f1) + (f2 * f2 + f3 * f3);
            const float rstd = 1.0f / sqrtf(wave_sum(s) * (1.f / 256.f) + NORM_EPS);
            u32x2 o; o.x = pk2(f0 * rstd * ckv_g[4 * l + 0], f1 * rstd * ckv_g[4 * l + 1]); o.y = pk2(f2 * rstd * ckv_g[4 * l + 2], f3 * rstd * ckv_g[4 * l + 3]);
            *(u32x2*)(KF + (size_t)m * KFW + 4 * l) = o;
        }
        if (l < 16) {
            const float x1 = bf2f(t.r1), x2 = bf2f(t.r2); const float cs = t.csa, sn = t.sna;
            KF[(size_t)m * KFW + 256 + l] = (bf16)f2bf(x1 * cs - x2 * sn); KF[(size_t)m * KFW + 256 + 16 + l] = (bf16)f2bf(x2 * cs + x1 * sn);
        }
        {
            const float v = bf2f(t.ki); const float rstd = 1.0f / sqrtf(wave_sum(v * v) * (1.f / 64.f) + NORM_EPS);
            const float y = v * rstd * kidx_g[l];
            const float ylo = __shfl(y, l & 7), yhi = __shfl(y, (l & 7) + 8);
            float o = y;
            if (l < 16) { const float cs = t.csi, sn = t.sni; o = (l < 8) ? (ylo * cs - yhi * sn) : (yhi * cs + ylo * sn); }
            KIDX[(size_t)m * 64 + l] = (bf16)f2bf(o);
        }
        if (l < 16) WIDX[(size_t)m * 16 + l] = bf2f(t.wi) * 0.03125f;
    };
    for (int m = c.gw; m < M; m += 2 * c.ngw) {
        const int m2 = m + c.ngw; const bool two = m2 < M;
        const Tok ta = ld(m); const Tok tb = ld(two ? m2 : m);
        proc(m, ta);
        if (two) proc(m2, tb);
    }
}
__device__ __forceinline__ void q_rope_fix(const Ctx& c, bf16* QALL, const float* __restrict__ ropea, const float* __restrict__ ropei) {
    const int l = c.lane;
    for (int m = c.gw; m < M; m += c.ngw) {
        bf16* q = QALL + (size_t)m * QC;
#pragma unroll
        for (int i = 0; i < 2; ++i) { const int p = l + 64 * i, hh = p >> 4, j = p & 15; bf16* a = q + 2048 + hh * 32 + j;
            const float x1 = bf2f(a[0]), x2 = bf2f(a[16]); const float cs = ropea[(size_t)m * 32 + j], sn = ropea[(size_t)m * 32 + 16 + j];
            a[0] = (bf16)f2bf(x1 * cs - x2 * sn); a[16] = (bf16)f2bf(x2 * cs + x1 * sn); }
#pragma unroll
        for (int i = 0; i < 2; ++i) { const int p = l + 64 * i, hh = p >> 3, j = p & 7; bf16* a = q + 2304 + hh * 64 + j;
            const float x1 = bf2f(a[0]), x2 = bf2f(a[8]); const float cs = ropei[(size_t)m * 16 + j], sn = ropei[(size_t)m * 16 + 8 + j];
            a[0] = (bf16)f2bf(x1 * cs - x2 * sn); a[8] = (bf16)f2bf(x2 * cs + x1 * sn); }
    }
}
__device__ __forceinline__ size_t sc_row_off(int b, int t) { const int ch = t >> 6; return (size_t)b * SC_PER_BATCH + (size_t)4096 * (ch * (ch + 1) / 2) + (size_t)(t & 63) * (64 * (ch + 1)); }
__device__ __forceinline__ void idx_scores_simple(const Ctx& c, const bf16* __restrict__ QALL, const bf16* __restrict__ KIDX, const float* __restrict__ WIDX, float* SC) {
    float* qs = (float*)c.lds;
    float* ws = qs + 1024;
    for (int m = c.bid; m < M; m += c.nb) {
        const int b = m / SEQ, t = m % SEQ, limit = ((t >> 6) + 1) * 64;
        __syncthreads();
        for (int i = c.tid; i < 1024; i += NTHR) qs[i] = bf2f(QALL[(size_t)m * QC + 2304 + i]);
        if (c.tid < 16) ws[c.tid] = WIDX[(size_t)m * 16 + c.tid];
        __syncthreads();
        if (limit <= 256) continue;
        float* row = SC + sc_row_off(b, t);
        for (int s = c.tid; s < limit; s += NTHR) {
            float k[64]; const u32x4* kp = (const u32x4*)(KIDX + (size_t)(b * SEQ + s) * 64);
#pragma unroll
            for (int j = 0; j < 8; ++j) unpack8(kp[j], k + 8 * j);
            float sc = 0.f;
#pragma unroll 1
            for (int h = 0; h < 16; ++h) { asm volatile("" ::: "memory"); float d = 0.f; const f32x4* q4 = (const f32x4*)(qs + h * 64);
#pragma unroll
                for (int j = 0; j < 16; ++j) { const f32x4 q = q4[j]; d += (q.x * k[4 * j] + q.y * k[4 * j + 1]) + (q.z * k[4 * j + 2] + q.w * k[4 * j + 3]); }
                sc += ws[h] * fmaxf(d, 0.f); }
            row[s] = sc;
        }
    }
}
__device__ __forceinline__ void select_row(const float* row, int limit, unsigned short* sel, int l_in, unsigned short* stg = nullptr) {
    int l = l_in; asm volatile("" : "+v"(l));
    const int ng = limit >> 9;
    unsigned key[64];
#pragma unroll
    for (int jg = 0; jg < 8; ++jg) {
        if (jg <= ng) {
#pragma unroll
            for (int j = 8 * jg; j < 8 * jg + 8; ++j) { const int s = j * 64 + l; key[j] = __float_as_uint(row[s < limit ? s : 0]); }
        } else {
#pragma unroll
            for (int j = 8 * jg; j < 8 * jg + 8; ++j) key[j] = 0u;
        }
    }
#pragma unroll
    for (int j = 0; j < 64; ++j) { const int s = j * 64 + l; unsigned u = key[j]; u = (u & 0x80000000u) ? ~u : (u | 0x80000000u); key[j] = (s < limit) ? u : 0u; }
    unsigned mx = 0u;
#pragma unroll
    for (int j = 0; j < 64; ++j) mx = key[j] > mx ? key[j] : mx;
#pragma unroll
    for (int o = 1; o < 64; o <<= 1) { const unsigned t = (unsigned)__shfl_xor((int)mx, o); mx = t > mx ? t : mx; }
    mx = (unsigned)__builtin_amdgcn_readfirstlane((int)mx);
    auto wave_count = [&](int v) -> int {
        v += __builtin_amdgcn_update_dpp(0, v, 0xB1, 0xf, 0xf, true); v += __builtin_amdgcn_update_dpp(0, v, 0x4E, 0xf, 0xf, true);
        v += __builtin_amdgcn_update_dpp(0, v, 0x141, 0xf, 0xf, true); v += __builtin_amdgcn_update_dpp(0, v, 0x140, 0xf, 0xf, true);
        return __builtin_amdgcn_readlane(v, 0) + __builtin_amdgcn_readlane(v, 16) + __builtin_amdgcn_readlane(v, 32) + __builtin_amdgcn_readlane(v, 48); };
    unsigned T = 0u;
#pragma unroll 1
    for (int bit = 31 - __builtin_clz(mx | 1u); bit >= 0; --bit) {
        const unsigned Tn = T | (1u << bit); int cl = 0;
#pragma unroll
        for (int jg = 0; jg < 8; ++jg) if (jg <= ng) {
#pragma unroll
            for (int j = 8 * jg; j < 8 * jg + 8; ++j) cl += (key[j] >= Tn) ? 1 : 0; }
        const int cnt = wave_count(cl);
        if (cnt >= 256) T = Tn;
        if (cnt == 256) break;
    }
    int cgl = 0;
#pragma unroll
    for (int j = 0; j < 64; ++j) cgl += (key[j] > T) ? 1 : 0;
    const int cgt = wave_count(cgl);
    const int need_eq = 256 - cgt;
    int base = 0, beq = 0;
    const unsigned long long lt = (1ull << l) - 1ull;
    if (stg) {
#pragma unroll
        for (int jg = 0; jg < 8; ++jg) if (jg <= ng) {
#pragma unroll
            for (int j = 8 * jg; j < 8 * jg + 8; ++j) {
                const unsigned long long mg = __ballot(key[j] > T);
                const int pos = base + (int)__builtin_amdgcn_mbcnt_hi((unsigned)(mg >> 32), __builtin_amdgcn_mbcnt_lo((unsigned)mg, 0u));
                if (key[j] > T) stg[pos] = (unsigned short)(j * 64 + l);
                base += __popcll(mg);
                const unsigned long long me = __ballot(key[j] == T);
                if (me != 0ull) {
                    const int pe = beq + (int)__builtin_amdgcn_mbcnt_hi((unsigned)(me >> 32), __builtin_amdgcn_mbcnt_lo((unsigned)me, 0u));
                    if (key[j] == T && pe < need_eq) stg[cgt + pe] = (unsigned short)(j * 64 + l);
                    beq += __popcll(me);
                }
            }
        }
        __builtin_amdgcn_fence(__ATOMIC_RELEASE, "wavefront"); __builtin_amdgcn_wave_barrier(); __builtin_amdgcn_fence(__ATOMIC_ACQUIRE, "wavefront");
        *(u32x2*)(sel + 4 * l) = *(const u32x2*)(stg + 4 * l);
        __builtin_amdgcn_fence(__ATOMIC_RELEASE, "wavefront"); __builtin_amdgcn_wave_barrier(); __builtin_amdgcn_fence(__ATOMIC_ACQUIRE, "wavefront");
        return;
    }
#pragma unroll
    for (int jg = 0; jg < 8; ++jg) if (jg <= ng) {
#pragma unroll
        for (int j = 8 * jg; j < 8 * jg + 8; ++j) {
            const unsigned long long mg = __ballot(key[j] > T), me = __ballot(key[j] == T);
            if (key[j] > T) sel[base + __popcll(mg & lt)] = (unsigned short)(j * 64 + l);
            base += __popcll(mg);
            const int pe = beq + __popcll(me & lt);
            if (key[j] == T && pe < need_eq) sel[cgt + pe] = (unsigned short)(j * 64 + l);
            beq += __popcll(me);
        }
    }
}
__device__ __forceinline__ void bs_transpose32(unsigned (&A)[32]) {
    unsigned m = 0x0000FFFFu;
#pragma unroll
    for (int j = 16; j != 0; j >>= 1) {
#pragma unroll
        for (int k = 0; k < 32; ++k) {
            if ((k & j) == 0) {
                const unsigned t = (A[k] ^ (A[k + j] >> j)) & m;
                A[k] ^= t; A[k + j] ^= (t << j);
            }
        }
        m ^= (m << (j >> 1));
    }
}
__device__ __forceinline__ void select_row_bs(const float* row, int limit, unsigned short* sel, int l_in, unsigned short* stg) {
    int l = l_in; asm volatile("" : "+v"(l));
    const int nsl = limit >> 6;
    const int ng = limit >> 9;
    unsigned lo[32], hi[32];
#pragma unroll
    for (int jg = 0; jg < 8; ++jg) {
        if (jg <= ng) {
#pragma unroll
            for (int j = 8 * jg; j < 8 * jg + 8; ++j) { const int s = j * 64 + l; const unsigned u = __float_as_uint(row[s < limit ? s : 0]);
                if (j < 32) lo[j & 31] = u; else hi[j & 31] = u; }
        } else {
#pragma unroll
            for (int j = 8 * jg; j < 8 * jg + 8; ++j) { if (j < 32) lo[j & 31] = 0u; else hi[j & 31] = 0u; }
        }
    }
    asm volatile("" ::: "memory");
#pragma unroll
    for (int j = 0; j < 64; ++j) { const unsigned u = (j < 32) ? lo[j & 31] : hi[j & 31];
        const unsigned kx = (j < nsl) ? ((u & 0x80000000u) ? ~u : (u | 0x80000000u)) : 0u;
        if (j < 32) lo[j & 31] = kx; else hi[j & 31] = kx; }
    const bool has_hi = nsl > 32;
    bs_transpose32(lo);
    if (has_hi) bs_transpose32(hi);
    auto wave_count = [&](int v) -> int {
        v += __builtin_amdgcn_update_dpp(0, v, 0xB1, 0xf, 0xf, true); v += __builtin_amdgcn_update_dpp(0, v, 0x4E, 0xf, 0xf, true);
        v += __builtin_amdgcn_update_dpp(0, v, 0x141, 0xf, 0xf, true); v += __builtin_amdgcn_update_dpp(0, v, 0x140, 0xf, 0xf, true);
        return __builtin_amdgcn_readlane(v, 0) + __builtin_amdgcn_readlane(v, 16) + __builtin_amdgcn_readlane(v, 32) + __builtin_amdgcn_readlane(v, 48); };
    unsigned clo = 0xffffffffu, chi = has_hi ? 0xffffffffu : 0u, glo = 0u, ghi = 0u;
    int G = 0;
#pragma unroll
    for (int i = 0; i < 32; ++i) {
        const unsigned olo = clo & lo[i], ohi = chi & hi[i];
        const int tot = G + wave_count(__builtin_popcount(olo) + __builtin_popcount(ohi));
        const bool take = tot >= 256;
        const unsigned mt = take ? 0u : 0xffffffffu;
        G = take ? G : tot;
        glo |= olo & mt; ghi |= ohi & mt;
        clo = olo ^ (clo & mt); chi = ohi ^ (chi & mt);
        if (tot == 256) break;
    }
    {
        const int need = 256 - G;
        const int ceq = wave_count(__builtin_popcount(clo) + __builtin_popcount(chi));
        if (ceq == need) { glo |= clo; ghi |= chi; }
        else {
            int beq = 0;
#pragma unroll 1
            for (int k = 0; k < 64; ++k) {
                const unsigned bm = 0x80000000u >> (k & 31);
                const bool mine = ((k < 32 ? clo : chi) & bm) != 0u;
                const unsigned long long me = __ballot(mine);
                if (me != 0ull) {
                    const int pe = beq + (int)__builtin_amdgcn_mbcnt_hi((unsigned)(me >> 32), __builtin_amdgcn_mbcnt_lo((unsigned)me, 0u));
                    if (mine && pe < need) { if (k < 32) glo |= bm; else ghi |= bm; }
                    beq += __popcll(me);
                }
            }
        }
    }
    const int cl = __builtin_popcount(glo) + __builtin_popcount(ghi);
    int inc = cl;
#pragma unroll
    for (int o = 1; o < 64; o <<= 1) { const int t = __shfl_up(inc, o); inc += (l >= o) ? t : 0; }
    int pos = inc - cl;
    while (__ballot(glo != 0u) != 0ull) {
        if (glo != 0u) { const int s = __builtin_clz(glo); glo &= ~(0x80000000u >> s); stg[pos++] = (unsigned short)(s * 64 + l); }
    }
    while (__ballot(ghi != 0u) != 0ull) {
        if (ghi != 0u) { const int s = __builtin_clz(ghi); ghi &= ~(0x80000000u >> s); stg[pos++] = (unsigned short)((32 + s) * 64 + l); }
    }
    __builtin_amdgcn_fence(__ATOMIC_RELEASE, "wavefront"); __builtin_amdgcn_wave_barrier(); __builtin_amdgcn_fence(__ATOMIC_ACQUIRE, "wavefront");
    *(u32x2*)(sel + 4 * l) = *(const u32x2*)(stg + 4 * l);
    __builtin_amdgcn_fence(__ATOMIC_RELEASE, "wavefront"); __builtin_amdgcn_wave_barrier(); __builtin_amdgcn_fence(__ATOMIC_ACQUIRE, "wavefront");
}
__device__ __forceinline__ void topk_select(const Ctx& c, const float* __restrict__ SC, bf16* SEL  ) {
    const int l = c.lane;
    for (int m = c.gw; m < M; m += c.ngw) {
        const int b = m / SEQ, t = m % SEQ, limit = ((t >> 6) + 1) * 64;
        unsigned short* sel = (unsigned short*)SEL + (size_t)m * 256;
        if (limit <= 256) { for (int i = l; i < 256; i += 64) sel[i] = (unsigned short)(i < limit ? i : 0); continue; }
        select_row(SC + sc_row_off(b, t), limit, sel, l);
    }
}
__device__ __forceinline__ void dsa_attn_simple(const Ctx& c, const bf16* __restrict__ QALL, const bf16* __restrict__ KF, const bf16* __restrict__ SEL, bf16* OLY, int mmax = M) {
    float* qf = (float*)c.lds;
    float* P = qf + 8 * 288;
    int* sl = (int*)(P + 8 * 256);
    const float scale = 0.08838834764831845f;
    for (int m = c.bid; m < mmax; m += c.nb) {
        const int b = m / SEQ, t = m % SEQ, limit = ((t >> 6) + 1) * 64, cnt = limit < 256 ? limit : 256;
        __syncthreads();
        for (int i = c.tid; i < 8 * 288; i += NTHR) { const int h = i / 288, d = i % 288; qf[i] = bf2f(d < 256 ? QALL[(size_t)m * QC + h * 256 + d] : QALL[(size_t)m * QC + 2048 + h * 32 + (d - 256)]); }
        if (c.tid < 256) sl[c.tid] = (int)((const unsigned short*)SEL)[(size_t)m * 256 + c.tid];
        __syncthreads();
        if (c.tid < 256) {
            float acc[8];
#pragma unroll
            for (int h = 0; h < 8; ++h) acc[h] = 0.f;
            if (c.tid < cnt) {
                const u32x4* kp = (const u32x4*)(KF + (size_t)(b * SEQ + sl[c.tid]) * KFW);
                for (int ch = 0; ch < 36; ++ch) { float k[8]; unpack8(kp[ch], k);
#pragma unroll
                    for (int h = 0; h < 8; ++h) { const float* q = qf + h * 288 + ch * 8;
#pragma unroll
                        for (int j = 0; j < 8; ++j) acc[h] += k[j] * q[j]; } }
            }
#pragma unroll
            for (int h = 0; h < 8; ++h) P[h * 256 + c.tid] = (c.tid < cnt) ? acc[h] * scale : -INFINITY;
        }
        __syncthreads();
        {
            const int h = c.wave; float v[4]; float mx = -INFINITY;
#pragma unroll
            for (int i = 0; i < 4; ++i) { v[i] = P[h * 256 + c.lane + 64 * i]; mx = fmaxf(mx, v[i]); }
            mx = wave_max(mx); float s = 0.f;
#pragma unroll
            for (int i = 0; i < 4; ++i) { v[i] = __expf(v[i] - mx); s += v[i]; }
            s = wave_sum(s); const float inv = 1.f / s;
#pragma unroll
            for (int i = 0; i < 4; ++i) P[h * 256 + c.lane + 64 * i] = v[i] * inv;
        }
        __syncthreads();
        {
            const int r = c.tid & 255, hg = c.tid >> 8; float o[4] = {0.f, 0.f, 0.f, 0.f};
            for (int i = 0; i < cnt; ++i) { const float v = bf2f(KF[(size_t)(b * SEQ + sl[i]) * KFW + r]);
#pragma unroll
                for (int hh = 0; hh < 4; ++hh) o[hh] += P[(hg * 4 + hh) * 256 + i] * v; }
#pragma unroll
            for (int hh = 0; hh < 4; ++hh) OLY[(size_t)m * OC + (hg * 4 + hh) * 256 + r] = (bf16)f2bf(o[hh]);
        }
    }
}
__device__ __forceinline__ void xattn_simple(const Ctx& c, const bf16* __restrict__ XQ, const bf16* __restrict__ KVBIG, int layer, bf16* XO) {
    float* qf = (float*)c.lds;
    float* P = qf + 512;
    const float scale = 0.08838834764831845f;
    for (int m = c.bid; m < M; m += c.nb) {
        const int b = m / SEQ;
        const bf16* kvb = KVBIG + (size_t)(layer * 2048 + b * 256) * 4096 + layer * 1024;
        __syncthreads();
        qf[c.tid] = bf2f(XQ[(size_t)m * 512 + c.tid]);
        __syncthreads();
        {
            const int j = c.tid & 255, hp = c.tid >> 8;
#pragma unroll
            for (int hh = 0; hh < 2; ++hh) { const int h = hp * 2 + hh; const u32x4* kp = (const u32x4*)(kvb + (size_t)j * 4096 + h * 128); float d = 0.f;
                for (int ch = 0; ch < 16; ++ch) { float k[8]; unpack8(kp[ch], k);
#pragma unroll
                    for (int e = 0; e < 8; ++e) d += k[e] * qf[h * 128 + ch * 8 + e]; }
                P[h * 256 + j] = d * scale; }
        }
        __syncthreads();
        if (c.wave < 4) { const int h = c.wave; float v[4]; float mx = -INFINITY;
#pragma unroll
            for (int i = 0; i < 4; ++i) { v[i] = P[h * 256 + c.lane + 64 * i]; mx = fmaxf(mx, v[i]); }
            mx = wave_max(mx); float s = 0.f;
#pragma unroll
            for (int i = 0; i < 4; ++i) { v[i] = __expf(v[i] - mx); s += v[i]; }
            s = wave_sum(s); const float inv = 1.f / s;
#pragma unroll
            for (int i = 0; i < 4; ++i) P[h * 256 + c.lane + 64 * i] = v[i] * inv; }
        __syncthreads();
        {   const int h = c.tid >> 7; float o = 0.f;
            for (int j = 0; j < 256; ++j) o += P[h * 256 + j] * bf2f(kvb[(size_t)j * 4096 + 512 + c.tid]);
            XO[(size_t)m * 512 + c.tid] = (bf16)f2bf(o); }
    }
}
__device__ __forceinline__ float x16_max(float v) { const unsigned u = __builtin_bit_cast(unsigned, v); auto r = __builtin_amdgcn_permlane16_swap(u, u, false, false); return fmaxf(__builtin_bit_cast(float, (unsigned)r[0]), __builtin_bit_cast(float, (unsigned)r[1])); }
__device__ __forceinline__ float x32_max(float v) { const unsigned u = __builtin_bit_cast(unsigned, v); auto r = __builtin_amdgcn_permlane32_swap(u, u, false, false); return fmaxf(__builtin_bit_cast(float, (unsigned)r[0]), __builtin_bit_cast(float, (unsigned)r[1])); }
__device__ __forceinline__ float x16_sum(float v) { const unsigned u = __builtin_bit_cast(unsigned, v); auto r = __builtin_amdgcn_permlane16_swap(u, u, false, false); return __builtin_bit_cast(float, (unsigned)r[0]) + __builtin_bit_cast(float, (unsigned)r[1]); }
__device__ __forceinline__ float x32_sum(float v) { const unsigned u = __builtin_bit_cast(unsigned, v); auto r = __builtin_amdgcn_permlane32_swap(u, u, false, false); return __builtin_bit_cast(float, (unsigned)r[0]) + __builtin_bit_cast(float, (unsigned)r[1]); }
typedef short bf16x8 __attribute__((ext_vector_type(8)));
typedef short bf16x4 __attribute__((ext_vector_type(4)));
__device__ __forceinline__ bf16x4 tr_read4(const unsigned char* p) { return __builtin_amdgcn_ds_read_tr16_b64_v4i16((LAS bf16x4*)p); }
__device__ __forceinline__ bf16x8 cat8(bf16x4 a, bf16x4 b) { return __builtin_shufflevector(a, b, 0, 1, 2, 3, 4, 5, 6, 7); }
__device__ __forceinline__ bf16x8 pack_p8(const f32x4 a, const f32x4 b) {
    u32x4 w; w.x = pg8::cvt_pk_bf16(a[0], a[1]); w.y = pg8::cvt_pk_bf16(a[2], a[3]); w.z = pg8::cvt_pk_bf16(b[0], b[1]); w.w = pg8::cvt_pk_bf16(b[2], b[3]);
    return __builtin_bit_cast(bf16x8, w);
}
__device__ __forceinline__ bf16x8 rope_frag(const bf16x8 xf, const bf16x8 pf, const float* cs, const float* sn, bool lo) {
    float x[8], p[8]; unpack8(__builtin_bit_cast(u32x4, xf), x); unpack8(__builtin_bit_cast(u32x4, pf), p);
    const float sg = lo ? -1.f : 1.f; float o[8];
#pragma unroll
    for (int j = 0; j < 8; ++j) o[j] = x[j] * cs[j] + sg * p[j] * sn[j];
    u32x4 w; w.x = pg8::cvt_pk_bf16(o[0], o[1]); w.y = pg8::cvt_pk_bf16(o[2], o[3]); w.z = pg8::cvt_pk_bf16(o[4], o[5]); w.w = pg8::cvt_pk_bf16(o[6], o[7]);
    return __builtin_bit_cast(bf16x8, w);
}
__device__ __forceinline__ bf16x8 xchg_frag(const bf16x8 v, int lane_xor) { u32x4 u = __builtin_bit_cast(u32x4, v); u32x4 r;
    r.x = (unsigned)__shfl_xor((int)u.x, lane_xor); r.y = (unsigned)__shfl_xor((int)u.y, lane_xor); r.z = (unsigned)__shfl_xor((int)u.z, lane_xor); r.w = (unsigned)__shfl_xor((int)u.w, lane_xor); return __builtin_bit_cast(bf16x8, r); }
constexpr int XA_PITCH = 272;
__device__ __forceinline__ void xattn_mfma(const Ctx& c, const bf16* __restrict__ XQ, const bf16* __restrict__ KVBIG, int layer, bf16* XO) {
    unsigned char* Kl = c.lds; unsigned char* Vl = c.lds + 256 * XA_PITCH;
    const int l = c.lane, n16 = l & 15, g = l >> 4;
    const float scale = 0.08838834764831845f * 1.4426950408889634f;
    for (int unit = c.bid; unit < 256; unit += c.nb) {
        const int b = unit >> 5, h = (unit >> 3) & 3, qc = unit & 7;
        const bf16* kvb = KVBIG + (size_t)(layer * 2048 + b * 256) * 4096 + layer * 1024 + h * 128;
        __syncthreads();
        {
            u32x4 kq[8], vq[8];
#pragma unroll
            for (int j = 0; j < 8; ++j) { const int i = c.tid + NTHR * j, row = i >> 4, ch = i & 15; kq[j] = *(const u32x4*)(kvb + (size_t)row * 4096 + ch * 8); vq[j] = *(const u32x4*)(kvb + (size_t)row * 4096 + 512 + ch * 8); }
#pragma unroll
            for (int j = 0; j < 8; ++j) { const int i = c.tid + NTHR * j, row = i >> 4, ch = i & 15; *(u32x4*)(Kl + row * XA_PITCH + ch * 16) = kq[j]; *(u32x4*)(Vl + row * XA_PITCH + ch * 16) = vq[j]; }
        }
        bf16x8 Qall[4][4];
#pragma unroll
        for (int g4 = 0; g4 < 4; ++g4) { const size_t m = (size_t)b * SEQ + qc * 512 + c.wave * 64 + g4 * 16 + n16;
#pragma unroll
            for (int kk = 0; kk < 4; ++kk) Qall[g4][kk] = *(const bf16x8*)(XQ + m * 512 + h * 128 + 32 * kk + 8 * g); }
        __syncthreads();
#pragma unroll
        for (int g4 = 0; g4 < 4; ++g4) {
            const size_t m = (size_t)b * SEQ + qc * 512 + c.wave * 64 + g4 * 16 + n16;
            bf16x8 Qb[4];
#pragma unroll
            for (int kk = 0; kk < 4; ++kk) Qb[kk] = Qall[g4][kk];
            f32x4 S[16];
#pragma unroll
            for (int j = 0; j < 16; ++j) { S[j] = (f32x4){0.f, 0.f, 0.f, 0.f};
#pragma unroll
                for (int kk = 0; kk < 4; ++kk) { const bf16x8 A = *(const bf16x8*)(Kl + (16 * j + n16) * XA_PITCH + (32 * kk + 8 * g) * 2);
                    S[j] = __builtin_amdgcn_mfma_f32_16x16x32_bf16(A, Qb[kk], S[j], 0, 0, 0); } }
            float mx = -INFINITY;
#pragma unroll
            for (int j = 0; j < 16; ++j) mx = fmaxf(mx, fmaxf(fmaxf(S[j][0], S[j][1]), fmaxf(S[j][2], S[j][3])));
            mx = x32_max(x16_max(mx));
            float sum = 0.f; const float mo = mx * scale;
#pragma unroll
            for (int j = 0; j < 16; ++j) {
#pragma unroll
                for (int r = 0; r < 4; ++r) { const float p = __builtin_amdgcn_exp2f(S[j][r] * scale - mo); S[j][r] = p; sum += p; } }
            sum = x32_sum(x16_sum(sum));
            const float inv = 1.f / sum;
            bf16x8 Pb[8];
#pragma unroll
            for (int jj = 0; jj < 8; ++jj) Pb[jj] = pack_p8(S[2 * jj], S[2 * jj + 1]);
            const int q4 = n16 >> 2, p4 = l & 3;
#pragma unroll
            for (int dt = 0; dt < 8; ++dt) { f32x4 O = (f32x4){0.f, 0.f, 0.f, 0.f};
#pragma unroll
                for (int jj = 0; jj < 8; ++jj) { const unsigned char* vp = Vl + (32 * jj + 4 * g + q4) * XA_PITCH + (16 * dt) * 2 + 8 * p4;
                    const bf16x8 A = cat8(tr_read4(vp), tr_read4(vp + 16 * XA_PITCH));
                    O = __builtin_amdgcn_mfma_f32_16x16x32_bf16(A, Pb[jj], O, 0, 0, 0); }
                u32x2 w; w.x = pg8::cvt_pk_bf16(O[0] * inv, O[1] * inv); w.y = pg8::cvt_pk_bf16(O[2] * inv, O[3] * inv);
                *(u32x2*)(XO + m * 512 + h * 128 + 16 * dt + 4 * g) = w; }
        }
    }
}
__device__ __forceinline__ void diag_cmp_bf16(const Ctx& c, const bf16* A, int lda, const bf16* B, int ldb, int rows, int cols, float* acc) {
    float d2 = 0.f, a2 = 0.f;
    const size_t n = (size_t)rows * cols;
    for (size_t i = (size_t)c.bid * NTHR + c.tid; i < n; i += (size_t)c.nb * NTHR) { const size_t r = i / cols, cc = i % cols; const float a = bf2f(A[r * lda + cc]), b = bf2f(B[r * ldb + cc]); d2 += (a - b) * (a - b); a2 += a * a; }
    d2 = wave_sum(d2); a2 = wave_sum(a2);
    if (c.lane == 0) { atomicAdd(acc, d2); atomicAdd(acc + 1, a2); }
}
constexpr int DA_PITCH = 528, DA_WAVE_BYTES = 32 * DA_PITCH;
__device__ __forceinline__ void dsa_attn_mfma(const Ctx& c, const bf16* __restrict__ QALL, const bf16* __restrict__ KF, const bf16* __restrict__ SEL, const float* __restrict__ ROPEA, bf16* OLY, int m_first, int m_stride, int m_end) {
    unsigned char* Vw = c.lds + c.wave * DA_WAVE_BYTES;
    const int l = c.lane, n16 = l & 15, g = l >> 4, q4 = n16 >> 2, p4 = l & 3, hh = n16 & 7;
    const float scale = 0.08838834764831845f * 1.4426950408889634f;
    bf16x8 K0[9], K1[9];
    int sx0 = 0, sx1 = 0;
    bool qpre = false;
#pragma unroll 1
    for (int m = m_first; m < m_end; m += m_stride) {
        const int b = m / SEQ, t = m % SEQ, limit = ((t >> 6) + 1) * 64, cnt = limit < 256 ? limit : 256, nblk = cnt >> 5;
        const bf16* qrow = QALL + (size_t)m * QC;
        bf16x8 Qb[9];
        if (qpre) {
#pragma unroll
            for (int kk = 0; kk < 9; ++kk) Qb[kk] = K0[kk];
        } else {
#pragma unroll
            for (int kk = 0; kk < 8; ++kk) Qb[kk] = *(const bf16x8*)(qrow + hh * 256 + 32 * kk + 8 * g);
            Qb[8] = *(const bf16x8*)(qrow + 2048 + hh * 32 + 8 * g);
        }
        {
            const bf16x8 pf = xchg_frag(Qb[8], 32); float cs[8], sn[8];
            const f32x4 c0 = *(const f32x4*)(ROPEA + (size_t)m * 32 + 8 * (g & 1)), c1 = *(const f32x4*)(ROPEA + (size_t)m * 32 + 8 * (g & 1) + 4), s0 = *(const f32x4*)(ROPEA + (size_t)m * 32 + 16 + 8 * (g & 1)), s1 = *(const f32x4*)(ROPEA + (size_t)m * 32 + 16 + 8 * (g & 1) + 4);
            cs[0] = c0.x; cs[1] = c0.y; cs[2] = c0.z; cs[3] = c0.w; cs[4] = c1.x; cs[5] = c1.y; cs[6] = c1.z; cs[7] = c1.w; sn[0] = s0.x; sn[1] = s0.y; sn[2] = s0.z; sn[3] = s0.w; sn[4] = s1.x; sn[5] = s1.y; sn[6] = s1.z; sn[7] = s1.w;
            Qb[8] = rope_frag(Qb[8], pf, cs, sn, g < 2); }
        f32x4 O[16];
#pragma unroll
        for (int dt = 0; dt < 16; ++dt) O[dt] = (f32x4){0.f, 0.f, 0.f, 0.f};
        float mrun = -INFINITY, lrun = 0.f;
        const unsigned short* selp = (const unsigned short*)SEL + (size_t)m * 256;
        const bf16* kfb = KF + (size_t)b * SEQ * KFW;
#define DA_IDX(BLK) do { sx0 = selp[32 * (BLK) + n16]; sx1 = selp[32 * (BLK) + 16 + n16]; } while (0)
#define DA_GATHER() do { const bf16* r0_ = kfb + (size_t)sx0 * KFW + 8 * g; const bf16* r1_ = kfb + (size_t)sx1 * KFW + 8 * g; \
            _Pragma("unroll") for (int kk = 0; kk < 9; ++kk) { K0[kk] = *(const bf16x8*)(r0_ + 32 * kk); K1[kk] = *(const bf16x8*)(r1_ + 32 * kk); } } while (0)
        if (!qpre) DA_IDX(0);
        DA_GATHER(); DA_IDX(nblk > 1 ? 1 : 0);
#pragma unroll 1
        for (int blk = 0; blk < nblk; ++blk) {
            f32x4 S0 = (f32x4){0.f, 0.f, 0.f, 0.f}, S1 = (f32x4){0.f, 0.f, 0.f, 0.f};
#pragma unroll
            for (int kk = 0; kk < 9; ++kk) { S0 = __builtin_amdgcn_mfma_f32_16x16x32_bf16(K0[kk], Qb[kk], S0, 0, 0, 0); S1 = __builtin_amdgcn_mfma_f32_16x16x32_bf16(K1[kk], Qb[kk], S1, 0, 0, 0); }
#pragma unroll
            for (int kk = 0; kk < 8; ++kk) { *(bf16x8*)(Vw + n16 * DA_PITCH + (32 * kk + 8 * g) * 2) = K0[kk]; *(bf16x8*)(Vw + (16 + n16) * DA_PITCH + (32 * kk + 8 * g) * 2) = K1[kk]; }
            __builtin_amdgcn_sched_barrier(0);
            if (blk + 1 < nblk) { DA_GATHER(); DA_IDX(blk + 2 < nblk ? blk + 2 : blk + 1); }
            else if (m + m_stride < m_end) {
                const bf16* qn = QALL + (size_t)(m + m_stride) * QC;
#pragma unroll
                for (int kk = 0; kk < 8; ++kk) K0[kk] = *(const bf16x8*)(qn + hh * 256 + 32 * kk + 8 * g);
                K0[8] = *(const bf16x8*)(qn + 2048 + hh * 32 + 8 * g);
                { const unsigned short* seln = (const unsigned short*)SEL + (size_t)(m + m_stride) * 256; sx0 = seln[n16]; sx1 = seln[16 + n16]; } }
            __builtin_amdgcn_sched_barrier(0);
            float bm = fmaxf(fmaxf(fmaxf(S0[0], S0[1]), fmaxf(S0[2], S0[3])), fmaxf(fmaxf(S1[0], S1[1]), fmaxf(S1[2], S1[3])));
            bm = x32_max(x16_max(bm));
            const float mnew = fmaxf(mrun, bm), alpha = __builtin_amdgcn_exp2f((mrun - mnew) * scale), mo = mnew * scale; mrun = mnew;
            float ps = 0.f;
#pragma unroll
            for (int r = 0; r < 4; ++r) { S0[r] = __builtin_amdgcn_exp2f(S0[r] * scale - mo); S1[r] = __builtin_amdgcn_exp2f(S1[r] * scale - mo); ps += S0[r] + S1[r]; }
            lrun = lrun * alpha + ps;
            const bf16x8 Pb = pack_p8(S0, S1);
#pragma unroll
            for (int dt = 0; dt < 16; ++dt) { O[dt] = O[dt] * alpha;
                const unsigned char* vp = Vw + (4 * g + q4) * DA_PITCH + (16 * dt) * 2 + 8 * p4;
                const bf16x8 A = cat8(tr_read4(vp), tr_read4(vp + 16 * DA_PITCH));
                O[dt] = __builtin_amdgcn_mfma_f32_16x16x32_bf16(A, Pb, O[dt], 0, 0, 0); }
        }
#undef DA_GATHER
#undef DA_IDX
        qpre = (m + m_stride < m_end);
        lrun = x32_sum(x16_sum(lrun));
        const float inv = 1.f / lrun;
        if (n16 < 8) {
            bf16* orow = OLY + (size_t)m * OC + n16 * 256 + 4 * g;
#pragma unroll
            for (int dt = 0; dt < 16; ++dt) { u32x2 w; w.x = pg8::cvt_pk_bf16(O[dt][0] * inv, O[dt][1] * inv); w.y = pg8::cvt_pk_bf16(O[dt][2] * inv, O[dt][3] * inv); *(u32x2*)(orow + 16 * dt) = w; }
        }
    }
}
__device__ __forceinline__ void dsa_attn_queue(const Ctx& c, const bf16* __restrict__ QALL, const bf16* __restrict__ KF, const bf16* __restrict__ SEL, const float* __restrict__ ROPEA, bf16* OLY, unsigned* counter, volatile LAS unsigned* slot) {
    for (;;) {
        __syncthreads();
        if (c.tid == 0) *slot = __hip_atomic_fetch_add(counter, 1u, __ATOMIC_RELAXED, __HIP_MEMORY_SCOPE_AGENT);
        __syncthreads();
        const int chunk = (int)*slot;
        if (chunk >= M / 16) break;
        dsa_attn_mfma(c, QALL, KF, SEL, ROPEA, OLY, chunk * 16 + c.wave, 8, chunk * 16 + 16);
    }
}
__device__ __forceinline__ float relu1(float x) { const int b = __builtin_bit_cast(int, x); return __builtin_bit_cast(float, b > 0 ? b : 0); }
__device__ __forceinline__ void idx_topk_mfma(const Ctx& c, const bf16* __restrict__ QALL, const bf16* __restrict__ KIDX, const float* __restrict__ WIDX, const float* __restrict__ ROPEI, float* scr, bf16* SEL, int nitems) {
    const int l = c.lane, n16 = l & 15, g = l >> 4, qg = c.wave & 3, kh = c.wave >> 2;
#pragma unroll 1
    for (int item = c.bid; item < nitems; item += c.nb) {
        const int b = item >> 5, pr = item & 31;
#pragma unroll 1
        for (int which = 0; which < 2; ++which) {
            const int ch = which ? 63 - pr : pr, L = 64 * (ch + 1), t0 = 64 * ch;
            if (L > 256) {
            const size_t m = (size_t)b * SEQ + t0 + 16 * qg + n16;
            float* srow = scr + (size_t)(16 * qg + n16) * L + 4 * g;
            const int nt = L >> 5, j0 = kh * nt, j1 = j0 + nt;
            const bf16* kp = KIDX + ((size_t)b * SEQ + n16) * 64 + 8 * g;
            {
                bf16x8 Qi[16][2]; float w[16];
                { const bf16* qp = QALL + m * QC + 2304 + 8 * g;
#pragma unroll
                  for (int h = 0; h < 16; ++h) { Qi[h][0] = *(const bf16x8*)(qp + h * 64); Qi[h][1] = *(const bf16x8*)(qp + h * 64 + 32); }
                  {
                      float cs[8], sn[8]; const f32x4 c0 = *(const f32x4*)(ROPEI + m * 16), c1 = *(const f32x4*)(ROPEI + m * 16 + 4), s0 = *(const f32x4*)(ROPEI + m * 16 + 8), s1 = *(const f32x4*)(ROPEI + m * 16 + 12);
                      cs[0] = c0.x; cs[1] = c0.y; cs[2] = c0.z; cs[3] = c0.w; cs[4] = c1.x; cs[5] = c1.y; cs[6] = c1.z; cs[7] = c1.w; sn[0] = s0.x; sn[1] = s0.y; sn[2] = s0.z; sn[3] = s0.w; sn[4] = s1.x; sn[5] = s1.y; sn[6] = s1.z; sn[7] = s1.w;
#pragma unroll
                      for (int h = 0; h < 16; ++h) { const bf16x8 pf = xchg_frag(Qi[h][0], 16); const bf16x8 rf = rope_frag(Qi[h][0], pf, cs, sn, g == 0); if (g < 2) Qi[h][0] = rf; } }
                  const f32x4* wp = (const f32x4*)(WIDX + m * 16);
#pragma unroll
                  for (int q = 0; q < 4; ++q) { const f32x4 v = wp[q]; w[4 * q] = v.x; w[4 * q + 1] = v.y; w[4 * q + 2] = v.z; w[4 * q + 3] = v.w; } }
                bf16x8 Ka = *(const bf16x8*)(kp + (size_t)j0 * 1024), Kb = *(const bf16x8*)(kp + (size_t)j0 * 1024 + 32);
#pragma unroll 1
                for (int j = j0; j < j1; ++j) {
                    const int jn = (j + 1 < j1) ? j + 1 : j;
                    const bf16x8 Na = *(const bf16x8*)(kp + (size_t)jn * 1024), Nb = *(const bf16x8*)(kp + (size_t)jn * 1024 + 32);
                    f32x2 s01 = (f32x2){0.f, 0.f}, s23 = (f32x2){0.f, 0.f};
                    f32x4 a = __builtin_amdgcn_mfma_f32_16x16x32_bf16(Ka, Qi[0][0], (f32x4){0.f, 0.f, 0.f, 0.f}, 0, 0, 0); a = __builtin_amdgcn_mfma_f32_16x16x32_bf16(Kb, Qi[0][1], a, 0, 0, 0);
#pragma unroll
                    for (int h = 0; h < 16; ++h) { f32x4 an = a;
                        if (h < 15) { an = __builtin_amdgcn_mfma_f32_16x16x32_bf16(Ka, Qi[h + 1][0], (f32x4){0.f, 0.f, 0.f, 0.f}, 0, 0, 0); an = __builtin_amdgcn_mfma_f32_16x16x32_bf16(Kb, Qi[h + 1][1], an, 0, 0, 0); }
                        const f32x2 wv = (f32x2){w[h], w[h]};
                        s01 = (f32x2){relu1(a[0]), relu1(a[1])} * wv + s01; s23 = (f32x2){relu1(a[2]), relu1(a[3])} * wv + s23; a = an; }
                    *(f32x4*)(srow + 16 * j) = (f32x4){s01.x, s01.y, s23.x, s23.y};
                    Ka = Na; Kb = Nb;
                }
            }
            }
            asm volatile("s_waitcnt vmcnt(0)" ::: "memory");
            __syncthreads();
            __builtin_amdgcn_fence(__ATOMIC_ACQUIRE, "agent");
            asm volatile("s_waitcnt vmcnt(0)" ::: "memory");
#pragma unroll 1
            for (int i = 0; i < 8; ++i) {
                const int ql = c.wave * 8 + i;
                unsigned short* sel = (unsigned short*)SEL + ((size_t)b * SEQ + t0 + ql) * 256;
                if (L <= 256) { for (int k = l; k < 256; k += 64) sel[k] = (unsigned short)(k < L ? k : 0); }
                else select_row_bs(scr + (size_t)ql * L, L, sel, l, (unsigned short*)(c.lds + c.wave * 512));
            }
            __syncthreads();
        }
    }
}
__device__ __forceinline__ void diag_cmp_sel(const Ctx& c, const bf16* SA, const bf16* SB, int nbatch, float* acc) {
    unsigned* bm = (unsigned*)(c.lds + c.wave * 512);
    float miss = 0.f, tot = 0.f;
    for (int m = c.gw; m < nbatch * SEQ; m += c.ngw) {
        const int t = m % SEQ; if (t < 256) continue;
        bm[c.lane] = 0u; bm[64 + c.lane] = 0u;
        __builtin_amdgcn_fence(__ATOMIC_RELEASE, "wavefront"); __builtin_amdgcn_wave_barrier();
        for (int i = c.lane; i < 256; i += 64) { const unsigned s = ((const unsigned short*)SA)[(size_t)m * 256 + i]; atomicOr(&bm[s >> 5], 1u << (s & 31)); }
        __builtin_amdgcn_fence(__ATOMIC_RELEASE, "wavefront"); __builtin_amdgcn_wave_barrier(); __builtin_amdgcn_fence(__ATOMIC_ACQUIRE, "wavefront");
        for (int i = c.lane; i < 256; i += 64) { const unsigned s = ((const unsigned short*)SB)[(size_t)m * 256 + i]; miss += ((bm[s >> 5] >> (s & 31)) & 1u) ? 0.f : 1.f; tot += 1.f; }
        __builtin_amdgcn_fence(__ATOMIC_RELEASE, "wavefront"); __builtin_amdgcn_wave_barrier();
    }
    miss = wave_sum(miss); tot = wave_sum(tot);
    if (c.lane == 0) { atomicAdd(acc, miss); atomicAdd(acc + 1, tot); }
}
__device__ __forceinline__ void idx_topk_lds(const Ctx& c, const bf16* __restrict__ QALL, const bf16* __restrict__ KIDX, const float* __restrict__ WIDX, const float* __restrict__ ROPEI, u32x4* qscr, bf16* SEL, int nitems) {
    float* SCL = (float*)c.lds;
    f32x4* WL = (f32x4*)(c.lds + 131072);
    const int w8 = c.wave;
#pragma unroll 1
    for (int item = c.bid; item < nitems; item += c.nb) {
        const int b = item >> 5, pr = item & 31;
#pragma unroll 1
        for (int which = 0; which < 2; ++which) {
            int l = c.lane; asm volatile("" : "+v"(l));
            const int n16 = l & 15, g = l >> 4;
            const int ch = which ? 63 - pr : pr, L = 64 * (ch + 1), t0 = 64 * ch;
            if (L <= 256) {
#pragma unroll 1
                for (int i = 0; i < 8; ++i) { unsigned short* sel = (unsigned short*)SEL + ((size_t)b * SEQ + t0 + w8 * 8 + i) * 256; for (int k = l; k < 256; k += 64) sel[k] = (unsigned short)(k < L ? k : 0); }
                continue;
            }
            __syncthreads();
            if (w8 < 4) {
                const size_t m = (size_t)b * SEQ + t0 + 16 * w8 + n16;
                const bf16* qp = QALL + m * QC + 2304 + 8 * g;
                float cs[8], sn[8]; const f32x4 c0 = *(const f32x4*)(ROPEI + m * 16), c1 = *(const f32x4*)(ROPEI + m * 16 + 4), s0 = *(const f32x4*)(ROPEI + m * 16 + 8), s1 = *(const f32x4*)(ROPEI + m * 16 + 12);
                cs[0] = c0.x; cs[1] = c0.y; cs[2] = c0.z; cs[3] = c0.w; cs[4] = c1.x; cs[5] = c1.y; cs[6] = c1.z; cs[7] = c1.w; sn[0] = s0.x; sn[1] = s0.y; sn[2] = s0.z; sn[3] = s0.w; sn[4] = s1.x; sn[5] = s1.y; sn[6] = s1.z; sn[7] = s1.w;
#pragma unroll 4
                for (int h = 0; h < 16; ++h) { bf16x8 f0 = *(const bf16x8*)(qp + h * 64); const bf16x8 f1 = *(const bf16x8*)(qp + h * 64 + 32);
                    const bf16x8 pf = xchg_frag(f0, 16); const bf16x8 rf = rope_frag(f0, pf, cs, sn, g == 0); if (g < 2) f0 = rf;
                    qscr[(w8 * 64 + l) * 32 + h * 2] = __builtin_bit_cast(u32x4, f0); qscr[(w8 * 64 + l) * 32 + h * 2 + 1] = __builtin_bit_cast(u32x4, f1); }
            }
            asm volatile("s_waitcnt vmcnt(0)" ::: "memory");
            __syncthreads();
            __builtin_amdgcn_fence(__ATOMIC_ACQUIRE, "agent"); asm volatile("s_waitcnt vmcnt(0)" ::: "memory");
            const bf16* kp = KIDX + ((size_t)b * SEQ + n16) * 64 + 8 * g;
            const int ntile = L >> 4;
#pragma unroll 1
            for (int qsub = 0; qsub < 8; ++qsub) {
                asm volatile("" ::: "memory");
                bf16x8 Qi[16][2];
                { const int srcl = g * 16 + (qsub & 1) * 8 + (n16 & 7); const u32x4* fp = qscr + (size_t)((qsub >> 1) * 64 + srcl) * 32;
#pragma unroll
                  for (int h = 0; h < 16; ++h) { Qi[h][0] = __builtin_bit_cast(bf16x8, fp[h * 2]); Qi[h][1] = __builtin_bit_cast(bf16x8, fp[h * 2 + 1]); }
                  if (w8 == 0 && l < 32) WL[l] = *(const f32x4*)(WIDX + ((size_t)b * SEQ + t0 + 8 * qsub + (l >> 2)) * 16 + 4 * (l & 3)); }
                __syncthreads();
                const f32x4* wq = WL + (n16 & 7) * 4;
                float* srow = SCL + (n16 & 7) * 4096 + 4 * g;
                int j = w8;
                bf16x8 Ka = *(const bf16x8*)(kp + (size_t)j * 1024), Kb = *(const bf16x8*)(kp + (size_t)j * 1024 + 32);
#pragma unroll 1
                for (; j < ntile; j += 8) {
                    const int jn = (j + 8 < ntile) ? j + 8 : j;
                    const bf16x8 Na = *(const bf16x8*)(kp + (size_t)jn * 1024), Nb = *(const bf16x8*)(kp + (size_t)jn * 1024 + 32);
                    f32x2 s01 = (f32x2){0.f, 0.f}, s23 = (f32x2){0.f, 0.f};
                    f32x4 a = __builtin_amdgcn_mfma_f32_16x16x32_bf16(Ka, Qi[0][0], (f32x4){0.f, 0.f, 0.f, 0.f}, 0, 0, 0); a = __builtin_amdgcn_mfma_f32_16x16x32_bf16(Kb, Qi[0][1], a, 0, 0, 0);
#pragma unroll
                    for (int h4 = 0; h4 < 4; ++h4) { const f32x4 w4 = wq[h4];
#pragma unroll
                        for (int hh = 0; hh < 4; ++hh) { const int h = 4 * h4 + hh; f32x4 an = a;
                            if (h < 15) { an = __builtin_amdgcn_mfma_f32_16x16x32_bf16(Ka, Qi[h + 1][0], (f32x4){0.f, 0.f, 0.f, 0.f}, 0, 0, 0); an = __builtin_amdgcn_mfma_f32_16x16x32_bf16(Kb, Qi[h + 1][1], an, 0, 0, 0); }
                            const f32x2 wv = (f32x2){w4[hh], w4[hh]};
                            s01 = (f32x2){relu1(a[0]), relu1(a[1])} * wv + s01; s23 = (f32x2){relu1(a[2]), relu1(a[3])} * wv + s23; a = an; } }
                    if (n16 < 8) *(f32x4*)(srow + 16 * j) = (f32x4){s01.x, s01.y, s23.x, s23.y};
                    Ka = Na; Kb = Nb;
                }
                __syncthreads();
                select_row(SCL + w8 * 4096, L, (unsigned short*)SEL + ((size_t)b * SEQ + t0 + 8 * qsub + w8) * 256, l);
                __syncthreads();
            }
        }
    }
}
#if DIAG == 7
__device__ __forceinline__ void select_row_v1(const float* row, int limit, unsigned short* sel, int l_in) {
    int l = l_in; asm volatile("" : "+v"(l));
    const int ng = limit >> 9;
    unsigned key[64];
#pragma unroll
    for (int j = 0; j < 64; ++j) { const int s = j * 64 + l; unsigned u = 0u; if (s < limit) { u = __float_as_uint(row[s]); u = (u & 0x80000000u) ? ~u : (u | 0x80000000u); } key[j] = u; }
    unsigned mx = 0u;
#pragma unroll
    for (int j = 0; j < 64; ++j) mx = key[j] > mx ? key[j] : mx;
#pragma unroll
    for (int o = 1; o < 64; o <<= 1) { const unsigned t = (unsigned)__shfl_xor((int)mx, o); mx = t > mx ? t : mx; }
    mx = (unsigned)__builtin_amdgcn_readfirstlane((int)mx);
    unsigned T = 0u;
#pragma unroll 1
    for (int bit = 31 - __builtin_clz(mx | 1u); bit >= 0; --bit) {
        const unsigned Tn = T | (1u << bit); int cnt = 0;
#pragma unroll
        for (int jg = 0; jg < 8; ++jg) if (jg <= ng) {
#pragma unroll
            for (int j = 8 * jg; j < 8 * jg + 8; ++j) cnt += __popcll(__ballot(key[j] >= Tn)); }
        if (cnt >= 256) T = Tn;
        if (cnt == 256) break;
    }
    int cgt = 0;
#pragma unroll
    for (int j = 0; j < 64; ++j) cgt += __popcll(__ballot(key[j] > T));
    const int need_eq = 256 - cgt;
    int base = 0, beq = 0;
    const unsigned long long lt = (1ull << l) - 1ull;
#pragma unroll
    for (int jg = 0; jg < 8; ++jg) if (jg <= ng) {
#pragma unroll
        for (int j = 8 * jg; j < 8 * jg + 8; ++j) {
            const unsigned long long mg = __ballot(key[j] > T), me = __ballot(key[j] == T);
            if (key[j] > T) sel[base + __popcll(mg & lt)] = (unsigned short)(j * 64 + l);
            base += __popcll(mg);
            const int pe = beq + __popcll(me & lt);
            if (key[j] == T && pe < need_eq) sel[cgt + pe] = (unsigned short)(j * 64 + l);
            beq += __popcll(me);
        }
    }
}
__device__ __forceinline__ void idx_topk_v1(const Ctx& c, const bf16* __restrict__ QALL, const bf16* __restrict__ KIDX, const float* __restrict__ WIDX, float* scr, bf16* SEL, int nitems) {
    const int l = c.lane, n16 = l & 15, g = l >> 4, qg = c.wave & 3, kh = c.wave >> 2;
#pragma unroll 1
    for (int item = c.bid; item < nitems; item += c.nb) {
        const int b = item >> 5, pr = item & 31;
#pragma unroll 1
        for (int which = 0; which < 2; ++which) {
            const int ch = which ? 63 - pr : pr, L = 64 * (ch + 1), t0 = 64 * ch;
            if (L > 256) {
            const size_t m = (size_t)b * SEQ + t0 + 16 * qg + n16;
            float* srow = scr + (size_t)(16 * qg + n16) * L + 4 * g;
            const int nt = L >> 5, j0 = kh * nt, j1 = j0 + nt;
            const bf16* kp = KIDX + ((size_t)b * SEQ + n16) * 64 + 8 * g;
#pragma unroll 1
            for (int hp = 0; hp < 2; ++hp) {
                bf16x8 Qi[8][2]; float w[8];
                { const bf16* qp = QALL + m * QC + 2304 + hp * 512 + 8 * g;
#pragma unroll
                  for (int h = 0; h < 8; ++h) { Qi[h][0] = *(const bf16x8*)(qp + h * 64); Qi[h][1] = *(const bf16x8*)(qp + h * 64 + 32); }
                  const f32x4* wp = (const f32x4*)(WIDX + m * 16 + hp * 8);
#pragma unroll
                  for (int q = 0; q < 2; ++q) { const f32x4 v = wp[q]; w[4 * q] = v.x; w[4 * q + 1] = v.y; w[4 * q + 2] = v.z; w[4 * q + 3] = v.w; } }
                if (hp) { asm volatile("s_waitcnt vmcnt(0)" ::: "memory"); __builtin_amdgcn_fence(__ATOMIC_ACQUIRE, "agent"); asm volatile("s_waitcnt vmcnt(0)" ::: "memory"); }
                bf16x8 Ka = *(const bf16x8*)(kp + (size_t)j0 * 1024), Kb = *(const bf16x8*)(kp + (size_t)j0 * 1024 + 32);
                f32x4 pv = (f32x4){0.f, 0.f, 0.f, 0.f}; if (hp) pv = *(const f32x4*)(srow + 16 * j0);
#pragma unroll 1
                for (int j = j0; j < j1; ++j) {
                    const int jn = (j + 1 < j1) ? j + 1 : j;
                    const bf16x8 Na = *(const bf16x8*)(kp + (size_t)jn * 1024), Nb = *(const bf16x8*)(kp + (size_t)jn * 1024 + 32);
                    f32x4 pn = (f32x4){0.f, 0.f, 0.f, 0.f}; if (hp) pn = *(const f32x4*)(srow + 16 * jn);
                    f32x4 sc = pv;
#pragma unroll
                    for (int h = 0; h < 8; ++h) { f32x4 a = __builtin_amdgcn_mfma_f32_16x16x32_bf16(Ka, Qi[h][0], (f32x4){0.f, 0.f, 0.f, 0.f}, 0, 0, 0); a = __builtin_amdgcn_mfma_f32_16x16x32_bf16(Kb, Qi[h][1], a, 0, 0, 0);
                        sc[0] += w[h] * fmaxf(a[0], 0.f); sc[1] += w[h] * fmaxf(a[1], 0.f); sc[2] += w[h] * fmaxf(a[2], 0.f); sc[3] += w[h] * fmaxf(a[3], 0.f); }
                    *(f32x4*)(srow + 16 * j) = sc;
                    Ka = Na; Kb = Nb; pv = pn;
                }
            }
            }
            asm volatile("s_waitcnt vmcnt(0)" ::: "memory");
            __syncthreads();
            __builtin_amdgcn_fence(__ATOMIC_ACQUIRE, "agent");
            asm volatile("s_waitcnt vmcnt(0)" ::: "memory");
#pragma unroll 1
            for (int i = 0; i < 8; ++i) {
                const int ql = c.wave * 8 + i;
                unsigned short* sel = (unsigned short*)SEL + ((size_t)b * SEQ + t0 + ql) * 256;
                if (L <= 256) { for (int k = l; k < 256; k += 64) sel[k] = (unsigned short)(k < L ? k : 0); }
                else select_row_v1(scr + (size_t)ql * L, L, sel, l);
            }
            __syncthreads();
        }
    }
}
#endif
constexpr int RW_TB = 32;
struct RwkvP { const float *mu, *w0, *w2, *a0, *a2, *g2, *k_k, *k_a, *r_k, *ln_w, *ln_b; };
__device__ __forceinline__ void rwkv_phase(const Ctx& c, const bf16* __restrict__ H, const RwkvP P, bf16* OLY) {
    float* A_WR = (float*)c.lds;
    float* A_K2 = A_WR + RW_TB * 64;
    float* A_V = A_K2 + RW_TB * 64;
    float* A_W = A_V + RW_TB * 64;
    float* A_NKK = A_W + RW_TB * 64;
    float* A_B = A_NKK + RW_TB * 64;
    float* A_G = A_B + RW_TB * 64;
    float* A_OUT = A_G + RW_TB * 64;
    float* L_TW = A_OUT + RW_TB * 64;
    float* L_AL = L_TW + RW_TB * 64;
    float* L_SG = L_AL + RW_TB * 64;
    float* SC1 = L_SG + RW_TB * 160; float* SC2 = SC1 + RW_TB; float* SC3 = SC2 + RW_TB;
    const int l = c.lane, w = c.wave;
    for (int item = c.bid; item < NB * 16; item += c.nb) {
        const int b = item >> 4, h = item & 15, hk = h * 64 + l;
        const float w0v = P.w0[hk], a0v = P.a0[hk], kkv = P.k_k[hk], kav = P.k_a[hk], rkv = P.r_k[hk], lnw = P.ln_w[hk], lnb = P.ln_b[hk];
        float S[8];
#pragma unroll
        for (int i = 0; i < 8; ++i) S[i] = 0.f;
        const int srow = w * 8 + (l >> 3), sj = l & 7;
        for (int t0 = 0; t0 < SEQ; t0 += RW_TB) {
            __syncthreads();
            for (int idx = c.tid; idx < RW_TB * 480; idx += NTHR) {
                const int t = idx / 480, cc = idx % 480; int col; float* dst;
                if (cc < 64) { col = 880 + h * 64 + cc; dst = A_WR + t * 64 + cc; }
                else if (cc < 128) { col = 1904 + h * 64 + (cc - 64); dst = A_K2 + t * 64 + (cc - 64); }
                else if (cc < 192) { col = 2928 + h * 64 + (cc - 128); dst = A_V + t * 64 + (cc - 128); }
                else if (cc < 256) { col = 3952 + (cc - 192); dst = L_TW + t * 64 + (cc - 192); }
                else if (cc < 320) { col = 4016 + (cc - 256); dst = L_AL + t * 64 + (cc - 256); }
                else { col = 4080 + (cc - 320); dst = L_SG + t * 160 + (cc - 320); }
                const size_t m = (size_t)b * SEQ + t0 + t;
                const float x = bf2f(H[m * HC + col]); const float xp = (t0 + t > 0) ? bf2f(H[(m - 1) * HC + col]) : 0.f;
                float hm = x + (xp - x) * P.mu[col - 880];
                if (cc >= 192 && cc < 256) hm = tanhf(hm); else if (cc >= 320) hm = sigmoidf_(hm);
                *dst = hm;
            }
            __syncthreads();
            {
                float wl[RW_TB / 8], al[RW_TB / 8], gg[RW_TB / 8];
#pragma unroll
                for (int i = 0; i < RW_TB / 8; ++i) { wl[i] = 0.f; al[i] = 0.f; gg[i] = 0.f; }
                for (int j = 0; j < 64; ++j) { const float w2v = P.w2[(size_t)j * 1024 + hk], a2v = P.a2[(size_t)j * 1024 + hk];
#pragma unroll
                    for (int i = 0; i < RW_TB / 8; ++i) { wl[i] += L_TW[(w + 8 * i) * 64 + j] * w2v; al[i] += L_AL[(w + 8 * i) * 64 + j] * a2v; } }
                for (int j = 0; j < 160; ++j) { const float g2v = P.g2[(size_t)j * 1024 + hk];
#pragma unroll
                    for (int i = 0; i < RW_TB / 8; ++i) gg[i] += L_SG[(w + 8 * i) * 160 + j] * g2v; }
#pragma unroll
                for (int i = 0; i < RW_TB / 8; ++i) {
                    const int t = w + 8 * i, o = t * 64 + l;
                    const float dec = __expf(-0.6065306597126334f * sigmoidf_(w0v + wl[i]));
                    const float a = sigmoidf_(a0v + al[i]);
                    const float kr = A_K2[o], r = A_WR[o];
                    float kk = kr * kkv; const float nrm = wave_sum(kk * kk); kk = kk * (1.0f / sqrtf(fmaxf(nrm, 1e-24f)));
                    const float k2 = kr * (1.f + (a - 1.f) * kav), bb = kk * a;
                    const float s1 = wave_sum(bb * r), s2 = wave_sum(k2 * r), s3 = wave_sum(r * k2 * rkv);
                    A_W[o] = dec; A_NKK[o] = -kk; A_B[o] = bb; A_K2[o] = k2; A_WR[o] = dec * r; A_G[o] = gg[i];
                    if (l == 0) { SC1[t] = s1; SC2[t] = s2; SC3[t] = s3; }
                }
            }
            __syncthreads();
            for (int t = 0; t < RW_TB; ++t) {
                const f32x4* pw = (const f32x4*)(A_W + t * 64 + 8 * sj); const f32x4* pn = (const f32x4*)(A_NKK + t * 64 + 8 * sj); const f32x4* pb = (const f32x4*)(A_B + t * 64 + 8 * sj);
                const f32x4* pk = (const f32x4*)(A_K2 + t * 64 + 8 * sj); const f32x4* pr = (const f32x4*)(A_WR + t * 64 + 8 * sj);
                const f32x4 w0_ = pw[0], w1_ = pw[1], n0 = pn[0], n1 = pn[1], b0 = pb[0], b1 = pb[1], k0 = pk[0], k1 = pk[1], r0 = pr[0], r1 = pr[1];
                const float vv = A_V[t * 64 + srow], s1 = SC1[t], s2 = SC2[t];
                float sa = (S[0] * n0.x + S[1] * n0.y) + (S[2] * n0.z + S[3] * n0.w) + (S[4] * n1.x + S[5] * n1.y) + (S[6] * n1.z + S[7] * n1.w);
                float p = (S[0] * r0.x + S[1] * r0.y) + (S[2] * r0.z + S[3] * r0.w) + (S[4] * r1.x + S[5] * r1.y) + (S[6] * r1.z + S[7] * r1.w);
                sa += __shfl_xor(sa, 1); p += __shfl_xor(p, 1); sa += __shfl_xor(sa, 2); p += __shfl_xor(p, 2); sa += __shfl_xor(sa, 4); p += __shfl_xor(p, 4);
                S[0] = S[0] * w0_.x + (sa * b0.x + vv * k0.x); S[1] = S[1] * w0_.y + (sa * b0.y + vv * k0.y); S[2] = S[2] * w0_.z + (sa * b0.z + vv * k0.z); S[3] = S[3] * w0_.w + (sa * b0.w + vv * k0.w);
                S[4] = S[4] * w1_.x + (sa * b1.x + vv * k1.x); S[5] = S[5] * w1_.y + (sa * b1.y + vv * k1.y); S[6] = S[6] * w1_.z + (sa * b1.z + vv * k1.z); S[7] = S[7] * w1_.w + (sa * b1.w + vv * k1.w);
                if (sj == 0) A_OUT[t * 64 + srow] = p + sa * s1 + vv * s2;
            }
            __syncthreads();
#pragma unroll
            for (int i = 0; i < RW_TB / 8; ++i) {
                const int t = w + 8 * i, o = t * 64 + l;
                const float x = A_OUT[o]; const float mean = wave_sum(x) * (1.f / 64.f); const float dx = x - mean; const float var = wave_sum(dx * dx) * (1.f / 64.f);
                float y = dx * (1.0f / sqrtf(var + 64e-5f)) * lnw + lnb;
                y = (y + SC3[t] * A_V[o]) * A_G[o];
                OLY[((size_t)b * SEQ + t0 + t) * OC + 2048 + hk] = (bf16)f2bf(y);
            }
        }
    }
}

constexpr int S5_TB = 16;
struct S5P { const float *lam_re, *lam_im, *log_dt, *b_re, *b_im, *c_re, *c_im, *d; };
__device__ __forceinline__ float gelu_tanh(float y) { return 0.5f * y * (1.f + tanhf(0.7978845608028654f * (y + 0.044715f * y * y * y))); }
__device__ __forceinline__ void s5_phase(const Ctx& c, const bf16* __restrict__ U, const S5P P, bf16* Z) {
    constexpr int PERW = 256 + 2 * S5_TB * 65 + 2 * 64 * 16;
    float* UU = (float*)c.lds + c.wave * PERW;
    float* XSr = UU + 256; float* XSi = XSr + S5_TB * 65;
    float* CTr = XSi + S5_TB * 65; float* CTi = CTr + 64 * 16;
    const int l = c.lane;
    for (int item = c.bid; item < NB * 16; item += c.nb) {
        const int b = item >> 4, g = (item & 15) * 8 + c.wave;
        __syncthreads();
        float lbr, lbi, Br[16], Bi[16];
        {
            const float lr = fminf(P.lam_re[g * 64 + l], -1e-4f), li = P.lam_im[g * 64 + l], dt = expf(P.log_dt[g]);
            const float e = expf(lr * dt); lbr = e * cosf(li * dt); lbi = e * sinf(li * dt);
            const float nr = lbr - 1.f, ni = lbi, den = 1.f / (lr * lr + li * li);
            const float cr = (nr * lr + ni * li) * den, ci = (ni * lr - nr * li) * den;
#pragma unroll
            for (int i = 0; i < 16; ++i) { const float br = P.b_re[(size_t)(g * 64 + l) * 16 + i], bi = P.b_im[(size_t)(g * 64 + l) * 16 + i]; Br[i] = cr * br - ci * bi; Bi[i] = cr * bi + ci * br; }
#pragma unroll
            for (int o = 0; o < 16; ++o) { CTr[l * 16 + o] = P.c_re[(size_t)(g * 16 + o) * 64 + l]; CTi[l * 16 + o] = P.c_im[(size_t)(g * 16 + o) * 64 + l]; }
        }
        float dsk[4];
#pragma unroll
        for (int e = 0; e < 4; ++e) dsk[e] = P.d[g * 16 + (l >> 4) * 4 + e];
        float xr = 0.f, xi = 0.f;
        for (int t0 = 0; t0 < SEQ; t0 += S5_TB) {
            __syncthreads();
            { const int row = l >> 2, q = l & 3; const u32x2 w2 = *(const u32x2*)(U + ((size_t)b * SEQ + t0 + row) * D + g * 16 + 4 * q);
              float* d = UU + row * 16 + 4 * q; d[0] = bf2f(w2.x & 0xffffu); d[1] = bf2f(w2.x >> 16); d[2] = bf2f(w2.y & 0xffffu); d[3] = bf2f(w2.y >> 16); }
            __syncthreads();
            for (int t = 0; t < S5_TB; ++t) {
                const f32x4* up = (const f32x4*)(UU + t * 16); const f32x4 u0 = up[0], u1 = up[1], u2 = up[2], u3 = up[3];
                const float u[16] = {u0.x, u0.y, u0.z, u0.w, u1.x, u1.y, u1.z, u1.w, u2.x, u2.y, u2.z, u2.w, u3.x, u3.y, u3.z, u3.w};
                float bur = 0.f, bui = 0.f;
#pragma unroll
                for (int i = 0; i < 16; ++i) { bur += Br[i] * u[i]; bui += Bi[i] * u[i]; }
                const float nxr = lbr * xr - lbi * xi + bur, nxi = lbr * xi + lbi * xr + bui; xr = nxr; xi = nxi;
                XSr[t * 65 + l] = xr; XSi[t * 65 + l] = xi;
            }
            __syncthreads();
            {   const int t = l & 15, oq = l >> 4; float y[4] = {0.f, 0.f, 0.f, 0.f};
                for (int p = 0; p < 64; ++p) { const float a = XSr[t * 65 + p], bb = XSi[t * 65 + p]; const f32x4 cr = *(const f32x4*)(CTr + p * 16 + oq * 4), ci = *(const f32x4*)(CTi + p * 16 + oq * 4);
                    y[0] += a * cr.x - bb * ci.x; y[1] += a * cr.y - bb * ci.y; y[2] += a * cr.z - bb * ci.z; y[3] += a * cr.w - bb * ci.w; }
                float z[4];
#pragma unroll
                for (int e = 0; e < 4; ++e) z[e] = gelu_tanh(y[e] + dsk[e] * UU[t * 16 + oq * 4 + e]);
                u32x2 o; o.x = pk2(z[0], z[1]); o.y = pk2(z[2], z[3]);
                *(u32x2*)(Z + ((size_t)b * SEQ + t0 + t) * D + g * 16 + oq * 4) = o; }
        }
    }
}
template <int CTRL> __device__ __forceinline__ float dpp_mov(float v) { return __builtin_bit_cast(float, __builtin_amdgcn_update_dpp(0, __builtin_bit_cast(int, v), CTRL, 0xf, 0xf, true)); }
__device__ __forceinline__ float sum8(float v) { v += dpp_mov<0xB1>(v); v += dpp_mov<0x4E>(v); v += dpp_mov<0x141>(v); return v; }
__device__ __forceinline__ float wave_sum_fast(float v) { v += dpp_mov<0xB1>(v); v += dpp_mov<0x4E>(v); v += dpp_mov<0x141>(v); v += dpp_mov<0x140>(v); v += __shfl_xor(v, 16); v += __shfl_xor(v, 32); return v; }
__device__ __forceinline__ float fast_tanh(float x) { const float e = __expf(2.f * x); return 1.f - 2.f * __builtin_amdgcn_rcpf(e + 1.f); }
__device__ __forceinline__ void rwkv_lora_prep(const Ctx& c, const bf16* __restrict__ H, const float* __restrict__ mu, bf16* LX) {
    const int l = c.lane;
    const int per = (M + c.ngw - 1) / c.ngw;
    const int mA = c.gw * per, mE = (mA + per < M) ? mA + per : M;
    if (l < 36 && mA < M) {
        const int col = 3952 + 8 * l;
        const f32x4 m0 = *(const f32x4*)(mu + 3072 + 8 * l), m1 = *(const f32x4*)(mu + 3072 + 8 * l + 4);
        const float mv[8] = {m0.x, m0.y, m0.z, m0.w, m1.x, m1.y, m1.z, m1.w};
        float p[8];
        if ((mA % SEQ) > 0) unpack8(*(const u32x4*)(H + (size_t)(mA - 1) * HC + col), p); else {
#pragma unroll
            for (int j = 0; j < 8; ++j) p[j] = 0.f; }
#pragma unroll 1
        for (int mb = mA; mb < mE; mb += 8) {
            u32x4 rq[8];
#pragma unroll
            for (int i = 0; i < 8; ++i) { const int mm = (mb + i < mE) ? mb + i : mE - 1; rq[i] = *(const u32x4*)(H + (size_t)mm * HC + col); }
#pragma unroll
            for (int i = 0; i < 8; ++i) { const int m = mb + i;
                if (m < mE) {
                    float x[8]; unpack8(rq[i], x);
                    if ((m % SEQ) == 0) {
#pragma unroll
                        for (int j = 0; j < 8; ++j) p[j] = 0.f; }
                    float hm[8];
#pragma unroll
                    for (int j = 0; j < 8; ++j) { float v = x[j] + (p[j] - x[j]) * mv[j]; if (l < 8) v = fast_tanh(v); else if (l >= 16) v = sigmoidf_(v); hm[j] = v; p[j] = x[j]; }
                    u32x4 o; o.x = pg8::cvt_pk_bf16(hm[0], hm[1]); o.y = pg8::cvt_pk_bf16(hm[2], hm[3]); o.z = pg8::cvt_pk_bf16(hm[4], hm[5]); o.w = pg8::cvt_pk_bf16(hm[6], hm[7]);
                    *(u32x4*)(LX + (size_t)m * 288 + 8 * l) = o;
                }
            }
        }
    }
}
constexpr int RW2_RAWP = 384;
constexpr int RW2_TWP = 144, RW2_SGP = 336;
__device__ __forceinline__ void rwkv_phase2(const Ctx& c, const bf16* __restrict__ H, const bf16* __restrict__ LX, const RwkvP P, bf16* OUT, int ldo, int coloff, int wb = NB) {
    unsigned char* RAW = c.lds;
    float* A_WR = (float*)(c.lds + 12800);
    float* A_K2 = A_WR + 2048; float* A_V = A_K2 + 2048; float* A_W = A_V + 2048; float* A_NKK = A_W + 2048; float* A_B = A_NKK + 2048; float* A_G = A_B + 2048; float* A_OUT = A_G + 2048;
    float* LO_W = A_OUT + 2048; float* LO_A = LO_W + 2048; float* PR3 = LO_A + 2048;
    unsigned char* L_TW = (unsigned char*)(PR3 + 2048); unsigned char* L_AL = L_TW + 32 * RW2_TWP; unsigned char* L_SG = L_AL + 32 * RW2_TWP;
    float* MU = (float*)(L_SG + 32 * RW2_SGP); float* SC3 = MU + 480 + 64;
    unsigned char* G2T = (unsigned char*)(SC3 + 32);
    float* SCP = (float*)(G2T + 64 * RW2_SGP);
    float* GN = SCP + 128; float* CST = GN + 64;
    float* PR0 = (float*)L_TW; float* PR1 = PR0 + 2048; float* PR2 = A_OUT;
    const int l = c.lane, w = c.wave, n16 = l & 15, g = l >> 4;
#pragma unroll 1
    for (int item = c.bid; item < NB * 16; item += c.nb) {
        const int b = item >> 4, h = item & 15, hk = h * 64 + l;
        __syncthreads();
        if (w < 7) { const float* src = w == 0 ? P.w0 : w == 1 ? P.a0 : w == 2 ? P.k_k : w == 3 ? P.k_a : w == 4 ? P.r_k : w == 5 ? P.ln_w : P.ln_b; CST[w * 64 + l] = src[hk]; }
#pragma unroll 1
        for (int qb = 0; qb < 20; qb += 5) {
            float gq[5];
#pragma unroll
            for (int q = 0; q < 5; ++q) { const int i = c.tid + NTHR * (qb + q); gq[q] = P.g2[(size_t)(i >> 6) * 1024 + h * 64 + (i & 63)]; }
#pragma unroll
            for (int q = 0; q < 5; ++q) { const int i = c.tid + NTHR * (qb + q); *(unsigned short*)(G2T + (i & 63) * RW2_SGP + (i >> 6) * 2) = (unsigned short)f2bf(gq[q]); }
        }
        for (int i = c.tid; i < 192; i += NTHR) { const int mi = i < 64 ? h * 64 + i : i < 128 ? 1024 + h * 64 + (i - 64) : 2048 + h * 64 + (i - 128); MU[i] = P.mu[mi]; }
        const int tt = w >> 2, nt = w & 3;
        bf16x8 W2B[2], A2B[2];
        { const int kc = h * 64 + 16 * nt + n16;
          auto ldfrag = [&](const float* Wp, int kk) -> bf16x8 { float f[8]; int gq = g, kq = kc; asm volatile("" : "+v"(gq), "+v"(kq));
              const float* wp = Wp + (size_t)(32 * kk + 8 * gq) * 1024 + kq;
#pragma unroll
              for (int q = 0; q < 8; ++q) f[q] = wp[q * 1024];
              u32x4 u; u.x = pk2(f[0], f[1]); u.y = pk2(f[2], f[3]); u.z = pk2(f[4], f[5]); u.w = pk2(f[6], f[7]);
              asm volatile("" : "+v"(u));
              return __builtin_bit_cast(bf16x8, u); };
          W2B[0] = ldfrag(P.w2, 0); W2B[1] = ldfrag(P.w2, 1); A2B[0] = ldfrag(P.a2, 0); A2B[1] = ldfrag(P.a2, 1);
        }
        f32x2 S[4];
#pragma unroll
        for (int i = 0; i < 4; ++i) S[i] = (f32x2){0.f, 0.f};
        const int srow = w * 8 + 2 * (l >> 4), sj = l & 15;
        u32x4 raw[4];
        int goff[4]; unsigned ldst[4];
        { const long offL = (const char*)LX - (const char*)H;
#pragma unroll
          for (int k = 0; k < 4; ++k) { const int q_ = c.tid + 512 * k;
              if (q_ < 792) { const int cq_ = q_ % 24, row_ = q_ / 24; const int rc_ = (cq_ < 8 ? 880 : cq_ < 16 ? 1904 - 64 : 2928 - 128) + h * 64 + cq_ * 8;
                  goff[k] = (int)((((long)b * SEQ + row_ - 1) * HC + rc_) * 2); ldst[k] = (unsigned)((RAW - c.lds) + row_ * RW2_RAWP + cq_ * 16); }
              else { int e_ = q_ - 792; const bool ok_ = e_ < 1152; e_ = ok_ ? e_ : 0; const int t_ = e_ / 36, p_ = e_ % 36;
                  goff[k] = (int)(offL + (((long)b * SEQ + t_) * 288 + p_ * 8) * 2);
                  const unsigned char* d_ = p_ < 8 ? L_TW + t_ * RW2_TWP + p_ * 16 : p_ < 16 ? L_AL + t_ * RW2_TWP + (p_ - 8) * 16 : L_SG + t_ * RW2_SGP + (p_ - 16) * 16;
                  ldst[k] = ok_ ? (unsigned)(d_ - c.lds) : 0xffffffffu; } } }
#define RW2_LOAD(T0) do { _Pragma("unroll") for (int k = 0; k < 4; ++k) { \
            const int sb_ = (k == 0) ? HC * 2 : (k >= 2) ? 576 : ((c.tid + 512 < 792) ? HC * 2 : 576); \
            raw[k] = *(const u32x4*)((const char*)H + (long)(goff[k] + (T0) * sb_)); } } while (0)
        RW2_LOAD(0);
#pragma unroll 1
        for (int t0 = 0; t0 < SEQ; t0 += 32) {
            __syncthreads();
#pragma unroll
            for (int k = 0; k < 4; ++k) {
                u32x4 v_ = raw[k]; if (k == 0 && t0 == 0 && c.tid < 24) v_ = (u32x4){0u, 0u, 0u, 0u};
                if (k < 3 || ldst[k] != 0xffffffffu) *(u32x4*)(c.lds + ldst[k]) = v_; }
            { const int tn_ = (t0 + 32 < SEQ) ? t0 + 32 : t0; RW2_LOAD(tn_); }
            __syncthreads();
            if (c.tid < 384) {
                const int cpi = c.tid % 96, qb = c.tid / 96, cp = cpi * 2, tb = qb * 8;
                const float mu0 = MU[cp], mu1 = MU[cp + 1];
                unsigned xq[9];
#pragma unroll
                for (int t = 0; t < 9; ++t) xq[t] = *(const unsigned*)(RAW + (tb + t) * RW2_RAWP + cp * 2);
                const unsigned xb = xq[0];
                float p0 = bf2f(xb & 0xffffu), p1 = bf2f(xb >> 16);
                float* dst = (cp < 64 ? A_WR + cp : cp < 128 ? A_K2 + (cp - 64) : A_V + (cp - 128)) + tb * 64;
#pragma unroll
                for (int t = 0; t < 8; ++t) { const unsigned xa = xq[t + 1]; const float x0 = bf2f(xa & 0xffffu), x1 = bf2f(xa >> 16);
                    *(f32x2*)(dst + t * 64) = (f32x2){x0 + (p0 - x0) * mu0, x1 + (p1 - x1) * mu1}; p0 = x0; p1 = x1; }
            }
            {
                f32x4 aw = (f32x4){0.f, 0.f, 0.f, 0.f}, aa = aw, ag = aw;
#pragma unroll
                for (int kk = 0; kk < 2; ++kk) { const bf16x8 At = *(const bf16x8*)(L_TW + (16 * tt + n16) * RW2_TWP + (32 * kk + 8 * g) * 2), Aa = *(const bf16x8*)(L_AL + (16 * tt + n16) * RW2_TWP + (32 * kk + 8 * g) * 2);
                    aw = __builtin_amdgcn_mfma_f32_16x16x32_bf16(At, W2B[kk], aw, 0, 0, 0); aa = __builtin_amdgcn_mfma_f32_16x16x32_bf16(Aa, A2B[kk], aa, 0, 0, 0); }
#pragma unroll
                for (int kk = 0; kk < 5; ++kk) { const bf16x8 Ag = *(const bf16x8*)(L_SG + (16 * tt + n16) * RW2_SGP + (32 * kk + 8 * g) * 2); const bf16x8 Gb = *(const bf16x8*)(G2T + (16 * nt + n16) * RW2_SGP + (32 * kk + 8 * g) * 2); ag = __builtin_amdgcn_mfma_f32_16x16x32_bf16(Ag, Gb, ag, 0, 0, 0); }
#pragma unroll
                for (int r = 0; r < 4; ++r) { const int o = (16 * tt + 4 * g + r) * 64 + 16 * nt + n16; LO_W[o] = aw[r]; LO_A[o] = aa[r]; A_G[o] = ag[r]; }
            }
            __syncthreads();
            {
                const float w0v = CST[l], a0v = CST[64 + l], kkv = CST[128 + l], kav = CST[192 + l], rkv = CST[256 + l];
                float lw_[4], la_[4], kr_[4], r_[4];
#pragma unroll
                for (int i = 0; i < 4; ++i) { const int o = (w + 8 * i) * 64 + l; lw_[i] = LO_W[o]; la_[i] = LO_A[o]; kr_[i] = A_K2[o]; r_[i] = A_WR[o]; }
#pragma unroll
                for (int i = 0; i < 4; ++i) { const int o = (w + 8 * i) * 64 + l;
                    const float dec = __expf(-0.6065306597126334f * sigmoidf_(w0v + lw_[i]));
                    const float a = sigmoidf_(a0v + la_[i]);
                    const float kr = kr_[i], r = r_[i];
                    const float kk0 = kr * kkv, k2 = kr * (1.f + (a - 1.f) * kav), bb0 = kk0 * a, k2r = k2 * r;
                    A_W[o] = dec; A_NKK[o] = -kk0; A_B[o] = bb0; A_K2[o] = k2; A_WR[o] = dec * r;
                    PR0[o] = kk0 * kk0; PR1[o] = bb0 * r; PR2[o] = k2r; PR3[o] = k2r * rkv; }
            }
            __syncthreads();
            {
                const int t = c.tid >> 4, q = (c.tid >> 2) & 3, qu = c.tid & 3;
                const float* src = (q == 0 ? PR0 : q == 1 ? PR1 : q == 2 ? PR2 : PR3) + t * 64 + 16 * qu;
                const f32x4 v0 = *(const f32x4*)src, v1 = *(const f32x4*)(src + 4), v2 = *(const f32x4*)(src + 8), v3 = *(const f32x4*)(src + 12);
                float sm = ((v0.x + v0.y) + (v0.z + v0.w)) + ((v1.x + v1.y) + (v1.z + v1.w)) + ((v2.x + v2.y) + (v2.z + v2.w)) + ((v3.x + v3.y) + (v3.z + v3.w));
                sm += dpp_mov<0xB1>(sm); sm += dpp_mov<0x4E>(sm);
                if (qu == 0) SCP[t * 4 + q] = (q == 0) ? __builtin_amdgcn_rcpf(fmaxf(sm, 1e-24f)) : sm;
            }
            __syncthreads();
#if DBL & 0x4000
            { f32x2 Ssv[4]; Ssv[0] = S[0]; Ssv[1] = S[1]; Ssv[2] = S[2]; Ssv[3] = S[3];
            {
                f32x4 n0, n1, r0, r1, w0_, w1_, b0, b1, k0, k1; f32x3 sp; float vv;
                const unsigned char* pk_ = (const unsigned char*)A_WR + 32 * sj;
                const unsigned char* pv_ = (const unsigned char*)A_WR + 4 * srow;
                const unsigned char* ps_ = (const unsigned char*)SCP;
                constexpr int O_WR = 0, O_K2 = 8192, O_V = 16384, O_W = 24576, O_NKK = 32768, O_B = 40960, O_OUT = 57344;
#define RW2_LD_DOT(T) do { n0 = *(const f32x4*)(pk_ + O_NKK + (T) * 256); n1 = *(const f32x4*)(pk_ + O_NKK + (T) * 256 + 16); r0 = *(const f32x4*)(pk_ + O_WR + (T) * 256); r1 = *(const f32x4*)(pk_ + O_WR + (T) * 256 + 16); } while (0)
#define RW2_LD_UPD(T) do { w0_ = *(const f32x4*)(pk_ + O_W + (T) * 256); w1_ = *(const f32x4*)(pk_ + O_W + (T) * 256 + 16); b0 = *(const f32x4*)(pk_ + O_B + (T) * 256); b1 = *(const f32x4*)(pk_ + O_B + (T) * 256 + 16); \
                    k0 = *(const f32x4*)(pk_ + O_K2 + (T) * 256); k1 = *(const f32x4*)(pk_ + O_K2 + (T) * 256 + 16); vv = *(const float*)(pv_ + O_V + (T) * 256); sp = *(const f32x3*)(ps_ + (T) * 16); } while (0)
#define RW2_STEP(T) do { \
                    f32x2 sa2 = S[0] * (f32x2){n0.x, n0.y}; sa2 = S[1] * (f32x2){n0.z, n0.w} + sa2; sa2 = S[2] * (f32x2){n1.x, n1.y} + sa2; sa2 = S[3] * (f32x2){n1.z, n1.w} + sa2; \
                    f32x2 p2 = S[0] * (f32x2){r0.x, r0.y}; p2 = S[1] * (f32x2){r0.z, r0.w} + p2; p2 = S[2] * (f32x2){r1.x, r1.y} + p2; p2 = S[3] * (f32x2){r1.z, r1.w} + p2; \
                    __builtin_amdgcn_sched_barrier(0); RW2_LD_DOT((T) + 1); __builtin_amdgcn_sched_barrier(0); \
                    const float sa = sum8(sa2.x + sa2.y) * sp.x, p = sum8(p2.x + p2.y); \
                    const f32x2 sav = (f32x2){sa, sa}, vvv = (f32x2){vv, vv}; \
                    S[0] = S[0] * (f32x2){w0_.x, w0_.y} + (sav * (f32x2){b0.x, b0.y} + vvv * (f32x2){k0.x, k0.y}); \
                    S[1] = S[1] * (f32x2){w0_.z, w0_.w} + (sav * (f32x2){b0.z, b0.w} + vvv * (f32x2){k0.z, k0.w}); \
                    S[2] = S[2] * (f32x2){w1_.x, w1_.y} + (sav * (f32x2){b1.x, b1.y} + vvv * (f32x2){k1.x, k1.y}); \
                    S[3] = S[3] * (f32x2){w1_.z, w1_.w} + (sav * (f32x2){b1.z, b1.w} + vvv * (f32x2){k1.z, k1.w}); \
                    const float ov = p + sa * sp.y + vv * sp.z; \
                    __builtin_amdgcn_sched_barrier(0); RW2_LD_UPD((T) + 1); *(float*)(const_cast<unsigned char*>(pv_) + O_OUT + (T) * 256) = ov;        __builtin_amdgcn_sched_barrier(0); } while (0)
                RW2_LD_DOT(0); RW2_LD_UPD(0);
#pragma unroll 1
                for (int t4 = 0; t4 < 8; ++t4) {
                    RW2_STEP(0); RW2_STEP(1); RW2_STEP(2); RW2_STEP(3);
                    pk_ += 1024; pv_ += 1024; ps_ += 64;
                }
#undef RW2_LD_DOT
#undef RW2_LD_UPD
#undef RW2_STEP
            }
            S[0] = Ssv[0]; S[1] = Ssv[1]; S[2] = Ssv[2]; S[3] = Ssv[3]; asm volatile("" : "+v"(S[0]), "+v"(S[1]), "+v"(S[2]), "+v"(S[3])); __syncthreads(); }
#endif
            {
                f32x4 nn, rr, ww, bq, kq; f32x3 sp; f32x2 vv2;
                const unsigned char* pk_ = (const unsigned char*)A_WR + 16 * sj;
                const unsigned char* pv_ = (const unsigned char*)A_WR + 4 * srow;
                const unsigned char* ps_ = (const unsigned char*)SCP;
                constexpr int O_WR = 0, O_K2 = 8192, O_V = 16384, O_W = 24576, O_NKK = 32768, O_B = 40960, O_OUT = 57344;
#define SPL(x) ((f32x2){(x), (x)})
#define RW2_DPP1(R, C) "v_add_f32_dpp " R ", " R ", " R " " C " row_mask:0xf bank_mask:0xf bound_ctrl:1\n\t"
#define RW2_DPP4(C) RW2_DPP1("%0", C) RW2_DPP1("%1", C) RW2_DPP1("%2", C) RW2_DPP1("%3", C)
#define RW2_LD_DOT(T) do { nn = *(const f32x4*)(pk_ + O_NKK + (T) * 256); rr = *(const f32x4*)(pk_ + O_WR + (T) * 256); } while (0)
#define RW2_LD_UPD(T) do { ww = *(const f32x4*)(pk_ + O_W + (T) * 256); bq = *(const f32x4*)(pk_ + O_B + (T) * 256); kq = *(const f32x4*)(pk_ + O_K2 + (T) * 256); \
                    vv2 = *(const f32x2*)(pv_ + O_V + (T) * 256); sp = *(const f32x3*)(ps_ + (T) * 16); } while (0)
#define RW2_STEP(T) do { \
                    f32x2 sa2 = S[0] * SPL(nn.x); sa2 = S[1] * SPL(nn.y) + sa2; sa2 = S[2] * SPL(nn.z) + sa2; sa2 = S[3] * SPL(nn.w) + sa2; \
                    f32x2 p2 = S[0] * SPL(rr.x); p2 = S[1] * SPL(rr.y) + p2; p2 = S[2] * SPL(rr.z) + p2; p2 = S[3] * SPL(rr.w) + p2; \
                    __builtin_amdgcn_sched_barrier(0); RW2_LD_DOT((T) + 1); __builtin_amdgcn_sched_barrier(0); \
                    float sx = sa2.x, sy = sa2.y, px = p2.x, py = p2.y; \
                    asm volatile("s_nop 1\n\t" RW2_DPP4("quad_perm:[1,0,3,2]") RW2_DPP4("quad_perm:[2,3,0,1]") RW2_DPP4("row_half_mirror") RW2_DPP4("row_mirror") : "+v"(sx), "+v"(sy), "+v"(px), "+v"(py)); \
                    const f32x2 sav = (f32x2){sx, sy} * SPL(sp.x); \
                    S[0] = S[0] * SPL(ww.x) + (sav * SPL(bq.x) + vv2 * SPL(kq.x)); \
                    S[1] = S[1] * SPL(ww.y) + (sav * SPL(bq.y) + vv2 * SPL(kq.y)); \
                    S[2] = S[2] * SPL(ww.z) + (sav * SPL(bq.z) + vv2 * SPL(kq.z)); \
                    S[3] = S[3] * SPL(ww.w) + (sav * SPL(bq.w) + vv2 * SPL(kq.w)); \
                    const f32x2 ov2 = (f32x2){px, py} + sav * SPL(sp.y) + vv2 * SPL(sp.z); \
                    __builtin_amdgcn_sched_barrier(0); RW2_LD_UPD((T) + 1); *(f32x2*)(const_cast<unsigned char*>(pv_) + O_OUT + (T) * 256) = ov2;        __builtin_amdgcn_sched_barrier(0); } while (0)
                RW2_LD_DOT(0); RW2_LD_UPD(0);
#pragma unroll 1
                for (int t4 = 0; t4 < 8; ++t4) {
                    RW2_STEP(0); RW2_STEP(1); RW2_STEP(2); RW2_STEP(3);
                    pk_ += 1024; pv_ += 1024; ps_ += 64;
                }
#undef RW2_LD_DOT
#undef RW2_LD_UPD
#undef RW2_STEP
#undef SPL
#undef RW2_DPP1
#undef RW2_DPP4
            }
            __syncthreads();
            {
                const int t = c.tid >> 4, part = c.tid & 15;
                const f32x4 v = *(const f32x4*)(A_OUT + t * 64 + 4 * part);
                float s1 = (v.x + v.y) + (v.z + v.w), s2 = (v.x * v.x + v.y * v.y) + (v.z * v.z + v.w * v.w);
                s1 += dpp_mov<0xB1>(s1); s2 += dpp_mov<0xB1>(s2); s1 += dpp_mov<0x4E>(s1); s2 += dpp_mov<0x4E>(s2);
                s1 += dpp_mov<0x141>(s1); s2 += dpp_mov<0x141>(s2); s1 += dpp_mov<0x140>(s1); s2 += dpp_mov<0x140>(s2);
                if (part == 0) { const float mean = s1 * (1.f / 64.f), var = fmaxf(s2 * (1.f / 64.f) - mean * mean, 0.f); GN[t * 2] = mean; GN[t * 2 + 1] = __builtin_amdgcn_rsqf(var + 64e-5f); }
            }
            __syncthreads();
            {
                float ao[4], gm[4], gr[4], bs[4], av[4], ag[4];
                const float lw = CST[320 + l], lb = CST[384 + l];
#pragma unroll
                for (int i = 0; i < 4; ++i) { const int t = w + 8 * i, o = t * 64 + l; ao[i] = A_OUT[o]; gm[i] = GN[t * 2]; gr[i] = GN[t * 2 + 1]; bs[i] = SCP[t * 4 + 3]; av[i] = A_V[o]; ag[i] = A_G[o]; }
#pragma unroll
                for (int i = 0; i < 4; ++i) { const int t = w + 8 * i;
                    float y = (ao[i] - gm[i]) * gr[i] * lw + lb;
                    y = (y + bs[i] * av[i]) * ag[i];
                    if (b < wb) OUT[((size_t)b * SEQ + t0 + t) * ldo + coloff + hk] = (bf16)f2bf(y); }
            }
        }
#undef RW2_LOAD
    }
}
constexpr int S5B_BUP = 132 * 4, S5B_XP = 272;
constexpr int S5B_WAVE = 16 * S5B_BUP + 16 * S5B_XP;
__device__ __forceinline__ void wave_lds_sync() { __builtin_amdgcn_fence(__ATOMIC_RELEASE, "wavefront"); __builtin_amdgcn_wave_barrier(); __builtin_amdgcn_fence(__ATOMIC_ACQUIRE, "wavefront"); }
__device__ __forceinline__ float gelu_fast(float y) { const float u2 = 1.5957691216057308f * (y + 0.044715f * y * y * y); return y * __builtin_amdgcn_rcpf(1.f + __expf(-u2)); }
__device__ __forceinline__ void s5_phase2(const Ctx& c, const bf16* __restrict__ U, const S5P P, bf16* Z) {
    if (c.wave >= 4) return;
    float* BU = (float*)(c.lds + c.wave * S5B_WAVE); unsigned char* XB = c.lds + c.wave * S5B_WAVE + 16 * S5B_BUP;
    const int l = c.lane, n16 = l & 15, g = l >> 4;
#pragma unroll 1
    for (int item = c.bid; item < 256; item += c.nb) {
        const int b = item >> 5, grp = (item & 31) * 4 + c.wave;
        float lbr, lbi;
        { const float lr = fminf(P.lam_re[grp * 64 + l], -1e-4f), li = P.lam_im[grp * 64 + l], dt = expf(P.log_dt[grp]);
          const float e = expf(lr * dt); lbr = e * cosf(li * dt); lbi = e * sinf(li * dt);
          const float nr = lbr - 1.f, ni = lbi, den = 1.f / (lr * lr + li * li);
          BU[l] = (nr * lr + ni * li) * den; BU[64 + l] = (ni * lr - nr * li) * den; }
        wave_lds_sync();
        bf16x4 Bre[4], Bim[4];
#pragma unroll
        for (int nt = 0; nt < 4; ++nt) { const int p = 16 * nt + n16; const float cr = BU[p], ci = BU[64 + p];
            const f32x4 br = *(const f32x4*)(P.b_re + (size_t)(grp * 64 + p) * 16 + 4 * g), bi = *(const f32x4*)(P.b_im + (size_t)(grp * 64 + p) * 16 + 4 * g);
            u32x2 wr, wi; wr.x = pk2(cr * br.x - ci * bi.x, cr * br.y - ci * bi.y); wr.y = pk2(cr * br.z - ci * bi.z, cr * br.w - ci * bi.w);
            wi.x = pk2(cr * bi.x + ci * br.x, cr * bi.y + ci * br.y); wi.y = pk2(cr * bi.z + ci * br.z, cr * bi.w + ci * br.w);
            Bre[nt] = __builtin_bit_cast(bf16x4, wr); Bim[nt] = __builtin_bit_cast(bf16x4, wi); }
        wave_lds_sync();
        bf16x8 Cf[4];
#pragma unroll
        for (int kk = 0; kk < 4; ++kk) { const int p0 = 16 * kk + 4 * g;
            const f32x4 vr = *(const f32x4*)(P.c_re + (size_t)(grp * 16 + n16) * 64 + p0), vi = *(const f32x4*)(P.c_im + (size_t)(grp * 16 + n16) * 64 + p0);
            u32x4 w; w.x = pk2(vr.x, -vi.x); w.y = pk2(vr.y, -vi.y); w.z = pk2(vr.z, -vi.z); w.w = pk2(vr.w, -vi.w); Cf[kk] = __builtin_bit_cast(bf16x8, w); }
        bf16x4 Df; { const float dsk = P.d[grp * 16 + n16]; const int kq = n16 - 4 * g; u32x2 w; w.x = pk2(kq == 0 ? dsk : 0.f, kq == 1 ? dsk : 0.f); w.y = pk2(kq == 2 ? dsk : 0.f, kq == 3 ? dsk : 0.f); Df = __builtin_bit_cast(bf16x4, w); }
        f32x2 xs = (f32x2){0.f, 0.f};
        const bf16* ub = U + (size_t)b * SEQ * D + grp * 16;
        u32x2 ua[4];
#define S5B_LOAD(k, T0) do { ua[k] = *(const u32x2*)(ub + (size_t)((T0) + n16) * D + 4 * g); } while (0)
#pragma unroll
        for (int k = 0; k < 4; ++k) S5B_LOAD(k, 16 * k);
#pragma unroll 1
        for (int t0 = 0; t0 < SEQ; t0 += 64) {
#pragma unroll
            for (int k = 0; k < 4; ++k) {
                const int tb = t0 + 16 * k;
                const bf16x4 A = __builtin_bit_cast(bf16x4, ua[k]);
                { const int tn = (tb + 64 < SEQ) ? tb + 64 : tb; S5B_LOAD(k, tn); }
                const f32x4 yd = __builtin_amdgcn_mfma_f32_16x16x16bf16_1k(A, Df, (f32x4){0.f, 0.f, 0.f, 0.f}, 0, 0, 0);
#pragma unroll
                for (int nt = 0; nt < 4; ++nt) {
                    const f32x4 ar = __builtin_amdgcn_mfma_f32_16x16x16bf16_1k(A, Bre[nt], (f32x4){0.f, 0.f, 0.f, 0.f}, 0, 0, 0);
                    const f32x4 ai = __builtin_amdgcn_mfma_f32_16x16x16bf16_1k(A, Bim[nt], (f32x4){0.f, 0.f, 0.f, 0.f}, 0, 0, 0);
#pragma unroll
                    for (int r = 0; r < 4; ++r) *(f32x2*)(BU + (4 * g + r) * 132 + 2 * (16 * nt + n16)) = (f32x2){ar[r], ai[r]};
                }
                wave_lds_sync();
#pragma unroll 4
                for (int t = 0; t < 16; ++t) {
                    const f32x2 bu = *(const f32x2*)(BU + t * 132 + 2 * l);
                    const f32x2 tq = (f32x2){lbr, lbr} * xs + bu;
                    xs = (f32x2){-lbi, lbi} * (f32x2){xs.y, xs.x} + tq;
                    *(unsigned*)(XB + t * S5B_XP + l * 4) = pg8::cvt_pk_bf16(xs.x, xs.y);
                }
                wave_lds_sync();
                f32x4 y = (f32x4){0.f, 0.f, 0.f, 0.f};
#pragma unroll
                for (int kk = 0; kk < 4; ++kk) { const bf16x8 Ax = *(const bf16x8*)(XB + n16 * S5B_XP + (32 * kk + 8 * g) * 2); y = __builtin_amdgcn_mfma_f32_16x16x32_bf16(Ax, Cf[kk], y, 0, 0, 0); }
#pragma unroll
                for (int r = 0; r < 4; ++r) Z[((size_t)b * SEQ + tb + 4 * g + r) * D + grp * 16 + n16] = (bf16)f2bf(gelu_fast(y[r] + yd[r]));
                wave_lds_sync();
            }
        }
#undef S5B_LOAD
    }
}
struct Args { const void* in[45]; float* out; unsigned char* ws; int ph_lo, ph_hi; };
static_assert(sizeof(Args) == 45 * 8 + 8 + 8 + 8, "Args has no padding");
constexpr int PH_EVEN = 9, PH_ODD = 4, PH_COMMON = 13;
constexpr int NPHASES = 2 * (1 + PH_EVEN + PH_COMMON) + 2 * (1 + PH_ODD + PH_COMMON) + 1;

__global__ void __launch_bounds__(NTHR, 2) mega(Args args) {
    extern __shared__ __attribute__((aligned(16))) unsigned char lds[];
    volatile LAS unsigned* MISC = (volatile LAS unsigned*)((LAS unsigned char*)lds + MISC_OFF);
    if (threadIdx.x < 64) MISC[threadIdx.x] = 0u;
    __syncthreads();
    unsigned char* ws = args.ws;
    XcdBarrier bar = xcd_barrier_post((unsigned*)(ws + WS_CTL) + 4096, MISC + 8, gridDim.x);
    const int half = (int)gridDim.x >> 1;
    XcdBarrier bar2 = bar; if ((int)blockIdx.x >= half) bar2 = xcd_barrier_post((unsigned*)(ws + WS_CTL) + 8192, MISC + 10, gridDim.x - half);
    const int lo = args.ph_lo, hi = args.ph_hi;
    int pid = 0;
#define PH_BEGIN if (pid >= lo && pid < hi) { Ctx c; { int t_ = threadIdx.x, b_ = blockIdx.x; asm volatile("" : "+v"(t_)); asm volatile("" : "+s"(b_)); c.lds = lds; c.tid = t_; c.lane = t_ & 63; c.wave = __builtin_amdgcn_readfirstlane(t_ >> 6); c.bid = b_; { int n_ = gridDim.x; asm volatile("" : "+s"(n_)); c.nb = n_; } c.gw = c.bid * NWAVES + c.wave; c.ngw = c.nb * NWAVES; }
#define PH_END } if (pid >= lo && pid + 1 < hi) { xcd_barrier(bar); if (DBL & 2048) xcd_barrier(bar); } ++pid;
#define IN_F(i) (*(const float* const __attribute__((address_space(4)))*)(KARGS() + 8 * (i)))

    typedef const unsigned char __attribute__((address_space(4)))* kptr_t;
#define KARGS() ({ kptr_t p_ = (kptr_t)__builtin_amdgcn_kernarg_segment_ptr(); asm volatile("" : "+s"(p_)); p_; })
#define WSP(off) ((*(unsigned char* const __attribute__((address_space(4)))*)(KARGS() + 368)) + (off))
#define X ((float*)(*(float* const __attribute__((address_space(4)))*)(KARGS() + 360)))
#define ROPEA ((float*)WSP(WS_ROPEA))
#define ROPEI ((float*)WSP(WS_ROPEI))
#define KVBIG ((bf16*)WSP(WS_KVBIG))
#define WKV ((bf16*)WSP(WS_WKV))
#define W_IN ((bf16*)WSP(WS_WMIX + WMIX_IN))
#define WQ ((bf16*)WSP(WS_WMIX + WMIX_Q))
#define WOUT ((bf16*)WSP(WS_WMIX + WMIX_OUT))
#define WO_IN ((bf16*)WSP(WS_WMIX + WMIX_O_IN))
#define WO_GLU ((bf16*)WSP(WS_WMIX + WMIX_O_GLU))
#define WO_OUT ((bf16*)WSP(WS_WMIX + WMIX_O_OUT))
#define WXQ ((bf16*)WSP(WS_WXQ))
#define WXO ((bf16*)WSP(WS_WXO))
#define WUP ((bf16*)WSP(WS_WUP))
#define WDN ((bf16*)WSP(WS_WDN))
#define CQN ((bf16*)WSP(WS_CQN))
#define KF ((bf16*)WSP(WS_KF))
#define KIDX ((bf16*)WSP(WS_KIDX))
#define WIDX ((float*)WSP(WS_WIDX))
#define SEL ((bf16*)WSP(WS_SEL))
#define Hb ((bf16*)WSP(WS_R1))
#define SC ((float*)WSP(WS_R1))
#define HID ((bf16*)WSP(WS_R1))
#define Ub ((bf16*)WSP(WS_R1))
#define YC ((bf16*)WSP(WS_R1 + (size_t)M * D * 2))
#define XN ((bf16*)WSP(WS_R2))
#define QALL ((bf16*)X)
#define OLY ((bf16*)WSP(WS_R3))
#define Zb ((bf16*)WSP(WS_R3))
#define XQ ((bf16*)WSP(WS_R3))
#define XO ((bf16*)WSP(WS_R3 + (size_t)M * 512 * 2))
#define MEMN ((bf16*)WSP(WS_R3))
    LAS unsigned char* glds = (LAS unsigned char*)lds;

#define RS_A ((unsigned long long*)WSP(WS_CTL + 131072))
#define RS_B ((unsigned long long*)WSP(WS_CTL + 393216))
#define RS_C ((unsigned long long*)WSP(WS_CTL + 655360))
    for (int layer = 0; layer < DEPTH; ++layer) {
        const int li = layer >> 1;
        PH_BEGIN
#define ROTC(r_) Ctx cr = c; cr.gw = (c.gw + c.ngw - ((r_) % c.ngw)) % c.ngw
            if ((layer & 1) == 0) {
                conv_mat(c, IN_F(13) + (size_t)li * 2048 * EVEN_COLS, 2048, EVEN_COLS, EVEN_COLS, HC, W_IN, 2048, 0, 0, IN_F(3) + layer * D);
                build_wql(c, IN_F(18) + (size_t)li * 512 * 1024, IN_F(19) + (size_t)li * 256 * 768, WQ);
                for (int h = 0; h < 8; ++h) { ROTC(4352 + 8 * h); conv_mat(cr, IN_F(18) + (size_t)li * 512 * 1024 + h * 128, 512, 1024, 32, 32, WQ, 512, 2048 + h * 32, 0); }
                { ROTC(4352 + 64); conv_mat(cr, IN_F(21) + (size_t)li * 512 * 1024, 512, 1024, 1024, 1024, WQ, 512, 2304, 0); }
                build_wout(c, IN_F(20) + (size_t)li * 256 * 1024, IN_F(14) + (size_t)li * 2048 * 2048, WOUT);
                { ROTC(4352 + 64 + 256); conv_mat(cr, IN_F(14) + (size_t)li * 2048 * 2048 + (size_t)1024 * 2048, 1024, 2048, 2048, 2048, WOUT, OC, 0, 2048); }
                { ROTC(4352 + 64 + 256 + 1024); conv_mat(cr, IN_F(8) + (size_t)layer * 2048 * 512, 2048, 512, 512, 512, WXQ, 2048, 0, 0, IN_F(4) + layer * D); }
                { ROTC(4352 + 64 + 256 + 1024 + 512); conv_mat(cr, IN_F(10) + (size_t)layer * 512 * 2048, 512, 2048, 2048, 2048, WXO, 512, 0, 0); }
            } else {
                conv_mat(c, IN_F(33) + (size_t)li * 2048 * 2048, 2048, 2048, 2048, 2048, WO_IN, 2048, 0, 0, IN_F(3) + layer * D);
            }
#undef ROTC
            { unsigned long long* ra = RS_A; unsigned long long* rb = RS_B; for (int i = c.bid * NTHR + c.tid; i < M; i += c.nb * NTHR) { ra[i] = 0ull; rb[i] = 0ull; } }
            if (layer == 0) {
                for (int l2 = 0; l2 < 4; ++l2) {
                    { Ctx cr = c; cr.gw = (c.gw + c.ngw - ((l2 * 1024) % c.ngw)) % c.ngw; conv_mat(cr, IN_F(9) + (size_t)l2 * 2048 * 1024, 2048, 1024, 1024, 1024, WKV, 2048, l2 * 1024, 0); }
                    norm_rows_bf16(c, IN_F(1), IN_F(5) + l2 * D, MEMN + (size_t)l2 * MEMR * D, MEMR);
                }
                rope_tables(c, (const int*)IN_F(2), ROPEA, ROPEI);
                cast_rows_ss(c, IN_F(0), XN, RS_C, M);
            }
#if DBL & 1
            __syncthreads();
            if ((layer & 1) == 0) {
                conv_mat(c, IN_F(13) + (size_t)li * 2048 * EVEN_COLS, 2048, EVEN_COLS, EVEN_COLS, HC, W_IN, 2048, 0, 0, IN_F(3) + layer * D);
                build_wql(c, IN_F(18) + (size_t)li * 512 * 1024, IN_F(19) + (size_t)li * 256 * 768, WQ);
                for (int h = 0; h < 8; ++h) conv_mat(c, IN_F(18) + (size_t)li * 512 * 1024 + h * 128, 512, 1024, 32, 32, WQ, 512, 2048 + h * 32, 0);
                conv_mat(c, IN_F(21) + (size_t)li * 512 * 1024, 512, 1024, 1024, 1024, WQ, 512, 2304, 0);
                build_wout(c, IN_F(20) + (size_t)li * 256 * 1024, IN_F(14) + (size_t)li * 2048 * 2048, WOUT);
                conv_mat(c, IN_F(14) + (size_t)li * 2048 * 2048 + (size_t)1024 * 2048, 1024, 2048, 2048, 2048, WOUT, OC, 0, 2048);
            } else {
                conv_mat(c, IN_F(33) + (size_t)li * 2048 * 2048, 2048, 2048, 2048, 2048, WO_IN, 2048, 0, 0, IN_F(3) + layer * D);
                conv_mat(c, IN_F(43) + (size_t)li * 2048 * 2048, 2048, 2048, 2048, 2048, WO_GLU, 2048, 0, 0);
                conv_mat(c, IN_F(34) + (size_t)li * 2048 * 2048, 2048, 2048, 2048, 2048, WO_OUT, 2048, 0, 0);
            }
            conv_mat(c, IN_F(8) + (size_t)layer * 2048 * 512, 2048, 512, 512, 512, WXQ, 2048, 0, 0, IN_F(4) + layer * D);
            conv_mat(c, IN_F(10) + (size_t)layer * 512 * 2048, 512, 2048, 2048, 2048, WXO, 512, 0, 0);
            { unsigned long long* ra = RS_A; unsigned long long* rb = RS_B; for (int i = c.bid * NTHR + c.tid; i < M; i += c.nb * NTHR) { ra[i] = 0ull; rb[i] = 0ull; } }
            if (layer == 0) {
                for (int l2 = 0; l2 < 4; ++l2) {
                    conv_mat(c, IN_F(9) + (size_t)l2 * 2048 * 1024, 2048, 1024, 1024, 1024, WKV, 2048, l2 * 1024, 0);
                    norm_rows_bf16(c, IN_F(1), IN_F(5) + l2 * D, MEMN + (size_t)l2 * MEMR * D, MEMR);
                }
                rope_tables(c, (const int*)IN_F(2), ROPEA, ROPEI);
                cast_rows_ss(c, IN_F(0), XN, RS_C, M);
            }
#endif
        PH_END
        if ((layer & 1) == 0) {
            PH_BEGIN
                { pg8::Gemm g{XN, W_IN, 2048, 2048, 2048}; pg8::StaticOrder S; S.init(128, HC / 256, c.nb, c.bid); pg8::EpiBf16<0> E{Hb, HC, RS_C};
                  pg8::gemm_phase<pg8::EpiBf16<0>, pg8::StaticOrder, true, true>(glds, g, S, E);
                  if (DBL & 1024) { __syncthreads(); pg8::gemm_phase<pg8::EpiBf16<0>, pg8::StaticOrder, true, true>(glds, g, S, E); } }
                if (layer == 0) { __syncthreads(); pg8::Gemm g{MEMN, WKV, 2048, 2048, 2048}; pg8::KvOrder S{c.nb, (c.bid + (c.nb >> 1)) % c.nb};        pg8::EpiBf16<0> E{KVBIG, 4096, nullptr};
                  pg8::gemm_phase<pg8::EpiBf16<0>, pg8::KvOrder, true, true>(glds, g, S, E); }
                else if (c.bid >= half) {
                    __syncthreads(); Ctx d = c; d.bid = c.bid - half; d.nb = c.nb - half; d.gw = d.bid * NWAVES + d.wave; d.ngw = d.nb * NWAVES;
                    conv_mat(d, IN_F(12) + (size_t)layer * FFN * 2048, FFN, 2048, 2048, 2048, WDN, FFN, 0, 0); }
            PH_END
            PH_BEGIN
                rwkv_lora_prep(c, Hb, IN_F(22) + li * B_COLS, (bf16*)WSP(WS_END + 96 * MiB));
            PH_END
            PH_BEGIN
                if (c.bid < half) {
                    Ctx r = c; r.nb = half; r.ngw = half * NWAVES;
                    const RwkvP P{IN_F(22) + li * B_COLS, IN_F(23) + li * 1024, IN_F(24) + (size_t)li * 65536, IN_F(25) + li * 1024, IN_F(26) + (size_t)li * 65536, IN_F(27) + (size_t)li * 163840,
                                  IN_F(28) + li * 1024, IN_F(29) + li * 1024, IN_F(30) + li * 1024, IN_F(31) + li * 1024, IN_F(32) + li * 1024};
#if DIAG == 4
                    rwkv_phase(r, Hb, P, OLY);
                    rwkv_phase2(r, Hb, (const bf16*)WSP(WS_END + 96 * MiB), P, (bf16*)WSP(WS_END + 116 * MiB), 1024, 0, 1);
#else
                    rwkv_phase2(r, Hb, (const bf16*)WSP(WS_END + 96 * MiB), P, OLY, OC, 2048);
#endif
                    __syncthreads();
                    if (layer == 0) conv_mat(r, IN_F(12) + (size_t)layer * FFN * 2048, FFN, 2048, 2048, 2048, WDN, FFN, 0, 0);
                } else {
                    Ctx d = c; d.bid = c.bid - half; d.nb = c.nb - half; d.gw = d.bid * NWAVES + d.wave; d.ngw = d.nb * NWAVES;
                    dsa_prep(d, Hb, IN_F(15) + li * 512, IN_F(16) + li * 256, IN_F(17) + li * 64, ROPEA, ROPEI, CQN, KF, KIDX, WIDX);
                    xcd_barrier(bar2);
                    { pg8::Gemm g{CQN, WQ, 512, 512, 512}; pg8::StaticOrder S; S.init(128, QC / 256, d.nb, d.bid); pg8::EpiBf16<0> E{QALL, QC, nullptr};
                      pg8::gemm_phase<pg8::EpiBf16<0>, pg8::StaticOrder, true, true>(glds, g, S, E); }
                    xcd_barrier(bar2);
                    idx_topk_mfma(d, QALL, KIDX, WIDX, ROPEI, (float*)(d.bid < 32 ? WSP(WS_CQN + (size_t)d.bid * MiB) : WSP(WS_END + (size_t)(d.bid - 32) * MiB)), SEL, 256);
                    conv_mat(d, IN_F(11) + (size_t)layer * 2048 * FFN, 2048, FFN, FFN, FFN, WUP, 2048, 0, 0, IN_F(6) + layer * D);
                    xcd_barrier(bar2);
                    if (d.bid == 0 && c.tid == 0) __hip_atomic_store((unsigned*)WSP(WS_CTL) + 12288 + 64 * (2 + li), 1u, __ATOMIC_RELAXED, __HIP_MEMORY_SCOPE_AGENT);
                }
                if (c.bid < half) {
                    if (c.tid == 0) { unsigned* fl = (unsigned*)WSP(WS_CTL) + 12288 + 64 * (2 + li); unsigned sp = 0;
                        while (__hip_atomic_load(fl, __ATOMIC_RELAXED, __HIP_MEMORY_SCOPE_AGENT) == 0u) { __builtin_amdgcn_s_sleep(8); if (++sp > (1u << 22)) break; } }
                    __syncthreads();
                    __builtin_amdgcn_fence(__ATOMIC_ACQUIRE, "agent"); asm volatile("s_waitcnt vmcnt(0)" ::: "memory");
                }
                dsa_attn_queue(c, QALL, KF, SEL, ROPEA, OLY, (unsigned*)WSP(WS_CTL) + 12288 + 64 * li, MISC + 12);
            PH_END
#if DBL & 32
            PH_BEGIN
                if (c.bid < half) {
                    Ctx r = c; r.nb = half; r.ngw = half * NWAVES;
                    const RwkvP P{IN_F(22) + li * B_COLS, IN_F(23) + li * 1024, IN_F(24) + (size_t)li * 65536, IN_F(25) + li * 1024, IN_F(26) + (size_t)li * 65536, IN_F(27) + (size_t)li * 163840,
                                  IN_F(28) + li * 1024, IN_F(29) + li * 1024, IN_F(30) + li * 1024, IN_F(31) + li * 1024, IN_F(32) + li * 1024};
                    rwkv_phase2(r, Hb, (const bf16*)WSP(WS_END + 96 * MiB), P, OLY, OC, 2048);
                }
            PH_END
#endif
#if DBL & 8
            PH_BEGIN
                if (c.bid >= half) {
                    Ctx d = c; d.bid = c.bid - half; d.nb = c.nb - half; d.gw = d.bid * NWAVES + d.wave; d.ngw = d.nb * NWAVES;
                    idx_topk_mfma(d, QALL, KIDX, WIDX, ROPEI, (float*)(d.bid < 32 ? WSP(WS_CQN + (size_t)d.bid * MiB) : WSP(WS_END + (size_t)(d.bid - 32) * MiB)), SEL, 256);
                }
            PH_END
#endif
#if DIAG == 4
            PH_BEGIN
                diag_cmp_bf16(c, OLY + 2048, OC, (bf16*)WSP(WS_END + 116 * MiB), 1024, SEQ, 1024, (float*)WSP(WS_CTL + 65536));
            PH_END
#endif
#if DIAG == 7 || DIAG == 8
            PH_BEGIN
                q_rope_fix(c, QALL, ROPEA, ROPEI);
            PH_END
#endif
#if DIAG == 7
            PH_BEGIN
                if (c.bid >= half) { Ctx d = c; d.bid = c.bid - half; d.nb = c.nb - half; d.gw = d.bid * NWAVES + d.wave; d.ngw = d.nb * NWAVES;
                    idx_topk_v1(d, QALL, KIDX, WIDX, (float*)(d.bid < 32 ? WSP(WS_CQN + (size_t)d.bid * MiB) : WSP(WS_END + (size_t)(d.bid - 32) * MiB)), (bf16*)WSP(WS_END + 116 * MiB), 128); }
            PH_END
            PH_BEGIN
                diag_cmp_sel(c, SEL, (bf16*)WSP(WS_END + 116 * MiB), 4, (float*)WSP(WS_CTL + 65536));
            PH_END
#endif
#if DIAG == 8
            PH_BEGIN
                dsa_attn_simple(c, QALL, KF, SEL, (bf16*)WSP(WS_END + 116 * MiB), 1024);
            PH_END
            PH_BEGIN
                diag_cmp_bf16(c, OLY, OC, (bf16*)WSP(WS_END + 116 * MiB), OC, 1024, 2048, (float*)WSP(WS_CTL + 65536));
            PH_END
#endif
            PH_BEGIN
                { pg8::Gemm g{OLY, WOUT, OC, OC, OC}; pg8::StaticOrder S; S.init(128, 8, c.nb, c.bid); pg8::EpiRes E{XN, D, RS_A};
                  pg8::gemm_phase<pg8::EpiRes, pg8::StaticOrder, true, true>(glds, g, S, E); }
            PH_END
        } else {
            PH_BEGIN
                { pg8::Gemm g{XN, WO_IN, 2048, 2048, 2048}; pg8::StaticOrder S; S.init(128, 8, c.nb, c.bid); pg8::EpiBf16<0> E{Ub, D, RS_C};
                  pg8::gemm_phase<pg8::EpiBf16<0>, pg8::StaticOrder, true, true>(glds, g, S, E);
                  if (DBL & 1024) { __syncthreads(); pg8::gemm_phase<pg8::EpiBf16<0>, pg8::StaticOrder, true, true>(glds, g, S, E); } }
            PH_END
            PH_BEGIN
                { const S5P P{IN_F(35) + li * 8192, IN_F(36) + li * 8192, IN_F(37) + li * 128, IN_F(38) + (size_t)li * 131072, IN_F(39) + (size_t)li * 131072, IN_F(40) + (size_t)li * 131072, IN_F(41) + (size_t)li * 131072, IN_F(42) + li * D};
                  s5_phase2(c, Ub, P, Zb); }
                if (c.wave >= 4) {
                    Ctx v = c; v.lds = c.lds + 65536 - 4 * 8704; v.gw = c.bid * 4 + (c.wave - 4); v.ngw = c.nb * 4;
                    conv_mat(v, IN_F(11) + (size_t)layer * 2048 * FFN, 2048, FFN, FFN, FFN, WUP, 2048, 0, 0, IN_F(6) + layer * D);
                    conv_mat(v, IN_F(12) + (size_t)layer * FFN * 2048, FFN, 2048, 2048, 2048, WDN, FFN, 0, 0);
                    conv_mat(v, IN_F(43) + (size_t)li * 2048 * 2048, 2048, 2048, 2048, 2048, WO_GLU, 2048, 0, 0);
                    conv_mat(v, IN_F(34) + (size_t)li * 2048 * 2048, 2048, 2048, 2048, 2048, WO_OUT, 2048, 0, 0);
                    conv_mat(v, IN_F(8) + (size_t)layer * 2048 * 512, 2048, 512, 512, 512, WXQ, 2048, 0, 0, IN_F(4) + layer * D);
                    { Ctx vr = v; vr.gw = (v.gw + v.ngw - (512 % v.ngw)) % v.ngw; conv_mat(vr, IN_F(10) + (size_t)layer * 512 * 2048, 512, 2048, 2048, 2048, WXO, 512, 0, 0); }
                }
            PH_END
#if DIAG == 5
            PH_BEGIN
                { const S5P P{IN_F(35) + li * 8192, IN_F(36) + li * 8192, IN_F(37) + li * 128, IN_F(38) + (size_t)li * 131072, IN_F(39) + (size_t)li * 131072, IN_F(40) + (size_t)li * 131072, IN_F(41) + (size_t)li * 131072, IN_F(42) + li * D};
                  s5_phase(c, Ub, P, YC); }
            PH_END
            PH_BEGIN
                diag_cmp_bf16(c, YC, D, Zb, D, M, D, (float*)WSP(WS_CTL + 65536));
            PH_END
#endif
            PH_BEGIN
                { pg8::Gemm g{Zb, WO_GLU, 2048, 2048, 2048}; pg8::StaticOrder S; S.init(128, 8, c.nb, c.bid); pg8::EpiGlu E{Zb, YC, D, IN_F(44) + li * D};
                  pg8::gemm_phase<pg8::EpiGlu, pg8::StaticOrder, true, true>(glds, g, S, E); }
            PH_END
            PH_BEGIN
                { pg8::Gemm g{YC, WO_OUT, 2048, 2048, 2048}; pg8::StaticOrder S; S.init(128, 8, c.nb, c.bid); pg8::EpiRes E{XN, D, RS_A};
                  pg8::gemm_phase<pg8::EpiRes, pg8::StaticOrder, true, true>(glds, g, S, E); }
            PH_END
        }
        PH_BEGIN
            { unsigned long long* rc = RS_C; for (int i = c.bid * NTHR + c.tid; i < M; i += c.nb * NTHR) rc[i] = 0ull; }
            { pg8::Gemm g{XN, WXQ, 2048, 2048, 2048}; pg8::StaticOrder S; S.init(128, 2, c.nb, c.bid); pg8::EpiBf16<0> E{XQ, 512, RS_A};
              pg8::gemm_phase<pg8::EpiBf16<0>, pg8::StaticOrder, true, true>(glds, g, S, E); }
        PH_END
        PH_BEGIN
            xattn_mfma(c, XQ, KVBIG, layer, XO); if (DBL & 128) { asm volatile("" ::: "memory"); xattn_mfma(c, XQ, KVBIG, layer, XO); }
        PH_END
        PH_BEGIN
            { pg8::Gemm g{XO, WXO, 512, 512, 512}; pg8::StaticOrder S; S.init(128, 8, c.nb, c.bid); pg8::EpiRes E{XN, D, RS_B};
              pg8::gemm_phase<pg8::EpiRes, pg8::StaticOrder, true, true>(glds, g, S, E); }
        PH_END
        for (int q = 0; q < 5; ++q) {
            PH_BEGIN
                if (q > 0) { const int qd = q - 1; bf16* hid = HID + (size_t)(qd & 1) * 8192 * FFN;
                    pg8::Gemm g{hid, WDN, FFN, FFN, FFN}; pg8::StaticOrder S; S.init(32, 8, c.nb, c.bid); pg8::EpiRes E{XN + (size_t)qd * 8192 * D, D, RS_C + qd * 8192};
                    pg8::gemm_phase<pg8::EpiRes, pg8::StaticOrder, true, true>(glds, g, S, E); __syncthreads(); }
                if (q < 4) { bf16* hid = HID + (size_t)(q & 1) * 8192 * FFN;
                    pg8::Gemm g{XN + (size_t)q * 8192 * D, WUP, 2048, 2048, 2048}; pg8::StaticOrder S; S.init(32, 32, c.nb, c.bid); pg8::EpiBf16<1> E{hid, FFN, RS_B + q * 8192};
                    pg8::gemm_phase<pg8::EpiBf16<1>, pg8::StaticOrder, true, true>(glds, g, S, E); }
            PH_END
        }
    }
    PH_BEGIN
        scale_rows_out(c, XN, IN_F(7), RS_C, X, M);
    PH_END
#if DIAG
    PH_BEGIN
        { const float* dg = (const float*)WSP(WS_CTL + 65536); const float sc = 1.f + sqrtf(100.f * dg[0] / fmaxf(dg[1], 1e-30f));
          float* xo = X; for (size_t i = (size_t)c.bid * NTHR + c.tid; i < (size_t)M * D; i += (size_t)c.nb * NTHR) xo[i] *= sc; }
    PH_END
#endif
#undef PH_BEGIN
#undef PH_END
#undef IN_F
#undef X
}

extern "C" void kernel_launch(void* const* d_in, const int* in_sizes, int n_in, void* d_out, int out_size, void* d_ws, size_t ws_size, hipStream_t stream) {
    static int grid = 0;
    if (grid == 0) {
        if (n_in != 45 || out_size != M * D || ws_size < WS_END + 116 * MiB) { fprintf(stderr, "kernel_launch: unexpected shapes (n_in %d, out %d, ws %zu, need %zu)\n", n_in, out_size, ws_size, (size_t)WS_END); grid = -1; return; }
        int dev = 0, cus = 0, per_cu = 0;
        if (hipGetDevice(&dev) != hipSuccess || hipDeviceGetAttribute(&cus, hipDeviceAttributeMultiprocessorCount, dev) != hipSuccess) { grid = -1; return; }
        if (hipFuncSetAttribute((const void*)mega, hipFuncAttributeMaxDynamicSharedMemorySize, LDS_BYTES) != hipSuccess) { fprintf(stderr, "kernel_launch: hipFuncSetAttribute failed\n"); grid = -1; return; }
        if (hipOccupancyMaxActiveBlocksPerMultiprocessor(&per_cu, (const void*)mega, NTHR, LDS_BYTES) != hipSuccess || per_cu < 1) fprintf(stderr, "kernel_launch: occupancy query reports %d\n", per_cu);
        (void)hipGetLastError();
        grid = cus;
    }
    if (grid < 0) return;
    (void)hipMemsetAsync((char*)d_ws + WS_CTL, 0, CTL_BYTES, stream);
    Args a{};
    for (int i = 0; i < 45; ++i) a.in[i] = d_in[i];
    a.out = (float*)d_out; a.ws = (unsigned char*)d_ws;
#if MK_ONE_LAUNCH
    a.ph_lo = 0; a.ph_hi = 1 << 20;
    hipLaunchKernelGGL(mega, dim3(grid), dim3(NTHR), LDS_BYTES, stream, a);
#else
    for (int p = 0; p < NPHASES; ++p) { a.ph_lo = p; a.ph_hi = p + 1; hipLaunchKernelGGL(mega, dim3(grid), dim3(NTHR), LDS_BYTES, stream, a); }
#endif
}
```

```cpp
#include <hip/hip_runtime.h>
#include <cstdio>
#include <cstdint>

#ifndef DIAG
#define DIAG 0
#endif
#ifndef ATTN_SPLIT
#define ATTN_SPLIT 0
#endif
#ifndef DBL
#define DBL 0
#endif
#ifndef MK_ONE_LAUNCH
#define MK_ONE_LAUNCH 1
#endif

constexpr int D = 2048, NB = 8, SEQ = 4096, M = NB * SEQ, DEPTH = 4;
constexpr int HC = 4352;
constexpr int EVEN_COLS = 4240, A_COLS = 880, B_COLS = 3360;
constexpr int QC = 3328;
constexpr int OC = 3072;
constexpr int KFW = 288;
constexpr int FFN = 8192;
constexpr int MEMR = NB * 256;
constexpr float NORM_EPS = 1e-5f;
constexpr size_t SC_PER_BATCH = (size_t)4096 * 64 * 65 / 2;

typedef unsigned short bf16;
typedef float f32x4 __attribute__((ext_vector_type(4)));
typedef unsigned u32x4 __attribute__((ext_vector_type(4)));
typedef unsigned u32x2 __attribute__((ext_vector_type(2)));
typedef float f32x2 __attribute__((ext_vector_type(2)));
typedef float f32x3 __attribute__((ext_vector_type(3)));
#define LAS __attribute__((address_space(3)))

constexpr size_t MiB = 1u << 20;
constexpr size_t al256(size_t x) { return (x + 255) & ~(size_t)255; }
constexpr size_t WS_CTL = 0, CTL_BYTES = 1 * MiB;
constexpr size_t WS_ROPEA = WS_CTL + CTL_BYTES;
constexpr size_t WS_ROPEI = WS_ROPEA + (size_t)M * 32 * 4;
constexpr size_t WS_KVBIG = WS_ROPEI + (size_t)M * 16 * 4;
constexpr size_t WS_WKV = WS_KVBIG + (size_t)8192 * 4096 * 2;
constexpr size_t WS_WMIX = WS_WKV + (size_t)4096 * 2048 * 2;
constexpr size_t WMIX_IN = 0, WMIX_Q = (size_t)HC * 2048 * 2, WMIX_OUT = WMIX_Q + (size_t)QC * 512 * 2, WMIX_BYTES = WMIX_OUT + (size_t)2048 * OC * 2;
constexpr size_t WMIX_O_IN = 0, WMIX_O_GLU = (size_t)2048 * 2048 * 2, WMIX_O_OUT = 2 * WMIX_O_GLU;
constexpr size_t WS_WXQ = al256(WS_WMIX + WMIX_BYTES);
constexpr size_t WS_WXO = WS_WXQ + (size_t)512 * 2048 * 2;
constexpr size_t WS_WUP = WS_WXO + (size_t)2048 * 512 * 2;
constexpr size_t WS_WDN = WS_WUP + (size_t)FFN * 2048 * 2;
constexpr size_t WS_CQN = WS_WDN + (size_t)2048 * FFN * 2;
constexpr size_t WS_KF = WS_CQN + (size_t)M * 512 * 2;
constexpr size_t WS_KIDX = WS_KF + (size_t)M * KFW * 2;
constexpr size_t WS_WIDX = WS_KIDX + (size_t)M * 64 * 2;
constexpr size_t WS_SEL = WS_WIDX + (size_t)M * 16 * 4;
constexpr size_t WS_R1 = al256(WS_SEL + (size_t)M * 256 * 2);
constexpr size_t R1_BYTES = (size_t)M * HC * 2;
constexpr size_t WS_R2 = WS_R1 + R1_BYTES;
constexpr size_t R2_BYTES = (size_t)M * QC * 2;
constexpr size_t WS_R3 = WS_R2 + R2_BYTES;
constexpr size_t R3_BYTES = (size_t)M * OC * 2;
constexpr size_t WS_END = WS_R3 + R3_BYTES;
static_assert(SC_PER_BATCH * NB * 4 <= R1_BYTES, "scores fit R1");
static_assert((size_t)8192 * FFN * 2 <= R1_BYTES && (size_t)M * 2048 * 2 * 2 <= R1_BYTES, "R1 overlays");

__device__ __forceinline__ float bf2f(unsigned v) { return __uint_as_float(v << 16); }
__device__ __forceinline__ unsigned f2bf(float f) { unsigned u = __float_as_uint(f); return (u + 0x7fffu + ((u >> 16) & 1u)) >> 16; }
__device__ __forceinline__ unsigned pk2(float lo, float hi) { return f2bf(lo) | (f2bf(hi) << 16); }
__device__ __forceinline__ float wave_sum(float v) {
#pragma unroll
    for (int o = 1; o < 64; o <<= 1) v += __shfl_xor(v, o);
    return v;
}
__device__ __forceinline__ float wave_max(float v) {
#pragma unroll
    for (int o = 1; o < 64; o <<= 1) v = fmaxf(v, __shfl_xor(v, o));
    return v;
}
__device__ __forceinline__ void unpack8(const u32x4 w, float* f) {
    f[0] = __uint_as_float(w.x << 16); f[1] = __uint_as_float(w.x & 0xffff0000u); f[2] = __uint_as_float(w.y << 16); f[3] = __uint_as_float(w.y & 0xffff0000u);
    f[4] = __uint_as_float(w.z << 16); f[5] = __uint_as_float(w.z & 0xffff0000u); f[6] = __uint_as_float(w.w << 16); f[7] = __uint_as_float(w.w & 0xffff0000u);
}
__device__ __forceinline__ float sigmoidf_(float x) { return __builtin_amdgcn_rcpf(1.f + __expf(-x)); }
namespace pg8 {
#define PG8_LAS __attribute__((address_space(3)))
typedef unsigned short bf16_t;
typedef short bf16x8 __attribute__((ext_vector_type(8)));
typedef float f32x4 __attribute__((ext_vector_type(4)));
typedef unsigned u32x4 __attribute__((ext_vector_type(4)));
constexpr int BM = 256, BK = 64, HALF = 128, HTB = HALF * BK * 2, STAGE_BYTES = 8 * HTB, NXCD = 8, WGM = 4;

__host__ __device__ __forceinline__ int lds_byte(int r, int c) { const int st = (r >> 4) * 2 + (c >> 5), rr = r & 15, cc = c & 31, ob = rr * 64 + cc * 2; return st * 1024 + (ob ^ (((ob >> 9) & 1) << 5)); }
__host__ __device__ __forceinline__ void stage_rc(int b, int& R, int& C) { const int st = b / 1024, sb = b % 1024, swz = sb ^ (((sb >> 9) & 1) << 5); R = (st >> 1) * 16 + swz / 64; C = (st & 1) * 32 + (swz % 64) / 2; }
__host__ __device__ __forceinline__ int perm32(int rho) { const int n = rho >> 4, i = rho & 15; return 8 * (i >> 2) + 4 * n + (i & 3); }

struct Unit { int pm, pn; };
struct Gemm { const bf16_t* A; const bf16_t* Bt; int lda, ldb, K, pad; };

struct StaticOrder {
    int nM, nN, nwg, G, c;
    __host__ __device__ void init(int nM_, int nN_, int G_, int c_) { nM = nM_; nN = nN_; nwg = nM * nN; G = G_; c = c_; }
    __host__ __device__ bool next(int i, Unit& u) const {
        const long L = (long)i * G + c; if (L >= nwg) return false;
        int wgid = (int)L; { const int q = nwg / NXCD, r = nwg % NXCD, xcd = wgid % NXCD, off = wgid / NXCD; wgid = (xcd < r ? xcd * (q + 1) : r * (q + 1) + (xcd - r) * q) + off; }
        const int nig = WGM * nN, gid = wgid / nig, fm = gid * WGM, gsz = (nM - fm) < WGM ? (nM - fm) : WGM;
        u.pm = fm + ((wgid % nig) % gsz); u.pn = (wgid % nig) / gsz; return true;
    }
    __device__ __forceinline__ void a_ready(const Unit&) const {}
    __device__ __forceinline__ void done(const Unit&) const {}
};
struct KvOrder {
    int G, c;
    __device__ bool next(int i, Unit& u) const { const int L = i * G + c; if (L >= 128) return false; const int ly = L >> 5, r = L & 31; u.pm = ly * 8 + (r & 7); u.pn = ly * 4 + (r >> 3); return true; }
    __device__ __forceinline__ void a_ready(const Unit&) const {}
    __device__ __forceinline__ void done(const Unit&) const {}
};

__device__ __forceinline__ unsigned cvt_pk_bf16(float lo, float hi) { unsigned r; asm volatile("v_cvt_pk_bf16_f32 %0, %1, %2" : "=v"(r) : "v"(lo), "v"(hi)); return r; }

template <int ACT> struct EpiBf16 {
    static constexpr bool PERM = true, AFTER_DRAIN = false;
    bf16_t* O; int ldc; const unsigned long long* rowss;
    __device__ __forceinline__ void operator()(const f32x4 (&acc)[2][2][4][2], const Unit& u, int wr, int wc, int fr, int fq) const {
        const int row0 = u.pm * BM + wr * 64 + fr; const int col0 = u.pn * BM + wc * 32 + 8 * fq;
        unsigned long long rq[2][4];
#pragma unroll
        for (int ai = 0; ai < 2; ++ai)
#pragma unroll
            for (int m = 0; m < 4; ++m) rq[ai][m] = rowss ? rowss[row0 + ai * HALF + m * 16] : 0ull;
        if (rowss) asm volatile("" : "+v"(rq[0][0]), "+v"(rq[0][1]), "+v"(rq[0][2]), "+v"(rq[0][3]), "+v"(rq[1][0]), "+v"(rq[1][1]), "+v"(rq[1][2]), "+v"(rq[1][3]));
#pragma unroll
        for (int ai = 0; ai < 2; ++ai)
#pragma unroll
            for (int m = 0; m < 4; ++m) { bf16_t* rowp = O + (size_t)(row0 + ai * HALF + m * 16) * ldc + col0;
                const float rs = rowss ? __builtin_amdgcn_rsqf((float)rq[ai][m] * (5.9604644775390625e-08f / 2048.f) + 1e-5f) : 1.f;
#pragma unroll
                for (int bj = 0; bj < 2; ++bj) { f32x4 v0 = acc[ai][bj][m][0] * rs, v1 = acc[ai][bj][m][1] * rs;
                    if (ACT == 1) {
#pragma unroll
                        for (int j = 0; j < 4; ++j) { const float a = fmaxf(v0[j], 0.f), b = fmaxf(v1[j], 0.f); v0[j] = a * a; v1[j] = b * b; } }
                    u32x4 w; w.x = cvt_pk_bf16(v0[0], v0[1]); w.y = cvt_pk_bf16(v0[2], v0[3]); w.z = cvt_pk_bf16(v1[0], v1[1]); w.w = cvt_pk_bf16(v1[2], v1[3]);
                    *(u32x4*)(rowp + bj * HALF) = w; } }
    }
};
struct EpiRes {
    static constexpr bool PERM = false, AFTER_DRAIN = false;
    bf16_t* xb; int ldc; unsigned long long* rowss;
    __device__ __forceinline__ void operator()(const f32x4 (&acc)[2][2][4][2], const Unit& u, int wr, int wc, int fr, int fq) const {
        typedef unsigned u32x2_ __attribute__((ext_vector_type(2)));
        const int row0 = u.pm * BM + wr * 64 + fr, col0 = u.pn * BM + wc * 32 + 4 * fq;
#pragma unroll
        for (int ai = 0; ai < 2; ++ai) {
            u32x2_ bv[4][2][2];
#pragma unroll
            for (int m = 0; m < 4; ++m) { const bf16_t* rp = xb + (size_t)(row0 + ai * HALF + m * 16) * ldc + col0;
#pragma unroll
                for (int bj = 0; bj < 2; ++bj)
#pragma unroll
                    for (int n = 0; n < 2; ++n) bv[m][bj][n] = *(const u32x2_*)(rp + bj * HALF + n * 16); }
#pragma unroll
            for (int m = 0; m < 4; ++m) { bf16_t* rp = xb + (size_t)(row0 + ai * HALF + m * 16) * ldc + col0; float ss = 0.f;
#pragma unroll
                for (int bj = 0; bj < 2; ++bj)
#pragma unroll
                    for (int n = 0; n < 2; ++n) { const u32x2_ b = bv[m][bj][n]; f32x4 x = acc[ai][bj][m][n];
                        x[0] += __uint_as_float(b.x << 16); x[1] += __uint_as_float(b.x & 0xffff0000u); x[2] += __uint_as_float(b.y << 16); x[3] += __uint_as_float(b.y & 0xffff0000u);
                        u32x2_ w; w.x = cvt_pk_bf16(x[0], x[1]); w.y = cvt_pk_bf16(x[2], x[3]); *(u32x2_*)(rp + bj * HALF + n * 16) = w;
                        const float r0 = __uint_as_float(w.x << 16), r1 = __uint_as_float(w.x & 0xffff0000u), r2 = __uint_as_float(w.y << 16), r3 = __uint_as_float(w.y & 0xffff0000u);
                        ss += (r0 * r0 + r1 * r1) + (r2 * r2 + r3 * r3); }
                ss += __shfl_xor(ss, 16); ss += __shfl_xor(ss, 32);
                if (fq == 0) atomicAdd(rowss + row0 + ai * HALF + m * 16, (unsigned long long)(ss * 16777216.0f)); }
            asm volatile("" ::: "memory"); }
    }
};
struct EpiGlu {
    static constexpr bool PERM = true, AFTER_DRAIN = false;
    const bf16_t* Z; bf16_t* O; int ldc; const float* bias;
    __device__ __forceinline__ void operator()(const f32x4 (&acc)[2][2][4][2], const Unit& u, int wr, int wc, int fr, int fq) const {
        const int row0 = u.pm * BM + wr * 64 + fr; const int col0 = u.pn * BM + wc * 32 + 8 * fq;
        f32x4 bv[2][2];
#pragma unroll
        for (int bj = 0; bj < 2; ++bj)
#pragma unroll
            for (int n = 0; n < 2; ++n) bv[bj][n] = *(const f32x4*)(bias + col0 + bj * HALF + 4 * n);
#pragma unroll
        for (int ai = 0; ai < 2; ++ai) {
            u32x4 zq[4][2];
#pragma unroll
            for (int m = 0; m < 4; ++m)
#pragma unroll
                for (int bj = 0; bj < 2; ++bj) zq[m][bj] = *(const u32x4*)(Z + (size_t)(row0 + ai * HALF + m * 16) * ldc + col0 + bj * HALF);
#pragma unroll
            for (int m = 0; m < 4; ++m) { const size_t off = (size_t)(row0 + ai * HALF + m * 16) * ldc + col0;
#pragma unroll
                for (int bj = 0; bj < 2; ++bj) { const f32x4 v0 = acc[ai][bj][m][0] + bv[bj][0], v1 = acc[ai][bj][m][1] + bv[bj][1];
                    const u32x4 zz = zq[m][bj]; float z[8], o[8];
                    z[0] = __uint_as_float(zz.x << 16); z[1] = __uint_as_float(zz.x & 0xffff0000u); z[2] = __uint_as_float(zz.y << 16); z[3] = __uint_as_float(zz.y & 0xffff0000u);
                    z[4] = __uint_as_float(zz.z << 16); z[5] = __uint_as_float(zz.z & 0xffff0000u); z[6] = __uint_as_float(zz.w << 16); z[7] = __uint_as_float(zz.w & 0xffff0000u);
#pragma unroll
                    for (int j = 0; j < 4; ++j) { o[j] = z[j] * __builtin_amdgcn_rcpf(1.f + __expf(-v0[j])); o[4 + j] = z[4 + j] * __builtin_amdgcn_rcpf(1.f + __expf(-v1[j])); }
                    u32x4 w; w.x = cvt_pk_bf16(o[0], o[1]); w.y = cvt_pk_bf16(o[2], o[3]); w.z = cvt_pk_bf16(o[4], o[5]); w.w = cvt_pk_bf16(o[6], o[7]);
                    *(u32x4*)(O + off + bj * HALF) = w; } }
            asm volatile("" ::: "memory"); }
    }
};

template <class Epi, class Sched, bool ALIGN_EPI = false, bool SP2 = false>
__device__ __forceinline__ void gemm_phase(PG8_LAS unsigned char* lds, const Gemm g, const Sched& S, const Epi& E) {
    int tid_l = threadIdx.x; asm volatile("" : "+v"(tid_l));
    const int tid = tid_l, wid = __builtin_amdgcn_readfirstlane(tid >> 6), lane = tid & 63, wr = wid >> 2, wc = wid & 3, fr = lane & 15, fq = lane >> 4;
    const int K = g.K, nt = K / BK;
    unsigned voffA[2], voffB[2];
#pragma unroll
    for (int i = 0; i < 2; ++i) { int R, C; stage_rc(tid * 16 + i * 8192, R, C); const int Rb = Epi::PERM ? ((R & ~31) + perm32(R & 31)) : R;
        voffA[i] = (unsigned)(R * g.lda + C) * 2u; voffB[i] = (unsigned)(Rb * g.ldb + C) * 2u; }
    const size_t kstep = (size_t)(BK * 2);
    const size_t hstepA = (size_t)HALF * g.lda * 2, hstepB = (size_t)HALF * g.ldb * 2;
    const size_t tstepA = 2 * hstepA, tstepB = 2 * hstepB;
    const unsigned ldsw = (unsigned)wid * 1024u;
    const int aoff = lds_byte(wr * 64 + fr, fq * 8), boff = lds_byte(wc * 32 + fr, fq * 8);
#define PG8_SA(b, h) (((b) * 2 + (h)) * HTB)
#define PG8_SB(b, h) ((4 + (b) * 2 + (h)) * HTB)
#define PG8_STAGE(bufoff, gbase, voff) do { _Pragma("unroll") for (int _i = 0; _i < 2; ++_i) \
        __builtin_amdgcn_global_load_lds((const unsigned*)((const char*)(gbase) + (voff)[_i]), (PG8_LAS unsigned*)(lds + (bufoff) + ldsw + _i * 8192), 16, 0, 0); } while (0)
#define PG8_LDA(dst, b, h) do { _Pragma("unroll") for (int m = 0; m < 4; ++m) _Pragma("unroll") for (int k = 0; k < 2; ++k) dst[m][k] = *(const PG8_LAS bf16x8*)(lds + PG8_SA(b, h) + aoff + m * 2048 + k * 1024); } while (0)
#define PG8_LDB(dst, b, h) do { _Pragma("unroll") for (int n = 0; n < 2; ++n) _Pragma("unroll") for (int k = 0; k < 2; ++k) dst[n][k] = *(const PG8_LAS bf16x8*)(lds + PG8_SB(b, h) + boff + n * 2048 + k * 1024); } while (0)
#define PG8_MMA(ai, bj, At, Bt) do { __builtin_amdgcn_s_setprio(1); _Pragma("unroll") for (int m = 0; m < 4; ++m) _Pragma("unroll") for (int n = 0; n < 2; ++n) _Pragma("unroll") for (int k = 0; k < 2; ++k) \
        acc[ai][bj][m][n] = __builtin_amdgcn_mfma_f32_16x16x32_bf16(Bt[n][k], At[m][k], acc[ai][bj][m][n], 0, 0, 0); __builtin_amdgcn_s_setprio(0); } while (0)
#define PG8_WAIT_V(n) asm volatile("s_waitcnt vmcnt(" #n ")" ::: "memory")
#define PG8_WAIT_L(n) asm volatile("s_waitcnt lgkmcnt(" #n ")" ::: "memory")
#define PG8_BAR __builtin_amdgcn_s_barrier()
#define PG8_SCHED __builtin_amdgcn_sched_barrier(0)
    Unit cur, nxt; int ui = 0;
    if (!S.next(0, cur)) return;
    f32x4 acc[2][2][4][2];
#pragma unroll
    for (int a = 0; a < 2; ++a)
#pragma unroll
        for (int b = 0; b < 2; ++b)
#pragma unroll
            for (int m = 0; m < 4; ++m)
#pragma unroll
                for (int n = 0; n < 2; ++n) acc[a][b][m][n] = (f32x4){0.f, 0.f, 0.f, 0.f};
    bf16x8 At[4][2], B0[2][2], B1[2][2];
    const char* cA = (const char*)g.A + (size_t)cur.pm * tstepA; const char* cB = (const char*)g.Bt + (size_t)cur.pn * tstepB;
    S.a_ready(cur);
    if constexpr (SP2) {
        PG8_STAGE(PG8_SB(0, 0), cB, voffB); PG8_STAGE(PG8_SB(0, 1), cB + hstepB, voffB); PG8_STAGE(PG8_SA(0, 0), cA, voffA); PG8_STAGE(PG8_SA(0, 1), cA + hstepA, voffA);
        if (wr == 1) PG8_BAR;
        PG8_WAIT_V(2); PG8_BAR;
        PG8_STAGE(PG8_SB(1, 0), cB + kstep, voffB); PG8_STAGE(PG8_SA(1, 0), cA + kstep, voffA); PG8_STAGE(PG8_SB(1, 1), cB + hstepB + kstep, voffB);
        PG8_WAIT_V(6); PG8_BAR;
    } else {
        PG8_STAGE(PG8_SB(0, 0), cB, voffB); PG8_STAGE(PG8_SA(0, 0), cA, voffA); PG8_STAGE(PG8_SB(0, 1), cB + hstepB, voffB); PG8_STAGE(PG8_SA(0, 1), cA + hstepA, voffA);
        if (wr == 1) PG8_BAR;
        PG8_WAIT_V(4); PG8_BAR;
        PG8_STAGE(PG8_SB(1, 0), cB + kstep, voffB); PG8_STAGE(PG8_SA(1, 0), cA + kstep, voffA); PG8_STAGE(PG8_SB(1, 1), cB + hstepB + kstep, voffB);
        PG8_WAIT_V(6); PG8_BAR;
    }
    for (;;) {
        const bool has_next = S.next(ui + 1, nxt);
        const char* nA = has_next ? (const char*)g.A + (size_t)nxt.pm * tstepA : cA; const char* nB = has_next ? (const char*)g.Bt + (size_t)nxt.pn * tstepB : cB;
        for (int t = 0; t < nt; t += 2) {
            const bool last = (t == nt - 2);
            const char* a1 = cA + (size_t)(t + 1) * kstep;
            const char* a2 = last ? nA : cA + (size_t)(t + 2) * kstep; const char* b2 = last ? nB : cB + (size_t)(t + 2) * kstep;
            const char* a3 = a2 + kstep; const char* b3 = b2 + kstep;
            if (last && has_next) S.a_ready(nxt);
            if constexpr (SP2) {
            PG8_LDB(B0, 0, 0); PG8_LDB(B1, 0, 1); PG8_SCHED; PG8_LDA(At, 0, 0); PG8_STAGE(PG8_SA(1, 1), a1 + hstepA, voffA);
            PG8_WAIT_V(8); PG8_WAIT_L(0); PG8_BAR; PG8_MMA(0, 0, At, B0); PG8_MMA(0, 1, At, B1); PG8_BAR; PG8_SCHED;
            PG8_LDA(At, 0, 1); PG8_STAGE(PG8_SB(0, 0), b2, voffB); PG8_STAGE(PG8_SB(0, 1), b2 + hstepB, voffB); PG8_STAGE(PG8_SA(0, 0), a2, voffA);
            PG8_WAIT_V(8); PG8_WAIT_L(0); PG8_BAR; PG8_MMA(1, 0, At, B0); PG8_MMA(1, 1, At, B1); PG8_BAR; PG8_SCHED;
            PG8_LDB(B0, 1, 0); PG8_LDB(B1, 1, 1); PG8_SCHED; PG8_LDA(At, 1, 0); PG8_STAGE(PG8_SA(0, 1), a2 + hstepA, voffA);
            PG8_WAIT_V(8); PG8_WAIT_L(0); PG8_BAR; PG8_MMA(0, 0, At, B0); PG8_MMA(0, 1, At, B1); PG8_BAR; PG8_SCHED;
            PG8_LDA(At, 1, 1); PG8_STAGE(PG8_SB(1, 0), b3, voffB); PG8_STAGE(PG8_SB(1, 1), b3 + hstepB, voffB); PG8_STAGE(PG8_SA(1, 0), a3, voffA);
            PG8_WAIT_V(8); PG8_WAIT_L(0); PG8_BAR; PG8_MMA(1, 0, At, B0); PG8_MMA(1, 1, At, B1); PG8_BAR; PG8_SCHED;
            } else {
            PG8_LDB(B0, 0, 0); PG8_SCHED; PG8_LDA(At, 0, 0); PG8_STAGE(PG8_SA(1, 1), a1 + hstepA, voffA);
            PG8_WAIT_L(8); PG8_BAR; PG8_WAIT_L(0); PG8_MMA(0, 0, At, B0); PG8_BAR; PG8_SCHED;
            PG8_LDB(B1, 0, 1); PG8_STAGE(PG8_SB(0, 0), b2, voffB);
            PG8_BAR; PG8_WAIT_L(0); PG8_MMA(0, 1, At, B1); PG8_BAR;
            PG8_LDA(At, 0, 1); PG8_STAGE(PG8_SA(0, 0), a2, voffA);
            PG8_BAR; PG8_WAIT_L(0); PG8_MMA(1, 0, At, B0); PG8_BAR; PG8_SCHED;
            PG8_STAGE(PG8_SB(0, 1), b2 + hstepB, voffB);
            PG8_WAIT_V(6); PG8_BAR; PG8_MMA(1, 1, At, B1); PG8_BAR;
            PG8_LDB(B0, 1, 0); PG8_SCHED; PG8_LDA(At, 1, 0); PG8_STAGE(PG8_SA(0, 1), a2 + hstepA, voffA);
            PG8_WAIT_L(8); PG8_BAR; PG8_WAIT_L(0); PG8_MMA(0, 0, At, B0); PG8_BAR; PG8_SCHED;
            PG8_LDB(B1, 1, 1); PG8_STAGE(PG8_SB(1, 0), b3, voffB);
            PG8_BAR; PG8_WAIT_L(0); PG8_MMA(0, 1, At, B1); PG8_BAR;
            PG8_LDA(At, 1, 1); PG8_STAGE(PG8_SA(1, 0), a3, voffA);
            PG8_BAR; PG8_WAIT_L(0); PG8_MMA(1, 0, At, B0); PG8_BAR; PG8_SCHED;
            PG8_STAGE(PG8_SB(1, 1), b3 + hstepB, voffB);
            PG8_WAIT_V(6); PG8_BAR; PG8_MMA(1, 1, At, B1); PG8_BAR;
            }
        }
        if constexpr (ALIGN_EPI) { if (wr == 0) PG8_BAR; }
        E(acc, cur, wr, wc, fr, fq); S.done(cur);
        if (!has_next) break;
#pragma unroll
        for (int a = 0; a < 2; ++a)
#pragma unroll
            for (int b = 0; b < 2; ++b)
#pragma unroll
                for (int m = 0; m < 4; ++m)
#pragma unroll
                    for (int n = 0; n < 2; ++n) acc[a][b][m][n] = (f32x4){0.f, 0.f, 0.f, 0.f};
        cur = nxt; cA = nA; cB = nB; ++ui;
        if constexpr (ALIGN_EPI) { if (wr == 1) PG8_BAR; }
    }
    PG8_WAIT_V(0);
    if constexpr (!ALIGN_EPI) { if (wr == 0) PG8_BAR; }
    PG8_BAR;
#undef PG8_SA
#undef PG8_SB
#undef PG8_STAGE
#undef PG8_LDA
#undef PG8_LDB
#undef PG8_MMA
#undef PG8_WAIT_V
#undef PG8_WAIT_L
#undef PG8_BAR
#undef PG8_SCHED
}
}
#define XB_TMO      128
#define XB_XCNT(j)  (256  + 64 * (j))
#define XB_XSUB(j)  (1280 + 64 * (j))
#define XB_XGEN(j)  (2304 + 64 * (j))
#define XB_TOP      3328
#define XB_TOPGEN   3392
#define XCD_BAR_WORDS 3456
#define XB_SPIN_CAP (1u << 18)
__device__ __forceinline__ unsigned xb_ld(unsigned* p)              { return __hip_atomic_load(p, __ATOMIC_RELAXED, __HIP_MEMORY_SCOPE_AGENT); }
__device__ __forceinline__ unsigned xb_add(unsigned* p, unsigned v) { return __hip_atomic_fetch_add(p, v, __ATOMIC_RELAXED, __HIP_MEMORY_SCOPE_AGENT); }
__device__ __forceinline__ unsigned xb_xcc_id() { return (unsigned)__builtin_amdgcn_s_getreg((3 << 11) | 20) & 0xFu; }
#define XB_SPIN(cond, bar) do { unsigned _sp = 0; while (cond) { __builtin_amdgcn_s_sleep(1); \
    if ((++_sp & 255u) == 0u) { if (xb_ld(&(bar)[XB_TMO])) break; if (_sp > XB_SPIN_CAP) { atomicAdd(&(bar)[XB_TMO], 1u); break; } } } } while (0)
struct XcdBarrier { unsigned* bar; unsigned x; volatile LAS unsigned* st; unsigned G; };
__device__ __forceinline__ XcdBarrier xcd_barrier_post(unsigned* bar, volatile LAS unsigned* st, unsigned G) {
    XcdBarrier b; b.bar = bar; b.x = xb_xcc_id(); b.st = st; b.G = G;
    if (threadIdx.x == 0) (void)xb_add(&bar[XB_XCNT(b.x)], 1u);
    return b;
}
__device__ __forceinline__ void xcd_barrier_complete(unsigned* bar, unsigned x, unsigned G, unsigned& nloc, unsigned& nx) {
    unsigned sum, cnt, mine, sp = 0u;
    for (;;) {
        sum = 0u; cnt = 0u; mine = 0u;
#pragma unroll
        for (unsigned j = 0; j < 16; ++j) { const unsigned c = xb_ld(&bar[XB_XCNT(j)]); sum += c; cnt += (c > 0u) ? 1u : 0u; mine = (j == x) ? c : mine; }
        if (sum == G) break;
        __builtin_amdgcn_s_sleep(1);
        if ((++sp & 255u) == 0u) { if (xb_ld(&bar[XB_TMO])) break; if (sp > XB_SPIN_CAP) { atomicAdd(&bar[XB_TMO], 1u); break; } }
    }
    nloc = mine > 0u ? mine : 1u; nx = cnt > 0u ? cnt : 1u;
}
__device__ __forceinline__ void xcd_barrier(const XcdBarrier& b) {
    asm volatile("s_waitcnt vmcnt(0)" ::: "memory");
    __syncthreads();
    if (threadIdx.x == 0) {
        unsigned* bar = b.bar;
        __builtin_amdgcn_s_waitcnt(0);
        unsigned nloc = b.st[0], nx = b.st[1];
        if (nloc == 0u) { xcd_barrier_complete(bar, b.x, b.G, nloc, nx); b.st[0] = nloc; b.st[1] = nx; }
        const unsigned old = xb_add(&bar[XB_XSUB(b.x)], 1u);
        const unsigned gen = old / nloc;
        if (old + 1u == (gen + 1u) * nloc) {
            __builtin_amdgcn_fence(__ATOMIC_RELEASE, "agent");
            asm volatile("s_waitcnt vmcnt(0)" ::: "memory");
            const unsigned og = xb_add(&bar[XB_TOP], 1u);
            const unsigned tg = og / nx;
            if (og + 1u == (tg + 1u) * nx) xb_add(&bar[XB_TOPGEN], 1u);
            else XB_SPIN(xb_ld(&bar[XB_TOPGEN]) == tg, bar);
            __builtin_amdgcn_fence(__ATOMIC_ACQUIRE, "agent");
            xb_add(&bar[XB_XGEN(b.x)], 1u);
            asm volatile("s_waitcnt vmcnt(0)" ::: "memory");
        } else {
            XB_SPIN(xb_ld(&bar[XB_XGEN(b.x)]) == gen, bar);
            __builtin_amdgcn_fence(__ATOMIC_ACQUIRE, "agent");
            asm volatile("s_waitcnt vmcnt(0)" ::: "memory");
        }
    }
    __syncthreads();
}

constexpr int NWAVES = 8, NTHR = 512;
constexpr int LDS_BYTES = 155648;
constexpr int MISC_OFF = LDS_BYTES - 256;
struct Ctx { unsigned char* lds; int tid, lane, wave, gw, ngw, bid, nb; };

__device__ __forceinline__ void tr_item(const float* __restrict__ W, int ldw, int N, bf16* __restrict__ WT, int ldt, int row_off, int col_off, int kb, int nb, float* scr, int lane, const float* __restrict__ gk) {
    const int k0 = 64 * kb, n0 = 32 * nb; const int n = n0 + (lane & 31);
    float v[32];
    const float* wp = W + (size_t)(k0 + (lane >> 5)) * ldw + (n < N ? n : 0);
#pragma unroll
    for (int i = 0; i < 32; ++i) v[i] = wp[(size_t)(2 * i) * ldw];
    asm volatile("" : "+v"(v[0]), "+v"(v[1]), "+v"(v[2]), "+v"(v[3]), "+v"(v[4]), "+v"(v[5]), "+v"(v[6]), "+v"(v[7]), "+v"(v[8]), "+v"(v[9]), "+v"(v[10]), "+v"(v[11]), "+v"(v[12]), "+v"(v[13]), "+v"(v[14]), "+v"(v[15]));
    asm volatile("" : "+v"(v[16]), "+v"(v[17]), "+v"(v[18]), "+v"(v[19]), "+v"(v[20]), "+v"(v[21]), "+v"(v[22]), "+v"(v[23]), "+v"(v[24]), "+v"(v[25]), "+v"(v[26]), "+v"(v[27]), "+v"(v[28]), "+v"(v[29]), "+v"(v[30]), "+v"(v[31]));
    const float msk = (n < N) ? 1.f : 0.f;
    if (gk) {
        float gv[32];
#pragma unroll
        for (int i = 0; i < 32; ++i) gv[i] = gk[k0 + 2 * i + (lane >> 5)];
#pragma unroll
        for (int i = 0; i < 32; ++i) v[i] *= gv[i];
    }
#pragma unroll
    for (int i = 0; i < 32; ++i) { const int kk = 2 * i + (lane >> 5); scr[kk * 33 + (lane & 31)] = v[i] * msk; }
    __builtin_amdgcn_fence(__ATOMIC_RELEASE, "wavefront"); __builtin_amdgcn_wave_barrier(); __builtin_amdgcn_fence(__ATOMIC_ACQUIRE, "wavefront");
    const int c = lane & 7;
#pragma unroll
    for (int j = 0; j < 4; ++j) { const int nn = (lane >> 3) + 8 * j; const float* s = scr + (8 * c) * 33 + nn;
        u32x4 o; o.x = pk2(s[0 * 33], s[1 * 33]); o.y = pk2(s[2 * 33], s[3 * 33]); o.z = pk2(s[4 * 33], s[5 * 33]); o.w = pk2(s[6 * 33], s[7 * 33]);
        *(u32x4*)(WT + (size_t)(row_off + n0 + nn) * ldt + col_off + k0 + 8 * c) = o; }
    __builtin_amdgcn_fence(__ATOMIC_RELEASE, "wavefront"); __builtin_amdgcn_wave_barrier(); __builtin_amdgcn_fence(__ATOMIC_ACQUIRE, "wavefront");
}
__device__ __forceinline__ void conv_mat(const Ctx& c, const float* W, int K, int ldw, int N, int Npad, bf16* WT, int ldt, int row_off, int col_off, const float* gk = nullptr) {
    float* scr = (float*)(c.lds + c.wave * 8704);
    const int nblk = Npad / 32, nit = (K / 64) * nblk;
    for (int it = c.gw; it < nit; it += c.ngw) tr_item(W, ldw, N, WT, ldt, row_off, col_off, it / nblk, it % nblk, scr, c.lane, gk);
}

__device__ __forceinline__ void norm_rows_bf16(const Ctx& c, const float* __restrict__ X, const float* __restrict__ g, bf16* __restrict__ O, int nrows) {
    f32x4 gv[8];
#pragma unroll
    for (int j = 0; j < 8; ++j) gv[j] = *(const f32x4*)(g + 4 * c.lane + 256 * j);
    for (int m = c.gw; m < nrows; m += c.ngw) {
        const f32x4* xr = (const f32x4*)(X + (size_t)m * D) + c.lane; f32x4 v[8]; float s = 0.f;
#pragma unroll
        for (int j = 0; j < 8; ++j) { v[j] = xr[64 * j]; s += (v[j].x * v[j].x + v[j].y * v[j].y) + (v[j].z * v[j].z + v[j].w * v[j].w); }
        const float rstd = 1.0f / sqrtf(wave_sum(s) * (1.f / D) + NORM_EPS);
        u32x2* o8 = (u32x2*)(O + (size_t)m * D) + c.lane;
#pragma unroll
        for (int j = 0; j < 8; ++j) { u32x2 w; w.x = pk2(v[j].x * rstd * gv[j].x, v[j].y * rstd * gv[j].y); w.y = pk2(v[j].z * rstd * gv[j].z, v[j].w * rstd * gv[j].w); o8[64 * j] = w; }
    }
}
__device__ __forceinline__ void cast_rows_ss(const Ctx& c, const float* __restrict__ X, bf16* __restrict__ O, unsigned long long* rowss, int nrows) {
    for (int m = c.gw; m < nrows; m += 2 * c.ngw) {
        const int m2 = (m + c.ngw < nrows) ? m + c.ngw : m;
        const f32x4* xr = (const f32x4*)(X + (size_t)m * D) + c.lane; const f32x4* xr2 = (const f32x4*)(X + (size_t)m2 * D) + c.lane; f32x4 v[8], v2[8]; float s = 0.f, s2 = 0.f;
#pragma unroll
        for (int j = 0; j < 8; ++j) { v[j] = xr[64 * j]; v2[j] = xr2[64 * j]; }
#pragma unroll
        for (int j = 0; j < 8; ++j) { s += (v[j].x * v[j].x + v[j].y * v[j].y) + (v[j].z * v[j].z + v[j].w * v[j].w); s2 += (v2[j].x * v2[j].x + v2[j].y * v2[j].y) + (v2[j].z * v2[j].z + v2[j].w * v2[j].w); }
#pragma unroll
        for (int o = 1; o < 64; o <<= 1) { s += __shfl_xor(s, o); s2 += __shfl_xor(s2, o); }
        u32x2* o8 = (u32x2*)(O + (size_t)m * D) + c.lane; u32x2* o82 = (u32x2*)(O + (size_t)m2 * D) + c.lane;
#pragma unroll
        for (int j = 0; j < 8; ++j) { u32x2 w; w.x = pk2(v[j].x, v[j].y); w.y = pk2(v[j].z, v[j].w); o8[64 * j] = w; }
        if (c.lane == 0) rowss[m] = (unsigned long long)(s * 16777216.0f);
        if (m2 != m) {
#pragma unroll
            for (int j = 0; j < 8; ++j) { u32x2 w; w.x = pk2(v2[j].x, v2[j].y); w.y = pk2(v2[j].z, v2[j].w); o82[64 * j] = w; }
            if (c.lane == 0) rowss[m2] = (unsigned long long)(s2 * 16777216.0f);
        }
    }
}
__device__ __forceinline__ void scale_rows_out(const Ctx& c, const bf16* __restrict__ XB, const float* __restrict__ g, const unsigned long long* rowss, float* O, int nrows) {
    for (int m = c.gw; m < nrows; m += 2 * c.ngw) {
        const int m2 = (m + c.ngw < nrows) ? m + c.ngw : m;
        u32x4 xa[4], xb[4];
#pragma unroll
        for (int j = 0; j < 4; ++j) { xa[j] = *(const u32x4*)(XB + (size_t)m * D + 8 * c.lane + 512 * j); xb[j] = *(const u32x4*)(XB + (size_t)m2 * D + 8 * c.lane + 512 * j); }
        const float ra = __builtin_amdgcn_rsqf((float)rowss[m] * (5.9604644775390625e-08f / D) + NORM_EPS), rb = __builtin_amdgcn_rsqf((float)rowss[m2] * (5.9604644775390625e-08f / D) + NORM_EPS);
#pragma unroll
        for (int j = 0; j < 4; ++j) { float x[8]; unpack8(xa[j], x);
            const f32x4 g0 = *(const f32x4*)(g + 8 * c.lane + 512 * j), g1 = *(const f32x4*)(g + 8 * c.lane + 512 * j + 4);
            *(f32x4*)(O + (size_t)m * D + 8 * c.lane + 512 * j) = (f32x4){x[0] * ra * g0.x, x[1] * ra * g0.y, x[2] * ra * g0.z, x[3] * ra * g0.w};
            *(f32x4*)(O + (size_t)m * D + 8 * c.lane + 512 * j + 4) = (f32x4){x[4] * ra * g1.x, x[5] * ra * g1.y, x[6] * ra * g1.z, x[7] * ra * g1.w};
            if (m2 != m) { unpack8(xb[j], x);
                *(f32x4*)(O + (size_t)m2 * D + 8 * c.lane + 512 * j) = (f32x4){x[0] * rb * g0.x, x[1] * rb * g0.y, x[2] * rb * g0.z, x[3] * rb * g0.w};
                *(f32x4*)(O + (size_t)m2 * D + 8 * c.lane + 512 * j + 4) = (f32x4){x[4] * rb * g1.x, x[5] * rb * g1.y, x[6] * rb * g1.z, x[7] * rb * g1.w}; } }
    }
}
__device__ __forceinline__ void norm_rows_f32(const Ctx& c, float* X, const float* __restrict__ g, int nrows) {
    f32x4 gv[8];
#pragma unroll
    for (int j = 0; j < 8; ++j) gv[j] = *(const f32x4*)(g + 4 * c.lane + 256 * j);
    for (int m = c.gw; m < nrows; m += c.ngw) {
        f32x4* xr = (f32x4*)(X + (size_t)m * D) + c.lane; f32x4 v[8]; float s = 0.f;
#pragma unroll
        for (int j = 0; j < 8; ++j) { v[j] = xr[64 * j]; s += (v[j].x * v[j].x + v[j].y * v[j].y) + (v[j].z * v[j].z + v[j].w * v[j].w); }
        const float rstd = 1.0f / sqrtf(wave_sum(s) * (1.f / D) + NORM_EPS);
#pragma unroll
        for (int j = 0; j < 8; ++j) xr[64 * j] = v[j] * rstd * gv[j];
    }
}

__device__ __forceinline__ void rope_tables(const Ctx& c, const int* __restrict__ start_frame, float* ropea, float* ropei) {
    const float HA[16] = {1.000000000e+00f, 4.403665960e-01f, 1.939227432e-01f, 8.539710194e-02f, 3.760603070e-02f, 1.656044088e-02f, 7.292664610e-03f, 3.211446106e-03f, 1.414213562e-03f, 6.227724371e-04f, 2.742481884e-04f, 1.207697351e-04f, 5.318295734e-05f, 2.341999971e-05f, 1.031338525e-05f, 4.541670478e-06f};
    const float LA[16] = {0.000000000e+00f, 6.688275267e-09f, 1.547429962e-09f, -1.652958881e-09f, 2.282729838e-10f, -8.020459852e-10f, 1.273676581e-10f, -1.116812753e-10f, -1.115275407e-14f, -1.514006802e-11f, -1.268531807e-11f, 2.335000249e-12f, 1.624761415e-12f, -7.452659366e-13f, 1.309491117e-13f, 2.687890499e-15f};
    const float HI[8] = {1.000000000e+00f, 1.939227432e-01f, 3.760603070e-02f, 7.292664610e-03f, 1.414213562e-03f, 2.742481884e-04f, 5.318295734e-05f, 1.031338525e-05f};
    const float LI[8] = {0.000000000e+00f, 1.547429962e-09f, 2.282729838e-10f, 1.273676581e-10f, -1.115275407e-14f, -1.268531807e-11f, 1.624761415e-12f, 1.309491117e-13f};
    const int gt = c.bid * NTHR + c.tid, ngt = c.nb * NTHR;
    for (int i = gt; i < M * 24; i += ngt) {
        const int m = i / 24, j = i % 24; const int b = m / SEQ, t = m % SEQ;
        const float pos = (float)(start_frame[b] + t);
        float hi = 0.f, lo = 0.f;
#pragma unroll
        for (int q = 0; q < 16; ++q) if (j == q) { hi = HA[q]; lo = LA[q]; }
#pragma unroll
        for (int q = 0; q < 8; ++q) if (j == 16 + q) { hi = HI[q]; lo = LI[q]; }
        const float p = pos * hi, e = fmaf(pos, hi, -p) + pos * lo;
        float sn, cs; sincosf(p, &sn, &cs);
        const float cc = cs - e * sn, ss = sn + e * cs;
        if (j < 16) { ropea[(size_t)m * 32 + j] = cc; ropea[(size_t)m * 32 + 16 + j] = ss; }
        else { ropei[(size_t)m * 16 + (j - 16)] = cc; ropei[(size_t)m * 16 + 8 + (j - 16)] = ss; }
    }
}

__device__ __forceinline__ void build_wql(const Ctx& c, const float* __restrict__ w_uq, const float* __restrict__ w_uk, bf16* WQ) {
    const int gt = c.bid * NTHR + c.tid, ngt = c.nb * NTHR;
    for (int it = gt; it < 512 * 256; it += ngt) {
        const int cc = it & 511, rb = it >> 9, h = rb >> 5, r0 = (rb & 31) * 8;
        const float* a = w_uq + (size_t)cc * 1024 + h * 128 + 32; const float* bq = w_uk + (size_t)r0 * 768 + h * 96; float s[8];
#pragma unroll
        for (int j = 0; j < 8; ++j) s[j] = 0.f;
#pragma unroll 2
        for (int d4 = 0; d4 < 24; ++d4) { const f32x4 av = *(const f32x4*)(a + 4 * d4);
#pragma unroll
            for (int j = 0; j < 8; ++j) { const f32x4 bv = *(const f32x4*)(bq + (size_t)j * 768 + 4 * d4); s[j] += (av.x * bv.x + av.y * bv.y) + (av.z * bv.z + av.w * bv.w); } }
#pragma unroll
        for (int j = 0; j < 8; ++j) WQ[(size_t)(h * 256 + r0 + j) * 512 + cc] = (bf16)f2bf(s[j]);
    }
}
__device__ __forceinline__ void build_wout(const Ctx& c, const float* __restrict__ w_uv, const float* __restrict__ w_out, bf16* WO) {
    const int gt = c.bid * NTHR + c.tid, ngt = c.nb * NTHR;
    for (int i = gt; i < 8 * 32 * 2048; i += ngt) {
        const int n = i & 2047, rg = (i >> 11) & 31, h = i >> 16; float acc[8];
#pragma unroll
        for (int j = 0; j < 8; ++j) acc[j] = 0.f;
#pragma unroll 2
        for (int d4 = 0; d4 < 32; ++d4) {
            const float* wop = w_out + (size_t)(h * 128 + 4 * d4) * 2048 + n; const float wo0 = wop[0], wo1 = wop[2048], wo2 = wop[4096], wo3 = wop[6144];
#pragma unroll
            for (int j = 0; j < 8; ++j) { const f32x4 u = *(const f32x4*)(w_uv + (size_t)(rg * 8 + j) * 1024 + h * 128 + 4 * d4); acc[j] += (u.x * wo0 + u.y * wo1) + (u.z * wo2 + u.w * wo3); } }
        u32x4 o; o.x = pk2(acc[0], acc[1]); o.y = pk2(acc[2], acc[3]); o.z = pk2(acc[4], acc[5]); o.w = pk2(acc[6], acc[7]);
        *(u32x4*)(WO + (size_t)n * OC + h * 256 + rg * 8) = o;
    }
}

__device__ __forceinline__ void dsa_prep(const Ctx& c, const bf16* __restrict__ H, const float* __restrict__ cqn_g, const float* __restrict__ ckv_g, const float* __restrict__ kidx_g,
                                         const float* __restrict__ ropea, const float* __restrict__ ropei, bf16* CQN, bf16* KF, bf16* KIDX, float* WIDX) {
    const int l = c.lane;
    struct Tok { u32x4 cq; u32x2 ckv; unsigned short r1, r2, ki, wi; float csa, sna, csi, sni; };
    auto ld = [&](int m) -> Tok { Tok t; const bf16* h = H + (size_t)m * HC; const int l15 = l & 15, l7 = l & 7;
        t.cq = *(const u32x4*)(h + 8 * l); t.ckv = *(const u32x2*)(h + 512 + 4 * l); t.r1 = h[768 + l15]; t.r2 = h[768 + 16 + l15]; t.ki = h[800 + l]; t.wi = h[864 + l15];
        t.csa = ropea[(size_t)m * 32 + l15]; t.sna = ropea[(size_t)m * 32 + 16 + l15]; t.csi = ropei[(size_t)m * 16 + l7]; t.sni = ropei[(size_t)m * 16 + 8 + l7]; return t; };
    auto proc = [&](int m, const Tok& t) {
        {
            float f[8]; unpack8(t.cq, f); float s = 0.f;
#pragma unroll
            for (int j = 0; j < 8; ++j) s += f[j] * f[j];
            const float rstd = 1.0f / sqrtf(wave_sum(s) * (1.f / 512.f) + NORM_EPS);
            u32x4 o; o.x = pk2(f[0] * rstd * cqn_g[8 * l + 0], f[1] * rstd * cqn_g[8 * l + 1]); o.y = pk2(f[2] * rstd * cqn_g[8 * l + 2], f[3] * rstd * cqn_g[8 * l + 3]);
            o.z = pk2(f[4] * rstd * cqn_g[8 * l + 4], f[5] * rstd * cqn_g[8 * l + 5]); o.w = pk2(f[6] * rstd * cqn_g[8 * l + 6], f[7] * rstd * cqn_g[8 * l + 7]);
            *(u32x4*)(CQN + (size_t)m * 512 + 8 * l) = o;
        }
        {
            const u32x2 w = t.ckv; const float f0 = bf2f(w.x & 0xffffu), f1 = bf2f(w.x >> 16), f2 = bf2f(w.y & 0xffffu), f3 = bf2f(w.y >> 16);
            const float s = (f0 * f0 + f1 * f1) + (f2 * f2 + f3 * f3);
            const float rstd = 1.0f / sqrtf(wave_sum(s) * (1.f / 256.f) + NORM_EPS);
            u32x2 o; o.x = pk2(f0 * rstd * ckv_g[4 * l + 0], f1 * rstd * ckv_g[4 * l + 1]); o.y = pk2(f2 * rstd * ckv_g[4 * l + 2], f3 * rstd * ckv_g[4 * l + 3]);
            *(u32x2*)(KF + (size_t)m * KFW + 4 * l) = o;
        }
        if (l < 16) {
            const float x1 = bf2f(t.r1), x2 = bf2f(t.r2); const float cs = t.csa, sn = t.sna;
            KF[(size_t)m * KFW + 256 + l] = (bf16)f2bf(x1 * cs - x2 * sn); KF[(size_t)m * KFW + 256 + 16 + l] = (bf16)f2bf(x2 * cs + x1 * sn);
        }
        {
            const float v = bf2f(t.ki); const float rstd = 1.0f / sqrtf(wave_sum(v * v) * (1.f / 64.f) + NORM_EPS);
            const float y = v * rstd * kidx_g[l];
            const float ylo = __shfl(y, l & 7), yhi = __shfl(y, (l & 7) + 8);
            float o = y;
            if (l < 16) { const float cs = t.csi, sn = t.sni; o = (l < 8) ? (ylo * cs - yhi * sn) : (yhi * cs + ylo * sn); }
            KIDX[(size_t)m * 64 + l] = (bf16)f2bf(o);
        }
        if (l < 16) WIDX[(size_t)m * 16 + l] = bf2f(t.wi) * 0.03125f;
    };
    for (int m = c.gw; m < M; m += 2 * c.ngw) {
        const int m2 = m + c.ngw; const bool two = m2 < M;
        const Tok ta = ld(m); const Tok tb = ld(two ? m2 : m);
        proc(m, ta);
        if (two) proc(m2, tb);
    }
}
__device__ __forceinline__ void q_rope_fix(const Ctx& c, bf16* QALL, const float* __restrict__ ropea, const float* __restrict__ ropei) {
    const int l = c.lane;
    for (int m = c.gw; m < M; m += c.ngw) {
        bf16* q = QALL + (size_t)m * QC;
#pragma unroll
        for (int i = 0; i < 2; ++i) { const int p = l + 64 * i, hh = p >> 4, j = p & 15; bf16* a = q + 2048 + hh * 32 + j;
            const float x1 = bf2f(a[0]), x2 = bf2f(a[16]); const float cs = ropea[(size_t)m * 32 + j], sn = ropea[(size_t)m * 32 + 16 + j];
            a[0] = (bf16)f2bf(x1 * cs - x2 * sn); a[16] = (bf16)f2bf(x2 * cs + x1 * sn); }
#pragma unroll
        for (int i = 0; i < 2; ++i) { const int p = l + 64 * i, hh = p >> 3, j = p & 7; bf16* a = q + 2304 + hh * 64 + j;
            const float x1 = bf2f(a[0]), x2 = bf2f(a[8]); const float cs = ropei[(size_t)m * 16 + j], sn = ropei[(size_t)m * 16 + 8 + j];
            a[0] = (bf16)f2bf(x1 * cs - x2 * sn); a[8] = (bf16)f2bf(x2 * cs + x1 * sn); }
    }
}
__device__ __forceinline__ size_t sc_row_off(int b, int t) { const int ch = t >> 6; return (size_t)b * SC_PER_BATCH + (size_t)4096 * (ch * (ch + 1) / 2) + (size_t)(t & 63) * (64 * (ch + 1)); }
__device__ __forceinline__ void idx_scores_simple(const Ctx& c, const bf16* __restrict__ QALL, const bf16* __restrict__ KIDX, const float* __restrict__ WIDX, float* SC) {
    float* qs = (float*)c.lds;
    float* ws = qs + 1024;
    for (int m = c.bid; m < M; m += c.nb) {
        const int b = m / SEQ, t = m % SEQ, limit = ((t >> 6) + 1) * 64;
        __syncthreads();
        for (int i = c.tid; i < 1024; i += NTHR) qs[i] = bf2f(QALL[(size_t)m * QC + 2304 + i]);
        if (c.tid < 16) ws[c.tid] = WIDX[(size_t)m * 16 + c.tid];
        __syncthreads();
        if (limit <= 256) continue;
        float* row = SC + sc_row_off(b, t);
        for (int s = c.tid; s < limit; s += NTHR) {
            float k[64]; const u32x4* kp = (const u32x4*)(KIDX + (size_t)(b * SEQ + s) * 64);
#pragma unroll
            for (int j = 0; j < 8; ++j) unpack8(kp[j], k + 8 * j);
            float sc = 0.f;
#pragma unroll 1
            for (int h = 0; h < 16; ++h) { asm volatile("" ::: "memory"); float d = 0.f; const f32x4* q4 = (const f32x4*)(qs + h * 64);
#pragma unroll
                for (int j = 0; j < 16; ++j) { const f32x4 q = q4[j]; d += (q.x * k[4 * j] + q.y * k[4 * j + 1]) + (q.z * k[4 * j + 2] + q.w * k[4 * j + 3]); }
                sc += ws[h] * fmaxf(d, 0.f); }
            row[s] = sc;
        }
    }
}
__device__ __forceinline__ void select_row(const float* row, int limit, unsigned short* sel, int l_in, unsigned short* stg = nullptr) {
    int l = l_in; asm volatile("" : "+v"(l));
    const int ng = limit >> 9;
    unsigned key[64];
#pragma unroll
    for (int jg = 0; jg < 8; ++jg) {
        if (jg <= ng) {
#pragma unroll
            for (int j = 8 * jg; j < 8 * jg + 8; ++j) { const int s = j * 64 + l; key[j] = __float_as_uint(row[s < limit ? s : 0]); }
        } else {
#pragma unroll
            for (int j = 8 * jg; j < 8 * jg + 8; ++j) key[j] = 0u;
        }
    }
#pragma unroll
    for (int j = 0; j < 64; ++j) { const int s = j * 64 + l; unsigned u = key[j]; u = (u & 0x80000000u) ? ~u : (u | 0x80000000u); key[j] = (s < limit) ? u : 0u; }
    unsigned mx = 0u;
#pragma unroll
    for (int j = 0; j < 64; ++j) mx = key[j] > mx ? key[j] : mx;
#pragma unroll
    for (int o = 1; o < 64; o <<= 1) { const unsigned t = (unsigned)__shfl_xor((int)mx, o); mx = t > mx ? t : mx; }
    mx = (unsigned)__builtin_amdgcn_readfirstlane((int)mx);
    auto wave_count = [&](int v) -> int {
        v += __builtin_amdgcn_update_dpp(0, v, 0xB1, 0xf, 0xf, true); v += __builtin_amdgcn_update_dpp(0, v, 0x4E, 0xf, 0xf, true);
        v += __builtin_amdgcn_update_dpp(0, v, 0x141, 0xf, 0xf, true); v += __builtin_amdgcn_update_dpp(0, v, 0x140, 0xf, 0xf, true);
        return __builtin_amdgcn_readlane(v, 0) + __builtin_amdgcn_readlane(v, 16) + __builtin_amdgcn_readlane(v, 32) + __builtin_amdgcn_readlane(v, 48); };
    unsigned T = 0u;
#pragma unroll 1
    for (int bit = 31 - __builtin_clz(mx | 1u); bit >= 0; --bit) {
        const unsigned Tn = T | (1u << bit); int cl = 0;
#pragma unroll
        for (int jg = 0; jg < 8; ++jg) if (jg <= ng) {
#pragma unroll
            for (int j = 8 * jg; j < 8 * jg + 8; ++j) cl += (key[j] >= Tn) ? 1 : 0; }
        const int cnt = wave_count(cl);
        if (cnt >= 256) T = Tn;
        if (cnt == 256) break;
    }
    int cgl = 0;
#pragma unroll
    for (int j = 0; j < 64; ++j) cgl += (key[j] > T) ? 1 : 0;
    const int cgt = wave_count(cgl);
    const int need_eq = 256 - cgt;
    int base = 0, beq = 0;
    const unsigned long long lt = (1ull << l) - 1ull;
    if (stg) {
#pragma unroll
        for (int jg = 0; jg < 8; ++jg) if (jg <= ng) {
#pragma unroll
            for (int j = 8 * jg; j < 8 * jg + 8; ++j) {
                const unsigned long long mg = __ballot(key[j] > T);
                const int pos = base + (int)__builtin_amdgcn_mbcnt_hi((unsigned)(mg >> 32), __builtin_amdgcn_mbcnt_lo((unsigned)mg, 0u));
                if (key[j] > T) stg[pos] = (unsigned short)(j * 64 + l);
                base += __popcll(mg);
                const unsigned long long me = __ballot(key[j] == T);
                if (me != 0ull) {
                    const int pe = beq + (int)__builtin_amdgcn_mbcnt_hi((unsigned)(me >> 32), __builtin_amdgcn_mbcnt_lo((unsigned)me, 0u));
                    if (key[j] == T && pe < need_eq) stg[cgt + pe] = (unsigned short)(j * 64 + l);
                    beq += __popcll(me);
                }
            }
        }
        __builtin_amdgcn_fence(__ATOMIC_RELEASE, "wavefront"); __builtin_amdgcn_wave_barrier(); __builtin_amdgcn_fence(__ATOMIC_ACQUIRE, "wavefront");
        *(u32x2*)(sel + 4 * l) = *(const u32x2*)(stg + 4 * l);
        __builtin_amdgcn_fence(__ATOMIC_RELEASE, "wavefront"); __builtin_amdgcn_wave_barrier(); __builtin_amdgcn_fence(__ATOMIC_ACQUIRE, "wavefront");
        return;
    }
#pragma unroll
    for (int jg = 0; jg < 8; ++jg) if (jg <= ng) {
#pragma unroll
        for (int j = 8 * jg; j < 8 * jg + 8; ++j) {
            const unsigned long long mg = __ballot(key[j] > T), me = __ballot(key[j] == T);
            if (key[j] > T) sel[base + __popcll(mg & lt)] = (unsigned short)(j * 64 + l);
            base += __popcll(mg);
            const int pe = beq + __popcll(me & lt);
            if (key[j] == T && pe < need_eq) sel[cgt + pe] = (unsigned short)(j * 64 + l);
            beq += __popcll(me);
        }
    }
}
__device__ __forceinline__ void bs_transpose32(unsigned (&A)[32]) {
    unsigned m = 0x0000FFFFu;
#pragma unroll
    for (int j = 16; j != 0; j >>= 1) {
#pragma unroll
        for (int k = 0; k < 32; ++k) {
            if ((k & j) == 0) {
                const unsigned t = (A[k] ^ (A[k + j] >> j)) & m;
                A[k] ^= t; A[k + j] ^= (t << j);
            }
        }
        m ^= (m << (j >> 1));
    }
}
__device__ __forceinline__ void select_row_bs(const float* row, int limit, unsigned short* sel, int l_in, unsigned short* stg) {
    int l = l_in; asm volatile("" : "+v"(l));
    const int nsl = limit >> 6;
    const int ng = limit >> 9;
    unsigned lo[32], hi[32];
#pragma unroll
    for (int jg = 0; jg < 8; ++jg) {
        if (jg <= ng) {
#pragma unroll
            for (int j = 8 * jg; j < 8 * jg + 8; ++j) { const int s = j * 64 + l; const unsigned u = __float_as_uint(row[s < limit ? s : 0]);
                if (j < 32) lo[j & 31] = u; else hi[j & 31] = u; }
        } else {
#pragma unroll
            for (int j = 8 * jg; j < 8 * jg + 8; ++j) { if (j < 32) lo[j & 31] = 0u; else hi[j & 31] = 0u; }
        }
    }
    asm volatile("" ::: "memory");
#pragma unroll
    for (int j = 0; j < 64; ++j) { const unsigned u = (j < 32) ? lo[j & 31] : hi[j & 31];
        const unsigned kx = (j < nsl) ? ((u & 0x80000000u) ? ~u : (u | 0x80000000u)) : 0u;
        if (j < 32) lo[j & 31] = kx; else hi[j & 31] = kx; }
    const bool has_hi = nsl > 32;
    bs_transpose32(lo);
    if (has_hi) bs_transpose32(hi);
    auto wave_count = [&](int v) -> int {
        v += __builtin_amdgcn_update_dpp(0, v, 0xB1, 0xf, 0xf, true); v += __builtin_amdgcn_update_dpp(0, v, 0x4E, 0xf, 0xf, true);
        v += __builtin_amdgcn_update_dpp(0, v, 0x141, 0xf, 0xf, true); v += __builtin_amdgcn_update_dpp(0, v, 0x140, 0xf, 0xf, true);
        return __builtin_amdgcn_readlane(v, 0) + __builtin_amdgcn_readlane(v, 16) + __builtin_amdgcn_readlane(v, 32) + __builtin_amdgcn_readlane(v, 48); };
    unsigned clo = 0xffffffffu, chi = has_hi ? 0xffffffffu : 0u, glo = 0u, ghi = 0u;
    int G = 0;
#pragma unroll
    for (int i = 0; i < 32; ++i) {
        const unsigned olo = clo & lo[i], ohi = chi & hi[i];
        const int tot = G + wave_count(__builtin_popcount(olo) + __builtin_popcount(ohi));
        const bool take = tot >= 256;
        const unsigned mt = take ? 0u : 0xffffffffu;
        G = take ? G : tot;
        glo |= olo & mt; ghi |= ohi & mt;
        clo = olo ^ (clo & mt); chi = ohi ^ (chi & mt);
        if (tot == 256) break;
    }
    {
        const int need = 256 - G;
        const int ceq = wave_count(__builtin_popcount(clo) + __builtin_popcount(chi));
        if (ceq == need) { glo |= clo; ghi |= chi; }
        else {
            int beq = 0;
#pragma unroll 1
            for (int k = 0; k < 64; ++k) {
                const unsigned bm = 0x80000000u >> (k & 31);
                const bool mine = ((k < 32 ? clo : chi) & bm) != 0u;
                const unsigned long long me = __ballot(mine);
                if (me != 0ull) {
                    const int pe = beq + (int)__builtin_amdgcn_mbcnt_hi((unsigned)(me >> 32), __builtin_amdgcn_mbcnt_lo((unsigned)me, 0u));
                    if (mine && pe < need) { if (k < 32) glo |= bm; else ghi |= bm; }
                    beq += __popcll(me);
                }
            }
        }
    }
    const int cl = __builtin_popcount(glo) + __builtin_popcount(ghi);
    int inc = cl;
#pragma unroll
    for (int o = 1; o < 64; o <<= 1) { const int t = __shfl_up(inc, o); inc += (l >= o) ? t : 0; }
    int pos = inc - cl;
    while (__ballot(glo != 0u) != 0ull) {
        if (glo != 0u) { const int s = __builtin_clz(glo); glo &= ~(0x80000000u >> s); stg[pos++] = (unsigned short)(s * 64 + l); }
    }
    while (__ballot(ghi != 0u) != 0ull) {
        if (ghi != 0u) { const int s = __builtin_clz(ghi); ghi &= ~(0x80000000u >> s); stg[pos++] = (unsigned short)((32 + s) * 64 + l); }
    }
    __builtin_amdgcn_fence(__ATOMIC_RELEASE, "wavefront"); __builtin_amdgcn_wave_barrier(); __builtin_amdgcn_fence(__ATOMIC_ACQUIRE, "wavefront");
    *(u32x2*)(sel + 4 * l) = *(const u32x2*)(stg + 4 * l);
    __builtin_amdgcn_fence(__ATOMIC_RELEASE, "wavefront"); __builtin_amdgcn_wave_barrier(); __builtin_amdgcn_fence(__ATOMIC_ACQUIRE, "wavefront");
}
__device__ __forceinline__ void topk_select(const Ctx& c, const float* __restrict__ SC, bf16* SEL  ) {
    const int l = c.lane;
    for (int m = c.gw; m < M; m += c.ngw) {
        const int b = m / SEQ, t = m % SEQ, limit = ((t >> 6) + 1) * 64;
        unsigned short* sel = (unsigned short*)SEL + (size_t)m * 256;
        if (limit <= 256) { for (int i = l; i < 256; i += 64) sel[i] = (unsigned short)(i < limit ? i : 0); continue; }
        select_row(SC + sc_row_off(b, t), limit, sel, l);
    }
}
__device__ __forceinline__ void dsa_attn_simple(const Ctx& c, const bf16* __restrict__ QALL, const bf16* __restrict__ KF, const bf16* __restrict__ SEL, bf16* OLY, int mmax = M) {
    float* qf = (float*)c.lds;
    float* P = qf + 8 * 288;
    int* sl = (int*)(P + 8 * 256);
    const float scale = 0.08838834764831845f;
    for (int m = c.bid; m < mmax; m += c.nb) {
        const int b = m / SEQ, t = m % SEQ, limit = ((t >> 6) + 1) * 64, cnt = limit < 256 ? limit : 256;
        __syncthreads();
        for (int i = c.tid; i < 8 * 288; i += NTHR) { const int h = i / 288, d = i % 288; qf[i] = bf2f(d < 256 ? QALL[(size_t)m * QC + h * 256 + d] : QALL[(size_t)m * QC + 2048 + h * 32 + (d - 256)]); }
        if (c.tid < 256) sl[c.tid] = (int)((const unsigned short*)SEL)[(size_t)m * 256 + c.tid];
        __syncthreads();
        if (c.tid < 256) {
            float acc[8];
#pragma unroll
            for (int h = 0; h < 8; ++h) acc[h] = 0.f;
            if (c.tid < cnt) {
                const u32x4* kp = (const u32x4*)(KF + (size_t)(b * SEQ + sl[c.tid]) * KFW);
                for (int ch = 0; ch < 36; ++ch) { float k[8]; unpack8(kp[ch], k);
#pragma unroll
                    for (int h = 0; h < 8; ++h) { const float* q = qf + h * 288 + ch * 8;
#pragma unroll
                        for (int j = 0; j < 8; ++j) acc[h] += k[j] * q[j]; } }
            }
#pragma unroll
            for (int h = 0; h < 8; ++h) P[h * 256 + c.tid] = (c.tid < cnt) ? acc[h] * scale : -INFINITY;
        }
        __syncthreads();
        {
            const int h = c.wave; float v[4]; float mx = -INFINITY;
#pragma unroll
            for (int i = 0; i < 4; ++i) { v[i] = P[h * 256 + c.lane + 64 * i]; mx = fmaxf(mx, v[i]); }
            mx = wave_max(mx); float s = 0.f;
#pragma unroll
            for (int i = 0; i < 4; ++i) { v[i] = __expf(v[i] - mx); s += v[i]; }
            s = wave_sum(s); const float inv = 1.f / s;
#pragma unroll
            for (int i = 0; i < 4; ++i) P[h * 256 + c.lane + 64 * i] = v[i] * inv;
        }
        __syncthreads();
        {
            const int r = c.tid & 255, hg = c.tid >> 8; float o[4] = {0.f, 0.f, 0.f, 0.f};
            for (int i = 0; i < cnt; ++i) { const float v = bf2f(KF[(size_t)(b * SEQ + sl[i]) * KFW + r]);
#pragma unroll
                for (int hh = 0; hh < 4; ++hh) o[hh] += P[(hg * 4 + hh) * 256 + i] * v; }
#pragma unroll
            for (int hh = 0; hh < 4; ++hh) OLY[(size_t)m * OC + (hg * 4 + hh) * 256 + r] = (bf16)f2bf(o[hh]);
        }
    }
}
__device__ __forceinline__ void xattn_simple(const Ctx& c, const bf16* __restrict__ XQ, const bf16* __restrict__ KVBIG, int layer, bf16* XO) {
    float* qf = (float*)c.lds;
    float* P = qf + 512;
    const float scale = 0.08838834764831845f;
    for (int m = c.bid; m < M; m += c.nb) {
        const int b = m / SEQ;
        const bf16* kvb = KVBIG + (size_t)(layer * 2048 + b * 256) * 4096 + layer * 1024;
        __syncthreads();
        qf[c.tid] = bf2f(XQ[(size_t)m * 512 + c.tid]);
        __syncthreads();
        {
            const int j = c.tid & 255, hp = c.tid >> 8;
#pragma unroll
            for (int hh = 0; hh < 2; ++hh) { const int h = hp * 2 + hh; const u32x4* kp = (const u32x4*)(kvb + (size_t)j * 4096 + h * 128); float d = 0.f;
                for (int ch = 0; ch < 16; ++ch) { float k[8]; unpack8(kp[ch], k);
#pragma unroll
                    for (int e = 0; e < 8; ++e) d += k[e] * qf[h * 128 + ch * 8 + e]; }
                P[h * 256 + j] = d * scale; }
        }
        __syncthreads();
        if (c.wave < 4) { const int h = c.wave; float v[4]; float mx = -INFINITY;
#pragma unroll
            for (int i = 0; i < 4; ++i) { v[i] = P[h * 256 + c.lane + 64 * i]; mx = fmaxf(mx, v[i]); }
            mx = wave_max(mx); float s = 0.f;
#pragma unroll
            for (int i = 0; i < 4; ++i) { v[i] = __expf(v[i] - mx); s += v[i]; }
            s = wave_sum(s); const float inv = 1.f / s;
#pragma unroll
            for (int i = 0; i < 4; ++i) P[h * 256 + c.lane + 64 * i] = v[i] * inv; }
        __syncthreads();
        {   const int h = c.tid >> 7; float o = 0.f;
            for (int j = 0; j < 256; ++j) o += P[h * 256 + j] * bf2f(kvb[(size_t)j * 4096 + 512 + c.tid]);
            XO[(size_t)m * 512 + c.tid] = (bf16)f2bf(o); }
    }
}
__device__ __forceinline__ float x16_max(float v) { const unsigned u = __builtin_bit_cast(unsigned, v); auto r = __builtin_amdgcn_permlane16_swap(u, u, false, false); return fmaxf(__builtin_bit_cast(float, (unsigned)r[0]), __builtin_bit_cast(float, (unsigned)r[1])); }
__device__ __forceinline__ float x32_max(float v) { const unsigned u = __builtin_bit_cast(unsigned, v); auto r = __builtin_amdgcn_permlane32_swap(u, u, false, false); return fmaxf(__builtin_bit_cast(float, (unsigned)r[0]), __builtin_bit_cast(float, (unsigned)r[1])); }
__device__ __forceinline__ float x16_sum(float v) { const unsigned u = __builtin_bit_cast(unsigned, v); auto r = __builtin_amdgcn_permlane16_swap(u, u, false, false); return __builtin_bit_cast(float, (unsigned)r[0]) + __builtin_bit_cast(float, (unsigned)r[1]); }
__device__ __forceinline__ float x32_sum(float v) { const unsigned u = __builtin_bit_cast(unsigned, v); auto r = __builtin_amdgcn_permlane32_swap(u, u, false, false); return __builtin_bit_cast(float, (unsigned)r[0]) + __builtin_bit_cast(float, (unsigned)r[1]); }
typedef short bf16x8 __attribute__((ext_vector_type(8)));
typedef short bf16x4 __attribute__((ext_vector_type(4)));
__device__ __forceinline__ bf16x4 tr_read4(const unsigned char* p) { return __builtin_amdgcn_ds_read_tr16_b64_v4i16((LAS bf16x4*)p); }
__device__ __forceinline__ bf16x8 cat8(bf16x4 a, bf16x4 b) { return __builtin_shufflevector(a, b, 0, 1, 2, 3, 4, 5, 6, 7); }
__device__ __forceinline__ bf16x8 pack_p8(const f32x4 a, const f32x4 b) {
    u32x4 w; w.x = pg8::cvt_pk_bf16(a[0], a[1]); w.y = pg8::cvt_pk_bf16(a[2], a[3]); w.z = pg8::cvt_pk_bf16(b[0], b[1]); w.w = pg8::cvt_pk_bf16(b[2], b[3]);
    return __builtin_bit_cast(bf16x8, w);
}
__device__ __forceinline__ bf16x8 rope_frag(const bf16x8 xf, const bf16x8 pf, const float* cs, const float* sn, bool lo) {
    float x[8], p[8]; unpack8(__builtin_bit_cast(u32x4, xf), x); unpack8(__builtin_bit_cast(u32x4, pf), p);
    const float sg = lo ? -1.f : 1.f; float o[8];
#pragma unroll
    for (int j = 0; j < 8; ++j) o[j] = x[j] * cs[j] + sg * p[j] * sn[j];
    u32x4 w; w.x = pg8::cvt_pk_bf16(o[0], o[1]); w.y = pg8::cvt_pk_bf16(o[2], o[3]); w.z = pg8::cvt_pk_bf16(o[4], o[5]); w.w = pg8::cvt_pk_bf16(o[6], o[7]);
    return __builtin_bit_cast(bf16x8, w);
}
__device__ __forceinline__ bf16x8 xchg_frag(const bf16x8 v, int lane_xor) { u32x4 u = __builtin_bit_cast(u32x4, v); u32x4 r;
    r.x = (unsigned)__shfl_xor((int)u.x, lane_xor); r.y = (unsigned)__shfl_xor((int)u.y, lane_xor); r.z = (unsigned)__shfl_xor((int)u.z, lane_xor); r.w = (unsigned)__shfl_xor((int)u.w, lane_xor); return __builtin_bit_cast(bf16x8, r); }
constexpr int XA_PITCH = 272;
__device__ __forceinline__ void xattn_mfma(const Ctx& c, const bf16* __restrict__ XQ, const bf16* __restrict__ KVBIG, int layer, bf16* XO) {
    unsigned char* Kl = c.lds; unsigned char* Vl = c.lds + 256 * XA_PITCH;
    const int l = c.lane, n16 = l & 15, g = l >> 4;
    const float scale = 0.08838834764831845f * 1.4426950408889634f;
    for (int unit = c.bid; unit < 256; unit += c.nb) {
        const int b = unit >> 5, h = (unit >> 3) & 3, qc = unit & 7;
        const bf16* kvb = KVBIG + (size_t)(layer * 2048 + b * 256) * 4096 + layer * 1024 + h * 128;
        __syncthreads();
        {
            u32x4 kq[8], vq[8];
#pragma unroll
            for (int j = 0; j < 8; ++j) { const int i = c.tid + NTHR * j, row = i >> 4, ch = i & 15; kq[j] = *(const u32x4*)(kvb + (size_t)row * 4096 + ch * 8); vq[j] = *(const u32x4*)(kvb + (size_t)row * 4096 + 512 + ch * 8); }
#pragma unroll
            for (int j = 0; j < 8; ++j) { const int i = c.tid + NTHR * j, row = i >> 4, ch = i & 15; *(u32x4*)(Kl + row * XA_PITCH + ch * 16) = kq[j]; *(u32x4*)(Vl + row * XA_PITCH + ch * 16) = vq[j]; }
        }
        bf16x8 Qall[4][4];
#pragma unroll
        for (int g4 = 0; g4 < 4; ++g4) { const size_t m = (size_t)b * SEQ + qc * 512 + c.wave * 64 + g4 * 16 + n16;
#pragma unroll
            for (int kk = 0; kk < 4; ++kk) Qall[g4][kk] = *(const bf16x8*)(XQ + m * 512 + h * 128 + 32 * kk + 8 * g); }
        __syncthreads();
#pragma unroll
        for (int g4 = 0; g4 < 4; ++g4) {
            const size_t m = (size_t)b * SEQ + qc * 512 + c.wave * 64 + g4 * 16 + n16;
            bf16x8 Qb[4];
#pragma unroll
            for (int kk = 0; kk < 4; ++kk) Qb[kk] = Qall[g4][kk];
            f32x4 S[16];
#pragma unroll
            for (int j = 0; j < 16; ++j) { S[j] = (f32x4){0.f, 0.f, 0.f, 0.f};
#pragma unroll
                for (int kk = 0; kk < 4; ++kk) { const bf16x8 A = *(const bf16x8*)(Kl + (16 * j + n16) * XA_PITCH + (32 * kk + 8 * g) * 2);
                    S[j] = __builtin_amdgcn_mfma_f32_16x16x32_bf16(A, Qb[kk], S[j], 0, 0, 0); } }
            float mx = -INFINITY;
#pragma unroll
            for (int j = 0; j < 16; ++j) mx = fmaxf(mx, fmaxf(fmaxf(S[j][0], S[j][1]), fmaxf(S[j][2], S[j][3])));
            mx = x32_max(x16_max(mx));
            float sum = 0.f; const float mo = mx * scale;
#pragma unroll
            for (int j = 0; j < 16; ++j) {
#pragma unroll
                for (int r = 0; r < 4; ++r) { const float p = __builtin_amdgcn_exp2f(S[j][r] * scale - mo); S[j][r] = p; sum += p; } }
            sum = x32_sum(x16_sum(sum));
            const float inv = 1.f / sum;
            bf16x8 Pb[8];
#pragma unroll
            for (int jj = 0; jj < 8; ++jj) Pb[jj] = pack_p8(S[2 * jj], S[2 * jj + 1]);
            const int q4 = n16 >> 2, p4 = l & 3;
#pragma unroll
            for (int dt = 0; dt < 8; ++dt) { f32x4 O = (f32x4){0.f, 0.f, 0.f, 0.f};
#pragma unroll
                for (int jj = 0; jj < 8; ++jj) { const unsigned char* vp = Vl + (32 * jj + 4 * g + q4) * XA_PITCH + (16 * dt) * 2 + 8 * p4;
                    const bf16x8 A = cat8(tr_read4(vp), tr_read4(vp + 16 * XA_PITCH));
                    O = __builtin_amdgcn_mfma_f32_16x16x32_bf16(A, Pb[jj], O, 0, 0, 0); }
                u32x2 w; w.x = pg8::cvt_pk_bf16(O[0] * inv, O[1] * inv); w.y = pg8::cvt_pk_bf16(O[2] * inv, O[3] * inv);
                *(u32x2*)(XO + m * 512 + h * 128 + 16 * dt + 4 * g) = w; }
        }
    }
}
__device__ __forceinline__ void diag_cmp_bf16(const Ctx& c, const bf16* A, int lda, const bf16* B, int ldb, int rows, int cols, float* acc) {
    float d2 = 0.f, a2 = 0.f;
    const size_t n = (size_t)rows * cols;
    for (size_t i = (size_t)c.bid * NTHR + c.tid; i < n; i += (size_t)c.nb * NTHR) { const size_t r = i / cols, cc = i % cols; const float a = bf2f(A[r * lda + cc]), b = bf2f(B[r * ldb + cc]); d2 += (a - b) * (a - b); a2 += a * a; }
    d2 = wave_sum(d2); a2 = wave_sum(a2);
    if (c.lane == 0) { atomicAdd(acc, d2); atomicAdd(acc + 1, a2); }
}
constexpr int DA_PITCH = 528, DA_WAVE_BYTES = 32 * DA_PITCH;
__device__ __forceinline__ void dsa_attn_mfma(const Ctx& c, const bf16* __restrict__ QALL, const bf16* __restrict__ KF, const bf16* __restrict__ SEL, const float* __restrict__ ROPEA, bf16* OLY, int m_first, int m_stride, int m_end) {
    unsigned char* Vw = c.lds + c.wave * DA_WAVE_BYTES;
    const int l = c.lane, n16 = l & 15, g = l >> 4, q4 = n16 >> 2, p4 = l & 3, hh = n16 & 7;
    const float scale = 0.08838834764831845f * 1.4426950408889634f;
    bf16x8 K0[9], K1[9];
    int sx0 = 0, sx1 = 0;
    bool qpre = false;
#pragma unroll 1
    for (int m = m_first; m < m_end; m += m_stride) {
        const int b = m / SEQ, t = m % SEQ, limit = ((t >> 6) + 1) * 64, cnt = limit < 256 ? limit : 256, nblk = cnt >> 5;
        const bf16* qrow = QALL + (size_t)m * QC;
        bf16x8 Qb[9];
        if (qpre) {
#pragma unroll
            for (int kk = 0; kk < 9; ++kk) Qb[kk] = K0[kk];
        } else {
#pragma unroll
            for (int kk = 0; kk < 8; ++kk) Qb[kk] = *(const bf16x8*)(qrow + hh * 256 + 32 * kk + 8 * g);
            Qb[8] = *(const bf16x8*)(qrow + 2048 + hh * 32 + 8 * g);
        }
        {
            const bf16x8 pf = xchg_frag(Qb[8], 32); float cs[8], sn[8];
            const f32x4 c0 = *(const f32x4*)(ROPEA + (size_t)m * 32 + 8 * (g & 1)), c1 = *(const f32x4*)(ROPEA + (size_t)m * 32 + 8 * (g & 1) + 4), s0 = *(const f32x4*)(ROPEA + (size_t)m * 32 + 16 + 8 * (g & 1)), s1 = *(const f32x4*)(ROPEA + (size_t)m * 32 + 16 + 8 * (g & 1) + 4);
            cs[0] = c0.x; cs[1] = c0.y; cs[2] = c0.z; cs[3] = c0.w; cs[4] = c1.x; cs[5] = c1.y; cs[6] = c1.z; cs[7] = c1.w; sn[0] = s0.x; sn[1] = s0.y; sn[2] = s0.z; sn[3] = s0.w; sn[4] = s1.x; sn[5] = s1.y; sn[6] = s1.z; sn[7] = s1.w;
            Qb[8] = rope_frag(Qb[8], pf, cs, sn, g < 2); }
        f32x4 O[16];
#pragma unroll
        for (int dt = 0; dt < 16; ++dt) O[dt] = (f32x4){0.f, 0.f, 0.f, 0.f};
        float mrun = -INFINITY, lrun = 0.f;
        const unsigned short* selp = (const unsigned short*)SEL + (size_t)m * 256;
        const bf16* kfb = KF + (size_t)b * SEQ * KFW;
#define DA_IDX(BLK) do { sx0 = selp[32 * (BLK) + n16]; sx1 = selp[32 * (BLK) + 16 + n16]; } while (0)
#define DA_GATHER() do { const bf16* r0_ = kfb + (size_t)sx0 * KFW + 8 * g; const bf16* r1_ = kfb + (size_t)sx1 * KFW + 8 * g; \
            _Pragma("unroll") for (int kk = 0; kk < 9; ++kk) { K0[kk] = *(const bf16x8*)(r0_ + 32 * kk); K1[kk] = *(const bf16x8*)(r1_ + 32 * kk); } } while (0)
        if (!qpre) DA_IDX(0);
        DA_GATHER(); DA_IDX(nblk > 1 ? 1 : 0);
#pragma unroll 1
        for (int blk = 0; blk < nblk; ++blk) {
            f32x4 S0 = (f32x4){0.f, 0.f, 0.f, 0.f}, S1 = (f32x4){0.f, 0.f, 0.f, 0.f};
#pragma unroll
            for (int kk = 0; kk < 9; ++kk) { S0 = __builtin_amdgcn_mfma_f32_16x16x32_bf16(K0[kk], Qb[kk], S0, 0, 0, 0); S1 = __builtin_amdgcn_mfma_f32_16x16x32_bf16(K1[kk], Qb[kk], S1, 0, 0, 0); }
#pragma unroll
            for (int kk = 0; kk < 8; ++kk) { *(bf16x8*)(Vw + n16 * DA_PITCH + (32 * kk + 8 * g) * 2) = K0[kk]; *(bf16x8*)(Vw + (16 + n16) * DA_PITCH + (32 * kk + 8 * g) * 2) = K1[kk]; }
            __builtin_amdgcn_sched_barrier(0);
            if (blk + 1 < nblk) { DA_GATHER(); DA_IDX(blk + 2 < nblk ? blk + 2 : blk + 1); }
            else if (m + m_stride < m_end) {
                const bf16* qn = QALL + (size_t)(m + m_stride) * QC;
#pragma unroll
                for (int kk = 0; kk < 8; ++kk) K0[kk] = *(const bf16x8*)(qn + hh * 256 + 32 * kk + 8 * g);
                K0[8] = *(const bf16x8*)(qn + 2048 + hh * 32 + 8 * g);
                { const unsigned short* seln = (const unsigned short*)SEL + (size_t)(m + m_stride) * 256; sx0 = seln[n16]; sx1 = seln[16 + n16]; } }
            __builtin_amdgcn_sched_barrier(0);
            float bm = fmaxf(fmaxf(fmaxf(S0[0], S0[1]), fmaxf(S0[2], S0[3])), fmaxf(fmaxf(S1[0], S1[1]), fmaxf(S1[2], S1[3])));
            bm = x32_max(x16_max(bm));
            const float mnew = fmaxf(mrun, bm), alpha = __builtin_amdgcn_exp2f((mrun - mnew) * scale), mo = mnew * scale; mrun = mnew;
            float ps = 0.f;
#pragma unroll
            for (int r = 0; r < 4; ++r) { S0[r] = __builtin_amdgcn_exp2f(S0[r] * scale - mo); S1[r] = __builtin_amdgcn_exp2f(S1[r] * scale - mo); ps += S0[r] + S1[r]; }
            lrun = lrun * alpha + ps;
            const bf16x8 Pb = pack_p8(S0, S1);
#pragma unroll
            for (int dt = 0; dt < 16; ++dt) { O[dt] = O[dt] * alpha;
                const unsigned char* vp = Vw + (4 * g + q4) * DA_PITCH + (16 * dt) * 2 + 8 * p4;
                const bf16x8 A = cat8(tr_read4(vp), tr_read4(vp + 16 * DA_PITCH));
                O[dt] = __builtin_amdgcn_mfma_f32_16x16x32_bf16(A, Pb, O[dt], 0, 0, 0); }
        }
#undef DA_GATHER
#undef DA_IDX
        qpre = (m + m_stride < m_end);
        lrun = x32_sum(x16_sum(lrun));
        const float inv = 1.f / lrun;
        if (n16 < 8) {
            bf16* orow = OLY + (size_t)m * OC + n16 * 256 + 4 * g;
#pragma unroll
            for (int dt = 0; dt < 16; ++dt) { u32x2 w; w.x = pg8::cvt_pk_bf16(O[dt][0] * inv, O[dt][1] * inv); w.y = pg8::cvt_pk_bf16(O[dt][2] * inv, O[dt][3] * inv); *(u32x2*)(orow + 16 * dt) = w; }
        }
    }
}
__device__ __forceinline__ void dsa_attn_queue(const Ctx& c, const bf16* __restrict__ QALL, const bf16* __restrict__ KF, const bf16* __restrict__ SEL, const float* __restrict__ ROPEA, bf16* OLY, unsigned* counter, volatile LAS unsigned* slot) {
    for (;;) {
        __syncthreads();
        if (c.tid == 0) *slot = __hip_atomic_fetch_add(counter, 1u, __ATOMIC_RELAXED, __HIP_MEMORY_SCOPE_AGENT);
        __syncthreads();
        const int chunk = (int)*slot;
        if (chunk >= M / 16) break;
        dsa_attn_mfma(c, QALL, KF, SEL, ROPEA, OLY, chunk * 16 + c.wave, 8, chunk * 16 + 16);
    }
}
__device__ __forceinline__ float relu1(float x) { const int b = __builtin_bit_cast(int, x); return __builtin_bit_cast(float, b > 0 ? b : 0); }
__device__ __forceinline__ void idx_topk_mfma(const Ctx& c, const bf16* __restrict__ QALL, const bf16* __restrict__ KIDX, const float* __restrict__ WIDX, const float* __restrict__ ROPEI, float* scr, bf16* SEL, int nitems) {
    const int l = c.lane, n16 = l & 15, g = l >> 4, qg = c.wave & 3, kh = c.wave >> 2;
#pragma unroll 1
    for (int item = c.bid; item < nitems; item += c.nb) {
        const int b = item >> 5, pr = item & 31;
#pragma unroll 1
        for (int which = 0; which < 2; ++which) {
            const int ch = which ? 63 - pr : pr, L = 64 * (ch + 1), t0 = 64 * ch;
            if (L > 256) {
            const size_t m = (size_t)b * SEQ + t0 + 16 * qg + n16;
            float* srow = scr + (size_t)(16 * qg + n16) * L + 4 * g;
            const int nt = L >> 5, j0 = kh * nt, j1 = j0 + nt;
            const bf16* kp = KIDX + ((size_t)b * SEQ + n16) * 64 + 8 * g;
            {
                bf16x8 Qi[16][2]; float w[16];
                { const bf16* qp = QALL + m * QC + 2304 + 8 * g;
#pragma unroll
                  for (int h = 0; h < 16; ++h) { Qi[h][0] = *(const bf16x8*)(qp + h * 64); Qi[h][1] = *(const bf16x8*)(qp + h * 64 + 32); }
                  {
                      float cs[8], sn[8]; const f32x4 c0 = *(const f32x4*)(ROPEI + m * 16), c1 = *(const f32x4*)(ROPEI + m * 16 + 4), s0 = *(const f32x4*)(ROPEI + m * 16 + 8), s1 = *(const f32x4*)(ROPEI + m * 16 + 12);
                      cs[0] = c0.x; cs[1] = c0.y; cs[2] = c0.z; cs[3] = c0.w; cs[4] = c1.x; cs[5] = c1.y; cs[6] = c1.z; cs[7] = c1.w; sn[0] = s0.x; sn[1] = s0.y; sn[2] = s0.z; sn[3] = s0.w; sn[4] = s1.x; sn[5] = s1.y; sn[6] = s1.z; sn[7] = s1.w;
#pragma unroll
                      for (int h = 0; h < 16; ++h) { const bf16x8 pf = xchg_frag(Qi[h][0], 16); const bf16x8 rf = rope_frag(Qi[h][0], pf, cs, sn, g == 0); if (g < 2) Qi[h][0] = rf; } }
                  const f32x4* wp = (const f32x4*)(WIDX + m * 16);
#pragma unroll
                  for (int q = 0; q < 4; ++q) { const f32x4 v = wp[q]; w[4 * q] = v.x; w[4 * q + 1] = v.y; w[4 * q + 2] = v.z; w[4 * q + 3] = v.w; } }
                bf16x8 Ka = *(const bf16x8*)(kp + (size_t)j0 * 1024), Kb = *(const bf16x8*)(kp + (size_t)j0 * 1024 + 32);
#pragma unroll 1
                for (int j = j0; j < j1; ++j) {
                    const int jn = (j + 1 < j1) ? j + 1 : j;
                    const bf16x8 Na = *(const bf16x8*)(kp + (size_t)jn * 1024), Nb = *(const bf16x8*)(kp + (size_t)jn * 1024 + 32);
                    f32x2 s01 = (f32x2){0.f, 0.f}, s23 = (f32x2){0.f, 0.f};
                    f32x4 a = __builtin_amdgcn_mfma_f32_16x16x32_bf16(Ka, Qi[0][0], (f32x4){0.f, 0.f, 0.f, 0.f}, 0, 0, 0); a = __builtin_amdgcn_mfma_f32_16x16x32_bf16(Kb, Qi[0][1], a, 0, 0, 0);
#pragma unroll
                    for (int h = 0; h < 16; ++h) { f32x4 an = a;
                        if (h < 15) { an = __builtin_amdgcn_mfma_f32_16x16x32_bf16(Ka, Qi[h + 1][0], (f32x4){0.f, 0.f, 0.f, 0.f}, 0, 0, 0); an = __builtin_amdgcn_mfma_f32_16x16x32_bf16(Kb, Qi[h + 1][1], an, 0, 0, 0); }
                        const f32x2 wv = (f32x2){w[h], w[h]};
                        s01 = (f32x2){relu1(a[0]), relu1(a[1])} * wv + s01; s23 = (f32x2){relu1(a[2]), relu1(a[3])} * wv + s23; a = an; }
                    *(f32x4*)(srow + 16 * j) = (f32x4){s01.x, s01.y, s23.x, s23.y};
                    Ka = Na; Kb = Nb;
                }
            }
            }
            asm volatile("s_waitcnt vmcnt(0)" ::: "memory");
            __syncthreads();
            __builtin_amdgcn_fence(__ATOMIC_ACQUIRE, "agent");
            asm volatile("s_waitcnt vmcnt(0)" ::: "memory");
#pragma unroll 1
            for (int i = 0; i < 8; ++i) {
                const int ql = c.wave * 8 + i;
                unsigned short* sel = (unsigned short*)SEL + ((size_t)b * SEQ + t0 + ql) * 256;
                if (L <= 256) { for (int k = l; k < 256; k += 64) sel[k] = (unsigned short)(k < L ? k : 0); }
                else select_row_bs(scr + (size_t)ql * L, L, sel, l, (unsigned short*)(c.lds + c.wave * 512));
            }
            __syncthreads();
        }
    }
}
__device__ __forceinline__ void diag_cmp_sel(const Ctx& c, const bf16* SA, const bf16* SB, int nbatch, float* acc) {
    unsigned* bm = (unsigned*)(c.lds + c.wave * 512);
    float miss = 0.f, tot = 0.f;
    for (int m = c.gw; m < nbatch * SEQ; m += c.ngw) {
        const int t = m % SEQ; if (t < 256) continue;
        bm[c.lane] = 0u; bm[64 + c.lane] = 0u;
        __builtin_amdgcn_fence(__ATOMIC_RELEASE, "wavefront"); __builtin_amdgcn_wave_barrier();
        for (int i = c.lane; i < 256; i += 64) { const unsigned s = ((const unsigned short*)SA)[(size_t)m * 256 + i]; atomicOr(&bm[s >> 5], 1u << (s & 31)); }
        __builtin_amdgcn_fence(__ATOMIC_RELEASE, "wavefront"); __builtin_amdgcn_wave_barrier(); __builtin_amdgcn_fence(__ATOMIC_ACQUIRE, "wavefront");
        for (int i = c.lane; i < 256; i += 64) { const unsigned s = ((const unsigned short*)SB)[(size_t)m * 256 + i]; miss += ((bm[s >> 5] >> (s & 31)) & 1u) ? 0.f : 1.f; tot += 1.f; }
        __builtin_amdgcn_fence(__ATOMIC_RELEASE, "wavefront"); __builtin_amdgcn_wave_barrier();
    }
    miss = wave_sum(miss); tot = wave_sum(tot);
    if (c.lane == 0) { atomicAdd(acc, miss); atomicAdd(acc + 1, tot); }
}
__device__ __forceinline__ void idx_topk_lds(const Ctx& c, const bf16* __restrict__ QALL, const bf16* __restrict__ KIDX, const float* __restrict__ WIDX, const float* __restrict__ ROPEI, u32x4* qscr, bf16* SEL, int nitems) {
    float* SCL = (float*)c.lds;
    f32x4* WL = (f32x4*)(c.lds + 131072);
    const int w8 = c.wave;
#pragma unroll 1
    for (int item = c.bid; item < nitems; item += c.nb) {
        const int b = item >> 5, pr = item & 31;
#pragma unroll 1
        for (int which = 0; which < 2; ++which) {
            int l = c.lane; asm volatile("" : "+v"(l));
            const int n16 = l & 15, g = l >> 4;
            const int ch = which ? 63 - pr : pr, L = 64 * (ch + 1), t0 = 64 * ch;
            if (L <= 256) {
#pragma unroll 1
                for (int i = 0; i < 8; ++i) { unsigned short* sel = (unsigned short*)SEL + ((size_t)b * SEQ + t0 + w8 * 8 + i) * 256; for (int k = l; k < 256; k += 64) sel[k] = (unsigned short)(k < L ? k : 0); }
                continue;
            }
            __syncthreads();
            if (w8 < 4) {
                const size_t m = (size_t)b * SEQ + t0 + 16 * w8 + n16;
                const bf16* qp = QALL + m * QC + 2304 + 8 * g;
                float cs[8], sn[8]; const f32x4 c0 = *(const f32x4*)(ROPEI + m * 16), c1 = *(const f32x4*)(ROPEI + m * 16 + 4), s0 = *(const f32x4*)(ROPEI + m * 16 + 8), s1 = *(const f32x4*)(ROPEI + m * 16 + 12);
                cs[0] = c0.x; cs[1] = c0.y; cs[2] = c0.z; cs[3] = c0.w; cs[4] = c1.x; cs[5] = c1.y; cs[6] = c1.z; cs[7] = c1.w; sn[0] = s0.x; sn[1] = s0.y; sn[2] = s0.z; sn[3] = s0.w; sn[4] = s1.x; sn[5] = s1.y; sn[6] = s1.z; sn[7] = s1.w;
#pragma unroll 4
                for (int h = 0; h < 16; ++h) { bf16x8 f0 = *(const bf16x8*)(qp + h * 64); const bf16x8 f1 = *(const bf16x8*)(qp + h * 64 + 32);
                    const bf16x8 pf = xchg_frag(f0, 16); const bf16x8 rf = rope_frag(f0, pf, cs, sn, g == 0); if (g < 2) f0 = rf;
                    qscr[(w8 * 64 + l) * 32 + h * 2] = __builtin_bit_cast(u32x4, f0); qscr[(w8 * 64 + l) * 32 + h * 2 + 1] = __builtin_bit_cast(u32x4, f1); }
            }
            asm volatile("s_waitcnt vmcnt(0)" ::: "memory");
            __syncthreads();
            __builtin_amdgcn_fence(__ATOMIC_ACQUIRE, "agent"); asm volatile("s_waitcnt vmcnt(0)" ::: "memory");
            const bf16* kp = KIDX + ((size_t)b * SEQ + n16) * 64 + 8 * g;
            const int ntile = L >> 4;
#pragma unroll 1
            for (int qsub = 0; qsub < 8; ++qsub) {
                asm volatile("" ::: "memory");
                bf16x8 Qi[16][2];
                { const int srcl = g * 16 + (qsub & 1) * 8 + (n16 & 7); const u32x4* fp = qscr + (size_t)((qsub >> 1) * 64 + srcl) * 32;
#pragma unroll
                  for (int h = 0; h < 16; ++h) { Qi[h][0] = __builtin_bit_cast(bf16x8, fp[h * 2]); Qi[h][1] = __builtin_bit_cast(bf16x8, fp[h * 2 + 1]); }
                  if (w8 == 0 && l < 32) WL[l] = *(const f32x4*)(WIDX + ((size_t)b * SEQ + t0 + 8 * qsub + (l >> 2)) * 16 + 4 * (l & 3)); }
                __syncthreads();
                const f32x4* wq = WL + (n16 & 7) * 4;
                float* srow = SCL + (n16 & 7) * 4096 + 4 * g;
                int j = w8;
                bf16x8 Ka = *(const bf16x8*)(kp + (size_t)j * 1024), Kb = *(const bf16x8*)(kp + (size_t)j * 1024 + 32);
#pragma unroll 1
                for (; j < ntile; j += 8) {
                    const int jn = (j + 8 < ntile) ? j + 8 : j;
                    const bf16x8 Na = *(const bf16x8*)(kp + (size_t)jn * 1024), Nb = *(const bf16x8*)(kp + (size_t)jn * 1024 + 32);
                    f32x2 s01 = (f32x2){0.f, 0.f}, s23 = (f32x2){0.f, 0.f};
                    f32x4 a = __builtin_amdgcn_mfma_f32_16x16x32_bf16(Ka, Qi[0][0], (f32x4){0.f, 0.f, 0.f, 0.f}, 0, 0, 0); a = __builtin_amdgcn_mfma_f32_16x16x32_bf16(Kb, Qi[0][1], a, 0, 0, 0);
#pragma unroll
                    for (int h4 = 0; h4 < 4; ++h4) { const f32x4 w4 = wq[h4];
#pragma unroll
                        for (int hh = 0; hh < 4; ++hh) { const int h = 4 * h4 + hh; f32x4 an = a;
                            if (h < 15) { an = __builtin_amdgcn_mfma_f32_16x16x32_bf16(Ka, Qi[h + 1][0], (f32x4){0.f, 0.f, 0.f, 0.f}, 0, 0, 0); an = __builtin_amdgcn_mfma_f32_16x16x32_bf16(Kb, Qi[h + 1][1], an, 0, 0, 0); }
                            const f32x2 wv = (f32x2){w4[hh], w4[hh]};
                            s01 = (f32x2){relu1(a[0]), relu1(a[1])} * wv + s01; s23 = (f32x2){relu1(a[2]), relu1(a[3])} * wv + s23; a = an; } }
                    if (n16 < 8) *(f32x4*)(srow + 16 * j) = (f32x4){s01.x, s01.y, s23.x, s23.y};
                    Ka = Na; Kb = Nb;
                }
                __syncthreads();
                select_row(SCL + w8 * 4096, L, (unsigned short*)SEL + ((size_t)b * SEQ + t0 + 8 * qsub + w8) * 256, l);
                __syncthreads();
            }
        }
    }
}
#if DIAG == 7
__device__ __forceinline__ void select_row_v1(const float* row, int limit, unsigned short* sel, int l_in) {
    int l = l_in; asm volatile("" : "+v"(l));
    const int ng = limit >> 9;
    unsigned key[64];
#pragma unroll
    for (int j = 0; j < 64; ++j) { const int s = j * 64 + l; unsigned u = 0u; if (s < limit) { u = __float_as_uint(row[s]); u = (u & 0x80000000u) ? ~u : (u | 0x80000000u); } key[j] = u; }
    unsigned mx = 0u;
#pragma unroll
    for (int j = 0; j < 64; ++j) mx = key[j] > mx ? key[j] : mx;
#pragma unroll
    for (int o = 1; o < 64; o <<= 1) { const unsigned t = (unsigned)__shfl_xor((int)mx, o); mx = t > mx ? t : mx; }
    mx = (unsigned)__builtin_amdgcn_readfirstlane((int)mx);
    unsigned T = 0u;
#pragma unroll 1
    for (int bit = 31 - __builtin_clz(mx | 1u); bit >= 0; --bit) {
        const unsigned Tn = T | (1u << bit); int cnt = 0;
#pragma unroll
        for (int jg = 0; jg < 8; ++jg) if (jg <= ng) {
#pragma unroll
            for (int j = 8 * jg; j < 8 * jg + 8; ++j) cnt += __popcll(__ballot(key[j] >= Tn)); }
        if (cnt >= 256) T = Tn;
        if (cnt == 256) break;
    }
    int cgt = 0;
#pragma unroll
    for (int j = 0; j < 64; ++j) cgt += __popcll(__ballot(key[j] > T));
    const int need_eq = 256 - cgt;
    int base = 0, beq = 0;
    const unsigned long long lt = (1ull << l) - 1ull;
#pragma unroll
    for (int jg = 0; jg < 8; ++jg) if (jg <= ng) {
#pragma unroll
        for (int j = 8 * jg; j < 8 * jg + 8; ++j) {
            const unsigned long long mg = __ballot(key[j] > T), me = __ballot(key[j] == T);
            if (key[j] > T) sel[base + __popcll(mg & lt)] = (unsigned short)(j * 64 + l);
            base += __popcll(mg);
            const int pe = beq + __popcll(me & lt);
            if (key[j] == T && pe < need_eq) sel[cgt + pe] = (unsigned short)(j * 64 + l);
            beq += __popcll(me);
        }
    }
}
__device__ __forceinline__ void idx_topk_v1(const Ctx& c, const bf16* __restrict__ QALL, const bf16* __restrict__ KIDX, const float* __restrict__ WIDX, float* scr, bf16* SEL, int nitems) {
    const int l = c.lane, n16 = l & 15, g = l >> 4, qg = c.wave & 3, kh = c.wave >> 2;
#pragma unroll 1
    for (int item = c.bid; item < nitems; item += c.nb) {
        const int b = item >> 5, pr = item & 31;
#pragma unroll 1
        for (int which = 0; which < 2; ++which) {
            const int ch = which ? 63 - pr : pr, L = 64 * (ch + 1), t0 = 64 * ch;
            if (L > 256) {
            const size_t m = (size_t)b * SEQ + t0 + 16 * qg + n16;
            float* srow = scr + (size_t)(16 * qg + n16) * L + 4 * g;
            const int nt = L >> 5, j0 = kh * nt, j1 = j0 + nt;
            const bf16* kp = KIDX + ((size_t)b * SEQ + n16) * 64 + 8 * g;
#pragma unroll 1
            for (int hp = 0; hp < 2; ++hp) {
                bf16x8 Qi[8][2]; float w[8];
                { const bf16* qp = QALL + m * QC + 2304 + hp * 512 + 8 * g;
#pragma unroll
                  for (int h = 0; h < 8; ++h) { Qi[h][0] = *(const bf16x8*)(qp + h * 64); Qi[h][1] = *(const bf16x8*)(qp + h * 64 + 32); }
                  const f32x4* wp = (const f32x4*)(WIDX + m * 16 + hp * 8);
#pragma unroll
                  for (int q = 0; q < 2; ++q) { const f32x4 v = wp[q]; w[4 * q] = v.x; w[4 * q + 1] = v.y; w[4 * q + 2] = v.z; w[4 * q + 3] = v.w; } }
                if (hp) { asm volatile("s_waitcnt vmcnt(0)" ::: "memory"); __builtin_amdgcn_fence(__ATOMIC_ACQUIRE, "agent"); asm volatile("s_waitcnt vmcnt(0)" ::: "memory"); }
                bf16x8 Ka = *(const bf16x8*)(kp + (size_t)j0 * 1024), Kb = *(const bf16x8*)(kp + (size_t)j0 * 1024 + 32);
                f32x4 pv = (f32x4){0.f, 0.f, 0.f, 0.f}; if (hp) pv = *(const f32x4*)(srow + 16 * j0);
#pragma unroll 1
                for (int j = j0; j < j1; ++j) {
                    const int jn = (j + 1 < j1) ? j + 1 : j;
                    const bf16x8 Na = *(const bf16x8*)(kp + (size_t)jn * 1024), Nb = *(const bf16x8*)(kp + (size_t)jn * 1024 + 32);
                    f32x4 pn = (f32x4){0.f, 0.f, 0.f, 0.f}; if (hp) pn = *(const f32x4*)(srow + 16 * jn);
                    f32x4 sc = pv;
#pragma unroll
                    for (int h = 0; h < 8; ++h) { f32x4 a = __builtin_amdgcn_mfma_f32_16x16x32_bf16(Ka, Qi[h][0], (f32x4){0.f, 0.f, 0.f, 0.f}, 0, 0, 0); a = __builtin_amdgcn_mfma_f32_16x16x32_bf16(Kb, Qi[h][1], a, 0, 0, 0);
                        sc[0] += w[h] * fmaxf(a[0], 0.f); sc[1] += w[h] * fmaxf(a[1], 0.f); sc[2] += w[h] * fmaxf(a[2], 0.f); sc[3] += w[h] * fmaxf(a[3], 0.f); }
                    *(f32x4*)(srow + 16 * j) = sc;
                    Ka = Na; Kb = Nb; pv = pn;
                }
            }
            }
            asm volatile("s_waitcnt vmcnt(0)" ::: "memory");
            __syncthreads();
            __builtin_amdgcn_fence(__ATOMIC_ACQUIRE, "agent");
            asm volatile("s_waitcnt vmcnt(0)" ::: "memory");
#pragma unroll 1
            for (int i = 0; i < 8; ++i) {
                const int ql = c.wave * 8 + i;
                unsigned short* sel = (unsigned short*)SEL + ((size_t)b * SEQ + t0 + ql) * 256;
                if (L <= 256) { for (int k = l; k < 256; k += 64) sel[k] = (unsigned short)(k < L ? k : 0); }
                else select_row_v1(scr + (size_t)ql * L, L, sel, l);
            }
            __syncthreads();
        }
    }
}
#endif
constexpr int RW_TB = 32;
struct RwkvP { const float *mu, *w0, *w2, *a0, *a2, *g2, *k_k, *k_a, *r_k, *ln_w, *ln_b; };
__device__ __forceinline__ void rwkv_phase(const Ctx& c, const bf16* __restrict__ H, const RwkvP P, bf16* OLY) {
    float* A_WR = (float*)c.lds;
    float* A_K2 = A_WR + RW_TB * 64;
    float* A_V = A_K2 + RW_TB * 64;
    float* A_W = A_V + RW_TB * 64;
    float* A_NKK = A_W + RW_TB * 64;
    float* A_B = A_NKK + RW_TB * 64;
    float* A_G = A_B + RW_TB * 64;
    float* A_OUT = A_G + RW_TB * 64;
    float* L_TW = A_OUT + RW_TB * 64;
    float* L_AL = L_TW + RW_TB * 64;
    float* L_SG = L_AL + RW_TB * 64;
    float* SC1 = L_SG + RW_TB * 160; float* SC2 = SC1 + RW_TB; float* SC3 = SC2 + RW_TB;
    const int l = c.lane, w = c.wave;
    for (int item = c.bid; item < NB * 16; item += c.nb) {
        const int b = item >> 4, h = item & 15, hk = h * 64 + l;
        const float w0v = P.w0[hk], a0v = P.a0[hk], kkv = P.k_k[hk], kav = P.k_a[hk], rkv = P.r_k[hk], lnw = P.ln_w[hk], lnb = P.ln_b[hk];
        float S[8];
#pragma unroll
        for (int i = 0; i < 8; ++i) S[i] = 0.f;
        const int srow = w * 8 + (l >> 3), sj = l & 7;
        for (int t0 = 0; t0 < SEQ; t0 += RW_TB) {
            __syncthreads();
            for (int idx = c.tid; idx < RW_TB * 480; idx += NTHR) {
                const int t = idx / 480, cc = idx % 480; int col; float* dst;
                if (cc < 64) { col = 880 + h * 64 + cc; dst = A_WR + t * 64 + cc; }
                else if (cc < 128) { col = 1904 + h * 64 + (cc - 64); dst = A_K2 + t * 64 + (cc - 64); }
                else if (cc < 192) { col = 2928 + h * 64 + (cc - 128); dst = A_V + t * 64 + (cc - 128); }
                else if (cc < 256) { col = 3952 + (cc - 192); dst = L_TW + t * 64 + (cc - 192); }
                else if (cc < 320) { col = 4016 + (cc - 256); dst = L_AL + t * 64 + (cc - 256); }
                else { col = 4080 + (cc - 320); dst = L_SG + t * 160 + (cc - 320); }
                const size_t m = (size_t)b * SEQ + t0 + t;
                const float x = bf2f(H[m * HC + col]); const float xp = (t0 + t > 0) ? bf2f(H[(m - 1) * HC + col]) : 0.f;
                float hm = x + (xp - x) * P.mu[col - 880];
                if (cc >= 192 && cc < 256) hm = tanhf(hm); else if (cc >= 320) hm = sigmoidf_(hm);
                *dst = hm;
            }
            __syncthreads();
            {
                float wl[RW_TB / 8], al[RW_TB / 8], gg[RW_TB / 8];
#pragma unroll
                for (int i = 0; i < RW_TB / 8; ++i) { wl[i] = 0.f; al[i] = 0.f; gg[i] = 0.f; }
                for (int j = 0; j < 64; ++j) { const float w2v = P.w2[(size_t)j * 1024 + hk], a2v = P.a2[(size_t)j * 1024 + hk];
#pragma unroll
                    for (int i = 0; i < RW_TB / 8; ++i) { wl[i] += L_TW[(w + 8 * i) * 64 + j] * w2v; al[i] += L_AL[(w + 8 * i) * 64 + j] * a2v; } }
                for (int j = 0; j < 160; ++j) { const float g2v = P.g2[(size_t)j * 1024 + hk];
#pragma unroll
                    for (int i = 0; i < RW_TB / 8; ++i) gg[i] += L_SG[(w + 8 * i) * 160 + j] * g2v; }
#pragma unroll
                for (int i = 0; i < RW_TB / 8; ++i) {
                    const int t = w + 8 * i, o = t * 64 + l;
                    const float dec = __expf(-0.6065306597126334f * sigmoidf_(w0v + wl[i]));
                    const float a = sigmoidf_(a0v + al[i]);
                    const float kr = A_K2[o], r = A_WR[o];
                    float kk = kr * kkv; const float nrm = wave_sum(kk * kk); kk = kk * (1.0f / sqrtf(fmaxf(nrm, 1e-24f)));
                    const float k2 = kr * (1.f + (a - 1.f) * kav), bb = kk * a;
                    const float s1 = wave_sum(bb * r), s2 = wave_sum(k2 * r), s3 = wave_sum(r * k2 * rkv);
                    A_W[o] = dec; A_NKK[o] = -kk; A_B[o] = bb; A_K2[o] = k2; A_WR[o] = dec * r; A_G[o] = gg[i];
                    if (l == 0) { SC1[t] = s1; SC2[t] = s2; SC3[t] = s3; }
                }
            }
            __syncthreads();
            for (int t = 0; t < RW_TB; ++t) {
                const f32x4* pw = (const f32x4*)(A_W + t * 64 + 8 * sj); const f32x4* pn = (const f32x4*)(A_NKK + t * 64 + 8 * sj); const f32x4* pb = (const f32x4*)(A_B + t * 64 + 8 * sj);
                const f32x4* pk = (const f32x4*)(A_K2 + t * 64 + 8 * sj); const f32x4* pr = (const f32x4*)(A_WR + t * 64 + 8 * sj);
                const f32x4 w0_ = pw[0], w1_ = pw[1], n0 = pn[0], n1 = pn[1], b0 = pb[0], b1 = pb[1], k0 = pk[0], k1 = pk[1], r0 = pr[0], r1 = pr[1];
                const float vv = A_V[t * 64 + srow], s1 = SC1[t], s2 = SC2[t];
                float sa = (S[0] * n0.x + S[1] * n0.y) + (S[2] * n0.z + S[3] * n0.w) + (S[4] * n1.x + S[5] * n1.y) + (S[6] * n1.z + S[7] * n1.w);
                float p = (S[0] * r0.x + S[1] * r0.y) + (S[2] * r0.z + S[3] * r0.w) + (S[4] * r1.x + S[5] * r1.y) + (S[6] * r1.z + S[7] * r1.w);
                sa += __shfl_xor(sa, 1); p += __shfl_xor(p, 1); sa += __shfl_xor(sa, 2); p += __shfl_xor(p, 2); sa += __shfl_xor(sa, 4); p += __shfl_xor(p, 4);
                S[0] = S[0] * w0_.x + (sa * b0.x + vv * k0.x); S[1] = S[1] * w0_.y + (sa * b0.y + vv * k0.y); S[2] = S[2] * w0_.z + (sa * b0.z + vv * k0.z); S[3] = S[3] * w0_.w + (sa * b0.w + vv * k0.w);
                S[4] = S[4] * w1_.x + (sa * b1.x + vv * k1.x); S[5] = S[5] * w1_.y + (sa * b1.y + vv * k1.y); S[6] = S[6] * w1_.z + (sa * b1.z + vv * k1.z); S[7] = S[7] * w1_.w + (sa * b1.w + vv * k1.w);
                if (sj == 0) A_OUT[t * 64 + srow] = p + sa * s1 + vv * s2;
            }
            __syncthreads();
#pragma unroll
            for (int i = 0; i < RW_TB / 8; ++i) {
                const int t = w + 8 * i, o = t * 64 + l;
                const float x = A_OUT[o]; const float mean = wave_sum(x) * (1.f / 64.f); const float dx = x - mean; const float var = wave_sum(dx * dx) * (1.f / 64.f);
                float y = dx * (1.0f / sqrtf(var + 64e-5f)) * lnw + lnb;
                y = (y + SC3[t] * A_V[o]) * A_G[o];
                OLY[((size_t)b * SEQ + t0 + t) * OC + 2048 + hk] = (bf16)f2bf(y);
            }
        }
    }
}

constexpr int S5_TB = 16;
struct S5P { const float *lam_re, *lam_im, *log_dt, *b_re, *b_im, *c_re, *c_im, *d; };
__device__ __forceinline__ float gelu_tanh(float y) { return 0.5f * y * (1.f + tanhf(0.7978845608028654f * (y + 0.044715f * y * y * y))); }
__device__ __forceinline__ void s5_phase(const Ctx& c, const bf16* __restrict__ U, const S5P P, bf16* Z) {
    constexpr int PERW = 256 + 2 * S5_TB * 65 + 2 * 64 * 16;
    float* UU = (float*)c.lds + c.wave * PERW;
    float* XSr = UU + 256; float* XSi = XSr + S5_TB * 65;
    float* CTr = XSi + S5_TB * 65; float* CTi = CTr + 64 * 16;
    const int l = c.lane;
    for (int item = c.bid; item < NB * 16; item += c.nb) {
        const int b = item >> 4, g = (item & 15) * 8 + c.wave;
        __syncthreads();
        float lbr, lbi, Br[16], Bi[16];
        {
            const float lr = fminf(P.lam_re[g * 64 + l], -1e-4f), li = P.lam_im[g * 64 + l], dt = expf(P.log_dt[g]);
            const float e = expf(lr * dt); lbr = e * cosf(li * dt); lbi = e * sinf(li * dt);
            const float nr = lbr - 1.f, ni = lbi, den = 1.f / (lr * lr + li * li);
            const float cr = (nr * lr + ni * li) * den, ci = (ni * lr - nr * li) * den;
#pragma unroll
            for (int i = 0; i < 16; ++i) { const float br = P.b_re[(size_t)(g * 64 + l) * 16 + i], bi = P.b_im[(size_t)(g * 64 + l) * 16 + i]; Br[i] = cr * br - ci * bi; Bi[i] = cr * bi + ci * br; }
#pragma unroll
            for (int o = 0; o < 16; ++o) { CTr[l * 16 + o] = P.c_re[(size_t)(g * 16 + o) * 64 + l]; CTi[l * 16 + o] = P.c_im[(size_t)(g * 16 + o) * 64 + l]; }
        }
        float dsk[4];
#pragma unroll
        for (int e = 0; e < 4; ++e) dsk[e] = P.d[g * 16 + (l >> 4) * 4 + e];
        float xr = 0.f, xi = 0.f;
        for (int t0 = 0; t0 < SEQ; t0 += S5_TB) {
            __syncthreads();
            { const int row = l >> 2, q = l & 3; const u32x2 w2 = *(const u32x2*)(U + ((size_t)b * SEQ + t0 + row) * D + g * 16 + 4 * q);
              float* d = UU + row * 16 + 4 * q; d[0] = bf2f(w2.x & 0xffffu); d[1] = bf2f(w2.x >> 16); d[2] = bf2f(w2.y & 0xffffu); d[3] = bf2f(w2.y >> 16); }
            __syncthreads();
            for (int t = 0; t < S5_TB; ++t) {
                const f32x4* up = (const f32x4*)(UU + t * 16); const f32x4 u0 = up[0], u1 = up[1], u2 = up[2], u3 = up[3];
                const float u[16] = {u0.x, u0.y, u0.z, u0.w, u1.x, u1.y, u1.z, u1.w, u2.x, u2.y, u2.z, u2.w, u3.x, u3.y, u3.z, u3.w};
                float bur = 0.f, bui = 0.f;
#pragma unroll
                for (int i = 0; i < 16; ++i) { bur += Br[i] * u[i]; bui += Bi[i] * u[i]; }
                const float nxr = lbr * xr - lbi * xi + bur, nxi = lbr * xi + lbi * xr + bui; xr = nxr; xi = nxi;
                XSr[t * 65 + l] = xr; XSi[t * 65 + l] = xi;
            }
            __syncthreads();
            {   const int t = l & 15, oq = l >> 4; float y[4] = {0.f, 0.f, 0.f, 0.f};
                for (int p = 0; p < 64; ++p) { const float a = XSr[t * 65 + p], bb = XSi[t * 65 + p]; const f32x4 cr = *(const f32x4*)(CTr + p * 16 + oq * 4), ci = *(const f32x4*)(CTi + p * 16 + oq * 4);
                    y[0] += a * cr.x - bb * ci.x; y[1] += a * cr.y - bb * ci.y; y[2] += a * cr.z - bb * ci.z; y[3] += a * cr.w - bb * ci.w; }
                float z[4];
#pragma unroll
                for (int e = 0; e < 4; ++e) z[e] = gelu_tanh(y[e] + dsk[e] * UU[t * 16 + oq * 4 + e]);
                u32x2 o; o.x = pk2(z[0], z[1]); o.y = pk2(z[2], z[3]);
                *(u32x2*)(Z + ((size_t)b * SEQ + t0 + t) * D + g * 16 + oq * 4) = o; }
        }
    }
}
template <int CTRL> __device__ __forceinline__ float dpp_mov(float v) { return __builtin_bit_cast(float, __builtin_amdgcn_update_dpp(0, __builtin_bit_cast(int, v), CTRL, 0xf, 0xf, true)); }
__device__ __forceinline__ float sum8(float v) { v += dpp_mov<0xB1>(v); v += dpp_mov<0x4E>(v); v += dpp_mov<0x141>(v); return v; }
__device__ __forceinline__ float wave_sum_fast(float v) { v += dpp_mov<0xB1>(v); v += dpp_mov<0x4E>(v); v += dpp_mov<0x141>(v); v += dpp_mov<0x140>(v); v += __shfl_xor(v, 16); v += __shfl_xor(v, 32); return v; }
__device__ __forceinline__ float fast_tanh(float x) { const float e = __expf(2.f * x); return 1.f - 2.f * __builtin_amdgcn_rcpf(e + 1.f); }
__device__ __forceinline__ void rwkv_lora_prep(const Ctx& c, const bf16* __restrict__ H, const float* __restrict__ mu, bf16* LX) {
    const int l = c.lane;
    const int per = (M + c.ngw - 1) / c.ngw;
    const int mA = c.gw * per, mE = (mA + per < M) ? mA + per : M;
    if (l < 36 && mA < M) {
        const int col = 3952 + 8 * l;
        const f32x4 m0 = *(const f32x4*)(mu + 3072 + 8 * l), m1 = *(const f32x4*)(mu + 3072 + 8 * l + 4);
        const float mv[8] = {m0.x, m0.y, m0.z, m0.w, m1.x, m1.y, m1.z, m1.w};
        float p[8];
        if ((mA % SEQ) > 0) unpack8(*(const u32x4*)(H + (size_t)(mA - 1) * HC + col), p); else {
#pragma unroll
            for (int j = 0; j < 8; ++j) p[j] = 0.f; }
#pragma unroll 1
        for (int mb = mA; mb < mE; mb += 8) {
            u32x4 rq[8];
#pragma unroll
            for (int i = 0; i < 8; ++i) { const int mm = (mb + i < mE) ? mb + i : mE - 1; rq[i] = *(const u32x4*)(H + (size_t)mm * HC + col); }
#pragma unroll
            for (int i = 0; i < 8; ++i) { const int m = mb + i;
                if (m < mE) {
                    float x[8]; unpack8(rq[i], x);
                    if ((m % SEQ) == 0) {
#pragma unroll
                        for (int j = 0; j < 8; ++j) p[j] = 0.f; }
                    float hm[8];
#pragma unroll
                    for (int j = 0; j < 8; ++j) { float v = x[j] + (p[j] - x[j]) * mv[j]; if (l < 8) v = fast_tanh(v); else if (l >= 16) v = sigmoidf_(v); hm[j] = v; p[j] = x[j]; }
                    u32x4 o; o.x = pg8::cvt_pk_bf16(hm[0], hm[1]); o.y = pg8::cvt_pk_bf16(hm[2], hm[3]); o.z = pg8::cvt_pk_bf16(hm[4], hm[5]); o.w = pg8::cvt_pk_bf16(hm[6], hm[7]);
                    *(u32x4*)(LX + (size_t)m * 288 + 8 * l) = o;
                }
            }
        }
    }
}
constexpr int RW2_RAWP = 384;
constexpr int RW2_TWP = 144, RW2_SGP = 336;
__device__ __forceinline__ void rwkv_phase2(const Ctx& c, const bf16* __restrict__ H, const bf16* __restrict__ LX, const RwkvP P, bf16* OUT, int ldo, int coloff, int wb = NB) {
    unsigned char* RAW = c.lds;
    float* A_WR = (float*)(c.lds + 12800);
    float* A_K2 = A_WR + 2048; float* A_V = A_K2 + 2048; float* A_W = A_V + 2048; float* A_NKK = A_W + 2048; float* A_B = A_NKK + 2048; float* A_G = A_B + 2048; float* A_OUT = A_G + 2048;
    float* LO_W = A_OUT + 2048; float* LO_A = LO_W + 2048; float* PR3 = LO_A + 2048;
    unsigned char* L_TW = (unsigned char*)(PR3 + 2048); unsigned char* L_AL = L_TW + 32 * RW2_TWP; unsigned char* L_SG = L_AL + 32 * RW2_TWP;
    float* MU = (float*)(L_SG + 32 * RW2_SGP); float* SC3 = MU + 480 + 64;
    unsigned char* G2T = (unsigned char*)(SC3 + 32);
    float* SCP = (float*)(G2T + 64 * RW2_SGP);
    float* GN = SCP + 128; float* CST = GN + 64;
    float* PR0 = (float*)L_TW; float* PR1 = PR0 + 2048; float* PR2 = A_OUT;
    const int l = c.lane, w = c.wave, n16 = l & 15, g = l >> 4;
#pragma unroll 1
    for (int item = c.bid; item < NB * 16; item += c.nb) {
        const int b = item >> 4, h = item & 15, hk = h * 64 + l;
        __syncthreads();
        if (w < 7) { const float* src = w == 0 ? P.w0 : w == 1 ? P.a0 : w == 2 ? P.k_k : w == 3 ? P.k_a : w == 4 ? P.r_k : w == 5 ? P.ln_w : P.ln_b; CST[w * 64 + l] = src[hk]; }
#pragma unroll 1
        for (int qb = 0; qb < 20; qb += 5) {
            float gq[5];
#pragma unroll
            for (int q = 0; q < 5; ++q) { const int i = c.tid + NTHR * (qb + q); gq[q] = P.g2[(size_t)(i >> 6) * 1024 + h * 64 + (i & 63)]; }
#pragma unroll
            for (int q = 0; q < 5; ++q) { const int i = c.tid + NTHR * (qb + q); *(unsigned short*)(G2T + (i & 63) * RW2_SGP + (i >> 6) * 2) = (unsigned short)f2bf(gq[q]); }
        }
        for (int i = c.tid; i < 192; i += NTHR) { const int mi = i < 64 ? h * 64 + i : i < 128 ? 1024 + h * 64 + (i - 64) : 2048 + h * 64 + (i - 128); MU[i] = P.mu[mi]; }
        const int tt = w >> 2, nt = w & 3;
        bf16x8 W2B[2], A2B[2];
        { const int kc = h * 64 + 16 * nt + n16;
          auto ldfrag = [&](const float* Wp, int kk) -> bf16x8 { float f[8]; int gq = g, kq = kc; asm volatile("" : "+v"(gq), "+v"(kq));
              const float* wp = Wp + (size_t)(32 * kk + 8 * gq) * 1024 + kq;
#pragma unroll
              for (int q = 0; q < 8; ++q) f[q] = wp[q * 1024];
              u32x4 u; u.x = pk2(f[0], f[1]); u.y = pk2(f[2], f[3]); u.z = pk2(f[4], f[5]); u.w = pk2(f[6], f[7]);
              asm volatile("" : "+v"(u));
              return __builtin_bit_cast(bf16x8, u); };
          W2B[0] = ldfrag(P.w2, 0); W2B[1] = ldfrag(P.w2, 1); A2B[0] = ldfrag(P.a2, 0); A2B[1] = ldfrag(P.a2, 1);
        }
        f32x2 S[4];
#pragma unroll
        for (int i = 0; i < 4; ++i) S[i] = (f32x2){0.f, 0.f};
        const int srow = w * 8 + 2 * (l >> 4), sj = l & 15;
        u32x4 raw[4];
        int goff[4]; unsigned ldst[4];
        { const long offL = (const char*)LX - (const char*)H;
#pragma unroll
          for (int k = 0; k < 4; ++k) { const int q_ = c.tid + 512 * k;
              if (q_ < 792) { const int cq_ = q_ % 24, row_ = q_ / 24; const int rc_ = (cq_ < 8 ? 880 : cq_ < 16 ? 1904 - 64 : 2928 - 128) + h * 64 + cq_ * 8;
                  goff[k] = (int)((((long)b * SEQ + row_ - 1) * HC + rc_) * 2); ldst[k] = (unsigned)((RAW - c.lds) + row_ * RW2_RAWP + cq_ * 16); }
              else { int e_ = q_ - 792; const bool ok_ = e_ < 1152; e_ = ok_ ? e_ : 0; const int t_ = e_ / 36, p_ = e_ % 36;
                  goff[k] = (int)(offL + (((long)b * SEQ + t_) * 288 + p_ * 8) * 2);
                  const unsigned char* d_ = p_ < 8 ? L_TW + t_ * RW2_TWP + p_ * 16 : p_ < 16 ? L_AL + t_ * RW2_TWP + (p_ - 8) * 16 : L_SG + t_ * RW2_SGP + (p_ - 16) * 16;
                  ldst[k] = ok_ ? (unsigned)(d_ - c.lds) : 0xffffffffu; } } }
#define RW2_LOAD(T0) do { _Pragma("unroll") for (int k = 0; k < 4; ++k) { \
            const int sb_ = (k == 0) ? HC * 2 : (k >= 2) ? 576 : ((c.tid + 512 < 792) ? HC * 2 : 576); \
            raw[k] = *(const u32x4*)((const char*)H + (long)(goff[k] + (T0) * sb_)); } } while (0)
        RW2_LOAD(0);
#pragma unroll 1
        for (int t0 = 0; t0 < SEQ; t0 += 32) {
            __syncthreads();
#pragma unroll
            for (int k = 0; k < 4; ++k) {
                u32x4 v_ = raw[k]; if (k == 0 && t0 == 0 && c.tid < 24) v_ = (u32x4){0u, 0u, 0u, 0u};
                if (k < 3 || ldst[k] != 0xffffffffu) *(u32x4*)(c.lds + ldst[k]) = v_; }
            { const int tn_ = (t0 + 32 < SEQ) ? t0 + 32 : t0; RW2_LOAD(tn_); }
            __syncthreads();
            if (c.tid < 384) {
                const int cpi = c.tid % 96, qb = c.tid / 96, cp = cpi * 2, tb = qb * 8;
                const float mu0 = MU[cp], mu1 = MU[cp + 1];
                unsigned xq[9];
#pragma unroll
                for (int t = 0; t < 9; ++t) xq[t] = *(const unsigned*)(RAW + (tb + t) * RW2_RAWP + cp * 2);
                const unsigned xb = xq[0];
                float p0 = bf2f(xb & 0xffffu), p1 = bf2f(xb >> 16);
                float* dst = (cp < 64 ? A_WR + cp : cp < 128 ? A_K2 + (cp - 64) : A_V + (cp - 128)) + tb * 64;
#pragma unroll
                for (int t = 0; t < 8; ++t) { const unsigned xa = xq[t + 1]; const float x0 = bf2f(xa & 0xffffu), x1 = bf2f(xa >> 16);
                    *(f32x2*)(dst + t * 64) = (f32x2){x0 + (p0 - x0) * mu0, x1 + (p1 - x1) * mu1}; p0 = x0; p1 = x1; }
            }
            {
                f32x4 aw = (f32x4){0.f, 0.f, 0.f, 0.f}, aa = aw, ag = aw;
#pragma unroll
                for (int kk = 0; kk < 2; ++kk) { const bf16x8 At = *(const bf16x8*)(L_TW + (16 * tt + n16) * RW2_TWP + (32 * kk + 8 * g) * 2), Aa = *(const bf16x8*)(L_AL + (16 * tt + n16) * RW2_TWP + (32 * kk + 8 * g) * 2);
                    aw = __builtin_amdgcn_mfma_f32_16x16x32_bf16(At, W2B[kk], aw, 0, 0, 0); aa = __builtin_amdgcn_mfma_f32_16x16x32_bf16(Aa, A2B[kk], aa, 0, 0, 0); }
#pragma unroll
                for (int kk = 0; kk < 5; ++kk) { const bf16x8 Ag = *(const bf16x8*)(L_SG + (16 * tt + n16) * RW2_SGP + (32 * kk + 8 * g) * 2); const bf16x8 Gb = *(const bf16x8*)(G2T + (16 * nt + n16) * RW2_SGP + (32 * kk + 8 * g) * 2); ag = __builtin_amdgcn_mfma_f32_16x16x32_bf16(Ag, Gb, ag, 0, 0, 0); }
#pragma unroll
                for (int r = 0; r < 4; ++r) { const int o = (16 * tt + 4 * g + r) * 64 + 16 * nt + n16; LO_W[o] = aw[r]; LO_A[o] = aa[r]; A_G[o] = ag[r]; }
            }
            __syncthreads();
            {
                const float w0v = CST[l], a0v = CST[64 + l], kkv = CST[128 + l], kav = CST[192 + l], rkv = CST[256 + l];
                float lw_[4], la_[4], kr_[4], r_[4];
#pragma unroll
                for (int i = 0; i < 4; ++i) { const int o = (w + 8 * i) * 64 + l; lw_[i] = LO_W[o]; la_[i] = LO_A[o]; kr_[i] = A_K2[o]; r_[i] = A_WR[o]; }
#pragma unroll
                for (int i = 0; i < 4; ++i) { const int o = (w + 8 * i) * 64 + l;
                    const float dec = __expf(-0.6065306597126334f * sigmoidf_(w0v + lw_[i]));
                    const float a = sigmoidf_(a0v + la_[i]);
                    const float kr = kr_[i], r = r_[i];
                    const float kk0 = kr * kkv, k2 = kr * (1.f + (a - 1.f) * kav), bb0 = kk0 * a, k2r = k2 * r;
                    A_W[o] = dec; A_NKK[o] = -kk0; A_B[o] = bb0; A_K2[o] = k2; A_WR[o] = dec * r;
                    PR0[o] = kk0 * kk0; PR1[o] = bb0 * r; PR2[o] = k2r; PR3[o] = k2r * rkv; }
            }
            __syncthreads();
            {
                const int t = c.tid >> 4, q = (c.tid >> 2) & 3, qu = c.tid & 3;
                const float* src = (q == 0 ? PR0 : q == 1 ? PR1 : q == 2 ? PR2 : PR3) + t * 64 + 16 * qu;
                const f32x4 v0 = *(const f32x4*)src, v1 = *(const f32x4*)(src + 4), v2 = *(const f32x4*)(src + 8), v3 = *(const f32x4*)(src + 12);
                float sm = ((v0.x + v0.y) + (v0.z + v0.w)) + ((v1.x + v1.y) + (v1.z + v1.w)) + ((v2.x + v2.y) + (v2.z + v2.w)) + ((v3.x + v3.y) + (v3.z + v3.w));
                sm += dpp_mov<0xB1>(sm); sm += dpp_mov<0x4E>(sm);
                if (qu == 0) SCP[t * 4 + q] = (q == 0) ? __builtin_amdgcn_rcpf(fmaxf(sm, 1e-24f)) : sm;
            }
            __syncthreads();
#if DBL & 0x4000
            { f32x2 Ssv[4]; Ssv[0] = S[0]; Ssv[1] = S[1]; Ssv[2] = S[2]; Ssv[3] = S[3];
            {
                f32x4 n0, n1, r0, r1, w0_, w1_, b0, b1, k0, k1; f32x3 sp; float vv;
                const unsigned char* pk_ = (const unsigned char*)A_WR + 32 * sj;
                const unsigned char* pv_ = (const unsigned char*)A_WR + 4 * srow;
                const unsigned char* ps_ = (const unsigned char*)SCP;
                constexpr int O_WR = 0, O_K2 = 8192, O_V = 16384, O_W = 24576, O_NKK = 32768, O_B = 40960, O_OUT = 57344;
#define RW2_LD_DOT(T) do { n0 = *(const f32x4*)(pk_ + O_NKK + (T) * 256); n1 = *(const f32x4*)(pk_ + O_NKK + (T) * 256 + 16); r0 = *(const f32x4*)(pk_ + O_WR + (T) * 256); r1 = *(const f32x4*)(pk_ + O_WR + (T) * 256 + 16); } while (0)
#define RW2_LD_UPD(T) do { w0_ = *(const f32x4*)(pk_ + O_W + (T) * 256); w1_ = *(const f32x4*)(pk_ + O_W + (T) * 256 + 16); b0 = *(const f32x4*)(pk_ + O_B + (T) * 256); b1 = *(const f32x4*)(pk_ + O_B + (T) * 256 + 16); \
                    k0 = *(const f32x4*)(pk_ + O_K2 + (T) * 256); k1 = *(const f32x4*)(pk_ + O_K2 + (T) * 256 + 16); vv = *(const float*)(pv_ + O_V + (T) * 256); sp = *(const f32x3*)(ps_ + (T) * 16); } while (0)
#define RW2_STEP(T) do { \
                    f32x2 sa2 = S[0] * (f32x2){n0.x, n0.y}; sa2 = S[1] * (f32x2){n0.z, n0.w} + sa2; sa2 = S[2] * (f32x2){n1.x, n1.y} + sa2; sa2 = S[3] * (f32x2){n1.z, n1.w} + sa2; \
                    f32x2 p2 = S[0] * (f32x2){r0.x, r0.y}; p2 = S[1] * (f32x2){r0.z, r0.w} + p2; p2 = S[2] * (f32x2){r1.x, r1.y} + p2; p2 = S[3] * (f32x2){r1.z, r1.w} + p2; \
                    __builtin_amdgcn_sched_barrier(0); RW2_LD_DOT((T) + 1); __builtin_amdgcn_sched_barrier(0); \
                    const float sa = sum8(sa2.x + sa2.y) * sp.x, p = sum8(p2.x + p2.y); \
                    const f32x2 sav = (f32x2){sa, sa}, vvv = (f32x2){vv, vv}; \
                    S[0] = S[0] * (f32x2){w0_.x, w0_.y} + (sav * (f32x2){b0.x, b0.y} + vvv * (f32x2){k0.x, k0.y}); \
                    S[1] = S[1] * (f32x2){w0_.z, w0_.w} + (sav * (f32x2){b0.z, b0.w} + vvv * (f32x2){k0.z, k0.w}); \
                    S[2] = S[2] * (f32x2){w1_.x, w1_.y} + (sav * (f32x2){b1.x, b1.y} + vvv * (f32x2){k1.x, k1.y}); \
                    S[3] = S[3] * (f32x2){w1_.z, w1_.w} + (sav * (f32x2){b1.z, b1.w} + vvv * (f32x2){k1.z, k1.w}); \
                    const float ov = p + sa * sp.y + vv * sp.z; \
                    __builtin_amdgcn_sched_barrier(0); RW2_LD_UPD((T) + 1); *(float*)(const_cast<unsigned char*>(pv_) + O_OUT + (T) * 256) = ov;        __builtin_amdgcn_sched_barrier(0); } while (0)
                RW2_LD_DOT(0); RW2_LD_UPD(0);
#pragma unroll 1
                for (int t4 = 0; t4 < 8; ++t4) {
                    RW2_STEP(0); RW2_STEP(1); RW2_STEP(2); RW2_STEP(3);
                    pk_ += 1024; pv_ += 1024; ps_ += 64;
                }
#undef RW2_LD_DOT
#undef RW2_LD_UPD
#undef RW2_STEP
            }
            S[0] = Ssv[0]; S[1] = Ssv[1]; S[2] = Ssv[2]; S[3] = Ssv[3]; asm volatile("" : "+v"(S[0]), "+v"(S[1]), "+v"(S[2]), "+v"(S[3])); __syncthreads(); }
#endif
            {
                f32x4 nn, rr, ww, bq, kq; f32x3 sp; f32x2 vv2;
                const unsigned char* pk_ = (const unsigned char*)A_WR + 16 * sj;
                const unsigned char* pv_ = (const unsigned char*)A_WR + 4 * srow;
                const unsigned char* ps_ = (const unsigned char*)SCP;
                constexpr int O_WR = 0, O_K2 = 8192, O_V = 16384, O_W = 24576, O_NKK = 32768, O_B = 40960, O_OUT = 57344;
#define SPL(x) ((f32x2){(x), (x)})
#define RW2_DPP1(R, C) "v_add_f32_dpp " R ", " R ", " R " " C " row_mask:0xf bank_mask:0xf bound_ctrl:1\n\t"
#define RW2_DPP4(C) RW2_DPP1("%0", C) RW2_DPP1("%1", C) RW2_DPP1("%2", C) RW2_DPP1("%3", C)
#define RW2_LD_DOT(T) do { nn = *(const f32x4*)(pk_ + O_NKK + (T) * 256); rr = *(const f32x4*)(pk_ + O_WR + (T) * 256); } while (0)
#define RW2_LD_UPD(T) do { ww = *(const f32x4*)(pk_ + O_W + (T) * 256); bq = *(const f32x4*)(pk_ + O_B + (T) * 256); kq = *(const f32x4*)(pk_ + O_K2 + (T) * 256); \
                    vv2 = *(const f32x2*)(pv_ + O_V + (T) * 256); sp = *(const f32x3*)(ps_ + (T) * 16); } while (0)
#define RW2_STEP(T) do { \
                    f32x2 sa2 = S[0] * SPL(nn.x); sa2 = S[1] * SPL(nn.y) + sa2; sa2 = S[2] * SPL(nn.z) + sa2; sa2 = S[3] * SPL(nn.w) + sa2; \
                    f32x2 p2 = S[0] * SPL(rr.x); p2 = S[1] * SPL(rr.y) + p2; p2 = S[2] * SPL(rr.z) + p2; p2 = S[3] * SPL(rr.w) + p2; \
                    __builtin_amdgcn_sched_barrier(0); RW2_LD_DOT((T) + 1); __builtin_amdgcn_sched_barrier(0); \
                    float sx = sa2.x, sy = sa2.y, px = p2.x, py = p2.y; \
                    asm volatile("s_nop 1\n\t" RW2_DPP4("quad_perm:[1,0,3,2]") RW2_DPP4("quad_perm:[2,3,0,1]") RW2_DPP4("row_half_mirror") RW2_DPP4("row_mirror") : "+v"(sx), "+v"(sy), "+v"(px), "+v"(py)); \
                    const f32x2 sav = (f32x2){sx, sy} * SPL(sp.x); \
                    S[0] = S[0] * SPL(ww.x) + (sav * SPL(bq.x) + vv2 * SPL(kq.x)); \
                    S[1] = S[1] * SPL(ww.y) + (sav * SPL(bq.y) + vv2 * SPL(kq.y)); \
                    S[2] = S[2] * SPL(ww.z) + (sav * SPL(bq.z) + vv2 * SPL(kq.z)); \
                    S[3] = S[3] * SPL(ww.w) + (sav * SPL(bq.w) + vv2 * SPL(kq.w)); \
                    const f32x2 ov2 = (f32x2){px, py} + sav * SPL(sp.y) + vv2 * SPL(sp.z); \
                    __builtin_amdgcn_sched_barrier(0); RW2_LD_UPD((T) + 1); *(f32x2*)(const_cast<unsigned char*>(pv_) + O_OUT + (T) * 256) = ov2;        __builtin_amdgcn_sched_barrier(0); } while (0)
                RW2_LD_DOT(0); RW2_LD_UPD(0);
#pragma unroll 1
                for (int t4 = 0; t4 < 8; ++t4) {
                    RW2_STEP(0); RW2_STEP(1); RW2_STEP(2); RW2_STEP(3);
                    pk_ += 1024; pv_ += 1024; ps_ += 64;
                }
#undef RW2_LD_DOT
#undef RW2_LD_UPD
#undef RW2_STEP
#undef SPL
#undef RW2_DPP1
#undef RW2_DPP4
            }
            __syncthreads();
            {
                const int t = c.tid >> 4, part = c.tid & 15;
                const f32x4 v = *(const f32x4*)(A_OUT + t * 64 + 4 * part);
                float s1 = (v.x + v.y) + (v.z + v.w), s2 = (v.x * v.x + v.y * v.y) + (v.z * v.z + v.w * v.w);
                s1 += dpp_mov<0xB1>(s1); s2 += dpp_mov<0xB1>(s2); s1 += dpp_mov<0x4E>(s1); s2 += dpp_mov<0x4E>(s2);
                s1 += dpp_mov<0x141>(s1); s2 += dpp_mov<0x141>(s2); s1 += dpp_mov<0x140>(s1); s2 += dpp_mov<0x140>(s2);
                if (part == 0) { const float mean = s1 * (1.f / 64.f), var = fmaxf(s2 * (1.f / 64.f) - mean * mean, 0.f); GN[t * 2] = mean; GN[t * 2 + 1] = __builtin_amdgcn_rsqf(var + 64e-5f); }
            }
            __syncthreads();
            {
                float ao[4], gm[4], gr[4], bs[4], av[4], ag[4];
                const float lw = CST[320 + l], lb = CST[384 + l];
#pragma unroll
                for (int i = 0; i < 4; ++i) { const int t = w + 8 * i, o = t * 64 + l; ao[i] = A_OUT[o]; gm[i] = GN[t * 2]; gr[i] = GN[t * 2 + 1]; bs[i] = SCP[t * 4 + 3]; av[i] = A_V[o]; ag[i] = A_G[o]; }
#pragma unroll
                for (int i = 0; i < 4; ++i) { const int t = w + 8 * i;
                    float y = (ao[i] - gm[i]) * gr[i] * lw + lb;
                    y = (y + bs[i] * av[i]) * ag[i];
                    if (b < wb) OUT[((size_t)b * SEQ + t0 + t) * ldo + coloff + hk] = (bf16)f2bf(y); }
            }
        }
#undef RW2_LOAD
    }
}
constexpr int S5B_BUP = 132 * 4, S5B_XP = 272;
constexpr int S5B_WAVE = 16 * S5B_BUP + 16 * S5B_XP;
__device__ __forceinline__ void wave_lds_sync() { __builtin_amdgcn_fence(__ATOMIC_RELEASE, "wavefront"); __builtin_amdgcn_wave_barrier(); __builtin_amdgcn_fence(__ATOMIC_ACQUIRE, "wavefront"); }
__device__ __forceinline__ float gelu_fast(float y) { const float u2 = 1.5957691216057308f * (y + 0.044715f * y * y * y); return y * __builtin_amdgcn_rcpf(1.f + __expf(-u2)); }
__device__ __forceinline__ void s5_phase2(const Ctx& c, const bf16* __restrict__ U, const S5P P, bf16* Z) {
    if (c.wave >= 4) return;
    float* BU = (float*)(c.lds + c.wave * S5B_WAVE); unsigned char* XB = c.lds + c.wave * S5B_WAVE + 16 * S5B_BUP;
    const int l = c.lane, n16 = l & 15, g = l >> 4;
#pragma unroll 1
    for (int item = c.bid; item < 256; item += c.nb) {
        const int b = item >> 5, grp = (item & 31) * 4 + c.wave;
        float lbr, lbi;
        { const float lr = fminf(P.lam_re[grp * 64 + l], -1e-4f), li = P.lam_im[grp * 64 + l], dt = expf(P.log_dt[grp]);
          const float e = expf(lr * dt); lbr = e * cosf(li * dt); lbi = e * sinf(li * dt);
          const float nr = lbr - 1.f, ni = lbi, den = 1.f / (lr * lr + li * li);
          BU[l] = (nr * lr + ni * li) * den; BU[64 + l] = (ni * lr - nr * li) * den; }
        wave_lds_sync();
        bf16x4 Bre[4], Bim[4];
#pragma unroll
        for (int nt = 0; nt < 4; ++nt) { const int p = 16 * nt + n16; const float cr = BU[p], ci = BU[64 + p];
            const f32x4 br = *(const f32x4*)(P.b_re + (size_t)(grp * 64 + p) * 16 + 4 * g), bi = *(const f32x4*)(P.b_im + (size_t)(grp * 64 + p) * 16 + 4 * g);
            u32x2 wr, wi; wr.x = pk2(cr * br.x - ci * bi.x, cr * br.y - ci * bi.y); wr.y = pk2(cr * br.z - ci * bi.z, cr * br.w - ci * bi.w);
            wi.x = pk2(cr * bi.x + ci * br.x, cr * bi.y + ci * br.y); wi.y = pk2(cr * bi.z + ci * br.z, cr * bi.w + ci * br.w);
            Bre[nt] = __builtin_bit_cast(bf16x4, wr); Bim[nt] = __builtin_bit_cast(bf16x4, wi); }
        wave_lds_sync();
        bf16x8 Cf[4];
#pragma unroll
        for (int kk = 0; kk < 4; ++kk) { const int p0 = 16 * kk + 4 * g;
            const f32x4 vr = *(const f32x4*)(P.c_re + (size_t)(grp * 16 + n16) * 64 + p0), vi = *(const f32x4*)(P.c_im + (size_t)(grp * 16 + n16) * 64 + p0);
            u32x4 w; w.x = pk2(vr.x, -vi.x); w.y = pk2(vr.y, -vi.y); w.z = pk2(vr.z, -vi.z); w.w = pk2(vr.w, -vi.w); Cf[kk] = __builtin_bit_cast(bf16x8, w); }
        bf16x4 Df; { const float dsk = P.d[grp * 16 + n16]; const int kq = n16 - 4 * g; u32x2 w; w.x = pk2(kq == 0 ? dsk : 0.f, kq == 1 ? dsk : 0.f); w.y = pk2(kq == 2 ? dsk : 0.f, kq == 3 ? dsk : 0.f); Df = __builtin_bit_cast(bf16x4, w); }
        f32x2 xs = (f32x2){0.f, 0.f};
        const bf16* ub = U + (size_t)b * SEQ * D + grp * 16;
        u32x2 ua[4];
#define S5B_LOAD(k, T0) do { ua[k] = *(const u32x2*)(ub + (size_t)((T0) + n16) * D + 4 * g); } while (0)
#pragma unroll
        for (int k = 0; k < 4; ++k) S5B_LOAD(k, 16 * k);
#pragma unroll 1
        for (int t0 = 0; t0 < SEQ; t0 += 64) {
#pragma unroll
            for (int k = 0; k < 4; ++k) {
                const int tb = t0 + 16 * k;
                const bf16x4 A = __builtin_bit_cast(bf16x4, ua[k]);
                { const int tn = (tb + 64 < SEQ) ? tb + 64 : tb; S5B_LOAD(k, tn); }
                const f32x4 yd = __builtin_amdgcn_mfma_f32_16x16x16bf16_1k(A, Df, (f32x4){0.f, 0.f, 0.f, 0.f}, 0, 0, 0);
#pragma unroll
                for (int nt = 0; nt < 4; ++nt) {
                    const f32x4 ar = __builtin_amdgcn_mfma_f32_16x16x16bf16_1k(A, Bre[nt], (f32x4){0.f, 0.f, 0.f, 0.f}, 0, 0, 0);
                    const f32x4 ai = __builtin_amdgcn_mfma_f32_16x16x16bf16_1k(A, Bim[nt], (f32x4){0.f, 0.f, 0.f, 0.f}, 0, 0, 0);
#pragma unroll
                    for (int r = 0; r < 4; ++r) *(f32x2*)(BU + (4 * g + r) * 132 + 2 * (16 * nt + n16)) = (f32x2){ar[r], ai[r]};
                }
                wave_lds_sync();
#pragma unroll 4
                for (int t = 0; t < 16; ++t) {
                    const f32x2 bu = *(const f32x2*)(BU + t * 132 + 2 * l);
                    const f32x2 tq = (f32x2){lbr, lbr} * xs + bu;
                    xs = (f32x2){-lbi, lbi} * (f32x2){xs.y, xs.x} + tq;
                    *(unsigned*)(XB + t * S5B_XP + l * 4) = pg8::cvt_pk_bf16(xs.x, xs.y);
                }
                wave_lds_sync();
                f32x4 y = (f32x4){0.f, 0.f, 0.f, 0.f};
#pragma unroll
                for (int kk = 0; kk < 4; ++kk) { const bf16x8 Ax = *(const bf16x8*)(XB + n16 * S5B_XP + (32 * kk + 8 * g) * 2); y = __builtin_amdgcn_mfma_f32_16x16x32_bf16(Ax, Cf[kk], y, 0, 0, 0); }
#pragma unroll
                for (int r = 0; r < 4; ++r) Z[((size_t)b * SEQ + tb + 4 * g + r) * D + grp * 16 + n16] = (bf16)f2bf(gelu_fast(y[r] + yd[r]));
                wave_lds_sync();
            }
        }
#undef S5B_LOAD
    }
}
struct Args { const void* in[45]; float* out; unsigned char* ws; int ph_lo, ph_hi; };
static_assert(sizeof(Args) == 45 * 8 + 8 + 8 + 8, "Args has no padding");
constexpr int PH_EVEN = 9, PH_ODD = 4, PH_COMMON = 13;
constexpr int NPHASES = 2 * (1 + PH_EVEN + PH_COMMON) + 2 * (1 + PH_ODD + PH_COMMON) + 1;

__global__ void __launch_bounds__(NTHR, 2) mega(Args args) {
    extern __shared__ __attribute__((aligned(16))) unsigned char lds[];
    volatile LAS unsigned* MISC = (volatile LAS unsigned*)((LAS unsigned char*)lds + MISC_OFF);
    if (threadIdx.x < 64) MISC[threadIdx.x] = 0u;
    __syncthreads();
    unsigned char* ws = args.ws;
    XcdBarrier bar = xcd_barrier_post((unsigned*)(ws + WS_CTL) + 4096, MISC + 8, gridDim.x);
    const int half = (int)gridDim.x >> 1;
    XcdBarrier bar2 = bar; if ((int)blockIdx.x >= half) bar2 = xcd_barrier_post((unsigned*)(ws + WS_CTL) + 8192, MISC + 10, gridDim.x - half);
    const int lo = args.ph_lo, hi = args.ph_hi;
    int pid = 0;
#define PH_BEGIN if (pid >= lo && pid < hi) { Ctx c; { int t_ = threadIdx.x, b_ = blockIdx.x; asm volatile("" : "+v"(t_)); asm volatile("" : "+s"(b_)); c.lds = lds; c.tid = t_; c.lane = t_ & 63; c.wave = __builtin_amdgcn_readfirstlane(t_ >> 6); c.bid = b_; { int n_ = gridDim.x; asm volatile("" : "+s"(n_)); c.nb = n_; } c.gw = c.bid * NWAVES + c.wave; c.ngw = c.nb * NWAVES; }
#define PH_END } if (pid >= lo && pid + 1 < hi) { xcd_barrier(bar); if (DBL & 2048) xcd_barrier(bar); } ++pid;
#define IN_F(i) (*(const float* const __attribute__((address_space(4)))*)(KARGS() + 8 * (i)))

    typedef const unsigned char __attribute__((address_space(4)))* kptr_t;
#define KARGS() ({ kptr_t p_ = (kptr_t)__builtin_amdgcn_kernarg_segment_ptr(); asm volatile("" : "+s"(p_)); p_; })
#define WSP(off) ((*(unsigned char* const __attribute__((address_space(4)))*)(KARGS() + 368)) + (off))
#define X ((float*)(*(float* const __attribute__((address_space(4)))*)(KARGS() + 360)))
#define ROPEA ((float*)WSP(WS_ROPEA))
#define ROPEI ((float*)WSP(WS_ROPEI))
#define KVBIG ((bf16*)WSP(WS_KVBIG))
#define WKV ((bf16*)WSP(WS_WKV))
#define W_IN ((bf16*)WSP(WS_WMIX + WMIX_IN))
#define WQ ((bf16*)WSP(WS_WMIX + WMIX_Q))
#define WOUT ((bf16*)WSP(WS_WMIX + WMIX_OUT))
#define WO_IN ((bf16*)WSP(WS_WMIX + WMIX_O_IN))
#define WO_GLU ((bf16*)WSP(WS_WMIX + WMIX_O_GLU))
#define WO_OUT ((bf16*)WSP(WS_WMIX + WMIX_O_OUT))
#define WXQ ((bf16*)WSP(WS_WXQ))
#define WXO ((bf16*)WSP(WS_WXO))
#define WUP ((bf16*)WSP(WS_WUP))
#define WDN ((bf16*)WSP(WS_WDN))
#define CQN ((bf16*)WSP(WS_CQN))
#define KF ((bf16*)WSP(WS_KF))
#define KIDX ((bf16*)WSP(WS_KIDX))
#define WIDX ((float*)WSP(WS_WIDX))
#define SEL ((bf16*)WSP(WS_SEL))
#define Hb ((bf16*)WSP(WS_R1))
#define SC ((float*)WSP(WS_R1))
#define HID ((bf16*)WSP(WS_R1))
#define Ub ((bf16*)WSP(WS_R1))
#define YC ((bf16*)WSP(WS_R1 + (size_t)M * D * 2))
#define XN ((bf16*)WSP(WS_R2))
#define QALL ((bf16*)X)
#define OLY ((bf16*)WSP(WS_R3))
#define Zb ((bf16*)WSP(WS_R3))
#define XQ ((bf16*)WSP(WS_R3))
#define XO ((bf16*)WSP(WS_R3 + (size_t)M * 512 * 2))
#define MEMN ((bf16*)WSP(WS_R3))
    LAS unsigned char* glds = (LAS unsigned char*)lds;

#define RS_A ((unsigned long long*)WSP(WS_CTL + 131072))
#define RS_B ((unsigned long long*)WSP(WS_CTL + 393216))
#define RS_C ((unsigned long long*)WSP(WS_CTL + 655360))
    for (int layer = 0; layer < DEPTH; ++layer) {
        const int li = layer >> 1;
        PH_BEGIN
#define ROTC(r_) Ctx cr = c; cr.gw = (c.gw + c.ngw - ((r_) % c.ngw)) % c.ngw
            if ((layer & 1) == 0) {
                conv_mat(c, IN_F(13) + (size_t)li * 2048 * EVEN_COLS, 2048, EVEN_COLS, EVEN_COLS, HC, W_IN, 2048, 0, 0, IN_F(3) + layer * D);
                build_wql(c, IN_F(18) + (size_t)li * 512 * 1024, IN_F(19) + (size_t)li * 256 * 768, WQ);
                for (int h = 0; h < 8; ++h) { ROTC(4352 + 8 * h); conv_mat(cr, IN_F(18) + (size_t)li * 512 * 1024 + h * 128, 512, 1024, 32, 32, WQ, 512, 2048 + h * 32, 0); }
                { ROTC(4352 + 64); conv_mat(cr, IN_F(21) + (size_t)li * 512 * 1024, 512, 1024, 1024, 1024, WQ, 512, 2304, 0); }
                build_wout(c, IN_F(20) + (size_t)li * 256 * 1024, IN_F(14) + (size_t)li * 2048 * 2048, WOUT);
                { ROTC(4352 + 64 + 256); conv_mat(cr, IN_F(14) + (size_t)li * 2048 * 2048 + (size_t)1024 * 2048, 1024, 2048, 2048, 2048, WOUT, OC, 0, 2048); }
                { ROTC(4352 + 64 + 256 + 1024); conv_mat(cr, IN_F(8) + (size_t)layer * 2048 * 512, 2048, 512, 512, 512, WXQ, 2048, 0, 0, IN_F(4) + layer * D); }
                { ROTC(4352 + 64 + 256 + 1024 + 512); conv_mat(cr, IN_F(10) + (size_t)layer * 512 * 2048, 512, 2048, 2048, 2048, WXO, 512, 0, 0); }
            } else {
                conv_mat(c, IN_F(33) + (size_t)li * 2048 * 2048, 2048, 2048, 2048, 2048, WO_IN, 2048, 0, 0, IN_F(3) + layer * D);
            }
#undef ROTC
            { unsigned long long* ra = RS_A; unsigned long long* rb = RS_B; for (int i = c.bid * NTHR + c.tid; i < M; i += c.nb * NTHR) { ra[i] = 0ull; rb[i] = 0ull; } }
            if (layer == 0) {
                for (int l2 = 0; l2 < 4; ++l2) {
                    { Ctx cr = c; cr.gw = (c.gw + c.ngw - ((l2 * 1024) % c.ngw)) % c.ngw; conv_mat(cr, IN_F(9) + (size_t)l2 * 2048 * 1024, 2048, 1024, 1024, 1024, WKV, 2048, l2 * 1024, 0); }
                    norm_rows_bf16(c, IN_F(1), IN_F(5) + l2 * D, MEMN + (size_t)l2 * MEMR * D, MEMR);
                }
                rope_tables(c, (const int*)IN_F(2), ROPEA, ROPEI);
                cast_rows_ss(c, IN_F(0), XN, RS_C, M);
            }
#if DBL & 1
            __syncthreads();
            if ((layer & 1) == 0) {
                conv_mat(c, IN_F(13) + (size_t)li * 2048 * EVEN_COLS, 2048, EVEN_COLS, EVEN_COLS, HC, W_IN, 2048, 0, 0, IN_F(3) + layer * D);
                build_wql(c, IN_F(18) + (size_t)li * 512 * 1024, IN_F(19) + (size_t)li * 256 * 768, WQ);
                for (int h = 0; h < 8; ++h) conv_mat(c, IN_F(18) + (size_t)li * 512 * 1024 + h * 128, 512, 1024, 32, 32, WQ, 512, 2048 + h * 32, 0);
                conv_mat(c, IN_F(21) + (size_t)li * 512 * 1024, 512, 1024, 1024, 1024, WQ, 512, 2304, 0);
                build_wout(c, IN_F(20) + (size_t)li * 256 * 1024, IN_F(14) + (size_t)li * 2048 * 2048, WOUT);
                conv_mat(c, IN_F(14) + (size_t)li * 2048 * 2048 + (size_t)1024 * 2048, 1024, 2048, 2048, 2048, WOUT, OC, 0, 2048);
            } else {
                conv_mat(c, IN_F(33) + (size_t)li * 2048 * 2048, 2048, 2048, 2048, 2048, WO_IN, 2048, 0, 0, IN_F(3) + layer * D);
                conv_mat(c, IN_F(43) + (size_t)li * 2048 * 2048, 2048, 2048, 2048, 2048, WO_GLU, 2048, 0, 0);
                conv_mat(c, IN_F(34) + (size_t)li * 2048 * 2048, 2048, 2048, 2048, 2048, WO_OUT, 2048, 0, 0);
            }
            conv_mat(c, IN_F(8) + (size_t)layer * 2048 * 512, 2048, 512, 512, 512, WXQ, 2048, 0, 0, IN_F(4) + layer * D);
            conv_mat(c, IN_F(10) + (size_t)layer * 512 * 2048, 512, 2048, 2048, 2048, WXO, 512, 0, 0);
            { unsigned long long* ra = RS_A; unsigned long long* rb = RS_B; for (int i = c.bid * NTHR + c.tid; i < M; i += c.nb * NTHR) { ra[i] = 0ull; rb[i] = 0ull; } }
            if (layer == 0) {
                for (int l2 = 0; l2 < 4; ++l2) {
                    conv_mat(c, IN_F(9) + (size_t)l2 * 2048 * 1024, 2048, 1024, 1024, 1024, WKV, 2048, l2 * 1024, 0);
                    norm_rows_bf16(c, IN_F(1), IN_F(5) + l2 * D, MEMN + (size_t)l2 * MEMR * D, MEMR);
                }
                rope_tables(c, (const int*)IN_F(2), ROPEA, ROPEI);
                cast_rows_ss(c, IN_F(0), XN, RS_C, M);
            }
#endif
        PH_END
        if ((layer & 1) == 0) {
            PH_BEGIN
                { pg8::Gemm g{XN, W_IN, 2048, 2048, 2048}; pg8::StaticOrder S; S.init(128, HC / 256, c.nb, c.bid); pg8::EpiBf16<0> E{Hb, HC, RS_C};
                  pg8::gemm_phase<pg8::EpiBf16<0>, pg8::StaticOrder, true, true>(glds, g, S, E);
                  if (DBL & 1024) { __syncthreads(); pg8::gemm_phase<pg8::EpiBf16<0>, pg8::StaticOrder, true, true>(glds, g, S, E); } }
                if (layer == 0) { __syncthreads(); pg8::Gemm g{MEMN, WKV, 2048, 2048, 2048}; pg8::KvOrder S{c.nb, (c.bid + (c.nb >> 1)) % c.nb};        pg8::EpiBf16<0> E{KVBIG, 4096, nullptr};
                  pg8::gemm_phase<pg8::EpiBf16<0>, pg8::KvOrder, true, true>(glds, g, S, E); }
                else if (c.bid >= half) {
                    __syncthreads(); Ctx d = c; d.bid = c.bid - half; d.nb = c.nb - half; d.gw = d.bid * NWAVES + d.wave; d.ngw = d.nb * NWAVES;
                    conv_mat(d, IN_F(12) + (size_t)layer * FFN * 2048, FFN, 2048, 2048, 2048, WDN, FFN, 0, 0); }
            PH_END
            PH_BEGIN
                rwkv_lora_prep(c, Hb, IN_F(22) + li * B_COLS, (bf16*)WSP(WS_END + 96 * MiB));
            PH_END
            PH_BEGIN
                if (c.bid < half) {
                    Ctx r = c; r.nb = half; r.ngw = half * NWAVES;
                    const RwkvP P{IN_F(22) + li * B_COLS, IN_F(23) + li * 1024, IN_F(24) + (size_t)li * 65536, IN_F(25) + li * 1024, IN_F(26) + (size_t)li * 65536, IN_F(27) + (size_t)li * 163840,
                                  IN_F(28) + li * 1024, IN_F(29) + li * 1024, IN_F(30) + li * 1024, IN_F(31) + li * 1024, IN_F(32) + li * 1024};
#if DIAG == 4
                    rwkv_phase(r, Hb, P, OLY);
                    rwkv_phase2(r, Hb, (const bf16*)WSP(WS_END + 96 * MiB), P, (bf16*)WSP(WS_END + 116 * MiB), 1024, 0, 1);
#else
                    rwkv_phase2(r, Hb, (const bf16*)WSP(WS_END + 96 * MiB), P, OLY, OC, 2048);
#endif
                    __syncthreads();
                    if (layer == 0) conv_mat(r, IN_F(12) + (size_t)layer * FFN * 2048, FFN, 2048, 2048, 2048, WDN, FFN, 0, 0);
                } else {
                    Ctx d = c; d.bid = c.bid - half; d.nb = c.nb - half; d.gw = d.bid * NWAVES + d.wave; d.ngw = d.nb * NWAVES;
                    dsa_prep(d, Hb, IN_F(15) + li * 512, IN_F(16) + li * 256, IN_F(17) + li * 64, ROPEA, ROPEI, CQN, KF, KIDX, WIDX);
                    xcd_barrier(bar2);
                    { pg8::Gemm g{CQN, WQ, 512, 512, 512}; pg8::StaticOrder S; S.init(128, QC / 256, d.nb, d.bid); pg8::EpiBf16<0> E{QALL, QC, nullptr};
                      pg8::gemm_phase<pg8::EpiBf16<0>, pg8::StaticOrder, true, true>(glds, g, S, E); }
                    xcd_barrier(bar2);
                    idx_topk_mfma(d, QALL, KIDX, WIDX, ROPEI, (float*)(d.bid < 32 ? WSP(WS_CQN + (size_t)d.bid * MiB) : WSP(WS_END + (size_t)(d.bid - 32) * MiB)), SEL, 256);
                    conv_mat(d, IN_F(11) + (size_t)layer * 2048 * FFN, 2048, FFN, FFN, FFN, WUP, 2048, 0, 0, IN_F(6) + layer * D);
                    xcd_barrier(bar2);
                    if (d.bid == 0 && c.tid == 0) __hip_atomic_store((unsigned*)WSP(WS_CTL) + 12288 + 64 * (2 + li), 1u, __ATOMIC_RELAXED, __HIP_MEMORY_SCOPE_AGENT);
                }
                if (c.bid < half) {
                    if (c.tid == 0) { unsigned* fl = (unsigned*)WSP(WS_CTL) + 12288 + 64 * (2 + li); unsigned sp = 0;
                        while (__hip_atomic_load(fl, __ATOMIC_RELAXED, __HIP_MEMORY_SCOPE_AGENT) == 0u) { __builtin_amdgcn_s_sleep(8); if (++sp > (1u << 22)) break; } }
                    __syncthreads();
                    __builtin_amdgcn_fence(__ATOMIC_ACQUIRE, "agent"); asm volatile("s_waitcnt vmcnt(0)" ::: "memory");
                }
                dsa_attn_queue(c, QALL, KF, SEL, ROPEA, OLY, (unsigned*)WSP(WS_CTL) + 12288 + 64 * li, MISC + 12);
            PH_END
#if DBL & 32
            PH_BEGIN
                if (c.bid < half) {
                    Ctx r = c; r.nb = half; r.ngw = half * NWAVES;
                    const RwkvP P{IN_F(22) + li * B_COLS, IN_F(23) + li * 1024, IN_F(24) + (size_t)li * 65536, IN_F(25) + li * 1024, IN_F(26) + (size_t)li * 65536, IN_F(27) + (size_t)li * 163840,
                                  IN_F(28) + li * 1024, IN_F(29) + li * 1024, IN_F(30) + li * 1024, IN_F(31) + li * 1024, IN_F(32) + li * 1024};
                    rwkv_phase2(r, Hb, (const bf16*)WSP(WS_END + 96 * MiB), P, OLY, OC, 2048);
                }
            PH_END
#endif
#if DBL & 8
            PH_BEGIN
                if (c.bid >= half) {
                    Ctx d = c; d.bid = c.bid - half; d.nb = c.nb - half; d.gw = d.bid * NWAVES + d.wave; d.ngw = d.nb * NWAVES;
                    idx_topk_mfma(d, QALL, KIDX, WIDX, ROPEI, (float*)(d.bid < 32 ? WSP(WS_CQN + (size_t)d.bid * MiB) : WSP(WS_END + (size_t)(d.bid - 32) * MiB)), SEL, 256);
                }
            PH_END
#endif
#if DIAG == 4
            PH_BEGIN
                diag_cmp_bf16(c, OLY + 2048, OC, (bf16*)WSP(WS_END + 116 * MiB), 1024, SEQ, 1024, (float*)WSP(WS_CTL + 65536));
            PH_END
#endif
#if DIAG == 7 || DIAG == 8
            PH_BEGIN
                q_rope_fix(c, QALL, ROPEA, ROPEI);
            PH_END
#endif
#if DIAG == 7
            PH_BEGIN
                if (c.bid >= half) { Ctx d = c; d.bid = c.bid - half; d.nb = c.nb - half; d.gw = d.bid * NWAVES + d.wave; d.ngw = d.nb * NWAVES;
                    idx_topk_v1(d, QALL, KIDX, WIDX, (float*)(d.bid < 32 ? WSP(WS_CQN + (size_t)d.bid * MiB) : WSP(WS_END + (size_t)(d.bid - 32) * MiB)), (bf16*)WSP(WS_END + 116 * MiB), 128); }
            PH_END
            PH_BEGIN
                diag_cmp_sel(c, SEL, (bf16*)WSP(WS_END + 116 * MiB), 4, (float*)WSP(WS_CTL + 65536));
            PH_END
#endif
#if DIAG == 8
            PH_BEGIN
                dsa_attn_simple(c, QALL, KF, SEL, (bf16*)WSP(WS_END + 116 * MiB), 1024);
            PH_END
            PH_BEGIN
                diag_cmp_bf16(c, OLY, OC, (bf16*)WSP(WS_END + 116 * MiB), OC, 1024, 2048, (float*)WSP(WS_CTL + 65536));
            PH_END
#endif
            PH_BEGIN
                { pg8::Gemm g{OLY, WOUT, OC, OC, OC}; pg8::StaticOrder S; S.init(128, 8, c.nb, c.bid); pg8::EpiRes E{XN, D, RS_A};
                  pg8::gemm_phase<pg8::EpiRes, pg8::StaticOrder, true, true>(glds, g, S, E); }
            PH_END
        } else {
            PH_BEGIN
                { pg8::Gemm g{XN, WO_IN, 2048, 2048, 2048}; pg8::StaticOrder S; S.init(128, 8, c.nb, c.bid); pg8::EpiBf16<0> E{Ub, D, RS_C};
                  pg8::gemm_phase<pg8::EpiBf16<0>, pg8::StaticOrder, true, true>(glds, g, S, E);
                  if (DBL & 1024) { __syncthreads(); pg8::gemm_phase<pg8::EpiBf16<0>, pg8::StaticOrder, true, true>(glds, g, S, E); } }
            PH_END
            PH_BEGIN
                { const S5P P{IN_F(35) + li * 8192, IN_F(36) + li * 8192, IN_F(37) + li * 128, IN_F(38) + (size_t)li * 131072, IN_F(39) + (size_t)li * 131072, IN_F(40) + (size_t)li * 131072, IN_F(41) + (size_t)li * 131072, IN_F(42) + li * D};
                  s5_phase2(c, Ub, P, Zb); }
                if (c.wave >= 4) {
                    Ctx v = c; v.lds = c.lds + 65536 - 4 * 8704; v.gw = c.bid * 4 + (c.wave - 4); v.ngw = c.nb * 4;
                    conv_mat(v, IN_F(11) + (size_t)layer * 2048 * FFN, 2048, FFN, FFN, FFN, WUP, 2048, 0, 0, IN_F(6) + layer * D);
                    conv_mat(v, IN_F(12) + (size_t)layer * FFN * 2048, FFN, 2048, 2048, 2048, WDN, FFN, 0, 0);
                    conv_mat(v, IN_F(43) + (size_t)li * 2048 * 2048, 2048, 2048, 2048, 2048, WO_GLU, 2048, 0, 0);
                    conv_mat(v, IN_F(34) + (size_t)li * 2048 * 2048, 2048, 2048, 2048, 2048, WO_OUT, 2048, 0, 0);
                    conv_mat(v, IN_F(8) + (size_t)layer * 2048 * 512, 2048, 512, 512, 512, WXQ, 2048, 0, 0, IN_F(4) + layer * D);
                    { Ctx vr = v; vr.gw = (v.gw + v.ngw - (512 % v.ngw)) % v.ngw; conv_mat(vr, IN_F(10) + (size_t)layer * 512 * 2048, 512, 2048, 2048, 2048, WXO, 512, 0, 0); }
                }
            PH_END
#if DIAG == 5
            PH_BEGIN
                { const S5P P{IN_F(35) + li * 8192, IN_F(36) + li * 8192, IN_F(37) + li * 128, IN_F(38) + (size_t)li * 131072, IN_F(39) + (size_t)li * 131072, IN_F(40) + (size_t)li * 131072, IN_F(41) + (size_t)li * 131072, IN_F(42) + li * D};
                  s5_phase(c, Ub, P, YC); }
            PH_END
            PH_BEGIN
                diag_cmp_bf16(c, YC, D, Zb, D, M, D, (float*)WSP(WS_CTL + 65536));
            PH_END
#endif
            PH_BEGIN
                { pg8::Gemm g{Zb, WO_GLU, 2048, 2048, 2048}; pg8::StaticOrder S; S.init(128, 8, c.nb, c.bid); pg8::EpiGlu E{Zb, YC, D, IN_F(44) + li * D};
                  pg8::gemm_phase<pg8::EpiGlu, pg8::StaticOrder, true, true>(glds, g, S, E); }
            PH_END
            PH_BEGIN
                { pg8::Gemm g{YC, WO_OUT, 2048, 2048, 2048}; pg8::StaticOrder S; S.init(128, 8, c.nb, c.bid); pg8::EpiRes E{XN, D, RS_A};
                  pg8::gemm_phase<pg8::EpiRes, pg8::StaticOrder, true, true>(glds, g, S, E); }
            PH_END
        }
        PH_BEGIN
            { unsigned long long* rc = RS_C; for (int i = c.bid * NTHR + c.tid; i < M; i += c.nb * NTHR) rc[i] = 0ull; }
            { pg8::Gemm g{XN, WXQ, 2048, 2048, 2048}; pg8::StaticOrder S; S.init(128, 2, c.nb, c.bid); pg8::EpiBf16<0> E{XQ, 512, RS_A};
              pg8::gemm_phase<pg8::EpiBf16<0>, pg8::StaticOrder, true, true>(glds, g, S, E); }
        PH_END
        PH_BEGIN
            xattn_mfma(c, XQ, KVBIG, layer, XO); if (DBL & 128) { asm volatile("" ::: "memory"); xattn_mfma(c, XQ, KVBIG, layer, XO); }
        PH_END
        PH_BEGIN
            { pg8::Gemm g{XO, WXO, 512, 512, 512}; pg8::StaticOrder S; S.init(128, 8, c.nb, c.bid); pg8::EpiRes E{XN, D, RS_B};
              pg8::gemm_phase<pg8::EpiRes, pg8::StaticOrder, true, true>(glds, g, S, E); }
        PH_END
        for (int q = 0; q < 5; ++q) {
            PH_BEGIN
                if (q > 0) { const int qd = q - 1; bf16* hid = HID + (size_t)(qd & 1) * 8192 * FFN;
                    pg8::Gemm g{hid, WDN, FFN, FFN, FFN}; pg8::StaticOrder S; S.init(32, 8, c.nb, c.bid); pg8::EpiRes E{XN + (size_t)qd * 8192 * D, D, RS_C + qd * 8192};
                    pg8::gemm_phase<pg8::EpiRes, pg8::StaticOrder, true, true>(glds, g, S, E); __syncthreads(); }
                if (q < 4) { bf16* hid = HID + (size_t)(q & 1) * 8192 * FFN;
                    pg8::Gemm g{XN + (size_t)q * 8192 * D, WUP, 2048, 2048, 2048}; pg8::StaticOrder S; S.init(32, 32, c.nb, c.bid); pg8::EpiBf16<1> E{hid, FFN, RS_B + q * 8192};
                    pg8::gemm_phase<pg8::EpiBf16<1>, pg8::StaticOrder, true, true>(glds, g, S, E); }
            PH_END
        }
    }
    PH_BEGIN
        scale_rows_out(c, XN, IN_F(7), RS_C, X, M);
    PH_END
#if DIAG
    PH_BEGIN
        { const float* dg = (const float*)WSP(WS_CTL + 65536); const float sc = 1.f + sqrtf(100.f * dg[0] / fmaxf(dg[1], 1e-30f));
          float* xo = X; for (size_t i = (size_t)c.bid * NTHR + c.tid; i < (size_t)M * D; i += (size_t)c.nb * NTHR) xo[i] *= sc; }
    PH_END
#endif
#undef PH_BEGIN
#undef PH_END
#undef IN_F
#undef X
}

extern "C" void kernel_launch(void* const* d_in, const int* in_sizes, int n_in, void* d_out, int out_size, void* d_ws, size_t ws_size, hipStream_t stream) {
    static int grid = 0;
    if (grid == 0) {
        if (n_in != 45 || out_size != M * D || ws_size < WS_END + 116 * MiB) { fprintf(stderr, "kernel_launch: unexpected shapes (n_in %d, out %d, ws %zu, need %zu)\n", n_in, out_size, ws_size, (size_t)WS_END); grid = -1; return; }
        int dev = 0, cus = 0, per_cu = 0;
        if (hipGetDevice(&dev) != hipSuccess || hipDeviceGetAttribute(&cus, hipDeviceAttributeMultiprocessorCount, dev) != hipSuccess) { grid = -1; return; }
        if (hipFuncSetAttribute((const void*)mega, hipFuncAttributeMaxDynamicSharedMemorySize, LDS_BYTES) != hipSuccess) { fprintf(stderr, "kernel_launch: hipFuncSetAttribute failed\n"); grid = -1; return; }
        if (hipOccupancyMaxActiveBlocksPerMultiprocessor(&per_cu, (const void*)mega, NTHR, LDS_BYTES) != hipSuccess || per_cu < 1) fprintf(stderr, "kernel_launch: occupancy query reports %d\n", per_cu);
        (void)hipGetLastError();
        grid = cus;
    }
    if (grid < 0) return;
    (void)hipMemsetAsync((char*)d_ws + WS_CTL, 0, CTL_BYTES, stream);
    Args a{};
    for (int i = 0; i < 45; ++i) a.in[i] = d_in[i];
    a.out = (float*)d_out; a.ws = (unsigned char*)d_ws;
#if MK_ONE_LAUNCH
    a.ph_lo = 0; a.ph_hi = 1 << 20;
    hipLaunchKernelGGL(mega, dim3(grid), dim3(NTHR), LDS_BYTES, stream, a);
#else
    for (int p = 0; p < NPHASES; ++p) { a.ph_lo = p; a.ph_hi = p + 1; hipLaunchKernelGGL(mega, dim3(grid), dim3(NTHR), LDS_BYTES, stream, a); }
#endif
}
```

```cpp
#include <hip/hip_runtime.h>
#include <cstdio>
#include <cstdint>

#ifndef DIAG
#define DIAG 0
#endif
#ifndef ATTN_SPLIT
#define ATTN_SPLIT 0
#endif
#ifndef DBL
#define DBL 0
#endif
#ifndef UP_WGM
#define UP_WGM 8
#endif
#ifndef DN_WGM
#define DN_WGM 4
#endif
#ifndef MK_ONE_LAUNCH
#define MK_ONE_LAUNCH 1
#endif

constexpr int D = 2048, NB = 8, SEQ = 4096, M = NB * SEQ, DEPTH = 4;
constexpr int HC = 4352;
constexpr int EVEN_COLS = 4240, A_COLS = 880, B_COLS = 3360;
constexpr int QC = 3328;
constexpr int OC = 3072;
constexpr int KFW = 288;
constexpr int FFN = 8192;
constexpr int MEMR = NB * 256;
constexpr float NORM_EPS = 1e-5f;
constexpr size_t SC_PER_BATCH = (size_t)4096 * 64 * 65 / 2;

typedef unsigned short bf16;
typedef float f32x4 __attribute__((ext_vector_type(4)));
typedef unsigned u32x4 __attribute__((ext_vector_type(4)));
typedef unsigned u32x2 __attribute__((ext_vector_type(2)));
typedef float f32x2 __attribute__((ext_vector_type(2)));
typedef float f32x3 __attribute__((ext_vector_type(3)));
#define LAS __attribute__((address_space(3)))

constexpr size_t MiB = 1u << 20;
constexpr size_t al256(size_t x) { return (x + 255) & ~(size_t)255; }
constexpr size_t WS_CTL = 0, CTL_BYTES = 1 * MiB;
constexpr size_t WS_ROPEA = WS_CTL + CTL_BYTES;
constexpr size_t WS_ROPEI = WS_ROPEA + (size_t)M * 32 * 4;
constexpr size_t WS_KVBIG = WS_ROPEI + (size_t)M * 16 * 4;
constexpr size_t WS_WKV = WS_KVBIG + (size_t)8192 * 4096 * 2;
constexpr size_t WS_WMIX = WS_WKV + (size_t)4096 * 2048 * 2;
constexpr size_t WMIX_IN = 0, WMIX_Q = (size_t)HC * 2048 * 2, WMIX_OUT = WMIX_Q + (size_t)QC * 512 * 2, WMIX_BYTES = WMIX_OUT + (size_t)2048 * OC * 2;
constexpr size_t WMIX_O_IN = 0, WMIX_O_GLU = (size_t)2048 * 2048 * 2, WMIX_O_OUT = 2 * WMIX_O_GLU;
constexpr size_t WS_WXQ = al256(WS_WMIX + WMIX_BYTES);
constexpr size_t WS_WXO = WS_WXQ + (size_t)512 * 2048 * 2;
constexpr size_t WS_WUP = WS_WXO + (size_t)2048 * 512 * 2;
constexpr size_t WS_WDN = WS_WUP + (size_t)FFN * 2048 * 2;
constexpr size_t WS_CQN = WS_WDN + (size_t)2048 * FFN * 2;
constexpr size_t WS_KF = WS_CQN + (size_t)M * 512 * 2;
constexpr size_t WS_KIDX = WS_KF + (size_t)M * KFW * 2;
constexpr size_t WS_WIDX = WS_KIDX + (size_t)M * 64 * 2;
constexpr size_t WS_SEL = WS_WIDX + (size_t)M * 16 * 4;
constexpr size_t WS_R1 = al256(WS_SEL + (size_t)M * 256 * 2);
constexpr size_t R1_BYTES = (size_t)M * HC * 2;
constexpr size_t WS_R2 = WS_R1 + R1_BYTES;
constexpr size_t R2_BYTES = (size_t)M * QC * 2;
constexpr size_t WS_R3 = WS_R2 + R2_BYTES;
constexpr size_t R3_BYTES = (size_t)M * OC * 2;
constexpr size_t WS_END = WS_R3 + R3_BYTES;
static_assert(SC_PER_BATCH * NB * 4 <= R1_BYTES, "scores fit R1");
static_assert((size_t)8192 * FFN * 2 <= R1_BYTES && (size_t)M * 2048 * 2 * 2 <= R1_BYTES, "R1 overlays");

__device__ __forceinline__ float bf2f(unsigned v) { return __uint_as_float(v << 16); }
__device__ __forceinline__ unsigned f2bf(float f) { unsigned u = __float_as_uint(f); return (u + 0x7fffu + ((u >> 16) & 1u)) >> 16; }
__device__ __forceinline__ unsigned pk2(float lo, float hi) { return f2bf(lo) | (f2bf(hi) << 16); }
__device__ __forceinline__ float wave_sum(float v) {
#pragma unroll
    for (int o = 1; o < 64; o <<= 1) v += __shfl_xor(v, o);
    return v;
}
__device__ __forceinline__ float wave_max(float v) {
#pragma unroll
    for (int o = 1; o < 64; o <<= 1) v = fmaxf(v, __shfl_xor(v, o));
    return v;
}
__device__ __forceinline__ void unpack8(const u32x4 w, float* f) {
    f[0] = __uint_as_float(w.x << 16); f[1] = __uint_as_float(w.x & 0xffff0000u); f[2] = __uint_as_float(w.y << 16); f[3] = __uint_as_float(w.y & 0xffff0000u);
    f[4] = __uint_as_float(w.z << 16); f[5] = __uint_as_float(w.z & 0xffff0000u); f[6] = __uint_as_float(w.w << 16); f[7] = __uint_as_float(w.w & 0xffff0000u);
}
__device__ __forceinline__ float sigmoidf_(float x) { return __builtin_amdgcn_rcpf(1.f + __expf(-x)); }
namespace pg8 {
#define PG8_LAS __attribute__((address_space(3)))
typedef unsigned short bf16_t;
typedef short bf16x8 __attribute__((ext_vector_type(8)));
typedef float f32x4 __attribute__((ext_vector_type(4)));
typedef unsigned u32x4 __attribute__((ext_vector_type(4)));
constexpr int BM = 256, BK = 64, HALF = 128, HTB = HALF * BK * 2, STAGE_BYTES = 8 * HTB, NXCD = 8, WGM = 4;

__host__ __device__ __forceinline__ int lds_byte(int r, int c) { const int st = (r >> 4) * 2 + (c >> 5), rr = r & 15, cc = c & 31, ob = rr * 64 + cc * 2; return st * 1024 + (ob ^ (((ob >> 9) & 1) << 5)); }
__host__ __device__ __forceinline__ void stage_rc(int b, int& R, int& C) { const int st = b / 1024, sb = b % 1024, swz = sb ^ (((sb >> 9) & 1) << 5); R = (st >> 1) * 16 + swz / 64; C = (st & 1) * 32 + (swz % 64) / 2; }
__host__ __device__ __forceinline__ int perm32(int rho) { const int n = rho >> 4, i = rho & 15; return 8 * (i >> 2) + 4 * n + (i & 3); }

struct Unit { int pm, pn; };
struct Gemm { const bf16_t* A; const bf16_t* Bt; int lda, ldb, K, pad; };

struct StaticOrder {
    int nM, nN, nwg, G, c, wgm;
    __host__ __device__ void init(int nM_, int nN_, int G_, int c_, int wgm_ = WGM) { nM = nM_; nN = nN_; nwg = nM * nN; G = G_; c = c_; wgm = wgm_; }
    __host__ __device__ bool next(int i, Unit& u) const {
        const long L = (long)i * G + c; if (L >= nwg) return false;
        int wgid = (int)L; { const int q = nwg / NXCD, r = nwg % NXCD, xcd = wgid % NXCD, off = wgid / NXCD; wgid = (xcd < r ? xcd * (q + 1) : r * (q + 1) + (xcd - r) * q) + off; }
        const int nig = wgm * nN, gid = wgid / nig, fm = gid * wgm, gsz = (nM - fm) < wgm ? (nM - fm) : wgm;
        u.pm = fm + ((wgid % nig) % gsz); u.pn = (wgid % nig) / gsz; return true;
    }
    __device__ __forceinline__ void a_ready(const Unit&) const {}
    __device__ __forceinline__ void done(const Unit&) const {}
};
struct KvOrder {
    int G, c;
    __device__ bool next(int i, Unit& u) const { const int L = i * G + c; if (L >= 128) return false; const int ly = L >> 5, r = L & 31; u.pm = ly * 8 + (r & 7); u.pn = ly * 4 + (r >> 3); return true; }
    __device__ __forceinline__ void a_ready(const Unit&) const {}
    __device__ __forceinline__ void done(const Unit&) const {}
};

__device__ __forceinline__ unsigned cvt_pk_bf16(float lo, float hi) { unsigned r; asm volatile("v_cvt_pk_bf16_f32 %0, %1, %2" : "=v"(r) : "v"(lo), "v"(hi)); return r; }

template <int ACT> struct EpiBf16 {
    static constexpr bool PERM = true, AFTER_DRAIN = false;
    bf16_t* O; int ldc; const unsigned long long* rowss;
    __device__ __forceinline__ void operator()(const f32x4 (&acc)[2][2][4][2], const Unit& u, int wr, int wc, int fr, int fq) const {
        const int row0 = u.pm * BM + wr * 64 + fr; const int col0 = u.pn * BM + wc * 32 + 8 * fq;
        unsigned long long rq[2][4];
#pragma unroll
        for (int ai = 0; ai < 2; ++ai)
#pragma unroll
            for (int m = 0; m < 4; ++m) rq[ai][m] = rowss ? rowss[row0 + ai * HALF + m * 16] : 0ull;
        if (rowss) asm volatile("" : "+v"(rq[0][0]), "+v"(rq[0][1]), "+v"(rq[0][2]), "+v"(rq[0][3]), "+v"(rq[1][0]), "+v"(rq[1][1]), "+v"(rq[1][2]), "+v"(rq[1][3]));
#pragma unroll
        for (int ai = 0; ai < 2; ++ai)
#pragma unroll
            for (int m = 0; m < 4; ++m) { bf16_t* rowp = O + (size_t)(row0 + ai * HALF + m * 16) * ldc + col0;
                const float rs = rowss ? __builtin_amdgcn_rsqf((float)rq[ai][m] * (5.9604644775390625e-08f / 2048.f) + 1e-5f) : 1.f;
#pragma unroll
                for (int bj = 0; bj < 2; ++bj) { f32x4 v0 = acc[ai][bj][m][0] * rs, v1 = acc[ai][bj][m][1] * rs;
                    if (ACT == 1) {
#pragma unroll
                        for (int j = 0; j < 4; ++j) { const float a = fmaxf(v0[j], 0.f), b = fmaxf(v1[j], 0.f); v0[j] = a * a; v1[j] = b * b; } }
                    u32x4 w; w.x = cvt_pk_bf16(v0[0], v0[1]); w.y = cvt_pk_bf16(v0[2], v0[3]); w.z = cvt_pk_bf16(v1[0], v1[1]); w.w = cvt_pk_bf16(v1[2], v1[3]);
                    *(u32x4*)(rowp + bj * HALF) = w; } }
    }
};
struct EpiRes {
    static constexpr bool PERM = false, AFTER_DRAIN = false;
    bf16_t* xb; int ldc; unsigned long long* rowss;
    __device__ __forceinline__ void operator()(const f32x4 (&acc)[2][2][4][2], const Unit& u, int wr, int wc, int fr, int fq) const {
        typedef unsigned u32x2_ __attribute__((ext_vector_type(2)));
        const int row0 = u.pm * BM + wr * 64 + fr, col0 = u.pn * BM + wc * 32 + 4 * fq;
#pragma unroll
        for (int ai = 0; ai < 2; ++ai) {
            u32x2_ bv[4][2][2];
#pragma unroll
            for (int m = 0; m < 4; ++m) { const bf16_t* rp = xb + (size_t)(row0 + ai * HALF + m * 16) * ldc + col0;
#pragma unroll
                for (int bj = 0; bj < 2; ++bj)
#pragma unroll
                    for (int n = 0; n < 2; ++n) bv[m][bj][n] = *(const u32x2_*)(rp + bj * HALF + n * 16); }
#pragma unroll
            for (int m = 0; m < 4; ++m) { bf16_t* rp = xb + (size_t)(row0 + ai * HALF + m * 16) * ldc + col0; float ss = 0.f;
#pragma unroll
                for (int bj = 0; bj < 2; ++bj)
#pragma unroll
                    for (int n = 0; n < 2; ++n) { const u32x2_ b = bv[m][bj][n]; f32x4 x = acc[ai][bj][m][n];
                        x[0] += __uint_as_float(b.x << 16); x[1] += __uint_as_float(b.x & 0xffff0000u); x[2] += __uint_as_float(b.y << 16); x[3] += __uint_as_float(b.y & 0xffff0000u);
                        u32x2_ w; w.x = cvt_pk_bf16(x[0], x[1]); w.y = cvt_pk_bf16(x[2], x[3]); *(u32x2_*)(rp + bj * HALF + n * 16) = w;
                        const float r0 = __uint_as_float(w.x << 16), r1 = __uint_as_float(w.x & 0xffff0000u), r2 = __uint_as_float(w.y << 16), r3 = __uint_as_float(w.y & 0xffff0000u);
                        ss += (r0 * r0 + r1 * r1) + (r2 * r2 + r3 * r3); }
                ss += __shfl_xor(ss, 16); ss += __shfl_xor(ss, 32);
                if (fq == 0) atomicAdd(rowss + row0 + ai * HALF + m * 16, (unsigned long long)(ss * 16777216.0f)); }
            asm volatile("" ::: "memory"); }
    }
};
struct EpiGlu {
    static constexpr bool PERM = true, AFTER_DRAIN = false;
    const bf16_t* Z; bf16_t* O; int ldc; const float* bias;
    __device__ __forceinline__ void operator()(const f32x4 (&acc)[2][2][4][2], const Unit& u, int wr, int wc, int fr, int fq) const {
        const int row0 = u.pm * BM + wr * 64 + fr; const int col0 = u.pn * BM + wc * 32 + 8 * fq;
        f32x4 bv[2][2];
#pragma unroll
        for (int bj = 0; bj < 2; ++bj)
#pragma unroll
            for (int n = 0; n < 2; ++n) bv[bj][n] = *(const f32x4*)(bias + col0 + bj * HALF + 4 * n);
#pragma unroll
        for (int ai = 0; ai < 2; ++ai) {
            u32x4 zq[4][2];
#pragma unroll
            for (int m = 0; m < 4; ++m)
#pragma unroll
                for (int bj = 0; bj < 2; ++bj) zq[m][bj] = *(const u32x4*)(Z + (size_t)(row0 + ai * HALF + m * 16) * ldc + col0 + bj * HALF);
#pragma unroll
            for (int m = 0; m < 4; ++m) { const size_t off = (size_t)(row0 + ai * HALF + m * 16) * ldc + col0;
#pragma unroll
                for (int bj = 0; bj < 2; ++bj) { const f32x4 v0 = acc[ai][bj][m][0] + bv[bj][0], v1 = acc[ai][bj][m][1] + bv[bj][1];
                    const u32x4 zz = zq[m][bj]; float z[8], o[8];
                    z[0] = __uint_as_float(zz.x << 16); z[1] = __uint_as_float(zz.x & 0xffff0000u); z[2] = __uint_as_float(zz.y << 16); z[3] = __uint_as_float(zz.y & 0xffff0000u);
                    z[4] = __uint_as_float(zz.z << 16); z[5] = __uint_as_float(zz.z & 0xffff0000u); z[6] = __uint_as_float(zz.w << 16); z[7] = __uint_as_float(zz.w & 0xffff0000u);
#pragma unroll
                    for (int j = 0; j < 4; ++j) { o[j] = z[j] * __builtin_amdgcn_rcpf(1.f + __expf(-v0[j])); o[4 + j] = z[4 + j] * __builtin_amdgcn_rcpf(1.f + __expf(-v1[j])); }
                    u32x4 w; w.x = cvt_pk_bf16(o[0], o[1]); w.y = cvt_pk_bf16(o[2], o[3]); w.z = cvt_pk_bf16(o[4], o[5]); w.w = cvt_pk_bf16(o[6], o[7]);
                    *(u32x4*)(O + off + bj * HALF) = w; } }
            asm volatile("" ::: "memory"); }
    }
};

template <class Epi, class Sched, bool ALIGN_EPI = false, bool SP2 = false>
__device__ __forceinline__ void gemm_phase(PG8_LAS unsigned char* lds, const Gemm g, const Sched& S, const Epi& E) {
    int tid_l = threadIdx.x; asm volatile("" : "+v"(tid_l));
    const int tid = tid_l, wid = __builtin_amdgcn_readfirstlane(tid >> 6), lane = tid & 63, wr = wid >> 2, wc = wid & 3, fr = lane & 15, fq = lane >> 4;
    const int K = g.K, nt = K / BK;
    unsigned voffA[2], voffB[2];
#pragma unroll
    for (int i = 0; i < 2; ++i) { int R, C; stage_rc(tid * 16 + i * 8192, R, C); const int Rb = Epi::PERM ? ((R & ~31) + perm32(R & 31)) : R;
        voffA[i] = (unsigned)(R * g.lda + C) * 2u; voffB[i] = (unsigned)(Rb * g.ldb + C) * 2u; }
    const size_t kstep = (size_t)(BK * 2);
    const size_t hstepA = (size_t)HALF * g.lda * 2, hstepB = (size_t)HALF * g.ldb * 2;
    const size_t tstepA = 2 * hstepA, tstepB = 2 * hstepB;
    const unsigned ldsw = (unsigned)wid * 1024u;
    const int aoff = lds_byte(wr * 64 + fr, fq * 8), boff = lds_byte(wc * 32 + fr, fq * 8);
#define PG8_SA(b, h) (((b) * 2 + (h)) * HTB)
#define PG8_SB(b, h) ((4 + (b) * 2 + (h)) * HTB)
#define PG8_STAGE(bufoff, gbase, voff) do { _Pragma("unroll") for (int _i = 0; _i < 2; ++_i) \
        __builtin_amdgcn_global_load_lds((const unsigned*)((const char*)(gbase) + (voff)[_i]), (PG8_LAS unsigned*)(lds + (bufoff) + ldsw + _i * 8192), 16, 0, 0); } while (0)
#define PG8_LDA(dst, b, h) do { _Pragma("unroll") for (int m = 0; m < 4; ++m) _Pragma("unroll") for (int k = 0; k < 2; ++k) dst[m][k] = *(const PG8_LAS bf16x8*)(lds + PG8_SA(b, h) + aoff + m * 2048 + k * 1024); } while (0)
#define PG8_LDB(dst, b, h) do { _Pragma("unroll") for (int n = 0; n < 2; ++n) _Pragma("unroll") for (int k = 0; k < 2; ++k) dst[n][k] = *(const PG8_LAS bf16x8*)(lds + PG8_SB(b, h) + boff + n * 2048 + k * 1024); } while (0)
#define PG8_MMA(ai, bj, At, Bt) do { __builtin_amdgcn_s_setprio(1); _Pragma("unroll") for (int m = 0; m < 4; ++m) _Pragma("unroll") for (int n = 0; n < 2; ++n) _Pragma("unroll") for (int k = 0; k < 2; ++k) \
        acc[ai][bj][m][n] = __builtin_amdgcn_mfma_f32_16x16x32_bf16(Bt[n][k], At[m][k], acc[ai][bj][m][n], 0, 0, 0); __builtin_amdgcn_s_setprio(0); } while (0)
#define PG8_WAIT_V(n) asm volatile("s_waitcnt vmcnt(" #n ")" ::: "memory")
#define PG8_WAIT_L(n) asm volatile("s_waitcnt lgkmcnt(" #n ")" ::: "memory")
#define PG8_BAR __builtin_amdgcn_s_barrier()
#define PG8_SCHED __builtin_amdgcn_sched_barrier(0)
    Unit cur, nxt; int ui = 0;
    if (!S.next(0, cur)) return;
    f32x4 acc[2][2][4][2];
#pragma unroll
    for (int a = 0; a < 2; ++a)
#pragma unroll
        for (int b = 0; b < 2; ++b)
#pragma unroll
            for (int m = 0; m < 4; ++m)
#pragma unroll
                for (int n = 0; n < 2; ++n) acc[a][b][m][n] = (f32x4){0.f, 0.f, 0.f, 0.f};
    bf16x8 At[4][2], B0[2][2], B1[2][2];
    const char* cA = (const char*)g.A + (size_t)cur.pm * tstepA; const char* cB = (const char*)g.Bt + (size_t)cur.pn * tstepB;
    S.a_ready(cur);
    if constexpr (SP2) {
        PG8_STAGE(PG8_SB(0, 0), cB, voffB); PG8_STAGE(PG8_SB(0, 1), cB + hstepB, voffB); PG8_STAGE(PG8_SA(0, 0), cA, voffA); PG8_STAGE(PG8_SA(0, 1), cA + hstepA, voffA);
        if (wr == 1) PG8_BAR;
        PG8_WAIT_V(2); PG8_BAR;
        PG8_STAGE(PG8_SB(1, 0), cB + kstep, voffB); PG8_STAGE(PG8_SA(1, 0), cA + kstep, voffA); PG8_STAGE(PG8_SB(1, 1), cB + hstepB + kstep, voffB);
        PG8_WAIT_V(6); PG8_BAR;
    } else {
        PG8_STAGE(PG8_SB(0, 0), cB, voffB); PG8_STAGE(PG8_SA(0, 0), cA, voffA); PG8_STAGE(PG8_SB(0, 1), cB + hstepB, voffB); PG8_STAGE(PG8_SA(0, 1), cA + hstepA, voffA);
        if (wr == 1) PG8_BAR;
        PG8_WAIT_V(4); PG8_BAR;
        PG8_STAGE(PG8_SB(1, 0), cB + kstep, voffB); PG8_STAGE(PG8_SA(1, 0), cA + kstep, voffA); PG8_STAGE(PG8_SB(1, 1), cB + hstepB + kstep, voffB);
        PG8_WAIT_V(6); PG8_BAR;
    }
    for (;;) {
        const bool has_next = S.next(ui + 1, nxt);
        const char* nA = has_next ? (const char*)g.A + (size_t)nxt.pm * tstepA : cA; const char* nB = has_next ? (const char*)g.Bt + (size_t)nxt.pn * tstepB : cB;
        for (int t = 0; t < nt; t += 2) {
            const bool last = (t == nt - 2);
            const char* a1 = cA + (size_t)(t + 1) * kstep;
            const char* a2 = last ? nA : cA + (size_t)(t + 2) * kstep; const char* b2 = last ? nB : cB + (size_t)(t + 2) * kstep;
            const char* a3 = a2 + kstep; const char* b3 = b2 + kstep;
            if (last && has_next) S.a_ready(nxt);
            if constexpr (SP2) {
            PG8_LDB(B0, 0, 0); PG8_LDB(B1, 0, 1); PG8_SCHED; PG8_LDA(At, 0, 0); PG8_STAGE(PG8_SA(1, 1), a1 + hstepA, voffA);
            PG8_WAIT_V(8); PG8_WAIT_L(0); PG8_BAR; PG8_MMA(0, 0, At, B0); PG8_MMA(0, 1, At, B1); PG8_BAR; PG8_SCHED;
            PG8_LDA(At, 0, 1); PG8_STAGE(PG8_SB(0, 0), b2, voffB); PG8_STAGE(PG8_SB(0, 1), b2 + hstepB, voffB); PG8_STAGE(PG8_SA(0, 0), a2, voffA);
            PG8_WAIT_V(8); PG8_WAIT_L(0); PG8_BAR; PG8_MMA(1, 0, At, B0); PG8_MMA(1, 1, At, B1); PG8_BAR; PG8_SCHED;
            PG8_LDB(B0, 1, 0); PG8_LDB(B1, 1, 1); PG8_SCHED; PG8_LDA(At, 1, 0); PG8_STAGE(PG8_SA(0, 1), a2 + hstepA, voffA);
            PG8_WAIT_V(8); PG8_WAIT_L(0); PG8_BAR; PG8_MMA(0, 0, At, B0); PG8_MMA(0, 1, At, B1); PG8_BAR; PG8_SCHED;
            PG8_LDA(At, 1, 1); PG8_STAGE(PG8_SB(1, 0), b3, voffB); PG8_STAGE(PG8_SB(1, 1), b3 + hstepB, voffB); PG8_STAGE(PG8_SA(1, 0), a3, voffA);
            PG8_WAIT_V(8); PG8_WAIT_L(0); PG8_BAR; PG8_MMA(1, 0, At, B0); PG8_MMA(1, 1, At, B1); PG8_BAR; PG8_SCHED;
            } else {
            PG8_LDB(B0, 0, 0); PG8_SCHED; PG8_LDA(At, 0, 0); PG8_STAGE(PG8_SA(1, 1), a1 + hstepA, voffA);
            PG8_WAIT_L(8); PG8_BAR; PG8_WAIT_L(0); PG8_MMA(0, 0, At, B0); PG8_BAR; PG8_SCHED;
            PG8_LDB(B1, 0, 1); PG8_STAGE(PG8_SB(0, 0), b2, voffB);
            PG8_BAR; PG8_WAIT_L(0); PG8_MMA(0, 1, At, B1); PG8_BAR;
            PG8_LDA(At, 0, 1); PG8_STAGE(PG8_SA(0, 0), a2, voffA);
            PG8_BAR; PG8_WAIT_L(0); PG8_MMA(1, 0, At, B0); PG8_BAR; PG8_SCHED;
            PG8_STAGE(PG8_SB(0, 1), b2 + hstepB, voffB);
            PG8_WAIT_V(6); PG8_BAR; PG8_MMA(1, 1, At, B1); PG8_BAR;
            PG8_LDB(B0, 1, 0); PG8_SCHED; PG8_LDA(At, 1, 0); PG8_STAGE(PG8_SA(0, 1), a2 + hstepA, voffA);
            PG8_WAIT_L(8); PG8_BAR; PG8_WAIT_L(0); PG8_MMA(0, 0, At, B0); PG8_BAR; PG8_SCHED;
            PG8_LDB(B1, 1, 1); PG8_STAGE(PG8_SB(1, 0), b3, voffB);
            PG8_BAR; PG8_WAIT_L(0); PG8_MMA(0, 1, At, B1); PG8_BAR;
            PG8_LDA(At, 1, 1); PG8_STAGE(PG8_SA(1, 0), a3, voffA);
            PG8_BAR; PG8_WAIT_L(0); PG8_MMA(1, 0, At, B0); PG8_BAR; PG8_SCHED;
            PG8_STAGE(PG8_SB(1, 1), b3 + hstepB, voffB);
            PG8_WAIT_V(6); PG8_BAR; PG8_MMA(1, 1, At, B1); PG8_BAR;
            }
        }
        if constexpr (ALIGN_EPI) { if (wr == 0) PG8_BAR; }
        E(acc, cur, wr, wc, fr, fq); S.done(cur);
        if (!has_next) break;
#pragma unroll
        for (int a = 0; a < 2; ++a)
#pragma unroll
            for (int b = 0; b < 2; ++b)
#pragma unroll
                for (int m = 0; m < 4; ++m)
#pragma unroll
                    for (int n = 0; n < 2; ++n) acc[a][b][m][n] = (f32x4){0.f, 0.f, 0.f, 0.f};
        cur = nxt; cA = nA; cB = nB; ++ui;
        if constexpr (ALIGN_EPI) { if (wr == 1) PG8_BAR; }
    }
    PG8_WAIT_V(0);
    if constexpr (!ALIGN_EPI) { if (wr == 0) PG8_BAR; }
    PG8_BAR;
#undef PG8_SA
#undef PG8_SB
#undef PG8_STAGE
#undef PG8_LDA
#undef PG8_LDB
#undef PG8_MMA
#undef PG8_WAIT_V
#undef PG8_WAIT_L
#undef PG8_BAR
#undef PG8_SCHED
}
}
#define XB_TMO      128
#define XB_XCNT(j)  (256  + 64 * (j))
#define XB_XSUB(j)  (1280 + 64 * (j))
#define XB_XGEN(j)  (2304 + 64 * (j))
#define XB_TOP      3328
#define XB_TOPGEN   3392
#define XCD_BAR_WORDS 3456
#define XB_SPIN_CAP (1u << 18)
__device__ __forceinline__ unsigned xb_ld(unsigned* p)              { return __hip_atomic_load(p, __ATOMIC_RELAXED, __HIP_MEMORY_SCOPE_AGENT); }
__device__ __forceinline__ unsigned xb_add(unsigned* p, unsigned v) { return __hip_atomic_fetch_add(p, v, __ATOMIC_RELAXED, __HIP_MEMORY_SCOPE_AGENT); }
__device__ __forceinline__ unsigned xb_xcc_id() { return (unsigned)__builtin_amdgcn_s_getreg((3 << 11) | 20) & 0xFu; }
#define XB_SPIN(cond, bar) do { unsigned _sp = 0; while (cond) { __builtin_amdgcn_s_sleep(1); \
    if ((++_sp & 255u) == 0u) { if (xb_ld(&(bar)[XB_TMO])) break; if (_sp > XB_SPIN_CAP) { atomicAdd(&(bar)[XB_TMO], 1u); break; } } } } while (0)
struct XcdBarrier { unsigned* bar; unsigned x; volatile LAS unsigned* st; unsigned G; };
__device__ __forceinline__ XcdBarrier xcd_barrier_post(unsigned* bar, volatile LAS unsigned* st, unsigned G) {
    XcdBarrier b; b.bar = bar; b.x = xb_xcc_id(); b.st = st; b.G = G;
    if (threadIdx.x == 0) (void)xb_add(&bar[XB_XCNT(b.x)], 1u);
    return b;
}
__device__ __forceinline__ void xcd_barrier_complete(unsigned* bar, unsigned x, unsigned G, unsigned& nloc, unsigned& nx) {
    unsigned sum, cnt, mine, sp = 0u;
    for (;;) {
        sum = 0u; cnt = 0u; mine = 0u;
#pragma unroll
        for (unsigned j = 0; j < 16; ++j) { const unsigned c = xb_ld(&bar[XB_XCNT(j)]); sum += c; cnt += (c > 0u) ? 1u : 0u; mine = (j == x) ? c : mine; }
        if (sum == G) break;
        __builtin_amdgcn_s_sleep(1);
        if ((++sp & 255u) == 0u) { if (xb_ld(&bar[XB_TMO])) break; if (sp > XB_SPIN_CAP) { atomicAdd(&bar[XB_TMO], 1u); break; } }
    }
    nloc = mine > 0u ? mine : 1u; nx = cnt > 0u ? cnt : 1u;
}
__device__ __forceinline__ void xcd_barrier(const XcdBarrier& b) {
    asm volatile("s_waitcnt vmcnt(0)" ::: "memory");
    __syncthreads();
    if (threadIdx.x == 0) {
        unsigned* bar = b.bar;
        __builtin_amdgcn_s_waitcnt(0);
        unsigned nloc = b.st[0], nx = b.st[1];
        if (nloc == 0u) { xcd_barrier_complete(bar, b.x, b.G, nloc, nx); b.st[0] = nloc; b.st[1] = nx; }
        const unsigned old = xb_add(&bar[XB_XSUB(b.x)], 1u);
        const unsigned gen = old / nloc;
        if (old + 1u == (gen + 1u) * nloc) {
            __builtin_amdgcn_fence(__ATOMIC_RELEASE, "agent");
            asm volatile("s_waitcnt vmcnt(0)" ::: "memory");
            const unsigned og = xb_add(&bar[XB_TOP], 1u);
            const unsigned tg = og / nx;
            if (og + 1u == (tg + 1u) * nx) xb_add(&bar[XB_TOPGEN], 1u);
            else XB_SPIN(xb_ld(&bar[XB_TOPGEN]) == tg, bar);
            __builtin_amdgcn_fence(__ATOMIC_ACQUIRE, "agent");
            xb_add(&bar[XB_XGEN(b.x)], 1u);
            asm volatile("s_waitcnt vmcnt(0)" ::: "memory");
        } else {
            XB_SPIN(xb_ld(&bar[XB_XGEN(b.x)]) == gen, bar);
            __builtin_amdgcn_fence(__ATOMIC_ACQUIRE, "agent");
            asm volatile("s_waitcnt vmcnt(0)" ::: "memory");
        }
    }
    __syncthreads();
}

constexpr int NWAVES = 8, NTHR = 512;
constexpr int LDS_BYTES = 155648;
constexpr int MISC_OFF = LDS_BYTES - 256;
struct Ctx { unsigned char* lds; int tid, lane, wave, gw, ngw, bid, nb; };

__device__ __forceinline__ void tr_item(const float* __restrict__ W, int ldw, int N, bf16* __restrict__ WT, int ldt, int row_off, int col_off, int kb, int nb, float* scr, int lane, const float* __restrict__ gk) {
    const int k0 = 64 * kb, n0 = 32 * nb; const int n = n0 + (lane & 31);
    float v[32];
    const float* wp = W + (size_t)(k0 + (lane >> 5)) * ldw + (n < N ? n : 0);
#pragma unroll
    for (int i = 0; i < 32; ++i) v[i] = wp[(size_t)(2 * i) * ldw];
    asm volatile("" : "+v"(v[0]), "+v"(v[1]), "+v"(v[2]), "+v"(v[3]), "+v"(v[4]), "+v"(v[5]), "+v"(v[6]), "+v"(v[7]), "+v"(v[8]), "+v"(v[9]), "+v"(v[10]), "+v"(v[11]), "+v"(v[12]), "+v"(v[13]), "+v"(v[14]), "+v"(v[15]));
    asm volatile("" : "+v"(v[16]), "+v"(v[17]), "+v"(v[18]), "+v"(v[19]), "+v"(v[20]), "+v"(v[21]), "+v"(v[22]), "+v"(v[23]), "+v"(v[24]), "+v"(v[25]), "+v"(v[26]), "+v"(v[27]), "+v"(v[28]), "+v"(v[29]), "+v"(v[30]), "+v"(v[31]));
    const float msk = (n < N) ? 1.f : 0.f;
    if (gk) {
        float gv[32];
#pragma unroll
        for (int i = 0; i < 32; ++i) gv[i] = gk[k0 + 2 * i + (lane >> 5)];
#pragma unroll
        for (int i = 0; i < 32; ++i) v[i] *= gv[i];
    }
#pragma unroll
    for (int i = 0; i < 32; ++i) { const int kk = 2 * i + (lane >> 5); scr[kk * 33 + (lane & 31)] = v[i] * msk; }
    __builtin_amdgcn_fence(__ATOMIC_RELEASE, "wavefront"); __builtin_amdgcn_wave_barrier(); __builtin_amdgcn_fence(__ATOMIC_ACQUIRE, "wavefront");
    const int c = lane & 7;
#pragma unroll
    for (int j = 0; j < 4; ++j) { const int nn = (lane >> 3) + 8 * j; const float* s = scr + (8 * c) * 33 + nn;
        u32x4 o; o.x = pk2(s[0 * 33], s[1 * 33]); o.y = pk2(s[2 * 33], s[3 * 33]); o.z = pk2(s[4 * 33], s[5 * 33]); o.w = pk2(s[6 * 33], s[7 * 33]);
        *(u32x4*)(WT + (size_t)(row_off + n0 + nn) * ldt + col_off + k0 + 8 * c) = o; }
    __builtin_amdgcn_fence(__ATOMIC_RELEASE, "wavefront"); __builtin_amdgcn_wave_barrier(); __builtin_amdgcn_fence(__ATOMIC_ACQUIRE, "wavefront");
}
__device__ __forceinline__ void conv_mat(const Ctx& c, const float* W, int K, int ldw, int N, int Npad, bf16* WT, int ldt, int row_off, int col_off, const float* gk = nullptr) {
    float* scr = (float*)(c.lds + c.wave * 8704);
    const int nblk = Npad / 32, nit = (K / 64) * nblk;
    for (int it = c.gw; it < nit; it += c.ngw) tr_item(W, ldw, N, WT, ldt, row_off, col_off, it / nblk, it % nblk, scr, c.lane, gk);
}

__device__ __forceinline__ void norm_rows_bf16(const Ctx& c, const float* __restrict__ X, const float* __restrict__ g, bf16* __restrict__ O, int nrows) {
    f32x4 gv[8];
#pragma unroll
    for (int j = 0; j < 8; ++j) gv[j] = *(const f32x4*)(g + 4 * c.lane + 256 * j);
    for (int m = c.gw; m < nrows; m += c.ngw) {
        const f32x4* xr = (const f32x4*)(X + (size_t)m * D) + c.lane; f32x4 v[8]; float s = 0.f;
#pragma unroll
        for (int j = 0; j < 8; ++j) { v[j] = xr[64 * j]; s += (v[j].x * v[j].x + v[j].y * v[j].y) + (v[j].z * v[j].z + v[j].w * v[j].w); }
        const float rstd = 1.0f / sqrtf(wave_sum(s) * (1.f / D) + NORM_EPS);
        u32x2* o8 = (u32x2*)(O + (size_t)m * D) + c.lane;
#pragma unroll
        for (int j = 0; j < 8; ++j) { u32x2 w; w.x = pk2(v[j].x * rstd * gv[j].x, v[j].y * rstd * gv[j].y); w.y = pk2(v[j].z * rstd * gv[j].z, v[j].w * rstd * gv[j].w); o8[64 * j] = w; }
    }
}
__device__ __forceinline__ void cast_rows_ss(const Ctx& c, const float* __restrict__ X, bf16* __restrict__ O, unsigned long long* rowss, int nrows) {
    for (int m = c.gw; m < nrows; m += 2 * c.ngw) {
        const int m2 = (m + c.ngw < nrows) ? m + c.ngw : m;
        const f32x4* xr = (const f32x4*)(X + (size_t)m * D) + c.lane; const f32x4* xr2 = (const f32x4*)(X + (size_t)m2 * D) + c.lane; f32x4 v[8], v2[8]; float s = 0.f, s2 = 0.f;
#pragma unroll
        for (int j = 0; j < 8; ++j) { v[j] = xr[64 * j]; v2[j] = xr2[64 * j]; }
#pragma unroll
        for (int j = 0; j < 8; ++j) { s += (v[j].x * v[j].x + v[j].y * v[j].y) + (v[j].z * v[j].z + v[j].w * v[j].w); s2 += (v2[j].x * v2[j].x + v2[j].y * v2[j].y) + (v2[j].z * v2[j].z + v2[j].w * v2[j].w); }
#pragma unroll
        for (int o = 1; o < 64; o <<= 1) { s += __shfl_xor(s, o); s2 += __shfl_xor(s2, o); }
        u32x2* o8 = (u32x2*)(O + (size_t)m * D) + c.lane; u32x2* o82 = (u32x2*)(O + (size_t)m2 * D) + c.lane;
#pragma unroll
        for (int j = 0; j < 8; ++j) { u32x2 w; w.x = pk2(v[j].x, v[j].y); w.y = pk2(v[j].z, v[j].w); o8[64 * j] = w; }
        if (c.lane == 0) rowss[m] = (unsigned long long)(s * 16777216.0f);
        if (m2 != m) {
#pragma unroll
            for (int j = 0; j < 8; ++j) { u32x2 w; w.x = pk2(v2[j].x, v2[j].y); w.y = pk2(v2[j].z, v2[j].w); o82[64 * j] = w; }
            if (c.lane == 0) rowss[m2] = (unsigned long long)(s2 * 16777216.0f);
        }
    }
}
__device__ __forceinline__ void scale_rows_out(const Ctx& c, const bf16* __restrict__ XB, const float* __restrict__ g, const unsigned long long* rowss, float* O, int nrows) {
    for (int m = c.gw; m < nrows; m += 2 * c.ngw) {
        const int m2 = (m + c.ngw < nrows) ? m + c.ngw : m;
        u32x4 xa[4], xb[4];
#pragma unroll
        for (int j = 0; j < 4; ++j) { xa[j] = *(const u32x4*)(XB + (size_t)m * D + 8 * c.lane + 512 * j); xb[j] = *(const u32x4*)(XB + (size_t)m2 * D + 8 * c.lane + 512 * j); }
        const float ra = __builtin_amdgcn_rsqf((float)rowss[m] * (5.9604644775390625e-08f / D) + NORM_EPS), rb = __builtin_amdgcn_rsqf((float)rowss[m2] * (5.9604644775390625e-08f / D) + NORM_EPS);
#pragma unroll
        for (int j = 0; j < 4; ++j) { float x[8]; unpack8(xa[j], x);
            const f32x4 g0 = *(const f32x4*)(g + 8 * c.lane + 512 * j), g1 = *(const f32x4*)(g + 8 * c.lane + 512 * j + 4);
            *(f32x4*)(O + (size_t)m * D + 8 * c.lane + 512 * j) = (f32x4){x[0] * ra * g0.x, x[1] * ra * g0.y, x[2] * ra * g0.z, x[3] * ra * g0.w};
            *(f32x4*)(O + (size_t)m * D + 8 * c.lane + 512 * j + 4) = (f32x4){x[4] * ra * g1.x, x[5] * ra * g1.y, x[6] * ra * g1.z, x[7] * ra * g1.w};
            if (m2 != m) { unpack8(xb[j], x);
                *(f32x4*)(O + (size_t)m2 * D + 8 * c.lane + 512 * j) = (f32x4){x[0] * rb * g0.x, x[1] * rb * g0.y, x[2] * rb * g0.z, x[3] * rb * g0.w};
                *(f32x4*)(O + (size_t)m2 * D + 8 * c.lane + 512 * j + 4) = (f32x4){x[4] * rb * g1.x, x[5] * rb * g1.y, x[6] * rb * g1.z, x[7] * rb * g1.w}; } }
    }
}
__device__ __forceinline__ void norm_rows_f32(const Ctx& c, float* X, const float* __restrict__ g, int nrows) {
    f32x4 gv[8];
#pragma unroll
    for (int j = 0; j < 8; ++j) gv[j] = *(const f32x4*)(g + 4 * c.lane + 256 * j);
    for (int m = c.gw; m < nrows; m += c.ngw) {
        f32x4* xr = (f32x4*)(X + (size_t)m * D) + c.lane; f32x4 v[8]; float s = 0.f;
#pragma unroll
        for (int j = 0; j < 8; ++j) { v[j] = xr[64 * j]; s += (v[j].x * v[j].x + v[j].y * v[j].y) + (v[j].z * v[j].z + v[j].w * v[j].w); }
        const float rstd = 1.0f / sqrtf(wave_sum(s) * (1.f / D) + NORM_EPS);
#pragma unroll
        for (int j = 0; j < 8; ++j) xr[64 * j] = v[j] * rstd * gv[j];
    }
}

__device__ __forceinline__ void rope_tables(const Ctx& c, const int* __restrict__ start_frame, float* ropea, float* ropei) {
    const float HA[16] = {1.000000000e+00f, 4.403665960e-01f, 1.939227432e-01f, 8.539710194e-02f, 3.760603070e-02f, 1.656044088e-02f, 7.292664610e-03f, 3.211446106e-03f, 1.414213562e-03f, 6.227724371e-04f, 2.742481884e-04f, 1.207697351e-04f, 5.318295734e-05f, 2.341999971e-05f, 1.031338525e-05f, 4.541670478e-06f};
    const float LA[16] = {0.000000000e+00f, 6.688275267e-09f, 1.547429962e-09f, -1.652958881e-09f, 2.282729838e-10f, -8.020459852e-10f, 1.273676581e-10f, -1.116812753e-10f, -1.115275407e-14f, -1.514006802e-11f, -1.268531807e-11f, 2.335000249e-12f, 1.624761415e-12f, -7.452659366e-13f, 1.309491117e-13f, 2.687890499e-15f};
    const float HI[8] = {1.000000000e+00f, 1.939227432e-01f, 3.760603070e-02f, 7.292664610e-03f, 1.414213562e-03f, 2.742481884e-04f, 5.318295734e-05f, 1.031338525e-05f};
    const float LI[8] = {0.000000000e+00f, 1.547429962e-09f, 2.282729838e-10f, 1.273676581e-10f, -1.115275407e-14f, -1.268531807e-11f, 1.624761415e-12f, 1.309491117e-13f};
    const int gt = c.bid * NTHR + c.tid, ngt = c.nb * NTHR;
    for (int i = gt; i < M * 24; i += ngt) {
        const int m = i / 24, j = i % 24; const int b = m / SEQ, t = m % SEQ;
        const float pos = (float)(start_frame[b] + t);
        float hi = 0.f, lo = 0.f;
#pragma unroll
        for (int q = 0; q < 16; ++q) if (j == q) { hi = HA[q]; lo = LA[q]; }
#pragma unroll
        for (int q = 0; q < 8; ++q) if (j == 16 + q) { hi = HI[q]; lo = LI[q]; }
        const float p = pos * hi, e = fmaf(pos, hi, -p) + pos * lo;
        float sn, cs; sincosf(p, &sn, &cs);
        const float cc = cs - e * sn, ss = sn + e * cs;
        if (j < 16) { ropea[(size_t)m * 32 + j] = cc; ropea[(size_t)m * 32 + 16 + j] = ss; }
        else { ropei[(size_t)m * 16 + (j - 16)] = cc; ropei[(size_t)m * 16 + 8 + (j - 16)] = ss; }
    }
}

__device__ __forceinline__ void build_wql(const Ctx& c, const float* __restrict__ w_uq, const float* __restrict__ w_uk, bf16* WQ) {
    const int gt = c.bid * NTHR + c.tid, ngt = c.nb * NTHR;
    for (int it = gt; it < 512 * 256; it += ngt) {
        const int cc = it & 511, rb = it >> 9, h = rb >> 5, r0 = (rb & 31) * 8;
        const float* a = w_uq + (size_t)cc * 1024 + h * 128 + 32; const float* bq = w_uk + (size_t)r0 * 768 + h * 96; float s[8];
#pragma unroll
        for (int j = 0; j < 8; ++j) s[j] = 0.f;
#pragma unroll 2
        for (int d4 = 0; d4 < 24; ++d4) { const f32x4 av = *(const f32x4*)(a + 4 * d4);
#pragma unroll
            for (int j = 0; j < 8; ++j) { const f32x4 bv = *(const f32x4*)(bq + (size_t)j * 768 + 4 * d4); s[j] += (av.x * bv.x + av.y * bv.y) + (av.z * bv.z + av.w * bv.w); } }
#pragma unroll
        for (int j = 0; j < 8; ++j) WQ[(size_t)(h * 256 + r0 + j) * 512 + cc] = (bf16)f2bf(s[j]);
    }
}
__device__ __forceinline__ void build_wout(const Ctx& c, const float* __restrict__ w_uv, const float* __restrict__ w_out, bf16* WO) {
    const int gt = c.bid * NTHR + c.tid, ngt = c.nb * NTHR;
    for (int i = gt; i < 8 * 32 * 2048; i += ngt) {
        const int n = i & 2047, rg = (i >> 11) & 31, h = i >> 16; float acc[8];
#pragma unroll
        for (int j = 0; j < 8; ++j) acc[j] = 0.f;
#pragma unroll 2
        for (int d4 = 0; d4 < 32; ++d4) {
            const float* wop = w_out + (size_t)(h * 128 + 4 * d4) * 2048 + n; const float wo0 = wop[0], wo1 = wop[2048], wo2 = wop[4096], wo3 = wop[6144];
#pragma unroll
            for (int j = 0; j < 8; ++j) { const f32x4 u = *(const f32x4*)(w_uv + (size_t)(rg * 8 + j) * 1024 + h * 128 + 4 * d4); acc[j] += (u.x * wo0 + u.y * wo1) + (u.z * wo2 + u.w * wo3); } }
        u32x4 o; o.x = pk2(acc[0], acc[1]); o.y = pk2(acc[2], acc[3]); o.z = pk2(acc[4], acc[5]); o.w = pk2(acc[6], acc[7]);
        *(u32x4*)(WO + (size_t)n * OC + h * 256 + rg * 8) = o;
    }
}

__device__ __forceinline__ void dsa_prep(const Ctx& c, const bf16* __restrict__ H, const float* __restrict__ cqn_g, const float* __restrict__ ckv_g, const float* __restrict__ kidx_g,
                                         const float* __restrict__ ropea, const float* __restrict__ ropei, bf16* CQN, bf16* KF, bf16* KIDX, float* WIDX) {
    const int l = c.lane;
    struct Tok { u32x4 cq; u32x2 ckv; unsigned short r1, r2, ki, wi; float csa, sna, csi, sni; };
    auto ld = [&](int m) -> Tok { Tok t; const bf16* h = H + (size_t)m * HC; const int l15 = l & 15, l7 = l & 7;
        t.cq = *(const u32x4*)(h + 8 * l); t.ckv = *(const u32x2*)(h + 512 + 4 * l); t.r1 = h[768 + l15]; t.r2 = h[768 + 16 + l15]; t.ki = h[800 + l]; t.wi = h[864 + l15];
        t.csa = ropea[(size_t)m * 32 + l15]; t.sna = ropea[(size_t)m * 32 + 16 + l15]; t.csi = ropei[(size_t)m * 16 + l7]; t.sni = ropei[(size_t)m * 16 + 8 + l7]; return t; };
    auto proc = [&](int m, const Tok& t) {
        {
            float f[8]; unpack8(t.cq, f); float s = 0.f;
#pragma unroll
            for (int j = 0; j < 8; ++j) s += f[j] * f[j];
            const float rstd = 1.0f / sqrtf(wave_sum(s) * (1.f / 512.f) + NORM_EPS);
            u32x4 o; o.x = pk2(f[0] * rstd * cqn_g[8 * l + 0], f[1] * rstd * cqn_g[8 * l + 1]); o.y = pk2(f[2] * rstd * cqn_g[8 * l + 2], f[3] * rstd * cqn_g[8 * l + 3]);
            o.z = pk2(f[4] * rstd * cqn_g[8 * l + 4], f[5] * rstd * cqn_g[8 * l + 5]); o.w = pk2(f[6] * rstd * cqn_g[8 * l + 6], f[7] * rstd * cqn_g[8 * l + 7]);
            *(u32x4*)(CQN + (size_t)m * 512 + 8 * l) = o;
        }
        {
            const u32x2 w = t.ckv; const float f0 = bf2f(w.x & 0xffffu), f1 = bf2f(w.x >> 16), f2 = bf2f(w.y & 0xffffu), f3 = bf2f(w.y >> 16);
            const float s = (f0 * f0 + f1 * f1) + (f2 * f2 + f3 * f3);
            const float rstd = 1.0f / sqrtf(wave_sum(s) * (1.f / 256.f) + NORM_EPS);
            u32x2 o; o.x = pk2(f0 * rstd * ckv_g[4 * l + 0], f1 * rstd * ckv_g[4 * l + 1]); o.y = pk2(f2 * rstd * ckv_g[4 * l + 2], f3 * rstd * ckv_g[4 * l + 3]);
            *(u32x2*)(KF + (size_t)m * KFW + 4 * l) = o;
        }
        if (l < 16) {
            const float x1 = bf2f(t.r1), x2 = bf2f(t.r2); const float cs = t.csa, sn = t.sna;
            KF[(size_t)m * KFW + 256 + l] = (bf16)f2bf(x1 * cs - x2 * sn); KF[(size_t)m * KFW + 256 + 16 + l] = (bf16)f2bf(x2 * cs + x1 * sn);
        }
        {
            const float v = bf2f(t.ki); const float rstd = 1.0f / sqrtf(wave_sum(v * v) * (1.f / 64.f) + NORM_EPS);
            const float y = v * rstd * kidx_g[l];
            const float ylo = __shfl(y, l & 7), yhi = __shfl(y, (l & 7) + 8);
            float o = y;
            if (l < 16) { const float cs = t.csi, sn = t.sni; o = (l < 8) ? (ylo * cs - yhi * sn) : (yhi * cs + ylo * sn); }
            KIDX[(size_t)m * 64 + l] = (bf16)f2bf(o);
        }
        if (l < 16) WIDX[(size_t)m * 16 + l] = bf2f(t.wi) * 0.03125f;
    };
    for (int m = c.gw; m < M; m += 2 * c.ngw) {
        const int m2 = m + c.ngw; const bool two = m2 < M;
        const Tok ta = ld(m); const Tok tb = ld(two ? m2 : m);
        proc(m, ta);
        if (two) proc(m2, tb);
    }
}
__device__ __forceinline__ void q_rope_fix(const Ctx& c, bf16* QALL, const float* __restrict__ ropea, const float* __restrict__ ropei) {
    const int l = c.lane;
    for (int m = c.gw; m < M; m += c.ngw) {
        bf16* q = QALL + (size_t)m * QC;
#pragma unroll
        for (int i = 0; i < 2; ++i) { const int p = l + 64 * i, hh = p >> 4, j = p & 15; bf16* a = q + 2048 + hh * 32 + j;
            const float x1 = bf2f(a[0]), x2 = bf2f(a[16]); const float cs = ropea[(size_t)m * 32 + j], sn = ropea[(size_t)m * 32 + 16 + j];
            a[0] = (bf16)f2bf(x1 * cs - x2 * sn); a[16] = (bf16)f2bf(x2 * cs + x1 * sn); }
#pragma unroll
        for (int i = 0; i < 2; ++i) { const int p = l + 64 * i, hh = p >> 3, j = p & 7; bf16* a = q + 2304 + hh * 64 + j;
            const float x1 = bf2f(a[0]), x2 = bf2f(a[8]); const float cs = ropei[(size_t)m * 16 + j], sn = ropei[(size_t)m * 16 + 8 + j];
            a[0] = (bf16)f2bf(x1 * cs - x2 * sn); a[8] = (bf16)f2bf(x2 * cs + x1 * sn); }
    }
}
__device__ __forceinline__ size_t sc_row_off(int b, int t) { const int ch = t >> 6; return (size_t)b * SC_PER_BATCH + (size_t)4096 * (ch * (ch + 1) / 2) + (size_t)(t & 63) * (64 * (ch + 1)); }
__device__ __forceinline__ void idx_scores_simple(const Ctx& c, const bf16* __restrict__ QALL, const bf16* __restrict__ KIDX, const float* __restrict__ WIDX, float* SC) {
    float* qs = (float*)c.lds;
    float* ws = qs + 1024;
    for (int m = c.bid; m < M; m += c.nb) {
        const int b = m / SEQ, t = m % SEQ, limit = ((t >> 6) + 1) * 64;
        __syncthreads();
        for (int i = c.tid; i < 1024; i += NTHR) qs[i] = bf2f(QALL[(size_t)m * QC + 2304 + i]);
        if (c.tid < 16) ws[c.tid] = WIDX[(size_t)m * 16 + c.tid];
        __syncthreads();
        if (limit <= 256) continue;
        float* row = SC + sc_row_off(b, t);
        for (int s = c.tid; s < limit; s += NTHR) {
            float k[64]; const u32x4* kp = (const u32x4*)(KIDX + (size_t)(b * SEQ + s) * 64);
#pragma unroll
            for (int j = 0; j < 8; ++j) unpack8(kp[j], k + 8 * j);
            float sc = 0.f;
#pragma unroll 1
            for (int h = 0; h < 16; ++h) { asm volatile("" ::: "memory"); float d = 0.f; const f32x4* q4 = (const f32x4*)(qs + h * 64);
#pragma unroll
                for (int j = 0; j < 16; ++j) { const f32x4 q = q4[j]; d += (q.x * k[4 * j] + q.y * k[4 * j + 1]) + (q.z * k[4 * j + 2] + q.w * k[4 * j + 3]); }
                sc += ws[h] * fmaxf(d, 0.f); }
            row[s] = sc;
        }
    }
}
__device__ __forceinline__ void select_row(const float* row, int limit, unsigned short* sel, int l_in, unsigned short* stg = nullptr) {
    int l = l_in; asm volatile("" : "+v"(l));
    const int ng = limit >> 9;
    unsigned key[64];
#pragma unroll
    for (int jg = 0; jg < 8; ++jg) {
        if (jg <= ng) {
#pragma unroll
            for (int j = 8 * jg; j < 8 * jg + 8; ++j) { const int s = j * 64 + l; key[j] = __float_as_uint(row[s < limit ? s : 0]); }
        } else {
#pragma unroll
            for (int j = 8 * jg; j < 8 * jg + 8; ++j) key[j] = 0u;
        }
    }
#pragma unroll
    for (int j = 0; j < 64; ++j) { const int s = j * 64 + l; unsigned u = key[j]; u = (u & 0x80000000u) ? ~u : (u | 0x80000000u); key[j] = (s < limit) ? u : 0u; }
    unsigned mx = 0u;
#pragma unroll
    for (int j = 0; j < 64; ++j) mx = key[j] > mx ? key[j] : mx;
#pragma unroll
    for (int o = 1; o < 64; o <<= 1) { const unsigned t = (unsigned)__shfl_xor((int)mx, o); mx = t > mx ? t : mx; }
    mx = (unsigned)__builtin_amdgcn_readfirstlane((int)mx);
    auto wave_count = [&](int v) -> int {
        v += __builtin_amdgcn_update_dpp(0, v, 0xB1, 0xf, 0xf, true); v += __builtin_amdgcn_update_dpp(0, v, 0x4E, 0xf, 0xf, true);
        v += __builtin_amdgcn_update_dpp(0, v, 0x141, 0xf, 0xf, true); v += __builtin_amdgcn_update_dpp(0, v, 0x140, 0xf, 0xf, true);
        return __builtin_amdgcn_readlane(v, 0) + __builtin_amdgcn_readlane(v, 16) + __builtin_amdgcn_readlane(v, 32) + __builtin_amdgcn_readlane(v, 48); };
    unsigned T = 0u;
#pragma unroll 1
    for (int bit = 31 - __builtin_clz(mx | 1u); bit >= 0; --bit) {
        const unsigned Tn = T | (1u << bit); int cl = 0;
#pragma unroll
        for (int jg = 0; jg < 8; ++jg) if (jg <= ng) {
#pragma unroll
            for (int j = 8 * jg; j < 8 * jg + 8; ++j) cl += (key[j] >= Tn) ? 1 : 0; }
        const int cnt = wave_count(cl);
        if (cnt >= 256) T = Tn;
        if (cnt == 256) break;
    }
    int cgl = 0;
#pragma unroll
    for (int j = 0; j < 64; ++j) cgl += (key[j] > T) ? 1 : 0;
    const int cgt = wave_count(cgl);
    const int need_eq = 256 - cgt;
    int base = 0, beq = 0;
    const unsigned long long lt = (1ull << l) - 1ull;
    if (stg) {
#pragma unroll
        for (int jg = 0; jg < 8; ++jg) if (jg <= ng) {
#pragma unroll
            for (int j = 8 * jg; j < 8 * jg + 8; ++j) {
                const unsigned long long mg = __ballot(key[j] > T);
                const int pos = base + (int)__builtin_amdgcn_mbcnt_hi((unsigned)(mg >> 32), __builtin_amdgcn_mbcnt_lo((unsigned)mg, 0u));
                if (key[j] > T) stg[pos] = (unsigned short)(j * 64 + l);
                base += __popcll(mg);
                const unsigned long long me = __ballot(key[j] == T);
                if (me != 0ull) {
                    const int pe = beq + (int)__builtin_amdgcn_mbcnt_hi((unsigned)(me >> 32), __builtin_amdgcn_mbcnt_lo((unsigned)me, 0u));
                    if (key[j] == T && pe < need_eq) stg[cgt + pe] = (unsigned short)(j * 64 + l);
                    beq += __popcll(me);
                }
            }
        }
        __builtin_amdgcn_fence(__ATOMIC_RELEASE, "wavefront"); __builtin_amdgcn_wave_barrier(); __builtin_amdgcn_fence(__ATOMIC_ACQUIRE, "wavefront");
        *(u32x2*)(sel + 4 * l) = *(const u32x2*)(stg + 4 * l);
        __builtin_amdgcn_fence(__ATOMIC_RELEASE, "wavefront"); __builtin_amdgcn_wave_barrier(); __builtin_amdgcn_fence(__ATOMIC_ACQUIRE, "wavefront");
        return;
    }
#pragma unroll
    for (int jg = 0; jg < 8; ++jg) if (jg <= ng) {
#pragma unroll
        for (int j = 8 * jg; j < 8 * jg + 8; ++j) {
            const unsigned long long mg = __ballot(key[j] > T), me = __ballot(key[j] == T);
            if (key[j] > T) sel[base + __popcll(mg & lt)] = (unsigned short)(j * 64 + l);
            base += __popcll(mg);
            const int pe = beq + __popcll(me & lt);
            if (key[j] == T && pe < need_eq) sel[cgt + pe] = (unsigned short)(j * 64 + l);
            beq += __popcll(me);
        }
    }
}
__device__ __forceinline__ void bs_transpose32(unsigned (&A)[32]) {
    unsigned m = 0x0000FFFFu;
#pragma unroll
    for (int j = 16; j != 0; j >>= 1) {
#pragma unroll
        for (int k = 0; k < 32; ++k) {
            if ((k & j) == 0) {
                const unsigned t = (A[k] ^ (A[k + j] >> j)) & m;
                A[k] ^= t; A[k + j] ^= (t << j);
            }
        }
        m ^= (m << (j >> 1));
    }
}
__device__ __forceinline__ void select_row_bs(const float* row, int limit, unsigned short* sel, int l_in, unsigned short* stg) {
    int l = l_in; asm volatile("" : "+v"(l));
    const int nsl = limit >> 6;
    const int ng = limit >> 9;
    unsigned lo[32], hi[32];
#pragma unroll
    for (int jg = 0; jg < 8; ++jg) {
        if (jg <= ng) {
#pragma unroll
            for (int j = 8 * jg; j < 8 * jg + 8; ++j) { const int s = j * 64 + l; const unsigned u = __float_as_uint(row[s < limit ? s : 0]);
                if (j < 32) lo[j & 31] = u; else hi[j & 31] = u; }
        } else {
#pragma unroll
            for (int j = 8 * jg; j < 8 * jg + 8; ++j) { if (j < 32) lo[j & 31] = 0u; else hi[j & 31] = 0u; }
        }
    }
    asm volatile("" ::: "memory");
#pragma unroll
    for (int j = 0; j < 64; ++j) { const unsigned u = (j < 32) ? lo[j & 31] : hi[j & 31];
        const unsigned kx = (j < nsl) ? ((u & 0x80000000u) ? ~u : (u | 0x80000000u)) : 0u;
        if (j < 32) lo[j & 31] = kx; else hi[j & 31] = kx; }
    const bool has_hi = nsl > 32;
    bs_transpose32(lo);
    if (has_hi) bs_transpose32(hi);
    auto wave_count = [&](int v) -> int {
        v += __builtin_amdgcn_update_dpp(0, v, 0xB1, 0xf, 0xf, true); v += __builtin_amdgcn_update_dpp(0, v, 0x4E, 0xf, 0xf, true);
        v += __builtin_amdgcn_update_dpp(0, v, 0x141, 0xf, 0xf, true); v += __builtin_amdgcn_update_dpp(0, v, 0x140, 0xf, 0xf, true);
        return __builtin_amdgcn_readlane(v, 0) + __builtin_amdgcn_readlane(v, 16) + __builtin_amdgcn_readlane(v, 32) + __builtin_amdgcn_readlane(v, 48); };
    unsigned clo = 0xffffffffu, chi = has_hi ? 0xffffffffu : 0u, glo = 0u, ghi = 0u;
    int G = 0;
#pragma unroll
    for (int i = 0; i < 32; ++i) {
        const unsigned olo = clo & lo[i], ohi = chi & hi[i];
        const int tot = G + wave_count(__builtin_popcount(olo) + __builtin_popcount(ohi));
        const bool take = tot >= 256;
        const unsigned mt = take ? 0u : 0xffffffffu;
        G = take ? G : tot;
        glo |= olo & mt; ghi |= ohi & mt;
        clo = olo ^ (clo & mt); chi = ohi ^ (chi & mt);
        if (tot == 256) break;
    }
    {
        const int need = 256 - G;
        const int ceq = wave_count(__builtin_popcount(clo) + __builtin_popcount(chi));
        if (ceq == need) { glo |= clo; ghi |= chi; }
        else {
            int beq = 0;
#pragma unroll 1
            for (int k = 0; k < 64; ++k) {
                const unsigned bm = 0x80000000u >> (k & 31);
                const bool mine = ((k < 32 ? clo : chi) & bm) != 0u;
                const unsigned long long me = __ballot(mine);
                if (me != 0ull) {
                    const int pe = beq + (int)__builtin_amdgcn_mbcnt_hi((unsigned)(me >> 32), __builtin_amdgcn_mbcnt_lo((unsigned)me, 0u));
                    if (mine && pe < need) { if (k < 32) glo |= bm; else ghi |= bm; }
                    beq += __popcll(me);
                }
            }
        }
    }
    const int cl = __builtin_popcount(glo) + __builtin_popcount(ghi);
    int inc = cl;
#pragma unroll
    for (int o = 1; o < 64; o <<= 1) { const int t = __shfl_up(inc, o); inc += (l >= o) ? t : 0; }
    int pos = inc - cl;
    while (__ballot(glo != 0u) != 0ull) {
        if (glo != 0u) { const int s = __builtin_clz(glo); glo &= ~(0x80000000u >> s); stg[pos++] = (unsigned short)(s * 64 + l); }
    }
    while (__ballot(ghi != 0u) != 0ull) {
        if (ghi != 0u) { const int s = __builtin_clz(ghi); ghi &= ~(0x80000000u >> s); stg[pos++] = (unsigned short)((32 + s) * 64 + l); }
    }
    __builtin_amdgcn_fence(__ATOMIC_RELEASE, "wavefront"); __builtin_amdgcn_wave_barrier(); __builtin_amdgcn_fence(__ATOMIC_ACQUIRE, "wavefront");
    *(u32x2*)(sel + 4 * l) = *(const u32x2*)(stg + 4 * l);
    __builtin_amdgcn_fence(__ATOMIC_RELEASE, "wavefront"); __builtin_amdgcn_wave_barrier(); __builtin_amdgcn_fence(__ATOMIC_ACQUIRE, "wavefront");
}
__device__ __forceinline__ void topk_select(const Ctx& c, const float* __restrict__ SC, bf16* SEL  ) {
    const int l = c.lane;
    for (int m = c.gw; m < M; m += c.ngw) {
        const int b = m / SEQ, t = m % SEQ, limit = ((t >> 6) + 1) * 64;
        unsigned short* sel = (unsigned short*)SEL + (size_t)m * 256;
        if (limit <= 256) { for (int i = l; i < 256; i += 64) sel[i] = (unsigned short)(i < limit ? i : 0); continue; }
        select_row(SC + sc_row_off(b, t), limit, sel, l);
    }
}
__device__ __forceinline__ void dsa_attn_simple(const Ctx& c, const bf16* __restrict__ QALL, const bf16* __restrict__ KF, const bf16* __restrict__ SEL, bf16* OLY, int mmax = M) {
    float* qf = (float*)c.lds;
    float* P = qf + 8 * 288;
    int* sl = (int*)(P + 8 * 256);
    const float scale = 0.08838834764831845f;
    for (int m = c.bid; m < mmax; m += c.nb) {
        const int b = m / SEQ, t = m % SEQ, limit = ((t >> 6) + 1) * 64, cnt = limit < 256 ? limit : 256;
        __syncthreads();
        for (int i = c.tid; i < 8 * 288; i += NTHR) { const int h = i / 288, d = i % 288; qf[i] = bf2f(d < 256 ? QALL[(size_t)m * QC + h * 256 + d] : QALL[(size_t)m * QC + 2048 + h * 32 + (d - 256)]); }
        if (c.tid < 256) sl[c.tid] = (int)((const unsigned short*)SEL)[(size_t)m * 256 + c.tid];
        __syncthreads();
        if (c.tid < 256) {
            float acc[8];
#pragma unroll
            for (int h = 0; h < 8; ++h) acc[h] = 0.f;
            if (c.tid < cnt) {
                const u32x4* kp = (const u32x4*)(KF + (size_t)(b * SEQ + sl[c.tid]) * KFW);
                for (int ch = 0; ch < 36; ++ch) { float k[8]; unpack8(kp[ch], k);
#pragma unroll
                    for (int h = 0; h < 8; ++h) { const float* q = qf + h * 288 + ch * 8;
#pragma unroll
                        for (int j = 0; j < 8; ++j) acc[h] += k[j] * q[j]; } }
            }
#pragma unroll
            for (int h = 0; h < 8; ++h) P[h * 256 + c.tid] = (c.tid < cnt) ? acc[h] * scale : -INFINITY;
        }
        __syncthreads();
        {
            const int h = c.wave; float v[4]; float mx = -INFINITY;
#pragma unroll
            for (int i = 0; i < 4; ++i) { v[i] = P[h * 256 + c.lane + 64 * i]; mx = fmaxf(mx, v[i]); }
            mx = wave_max(mx); float s = 0.f;
#pragma unroll
            for (int i = 0; i < 4; ++i) { v[i] = __expf(v[i] - mx); s += v[i]; }
            s = wave_sum(s); const float inv = 1.f / s;
#pragma unroll
            for (int i = 0; i < 4; ++i) P[h * 256 + c.lane + 64 * i] = v[i] * inv;
        }
        __syncthreads();
        {
            const int r = c.tid & 255, hg = c.tid >> 8; float o[4] = {0.f, 0.f, 0.f, 0.f};
            for (int i = 0; i < cnt; ++i) { const float v = bf2f(KF[(size_t)(b * SEQ + sl[i]) * KFW + r]);
#pragma unroll
                for (int hh = 0; hh < 4; ++hh) o[hh] += P[(hg * 4 + hh) * 256 + i] * v; }
#pragma unroll
            for (int hh = 0; hh < 4; ++hh) OLY[(size_t)m * OC + (hg * 4 + hh) * 256 + r] = (bf16)f2bf(o[hh]);
        }
    }
}
__device__ __forceinline__ void xattn_simple(const Ctx& c, const bf16* __restrict__ XQ, const bf16* __restrict__ KVBIG, int layer, bf16* XO) {
    float* qf = (float*)c.lds;
    float* P = qf + 512;
    const float scale = 0.08838834764831845f;
    for (int m = c.bid; m < M; m += c.nb) {
        const int b = m / SEQ;
        const bf16* kvb = KVBIG + (size_t)(layer * 2048 + b * 256) * 4096 + layer * 1024;
        __syncthreads();
        qf[c.tid] = bf2f(XQ[(size_t)m * 512 + c.tid]);
        __syncthreads();
        {
            const int j = c.tid & 255, hp = c.tid >> 8;
#pragma unroll
            for (int hh = 0; hh < 2; ++hh) { const int h = hp * 2 + hh; const u32x4* kp = (const u32x4*)(kvb + (size_t)j * 4096 + h * 128); float d = 0.f;
                for (int ch = 0; ch < 16; ++ch) { float k[8]; unpack8(kp[ch], k);
#pragma unroll
                    for (int e = 0; e < 8; ++e) d += k[e] * qf[h * 128 + ch * 8 + e]; }
                P[h * 256 + j] = d * scale; }
        }
        __syncthreads();
        if (c.wave < 4) { const int h = c.wave; float v[4]; float mx = -INFINITY;
#pragma unroll
            for (int i = 0; i < 4; ++i) { v[i] = P[h * 256 + c.lane + 64 * i]; mx = fmaxf(mx, v[i]); }
            mx = wave_max(mx); float s = 0.f;
#pragma unroll
            for (int i = 0; i < 4; ++i) { v[i] = __expf(v[i] - mx); s += v[i]; }
            s = wave_sum(s); const float inv = 1.f / s;
#pragma unroll
            for (int i = 0; i < 4; ++i) P[h * 256 + c.lane + 64 * i] = v[i] * inv; }
        __syncthreads();
        {   const int h = c.tid >> 7; float o = 0.f;
            for (int j = 0; j < 256; ++j) o += P[h * 256 + j] * bf2f(kvb[(size_t)j * 4096 + 512 + c.tid]);
            XO[(size_t)m * 512 + c.tid] = (bf16)f2bf(o); }
    }
}
__device__ __forceinline__ float x16_max(float v) { const unsigned u = __builtin_bit_cast(unsigned, v); auto r = __builtin_amdgcn_permlane16_swap(u, u, false, false); return fmaxf(__builtin_bit_cast(float, (unsigned)r[0]), __builtin_bit_cast(float, (unsigned)r[1])); }
__device__ __forceinline__ float x32_max(float v) { const unsigned u = __builtin_bit_cast(unsigned, v); auto r = __builtin_amdgcn_permlane32_swap(u, u, false, false); return fmaxf(__builtin_bit_cast(float, (unsigned)r[0]), __builtin_bit_cast(float, (unsigned)r[1])); }
__device__ __forceinline__ float x16_sum(float v) { const unsigned u = __builtin_bit_cast(unsigned, v); auto r = __builtin_amdgcn_permlane16_swap(u, u, false, false); return __builtin_bit_cast(float, (unsigned)r[0]) + __builtin_bit_cast(float, (unsigned)r[1]); }
__device__ __forceinline__ float x32_sum(float v) { const unsigned u = __builtin_bit_cast(unsigned, v); auto r = __builtin_amdgcn_permlane32_swap(u, u, false, false); return __builtin_bit_cast(float, (unsigned)r[0]) + __builtin_bit_cast(float, (unsigned)r[1]); }
typedef short bf16x8 __attribute__((ext_vector_type(8)));
typedef short bf16x4 __attribute__((ext_vector_type(4)));
__device__ __forceinline__ bf16x4 tr_read4(const unsigned char* p) { return __builtin_amdgcn_ds_read_tr16_b64_v4i16((LAS bf16x4*)p); }
__device__ __forceinline__ bf16x8 cat8(bf16x4 a, bf16x4 b) { return __builtin_shufflevector(a, b, 0, 1, 2, 3, 4, 5, 6, 7); }
__device__ __forceinline__ bf16x8 pack_p8(const f32x4 a, const f32x4 b) {
    u32x4 w; w.x = pg8::cvt_pk_bf16(a[0], a[1]); w.y = pg8::cvt_pk_bf16(a[2], a[3]); w.z = pg8::cvt_pk_bf16(b[0], b[1]); w.w = pg8::cvt_pk_bf16(b[2], b[3]);
    return __builtin_bit_cast(bf16x8, w);
}
__device__ __forceinline__ bf16x8 rope_frag(const bf16x8 xf, const bf16x8 pf, const float* cs, const float* sn, bool lo) {
    float x[8], p[8]; unpack8(__builtin_bit_cast(u32x4, xf), x); unpack8(__builtin_bit_cast(u32x4, pf), p);
    const float sg = lo ? -1.f : 1.f; float o[8];
#pragma unroll
    for (int j = 0; j < 8; ++j) o[j] = x[j] * cs[j] + sg * p[j] * sn[j];
    u32x4 w; w.x = pg8::cvt_pk_bf16(o[0], o[1]); w.y = pg8::cvt_pk_bf16(o[2], o[3]); w.z = pg8::cvt_pk_bf16(o[4], o[5]); w.w = pg8::cvt_pk_bf16(o[6], o[7]);
    return __builtin_bit_cast(bf16x8, w);
}
__device__ __forceinline__ bf16x8 xchg_frag(const bf16x8 v, int lane_xor) { u32x4 u = __builtin_bit_cast(u32x4, v); u32x4 r;
    r.x = (unsigned)__shfl_xor((int)u.x, lane_xor); r.y = (unsigned)__shfl_xor((int)u.y, lane_xor); r.z = (unsigned)__shfl_xor((int)u.z, lane_xor); r.w = (unsigned)__shfl_xor((int)u.w, lane_xor); return __builtin_bit_cast(bf16x8, r); }
constexpr int XA_PITCH = 272;
__device__ __forceinline__ void xattn_mfma(const Ctx& c, const bf16* __restrict__ XQ, const bf16* __restrict__ KVBIG, int layer, bf16* XO) {
    unsigned char* Kl = c.lds; unsigned char* Vl = c.lds + 256 * XA_PITCH;
    const int l = c.lane, n16 = l & 15, g = l >> 4;
    const float scale = 0.08838834764831845f * 1.4426950408889634f;
    for (int unit = c.bid; unit < 256; unit += c.nb) {
        const int b = unit >> 5, h = (unit >> 3) & 3, qc = unit & 7;
        const bf16* kvb = KVBIG + (size_t)(layer * 2048 + b * 256) * 4096 + layer * 1024 + h * 128;
        __syncthreads();
        {
            u32x4 kq[8], vq[8];
#pragma unroll
            for (int j = 0; j < 8; ++j) { const int i = c.tid + NTHR * j, row = i >> 4, ch = i & 15; kq[j] = *(const u32x4*)(kvb + (size_t)row * 4096 + ch * 8); vq[j] = *(const u32x4*)(kvb + (size_t)row * 4096 + 512 + ch * 8); }
#pragma unroll
            for (int j = 0; j < 8; ++j) { const int i = c.tid + NTHR * j, row = i >> 4, ch = i & 15; *(u32x4*)(Kl + row * XA_PITCH + ch * 16) = kq[j]; *(u32x4*)(Vl + row * XA_PITCH + ch * 16) = vq[j]; }
        }
        bf16x8 Qall[4][4];
#pragma unroll
        for (int g4 = 0; g4 < 4; ++g4) { const size_t m = (size_t)b * SEQ + qc * 512 + c.wave * 64 + g4 * 16 + n16;
#pragma unroll
            for (int kk = 0; kk < 4; ++kk) Qall[g4][kk] = *(const bf16x8*)(XQ + m * 512 + h * 128 + 32 * kk + 8 * g); }
        __syncthreads();
#pragma unroll
        for (int g4 = 0; g4 < 4; ++g4) {
            const size_t m = (size_t)b * SEQ + qc * 512 + c.wave * 64 + g4 * 16 + n16;
            bf16x8 Qb[4];
#pragma unroll
            for (int kk = 0; kk < 4; ++kk) Qb[kk] = Qall[g4][kk];
            f32x4 S[16];
#pragma unroll
            for (int j = 0; j < 16; ++j) { S[j] = (f32x4){0.f, 0.f, 0.f, 0.f};
#pragma unroll
                for (int kk = 0; kk < 4; ++kk) { const bf16x8 A = *(const bf16x8*)(Kl + (16 * j + n16) * XA_PITCH + (32 * kk + 8 * g) * 2);
                    S[j] = __builtin_amdgcn_mfma_f32_16x16x32_bf16(A, Qb[kk], S[j], 0, 0, 0); } }
            float mx = -INFINITY;
#pragma unroll
            for (int j = 0; j < 16; ++j) mx = fmaxf(mx, fmaxf(fmaxf(S[j][0], S[j][1]), fmaxf(S[j][2], S[j][3])));
            mx = x32_max(x16_max(mx));
            float sum = 0.f; const float mo = mx * scale;
#pragma unroll
            for (int j = 0; j < 16; ++j) {
#pragma unroll
                for (int r = 0; r < 4; ++r) { const float p = __builtin_amdgcn_exp2f(S[j][r] * scale - mo); S[j][r] = p; sum += p; } }
            sum = x32_sum(x16_sum(sum));
            const float inv = 1.f / sum;
            bf16x8 Pb[8];
#pragma unroll
            for (int jj = 0; jj < 8; ++jj) Pb[jj] = pack_p8(S[2 * jj], S[2 * jj + 1]);
            const int q4 = n16 >> 2, p4 = l & 3;
#pragma unroll
            for (int dt = 0; dt < 8; ++dt) { f32x4 O = (f32x4){0.f, 0.f, 0.f, 0.f};
#pragma unroll
                for (int jj = 0; jj < 8; ++jj) { const unsigned char* vp = Vl + (32 * jj + 4 * g + q4) * XA_PITCH + (16 * dt) * 2 + 8 * p4;
                    const bf16x8 A = cat8(tr_read4(vp), tr_read4(vp + 16 * XA_PITCH));
                    O = __builtin_amdgcn_mfma_f32_16x16x32_bf16(A, Pb[jj], O, 0, 0, 0); }
                u32x2 w; w.x = pg8::cvt_pk_bf16(O[0] * inv, O[1] * inv); w.y = pg8::cvt_pk_bf16(O[2] * inv, O[3] * inv);
                *(u32x2*)(XO + m * 512 + h * 128 + 16 * dt + 4 * g) = w; }
        }
    }
}
__device__ __forceinline__ void diag_cmp_bf16(const Ctx& c, const bf16* A, int lda, const bf16* B, int ldb, int rows, int cols, float* acc) {
    float d2 = 0.f, a2 = 0.f;
    const size_t n = (size_t)rows * cols;
    for (size_t i = (size_t)c.bid * NTHR + c.tid; i < n; i += (size_t)c.nb * NTHR) { const size_t r = i / cols, cc = i % cols; const float a = bf2f(A[r * lda + cc]), b = bf2f(B[r * ldb + cc]); d2 += (a - b) * (a - b); a2 += a * a; }
    d2 = wave_sum(d2); a2 = wave_sum(a2);
    if (c.lane == 0) { atomicAdd(acc, d2); atomicAdd(acc + 1, a2); }
}
constexpr int DA_PITCH = 528, DA_WAVE_BYTES = 32 * DA_PITCH;
__device__ __forceinline__ void dsa_attn_mfma(const Ctx& c, const bf16* __restrict__ QALL, const bf16* __restrict__ KF, const bf16* __restrict__ SEL, const float* __restrict__ ROPEA, bf16* OLY, int m_first, int m_stride, int m_end) {
    unsigned char* Vw = c.lds + c.wave * DA_WAVE_BYTES;
    const int l = c.lane, n16 = l & 15, g = l >> 4, q4 = n16 >> 2, p4 = l & 3, hh = n16 & 7;
    const float scale = 0.08838834764831845f * 1.4426950408889634f;
    bf16x8 K0[9], K1[9];
    int sx0 = 0, sx1 = 0;
    bool qpre = false;
#pragma unroll 1
    for (int m = m_first; m < m_end; m += m_stride) {
        const int b = m / SEQ, t = m % SEQ, limit = ((t >> 6) + 1) * 64, cnt = limit < 256 ? limit : 256, nblk = cnt >> 5;
        const bf16* qrow = QALL + (size_t)m * QC;
        bf16x8 Qb[9];
        if (qpre) {
#pragma unroll
            for (int kk = 0; kk < 9; ++kk) Qb[kk] = K0[kk];
        } else {
#pragma unroll
            for (int kk = 0; kk < 8; ++kk) Qb[kk] = *(const bf16x8*)(qrow + hh * 256 + 32 * kk + 8 * g);
            Qb[8] = *(const bf16x8*)(qrow + 2048 + hh * 32 + 8 * g);
        }
        {
            const bf16x8 pf = xchg_frag(Qb[8], 32); float cs[8], sn[8];
            const f32x4 c0 = *(const f32x4*)(ROPEA + (size_t)m * 32 + 8 * (g & 1)), c1 = *(const f32x4*)(ROPEA + (size_t)m * 32 + 8 * (g & 1) + 4), s0 = *(const f32x4*)(ROPEA + (size_t)m * 32 + 16 + 8 * (g & 1)), s1 = *(const f32x4*)(ROPEA + (size_t)m * 32 + 16 + 8 * (g & 1) + 4);
            cs[0] = c0.x; cs[1] = c0.y; cs[2] = c0.z; cs[3] = c0.w; cs[4] = c1.x; cs[5] = c1.y; cs[6] = c1.z; cs[7] = c1.w; sn[0] = s0.x; sn[1] = s0.y; sn[2] = s0.z; sn[3] = s0.w; sn[4] = s1.x; sn[5] = s1.y; sn[6] = s1.z; sn[7] = s1.w;
            Qb[8] = rope_frag(Qb[8], pf, cs, sn, g < 2); }
        f32x4 O[16];
#pragma unroll
        for (int dt = 0; dt < 16; ++dt) O[dt] = (f32x4){0.f, 0.f, 0.f, 0.f};
        float mrun = -INFINITY, lrun = 0.f;
        const unsigned short* selp = (const unsigned short*)SEL + (size_t)m * 256;
        const bf16* kfb = KF + (size_t)b * SEQ * KFW;
#define DA_IDX(BLK) do { sx0 = selp[32 * (BLK) + n16]; sx1 = selp[32 * (BLK) + 16 + n16]; } while (0)
#define DA_GATHER() do { const bf16* r0_ = kfb + (size_t)sx0 * KFW + 8 * g; const bf16* r1_ = kfb + (size_t)sx1 * KFW + 8 * g; \
            _Pragma("unroll") for (int kk = 0; kk < 9; ++kk) { K0[kk] = *(const bf16x8*)(r0_ + 32 * kk); K1[kk] = *(const bf16x8*)(r1_ + 32 * kk); } } while (0)
        if (!qpre) DA_IDX(0);
        DA_GATHER(); DA_IDX(nblk > 1 ? 1 : 0);
#pragma unroll 1
        for (int blk = 0; blk < nblk; ++blk) {
            f32x4 S0 = (f32x4){0.f, 0.f, 0.f, 0.f}, S1 = (f32x4){0.f, 0.f, 0.f, 0.f};
#pragma unroll
            for (int kk = 0; kk < 9; ++kk) { S0 = __builtin_amdgcn_mfma_f32_16x16x32_bf16(K0[kk], Qb[kk], S0, 0, 0, 0); S1 = __builtin_amdgcn_mfma_f32_16x16x32_bf16(K1[kk], Qb[kk], S1, 0, 0, 0); }
#pragma unroll
            for (int kk = 0; kk < 8; ++kk) { *(bf16x8*)(Vw + n16 * DA_PITCH + (32 * kk + 8 * g) * 2) = K0[kk]; *(bf16x8*)(Vw + (16 + n16) * DA_PITCH + (32 * kk + 8 * g) * 2) = K1[kk]; }
            __builtin_amdgcn_sched_barrier(0);
            if (blk + 1 < nblk) { DA_GATHER(); DA_IDX(blk + 2 < nblk ? blk + 2 : blk + 1); }
            else if (m + m_stride < m_end) {
                const bf16* qn = QALL + (size_t)(m + m_stride) * QC;
#pragma unroll
                for (int kk = 0; kk < 8; ++kk) K0[kk] = *(const bf16x8*)(qn + hh * 256 + 32 * kk + 8 * g);
                K0[8] = *(const bf16x8*)(qn + 2048 + hh * 32 + 8 * g);
                { const unsigned short* seln = (const unsigned short*)SEL + (size_t)(m + m_stride) * 256; sx0 = seln[n16]; sx1 = seln[16 + n16]; } }
            __builtin_amdgcn_sched_barrier(0);
            float bm = fmaxf(fmaxf(fmaxf(S0[0], S0[1]), fmaxf(S0[2], S0[3])), fmaxf(fmaxf(S1[0], S1[1]), fmaxf(S1[2], S1[3])));
            bm = x32_max(x16_max(bm));
            const float mnew = fmaxf(mrun, bm), alpha = __builtin_amdgcn_exp2f((mrun - mnew) * scale), mo = mnew * scale; mrun = mnew;
            float ps = 0.f;
#pragma unroll
            for (int r = 0; r < 4; ++r) { S0[r] = __builtin_amdgcn_exp2f(S0[r] * scale - mo); S1[r] = __builtin_amdgcn_exp2f(S1[r] * scale - mo); ps += S0[r] + S1[r]; }
            lrun = lrun * alpha + ps;
            const bf16x8 Pb = pack_p8(S0, S1);
#pragma unroll
            for (int dt = 0; dt < 16; ++dt) { O[dt] = O[dt] * alpha;
                const unsigned char* vp = Vw + (4 * g + q4) * DA_PITCH + (16 * dt) * 2 + 8 * p4;
                const bf16x8 A = cat8(tr_read4(vp), tr_read4(vp + 16 * DA_PITCH));
                O[dt] = __builtin_amdgcn_mfma_f32_16x16x32_bf16(A, Pb, O[dt], 0, 0, 0); }
        }
#undef DA_GATHER
#undef DA_IDX
        qpre = (m + m_stride < m_end);
        lrun = x32_sum(x16_sum(lrun));
        const float inv = 1.f / lrun;
        if (n16 < 8) {
            bf16* orow = OLY + (size_t)m * OC + n16 * 256 + 4 * g;
#pragma unroll
            for (int dt = 0; dt < 16; ++dt) { u32x2 w; w.x = pg8::cvt_pk_bf16(O[dt][0] * inv, O[dt][1] * inv); w.y = pg8::cvt_pk_bf16(O[dt][2] * inv, O[dt][3] * inv); *(u32x2*)(orow + 16 * dt) = w; }
        }
    }
}
__device__ __forceinline__ void dsa_attn_queue(const Ctx& c, const bf16* __restrict__ QALL, const bf16* __restrict__ KF, const bf16* __restrict__ SEL, const float* __restrict__ ROPEA, bf16* OLY, unsigned* counter, volatile LAS unsigned* slot) {
    for (;;) {
        __syncthreads();
        if (c.tid == 0) *slot = __hip_atomic_fetch_add(counter, 1u, __ATOMIC_RELAXED, __HIP_MEMORY_SCOPE_AGENT);
        __syncthreads();
        const int chunk = (int)*slot;
        if (chunk >= M / 16) break;
        dsa_attn_mfma(c, QALL, KF, SEL, ROPEA, OLY, chunk * 16 + c.wave, 8, chunk * 16 + 16);
    }
}
__device__ __forceinline__ float relu1(float x) { const int b = __builtin_bit_cast(int, x); return __builtin_bit_cast(float, b > 0 ? b : 0); }
__device__ __forceinline__ void idx_topk_mfma(const Ctx& c, const bf16* __restrict__ QALL, const bf16* __restrict__ KIDX, const float* __restrict__ WIDX, const float* __restrict__ ROPEI, float* scr, bf16* SEL, int nitems) {
    const int l = c.lane, n16 = l & 15, g = l >> 4, qg = c.wave & 3, kh = c.wave >> 2;
#pragma unroll 1
    for (int item = c.bid; item < nitems; item += c.nb) {
        const int b = item >> 5, pr = item & 31;
#pragma unroll 1
        for (int which = 0; which < 2; ++which) {
            const int ch = which ? 63 - pr : pr, L = 64 * (ch + 1), t0 = 64 * ch;
            if (L > 256) {
            const size_t m = (size_t)b * SEQ + t0 + 16 * qg + n16;
            float* srow = scr + (size_t)(16 * qg + n16) * L + 4 * g;
            const int nt = L >> 5, j0 = kh * nt, j1 = j0 + nt;
            const bf16* kp = KIDX + ((size_t)b * SEQ + n16) * 64 + 8 * g;
            {
                bf16x8 Qi[16][2]; float w[16];
                { const bf16* qp = QALL + m * QC + 2304 + 8 * g;
#pragma unroll
                  for (int h = 0; h < 16; ++h) { Qi[h][0] = *(const bf16x8*)(qp + h * 64); Qi[h][1] = *(const bf16x8*)(qp + h * 64 + 32); }
                  {
                      float cs[8], sn[8]; const f32x4 c0 = *(const f32x4*)(ROPEI + m * 16), c1 = *(const f32x4*)(ROPEI + m * 16 + 4), s0 = *(const f32x4*)(ROPEI + m * 16 + 8), s1 = *(const f32x4*)(ROPEI + m * 16 + 12);
                      cs[0] = c0.x; cs[1] = c0.y; cs[2] = c0.z; cs[3] = c0.w; cs[4] = c1.x; cs[5] = c1.y; cs[6] = c1.z; cs[7] = c1.w; sn[0] = s0.x; sn[1] = s0.y; sn[2] = s0.z; sn[3] = s0.w; sn[4] = s1.x; sn[5] = s1.y; sn[6] = s1.z; sn[7] = s1.w;
#pragma unroll
                      for (int h = 0; h < 16; ++h) { const bf16x8 pf = xchg_frag(Qi[h][0], 16); const bf16x8 rf = rope_frag(Qi[h][0], pf, cs, sn, g == 0); if (g < 2) Qi[h][0] = rf; } }
                  const f32x4* wp = (const f32x4*)(WIDX + m * 16);
#pragma unroll
                  for (int q = 0; q < 4; ++q) { const f32x4 v = wp[q]; w[4 * q] = v.x; w[4 * q + 1] = v.y; w[4 * q + 2] = v.z; w[4 * q + 3] = v.w; } }
                bf16x8 Ka = *(const bf16x8*)(kp + (size_t)j0 * 1024), Kb = *(const bf16x8*)(kp + (size_t)j0 * 1024 + 32);
#pragma unroll 1
                for (int j = j0; j < j1; ++j) {
                    const int jn = (j + 1 < j1) ? j + 1 : j;
                    const bf16x8 Na = *(const bf16x8*)(kp + (size_t)jn * 1024), Nb = *(const bf16x8*)(kp + (size_t)jn * 1024 + 32);
                    f32x2 s01 = (f32x2){0.f, 0.f}, s23 = (f32x2){0.f, 0.f};
                    f32x4 a = __builtin_amdgcn_mfma_f32_16x16x32_bf16(Ka, Qi[0][0], (f32x4){0.f, 0.f, 0.f, 0.f}, 0, 0, 0); a = __builtin_amdgcn_mfma_f32_16x16x32_bf16(Kb, Qi[0][1], a, 0, 0, 0);
#pragma unroll
                    for (int h = 0; h < 16; ++h) { f32x4 an = a;
                        if (h < 15) { an = __builtin_amdgcn_mfma_f32_16x16x32_bf16(Ka, Qi[h + 1][0], (f32x4){0.f, 0.f, 0.f, 0.f}, 0, 0, 0); an = __builtin_amdgcn_mfma_f32_16x16x32_bf16(Kb, Qi[h + 1][1], an, 0, 0, 0); }
                        const f32x2 wv = (f32x2){w[h], w[h]};
                        s01 = (f32x2){relu1(a[0]), relu1(a[1])} * wv + s01; s23 = (f32x2){relu1(a[2]), relu1(a[3])} * wv + s23; a = an; }
                    *(f32x4*)(srow + 16 * j) = (f32x4){s01.x, s01.y, s23.x, s23.y};
                    Ka = Na; Kb = Nb;
                }
            }
            }
            asm volatile("s_waitcnt vmcnt(0)" ::: "memory");
            __syncthreads();
            __builtin_amdgcn_fence(__ATOMIC_ACQUIRE, "agent");
            asm volatile("s_waitcnt vmcnt(0)" ::: "memory");
#pragma unroll 1
            for (int i = 0; i < 8; ++i) {
                const int ql = c.wave * 8 + i;
                unsigned short* sel = (unsigned short*)SEL + ((size_t)b * SEQ + t0 + ql) * 256;
                if (L <= 256) { for (int k = l; k < 256; k += 64) sel[k] = (unsigned short)(k < L ? k : 0); }
                else select_row_bs(scr + (size_t)ql * L, L, sel, l, (unsigned short*)(c.lds + c.wave * 512));
            }
            __syncthreads();
        }
    }
}
__device__ __forceinline__ void diag_cmp_sel(const Ctx& c, const bf16* SA, const bf16* SB, int nbatch, float* acc) {
    unsigned* bm = (unsigned*)(c.lds + c.wave * 512);
    float miss = 0.f, tot = 0.f;
    for (int m = c.gw; m < nbatch * SEQ; m += c.ngw) {
        const int t = m % SEQ; if (t < 256) continue;
        bm[c.lane] = 0u; bm[64 + c.lane] = 0u;
        __builtin_amdgcn_fence(__ATOMIC_RELEASE, "wavefront"); __builtin_amdgcn_wave_barrier();
        for (int i = c.lane; i < 256; i += 64) { const unsigned s = ((const unsigned short*)SA)[(size_t)m * 256 + i]; atomicOr(&bm[s >> 5], 1u << (s & 31)); }
        __builtin_amdgcn_fence(__ATOMIC_RELEASE, "wavefront"); __builtin_amdgcn_wave_barrier(); __builtin_amdgcn_fence(__ATOMIC_ACQUIRE, "wavefront");
        for (int i = c.lane; i < 256; i += 64) { const unsigned s = ((const unsigned short*)SB)[(size_t)m * 256 + i]; miss += ((bm[s >> 5] >> (s & 31)) & 1u) ? 0.f : 1.f; tot += 1.f; }
        __builtin_amdgcn_fence(__ATOMIC_RELEASE, "wavefront"); __builtin_amdgcn_wave_barrier();
    }
    miss = wave_sum(miss); tot = wave_sum(tot);
    if (c.lane == 0) { atomicAdd(acc, miss); atomicAdd(acc + 1, tot); }
}
__device__ __forceinline__ void idx_topk_lds(const Ctx& c, const bf16* __restrict__ QALL, const bf16* __restrict__ KIDX, const float* __restrict__ WIDX, const float* __restrict__ ROPEI, u32x4* qscr, bf16* SEL, int nitems) {
    float* SCL = (float*)c.lds;
    f32x4* WL = (f32x4*)(c.lds + 131072);
    const int w8 = c.wave;
#pragma unroll 1
    for (int item = c.bid; item < nitems; item += c.nb) {
        const int b = item >> 5, pr = item & 31;
#pragma unroll 1
        for (int which = 0; which < 2; ++which) {
            int l = c.lane; asm volatile("" : "+v"(l));
            const int n16 = l & 15, g = l >> 4;
            const int ch = which ? 63 - pr : pr, L = 64 * (ch + 1), t0 = 64 * ch;
            if (L <= 256) {
#pragma unroll 1
                for (int i = 0; i < 8; ++i) { unsigned short* sel = (unsigned short*)SEL + ((size_t)b * SEQ + t0 + w8 * 8 + i) * 256; for (int k = l; k < 256; k += 64) sel[k] = (unsigned short)(k < L ? k : 0); }
                continue;
            }
            __syncthreads();
            if (w8 < 4) {
                const size_t m = (size_t)b * SEQ + t0 + 16 * w8 + n16;
                const bf16* qp = QALL + m * QC + 2304 + 8 * g;
                float cs[8], sn[8]; const f32x4 c0 = *(const f32x4*)(ROPEI + m * 16), c1 = *(const f32x4*)(ROPEI + m * 16 + 4), s0 = *(const f32x4*)(ROPEI + m * 16 + 8), s1 = *(const f32x4*)(ROPEI + m * 16 + 12);
                cs[0] = c0.x; cs[1] = c0.y; cs[2] = c0.z; cs[3] = c0.w; cs[4] = c1.x; cs[5] = c1.y; cs[6] = c1.z; cs[7] = c1.w; sn[0] = s0.x; sn[1] = s0.y; sn[2] = s0.z; sn[3] = s0.w; sn[4] = s1.x; sn[5] = s1.y; sn[6] = s1.z; sn[7] = s1.w;
#pragma unroll 4
                for (int h = 0; h < 16; ++h) { bf16x8 f0 = *(const bf16x8*)(qp + h * 64); const bf16x8 f1 = *(const bf16x8*)(qp + h * 64 + 32);
                    const bf16x8 pf = xchg_frag(f0, 16); const bf16x8 rf = rope_frag(f0, pf, cs, sn, g == 0); if (g < 2) f0 = rf;
                    qscr[(w8 * 64 + l) * 32 + h * 2] = __builtin_bit_cast(u32x4, f0); qscr[(w8 * 64 + l) * 32 + h * 2 + 1] = __builtin_bit_cast(u32x4, f1); }
            }
            asm volatile("s_waitcnt vmcnt(0)" ::: "memory");
            __syncthreads();
            __builtin_amdgcn_fence(__ATOMIC_ACQUIRE, "agent"); asm volatile("s_waitcnt vmcnt(0)" ::: "memory");
            const bf16* kp = KIDX + ((size_t)b * SEQ + n16) * 64 + 8 * g;
            const int ntile = L >> 4;
#pragma unroll 1
            for (int qsub = 0; qsub < 8; ++qsub) {
                asm volatile("" ::: "memory");
                bf16x8 Qi[16][2];
                { const int srcl = g * 16 + (qsub & 1) * 8 + (n16 & 7); const u32x4* fp = qscr + (size_t)((qsub >> 1) * 64 + srcl) * 32;
#pragma unroll
                  for (int h = 0; h < 16; ++h) { Qi[h][0] = __builtin_bit_cast(bf16x8, fp[h * 2]); Qi[h][1] = __builtin_bit_cast(bf16x8, fp[h * 2 + 1]); }
                  if (w8 == 0 && l < 32) WL[l] = *(const f32x4*)(WIDX + ((size_t)b * SEQ + t0 + 8 * qsub + (l >> 2)) * 16 + 4 * (l & 3)); }
                __syncthreads();
                const f32x4* wq = WL + (n16 & 7) * 4;
                float* srow = SCL + (n16 & 7) * 4096 + 4 * g;
                int j = w8;
                bf16x8 Ka = *(const bf16x8*)(kp + (size_t)j * 1024), Kb = *(const bf16x8*)(kp + (size_t)j * 1024 + 32);
#pragma unroll 1
                for (; j < ntile; j += 8) {
                    const int jn = (j + 8 < ntile) ? j + 8 : j;
                    const bf16x8 Na = *(const bf16x8*)(kp + (size_t)jn * 1024), Nb = *(const bf16x8*)(kp + (size_t)jn * 1024 + 32);
                    f32x2 s01 = (f32x2){0.f, 0.f}, s23 = (f32x2){0.f, 0.f};
                    f32x4 a = __builtin_amdgcn_mfma_f32_16x16x32_bf16(Ka, Qi[0][0], (f32x4){0.f, 0.f, 0.f, 0.f}, 0, 0, 0); a = __builtin_amdgcn_mfma_f32_16x16x32_bf16(Kb, Qi[0][1], a, 0, 0, 0);
#pragma unroll
                    for (int h4 = 0; h4 < 4; ++h4) { const f32x4 w4 = wq[h4];
#pragma unroll
                        for (int hh = 0; hh < 4; ++hh) { const int h = 4 * h4 + hh; f32x4 an = a;
                            if (h < 15) { an = __builtin_amdgcn_mfma_f32_16x16x32_bf16(Ka, Qi[h + 1][0], (f32x4){0.f, 0.f, 0.f, 0.f}, 0, 0, 0); an = __builtin_amdgcn_mfma_f32_16x16x32_bf16(Kb, Qi[h + 1][1], an, 0, 0, 0); }
                            const f32x2 wv = (f32x2){w4[hh], w4[hh]};
                            s01 = (f32x2){relu1(a[0]), relu1(a[1])} * wv + s01; s23 = (f32x2){relu1(a[2]), relu1(a[3])} * wv + s23; a = an; } }
                    if (n16 < 8) *(f32x4*)(srow + 16 * j) = (f32x4){s01.x, s01.y, s23.x, s23.y};
                    Ka = Na; Kb = Nb;
                }
                __syncthreads();
                select_row(SCL + w8 * 4096, L, (unsigned short*)SEL + ((size_t)b * SEQ + t0 + 8 * qsub + w8) * 256, l);
                __syncthreads();
            }
        }
    }
}
#if DIAG == 7
__device__ __forceinline__ void select_row_v1(const float* row, int limit, unsigned short* sel, int l_in) {
    int l = l_in; asm volatile("" : "+v"(l));
    const int ng = limit >> 9;
    unsigned key[64];
#pragma unroll
    for (int j = 0; j < 64; ++j) { const int s = j * 64 + l; unsigned u = 0u; if (s < limit) { u = __float_as_uint(row[s]); u = (u & 0x80000000u) ? ~u : (u | 0x80000000u); } key[j] = u; }
    unsigned mx = 0u;
#pragma unroll
    for (int j = 0; j < 64; ++j) mx = key[j] > mx ? key[j] : mx;
#pragma unroll
    for (int o = 1; o < 64; o <<= 1) { const unsigned t = (unsigned)__shfl_xor((int)mx, o); mx = t > mx ? t : mx; }
    mx = (unsigned)__builtin_amdgcn_readfirstlane((int)mx);
    unsigned T = 0u;
#pragma unroll 1
    for (int bit = 31 - __builtin_clz(mx | 1u); bit >= 0; --bit) {
        const unsigned Tn = T | (1u << bit); int cnt = 0;
#pragma unroll
        for (int jg = 0; jg < 8; ++jg) if (jg <= ng) {
#pragma unroll
            for (int j = 8 * jg; j < 8 * jg + 8; ++j) cnt += __popcll(__ballot(key[j] >= Tn)); }
        if (cnt >= 256) T = Tn;
        if (cnt == 256) break;
    }
    int cgt = 0;
#pragma unroll
    for (int j = 0; j < 64; ++j) cgt += __popcll(__ballot(key[j] > T));
    const int need_eq = 256 - cgt;
    int base = 0, beq = 0;
    const unsigned long long lt = (1ull << l) - 1ull;
#pragma unroll
    for (int jg = 0; jg < 8; ++jg) if (jg <= ng) {
#pragma unroll
        for (int j = 8 * jg; j < 8 * jg + 8; ++j) {
            const unsigned long long mg = __ballot(key[j] > T), me = __ballot(key[j] == T);
            if (key[j] > T) sel[base + __popcll(mg & lt)] = (unsigned short)(j * 64 + l);
            base += __popcll(mg);
            const int pe = beq + __popcll(me & lt);
            if (key[j] == T && pe < need_eq) sel[cgt + pe] = (unsigned short)(j * 64 + l);
            beq += __popcll(me);
        }
    }
}
__device__ __forceinline__ void idx_topk_v1(const Ctx& c, const bf16* __restrict__ QALL, const bf16* __restrict__ KIDX, const float* __restrict__ WIDX, float* scr, bf16* SEL, int nitems) {
    const int l = c.lane, n16 = l & 15, g = l >> 4, qg = c.wave & 3, kh = c.wave >> 2;
#pragma unroll 1
    for (int item = c.bid; item < nitems; item += c.nb) {
        const int b = item >> 5, pr = item & 31;
#pragma unroll 1
        for (int which = 0; which < 2; ++which) {
            const int ch = which ? 63 - pr : pr, L = 64 * (ch + 1), t0 = 64 * ch;
            if (L > 256) {
            const size_t m = (size_t)b * SEQ + t0 + 16 * qg + n16;
            float* srow = scr + (size_t)(16 * qg + n16) * L + 4 * g;
            const int nt = L >> 5, j0 = kh * nt, j1 = j0 + nt;
            const bf16* kp = KIDX + ((size_t)b * SEQ + n16) * 64 + 8 * g;
#pragma unroll 1
            for (int hp = 0; hp < 2; ++hp) {
                bf16x8 Qi[8][2]; float w[8];
                { const bf16* qp = QALL + m * QC + 2304 + hp * 512 + 8 * g;
#pragma unroll
                  for (int h = 0; h < 8; ++h) { Qi[h][0] = *(const bf16x8*)(qp + h * 64); Qi[h][1] = *(const bf16x8*)(qp + h * 64 + 32); }
                  const f32x4* wp = (const f32x4*)(WIDX + m * 16 + hp * 8);
#pragma unroll
                  for (int q = 0; q < 2; ++q) { const f32x4 v = wp[q]; w[4 * q] = v.x; w[4 * q + 1] = v.y; w[4 * q + 2] = v.z; w[4 * q + 3] = v.w; } }
                if (hp) { asm volatile("s_waitcnt vmcnt(0)" ::: "memory"); __builtin_amdgcn_fence(__ATOMIC_ACQUIRE, "agent"); asm volatile("s_waitcnt vmcnt(0)" ::: "memory"); }
                bf16x8 Ka = *(const bf16x8*)(kp + (size_t)j0 * 1024), Kb = *(const bf16x8*)(kp + (size_t)j0 * 1024 + 32);
                f32x4 pv = (f32x4){0.f, 0.f, 0.f, 0.f}; if (hp) pv = *(const f32x4*)(srow + 16 * j0);
#pragma unroll 1
                for (int j = j0; j < j1; ++j) {
                    const int jn = (j + 1 < j1) ? j + 1 : j;
                    const bf16x8 Na = *(const bf16x8*)(kp + (size_t)jn * 1024), Nb = *(const bf16x8*)(kp + (size_t)jn * 1024 + 32);
                    f32x4 pn = (f32x4){0.f, 0.f, 0.f, 0.f}; if (hp) pn = *(const f32x4*)(srow + 16 * jn);
                    f32x4 sc = pv;
#pragma unroll
                    for (int h = 0; h < 8; ++h) { f32x4 a = __builtin_amdgcn_mfma_f32_16x16x32_bf16(Ka, Qi[h][0], (f32x4){0.f, 0.f, 0.f, 0.f}, 0, 0, 0); a = __builtin_amdgcn_mfma_f32_16x16x32_bf16(Kb, Qi[h][1], a, 0, 0, 0);
                        sc[0] += w[h] * fmaxf(a[0], 0.f); sc[1] += w[h] * fmaxf(a[1], 0.f); sc[2] += w[h] * fmaxf(a[2], 0.f); sc[3] += w[h] * fmaxf(a[3], 0.f); }
                    *(f32x4*)(srow + 16 * j) = sc;
                    Ka = Na; Kb = Nb; pv = pn;
                }
            }
            }
            asm volatile("s_waitcnt vmcnt(0)" ::: "memory");
            __syncthreads();
            __builtin_amdgcn_fence(__ATOMIC_ACQUIRE, "agent");
            asm volatile("s_waitcnt vmcnt(0)" ::: "memory");
#pragma unroll 1
            for (int i = 0; i < 8; ++i) {
                const int ql = c.wave * 8 + i;
                unsigned short* sel = (unsigned short*)SEL + ((size_t)b * SEQ + t0 + ql) * 256;
                if (L <= 256) { for (int k = l; k < 256; k += 64) sel[k] = (unsigned short)(k < L ? k : 0); }
                else select_row_v1(scr + (size_t)ql * L, L, sel, l);
            }
            __syncthreads();
        }
    }
}
#endif
constexpr int RW_TB = 32;
struct RwkvP { const float *mu, *w0, *w2, *a0, *a2, *g2, *k_k, *k_a, *r_k, *ln_w, *ln_b; };
__device__ __forceinline__ void rwkv_phase(const Ctx& c, const bf16* __restrict__ H, const RwkvP P, bf16* OLY) {
    float* A_WR = (float*)c.lds;
    float* A_K2 = A_WR + RW_TB * 64;
    float* A_V = A_K2 + RW_TB * 64;
    float* A_W = A_V + RW_TB * 64;
    float* A_NKK = A_W + RW_TB * 64;
    float* A_B = A_NKK + RW_TB * 64;
    float* A_G = A_B + RW_TB * 64;
    float* A_OUT = A_G + RW_TB * 64;
    float* L_TW = A_OUT + RW_TB * 64;
    float* L_AL = L_TW + RW_TB * 64;
    float* L_SG = L_AL + RW_TB * 64;
    float* SC1 = L_SG + RW_TB * 160; float* SC2 = SC1 + RW_TB; float* SC3 = SC2 + RW_TB;
    const int l = c.lane, w = c.wave;
    for (int item = c.bid; item < NB * 16; item += c.nb) {
        const int b = item >> 4, h = item & 15, hk = h * 64 + l;
        const float w0v = P.w0[hk], a0v = P.a0[hk], kkv = P.k_k[hk], kav = P.k_a[hk], rkv = P.r_k[hk], lnw = P.ln_w[hk], lnb = P.ln_b[hk];
        float S[8];
#pragma unroll
        for (int i = 0; i < 8; ++i) S[i] = 0.f;
        const int srow = w * 8 + (l >> 3), sj = l & 7;
        for (int t0 = 0; t0 < SEQ; t0 += RW_TB) {
            __syncthreads();
            for (int idx = c.tid; idx < RW_TB * 480; idx += NTHR) {
                const int t = idx / 480, cc = idx % 480; int col; float* dst;
                if (cc < 64) { col = 880 + h * 64 + cc; dst = A_WR + t * 64 + cc; }
                else if (cc < 128) { col = 1904 + h * 64 + (cc - 64); dst = A_K2 + t * 64 + (cc - 64); }
                else if (cc < 192) { col = 2928 + h * 64 + (cc - 128); dst = A_V + t * 64 + (cc - 128); }
                else if (cc < 256) { col = 3952 + (cc - 192); dst = L_TW + t * 64 + (cc - 192); }
                else if (cc < 320) { col = 4016 + (cc - 256); dst = L_AL + t * 64 + (cc - 256); }
                else { col = 4080 + (cc - 320); dst = L_SG + t * 160 + (cc - 320); }
                const size_t m = (size_t)b * SEQ + t0 + t;
                const float x = bf2f(H[m * HC + col]); const float xp = (t0 + t > 0) ? bf2f(H[(m - 1) * HC + col]) : 0.f;
                float hm = x + (xp - x) * P.mu[col - 880];
                if (cc >= 192 && cc < 256) hm = tanhf(hm); else if (cc >= 320) hm = sigmoidf_(hm);
                *dst = hm;
            }
            __syncthreads();
            {
                float wl[RW_TB / 8], al[RW_TB / 8], gg[RW_TB / 8];
#pragma unroll
                for (int i = 0; i < RW_TB / 8; ++i) { wl[i] = 0.f; al[i] = 0.f; gg[i] = 0.f; }
                for (int j = 0; j < 64; ++j) { const float w2v = P.w2[(size_t)j * 1024 + hk], a2v = P.a2[(size_t)j * 1024 + hk];
#pragma unroll
                    for (int i = 0; i < RW_TB / 8; ++i) { wl[i] += L_TW[(w + 8 * i) * 64 + j] * w2v; al[i] += L_AL[(w + 8 * i) * 64 + j] * a2v; } }
                for (int j = 0; j < 160; ++j) { const float g2v = P.g2[(size_t)j * 1024 + hk];
#pragma unroll
                    for (int i = 0; i < RW_TB / 8; ++i) gg[i] += L_SG[(w + 8 * i) * 160 + j] * g2v; }
#pragma unroll
                for (int i = 0; i < RW_TB / 8; ++i) {
                    const int t = w + 8 * i, o = t * 64 + l;
                    const float dec = __expf(-0.6065306597126334f * sigmoidf_(w0v + wl[i]));
                    const float a = sigmoidf_(a0v + al[i]);
                    const float kr = A_K2[o], r = A_WR[o];
                    float kk = kr * kkv; const float nrm = wave_sum(kk * kk); kk = kk * (1.0f / sqrtf(fmaxf(nrm, 1e-24f)));
                    const float k2 = kr * (1.f + (a - 1.f) * kav), bb = kk * a;
                    const float s1 = wave_sum(bb * r), s2 = wave_sum(k2 * r), s3 = wave_sum(r * k2 * rkv);
                    A_W[o] = dec; A_NKK[o] = -kk; A_B[o] = bb; A_K2[o] = k2; A_WR[o] = dec * r; A_G[o] = gg[i];
                    if (l == 0) { SC1[t] = s1; SC2[t] = s2; SC3[t] = s3; }
                }
            }
            __syncthreads();
            for (int t = 0; t < RW_TB; ++t) {
                const f32x4* pw = (const f32x4*)(A_W + t * 64 + 8 * sj); const f32x4* pn = (const f32x4*)(A_NKK + t * 64 + 8 * sj); const f32x4* pb = (const f32x4*)(A_B + t * 64 + 8 * sj);
                const f32x4* pk = (const f32x4*)(A_K2 + t * 64 + 8 * sj); const f32x4* pr = (const f32x4*)(A_WR + t * 64 + 8 * sj);
                const f32x4 w0_ = pw[0], w1_ = pw[1], n0 = pn[0], n1 = pn[1], b0 = pb[0], b1 = pb[1], k0 = pk[0], k1 = pk[1], r0 = pr[0], r1 = pr[1];
                const float vv = A_V[t * 64 + srow], s1 = SC1[t], s2 = SC2[t];
                float sa = (S[0] * n0.x + S[1] * n0.y) + (S[2] * n0.z + S[3] * n0.w) + (S[4] * n1.x + S[5] * n1.y) + (S[6] * n1.z + S[7] * n1.w);
                float p = (S[0] * r0.x + S[1] * r0.y) + (S[2] * r0.z + S[3] * r0.w) + (S[4] * r1.x + S[5] * r1.y) + (S[6] * r1.z + S[7] * r1.w);
                sa += __shfl_xor(sa, 1); p += __shfl_xor(p, 1); sa += __shfl_xor(sa, 2); p += __shfl_xor(p, 2); sa += __shfl_xor(sa, 4); p += __shfl_xor(p, 4);
                S[0] = S[0] * w0_.x + (sa * b0.x + vv * k0.x); S[1] = S[1] * w0_.y + (sa * b0.y + vv * k0.y); S[2] = S[2] * w0_.z + (sa * b0.z + vv * k0.z); S[3] = S[3] * w0_.w + (sa * b0.w + vv * k0.w);
                S[4] = S[4] * w1_.x + (sa * b1.x + vv * k1.x); S[5] = S[5] * w1_.y + (sa * b1.y + vv * k1.y); S[6] = S[6] * w1_.z + (sa * b1.z + vv * k1.z); S[7] = S[7] * w1_.w + (sa * b1.w + vv * k1.w);
                if (sj == 0) A_OUT[t * 64 + srow] = p + sa * s1 + vv * s2;
            }
            __syncthreads();
#pragma unroll
            for (int i = 0; i < RW_TB / 8; ++i) {
                const int t = w + 8 * i, o = t * 64 + l;
                const float x = A_OUT[o]; const float mean = wave_sum(x) * (1.f / 64.f); const float dx = x - mean; const float var = wave_sum(dx * dx) * (1.f / 64.f);
                float y = dx * (1.0f / sqrtf(var + 64e-5f)) * lnw + lnb;
                y = (y + SC3[t] * A_V[o]) * A_G[o];
                OLY[((size_t)b * SEQ + t0 + t) * OC + 2048 + hk] = (bf16)f2bf(y);
            }
        }
    }
}

constexpr int S5_TB = 16;
struct S5P { const float *lam_re, *lam_im, *log_dt, *b_re, *b_im, *c_re, *c_im, *d; };
__device__ __forceinline__ float gelu_tanh(float y) { return 0.5f * y * (1.f + tanhf(0.7978845608028654f * (y + 0.044715f * y * y * y))); }
__device__ __forceinline__ void s5_phase(const Ctx& c, const bf16* __restrict__ U, const S5P P, bf16* Z) {
    constexpr int PERW = 256 + 2 * S5_TB * 65 + 2 * 64 * 16;
    float* UU = (float*)c.lds + c.wave * PERW;
    float* XSr = UU + 256; float* XSi = XSr + S5_TB * 65;
    float* CTr = XSi + S5_TB * 65; float* CTi = CTr + 64 * 16;
    const int l = c.lane;
    for (int item = c.bid; item < NB * 16; item += c.nb) {
        const int b = item >> 4, g = (item & 15) * 8 + c.wave;
        __syncthreads();
        float lbr, lbi, Br[16], Bi[16];
        {
            const float lr = fminf(P.lam_re[g * 64 + l], -1e-4f), li = P.lam_im[g * 64 + l], dt = expf(P.log_dt[g]);
            const float e = expf(lr * dt); lbr = e * cosf(li * dt); lbi = e * sinf(li * dt);
            const float nr = lbr - 1.f, ni = lbi, den = 1.f / (lr * lr + li * li);
            const float cr = (nr * lr + ni * li) * den, ci = (ni * lr - nr * li) * den;
#pragma unroll
            for (int i = 0; i < 16; ++i) { const float br = P.b_re[(size_t)(g * 64 + l) * 16 + i], bi = P.b_im[(size_t)(g * 64 + l) * 16 + i]; Br[i] = cr * br - ci * bi; Bi[i] = cr * bi + ci * br; }
#pragma unroll
            for (int o = 0; o < 16; ++o) { CTr[l * 16 + o] = P.c_re[(size_t)(g * 16 + o) * 64 + l]; CTi[l * 16 + o] = P.c_im[(size_t)(g * 16 + o) * 64 + l]; }
        }
        float dsk[4];
#pragma unroll
        for (int e = 0; e < 4; ++e) dsk[e] = P.d[g * 16 + (l >> 4) * 4 + e];
        float xr = 0.f, xi = 0.f;
        for (int t0 = 0; t0 < SEQ; t0 += S5_TB) {
            __syncthreads();
            { const int row = l >> 2, q = l & 3; const u32x2 w2 = *(const u32x2*)(U + ((size_t)b * SEQ + t0 + row) * D + g * 16 + 4 * q);
              float* d = UU + row * 16 + 4 * q; d[0] = bf2f(w2.x & 0xffffu); d[1] = bf2f(w2.x >> 16); d[2] = bf2f(w2.y & 0xffffu); d[3] = bf2f(w2.y >> 16); }
            __syncthreads();
            for (int t = 0; t < S5_TB; ++t) {
                const f32x4* up = (const f32x4*)(UU + t * 16); const f32x4 u0 = up[0], u1 = up[1], u2 = up[2], u3 = up[3];
                const float u[16] = {u0.x, u0.y, u0.z, u0.w, u1.x, u1.y, u1.z, u1.w, u2.x, u2.y, u2.z, u2.w, u3.x, u3.y, u3.z, u3.w};
                float bur = 0.f, bui = 0.f;
#pragma unroll
                for (int i = 0; i < 16; ++i) { bur += Br[i] * u[i]; bui += Bi[i] * u[i]; }
                const float nxr = lbr * xr - lbi * xi + bur, nxi = lbr * xi + lbi * xr + bui; xr = nxr; xi = nxi;
                XSr[t * 65 + l] = xr; XSi[t * 65 + l] = xi;
            }
            __syncthreads();
            {   const int t = l & 15, oq = l >> 4; float y[4] = {0.f, 0.f, 0.f, 0.f};
                for (int p = 0; p < 64; ++p) { const float a = XSr[t * 65 + p], bb = XSi[t * 65 + p]; const f32x4 cr = *(const f32x4*)(CTr + p * 16 + oq * 4), ci = *(const f32x4*)(CTi + p * 16 + oq * 4);
                    y[0] += a * cr.x - bb * ci.x; y[1] += a * cr.y - bb * ci.y; y[2] += a * cr.z - bb * ci.z; y[3] += a * cr.w - bb * ci.w; }
                float z[4];
#pragma unroll
                for (int e = 0; e < 4; ++e) z[e] = gelu_tanh(y[e] + dsk[e] * UU[t * 16 + oq * 4 + e]);
                u32x2 o; o.x = pk2(z[0], z[1]); o.y = pk2(z[2], z[3]);
                *(u32x2*)(Z + ((size_t)b * SEQ + t0 + t) * D + g * 16 + oq * 4) = o; }
        }
    }
}
template <int CTRL> __device__ __forceinline__ float dpp_mov(float v) { return __builtin_bit_cast(float, __builtin_amdgcn_update_dpp(0, __builtin_bit_cast(int, v), CTRL, 0xf, 0xf, true)); }
__device__ __forceinline__ float sum8(float v) { v += dpp_mov<0xB1>(v); v += dpp_mov<0x4E>(v); v += dpp_mov<0x141>(v); return v; }
__device__ __forceinline__ float wave_sum_fast(float v) { v += dpp_mov<0xB1>(v); v += dpp_mov<0x4E>(v); v += dpp_mov<0x141>(v); v += dpp_mov<0x140>(v); v += __shfl_xor(v, 16); v += __shfl_xor(v, 32); return v; }
__device__ __forceinline__ float fast_tanh(float x) { const float e = __expf(2.f * x); return 1.f - 2.f * __builtin_amdgcn_rcpf(e + 1.f); }
__device__ __forceinline__ void rwkv_lora_prep(const Ctx& c, const bf16* __restrict__ H, const float* __restrict__ mu, bf16* LX) {
    const int l = c.lane;
    const int per = (M + c.ngw - 1) / c.ngw;
    const int mA = c.gw * per, mE = (mA + per < M) ? mA + per : M;
    if (l < 36 && mA < M) {
        const int col = 3952 + 8 * l;
        const f32x4 m0 = *(const f32x4*)(mu + 3072 + 8 * l), m1 = *(const f32x4*)(mu + 3072 + 8 * l + 4);
        const float mv[8] = {m0.x, m0.y, m0.z, m0.w, m1.x, m1.y, m1.z, m1.w};
        float p[8];
        if ((mA % SEQ) > 0) unpack8(*(const u32x4*)(H + (size_t)(mA - 1) * HC + col), p); else {
#pragma unroll
            for (int j = 0; j < 8; ++j) p[j] = 0.f; }
#pragma unroll 1
        for (int mb = mA; mb < mE; mb += 8) {
            u32x4 rq[8];
#pragma unroll
            for (int i = 0; i < 8; ++i) { const int mm = (mb + i < mE) ? mb + i : mE - 1; rq[i] = *(const u32x4*)(H + (size_t)mm * HC + col); }
#pragma unroll
            for (int i = 0; i < 8; ++i) { const int m = mb + i;
                if (m < mE) {
                    float x[8]; unpack8(rq[i], x);
                    if ((m % SEQ) == 0) {
#pragma unroll
                        for (int j = 0; j < 8; ++j) p[j] = 0.f; }
                    float hm[8];
#pragma unroll
                    for (int j = 0; j < 8; ++j) { float v = x[j] + (p[j] - x[j]) * mv[j]; if (l < 8) v = fast_tanh(v); else if (l >= 16) v = sigmoidf_(v); hm[j] = v; p[j] = x[j]; }
                    u32x4 o; o.x = pg8::cvt_pk_bf16(hm[0], hm[1]); o.y = pg8::cvt_pk_bf16(hm[2], hm[3]); o.z = pg8::cvt_pk_bf16(hm[4], hm[5]); o.w = pg8::cvt_pk_bf16(hm[6], hm[7]);
                    *(u32x4*)(LX + (size_t)m * 288 + 8 * l) = o;
                }
            }
        }
    }
}
constexpr int RW2_RAWP = 384;
constexpr int RW2_TWP = 144, RW2_SGP = 336;
__device__ __forceinline__ void rwkv_phase2(const Ctx& c, const bf16* __restrict__ H, const bf16* __restrict__ LX, const RwkvP P, bf16* OUT, int ldo, int coloff, int wb = NB) {
    unsigned char* RAW = c.lds;
    float* A_WR = (float*)(c.lds + 12800);
    float* A_K2 = A_WR + 2048; float* A_V = A_K2 + 2048; float* A_W = A_V + 2048; float* A_NKK = A_W + 2048; float* A_B = A_NKK + 2048; float* A_G = A_B + 2048; float* A_OUT = A_G + 2048;
    float* LO_W = A_OUT + 2048; float* LO_A = LO_W + 2048; float* PR3 = LO_A + 2048;
    unsigned char* L_TW = (unsigned char*)(PR3 + 2048); unsigned char* L_AL = L_TW + 32 * RW2_TWP; unsigned char* L_SG = L_AL + 32 * RW2_TWP;
    float* MU = (float*)(L_SG + 32 * RW2_SGP); float* SC3 = MU + 480 + 64;
    unsigned char* G2T = (unsigned char*)(SC3 + 32);
    float* SCP = (float*)(G2T + 64 * RW2_SGP);
    float* GN = SCP + 128; float* CST = GN + 64;
    float* PR0 = (float*)L_TW; float* PR1 = PR0 + 2048; float* PR2 = A_OUT;
    const int l = c.lane, w = c.wave, n16 = l & 15, g = l >> 4;
#pragma unroll 1
    for (int item = c.bid; item < NB * 16; item += c.nb) {
        const int b = item >> 4, h = item & 15, hk = h * 64 + l;
        __syncthreads();
        if (w < 7) { const float* src = w == 0 ? P.w0 : w == 1 ? P.a0 : w == 2 ? P.k_k : w == 3 ? P.k_a : w == 4 ? P.r_k : w == 5 ? P.ln_w : P.ln_b; CST[w * 64 + l] = src[hk]; }
#pragma unroll 1
        for (int qb = 0; qb < 20; qb += 5) {
            float gq[5];
#pragma unroll
            for (int q = 0; q < 5; ++q) { const int i = c.tid + NTHR * (qb + q); gq[q] = P.g2[(size_t)(i >> 6) * 1024 + h * 64 + (i & 63)]; }
#pragma unroll
            for (int q = 0; q < 5; ++q) { const int i = c.tid + NTHR * (qb + q); *(unsigned short*)(G2T + (i & 63) * RW2_SGP + (i >> 6) * 2) = (unsigned short)f2bf(gq[q]); }
        }
        for (int i = c.tid; i < 192; i += NTHR) { const int mi = i < 64 ? h * 64 + i : i < 128 ? 1024 + h * 64 + (i - 64) : 2048 + h * 64 + (i - 128); MU[i] = P.mu[mi]; }
        const int tt = w >> 2, nt = w & 3;
        bf16x8 W2B[2], A2B[2];
        { const int kc = h * 64 + 16 * nt + n16;
          auto ldfrag = [&](const float* Wp, int kk) -> bf16x8 { float f[8]; int gq = g, kq = kc; asm volatile("" : "+v"(gq), "+v"(kq));
              const float* wp = Wp + (size_t)(32 * kk + 8 * gq) * 1024 + kq;
#pragma unroll
              for (int q = 0; q < 8; ++q) f[q] = wp[q * 1024];
              u32x4 u; u.x = pk2(f[0], f[1]); u.y = pk2(f[2], f[3]); u.z = pk2(f[4], f[5]); u.w = pk2(f[6], f[7]);
              asm volatile("" : "+v"(u));
              return __builtin_bit_cast(bf16x8, u); };
          W2B[0] = ldfrag(P.w2, 0); W2B[1] = ldfrag(P.w2, 1); A2B[0] = ldfrag(P.a2, 0); A2B[1] = ldfrag(P.a2, 1);
        }
        f32x2 S[4];
#pragma unroll
        for (int i = 0; i < 4; ++i) S[i] = (f32x2){0.f, 0.f};
        const int srow = w * 8 + 2 * (l >> 4), sj = l & 15;
        u32x4 raw[4];
        int goff[4]; unsigned ldst[4];
        { const long offL = (const char*)LX - (const char*)H;
#pragma unroll
          for (int k = 0; k < 4; ++k) { const int q_ = c.tid + 512 * k;
              if (q_ < 792) { const int cq_ = q_ % 24, row_ = q_ / 24; const int rc_ = (cq_ < 8 ? 880 : cq_ < 16 ? 1904 - 64 : 2928 - 128) + h * 64 + cq_ * 8;
                  goff[k] = (int)((((long)b * SEQ + row_ - 1) * HC + rc_) * 2); ldst[k] = (unsigned)((RAW - c.lds) + row_ * RW2_RAWP + cq_ * 16); }
              else { int e_ = q_ - 792; const bool ok_ = e_ < 1152; e_ = ok_ ? e_ : 0; const int t_ = e_ / 36, p_ = e_ % 36;
                  goff[k] = (int)(offL + (((long)b * SEQ + t_) * 288 + p_ * 8) * 2);
                  const unsigned char* d_ = p_ < 8 ? L_TW + t_ * RW2_TWP + p_ * 16 : p_ < 16 ? L_AL + t_ * RW2_TWP + (p_ - 8) * 16 : L_SG + t_ * RW2_SGP + (p_ - 16) * 16;
                  ldst[k] = ok_ ? (unsigned)(d_ - c.lds) : 0xffffffffu; } } }
#define RW2_LOAD(T0) do { _Pragma("unroll") for (int k = 0; k < 4; ++k) { \
            const int sb_ = (k == 0) ? HC * 2 : (k >= 2) ? 576 : ((c.tid + 512 < 792) ? HC * 2 : 576); \
            raw[k] = *(const u32x4*)((const char*)H + (long)(goff[k] + (T0) * sb_)); } } while (0)
        RW2_LOAD(0);
#pragma unroll 1
        for (int t0 = 0; t0 < SEQ; t0 += 32) {
            __syncthreads();
#pragma unroll
            for (int k = 0; k < 4; ++k) {
                u32x4 v_ = raw[k]; if (k == 0 && t0 == 0 && c.tid < 24) v_ = (u32x4){0u, 0u, 0u, 0u};
                if (k < 3 || ldst[k] != 0xffffffffu) *(u32x4*)(c.lds + ldst[k]) = v_; }
            { const int tn_ = (t0 + 32 < SEQ) ? t0 + 32 : t0; RW2_LOAD(tn_); }
            __syncthreads();
            if (c.tid < 384) {
                const int cpi = c.tid % 96, qb = c.tid / 96, cp = cpi * 2, tb = qb * 8;
                const float mu0 = MU[cp], mu1 = MU[cp + 1];
                unsigned xq[9];
#pragma unroll
                for (int t = 0; t < 9; ++t) xq[t] = *(const unsigned*)(RAW + (tb + t) * RW2_RAWP + cp * 2);
                const unsigned xb = xq[0];
                float p0 = bf2f(xb & 0xffffu), p1 = bf2f(xb >> 16);
                float* dst = (cp < 64 ? A_WR + cp : cp < 128 ? A_K2 + (cp - 64) : A_V + (cp - 128)) + tb * 64;
#pragma unroll
                for (int t = 0; t < 8; ++t) { const unsigned xa = xq[t + 1]; const float x0 = bf2f(xa & 0xffffu), x1 = bf2f(xa >> 16);
                    *(f32x2*)(dst + t * 64) = (f32x2){x0 + (p0 - x0) * mu0, x1 + (p1 - x1) * mu1}; p0 = x0; p1 = x1; }
            }
            {
                f32x4 aw = (f32x4){0.f, 0.f, 0.f, 0.f}, aa = aw, ag = aw;
#pragma unroll
                for (int kk = 0; kk < 2; ++kk) { const bf16x8 At = *(const bf16x8*)(L_TW + (16 * tt + n16) * RW2_TWP + (32 * kk + 8 * g) * 2), Aa = *(const bf16x8*)(L_AL + (16 * tt + n16) * RW2_TWP + (32 * kk + 8 * g) * 2);
                    aw = __builtin_amdgcn_mfma_f32_16x16x32_bf16(At, W2B[kk], aw, 0, 0, 0); aa = __builtin_amdgcn_mfma_f32_16x16x32_bf16(Aa, A2B[kk], aa, 0, 0, 0); }
#pragma unroll
                for (int kk = 0; kk < 5; ++kk) { const bf16x8 Ag = *(const bf16x8*)(L_SG + (16 * tt + n16) * RW2_SGP + (32 * kk + 8 * g) * 2); const bf16x8 Gb = *(const bf16x8*)(G2T + (16 * nt + n16) * RW2_SGP + (32 * kk + 8 * g) * 2); ag = __builtin_amdgcn_mfma_f32_16x16x32_bf16(Ag, Gb, ag, 0, 0, 0); }
#pragma unroll
                for (int r = 0; r < 4; ++r) { const int o = (16 * tt + 4 * g + r) * 64 + 16 * nt + n16; LO_W[o] = aw[r]; LO_A[o] = aa[r]; A_G[o] = ag[r]; }
            }
            __syncthreads();
            {
                const float w0v = CST[l], a0v = CST[64 + l], kkv = CST[128 + l], kav = CST[192 + l], rkv = CST[256 + l];
                float lw_[4], la_[4], kr_[4], r_[4];
#pragma unroll
                for (int i = 0; i < 4; ++i) { const int o = (w + 8 * i) * 64 + l; lw_[i] = LO_W[o]; la_[i] = LO_A[o]; kr_[i] = A_K2[o]; r_[i] = A_WR[o]; }
#pragma unroll
                for (int i = 0; i < 4; ++i) { const int o = (w + 8 * i) * 64 + l;
                    const float dec = __expf(-0.6065306597126334f * sigmoidf_(w0v + lw_[i]));
                    const float a = sigmoidf_(a0v + la_[i]);
                    const float kr = kr_[i], r = r_[i];
                    const float kk0 = kr * kkv, k2 = kr * (1.f + (a - 1.f) * kav), bb0 = kk0 * a, k2r = k2 * r;
                    A_W[o] = dec; A_NKK[o] = -kk0; A_B[o] = bb0; A_K2[o] = k2; A_WR[o] = dec * r;
                    PR0[o] = kk0 * kk0; PR1[o] = bb0 * r; PR2[o] = k2r; PR3[o] = k2r * rkv; }
            }
            __syncthreads();
            {
                const int t = c.tid >> 4, q = (c.tid >> 2) & 3, qu = c.tid & 3;
                const float* src = (q == 0 ? PR0 : q == 1 ? PR1 : q == 2 ? PR2 : PR3) + t * 64 + 16 * qu;
                const f32x4 v0 = *(const f32x4*)src, v1 = *(const f32x4*)(src + 4), v2 = *(const f32x4*)(src + 8), v3 = *(const f32x4*)(src + 12);
                float sm = ((v0.x + v0.y) + (v0.z + v0.w)) + ((v1.x + v1.y) + (v1.z + v1.w)) + ((v2.x + v2.y) + (v2.z + v2.w)) + ((v3.x + v3.y) + (v3.z + v3.w));
                sm += dpp_mov<0xB1>(sm); sm += dpp_mov<0x4E>(sm);
                if (qu == 0) SCP[t * 4 + q] = (q == 0) ? __builtin_amdgcn_rcpf(fmaxf(sm, 1e-24f)) : sm;
            }
            __syncthreads();
#if DBL & 0x4000
            { f32x2 Ssv[4]; Ssv[0] = S[0]; Ssv[1] = S[1]; Ssv[2] = S[2]; Ssv[3] = S[3];
            {
                f32x4 n0, n1, r0, r1, w0_, w1_, b0, b1, k0, k1; f32x3 sp; float vv;
                const unsigned char* pk_ = (const unsigned char*)A_WR + 32 * sj;
                const unsigned char* pv_ = (const unsigned char*)A_WR + 4 * srow;
                const unsigned char* ps_ = (const unsigned char*)SCP;
                constexpr int O_WR = 0, O_K2 = 8192, O_V = 16384, O_W = 24576, O_NKK = 32768, O_B = 40960, O_OUT = 57344;
#define RW2_LD_DOT(T) do { n0 = *(const f32x4*)(pk_ + O_NKK + (T) * 256); n1 = *(const f32x4*)(pk_ + O_NKK + (T) * 256 + 16); r0 = *(const f32x4*)(pk_ + O_WR + (T) * 256); r1 = *(const f32x4*)(pk_ + O_WR + (T) * 256 + 16); } while (0)
#define RW2_LD_UPD(T) do { w0_ = *(const f32x4*)(pk_ + O_W + (T) * 256); w1_ = *(const f32x4*)(pk_ + O_W + (T) * 256 + 16); b0 = *(const f32x4*)(pk_ + O_B + (T) * 256); b1 = *(const f32x4*)(pk_ + O_B + (T) * 256 + 16); \
                    k0 = *(const f32x4*)(pk_ + O_K2 + (T) * 256); k1 = *(const f32x4*)(pk_ + O_K2 + (T) * 256 + 16); vv = *(const float*)(pv_ + O_V + (T) * 256); sp = *(const f32x3*)(ps_ + (T) * 16); } while (0)
#define RW2_STEP(T) do { \
                    f32x2 sa2 = S[0] * (f32x2){n0.x, n0.y}; sa2 = S[1] * (f32x2){n0.z, n0.w} + sa2; sa2 = S[2] * (f32x2){n1.x, n1.y} + sa2; sa2 = S[3] * (f32x2){n1.z, n1.w} + sa2; \
                    f32x2 p2 = S[0] * (f32x2){r0.x, r0.y}; p2 = S[1] * (f32x2){r0.z, r0.w} + p2; p2 = S[2] * (f32x2){r1.x, r1.y} + p2; p2 = S[3] * (f32x2){r1.z, r1.w} + p2; \
                    __builtin_amdgcn_sched_barrier(0); RW2_LD_DOT((T) + 1); __builtin_amdgcn_sched_barrier(0); \
                    const float sa = sum8(sa2.x + sa2.y) * sp.x, p = sum8(p2.x + p2.y); \
                    const f32x2 sav = (f32x2){sa, sa}, vvv = (f32x2){vv, vv}; \
                    S[0] = S[0] * (f32x2){w0_.x, w0_.y} + (sav * (f32x2){b0.x, b0.y} + vvv * (f32x2){k0.x, k0.y}); \
                    S[1] = S[1] * (f32x2){w0_.z, w0_.w} + (sav * (f32x2){b0.z, b0.w} + vvv * (f32x2){k0.z, k0.w}); \
                    S[2] = S[2] * (f32x2){w1_.x, w1_.y} + (sav * (f32x2){b1.x, b1.y} + vvv * (f32x2){k1.x, k1.y}); \
                    S[3] = S[3] * (f32x2){w1_.z, w1_.w} + (sav * (f32x2){b1.z, b1.w} + vvv * (f32x2){k1.z, k1.w}); \
                    const float ov = p + sa * sp.y + vv * sp.z; \
                    __builtin_amdgcn_sched_barrier(0); RW2_LD_UPD((T) + 1); *(float*)(const_cast<unsigned char*>(pv_) + O_OUT + (T) * 256) = ov;        __builtin_amdgcn_sched_barrier(0); } while (0)
                RW2_LD_DOT(0); RW2_LD_UPD(0);
#pragma unroll 1
                for (int t4 = 0; t4 < 8; ++t4) {
                    RW2_STEP(0); RW2_STEP(1); RW2_STEP(2); RW2_STEP(3);
                    pk_ += 1024; pv_ += 1024; ps_ += 64;
                }
#undef RW2_LD_DOT
#undef RW2_LD_UPD
#undef RW2_STEP
            }
            S[0] = Ssv[0]; S[1] = Ssv[1]; S[2] = Ssv[2]; S[3] = Ssv[3]; asm volatile("" : "+v"(S[0]), "+v"(S[1]), "+v"(S[2]), "+v"(S[3])); __syncthreads(); }
#endif
            {
                f32x4 nn, rr, ww, bq, kq; f32x3 sp; f32x2 vv2;
                const unsigned char* pk_ = (const unsigned char*)A_WR + 16 * sj;
                const unsigned char* pv_ = (const unsigned char*)A_WR + 4 * srow;
                const unsigned char* ps_ = (const unsigned char*)SCP;
                constexpr int O_WR = 0, O_K2 = 8192, O_V = 16384, O_W = 24576, O_NKK = 32768, O_B = 40960, O_OUT = 57344;
#define SPL(x) ((f32x2){(x), (x)})
#define RW2_DPP1(R, C) "v_add_f32_dpp " R ", " R ", " R " " C " row_mask:0xf bank_mask:0xf bound_ctrl:1\n\t"
#define RW2_DPP4(C) RW2_DPP1("%0", C) RW2_DPP1("%1", C) RW2_DPP1("%2", C) RW2_DPP1("%3", C)
#define RW2_LD_DOT(T) do { nn = *(const f32x4*)(pk_ + O_NKK + (T) * 256); rr = *(const f32x4*)(pk_ + O_WR + (T) * 256); } while (0)
#define RW2_LD_UPD(T) do { ww = *(const f32x4*)(pk_ + O_W + (T) * 256); bq = *(const f32x4*)(pk_ + O_B + (T) * 256); kq = *(const f32x4*)(pk_ + O_K2 + (T) * 256); \
                    vv2 = *(const f32x2*)(pv_ + O_V + (T) * 256); sp = *(const f32x3*)(ps_ + (T) * 16); } while (0)
#define RW2_STEP(T) do { \
                    f32x2 sa2 = S[0] * SPL(nn.x); sa2 = S[1] * SPL(nn.y) + sa2; sa2 = S[2] * SPL(nn.z) + sa2; sa2 = S[3] * SPL(nn.w) + sa2; \
                    f32x2 p2 = S[0] * SPL(rr.x); p2 = S[1] * SPL(rr.y) + p2; p2 = S[2] * SPL(rr.z) + p2; p2 = S[3] * SPL(rr.w) + p2; \
                    __builtin_amdgcn_sched_barrier(0); RW2_LD_DOT((T) + 1); __builtin_amdgcn_sched_barrier(0); \
                    float sx = sa2.x, sy = sa2.y, px = p2.x, py = p2.y; \
                    asm volatile("s_nop 1\n\t" RW2_DPP4("quad_perm:[1,0,3,2]") RW2_DPP4("quad_perm:[2,3,0,1]") RW2_DPP4("row_half_mirror") RW2_DPP4("row_mirror") : "+v"(sx), "+v"(sy), "+v"(px), "+v"(py)); \
                    const f32x2 sav = (f32x2){sx, sy} * SPL(sp.x); \
                    S[0] = S[0] * SPL(ww.x) + (sav * SPL(bq.x) + vv2 * SPL(kq.x)); \
                    S[1] = S[1] * SPL(ww.y) + (sav * SPL(bq.y) + vv2 * SPL(kq.y)); \
                    S[2] = S[2] * SPL(ww.z) + (sav * SPL(bq.z) + vv2 * SPL(kq.z)); \
                    S[3] = S[3] * SPL(ww.w) + (sav * SPL(bq.w) + vv2 * SPL(kq.w)); \
                    const f32x2 ov2 = (f32x2){px, py} + sav * SPL(sp.y) + vv2 * SPL(sp.z); \
                    __builtin_amdgcn_sched_barrier(0); RW2_LD_UPD((T) + 1); *(f32x2*)(const_cast<unsigned char*>(pv_) + O_OUT + (T) * 256) = ov2;        __builtin_amdgcn_sched_barrier(0); } while (0)
                RW2_LD_DOT(0); RW2_LD_UPD(0);
#pragma unroll 1
                for (int t4 = 0; t4 < 8; ++t4) {
                    RW2_STEP(0); RW2_STEP(1); RW2_STEP(2); RW2_STEP(3);
                    pk_ += 1024; pv_ += 1024; ps_ += 64;
                }
#undef RW2_LD_DOT
#undef RW2_LD_UPD
#undef RW2_STEP
#undef SPL
#undef RW2_DPP1
#undef RW2_DPP4
            }
            __syncthreads();
            {
                const int t = c.tid >> 4, part = c.tid & 15;
                const f32x4 v = *(const f32x4*)(A_OUT + t * 64 + 4 * part);
                float s1 = (v.x + v.y) + (v.z + v.w), s2 = (v.x * v.x + v.y * v.y) + (v.z * v.z + v.w * v.w);
                s1 += dpp_mov<0xB1>(s1); s2 += dpp_mov<0xB1>(s2); s1 += dpp_mov<0x4E>(s1); s2 += dpp_mov<0x4E>(s2);
                s1 += dpp_mov<0x141>(s1); s2 += dpp_mov<0x141>(s2); s1 += dpp_mov<0x140>(s1); s2 += dpp_mov<0x140>(s2);
                if (part == 0) { const float mean = s1 * (1.f / 64.f), var = fmaxf(s2 * (1.f / 64.f) - mean * mean, 0.f); GN[t * 2] = mean; GN[t * 2 + 1] = __builtin_amdgcn_rsqf(var + 64e-5f); }
            }
            __syncthreads();
            {
                float ao[4], gm[4], gr[4], bs[4], av[4], ag[4];
                const float lw = CST[320 + l], lb = CST[384 + l];
#pragma unroll
                for (int i = 0; i < 4; ++i) { const int t = w + 8 * i, o = t * 64 + l; ao[i] = A_OUT[o]; gm[i] = GN[t * 2]; gr[i] = GN[t * 2 + 1]; bs[i] = SCP[t * 4 + 3]; av[i] = A_V[o]; ag[i] = A_G[o]; }
#pragma unroll
                for (int i = 0; i < 4; ++i) { const int t = w + 8 * i;
                    float y = (ao[i] - gm[i]) * gr[i] * lw + lb;
                    y = (y + bs[i] * av[i]) * ag[i];
                    if (b < wb) OUT[((size_t)b * SEQ + t0 + t) * ldo + coloff + hk] = (bf16)f2bf(y); }
            }
        }
#undef RW2_LOAD
    }
}
constexpr int S5B_BUP = 132 * 4, S5B_XP = 272;
constexpr int S5B_WAVE = 16 * S5B_BUP + 16 * S5B_XP;
__device__ __forceinline__ void wave_lds_sync() { __builtin_amdgcn_fence(__ATOMIC_RELEASE, "wavefront"); __builtin_amdgcn_wave_barrier(); __builtin_amdgcn_fence(__ATOMIC_ACQUIRE, "wavefront"); }
__device__ __forceinline__ float gelu_fast(float y) { const float u2 = 1.5957691216057308f * (y + 0.044715f * y * y * y); return y * __builtin_amdgcn_rcpf(1.f + __expf(-u2)); }
__device__ __forceinline__ void s5_phase2(const Ctx& c, const bf16* __restrict__ U, const S5P P, bf16* Z) {
    if (c.wave >= 4) return;
    float* BU = (float*)(c.lds + c.wave * S5B_WAVE); unsigned char* XB = c.lds + c.wave * S5B_WAVE + 16 * S5B_BUP;
    const int l = c.lane, n16 = l & 15, g = l >> 4;
#pragma unroll 1
    for (int item = c.bid; item < 256; item += c.nb) {
        const int b = item >> 5, grp = (item & 31) * 4 + c.wave;
        float lbr, lbi;
        { const float lr = fminf(P.lam_re[grp * 64 + l], -1e-4f), li = P.lam_im[grp * 64 + l], dt = expf(P.log_dt[grp]);
          const float e = expf(lr * dt); lbr = e * cosf(li * dt); lbi = e * sinf(li * dt);
          const float nr = lbr - 1.f, ni = lbi, den = 1.f / (lr * lr + li * li);
          BU[l] = (nr * lr + ni * li) * den; BU[64 + l] = (ni * lr - nr * li) * den; }
        wave_lds_sync();
        bf16x4 Bre[4], Bim[4];
#pragma unroll
        for (int nt = 0; nt < 4; ++nt) { const int p = 16 * nt + n16; const float cr = BU[p], ci = BU[64 + p];
            const f32x4 br = *(const f32x4*)(P.b_re + (size_t)(grp * 64 + p) * 16 + 4 * g), bi = *(const f32x4*)(P.b_im + (size_t)(grp * 64 + p) * 16 + 4 * g);
            u32x2 wr, wi; wr.x = pk2(cr * br.x - ci * bi.x, cr * br.y - ci * bi.y); wr.y = pk2(cr * br.z - ci * bi.z, cr * br.w - ci * bi.w);
            wi.x = pk2(cr * bi.x + ci * br.x, cr * bi.y + ci * br.y); wi.y = pk2(cr * bi.z + ci * br.z, cr * bi.w + ci * br.w);
            Bre[nt] = __builtin_bit_cast(bf16x4, wr); Bim[nt] = __builtin_bit_cast(bf16x4, wi); }
        wave_lds_sync();
        bf16x8 Cf[4];
#pragma unroll
        for (int kk = 0; kk < 4; ++kk) { const int p0 = 16 * kk + 4 * g;
            const f32x4 vr = *(const f32x4*)(P.c_re + (size_t)(grp * 16 + n16) * 64 + p0), vi = *(const f32x4*)(P.c_im + (size_t)(grp * 16 + n16) * 64 + p0);
            u32x4 w; w.x = pk2(vr.x, -vi.x); w.y = pk2(vr.y, -vi.y); w.z = pk2(vr.z, -vi.z); w.w = pk2(vr.w, -vi.w); Cf[kk] = __builtin_bit_cast(bf16x8, w); }
        bf16x4 Df; { const float dsk = P.d[grp * 16 + n16]; const int kq = n16 - 4 * g; u32x2 w; w.x = pk2(kq == 0 ? dsk : 0.f, kq == 1 ? dsk : 0.f); w.y = pk2(kq == 2 ? dsk : 0.f, kq == 3 ? dsk : 0.f); Df = __builtin_bit_cast(bf16x4, w); }
        f32x2 xs = (f32x2){0.f, 0.f};
        const bf16* ub = U + (size_t)b * SEQ * D + grp * 16;
        u32x2 ua[4];
#define S5B_LOAD(k, T0) do { ua[k] = *(const u32x2*)(ub + (size_t)((T0) + n16) * D + 4 * g); } while (0)
#pragma unroll
        for (int k = 0; k < 4; ++k) S5B_LOAD(k, 16 * k);
#pragma unroll 1
        for (int t0 = 0; t0 < SEQ; t0 += 64) {
#pragma unroll
            for (int k = 0; k < 4; ++k) {
                const int tb = t0 + 16 * k;
                const bf16x4 A = __builtin_bit_cast(bf16x4, ua[k]);
                { const int tn = (tb + 64 < SEQ) ? tb + 64 : tb; S5B_LOAD(k, tn); }
                const f32x4 yd = __builtin_amdgcn_mfma_f32_16x16x16bf16_1k(A, Df, (f32x4){0.f, 0.f, 0.f, 0.f}, 0, 0, 0);
#pragma unroll
                for (int nt = 0; nt < 4; ++nt) {
                    const f32x4 ar = __builtin_amdgcn_mfma_f32_16x16x16bf16_1k(A, Bre[nt], (f32x4){0.f, 0.f, 0.f, 0.f}, 0, 0, 0);
                    const f32x4 ai = __builtin_amdgcn_mfma_f32_16x16x16bf16_1k(A, Bim[nt], (f32x4){0.f, 0.f, 0.f, 0.f}, 0, 0, 0);
#pragma unroll
                    for (int r = 0; r < 4; ++r) *(f32x2*)(BU + (4 * g + r) * 132 + 2 * (16 * nt + n16)) = (f32x2){ar[r], ai[r]};
                }
                wave_lds_sync();
#pragma unroll 4
                for (int t = 0; t < 16; ++t) {
                    const f32x2 bu = *(const f32x2*)(BU + t * 132 + 2 * l);
                    const f32x2 tq = (f32x2){lbr, lbr} * xs + bu;
                    xs = (f32x2){-lbi, lbi} * (f32x2){xs.y, xs.x} + tq;
                    *(unsigned*)(XB + t * S5B_XP + l * 4) = pg8::cvt_pk_bf16(xs.x, xs.y);
                }
                wave_lds_sync();
                f32x4 y = (f32x4){0.f, 0.f, 0.f, 0.f};
#pragma unroll
                for (int kk = 0; kk < 4; ++kk) { const bf16x8 Ax = *(const bf16x8*)(XB + n16 * S5B_XP + (32 * kk + 8 * g) * 2); y = __builtin_amdgcn_mfma_f32_16x16x32_bf16(Ax, Cf[kk], y, 0, 0, 0); }
#pragma unroll
                for (int r = 0; r < 4; ++r) Z[((size_t)b * SEQ + tb + 4 * g + r) * D + grp * 16 + n16] = (bf16)f2bf(gelu_fast(y[r] + yd[r]));
                wave_lds_sync();
            }
        }
#undef S5B_LOAD
    }
}
struct Args { const void* in[45]; float* out; unsigned char* ws; int ph_lo, ph_hi; };
static_assert(sizeof(Args) == 45 * 8 + 8 + 8 + 8, "Args has no padding");
constexpr int PH_EVEN = 9, PH_ODD = 4, PH_COMMON = 13;
constexpr int NPHASES = 2 * (1 + PH_EVEN + PH_COMMON) + 2 * (1 + PH_ODD + PH_COMMON) + 1;

__global__ void __launch_bounds__(NTHR, 2) mega(Args args) {
    extern __shared__ __attribute__((aligned(16))) unsigned char lds[];
    volatile LAS unsigned* MISC = (volatile LAS unsigned*)((LAS unsigned char*)lds + MISC_OFF);
    if (threadIdx.x < 64) MISC[threadIdx.x] = 0u;
    __syncthreads();
    unsigned char* ws = args.ws;
    XcdBarrier bar = xcd_barrier_post((unsigned*)(ws + WS_CTL) + 4096, MISC + 8, gridDim.x);
    const int half = (int)gridDim.x >> 1;
    XcdBarrier bar2 = bar; if ((int)blockIdx.x >= half) bar2 = xcd_barrier_post((unsigned*)(ws + WS_CTL) + 8192, MISC + 10, gridDim.x - half);
    const int lo = args.ph_lo, hi = args.ph_hi;
    int pid = 0;
#define PH_BEGIN if (pid >= lo && pid < hi) { Ctx c; { int t_ = threadIdx.x, b_ = blockIdx.x; asm volatile("" : "+v"(t_)); asm volatile("" : "+s"(b_)); c.lds = lds; c.tid = t_; c.lane = t_ & 63; c.wave = __builtin_amdgcn_readfirstlane(t_ >> 6); c.bid = b_; { int n_ = gridDim.x; asm volatile("" : "+s"(n_)); c.nb = n_; } c.gw = c.bid * NWAVES + c.wave; c.ngw = c.nb * NWAVES; }
#define PH_END } if (pid >= lo && pid + 1 < hi) { xcd_barrier(bar); if (DBL & 2048) xcd_barrier(bar); } ++pid;
#define IN_F(i) (*(const float* const __attribute__((address_space(4)))*)(KARGS() + 8 * (i)))

    typedef const unsigned char __attribute__((address_space(4)))* kptr_t;
#define KARGS() ({ kptr_t p_ = (kptr_t)__builtin_amdgcn_kernarg_segment_ptr(); asm volatile("" : "+s"(p_)); p_; })
#define WSP(off) ((*(unsigned char* const __attribute__((address_space(4)))*)(KARGS() + 368)) + (off))
#define X ((float*)(*(float* const __attribute__((address_space(4)))*)(KARGS() + 360)))
#define ROPEA ((float*)WSP(WS_ROPEA))
#define ROPEI ((float*)WSP(WS_ROPEI))
#define KVBIG ((bf16*)WSP(WS_KVBIG))
#define WKV ((bf16*)WSP(WS_WKV))
#define W_IN ((bf16*)WSP(WS_WMIX + WMIX_IN))
#define WQ ((bf16*)WSP(WS_WMIX + WMIX_Q))
#define WOUT ((bf16*)WSP(WS_WMIX + WMIX_OUT))
#define WO_IN ((bf16*)WSP(WS_WMIX + WMIX_O_IN))
#define WO_GLU ((bf16*)WSP(WS_WMIX + WMIX_O_GLU))
#define WO_OUT ((bf16*)WSP(WS_WMIX + WMIX_O_OUT))
#define WXQ ((bf16*)WSP(WS_WXQ))
#define WXO ((bf16*)WSP(WS_WXO))
#define WUP ((bf16*)WSP(WS_WUP))
#define WDN ((bf16*)WSP(WS_WDN))
#define CQN ((bf16*)WSP(WS_CQN))
#define KF ((bf16*)WSP(WS_KF))
#define KIDX ((bf16*)WSP(WS_KIDX))
#define WIDX ((float*)WSP(WS_WIDX))
#define SEL ((bf16*)WSP(WS_SEL))
#define Hb ((bf16*)WSP(WS_R1))
#define SC ((float*)WSP(WS_R1))
#define HID ((bf16*)WSP(WS_R1))
#define Ub ((bf16*)WSP(WS_R1))
#define YC ((bf16*)WSP(WS_R1 + (size_t)M * D * 2))
#define XN ((bf16*)WSP(WS_R2))
#define QALL ((bf16*)X)
#define OLY ((bf16*)WSP(WS_R3))
#define Zb ((bf16*)WSP(WS_R3))
#define XQ ((bf16*)WSP(WS_R3))
#define XO ((bf16*)WSP(WS_R3 + (size_t)M * 512 * 2))
#define MEMN ((bf16*)WSP(WS_R3))
    LAS unsigned char* glds = (LAS unsigned char*)lds;

#define RS_A ((unsigned long long*)WSP(WS_CTL + 131072))
#define RS_B ((unsigned long long*)WSP(WS_CTL + 393216))
#define RS_C ((unsigned long long*)WSP(WS_CTL + 655360))
    for (int layer = 0; layer < DEPTH; ++layer) {
        const int li = layer >> 1;
        PH_BEGIN
#define ROTC(r_) Ctx cr = c; cr.gw = (c.gw + c.ngw - ((r_) % c.ngw)) % c.ngw
            if ((layer & 1) == 0) {
                conv_mat(c, IN_F(13) + (size_t)li * 2048 * EVEN_COLS, 2048, EVEN_COLS, EVEN_COLS, HC, W_IN, 2048, 0, 0, IN_F(3) + layer * D);
                build_wql(c, IN_F(18) + (size_t)li * 512 * 1024, IN_F(19) + (size_t)li * 256 * 768, WQ);
                for (int h = 0; h < 8; ++h) { ROTC(4352 + 8 * h); conv_mat(cr, IN_F(18) + (size_t)li * 512 * 1024 + h * 128, 512, 1024, 32, 32, WQ, 512, 2048 + h * 32, 0); }
                { ROTC(4352 + 64); conv_mat(cr, IN_F(21) + (size_t)li * 512 * 1024, 512, 1024, 1024, 1024, WQ, 512, 2304, 0); }
                build_wout(c, IN_F(20) + (size_t)li * 256 * 1024, IN_F(14) + (size_t)li * 2048 * 2048, WOUT);
                { ROTC(4352 + 64 + 256); conv_mat(cr, IN_F(14) + (size_t)li * 2048 * 2048 + (size_t)1024 * 2048, 1024, 2048, 2048, 2048, WOUT, OC, 0, 2048); }
                { ROTC(4352 + 64 + 256 + 1024); conv_mat(cr, IN_F(8) + (size_t)layer * 2048 * 512, 2048, 512, 512, 512, WXQ, 2048, 0, 0, IN_F(4) + layer * D); }
                { ROTC(4352 + 64 + 256 + 1024 + 512); conv_mat(cr, IN_F(10) + (size_t)layer * 512 * 2048, 512, 2048, 2048, 2048, WXO, 512, 0, 0); }
            } else {
                conv_mat(c, IN_F(33) + (size_t)li * 2048 * 2048, 2048, 2048, 2048, 2048, WO_IN, 2048, 0, 0, IN_F(3) + layer * D);
            }
#undef ROTC
            { unsigned long long* ra = RS_A; unsigned long long* rb = RS_B; for (int i = c.bid * NTHR + c.tid; i < M; i += c.nb * NTHR) { ra[i] = 0ull; rb[i] = 0ull; } }
            if (layer == 0) {
                for (int l2 = 0; l2 < 4; ++l2) {
                    { Ctx cr = c; cr.gw = (c.gw + c.ngw - ((l2 * 1024) % c.ngw)) % c.ngw; conv_mat(cr, IN_F(9) + (size_t)l2 * 2048 * 1024, 2048, 1024, 1024, 1024, WKV, 2048, l2 * 1024, 0); }
                    norm_rows_bf16(c, IN_F(1), IN_F(5) + l2 * D, MEMN + (size_t)l2 * MEMR * D, MEMR);
                }
                rope_tables(c, (const int*)IN_F(2), ROPEA, ROPEI);
                cast_rows_ss(c, IN_F(0), XN, RS_C, M);
            }
#if DBL & 1
            __syncthreads();
            if ((layer & 1) == 0) {
                conv_mat(c, IN_F(13) + (size_t)li * 2048 * EVEN_COLS, 2048, EVEN_COLS, EVEN_COLS, HC, W_IN, 2048, 0, 0, IN_F(3) + layer * D);
                build_wql(c, IN_F(18) + (size_t)li * 512 * 1024, IN_F(19) + (size_t)li * 256 * 768, WQ);
                for (int h = 0; h < 8; ++h) conv_mat(c, IN_F(18) + (size_t)li * 512 * 1024 + h * 128, 512, 1024, 32, 32, WQ, 512, 2048 + h * 32, 0);
                conv_mat(c, IN_F(21) + (size_t)li * 512 * 1024, 512, 1024, 1024, 1024, WQ, 512, 2304, 0);
                build_wout(c, IN_F(20) + (size_t)li * 256 * 1024, IN_F(14) + (size_t)li * 2048 * 2048, WOUT);
                conv_mat(c, IN_F(14) + (size_t)li * 2048 * 2048 + (size_t)1024 * 2048, 1024, 2048, 2048, 2048, WOUT, OC, 0, 2048);
            } else {
                conv_mat(c, IN_F(33) + (size_t)li * 2048 * 2048, 2048, 2048, 2048, 2048, WO_IN, 2048, 0, 0, IN_F(3) + layer * D);
                conv_mat(c, IN_F(43) + (size_t)li * 2048 * 2048, 2048, 2048, 2048, 2048, WO_GLU, 2048, 0, 0);
                conv_mat(c, IN_F(34) + (size_t)li * 2048 * 2048, 2048, 2048, 2048, 2048, WO_OUT, 2048, 0, 0);
            }
            conv_mat(c, IN_F(8) + (size_t)layer * 2048 * 512, 2048, 512, 512, 512, WXQ, 2048, 0, 0, IN_F(4) + layer * D);
            conv_mat(c, IN_F(10) + (size_t)layer * 512 * 2048, 512, 2048, 2048, 2048, WXO, 512, 0, 0);
            { unsigned long long* ra = RS_A; unsigned long long* rb = RS_B; for (int i = c.bid * NTHR + c.tid; i < M; i += c.nb * NTHR) { ra[i] = 0ull; rb[i] = 0ull; } }
            if (layer == 0) {
                for (int l2 = 0; l2 < 4; ++l2) {
                    conv_mat(c, IN_F(9) + (size_t)l2 * 2048 * 1024, 2048, 1024, 1024, 1024, WKV, 2048, l2 * 1024, 0);
                    norm_rows_bf16(c, IN_F(1), IN_F(5) + l2 * D, MEMN + (size_t)l2 * MEMR * D, MEMR);
                }
                rope_tables(c, (const int*)IN_F(2), ROPEA, ROPEI);
                cast_rows_ss(c, IN_F(0), XN, RS_C, M);
            }
#endif
        PH_END
        if ((layer & 1) == 0) {
            PH_BEGIN
                { pg8::Gemm g{XN, W_IN, 2048, 2048, 2048}; pg8::StaticOrder S; S.init(128, HC / 256, c.nb, c.bid); pg8::EpiBf16<0> E{Hb, HC, RS_C};
                  pg8::gemm_phase<pg8::EpiBf16<0>, pg8::StaticOrder, true, true>(glds, g, S, E);
                  if (DBL & 1024) { __syncthreads(); pg8::gemm_phase<pg8::EpiBf16<0>, pg8::StaticOrder, true, true>(glds, g, S, E); } }
                if (layer == 0) { __syncthreads(); pg8::Gemm g{MEMN, WKV, 2048, 2048, 2048}; pg8::KvOrder S{c.nb, (c.bid + (c.nb >> 1)) % c.nb};        pg8::EpiBf16<0> E{KVBIG, 4096, nullptr};
                  pg8::gemm_phase<pg8::EpiBf16<0>, pg8::KvOrder, true, true>(glds, g, S, E); }
                else if (c.bid >= half) {
                    __syncthreads(); Ctx d = c; d.bid = c.bid - half; d.nb = c.nb - half; d.gw = d.bid * NWAVES + d.wave; d.ngw = d.nb * NWAVES;
                    conv_mat(d, IN_F(12) + (size_t)layer * FFN * 2048, FFN, 2048, 2048, 2048, WDN, FFN, 0, 0); }
            PH_END
            PH_BEGIN
                rwkv_lora_prep(c, Hb, IN_F(22) + li * B_COLS, (bf16*)WSP(WS_END + 96 * MiB));
            PH_END
            PH_BEGIN
                if (c.bid < half) {
                    Ctx r = c; r.nb = half; r.ngw = half * NWAVES;
                    const RwkvP P{IN_F(22) + li * B_COLS, IN_F(23) + li * 1024, IN_F(24) + (size_t)li * 65536, IN_F(25) + li * 1024, IN_F(26) + (size_t)li * 65536, IN_F(27) + (size_t)li * 163840,
                                  IN_F(28) + li * 1024, IN_F(29) + li * 1024, IN_F(30) + li * 1024, IN_F(31) + li * 1024, IN_F(32) + li * 1024};
#if DIAG == 4
                    rwkv_phase(r, Hb, P, OLY);
                    rwkv_phase2(r, Hb, (const bf16*)WSP(WS_END + 96 * MiB), P, (bf16*)WSP(WS_END + 116 * MiB), 1024, 0, 1);
#else
                    rwkv_phase2(r, Hb, (const bf16*)WSP(WS_END + 96 * MiB), P, OLY, OC, 2048);
#endif
                    __syncthreads();
                    if (layer == 0) conv_mat(r, IN_F(12) + (size_t)layer * FFN * 2048, FFN, 2048, 2048, 2048, WDN, FFN, 0, 0);
                } else {
                    Ctx d = c; d.bid = c.bid - half; d.nb = c.nb - half; d.gw = d.bid * NWAVES + d.wave; d.ngw = d.nb * NWAVES;
                    dsa_prep(d, Hb, IN_F(15) + li * 512, IN_F(16) + li * 256, IN_F(17) + li * 64, ROPEA, ROPEI, CQN, KF, KIDX, WIDX);
                    xcd_barrier(bar2);
                    { pg8::Gemm g{CQN, WQ, 512, 512, 512}; pg8::StaticOrder S; S.init(128, QC / 256, d.nb, d.bid); pg8::EpiBf16<0> E{QALL, QC, nullptr};
                      pg8::gemm_phase<pg8::EpiBf16<0>, pg8::StaticOrder, true, true>(glds, g, S, E); }
                    xcd_barrier(bar2);
                    idx_topk_mfma(d, QALL, KIDX, WIDX, ROPEI, (float*)(d.bid < 32 ? WSP(WS_CQN + (size_t)d.bid * MiB) : WSP(WS_END + (size_t)(d.bid - 32) * MiB)), SEL, 256);
                    conv_mat(d, IN_F(11) + (size_t)layer * 2048 * FFN, 2048, FFN, FFN, FFN, WUP, 2048, 0, 0, IN_F(6) + layer * D);
                    xcd_barrier(bar2);
                    if (d.bid == 0 && c.tid == 0) __hip_atomic_store((unsigned*)WSP(WS_CTL) + 12288 + 64 * (2 + li), 1u, __ATOMIC_RELAXED, __HIP_MEMORY_SCOPE_AGENT);
                }
                if (c.bid < half) {
                    if (c.tid == 0) { unsigned* fl = (unsigned*)WSP(WS_CTL) + 12288 + 64 * (2 + li); unsigned sp = 0;
                        while (__hip_atomic_load(fl, __ATOMIC_RELAXED, __HIP_MEMORY_SCOPE_AGENT) == 0u) { __builtin_amdgcn_s_sleep(8); if (++sp > (1u << 22)) break; } }
                    __syncthreads();
                    __builtin_amdgcn_fence(__ATOMIC_ACQUIRE, "agent"); asm volatile("s_waitcnt vmcnt(0)" ::: "memory");
                }
                dsa_attn_queue(c, QALL, KF, SEL, ROPEA, OLY, (unsigned*)WSP(WS_CTL) + 12288 + 64 * li, MISC + 12);
            PH_END
#if DBL & 32
            PH_BEGIN
                if (c.bid < half) {
                    Ctx r = c; r.nb = half; r.ngw = half * NWAVES;
                    const RwkvP P{IN_F(22) + li * B_COLS, IN_F(23) + li * 1024, IN_F(24) + (size_t)li * 65536, IN_F(25) + li * 1024, IN_F(26) + (size_t)li * 65536, IN_F(27) + (size_t)li * 163840,
                                  IN_F(28) + li * 1024, IN_F(29) + li * 1024, IN_F(30) + li * 1024, IN_F(31) + li * 1024, IN_F(32) + li * 1024};
                    rwkv_phase2(r, Hb, (const bf16*)WSP(WS_END + 96 * MiB), P, OLY, OC, 2048);
                }
            PH_END
#endif
#if DBL & 8
            PH_BEGIN
                if (c.bid >= half) {
                    Ctx d = c; d.bid = c.bid - half; d.nb = c.nb - half; d.gw = d.bid * NWAVES + d.wave; d.ngw = d.nb * NWAVES;
                    idx_topk_mfma(d, QALL, KIDX, WIDX, ROPEI, (float*)(d.bid < 32 ? WSP(WS_CQN + (size_t)d.bid * MiB) : WSP(WS_END + (size_t)(d.bid - 32) * MiB)), SEL, 256);
                }
            PH_END
#endif
#if DIAG == 4
            PH_BEGIN
                diag_cmp_bf16(c, OLY + 2048, OC, (bf16*)WSP(WS_END + 116 * MiB), 1024, SEQ, 1024, (float*)WSP(WS_CTL + 65536));
            PH_END
#endif
#if DIAG == 7 || DIAG == 8
            PH_BEGIN
                q_rope_fix(c, QALL, ROPEA, ROPEI);
            PH_END
#endif
#if DIAG == 7
            PH_BEGIN
                if (c.bid >= half) { Ctx d = c; d.bid = c.bid - half; d.nb = c.nb - half; d.gw = d.bid * NWAVES + d.wave; d.ngw = d.nb * NWAVES;
                    idx_topk_v1(d, QALL, KIDX, WIDX, (float*)(d.bid < 32 ? WSP(WS_CQN + (size_t)d.bid * MiB) : WSP(WS_END + (size_t)(d.bid - 32) * MiB)), (bf16*)WSP(WS_END + 116 * MiB), 128); }
            PH_END
            PH_BEGIN
                diag_cmp_sel(c, SEL, (bf16*)WSP(WS_END + 116 * MiB), 4, (float*)WSP(WS_CTL + 65536));
            PH_END
#endif
#if DIAG == 8
            PH_BEGIN
                dsa_attn_simple(c, QALL, KF, SEL, (bf16*)WSP(WS_END + 116 * MiB), 1024);
            PH_END
            PH_BEGIN
                diag_cmp_bf16(c, OLY, OC, (bf16*)WSP(WS_END + 116 * MiB), OC, 1024, 2048, (float*)WSP(WS_CTL + 65536));
            PH_END
#endif
            PH_BEGIN
                { pg8::Gemm g{OLY, WOUT, OC, OC, OC}; pg8::StaticOrder S; S.init(128, 8, c.nb, c.bid); pg8::EpiRes E{XN, D, RS_A};
                  pg8::gemm_phase<pg8::EpiRes, pg8::StaticOrder, true, true>(glds, g, S, E); }
            PH_END
        } else {
            PH_BEGIN
                { pg8::Gemm g{XN, WO_IN, 2048, 2048, 2048}; pg8::StaticOrder S; S.init(128, 8, c.nb, c.bid); pg8::EpiBf16<0> E{Ub, D, RS_C};
                  pg8::gemm_phase<pg8::EpiBf16<0>, pg8::StaticOrder, true, true>(glds, g, S, E);
                  if (DBL & 1024) { __syncthreads(); pg8::gemm_phase<pg8::EpiBf16<0>, pg8::StaticOrder, true, true>(glds, g, S, E); } }
            PH_END
            PH_BEGIN
                { const S5P P{IN_F(35) + li * 8192, IN_F(36) + li * 8192, IN_F(37) + li * 128, IN_F(38) + (size_t)li * 131072, IN_F(39) + (size_t)li * 131072, IN_F(40) + (size_t)li * 131072, IN_F(41) + (size_t)li * 131072, IN_F(42) + li * D};
                  s5_phase2(c, Ub, P, Zb); }
                if (c.wave >= 4) {
                    Ctx v = c; v.lds = c.lds + 65536 - 4 * 8704; v.gw = c.bid * 4 + (c.wave - 4); v.ngw = c.nb * 4;
                    conv_mat(v, IN_F(11) + (size_t)layer * 2048 * FFN, 2048, FFN, FFN, FFN, WUP, 2048, 0, 0, IN_F(6) + layer * D);
                    conv_mat(v, IN_F(12) + (size_t)layer * FFN * 2048, FFN, 2048, 2048, 2048, WDN, FFN, 0, 0);
                    conv_mat(v, IN_F(43) + (size_t)li * 2048 * 2048, 2048, 2048, 2048, 2048, WO_GLU, 2048, 0, 0);
                    conv_mat(v, IN_F(34) + (size_t)li * 2048 * 2048, 2048, 2048, 2048, 2048, WO_OUT, 2048, 0, 0);
                    conv_mat(v, IN_F(8) + (size_t)layer * 2048 * 512, 2048, 512, 512, 512, WXQ, 2048, 0, 0, IN_F(4) + layer * D);
                    { Ctx vr = v; vr.gw = (v.gw + v.ngw - (512 % v.ngw)) % v.ngw; conv_mat(vr, IN_F(10) + (size_t)layer * 512 * 2048, 512, 2048, 2048, 2048, WXO, 512, 0, 0); }
                }
            PH_END
#if DIAG == 5
            PH_BEGIN
                { const S5P P{IN_F(35) + li * 8192, IN_F(36) + li * 8192, IN_F(37) + li * 128, IN_F(38) + (size_t)li * 131072, IN_F(39) + (size_t)li * 131072, IN_F(40) + (size_t)li * 131072, IN_F(41) + (size_t)li * 131072, IN_F(42) + li * D};
                  s5_phase(c, Ub, P, YC); }
            PH_END
            PH_BEGIN
                diag_cmp_bf16(c, YC, D, Zb, D, M, D, (float*)WSP(WS_CTL + 65536));
            PH_END
#endif
            PH_BEGIN
                { pg8::Gemm g{Zb, WO_GLU, 2048, 2048, 2048}; pg8::StaticOrder S; S.init(128, 8, c.nb, c.bid); pg8::EpiGlu E{Zb, YC, D, IN_F(44) + li * D};
                  pg8::gemm_phase<pg8::EpiGlu, pg8::StaticOrder, true, true>(glds, g, S, E); }
            PH_END
            PH_BEGIN
                { pg8::Gemm g{YC, WO_OUT, 2048, 2048, 2048}; pg8::StaticOrder S; S.init(128, 8, c.nb, c.bid); pg8::EpiRes E{XN, D, RS_A};
                  pg8::gemm_phase<pg8::EpiRes, pg8::StaticOrder, true, true>(glds, g, S, E); }
            PH_END
        }
        PH_BEGIN
            { unsigned long long* rc = RS_C; for (int i = c.bid * NTHR + c.tid; i < M; i += c.nb * NTHR) rc[i] = 0ull; }
            { pg8::Gemm g{XN, WXQ, 2048, 2048, 2048}; pg8::StaticOrder S; S.init(128, 2, c.nb, c.bid); pg8::EpiBf16<0> E{XQ, 512, RS_A};
              pg8::gemm_phase<pg8::EpiBf16<0>, pg8::StaticOrder, true, true>(glds, g, S, E); }
        PH_END
        PH_BEGIN
            xattn_mfma(c, XQ, KVBIG, layer, XO); if (DBL & 128) { asm volatile("" ::: "memory"); xattn_mfma(c, XQ, KVBIG, layer, XO); }
        PH_END
        PH_BEGIN
            { pg8::Gemm g{XO, WXO, 512, 512, 512}; pg8::StaticOrder S; S.init(128, 8, c.nb, c.bid); pg8::EpiRes E{XN, D, RS_B};
              pg8::gemm_phase<pg8::EpiRes, pg8::StaticOrder, true, true>(glds, g, S, E); }
        PH_END
        for (int q = 0; q < 5; ++q) {
            PH_BEGIN
                if (q > 0) { const int qd = q - 1; bf16* hid = HID + (size_t)(qd & 1) * 8192 * FFN;
                    pg8::Gemm g{hid, WDN, FFN, FFN, FFN}; pg8::StaticOrder S; S.init(32, 8, c.nb, c.bid, DN_WGM); pg8::EpiRes E{XN + (size_t)qd * 8192 * D, D, RS_C + qd * 8192};
                    pg8::gemm_phase<pg8::EpiRes, pg8::StaticOrder, true, true>(glds, g, S, E); __syncthreads(); }
                if (q < 4) { bf16* hid = HID + (size_t)(q & 1) * 8192 * FFN;
                    pg8::Gemm g{XN + (size_t)q * 8192 * D, WUP, 2048, 2048, 2048}; pg8::StaticOrder S; S.init(32, 32, c.nb, c.bid, UP_WGM); pg8::EpiBf16<1> E{hid, FFN, RS_B + q * 8192};
                    pg8::gemm_phase<pg8::EpiBf16<1>, pg8::StaticOrder, true, true>(glds, g, S, E); }
            PH_END
        }
    }
    PH_BEGIN
        scale_rows_out(c, XN, IN_F(7), RS_C, X, M);
    PH_END
#if DIAG
    PH_BEGIN
        { const float* dg = (const float*)WSP(WS_CTL + 65536); const float sc = 1.f + sqrtf(100.f * dg[0] / fmaxf(dg[1], 1e-30f));
          float* xo = X; for (size_t i = (size_t)c.bid * NTHR + c.tid; i < (size_t)M * D; i += (size_t)c.nb * NTHR) xo[i] *= sc; }
    PH_END
#endif
#undef PH_BEGIN
#undef PH_END
#undef IN_F
#undef X
}

extern "C" void kernel_launch(void* const* d_in, const int* in_sizes, int n_in, void* d_out, int out_size, void* d_ws, size_t ws_size, hipStream_t stream) {
    static int grid = 0;
    if (grid == 0) {
        if (n_in != 45 || out_size != M * D || ws_size < WS_END + 116 * MiB) { fprintf(stderr, "kernel_launch: unexpected shapes (n_in %d, out %d, ws %zu, need %zu)\n", n_in, out_size, ws_size, (size_t)WS_END); grid = -1; return; }
        int dev = 0, cus = 0, per_cu = 0;
        if (hipGetDevice(&dev) != hipSuccess || hipDeviceGetAttribute(&cus, hipDeviceAttributeMultiprocessorCount, dev) != hipSuccess) { grid = -1; return; }
        if (hipFuncSetAttribute((const void*)mega, hipFuncAttributeMaxDynamicSharedMemorySize, LDS_BYTES) != hipSuccess) { fprintf(stderr, "kernel_launch: hipFuncSetAttribute failed\n"); grid = -1; return; }
        if (hipOccupancyMaxActiveBlocksPerMultiprocessor(&per_cu, (const void*)mega, NTHR, LDS_BYTES) != hipSuccess || per_cu < 1) fprintf(stderr, "kernel_launch: occupancy query reports %d\n", per_cu);
        (void)hipGetLastError();
        grid = cus;
    }
    if (grid < 0) return;
    (void)hipMemsetAsync((char*)d_ws + WS_CTL, 0, CTL_BYTES, stream);
    Args a{};
    for (int i = 0; i < 45; ++i) a.in[i] = d_in[i];
    a.out = (float*)d_out; a.ws = (unsigned char*)d_ws;
#if MK_ONE_LAUNCH
    a.ph_lo = 0; a.ph_hi = 1 << 20;
    hipLaunchKernelGGL(mega, dim3(grid), dim3(NTHR), LDS_BYTES, stream, a);
#else
    for (int p = 0; p < NPHASES; ++p) { a.ph_lo = p; a.ph_hi = p + 1; hipLaunchKernelGGL(mega, dim3(grid), dim3(NTHR), LDS_BYTES, stream, a); }
#endif
}
```
